# Optimizing an MI355X kernel written in HIP

```python
import math
import jax, jax.numpy as jnp
from jax import lax
import numpy as np

D_MODEL = 2048
BATCH = 4
SEQ = 2048
DEPTH = 1

F32 = jnp.float32
D_MIX = D_MODEL
HG_WIDTH = D_MIX // 2
HG_HEAD_DIM = 128
HG_HEADS = HG_WIDTH // HG_HEAD_DIM
HG_CHUNK = 64
HY_WIDTH = D_MIX - HG_WIDTH
HY_ORDER = 2
HY_SHORT = 3
HY_EMB = 33
HY_BANDS = (HY_EMB - 1) // 2
HY_FILTER_HIDDEN = 64
HY_FAST_DECAY_PCT = 0.3
HY_SLOW_DECAY_PCT = 1.5
HY_DECAY_TARGET = 1e-2
N_EXPERTS = 32
TOP_K = 4
D_FF = D_MODEL
SWIGLU_ALPHA = 1.702
SWIGLU_LIMIT = 7.0
MOE_BLOCK = 128
NORM_EPS = 1e-5
D_IN = 5 * HG_WIDTH + (HY_ORDER + 1) * HY_WIDTH

kernel_name = 'hymba_hgrn2_hyena_moe_encoder'


def rms_norm(x, gain):
    xf = x.astype(F32)
    y = xf * lax.rsqrt(jnp.mean(xf * xf, axis=-1, keepdims=True) + NORM_EPS)
    return (y * gain.astype(F32)).astype(x.dtype)


def hgrn_lower_bounds(lb_logits):
    p = jax.nn.softmax(lb_logits.astype(F32), axis=0)
    return jnp.cumsum(p, axis=0)[:DEPTH]


def gla_scan(q, k, v, log_f):
    B, H, L, DK = q.shape
    DV = v.shape[-1]
    n = L // HG_CHUNK

    def chunks(a):
        return jnp.moveaxis(a.reshape(B, H, n, HG_CHUNK, a.shape[-1]), 2, 0)

    lower = jnp.tril(jnp.ones((HG_CHUNK, HG_CHUNK), bool))[:, :, None]

    def step(state, inp):
        qc, kc, vc, gc = inp
        b = jnp.cumsum(gc, axis=2)
        b_last = b[:, :, -1:, :]
        o_inter = jnp.einsum('bhtk,bhkv->bhtv', qc * jnp.exp(b), state)
        decay = jnp.exp(jnp.where(lower, b[:, :, :, None, :] - b[:, :, None, :, :], -jnp.inf))
        scores = jnp.einsum('bhtsk,bhsk->bhts', qc[:, :, :, None, :] * decay, kc)
        o_intra = jnp.einsum('bhts,bhsv->bhtv', scores, vc)
        new_state = (jnp.exp(b_last[:, :, 0, :])[..., None] * state
                     + jnp.einsum('bhsk,bhsv->bhkv', kc * jnp.exp(b_last - b), vc))
        return new_state, o_inter + o_intra

    s0 = jnp.zeros((B, H, DK, DV), F32)
    _, o = lax.scan(step, s0, (chunks(q), chunks(k), chunks(v), chunks(log_f)))
    return jnp.moveaxis(o, 0, 2).reshape(B, H, L, DV)


def hgrn2_mixer(q_raw, zf_fwd, zf_bwd, i_raw, g_raw, lb, norm_gain):
    B, L, _ = q_raw.shape

    def heads(a):
        return a.astype(F32).reshape(B, L, HG_HEADS, HG_HEAD_DIM).transpose(0, 2, 1, 3)

    q = heads(jax.nn.silu(q_raw.astype(F32)))
    v = heads(i_raw)

    def run(zf, lbd, reverse):
        f = lbd + (1.0 - lbd) * jax.nn.sigmoid(zf.astype(F32))
        k, log_f = heads(1.0 - f), heads(jnp.log(f))
        if reverse:
            o = gla_scan(jnp.flip(q, 2), jnp.flip(k, 2), jnp.flip(v, 2), jnp.flip(log_f, 2))
            return jnp.flip(o, 2)
        return gla_scan(q, k, v, log_f)

    o = run(zf_fwd, lb[0], False) + run(zf_bwd, lb[1], True)
    o = o * lax.rsqrt(jnp.mean(o * o, axis=-1, keepdims=True) + NORM_EPS)
    o = o.transpose(0, 2, 1, 3).reshape(B, L, HG_WIDTH) * norm_gain.astype(F32)
    return (o * jax.nn.silu(g_raw.astype(F32))).astype(q_raw.dtype)


def hyena_filters(L, w1, b1, w2, b2, w3, b3, w4, freq):
    pos = jnp.arange(L, dtype=F32)
    t = pos / max(L - 1, 1)
    bands = jnp.linspace(1e-4, HY_BANDS - 1, HY_BANDS, dtype=F32)
    ang = (2.0 * math.pi / L) * pos[:, None] * bands[None, :]
    z = jnp.concatenate([t[:, None], jnp.cos(ang), -jnp.sin(ang)], axis=-1)
    fr = freq.astype(F32)
    h = jnp.sin(fr * (z @ w1 + b1).astype(F32))
    h = jnp.sin(fr * (h @ w2 + b2).astype(F32))
    h = jnp.sin(fr * (h @ w3 + b3).astype(F32))
    h = (h @ w4).astype(F32)
    min_decay = math.log(HY_DECAY_TARGET) / HY_FAST_DECAY_PCT
    max_decay = math.log(HY_DECAY_TARGET) / HY_SLOW_DECAY_PCT
    deltas = jnp.abs(jnp.linspace(min_decay, max_decay, HY_WIDTH, dtype=F32))
    window = jnp.exp(-t[:, None] * deltas[None, :])
    return h.reshape(L, HY_ORDER, 2, HY_WIDTH) * window[:, None, None, :]


def two_sided_fftconv(u, h_fwd, h_bwd, bias):
    L = u.shape[1]
    C = h_fwd.shape[-1]
    kern = jnp.concatenate([h_fwd, jnp.zeros((1, C), F32), h_bwd[:0:-1]], axis=0)
    uf = u.astype(F32)
    spec = jnp.fft.rfft(uf, n=2 * L, axis=1) * jnp.fft.rfft(kern, n=2 * L, axis=0)[None]
    y = jnp.fft.irfft(spec, n=2 * L, axis=1)[:, :L]
    return y + uf * bias


def hyena_mixer(proj, conv_w, conv_b, filters, hy_bias, norm_gain):
    C3 = proj.shape[-1]
    pad = HY_SHORT // 2
    u = lax.conv_general_dilated(proj, conv_w[:, None, :], window_strides=(1,), padding=((pad, pad),),
                                 dimension_numbers=('NWC', 'WIO', 'NWC'), feature_group_count=C3) + conv_b
    v, x1, x2 = jnp.split(u, HY_ORDER + 1, axis=-1)
    z = v.astype(F32)
    for o, gate in enumerate((x1, x2)):
        z = gate.astype(F32) * two_sided_fftconv(z, filters[:, o, 0], filters[:, o, 1], hy_bias[o].astype(F32))
    return rms_norm(z, norm_gain).astype(proj.dtype)


def swiglu_clamped(h):
    glu, lin = jnp.split(h, 2, axis=-1)
    glu = jnp.minimum(glu, SWIGLU_LIMIT)
    lin = jnp.clip(lin, -SWIGLU_LIMIT, SWIGLU_LIMIT)
    return glu * jax.nn.sigmoid(SWIGLU_ALPHA * glu) * (lin + 1.0)


def moe_ffn(xn, w_router, b_router, w1, b1, w2, b2):
    B, L, D = xn.shape
    N = B * L
    A = N * TOP_K
    xt = xn.reshape(N, D)
    logits = (xt @ w_router + b_router).astype(F32)
    top_logits, top_idx = lax.top_k(logits, TOP_K)
    gates = jax.nn.softmax(top_logits, axis=-1)
    e_flat = top_idx.reshape(A)
    tok_flat = jnp.repeat(jnp.arange(N, dtype=jnp.int32), TOP_K)
    order = jnp.argsort(e_flat)
    e_sorted = e_flat[order]
    counts = jnp.bincount(e_flat, length=N_EXPERTS)
    padded = (counts + MOE_BLOCK - 1) // MOE_BLOCK * MOE_BLOCK
    starts = jnp.cumsum(counts) - counts
    pends = jnp.cumsum(padded)
    dest = (pends - padded)[e_sorted] + jnp.arange(A, dtype=jnp.int32) - starts[e_sorted]
    n_blocks = (A + N_EXPERTS * (MOE_BLOCK - 1) + MOE_BLOCK - 1) // MOE_BLOCK
    P = n_blocks * MOE_BLOCK
    slot_tok = jnp.full((P,), N, jnp.int32).at[dest].set(tok_flat[order])
    slot_gate = jnp.zeros((P,), F32).at[dest].set(gates.reshape(A)[order])
    block_start = jnp.arange(n_blocks, dtype=jnp.int32) * MOE_BLOCK
    block_expert = jnp.minimum(jnp.sum(block_start[:, None] >= pends[None, :], axis=1), N_EXPERTS - 1)
    xpad = jnp.concatenate([xt, jnp.zeros((1, D), xt.dtype)], axis=0)
    x_blocks = xpad[slot_tok].reshape(n_blocks, MOE_BLOCK, D)

    def expert_block(args):
        xb, e = args
        h = swiglu_clamped(xb @ w1[e] + b1[e])
        return h @ w2[e] + b2[e]

    y = lax.map(expert_block, (x_blocks, block_expert)).reshape(P, D)
    y = y.astype(F32) * slot_gate[:, None]
    out = jnp.zeros((N + 1, D), F32).at[slot_tok].add(y)[:N]
    return out.reshape(B, L, D).astype(xn.dtype)


def setup_inputs(seed: int = 0) -> dict:
    key = jax.random.key(seed)
    ks = jax.random.split(key, 26)
    nrm = jax.random.normal
    lb_logits = 0.1 * nrm(ks[3], (DEPTH + 1, 2, HG_WIDTH), F32)
    lb_logits = lb_logits.at[-1].add(2.0)
    return {
        'x': nrm(ks[0], (BATCH, SEQ, D_MODEL), F32),
        'norm_mix_gain': 1.0 + 0.02 * nrm(ks[1], (DEPTH, D_MODEL), F32),
        'w_in': nrm(ks[2], (DEPTH, D_MODEL, D_IN), F32) * D_MODEL ** -0.5,
        'hgrn_lb_logits': lb_logits,
        'hgrn_norm_gain': 1.0 + 0.02 * nrm(ks[4], (DEPTH, HG_WIDTH), F32),
        'hy_conv_w': nrm(ks[5], (DEPTH, HY_SHORT, (HY_ORDER + 1) * HY_WIDTH), F32) * HY_SHORT ** -0.5,
        'hy_conv_b': 0.02 * nrm(ks[6], (DEPTH, (HY_ORDER + 1) * HY_WIDTH), F32),
        'hy_filt_w1': nrm(ks[7], (DEPTH, HY_EMB, HY_FILTER_HIDDEN), F32) * HY_EMB ** -0.5,
        'hy_filt_b1': 0.02 * nrm(ks[8], (DEPTH, HY_FILTER_HIDDEN), F32),
        'hy_filt_w2': nrm(ks[9], (DEPTH, HY_FILTER_HIDDEN, HY_FILTER_HIDDEN), F32) * HY_FILTER_HIDDEN ** -0.5,
        'hy_filt_b2': 0.02 * nrm(ks[10], (DEPTH, HY_FILTER_HIDDEN), F32),
        'hy_filt_w3': nrm(ks[11], (DEPTH, HY_FILTER_HIDDEN, HY_FILTER_HIDDEN), F32) * HY_FILTER_HIDDEN ** -0.5,
        'hy_filt_b3': 0.02 * nrm(ks[12], (DEPTH, HY_FILTER_HIDDEN), F32),
        'hy_filt_w4': nrm(ks[13], (DEPTH, HY_FILTER_HIDDEN, HY_ORDER * 2 * HY_WIDTH), F32) * (0.1 * HY_FILTER_HIDDEN ** -0.5),
        'hy_filt_freq': 1.0 + 0.1 * nrm(ks[14], (DEPTH, HY_FILTER_HIDDEN), F32),
        'hy_bias': 0.5 * nrm(ks[15], (DEPTH, HY_ORDER, HY_WIDTH), F32),
        'hy_norm_gain': 1.0 + 0.02 * nrm(ks[16], (DEPTH, HY_WIDTH), F32),
        'w_out': nrm(ks[17], (DEPTH, D_MIX, D_MODEL), F32) * D_MIX ** -0.5,
        'norm_ffn_gain': 1.0 + 0.02 * nrm(ks[18], (DEPTH, D_MODEL), F32),
        'w_router': nrm(ks[19], (DEPTH, D_MODEL, N_EXPERTS), F32) * D_MODEL ** -0.5,
        'b_router': 0.01 * nrm(ks[20], (DEPTH, N_EXPERTS), F32),
        'moe_w1': nrm(ks[21], (DEPTH, N_EXPERTS, D_MODEL, 2 * D_FF), F32) * D_MODEL ** -0.5,
        'moe_b1': 0.01 * nrm(ks[22], (DEPTH, N_EXPERTS, 2 * D_FF), F32),
        'moe_w2': nrm(ks[23], (DEPTH, N_EXPERTS, D_FF, D_MODEL), F32) * D_FF ** -0.5,
        'moe_b2': 0.01 * nrm(ks[24], (DEPTH, N_EXPERTS, D_MODEL), F32),
        'final_norm_gain': 1.0 + 0.02 * nrm(ks[25], (D_MODEL,), F32),
    }


def reference(x, norm_mix_gain, w_in, hgrn_lb_logits, hgrn_norm_gain, hy_conv_w, hy_conv_b,
              hy_filt_w1, hy_filt_b1, hy_filt_w2, hy_filt_b2, hy_filt_w3, hy_filt_b3, hy_filt_w4,
              hy_filt_freq, hy_bias, hy_norm_gain, w_out, norm_ffn_gain, w_router, b_router,
              moe_w1, moe_b1, moe_w2, moe_b2, final_norm_gain):
    L = x.shape[1]
    lbs = hgrn_lower_bounds(hgrn_lb_logits)
    split_at = [HG_WIDTH * i for i in range(1, 6)]
    for layer in range(DEPTH):
        h = rms_norm(x, norm_mix_gain[layer])
        proj = h @ w_in[layer]
        q_raw, zf_fwd, zf_bwd, i_raw, g_raw, hy_proj = jnp.split(proj, split_at, axis=-1)
        hg = hgrn2_mixer(q_raw, zf_fwd, zf_bwd, i_raw, g_raw, lbs[layer], hgrn_norm_gain[layer])
        filters = hyena_filters(L, hy_filt_w1[layer], hy_filt_b1[layer], hy_filt_w2[layer], hy_filt_b2[layer],
                                hy_filt_w3[layer], hy_filt_b3[layer], hy_filt_w4[layer], hy_filt_freq[layer])
        hy = hyena_mixer(hy_proj, hy_conv_w[layer], hy_conv_b[layer], filters, hy_bias[layer], hy_norm_gain[layer])
        x = x + jnp.concatenate([hg, hy], axis=-1) @ w_out[layer]
        x = x + moe_ffn(rms_norm(x, norm_ffn_gain[layer]), w_router[layer], b_router[layer],
                        moe_w1[layer], moe_b1[layer], moe_w2[layer], moe_b2[layer])
    return rms_norm(x, final_norm_gain)
```

```cpp
#include <hip/hip_runtime.h>
#include <stdint.h>

constexpr int BATCH = 4, SEQ = 2048, DM = 2048, NTOK = BATCH * SEQ;
constexpr int HGW = 1024, HGD = 128, HGH = 8;
constexpr int HYW = 1024;
constexpr int DIN = 8192;
constexpr int NE = 32, TOPK = 4, DFF = 2048;
constexpr int NSLOT = NTOK * TOPK;
constexpr float EPS = 1e-5f;

constexpr size_t MB = 1024ull * 1024ull;
constexpr size_t WS_CTL = 0;
constexpr size_t WS_H = 1 * MB;
constexpr size_t WS_PROJ = WS_H + 64 * MB;
constexpr size_t WS_OF = WS_PROJ + 256 * MB;
constexpr size_t WS_OB = WS_OF + 32 * MB;
constexpr size_t WS_FILT = WS_OB + 32 * MB;
constexpr size_t WS_U = WS_FILT + 32 * MB;
constexpr size_t WS_Z1 = WS_U + 96 * MB;
constexpr size_t WS_Z2 = WS_Z1 + 32 * MB;
constexpr size_t WS_MIX = WS_Z2 + 32 * MB;
constexpr size_t WS_X1 = WS_MIX + 64 * MB;
constexpr size_t WS_XN = WS_X1 + 64 * MB;
constexpr size_t WS_TOPI = WS_XN + 64 * MB;
constexpr size_t WS_TOPG = WS_TOPI + 1 * MB;
constexpr size_t WS_STOK = WS_TOPG + 1 * MB;
constexpr size_t WS_SOF = WS_STOK + 1 * MB;
constexpr size_t WS_HPRE = WS_SOF + 1 * MB;
constexpr size_t WS_HMID = WS_HPRE + 512 * MB;
constexpr size_t WS_Y = WS_HMID + 256 * MB;
constexpr size_t WS_END = WS_Y + 256 * MB;

__device__ __forceinline__ float sigmoidf_(float x) { return 1.0f / (1.0f + __expf(-x)); }
__device__ __forceinline__ float siluf_(float x) { return x * sigmoidf_(x); }

__global__ void __launch_bounds__(256) k_rmsnorm(const float* __restrict__ x, const float* __restrict__ gain, float* __restrict__ out, int D, int ldx, int ldo) {
    __shared__ float red[4];
    const int row = blockIdx.x, t = threadIdx.x;
    const float* xr = x + (size_t)row * ldx;
    float s = 0.f;
    for (int i = t; i < D; i += 256) { float v = xr[i]; s += v * v; }
    for (int o = 32; o >= 1; o >>= 1) s += __shfl_xor(s, o);
    if ((t & 63) == 0) red[t >> 6] = s;
    __syncthreads();
    s = red[0] + red[1] + red[2] + red[3];
    const float r = rsqrtf(s / (float)D + EPS);
    for (int i = t; i < D; i += 256) out[(size_t)row * ldo + i] = xr[i] * r * gain[i];
}

struct GemmP {
    const float* A; int lda; const int* rowidx;
    const float* B; int ldb; size_t bstride;
    const float* bias; int biasstride;
    float* C; int ldc;
    const float* resid; int ldr;
    int M, N, K;
    const int* offs;
};
__global__ void __launch_bounds__(256) k_gemm_f32(GemmP p) {
    __shared__ float sA[16][64 + 1];
    __shared__ float sB[16][64];
    int rbase = 0, M = p.M;
    const float* B = p.B; const float* bias = p.bias;
    if (p.offs) { const int e = blockIdx.z; rbase = p.offs[e]; M = p.offs[e + 1] - rbase; B += (size_t)e * p.bstride; if (bias) bias += (size_t)e * p.biasstride; }
    const int m0 = blockIdx.y * 64, n0 = blockIdx.x * 64;
    if (m0 >= M) return;
    const int t = threadIdx.x, tx = t & 15, ty = t >> 4;
    float acc[4][4] = {};
    const int ar = t >> 2, ak = (t & 3) * 4;
    int arow = m0 + ar; const bool avalid = arow < M;
    size_t aoff = 0;
    if (avalid) { const int gr = rbase + arow; aoff = (size_t)(p.rowidx ? p.rowidx[gr] : gr) * p.lda; }
    const int bk = t >> 4, bn = (t & 15) * 4;
    for (int k0 = 0; k0 < p.K; k0 += 16) {
        float4 av = make_float4(0.f, 0.f, 0.f, 0.f);
        if (avalid) av = *(const float4*)(p.A + aoff + k0 + ak);
        sA[ak + 0][ar] = av.x; sA[ak + 1][ar] = av.y; sA[ak + 2][ar] = av.z; sA[ak + 3][ar] = av.w;
        const float4 bv = *(const float4*)(B + (size_t)(k0 + bk) * p.ldb + n0 + bn);
        *(float4*)&sB[bk][bn] = bv;
        __syncthreads();
#pragma unroll
        for (int kk = 0; kk < 16; ++kk) {
            float a[4], b[4];
#pragma unroll
            for (int i = 0; i < 4; ++i) a[i] = sA[kk][ty * 4 + i];
            const float4 b4 = *(const float4*)&sB[kk][tx * 4];
            b[0] = b4.x; b[1] = b4.y; b[2] = b4.z; b[3] = b4.w;
#pragma unroll
            for (int i = 0; i < 4; ++i)
#pragma unroll
                for (int j = 0; j < 4; ++j) acc[i][j] = fmaf(a[i], b[j], acc[i][j]);
        }
        __syncthreads();
    }
#pragma unroll
    for (int i = 0; i < 4; ++i) {
        const int r = m0 + ty * 4 + i;
        if (r >= M) continue;
        const int gr = rbase + r;
        const int n = n0 + tx * 4;
        float4 o = make_float4(acc[i][0], acc[i][1], acc[i][2], acc[i][3]);
        if (bias) { o.x += bias[n]; o.y += bias[n + 1]; o.z += bias[n + 2]; o.w += bias[n + 3]; }
        if (p.resid) { const float4 rv = *(const float4*)(p.resid + (size_t)gr * p.ldr + n); o.x += rv.x; o.y += rv.y; o.z += rv.z; o.w += rv.w; }
        *(float4*)(p.C + (size_t)gr * p.ldc + n) = o;
    }
}

__global__ void __launch_bounds__(256) k_hgrn_naive(const float* __restrict__ proj, const float* __restrict__ lb_logits, float* __restrict__ o_f, float* __restrict__ o_b) {
    __shared__ float sq[128], sf[128], sk[128], sv[128], part[2][128];
    const int dir = blockIdx.x & 1, h = (blockIdx.x >> 1) & 7, b = blockIdx.x >> 4;
    const int t = threadIdx.x, v = t & 127, kh = t >> 7;
    float S[64];
#pragma unroll
    for (int i = 0; i < 64; ++i) S[i] = 0.f;
    float lb = 0.f;
    if (t < 128) { const int c = h * 128 + t; const float l0 = lb_logits[(0 * 2 + dir) * HGW + c], l1 = lb_logits[(1 * 2 + dir) * HGW + c]; lb = 1.0f / (1.0f + expf(l1 - l0)); }
    float* od = dir ? o_b : o_f;
    for (int s = 0; s < SEQ; ++s) {
        const int n = dir ? (SEQ - 1 - s) : s;
        const size_t tok = (size_t)b * SEQ + n;
        const float* pr = proj + tok * DIN;
        if (t < 128) {
            const float qr = pr[h * 128 + t], zf = pr[(1 + dir) * 1024 + h * 128 + t];
            const float f = lb + (1.0f - lb) * sigmoidf_(zf);
            sq[t] = siluf_(qr); sf[t] = f; sk[t] = 1.0f - f;
        } else {
            sv[t - 128] = pr[3072 + h * 128 + (t - 128)];
        }
        __syncthreads();
        const float vv = sv[v];
        float acc = 0.f;
#pragma unroll
        for (int i = 0; i < 64; ++i) { const int k = kh * 64 + i; S[i] = fmaf(sf[k], S[i], sk[k] * vv); acc = fmaf(sq[k], S[i], acc); }
        part[kh][v] = acc;
        __syncthreads();
        if (t < 128) od[tok * HGW + h * 128 + t] = part[0][t] + part[1][t];
    }
}
__global__ void __launch_bounds__(128) k_hgrn_final(const float* __restrict__ o_f, const float* __restrict__ o_b, const float* __restrict__ proj, const float* __restrict__ gain, float* __restrict__ mix) {
    __shared__ float red[2];
    const int tok = blockIdx.x >> 3, h = blockIdx.x & 7, t = threadIdx.x, c = h * 128 + t;
    const float o = o_f[(size_t)tok * HGW + c] + o_b[(size_t)tok * HGW + c];
    float s = o * o;
    for (int k = 32; k >= 1; k >>= 1) s += __shfl_xor(s, k);
    if ((t & 63) == 0) red[t >> 6] = s;
    __syncthreads();
    s = red[0] + red[1];
    const float r = rsqrtf(s / 128.0f + EPS);
    const float g = proj[(size_t)tok * DIN + 4096 + c];
    mix[(size_t)tok * DM + c] = o * r * gain[c] * siluf_(g);
}

__global__ void __launch_bounds__(256) k_hy_filters(const float* __restrict__ w1, const float* __restrict__ b1, const float* __restrict__ w2, const float* __restrict__ b2,
                                                     const float* __restrict__ w3, const float* __restrict__ b3, const float* __restrict__ w4, const float* __restrict__ freq, float* __restrict__ filt) {
    __shared__ float z[33], h1[64], h2[64], h3[64];
    const int m = blockIdx.x, t = threadIdx.x;
    const float tt = (float)m / (float)(SEQ - 1);
    if (t == 0) z[0] = tt;
    if (t >= 1 && t <= 16) { const int i = t - 1; const float band = 1e-4f + (float)i * ((15.0f - 1e-4f) / 15.0f); const float ang = (2.0f * 3.14159265358979323846f / (float)SEQ) * (float)m * band; z[1 + i] = cosf(ang); z[17 + i] = -sinf(ang); }
    __syncthreads();
    if (t < 64) { float s = b1[t]; for (int i = 0; i < 33; ++i) s += z[i] * w1[i * 64 + t]; h1[t] = sinf(freq[t] * s); }
    __syncthreads();
    if (t < 64) { float s = b2[t]; for (int i = 0; i < 64; ++i) s += h1[i] * w2[i * 64 + t]; h2[t] = sinf(freq[t] * s); }
    __syncthreads();
    if (t < 64) { float s = b3[t]; for (int i = 0; i < 64; ++i) s += h2[i] * w3[i * 64 + t]; h3[t] = sinf(freq[t] * s); }
    __syncthreads();
    const float mind = logf(1e-2f) / 0.3f, maxd = logf(1e-2f) / 1.5f;
    for (int col = t; col < 4096; col += 256) {
        float s = 0.f;
        for (int i = 0; i < 64; ++i) s += h3[i] * w4[i * 4096 + col];
        const int c = col & 1023;
        const float delta = fabsf(mind + (float)c * ((maxd - mind) / 1023.0f));
        filt[(size_t)m * 4096 + col] = s * expf(-tt * delta);
    }
}
__global__ void __launch_bounds__(256) k_conv3(const float* __restrict__ proj, const float* __restrict__ cw, const float* __restrict__ cb, float* __restrict__ u) {
    const size_t i = (size_t)blockIdx.x * 256 + threadIdx.x;
    const int c = (int)(i % 3072); const int tok = (int)(i / 3072); const int n = tok & (SEQ - 1);
    const float* p = proj + (size_t)tok * DIN + 5120 + c;
    float s = cb[c] + cw[1 * 3072 + c] * p[0];
    if (n > 0) s += cw[0 * 3072 + c] * p[-(ptrdiff_t)DIN];
    if (n < SEQ - 1) s += cw[2 * 3072 + c] * p[DIN];
    u[i] = s;
}
__global__ void __launch_bounds__(256) k_longconv(const float* __restrict__ filt, int o, const float* __restrict__ zin, int ldz, const float* __restrict__ gate, int ldg,
                                                   const float* __restrict__ hbias, float* __restrict__ zout) {
    const int c = blockIdx.x * 64 + (threadIdx.x & 63), n = blockIdx.y * 4 + (threadIdx.x >> 6), b = blockIdx.z;
    const float* ff = filt + o * 2048 + c;
    const float* fb = filt + o * 2048 + 1024 + c;
    const float* zb = zin + (size_t)b * SEQ * ldz + c;
    float acc = 0.f;
    for (int m = 0; m <= n; ++m) acc = fmaf(ff[(size_t)m * 4096], zb[(size_t)(n - m) * ldz], acc);
    for (int m = 1; m < SEQ - n; ++m) acc = fmaf(fb[(size_t)m * 4096], zb[(size_t)(n + m) * ldz], acc);
    const size_t tok = (size_t)b * SEQ + n;
    const float zc = zb[(size_t)n * ldz];
    zout[tok * HYW + c] = gate[tok * ldg + c] * (acc + hbias[o * HYW + c] * zc);
}

__global__ void __launch_bounds__(256) k_router(const float* __restrict__ xn, const float* __restrict__ wr, const float* __restrict__ br, int* __restrict__ topi, float* __restrict__ topg, int* __restrict__ counts) {
    __shared__ float part[8][32];
    __shared__ float lg[NE];
    __shared__ int sidx[4];
    __shared__ float sval[4];
    const int tok = blockIdx.x, t = threadIdx.x, e = t & 31, pt = t >> 5;
    const float* x = xn + (size_t)tok * DM;
    float s = 0.f;
    for (int d = pt * 256; d < pt * 256 + 256; ++d) s = fmaf(x[d], wr[d * NE + e], s);
    part[pt][e] = s;
    __syncthreads();
    if (t < NE) { float a = br[t]; for (int q = 0; q < 8; ++q) a += part[q][t]; lg[t] = a; }
    __syncthreads();
    if (t == 0) {
        for (int k = 0; k < 4; ++k) { int bi = 0; float bv = -3.0e38f; for (int j = 0; j < NE; ++j) { const float l = lg[j]; if (l > bv) { bv = l; bi = j; } } sidx[k] = bi; sval[k] = bv; lg[bi] = -3.4e38f; }
        float sum = 0.f;
        for (int k = 0; k < 4; ++k) sum += expf(sval[k] - sval[0]);
        for (int k = 0; k < 4; ++k) { const int id = sidx[k]; topi[tok * 4 + k] = id; topg[tok * 4 + k] = expf(sval[k] - sval[0]) / sum; atomicAdd(&counts[id], 1); }
    }
}
__global__ void k_offsets(const int* __restrict__ counts, int* __restrict__ offs) {
    if (threadIdx.x == 0) { int a = 0; for (int e = 0; e < NE; ++e) { offs[e] = a; a += counts[e]; } offs[NE] = a; }
}
__global__ void __launch_bounds__(256) k_scatter(const int* __restrict__ topi, const int* __restrict__ offs, int* __restrict__ cursor, int* __restrict__ stok, int* __restrict__ sof) {
    const int i = blockIdx.x * 256 + threadIdx.x;
    const int e = topi[i];
    const int pos = atomicAdd(&cursor[e], 1);
    const int slot = offs[e] + pos;
    stok[slot] = i >> 2; sof[i] = slot;
}
__global__ void __launch_bounds__(256) k_swiglu(const float* __restrict__ hpre, float* __restrict__ hmid) {
    const size_t i = (size_t)blockIdx.x * 256 + threadIdx.x;
    const size_t r = i >> 11; const int c = (int)(i & 2047);
    float glu = hpre[r * 4096 + c], lin = hpre[r * 4096 + 2048 + c];
    glu = fminf(glu, 7.0f); lin = fminf(fmaxf(lin, -7.0f), 7.0f);
    hmid[i] = glu * sigmoidf_(1.702f * glu) * (lin + 1.0f);
}
__global__ void __launch_bounds__(256) k_combine_final(const float* __restrict__ x1, const float* __restrict__ y, const int* __restrict__ sof, const float* __restrict__ topg, const float* __restrict__ gain, float* __restrict__ out) {
    __shared__ float red[4];
    const int tok = blockIdx.x, t = threadIdx.x;
    float v[8]; float s = 0.f;
    int sl[4]; float g[4];
#pragma unroll
    for (int k = 0; k < 4; ++k) { sl[k] = sof[tok * 4 + k]; g[k] = topg[tok * 4 + k]; }
#pragma unroll
    for (int j = 0; j < 8; ++j) {
        const int i = t + j * 256;
        float a = x1[(size_t)tok * DM + i];
#pragma unroll
        for (int k = 0; k < 4; ++k) a += g[k] * y[(size_t)sl[k] * DM + i];
        v[j] = a; s += a * a;
    }
    for (int o = 32; o >= 1; o >>= 1) s += __shfl_xor(s, o);
    if ((t & 63) == 0) red[t >> 6] = s;
    __syncthreads();
    s = red[0] + red[1] + red[2] + red[3];
    const float r = rsqrtf(s / (float)DM + EPS);
#pragma unroll
    for (int j = 0; j < 8; ++j) { const int i = t + j * 256; out[(size_t)tok * DM + i] = v[j] * r * gain[i]; }
}


typedef short bf16x8 __attribute__((ext_vector_type(8)));
typedef float f32x4 __attribute__((ext_vector_type(4)));
typedef float f32x2 __attribute__((ext_vector_type(2)));
typedef unsigned u32x4 __attribute__((ext_vector_type(4)));
typedef unsigned u32x2 __attribute__((ext_vector_type(2)));
typedef unsigned short u16;
#define LAS __attribute__((address_space(3)))

__device__ __forceinline__ unsigned pk_bf16(float lo, float hi) {
    typedef __bf16 bf2 __attribute__((ext_vector_type(2)));
    const f32x2 v = {lo, hi};
    const bf2 r = __builtin_convertvector(v, bf2);
    return __builtin_bit_cast(unsigned, r);
}
__device__ __forceinline__ float bf2f(u16 b) { return __uint_as_float(((unsigned)b) << 16); }
__device__ __forceinline__ float bflo(unsigned w) { return __uint_as_float(w << 16); }
__device__ __forceinline__ float bfhi(unsigned w) { return __uint_as_float(w & 0xffff0000u); }

__device__ __forceinline__ int lds_byte(int r, int c) { const int st = (r >> 4) * 2 + (c >> 5), ob = (r & 15) * 64 + (c & 31) * 2; return st * 1024 + (ob ^ (((ob >> 9) & 1) << 5)); }
__device__ __forceinline__ void stage_rc(int b, int& R, int& C) { const int st = b >> 10, sb = b & 1023, swz = sb ^ (((sb >> 9) & 1) << 5); R = (st >> 1) * 16 + swz / 64; C = (st & 1) * 32 + (swz % 64) / 2; }
__device__ __forceinline__ f32x4 unperm(const f32x4 a, const bool s) { f32x4 o; o[0] = s ? a[1] : a[0]; o[1] = s ? a[0] : a[1]; o[2] = s ? a[3] : a[2]; o[3] = s ? a[2] : a[3]; return o; }

constexpr int GEMM_LDS = 131072;

template <bool TRANS, bool RAGGED, class ColMap, class Epi>
__device__ __forceinline__ void gemm_unit(LAS unsigned char* lds, const u16* __restrict__ A, int lda, const int* __restrict__ arows, int arow0, int rows_valid,
                                          const float* __restrict__ B, int ldb, int K, const ColMap colmap, const Epi epi) {
    const int tid = threadIdx.x, wid = __builtin_amdgcn_readfirstlane(tid >> 6), lane = tid & 63;
    const int wr = wid >> 2, wc = wid & 3, fr = lane & 15, fq = lane >> 4;
    const int nt = K >> 6;
    const char* ap[4];
#pragma unroll
    for (int i = 0; i < 4; ++i) {
        int R, C; stage_rc(wid * 1024 + i * 8192 + lane * 16, R, C);
        const int rr = RAGGED ? (R < rows_valid ? R : rows_valid - 1) : R;
        const long rowid = arows ? (long)arows[rr] : (long)(arow0 + rr);
        ap[i] = (const char*)A + ((size_t)rowid * lda + C) * 2;
    }
    const int g = (lane & 3) + 4 * (wid >> 2), rg = (wid & 3) * 16 + (lane >> 2);
    const float* bp = B + (size_t)(8 * g) * ldb + colmap(rg);
    const int bbase = 65536 + lds_byte(4 * rg, 8 * g);
    const int bw0 = bbase + ((rg & 1) ? 64 : 0), bw1 = bbase + ((rg & 1) ? 0 : 64);
    const int aoff = lds_byte(wr * 128 + fr, fq * 8), boff = 65536 + lds_byte(wc * 64 + fr, fq * 8);
    int mvalid = 8;
    if (RAGGED) { mvalid = (rows_valid - wr * 128 + 15) >> 4; mvalid = mvalid < 0 ? 0 : (mvalid > 8 ? 8 : mvalid); }
    f32x4 vb[8];
    f32x4 acc[8][4];
#pragma unroll
    for (int m = 0; m < 8; ++m)
#pragma unroll
        for (int n = 0; n < 4; ++n) acc[m][n] = (f32x4){0.f, 0.f, 0.f, 0.f};
#define GE_GLDS_A(buf, kt) do { _Pragma("unroll") for (int _i = 0; _i < 4; ++_i) \
        __builtin_amdgcn_global_load_lds((const unsigned*)(ap[_i] + (size_t)(kt) * 128), (LAS unsigned*)(lds + (buf) * 32768 + wid * 1024 + _i * 8192), 16, 0, 0); } while (0)
#define GE_LOAD_B(kt) do { _Pragma("unroll") for (int _k = 0; _k < 8; ++_k) vb[_k] = *(const f32x4*)(bp + (size_t)((kt) * 64 + _k) * ldb); } while (0)
#define GE_WRITE_B(buf) do { _Pragma("unroll") for (int _i = 0; _i < 4; ++_i) { u32x4 _w; _w[0] = pk_bf16(vb[0][_i], vb[1][_i]); _w[1] = pk_bf16(vb[2][_i], vb[3][_i]); \
        _w[2] = pk_bf16(vb[4][_i], vb[5][_i]); _w[3] = pk_bf16(vb[6][_i], vb[7][_i]); \
        *(LAS u32x4*)(lds + ((_i & 1) ? bw1 : bw0) + (_i >> 1) * 128 + (buf) * 32768) = _w; } } while (0)
#define GE_KSTEP(buf, ks) do { bf16x8 Bf[4]; \
        _Pragma("unroll") for (int n = 0; n < 4; ++n) Bf[n] = *(const LAS bf16x8*)(lds + (buf) * 32768 + boff + n * 2048 + (ks) * 1024); \
        _Pragma("unroll") for (int mh = 0; mh < 2; ++mh) { bf16x8 At[4]; \
            _Pragma("unroll") for (int m = 0; m < 4; ++m) At[m] = *(const LAS bf16x8*)(lds + (buf) * 32768 + aoff + (mh * 4 + m) * 2048 + (ks) * 1024); \
            _Pragma("unroll") for (int m = 0; m < 4; ++m) { if (!RAGGED || (mh * 4 + m) < mvalid) { _Pragma("unroll") for (int n = 0; n < 4; ++n) \
                acc[mh * 4 + m][n] = TRANS ? __builtin_amdgcn_mfma_f32_16x16x32_bf16(At[m], Bf[n], acc[mh * 4 + m][n], 0, 0, 0) : __builtin_amdgcn_mfma_f32_16x16x32_bf16(Bf[n], At[m], acc[mh * 4 + m][n], 0, 0, 0); } } } } while (0)
    GE_GLDS_A(0, 0);
    GE_LOAD_B(0);
    asm volatile("s_waitcnt vmcnt(0)" ::: "memory");
    GE_WRITE_B(0);
    if (nt > 1) GE_LOAD_B(1);
    asm volatile("s_waitcnt lgkmcnt(0)" ::: "memory");
    __builtin_amdgcn_s_barrier();
    for (int t = 0; t < nt; ++t) {
        const int cur = t & 1;
        if (t + 1 < nt) { GE_WRITE_B(cur ^ 1); GE_GLDS_A(cur ^ 1, t + 1); }
        if (t + 2 < nt) GE_LOAD_B(t + 2);
        GE_KSTEP(cur, 0);
        GE_KSTEP(cur, 1);
        asm volatile("s_waitcnt vmcnt(0) lgkmcnt(0)" ::: "memory");
        __builtin_amdgcn_s_barrier();
    }
#undef GE_GLDS_A
#undef GE_LOAD_B
#undef GE_WRITE_B
#undef GE_KSTEP
    epi(acc, wr, wc, fr, fq);
}

__device__ __forceinline__ int xcd_logical(int b, int G) { return (G & 7) ? b : (b & 7) * (G >> 3) + (b >> 3); }

struct ColMapDense { int c0; __device__ __forceinline__ int operator()(int rg) const { return c0 + 4 * rg; } };
struct EpiPG { u16* PG; int tok0, col0;
    __device__ __forceinline__ void operator()(const f32x4 (&acc)[8][4], int wr, int wc, int fr, int fq) const {
#pragma unroll
        for (int m = 0; m < 8; ++m) { u16* rowp = PG + (size_t)(tok0 + wr * 128 + m * 16 + fr) * 5120 + col0 + wc * 64 + 4 * fq;
#pragma unroll
            for (int n = 0; n < 4; ++n) { const f32x4 v = unperm(acc[m][n], fq & 1); u32x2 w; w[0] = pk_bf16(v[0], v[1]); w[1] = pk_bf16(v[2], v[3]); *(u32x2*)(rowp + n * 16) = w; } }
    } };
struct EpiHYT { u16* HYT; int tok0, col0;
    __device__ __forceinline__ void operator()(const f32x4 (&acc)[8][4], int wr, int wc, int fr, int fq) const {
#pragma unroll
        for (int n = 0; n < 4; ++n) { const int rho = wc * 64 + n * 16 + fr; const int col = col0 + (rho & ~3) + ((rho & 3) ^ ((rho >> 2) & 1));
            u16* colp = HYT + (size_t)col * NTOK + tok0 + wr * 128 + 4 * fq;
#pragma unroll
            for (int m = 0; m < 8; ++m) { const f32x4 v = acc[m][n]; u32x2 w; w[0] = pk_bf16(v[0], v[1]); w[1] = pk_bf16(v[2], v[3]); *(u32x2*)(colp + m * 16) = w; } }
    } };
__global__ void __launch_bounds__(512, 2) k_gemm1(const u16* __restrict__ Hb, const float* __restrict__ w_in, u16* __restrict__ PG, u16* __restrict__ HYT) {
    extern __shared__ __attribute__((aligned(16))) unsigned char shm[];
    LAS unsigned char* lds = (LAS unsigned char*)shm;
    const int G = gridDim.x, c = xcd_logical(blockIdx.x, G);
    for (int u = c; u < 1024; u += G) {
        const int i = u >> 8, x = (u >> 5) & 7, j = u & 31;
        const int mt = (x & 3) * 8 + (j & 7), nt = ((x >> 2) + 2 * i) * 4 + (j >> 3);
        ColMapDense cm{nt * 256};
        if (nt < 20) { EpiPG e{PG, mt * 256, nt * 256}; gemm_unit<false, false>(lds, Hb, DM, nullptr, mt * 256, 256, w_in, DIN, DM, cm, e); }
        else { EpiHYT e{HYT, mt * 256, nt * 256 - 5120}; gemm_unit<true, false>(lds, Hb, DM, nullptr, mt * 256, 256, w_in, DIN, DM, cm, e); }
    }
}
struct EpiX1 { const float* x; float* X1; int tok0, col0;
    __device__ __forceinline__ void operator()(const f32x4 (&acc)[8][4], int wr, int wc, int fr, int fq) const {
#pragma unroll
        for (int m = 0; m < 8; ++m) { const size_t off = (size_t)(tok0 + wr * 128 + m * 16 + fr) * DM + col0 + wc * 64 + 4 * fq;
#pragma unroll
            for (int n = 0; n < 4; ++n) { const f32x4 r = *(const f32x4*)(x + off + n * 16); *(f32x4*)(X1 + off + n * 16) = r + unperm(acc[m][n], fq & 1); }
            asm volatile("" ::: "memory"); }
    } };
__global__ void __launch_bounds__(512, 2) k_gemm_wout(const u16* __restrict__ MIXB, const float* __restrict__ w_out, const float* __restrict__ x, float* __restrict__ X1) {
    extern __shared__ __attribute__((aligned(16))) unsigned char shm[];
    LAS unsigned char* lds = (LAS unsigned char*)shm;
    const int G = gridDim.x, c = xcd_logical(blockIdx.x, G);
    for (int u = c; u < 256; u += G) {
        const int xx = u >> 5, j = u & 31;
        const int mt = (xx >> 1) * 8 + (j & 7), nt = (xx & 1) * 4 + (j >> 3);
        ColMapDense cm{nt * 256}; EpiX1 e{x, X1, mt * 256, nt * 256};
        gemm_unit<false, false>(lds, MIXB, DM, nullptr, mt * 256, 256, w_out, DM, DM, cm, e);
    }
}
struct ColMapGlu { int nt; __device__ __forceinline__ int operator()(int rg) const { const int wcq = rg >> 4, n = (rg >> 2) & 3, f = rg & 3; return (n >> 1) * 2048 + nt * 128 + wcq * 32 + (n & 1) * 16 + f * 4; } };
struct EpiSwiglu { u16* HM; const float* b1; int slot0, nt, rows_valid;
    __device__ __forceinline__ void operator()(const f32x4 (&acc)[8][4], int wr, int wc, int fr, int fq) const {
        f32x4 bg[2], bl[2];
#pragma unroll
        for (int nn = 0; nn < 2; ++nn) { const int col = nt * 128 + wc * 32 + nn * 16 + 4 * fq; bg[nn] = *(const f32x4*)(b1 + col); bl[nn] = *(const f32x4*)(b1 + 2048 + col); }
#pragma unroll
        for (int m = 0; m < 8; ++m) { const int row = wr * 128 + m * 16 + fr;
            if (row < rows_valid) {
#pragma unroll
                for (int nn = 0; nn < 2; ++nn) { const f32x4 gl = unperm(acc[m][nn], fq & 1) + bg[nn], li = unperm(acc[m][nn + 2], fq & 1) + bl[nn]; float o[4];
#pragma unroll
                    for (int j = 0; j < 4; ++j) { const float gq = fminf(gl[j], 7.0f), lq = fminf(fmaxf(li[j], -7.0f), 7.0f); o[j] = gq * (1.0f / (1.0f + __expf(-1.702f * gq))) * (lq + 1.0f); }
                    u32x2 w; w[0] = pk_bf16(o[0], o[1]); w[1] = pk_bf16(o[2], o[3]);
                    *(u32x2*)(HM + (size_t)(slot0 + row) * DFF + nt * 128 + wc * 32 + nn * 16 + 4 * fq) = w; } } }
    } };
struct EpiY { u16* Y; const float* b2; int slot0, col0, rows_valid;
    __device__ __forceinline__ void operator()(const f32x4 (&acc)[8][4], int wr, int wc, int fr, int fq) const {
        f32x4 bv[4];
#pragma unroll
        for (int n = 0; n < 4; ++n) bv[n] = *(const f32x4*)(b2 + col0 + wc * 64 + n * 16 + 4 * fq);
#pragma unroll
        for (int m = 0; m < 8; ++m) { const int row = wr * 128 + m * 16 + fr;
            if (row < rows_valid) { u16* rowp = Y + (size_t)(slot0 + row) * DM + col0 + wc * 64 + 4 * fq;
#pragma unroll
                for (int n = 0; n < 4; ++n) { const f32x4 v = unperm(acc[m][n], fq & 1) + bv[n]; u32x2 w; w[0] = pk_bf16(v[0], v[1]); w[1] = pk_bf16(v[2], v[3]); *(u32x2*)(rowp + n * 16) = w; } } }
    } };
template <int NTILES>
__device__ __forceinline__ bool moe_decode(const int* __restrict__ offs, int u, int& e, int& mt, int& nt, int& slot0, int& rows) {
    int base = 0;
    for (int q = 0; q < NE; ++q) { const int o0 = offs[q], cnt = offs[q + 1] - o0, mtl = (cnt + 255) >> 8, nu = mtl * NTILES;
        if (u < base + nu) { const int ul = u - base; e = q; mt = ul % mtl; nt = ul / mtl; slot0 = o0 + mt * 256; rows = cnt - mt * 256; if (rows > 256) rows = 256; return true; }
        base += nu; }
    return false;
}
__global__ void __launch_bounds__(512, 2) k_moe_a(const u16* __restrict__ XNB, const int* __restrict__ stok, const int* __restrict__ offs, const float* __restrict__ w1, const float* __restrict__ b1, u16* __restrict__ HM) {
    extern __shared__ __attribute__((aligned(16))) unsigned char shm[];
    LAS unsigned char* lds = (LAS unsigned char*)shm;
    const int G = gridDim.x, c = xcd_logical(blockIdx.x, G);
    for (int u = c;; u += G) {
        int e, mt, nt, slot0, rows;
        if (!moe_decode<16>(offs, u, e, mt, nt, slot0, rows)) break;
        ColMapGlu cm{nt}; EpiSwiglu ep{HM, b1 + (size_t)e * 2 * DFF, slot0, nt, rows};
        gemm_unit<false, true>(lds, XNB, DM, stok + slot0, 0, rows, w1 + (size_t)e * DM * 2 * DFF, 2 * DFF, DM, cm, ep);
    }
}
__global__ void __launch_bounds__(512, 2) k_moe_b(const u16* __restrict__ HM, const int* __restrict__ offs, const float* __restrict__ w2, const float* __restrict__ b2, u16* __restrict__ Y) {
    extern __shared__ __attribute__((aligned(16))) unsigned char shm[];
    LAS unsigned char* lds = (LAS unsigned char*)shm;
    const int G = gridDim.x, c = xcd_logical(blockIdx.x, G);
    for (int u = c;; u += G) {
        int e, mt, nt, slot0, rows;
        if (!moe_decode<8>(offs, u, e, mt, nt, slot0, rows)) break;
        ColMapDense cm{nt * 256}; EpiY ep{Y, b2 + (size_t)e * DM, slot0, nt * 256, rows};
        gemm_unit<false, true>(lds, HM, DFF, nullptr, slot0, rows, w2 + (size_t)e * DFF * DM, DM, DFF, cm, ep);
    }
}

__global__ void __launch_bounds__(256) k_rmsnorm_bf(const float* __restrict__ x, const float* __restrict__ gain, float* __restrict__ outf, u16* __restrict__ outb, int D) {
    __shared__ float red[4];
    const int row = blockIdx.x, t = threadIdx.x;
    const float* xr = x + (size_t)row * D;
    float s = 0.f;
    for (int i = t; i < D; i += 256) { float v = xr[i]; s += v * v; }
    for (int o = 32; o >= 1; o >>= 1) s += __shfl_xor(s, o);
    if ((t & 63) == 0) red[t >> 6] = s;
    __syncthreads();
    s = red[0] + red[1] + red[2] + red[3];
    const float r = rsqrtf(s / (float)D + EPS);
    for (int i = t * 2; i < D; i += 512) { const float a = xr[i] * r * gain[i], b = xr[i + 1] * r * gain[i + 1];
        if (outf) { outf[(size_t)row * D + i] = a; outf[(size_t)row * D + i + 1] = b; }
        *(unsigned*)(outb + (size_t)row * D + i) = pk_bf16(a, b); }
}
__global__ void __launch_bounds__(256) k_unpack_proj(const u16* __restrict__ PG, const u16* __restrict__ HYT, float* __restrict__ proj) {
    const size_t i = (size_t)blockIdx.x * 256 + threadIdx.x;
    const int col = (int)(i & 8191); const size_t tok = i >> 13;
    proj[i] = col < 5120 ? bf2f(PG[tok * 5120 + col]) : bf2f(HYT[(size_t)(col - 5120) * NTOK + tok]);
}
__global__ void __launch_bounds__(256) k_f2bf(const float* __restrict__ in, u16* __restrict__ out) {
    const size_t i = ((size_t)blockIdx.x * 256 + threadIdx.x) * 2;
    *(unsigned*)(out + i) = pk_bf16(in[i], in[i + 1]);
}
__global__ void __launch_bounds__(256) k_combine_final_bf(const float* __restrict__ x1, const u16* __restrict__ y, const int* __restrict__ sof, const float* __restrict__ topg, const float* __restrict__ gain, float* __restrict__ out) {
    __shared__ float red[4];
    const int tok = blockIdx.x, t = threadIdx.x;
    float v[8]; float s = 0.f;
    int sl[4]; float g[4];
#pragma unroll
    for (int k = 0; k < 4; ++k) { sl[k] = sof[tok * 4 + k]; g[k] = topg[tok * 4 + k]; }
#pragma unroll
    for (int j = 0; j < 8; ++j) {
        const int i = t + j * 256;
        float a = x1[(size_t)tok * DM + i];
#pragma unroll
        for (int k = 0; k < 4; ++k) a += g[k] * bf2f(y[(size_t)sl[k] * DM + i]);
        v[j] = a; s += a * a;
    }
    for (int o = 32; o >= 1; o >>= 1) s += __shfl_xor(s, o);
    if ((t & 63) == 0) red[t >> 6] = s;
    __syncthreads();
    s = red[0] + red[1] + red[2] + red[3];
    const float r = rsqrtf(s / (float)DM + EPS);
#pragma unroll
    for (int j = 0; j < 8; ++j) { const int i = t + j * 256; out[(size_t)tok * DM + i] = v[j] * r * gain[i]; }
}


typedef float f32x16 __attribute__((ext_vector_type(16)));
__device__ __forceinline__ void h3_row(int m, const float* __restrict__ w1, const float* __restrict__ b1, const float* __restrict__ w2, const float* __restrict__ b2,
                                       const float* __restrict__ w3, const float* __restrict__ b3, const float* __restrict__ freq, LAS float* sc  , float* __restrict__ H3) {
    const int j = threadIdx.x & 63;
    const float tt = (float)m / (float)(SEQ - 1);
    if (j == 0) sc[0] = tt;
    if (j >= 1 && j <= 16) { const int i = j - 1; const float band = 1e-4f + (float)i * ((15.0f - 1e-4f) / 15.0f); const float ang = (2.0f * 3.14159265358979323846f / (float)SEQ) * (float)m * band; sc[1 + i] = cosf(ang); sc[17 + i] = -sinf(ang); }
    __builtin_amdgcn_wave_barrier();
    const float fr = freq[j];
    float s = b1[j];
    for (int i = 0; i < 33; ++i) s += sc[i] * w1[i * 64 + j];
    const float h1 = sinf(fr * s);
    sc[64 + j] = h1;
    __builtin_amdgcn_wave_barrier();
    s = b2[j];
    for (int i = 0; i < 64; ++i) s += sc[64 + i] * w2[i * 64 + j];
    const float h2 = sinf(fr * s);
    __builtin_amdgcn_wave_barrier();
    sc[j] = h2;
    __builtin_amdgcn_wave_barrier();
    s = b3[j];
    for (int i = 0; i < 64; ++i) s += sc[i] * w3[i * 64 + j];
    H3[(size_t)m * 64 + j] = sinf(fr * s);
    __builtin_amdgcn_wave_barrier();
}
__global__ void __launch_bounds__(256) k_h3(const float* __restrict__ w1, const float* __restrict__ b1, const float* __restrict__ w2, const float* __restrict__ b2,
                                            const float* __restrict__ w3, const float* __restrict__ b3, const float* __restrict__ freq, float* __restrict__ H3) {
    __shared__ float sc[4][128];
    const int w = threadIdx.x >> 6;
    h3_row(blockIdx.x * 4 + w, w1, b1, w2, b2, w3, b3, freq, (LAS float*)&sc[w][0], H3);
}
constexpr int FR_LEN = 4128;
__device__ __forceinline__ void frgen_item(int item, const float* __restrict__ H3, const float* __restrict__ w4, u16* __restrict__ FR, LAS float* hs  ) {
    const int tid = threadIdx.x, m0 = item * 8;
    for (int i = tid; i < 11 * 64; i += 512) { int m = m0 - 1 + (i >> 6); m = m < 0 ? 0 : (m > SEQ - 1 ? SEQ - 1 : m); hs[i] = H3[(size_t)m * 64 + (i & 63)]; }
    __syncthreads();
    const float mind = logf(1e-2f) / 0.3f, maxd = logf(1e-2f) / 1.5f;
    for (int p = 0; p < 4; ++p) {
        const int oc = tid + p * 512, o = oc >> 10, c = oc & 1023;
        const float* wf = w4 + o * 2048 + c; const float* wb = wf + 1024;
        float af[11], ab[11];
#pragma unroll
        for (int q = 0; q < 11; ++q) { af[q] = 0.f; ab[q] = 0.f; }
        for (int i = 0; i < 64; ++i) {
            const float xf = wf[(size_t)i * 4096], xb = wb[(size_t)i * 4096];
#pragma unroll
            for (int q = 0; q < 11; ++q) { const float h = hs[q * 64 + i]; af[q] = fmaf(h, xf, af[q]); ab[q] = fmaf(h, xb, ab[q]); }
        }
        const float delta = fabsf(mind + (float)c * ((maxd - mind) / 1023.0f));
#pragma unroll
        for (int q = 0; q < 11; ++q) { const int m = m0 - 1 + q; const float wv = (m >= 0 && m <= SEQ - 1) ? __expf(-((float)m / (float)(SEQ - 1)) * delta) : 0.f; af[q] *= wv; ab[q] *= wv; }
        u16* base = FR + (size_t)(oc * 2) * FR_LEN;
        u32x4 w;
        w[0] = pk_bf16(af[8], af[7]); w[1] = pk_bf16(af[6], af[5]); w[2] = pk_bf16(af[4], af[3]); w[3] = pk_bf16(af[2], af[1]);
        *(u32x4*)(base + 2040 - m0) = w;
        const float last = (m0 == 0) ? ab[2] : af[0];
        w[0] = pk_bf16(af[7], af[6]); w[1] = pk_bf16(af[5], af[4]); w[2] = pk_bf16(af[3], af[2]); w[3] = pk_bf16(af[1], last);
        *(u32x4*)(base + FR_LEN + 2040 - m0) = w;
        w[0] = pk_bf16(ab[2], ab[3]); w[1] = pk_bf16(ab[4], ab[5]); w[2] = pk_bf16(ab[6], ab[7]); w[3] = pk_bf16(ab[8], ab[9]);
        *(u32x4*)(base + 2048 + m0) = w;
        w[0] = pk_bf16(ab[3], ab[4]); w[1] = pk_bf16(ab[5], ab[6]); w[2] = pk_bf16(ab[7], ab[8]); w[3] = pk_bf16(ab[9], ab[10]);
        *(u32x4*)(base + FR_LEN + 2048 + m0) = w;
        if (item == 255) {
            const u32x4 z = {0u, 0u, 0u, 0u};
#pragma unroll
            for (int q = 0; q < 4; ++q) { *(u32x4*)(base + 4096 + q * 8) = z; *(u32x4*)(base + FR_LEN + 4096 + q * 8) = z; }
        }
    }
    __syncthreads();
}
__global__ void __launch_bounds__(512) k_frgen(const float* __restrict__ H3, const float* __restrict__ w4, u16* __restrict__ FR) {
    __shared__ float hs[11 * 64];
    frgen_item(blockIdx.x, H3, w4, FR, (LAS float*)hs);
}

constexpr int HY_ZSTRIDE = 2312;
constexpr int HY_ZCH = 256 + 4 * HY_ZSTRIDE;
constexpr int HY_ZBYTES = HY_ZCH * 2;
constexpr int HY_FB = 4 * HY_ZBYTES;
constexpr int HY_FCH = 2 * FR_LEN * 2;
constexpr int HY_LDS = HY_FB + 4 * HY_FCH;

__device__ __forceinline__ void hy_load_row(LAS unsigned char* lds, int dest, int boff0, int bstride, const u16* __restrict__ row, float w0, float w1, float w2, float cb, int pl) {
#pragma unroll 2
    for (int it = 0; it < 8; ++it) {
        const int idx = pl + 128 * it, tok0 = idx * 8, b = tok0 >> 11, n0 = tok0 & 2047;
        const u32x4 raw = *(const u32x4*)(row + tok0);
        const float pm = (n0 > 0) ? bf2f(row[tok0 - 1]) : 0.f;
        const float pn = (n0 + 8 < SEQ) ? bf2f(row[tok0 + 8]) : 0.f;
        float p[10];
        p[0] = pm; p[9] = pn;
#pragma unroll
        for (int q = 0; q < 4; ++q) { p[1 + 2 * q] = bflo(raw[q]); p[2 + 2 * q] = bfhi(raw[q]); }
        float o[8];
#pragma unroll
        for (int q = 0; q < 8; ++q) o[q] = fmaf(w0, p[q], fmaf(w1, p[q + 1], fmaf(w2, p[q + 2], cb)));
        u32x4 w; w[0] = pk_bf16(o[0], o[1]); w[1] = pk_bf16(o[2], o[3]); w[2] = pk_bf16(o[4], o[5]); w[3] = pk_bf16(o[6], o[7]);
        *(LAS u32x4*)(lds + dest + (boff0 + b * bstride + n0) * 2) = w;
    }
}
__device__ __forceinline__ void hy_load_filters(LAS unsigned char* lds, int fb, const u16* __restrict__ src, int pl) {
    for (int idx = pl; idx < HY_FCH / 16; idx += 128) *(LAS u32x4*)(lds + fb + idx * 16) = *(const u32x4*)((const char*)src + idx * 16);
}
__device__ __forceinline__ void hy_mfma_loop(LAS unsigned char* lds, int zb, int fb, int hlf, int lane, f32x16 (&acc)[4]) {
    const int r = lane & 31, hh = lane >> 5, il = r >> 2, b = r & 3;
    const int bbase = zb + (256 + b * HY_ZSTRIDE + 32 * il + 8 * hh) * 2;
    const int xl = 2047 - r + 8 * hh - 1024 * hlf;
    const int abase = (r & 1) ? (fb + 2 * xl) : (fb + FR_LEN * 2 + 2 * (xl - 1));
#pragma unroll
    for (int q = 0; q < 4; ++q)
#pragma unroll
        for (int i = 0; i < 16; ++i) acc[q][i] = 0.f;
    for (int d0 = 0; d0 < 8; ++d0) {
#pragma unroll
        for (int ks = 0; ks < 2; ++ks) {
            bf16x8 Bt[9];
#pragma unroll
            for (int j = 0; j < 9; ++j) Bt[j] = *(const LAS bf16x8*)(lds + bbase + 512 * j - 64 * d0 + 32 * ks);
#pragma unroll
            for (int ep = -8; ep <= 3; ++ep) {
                const LAS unsigned* ap = (const LAS unsigned*)(lds + abase - 64 * d0 - 512 * ep + 32 * ks);
                u32x4 av; av[0] = ap[0]; av[1] = ap[1]; av[2] = ap[2]; av[3] = ap[3];
                const bf16x8 a = __builtin_bit_cast(bf16x8, av);
#pragma unroll
                for (int ctl = 0; ctl < 4; ++ctl) { const int jt = ctl - ep; if (jt >= 0 && jt <= 8) acc[ctl] = __builtin_amdgcn_mfma_f32_32x32x16_bf16(a, Bt[jt], acc[ctl], 0, 0, 0); }
            }
        }
    }
}
__device__ __forceinline__ void hy_epilogue(LAS unsigned char* lds, int zb, int gb, int hlf, int lane, const f32x16 (&acc)[4], float bias) {
    const int r = lane & 31, hh = lane >> 5, il = r >> 2, b = r & 3;
#pragma unroll
    for (int ctl = 0; ctl < 4; ++ctl) {
        const int I = 8 * (4 * hlf + ctl) + il;
#pragma unroll
        for (int q = 0; q < 4; ++q) {
            const int n4 = 32 * I + 8 * q + 4 * hh;
            LAS u32x2* zp = (LAS u32x2*)(lds + zb + (256 + b * HY_ZSTRIDE + n4) * 2);
            const u32x2 zv = *zp, gv = *(const LAS u32x2*)(lds + gb + (b * 2048 + n4) * 2);
            const float z0 = bflo(zv[0]), z1 = bfhi(zv[0]), z2 = bflo(zv[1]), z3 = bfhi(zv[1]);
            const float g0 = bflo(gv[0]), g1 = bfhi(gv[0]), g2 = bflo(gv[1]), g3 = bfhi(gv[1]);
            u32x2 o; o[0] = pk_bf16(g0 * fmaf(bias, z0, acc[ctl][4 * q + 0]), g1 * fmaf(bias, z1, acc[ctl][4 * q + 1]));
            o[1] = pk_bf16(g2 * fmaf(bias, z2, acc[ctl][4 * q + 2]), g3 * fmaf(bias, z3, acc[ctl][4 * q + 3]));
            *zp = o;
        }
    }
}
__device__ __forceinline__ void hyena_unit(LAS unsigned char* lds, int unit, const u16* __restrict__ HYT, const u16* __restrict__ FR, const float* __restrict__ cw, const float* __restrict__ cbv,
                                           const float* __restrict__ hbias, u16* __restrict__ Z2T) {
    const int tid = threadIdx.x, wid = __builtin_amdgcn_readfirstlane(tid >> 6), lane = tid & 63;
    const int cs = wid & 3, hlf = wid >> 2, c = unit * 4 + cs, pl = lane + 64 * hlf;
    const int zb = cs * HY_ZBYTES, fb = HY_FB + cs * HY_FCH;
    { const u32x4 z = {0u, 0u, 0u, 0u}; for (int idx = pl; idx < HY_ZBYTES / 16; idx += 128) *(LAS u32x4*)(lds + zb + idx * 16) = z; }
    __syncthreads();
    hy_load_row(lds, zb, 256, HY_ZSTRIDE, HYT + (size_t)c * NTOK, cw[0 * 3072 + c], cw[1 * 3072 + c], cw[2 * 3072 + c], cbv[c], pl);
    f32x16 acc[4];
#pragma unroll
    for (int o = 0; o < 2; ++o) {
        hy_load_filters(lds, fb, FR + (size_t)((o * 1024 + c) * 2) * FR_LEN, pl);
        __syncthreads();
        hy_mfma_loop(lds, zb, fb, hlf, lane, acc);
        __syncthreads();
        const int gc = (1 + o) * 1024 + c;
        hy_load_row(lds, fb, 0, 2048, HYT + (size_t)gc * NTOK, cw[0 * 3072 + gc], cw[1 * 3072 + gc], cw[2 * 3072 + gc], cbv[gc], pl);
        __syncthreads();
        hy_epilogue(lds, zb, fb, hlf, lane, acc, hbias[o * HYW + c]);
        __syncthreads();
    }
#pragma unroll 2
    for (int it = 0; it < 8; ++it) { const int idx = pl + 128 * it, tok0 = idx * 8, b = tok0 >> 11, n0 = tok0 & 2047;
        *(u32x4*)(Z2T + (size_t)c * NTOK + tok0) = *(const LAS u32x4*)(lds + zb + (256 + b * HY_ZSTRIDE + n0) * 2); }
    __syncthreads();
}
__global__ void __launch_bounds__(512, 2) k_hyena(const u16* __restrict__ HYT, const u16* __restrict__ FR, const float* __restrict__ cw, const float* __restrict__ cbv, const float* __restrict__ hbias, u16* __restrict__ Z2T) {
    extern __shared__ __attribute__((aligned(16))) unsigned char shm[];
    for (int u = blockIdx.x; u < 256; u += gridDim.x) hyena_unit((LAS unsigned char*)shm, u, HYT, FR, cw, cbv, hbias, Z2T);
}
__global__ void __launch_bounds__(256) k_hy_norm(const u16* __restrict__ Z2T, const float* __restrict__ gain, u16* __restrict__ MIXB) {
    extern __shared__ __attribute__((aligned(16))) unsigned char shm[];
    u16* tile = (u16*)shm;
    float* ssq = (float*)(shm + 1024 * 80);
    const int t = threadIdx.x, tok0 = blockIdx.x * 32;
    if (t < 32) ssq[t] = 0.f;
    __syncthreads();
    float part[8];
#pragma unroll
    for (int q = 0; q < 8; ++q) part[q] = 0.f;
    const int ch = t & 3;
    for (int it = 0; it < 16; ++it) {
        const int c = (t >> 2) + 64 * it;
        const u32x4 v = *(const u32x4*)(Z2T + (size_t)c * NTOK + tok0 + ch * 8);
        *(u32x4*)(tile + c * 40 + ch * 8) = v;
#pragma unroll
        for (int q = 0; q < 4; ++q) { const float a = bflo(v[q]), b = bfhi(v[q]); part[2 * q] += a * a; part[2 * q + 1] += b * b; }
    }
#pragma unroll
    for (int q = 0; q < 8; ++q) atomicAdd(&ssq[ch * 8 + q], part[q]);
    __syncthreads();
    const int tt = t >> 3;
    const float r = rsqrtf(ssq[tt] / (float)HYW + EPS);
    for (int k = 0; k < 16; ++k) {
        const int c0 = ((t & 7) + 8 * k) * 8;
        float o[8];
#pragma unroll
        for (int q = 0; q < 8; ++q) o[q] = bf2f(tile[(c0 + q) * 40 + tt]) * r * gain[c0 + q];
        u32x4 w; w[0] = pk_bf16(o[0], o[1]); w[1] = pk_bf16(o[2], o[3]); w[2] = pk_bf16(o[4], o[5]); w[3] = pk_bf16(o[6], o[7]);
        *(u32x4*)(MIXB + (size_t)(tok0 + tt) * DM + 1024 + c0) = w;
    }
}

constexpr int HG_RAWQ = 0, HG_RAWF = 16384, HG_RAWV = 32768;
constexpr int HG_QM = 36864, HG_KM = HG_QM + 17408, HG_QI = HG_KM + 17408;
constexpr int HG_KL = HG_QI + 17408;
constexpr int HG_VT = HG_KL + 18432;
constexpr int HG_P = HG_VT + 4608;
constexpr int HG_ST = HG_P + 9216;
constexpr int HG_TOT = HG_ST + 8704;
constexpr int HG_EL2 = HG_TOT + 2048;
constexpr int HG_LDS = HG_EL2 + 512;

__device__ __forceinline__ void hgrn_unit(LAS unsigned char* lds, int unit, const u16* __restrict__ PG, const float* __restrict__ lb_logits, float* __restrict__ OF, float* __restrict__ OB) {
    const int tid = threadIdx.x, wid = __builtin_amdgcn_readfirstlane(tid >> 6), lane = tid & 63, fr = lane & 15, fq = lane >> 4;
    const int vq = unit & 3, dir = (unit >> 2) & 1, h = (unit >> 3) & 7, b = unit >> 6;
    const int k = tid & 127, seg = tid >> 7;
    float* __restrict__ O = dir ? OB : OF;
    float lb;
    { const int c = h * 128 + k; const float l0 = lb_logits[(0 * 2 + dir) * HGW + c], l1 = lb_logits[(1 * 2 + dir) * HGW + c]; lb = 1.0f / (1.0f + __expf(l1 - l0)); }
    for (int i = tid; i < 8704 / 16; i += 512) *(LAS u32x4*)(lds + HG_ST + i * 16) = (u32x4){0u, 0u, 0u, 0u};
    f32x4 Sacc[2];
    Sacc[0] = (f32x4){0.f, 0.f, 0.f, 0.f}; Sacc[1] = Sacc[0];
    u32x4 pq[2], pf[2], pv;
    const int colq = h * 128, colf = (1 + dir) * 1024 + h * 128, colv = 3072 + h * 128 + vq * 32;
#define HG_TOK(c, tau) ((size_t)b * SEQ + (dir ? (SEQ - 1 - 64 * (c) - (tau)) : (64 * (c) + (tau))))
#define HG_PREFETCH(c) do { _Pragma("unroll") for (int _i = 0; _i < 2; ++_i) { const int _x = tid + 512 * _i, _tau = _x >> 4, _p = _x & 15; const u16* _r = PG + HG_TOK(c, _tau) * 5120; \
            pq[_i] = *(const u32x4*)(_r + colq + _p * 8); pf[_i] = *(const u32x4*)(_r + colf + _p * 8); } \
        if (tid < 256) { const int _tau = tid >> 2, _p = tid & 3; pv = *(const u32x4*)(PG + HG_TOK(c, _tau) * 5120 + colv + _p * 8); } } while (0)
    HG_PREFETCH(0);
    for (int c = 0; c < 32; ++c) {
#pragma unroll
        for (int i = 0; i < 2; ++i) { const int x = tid + 512 * i; *(LAS u32x4*)(lds + HG_RAWQ + x * 16) = pq[i]; *(LAS u32x4*)(lds + HG_RAWF + x * 16) = pf[i]; }
        if (tid < 256) *(LAS u32x4*)(lds + HG_RAWV + tid * 16) = pv;
        if (c + 1 < 32) HG_PREFETCH(c + 1);
        __syncthreads();
        float qv[16], kv[16], bl[16];
        { float run = 0.f;
#pragma unroll
          for (int i = 0; i < 16; ++i) { const int tau = seg * 16 + i;
              const float qr = bf2f(*(const LAS u16*)(lds + HG_RAWQ + tau * 256 + k * 2)), zf = bf2f(*(const LAS u16*)(lds + HG_RAWF + tau * 256 + k * 2));
              const float sg = 1.0f / (1.0f + __expf(-zf)); const float f = lb + (1.0f - lb) * sg;
              run += __logf(f); bl[i] = run; kv[i] = 1.0f - f; qv[i] = qr / (1.0f + __expf(-qr)); }
          *(LAS float*)(lds + HG_TOT + (seg * 128 + k) * 4) = run; }
        __syncthreads();
        { const float t0 = *(const LAS float*)(lds + HG_TOT + (0 * 128 + k) * 4), t1 = *(const LAS float*)(lds + HG_TOT + (1 * 128 + k) * 4),
                      t2 = *(const LAS float*)(lds + HG_TOT + (2 * 128 + k) * 4), t3 = *(const LAS float*)(lds + HG_TOT + (3 * 128 + k) * 4);
          const float pre = (seg > 0 ? t0 : 0.f) + (seg > 1 ? t1 : 0.f) + (seg > 2 ? t2 : 0.f);
          const float bref = t0 + t1, blast = bref + t2 + t3;
          const float er = __expf(bref), el = __expf(blast - bref);
          if (seg == 0) *(LAS float*)(lds + HG_EL2 + k * 4) = __expf(blast);
          unsigned klp[8];
#pragma unroll
          for (int i = 0; i < 16; i += 2) {
              float klv[2];
#pragma unroll
              for (int u = 0; u < 2; ++u) { const int tau = seg * 16 + i + u; const float bb = pre + bl[i + u];
                  const float e1 = __expf(bb - bref), e2 = __expf(bref - bb);
                  const float qm = qv[i + u] * e1, km = kv[i + u] * e2;
                  *(LAS u16*)(lds + HG_QM + tau * 272 + k * 2) = (u16)(pk_bf16(qm, 0.f) & 0xffffu);
                  *(LAS u16*)(lds + HG_KM + tau * 272 + k * 2) = (u16)(pk_bf16(km, 0.f) & 0xffffu);
                  *(LAS u16*)(lds + HG_QI + tau * 272 + k * 2) = (u16)(pk_bf16(qm * er, 0.f) & 0xffffu);
                  klv[u] = km * el; }
              klp[i >> 1] = pk_bf16(klv[0], klv[1]); }
          *(LAS u32x4*)(lds + HG_KL + k * 144 + seg * 32) = (u32x4){klp[0], klp[1], klp[2], klp[3]};
          *(LAS u32x4*)(lds + HG_KL + k * 144 + seg * 32 + 16) = (u32x4){klp[4], klp[5], klp[6], klp[7]};
          { const int v = tid & 31, tg = tid >> 5; unsigned short e[4];
#pragma unroll
            for (int u = 0; u < 4; ++u) e[u] = *(const LAS u16*)(lds + HG_RAWV + (tg * 4 + u) * 64 + v * 2);
            *(LAS u32x2*)(lds + HG_VT + v * 144 + tg * 8) = (u32x2){(unsigned)e[0] | ((unsigned)e[1] << 16), (unsigned)e[2] | ((unsigned)e[3] << 16)}; } }
        __syncthreads();
#pragma unroll
        for (int q = 0; q < 2; ++q) { const int idx = wid * 2 + q, ti = idx >> 2, si = idx & 3;
            f32x4 a = {0.f, 0.f, 0.f, 0.f};
            if (si <= ti) {
#pragma unroll
                for (int ks = 0; ks < 4; ++ks) { const bf16x8 ka = *(const LAS bf16x8*)(lds + HG_KM + (si * 16 + fr) * 272 + (ks * 32 + fq * 8) * 2), qb = *(const LAS bf16x8*)(lds + HG_QM + (ti * 16 + fr) * 272 + (ks * 32 + fq * 8) * 2);
                    a = __builtin_amdgcn_mfma_f32_16x16x32_bf16(ka, qb, a, 0, 0, 0); } }
            const int tau = ti * 16 + fr, s0 = si * 16 + fq * 4;
            float pvv[4];
#pragma unroll
            for (int j = 0; j < 4; ++j) pvv[j] = (si <= ti && s0 + j <= tau) ? a[j] : 0.f;
            *(LAS u32x2*)(lds + HG_P + tau * 144 + s0 * 2) = (u32x2){pk_bf16(pvv[0], pvv[1]), pk_bf16(pvv[2], pvv[3])}; }
        const int ti = wid >> 1, vi = wid & 1;
        f32x4 oacc = {0.f, 0.f, 0.f, 0.f};
#pragma unroll
        for (int ks = 0; ks < 4; ++ks) { const bf16x8 qa = *(const LAS bf16x8*)(lds + HG_QI + (ti * 16 + fr) * 272 + (ks * 32 + fq * 8) * 2), sb = *(const LAS bf16x8*)(lds + HG_ST + (vi * 16 + fr) * 272 + (ks * 32 + fq * 8) * 2);
            oacc = __builtin_amdgcn_mfma_f32_16x16x32_bf16(qa, sb, oacc, 0, 0, 0); }
        { const f32x4 e2 = *(const LAS f32x4*)(lds + HG_EL2 + (wid * 16 + fq * 4) * 4);
#pragma unroll
          for (int v2 = 0; v2 < 2; ++v2) { Sacc[v2] = Sacc[v2] * e2;
#pragma unroll
              for (int ks = 0; ks < 2; ++ks) { const bf16x8 ka = *(const LAS bf16x8*)(lds + HG_KL + (wid * 16 + fr) * 144 + (ks * 32 + fq * 8) * 2), vb = *(const LAS bf16x8*)(lds + HG_VT + (v2 * 16 + fr) * 144 + (ks * 32 + fq * 8) * 2);
                  Sacc[v2] = __builtin_amdgcn_mfma_f32_16x16x32_bf16(ka, vb, Sacc[v2], 0, 0, 0); } } }
        __syncthreads();
#pragma unroll
        for (int ks = 0; ks < 2; ++ks) { const bf16x8 pa = *(const LAS bf16x8*)(lds + HG_P + (ti * 16 + fr) * 144 + (ks * 32 + fq * 8) * 2), vb = *(const LAS bf16x8*)(lds + HG_VT + (vi * 16 + fr) * 144 + (ks * 32 + fq * 8) * 2);
            oacc = __builtin_amdgcn_mfma_f32_16x16x32_bf16(pa, vb, oacc, 0, 0, 0); }
#pragma unroll
        for (int j = 0; j < 4; ++j) { const int tau = ti * 16 + fq * 4 + j; O[HG_TOK(c, tau) * HGW + h * 128 + vq * 32 + vi * 16 + fr] = oacc[j]; }
#pragma unroll
        for (int v2 = 0; v2 < 2; ++v2) *(LAS u32x2*)(lds + HG_ST + (v2 * 16 + fr) * 272 + (wid * 16 + fq * 4) * 2) = (u32x2){pk_bf16(Sacc[v2][0], Sacc[v2][1]), pk_bf16(Sacc[v2][2], Sacc[v2][3])};
    }
    __syncthreads();
#undef HG_TOK
#undef HG_PREFETCH
}
__global__ void __launch_bounds__(512, 2) k_hgrn(const u16* __restrict__ PG, const float* __restrict__ lb_logits, float* __restrict__ OF, float* __restrict__ OB) {
    extern __shared__ __attribute__((aligned(16))) unsigned char shm[];
    for (int u = blockIdx.x; u < 256; u += gridDim.x) hgrn_unit((LAS unsigned char*)shm, u, PG, lb_logits, OF, OB);
}
__global__ void __launch_bounds__(128) k_hgrn_final2(const float* __restrict__ o_f, const float* __restrict__ o_b, const u16* __restrict__ PG, const float* __restrict__ gain, u16* __restrict__ mixb) {
    __shared__ float red[2];
    const int tok = blockIdx.x >> 3, h = blockIdx.x & 7, t = threadIdx.x, c = h * 128 + t;
    const float o = o_f[(size_t)tok * HGW + c] + o_b[(size_t)tok * HGW + c];
    float s = o * o;
    for (int k = 32; k >= 1; k >>= 1) s += __shfl_xor(s, k);
    if ((t & 63) == 0) red[t >> 6] = s;
    __syncthreads();
    s = red[0] + red[1];
    const float r = rsqrtf(s / 128.0f + EPS);
    const float g = bf2f(PG[(size_t)tok * 5120 + 4096 + c]);
    const float v = o * r * gain[c] * (g / (1.0f + __expf(-g)));
    const float vn = __shfl_down(v, 1);
    if ((t & 1) == 0) *(unsigned*)(mixb + (size_t)tok * DM + c) = pk_bf16(v, vn);
}
constexpr size_t WS_HB = WS_END;
constexpr size_t WS_PG = WS_HB + 32 * MB;
constexpr size_t WS_HYT = WS_PG + 80 * MB;
constexpr size_t WS_MIXB = WS_HYT + 48 * MB;
constexpr size_t WS_XNB = WS_MIXB + 32 * MB;
constexpr size_t WS_HMB = WS_XNB + 32 * MB;
constexpr size_t WS_YB = WS_HMB + 128 * MB;
constexpr size_t WS_H3 = WS_YB + 128 * MB;
constexpr size_t WS_FR = WS_H3 + 1 * MB;
constexpr size_t WS_Z2T = WS_FR + 34 * MB;
constexpr size_t WS_END2 = WS_Z2T + 16 * MB;

__global__ void __launch_bounds__(128) k_hgrn_final_bf(const float* __restrict__ o_f, const float* __restrict__ o_b, const float* __restrict__ proj, const float* __restrict__ gain, u16* __restrict__ mixb) {
    __shared__ float red[2];
    const int tok = blockIdx.x >> 3, h = blockIdx.x & 7, t = threadIdx.x, c = h * 128 + t;
    const float o = o_f[(size_t)tok * HGW + c] + o_b[(size_t)tok * HGW + c];
    float s = o * o;
    for (int k = 32; k >= 1; k >>= 1) s += __shfl_xor(s, k);
    if ((t & 63) == 0) red[t >> 6] = s;
    __syncthreads();
    s = red[0] + red[1];
    const float r = rsqrtf(s / 128.0f + EPS);
    const float g = proj[(size_t)tok * DIN + 4096 + c];
    const float v = o * r * gain[c] * siluf_(g);
    const float vn = __shfl_down(v, 1);
    if ((t & 1) == 0) *(unsigned*)(mixb + (size_t)tok * DM + c) = pk_bf16(v, vn);
}

extern "C" void kernel_launch(void* const* d_in, const int* in_sizes, int n_in, void* d_out, int out_size, void* d_ws, size_t ws_size, hipStream_t stream) {
    const float* x = (const float*)d_in[0];
    const float* norm_mix_gain = (const float*)d_in[1];
    const float* w_in = (const float*)d_in[2];
    const float* lb_logits = (const float*)d_in[3];
    const float* hgrn_norm_gain = (const float*)d_in[4];
    const float* hy_conv_w = (const float*)d_in[5];
    const float* hy_conv_b = (const float*)d_in[6];
    const float* fw1 = (const float*)d_in[7];
    const float* fb1 = (const float*)d_in[8];
    const float* fw2 = (const float*)d_in[9];
    const float* fb2 = (const float*)d_in[10];
    const float* fw3 = (const float*)d_in[11];
    const float* fb3 = (const float*)d_in[12];
    const float* fw4 = (const float*)d_in[13];
    const float* ffreq = (const float*)d_in[14];
    const float* hy_bias = (const float*)d_in[15];
    const float* hy_norm_gain = (const float*)d_in[16];
    const float* w_out = (const float*)d_in[17];
    const float* norm_ffn_gain = (const float*)d_in[18];
    const float* w_router = (const float*)d_in[19];
    const float* b_router = (const float*)d_in[20];
    const float* moe_w1 = (const float*)d_in[21];
    const float* moe_b1 = (const float*)d_in[22];
    const float* moe_w2 = (const float*)d_in[23];
    const float* moe_b2 = (const float*)d_in[24];
    const float* final_gain = (const float*)d_in[25];
    float* out = (float*)d_out;
    char* ws = (char*)d_ws;
    if (ws_size < WS_END2) return;
    int* counts = (int*)(ws + WS_CTL);
    int* cursor = (int*)(ws + WS_CTL + 256);
    int* offs = (int*)(ws + WS_CTL + 512);
    float* PROJ = (float*)(ws + WS_PROJ);
    float* OF = (float*)(ws + WS_OF);
    float* OB = (float*)(ws + WS_OB);
    float* X1 = (float*)(ws + WS_X1);
    float* XN = (float*)(ws + WS_XN);
    int* TOPI = (int*)(ws + WS_TOPI);
    float* TOPG = (float*)(ws + WS_TOPG);
    int* STOK = (int*)(ws + WS_STOK);
    int* SOF = (int*)(ws + WS_SOF);
    u16* HB = (u16*)(ws + WS_HB);
    u16* PG = (u16*)(ws + WS_PG);
    u16* HYT = (u16*)(ws + WS_HYT);
    u16* MIXB = (u16*)(ws + WS_MIXB);
    u16* XNB = (u16*)(ws + WS_XNB);
    u16* HMB = (u16*)(ws + WS_HMB);
    u16* YB = (u16*)(ws + WS_YB);
    float* H3 = (float*)(ws + WS_H3);
    u16* FR = (u16*)(ws + WS_FR);
    u16* Z2T = (u16*)(ws + WS_Z2T);
    static bool inited = false;
    if (!inited) {
        hipFuncSetAttribute((const void*)k_gemm1, hipFuncAttributeMaxDynamicSharedMemorySize, GEMM_LDS);
        hipFuncSetAttribute((const void*)k_gemm_wout, hipFuncAttributeMaxDynamicSharedMemorySize, GEMM_LDS);
        hipFuncSetAttribute((const void*)k_moe_a, hipFuncAttributeMaxDynamicSharedMemorySize, GEMM_LDS);
        hipFuncSetAttribute((const void*)k_moe_b, hipFuncAttributeMaxDynamicSharedMemorySize, GEMM_LDS);
        hipFuncSetAttribute((const void*)k_hyena, hipFuncAttributeMaxDynamicSharedMemorySize, HY_LDS);
        hipFuncSetAttribute((const void*)k_hgrn, hipFuncAttributeMaxDynamicSharedMemorySize, HG_LDS);
        hipFuncSetAttribute((const void*)k_hy_norm, hipFuncAttributeMaxDynamicSharedMemorySize, 82048);
        inited = true;
    }
    (void)hipMemsetAsync(ws + WS_CTL, 0, 65536, stream);
    k_rmsnorm_bf<<<NTOK, 256, 0, stream>>>(x, norm_mix_gain, nullptr, HB, DM);
    k_h3<<<SEQ / 4, 256, 0, stream>>>(fw1, fb1, fw2, fb2, fw3, fb3, ffreq, H3);
    k_frgen<<<256, 512, 0, stream>>>(H3, fw4, FR);
    k_gemm1<<<256, 512, GEMM_LDS, stream>>>(HB, w_in, PG, HYT);
    k_hgrn<<<256, 512, HG_LDS, stream>>>(PG, lb_logits, OF, OB);
    k_hgrn_final2<<<NTOK * HGH, 128, 0, stream>>>(OF, OB, PG, hgrn_norm_gain, MIXB);
    k_hyena<<<256, 512, HY_LDS, stream>>>(HYT, FR, hy_conv_w, hy_conv_b, hy_bias, Z2T);
    k_hy_norm<<<NTOK / 32, 256, 82048, stream>>>(Z2T, hy_norm_gain, MIXB);
    k_gemm_wout<<<256, 512, GEMM_LDS, stream>>>(MIXB, w_out, x, X1);
    k_rmsnorm_bf<<<NTOK, 256, 0, stream>>>(X1, norm_ffn_gain, XN, XNB, DM);
    k_router<<<NTOK, 256, 0, stream>>>(XN, w_router, b_router, TOPI, TOPG, counts);
    k_offsets<<<1, 64, 0, stream>>>(counts, offs);
    k_scatter<<<NSLOT / 256, 256, 0, stream>>>(TOPI, offs, cursor, STOK, SOF);
    k_moe_a<<<256, 512, GEMM_LDS, stream>>>(XNB, STOK, offs, moe_w1, moe_b1, HMB);
    k_moe_b<<<256, 512, GEMM_LDS, stream>>>(HMB, offs, moe_w2, moe_b2, YB);
    k_combine_final_bf<<<NTOK, 256, 0, stream>>>(X1, YB, SOF, TOPG, final_gain, out);
}
```

```cpp
#include <hip/hip_runtime.h>
#include <stdint.h>

constexpr int BATCH = 4, SEQ = 2048, DM = 2048, NTOK = BATCH * SEQ;
constexpr int HGW = 1024, HGD = 128, HGH = 8;
constexpr int HYW = 1024;
constexpr int DIN = 8192;
constexpr int NE = 32, TOPK = 4, DFF = 2048;
constexpr int NSLOT = NTOK * TOPK;
constexpr float EPS = 1e-5f;

constexpr size_t MB = 1024ull * 1024ull;
constexpr size_t WS_CTL = 0;
constexpr size_t WS_HB = 1 * MB;
constexpr size_t WS_PG = WS_HB + 32 * MB;
constexpr size_t WS_HYT = WS_PG + 80 * MB;
constexpr size_t WS_MIXB = WS_HYT + 48 * MB;
constexpr size_t WS_XNB = WS_MIXB + 32 * MB;
constexpr size_t WS_HMB = WS_XNB + 32 * MB;
constexpr size_t WS_YB = WS_HMB + 128 * MB;
constexpr size_t WS_H3 = WS_YB + 128 * MB;
constexpr size_t WS_FR = WS_H3 + 1 * MB;
constexpr size_t WS_Z2T = WS_FR + 34 * MB;
constexpr size_t WS_OF = WS_Z2T + 16 * MB;
constexpr size_t WS_OB = WS_OF + 32 * MB;
constexpr size_t WS_X1 = WS_OB + 32 * MB;
constexpr size_t WS_TOPI = WS_X1 + 64 * MB;
constexpr size_t WS_TOPG = WS_TOPI + 1 * MB;
constexpr size_t WS_STOK = WS_TOPG + 1 * MB;
constexpr size_t WS_SOF = WS_STOK + 1 * MB;
constexpr size_t WS_END2 = WS_SOF + 1 * MB;

typedef short bf16x8 __attribute__((ext_vector_type(8)));
typedef float f32x4 __attribute__((ext_vector_type(4)));
typedef float f32x2 __attribute__((ext_vector_type(2)));
typedef unsigned u32x4 __attribute__((ext_vector_type(4)));
typedef unsigned u32x2 __attribute__((ext_vector_type(2)));
typedef unsigned short u16;
#define LAS __attribute__((address_space(3)))

__device__ __forceinline__ unsigned pk_bf16(float lo, float hi) {
    typedef __bf16 bf2 __attribute__((ext_vector_type(2)));
    const f32x2 v = {lo, hi};
    const bf2 r = __builtin_convertvector(v, bf2);
    return __builtin_bit_cast(unsigned, r);
}
__device__ __forceinline__ float bf2f(u16 b) { return __uint_as_float(((unsigned)b) << 16); }
__device__ __forceinline__ float bflo(unsigned w) { return __uint_as_float(w << 16); }
__device__ __forceinline__ float bfhi(unsigned w) { return __uint_as_float(w & 0xffff0000u); }

__device__ __forceinline__ int lds_byte(int r, int c) { const int st = (r >> 4) * 2 + (c >> 5), ob = (r & 15) * 64 + (c & 31) * 2; return st * 1024 + (ob ^ (((ob >> 9) & 1) << 5)); }
__device__ __forceinline__ void stage_rc(int b, int& R, int& C) { const int st = b >> 10, sb = b & 1023, swz = sb ^ (((sb >> 9) & 1) << 5); R = (st >> 1) * 16 + swz / 64; C = (st & 1) * 32 + (swz % 64) / 2; }
__device__ __forceinline__ f32x4 unperm(const f32x4 a, const bool s) { f32x4 o; o[0] = s ? a[1] : a[0]; o[1] = s ? a[0] : a[1]; o[2] = s ? a[3] : a[2]; o[3] = s ? a[2] : a[3]; return o; }

__device__ __forceinline__ int tid_fresh() { int t = threadIdx.x; asm volatile("" : "+v"(t)); return t; }
constexpr int GEMM_LDS = 131072;

template <bool TRANS, bool RAGGED, class ColMap, class Epi>
__device__ __forceinline__ void gemm_unit(LAS unsigned char* lds, const u16* __restrict__ A, int lda, const int* __restrict__ arows, int arow0, int rows_valid,
                                          const float* __restrict__ B, int ldb, int K, const ColMap colmap, const Epi epi) {
    const int tid = tid_fresh(), wid = __builtin_amdgcn_readfirstlane(tid >> 6), lane = tid & 63;
    const int wr = wid >> 2, wc = wid & 3, fr = lane & 15, fq = lane >> 4;
    const int nt = K >> 6;
    const char* ap[4];
#pragma unroll
    for (int i = 0; i < 4; ++i) {
        int R, C; stage_rc(wid * 1024 + i * 8192 + lane * 16, R, C);
        const int rr = RAGGED ? (R < rows_valid ? R : rows_valid - 1) : R;
        const long rowid = arows ? (long)arows[rr] : (long)(arow0 + rr);
        ap[i] = (const char*)A + ((size_t)rowid * lda + C) * 2;
    }
    const int g = (lane & 3) + 4 * (wid >> 2), rg = (wid & 3) * 16 + (lane >> 2);
    const float* bp = B + (size_t)(8 * g) * ldb + colmap(rg);
    const int bbase = 65536 + lds_byte(4 * rg, 8 * g);
    const int bw0 = bbase + ((rg & 1) ? 64 : 0), bw1 = bbase + ((rg & 1) ? 0 : 64);
    const int aoff = lds_byte(wr * 128 + fr, fq * 8), boff = 65536 + lds_byte(wc * 64 + fr, fq * 8);
    int mvalid = 8;
    if (RAGGED) { mvalid = (rows_valid - wr * 128 + 15) >> 4; mvalid = mvalid < 0 ? 0 : (mvalid > 8 ? 8 : mvalid); }
    f32x4 vb[8];
    f32x4 acc[8][4];
#pragma unroll
    for (int m = 0; m < 8; ++m)
#pragma unroll
        for (int n = 0; n < 4; ++n) acc[m][n] = (f32x4){0.f, 0.f, 0.f, 0.f};
#define GE_GLDS_A(buf, kt) do { _Pragma("unroll") for (int _i = 0; _i < 4; ++_i) \
        __builtin_amdgcn_global_load_lds((const unsigned*)(ap[_i] + (size_t)(kt) * 128), (LAS unsigned*)(lds + (buf) * 32768 + wid * 1024 + _i * 8192), 16, 0, 0); } while (0)
#define GE_LOAD_B(kt) do { _Pragma("unroll") for (int _k = 0; _k < 8; ++_k) vb[_k] = *(const f32x4*)(bp + (size_t)((kt) * 64 + _k) * ldb); } while (0)
#define GE_WRITE_B(buf) do { _Pragma("unroll") for (int _i = 0; _i < 4; ++_i) { u32x4 _w; _w[0] = pk_bf16(vb[0][_i], vb[1][_i]); _w[1] = pk_bf16(vb[2][_i], vb[3][_i]); \
        _w[2] = pk_bf16(vb[4][_i], vb[5][_i]); _w[3] = pk_bf16(vb[6][_i], vb[7][_i]); \
        *(LAS u32x4*)(lds + ((_i & 1) ? bw1 : bw0) + (_i >> 1) * 128 + (buf) * 32768) = _w; } } while (0)
#define GE_KSTEP(buf, ks) do { bf16x8 Bf[4]; \
        _Pragma("unroll") for (int n = 0; n < 4; ++n) Bf[n] = *(const LAS bf16x8*)(lds + (buf) * 32768 + boff + n * 2048 + (ks) * 1024); \
        _Pragma("unroll") for (int mh = 0; mh < 2; ++mh) { bf16x8 At[4]; \
            _Pragma("unroll") for (int m = 0; m < 4; ++m) At[m] = *(const LAS bf16x8*)(lds + (buf) * 32768 + aoff + (mh * 4 + m) * 2048 + (ks) * 1024); \
            _Pragma("unroll") for (int m = 0; m < 4; ++m) { if (!RAGGED || (mh * 4 + m) < mvalid) { _Pragma("unroll") for (int n = 0; n < 4; ++n) \
                acc[mh * 4 + m][n] = TRANS ? __builtin_amdgcn_mfma_f32_16x16x32_bf16(At[m], Bf[n], acc[mh * 4 + m][n], 0, 0, 0) : __builtin_amdgcn_mfma_f32_16x16x32_bf16(Bf[n], At[m], acc[mh * 4 + m][n], 0, 0, 0); } } } } while (0)
    GE_GLDS_A(0, 0);
    GE_LOAD_B(0);
    asm volatile("s_waitcnt vmcnt(0)" ::: "memory");
    GE_WRITE_B(0);
    if (nt > 1) GE_LOAD_B(1);
    asm volatile("s_waitcnt lgkmcnt(0)" ::: "memory");
    __builtin_amdgcn_s_barrier();
    for (int t = 0; t < nt; ++t) {
        const int cur = t & 1;
        if (t + 1 < nt) { GE_WRITE_B(cur ^ 1); GE_GLDS_A(cur ^ 1, t + 1); }
        if (t + 2 < nt) GE_LOAD_B(t + 2);
        GE_KSTEP(cur, 0);
        GE_KSTEP(cur, 1);
        asm volatile("s_waitcnt vmcnt(0) lgkmcnt(0)" ::: "memory");
        __builtin_amdgcn_s_barrier();
    }
#undef GE_GLDS_A
#undef GE_LOAD_B
#undef GE_WRITE_B
#undef GE_KSTEP
    __builtin_amdgcn_sched_barrier(0);
    { const int tz = tid_fresh(), wz = __builtin_amdgcn_readfirstlane(tz >> 6), lz = tz & 63;
      epi(acc, wz >> 2, wz & 3, lz & 15, lz >> 4); }
}

__device__ __forceinline__ int xcd_logical(int b, int G) { return (G & 7) ? b : (b & 7) * (G >> 3) + (b >> 3); }

struct ColMapDense { int c0; __device__ __forceinline__ int operator()(int rg) const { return c0 + 4 * rg; } };
struct EpiPG { u16* PG; int tok0, col0;
    __device__ __forceinline__ void operator()(const f32x4 (&acc)[8][4], int wr, int wc, int fr, int fq) const {
#pragma unroll
        for (int m = 0; m < 8; ++m) { u16* rowp = PG + (size_t)(tok0 + wr * 128 + m * 16 + fr) * 5120 + col0 + wc * 64 + 4 * fq;
#pragma unroll
            for (int n = 0; n < 4; ++n) { const f32x4 v = unperm(acc[m][n], fq & 1); u32x2 w; w[0] = pk_bf16(v[0], v[1]); w[1] = pk_bf16(v[2], v[3]); *(u32x2*)(rowp + n * 16) = w; } }
    } };
struct EpiHYT { u16* HYT; int tok0, col0;
    __device__ __forceinline__ void operator()(const f32x4 (&acc)[8][4], int wr, int wc, int fr, int fq) const {
#pragma unroll
        for (int n = 0; n < 4; ++n) { const int rho = wc * 64 + n * 16 + fr; const int col = col0 + (rho & ~3) + ((rho & 3) ^ ((rho >> 2) & 1));
            u16* colp = HYT + (size_t)col * NTOK + tok0 + wr * 128 + 4 * fq;
#pragma unroll
            for (int m = 0; m < 8; ++m) { const f32x4 v = acc[m][n]; u32x2 w; w[0] = pk_bf16(v[0], v[1]); w[1] = pk_bf16(v[2], v[3]); *(u32x2*)(colp + m * 16) = w; } }
    } };
struct EpiX1 { const float* x; float* X1; int tok0, col0;
    __device__ __forceinline__ void operator()(const f32x4 (&acc)[8][4], int wr, int wc, int fr, int fq) const {
#pragma unroll
        for (int m = 0; m < 8; ++m) { const size_t off = (size_t)(tok0 + wr * 128 + m * 16 + fr) * DM + col0 + wc * 64 + 4 * fq;
#pragma unroll
            for (int n = 0; n < 4; ++n) { const f32x4 r = *(const f32x4*)(x + off + n * 16); *(f32x4*)(X1 + off + n * 16) = r + unperm(acc[m][n], fq & 1); }
            asm volatile("" ::: "memory"); }
    } };
struct ColMapGlu { int nt; __device__ __forceinline__ int operator()(int rg) const { const int wcq = rg >> 4, n = (rg >> 2) & 3, f = rg & 3; return (n >> 1) * 2048 + nt * 128 + wcq * 32 + (n & 1) * 16 + f * 4; } };
struct EpiSwiglu { u16* HM; const float* b1; int slot0, nt, rows_valid;
    __device__ __forceinline__ void operator()(const f32x4 (&acc)[8][4], int wr, int wc, int fr, int fq) const {
        f32x4 bg[2], bl[2];
#pragma unroll
        for (int nn = 0; nn < 2; ++nn) { const int col = nt * 128 + wc * 32 + nn * 16 + 4 * fq; bg[nn] = *(const f32x4*)(b1 + col); bl[nn] = *(const f32x4*)(b1 + 2048 + col); }
#pragma unroll
        for (int m = 0; m < 8; ++m) { const int row = wr * 128 + m * 16 + fr;
            if (row < rows_valid) {
#pragma unroll
                for (int nn = 0; nn < 2; ++nn) { const f32x4 gl = unperm(acc[m][nn], fq & 1) + bg[nn], li = unperm(acc[m][nn + 2], fq & 1) + bl[nn]; float o[4];
#pragma unroll
                    for (int j = 0; j < 4; ++j) { const float gq = fminf(gl[j], 7.0f), lq = fminf(fmaxf(li[j], -7.0f), 7.0f); o[j] = gq * (1.0f / (1.0f + __expf(-1.702f * gq))) * (lq + 1.0f); }
                    u32x2 w; w[0] = pk_bf16(o[0], o[1]); w[1] = pk_bf16(o[2], o[3]);
                    *(u32x2*)(HM + (size_t)(slot0 + row) * DFF + nt * 128 + wc * 32 + nn * 16 + 4 * fq) = w; } } }
    } };
struct EpiY { u16* Y; const float* b2; int slot0, col0, rows_valid;
    __device__ __forceinline__ void operator()(const f32x4 (&acc)[8][4], int wr, int wc, int fr, int fq) const {
        f32x4 bv[4];
#pragma unroll
        for (int n = 0; n < 4; ++n) bv[n] = *(const f32x4*)(b2 + col0 + wc * 64 + n * 16 + 4 * fq);
#pragma unroll
        for (int m = 0; m < 8; ++m) { const int row = wr * 128 + m * 16 + fr;
            if (row < rows_valid) { u16* rowp = Y + (size_t)(slot0 + row) * DM + col0 + wc * 64 + 4 * fq;
#pragma unroll
                for (int n = 0; n < 4; ++n) { const f32x4 v = unperm(acc[m][n], fq & 1) + bv[n]; u32x2 w; w[0] = pk_bf16(v[0], v[1]); w[1] = pk_bf16(v[2], v[3]); *(u32x2*)(rowp + n * 16) = w; } } }
    } };
template <int NTILES>
__device__ __forceinline__ bool moe_decode(const int* __restrict__ offs, int u, int& e, int& mt, int& nt, int& slot0, int& rows) {
    int base = 0;
    for (int q = 0; q < NE; ++q) { const int o0 = offs[q], cnt = offs[q + 1] - o0, mtl = (cnt + 255) >> 8, nu = mtl * NTILES;
        if (u < base + nu) { const int ul = u - base; e = q; mt = ul % mtl; nt = ul / mtl; slot0 = o0 + mt * 256; rows = cnt - mt * 256; if (rows > 256) rows = 256; return true; }
        base += nu; }
    return false;
}


typedef float f32x16 __attribute__((ext_vector_type(16)));
__device__ __forceinline__ void h3_row(int m, const float* __restrict__ w1, const float* __restrict__ b1, const float* __restrict__ w2, const float* __restrict__ b2,
                                       const float* __restrict__ w3, const float* __restrict__ b3, const float* __restrict__ freq, LAS float* sc  , float* __restrict__ H3) {
    const int j = tid_fresh() & 63;
    const float tt = (float)m / (float)(SEQ - 1);
    if (j == 0) sc[0] = tt;
    if (j >= 1 && j <= 16) { const int i = j - 1; const float band = 1e-4f + (float)i * ((15.0f - 1e-4f) / 15.0f); const float ang = (2.0f * 3.14159265358979323846f / (float)SEQ) * (float)m * band; sc[1 + i] = cosf(ang); sc[17 + i] = -sinf(ang); }
    __builtin_amdgcn_wave_barrier();
    const float fr = freq[j];
    float s = b1[j];
    for (int i = 0; i < 33; ++i) s += sc[i] * w1[i * 64 + j];
    const float h1 = sinf(fr * s);
    sc[64 + j] = h1;
    __builtin_amdgcn_wave_barrier();
    s = b2[j];
    for (int i = 0; i < 64; ++i) s += sc[64 + i] * w2[i * 64 + j];
    const float h2 = sinf(fr * s);
    __builtin_amdgcn_wave_barrier();
    sc[j] = h2;
    __builtin_amdgcn_wave_barrier();
    s = b3[j];
    for (int i = 0; i < 64; ++i) s += sc[i] * w3[i * 64 + j];
    H3[(size_t)m * 64 + j] = sinf(fr * s);
    __builtin_amdgcn_wave_barrier();
}
constexpr int FR_LEN = 4128;
__device__ __forceinline__ void frgen_item(int item, const float* __restrict__ H3, const float* __restrict__ w4, u16* __restrict__ FR, LAS float* hs  ) {
    const int tid = tid_fresh(), m0 = item * 8;
    for (int i = tid; i < 11 * 64; i += 512) { int m = m0 - 1 + (i >> 6); m = m < 0 ? 0 : (m > SEQ - 1 ? SEQ - 1 : m); hs[i] = H3[(size_t)m * 64 + (i & 63)]; }
    __syncthreads();
    const float mind = logf(1e-2f) / 0.3f, maxd = logf(1e-2f) / 1.5f;
    for (int p = 0; p < 4; ++p) {
        const int oc = tid + p * 512, o = oc >> 10, c = oc & 1023;
        const float* wf = w4 + o * 2048 + c; const float* wb = wf + 1024;
        float af[11], ab[11];
#pragma unroll
        for (int q = 0; q < 11; ++q) { af[q] = 0.f; ab[q] = 0.f; }
        for (int i = 0; i < 64; ++i) {
            const float xf = wf[(size_t)i * 4096], xb = wb[(size_t)i * 4096];
#pragma unroll
            for (int q = 0; q < 11; ++q) { const float h = hs[q * 64 + i]; af[q] = fmaf(h, xf, af[q]); ab[q] = fmaf(h, xb, ab[q]); }
        }
        const float delta = fabsf(mind + (float)c * ((maxd - mind) / 1023.0f));
#pragma unroll
        for (int q = 0; q < 11; ++q) { const int m = m0 - 1 + q; const float wv = (m >= 0 && m <= SEQ - 1) ? __expf(-((float)m / (float)(SEQ - 1)) * delta) : 0.f; af[q] *= wv; ab[q] *= wv; }
        u16* base = FR + (size_t)(oc * 2) * FR_LEN;
        u32x4 w;
        w[0] = pk_bf16(af[8], af[7]); w[1] = pk_bf16(af[6], af[5]); w[2] = pk_bf16(af[4], af[3]); w[3] = pk_bf16(af[2], af[1]);
        *(u32x4*)(base + 2040 - m0) = w;
        const float last = (m0 == 0) ? ab[2] : af[0];
        w[0] = pk_bf16(af[7], af[6]); w[1] = pk_bf16(af[5], af[4]); w[2] = pk_bf16(af[3], af[2]); w[3] = pk_bf16(af[1], last);
        *(u32x4*)(base + FR_LEN + 2040 - m0) = w;
        w[0] = pk_bf16(ab[2], ab[3]); w[1] = pk_bf16(ab[4], ab[5]); w[2] = pk_bf16(ab[6], ab[7]); w[3] = pk_bf16(ab[8], ab[9]);
        *(u32x4*)(base + 2048 + m0) = w;
        w[0] = pk_bf16(ab[3], ab[4]); w[1] = pk_bf16(ab[5], ab[6]); w[2] = pk_bf16(ab[7], ab[8]); w[3] = pk_bf16(ab[9], ab[10]);
        *(u32x4*)(base + FR_LEN + 2048 + m0) = w;
        if (item == 255) {
            const u32x4 z = {0u, 0u, 0u, 0u};
#pragma unroll
            for (int q = 0; q < 4; ++q) { *(u32x4*)(base + 4096 + q * 8) = z; *(u32x4*)(base + FR_LEN + 4096 + q * 8) = z; }
        }
    }
    __syncthreads();
}

constexpr int HY_ZSTRIDE = 2312;
constexpr int HY_ZCH = 256 + 4 * HY_ZSTRIDE;
constexpr int HY_ZBYTES = HY_ZCH * 2;
constexpr int HY_FB = 4 * HY_ZBYTES;
constexpr int HY_FCH = 2 * FR_LEN * 2;
constexpr int HY_LDS = HY_FB + 4 * HY_FCH;

__device__ __forceinline__ void hy_load_row(LAS unsigned char* lds, int dest, int boff0, int bstride, const u16* __restrict__ row, float w0, float w1, float w2, float cb, int pl) {
#pragma unroll 2
    for (int it = 0; it < 8; ++it) {
        const int idx = pl + 128 * it, tok0 = idx * 8, b = tok0 >> 11, n0 = tok0 & 2047;
        const u32x4 raw = *(const u32x4*)(row + tok0);
        const float pm = (n0 > 0) ? bf2f(row[tok0 - 1]) : 0.f;
        const float pn = (n0 + 8 < SEQ) ? bf2f(row[tok0 + 8]) : 0.f;
        float p[10];
        p[0] = pm; p[9] = pn;
#pragma unroll
        for (int q = 0; q < 4; ++q) { p[1 + 2 * q] = bflo(raw[q]); p[2 + 2 * q] = bfhi(raw[q]); }
        float o[8];
#pragma unroll
        for (int q = 0; q < 8; ++q) o[q] = fmaf(w0, p[q], fmaf(w1, p[q + 1], fmaf(w2, p[q + 2], cb)));
        u32x4 w; w[0] = pk_bf16(o[0], o[1]); w[1] = pk_bf16(o[2], o[3]); w[2] = pk_bf16(o[4], o[5]); w[3] = pk_bf16(o[6], o[7]);
        *(LAS u32x4*)(lds + dest + (boff0 + b * bstride + n0) * 2) = w;
    }
}
__device__ __forceinline__ void hy_load_filters(LAS unsigned char* lds, int fb, const u16* __restrict__ src, int pl) {
    for (int idx = pl; idx < HY_FCH / 16; idx += 128) *(LAS u32x4*)(lds + fb + idx * 16) = *(const u32x4*)((const char*)src + idx * 16);
}
__device__ __forceinline__ void hy_mfma_loop(LAS unsigned char* lds, int zb, int fb, int hlf, int lane, f32x16 (&acc)[4]) {
    const int r = lane & 31, hh = lane >> 5, il = r >> 2, b = r & 3;
    const int bbase = zb + (256 + b * HY_ZSTRIDE + 32 * il + 8 * hh) * 2;
    const int xl = 2047 - r + 8 * hh - 1024 * hlf;
    const int abase = (r & 1) ? (fb + 2 * xl) : (fb + FR_LEN * 2 + 2 * (xl - 1));
#pragma unroll
    for (int q = 0; q < 4; ++q)
#pragma unroll
        for (int i = 0; i < 16; ++i) acc[q][i] = 0.f;
    for (int d0 = 0; d0 < 8; ++d0) {
#pragma unroll
        for (int ks = 0; ks < 2; ++ks) {
            bf16x8 Bt[9];
#pragma unroll
            for (int j = 0; j < 9; ++j) Bt[j] = *(const LAS bf16x8*)(lds + bbase + 512 * j - 64 * d0 + 32 * ks);
#pragma unroll
            for (int ep = -8; ep <= 3; ++ep) {
                const LAS unsigned* ap = (const LAS unsigned*)(lds + abase - 64 * d0 - 512 * ep + 32 * ks);
                u32x4 av; av[0] = ap[0]; av[1] = ap[1]; av[2] = ap[2]; av[3] = ap[3];
                const bf16x8 a = __builtin_bit_cast(bf16x8, av);
#pragma unroll
                for (int ctl = 0; ctl < 4; ++ctl) { const int jt = ctl - ep; if (jt >= 0 && jt <= 8) acc[ctl] = __builtin_amdgcn_mfma_f32_32x32x16_bf16(a, Bt[jt], acc[ctl], 0, 0, 0); }
            }
        }
    }
}
__device__ __forceinline__ void hy_epilogue(LAS unsigned char* lds, int zb, int gb, int hlf, int lane, const f32x16 (&acc)[4], float bias) {
    const int r = lane & 31, hh = lane >> 5, il = r >> 2, b = r & 3;
#pragma unroll
    for (int ctl = 0; ctl < 4; ++ctl) {
        const int I = 8 * (4 * hlf + ctl) + il;
#pragma unroll
        for (int q = 0; q < 4; ++q) {
            const int n4 = 32 * I + 8 * q + 4 * hh;
            LAS u32x2* zp = (LAS u32x2*)(lds + zb + (256 + b * HY_ZSTRIDE + n4) * 2);
            const u32x2 zv = *zp, gv = *(const LAS u32x2*)(lds + gb + (b * 2048 + n4) * 2);
            const float z0 = bflo(zv[0]), z1 = bfhi(zv[0]), z2 = bflo(zv[1]), z3 = bfhi(zv[1]);
            const float g0 = bflo(gv[0]), g1 = bfhi(gv[0]), g2 = bflo(gv[1]), g3 = bfhi(gv[1]);
            u32x2 o; o[0] = pk_bf16(g0 * fmaf(bias, z0, acc[ctl][4 * q + 0]), g1 * fmaf(bias, z1, acc[ctl][4 * q + 1]));
            o[1] = pk_bf16(g2 * fmaf(bias, z2, acc[ctl][4 * q + 2]), g3 * fmaf(bias, z3, acc[ctl][4 * q + 3]));
            *zp = o;
        }
    }
}
__device__ __forceinline__ void hyena_unit(LAS unsigned char* lds, int unit, const u16* __restrict__ HYT, const u16* __restrict__ FR, const float* __restrict__ cw, const float* __restrict__ cbv,
                                           const float* __restrict__ hbias, u16* __restrict__ Z2T) {
    const int tid = tid_fresh(), wid = __builtin_amdgcn_readfirstlane(tid >> 6), lane = tid & 63;
    const int cs = wid & 3, hlf = wid >> 2, c = unit * 4 + cs, pl = lane + 64 * hlf;
    const int zb = cs * HY_ZBYTES, fb = HY_FB + cs * HY_FCH;
    { const u32x4 z = {0u, 0u, 0u, 0u}; for (int idx = pl; idx < HY_ZBYTES / 16; idx += 128) *(LAS u32x4*)(lds + zb + idx * 16) = z; }
    __syncthreads();
    hy_load_row(lds, zb, 256, HY_ZSTRIDE, HYT + (size_t)c * NTOK, cw[0 * 3072 + c], cw[1 * 3072 + c], cw[2 * 3072 + c], cbv[c], pl);
    f32x16 acc[4];
#pragma unroll
    for (int o = 0; o < 2; ++o) {
        hy_load_filters(lds, fb, FR + (size_t)((o * 1024 + c) * 2) * FR_LEN, pl);
        __syncthreads();
        hy_mfma_loop(lds, zb, fb, hlf, lane, acc);
        __syncthreads();
        const int gc = (1 + o) * 1024 + c;
        hy_load_row(lds, fb, 0, 2048, HYT + (size_t)gc * NTOK, cw[0 * 3072 + gc], cw[1 * 3072 + gc], cw[2 * 3072 + gc], cbv[gc], pl);
        __syncthreads();
        hy_epilogue(lds, zb, fb, hlf, lane, acc, hbias[o * HYW + c]);
        __syncthreads();
    }
#pragma unroll 2
    for (int it = 0; it < 8; ++it) { const int idx = pl + 128 * it, tok0 = idx * 8, b = tok0 >> 11, n0 = tok0 & 2047;
        *(u32x4*)(Z2T + (size_t)c * NTOK + tok0) = *(const LAS u32x4*)(lds + zb + (256 + b * HY_ZSTRIDE + n0) * 2); }
    __syncthreads();
}

constexpr int HG_RAWQ = 0, HG_RAWF = 16384, HG_RAWV = 32768;
constexpr int HG_QM = 36864, HG_KM = HG_QM + 17408, HG_QI = HG_KM + 17408;
constexpr int HG_KL = HG_QI + 17408;
constexpr int HG_VT = HG_KL + 18432;
constexpr int HG_P = HG_VT + 4608;
constexpr int HG_ST = HG_P + 9216;
constexpr int HG_TOT = HG_ST + 8704;
constexpr int HG_EL2 = HG_TOT + 2048;
constexpr int HG_LDS = HG_EL2 + 512;

__device__ __forceinline__ void hgrn_unit(LAS unsigned char* lds, int unit, const u16* __restrict__ PG, const float* __restrict__ lb_logits, float* __restrict__ OF, float* __restrict__ OB) {
    const int tid = tid_fresh(), wid = __builtin_amdgcn_readfirstlane(tid >> 6), lane = tid & 63, fr = lane & 15, fq = lane >> 4;
    const int vq = unit & 3, dir = (unit >> 2) & 1, h = (unit >> 3) & 7, b = unit >> 6;
    const int k = tid & 127, seg = tid >> 7;
    float* __restrict__ O = dir ? OB : OF;
    float lb;
    { const int c = h * 128 + k; const float l0 = lb_logits[(0 * 2 + dir) * HGW + c], l1 = lb_logits[(1 * 2 + dir) * HGW + c]; lb = 1.0f / (1.0f + __expf(l1 - l0)); }
    for (int i = tid; i < 8704 / 16; i += 512) *(LAS u32x4*)(lds + HG_ST + i * 16) = (u32x4){0u, 0u, 0u, 0u};
    f32x4 Sacc[2];
    Sacc[0] = (f32x4){0.f, 0.f, 0.f, 0.f}; Sacc[1] = Sacc[0];
    u32x4 pq[2], pf[2], pv;
    const int colq = h * 128, colf = (1 + dir) * 1024 + h * 128, colv = 3072 + h * 128 + vq * 32;
#define HG_TOK(c, tau) ((size_t)b * SEQ + (dir ? (SEQ - 1 - 64 * (c) - (tau)) : (64 * (c) + (tau))))
#define HG_PREFETCH(c) do { _Pragma("unroll") for (int _i = 0; _i < 2; ++_i) { const int _x = tid + 512 * _i, _tau = _x >> 4, _p = _x & 15; const u16* _r = PG + HG_TOK(c, _tau) * 5120; \
            pq[_i] = *(const u32x4*)(_r + colq + _p * 8); pf[_i] = *(const u32x4*)(_r + colf + _p * 8); } \
        if (tid < 256) { const int _tau = tid >> 2, _p = tid & 3; pv = *(const u32x4*)(PG + HG_TOK(c, _tau) * 5120 + colv + _p * 8); } } while (0)
    HG_PREFETCH(0);
    for (int c = 0; c < 32; ++c) {
#pragma unroll
        for (int i = 0; i < 2; ++i) { const int x = tid + 512 * i; *(LAS u32x4*)(lds + HG_RAWQ + x * 16) = pq[i]; *(LAS u32x4*)(lds + HG_RAWF + x * 16) = pf[i]; }
        if (tid < 256) *(LAS u32x4*)(lds + HG_RAWV + tid * 16) = pv;
        if (c + 1 < 32) HG_PREFETCH(c + 1);
        __syncthreads();
        float qv[16], kv[16], bl[16];
        { float run = 0.f;
#pragma unroll
          for (int i = 0; i < 16; ++i) { const int tau = seg * 16 + i;
              const float qr = bf2f(*(const LAS u16*)(lds + HG_RAWQ + tau * 256 + k * 2)), zf = bf2f(*(const LAS u16*)(lds + HG_RAWF + tau * 256 + k * 2));
              const float sg = 1.0f / (1.0f + __expf(-zf)); const float f = lb + (1.0f - lb) * sg;
              run += __logf(f); bl[i] = run; kv[i] = 1.0f - f; qv[i] = qr / (1.0f + __expf(-qr)); }
          *(LAS float*)(lds + HG_TOT + (seg * 128 + k) * 4) = run; }
        __syncthreads();
        { const float t0 = *(const LAS float*)(lds + HG_TOT + (0 * 128 + k) * 4), t1 = *(const LAS float*)(lds + HG_TOT + (1 * 128 + k) * 4),
                      t2 = *(const LAS float*)(lds + HG_TOT + (2 * 128 + k) * 4), t3 = *(const LAS float*)(lds + HG_TOT + (3 * 128 + k) * 4);
          const float pre = (seg > 0 ? t0 : 0.f) + (seg > 1 ? t1 : 0.f) + (seg > 2 ? t2 : 0.f);
          const float bref = t0 + t1, blast = bref + t2 + t3;
          const float er = __expf(bref), el = __expf(blast - bref);
          if (seg == 0) *(LAS float*)(lds + HG_EL2 + k * 4) = __expf(blast);
          unsigned klp[8];
#pragma unroll
          for (int i = 0; i < 16; i += 2) {
              float klv[2];
#pragma unroll
              for (int u = 0; u < 2; ++u) { const int tau = seg * 16 + i + u; const float bb = pre + bl[i + u];
                  const float e1 = __expf(bb - bref), e2 = __expf(bref - bb);
                  const float qm = qv[i + u] * e1, km = kv[i + u] * e2;
                  *(LAS u16*)(lds + HG_QM + tau * 272 + k * 2) = (u16)(pk_bf16(qm, 0.f) & 0xffffu);
                  *(LAS u16*)(lds + HG_KM + tau * 272 + k * 2) = (u16)(pk_bf16(km, 0.f) & 0xffffu);
                  *(LAS u16*)(lds + HG_QI + tau * 272 + k * 2) = (u16)(pk_bf16(qm * er, 0.f) & 0xffffu);
                  klv[u] = km * el; }
              klp[i >> 1] = pk_bf16(klv[0], klv[1]); }
          *(LAS u32x4*)(lds + HG_KL + k * 144 + seg * 32) = (u32x4){klp[0], klp[1], klp[2], klp[3]};
          *(LAS u32x4*)(lds + HG_KL + k * 144 + seg * 32 + 16) = (u32x4){klp[4], klp[5], klp[6], klp[7]};
          { const int v = tid & 31, tg = tid >> 5; unsigned short e[4];
#pragma unroll
            for (int u = 0; u < 4; ++u) e[u] = *(const LAS u16*)(lds + HG_RAWV + (tg * 4 + u) * 64 + v * 2);
            *(LAS u32x2*)(lds + HG_VT + v * 144 + tg * 8) = (u32x2){(unsigned)e[0] | ((unsigned)e[1] << 16), (unsigned)e[2] | ((unsigned)e[3] << 16)}; } }
        __syncthreads();
#pragma unroll
        for (int q = 0; q < 2; ++q) { const int idx = wid * 2 + q, ti = idx >> 2, si = idx & 3;
            f32x4 a = {0.f, 0.f, 0.f, 0.f};
            if (si <= ti) {
#pragma unroll
                for (int ks = 0; ks < 4; ++ks) { const bf16x8 ka = *(const LAS bf16x8*)(lds + HG_KM + (si * 16 + fr) * 272 + (ks * 32 + fq * 8) * 2), qb = *(const LAS bf16x8*)(lds + HG_QM + (ti * 16 + fr) * 272 + (ks * 32 + fq * 8) * 2);
                    a = __builtin_amdgcn_mfma_f32_16x16x32_bf16(ka, qb, a, 0, 0, 0); } }
            const int tau = ti * 16 + fr, s0 = si * 16 + fq * 4;
            float pvv[4];
#pragma unroll
            for (int j = 0; j < 4; ++j) pvv[j] = (si <= ti && s0 + j <= tau) ? a[j] : 0.f;
            *(LAS u32x2*)(lds + HG_P + tau * 144 + s0 * 2) = (u32x2){pk_bf16(pvv[0], pvv[1]), pk_bf16(pvv[2], pvv[3])}; }
        const int ti = wid >> 1, vi = wid & 1;
        f32x4 oacc = {0.f, 0.f, 0.f, 0.f};
#pragma unroll
        for (int ks = 0; ks < 4; ++ks) { const bf16x8 qa = *(const LAS bf16x8*)(lds + HG_QI + (ti * 16 + fr) * 272 + (ks * 32 + fq * 8) * 2), sb = *(const LAS bf16x8*)(lds + HG_ST + (vi * 16 + fr) * 272 + (ks * 32 + fq * 8) * 2);
            oacc = __builtin_amdgcn_mfma_f32_16x16x32_bf16(qa, sb, oacc, 0, 0, 0); }
        { const f32x4 e2 = *(const LAS f32x4*)(lds + HG_EL2 + (wid * 16 + fq * 4) * 4);
#pragma unroll
          for (int v2 = 0; v2 < 2; ++v2) { Sacc[v2] = Sacc[v2] * e2;
#pragma unroll
              for (int ks = 0; ks < 2; ++ks) { const bf16x8 ka = *(const LAS bf16x8*)(lds + HG_KL + (wid * 16 + fr) * 144 + (ks * 32 + fq * 8) * 2), vb = *(const LAS bf16x8*)(lds + HG_VT + (v2 * 16 + fr) * 144 + (ks * 32 + fq * 8) * 2);
                  Sacc[v2] = __builtin_amdgcn_mfma_f32_16x16x32_bf16(ka, vb, Sacc[v2], 0, 0, 0); } } }
        __syncthreads();
#pragma unroll
        for (int ks = 0; ks < 2; ++ks) { const bf16x8 pa = *(const LAS bf16x8*)(lds + HG_P + (ti * 16 + fr) * 144 + (ks * 32 + fq * 8) * 2), vb = *(const LAS bf16x8*)(lds + HG_VT + (vi * 16 + fr) * 144 + (ks * 32 + fq * 8) * 2);
            oacc = __builtin_amdgcn_mfma_f32_16x16x32_bf16(pa, vb, oacc, 0, 0, 0); }
#pragma unroll
        for (int j = 0; j < 4; ++j) { const int tau = ti * 16 + fq * 4 + j; O[HG_TOK(c, tau) * HGW + h * 128 + vq * 32 + vi * 16 + fr] = oacc[j]; }
#pragma unroll
        for (int v2 = 0; v2 < 2; ++v2) *(LAS u32x2*)(lds + HG_ST + (v2 * 16 + fr) * 272 + (wid * 16 + fq * 4) * 2) = (u32x2){pk_bf16(Sacc[v2][0], Sacc[v2][1]), pk_bf16(Sacc[v2][2], Sacc[v2][3])};
    }
    __syncthreads();
#undef HG_TOK
#undef HG_PREFETCH
}


#define XB_TMO      128
#define XB_XCNT(j)  (256  + 64 * (j))
#define XB_XSUB(j)  (1280 + 64 * (j))
#define XB_XGEN(j)  (2304 + 64 * (j))
#define XB_TOP      3328
#define XB_TOPGEN   3392
#define XCD_BAR_WORDS 3456
#define XB_SPIN_CAP (1u << 22)

__device__ __forceinline__ unsigned xb_ld(unsigned* p)              { return __hip_atomic_load(p, __ATOMIC_RELAXED, __HIP_MEMORY_SCOPE_AGENT); }
__device__ __forceinline__ unsigned xb_add(unsigned* p, unsigned v) { return __hip_atomic_fetch_add(p, v, __ATOMIC_RELAXED, __HIP_MEMORY_SCOPE_AGENT); }
__device__ __forceinline__ unsigned xb_xcc_id() { return (unsigned)__builtin_amdgcn_s_getreg((3 << 11) | 20) & 0xFu; }
#define XB_SPIN(cond, bar) do { unsigned _sp = 0; while (cond) { __builtin_amdgcn_s_sleep(1); \
    if ((++_sp & 255u) == 0u) { if (xb_ld(&(bar)[XB_TMO])) break; if (_sp > XB_SPIN_CAP) { atomicAdd(&(bar)[XB_TMO], 1u); break; } } } } while (0)

struct XcdBarrier {
    unsigned* bar; unsigned x;
    volatile LAS unsigned* st;
};

__device__ __forceinline__ XcdBarrier xcd_barrier_post(unsigned* bar, volatile LAS unsigned* st) {
    XcdBarrier b; b.bar = bar; b.x = xb_xcc_id(); b.st = st;
    if (threadIdx.x == 0) (void)xb_add(&bar[XB_XCNT(b.x)], 1u);
    return b;
}
__device__ __forceinline__ void xcd_barrier_complete(unsigned* bar, unsigned x, unsigned& nloc, unsigned& nx) {
    const unsigned G = gridDim.x * gridDim.y * gridDim.z;
    unsigned sum, cnt, mine, sp = 0u;
    for (;;) {
        sum = 0u; cnt = 0u; mine = 0u;
#pragma unroll
        for (unsigned j = 0; j < 16; ++j) { const unsigned c = xb_ld(&bar[XB_XCNT(j)]); sum += c; cnt += (c > 0u) ? 1u : 0u; mine = (j == x) ? c : mine; }
        if (sum == G) break;
        __builtin_amdgcn_s_sleep(1);
        if ((++sp & 255u) == 0u) { if (xb_ld(&bar[XB_TMO])) break; if (sp > XB_SPIN_CAP) { atomicAdd(&bar[XB_TMO], 1u); break; } }
    }
    nloc = mine > 0u ? mine : 1u; nx = cnt > 0u ? cnt : 1u;
}

__device__ __forceinline__ void xcd_barrier(const XcdBarrier& b) {
    asm volatile("s_waitcnt vmcnt(0)" ::: "memory");
    __syncthreads();
    if (threadIdx.x == 0) {
        unsigned* bar = b.bar;
        __builtin_amdgcn_s_waitcnt(0);
        unsigned nloc = b.st[0], nx = b.st[1];
        if (nloc == 0u) { xcd_barrier_complete(bar, b.x, nloc, nx); b.st[0] = nloc; b.st[1] = nx; }
        const unsigned old = xb_add(&bar[XB_XSUB(b.x)], 1u);
        const unsigned gen = old / nloc;
        if (old + 1u == (gen + 1u) * nloc) {
            __builtin_amdgcn_fence(__ATOMIC_RELEASE, "agent");
            asm volatile("s_waitcnt vmcnt(0)" ::: "memory");
            const unsigned og = xb_add(&bar[XB_TOP], 1u);
            const unsigned tg = og / nx;
            if (og + 1u == (tg + 1u) * nx) xb_add(&bar[XB_TOPGEN], 1u);
            else XB_SPIN(xb_ld(&bar[XB_TOPGEN]) == tg, bar);
            __builtin_amdgcn_fence(__ATOMIC_ACQUIRE, "agent");
            xb_add(&bar[XB_XGEN(b.x)], 1u);
            asm volatile("s_waitcnt vmcnt(0)" ::: "memory");
        } else {
            XB_SPIN(xb_ld(&bar[XB_XGEN(b.x)]) == gen, bar);
            __builtin_amdgcn_fence(__ATOMIC_ACQUIRE, "agent");
            asm volatile("s_waitcnt vmcnt(0)" ::: "memory");
        }
    }
    __syncthreads();
}

__device__ __forceinline__ float wave_sum(float s) {
#pragma unroll
    for (int o = 32; o >= 1; o >>= 1) s += __shfl_xor(s, o);
    return s;
}
__device__ __forceinline__ void rmsnorm_row_bf(const float* __restrict__ xr, const float* __restrict__ gain, u16* __restrict__ ob, int lane) {
    f32x4 v[8]; float s = 0.f;
#pragma unroll
    for (int j = 0; j < 8; ++j) { v[j] = *(const f32x4*)(xr + (lane + 64 * j) * 4); s += v[j][0] * v[j][0] + v[j][1] * v[j][1] + v[j][2] * v[j][2] + v[j][3] * v[j][3]; }
    s = wave_sum(s);
    const float r = rsqrtf(s * (1.0f / (float)DM) + EPS);
#pragma unroll
    for (int j = 0; j < 8; ++j) { const f32x4 g = *(const f32x4*)(gain + (lane + 64 * j) * 4); const f32x4 o = v[j] * r * g;
        *(u32x2*)(ob + (lane + 64 * j) * 4) = (u32x2){pk_bf16(o[0], o[1]), pk_bf16(o[2], o[3])}; }
}
__device__ __forceinline__ void hgrn_final_item(int item, const float* __restrict__ OF, const float* __restrict__ OB, const u16* __restrict__ PG, const float* __restrict__ gain, u16* __restrict__ MIXB, int lane) {
    const int tok = item >> 3, h = item & 7, c = h * 128 + 2 * lane;
    const f32x2 a = *(const f32x2*)(OF + (size_t)tok * HGW + c), b = *(const f32x2*)(OB + (size_t)tok * HGW + c);
    const float o0 = a[0] + b[0], o1 = a[1] + b[1];
    const float s = wave_sum(o0 * o0 + o1 * o1);
    const float r = rsqrtf(s * (1.0f / 128.0f) + EPS);
    const unsigned gw = *(const unsigned*)(PG + (size_t)tok * 5120 + 4096 + c);
    const float g0 = bflo(gw), g1 = bfhi(gw);
    const f32x2 gn = *(const f32x2*)(gain + c);
    const float v0 = o0 * r * gn[0] * (g0 / (1.0f + __expf(-g0))), v1 = o1 * r * gn[1] * (g1 / (1.0f + __expf(-g1)));
    *(unsigned*)(MIXB + (size_t)tok * DM + c) = pk_bf16(v0, v1);
}
__device__ __forceinline__ void hy_norm_tile(LAS unsigned char* lds, int tile_i, const u16* __restrict__ Z2T, const float* __restrict__ gain, u16* __restrict__ MIXB) {
    const int t = tid_fresh(), tok0 = tile_i * 32;
    LAS float* ssq = (LAS float*)(lds + 1024 * 80);
    if (t < 32) ssq[t] = 0.f;
    __syncthreads();
    float part[8];
#pragma unroll
    for (int q = 0; q < 8; ++q) part[q] = 0.f;
    const int ch = t & 3;
#pragma unroll
    for (int it = 0; it < 8; ++it) {
        const int c = (t >> 2) + 128 * it;
        const u32x4 v = *(const u32x4*)(Z2T + (size_t)c * NTOK + tok0 + ch * 8);
        *(LAS u32x4*)(lds + c * 80 + ch * 16) = v;
#pragma unroll
        for (int q = 0; q < 4; ++q) { const float a = bflo(v[q]), b = bfhi(v[q]); part[2 * q] += a * a; part[2 * q + 1] += b * b; }
    }
#pragma unroll
    for (int q = 0; q < 8; ++q) { float s = part[q]; s += __shfl_xor(s, 4); s += __shfl_xor(s, 8); s += __shfl_xor(s, 16); s += __shfl_xor(s, 32); part[q] = s; }
    if ((t & 63) < 4) {
#pragma unroll
        for (int q = 0; q < 8; ++q) atomicAdd((float*)(ssq + ch * 8 + q), part[q]);
    }
    __syncthreads();
    const int tt = t >> 4;
    const float r = rsqrtf(ssq[tt] * (1.0f / (float)HYW) + EPS);
#pragma unroll 2
    for (int k = 0; k < 8; ++k) {
        const int c0 = ((t & 15) + 16 * k) * 8;
        float o[8];
#pragma unroll
        for (int q = 0; q < 8; ++q) o[q] = bf2f(*(const LAS u16*)(lds + (c0 + q) * 80 + tt * 2)) * r * gain[c0 + q];
        *(u32x4*)(MIXB + (size_t)(tok0 + tt) * DM + 1024 + c0) = (u32x4){pk_bf16(o[0], o[1]), pk_bf16(o[2], o[3]), pk_bf16(o[4], o[5]), pk_bf16(o[6], o[7])};
    }
    __syncthreads();
}
constexpr int RT_XSTRIDE = 2049;
constexpr int RT_PART = 16 * RT_XSTRIDE * 4;
constexpr int RT_LG = RT_PART + 8 * 16 * 32 * 4;
constexpr int RT_END = RT_LG + 16 * 32 * 4;
__device__ __forceinline__ void router_tile(LAS unsigned char* lds, int tile_i, const float* __restrict__ X1, const float* __restrict__ gain, const float* __restrict__ wr, const float* __restrict__ br,
                                            u16* __restrict__ XNB, int* __restrict__ TOPI, float* __restrict__ TOPG, int* __restrict__ counts) {
    const int tid = tid_fresh(), wid = __builtin_amdgcn_readfirstlane(tid >> 6), lane = tid & 63;
    const int tok0 = tile_i * 16;
    LAS float* xs = (LAS float*)lds;
#pragma unroll
    for (int q = 0; q < 2; ++q) {
        const int tl = wid * 2 + q; const size_t tok = (size_t)tok0 + tl;
        const float* xr = X1 + tok * DM;
        f32x4 v[8]; float s = 0.f;
#pragma unroll
        for (int j = 0; j < 8; ++j) { v[j] = *(const f32x4*)(xr + (lane + 64 * j) * 4); s += v[j][0] * v[j][0] + v[j][1] * v[j][1] + v[j][2] * v[j][2] + v[j][3] * v[j][3]; }
        s = wave_sum(s);
        const float r = rsqrtf(s * (1.0f / (float)DM) + EPS);
#pragma unroll
        for (int j = 0; j < 8; ++j) { const int d = (lane + 64 * j) * 4; const f32x4 g = *(const f32x4*)(gain + d); const f32x4 o = v[j] * r * g;
            xs[tl * RT_XSTRIDE + d + 0] = o[0]; xs[tl * RT_XSTRIDE + d + 1] = o[1]; xs[tl * RT_XSTRIDE + d + 2] = o[2]; xs[tl * RT_XSTRIDE + d + 3] = o[3];
            *(u32x2*)(XNB + tok * DM + d) = (u32x2){pk_bf16(o[0], o[1]), pk_bf16(o[2], o[3])}; }
    }
    __syncthreads();
    {
        const int tl = lane & 15, kk = lane >> 4;
        f32x4 a0 = {0.f, 0.f, 0.f, 0.f}, a1 = a0;
        const LAS float* xp = xs + tl * RT_XSTRIDE + wid * 256 + kk;
        const float* wp = wr + (size_t)(wid * 256 + kk) * NE + tl;
#pragma unroll 8
        for (int ks = 0; ks < 64; ++ks) { const float a = xp[ks * 4]; const float b0 = wp[(size_t)ks * 4 * NE], b1 = wp[(size_t)ks * 4 * NE + 16];
            a0 = __builtin_amdgcn_mfma_f32_16x16x4f32(a, b0, a0, 0, 0, 0); a1 = __builtin_amdgcn_mfma_f32_16x16x4f32(a, b1, a1, 0, 0, 0); }
        LAS float* pp = (LAS float*)(lds + RT_PART) + wid * 512;
#pragma unroll
        for (int j = 0; j < 4; ++j) { pp[(kk * 4 + j) * 32 + tl] = a0[j]; pp[(kk * 4 + j) * 32 + 16 + tl] = a1[j]; }
    }
    __syncthreads();
    {   const LAS float* pp = (const LAS float*)(lds + RT_PART); float s = br[tid & 31];
#pragma unroll
        for (int w = 0; w < 8; ++w) s += pp[w * 512 + tid];
        ((LAS float*)(lds + RT_LG))[tid] = s; }
    __syncthreads();
    if (tid < 16) {
        LAS float* lg = (LAS float*)(lds + RT_LG) + tid * 32;
        int i0 = 0, i1 = 0, i2 = 0, i3 = 0; float v0, v1, v2, v3;
        { float bv = -3.0e38f; for (int j = 0; j < NE; ++j) { const float l = lg[j]; if (l > bv) { bv = l; i0 = j; } } v0 = bv; lg[i0] = -3.4e38f; }
        { float bv = -3.0e38f; for (int j = 0; j < NE; ++j) { const float l = lg[j]; if (l > bv) { bv = l; i1 = j; } } v1 = bv; lg[i1] = -3.4e38f; }
        { float bv = -3.0e38f; for (int j = 0; j < NE; ++j) { const float l = lg[j]; if (l > bv) { bv = l; i2 = j; } } v2 = bv; lg[i2] = -3.4e38f; }
        { float bv = -3.0e38f; for (int j = 0; j < NE; ++j) { const float l = lg[j]; if (l > bv) { bv = l; i3 = j; } } v3 = bv; lg[i3] = -3.4e38f; }
        const float e1 = __expf(v1 - v0), e2 = __expf(v2 - v0), e3 = __expf(v3 - v0), inv = 1.0f / (1.0f + e1 + e2 + e3);
        const int tok = tok0 + tid;
        *(int4*)(TOPI + tok * 4) = make_int4(i0, i1, i2, i3);
        *(f32x4*)(TOPG + tok * 4) = (f32x4){inv, e1 * inv, e2 * inv, e3 * inv};
        atomicAdd(&counts[i0], 1); atomicAdd(&counts[i1], 1); atomicAdd(&counts[i2], 1); atomicAdd(&counts[i3], 1);
    }
    __syncthreads();
}
__device__ __forceinline__ void combine_row(int tok, const float* __restrict__ X1, const u16* __restrict__ YB, const int* __restrict__ SOF, const float* __restrict__ TOPG, const float* __restrict__ gain, float* __restrict__ out, int lane) {
    const int4 sl = *(const int4*)(SOF + tok * 4); const f32x4 g = *(const f32x4*)(TOPG + tok * 4);
    const u16* y0 = YB + (size_t)sl.x * DM; const u16* y1 = YB + (size_t)sl.y * DM; const u16* y2 = YB + (size_t)sl.z * DM; const u16* y3 = YB + (size_t)sl.w * DM;
    f32x4 v[8]; float s = 0.f;
#pragma unroll
    for (int j = 0; j < 8; ++j) { const int d = (lane + 64 * j) * 4;
        f32x4 a = *(const f32x4*)(X1 + (size_t)tok * DM + d);
        const u32x2 q0 = *(const u32x2*)(y0 + d), q1 = *(const u32x2*)(y1 + d), q2 = *(const u32x2*)(y2 + d), q3 = *(const u32x2*)(y3 + d);
        a[0] += g[0] * bflo(q0[0]) + g[1] * bflo(q1[0]) + g[2] * bflo(q2[0]) + g[3] * bflo(q3[0]);
        a[1] += g[0] * bfhi(q0[0]) + g[1] * bfhi(q1[0]) + g[2] * bfhi(q2[0]) + g[3] * bfhi(q3[0]);
        a[2] += g[0] * bflo(q0[1]) + g[1] * bflo(q1[1]) + g[2] * bflo(q2[1]) + g[3] * bflo(q3[1]);
        a[3] += g[0] * bfhi(q0[1]) + g[1] * bfhi(q1[1]) + g[2] * bfhi(q2[1]) + g[3] * bfhi(q3[1]);
        v[j] = a; s += a[0] * a[0] + a[1] * a[1] + a[2] * a[2] + a[3] * a[3]; }
    s = wave_sum(s);
    const float r = rsqrtf(s * (1.0f / (float)DM) + EPS);
#pragma unroll
    for (int j = 0; j < 8; ++j) { const int d = (lane + 64 * j) * 4; const f32x4 gn = *(const f32x4*)(gain + d); *(f32x4*)(out + (size_t)tok * DM + d) = v[j] * r * gn; }
}

struct MegaP {
    const float *x, *norm_mix_gain, *w_in, *lb_logits, *hgrn_norm_gain, *hy_conv_w, *hy_conv_b, *fw1, *fb1, *fw2, *fb2, *fw3, *fb3, *fw4, *ffreq, *hy_bias, *hy_norm_gain, *w_out,
        *norm_ffn_gain, *w_router, *b_router, *moe_w1, *moe_b1, *moe_w2, *moe_b2, *final_gain;
    float* out; unsigned char* ws;
};
constexpr int MEGA_XB = RT_END;
constexpr int MEGA_LDS = RT_END + 64;
static_assert(MEGA_LDS >= HY_LDS + 64 && MEGA_LDS >= HG_LDS + 64 && MEGA_LDS >= GEMM_LDS + 64, "LDS");

__global__ void __launch_bounds__(512, 2) k_mega(const MegaP p) {
    extern __shared__ __attribute__((aligned(16))) unsigned char shm[];
    LAS unsigned char* lds = (LAS unsigned char*)shm;
    const int tid = threadIdx.x, wid = __builtin_amdgcn_readfirstlane(tid >> 6), lane = tid & 63;
    const int G = gridDim.x, bid = blockIdx.x, c = xcd_logical(bid, G);
    unsigned char* ws = p.ws;
#define counts ((int*)(ws + WS_CTL))
#define cursor ((int*)(ws + WS_CTL + 256))
#define offs ((int*)(ws + WS_CTL + 512))
#define barw ((unsigned*)(ws + WS_CTL + 16384))
#define HB ((u16*)(ws + WS_HB))
#define PG ((u16*)(ws + WS_PG))
#define HYT ((u16*)(ws + WS_HYT))
#define MIXB ((u16*)(ws + WS_MIXB))
#define XNB ((u16*)(ws + WS_XNB))
#define HMB ((u16*)(ws + WS_HMB))
#define YB ((u16*)(ws + WS_YB))
#define H3 ((float*)(ws + WS_H3))
#define FR ((u16*)(ws + WS_FR))
#define Z2T ((u16*)(ws + WS_Z2T))
#define OF ((float*)(ws + WS_OF))
#define OB ((float*)(ws + WS_OB))
#define X1 ((float*)(ws + WS_X1))
#define TOPI ((int*)(ws + WS_TOPI))
#define TOPG ((float*)(ws + WS_TOPG))
#define STOK ((int*)(ws + WS_STOK))
#define SOF ((int*)(ws + WS_SOF))
    if (tid == 0) *(LAS u32x4*)(lds + MEGA_XB) = (u32x4){0u, 0u, 0u, 0u};
    __syncthreads();
    XcdBarrier bar = xcd_barrier_post(barw, (volatile LAS unsigned*)(lds + MEGA_XB));

    for (int row = bid * 8 + wid; row < NTOK; row += G * 8) rmsnorm_row_bf(p.x + (size_t)row * DM, p.norm_mix_gain, HB + (size_t)row * DM, lane);
    for (int m = bid * 8 + wid; m < SEQ; m += G * 8) h3_row(m, p.fw1, p.fb1, p.fw2, p.fb2, p.fw3, p.fb3, p.ffreq, (LAS float*)(lds + wid * 512), H3);
    xcd_barrier(bar);
    for (int item = bid; item < 256; item += G) frgen_item(item, H3, p.fw4, FR, (LAS float*)lds);
    for (int u = c; u < 1024; u += G) {
        const int i = u >> 8, xx = (u >> 5) & 7, j = u & 31;
        const int mt = (xx & 3) * 8 + (j & 7), nt = ((xx >> 2) + 2 * i) * 4 + (j >> 3);
        ColMapDense cm{nt * 256};
        if (nt < 20) { EpiPG e{PG, mt * 256, nt * 256}; gemm_unit<false, false>(lds, HB, DM, nullptr, mt * 256, 256, p.w_in, DIN, DM, cm, e); }
        else { EpiHYT e{HYT, mt * 256, nt * 256 - 5120}; gemm_unit<true, false>(lds, HB, DM, nullptr, mt * 256, 256, p.w_in, DIN, DM, cm, e); }
    }
    xcd_barrier(bar);
    for (int u = bid; u < 256; u += G) hyena_unit(lds, u, HYT, FR, p.hy_conv_w, p.hy_conv_b, p.hy_bias, Z2T);
    for (int u = bid; u < 256; u += G) hgrn_unit(lds, u, PG, p.lb_logits, OF, OB);
    xcd_barrier(bar);
    for (int it = bid * 8 + wid; it < NTOK * HGH; it += G * 8) hgrn_final_item(it, OF, OB, PG, p.hgrn_norm_gain, MIXB, lane);
    for (int t = bid; t < NTOK / 32; t += G) hy_norm_tile(lds, t, Z2T, p.hy_norm_gain, MIXB);
    xcd_barrier(bar);
    for (int u = c; u < 256; u += G) {
        const int xx = u >> 5, j = u & 31;
        const int mt = (xx >> 1) * 8 + (j & 7), nt = (xx & 1) * 4 + (j >> 3);
        ColMapDense cm{nt * 256}; EpiX1 e{p.x, X1, mt * 256, nt * 256};
        gemm_unit<false, false>(lds, MIXB, DM, nullptr, mt * 256, 256, p.w_out, DM, DM, cm, e);
    }
    xcd_barrier(bar);
    for (int t = bid; t < NTOK / 16; t += G) router_tile(lds, t, X1, p.norm_ffn_gain, p.w_router, p.b_router, XNB, TOPI, TOPG, counts);
    xcd_barrier(bar);
    {
        LAS int* so = (LAS int*)lds;
        if (tid == 0) { int a = 0; for (int e = 0; e < NE; ++e) { so[e] = a; a += __hip_atomic_load(&counts[e], __ATOMIC_RELAXED, __HIP_MEMORY_SCOPE_AGENT); } so[NE] = a; }
        __syncthreads();
        if (bid == 0 && tid <= NE) offs[tid] = so[tid];
        for (int i = bid * 512 + tid; i < NSLOT; i += G * 512) { const int e = TOPI[i]; const int pos = atomicAdd(&cursor[e], 1); const int slot = so[e] + pos; STOK[slot] = i >> 2; SOF[i] = slot; }
    }
    xcd_barrier(bar);
    for (int u = c;; u += G) {
        int e, mt, nt, slot0, rows;
        if (!moe_decode<16>(offs, u, e, mt, nt, slot0, rows)) break;
        ColMapGlu cm{nt}; EpiSwiglu ep{HMB, p.moe_b1 + (size_t)e * 2 * DFF, slot0, nt, rows};
        gemm_unit<false, true>(lds, XNB, DM, STOK + slot0, 0, rows, p.moe_w1 + (size_t)e * DM * 2 * DFF, 2 * DFF, DM, cm, ep);
    }
    xcd_barrier(bar);
    for (int u = c;; u += G) {
        int e, mt, nt, slot0, rows;
        if (!moe_decode<8>(offs, u, e, mt, nt, slot0, rows)) break;
        ColMapDense cm{nt * 256}; EpiY ep{YB, p.moe_b2 + (size_t)e * DM, slot0, nt * 256, rows};
        gemm_unit<false, true>(lds, HMB, DFF, nullptr, slot0, rows, p.moe_w2 + (size_t)e * DFF * DM, DM, DFF, cm, ep);
    }
    xcd_barrier(bar);
    for (int tok = bid * 8 + wid; tok < NTOK; tok += G * 8) combine_row(tok, X1, YB, SOF, TOPG, p.final_gain, p.out, lane);
}
#undef counts
#undef cursor
#undef offs
#undef barw
#undef HB
#undef PG
#undef HYT
#undef MIXB
#undef XNB
#undef HMB
#undef YB
#undef H3
#undef FR
#undef Z2T
#undef OF
#undef OB
#undef X1
#undef TOPI
#undef TOPG
#undef STOK
#undef SOF

extern "C" void kernel_launch(void* const* d_in, const int* in_sizes, int n_in, void* d_out, int out_size, void* d_ws, size_t ws_size, hipStream_t stream) {
    if (n_in < 26 || ws_size < WS_END2) return;
    MegaP p{};
    const float** pp = (const float**)&p;
    for (int i = 0; i < 26; ++i) pp[i] = (const float*)d_in[i];
    p.out = (float*)d_out; p.ws = (unsigned char*)d_ws;
    static int grid = 0;
    if (!grid) {
        int dev = 0, cus = 0, per_cu = 0;
        (void)hipGetDevice(&dev);
        (void)hipDeviceGetAttribute(&cus, hipDeviceAttributeMultiprocessorCount, dev);
        (void)hipFuncSetAttribute((const void*)k_mega, hipFuncAttributeMaxDynamicSharedMemorySize, MEGA_LDS);
        (void)hipOccupancyMaxActiveBlocksPerMultiprocessor(&per_cu, (const void*)k_mega, 512, MEGA_LDS);
        if (per_cu < 1) per_cu = 1;
        grid = cus * 1;
        if (grid > 256) grid = 256;
        grid &= ~7;
        if (grid < 8) grid = 8;
    }
    (void)hipMemsetAsync((char*)d_ws + WS_CTL, 0, 65536, stream);
    hipLaunchKernelGGL(k_mega, dim3(grid), dim3(512), MEGA_LDS, stream, p);
}
```

```cpp
#include <hip/hip_runtime.h>
#include <stdint.h>

constexpr int BATCH = 4, SEQ = 2048, DM = 2048, NTOK = BATCH * SEQ;
constexpr int HGW = 1024, HGD = 128, HGH = 8;
constexpr int HYW = 1024;
constexpr int DIN = 8192;
constexpr int NE = 32, TOPK = 4, DFF = 2048;
constexpr int NSLOT = NTOK * TOPK;
constexpr float EPS = 1e-5f;

constexpr size_t MB = 1024ull * 1024ull;
constexpr size_t WS_CTL = 0;
constexpr size_t WS_HB = 1 * MB;
constexpr size_t WS_PG = WS_HB + 32 * MB;
constexpr size_t WS_HYT = WS_PG + 80 * MB;
constexpr size_t WS_MIXB = WS_HYT + 48 * MB;
constexpr size_t WS_XNB = WS_MIXB + 32 * MB;
constexpr size_t WS_HMB = WS_XNB + 32 * MB;
constexpr size_t WS_YB = WS_HMB + 128 * MB;
constexpr size_t WS_H3 = WS_YB + 128 * MB;
constexpr size_t WS_FR = WS_H3 + 1 * MB;
constexpr size_t WS_Z2T = WS_FR + 34 * MB;
constexpr size_t WS_OF = WS_Z2T + 16 * MB;
constexpr size_t WS_OB = WS_OF + 32 * MB;
constexpr size_t WS_X1 = WS_OB + 32 * MB;
constexpr size_t WS_TOPI = WS_X1 + 64 * MB;
constexpr size_t WS_TOPG = WS_TOPI + 1 * MB;
constexpr size_t WS_STOK = WS_TOPG + 1 * MB;
constexpr size_t WS_SOF = WS_STOK + 1 * MB;
constexpr size_t WS_WINT = WS_SOF + 1 * MB;
constexpr size_t WS_WOUTT = WS_WINT + 32 * MB;
constexpr size_t WS_W1T = WS_WOUTT + 8 * MB;
constexpr size_t WS_W2T = WS_W1T + 512 * MB;
constexpr size_t WS_END2 = WS_W2T + 256 * MB;

typedef short bf16x8 __attribute__((ext_vector_type(8)));
typedef float f32x4 __attribute__((ext_vector_type(4)));
typedef float f32x2 __attribute__((ext_vector_type(2)));
typedef unsigned u32x4 __attribute__((ext_vector_type(4)));
typedef unsigned u32x2 __attribute__((ext_vector_type(2)));
typedef unsigned short u16;
#define LAS __attribute__((address_space(3)))

__device__ __forceinline__ unsigned pk_bf16(float lo, float hi) {
    typedef __bf16 bf2 __attribute__((ext_vector_type(2)));
    const f32x2 v = {lo, hi};
    const bf2 r = __builtin_convertvector(v, bf2);
    return __builtin_bit_cast(unsigned, r);
}
__device__ __forceinline__ float bf2f(u16 b) { return __uint_as_float(((unsigned)b) << 16); }
__device__ __forceinline__ float bflo(unsigned w) { return __uint_as_float(w << 16); }
__device__ __forceinline__ float bfhi(unsigned w) { return __uint_as_float(w & 0xffff0000u); }

__device__ __forceinline__ int lds_byte(int r, int c) { const int st = (r >> 4) * 2 + (c >> 5), ob = (r & 15) * 64 + (c & 31) * 2; return st * 1024 + (ob ^ (((ob >> 9) & 1) << 5)); }
__device__ __forceinline__ void stage_rc(int b, int& R, int& C) { const int st = b >> 10, sb = b & 1023, swz = sb ^ (((sb >> 9) & 1) << 5); R = (st >> 1) * 16 + swz / 64; C = (st & 1) * 32 + (swz % 64) / 2; }
__device__ __forceinline__ f32x4 unperm(const f32x4 a, const bool s) { f32x4 o; o[0] = s ? a[1] : a[0]; o[1] = s ? a[0] : a[1]; o[2] = s ? a[3] : a[2]; o[3] = s ? a[2] : a[3]; return o; }

__device__ __forceinline__ int tid_fresh() { int t = threadIdx.x; asm volatile("" : "+v"(t)); return t; }
constexpr int GEMM_LDS = 131072;

template <bool TRANS, bool RAGGED, int PM = 0, class ColMap, class Epi>
__device__ __forceinline__ void gemm_unit(LAS unsigned char* lds, const u16* __restrict__ A, int lda, const int* __restrict__ arows, int arow0, int rows_valid,
                                          const float* __restrict__ B, int ldb, int K, const ColMap colmap, const Epi epi) {
    const int tid = tid_fresh(), wid = __builtin_amdgcn_readfirstlane(tid >> 6), lane = tid & 63;
    const int wr = wid >> 2, wc = wid & 3, fr = lane & 15, fq = lane >> 4;
    const int nt = K >> 6;
    const char* ap[4];
#pragma unroll
    for (int i = 0; i < 4; ++i) {
        int R, C; stage_rc(wid * 1024 + i * 8192 + lane * 16, R, C);
        const int rr = RAGGED ? (R < rows_valid ? R : rows_valid - 1) : R;
        const long rowid = arows ? (long)arows[rr] : (long)(arow0 + rr);
        ap[i] = (const char*)A + ((size_t)rowid * lda + C) * 2;
    }
    const int g = (lane & 3) + 4 * (wid >> 2), rg = (wid & 3) * 16 + (lane >> 2);
    const unsigned bvoff = (unsigned)(((size_t)(8 * g) * ldb + colmap(rg)) * 4);
    const int bbase = 65536 + lds_byte(4 * rg, 8 * g);
    const int bw0 = bbase + ((rg & 1) ? 64 : 0), bw1 = bbase + ((rg & 1) ? 0 : 64);
    const int aoff = lds_byte(wr * 128 + fr, fq * 8), boff = 65536 + lds_byte(wc * 64 + fr, fq * 8);
    int mvalid = 8;
    if (RAGGED) { mvalid = (rows_valid - wr * 128 + 15) >> 4; mvalid = mvalid < 0 ? 0 : (mvalid > 8 ? 8 : mvalid); }
    f32x4 vb0, vb1, vb2, vb3, vb4, vb5, vb6, vb7;
    if (PM & 1) { vb0 = (f32x4){1.f, 1.f, 1.f, 1.f}; vb1 = vb0; vb2 = vb0; vb3 = vb0; vb4 = vb0; vb5 = vb0; vb6 = vb0; vb7 = vb0; }
    f32x4 acc[8][4];
#pragma unroll
    for (int m = 0; m < 8; ++m)
#pragma unroll
        for (int n = 0; n < 4; ++n) acc[m][n] = (f32x4){0.f, 0.f, 0.f, 0.f};
    const size_t ldb4 = (size_t)ldb * 4;
#define GE_GLDS_A(buf, kt) do { if (!(PM & 2)) _Pragma("unroll") for (int _i = 0; _i < 4; ++_i) \
        __builtin_amdgcn_global_load_lds((const unsigned*)(ap[_i] + (size_t)(kt) * 128), (LAS unsigned*)(lds + (buf) * 32768 + wid * 1024 + _i * 8192), 16, 0, 0); } while (0)
#define GE_LD1(dst, sb) if (!(PM & 1)) asm volatile("global_load_dwordx4 %0, %1, %2" : "=v"(dst) : "v"(bvoff), "s"(sb) : "memory")
#define GE_LOAD_B(kt) do { const char* _sb = (const char*)B + (size_t)(kt) * 64 * ldb4; \
        GE_LD1(vb0, _sb); GE_LD1(vb1, _sb + ldb4); GE_LD1(vb2, _sb + 2 * ldb4); GE_LD1(vb3, _sb + 3 * ldb4); \
        GE_LD1(vb4, _sb + 4 * ldb4); GE_LD1(vb5, _sb + 5 * ldb4); GE_LD1(vb6, _sb + 6 * ldb4); GE_LD1(vb7, _sb + 7 * ldb4); } while (0)
#define GE_WAITV_B(n) asm volatile("s_waitcnt vmcnt(" #n ")" : "+v"(vb0), "+v"(vb1), "+v"(vb2), "+v"(vb3), "+v"(vb4), "+v"(vb5), "+v"(vb6), "+v"(vb7) :: "memory")
#define GE_WRITE_B(buf) do { _Pragma("unroll") for (int _i = 0; _i < 4; ++_i) { u32x4 _w; _w[0] = pk_bf16(vb0[_i], vb1[_i]); _w[1] = pk_bf16(vb2[_i], vb3[_i]); \
        _w[2] = pk_bf16(vb4[_i], vb5[_i]); _w[3] = pk_bf16(vb6[_i], vb7[_i]); \
        *(LAS u32x4*)(lds + ((_i & 1) ? bw1 : bw0) + (_i >> 1) * 128 + (buf) * 32768) = _w; } } while (0)
#define GE_KSTEP(buf, ks) do { bf16x8 Bf[4]; \
        _Pragma("unroll") for (int n = 0; n < 4; ++n) Bf[n] = *(const LAS bf16x8*)(lds + (buf) * 32768 + boff + n * 2048 + (ks) * 1024); \
        _Pragma("unroll") for (int mh = 0; mh < 2; ++mh) { bf16x8 At[4]; \
            _Pragma("unroll") for (int m = 0; m < 4; ++m) At[m] = *(const LAS bf16x8*)(lds + (buf) * 32768 + aoff + (mh * 4 + m) * 2048 + (ks) * 1024); \
            _Pragma("unroll") for (int m = 0; m < 4; ++m) { if (!RAGGED || (mh * 4 + m) < mvalid) { _Pragma("unroll") for (int n = 0; n < 4; ++n) \
                { if (PM & 4) { asm volatile("" :: "v"(At[m]), "v"(Bf[n])); } else acc[mh * 4 + m][n] = TRANS ? __builtin_amdgcn_mfma_f32_16x16x32_bf16(At[m], Bf[n], acc[mh * 4 + m][n], 0, 0, 0) : __builtin_amdgcn_mfma_f32_16x16x32_bf16(Bf[n], At[m], acc[mh * 4 + m][n], 0, 0, 0); } } } } } while (0)
    GE_GLDS_A(0, 0);
    GE_LOAD_B(0);
    GE_WAITV_B(0);
    GE_WRITE_B(0);
    GE_LOAD_B(1);
    asm volatile("s_waitcnt lgkmcnt(0)" ::: "memory");
    __builtin_amdgcn_s_barrier();
    int t = 0;
    for (; t < nt - 2; ++t) {
        const int cur = t & 1;
        GE_GLDS_A(cur ^ 1, t + 1);
        GE_KSTEP(cur, 0);
        GE_WAITV_B(4);
        GE_WRITE_B(cur ^ 1);
        GE_LOAD_B(t + 2);
        __builtin_amdgcn_sched_barrier(0);
        GE_KSTEP(cur, 1);
        asm volatile("s_waitcnt vmcnt(8) lgkmcnt(0)" ::: "memory");
        __builtin_amdgcn_s_barrier();
    }
    {
        const int cur = t & 1;
        GE_GLDS_A(cur ^ 1, t + 1);
        GE_KSTEP(cur, 0);
        GE_WAITV_B(4);
        GE_WRITE_B(cur ^ 1);
        GE_KSTEP(cur, 1);
        asm volatile("s_waitcnt vmcnt(0) lgkmcnt(0)" ::: "memory");
        __builtin_amdgcn_s_barrier();
        ++t;
    }
    {
        const int cur = t & 1;
        GE_KSTEP(cur, 0);
        GE_KSTEP(cur, 1);
        asm volatile("s_waitcnt lgkmcnt(0)" ::: "memory");
        __builtin_amdgcn_s_barrier();
    }
#undef GE_GLDS_A
#undef GE_LD1
#undef GE_LOAD_B
#undef GE_WAITV_B
#undef GE_WRITE_B
#undef GE_KSTEP
    __builtin_amdgcn_sched_barrier(0);
    { const int tz = tid_fresh(), wz = __builtin_amdgcn_readfirstlane(tz >> 6), lz = tz & 63;
      epi(acc, wz >> 2, wz & 3, lz & 15, lz >> 4); }
}

__device__ __forceinline__ int xcd_logical(int b, int G) { return (G & 7) ? b : (b & 7) * (G >> 3) + (b >> 3); }

struct ColMapDense { int c0; __device__ __forceinline__ int operator()(int rg) const { return c0 + 4 * rg; } };
struct EpiPG { u16* PG; int tok0, col0;
    __device__ __forceinline__ void operator()(const f32x4 (&acc)[8][4], int wr, int wc, int fr, int fq) const {
#pragma unroll
        for (int m = 0; m < 8; ++m) { u16* rowp = PG + (size_t)(tok0 + wr * 128 + m * 16 + fr) * 5120 + col0 + wc * 64 + 4 * fq;
#pragma unroll
            for (int n = 0; n < 4; ++n) { const f32x4 v = unperm(acc[m][n], fq & 1); u32x2 w; w[0] = pk_bf16(v[0], v[1]); w[1] = pk_bf16(v[2], v[3]); *(u32x2*)(rowp + n * 16) = w; } }
    } };
struct EpiHYT { u16* HYT; int tok0, col0;
    __device__ __forceinline__ void operator()(const f32x4 (&acc)[8][4], int wr, int wc, int fr, int fq) const {
#pragma unroll
        for (int n = 0; n < 4; ++n) { const int rho = wc * 64 + n * 16 + fr; const int col = col0 + (rho & ~3) + ((rho & 3) ^ ((rho >> 2) & 1));
            u16* colp = HYT + (size_t)col * NTOK + tok0 + wr * 128 + 4 * fq;
#pragma unroll
            for (int m = 0; m < 8; ++m) { const f32x4 v = acc[m][n]; u32x2 w; w[0] = pk_bf16(v[0], v[1]); w[1] = pk_bf16(v[2], v[3]); *(u32x2*)(colp + m * 16) = w; } }
    } };
struct EpiX1 { const float* x; float* X1; int tok0, col0;
    __device__ __forceinline__ void operator()(const f32x4 (&acc)[8][4], int wr, int wc, int fr, int fq) const {
#pragma unroll
        for (int m = 0; m < 8; ++m) { const size_t off = (size_t)(tok0 + wr * 128 + m * 16 + fr) * DM + col0 + wc * 64 + 4 * fq;
#pragma unroll
            for (int n = 0; n < 4; ++n) { const f32x4 r = *(const f32x4*)(x + off + n * 16); *(f32x4*)(X1 + off + n * 16) = r + unperm(acc[m][n], fq & 1); }
            asm volatile("" ::: "memory"); }
    } };
struct ColMapGlu { int nt; __device__ __forceinline__ int operator()(int rg) const { const int wcq = rg >> 4, n = (rg >> 2) & 3, f = rg & 3; return (n >> 1) * 2048 + nt * 128 + wcq * 32 + (n & 1) * 16 + f * 4; } };
struct EpiSwiglu { u16* HM; const float* b1; int slot0, nt, rows_valid;
    __device__ __forceinline__ void operator()(const f32x4 (&acc)[8][4], int wr, int wc, int fr, int fq) const {
        f32x4 bg[2], bl[2];
#pragma unroll
        for (int nn = 0; nn < 2; ++nn) { const int col = nt * 128 + wc * 32 + nn * 16 + 4 * fq; bg[nn] = *(const f32x4*)(b1 + col); bl[nn] = *(const f32x4*)(b1 + 2048 + col); }
#pragma unroll
        for (int m = 0; m < 8; ++m) { const int row = wr * 128 + m * 16 + fr;
            if (row < rows_valid) {
#pragma unroll
                for (int nn = 0; nn < 2; ++nn) { const f32x4 gl = unperm(acc[m][nn], fq & 1) + bg[nn], li = unperm(acc[m][nn + 2], fq & 1) + bl[nn]; float o[4];
#pragma unroll
                    for (int j = 0; j < 4; ++j) { const float gq = fminf(gl[j], 7.0f), lq = fminf(fmaxf(li[j], -7.0f), 7.0f); o[j] = gq * (1.0f / (1.0f + __expf(-1.702f * gq))) * (lq + 1.0f); }
                    u32x2 w; w[0] = pk_bf16(o[0], o[1]); w[1] = pk_bf16(o[2], o[3]);
                    *(u32x2*)(HM + (size_t)(slot0 + row) * DFF + nt * 128 + wc * 32 + nn * 16 + 4 * fq) = w; } } }
    } };
struct EpiY { u16* Y; const float* b2; int slot0, col0, rows_valid;
    __device__ __forceinline__ void operator()(const f32x4 (&acc)[8][4], int wr, int wc, int fr, int fq) const {
        f32x4 bv[4];
#pragma unroll
        for (int n = 0; n < 4; ++n) bv[n] = *(const f32x4*)(b2 + col0 + wc * 64 + n * 16 + 4 * fq);
#pragma unroll
        for (int m = 0; m < 8; ++m) { const int row = wr * 128 + m * 16 + fr;
            if (row < rows_valid) { u16* rowp = Y + (size_t)(slot0 + row) * DM + col0 + wc * 64 + 4 * fq;
#pragma unroll
                for (int n = 0; n < 4; ++n) { const f32x4 v = unperm(acc[m][n], fq & 1) + bv[n]; u32x2 w; w[0] = pk_bf16(v[0], v[1]); w[1] = pk_bf16(v[2], v[3]); *(u32x2*)(rowp + n * 16) = w; } } }
    } };
template <int NTILES>
__device__ __forceinline__ bool moe_decode(const int* __restrict__ offs, int u, int& e, int& mt, int& nt, int& slot0, int& rows) {
    int base = 0;
    for (int q = 0; q < NE; ++q) { const int o0 = offs[q], cnt = offs[q + 1] - o0, mtl = (cnt + 255) >> 8, nu = mtl * NTILES;
        if (u < base + nu) { const int ul = u - base; e = q; mt = ul % mtl; nt = ul / mtl; slot0 = o0 + mt * 256; rows = cnt - mt * 256; if (rows > 256) rows = 256; return true; }
        base += nu; }
    return false;
}


__device__ __forceinline__ int perm_col4(int rg) { const int rgl = rg & 31, t = rgl & 7; return 32 * (rgl >> 3) + 8 * (t & 3) + 4 * (t >> 2); }
__device__ __forceinline__ int perm32(int rho) { const int n = rho >> 4, i = rho & 15; return 8 * (i >> 2) + 4 * n + (i & 3); }
template <class ColMap>
__device__ __forceinline__ void convert_tile(const float* __restrict__ W, int ldb, int k0, const ColMap colmap, u16* __restrict__ dst, int tid) {
    const int wid = tid >> 6, lane = tid & 63;
    const int g = (lane & 3) + 4 * (wid >> 2), rg = (wid & 3) * 16 + (lane >> 2);
    const float* bp = W + (size_t)(k0 + 8 * g) * ldb + colmap(rg);
    f32x4 v[8];
#pragma unroll
    for (int kk = 0; kk < 8; ++kk) v[kk] = __builtin_nontemporal_load((const f32x4*)(bp + (size_t)kk * ldb));
    const int h = rg >> 5, r0 = (4 * rg) & 127;
    unsigned char* base = (unsigned char*)dst + h * 16384 + lds_byte(r0, 8 * g);
#pragma unroll
    for (int i = 0; i < 4; ++i) { u32x4 w; w[0] = pk_bf16(v[0][i], v[1][i]); w[1] = pk_bf16(v[2][i], v[3][i]); w[2] = pk_bf16(v[4][i], v[5][i]); w[3] = pk_bf16(v[6][i], v[7][i]);
        *(u32x4*)(base + i * 64) = w; }
}
struct ConvCtx { const float* w1; const float* w2; u16* W1T; u16* W2T; };
__device__ __forceinline__ int conv_seq2tile(int s) {
    if (s < 16384) return (s >> 9) * 512 + (s & 15) * 32 + ((s >> 4) & 31);
    const int q = s - 16384; return 16384 + (q >> 8) * 256 + (q & 7) * 32 + ((q >> 3) & 31);
}
__device__ __forceinline__ void conv_issue(const ConvCtx& cc, int m, int wid, int lane, f32x4 (&v)[8]) {
    const int g = (lane & 3) + 4 * (wid >> 2), rg = (wid & 3) * 16 + (lane >> 2);
    const float* bp; size_t ld;
    if (m < 16384) { const int e = m >> 9, nt = (m >> 5) & 15, kt = m & 31; ld = 2 * DFF; bp = cc.w1 + (size_t)e * DM * 2 * DFF + (size_t)(kt * 64 + 8 * g) * ld + (rg >> 5) * 2048 + nt * 128 + perm_col4(rg); }
    else { const int q = m - 16384, e = q >> 8, nt = (q >> 5) & 7, kt = q & 31; ld = DM; bp = cc.w2 + (size_t)e * DFF * DM + (size_t)(kt * 64 + 8 * g) * ld + nt * 256 + (rg >> 5) * 128 + perm_col4(rg); }
#pragma unroll
    for (int kk = 0; kk < 8; ++kk) v[kk] = __builtin_nontemporal_load((const f32x4*)(bp + (size_t)kk * ld));
}
__device__ __forceinline__ void conv_finish(const ConvCtx& cc, int m, int wid, int lane, const f32x4 (&v)[8]) {
    const int g = (lane & 3) + 4 * (wid >> 2), rg = (wid & 3) * 16 + (lane >> 2);
    u16* dst = (m < 16384) ? cc.W1T + (size_t)m * 16384 : cc.W2T + (size_t)(m - 16384) * 16384;
    unsigned char* base = (unsigned char*)dst + (rg >> 5) * 16384 + lds_byte((4 * rg) & 127, 8 * g);
#pragma unroll
    for (int i = 0; i < 4; ++i) { u32x4 w; w[0] = pk_bf16(v[0][i], v[1][i]); w[1] = pk_bf16(v[2][i], v[3][i]); w[2] = pk_bf16(v[4][i], v[5][i]); w[3] = pk_bf16(v[6][i], v[7][i]);
        __builtin_nontemporal_store(w, (u32x4*)(base + i * 64)); }
}
struct ColMapGluT { int nt; __device__ __forceinline__ int operator()(int rg) const { return (rg >> 5) * 2048 + nt * 128 + perm_col4(rg); } };
struct ColMapPerm { int c0; __device__ __forceinline__ int operator()(int rg) const { return c0 + (rg >> 5) * 128 + perm_col4(rg); } };

template <bool TRANS, class Epi>
__device__ __forceinline__ void gemm8_unit(LAS unsigned char* lds, const u16* __restrict__ A, int lda, const int* __restrict__ arows, int arow0, int rows_valid, const u16* __restrict__ Bt, int nt, const Epi epi) {
    const int tid = tid_fresh(), wid = __builtin_amdgcn_readfirstlane(tid >> 6), lane = tid & 63;
    const int wr = wid >> 2, wc = wid & 3, fr = lane & 15, fq = lane >> 4;
    unsigned aof[2][2];
#pragma unroll
    for (int h = 0; h < 2; ++h)
#pragma unroll
        for (int i = 0; i < 2; ++i) { int R, C; stage_rc(tid * 16 + i * 8192, R, C); int rr = h * 128 + R; rr = rr < rows_valid ? rr : rows_valid - 1;
            const unsigned rowid = arows ? (unsigned)arows[rr] : (unsigned)(arow0 + rr); aof[h][i] = (rowid * (unsigned)lda + (unsigned)C) * 2u; }
    const char* Ab = (const char*)A; const char* Bb = (const char*)Bt + tid * 16;
    const bool hi = rows_valid > 128;
#define G8_SA(b, h) (((b) * 2 + (h)) * 16384)
#define G8_SB(b, h) (65536 + ((b) * 2 + (h)) * 16384)
#define G8_STA(b, h, kt) do { _Pragma("unroll") for (int _i = 0; _i < 2; ++_i) \
        __builtin_amdgcn_global_load_lds((const unsigned*)(Ab + aof[h][_i] + (size_t)(kt) * 128), (LAS unsigned*)(lds + G8_SA(b, h) + wid * 1024 + _i * 8192), 16, 0, 0); } while (0)
#define G8_STB(b, h, kt) do { _Pragma("unroll") for (int _i = 0; _i < 2; ++_i) \
        __builtin_amdgcn_global_load_lds((const unsigned*)(Bb + (size_t)(kt) * 32768 + (h) * 16384 + _i * 8192), (LAS unsigned*)(lds + G8_SB(b, h) + wid * 1024 + _i * 8192), 16, 0, 0); } while (0)
#define G8_LDA(dst, b, h) do { _Pragma("unroll") for (int m = 0; m < 4; ++m) _Pragma("unroll") for (int k = 0; k < 2; ++k) dst[m][k] = *(const LAS bf16x8*)(lds + G8_SA(b, h) + aoff + m * 2048 + k * 1024); } while (0)
#define G8_LDB(dst, b, h) do { _Pragma("unroll") for (int n = 0; n < 2; ++n) _Pragma("unroll") for (int k = 0; k < 2; ++k) dst[n][k] = *(const LAS bf16x8*)(lds + G8_SB(b, h) + boff + n * 2048 + k * 1024); } while (0)
#define G8_MMA(ai, bj, At, Bq) do { if ((ai) == 0 || hi) { __builtin_amdgcn_s_setprio(1); _Pragma("unroll") for (int m = 0; m < 4; ++m) _Pragma("unroll") for (int n = 0; n < 2; ++n) _Pragma("unroll") for (int k = 0; k < 2; ++k) \
        acc[ai][bj][m][n] = TRANS ? __builtin_amdgcn_mfma_f32_16x16x32_bf16(At[m][k], Bq[n][k], acc[ai][bj][m][n], 0, 0, 0) : __builtin_amdgcn_mfma_f32_16x16x32_bf16(Bq[n][k], At[m][k], acc[ai][bj][m][n], 0, 0, 0); \
        __builtin_amdgcn_s_setprio(0); } } while (0)
#define G8_WV(n) asm volatile("s_waitcnt vmcnt(" #n ")" ::: "memory")
#define G8_WL(n) asm volatile("s_waitcnt lgkmcnt(" #n ")" ::: "memory")
#define G8_BAR __builtin_amdgcn_s_barrier()
#define G8_SCHED __builtin_amdgcn_sched_barrier(0)
    const int aoff = lds_byte(wr * 64 + fr, fq * 8), boff = lds_byte(wc * 32 + fr, fq * 8);
    f32x4 acc[2][2][4][2];
#pragma unroll
    for (int a = 0; a < 2; ++a)
#pragma unroll
        for (int b = 0; b < 2; ++b)
#pragma unroll
            for (int m = 0; m < 4; ++m)
#pragma unroll
                for (int n = 0; n < 2; ++n) acc[a][b][m][n] = (f32x4){0.f, 0.f, 0.f, 0.f};
    bf16x8 At[4][2], B0[2][2], B1[2][2];
    G8_STB(0, 0, 0); G8_STA(0, 0, 0); G8_STB(0, 1, 0); G8_STA(0, 1, 0);
    if (wr == 1) G8_BAR;
    G8_WV(4); G8_BAR;
    G8_STB(1, 0, 1); G8_STA(1, 0, 1); G8_STB(1, 1, 1);
    G8_WV(6); G8_BAR;
    for (int t = 0; t < nt - 2; t += 2) {
        G8_LDB(B0, 0, 0); G8_SCHED; G8_LDA(At, 0, 0); G8_STA(1, 1, t + 1);
        G8_WL(8); G8_BAR; G8_WL(0); G8_MMA(0, 0, At, B0); G8_BAR; G8_SCHED;
        G8_LDB(B1, 0, 1); G8_STB(0, 0, t + 2);
        G8_BAR; G8_WL(0); G8_MMA(0, 1, At, B1); G8_BAR;
        G8_LDA(At, 0, 1); G8_STA(0, 0, t + 2);
        G8_BAR; G8_WL(0); G8_MMA(1, 0, At, B0); G8_BAR; G8_SCHED;
        G8_STB(0, 1, t + 2);
        G8_WV(6); G8_BAR; G8_MMA(1, 1, At, B1); G8_BAR;
        G8_LDB(B0, 1, 0); G8_SCHED; G8_LDA(At, 1, 0); G8_STA(0, 1, t + 2);
        G8_WL(8); G8_BAR; G8_WL(0); G8_MMA(0, 0, At, B0); G8_BAR; G8_SCHED;
        G8_LDB(B1, 1, 1); G8_STB(1, 0, t + 3);
        G8_BAR; G8_WL(0); G8_MMA(0, 1, At, B1); G8_BAR;
        G8_LDA(At, 1, 1); G8_STA(1, 0, t + 3);
        G8_BAR; G8_WL(0); G8_MMA(1, 0, At, B0); G8_BAR; G8_SCHED;
        G8_STB(1, 1, t + 3);
        G8_WV(6); G8_BAR; G8_MMA(1, 1, At, B1); G8_BAR;
    }
    { G8_LDB(B0, 0, 0); G8_WV(0); G8_LDA(At, 0, 0); G8_STA(1, 1, nt - 1);
      G8_BAR; G8_WL(0); G8_MMA(0, 0, At, B0); G8_BAR;
      G8_LDB(B1, 0, 1); G8_BAR; G8_WL(0); G8_MMA(0, 1, At, B1); G8_BAR;
      G8_LDA(At, 0, 1); G8_WV(4); G8_BAR; G8_WL(0); G8_MMA(1, 0, At, B0); G8_MMA(1, 1, At, B1); G8_BAR; }
    { G8_LDB(B0, 1, 0); G8_LDA(At, 1, 0); G8_WV(2); G8_BAR; G8_WL(0); G8_MMA(0, 0, At, B0); G8_BAR;
      G8_LDB(B1, 1, 1); G8_WV(0); G8_BAR; G8_WL(0); G8_MMA(0, 1, At, B1); G8_BAR;
      G8_LDA(At, 1, 1); G8_BAR; G8_WL(0); G8_MMA(1, 0, At, B0); G8_MMA(1, 1, At, B1); G8_BAR; }
    if (wr == 0) G8_BAR;
#undef G8_SA
#undef G8_SB
#undef G8_STA
#undef G8_STB
#undef G8_LDA
#undef G8_LDB
#undef G8_MMA
#undef G8_WV
#undef G8_WL
#undef G8_BAR
#undef G8_SCHED
    __builtin_amdgcn_sched_barrier(0);
    { const int tz = tid_fresh(), wz = __builtin_amdgcn_readfirstlane(tz >> 6), lz = tz & 63;
      epi(acc, wz >> 2, wz & 3, lz & 15, lz >> 4); }
}
struct Epi8PG { u16* PG; int tok0, col0;
    __device__ __forceinline__ void operator()(const f32x4 (&acc)[2][2][4][2], int wr, int wc, int fr, int fq) const {
#pragma unroll
        for (int ai = 0; ai < 2; ++ai)
#pragma unroll
            for (int m = 0; m < 4; ++m) { u16* rowp = PG + (size_t)(tok0 + ai * 128 + wr * 64 + m * 16 + fr) * 5120 + col0 + wc * 32 + 8 * fq;
#pragma unroll
                for (int bj = 0; bj < 2; ++bj) { const f32x4 v0 = acc[ai][bj][m][0], v1 = acc[ai][bj][m][1];
                    *(u32x4*)(rowp + bj * 128) = (u32x4){pk_bf16(v0[0], v0[1]), pk_bf16(v0[2], v0[3]), pk_bf16(v1[0], v1[1]), pk_bf16(v1[2], v1[3])}; } }
    } };
struct Epi8HYT { u16* HYT; int tok0, col0;
    __device__ __forceinline__ void operator()(const f32x4 (&acc)[2][2][4][2], int wr, int wc, int fr, int fq) const {
#pragma unroll
        for (int bj = 0; bj < 2; ++bj)
#pragma unroll
            for (int n = 0; n < 2; ++n) { u16* colp = HYT + (size_t)(col0 + bj * 128 + wc * 32 + perm32(n * 16 + fr)) * NTOK + tok0 + wr * 64 + 4 * fq;
#pragma unroll
                for (int ai = 0; ai < 2; ++ai)
#pragma unroll
                    for (int m = 0; m < 4; ++m) { const f32x4 v = acc[ai][bj][m][n]; *(u32x2*)(colp + ai * 128 + m * 16) = (u32x2){pk_bf16(v[0], v[1]), pk_bf16(v[2], v[3])}; } }
    } };
struct Epi8X1 { const float* x; float* X1; int tok0, col0;
    __device__ __forceinline__ void operator()(const f32x4 (&acc)[2][2][4][2], int wr, int wc, int fr, int fq) const {
#pragma unroll
        for (int ai = 0; ai < 2; ++ai)
#pragma unroll
            for (int m = 0; m < 4; ++m) { const size_t off = (size_t)(tok0 + ai * 128 + wr * 64 + m * 16 + fr) * DM + col0 + wc * 32 + 8 * fq;
#pragma unroll
                for (int bj = 0; bj < 2; ++bj)
#pragma unroll
                    for (int n = 0; n < 2; ++n) { const f32x4 r = *(const f32x4*)(x + off + bj * 128 + n * 4); *(f32x4*)(X1 + off + bj * 128 + n * 4) = r + acc[ai][bj][m][n]; }
                asm volatile("" ::: "memory"); }
    } };
struct Epi8Swiglu { u16* HM; const float* b1; int slot0, nt, rows_valid;
    __device__ __forceinline__ void operator()(const f32x4 (&acc)[2][2][4][2], int wr, int wc, int fr, int fq) const {
        f32x4 bg[2], bl[2];
#pragma unroll
        for (int n = 0; n < 2; ++n) { const int col = nt * 128 + wc * 32 + 8 * fq + 4 * n; bg[n] = *(const f32x4*)(b1 + col); bl[n] = *(const f32x4*)(b1 + 2048 + col); }
#pragma unroll
        for (int ai = 0; ai < 2; ++ai)
#pragma unroll
            for (int m = 0; m < 4; ++m) { const int row = ai * 128 + wr * 64 + m * 16 + fr;
                if (row < rows_valid) { float o[8];
#pragma unroll
                    for (int n = 0; n < 2; ++n) { const f32x4 gl = acc[ai][0][m][n] + bg[n], li = acc[ai][1][m][n] + bl[n];
#pragma unroll
                        for (int j = 0; j < 4; ++j) { const float gq = fminf(gl[j], 7.0f), lq = fminf(fmaxf(li[j], -7.0f), 7.0f); o[4 * n + j] = gq * (1.0f / (1.0f + __expf(-1.702f * gq))) * (lq + 1.0f); } }
                    *(u32x4*)(HM + (size_t)(slot0 + row) * DFF + nt * 128 + wc * 32 + 8 * fq) = (u32x4){pk_bf16(o[0], o[1]), pk_bf16(o[2], o[3]), pk_bf16(o[4], o[5]), pk_bf16(o[6], o[7])}; } }
    } };
struct Epi8Y { u16* Y; const float* b2; int slot0, col0, rows_valid;
    __device__ __forceinline__ void operator()(const f32x4 (&acc)[2][2][4][2], int wr, int wc, int fr, int fq) const {
        f32x4 bv[2][2];
#pragma unroll
        for (int bj = 0; bj < 2; ++bj)
#pragma unroll
            for (int n = 0; n < 2; ++n) bv[bj][n] = *(const f32x4*)(b2 + col0 + bj * 128 + wc * 32 + 8 * fq + 4 * n);
#pragma unroll
        for (int ai = 0; ai < 2; ++ai)
#pragma unroll
            for (int m = 0; m < 4; ++m) { const int row = ai * 128 + wr * 64 + m * 16 + fr;
                if (row < rows_valid) { u16* rowp = Y + (size_t)(slot0 + row) * DM + col0 + wc * 32 + 8 * fq;
#pragma unroll
                    for (int bj = 0; bj < 2; ++bj) { const f32x4 v0 = acc[ai][bj][m][0] + bv[bj][0], v1 = acc[ai][bj][m][1] + bv[bj][1];
                        *(u32x4*)(rowp + bj * 128) = (u32x4){pk_bf16(v0[0], v0[1]), pk_bf16(v0[2], v0[3]), pk_bf16(v1[0], v1[1]), pk_bf16(v1[2], v1[3])}; } } }
    } };

typedef float f32x16 __attribute__((ext_vector_type(16)));
__device__ __forceinline__ void h3_row(int m, const float* __restrict__ w1, const float* __restrict__ b1, const float* __restrict__ w2, const float* __restrict__ b2,
                                       const float* __restrict__ w3, const float* __restrict__ b3, const float* __restrict__ freq, LAS float* sc  , float* __restrict__ H3) {
    const int j = tid_fresh() & 63;
    const float tt = (float)m / (float)(SEQ - 1);
    if (j == 0) sc[0] = tt;
    if (j >= 1 && j <= 16) { const int i = j - 1; const float band = 1e-4f + (float)i * ((15.0f - 1e-4f) / 15.0f); const float ang = (2.0f * 3.14159265358979323846f / (float)SEQ) * (float)m * band; sc[1 + i] = cosf(ang); sc[17 + i] = -sinf(ang); }
    __builtin_amdgcn_wave_barrier();
    const float fr = freq[j];
    float s = b1[j];
    for (int i = 0; i < 33; ++i) s += sc[i] * w1[i * 64 + j];
    const float h1 = sinf(fr * s);
    sc[64 + j] = h1;
    __builtin_amdgcn_wave_barrier();
    s = b2[j];
    for (int i = 0; i < 64; ++i) s += sc[64 + i] * w2[i * 64 + j];
    const float h2 = sinf(fr * s);
    __builtin_amdgcn_wave_barrier();
    sc[j] = h2;
    __builtin_amdgcn_wave_barrier();
    s = b3[j];
    for (int i = 0; i < 64; ++i) s += sc[i] * w3[i * 64 + j];
    H3[(size_t)m * 64 + j] = sinf(fr * s);
    __builtin_amdgcn_wave_barrier();
}
constexpr int FR_LEN = 4128;
__device__ __forceinline__ void frgen_item(int item, const float* __restrict__ H3, const float* __restrict__ w4, u16* __restrict__ FR, LAS float* hs  ) {
    const int tid = tid_fresh(), m0 = item * 8;
    for (int i = tid; i < 11 * 64; i += 512) { int m = m0 - 1 + (i >> 6); m = m < 0 ? 0 : (m > SEQ - 1 ? SEQ - 1 : m); hs[i] = H3[(size_t)m * 64 + (i & 63)]; }
    __syncthreads();
    const float mind = logf(1e-2f) / 0.3f, maxd = logf(1e-2f) / 1.5f;
    for (int p = 0; p < 4; ++p) {
        const int oc = tid + p * 512, o = oc >> 10, c = oc & 1023;
        const float* wf = w4 + o * 2048 + c; const float* wb = wf + 1024;
        float af[11], ab[11];
#pragma unroll
        for (int q = 0; q < 11; ++q) { af[q] = 0.f; ab[q] = 0.f; }
        for (int i = 0; i < 64; ++i) {
            const float xf = wf[(size_t)i * 4096], xb = wb[(size_t)i * 4096];
#pragma unroll
            for (int q = 0; q < 11; ++q) { const float h = hs[q * 64 + i]; af[q] = fmaf(h, xf, af[q]); ab[q] = fmaf(h, xb, ab[q]); }
        }
        const float delta = fabsf(mind + (float)c * ((maxd - mind) / 1023.0f));
#pragma unroll
        for (int q = 0; q < 11; ++q) { const int m = m0 - 1 + q; const float wv = (m >= 0 && m <= SEQ - 1) ? __expf(-((float)m / (float)(SEQ - 1)) * delta) : 0.f; af[q] *= wv; ab[q] *= wv; }
        u16* base = FR + (size_t)(oc * 2) * FR_LEN;
        u32x4 w;
        w[0] = pk_bf16(af[8], af[7]); w[1] = pk_bf16(af[6], af[5]); w[2] = pk_bf16(af[4], af[3]); w[3] = pk_bf16(af[2], af[1]);
        *(u32x4*)(base + 2040 - m0) = w;
        const float last = (m0 == 0) ? ab[2] : af[0];
        w[0] = pk_bf16(af[7], af[6]); w[1] = pk_bf16(af[5], af[4]); w[2] = pk_bf16(af[3], af[2]); w[3] = pk_bf16(af[1], last);
        *(u32x4*)(base + FR_LEN + 2040 - m0) = w;
        w[0] = pk_bf16(ab[2], ab[3]); w[1] = pk_bf16(ab[4], ab[5]); w[2] = pk_bf16(ab[6], ab[7]); w[3] = pk_bf16(ab[8], ab[9]);
        *(u32x4*)(base + 2048 + m0) = w;
        w[0] = pk_bf16(ab[3], ab[4]); w[1] = pk_bf16(ab[5], ab[6]); w[2] = pk_bf16(ab[7], ab[8]); w[3] = pk_bf16(ab[9], ab[10]);
        *(u32x4*)(base + FR_LEN + 2048 + m0) = w;
        if (item == 255) {
            const u32x4 z = {0u, 0u, 0u, 0u};
#pragma unroll
            for (int q = 0; q < 4; ++q) { *(u32x4*)(base + 4096 + q * 8) = z; *(u32x4*)(base + FR_LEN + 4096 + q * 8) = z; }
        }
    }
    __syncthreads();
}

constexpr int HY_ZSTRIDE = 2312;
constexpr int HY_ZCH = 256 + 4 * HY_ZSTRIDE;
constexpr int HY_ZBYTES = HY_ZCH * 2;
constexpr int HY_FB = 4 * HY_ZBYTES;
constexpr int HY_FCH = 2 * FR_LEN * 2;
constexpr int HY_LDS = HY_FB + 4 * HY_FCH;

__device__ __forceinline__ void hy_load_row(LAS unsigned char* lds, int dest, int boff0, int bstride, const u16* __restrict__ row, float w0, float w1, float w2, float cb, int pl) {
#pragma unroll 2
    for (int it = 0; it < 8; ++it) {
        const int idx = pl + 128 * it, tok0 = idx * 8, b = tok0 >> 11, n0 = tok0 & 2047;
        const u32x4 raw = *(const u32x4*)(row + tok0);
        const float pm = (n0 > 0) ? bf2f(row[tok0 - 1]) : 0.f;
        const float pn = (n0 + 8 < SEQ) ? bf2f(row[tok0 + 8]) : 0.f;
        float p[10];
        p[0] = pm; p[9] = pn;
#pragma unroll
        for (int q = 0; q < 4; ++q) { p[1 + 2 * q] = bflo(raw[q]); p[2 + 2 * q] = bfhi(raw[q]); }
        float o[8];
#pragma unroll
        for (int q = 0; q < 8; ++q) o[q] = fmaf(w0, p[q], fmaf(w1, p[q + 1], fmaf(w2, p[q + 2], cb)));
        u32x4 w; w[0] = pk_bf16(o[0], o[1]); w[1] = pk_bf16(o[2], o[3]); w[2] = pk_bf16(o[4], o[5]); w[3] = pk_bf16(o[6], o[7]);
        *(LAS u32x4*)(lds + dest + (boff0 + b * bstride + n0) * 2) = w;
    }
}
__device__ __forceinline__ void hy_load_filters(LAS unsigned char* lds, int fb, const u16* __restrict__ src, int pl) {
    for (int idx = pl; idx < HY_FCH / 16; idx += 128) *(LAS u32x4*)(lds + fb + idx * 16) = *(const u32x4*)((const char*)src + idx * 16);
}
__device__ __forceinline__ void hy_mfma_loop(LAS unsigned char* lds, int zb, int fb, int hlf, int lane, f32x16 (&acc)[4], const ConvCtx& cc, int mbase, int cunit, int wid) {
    const int r = lane & 31, hh = lane >> 5, il = r >> 2, b = r & 3;
    const int bbase = zb + (256 + b * HY_ZSTRIDE + 32 * il + 8 * hh) * 2;
    const int xl = 2047 - r + 8 * hh - 1024 * hlf;
    const int abase = (r & 1) ? (fb + 2 * xl) : (fb + FR_LEN * 2 + 2 * (xl - 1));
#pragma unroll
    for (int q = 0; q < 4; ++q)
#pragma unroll
        for (int i = 0; i < 16; ++i) acc[q][i] = 0.f;
    for (int d0 = 0; d0 < 8; ++d0) {
#pragma unroll
        for (int ks = 0; ks < 2; ++ks) {
            f32x4 cv[8];
            const int mcv = conv_seq2tile((mbase + d0 * 2 + ks) * 256 + cunit);
            conv_issue(cc, mcv, wid, lane, cv);
            bf16x8 Bt[9];
#pragma unroll
            for (int j = 0; j < 9; ++j) Bt[j] = *(const LAS bf16x8*)(lds + bbase + 512 * j - 64 * d0 + 32 * ks);
#pragma unroll
            for (int ep = -8; ep <= 3; ++ep) {
                const LAS unsigned* ap = (const LAS unsigned*)(lds + abase - 64 * d0 - 512 * ep + 32 * ks);
                u32x4 av; av[0] = ap[0]; av[1] = ap[1]; av[2] = ap[2]; av[3] = ap[3];
                const bf16x8 a = __builtin_bit_cast(bf16x8, av);
#pragma unroll
                for (int ctl = 0; ctl < 4; ++ctl) { const int jt = ctl - ep; if (jt >= 0 && jt <= 8) acc[ctl] = __builtin_amdgcn_mfma_f32_32x32x16_bf16(a, Bt[jt], acc[ctl], 0, 0, 0); }
            }
            conv_finish(cc, mcv, wid, lane, cv);
        }
    }
}
__device__ __forceinline__ void hy_epilogue(LAS unsigned char* lds, int zb, int gb, int hlf, int lane, const f32x16 (&acc)[4], float bias) {
    const int r = lane & 31, hh = lane >> 5, il = r >> 2, b = r & 3;
#pragma unroll
    for (int ctl = 0; ctl < 4; ++ctl) {
        const int I = 8 * (4 * hlf + ctl) + il;
#pragma unroll
        for (int q = 0; q < 4; ++q) {
            const int n4 = 32 * I + 8 * q + 4 * hh;
            LAS u32x2* zp = (LAS u32x2*)(lds + zb + (256 + b * HY_ZSTRIDE + n4) * 2);
            const u32x2 zv = *zp, gv = *(const LAS u32x2*)(lds + gb + (b * 2048 + n4) * 2);
            const float z0 = bflo(zv[0]), z1 = bfhi(zv[0]), z2 = bflo(zv[1]), z3 = bfhi(zv[1]);
            const float g0 = bflo(gv[0]), g1 = bfhi(gv[0]), g2 = bflo(gv[1]), g3 = bfhi(gv[1]);
            u32x2 o; o[0] = pk_bf16(g0 * fmaf(bias, z0, acc[ctl][4 * q + 0]), g1 * fmaf(bias, z1, acc[ctl][4 * q + 1]));
            o[1] = pk_bf16(g2 * fmaf(bias, z2, acc[ctl][4 * q + 2]), g3 * fmaf(bias, z3, acc[ctl][4 * q + 3]));
            *zp = o;
        }
    }
}
__device__ __forceinline__ void hyena_unit(LAS unsigned char* lds, int unit, const u16* __restrict__ HYT, const u16* __restrict__ FR, const float* __restrict__ cw, const float* __restrict__ cbv,
                                           const float* __restrict__ hbias, u16* __restrict__ Z2T, const ConvCtx& cc) {
    const int tid = tid_fresh(), wid = __builtin_amdgcn_readfirstlane(tid >> 6), lane = tid & 63;
    const int cs = wid & 3, hlf = wid >> 2, c = unit * 4 + cs, pl = lane + 64 * hlf;
    const int zb = cs * HY_ZBYTES, fb = HY_FB + cs * HY_FCH;
    { const u32x4 z = {0u, 0u, 0u, 0u}; for (int idx = pl; idx < HY_ZBYTES / 16; idx += 128) *(LAS u32x4*)(lds + zb + idx * 16) = z; }
    __syncthreads();
    hy_load_row(lds, zb, 256, HY_ZSTRIDE, HYT + (size_t)c * NTOK, cw[0 * 3072 + c], cw[1 * 3072 + c], cw[2 * 3072 + c], cbv[c], pl);
    f32x16 acc[4];
#pragma unroll
    for (int o = 0; o < 2; ++o) {
        hy_load_filters(lds, fb, FR + (size_t)((o * 1024 + c) * 2) * FR_LEN, pl);
        __syncthreads();
        hy_mfma_loop(lds, zb, fb, hlf, lane, acc, cc, o * 16, unit, wid);
        __syncthreads();
        const int gc = (1 + o) * 1024 + c;
        hy_load_row(lds, fb, 0, 2048, HYT + (size_t)gc * NTOK, cw[0 * 3072 + gc], cw[1 * 3072 + gc], cw[2 * 3072 + gc], cbv[gc], pl);
        __syncthreads();
        hy_epilogue(lds, zb, fb, hlf, lane, acc, hbias[o * HYW + c]);
        __syncthreads();
    }
#pragma unroll 2
    for (int it = 0; it < 8; ++it) { const int idx = pl + 128 * it, tok0 = idx * 8, b = tok0 >> 11, n0 = tok0 & 2047;
        *(u32x4*)(Z2T + (size_t)c * NTOK + tok0) = *(const LAS u32x4*)(lds + zb + (256 + b * HY_ZSTRIDE + n0) * 2); }
    __syncthreads();
}

constexpr int HG_RAWQ = 0, HG_RAWF = 16384, HG_RAWV = 32768;
constexpr int HG_QM = 36864, HG_KM = HG_QM + 17408, HG_QI = HG_KM + 17408;
constexpr int HG_KL = HG_QI + 17408;
constexpr int HG_VT = HG_KL + 18432;
constexpr int HG_P = HG_VT + 4608;
constexpr int HG_ST = HG_P + 9216;
constexpr int HG_TOT = HG_ST + 8704;
constexpr int HG_EL2 = HG_TOT + 2048;
constexpr int HG_LDS = HG_EL2 + 512;

__device__ __forceinline__ void hgrn_unit(LAS unsigned char* lds, int unit, const u16* __restrict__ PG, const float* __restrict__ lb_logits, float* __restrict__ OF, float* __restrict__ OB, const ConvCtx& cc) {
    const int tid = tid_fresh(), wid = __builtin_amdgcn_readfirstlane(tid >> 6), lane = tid & 63, fr = lane & 15, fq = lane >> 4;
    const int vq = unit & 3, dir = (unit >> 2) & 1, h = (unit >> 3) & 7, b = unit >> 6;
    const int k = tid & 127, seg = tid >> 7;
    float* __restrict__ O = dir ? OB : OF;
    float lb;
    { const int c = h * 128 + k; const float l0 = lb_logits[(0 * 2 + dir) * HGW + c], l1 = lb_logits[(1 * 2 + dir) * HGW + c]; lb = 1.0f / (1.0f + __expf(l1 - l0)); }
    for (int i = tid; i < 8704 / 16; i += 512) *(LAS u32x4*)(lds + HG_ST + i * 16) = (u32x4){0u, 0u, 0u, 0u};
    f32x4 Sacc[2];
    Sacc[0] = (f32x4){0.f, 0.f, 0.f, 0.f}; Sacc[1] = Sacc[0];
    u32x4 pq[2], pf[2], pv;
    const int colq = h * 128, colf = (1 + dir) * 1024 + h * 128, colv = 3072 + h * 128 + vq * 32;
#define HG_TOK(c, tau) ((size_t)b * SEQ + (dir ? (SEQ - 1 - 64 * (c) - (tau)) : (64 * (c) + (tau))))
#define HG_PREFETCH(c) do { _Pragma("unroll") for (int _i = 0; _i < 2; ++_i) { const int _x = tid + 512 * _i, _tau = _x >> 4, _p = _x & 15; const u16* _r = PG + HG_TOK(c, _tau) * 5120; \
            pq[_i] = *(const u32x4*)(_r + colq + _p * 8); pf[_i] = *(const u32x4*)(_r + colf + _p * 8); } \
        if (tid < 256) { const int _tau = tid >> 2, _p = tid & 3; pv = *(const u32x4*)(PG + HG_TOK(c, _tau) * 5120 + colv + _p * 8); } } while (0)
    HG_PREFETCH(0);
    for (int c = 0; c < 32; ++c) {
#pragma unroll
        for (int i = 0; i < 2; ++i) { const int x = tid + 512 * i; *(LAS u32x4*)(lds + HG_RAWQ + x * 16) = pq[i]; *(LAS u32x4*)(lds + HG_RAWF + x * 16) = pf[i]; }
        if (tid < 256) *(LAS u32x4*)(lds + HG_RAWV + tid * 16) = pv;
        if (c + 1 < 32) HG_PREFETCH(c + 1);
        f32x4 cv[8];
        const int mqa = conv_seq2tile((32 + c * 2) * 256 + unit), mqb = conv_seq2tile((33 + c * 2) * 256 + unit);
        conv_issue(cc, mqa, wid, lane, cv);
        __syncthreads();
        float qv[16], kv[16], bl[16];
        { float run = 0.f;
#pragma unroll
          for (int i = 0; i < 16; ++i) { const int tau = seg * 16 + i;
              const float qr = bf2f(*(const LAS u16*)(lds + HG_RAWQ + tau * 256 + k * 2)), zf = bf2f(*(const LAS u16*)(lds + HG_RAWF + tau * 256 + k * 2));
              const float sg = 1.0f / (1.0f + __expf(-zf)); const float f = lb + (1.0f - lb) * sg;
              run += __logf(f); bl[i] = run; kv[i] = 1.0f - f; qv[i] = qr / (1.0f + __expf(-qr)); }
          *(LAS float*)(lds + HG_TOT + (seg * 128 + k) * 4) = run; }
        __syncthreads();
        { const float t0 = *(const LAS float*)(lds + HG_TOT + (0 * 128 + k) * 4), t1 = *(const LAS float*)(lds + HG_TOT + (1 * 128 + k) * 4),
                      t2 = *(const LAS float*)(lds + HG_TOT + (2 * 128 + k) * 4), t3 = *(const LAS float*)(lds + HG_TOT + (3 * 128 + k) * 4);
          const float pre = (seg > 0 ? t0 : 0.f) + (seg > 1 ? t1 : 0.f) + (seg > 2 ? t2 : 0.f);
          const float bref = t0 + t1, blast = bref + t2 + t3;
          const float er = __expf(bref), el = __expf(blast - bref);
          if (seg == 0) *(LAS float*)(lds + HG_EL2 + k * 4) = __expf(blast);
          unsigned klp[8];
#pragma unroll
          for (int i = 0; i < 16; i += 2) {
              float klv[2];
#pragma unroll
              for (int u = 0; u < 2; ++u) { const int tau = seg * 16 + i + u; const float bb = pre + bl[i + u];
                  const float e1 = __expf(bb - bref), e2 = __expf(bref - bb);
                  const float qm = qv[i + u] * e1, km = kv[i + u] * e2;
                  *(LAS u16*)(lds + HG_QM + tau * 272 + k * 2) = (u16)(pk_bf16(qm, 0.f) & 0xffffu);
                  *(LAS u16*)(lds + HG_KM + tau * 272 + k * 2) = (u16)(pk_bf16(km, 0.f) & 0xffffu);
                  *(LAS u16*)(lds + HG_QI + tau * 272 + k * 2) = (u16)(pk_bf16(qm * er, 0.f) & 0xffffu);
                  klv[u] = km * el; }
              klp[i >> 1] = pk_bf16(klv[0], klv[1]); }
          *(LAS u32x4*)(lds + HG_KL + k * 144 + seg * 32) = (u32x4){klp[0], klp[1], klp[2], klp[3]};
          *(LAS u32x4*)(lds + HG_KL + k * 144 + seg * 32 + 16) = (u32x4){klp[4], klp[5], klp[6], klp[7]};
          { const int v = tid & 31, tg = tid >> 5; unsigned short e[4];
#pragma unroll
            for (int u = 0; u < 4; ++u) e[u] = *(const LAS u16*)(lds + HG_RAWV + (tg * 4 + u) * 64 + v * 2);
            *(LAS u32x2*)(lds + HG_VT + v * 144 + tg * 8) = (u32x2){(unsigned)e[0] | ((unsigned)e[1] << 16), (unsigned)e[2] | ((unsigned)e[3] << 16)}; } }
        conv_finish(cc, mqa, wid, lane, cv);
        conv_issue(cc, mqb, wid, lane, cv);
        __syncthreads();
#pragma unroll
        for (int q = 0; q < 2; ++q) { const int idx = wid * 2 + q, ti = idx >> 2, si = idx & 3;
            f32x4 a = {0.f, 0.f, 0.f, 0.f};
            if (si <= ti) {
#pragma unroll
                for (int ks = 0; ks < 4; ++ks) { const bf16x8 ka = *(const LAS bf16x8*)(lds + HG_KM + (si * 16 + fr) * 272 + (ks * 32 + fq * 8) * 2), qb = *(const LAS bf16x8*)(lds + HG_QM + (ti * 16 + fr) * 272 + (ks * 32 + fq * 8) * 2);
                    a = __builtin_amdgcn_mfma_f32_16x16x32_bf16(ka, qb, a, 0, 0, 0); } }
            const int tau = ti * 16 + fr, s0 = si * 16 + fq * 4;
            float pvv[4];
#pragma unroll
            for (int j = 0; j < 4; ++j) pvv[j] = (si <= ti && s0 + j <= tau) ? a[j] : 0.f;
            *(LAS u32x2*)(lds + HG_P + tau * 144 + s0 * 2) = (u32x2){pk_bf16(pvv[0], pvv[1]), pk_bf16(pvv[2], pvv[3])}; }
        const int ti = wid >> 1, vi = wid & 1;
        f32x4 oacc = {0.f, 0.f, 0.f, 0.f};
#pragma unroll
        for (int ks = 0; ks < 4; ++ks) { const bf16x8 qa = *(const LAS bf16x8*)(lds + HG_QI + (ti * 16 + fr) * 272 + (ks * 32 + fq * 8) * 2), sb = *(const LAS bf16x8*)(lds + HG_ST + (vi * 16 + fr) * 272 + (ks * 32 + fq * 8) * 2);
            oacc = __builtin_amdgcn_mfma_f32_16x16x32_bf16(qa, sb, oacc, 0, 0, 0); }
        { const f32x4 e2 = *(const LAS f32x4*)(lds + HG_EL2 + (wid * 16 + fq * 4) * 4);
#pragma unroll
          for (int v2 = 0; v2 < 2; ++v2) { Sacc[v2] = Sacc[v2] * e2;
#pragma unroll
              for (int ks = 0; ks < 2; ++ks) { const bf16x8 ka = *(const LAS bf16x8*)(lds + HG_KL + (wid * 16 + fr) * 144 + (ks * 32 + fq * 8) * 2), vb = *(const LAS bf16x8*)(lds + HG_VT + (v2 * 16 + fr) * 144 + (ks * 32 + fq * 8) * 2);
                  Sacc[v2] = __builtin_amdgcn_mfma_f32_16x16x32_bf16(ka, vb, Sacc[v2], 0, 0, 0); } } }
        __syncthreads();
#pragma unroll
        for (int ks = 0; ks < 2; ++ks) { const bf16x8 pa = *(const LAS bf16x8*)(lds + HG_P + (ti * 16 + fr) * 144 + (ks * 32 + fq * 8) * 2), vb = *(const LAS bf16x8*)(lds + HG_VT + (vi * 16 + fr) * 144 + (ks * 32 + fq * 8) * 2);
            oacc = __builtin_amdgcn_mfma_f32_16x16x32_bf16(pa, vb, oacc, 0, 0, 0); }
#pragma unroll
        for (int j = 0; j < 4; ++j) { const int tau = ti * 16 + fq * 4 + j; O[HG_TOK(c, tau) * HGW + h * 128 + vq * 32 + vi * 16 + fr] = oacc[j]; }
        conv_finish(cc, mqb, wid, lane, cv);
#pragma unroll
        for (int v2 = 0; v2 < 2; ++v2) *(LAS u32x2*)(lds + HG_ST + (v2 * 16 + fr) * 272 + (wid * 16 + fq * 4) * 2) = (u32x2){pk_bf16(Sacc[v2][0], Sacc[v2][1]), pk_bf16(Sacc[v2][2], Sacc[v2][3])};
    }
    __syncthreads();
#undef HG_TOK
#undef HG_PREFETCH
}


#define XB_TMO      128
#define XB_XCNT(j)  (256  + 64 * (j))
#define XB_XSUB(j)  (1280 + 64 * (j))
#define XB_XGEN(j)  (2304 + 64 * (j))
#define XB_TOP      3328
#define XB_TOPGEN   3392
#define XCD_BAR_WORDS 3456
#define XB_SPIN_CAP (1u << 22)

__device__ __forceinline__ unsigned xb_ld(unsigned* p)              { return __hip_atomic_load(p, __ATOMIC_RELAXED, __HIP_MEMORY_SCOPE_AGENT); }
__device__ __forceinline__ unsigned xb_add(unsigned* p, unsigned v) { return __hip_atomic_fetch_add(p, v, __ATOMIC_RELAXED, __HIP_MEMORY_SCOPE_AGENT); }
__device__ __forceinline__ unsigned xb_xcc_id() { return (unsigned)__builtin_amdgcn_s_getreg((3 << 11) | 20) & 0xFu; }
#define XB_SPIN(cond, bar) do { unsigned _sp = 0; while (cond) { __builtin_amdgcn_s_sleep(1); \
    if ((++_sp & 255u) == 0u) { if (xb_ld(&(bar)[XB_TMO])) break; if (_sp > XB_SPIN_CAP) { atomicAdd(&(bar)[XB_TMO], 1u); break; } } } } while (0)

struct XcdBarrier {
    unsigned* bar; unsigned x;
    volatile LAS unsigned* st;
};

__device__ __forceinline__ XcdBarrier xcd_barrier_post(unsigned* bar, volatile LAS unsigned* st) {
    XcdBarrier b; b.bar = bar; b.x = xb_xcc_id(); b.st = st;
    if (threadIdx.x == 0) (void)xb_add(&bar[XB_XCNT(b.x)], 1u);
    return b;
}
__device__ __forceinline__ void xcd_barrier_complete(unsigned* bar, unsigned x, unsigned& nloc, unsigned& nx) {
    const unsigned G = gridDim.x * gridDim.y * gridDim.z;
    unsigned sum, cnt, mine, sp = 0u;
    for (;;) {
        sum = 0u; cnt = 0u; mine = 0u;
#pragma unroll
        for (unsigned j = 0; j < 16; ++j) { const unsigned c = xb_ld(&bar[XB_XCNT(j)]); sum += c; cnt += (c > 0u) ? 1u : 0u; mine = (j == x) ? c : mine; }
        if (sum == G) break;
        __builtin_amdgcn_s_sleep(1);
        if ((++sp & 255u) == 0u) { if (xb_ld(&bar[XB_TMO])) break; if (sp > XB_SPIN_CAP) { atomicAdd(&bar[XB_TMO], 1u); break; } }
    }
    nloc = mine > 0u ? mine : 1u; nx = cnt > 0u ? cnt : 1u;
}

__device__ __forceinline__ void xcd_barrier(const XcdBarrier& b) {
    asm volatile("s_waitcnt vmcnt(0)" ::: "memory");
    __syncthreads();
    if (threadIdx.x == 0) {
        unsigned* bar = b.bar;
        __builtin_amdgcn_s_waitcnt(0);
        unsigned nloc = b.st[0], nx = b.st[1];
        if (nloc == 0u) { xcd_barrier_complete(bar, b.x, nloc, nx); b.st[0] = nloc; b.st[1] = nx; }
        const unsigned old = xb_add(&bar[XB_XSUB(b.x)], 1u);
        const unsigned gen = old / nloc;
        if (old + 1u == (gen + 1u) * nloc) {
            __builtin_amdgcn_fence(__ATOMIC_RELEASE, "agent");
            asm volatile("s_waitcnt vmcnt(0)" ::: "memory");
            const unsigned og = xb_add(&bar[XB_TOP], 1u);
            const unsigned tg = og / nx;
            if (og + 1u == (tg + 1u) * nx) xb_add(&bar[XB_TOPGEN], 1u);
            else XB_SPIN(xb_ld(&bar[XB_TOPGEN]) == tg, bar);
            __builtin_amdgcn_fence(__ATOMIC_ACQUIRE, "agent");
            xb_add(&bar[XB_XGEN(b.x)], 1u);
            asm volatile("s_waitcnt vmcnt(0)" ::: "memory");
        } else {
            XB_SPIN(xb_ld(&bar[XB_XGEN(b.x)]) == gen, bar);
            __builtin_amdgcn_fence(__ATOMIC_ACQUIRE, "agent");
            asm volatile("s_waitcnt vmcnt(0)" ::: "memory");
        }
    }
    __syncthreads();
}

__device__ __forceinline__ float wave_sum(float s) {
#pragma unroll
    for (int o = 32; o >= 1; o >>= 1) s += __shfl_xor(s, o);
    return s;
}
__device__ __forceinline__ void rmsnorm_row_bf(const float* __restrict__ xr, const float* __restrict__ gain, u16* __restrict__ ob, int lane) {
    f32x4 v[8]; float s = 0.f;
#pragma unroll
    for (int j = 0; j < 8; ++j) { v[j] = *(const f32x4*)(xr + (lane + 64 * j) * 4); s += v[j][0] * v[j][0] + v[j][1] * v[j][1] + v[j][2] * v[j][2] + v[j][3] * v[j][3]; }
    s = wave_sum(s);
    const float r = rsqrtf(s * (1.0f / (float)DM) + EPS);
#pragma unroll
    for (int j = 0; j < 8; ++j) { const f32x4 g = *(const f32x4*)(gain + (lane + 64 * j) * 4); const f32x4 o = v[j] * r * g;
        *(u32x2*)(ob + (lane + 64 * j) * 4) = (u32x2){pk_bf16(o[0], o[1]), pk_bf16(o[2], o[3])}; }
}
__device__ __forceinline__ void hgrn_final_item(int item, const float* __restrict__ OF, const float* __restrict__ OB, const u16* __restrict__ PG, const float* __restrict__ gain, u16* __restrict__ MIXB, int lane) {
    const int tok = item >> 3, h = item & 7, c = h * 128 + 2 * lane;
    const f32x2 a = *(const f32x2*)(OF + (size_t)tok * HGW + c), b = *(const f32x2*)(OB + (size_t)tok * HGW + c);
    const float o0 = a[0] + b[0], o1 = a[1] + b[1];
    const float s = wave_sum(o0 * o0 + o1 * o1);
    const float r = rsqrtf(s * (1.0f / 128.0f) + EPS);
    const unsigned gw = *(const unsigned*)(PG + (size_t)tok * 5120 + 4096 + c);
    const float g0 = bflo(gw), g1 = bfhi(gw);
    const f32x2 gn = *(const f32x2*)(gain + c);
    const float v0 = o0 * r * gn[0] * (g0 / (1.0f + __expf(-g0))), v1 = o1 * r * gn[1] * (g1 / (1.0f + __expf(-g1)));
    *(unsigned*)(MIXB + (size_t)tok * DM + c) = pk_bf16(v0, v1);
}
__device__ __forceinline__ void hy_norm_tile(LAS unsigned char* lds, int tile_i, const u16* __restrict__ Z2T, const float* __restrict__ gain, u16* __restrict__ MIXB) {
    const int t = tid_fresh(), tok0 = tile_i * 32;
    LAS float* ssq = (LAS float*)(lds + 1024 * 80);
    if (t < 32) ssq[t] = 0.f;
    __syncthreads();
    float part[8];
#pragma unroll
    for (int q = 0; q < 8; ++q) part[q] = 0.f;
    const int ch = t & 3;
#pragma unroll
    for (int it = 0; it < 8; ++it) {
        const int c = (t >> 2) + 128 * it;
        const u32x4 v = *(const u32x4*)(Z2T + (size_t)c * NTOK + tok0 + ch * 8);
        *(LAS u32x4*)(lds + c * 80 + ch * 16) = v;
#pragma unroll
        for (int q = 0; q < 4; ++q) { const float a = bflo(v[q]), b = bfhi(v[q]); part[2 * q] += a * a; part[2 * q + 1] += b * b; }
    }
#pragma unroll
    for (int q = 0; q < 8; ++q) { float s = part[q]; s += __shfl_xor(s, 4); s += __shfl_xor(s, 8); s += __shfl_xor(s, 16); s += __shfl_xor(s, 32); part[q] = s; }
    if ((t & 63) < 4) {
#pragma unroll
        for (int q = 0; q < 8; ++q) atomicAdd((float*)(ssq + ch * 8 + q), part[q]);
    }
    __syncthreads();
    const int tt = t >> 4;
    const float r = rsqrtf(ssq[tt] * (1.0f / (float)HYW) + EPS);
#pragma unroll 2
    for (int k = 0; k < 8; ++k) {
        const int c0 = ((t & 15) + 16 * k) * 8;
        float o[8];
#pragma unroll
        for (int q = 0; q < 8; ++q) o[q] = bf2f(*(const LAS u16*)(lds + (c0 + q) * 80 + tt * 2)) * r * gain[c0 + q];
        *(u32x4*)(MIXB + (size_t)(tok0 + tt) * DM + 1024 + c0) = (u32x4){pk_bf16(o[0], o[1]), pk_bf16(o[2], o[3]), pk_bf16(o[4], o[5]), pk_bf16(o[6], o[7])};
    }
    __syncthreads();
}
constexpr int RT_XSTRIDE = 2049;
constexpr int RT_PART = 16 * RT_XSTRIDE * 4;
constexpr int RT_LG = RT_PART + 8 * 16 * 32 * 4;
constexpr int RT_HIST = RT_LG + 16 * 32 * 4;
constexpr int RT_END = RT_HIST + 128;
__device__ __forceinline__ void router_tile(LAS unsigned char* lds, int tile_i, const float* __restrict__ X1, const float* __restrict__ gain, const float* __restrict__ wr, const float* __restrict__ br,
                                            u16* __restrict__ XNB, int* __restrict__ TOPI, float* __restrict__ TOPG, int* __restrict__ counts) {
    const int tid = tid_fresh(), wid = __builtin_amdgcn_readfirstlane(tid >> 6), lane = tid & 63;
    const int tok0 = tile_i * 16;
    LAS float* xs = (LAS float*)lds;
#pragma unroll
    for (int q = 0; q < 2; ++q) {
        const int tl = wid * 2 + q; const size_t tok = (size_t)tok0 + tl;
        const float* xr = X1 + tok * DM;
        f32x4 v[8]; float s = 0.f;
#pragma unroll
        for (int j = 0; j < 8; ++j) { v[j] = *(const f32x4*)(xr + (lane + 64 * j) * 4); s += v[j][0] * v[j][0] + v[j][1] * v[j][1] + v[j][2] * v[j][2] + v[j][3] * v[j][3]; }
        s = wave_sum(s);
        const float r = rsqrtf(s * (1.0f / (float)DM) + EPS);
#pragma unroll
        for (int j = 0; j < 8; ++j) { const int d = (lane + 64 * j) * 4; const f32x4 g = *(const f32x4*)(gain + d); const f32x4 o = v[j] * r * g;
            xs[tl * RT_XSTRIDE + d + 0] = o[0]; xs[tl * RT_XSTRIDE + d + 1] = o[1]; xs[tl * RT_XSTRIDE + d + 2] = o[2]; xs[tl * RT_XSTRIDE + d + 3] = o[3];
            *(u32x2*)(XNB + tok * DM + d) = (u32x2){pk_bf16(o[0], o[1]), pk_bf16(o[2], o[3])}; }
    }
    __syncthreads();
    {
        const int tl = lane & 15, kk = lane >> 4;
        f32x4 a0 = {0.f, 0.f, 0.f, 0.f}, a1 = a0;
        const LAS float* xp = xs + tl * RT_XSTRIDE + wid * 256 + kk;
        const float* wp = wr + (size_t)(wid * 256 + kk) * NE + tl;
#pragma unroll 8
        for (int ks = 0; ks < 64; ++ks) { const float a = xp[ks * 4]; const float b0 = wp[(size_t)ks * 4 * NE], b1 = wp[(size_t)ks * 4 * NE + 16];
            a0 = __builtin_amdgcn_mfma_f32_16x16x4f32(a, b0, a0, 0, 0, 0); a1 = __builtin_amdgcn_mfma_f32_16x16x4f32(a, b1, a1, 0, 0, 0); }
        LAS float* pp = (LAS float*)(lds + RT_PART) + wid * 512;
#pragma unroll
        for (int j = 0; j < 4; ++j) { pp[(kk * 4 + j) * 32 + tl] = a0[j]; pp[(kk * 4 + j) * 32 + 16 + tl] = a1[j]; }
    }
    __syncthreads();
    {   const LAS float* pp = (const LAS float*)(lds + RT_PART); float s = br[tid & 31];
#pragma unroll
        for (int w = 0; w < 8; ++w) s += pp[w * 512 + tid];
        ((LAS float*)(lds + RT_LG))[tid] = s; }
    __syncthreads();
    if (tid < 16) {
        LAS float* lg = (LAS float*)(lds + RT_LG) + tid * 32;
        int i0 = 0, i1 = 0, i2 = 0, i3 = 0; float v0, v1, v2, v3;
        { float bv = -3.0e38f; for (int j = 0; j < NE; ++j) { const float l = lg[j]; if (l > bv) { bv = l; i0 = j; } } v0 = bv; lg[i0] = -3.4e38f; }
        { float bv = -3.0e38f; for (int j = 0; j < NE; ++j) { const float l = lg[j]; if (l > bv) { bv = l; i1 = j; } } v1 = bv; lg[i1] = -3.4e38f; }
        { float bv = -3.0e38f; for (int j = 0; j < NE; ++j) { const float l = lg[j]; if (l > bv) { bv = l; i2 = j; } } v2 = bv; lg[i2] = -3.4e38f; }
        { float bv = -3.0e38f; for (int j = 0; j < NE; ++j) { const float l = lg[j]; if (l > bv) { bv = l; i3 = j; } } v3 = bv; lg[i3] = -3.4e38f; }
        const float e1 = __expf(v1 - v0), e2 = __expf(v2 - v0), e3 = __expf(v3 - v0), inv = 1.0f / (1.0f + e1 + e2 + e3);
        const int tok = tok0 + tid;
        *(int4*)(TOPI + tok * 4) = make_int4(i0, i1, i2, i3);
        *(f32x4*)(TOPG + tok * 4) = (f32x4){inv, e1 * inv, e2 * inv, e3 * inv};
        LAS int* hist = (LAS int*)(lds + RT_HIST);
        atomicAdd((int*)(hist + i0), 1); atomicAdd((int*)(hist + i1), 1); atomicAdd((int*)(hist + i2), 1); atomicAdd((int*)(hist + i3), 1);
    }
    __syncthreads();
}
__device__ __forceinline__ void combine_row(int tok, const float* __restrict__ X1, const u16* __restrict__ YB, const int* __restrict__ SOF, const float* __restrict__ TOPG, const float* __restrict__ gain, float* __restrict__ out, int lane) {
    const int4 sl = *(const int4*)(SOF + tok * 4); const f32x4 g = *(const f32x4*)(TOPG + tok * 4);
    const u16* y0 = YB + (size_t)sl.x * DM; const u16* y1 = YB + (size_t)sl.y * DM; const u16* y2 = YB + (size_t)sl.z * DM; const u16* y3 = YB + (size_t)sl.w * DM;
    f32x4 v[8]; float s = 0.f;
#pragma unroll
    for (int j = 0; j < 8; ++j) { const int d = (lane + 64 * j) * 4;
        f32x4 a = *(const f32x4*)(X1 + (size_t)tok * DM + d);
        const u32x2 q0 = *(const u32x2*)(y0 + d), q1 = *(const u32x2*)(y1 + d), q2 = *(const u32x2*)(y2 + d), q3 = *(const u32x2*)(y3 + d);
        a[0] += g[0] * bflo(q0[0]) + g[1] * bflo(q1[0]) + g[2] * bflo(q2[0]) + g[3] * bflo(q3[0]);
        a[1] += g[0] * bfhi(q0[0]) + g[1] * bfhi(q1[0]) + g[2] * bfhi(q2[0]) + g[3] * bfhi(q3[0]);
        a[2] += g[0] * bflo(q0[1]) + g[1] * bflo(q1[1]) + g[2] * bflo(q2[1]) + g[3] * bflo(q3[1]);
        a[3] += g[0] * bfhi(q0[1]) + g[1] * bfhi(q1[1]) + g[2] * bfhi(q2[1]) + g[3] * bfhi(q3[1]);
        v[j] = a; s += a[0] * a[0] + a[1] * a[1] + a[2] * a[2] + a[3] * a[3]; }
    s = wave_sum(s);
    const float r = rsqrtf(s * (1.0f / (float)DM) + EPS);
#pragma unroll
    for (int j = 0; j < 8; ++j) { const int d = (lane + 64 * j) * 4; const f32x4 gn = *(const f32x4*)(gain + d); *(f32x4*)(out + (size_t)tok * DM + d) = v[j] * r * gn; }
}

#ifndef REP_P9
#define REP_P9 1
#endif
#ifndef REP_P3
#define REP_P3 1
#endif
#ifndef REP_FR
#define REP_FR 1
#endif
#ifndef REP_P0
#define REP_P0 1
#endif
#ifndef REP_CONV
#define REP_CONV 1
#endif
#ifndef REP_GEMM1
#define REP_GEMM1 1
#endif
#ifndef REP_HY
#define REP_HY 1
#endif
#ifndef REP_HG
#define REP_HG 1
#endif
#ifndef REP_MOEA
#define REP_MOEA 1
#endif
#ifndef REP_MOEB
#define REP_MOEB 1
#endif
#ifndef REP_WOUT
#define REP_WOUT 1
#endif
struct MegaP {
    const float *x, *norm_mix_gain, *w_in, *lb_logits, *hgrn_norm_gain, *hy_conv_w, *hy_conv_b, *fw1, *fb1, *fw2, *fb2, *fw3, *fb3, *fw4, *ffreq, *hy_bias, *hy_norm_gain, *w_out,
        *norm_ffn_gain, *w_router, *b_router, *moe_w1, *moe_b1, *moe_w2, *moe_b2, *final_gain;
    float* out; unsigned char* ws;
};
constexpr int MEGA_XB = RT_END;
constexpr int MEGA_LDS = RT_END + 64;
static_assert(MEGA_LDS >= HY_LDS + 64 && MEGA_LDS >= HG_LDS + 64 && MEGA_LDS >= GEMM_LDS + 64, "LDS");

__global__ void __launch_bounds__(512, 2) k_mega(const MegaP p_arg) {
    extern __shared__ __attribute__((aligned(16))) unsigned char shm[];
    LAS unsigned char* lds = (LAS unsigned char*)shm;
    const int tid = threadIdx.x, wid = __builtin_amdgcn_readfirstlane(tid >> 6), lane = tid & 63;
    const int G = gridDim.x, bid = blockIdx.x, c = xcd_logical(bid, G);
#define PHASE_ARGS() const MegaP __attribute__((address_space(4)))* pq_ = (const MegaP __attribute__((address_space(4)))*)__builtin_amdgcn_kernarg_segment_ptr(); asm volatile("" : "+s"(pq_)); unsigned char* ws = pq_->ws; (void)ws
    unsigned char* ws0; { PHASE_ARGS(); ws0 = ws; }
#define counts ((int*)(ws + WS_CTL))
#define cursor ((int*)(ws + WS_CTL + 4096))
#define offs ((int*)(ws + WS_CTL + 8192))
#define barw ((unsigned*)(ws + WS_CTL + 16384))
#define HB ((u16*)(ws + WS_HB))
#define PG ((u16*)(ws + WS_PG))
#define HYT ((u16*)(ws + WS_HYT))
#define MIXB ((u16*)(ws + WS_MIXB))
#define XNB ((u16*)(ws + WS_XNB))
#define HMB ((u16*)(ws + WS_HMB))
#define YB ((u16*)(ws + WS_YB))
#define H3 ((float*)(ws + WS_H3))
#define FR ((u16*)(ws + WS_FR))
#define Z2T ((u16*)(ws + WS_Z2T))
#define OF ((float*)(ws + WS_OF))
#define OB ((float*)(ws + WS_OB))
#define X1 ((float*)(ws + WS_X1))
#define TOPI ((int*)(ws + WS_TOPI))
#define TOPG ((float*)(ws + WS_TOPG))
#define STOK ((int*)(ws + WS_STOK))
#define SOF ((int*)(ws + WS_SOF))
#define WINT ((u16*)(ws + WS_WINT))
#define WOUTT ((u16*)(ws + WS_WOUTT))
#define W1T ((u16*)(ws + WS_W1T))
#define W2T ((u16*)(ws + WS_W2T))
    if (tid == 0) *(LAS u32x4*)(lds + MEGA_XB) = (u32x4){0u, 0u, 0u, 0u};
    __syncthreads();
    XcdBarrier bar = xcd_barrier_post((unsigned*)(ws0 + WS_CTL + 16384), (volatile LAS unsigned*)(lds + MEGA_XB));

    {
        PHASE_ARGS();
    for (int rep = 0; rep < REP_P0; ++rep) {
    for (int row = bid * 8 + wid; row < NTOK; row += G * 8) rmsnorm_row_bf(pq_->x + (size_t)row * DM, pq_->norm_mix_gain, HB + (size_t)row * DM, lane);
    for (int m = bid * 8 + wid; m < SEQ; m += G * 8) h3_row(m, pq_->fw1, pq_->fb1, pq_->fw2, pq_->fb2, pq_->fw3, pq_->fb3, pq_->ffreq, (LAS float*)(lds + wid * 512), H3); }
    for (int rep = 0; rep < REP_CONV; ++rep)
    for (int id = bid; id < 1024 + 256; id += G) {
        const int tz = tid_fresh();
        if (id < 1024) { const int nt = id >> 5, kt = id & 31; convert_tile(pq_->w_in, DIN, kt * 64, ColMapPerm{nt * 256}, WINT + (size_t)id * 16384, tz); }
        else { const int q = id - 1024, nt = q >> 5, kt = q & 31; convert_tile(pq_->w_out, DM, kt * 64, ColMapPerm{nt * 256}, WOUTT + (size_t)q * 16384, tz); }
    }
    }
    xcd_barrier(bar);
    {
        PHASE_ARGS();
    for (int rep = 0; rep < REP_FR; ++rep)
    for (int item = bid; item < 256; item += G) frgen_item(item, H3, pq_->fw4, FR, (LAS float*)lds);
    for (int rep = 0; rep < REP_GEMM1; ++rep)
    for (int u = c; u < 1024; u += G) {
        const int i = u >> 8, xx = (u >> 5) & 7, j = u & 31;
        const int mt = (xx & 3) * 8 + (j & 7), nt = ((xx >> 2) + 2 * i) * 4 + (j >> 3);
        const u16* bt = WINT + (size_t)nt * 32 * 16384;
        if (nt < 20) { Epi8PG e{PG, mt * 256, nt * 256}; gemm8_unit<false>(lds, HB, DM, nullptr, mt * 256, 256, bt, 32, e); }
        else { Epi8HYT e{HYT, mt * 256, nt * 256 - 5120}; gemm8_unit<true>(lds, HB, DM, nullptr, mt * 256, 256, bt, 32, e); }
    }
    }
    xcd_barrier(bar);
    {
        PHASE_ARGS();
    for (int rep = 0; rep < REP_HY; ++rep)
    for (int u = bid; u < 256; u += G) hyena_unit(lds, u, HYT, FR, pq_->hy_conv_w, pq_->hy_conv_b, pq_->hy_bias, Z2T, ConvCtx{pq_->moe_w1, pq_->moe_w2, W1T, W2T});
    for (int rep = 0; rep < REP_HG; ++rep)
    for (int u = bid; u < 256; u += G) hgrn_unit(lds, u, PG, pq_->lb_logits, OF, OB, ConvCtx{pq_->moe_w1, pq_->moe_w2, W1T, W2T});
    }
    xcd_barrier(bar);
    {
        PHASE_ARGS();
    for (int rep = 0; rep < REP_P3; ++rep) {
    for (int it = bid * 8 + wid; it < NTOK * HGH; it += G * 8) hgrn_final_item(it, OF, OB, PG, pq_->hgrn_norm_gain, MIXB, lane);
    for (int t = bid; t < NTOK / 32; t += G) hy_norm_tile(lds, t, Z2T, pq_->hy_norm_gain, MIXB); }
    }
    xcd_barrier(bar);
    {
        PHASE_ARGS();
    for (int u = c; u < 256; u += G) {
        const int xx = u >> 5, j = u & 31;
        const int mt = (xx >> 1) * 8 + (j & 7), nt = (xx & 1) * 4 + (j >> 3);
        Epi8X1 e{pq_->x, X1, mt * 256, nt * 256};
        gemm8_unit<false>(lds, MIXB, DM, nullptr, mt * 256, 256, WOUTT + (size_t)nt * 32 * 16384, 32, e);
    }
    }
    xcd_barrier(bar);
    {
        PHASE_ARGS();
    if (tid < NE) *(LAS int*)(lds + RT_HIST + tid * 4) = 0;
    __syncthreads();
    for (int t = bid; t < NTOK / 16; t += G) router_tile(lds, t, X1, pq_->norm_ffn_gain, pq_->w_router, pq_->b_router, XNB, TOPI, TOPG, counts);
    if (tid < NE) { const int hcount = *(const LAS int*)(lds + RT_HIST + tid * 4); if (hcount) atomicAdd(&counts[tid * 32], hcount); }
    }
    xcd_barrier(bar);
    {
        PHASE_ARGS();
    {
        LAS int* so = (LAS int*)lds;
        LAS int* lh = (LAS int*)(lds + 256);
        LAS int* lb2 = (LAS int*)(lds + 512);
        if (tid == 0) { int a = 0; for (int e = 0; e < NE; ++e) { so[e] = a; a += __hip_atomic_load(&counts[e * 32], __ATOMIC_RELAXED, __HIP_MEMORY_SCOPE_AGENT); } so[NE] = a; }
        if (tid < NE) lh[tid] = 0;
        __syncthreads();
        if (bid == 0 && tid <= NE) offs[tid] = so[tid];
        for (int i0 = bid * 512; i0 < NSLOT; i0 += G * 512) {
            const int i = i0 + tid; const int e = TOPI[i];
            const int lpos = atomicAdd((int*)(lh + e), 1);
            __syncthreads();
            if (tid < NE) { const int n = lh[tid]; lb2[tid] = so[tid] + (n ? atomicAdd(&cursor[tid * 32], n) : 0); }
            __syncthreads();
            const int slot = lb2[e] + lpos; STOK[slot] = i >> 2; SOF[i] = slot;
            __syncthreads();
            if (tid < NE) lh[tid] = 0;
            __syncthreads();
        }
    }
    }
    xcd_barrier(bar);
    {
        PHASE_ARGS();
    for (int rep = 0; rep < REP_MOEA; ++rep)
    for (int u = c;; u += G) {
        int e, mt, nt, slot0, rows;
        if (!moe_decode<16>(offs, u, e, mt, nt, slot0, rows)) break;
        Epi8Swiglu ep{HMB, pq_->moe_b1 + (size_t)e * 2 * DFF, slot0, nt, rows};
        gemm8_unit<false>(lds, XNB, DM, STOK + slot0, 0, rows, W1T + (size_t)(e * 16 + nt) * 32 * 16384, 32, ep);
    }
    }
    xcd_barrier(bar);
    {
        PHASE_ARGS();
    for (int rep = 0; rep < REP_MOEB; ++rep)
    for (int u = c;; u += G) {
        int e, mt, nt, slot0, rows;
        if (!moe_decode<8>(offs, u, e, mt, nt, slot0, rows)) break;
        Epi8Y ep{YB, pq_->moe_b2 + (size_t)e * DM, slot0, nt * 256, rows};
        gemm8_unit<false>(lds, HMB, DFF, nullptr, slot0, rows, W2T + (size_t)(e * 8 + nt) * 32 * 16384, 32, ep);
    }
    }
    xcd_barrier(bar);
    {
        PHASE_ARGS();
    for (int rep = 0; rep < REP_P9; ++rep)
    for (int tok = bid * 8 + wid; tok < NTOK; tok += G * 8) combine_row(tok, X1, YB, SOF, TOPG, pq_->final_gain, pq_->out, lane);
    }
}
#undef counts
#undef cursor
#undef offs
#undef barw
#undef HB
#undef PG
#undef HYT
#undef MIXB
#undef XNB
#undef HMB
#undef YB
#undef H3
#undef FR
#undef Z2T
#undef OF
#undef OB
#undef X1
#undef TOPI
#undef TOPG
#undef STOK
#undef SOF
#undef WINT
#undef WOUTT
#undef W1T
#undef W2T

extern "C" void kernel_launch(void* const* d_in, const int* in_sizes, int n_in, void* d_out, int out_size, void* d_ws, size_t ws_size, hipStream_t stream) {
    if (n_in < 26 || ws_size < WS_END2) return;
    MegaP p{};
    const float** pp = (const float**)&p;
    for (int i = 0; i < 26; ++i) pp[i] = (const float*)d_in[i];
    p.out = (float*)d_out; p.ws = (unsigned char*)d_ws;
    static int grid = 0;
    if (!grid) {
        int dev = 0, cus = 0, per_cu = 0;
        (void)hipGetDevice(&dev);
        (void)hipDeviceGetAttribute(&cus, hipDeviceAttributeMultiprocessorCount, dev);
        (void)hipFuncSetAttribute((const void*)k_mega, hipFuncAttributeMaxDynamicSharedMemorySize, MEGA_LDS);
        (void)hipOccupancyMaxActiveBlocksPerMultiprocessor(&per_cu, (const void*)k_mega, 512, MEGA_LDS);
        if (per_cu < 1) per_cu = 1;
        grid = cus * 1;
        if (grid > 256) grid = 256;
        grid &= ~7;
        if (grid < 8) grid = 8;
    }
    (void)hipMemsetAsync((char*)d_ws + WS_CTL, 0, 65536, stream);
    hipLaunchKernelGGL(k_mega, dim3(grid), dim3(512), MEGA_LDS, stream, p);
}
```

```cpp
#include <hip/hip_runtime.h>
#include <stdint.h>

constexpr int BATCH = 4, SEQ = 2048, DM = 2048, NTOK = BATCH * SEQ;
constexpr int HGW = 1024, HGD = 128, HGH = 8;
constexpr int HYW = 1024;
constexpr int DIN = 8192;
constexpr int NE = 32, TOPK = 4, DFF = 2048;
constexpr int NSLOT = NTOK * TOPK;
constexpr float EPS = 1e-5f;

constexpr size_t MB = 1024ull * 1024ull;
constexpr size_t WS_CTL = 0;
constexpr size_t WS_HB = 1 * MB;
constexpr size_t WS_PG = WS_HB + 32 * MB;
constexpr size_t WS_HYT = WS_PG + 80 * MB;
constexpr size_t WS_MIXB = WS_HYT + 48 * MB;
constexpr size_t WS_XNB = WS_MIXB + 32 * MB;
constexpr size_t WS_HMB = WS_XNB + 32 * MB;
constexpr size_t WS_YB = WS_HMB + 128 * MB;
constexpr size_t WS_H3 = WS_YB + 128 * MB;
constexpr size_t WS_FR = WS_H3 + 1 * MB;
constexpr size_t WS_Z2T = WS_FR + 34 * MB;
constexpr size_t WS_OF = WS_Z2T + 16 * MB;
constexpr size_t WS_OB = WS_OF + 32 * MB;
constexpr size_t WS_X1 = WS_OB + 32 * MB;
constexpr size_t WS_TOPI = WS_X1 + 64 * MB;
constexpr size_t WS_TOPG = WS_TOPI + 1 * MB;
constexpr size_t WS_STOK = WS_TOPG + 1 * MB;
constexpr size_t WS_SOF = WS_STOK + 1 * MB;
constexpr size_t WS_WINT = WS_SOF + 1 * MB;
constexpr size_t WS_WOUTT = WS_WINT + 32 * MB;
constexpr size_t WS_W1T = WS_WOUTT + 8 * MB;
constexpr size_t WS_W2T = WS_W1T + 512 * MB;
constexpr size_t WS_END2 = WS_W2T + 256 * MB;

typedef short bf16x8 __attribute__((ext_vector_type(8)));
typedef float f32x4 __attribute__((ext_vector_type(4)));
typedef float f32x2 __attribute__((ext_vector_type(2)));
typedef unsigned u32x4 __attribute__((ext_vector_type(4)));
typedef unsigned u32x2 __attribute__((ext_vector_type(2)));
typedef unsigned short u16;
#define LAS __attribute__((address_space(3)))

__device__ __forceinline__ unsigned pk_bf16(float lo, float hi) {
    typedef __bf16 bf2 __attribute__((ext_vector_type(2)));
    const f32x2 v = {lo, hi};
    const bf2 r = __builtin_convertvector(v, bf2);
    return __builtin_bit_cast(unsigned, r);
}
__device__ __forceinline__ float bf2f(u16 b) { return __uint_as_float(((unsigned)b) << 16); }
__device__ __forceinline__ float bflo(unsigned w) { return __uint_as_float(w << 16); }
__device__ __forceinline__ float bfhi(unsigned w) { return __uint_as_float(w & 0xffff0000u); }

__device__ __forceinline__ int lds_byte(int r, int c) { const int st = (r >> 4) * 2 + (c >> 5), ob = (r & 15) * 64 + (c & 31) * 2; return st * 1024 + (ob ^ (((ob >> 9) & 1) << 5)); }
__device__ __forceinline__ void stage_rc(int b, int& R, int& C) { const int st = b >> 10, sb = b & 1023, swz = sb ^ (((sb >> 9) & 1) << 5); R = (st >> 1) * 16 + swz / 64; C = (st & 1) * 32 + (swz % 64) / 2; }
__device__ __forceinline__ f32x4 unperm(const f32x4 a, const bool s) { f32x4 o; o[0] = s ? a[1] : a[0]; o[1] = s ? a[0] : a[1]; o[2] = s ? a[3] : a[2]; o[3] = s ? a[2] : a[3]; return o; }

__device__ __forceinline__ int tid_fresh() { int t = threadIdx.x; asm volatile("" : "+v"(t)); return t; }
constexpr int GEMM_LDS = 131072;

template <bool TRANS, bool RAGGED, int PM = 0, class ColMap, class Epi>
__device__ __forceinline__ void gemm_unit(LAS unsigned char* lds, const u16* __restrict__ A, int lda, const int* __restrict__ arows, int arow0, int rows_valid,
                                          const float* __restrict__ B, int ldb, int K, const ColMap colmap, const Epi epi) {
    const int tid = tid_fresh(), wid = __builtin_amdgcn_readfirstlane(tid >> 6), lane = tid & 63;
    const int wr = wid >> 2, wc = wid & 3, fr = lane & 15, fq = lane >> 4;
    const int nt = K >> 6;
    const char* ap[4];
#pragma unroll
    for (int i = 0; i < 4; ++i) {
        int R, C; stage_rc(wid * 1024 + i * 8192 + lane * 16, R, C);
        const int rr = RAGGED ? (R < rows_valid ? R : rows_valid - 1) : R;
        const long rowid = arows ? (long)arows[rr] : (long)(arow0 + rr);
        ap[i] = (const char*)A + ((size_t)rowid * lda + C) * 2;
    }
    const int g = (lane & 3) + 4 * (wid >> 2), rg = (wid & 3) * 16 + (lane >> 2);
    const unsigned bvoff = (unsigned)(((size_t)(8 * g) * ldb + colmap(rg)) * 4);
    const int bbase = 65536 + lds_byte(4 * rg, 8 * g);
    const int bw0 = bbase + ((rg & 1) ? 64 : 0), bw1 = bbase + ((rg & 1) ? 0 : 64);
    const int aoff = lds_byte(wr * 128 + fr, fq * 8), boff = 65536 + lds_byte(wc * 64 + fr, fq * 8);
    int mvalid = 8;
    if (RAGGED) { mvalid = (rows_valid - wr * 128 + 15) >> 4; mvalid = mvalid < 0 ? 0 : (mvalid > 8 ? 8 : mvalid); }
    f32x4 vb0, vb1, vb2, vb3, vb4, vb5, vb6, vb7;
    if (PM & 1) { vb0 = (f32x4){1.f, 1.f, 1.f, 1.f}; vb1 = vb0; vb2 = vb0; vb3 = vb0; vb4 = vb0; vb5 = vb0; vb6 = vb0; vb7 = vb0; }
    f32x4 acc[8][4];
#pragma unroll
    for (int m = 0; m < 8; ++m)
#pragma unroll
        for (int n = 0; n < 4; ++n) acc[m][n] = (f32x4){0.f, 0.f, 0.f, 0.f};
    const size_t ldb4 = (size_t)ldb * 4;
#define GE_GLDS_A(buf, kt) do { if (!(PM & 2)) _Pragma("unroll") for (int _i = 0; _i < 4; ++_i) \
        __builtin_amdgcn_global_load_lds((const unsigned*)(ap[_i] + (size_t)(kt) * 128), (LAS unsigned*)(lds + (buf) * 32768 + wid * 1024 + _i * 8192), 16, 0, 0); } while (0)
#define GE_LD1(dst, sb) if (!(PM & 1)) asm volatile("global_load_dwordx4 %0, %1, %2" : "=v"(dst) : "v"(bvoff), "s"(sb) : "memory")
#define GE_LOAD_B(kt) do { const char* _sb = (const char*)B + (size_t)(kt) * 64 * ldb4; \
        GE_LD1(vb0, _sb); GE_LD1(vb1, _sb + ldb4); GE_LD1(vb2, _sb + 2 * ldb4); GE_LD1(vb3, _sb + 3 * ldb4); \
        GE_LD1(vb4, _sb + 4 * ldb4); GE_LD1(vb5, _sb + 5 * ldb4); GE_LD1(vb6, _sb + 6 * ldb4); GE_LD1(vb7, _sb + 7 * ldb4); } while (0)
#define GE_WAITV_B(n) asm volatile("s_waitcnt vmcnt(" #n ")" : "+v"(vb0), "+v"(vb1), "+v"(vb2), "+v"(vb3), "+v"(vb4), "+v"(vb5), "+v"(vb6), "+v"(vb7) :: "memory")
#define GE_WRITE_B(buf) do { _Pragma("unroll") for (int _i = 0; _i < 4; ++_i) { u32x4 _w; _w[0] = pk_bf16(vb0[_i], vb1[_i]); _w[1] = pk_bf16(vb2[_i], vb3[_i]); \
        _w[2] = pk_bf16(vb4[_i], vb5[_i]); _w[3] = pk_bf16(vb6[_i], vb7[_i]); \
        *(LAS u32x4*)(lds + ((_i & 1) ? bw1 : bw0) + (_i >> 1) * 128 + (buf) * 32768) = _w; } } while (0)
#define GE_KSTEP(buf, ks) do { bf16x8 Bf[4]; \
        _Pragma("unroll") for (int n = 0; n < 4; ++n) Bf[n] = *(const LAS bf16x8*)(lds + (buf) * 32768 + boff + n * 2048 + (ks) * 1024); \
        _Pragma("unroll") for (int mh = 0; mh < 2; ++mh) { bf16x8 At[4]; \
            _Pragma("unroll") for (int m = 0; m < 4; ++m) At[m] = *(const LAS bf16x8*)(lds + (buf) * 32768 + aoff + (mh * 4 + m) * 2048 + (ks) * 1024); \
            _Pragma("unroll") for (int m = 0; m < 4; ++m) { if (!RAGGED || (mh * 4 + m) < mvalid) { _Pragma("unroll") for (int n = 0; n < 4; ++n) \
                { if (PM & 4) { asm volatile("" :: "v"(At[m]), "v"(Bf[n])); } else acc[mh * 4 + m][n] = TRANS ? __builtin_amdgcn_mfma_f32_16x16x32_bf16(At[m], Bf[n], acc[mh * 4 + m][n], 0, 0, 0) : __builtin_amdgcn_mfma_f32_16x16x32_bf16(Bf[n], At[m], acc[mh * 4 + m][n], 0, 0, 0); } } } } } while (0)
    GE_GLDS_A(0, 0);
    GE_LOAD_B(0);
    GE_WAITV_B(0);
    GE_WRITE_B(0);
    GE_LOAD_B(1);
    asm volatile("s_waitcnt lgkmcnt(0)" ::: "memory");
    __builtin_amdgcn_s_barrier();
    int t = 0;
    for (; t < nt - 2; ++t) {
        const int cur = t & 1;
        GE_GLDS_A(cur ^ 1, t + 1);
        GE_KSTEP(cur, 0);
        GE_WAITV_B(4);
        GE_WRITE_B(cur ^ 1);
        GE_LOAD_B(t + 2);
        __builtin_amdgcn_sched_barrier(0);
        GE_KSTEP(cur, 1);
        asm volatile("s_waitcnt vmcnt(8) lgkmcnt(0)" ::: "memory");
        __builtin_amdgcn_s_barrier();
    }
    {
        const int cur = t & 1;
        GE_GLDS_A(cur ^ 1, t + 1);
        GE_KSTEP(cur, 0);
        GE_WAITV_B(4);
        GE_WRITE_B(cur ^ 1);
        GE_KSTEP(cur, 1);
        asm volatile("s_waitcnt vmcnt(0) lgkmcnt(0)" ::: "memory");
        __builtin_amdgcn_s_barrier();
        ++t;
    }
    {
        const int cur = t & 1;
        GE_KSTEP(cur, 0);
        GE_KSTEP(cur, 1);
        asm volatile("s_waitcnt lgkmcnt(0)" ::: "memory");
        __builtin_amdgcn_s_barrier();
    }
#undef GE_GLDS_A
#undef GE_LD1
#undef GE_LOAD_B
#undef GE_WAITV_B
#undef GE_WRITE_B
#undef GE_KSTEP
    __builtin_amdgcn_sched_barrier(0);
    { const int tz = tid_fresh(), wz = __builtin_amdgcn_readfirstlane(tz >> 6), lz = tz & 63;
      epi(acc, wz >> 2, wz & 3, lz & 15, lz >> 4); }
}

__device__ __forceinline__ int xcd_logical(int b, int G) { return (G & 7) ? b : (b & 7) * (G >> 3) + (b >> 3); }

struct ColMapDense { int c0; __device__ __forceinline__ int operator()(int rg) const { return c0 + 4 * rg; } };
struct EpiPG { u16* PG; int tok0, col0;
    __device__ __forceinline__ void operator()(const f32x4 (&acc)[8][4], int wr, int wc, int fr, int fq) const {
#pragma unroll
        for (int m = 0; m < 8; ++m) { u16* rowp = PG + (size_t)(tok0 + wr * 128 + m * 16 + fr) * 5120 + col0 + wc * 64 + 4 * fq;
#pragma unroll
            for (int n = 0; n < 4; ++n) { const f32x4 v = unperm(acc[m][n], fq & 1); u32x2 w; w[0] = pk_bf16(v[0], v[1]); w[1] = pk_bf16(v[2], v[3]); *(u32x2*)(rowp + n * 16) = w; } }
    } };
struct EpiHYT { u16* HYT; int tok0, col0;
    __device__ __forceinline__ void operator()(const f32x4 (&acc)[8][4], int wr, int wc, int fr, int fq) const {
#pragma unroll
        for (int n = 0; n < 4; ++n) { const int rho = wc * 64 + n * 16 + fr; const int col = col0 + (rho & ~3) + ((rho & 3) ^ ((rho >> 2) & 1));
            u16* colp = HYT + (size_t)col * NTOK + tok0 + wr * 128 + 4 * fq;
#pragma unroll
            for (int m = 0; m < 8; ++m) { const f32x4 v = acc[m][n]; u32x2 w; w[0] = pk_bf16(v[0], v[1]); w[1] = pk_bf16(v[2], v[3]); *(u32x2*)(colp + m * 16) = w; } }
    } };
struct EpiX1 { const float* x; float* X1; int tok0, col0;
    __device__ __forceinline__ void operator()(const f32x4 (&acc)[8][4], int wr, int wc, int fr, int fq) const {
#pragma unroll
        for (int m = 0; m < 8; ++m) { const size_t off = (size_t)(tok0 + wr * 128 + m * 16 + fr) * DM + col0 + wc * 64 + 4 * fq;
#pragma unroll
            for (int n = 0; n < 4; ++n) { const f32x4 r = *(const f32x4*)(x + off + n * 16); *(f32x4*)(X1 + off + n * 16) = r + unperm(acc[m][n], fq & 1); }
            asm volatile("" ::: "memory"); }
    } };
struct ColMapGlu { int nt; __device__ __forceinline__ int operator()(int rg) const { const int wcq = rg >> 4, n = (rg >> 2) & 3, f = rg & 3; return (n >> 1) * 2048 + nt * 128 + wcq * 32 + (n & 1) * 16 + f * 4; } };
struct EpiSwiglu { u16* HM; const float* b1; int slot0, nt, rows_valid;
    __device__ __forceinline__ void operator()(const f32x4 (&acc)[8][4], int wr, int wc, int fr, int fq) const {
        f32x4 bg[2], bl[2];
#pragma unroll
        for (int nn = 0; nn < 2; ++nn) { const int col = nt * 128 + wc * 32 + nn * 16 + 4 * fq; bg[nn] = *(const f32x4*)(b1 + col); bl[nn] = *(const f32x4*)(b1 + 2048 + col); }
#pragma unroll
        for (int m = 0; m < 8; ++m) { const int row = wr * 128 + m * 16 + fr;
            if (row < rows_valid) {
#pragma unroll
                for (int nn = 0; nn < 2; ++nn) { const f32x4 gl = unperm(acc[m][nn], fq & 1) + bg[nn], li = unperm(acc[m][nn + 2], fq & 1) + bl[nn]; float o[4];
#pragma unroll
                    for (int j = 0; j < 4; ++j) { const float gq = fminf(gl[j], 7.0f), lq = fminf(fmaxf(li[j], -7.0f), 7.0f); o[j] = gq * (1.0f / (1.0f + __expf(-1.702f * gq))) * (lq + 1.0f); }
                    u32x2 w; w[0] = pk_bf16(o[0], o[1]); w[1] = pk_bf16(o[2], o[3]);
                    *(u32x2*)(HM + (size_t)(slot0 + row) * DFF + nt * 128 + wc * 32 + nn * 16 + 4 * fq) = w; } } }
    } };
struct EpiY { u16* Y; const float* b2; int slot0, col0, rows_valid;
    __device__ __forceinline__ void operator()(const f32x4 (&acc)[8][4], int wr, int wc, int fr, int fq) const {
        f32x4 bv[4];
#pragma unroll
        for (int n = 0; n < 4; ++n) bv[n] = *(const f32x4*)(b2 + col0 + wc * 64 + n * 16 + 4 * fq);
#pragma unroll
        for (int m = 0; m < 8; ++m) { const int row = wr * 128 + m * 16 + fr;
            if (row < rows_valid) { u16* rowp = Y + (size_t)(slot0 + row) * DM + col0 + wc * 64 + 4 * fq;
#pragma unroll
                for (int n = 0; n < 4; ++n) { const f32x4 v = unperm(acc[m][n], fq & 1) + bv[n]; u32x2 w; w[0] = pk_bf16(v[0], v[1]); w[1] = pk_bf16(v[2], v[3]); *(u32x2*)(rowp + n * 16) = w; } } }
    } };
template <int NTILES>
__device__ __forceinline__ bool moe_decode(const int* __restrict__ offs, int u, int& e, int& mt, int& nt, int& slot0, int& rows) {
    int base = 0;
    for (int q = 0; q < NE; ++q) { const int o0 = offs[q], cnt = offs[q + 1] - o0, mtl = (cnt + 255) >> 8, nu = mtl * NTILES;
        if (u < base + nu) { const int ul = u - base; e = q; mt = ul % mtl; nt = ul / mtl; slot0 = o0 + mt * 256; rows = cnt - mt * 256; if (rows > 256) rows = 256; return true; }
        base += nu; }
    return false;
}


__device__ __forceinline__ int perm_col4(int rg) { const int rgl = rg & 31, t = rgl & 7; return 32 * (rgl >> 3) + 8 * (t & 3) + 4 * (t >> 2); }
__device__ __forceinline__ int perm32(int rho) { const int n = rho >> 4, i = rho & 15; return 8 * (i >> 2) + 4 * n + (i & 3); }
template <class ColMap>
__device__ __forceinline__ void convert_tile(const float* __restrict__ W, int ldb, int k0, const ColMap colmap, u16* __restrict__ dst, int tid) {
    const int wid = tid >> 6, lane = tid & 63;
    const int g = (lane & 3) + 4 * (wid >> 2), rg = (wid & 3) * 16 + (lane >> 2);
    const float* bp = W + (size_t)(k0 + 8 * g) * ldb + colmap(rg);
    f32x4 v[8];
#pragma unroll
    for (int kk = 0; kk < 8; ++kk) v[kk] = __builtin_nontemporal_load((const f32x4*)(bp + (size_t)kk * ldb));
    const int h = rg >> 5, r0 = (4 * rg) & 127;
    unsigned char* base = (unsigned char*)dst + h * 16384 + lds_byte(r0, 8 * g);
#pragma unroll
    for (int i = 0; i < 4; ++i) { u32x4 w; w[0] = pk_bf16(v[0][i], v[1][i]); w[1] = pk_bf16(v[2][i], v[3][i]); w[2] = pk_bf16(v[4][i], v[5][i]); w[3] = pk_bf16(v[6][i], v[7][i]);
        *(u32x4*)(base + i * 64) = w; }
}
typedef int i32x8 __attribute__((ext_vector_type(8)));
typedef int i32x4 __attribute__((ext_vector_type(4)));
constexpr float W8_SCALE = 32.0f;
constexpr int W8_MX = 0x7A7A7A7A;
constexpr int A8_MX = 0x7F7F7F7F;
__device__ __forceinline__ unsigned pk_fp8x4(float a, float b, float c, float d) { int p = __builtin_amdgcn_cvt_pk_fp8_f32(a, b, 0, false); p = __builtin_amdgcn_cvt_pk_fp8_f32(c, d, p, true); return (unsigned)p; }
__device__ __forceinline__ int lds_byte_b(int r, int cb) { const int st = (r >> 4) * 2 + (cb >> 6), ob = (r & 15) * 64 + (cb & 63); return st * 1024 + (ob ^ (((ob >> 9) & 1) << 5)); }
struct ConvCtx { const float* w1; const float* w2; unsigned char* W1T; unsigned char* W2T; };
__device__ __forceinline__ int conv_seq2tile(int s) {
    if (s < 16384) return (s >> 9) * 512 + (s & 15) * 32 + ((s >> 4) & 31);
    const int q = s - 16384; return 16384 + (q >> 8) * 256 + (q & 7) * 32 + ((q >> 3) & 31);
}
__device__ __forceinline__ void conv_issue(const ConvCtx& cc, int m, int wid, int lane, f32x2 (&v)[16]) {
    const int rp = 16 * wid + (lane & 15), rg = rp >> 1, p2 = (rp & 1) * 2, kg = lane >> 4;
    const float* bp; size_t ld;
    if (m < 16384) { const int e = m >> 9, nt = (m >> 5) & 15, kt = m & 31; ld = 2 * DFF; bp = cc.w1 + (size_t)e * DM * 2 * DFF + (size_t)(kt * 64 + 16 * kg) * ld + (rg >> 5) * 2048 + nt * 128 + perm_col4(rg) + p2; }
    else { const int q = m - 16384, e = q >> 8, nt = (q >> 5) & 7, kt = q & 31; ld = DM; bp = cc.w2 + (size_t)e * DFF * DM + (size_t)(kt * 64 + 16 * kg) * ld + nt * 256 + (rg >> 5) * 128 + perm_col4(rg) + p2; }
#pragma unroll
    for (int kk = 0; kk < 16; ++kk) v[kk] = __builtin_nontemporal_load((const f32x2*)(bp + (size_t)kk * ld));
}
__device__ __forceinline__ void conv_finish(const ConvCtx& cc, int m, int wid, int lane, const f32x2 (&v)[16]) {
    const int rp = 16 * wid + (lane & 15), kg = lane >> 4;
    const int kt64 = m & 31;
    unsigned char* dst = (m < 16384) ? cc.W1T + ((size_t)(m >> 5) * 16 + (kt64 >> 1)) * 32768 : cc.W2T + ((size_t)((m - 16384) >> 5) * 16 + (kt64 >> 1)) * 32768;
    unsigned char* base = dst + (rp >> 6) * 16384 + lds_byte_b((2 * rp) & 127, (kt64 & 1) * 64 + 16 * kg);
#pragma unroll
    for (int i = 0; i < 2; ++i) { u32x4 w;
#pragma unroll
        for (int q = 0; q < 4; ++q) w[q] = pk_fp8x4(v[4 * q][i] * W8_SCALE, v[4 * q + 1][i] * W8_SCALE, v[4 * q + 2][i] * W8_SCALE, v[4 * q + 3][i] * W8_SCALE);
        __builtin_nontemporal_store(w, (u32x4*)(base + i * 64)); }
}
struct ColMapGluT { int nt; __device__ __forceinline__ int operator()(int rg) const { return (rg >> 5) * 2048 + nt * 128 + perm_col4(rg); } };
struct ColMapPerm { int c0; __device__ __forceinline__ int operator()(int rg) const { return c0 + (rg >> 5) * 128 + perm_col4(rg); } };

template <bool TRANS, bool FP8 = false, class Epi>
__device__ __forceinline__ void gemm8_unit(LAS unsigned char* lds, const u16* __restrict__ A, int lda, const int* __restrict__ arows, int arow0, int rows_valid, const u16* __restrict__ Bt, int nt, const Epi epi) {
    const int tid = tid_fresh(), wid = __builtin_amdgcn_readfirstlane(tid >> 6), lane = tid & 63;
    const int wr = wid >> 2, wc = wid & 3, fr = lane & 15, fq = lane >> 4;
    unsigned aof[2][2];
#pragma unroll
    for (int h = 0; h < 2; ++h)
#pragma unroll
        for (int i = 0; i < 2; ++i) { int R, C; stage_rc(tid * 16 + i * 8192, R, C); int rr = h * 128 + R; rr = rr < rows_valid ? rr : rows_valid - 1;
            const unsigned rowid = arows ? (unsigned)arows[rr] : (unsigned)(arow0 + rr); aof[h][i] = (rowid * (unsigned)lda + (unsigned)C) * 2u; }
    const char* Ab = (const char*)A; const char* Bb = (const char*)Bt + tid * 16;
    const bool hi = rows_valid > 128;
    int mxw = W8_MX, mxa = A8_MX; asm volatile("" : "+v"(mxw), "+v"(mxa));
#define G8_SA(b, h) (((b) * 2 + (h)) * 16384)
#define G8_SB(b, h) (65536 + ((b) * 2 + (h)) * 16384)
#define G8_STA(b, h, kt) do { _Pragma("unroll") for (int _i = 0; _i < 2; ++_i) \
        __builtin_amdgcn_global_load_lds((const unsigned*)(Ab + aof[h][_i] + (size_t)(kt) * 128), (LAS unsigned*)(lds + G8_SA(b, h) + wid * 1024 + _i * 8192), 16, 0, 0); } while (0)
#define G8_STB(b, h, kt) do { _Pragma("unroll") for (int _i = 0; _i < 2; ++_i) \
        __builtin_amdgcn_global_load_lds((const unsigned*)(Bb + (size_t)(kt) * 32768 + (h) * 16384 + _i * 8192), (LAS unsigned*)(lds + G8_SB(b, h) + wid * 1024 + _i * 8192), 16, 0, 0); } while (0)
#define G8_LDA(dst, b, h) do { _Pragma("unroll") for (int m = 0; m < 4; ++m) _Pragma("unroll") for (int k = 0; k < 2; ++k) dst[m][k] = *(const LAS bf16x8*)(lds + G8_SA(b, h) + aoff + m * 2048 + k * 1024); } while (0)
#define G8_LDB(dst, b, h) do { _Pragma("unroll") for (int n = 0; n < 2; ++n) _Pragma("unroll") for (int k = 0; k < 2; ++k) dst[n][k] = *(const LAS bf16x8*)(lds + G8_SB(b, h) + boff + n * 2048 + k * 1024); } while (0)
#define G8_MMA(ai, bj, At, Bq) do { if ((ai) == 0 || hi) { __builtin_amdgcn_s_setprio(1); _Pragma("unroll") for (int m = 0; m < 4; ++m) _Pragma("unroll") for (int n = 0; n < 2; ++n) { \
        if (FP8) { const i32x4 a0 = __builtin_bit_cast(i32x4, At[m][0]), a1 = __builtin_bit_cast(i32x4, At[m][1]), b0 = __builtin_bit_cast(i32x4, Bq[n][0]), b1 = __builtin_bit_cast(i32x4, Bq[n][1]); \
            const i32x8 a8 = __builtin_shufflevector(a0, a1, 0, 1, 2, 3, 4, 5, 6, 7), b8 = __builtin_shufflevector(b0, b1, 0, 1, 2, 3, 4, 5, 6, 7); \
            asm volatile("v_mfma_scale_f32_16x16x128_f8f6f4 %0, %1, %2, %0, %3, %4 op_sel_hi:[0,0,0]" : "+v"(acc[ai][bj][m][n]) : "v"(b8), "v"(a8), "v"(mxw), "v"(mxa)); } \
        else { _Pragma("unroll") for (int k = 0; k < 2; ++k) \
            acc[ai][bj][m][n] = TRANS ? __builtin_amdgcn_mfma_f32_16x16x32_bf16(At[m][k], Bq[n][k], acc[ai][bj][m][n], 0, 0, 0) : __builtin_amdgcn_mfma_f32_16x16x32_bf16(Bq[n][k], At[m][k], acc[ai][bj][m][n], 0, 0, 0); } } \
        __builtin_amdgcn_s_setprio(0); } } while (0)
#define G8_WV(n) asm volatile("s_waitcnt vmcnt(" #n ")" ::: "memory")
#define G8_WL(n) asm volatile("s_waitcnt lgkmcnt(" #n ")" ::: "memory")
#define G8_BAR __builtin_amdgcn_s_barrier()
#define G8_SCHED __builtin_amdgcn_sched_barrier(0)
    const int aoff = lds_byte(wr * 64 + fr, fq * 8), boff = lds_byte(wc * 32 + fr, fq * 8);
    f32x4 acc[2][2][4][2];
#pragma unroll
    for (int a = 0; a < 2; ++a)
#pragma unroll
        for (int b = 0; b < 2; ++b)
#pragma unroll
            for (int m = 0; m < 4; ++m)
#pragma unroll
                for (int n = 0; n < 2; ++n) acc[a][b][m][n] = (f32x4){0.f, 0.f, 0.f, 0.f};
    bf16x8 At[4][2], B0[2][2], B1[2][2];
    G8_STB(0, 0, 0); G8_STA(0, 0, 0); G8_STB(0, 1, 0); G8_STA(0, 1, 0);
    if (wr == 1) G8_BAR;
    G8_WV(4); G8_BAR;
    G8_STB(1, 0, 1); G8_STA(1, 0, 1); G8_STB(1, 1, 1);
    G8_WV(6); G8_BAR;
    for (int t = 0; t < nt - 2; t += 2) {
        G8_LDB(B0, 0, 0); G8_SCHED; G8_LDA(At, 0, 0); G8_STA(1, 1, t + 1);
        G8_WL(8); G8_BAR; G8_WL(0); G8_MMA(0, 0, At, B0); G8_BAR; G8_SCHED;
        G8_LDB(B1, 0, 1); G8_STB(0, 0, t + 2);
        G8_BAR; G8_WL(0); G8_MMA(0, 1, At, B1); G8_BAR;
        G8_LDA(At, 0, 1); G8_STA(0, 0, t + 2);
        G8_BAR; G8_WL(0); G8_MMA(1, 0, At, B0); G8_BAR; G8_SCHED;
        G8_STB(0, 1, t + 2);
        G8_WV(6); G8_BAR; G8_MMA(1, 1, At, B1); G8_BAR;
        G8_LDB(B0, 1, 0); G8_SCHED; G8_LDA(At, 1, 0); G8_STA(0, 1, t + 2);
        G8_WL(8); G8_BAR; G8_WL(0); G8_MMA(0, 0, At, B0); G8_BAR; G8_SCHED;
        G8_LDB(B1, 1, 1); G8_STB(1, 0, t + 3);
        G8_BAR; G8_WL(0); G8_MMA(0, 1, At, B1); G8_BAR;
        G8_LDA(At, 1, 1); G8_STA(1, 0, t + 3);
        G8_BAR; G8_WL(0); G8_MMA(1, 0, At, B0); G8_BAR; G8_SCHED;
        G8_STB(1, 1, t + 3);
        G8_WV(6); G8_BAR; G8_MMA(1, 1, At, B1); G8_BAR;
    }
    { G8_LDB(B0, 0, 0); G8_WV(0); G8_LDA(At, 0, 0); G8_STA(1, 1, nt - 1);
      G8_BAR; G8_WL(0); G8_MMA(0, 0, At, B0); G8_BAR;
      G8_LDB(B1, 0, 1); G8_BAR; G8_WL(0); G8_MMA(0, 1, At, B1); G8_BAR;
      G8_LDA(At, 0, 1); G8_WV(4); G8_BAR; G8_WL(0); G8_MMA(1, 0, At, B0); G8_MMA(1, 1, At, B1); G8_BAR; }
    { G8_LDB(B0, 1, 0); G8_LDA(At, 1, 0); G8_WV(2); G8_BAR; G8_WL(0); G8_MMA(0, 0, At, B0); G8_BAR;
      G8_LDB(B1, 1, 1); G8_WV(0); G8_BAR; G8_WL(0); G8_MMA(0, 1, At, B1); G8_BAR;
      G8_LDA(At, 1, 1); G8_BAR; G8_WL(0); G8_MMA(1, 0, At, B0); G8_MMA(1, 1, At, B1); G8_BAR; }
    if (wr == 0) G8_BAR;
#undef G8_SA
#undef G8_SB
#undef G8_STA
#undef G8_STB
#undef G8_LDA
#undef G8_LDB
#undef G8_MMA
#undef G8_WV
#undef G8_WL
#undef G8_BAR
#undef G8_SCHED
    __builtin_amdgcn_sched_barrier(0);
    { const int tz = tid_fresh(), wz = __builtin_amdgcn_readfirstlane(tz >> 6), lz = tz & 63;
      epi(acc, wz >> 2, wz & 3, lz & 15, lz >> 4); }
}
struct Epi8PG { u16* PG; int tok0, col0;
    __device__ __forceinline__ void operator()(const f32x4 (&acc)[2][2][4][2], int wr, int wc, int fr, int fq) const {
#pragma unroll
        for (int ai = 0; ai < 2; ++ai)
#pragma unroll
            for (int m = 0; m < 4; ++m) { u16* rowp = PG + (size_t)(tok0 + ai * 128 + wr * 64 + m * 16 + fr) * 5120 + col0 + wc * 32 + 8 * fq;
#pragma unroll
                for (int bj = 0; bj < 2; ++bj) { const f32x4 v0 = acc[ai][bj][m][0], v1 = acc[ai][bj][m][1];
                    *(u32x4*)(rowp + bj * 128) = (u32x4){pk_bf16(v0[0], v0[1]), pk_bf16(v0[2], v0[3]), pk_bf16(v1[0], v1[1]), pk_bf16(v1[2], v1[3])}; } }
    } };
struct Epi8HYT { u16* HYT; int tok0, col0;
    __device__ __forceinline__ void operator()(const f32x4 (&acc)[2][2][4][2], int wr, int wc, int fr, int fq) const {
#pragma unroll
        for (int bj = 0; bj < 2; ++bj)
#pragma unroll
            for (int n = 0; n < 2; ++n) { u16* colp = HYT + (size_t)(col0 + bj * 128 + wc * 32 + perm32(n * 16 + fr)) * NTOK + tok0 + wr * 64 + 4 * fq;
#pragma unroll
                for (int ai = 0; ai < 2; ++ai)
#pragma unroll
                    for (int m = 0; m < 4; ++m) { const f32x4 v = acc[ai][bj][m][n]; *(u32x2*)(colp + ai * 128 + m * 16) = (u32x2){pk_bf16(v[0], v[1]), pk_bf16(v[2], v[3])}; } }
    } };
struct Epi8X1 { const float* x; float* X1; int tok0, col0;
    __device__ __forceinline__ void operator()(const f32x4 (&acc)[2][2][4][2], int wr, int wc, int fr, int fq) const {
#pragma unroll
        for (int ai = 0; ai < 2; ++ai)
#pragma unroll
            for (int m = 0; m < 4; ++m) { const size_t off = (size_t)(tok0 + ai * 128 + wr * 64 + m * 16 + fr) * DM + col0 + wc * 32 + 8 * fq;
#pragma unroll
                for (int bj = 0; bj < 2; ++bj)
#pragma unroll
                    for (int n = 0; n < 2; ++n) { const f32x4 r = *(const f32x4*)(x + off + bj * 128 + n * 4); *(f32x4*)(X1 + off + bj * 128 + n * 4) = r + acc[ai][bj][m][n]; }
                asm volatile("" ::: "memory"); }
    } };
struct Epi8Swiglu { u16* HM; const float* b1; int slot0, nt, rows_valid;
    __device__ __forceinline__ void operator()(const f32x4 (&acc)[2][2][4][2], int wr, int wc, int fr, int fq) const {
        f32x4 bg[2], bl[2];
#pragma unroll
        for (int n = 0; n < 2; ++n) { const int col = nt * 128 + wc * 32 + 8 * fq + 4 * n; bg[n] = *(const f32x4*)(b1 + col); bl[n] = *(const f32x4*)(b1 + 2048 + col); }
#pragma unroll
        for (int ai = 0; ai < 2; ++ai)
#pragma unroll
            for (int m = 0; m < 4; ++m) { const int row = ai * 128 + wr * 64 + m * 16 + fr;
                if (row < rows_valid) { float o[8];
#pragma unroll
                    for (int n = 0; n < 2; ++n) { const f32x4 gl = acc[ai][0][m][n] + bg[n], li = acc[ai][1][m][n] + bl[n];
#pragma unroll
                        for (int j = 0; j < 4; ++j) { const float gq = fminf(gl[j], 7.0f), lq = fminf(fmaxf(li[j], -7.0f), 7.0f); o[4 * n + j] = gq * (1.0f / (1.0f + __expf(-1.702f * gq))) * (lq + 1.0f); } }
                    *(u32x4*)(HM + (size_t)(slot0 + row) * DFF + nt * 128 + wc * 32 + 8 * fq) = (u32x4){pk_bf16(o[0], o[1]), pk_bf16(o[2], o[3]), pk_bf16(o[4], o[5]), pk_bf16(o[6], o[7])}; } }
    } };
struct Epi8Swiglu8 { unsigned char* HM; const float* b1; int slot0, nt, rows_valid;
    __device__ __forceinline__ void operator()(const f32x4 (&acc)[2][2][4][2], int wr, int wc, int fr, int fq) const {
        f32x4 bg[2], bl[2];
#pragma unroll
        for (int n = 0; n < 2; ++n) { const int col = nt * 128 + wc * 32 + 8 * fq + 4 * n; bg[n] = *(const f32x4*)(b1 + col); bl[n] = *(const f32x4*)(b1 + 2048 + col); }
#pragma unroll
        for (int ai = 0; ai < 2; ++ai)
#pragma unroll
            for (int m = 0; m < 4; ++m) { const int row = ai * 128 + wr * 64 + m * 16 + fr;
                if (row < rows_valid) { float o[8];
#pragma unroll
                    for (int n = 0; n < 2; ++n) { const f32x4 gl = acc[ai][0][m][n] + bg[n], li = acc[ai][1][m][n] + bl[n];
#pragma unroll
                        for (int j = 0; j < 4; ++j) { const float gq = fminf(gl[j], 7.0f), lq = fminf(fmaxf(li[j], -7.0f), 7.0f); o[4 * n + j] = gq * (1.0f / (1.0f + __expf(-1.702f * gq))) * (lq + 1.0f); } }
                    *(u32x2*)(HM + (size_t)(slot0 + row) * DFF + nt * 128 + wc * 32 + 8 * fq) = (u32x2){pk_fp8x4(o[0], o[1], o[2], o[3]), pk_fp8x4(o[4], o[5], o[6], o[7])}; } }
    } };
struct Epi8Y { u16* Y; const float* b2; int slot0, col0, rows_valid;
    __device__ __forceinline__ void operator()(const f32x4 (&acc)[2][2][4][2], int wr, int wc, int fr, int fq) const {
        f32x4 bv[2][2];
#pragma unroll
        for (int bj = 0; bj < 2; ++bj)
#pragma unroll
            for (int n = 0; n < 2; ++n) bv[bj][n] = *(const f32x4*)(b2 + col0 + bj * 128 + wc * 32 + 8 * fq + 4 * n);
#pragma unroll
        for (int ai = 0; ai < 2; ++ai)
#pragma unroll
            for (int m = 0; m < 4; ++m) { const int row = ai * 128 + wr * 64 + m * 16 + fr;
                if (row < rows_valid) { u16* rowp = Y + (size_t)(slot0 + row) * DM + col0 + wc * 32 + 8 * fq;
#pragma unroll
                    for (int bj = 0; bj < 2; ++bj) { const f32x4 v0 = acc[ai][bj][m][0] + bv[bj][0], v1 = acc[ai][bj][m][1] + bv[bj][1];
                        *(u32x4*)(rowp + bj * 128) = (u32x4){pk_bf16(v0[0], v0[1]), pk_bf16(v0[2], v0[3]), pk_bf16(v1[0], v1[1]), pk_bf16(v1[2], v1[3])}; } } }
    } };
struct EpiNone { __device__ __forceinline__ void operator()(const f32x4 (&acc)[2][2][4][2], int wr, int wc, int fr, int fq) const {
#pragma unroll
        for (int a = 0; a < 2; ++a)
#pragma unroll
            for (int b = 0; b < 2; ++b)
#pragma unroll
                for (int m = 0; m < 4; ++m)
#pragma unroll
                    for (int n = 0; n < 2; ++n) asm volatile("" :: "v"(acc[a][b][m][n]));
    } };

typedef float f32x16 __attribute__((ext_vector_type(16)));
__device__ __forceinline__ void h3_row(int m, const float* __restrict__ w1, const float* __restrict__ b1, const float* __restrict__ w2, const float* __restrict__ b2,
                                       const float* __restrict__ w3, const float* __restrict__ b3, const float* __restrict__ freq, LAS float* sc  , float* __restrict__ H3) {
    const int j = tid_fresh() & 63;
    const float tt = (float)m / (float)(SEQ - 1);
    if (j == 0) sc[0] = tt;
    if (j >= 1 && j <= 16) { const int i = j - 1; const float band = 1e-4f + (float)i * ((15.0f - 1e-4f) / 15.0f); const float ang = (2.0f * 3.14159265358979323846f / (float)SEQ) * (float)m * band; sc[1 + i] = cosf(ang); sc[17 + i] = -sinf(ang); }
    __builtin_amdgcn_wave_barrier();
    const float fr = freq[j];
    float s = b1[j];
    for (int i = 0; i < 33; ++i) s += sc[i] * w1[i * 64 + j];
    const float h1 = sinf(fr * s);
    sc[64 + j] = h1;
    __builtin_amdgcn_wave_barrier();
    s = b2[j];
    for (int i = 0; i < 64; ++i) s += sc[64 + i] * w2[i * 64 + j];
    const float h2 = sinf(fr * s);
    __builtin_amdgcn_wave_barrier();
    sc[j] = h2;
    __builtin_amdgcn_wave_barrier();
    s = b3[j];
    for (int i = 0; i < 64; ++i) s += sc[i] * w3[i * 64 + j];
    H3[(size_t)m * 64 + j] = sinf(fr * s);
    __builtin_amdgcn_wave_barrier();
}
constexpr int FR_LEN = 4128;
__device__ __forceinline__ void frgen_item(int item, const float* __restrict__ H3, const float* __restrict__ w4, u16* __restrict__ FR, LAS float* hs  ) {
    const int tid = tid_fresh(), m0 = item * 8;
    for (int x = tid; x < 11 * 64; x += 512) { const int q = x >> 6, i = x & 63; int m = m0 - 1 + q; m = m < 0 ? 0 : (m > SEQ - 1 ? SEQ - 1 : m); hs[i * 12 + q] = H3[(size_t)m * 64 + i]; }
    __syncthreads();
    const float mind = logf(1e-2f) / 0.3f, maxd = logf(1e-2f) / 1.5f;
    for (int p = 0; p < 4; ++p) {
        const int oc = tid + p * 512, o = oc >> 10, c = oc & 1023;
        const float* wf = w4 + o * 2048 + c; const float* wb = wf + 1024;
        float af[12], ab[12];
#pragma unroll
        for (int q = 0; q < 12; ++q) { af[q] = 0.f; ab[q] = 0.f; }
#pragma unroll 4
        for (int i = 0; i < 64; ++i) {
            const float xf = wf[(size_t)i * 4096], xb = wb[(size_t)i * 4096];
            const f32x4 h0 = *(const LAS f32x4*)(hs + i * 12), h1 = *(const LAS f32x4*)(hs + i * 12 + 4), h2 = *(const LAS f32x4*)(hs + i * 12 + 8);
#pragma unroll
            for (int q = 0; q < 4; ++q) { af[q] = fmaf(h0[q], xf, af[q]); ab[q] = fmaf(h0[q], xb, ab[q]); af[4 + q] = fmaf(h1[q], xf, af[4 + q]); ab[4 + q] = fmaf(h1[q], xb, ab[4 + q]);
                af[8 + q] = fmaf(h2[q], xf, af[8 + q]); ab[8 + q] = fmaf(h2[q], xb, ab[8 + q]); }
        }
        const float delta = fabsf(mind + (float)c * ((maxd - mind) / 1023.0f));
#pragma unroll
        for (int q = 0; q < 11; ++q) { const int m = m0 - 1 + q; const float wv = (m >= 0 && m <= SEQ - 1) ? __expf(-((float)m / (float)(SEQ - 1)) * delta) : 0.f; af[q] *= wv; ab[q] *= wv; }
        u16* base = FR + (size_t)(oc * 2) * FR_LEN;
        u32x4 w;
        w[0] = pk_bf16(af[8], af[7]); w[1] = pk_bf16(af[6], af[5]); w[2] = pk_bf16(af[4], af[3]); w[3] = pk_bf16(af[2], af[1]);
        *(u32x4*)(base + 2040 - m0) = w;
        const float last = (m0 == 0) ? ab[2] : af[0];
        w[0] = pk_bf16(af[7], af[6]); w[1] = pk_bf16(af[5], af[4]); w[2] = pk_bf16(af[3], af[2]); w[3] = pk_bf16(af[1], last);
        *(u32x4*)(base + FR_LEN + 2040 - m0) = w;
        w[0] = pk_bf16(ab[2], ab[3]); w[1] = pk_bf16(ab[4], ab[5]); w[2] = pk_bf16(ab[6], ab[7]); w[3] = pk_bf16(ab[8], ab[9]);
        *(u32x4*)(base + 2048 + m0) = w;
        w[0] = pk_bf16(ab[3], ab[4]); w[1] = pk_bf16(ab[5], ab[6]); w[2] = pk_bf16(ab[7], ab[8]); w[3] = pk_bf16(ab[9], ab[10]);
        *(u32x4*)(base + FR_LEN + 2048 + m0) = w;
        if (item == 255) {
            const u32x4 z = {0u, 0u, 0u, 0u};
#pragma unroll
            for (int q = 0; q < 4; ++q) { *(u32x4*)(base + 4096 + q * 8) = z; *(u32x4*)(base + FR_LEN + 4096 + q * 8) = z; }
        }
    }
    __syncthreads();
}
constexpr int HY_ZSTRIDE = 2312;
constexpr int HY_ZCH = 256 + 4 * HY_ZSTRIDE;
constexpr int HY_ZBYTES = HY_ZCH * 2;
constexpr int HY_FB = 4 * HY_ZBYTES;
constexpr int HY_FCH = 2 * FR_LEN * 2;
constexpr int HY_LDS = HY_FB + 4 * HY_FCH;

__device__ __forceinline__ void hy_load_row(LAS unsigned char* lds, int dest, int boff0, int bstride, const u16* __restrict__ row, float w0, float w1, float w2, float cb, int pl) {
#pragma unroll 2
    for (int it = 0; it < 8; ++it) {
        const int idx = pl + 128 * it, tok0 = idx * 8, b = tok0 >> 11, n0 = tok0 & 2047;
        const u32x4 raw = *(const u32x4*)(row + tok0);
        const float pm = (n0 > 0) ? bf2f(row[tok0 - 1]) : 0.f;
        const float pn = (n0 + 8 < SEQ) ? bf2f(row[tok0 + 8]) : 0.f;
        float p[10];
        p[0] = pm; p[9] = pn;
#pragma unroll
        for (int q = 0; q < 4; ++q) { p[1 + 2 * q] = bflo(raw[q]); p[2 + 2 * q] = bfhi(raw[q]); }
        float o[8];
#pragma unroll
        for (int q = 0; q < 8; ++q) o[q] = fmaf(w0, p[q], fmaf(w1, p[q + 1], fmaf(w2, p[q + 2], cb)));
        u32x4 w; w[0] = pk_bf16(o[0], o[1]); w[1] = pk_bf16(o[2], o[3]); w[2] = pk_bf16(o[4], o[5]); w[3] = pk_bf16(o[6], o[7]);
        *(LAS u32x4*)(lds + dest + (boff0 + b * bstride + n0) * 2) = w;
    }
}
__device__ __forceinline__ void hy_load_filters(LAS unsigned char* lds, int fb, const u16* __restrict__ src, int pl) {
    for (int idx = pl; idx < HY_FCH / 16; idx += 128) *(LAS u32x4*)(lds + fb + idx * 16) = *(const u32x4*)((const char*)src + idx * 16);
}
__device__ __forceinline__ void hy_mfma_loop(LAS unsigned char* lds, int zb, int fb, int hlf, int lane, f32x16 (&acc)[4], const ConvCtx& cc, int mbase, int cunit, int wid) {
    const int r = lane & 31, hh = lane >> 5, il = r >> 2, b = r & 3;
    const int bbase = zb + (256 + b * HY_ZSTRIDE + 32 * il + 8 * hh) * 2;
    const int xl = 2047 - r + 8 * hh - 1024 * hlf;
    const int abase = (r & 1) ? (fb + 2 * xl) : (fb + FR_LEN * 2 + 2 * (xl - 1));
#pragma unroll
    for (int q = 0; q < 4; ++q)
#pragma unroll
        for (int i = 0; i < 16; ++i) acc[q][i] = 0.f;
    for (int d0 = 0; d0 < 8; ++d0) {
#pragma unroll
        for (int ks = 0; ks < 2; ++ks) {
            f32x2 cv[16];
            const int mcv = conv_seq2tile((mbase + d0 * 2 + ks) * 256 + cunit);
            conv_issue(cc, mcv, wid, lane, cv);
            bf16x8 Bt[9];
#pragma unroll
            for (int j = 0; j < 9; ++j) Bt[j] = *(const LAS bf16x8*)(lds + bbase + 512 * j - 64 * d0 + 32 * ks);
#pragma unroll
            for (int ep = -8; ep <= 3; ++ep) {
                const LAS unsigned* ap = (const LAS unsigned*)(lds + abase - 64 * d0 - 512 * ep + 32 * ks);
                u32x4 av; av[0] = ap[0]; av[1] = ap[1]; av[2] = ap[2]; av[3] = ap[3];
                const bf16x8 a = __builtin_bit_cast(bf16x8, av);
#pragma unroll
                for (int ctl = 0; ctl < 4; ++ctl) { const int jt = ctl - ep; if (jt >= 0 && jt <= 8) acc[ctl] = __builtin_amdgcn_mfma_f32_32x32x16_bf16(a, Bt[jt], acc[ctl], 0, 0, 0); }
            }
            conv_finish(cc, mcv, wid, lane, cv);
        }
    }
}
__device__ __forceinline__ void hy_epilogue(LAS unsigned char* lds, int zb, int gb, int hlf, int lane, const f32x16 (&acc)[4], float bias) {
    const int r = lane & 31, hh = lane >> 5, il = r >> 2, b = r & 3;
#pragma unroll
    for (int ctl = 0; ctl < 4; ++ctl) {
        const int I = 8 * (4 * hlf + ctl) + il;
#pragma unroll
        for (int q = 0; q < 4; ++q) {
            const int n4 = 32 * I + 8 * q + 4 * hh;
            LAS u32x2* zp = (LAS u32x2*)(lds + zb + (256 + b * HY_ZSTRIDE + n4) * 2);
            const u32x2 zv = *zp, gv = *(const LAS u32x2*)(lds + gb + (b * 2048 + n4) * 2);
            const float z0 = bflo(zv[0]), z1 = bfhi(zv[0]), z2 = bflo(zv[1]), z3 = bfhi(zv[1]);
            const float g0 = bflo(gv[0]), g1 = bfhi(gv[0]), g2 = bflo(gv[1]), g3 = bfhi(gv[1]);
            u32x2 o; o[0] = pk_bf16(g0 * fmaf(bias, z0, acc[ctl][4 * q + 0]), g1 * fmaf(bias, z1, acc[ctl][4 * q + 1]));
            o[1] = pk_bf16(g2 * fmaf(bias, z2, acc[ctl][4 * q + 2]), g3 * fmaf(bias, z3, acc[ctl][4 * q + 3]));
            *zp = o;
        }
    }
}
__device__ __forceinline__ void hyena_unit(LAS unsigned char* lds, int unit, const u16* __restrict__ HYT, const u16* __restrict__ FR, const float* __restrict__ cw, const float* __restrict__ cbv,
                                           const float* __restrict__ hbias, u16* __restrict__ Z2T, const ConvCtx& cc) {
    const int tid = tid_fresh(), wid = __builtin_amdgcn_readfirstlane(tid >> 6), lane = tid & 63;
    const int cs = wid & 3, hlf = wid >> 2, c = unit * 4 + cs, pl = lane + 64 * hlf;
    const int zb = cs * HY_ZBYTES, fb = HY_FB + cs * HY_FCH;
    { const u32x4 z = {0u, 0u, 0u, 0u}; for (int idx = pl; idx < HY_ZBYTES / 16; idx += 128) *(LAS u32x4*)(lds + zb + idx * 16) = z; }
    __syncthreads();
    hy_load_row(lds, zb, 256, HY_ZSTRIDE, HYT + (size_t)c * NTOK, cw[0 * 3072 + c], cw[1 * 3072 + c], cw[2 * 3072 + c], cbv[c], pl);
    f32x16 acc[4];
#pragma unroll
    for (int o = 0; o < 2; ++o) {
        hy_load_filters(lds, fb, FR + (size_t)((o * 1024 + c) * 2) * FR_LEN, pl);
        __syncthreads();
        hy_mfma_loop(lds, zb, fb, hlf, lane, acc, cc, o * 16, unit, wid);
        __syncthreads();
        const int gc = (1 + o) * 1024 + c;
        hy_load_row(lds, fb, 0, 2048, HYT + (size_t)gc * NTOK, cw[0 * 3072 + gc], cw[1 * 3072 + gc], cw[2 * 3072 + gc], cbv[gc], pl);
        __syncthreads();
        hy_epilogue(lds, zb, fb, hlf, lane, acc, hbias[o * HYW + c]);
        __syncthreads();
    }
#pragma unroll 2
    for (int it = 0; it < 8; ++it) { const int idx = pl + 128 * it, tok0 = idx * 8, b = tok0 >> 11, n0 = tok0 & 2047;
        *(u32x4*)(Z2T + (size_t)c * NTOK + tok0) = *(const LAS u32x4*)(lds + zb + (256 + b * HY_ZSTRIDE + n0) * 2); }
    __syncthreads();
}

constexpr int HG_RAWQ = 0, HG_RAWF = 16384, HG_RAWV = 32768;
constexpr int HG_QM = 36864, HG_KM = HG_QM + 17408, HG_QI = HG_KM + 17408;
constexpr int HG_KL = HG_QI + 17408;
constexpr int HG_VT = HG_KL + 18432;
constexpr int HG_P = HG_VT + 4608;
constexpr int HG_ST = HG_P + 9216;
constexpr int HG_TOT = HG_ST + 8704;
constexpr int HG_EL2 = HG_TOT + 2048;
constexpr int HG_LDS = HG_EL2 + 512;

__device__ __forceinline__ void hgrn_unit(LAS unsigned char* lds, int unit, const u16* __restrict__ PG, const float* __restrict__ lb_logits, float* __restrict__ OF, float* __restrict__ OB, const ConvCtx& cc) {
    const int tid = tid_fresh(), wid = __builtin_amdgcn_readfirstlane(tid >> 6), lane = tid & 63, fr = lane & 15, fq = lane >> 4;
    const int vq = unit & 3, dir = (unit >> 2) & 1, h = (unit >> 3) & 7, b = unit >> 6;
    const int k = tid & 127, seg = tid >> 7;
    float* __restrict__ O = dir ? OB : OF;
    float lb;
    { const int c = h * 128 + k; const float l0 = lb_logits[(0 * 2 + dir) * HGW + c], l1 = lb_logits[(1 * 2 + dir) * HGW + c]; lb = 1.0f / (1.0f + __expf(l1 - l0)); }
    for (int i = tid; i < 8704 / 16; i += 512) *(LAS u32x4*)(lds + HG_ST + i * 16) = (u32x4){0u, 0u, 0u, 0u};
    f32x4 Sacc[2];
    Sacc[0] = (f32x4){0.f, 0.f, 0.f, 0.f}; Sacc[1] = Sacc[0];
    u32x4 pq[2], pf[2], pv;
    const int colq = h * 128, colf = (1 + dir) * 1024 + h * 128, colv = 3072 + h * 128 + vq * 32;
#define HG_TOK(c, tau) ((size_t)b * SEQ + (dir ? (SEQ - 1 - 64 * (c) - (tau)) : (64 * (c) + (tau))))
#define HG_PREFETCH(c) do { _Pragma("unroll") for (int _i = 0; _i < 2; ++_i) { const int _x = tid + 512 * _i, _tau = _x >> 4, _p = _x & 15; const u16* _r = PG + HG_TOK(c, _tau) * 5120; \
            pq[_i] = *(const u32x4*)(_r + colq + _p * 8); pf[_i] = *(const u32x4*)(_r + colf + _p * 8); } \
        if (tid < 256) { const int _tau = tid >> 2, _p = tid & 3; pv = *(const u32x4*)(PG + HG_TOK(c, _tau) * 5120 + colv + _p * 8); } } while (0)
    HG_PREFETCH(0);
    for (int c = 0; c < 32; ++c) {
#pragma unroll
        for (int i = 0; i < 2; ++i) { const int x = tid + 512 * i; *(LAS u32x4*)(lds + HG_RAWQ + x * 16) = pq[i]; *(LAS u32x4*)(lds + HG_RAWF + x * 16) = pf[i]; }
        if (tid < 256) *(LAS u32x4*)(lds + HG_RAWV + tid * 16) = pv;
        if (c + 1 < 32) HG_PREFETCH(c + 1);
        f32x2 cv[16];
        const int mqa = conv_seq2tile((32 + c * 2) * 256 + unit), mqb = conv_seq2tile((33 + c * 2) * 256 + unit);
        conv_issue(cc, mqa, wid, lane, cv);
        __syncthreads();
        float qv[16], kv[16], bl[16];
        { float run = 0.f;
#pragma unroll
          for (int i = 0; i < 16; ++i) { const int tau = seg * 16 + i;
              const float qr = bf2f(*(const LAS u16*)(lds + HG_RAWQ + tau * 256 + k * 2)), zf = bf2f(*(const LAS u16*)(lds + HG_RAWF + tau * 256 + k * 2));
              const float sg = 1.0f / (1.0f + __expf(-zf)); const float f = lb + (1.0f - lb) * sg;
              run += __logf(f); bl[i] = run; kv[i] = 1.0f - f; qv[i] = qr / (1.0f + __expf(-qr)); }
          *(LAS float*)(lds + HG_TOT + (seg * 128 + k) * 4) = run; }
        __syncthreads();
        { const float t0 = *(const LAS float*)(lds + HG_TOT + (0 * 128 + k) * 4), t1 = *(const LAS float*)(lds + HG_TOT + (1 * 128 + k) * 4),
                      t2 = *(const LAS float*)(lds + HG_TOT + (2 * 128 + k) * 4), t3 = *(const LAS float*)(lds + HG_TOT + (3 * 128 + k) * 4);
          const float pre = (seg > 0 ? t0 : 0.f) + (seg > 1 ? t1 : 0.f) + (seg > 2 ? t2 : 0.f);
          const float bref = t0 + t1, blast = bref + t2 + t3;
          const float er = __expf(bref), el = __expf(blast - bref);
          if (seg == 0) *(LAS float*)(lds + HG_EL2 + k * 4) = __expf(blast);
          unsigned klp[8];
#pragma unroll
          for (int i = 0; i < 16; i += 2) {
              float klv[2];
#pragma unroll
              for (int u = 0; u < 2; ++u) { const int tau = seg * 16 + i + u; const float bb = pre + bl[i + u];
                  const float e1 = __expf(bb - bref), e2 = __expf(bref - bb);
                  const float qm = qv[i + u] * e1, km = kv[i + u] * e2;
                  *(LAS u16*)(lds + HG_QM + tau * 272 + k * 2) = (u16)(pk_bf16(qm, 0.f) & 0xffffu);
                  *(LAS u16*)(lds + HG_KM + tau * 272 + k * 2) = (u16)(pk_bf16(km, 0.f) & 0xffffu);
                  *(LAS u16*)(lds + HG_QI + tau * 272 + k * 2) = (u16)(pk_bf16(qm * er, 0.f) & 0xffffu);
                  klv[u] = km * el; }
              klp[i >> 1] = pk_bf16(klv[0], klv[1]); }
          *(LAS u32x4*)(lds + HG_KL + k * 144 + seg * 32) = (u32x4){klp[0], klp[1], klp[2], klp[3]};
          *(LAS u32x4*)(lds + HG_KL + k * 144 + seg * 32 + 16) = (u32x4){klp[4], klp[5], klp[6], klp[7]};
          { const int v = tid & 31, tg = tid >> 5; unsigned short e[4];
#pragma unroll
            for (int u = 0; u < 4; ++u) e[u] = *(const LAS u16*)(lds + HG_RAWV + (tg * 4 + u) * 64 + v * 2);
            *(LAS u32x2*)(lds + HG_VT + v * 144 + tg * 8) = (u32x2){(unsigned)e[0] | ((unsigned)e[1] << 16), (unsigned)e[2] | ((unsigned)e[3] << 16)}; } }
        conv_finish(cc, mqa, wid, lane, cv);
        conv_issue(cc, mqb, wid, lane, cv);
        __syncthreads();
#pragma unroll
        for (int q = 0; q < 2; ++q) { const int idx = wid * 2 + q, ti = idx >> 2, si = idx & 3;
            f32x4 a = {0.f, 0.f, 0.f, 0.f};
            if (si <= ti) {
#pragma unroll
                for (int ks = 0; ks < 4; ++ks) { const bf16x8 ka = *(const LAS bf16x8*)(lds + HG_KM + (si * 16 + fr) * 272 + (ks * 32 + fq * 8) * 2), qb = *(const LAS bf16x8*)(lds + HG_QM + (ti * 16 + fr) * 272 + (ks * 32 + fq * 8) * 2);
                    a = __builtin_amdgcn_mfma_f32_16x16x32_bf16(ka, qb, a, 0, 0, 0); } }
            const int tau = ti * 16 + fr, s0 = si * 16 + fq * 4;
            float pvv[4];
#pragma unroll
            for (int j = 0; j < 4; ++j) pvv[j] = (si <= ti && s0 + j <= tau) ? a[j] : 0.f;
            *(LAS u32x2*)(lds + HG_P + tau * 144 + s0 * 2) = (u32x2){pk_bf16(pvv[0], pvv[1]), pk_bf16(pvv[2], pvv[3])}; }
        const int ti = wid >> 1, vi = wid & 1;
        f32x4 oacc = {0.f, 0.f, 0.f, 0.f};
#pragma unroll
        for (int ks = 0; ks < 4; ++ks) { const bf16x8 qa = *(const LAS bf16x8*)(lds + HG_QI + (ti * 16 + fr) * 272 + (ks * 32 + fq * 8) * 2), sb = *(const LAS bf16x8*)(lds + HG_ST + (vi * 16 + fr) * 272 + (ks * 32 + fq * 8) * 2);
            oacc = __builtin_amdgcn_mfma_f32_16x16x32_bf16(qa, sb, oacc, 0, 0, 0); }
        { const f32x4 e2 = *(const LAS f32x4*)(lds + HG_EL2 + (wid * 16 + fq * 4) * 4);
#pragma unroll
          for (int v2 = 0; v2 < 2; ++v2) { Sacc[v2] = Sacc[v2] * e2;
#pragma unroll
              for (int ks = 0; ks < 2; ++ks) { const bf16x8 ka = *(const LAS bf16x8*)(lds + HG_KL + (wid * 16 + fr) * 144 + (ks * 32 + fq * 8) * 2), vb = *(const LAS bf16x8*)(lds + HG_VT + (v2 * 16 + fr) * 144 + (ks * 32 + fq * 8) * 2);
                  Sacc[v2] = __builtin_amdgcn_mfma_f32_16x16x32_bf16(ka, vb, Sacc[v2], 0, 0, 0); } } }
        __syncthreads();
#pragma unroll
        for (int ks = 0; ks < 2; ++ks) { const bf16x8 pa = *(const LAS bf16x8*)(lds + HG_P + (ti * 16 + fr) * 144 + (ks * 32 + fq * 8) * 2), vb = *(const LAS bf16x8*)(lds + HG_VT + (vi * 16 + fr) * 144 + (ks * 32 + fq * 8) * 2);
            oacc = __builtin_amdgcn_mfma_f32_16x16x32_bf16(pa, vb, oacc, 0, 0, 0); }
#pragma unroll
        for (int j = 0; j < 4; ++j) { const int tau = ti * 16 + fq * 4 + j; O[HG_TOK(c, tau) * HGW + h * 128 + vq * 32 + vi * 16 + fr] = oacc[j]; }
        conv_finish(cc, mqb, wid, lane, cv);
#pragma unroll
        for (int v2 = 0; v2 < 2; ++v2) *(LAS u32x2*)(lds + HG_ST + (v2 * 16 + fr) * 272 + (wid * 16 + fq * 4) * 2) = (u32x2){pk_bf16(Sacc[v2][0], Sacc[v2][1]), pk_bf16(Sacc[v2][2], Sacc[v2][3])};
    }
    __syncthreads();
#undef HG_TOK
#undef HG_PREFETCH
}


#define XB_TMO      128
#define XB_XCNT(j)  (256  + 64 * (j))
#define XB_XSUB(j)  (1280 + 64 * (j))
#define XB_XGEN(j)  (2304 + 64 * (j))
#define XB_TOP      3328
#define XB_TOPGEN   3392
#define XCD_BAR_WORDS 3456
#define XB_SPIN_CAP (1u << 22)

__device__ __forceinline__ unsigned xb_ld(unsigned* p)              { return __hip_atomic_load(p, __ATOMIC_RELAXED, __HIP_MEMORY_SCOPE_AGENT); }
__device__ __forceinline__ unsigned xb_add(unsigned* p, unsigned v) { return __hip_atomic_fetch_add(p, v, __ATOMIC_RELAXED, __HIP_MEMORY_SCOPE_AGENT); }
__device__ __forceinline__ unsigned xb_xcc_id() { return (unsigned)__builtin_amdgcn_s_getreg((3 << 11) | 20) & 0xFu; }
#define XB_SPIN(cond, bar) do { unsigned _sp = 0; while (cond) { __builtin_amdgcn_s_sleep(1); \
    if ((++_sp & 255u) == 0u) { if (xb_ld(&(bar)[XB_TMO])) break; if (_sp > XB_SPIN_CAP) { atomicAdd(&(bar)[XB_TMO], 1u); break; } } } } while (0)

struct XcdBarrier {
    unsigned* bar; unsigned x;
    volatile LAS unsigned* st;
};

__device__ __forceinline__ XcdBarrier xcd_barrier_post(unsigned* bar, volatile LAS unsigned* st) {
    XcdBarrier b; b.bar = bar; b.x = xb_xcc_id(); b.st = st;
    if (threadIdx.x == 0) (void)xb_add(&bar[XB_XCNT(b.x)], 1u);
    return b;
}
__device__ __forceinline__ void xcd_barrier_complete(unsigned* bar, unsigned x, unsigned& nloc, unsigned& nx) {
    const unsigned G = gridDim.x * gridDim.y * gridDim.z;
    unsigned sum, cnt, mine, sp = 0u;
    for (;;) {
        sum = 0u; cnt = 0u; mine = 0u;
#pragma unroll
        for (unsigned j = 0; j < 16; ++j) { const unsigned c = xb_ld(&bar[XB_XCNT(j)]); sum += c; cnt += (c > 0u) ? 1u : 0u; mine = (j == x) ? c : mine; }
        if (sum == G) break;
        __builtin_amdgcn_s_sleep(1);
        if ((++sp & 255u) == 0u) { if (xb_ld(&bar[XB_TMO])) break; if (sp > XB_SPIN_CAP) { atomicAdd(&bar[XB_TMO], 1u); break; } }
    }
    nloc = mine > 0u ? mine : 1u; nx = cnt > 0u ? cnt : 1u;
}

__device__ __forceinline__ void xcd_barrier(const XcdBarrier& b) {
    asm volatile("s_waitcnt vmcnt(0)" ::: "memory");
    __syncthreads();
    if (threadIdx.x == 0) {
        unsigned* bar = b.bar;
        __builtin_amdgcn_s_waitcnt(0);
        unsigned nloc = b.st[0], nx = b.st[1];
        if (nloc == 0u) { xcd_barrier_complete(bar, b.x, nloc, nx); b.st[0] = nloc; b.st[1] = nx; }
        const unsigned old = xb_add(&bar[XB_XSUB(b.x)], 1u);
        const unsigned gen = old / nloc;
        if (old + 1u == (gen + 1u) * nloc) {
            __builtin_amdgcn_fence(__ATOMIC_RELEASE, "agent");
            asm volatile("s_waitcnt vmcnt(0)" ::: "memory");
            const unsigned og = xb_add(&bar[XB_TOP], 1u);
            const unsigned tg = og / nx;
            if (og + 1u == (tg + 1u) * nx) xb_add(&bar[XB_TOPGEN], 1u);
            else XB_SPIN(xb_ld(&bar[XB_TOPGEN]) == tg, bar);
            __builtin_amdgcn_fence(__ATOMIC_ACQUIRE, "agent");
            xb_add(&bar[XB_XGEN(b.x)], 1u);
            asm volatile("s_waitcnt vmcnt(0)" ::: "memory");
        } else {
            XB_SPIN(xb_ld(&bar[XB_XGEN(b.x)]) == gen, bar);
            __builtin_amdgcn_fence(__ATOMIC_ACQUIRE, "agent");
            asm volatile("s_waitcnt vmcnt(0)" ::: "memory");
        }
    }
    __syncthreads();
}

__device__ __forceinline__ float wave_sum(float s) {
#pragma unroll
    for (int o = 32; o >= 1; o >>= 1) s += __shfl_xor(s, o);
    return s;
}
__device__ __forceinline__ void rmsnorm_row_bf(const float* __restrict__ xr, const float* __restrict__ gain, u16* __restrict__ ob, int lane) {
    f32x4 v[8]; float s = 0.f;
#pragma unroll
    for (int j = 0; j < 8; ++j) { v[j] = *(const f32x4*)(xr + (lane + 64 * j) * 4); s += v[j][0] * v[j][0] + v[j][1] * v[j][1] + v[j][2] * v[j][2] + v[j][3] * v[j][3]; }
    s = wave_sum(s);
    const float r = rsqrtf(s * (1.0f / (float)DM) + EPS);
#pragma unroll
    for (int j = 0; j < 8; ++j) { const f32x4 g = *(const f32x4*)(gain + (lane + 64 * j) * 4); const f32x4 o = v[j] * r * g;
        *(u32x2*)(ob + (lane + 64 * j) * 4) = (u32x2){pk_bf16(o[0], o[1]), pk_bf16(o[2], o[3])}; }
}
__device__ __forceinline__ void hgrn_final_item(int item, const float* __restrict__ OF, const float* __restrict__ OB, const u16* __restrict__ PG, const float* __restrict__ gain, u16* __restrict__ MIXB, int lane) {
    const int tok = item >> 3, h = item & 7, c = h * 128 + 2 * lane;
    const f32x2 a = *(const f32x2*)(OF + (size_t)tok * HGW + c), b = *(const f32x2*)(OB + (size_t)tok * HGW + c);
    const float o0 = a[0] + b[0], o1 = a[1] + b[1];
    const float s = wave_sum(o0 * o0 + o1 * o1);
    const float r = rsqrtf(s * (1.0f / 128.0f) + EPS);
    const unsigned gw = *(const unsigned*)(PG + (size_t)tok * 5120 + 4096 + c);
    const float g0 = bflo(gw), g1 = bfhi(gw);
    const f32x2 gn = *(const f32x2*)(gain + c);
    const float v0 = o0 * r * gn[0] * (g0 / (1.0f + __expf(-g0))), v1 = o1 * r * gn[1] * (g1 / (1.0f + __expf(-g1)));
    *(unsigned*)(MIXB + (size_t)tok * DM + c) = pk_bf16(v0, v1);
}
__device__ __forceinline__ void hy_norm_tile(LAS unsigned char* lds, int tile_i, const u16* __restrict__ Z2T, const float* __restrict__ gain, u16* __restrict__ MIXB) {
    const int t = tid_fresh(), tok0 = tile_i * 32;
    LAS float* ssq = (LAS float*)(lds + 1024 * 80);
    if (t < 32) ssq[t] = 0.f;
    __syncthreads();
    float part[8];
#pragma unroll
    for (int q = 0; q < 8; ++q) part[q] = 0.f;
    const int ch = t & 3;
#pragma unroll
    for (int it = 0; it < 8; ++it) {
        const int c = (t >> 2) + 128 * it;
        const u32x4 v = *(const u32x4*)(Z2T + (size_t)c * NTOK + tok0 + ch * 8);
        *(LAS u32x4*)(lds + c * 80 + ch * 16) = v;
#pragma unroll
        for (int q = 0; q < 4; ++q) { const float a = bflo(v[q]), b = bfhi(v[q]); part[2 * q] += a * a; part[2 * q + 1] += b * b; }
    }
#pragma unroll
    for (int q = 0; q < 8; ++q) { float s = part[q]; s += __shfl_xor(s, 4); s += __shfl_xor(s, 8); s += __shfl_xor(s, 16); s += __shfl_xor(s, 32); part[q] = s; }
    if ((t & 63) < 4) {
#pragma unroll
        for (int q = 0; q < 8; ++q) atomicAdd((float*)(ssq + ch * 8 + q), part[q]);
    }
    __syncthreads();
    const int tt = t >> 4;
    const float r = rsqrtf(ssq[tt] * (1.0f / (float)HYW) + EPS);
#pragma unroll 2
    for (int k = 0; k < 8; ++k) {
        const int c0 = ((t & 15) + 16 * k) * 8;
        float o[8];
#pragma unroll
        for (int q = 0; q < 8; ++q) o[q] = bf2f(*(const LAS u16*)(lds + (c0 + q) * 80 + tt * 2)) * r * gain[c0 + q];
        *(u32x4*)(MIXB + (size_t)(tok0 + tt) * DM + 1024 + c0) = (u32x4){pk_bf16(o[0], o[1]), pk_bf16(o[2], o[3]), pk_bf16(o[4], o[5]), pk_bf16(o[6], o[7])};
    }
    __syncthreads();
}
constexpr int RT_XSTRIDE = 2049;
constexpr int RT_PART = 16 * RT_XSTRIDE * 4;
constexpr int RT_LG = RT_PART + 8 * 16 * 32 * 4;
constexpr int RT_HIST = RT_LG + 16 * 32 * 4;
constexpr int RT_END = RT_HIST + 128;
__device__ __forceinline__ void router_tile(LAS unsigned char* lds, int tile_i, const float* __restrict__ X1, const float* __restrict__ gain, const float* __restrict__ wr, const float* __restrict__ br,
                                            unsigned char* __restrict__ XN8, int* __restrict__ TOPI, float* __restrict__ TOPG, int* __restrict__ counts) {
    const int tid = tid_fresh(), wid = __builtin_amdgcn_readfirstlane(tid >> 6), lane = tid & 63;
    const int tok0 = tile_i * 16;
    LAS float* xs = (LAS float*)lds;
#pragma unroll
    for (int q = 0; q < 2; ++q) {
        const int tl = wid * 2 + q; const size_t tok = (size_t)tok0 + tl;
        const float* xr = X1 + tok * DM;
        f32x4 v[8]; float s = 0.f;
#pragma unroll
        for (int j = 0; j < 8; ++j) { v[j] = *(const f32x4*)(xr + (lane + 64 * j) * 4); s += v[j][0] * v[j][0] + v[j][1] * v[j][1] + v[j][2] * v[j][2] + v[j][3] * v[j][3]; }
        s = wave_sum(s);
        const float r = rsqrtf(s * (1.0f / (float)DM) + EPS);
#pragma unroll
        for (int j = 0; j < 8; ++j) { const int d = (lane + 64 * j) * 4; const f32x4 g = *(const f32x4*)(gain + d); const f32x4 o = v[j] * r * g;
            xs[tl * RT_XSTRIDE + d + 0] = o[0]; xs[tl * RT_XSTRIDE + d + 1] = o[1]; xs[tl * RT_XSTRIDE + d + 2] = o[2]; xs[tl * RT_XSTRIDE + d + 3] = o[3];
            *(unsigned*)(XN8 + tok * DM + d) = pk_fp8x4(o[0], o[1], o[2], o[3]); }
    }
    __syncthreads();
    {
        const int tl = lane & 15, kk = lane >> 4;
        f32x4 a0 = {0.f, 0.f, 0.f, 0.f}, a1 = a0;
        const LAS float* xp = xs + tl * RT_XSTRIDE + wid * 256 + kk;
        const float* wp = wr + (size_t)(wid * 256 + kk) * NE + tl;
#pragma unroll 8
        for (int ks = 0; ks < 64; ++ks) { const float a = xp[ks * 4]; const float b0 = wp[(size_t)ks * 4 * NE], b1 = wp[(size_t)ks * 4 * NE + 16];
            a0 = __builtin_amdgcn_mfma_f32_16x16x4f32(a, b0, a0, 0, 0, 0); a1 = __builtin_amdgcn_mfma_f32_16x16x4f32(a, b1, a1, 0, 0, 0); }
        LAS float* pp = (LAS float*)(lds + RT_PART) + wid * 512;
#pragma unroll
        for (int j = 0; j < 4; ++j) { pp[(kk * 4 + j) * 32 + tl] = a0[j]; pp[(kk * 4 + j) * 32 + 16 + tl] = a1[j]; }
    }
    __syncthreads();
    {   const LAS float* pp = (const LAS float*)(lds + RT_PART); float s = br[tid & 31];
#pragma unroll
        for (int w = 0; w < 8; ++w) s += pp[w * 512 + tid];
        ((LAS float*)(lds + RT_LG))[tid] = s; }
    __syncthreads();
    if (tid < 16) {
        LAS float* lg = (LAS float*)(lds + RT_LG) + tid * 32;
        int i0 = 0, i1 = 0, i2 = 0, i3 = 0; float v0, v1, v2, v3;
        { float bv = -3.0e38f; for (int j = 0; j < NE; ++j) { const float l = lg[j]; if (l > bv) { bv = l; i0 = j; } } v0 = bv; lg[i0] = -3.4e38f; }
        { float bv = -3.0e38f; for (int j = 0; j < NE; ++j) { const float l = lg[j]; if (l > bv) { bv = l; i1 = j; } } v1 = bv; lg[i1] = -3.4e38f; }
        { float bv = -3.0e38f; for (int j = 0; j < NE; ++j) { const float l = lg[j]; if (l > bv) { bv = l; i2 = j; } } v2 = bv; lg[i2] = -3.4e38f; }
        { float bv = -3.0e38f; for (int j = 0; j < NE; ++j) { const float l = lg[j]; if (l > bv) { bv = l; i3 = j; } } v3 = bv; lg[i3] = -3.4e38f; }
        const float e1 = __expf(v1 - v0), e2 = __expf(v2 - v0), e3 = __expf(v3 - v0), inv = 1.0f / (1.0f + e1 + e2 + e3);
        const int tok = tok0 + tid;
        *(int4*)(TOPI + tok * 4) = make_int4(i0, i1, i2, i3);
        *(f32x4*)(TOPG + tok * 4) = (f32x4){inv, e1 * inv, e2 * inv, e3 * inv};
        LAS int* hist = (LAS int*)(lds + RT_HIST);
        atomicAdd((int*)(hist + i0), 1); atomicAdd((int*)(hist + i1), 1); atomicAdd((int*)(hist + i2), 1); atomicAdd((int*)(hist + i3), 1);
    }
    __syncthreads();
}
__device__ __forceinline__ void combine_row(int tok, const float* __restrict__ X1, const u16* __restrict__ YB, const int* __restrict__ SOF, const float* __restrict__ TOPG, const float* __restrict__ gain, float* __restrict__ out, int lane) {
    const int4 sl = *(const int4*)(SOF + tok * 4); const f32x4 g = *(const f32x4*)(TOPG + tok * 4);
    const u16* y0 = YB + (size_t)sl.x * DM; const u16* y1 = YB + (size_t)sl.y * DM; const u16* y2 = YB + (size_t)sl.z * DM; const u16* y3 = YB + (size_t)sl.w * DM;
    f32x4 v[8]; float s = 0.f;
#pragma unroll
    for (int j = 0; j < 8; ++j) { const int d = (lane + 64 * j) * 4;
        f32x4 a = *(const f32x4*)(X1 + (size_t)tok * DM + d);
        const u32x2 q0 = *(const u32x2*)(y0 + d), q1 = *(const u32x2*)(y1 + d), q2 = *(const u32x2*)(y2 + d), q3 = *(const u32x2*)(y3 + d);
        a[0] += g[0] * bflo(q0[0]) + g[1] * bflo(q1[0]) + g[2] * bflo(q2[0]) + g[3] * bflo(q3[0]);
        a[1] += g[0] * bfhi(q0[0]) + g[1] * bfhi(q1[0]) + g[2] * bfhi(q2[0]) + g[3] * bfhi(q3[0]);
        a[2] += g[0] * bflo(q0[1]) + g[1] * bflo(q1[1]) + g[2] * bflo(q2[1]) + g[3] * bflo(q3[1]);
        a[3] += g[0] * bfhi(q0[1]) + g[1] * bfhi(q1[1]) + g[2] * bfhi(q2[1]) + g[3] * bfhi(q3[1]);
        v[j] = a; s += a[0] * a[0] + a[1] * a[1] + a[2] * a[2] + a[3] * a[3]; }
    s = wave_sum(s);
    const float r = rsqrtf(s * (1.0f / (float)DM) + EPS);
#pragma unroll
    for (int j = 0; j < 8; ++j) { const int d = (lane + 64 * j) * 4; const f32x4 gn = *(const f32x4*)(gain + d); *(f32x4*)(out + (size_t)tok * DM + d) = v[j] * r * gn; }
}

#ifndef REP_P9
#define REP_P9 1
#endif
#ifndef REP_P3
#define REP_P3 1
#endif
#ifndef REP_FR
#define REP_FR 1
#endif
#ifndef REP_P0
#define REP_P0 1
#endif
#ifndef REP_CONV
#define REP_CONV 1
#endif
#ifndef REP_GEMM1
#define REP_GEMM1 1
#endif
#ifndef REP_HY
#define REP_HY 1
#endif
#ifndef REP_HG
#define REP_HG 1
#endif
#ifndef REP_MOEA
#define REP_MOEA 1
#endif
#ifndef REP_MOEB
#define REP_MOEB 1
#endif
#ifndef REP_WOUT
#define REP_WOUT 1
#endif
struct MegaP {
    const float *x, *norm_mix_gain, *w_in, *lb_logits, *hgrn_norm_gain, *hy_conv_w, *hy_conv_b, *fw1, *fb1, *fw2, *fb2, *fw3, *fb3, *fw4, *ffreq, *hy_bias, *hy_norm_gain, *w_out,
        *norm_ffn_gain, *w_router, *b_router, *moe_w1, *moe_b1, *moe_w2, *moe_b2, *final_gain;
    float* out; unsigned char* ws;
};
constexpr int MEGA_XB = RT_END;
constexpr int MEGA_LDS = RT_END + 64;
static_assert(MEGA_LDS >= HY_LDS + 64 && MEGA_LDS >= HG_LDS + 64 && MEGA_LDS >= GEMM_LDS + 64, "LDS");

__global__ void __launch_bounds__(512, 2) k_mega(const MegaP p_arg) {
    extern __shared__ __attribute__((aligned(16))) unsigned char shm[];
    LAS unsigned char* lds = (LAS unsigned char*)shm;
    const int tid = threadIdx.x, wid = __builtin_amdgcn_readfirstlane(tid >> 6), lane = tid & 63;
    const int G = gridDim.x, bid = blockIdx.x, c = xcd_logical(bid, G);
#define PHASE_ARGS() const MegaP __attribute__((address_space(4)))* pq_ = (const MegaP __attribute__((address_space(4)))*)__builtin_amdgcn_kernarg_segment_ptr(); asm volatile("" : "+s"(pq_)); unsigned char* ws = pq_->ws; (void)ws
    unsigned char* ws0; { PHASE_ARGS(); ws0 = ws; }
#define counts ((int*)(ws + WS_CTL))
#define cursor ((int*)(ws + WS_CTL + 4096))
#define offs ((int*)(ws + WS_CTL + 8192))
#define barw ((unsigned*)(ws + WS_CTL + 16384))
#define HB ((u16*)(ws + WS_HB))
#define PG ((u16*)(ws + WS_PG))
#define HYT ((u16*)(ws + WS_HYT))
#define MIXB ((u16*)(ws + WS_MIXB))
#define XNB ((u16*)(ws + WS_XNB))
#define HMB ((u16*)(ws + WS_HMB))
#define YB ((u16*)(ws + WS_YB))
#define H3 ((float*)(ws + WS_H3))
#define FR ((u16*)(ws + WS_FR))
#define Z2T ((u16*)(ws + WS_Z2T))
#define OF ((float*)(ws + WS_OF))
#define OB ((float*)(ws + WS_OB))
#define X1 ((float*)(ws + WS_X1))
#define TOPI ((int*)(ws + WS_TOPI))
#define TOPG ((float*)(ws + WS_TOPG))
#define STOK ((int*)(ws + WS_STOK))
#define SOF ((int*)(ws + WS_SOF))
#define WINT ((u16*)(ws + WS_WINT))
#define WOUTT ((u16*)(ws + WS_WOUTT))
#define W1T ((u16*)(ws + WS_W1T))
#define W2T ((u16*)(ws + WS_W2T))
    if (tid == 0) *(LAS u32x4*)(lds + MEGA_XB) = (u32x4){0u, 0u, 0u, 0u};
    __syncthreads();
    XcdBarrier bar = xcd_barrier_post((unsigned*)(ws0 + WS_CTL + 16384), (volatile LAS unsigned*)(lds + MEGA_XB));

    {
        PHASE_ARGS();
    for (int rep = 0; rep < REP_P0; ++rep) {
    for (int row = bid * 8 + wid; row < NTOK; row += G * 8) rmsnorm_row_bf(pq_->x + (size_t)row * DM, pq_->norm_mix_gain, HB + (size_t)row * DM, lane);
    for (int m = bid * 8 + wid; m < SEQ; m += G * 8) h3_row(m, pq_->fw1, pq_->fb1, pq_->fw2, pq_->fb2, pq_->fw3, pq_->fb3, pq_->ffreq, (LAS float*)(lds + wid * 512), H3); }
    for (int rep = 0; rep < REP_CONV; ++rep)
    for (int id = bid; id < 1024 + 256; id += G) {
        const int tz = tid_fresh();
        if (id < 1024) { const int nt = id >> 5, kt = id & 31; convert_tile(pq_->w_in, DIN, kt * 64, ColMapPerm{nt * 256}, WINT + (size_t)id * 16384, tz); }
        else { const int q = id - 1024, nt = q >> 5, kt = q & 31; convert_tile(pq_->w_out, DM, kt * 64, ColMapPerm{nt * 256}, WOUTT + (size_t)q * 16384, tz); }
    }
    }
    xcd_barrier(bar);
    {
        PHASE_ARGS();
    for (int rep = 0; rep < REP_FR; ++rep)
    for (int item = bid; item < 256; item += G) frgen_item(item, H3, pq_->fw4, FR, (LAS float*)lds);
    for (int rep = 0; rep < REP_GEMM1; ++rep)
    for (int u = c; u < 1024; u += G) {
        const int i = u >> 8, xx = (u >> 5) & 7, j = u & 31;
        const int mt = (xx & 3) * 8 + (j & 7), nt = ((xx >> 2) + 2 * i) * 4 + (j >> 3);
        const u16* bt = WINT + (size_t)nt * 32 * 16384;
        if (nt < 20) { Epi8PG e{PG, mt * 256, nt * 256}; gemm8_unit<false>(lds, HB, DM, nullptr, mt * 256, 256, bt, 32, e); }
        else { Epi8HYT e{HYT, mt * 256, nt * 256 - 5120}; gemm8_unit<true>(lds, HB, DM, nullptr, mt * 256, 256, bt, 32, e); }
    }
#ifdef PROBE_NOEPI
    for (int u = c; u < 1024; u += G) {
        const int i = u >> 8, xx = (u >> 5) & 7, j = u & 31;
        const int mt = (xx & 3) * 8 + (j & 7), nt = ((xx >> 2) + 2 * i) * 4 + (j >> 3);
        const u16* bt = WINT + (size_t)nt * 32 * 16384;
        EpiNone e{}; if (nt < 20) gemm8_unit<false>(lds, HB, DM, nullptr, mt * 256, 256, bt, 32, e); else gemm8_unit<true>(lds, HB, DM, nullptr, mt * 256, 256, bt, 32, e);
    }
#endif
    }
    xcd_barrier(bar);
    {
        PHASE_ARGS();
    for (int rep = 0; rep < REP_HY; ++rep)
    for (int u = bid; u < 256; u += G) hyena_unit(lds, u, HYT, FR, pq_->hy_conv_w, pq_->hy_conv_b, pq_->hy_bias, Z2T, ConvCtx{pq_->moe_w1, pq_->moe_w2, (unsigned char*)W1T, (unsigned char*)W2T});
    for (int rep = 0; rep < REP_HG; ++rep)
    for (int u = bid; u < 256; u += G) hgrn_unit(lds, u, PG, pq_->lb_logits, OF, OB, ConvCtx{pq_->moe_w1, pq_->moe_w2, (unsigned char*)W1T, (unsigned char*)W2T});
    }
    xcd_barrier(bar);
    {
        PHASE_ARGS();
    for (int rep = 0; rep < REP_P3; ++rep) {
    for (int it = bid * 8 + wid; it < NTOK * HGH; it += G * 8) hgrn_final_item(it, OF, OB, PG, pq_->hgrn_norm_gain, MIXB, lane);
    for (int t = bid; t < NTOK / 32; t += G) hy_norm_tile(lds, t, Z2T, pq_->hy_norm_gain, MIXB); }
    }
    xcd_barrier(bar);
    {
        PHASE_ARGS();
    for (int u = c; u < 256; u += G) {
        const int xx = u >> 5, j = u & 31;
        const int mt = (xx >> 1) * 8 + (j & 7), nt = (xx & 1) * 4 + (j >> 3);
        Epi8X1 e{pq_->x, X1, mt * 256, nt * 256};
        gemm8_unit<false>(lds, MIXB, DM, nullptr, mt * 256, 256, WOUTT + (size_t)nt * 32 * 16384, 32, e);
    }
    }
    xcd_barrier(bar);
    {
        PHASE_ARGS();
    if (tid < NE) *(LAS int*)(lds + RT_HIST + tid * 4) = 0;
    __syncthreads();
    for (int t = bid; t < NTOK / 16; t += G) router_tile(lds, t, X1, pq_->norm_ffn_gain, pq_->w_router, pq_->b_router, (unsigned char*)XNB, TOPI, TOPG, counts);
    if (tid < NE) { const int hcount = *(const LAS int*)(lds + RT_HIST + tid * 4); if (hcount) atomicAdd(&counts[tid * 32], hcount); }
    }
    xcd_barrier(bar);
    {
        PHASE_ARGS();
    {
        LAS int* so = (LAS int*)lds;
        LAS int* lh = (LAS int*)(lds + 256);
        LAS int* lb2 = (LAS int*)(lds + 512);
        if (tid == 0) { int a = 0; for (int e = 0; e < NE; ++e) { so[e] = a; a += __hip_atomic_load(&counts[e * 32], __ATOMIC_RELAXED, __HIP_MEMORY_SCOPE_AGENT); } so[NE] = a; }
        if (tid < NE) lh[tid] = 0;
        __syncthreads();
        if (bid == 0 && tid <= NE) offs[tid] = so[tid];
        for (int i0 = bid * 512; i0 < NSLOT; i0 += G * 512) {
            const int i = i0 + tid; const int e = TOPI[i];
            const int lpos = atomicAdd((int*)(lh + e), 1);
            __syncthreads();
            if (tid < NE) { const int n = lh[tid]; lb2[tid] = so[tid] + (n ? atomicAdd(&cursor[tid * 32], n) : 0); }
            __syncthreads();
            const int slot = lb2[e] + lpos; STOK[slot] = i >> 2; SOF[i] = slot;
            __syncthreads();
            if (tid < NE) lh[tid] = 0;
            __syncthreads();
        }
    }
    }
    xcd_barrier(bar);
    {
        PHASE_ARGS();
    for (int rep = 0; rep < REP_MOEA; ++rep)
    for (;;) {
        LAS int* qs = (LAS int*)(lds + MEGA_XB + 32);
        if (tid == 0) qs[0] = atomicAdd((int*)(ws + WS_CTL + 12288 + (bid & 7) * 128 + rep * 32), 1);
        __syncthreads();
        const int tk = qs[0];
        __syncthreads();
        const int u = 256 * (tk >> 5) + 32 * (bid & 7) + (tk & 31);
        int e, mt, nt, slot0, rows;
        if (!moe_decode<16>(offs, u, e, mt, nt, slot0, rows)) break;
        Epi8Swiglu8 ep{(unsigned char*)HMB, pq_->moe_b1 + (size_t)e * 2 * DFF, slot0, nt, rows};
        gemm8_unit<false, true>(lds, XNB, DM / 2, STOK + slot0, 0, rows, W1T + (size_t)(e * 16 + nt) * 16 * 16384, 16, ep);
    }
    }
    xcd_barrier(bar);
    {
        PHASE_ARGS();
    for (int rep = 0; rep < REP_MOEB; ++rep)
    for (;;) {
        LAS int* qs = (LAS int*)(lds + MEGA_XB + 32);
        if (tid == 0) qs[0] = atomicAdd((int*)(ws + WS_CTL + 13312 + (bid & 7) * 128 + rep * 32), 1);
        __syncthreads();
        const int tk = qs[0];
        __syncthreads();
        const int u = 256 * (tk >> 5) + 32 * (bid & 7) + (tk & 31);
        int e, mt, nt, slot0, rows;
        if (!moe_decode<8>(offs, u, e, mt, nt, slot0, rows)) break;
        Epi8Y ep{YB, pq_->moe_b2 + (size_t)e * DM, slot0, nt * 256, rows};
        gemm8_unit<false, true>(lds, HMB, DFF / 2, nullptr, slot0, rows, W2T + (size_t)(e * 8 + nt) * 16 * 16384, 16, ep);
    }
    }
    xcd_barrier(bar);
    {
        PHASE_ARGS();
    for (int rep = 0; rep < REP_P9; ++rep)
    for (int tok = bid * 8 + wid; tok < NTOK; tok += G * 8) combine_row(tok, X1, YB, SOF, TOPG, pq_->final_gain, pq_->out, lane);
    }
}
#undef counts
#undef cursor
#undef offs
#undef barw
#undef HB
#undef PG
#undef HYT
#undef MIXB
#undef XNB
#undef HMB
#undef YB
#undef H3
#undef FR
#undef Z2T
#undef OF
#undef OB
#undef X1
#undef TOPI
#undef TOPG
#undef STOK
#undef SOF
#undef WINT
#undef WOUTT
#undef W1T
#undef W2T

extern "C" void kernel_launch(void* const* d_in, const int* in_sizes, int n_in, void* d_out, int out_size, void* d_ws, size_t ws_size, hipStream_t stream) {
    if (n_in < 26 || ws_size < WS_END2) return;
    MegaP p{};
    const float** pp = (const float**)&p;
    for (int i = 0; i < 26; ++i) pp[i] = (const float*)d_in[i];
    p.out = (float*)d_out; p.ws = (unsigned char*)d_ws;
    static int grid = 0;
    if (!grid) {
        int dev = 0, cus = 0, per_cu = 0;
        (void)hipGetDevice(&dev);
        (void)hipDeviceGetAttribute(&cus, hipDeviceAttributeMultiprocessorCount, dev);
        (void)hipFuncSetAttribute((const void*)k_mega, hipFuncAttributeMaxDynamicSharedMemorySize, MEGA_LDS);
        (void)hipOccupancyMaxActiveBlocksPerMultiprocessor(&per_cu, (const void*)k_mega, 512, MEGA_LDS);
        if (per_cu < 1) per_cu = 1;
        grid = cus * 1;
        if (grid > 256) grid = 256;
        grid &= ~7;
        if (grid < 8) grid = 8;
    }
    (void)hipMemsetAsync((char*)d_ws + WS_CTL, 0, 65536, stream);
    hipLaunchKernelGGL(k_mega, dim3(grid), dim3(512), MEGA_LDS, stream, p);
}
```

```cpp
#include <hip/hip_runtime.h>
#include <stdint.h>

constexpr int BATCH = 4, SEQ = 2048, DM = 2048, NTOK = BATCH * SEQ;
constexpr int HGW = 1024, HGD = 128, HGH = 8;
constexpr int HYW = 1024;
constexpr int DIN = 8192;
constexpr int NE = 32, TOPK = 4, DFF = 2048;
constexpr int NSLOT = NTOK * TOPK;
constexpr float EPS = 1e-5f;

constexpr size_t MB = 1024ull * 1024ull;
constexpr size_t WS_CTL = 0;
constexpr size_t WS_HB = 1 * MB;
constexpr size_t WS_PG = WS_HB + 32 * MB;
constexpr size_t WS_HYT = WS_PG + 80 * MB;
constexpr size_t WS_MIXB = WS_HYT + 48 * MB;
constexpr size_t WS_XNB = WS_MIXB + 32 * MB;
constexpr size_t WS_HMB = WS_XNB + 32 * MB;
constexpr size_t WS_YB = WS_HMB + 128 * MB;
constexpr size_t WS_H3 = WS_YB + 128 * MB;
constexpr size_t WS_FR = WS_H3 + 1 * MB;
constexpr size_t WS_Z2T = WS_FR + 34 * MB;
constexpr size_t WS_OF = WS_Z2T + 16 * MB;
constexpr size_t WS_OB = WS_OF + 32 * MB;
constexpr size_t WS_X1 = WS_OB + 32 * MB;
constexpr size_t WS_TOPI = WS_X1 + 64 * MB;
constexpr size_t WS_TOPG = WS_TOPI + 1 * MB;
constexpr size_t WS_STOK = WS_TOPG + 1 * MB;
constexpr size_t WS_SOF = WS_STOK + 1 * MB;
constexpr size_t WS_WINT = WS_SOF + 1 * MB;
constexpr size_t WS_WOUTT = WS_WINT + 32 * MB;
constexpr size_t WS_W1T = WS_WOUTT + 8 * MB;
constexpr size_t WS_W2T = WS_W1T + 512 * MB;
constexpr size_t WS_END2 = WS_W2T + 256 * MB;

typedef short bf16x8 __attribute__((ext_vector_type(8)));
typedef float f32x4 __attribute__((ext_vector_type(4)));
typedef float f32x2 __attribute__((ext_vector_type(2)));
typedef unsigned u32x4 __attribute__((ext_vector_type(4)));
typedef unsigned u32x2 __attribute__((ext_vector_type(2)));
typedef unsigned short u16;
#define LAS __attribute__((address_space(3)))

__device__ __forceinline__ unsigned pk_bf16(float lo, float hi) {
    typedef __bf16 bf2 __attribute__((ext_vector_type(2)));
    const f32x2 v = {lo, hi};
    const bf2 r = __builtin_convertvector(v, bf2);
    return __builtin_bit_cast(unsigned, r);
}
__device__ __forceinline__ float bf2f(u16 b) { return __uint_as_float(((unsigned)b) << 16); }
__device__ __forceinline__ float bflo(unsigned w) { return __uint_as_float(w << 16); }
__device__ __forceinline__ float bfhi(unsigned w) { return __uint_as_float(w & 0xffff0000u); }

__device__ __forceinline__ int lds_byte(int r, int c) { const int st = (r >> 4) * 2 + (c >> 5), ob = (r & 15) * 64 + (c & 31) * 2; return st * 1024 + (ob ^ (((ob >> 9) & 1) << 5)); }
__device__ __forceinline__ void stage_rc(int b, int& R, int& C) { const int st = b >> 10, sb = b & 1023, swz = sb ^ (((sb >> 9) & 1) << 5); R = (st >> 1) * 16 + swz / 64; C = (st & 1) * 32 + (swz % 64) / 2; }
__device__ __forceinline__ f32x4 unperm(const f32x4 a, const bool s) { f32x4 o; o[0] = s ? a[1] : a[0]; o[1] = s ? a[0] : a[1]; o[2] = s ? a[3] : a[2]; o[3] = s ? a[2] : a[3]; return o; }

__device__ __forceinline__ int tid_fresh() { int t = threadIdx.x; asm volatile("" : "+v"(t)); return t; }
constexpr int GEMM_LDS = 131072;

template <bool TRANS, bool RAGGED, int PM = 0, class ColMap, class Epi>
__device__ __forceinline__ void gemm_unit(LAS unsigned char* lds, const u16* __restrict__ A, int lda, const int* __restrict__ arows, int arow0, int rows_valid,
                                          const float* __restrict__ B, int ldb, int K, const ColMap colmap, const Epi epi) {
    const int tid = tid_fresh(), wid = __builtin_amdgcn_readfirstlane(tid >> 6), lane = tid & 63;
    const int wr = wid >> 2, wc = wid & 3, fr = lane & 15, fq = lane >> 4;
    const int nt = K >> 6;
    const char* ap[4];
#pragma unroll
    for (int i = 0; i < 4; ++i) {
        int R, C; stage_rc(wid * 1024 + i * 8192 + lane * 16, R, C);
        const int rr = RAGGED ? (R < rows_valid ? R : rows_valid - 1) : R;
        const long rowid = arows ? (long)arows[rr] : (long)(arow0 + rr);
        ap[i] = (const char*)A + ((size_t)rowid * lda + C) * 2;
    }
    const int g = (lane & 3) + 4 * (wid >> 2), rg = (wid & 3) * 16 + (lane >> 2);
    const unsigned bvoff = (unsigned)(((size_t)(8 * g) * ldb + colmap(rg)) * 4);
    const int bbase = 65536 + lds_byte(4 * rg, 8 * g);
    const int bw0 = bbase + ((rg & 1) ? 64 : 0), bw1 = bbase + ((rg & 1) ? 0 : 64);
    const int aoff = lds_byte(wr * 128 + fr, fq * 8), boff = 65536 + lds_byte(wc * 64 + fr, fq * 8);
    int mvalid = 8;
    if (RAGGED) { mvalid = (rows_valid - wr * 128 + 15) >> 4; mvalid = mvalid < 0 ? 0 : (mvalid > 8 ? 8 : mvalid); }
    f32x4 vb0, vb1, vb2, vb3, vb4, vb5, vb6, vb7;
    if (PM & 1) { vb0 = (f32x4){1.f, 1.f, 1.f, 1.f}; vb1 = vb0; vb2 = vb0; vb3 = vb0; vb4 = vb0; vb5 = vb0; vb6 = vb0; vb7 = vb0; }
    f32x4 acc[8][4];
#pragma unroll
    for (int m = 0; m < 8; ++m)
#pragma unroll
        for (int n = 0; n < 4; ++n) acc[m][n] = (f32x4){0.f, 0.f, 0.f, 0.f};
    const size_t ldb4 = (size_t)ldb * 4;
#define GE_GLDS_A(buf, kt) do { if (!(PM & 2)) _Pragma("unroll") for (int _i = 0; _i < 4; ++_i) \
        __builtin_amdgcn_global_load_lds((const unsigned*)(ap[_i] + (size_t)(kt) * 128), (LAS unsigned*)(lds + (buf) * 32768 + wid * 1024 + _i * 8192), 16, 0, 0); } while (0)
#define GE_LD1(dst, sb) if (!(PM & 1)) asm volatile("global_load_dwordx4 %0, %1, %2" : "=v"(dst) : "v"(bvoff), "s"(sb) : "memory")
#define GE_LOAD_B(kt) do { const char* _sb = (const char*)B + (size_t)(kt) * 64 * ldb4; \
        GE_LD1(vb0, _sb); GE_LD1(vb1, _sb + ldb4); GE_LD1(vb2, _sb + 2 * ldb4); GE_LD1(vb3, _sb + 3 * ldb4); \
        GE_LD1(vb4, _sb + 4 * ldb4); GE_LD1(vb5, _sb + 5 * ldb4); GE_LD1(vb6, _sb + 6 * ldb4); GE_LD1(vb7, _sb + 7 * ldb4); } while (0)
#define GE_WAITV_B(n) asm volatile("s_waitcnt vmcnt(" #n ")" : "+v"(vb0), "+v"(vb1), "+v"(vb2), "+v"(vb3), "+v"(vb4), "+v"(vb5), "+v"(vb6), "+v"(vb7) :: "memory")
#define GE_WRITE_B(buf) do { _Pragma("unroll") for (int _i = 0; _i < 4; ++_i) { u32x4 _w; _w[0] = pk_bf16(vb0[_i], vb1[_i]); _w[1] = pk_bf16(vb2[_i], vb3[_i]); \
        _w[2] = pk_bf16(vb4[_i], vb5[_i]); _w[3] = pk_bf16(vb6[_i], vb7[_i]); \
        *(LAS u32x4*)(lds + ((_i & 1) ? bw1 : bw0) + (_i >> 1) * 128 + (buf) * 32768) = _w; } } while (0)
#define GE_KSTEP(buf, ks) do { bf16x8 Bf[4]; \
        _Pragma("unroll") for (int n = 0; n < 4; ++n) Bf[n] = *(const LAS bf16x8*)(lds + (buf) * 32768 + boff + n * 2048 + (ks) * 1024); \
        _Pragma("unroll") for (int mh = 0; mh < 2; ++mh) { bf16x8 At[4]; \
            _Pragma("unroll") for (int m = 0; m < 4; ++m) At[m] = *(const LAS bf16x8*)(lds + (buf) * 32768 + aoff + (mh * 4 + m) * 2048 + (ks) * 1024); \
            _Pragma("unroll") for (int m = 0; m < 4; ++m) { if (!RAGGED || (mh * 4 + m) < mvalid) { _Pragma("unroll") for (int n = 0; n < 4; ++n) \
                { if (PM & 4) { asm volatile("" :: "v"(At[m]), "v"(Bf[n])); } else acc[mh * 4 + m][n] = TRANS ? __builtin_amdgcn_mfma_f32_16x16x32_bf16(At[m], Bf[n], acc[mh * 4 + m][n], 0, 0, 0) : __builtin_amdgcn_mfma_f32_16x16x32_bf16(Bf[n], At[m], acc[mh * 4 + m][n], 0, 0, 0); } } } } } while (0)
    GE_GLDS_A(0, 0);
    GE_LOAD_B(0);
    GE_WAITV_B(0);
    GE_WRITE_B(0);
    GE_LOAD_B(1);
    asm volatile("s_waitcnt lgkmcnt(0)" ::: "memory");
    __builtin_amdgcn_s_barrier();
    int t = 0;
    for (; t < nt - 2; ++t) {
        const int cur = t & 1;
        GE_GLDS_A(cur ^ 1, t + 1);
        GE_KSTEP(cur, 0);
        GE_WAITV_B(4);
        GE_WRITE_B(cur ^ 1);
        GE_LOAD_B(t + 2);
        __builtin_amdgcn_sched_barrier(0);
        GE_KSTEP(cur, 1);
        asm volatile("s_waitcnt vmcnt(8) lgkmcnt(0)" ::: "memory");
        __builtin_amdgcn_s_barrier();
    }
    {
        const int cur = t & 1;
        GE_GLDS_A(cur ^ 1, t + 1);
        GE_KSTEP(cur, 0);
        GE_WAITV_B(4);
        GE_WRITE_B(cur ^ 1);
        GE_KSTEP(cur, 1);
        asm volatile("s_waitcnt vmcnt(0) lgkmcnt(0)" ::: "memory");
        __builtin_amdgcn_s_barrier();
        ++t;
    }
    {
        const int cur = t & 1;
        GE_KSTEP(cur, 0);
        GE_KSTEP(cur, 1);
        asm volatile("s_waitcnt lgkmcnt(0)" ::: "memory");
        __builtin_amdgcn_s_barrier();
    }
#undef GE_GLDS_A
#undef GE_LD1
#undef GE_LOAD_B
#undef GE_WAITV_B
#undef GE_WRITE_B
#undef GE_KSTEP
    __builtin_amdgcn_sched_barrier(0);
    { const int tz = tid_fresh(), wz = __builtin_amdgcn_readfirstlane(tz >> 6), lz = tz & 63;
      epi(acc, wz >> 2, wz & 3, lz & 15, lz >> 4); }
}

__device__ __forceinline__ int xcd_logical(int b, int G) { return (G & 7) ? b : (b & 7) * (G >> 3) + (b >> 3); }

struct ColMapDense { int c0; __device__ __forceinline__ int operator()(int rg) const { return c0 + 4 * rg; } };
struct EpiPG { u16* PG; int tok0, col0;
    __device__ __forceinline__ void operator()(const f32x4 (&acc)[8][4], int wr, int wc, int fr, int fq) const {
#pragma unroll
        for (int m = 0; m < 8; ++m) { u16* rowp = PG + (size_t)(tok0 + wr * 128 + m * 16 + fr) * 5120 + col0 + wc * 64 + 4 * fq;
#pragma unroll
            for (int n = 0; n < 4; ++n) { const f32x4 v = unperm(acc[m][n], fq & 1); u32x2 w; w[0] = pk_bf16(v[0], v[1]); w[1] = pk_bf16(v[2], v[3]); *(u32x2*)(rowp + n * 16) = w; } }
    } };
struct EpiHYT { u16* HYT; int tok0, col0;
    __device__ __forceinline__ void operator()(const f32x4 (&acc)[8][4], int wr, int wc, int fr, int fq) const {
#pragma unroll
        for (int n = 0; n < 4; ++n) { const int rho = wc * 64 + n * 16 + fr; const int col = col0 + (rho & ~3) + ((rho & 3) ^ ((rho >> 2) & 1));
            u16* colp = HYT + (size_t)col * NTOK + tok0 + wr * 128 + 4 * fq;
#pragma unroll
            for (int m = 0; m < 8; ++m) { const f32x4 v = acc[m][n]; u32x2 w; w[0] = pk_bf16(v[0], v[1]); w[1] = pk_bf16(v[2], v[3]); *(u32x2*)(colp + m * 16) = w; } }
    } };
struct EpiX1 { const float* x; float* X1; int tok0, col0;
    __device__ __forceinline__ void operator()(const f32x4 (&acc)[8][4], int wr, int wc, int fr, int fq) const {
#pragma unroll
        for (int m = 0; m < 8; ++m) { const size_t off = (size_t)(tok0 + wr * 128 + m * 16 + fr) * DM + col0 + wc * 64 + 4 * fq;
#pragma unroll
            for (int n = 0; n < 4; ++n) { const f32x4 r = *(const f32x4*)(x + off + n * 16); *(f32x4*)(X1 + off + n * 16) = r + unperm(acc[m][n], fq & 1); }
            asm volatile("" ::: "memory"); }
    } };
struct ColMapGlu { int nt; __device__ __forceinline__ int operator()(int rg) const { const int wcq = rg >> 4, n = (rg >> 2) & 3, f = rg & 3; return (n >> 1) * 2048 + nt * 128 + wcq * 32 + (n & 1) * 16 + f * 4; } };
struct EpiSwiglu { u16* HM; const float* b1; int slot0, nt, rows_valid;
    __device__ __forceinline__ void operator()(const f32x4 (&acc)[8][4], int wr, int wc, int fr, int fq) const {
        f32x4 bg[2], bl[2];
#pragma unroll
        for (int nn = 0; nn < 2; ++nn) { const int col = nt * 128 + wc * 32 + nn * 16 + 4 * fq; bg[nn] = *(const f32x4*)(b1 + col); bl[nn] = *(const f32x4*)(b1 + 2048 + col); }
#pragma unroll
        for (int m = 0; m < 8; ++m) { const int row = wr * 128 + m * 16 + fr;
            if (row < rows_valid) {
#pragma unroll
                for (int nn = 0; nn < 2; ++nn) { const f32x4 gl = unperm(acc[m][nn], fq & 1) + bg[nn], li = unperm(acc[m][nn + 2], fq & 1) + bl[nn]; float o[4];
#pragma unroll
                    for (int j = 0; j < 4; ++j) { const float gq = fminf(gl[j], 7.0f), lq = fminf(fmaxf(li[j], -7.0f), 7.0f); o[j] = gq * (1.0f / (1.0f + __expf(-1.702f * gq))) * (lq + 1.0f); }
                    u32x2 w; w[0] = pk_bf16(o[0], o[1]); w[1] = pk_bf16(o[2], o[3]);
                    *(u32x2*)(HM + (size_t)(slot0 + row) * DFF + nt * 128 + wc * 32 + nn * 16 + 4 * fq) = w; } } }
    } };
struct EpiY { u16* Y; const float* b2; int slot0, col0, rows_valid;
    __device__ __forceinline__ void operator()(const f32x4 (&acc)[8][4], int wr, int wc, int fr, int fq) const {
        f32x4 bv[4];
#pragma unroll
        for (int n = 0; n < 4; ++n) bv[n] = *(const f32x4*)(b2 + col0 + wc * 64 + n * 16 + 4 * fq);
#pragma unroll
        for (int m = 0; m < 8; ++m) { const int row = wr * 128 + m * 16 + fr;
            if (row < rows_valid) { u16* rowp = Y + (size_t)(slot0 + row) * DM + col0 + wc * 64 + 4 * fq;
#pragma unroll
                for (int n = 0; n < 4; ++n) { const f32x4 v = unperm(acc[m][n], fq & 1) + bv[n]; u32x2 w; w[0] = pk_bf16(v[0], v[1]); w[1] = pk_bf16(v[2], v[3]); *(u32x2*)(rowp + n * 16) = w; } } }
    } };
template <int NTILES>
__device__ __forceinline__ bool moe_decode(const int* __restrict__ offs, int u, int& e, int& mt, int& nt, int& slot0, int& rows) {
    int base = 0;
    for (int q = 0; q < NE; ++q) { const int o0 = offs[q], cnt = offs[q + 1] - o0, mtl = (cnt + 255) >> 8, nu = mtl * NTILES;
        if (u < base + nu) { const int ul = u - base; e = q; mt = ul % mtl; nt = ul / mtl; slot0 = o0 + mt * 256; rows = cnt - mt * 256; if (rows > 256) rows = 256; return true; }
        base += nu; }
    return false;
}


__device__ __forceinline__ int perm_col4(int rg) { const int rgl = rg & 31, t = rgl & 7; return 32 * (rgl >> 3) + 8 * (t & 3) + 4 * (t >> 2); }
__device__ __forceinline__ int perm32(int rho) { const int n = rho >> 4, i = rho & 15; return 8 * (i >> 2) + 4 * n + (i & 3); }
template <class ColMap>
__device__ __forceinline__ void convert_tile(const float* __restrict__ W, int ldb, int k0, const ColMap colmap, u16* __restrict__ dst, int tid) {
    const int wid = tid >> 6, lane = tid & 63;
    const int g = (lane & 3) + 4 * (wid >> 2), rg = (wid & 3) * 16 + (lane >> 2);
    const float* bp = W + (size_t)(k0 + 8 * g) * ldb + colmap(rg);
    f32x4 v[8];
#pragma unroll
    for (int kk = 0; kk < 8; ++kk) v[kk] = __builtin_nontemporal_load((const f32x4*)(bp + (size_t)kk * ldb));
    const int h = rg >> 5, r0 = (4 * rg) & 127;
    unsigned char* base = (unsigned char*)dst + h * 16384 + lds_byte(r0, 8 * g);
#pragma unroll
    for (int i = 0; i < 4; ++i) { u32x4 w; w[0] = pk_bf16(v[0][i], v[1][i]); w[1] = pk_bf16(v[2][i], v[3][i]); w[2] = pk_bf16(v[4][i], v[5][i]); w[3] = pk_bf16(v[6][i], v[7][i]);
        *(u32x4*)(base + i * 64) = w; }
}
typedef int i32x8 __attribute__((ext_vector_type(8)));
typedef int i32x4 __attribute__((ext_vector_type(4)));
constexpr float W8_SCALE = 32.0f;
constexpr int W8_MX = 0x7A7A7A7A;
constexpr int A8_MX = 0x7F7F7F7F;
__device__ __forceinline__ unsigned pk_fp8x4(float a, float b, float c, float d) { int p = __builtin_amdgcn_cvt_pk_fp8_f32(a, b, 0, false); p = __builtin_amdgcn_cvt_pk_fp8_f32(c, d, p, true); return (unsigned)p; }
__device__ __forceinline__ int lds_byte_b(int r, int cb) { const int st = (r >> 4) * 2 + (cb >> 6), ob = (r & 15) * 64 + (cb & 63); return st * 1024 + (ob ^ (((ob >> 9) & 1) << 5)); }
struct ConvCtx { const float* w1; const float* w2; unsigned char* W1T; unsigned char* W2T; };
__device__ __forceinline__ int conv_seq2tile(int s) {
    if (s < 16384) return (s >> 9) * 512 + (s & 15) * 32 + ((s >> 4) & 31);
    const int q = s - 16384; return 16384 + (q >> 8) * 256 + (q & 7) * 32 + ((q >> 3) & 31);
}
__device__ __forceinline__ void conv_issue(const ConvCtx& cc, int m, int wid, int lane, f32x2 (&v)[16]) {
    const int rp = 16 * wid + (lane & 15), rg = rp >> 1, p2 = (rp & 1) * 2, kg = lane >> 4;
    const float* bp; size_t ld;
    if (m < 16384) { const int e = m >> 9, nt = (m >> 5) & 15, kt = m & 31; ld = 2 * DFF; bp = cc.w1 + (size_t)e * DM * 2 * DFF + (size_t)(kt * 64 + 16 * kg) * ld + (rg >> 5) * 2048 + nt * 128 + perm_col4(rg) + p2; }
    else { const int q = m - 16384, e = q >> 8, nt = (q >> 5) & 7, kt = q & 31; ld = DM; bp = cc.w2 + (size_t)e * DFF * DM + (size_t)(kt * 64 + 16 * kg) * ld + nt * 256 + (rg >> 5) * 128 + perm_col4(rg) + p2; }
#pragma unroll
    for (int kk = 0; kk < 16; ++kk) v[kk] = __builtin_nontemporal_load((const f32x2*)(bp + (size_t)kk * ld));
}
__device__ __forceinline__ void conv_finish(const ConvCtx& cc, int m, int wid, int lane, const f32x2 (&v)[16]) {
    const int rp = 16 * wid + (lane & 15), kg = lane >> 4;
    const int kt64 = m & 31;
    unsigned char* dst = (m < 16384) ? cc.W1T + ((size_t)(m >> 5) * 16 + (kt64 >> 1)) * 32768 : cc.W2T + ((size_t)((m - 16384) >> 5) * 16 + (kt64 >> 1)) * 32768;
    unsigned char* base = dst + (rp >> 6) * 16384 + lds_byte_b((2 * rp) & 127, (kt64 & 1) * 64 + 16 * kg);
#pragma unroll
    for (int i = 0; i < 2; ++i) { u32x4 w;
#pragma unroll
        for (int q = 0; q < 4; ++q) w[q] = pk_fp8x4(v[4 * q][i] * W8_SCALE, v[4 * q + 1][i] * W8_SCALE, v[4 * q + 2][i] * W8_SCALE, v[4 * q + 3][i] * W8_SCALE);
        __builtin_nontemporal_store(w, (u32x4*)(base + i * 64)); }
}
struct ColMapGluT { int nt; __device__ __forceinline__ int operator()(int rg) const { return (rg >> 5) * 2048 + nt * 128 + perm_col4(rg); } };
struct ColMapPerm { int c0; __device__ __forceinline__ int operator()(int rg) const { return c0 + (rg >> 5) * 128 + perm_col4(rg); } };

template <bool TRANS, bool FP8 = false, class Epi>
__device__ __forceinline__ void gemm8_unit(LAS unsigned char* lds, const u16* __restrict__ A, int lda, const int* __restrict__ arows, int arow0, int rows_valid, const u16* __restrict__ Bt, int nt, const Epi epi) {
    const int tid = tid_fresh(), wid = __builtin_amdgcn_readfirstlane(tid >> 6), lane = tid & 63;
    const int wr = wid >> 2, wc = wid & 3, fr = lane & 15, fq = lane >> 4;
    unsigned aof[2][2];
#pragma unroll
    for (int h = 0; h < 2; ++h)
#pragma unroll
        for (int i = 0; i < 2; ++i) { int R, C; stage_rc(tid * 16 + i * 8192, R, C); int rr = h * 128 + R; rr = rr < rows_valid ? rr : rows_valid - 1;
            const unsigned rowid = arows ? (unsigned)arows[rr] : (unsigned)(arow0 + rr); aof[h][i] = (rowid * (unsigned)lda + (unsigned)C) * 2u; }
    const char* Ab = (const char*)A; const char* Bb = (const char*)Bt + tid * 16;
    const bool hi = rows_valid > 128;
    int mxw = W8_MX, mxa = A8_MX; asm volatile("" : "+v"(mxw), "+v"(mxa));
#define G8_SA(b, h) (((b) * 2 + (h)) * 16384)
#define G8_SB(b, h) (65536 + ((b) * 2 + (h)) * 16384)
#define G8_STA(b, h, kt) do { _Pragma("unroll") for (int _i = 0; _i < 2; ++_i) \
        __builtin_amdgcn_global_load_lds((const unsigned*)(Ab + aof[h][_i] + (size_t)(kt) * 128), (LAS unsigned*)(lds + G8_SA(b, h) + wid * 1024 + _i * 8192), 16, 0, 0); } while (0)
#define G8_STB(b, h, kt) do { _Pragma("unroll") for (int _i = 0; _i < 2; ++_i) \
        __builtin_amdgcn_global_load_lds((const unsigned*)(Bb + (size_t)(kt) * 32768 + (h) * 16384 + _i * 8192), (LAS unsigned*)(lds + G8_SB(b, h) + wid * 1024 + _i * 8192), 16, 0, 0); } while (0)
#define G8_LDA(dst, b, h) do { _Pragma("unroll") for (int m = 0; m < 4; ++m) _Pragma("unroll") for (int k = 0; k < 2; ++k) dst[m][k] = *(const LAS bf16x8*)(lds + G8_SA(b, h) + aoff + m * 2048 + k * 1024); } while (0)
#define G8_LDB(dst, b, h) do { _Pragma("unroll") for (int n = 0; n < 2; ++n) _Pragma("unroll") for (int k = 0; k < 2; ++k) dst[n][k] = *(const LAS bf16x8*)(lds + G8_SB(b, h) + boff + n * 2048 + k * 1024); } while (0)
#define G8_MMA(ai, bj, At, Bq) do { if ((ai) == 0 || hi) { __builtin_amdgcn_s_setprio(1); _Pragma("unroll") for (int m = 0; m < 4; ++m) _Pragma("unroll") for (int n = 0; n < 2; ++n) { \
        if (FP8) { const i32x4 a0 = __builtin_bit_cast(i32x4, At[m][0]), a1 = __builtin_bit_cast(i32x4, At[m][1]), b0 = __builtin_bit_cast(i32x4, Bq[n][0]), b1 = __builtin_bit_cast(i32x4, Bq[n][1]); \
            const i32x8 a8 = __builtin_shufflevector(a0, a1, 0, 1, 2, 3, 4, 5, 6, 7), b8 = __builtin_shufflevector(b0, b1, 0, 1, 2, 3, 4, 5, 6, 7); \
            asm volatile("v_mfma_scale_f32_16x16x128_f8f6f4 %0, %1, %2, %0, %3, %4 op_sel_hi:[0,0,0]" : "+v"(acc[ai][bj][m][n]) : "v"(b8), "v"(a8), "v"(mxw), "v"(mxa)); } \
        else { _Pragma("unroll") for (int k = 0; k < 2; ++k) \
            acc[ai][bj][m][n] = TRANS ? __builtin_amdgcn_mfma_f32_16x16x32_bf16(At[m][k], Bq[n][k], acc[ai][bj][m][n], 0, 0, 0) : __builtin_amdgcn_mfma_f32_16x16x32_bf16(Bq[n][k], At[m][k], acc[ai][bj][m][n], 0, 0, 0); } } \
        __builtin_amdgcn_s_setprio(0); } } while (0)
#define G8_WV(n) asm volatile("s_waitcnt vmcnt(" #n ")" ::: "memory")
#define G8_WL(n) asm volatile("s_waitcnt lgkmcnt(" #n ")" ::: "memory")
#define G8_BAR __builtin_amdgcn_s_barrier()
#define G8_SCHED __builtin_amdgcn_sched_barrier(0)
    const int aoff = lds_byte(wr * 64 + fr, fq * 8), boff = lds_byte(wc * 32 + fr, fq * 8);
    f32x4 acc[2][2][4][2];
#pragma unroll
    for (int a = 0; a < 2; ++a)
#pragma unroll
        for (int b = 0; b < 2; ++b)
#pragma unroll
            for (int m = 0; m < 4; ++m)
#pragma unroll
                for (int n = 0; n < 2; ++n) acc[a][b][m][n] = (f32x4){0.f, 0.f, 0.f, 0.f};
    bf16x8 At[4][2], B0[2][2], B1[2][2];
    G8_STB(0, 0, 0); G8_STA(0, 0, 0); G8_STB(0, 1, 0); G8_STA(0, 1, 0);
    if (wr == 1) G8_BAR;
    G8_WV(4); G8_BAR;
    G8_STB(1, 0, 1); G8_STA(1, 0, 1); G8_STB(1, 1, 1);
    G8_WV(6); G8_BAR;
    for (int t = 0; t < nt - 2; t += 2) {
        G8_LDB(B0, 0, 0); G8_SCHED; G8_LDA(At, 0, 0); G8_STA(1, 1, t + 1);
        G8_WL(8); G8_BAR; G8_WL(0); G8_MMA(0, 0, At, B0); G8_BAR; G8_SCHED;
        G8_LDB(B1, 0, 1); G8_STB(0, 0, t + 2);
        G8_BAR; G8_WL(0); G8_MMA(0, 1, At, B1); G8_BAR;
        G8_LDA(At, 0, 1); G8_STA(0, 0, t + 2);
        G8_BAR; G8_WL(0); G8_MMA(1, 0, At, B0); G8_BAR; G8_SCHED;
        G8_STB(0, 1, t + 2);
        G8_WV(6); G8_BAR; G8_MMA(1, 1, At, B1); G8_BAR;
        G8_LDB(B0, 1, 0); G8_SCHED; G8_LDA(At, 1, 0); G8_STA(0, 1, t + 2);
        G8_WL(8); G8_BAR; G8_WL(0); G8_MMA(0, 0, At, B0); G8_BAR; G8_SCHED;
        G8_LDB(B1, 1, 1); G8_STB(1, 0, t + 3);
        G8_BAR; G8_WL(0); G8_MMA(0, 1, At, B1); G8_BAR;
        G8_LDA(At, 1, 1); G8_STA(1, 0, t + 3);
        G8_BAR; G8_WL(0); G8_MMA(1, 0, At, B0); G8_BAR; G8_SCHED;
        G8_STB(1, 1, t + 3);
        G8_WV(6); G8_BAR; G8_MMA(1, 1, At, B1); G8_BAR;
    }
    { G8_LDB(B0, 0, 0); G8_WV(0); G8_LDA(At, 0, 0); G8_STA(1, 1, nt - 1);
      G8_BAR; G8_WL(0); G8_MMA(0, 0, At, B0); G8_BAR;
      G8_LDB(B1, 0, 1); G8_BAR; G8_WL(0); G8_MMA(0, 1, At, B1); G8_BAR;
      G8_LDA(At, 0, 1); G8_WV(4); G8_BAR; G8_WL(0); G8_MMA(1, 0, At, B0); G8_MMA(1, 1, At, B1); G8_BAR; }
    { G8_LDB(B0, 1, 0); G8_LDA(At, 1, 0); G8_WV(2); G8_BAR; G8_WL(0); G8_MMA(0, 0, At, B0); G8_BAR;
      G8_LDB(B1, 1, 1); G8_WV(0); G8_BAR; G8_WL(0); G8_MMA(0, 1, At, B1); G8_BAR;
      G8_LDA(At, 1, 1); G8_BAR; G8_WL(0); G8_MMA(1, 0, At, B0); G8_MMA(1, 1, At, B1); G8_BAR; }
    if (wr == 0) G8_BAR;
#undef G8_SA
#undef G8_SB
#undef G8_STA
#undef G8_STB
#undef G8_LDA
#undef G8_LDB
#undef G8_MMA
#undef G8_WV
#undef G8_WL
#undef G8_BAR
#undef G8_SCHED
    __builtin_amdgcn_sched_barrier(0);
    { const int tz = tid_fresh(), wz = __builtin_amdgcn_readfirstlane(tz >> 6), lz = tz & 63;
      epi(acc, wz >> 2, wz & 3, lz & 15, lz >> 4); }
}
struct Epi8PG { u16* PG; int tok0, col0;
    __device__ __forceinline__ void operator()(const f32x4 (&acc)[2][2][4][2], int wr, int wc, int fr, int fq) const {
#pragma unroll
        for (int ai = 0; ai < 2; ++ai)
#pragma unroll
            for (int m = 0; m < 4; ++m) { u16* rowp = PG + (size_t)(tok0 + ai * 128 + wr * 64 + m * 16 + fr) * 5120 + col0 + wc * 32 + 8 * fq;
#pragma unroll
                for (int bj = 0; bj < 2; ++bj) { const f32x4 v0 = acc[ai][bj][m][0], v1 = acc[ai][bj][m][1];
                    *(u32x4*)(rowp + bj * 128) = (u32x4){pk_bf16(v0[0], v0[1]), pk_bf16(v0[2], v0[3]), pk_bf16(v1[0], v1[1]), pk_bf16(v1[2], v1[3])}; } }
    } };
struct Epi8HYT { u16* HYT; int tok0, col0;
    __device__ __forceinline__ void operator()(const f32x4 (&acc)[2][2][4][2], int wr, int wc, int fr, int fq) const {
#pragma unroll
        for (int bj = 0; bj < 2; ++bj)
#pragma unroll
            for (int n = 0; n < 2; ++n) { u16* colp = HYT + (size_t)(col0 + bj * 128 + wc * 32 + perm32(n * 16 + fr)) * NTOK + tok0 + wr * 64 + 4 * fq;
#pragma unroll
                for (int ai = 0; ai < 2; ++ai)
#pragma unroll
                    for (int m = 0; m < 4; ++m) { const f32x4 v = acc[ai][bj][m][n]; *(u32x2*)(colp + ai * 128 + m * 16) = (u32x2){pk_bf16(v[0], v[1]), pk_bf16(v[2], v[3])}; } }
    } };
struct Epi8X1 { const float* x; float* X1; int tok0, col0;
    __device__ __forceinline__ void operator()(const f32x4 (&acc)[2][2][4][2], int wr, int wc, int fr, int fq) const {
#pragma unroll
        for (int ai = 0; ai < 2; ++ai)
#pragma unroll
            for (int m = 0; m < 4; ++m) { const size_t off = (size_t)(tok0 + ai * 128 + wr * 64 + m * 16 + fr) * DM + col0 + wc * 32 + 8 * fq;
#pragma unroll
                for (int bj = 0; bj < 2; ++bj)
#pragma unroll
                    for (int n = 0; n < 2; ++n) { const f32x4 r = *(const f32x4*)(x + off + bj * 128 + n * 4); *(f32x4*)(X1 + off + bj * 128 + n * 4) = r + acc[ai][bj][m][n]; }
                asm volatile("" ::: "memory"); }
    } };
struct Epi8Swiglu { u16* HM; const float* b1; int slot0, nt, rows_valid;
    __device__ __forceinline__ void operator()(const f32x4 (&acc)[2][2][4][2], int wr, int wc, int fr, int fq) const {
        f32x4 bg[2], bl[2];
#pragma unroll
        for (int n = 0; n < 2; ++n) { const int col = nt * 128 + wc * 32 + 8 * fq + 4 * n; bg[n] = *(const f32x4*)(b1 + col); bl[n] = *(const f32x4*)(b1 + 2048 + col); }
#pragma unroll
        for (int ai = 0; ai < 2; ++ai)
#pragma unroll
            for (int m = 0; m < 4; ++m) { const int row = ai * 128 + wr * 64 + m * 16 + fr;
                if (row < rows_valid) { float o[8];
#pragma unroll
                    for (int n = 0; n < 2; ++n) { const f32x4 gl = acc[ai][0][m][n] + bg[n], li = acc[ai][1][m][n] + bl[n];
#pragma unroll
                        for (int j = 0; j < 4; ++j) { const float gq = fminf(gl[j], 7.0f), lq = fminf(fmaxf(li[j], -7.0f), 7.0f); o[4 * n + j] = gq * (1.0f / (1.0f + __expf(-1.702f * gq))) * (lq + 1.0f); } }
                    *(u32x4*)(HM + (size_t)(slot0 + row) * DFF + nt * 128 + wc * 32 + 8 * fq) = (u32x4){pk_bf16(o[0], o[1]), pk_bf16(o[2], o[3]), pk_bf16(o[4], o[5]), pk_bf16(o[6], o[7])}; } }
    } };
struct Epi8Swiglu8 { unsigned char* HM; const float* b1; int slot0, nt, rows_valid;
    __device__ __forceinline__ void operator()(const f32x4 (&acc)[2][2][4][2], int wr, int wc, int fr, int fq) const {
        f32x4 bg[2], bl[2];
#pragma unroll
        for (int n = 0; n < 2; ++n) { const int col = nt * 128 + wc * 32 + 8 * fq + 4 * n; bg[n] = *(const f32x4*)(b1 + col); bl[n] = *(const f32x4*)(b1 + 2048 + col); }
#pragma unroll
        for (int ai = 0; ai < 2; ++ai)
#pragma unroll
            for (int m = 0; m < 4; ++m) { const int row = ai * 128 + wr * 64 + m * 16 + fr;
                if (row < rows_valid) { float o[8];
#pragma unroll
                    for (int n = 0; n < 2; ++n) { const f32x4 gl = acc[ai][0][m][n] + bg[n], li = acc[ai][1][m][n] + bl[n];
#pragma unroll
                        for (int j = 0; j < 4; ++j) { const float gq = fminf(gl[j], 7.0f), lq = fminf(fmaxf(li[j], -7.0f), 7.0f); o[4 * n + j] = gq * (1.0f / (1.0f + __expf(-1.702f * gq))) * (lq + 1.0f); } }
                    *(u32x2*)(HM + (size_t)(slot0 + row) * DFF + nt * 128 + wc * 32 + 8 * fq) = (u32x2){pk_fp8x4(o[0], o[1], o[2], o[3]), pk_fp8x4(o[4], o[5], o[6], o[7])}; } }
    } };
struct Epi8Y { u16* Y; const float* b2; int slot0, col0, rows_valid;
    __device__ __forceinline__ void operator()(const f32x4 (&acc)[2][2][4][2], int wr, int wc, int fr, int fq) const {
        f32x4 bv[2][2];
#pragma unroll
        for (int bj = 0; bj < 2; ++bj)
#pragma unroll
            for (int n = 0; n < 2; ++n) bv[bj][n] = *(const f32x4*)(b2 + col0 + bj * 128 + wc * 32 + 8 * fq + 4 * n);
#pragma unroll
        for (int ai = 0; ai < 2; ++ai)
#pragma unroll
            for (int m = 0; m < 4; ++m) { const int row = ai * 128 + wr * 64 + m * 16 + fr;
                if (row < rows_valid) { u16* rowp = Y + (size_t)(slot0 + row) * DM + col0 + wc * 32 + 8 * fq;
#pragma unroll
                    for (int bj = 0; bj < 2; ++bj) { const f32x4 v0 = acc[ai][bj][m][0] + bv[bj][0], v1 = acc[ai][bj][m][1] + bv[bj][1];
                        *(u32x4*)(rowp + bj * 128) = (u32x4){pk_bf16(v0[0], v0[1]), pk_bf16(v0[2], v0[3]), pk_bf16(v1[0], v1[1]), pk_bf16(v1[2], v1[3])}; } } }
    } };
struct EpiNone { __device__ __forceinline__ void operator()(const f32x4 (&acc)[2][2][4][2], int wr, int wc, int fr, int fq) const {
#pragma unroll
        for (int a = 0; a < 2; ++a)
#pragma unroll
            for (int b = 0; b < 2; ++b)
#pragma unroll
                for (int m = 0; m < 4; ++m)
#pragma unroll
                    for (int n = 0; n < 2; ++n) asm volatile("" :: "v"(acc[a][b][m][n]));
    } };

typedef float f32x16 __attribute__((ext_vector_type(16)));
__device__ __forceinline__ void h3_row(int m, const float* __restrict__ w1, const float* __restrict__ b1, const float* __restrict__ w2, const float* __restrict__ b2,
                                       const float* __restrict__ w3, const float* __restrict__ b3, const float* __restrict__ freq, LAS float* sc  , float* __restrict__ H3) {
    const int j = tid_fresh() & 63;
    const float tt = (float)m / (float)(SEQ - 1);
    if (j == 0) sc[0] = tt;
    if (j >= 1 && j <= 16) { const int i = j - 1; const float band = 1e-4f + (float)i * ((15.0f - 1e-4f) / 15.0f); const float ang = (2.0f * 3.14159265358979323846f / (float)SEQ) * (float)m * band; sc[1 + i] = cosf(ang); sc[17 + i] = -sinf(ang); }
    __builtin_amdgcn_wave_barrier();
    const float fr = freq[j];
    float s = b1[j];
    for (int i = 0; i < 33; ++i) s += sc[i] * w1[i * 64 + j];
    const float h1 = sinf(fr * s);
    sc[64 + j] = h1;
    __builtin_amdgcn_wave_barrier();
    s = b2[j];
    for (int i = 0; i < 64; ++i) s += sc[64 + i] * w2[i * 64 + j];
    const float h2 = sinf(fr * s);
    __builtin_amdgcn_wave_barrier();
    sc[j] = h2;
    __builtin_amdgcn_wave_barrier();
    s = b3[j];
    for (int i = 0; i < 64; ++i) s += sc[i] * w3[i * 64 + j];
    H3[(size_t)m * 64 + j] = sinf(fr * s);
    __builtin_amdgcn_wave_barrier();
}
constexpr int FR_LEN = 4128;
__device__ __forceinline__ void frgen_item(LAS unsigned char* lds, int item, const float* __restrict__ H3, const float* __restrict__ w4, u16* __restrict__ FR) {
    const int tid = tid_fresh(), wid = __builtin_amdgcn_readfirstlane(tid >> 6), lane = tid & 63, fr = lane & 15, fq = lane >> 4;
    const int oc0 = item * 8, o = oc0 >> 10;
    const int colB = o * 2048 + (fr >> 3) * 1024 + (oc0 & 1023) + (fr & 7);
    float wreg[16];
#pragma unroll
    for (int ks = 0; ks < 16; ++ks) wreg[ks] = w4[(size_t)(4 * ks + fq) * 4096 + colB];
    const int dir = fr >> 3, c = (oc0 & 1023) + (fr & 7);
    const float mind = logf(1e-2f) / 0.3f, maxd = logf(1e-2f) / 1.5f;
    const float delta = fabsf(mind + (float)c * ((maxd - mind) / 1023.0f));
    u16* r0 = FR + (size_t)((oc0 + (fr & 7)) * 2) * FR_LEN;
    LAS float* tile = (LAS float*)(lds + wid * 4608);
    const int wrow = lane >> 4, wcol = 4 * (lane & 15);
    f32x4 nx[4];
#pragma unroll
    for (int q = 0; q < 4; ++q) nx[q] = *(const f32x4*)(H3 + (size_t)wid * 1024 + q * 256 + lane * 4);
    for (int it = 0; it < 16; ++it) {
        const int mt = wid + 8 * it;
#pragma unroll
        for (int q = 0; q < 4; ++q) *(LAS f32x4*)(tile + (q * 4 + wrow) * 68 + wcol) = nx[q];
        if (it + 1 < 16) {
#pragma unroll
            for (int q = 0; q < 4; ++q) nx[q] = *(const f32x4*)(H3 + (size_t)(mt + 8) * 1024 + q * 256 + lane * 4);
        }
        f32x4 acc = {0.f, 0.f, 0.f, 0.f};
#pragma unroll
        for (int ks = 0; ks < 16; ++ks) acc = __builtin_amdgcn_mfma_f32_16x16x4f32(tile[fr * 68 + 4 * ks + fq], wreg[ks], acc, 0, 0, 0);
        const int m0 = mt * 16 + 4 * fq;
        float v[4];
#pragma unroll
        for (int j = 0; j < 4; ++j) v[j] = acc[j] * __expf(-((float)(m0 + j) / (float)(SEQ - 1)) * delta);
        if (dir == 0) {
            *(u32x2*)(r0 + 2044 - m0) = (u32x2){pk_bf16(v[3], v[2]), pk_bf16(v[1], v[0])};
#pragma unroll
            for (int j = 0; j < 4; ++j) r0[FR_LEN + 2046 - m0 - j] = (u16)(pk_bf16(v[j], 0.f) & 0xffffu);
        } else {
#pragma unroll
            for (int j = 0; j < 4; ++j) if (m0 + j >= 1) { const u16 b = (u16)(pk_bf16(v[j], 0.f) & 0xffffu); r0[2047 + m0 + j] = b; r0[FR_LEN + 2046 + m0 + j] = b; }
        }
    }
    if (tid < 8 * 34) { const int r = tid / 34, x = 4094 + tid % 34; u16* rr = FR + (size_t)((oc0 + r) * 2) * FR_LEN; if (x >= 4095) rr[x] = 0; rr[FR_LEN + x] = 0; }
    __syncthreads();
}
constexpr int HY_ZSTRIDE = 2312;
constexpr int HY_ZCH = 256 + 4 * HY_ZSTRIDE;
constexpr int HY_ZBYTES = HY_ZCH * 2;
constexpr int HY_FB = 4 * HY_ZBYTES;
constexpr int HY_FCH = 2 * FR_LEN * 2;
constexpr int HY_LDS = HY_FB + 4 * HY_FCH;

__device__ __forceinline__ void hy_load_row(LAS unsigned char* lds, int dest, int boff0, int bstride, const u16* __restrict__ row, float w0, float w1, float w2, float cb, int pl) {
#pragma unroll 2
    for (int it = 0; it < 8; ++it) {
        const int idx = pl + 128 * it, tok0 = idx * 8, b = tok0 >> 11, n0 = tok0 & 2047;
        const u32x4 raw = *(const u32x4*)(row + tok0);
        const float pm = (n0 > 0) ? bf2f(row[tok0 - 1]) : 0.f;
        const float pn = (n0 + 8 < SEQ) ? bf2f(row[tok0 + 8]) : 0.f;
        float p[10];
        p[0] = pm; p[9] = pn;
#pragma unroll
        for (int q = 0; q < 4; ++q) { p[1 + 2 * q] = bflo(raw[q]); p[2 + 2 * q] = bfhi(raw[q]); }
        float o[8];
#pragma unroll
        for (int q = 0; q < 8; ++q) o[q] = fmaf(w0, p[q], fmaf(w1, p[q + 1], fmaf(w2, p[q + 2], cb)));
        u32x4 w; w[0] = pk_bf16(o[0], o[1]); w[1] = pk_bf16(o[2], o[3]); w[2] = pk_bf16(o[4], o[5]); w[3] = pk_bf16(o[6], o[7]);
        *(LAS u32x4*)(lds + dest + (boff0 + b * bstride + n0) * 2) = w;
    }
}
__device__ __forceinline__ void hy_load_filters(LAS unsigned char* lds, int fb, const u16* __restrict__ src, int pl) {
    for (int idx = pl; idx < HY_FCH / 16; idx += 128) *(LAS u32x4*)(lds + fb + idx * 16) = *(const u32x4*)((const char*)src + idx * 16);
}
__device__ __forceinline__ void hy_mfma_loop(LAS unsigned char* lds, int zb, int fb, int hlf, int lane, f32x16 (&acc)[4], const ConvCtx& cc, int mbase, int cunit, int wid) {
    const int r = lane & 31, hh = lane >> 5, il = r >> 2, b = r & 3;
    const int bbase = zb + (256 + b * HY_ZSTRIDE + 32 * il + 8 * hh) * 2;
    const int xl = 2047 - r + 8 * hh - 1024 * hlf;
    const int abase = (r & 1) ? (fb + 2 * xl) : (fb + FR_LEN * 2 + 2 * (xl - 1));
#pragma unroll
    for (int q = 0; q < 4; ++q)
#pragma unroll
        for (int i = 0; i < 16; ++i) acc[q][i] = 0.f;
    for (int d0 = 0; d0 < 8; ++d0) {
#pragma unroll
        for (int ks = 0; ks < 2; ++ks) {
            f32x2 cv[16];
            const int mcv = conv_seq2tile((mbase + d0 * 2 + ks) * 256 + cunit);
            conv_issue(cc, mcv, wid, lane, cv);
            bf16x8 Bt[9];
#pragma unroll
            for (int j = 0; j < 9; ++j) Bt[j] = *(const LAS bf16x8*)(lds + bbase + 512 * j - 64 * d0 + 32 * ks);
#pragma unroll
            for (int ep = -8; ep <= 3; ++ep) {
                const LAS unsigned* ap = (const LAS unsigned*)(lds + abase - 64 * d0 - 512 * ep + 32 * ks);
                u32x4 av; av[0] = ap[0]; av[1] = ap[1]; av[2] = ap[2]; av[3] = ap[3];
                const bf16x8 a = __builtin_bit_cast(bf16x8, av);
#pragma unroll
                for (int ctl = 0; ctl < 4; ++ctl) { const int jt = ctl - ep; if (jt >= 0 && jt <= 8) acc[ctl] = __builtin_amdgcn_mfma_f32_32x32x16_bf16(a, Bt[jt], acc[ctl], 0, 0, 0); }
            }
            conv_finish(cc, mcv, wid, lane, cv);
        }
    }
}
__device__ __forceinline__ void hy_epilogue(LAS unsigned char* lds, int zb, int gb, int hlf, int lane, const f32x16 (&acc)[4], float bias) {
    const int r = lane & 31, hh = lane >> 5, il = r >> 2, b = r & 3;
#pragma unroll
    for (int ctl = 0; ctl < 4; ++ctl) {
        const int I = 8 * (4 * hlf + ctl) + il;
#pragma unroll
        for (int q = 0; q < 4; ++q) {
            const int n4 = 32 * I + 8 * q + 4 * hh;
            LAS u32x2* zp = (LAS u32x2*)(lds + zb + (256 + b * HY_ZSTRIDE + n4) * 2);
            const u32x2 zv = *zp, gv = *(const LAS u32x2*)(lds + gb + (b * 2048 + n4) * 2);
            const float z0 = bflo(zv[0]), z1 = bfhi(zv[0]), z2 = bflo(zv[1]), z3 = bfhi(zv[1]);
            const float g0 = bflo(gv[0]), g1 = bfhi(gv[0]), g2 = bflo(gv[1]), g3 = bfhi(gv[1]);
            u32x2 o; o[0] = pk_bf16(g0 * fmaf(bias, z0, acc[ctl][4 * q + 0]), g1 * fmaf(bias, z1, acc[ctl][4 * q + 1]));
            o[1] = pk_bf16(g2 * fmaf(bias, z2, acc[ctl][4 * q + 2]), g3 * fmaf(bias, z3, acc[ctl][4 * q + 3]));
            *zp = o;
        }
    }
}
__device__ __forceinline__ void hyena_unit(LAS unsigned char* lds, int unit, const u16* __restrict__ HYT, const u16* __restrict__ FR, const float* __restrict__ cw, const float* __restrict__ cbv,
                                           const float* __restrict__ hbias, u16* __restrict__ Z2T, const ConvCtx& cc) {
    const int tid = tid_fresh(), wid = __builtin_amdgcn_readfirstlane(tid >> 6), lane = tid & 63;
    const int cs = wid & 3, hlf = wid >> 2, c = unit * 4 + cs, pl = lane + 64 * hlf;
    const int zb = cs * HY_ZBYTES, fb = HY_FB + cs * HY_FCH;
    { const u32x4 z = {0u, 0u, 0u, 0u}; for (int idx = pl; idx < HY_ZBYTES / 16; idx += 128) *(LAS u32x4*)(lds + zb + idx * 16) = z; }
    __syncthreads();
    hy_load_row(lds, zb, 256, HY_ZSTRIDE, HYT + (size_t)c * NTOK, cw[0 * 3072 + c], cw[1 * 3072 + c], cw[2 * 3072 + c], cbv[c], pl);
    f32x16 acc[4];
#pragma unroll
    for (int o = 0; o < 2; ++o) {
        hy_load_filters(lds, fb, FR + (size_t)((o * 1024 + c) * 2) * FR_LEN, pl);
        __syncthreads();
        hy_mfma_loop(lds, zb, fb, hlf, lane, acc, cc, o * 16, unit, wid);
        __syncthreads();
        const int gc = (1 + o) * 1024 + c;
        hy_load_row(lds, fb, 0, 2048, HYT + (size_t)gc * NTOK, cw[0 * 3072 + gc], cw[1 * 3072 + gc], cw[2 * 3072 + gc], cbv[gc], pl);
        __syncthreads();
        hy_epilogue(lds, zb, fb, hlf, lane, acc, hbias[o * HYW + c]);
        __syncthreads();
    }
#pragma unroll 2
    for (int it = 0; it < 8; ++it) { const int idx = pl + 128 * it, tok0 = idx * 8, b = tok0 >> 11, n0 = tok0 & 2047;
        *(u32x4*)(Z2T + (size_t)c * NTOK + tok0) = *(const LAS u32x4*)(lds + zb + (256 + b * HY_ZSTRIDE + n0) * 2); }
    __syncthreads();
}

constexpr int HG_RAWQ = 0, HG_RAWF = 16384, HG_RAWV = 32768;
constexpr int HG_QM = 36864, HG_KM = HG_QM + 17408, HG_QI = HG_KM + 17408;
constexpr int HG_KL = HG_QI + 17408;
constexpr int HG_VT = HG_KL + 18432;
constexpr int HG_P = HG_VT + 4608;
constexpr int HG_ST = HG_P + 9216;
constexpr int HG_TOT = HG_ST + 8704;
constexpr int HG_EL2 = HG_TOT + 2048;
constexpr int HG_LDS = HG_EL2 + 512;

__device__ __forceinline__ void hgrn_unit(LAS unsigned char* lds, int unit, const u16* __restrict__ PG, const float* __restrict__ lb_logits, float* __restrict__ OF, float* __restrict__ OB, const ConvCtx& cc) {
    const int tid = tid_fresh(), wid = __builtin_amdgcn_readfirstlane(tid >> 6), lane = tid & 63, fr = lane & 15, fq = lane >> 4;
    const int vq = unit & 3, dir = (unit >> 2) & 1, h = (unit >> 3) & 7, b = unit >> 6;
    const int k = tid & 127, seg = tid >> 7;
    float* __restrict__ O = dir ? OB : OF;
    float lb;
    { const int c = h * 128 + k; const float l0 = lb_logits[(0 * 2 + dir) * HGW + c], l1 = lb_logits[(1 * 2 + dir) * HGW + c]; lb = 1.0f / (1.0f + __expf(l1 - l0)); }
    for (int i = tid; i < 8704 / 16; i += 512) *(LAS u32x4*)(lds + HG_ST + i * 16) = (u32x4){0u, 0u, 0u, 0u};
    f32x4 Sacc[2];
    Sacc[0] = (f32x4){0.f, 0.f, 0.f, 0.f}; Sacc[1] = Sacc[0];
    u32x4 pq[2], pf[2], pv;
    const int colq = h * 128, colf = (1 + dir) * 1024 + h * 128, colv = 3072 + h * 128 + vq * 32;
#define HG_TOK(c, tau) ((size_t)b * SEQ + (dir ? (SEQ - 1 - 64 * (c) - (tau)) : (64 * (c) + (tau))))
#define HG_PREFETCH(c) do { _Pragma("unroll") for (int _i = 0; _i < 2; ++_i) { const int _x = tid + 512 * _i, _tau = _x >> 4, _p = _x & 15; const u16* _r = PG + HG_TOK(c, _tau) * 5120; \
            pq[_i] = *(const u32x4*)(_r + colq + _p * 8); pf[_i] = *(const u32x4*)(_r + colf + _p * 8); } \
        if (tid < 256) { const int _tau = tid >> 2, _p = tid & 3; pv = *(const u32x4*)(PG + HG_TOK(c, _tau) * 5120 + colv + _p * 8); } } while (0)
    HG_PREFETCH(0);
    for (int c = 0; c < 32; ++c) {
#pragma unroll
        for (int i = 0; i < 2; ++i) { const int x = tid + 512 * i; *(LAS u32x4*)(lds + HG_RAWQ + x * 16) = pq[i]; *(LAS u32x4*)(lds + HG_RAWF + x * 16) = pf[i]; }
        if (tid < 256) *(LAS u32x4*)(lds + HG_RAWV + tid * 16) = pv;
        if (c + 1 < 32) HG_PREFETCH(c + 1);
        f32x2 cv[16];
        const int mqa = conv_seq2tile((32 + c * 2) * 256 + unit), mqb = conv_seq2tile((33 + c * 2) * 256 + unit);
        conv_issue(cc, mqa, wid, lane, cv);
        __syncthreads();
        float qv[16], kv[16], bl[16];
        { float run = 0.f;
#pragma unroll
          for (int i = 0; i < 16; ++i) { const int tau = seg * 16 + i;
              const float qr = bf2f(*(const LAS u16*)(lds + HG_RAWQ + tau * 256 + k * 2)), zf = bf2f(*(const LAS u16*)(lds + HG_RAWF + tau * 256 + k * 2));
              const float sg = 1.0f / (1.0f + __expf(-zf)); const float f = lb + (1.0f - lb) * sg;
              run += __logf(f); bl[i] = run; kv[i] = 1.0f - f; qv[i] = qr / (1.0f + __expf(-qr)); }
          *(LAS float*)(lds + HG_TOT + (seg * 128 + k) * 4) = run; }
        __syncthreads();
        { const float t0 = *(const LAS float*)(lds + HG_TOT + (0 * 128 + k) * 4), t1 = *(const LAS float*)(lds + HG_TOT + (1 * 128 + k) * 4),
                      t2 = *(const LAS float*)(lds + HG_TOT + (2 * 128 + k) * 4), t3 = *(const LAS float*)(lds + HG_TOT + (3 * 128 + k) * 4);
          const float pre = (seg > 0 ? t0 : 0.f) + (seg > 1 ? t1 : 0.f) + (seg > 2 ? t2 : 0.f);
          const float bref = t0 + t1, blast = bref + t2 + t3;
          const float er = __expf(bref), el = __expf(blast - bref);
          if (seg == 0) *(LAS float*)(lds + HG_EL2 + k * 4) = __expf(blast);
          unsigned klp[8];
#pragma unroll
          for (int i = 0; i < 16; i += 2) {
              float klv[2];
#pragma unroll
              for (int u = 0; u < 2; ++u) { const int tau = seg * 16 + i + u; const float bb = pre + bl[i + u];
                  const float e1 = __expf(bb - bref), e2 = __expf(bref - bb);
                  const float qm = qv[i + u] * e1, km = kv[i + u] * e2;
                  *(LAS u16*)(lds + HG_QM + tau * 272 + k * 2) = (u16)(pk_bf16(qm, 0.f) & 0xffffu);
                  *(LAS u16*)(lds + HG_KM + tau * 272 + k * 2) = (u16)(pk_bf16(km, 0.f) & 0xffffu);
                  *(LAS u16*)(lds + HG_QI + tau * 272 + k * 2) = (u16)(pk_bf16(qm * er, 0.f) & 0xffffu);
                  klv[u] = km * el; }
              klp[i >> 1] = pk_bf16(klv[0], klv[1]); }
          *(LAS u32x4*)(lds + HG_KL + k * 144 + seg * 32) = (u32x4){klp[0], klp[1], klp[2], klp[3]};
          *(LAS u32x4*)(lds + HG_KL + k * 144 + seg * 32 + 16) = (u32x4){klp[4], klp[5], klp[6], klp[7]};
          { const int v = tid & 31, tg = tid >> 5; unsigned short e[4];
#pragma unroll
            for (int u = 0; u < 4; ++u) e[u] = *(const LAS u16*)(lds + HG_RAWV + (tg * 4 + u) * 64 + v * 2);
            *(LAS u32x2*)(lds + HG_VT + v * 144 + tg * 8) = (u32x2){(unsigned)e[0] | ((unsigned)e[1] << 16), (unsigned)e[2] | ((unsigned)e[3] << 16)}; } }
        conv_finish(cc, mqa, wid, lane, cv);
        conv_issue(cc, mqb, wid, lane, cv);
        __syncthreads();
#pragma unroll
        for (int q = 0; q < 2; ++q) { const int idx = wid * 2 + q, ti = idx >> 2, si = idx & 3;
            f32x4 a = {0.f, 0.f, 0.f, 0.f};
            if (si <= ti) {
#pragma unroll
                for (int ks = 0; ks < 4; ++ks) { const bf16x8 ka = *(const LAS bf16x8*)(lds + HG_KM + (si * 16 + fr) * 272 + (ks * 32 + fq * 8) * 2), qb = *(const LAS bf16x8*)(lds + HG_QM + (ti * 16 + fr) * 272 + (ks * 32 + fq * 8) * 2);
                    a = __builtin_amdgcn_mfma_f32_16x16x32_bf16(ka, qb, a, 0, 0, 0); } }
            const int tau = ti * 16 + fr, s0 = si * 16 + fq * 4;
            float pvv[4];
#pragma unroll
            for (int j = 0; j < 4; ++j) pvv[j] = (si <= ti && s0 + j <= tau) ? a[j] : 0.f;
            *(LAS u32x2*)(lds + HG_P + tau * 144 + s0 * 2) = (u32x2){pk_bf16(pvv[0], pvv[1]), pk_bf16(pvv[2], pvv[3])}; }
        const int ti = wid >> 1, vi = wid & 1;
        f32x4 oacc = {0.f, 0.f, 0.f, 0.f};
#pragma unroll
        for (int ks = 0; ks < 4; ++ks) { const bf16x8 qa = *(const LAS bf16x8*)(lds + HG_QI + (ti * 16 + fr) * 272 + (ks * 32 + fq * 8) * 2), sb = *(const LAS bf16x8*)(lds + HG_ST + (vi * 16 + fr) * 272 + (ks * 32 + fq * 8) * 2);
            oacc = __builtin_amdgcn_mfma_f32_16x16x32_bf16(qa, sb, oacc, 0, 0, 0); }
        { const f32x4 e2 = *(const LAS f32x4*)(lds + HG_EL2 + (wid * 16 + fq * 4) * 4);
#pragma unroll
          for (int v2 = 0; v2 < 2; ++v2) { Sacc[v2] = Sacc[v2] * e2;
#pragma unroll
              for (int ks = 0; ks < 2; ++ks) { const bf16x8 ka = *(const LAS bf16x8*)(lds + HG_KL + (wid * 16 + fr) * 144 + (ks * 32 + fq * 8) * 2), vb = *(const LAS bf16x8*)(lds + HG_VT + (v2 * 16 + fr) * 144 + (ks * 32 + fq * 8) * 2);
                  Sacc[v2] = __builtin_amdgcn_mfma_f32_16x16x32_bf16(ka, vb, Sacc[v2], 0, 0, 0); } } }
        __syncthreads();
#pragma unroll
        for (int ks = 0; ks < 2; ++ks) { const bf16x8 pa = *(const LAS bf16x8*)(lds + HG_P + (ti * 16 + fr) * 144 + (ks * 32 + fq * 8) * 2), vb = *(const LAS bf16x8*)(lds + HG_VT + (vi * 16 + fr) * 144 + (ks * 32 + fq * 8) * 2);
            oacc = __builtin_amdgcn_mfma_f32_16x16x32_bf16(pa, vb, oacc, 0, 0, 0); }
#pragma unroll
        for (int j = 0; j < 4; ++j) { const int tau = ti * 16 + fq * 4 + j; O[HG_TOK(c, tau) * HGW + h * 128 + vq * 32 + vi * 16 + fr] = oacc[j]; }
        conv_finish(cc, mqb, wid, lane, cv);
#pragma unroll
        for (int v2 = 0; v2 < 2; ++v2) *(LAS u32x2*)(lds + HG_ST + (v2 * 16 + fr) * 272 + (wid * 16 + fq * 4) * 2) = (u32x2){pk_bf16(Sacc[v2][0], Sacc[v2][1]), pk_bf16(Sacc[v2][2], Sacc[v2][3])};
    }
    __syncthreads();
#undef HG_TOK
#undef HG_PREFETCH
}


#define XB_TMO      128
#define XB_XCNT(j)  (256  + 64 * (j))
#define XB_XSUB(j)  (1280 + 64 * (j))
#define XB_XGEN(j)  (2304 + 64 * (j))
#define XB_TOP      3328
#define XB_TOPGEN   3392
#define XCD_BAR_WORDS 3456
#define XB_SPIN_CAP (1u << 22)

__device__ __forceinline__ unsigned xb_ld(unsigned* p)              { return __hip_atomic_load(p, __ATOMIC_RELAXED, __HIP_MEMORY_SCOPE_AGENT); }
__device__ __forceinline__ unsigned xb_add(unsigned* p, unsigned v) { return __hip_atomic_fetch_add(p, v, __ATOMIC_RELAXED, __HIP_MEMORY_SCOPE_AGENT); }
__device__ __forceinline__ unsigned xb_xcc_id() { return (unsigned)__builtin_amdgcn_s_getreg((3 << 11) | 20) & 0xFu; }
#define XB_SPIN(cond, bar) do { unsigned _sp = 0; while (cond) { __builtin_amdgcn_s_sleep(1); \
    if ((++_sp & 255u) == 0u) { if (xb_ld(&(bar)[XB_TMO])) break; if (_sp > XB_SPIN_CAP) { atomicAdd(&(bar)[XB_TMO], 1u); break; } } } } while (0)

struct XcdBarrier {
    unsigned* bar; unsigned x;
    volatile LAS unsigned* st;
};

__device__ __forceinline__ XcdBarrier xcd_barrier_post(unsigned* bar, volatile LAS unsigned* st) {
    XcdBarrier b; b.bar = bar; b.x = xb_xcc_id(); b.st = st;
    if (threadIdx.x == 0) (void)xb_add(&bar[XB_XCNT(b.x)], 1u);
    return b;
}
__device__ __forceinline__ void xcd_barrier_complete(unsigned* bar, unsigned x, unsigned& nloc, unsigned& nx) {
    const unsigned G = gridDim.x * gridDim.y * gridDim.z;
    unsigned sum, cnt, mine, sp = 0u;
    for (;;) {
        sum = 0u; cnt = 0u; mine = 0u;
#pragma unroll
        for (unsigned j = 0; j < 16; ++j) { const unsigned c = xb_ld(&bar[XB_XCNT(j)]); sum += c; cnt += (c > 0u) ? 1u : 0u; mine = (j == x) ? c : mine; }
        if (sum == G) break;
        __builtin_amdgcn_s_sleep(1);
        if ((++sp & 255u) == 0u) { if (xb_ld(&bar[XB_TMO])) break; if (sp > XB_SPIN_CAP) { atomicAdd(&bar[XB_TMO], 1u); break; } }
    }
    nloc = mine > 0u ? mine : 1u; nx = cnt > 0u ? cnt : 1u;
}

__device__ __forceinline__ void xcd_barrier(const XcdBarrier& b) {
    asm volatile("s_waitcnt vmcnt(0)" ::: "memory");
    __syncthreads();
    if (threadIdx.x == 0) {
        unsigned* bar = b.bar;
        __builtin_amdgcn_s_waitcnt(0);
        unsigned nloc = b.st[0], nx = b.st[1];
        if (nloc == 0u) { xcd_barrier_complete(bar, b.x, nloc, nx); b.st[0] = nloc; b.st[1] = nx; }
        const unsigned old = xb_add(&bar[XB_XSUB(b.x)], 1u);
        const unsigned gen = old / nloc;
        if (old + 1u == (gen + 1u) * nloc) {
            __builtin_amdgcn_fence(__ATOMIC_RELEASE, "agent");
            asm volatile("s_waitcnt vmcnt(0)" ::: "memory");
            const unsigned og = xb_add(&bar[XB_TOP], 1u);
            const unsigned tg = og / nx;
            if (og + 1u == (tg + 1u) * nx) xb_add(&bar[XB_TOPGEN], 1u);
            else XB_SPIN(xb_ld(&bar[XB_TOPGEN]) == tg, bar);
            __builtin_amdgcn_fence(__ATOMIC_ACQUIRE, "agent");
            xb_add(&bar[XB_XGEN(b.x)], 1u);
            asm volatile("s_waitcnt vmcnt(0)" ::: "memory");
        } else {
            XB_SPIN(xb_ld(&bar[XB_XGEN(b.x)]) == gen, bar);
            __builtin_amdgcn_fence(__ATOMIC_ACQUIRE, "agent");
            asm volatile("s_waitcnt vmcnt(0)" ::: "memory");
        }
    }
    __syncthreads();
}

__device__ __forceinline__ float wave_sum(float s) {
#pragma unroll
    for (int o = 32; o >= 1; o >>= 1) s += __shfl_xor(s, o);
    return s;
}
__device__ __forceinline__ void rmsnorm_row_bf(const float* __restrict__ xr, const float* __restrict__ gain, u16* __restrict__ ob, int lane) {
    f32x4 v[8]; float s = 0.f;
#pragma unroll
    for (int j = 0; j < 8; ++j) { v[j] = *(const f32x4*)(xr + (lane + 64 * j) * 4); s += v[j][0] * v[j][0] + v[j][1] * v[j][1] + v[j][2] * v[j][2] + v[j][3] * v[j][3]; }
    s = wave_sum(s);
    const float r = rsqrtf(s * (1.0f / (float)DM) + EPS);
#pragma unroll
    for (int j = 0; j < 8; ++j) { const f32x4 g = *(const f32x4*)(gain + (lane + 64 * j) * 4); const f32x4 o = v[j] * r * g;
        *(u32x2*)(ob + (lane + 64 * j) * 4) = (u32x2){pk_bf16(o[0], o[1]), pk_bf16(o[2], o[3])}; }
}
__device__ __forceinline__ void hgrn_final_item(int item, const float* __restrict__ OF, const float* __restrict__ OB, const u16* __restrict__ PG, const float* __restrict__ gain, u16* __restrict__ MIXB, int lane) {
    const int tok = item >> 3, h = item & 7, c = h * 128 + 2 * lane;
    const f32x2 a = *(const f32x2*)(OF + (size_t)tok * HGW + c), b = *(const f32x2*)(OB + (size_t)tok * HGW + c);
    const float o0 = a[0] + b[0], o1 = a[1] + b[1];
    const float s = wave_sum(o0 * o0 + o1 * o1);
    const float r = rsqrtf(s * (1.0f / 128.0f) + EPS);
    const unsigned gw = *(const unsigned*)(PG + (size_t)tok * 5120 + 4096 + c);
    const float g0 = bflo(gw), g1 = bfhi(gw);
    const f32x2 gn = *(const f32x2*)(gain + c);
    const float v0 = o0 * r * gn[0] * (g0 / (1.0f + __expf(-g0))), v1 = o1 * r * gn[1] * (g1 / (1.0f + __expf(-g1)));
    *(unsigned*)(MIXB + (size_t)tok * DM + c) = pk_bf16(v0, v1);
}
__device__ __forceinline__ void hy_norm_tile(LAS unsigned char* lds, int tile_i, const u16* __restrict__ Z2T, const float* __restrict__ gain, u16* __restrict__ MIXB) {
    const int t = tid_fresh(), tok0 = tile_i * 32;
    LAS float* ssq = (LAS float*)(lds + 1024 * 80);
    if (t < 32) ssq[t] = 0.f;
    __syncthreads();
    float part[8];
#pragma unroll
    for (int q = 0; q < 8; ++q) part[q] = 0.f;
    const int ch = t & 3;
#pragma unroll
    for (int it = 0; it < 8; ++it) {
        const int c = (t >> 2) + 128 * it;
        const u32x4 v = *(const u32x4*)(Z2T + (size_t)c * NTOK + tok0 + ch * 8);
        *(LAS u32x4*)(lds + c * 80 + ch * 16) = v;
#pragma unroll
        for (int q = 0; q < 4; ++q) { const float a = bflo(v[q]), b = bfhi(v[q]); part[2 * q] += a * a; part[2 * q + 1] += b * b; }
    }
#pragma unroll
    for (int q = 0; q < 8; ++q) { float s = part[q]; s += __shfl_xor(s, 4); s += __shfl_xor(s, 8); s += __shfl_xor(s, 16); s += __shfl_xor(s, 32); part[q] = s; }
    if ((t & 63) < 4) {
#pragma unroll
        for (int q = 0; q < 8; ++q) atomicAdd((float*)(ssq + ch * 8 + q), part[q]);
    }
    __syncthreads();
    const int tt = t >> 4;
    const float r = rsqrtf(ssq[tt] * (1.0f / (float)HYW) + EPS);
#pragma unroll 2
    for (int k = 0; k < 8; ++k) {
        const int c0 = ((t & 15) + 16 * k) * 8;
        float o[8];
#pragma unroll
        for (int q = 0; q < 8; ++q) o[q] = bf2f(*(const LAS u16*)(lds + (c0 + q) * 80 + tt * 2)) * r * gain[c0 + q];
        *(u32x4*)(MIXB + (size_t)(tok0 + tt) * DM + 1024 + c0) = (u32x4){pk_bf16(o[0], o[1]), pk_bf16(o[2], o[3]), pk_bf16(o[4], o[5]), pk_bf16(o[6], o[7])};
    }
    __syncthreads();
}
constexpr int RT_XSTRIDE = 2049;
constexpr int RT_PART = 16 * RT_XSTRIDE * 4;
constexpr int RT_LG = RT_PART + 8 * 16 * 32 * 4;
constexpr int RT_HIST = RT_LG + 16 * 32 * 4;
constexpr int RT_END = RT_HIST + 128;
__device__ __forceinline__ void router_tile(LAS unsigned char* lds, int tile_i, const float* __restrict__ X1, const float* __restrict__ gain, const float* __restrict__ wr, const float* __restrict__ br,
                                            unsigned char* __restrict__ XN8, int* __restrict__ TOPI, float* __restrict__ TOPG, int* __restrict__ counts) {
    const int tid = tid_fresh(), wid = __builtin_amdgcn_readfirstlane(tid >> 6), lane = tid & 63;
    const int tok0 = tile_i * 16;
    LAS float* xs = (LAS float*)lds;
#pragma unroll
    for (int q = 0; q < 2; ++q) {
        const int tl = wid * 2 + q; const size_t tok = (size_t)tok0 + tl;
        const float* xr = X1 + tok * DM;
        f32x4 v[8]; float s = 0.f;
#pragma unroll
        for (int j = 0; j < 8; ++j) { v[j] = *(const f32x4*)(xr + (lane + 64 * j) * 4); s += v[j][0] * v[j][0] + v[j][1] * v[j][1] + v[j][2] * v[j][2] + v[j][3] * v[j][3]; }
        s = wave_sum(s);
        const float r = rsqrtf(s * (1.0f / (float)DM) + EPS);
#pragma unroll
        for (int j = 0; j < 8; ++j) { const int d = (lane + 64 * j) * 4; const f32x4 g = *(const f32x4*)(gain + d); const f32x4 o = v[j] * r * g;
            xs[tl * RT_XSTRIDE + d + 0] = o[0]; xs[tl * RT_XSTRIDE + d + 1] = o[1]; xs[tl * RT_XSTRIDE + d + 2] = o[2]; xs[tl * RT_XSTRIDE + d + 3] = o[3];
            *(unsigned*)(XN8 + tok * DM + d) = pk_fp8x4(o[0], o[1], o[2], o[3]); }
    }
    __syncthreads();
    {
        const int tl = lane & 15, kk = lane >> 4;
        f32x4 a0 = {0.f, 0.f, 0.f, 0.f}, a1 = a0;
        const LAS float* xp = xs + tl * RT_XSTRIDE + wid * 256 + kk;
        const float* wp = wr + (size_t)(wid * 256 + kk) * NE + tl;
#pragma unroll 8
        for (int ks = 0; ks < 64; ++ks) { const float a = xp[ks * 4]; const float b0 = wp[(size_t)ks * 4 * NE], b1 = wp[(size_t)ks * 4 * NE + 16];
            a0 = __builtin_amdgcn_mfma_f32_16x16x4f32(a, b0, a0, 0, 0, 0); a1 = __builtin_amdgcn_mfma_f32_16x16x4f32(a, b1, a1, 0, 0, 0); }
        LAS float* pp = (LAS float*)(lds + RT_PART) + wid * 512;
#pragma unroll
        for (int j = 0; j < 4; ++j) { pp[(kk * 4 + j) * 32 + tl] = a0[j]; pp[(kk * 4 + j) * 32 + 16 + tl] = a1[j]; }
    }
    __syncthreads();
    {   const LAS float* pp = (const LAS float*)(lds + RT_PART); float s = br[tid & 31];
#pragma unroll
        for (int w = 0; w < 8; ++w) s += pp[w * 512 + tid];
        ((LAS float*)(lds + RT_LG))[tid] = s; }
    __syncthreads();
    if (tid < 16) {
        LAS float* lg = (LAS float*)(lds + RT_LG) + tid * 32;
        int i0 = 0, i1 = 0, i2 = 0, i3 = 0; float v0, v1, v2, v3;
        { float bv = -3.0e38f; for (int j = 0; j < NE; ++j) { const float l = lg[j]; if (l > bv) { bv = l; i0 = j; } } v0 = bv; lg[i0] = -3.4e38f; }
        { float bv = -3.0e38f; for (int j = 0; j < NE; ++j) { const float l = lg[j]; if (l > bv) { bv = l; i1 = j; } } v1 = bv; lg[i1] = -3.4e38f; }
        { float bv = -3.0e38f; for (int j = 0; j < NE; ++j) { const float l = lg[j]; if (l > bv) { bv = l; i2 = j; } } v2 = bv; lg[i2] = -3.4e38f; }
        { float bv = -3.0e38f; for (int j = 0; j < NE; ++j) { const float l = lg[j]; if (l > bv) { bv = l; i3 = j; } } v3 = bv; lg[i3] = -3.4e38f; }
        const float e1 = __expf(v1 - v0), e2 = __expf(v2 - v0), e3 = __expf(v3 - v0), inv = 1.0f / (1.0f + e1 + e2 + e3);
        const int tok = tok0 + tid;
        *(int4*)(TOPI + tok * 4) = make_int4(i0, i1, i2, i3);
        *(f32x4*)(TOPG + tok * 4) = (f32x4){inv, e1 * inv, e2 * inv, e3 * inv};
        LAS int* hist = (LAS int*)(lds + RT_HIST);
        atomicAdd((int*)(hist + i0), 1); atomicAdd((int*)(hist + i1), 1); atomicAdd((int*)(hist + i2), 1); atomicAdd((int*)(hist + i3), 1);
    }
    __syncthreads();
}
__device__ __forceinline__ void combine_row(int tok, const float* __restrict__ X1, const u16* __restrict__ YB, const int* __restrict__ SOF, const float* __restrict__ TOPG, const float* __restrict__ gain, float* __restrict__ out, int lane) {
    const int4 sl = *(const int4*)(SOF + tok * 4); const f32x4 g = *(const f32x4*)(TOPG + tok * 4);
    const u16* y0 = YB + (size_t)sl.x * DM; const u16* y1 = YB + (size_t)sl.y * DM; const u16* y2 = YB + (size_t)sl.z * DM; const u16* y3 = YB + (size_t)sl.w * DM;
    f32x4 v[8]; float s = 0.f;
#pragma unroll
    for (int j = 0; j < 8; ++j) { const int d = (lane + 64 * j) * 4;
        f32x4 a = *(const f32x4*)(X1 + (size_t)tok * DM + d);
        const u32x2 q0 = *(const u32x2*)(y0 + d), q1 = *(const u32x2*)(y1 + d), q2 = *(const u32x2*)(y2 + d), q3 = *(const u32x2*)(y3 + d);
        a[0] += g[0] * bflo(q0[0]) + g[1] * bflo(q1[0]) + g[2] * bflo(q2[0]) + g[3] * bflo(q3[0]);
        a[1] += g[0] * bfhi(q0[0]) + g[1] * bfhi(q1[0]) + g[2] * bfhi(q2[0]) + g[3] * bfhi(q3[0]);
        a[2] += g[0] * bflo(q0[1]) + g[1] * bflo(q1[1]) + g[2] * bflo(q2[1]) + g[3] * bflo(q3[1]);
        a[3] += g[0] * bfhi(q0[1]) + g[1] * bfhi(q1[1]) + g[2] * bfhi(q2[1]) + g[3] * bfhi(q3[1]);
        v[j] = a; s += a[0] * a[0] + a[1] * a[1] + a[2] * a[2] + a[3] * a[3]; }
    s = wave_sum(s);
    const float r = rsqrtf(s * (1.0f / (float)DM) + EPS);
#pragma unroll
    for (int j = 0; j < 8; ++j) { const int d = (lane + 64 * j) * 4; const f32x4 gn = *(const f32x4*)(gain + d); *(f32x4*)(out + (size_t)tok * DM + d) = v[j] * r * gn; }
}

#ifndef REP_P9
#define REP_P9 1
#endif
#ifndef REP_P3
#define REP_P3 1
#endif
#ifndef REP_FR
#define REP_FR 1
#endif
#ifndef REP_P0
#define REP_P0 1
#endif
#ifndef REP_CONV
#define REP_CONV 1
#endif
#ifndef REP_GEMM1
#define REP_GEMM1 1
#endif
#ifndef REP_HY
#define REP_HY 1
#endif
#ifndef REP_HG
#define REP_HG 1
#endif
#ifndef REP_MOEA
#define REP_MOEA 1
#endif
#ifndef REP_MOEB
#define REP_MOEB 1
#endif
#ifndef REP_WOUT
#define REP_WOUT 1
#endif
struct MegaP {
    const float *x, *norm_mix_gain, *w_in, *lb_logits, *hgrn_norm_gain, *hy_conv_w, *hy_conv_b, *fw1, *fb1, *fw2, *fb2, *fw3, *fb3, *fw4, *ffreq, *hy_bias, *hy_norm_gain, *w_out,
        *norm_ffn_gain, *w_router, *b_router, *moe_w1, *moe_b1, *moe_w2, *moe_b2, *final_gain;
    float* out; unsigned char* ws;
};
constexpr int MEGA_XB = RT_END;
constexpr int MEGA_LDS = RT_END + 64 + 384;
static_assert(MEGA_LDS >= HY_LDS + 64 && MEGA_LDS >= HG_LDS + 64 && MEGA_LDS >= GEMM_LDS + 64, "LDS");

__global__ void __launch_bounds__(512, 2) k_mega(const MegaP p_arg) {
    extern __shared__ __attribute__((aligned(16))) unsigned char shm[];
    LAS unsigned char* lds = (LAS unsigned char*)shm;
    const int tid = threadIdx.x, wid = __builtin_amdgcn_readfirstlane(tid >> 6), lane = tid & 63;
    const int G = gridDim.x, bid = blockIdx.x, c = xcd_logical(bid, G);
#define PHASE_ARGS() const MegaP __attribute__((address_space(4)))* pq_ = (const MegaP __attribute__((address_space(4)))*)__builtin_amdgcn_kernarg_segment_ptr(); asm volatile("" : "+s"(pq_)); unsigned char* ws = pq_->ws; (void)ws
    unsigned char* ws0; { PHASE_ARGS(); ws0 = ws; }
#define counts ((int*)(ws + WS_CTL))
#define cursor ((int*)(ws + WS_CTL + 4096))
#define offs ((int*)(ws + WS_CTL + 8192))
#define barw ((unsigned*)(ws + WS_CTL + 16384))
#define HB ((u16*)(ws + WS_HB))
#define PG ((u16*)(ws + WS_PG))
#define HYT ((u16*)(ws + WS_HYT))
#define MIXB ((u16*)(ws + WS_MIXB))
#define XNB ((u16*)(ws + WS_XNB))
#define HMB ((u16*)(ws + WS_HMB))
#define YB ((u16*)(ws + WS_YB))
#define H3 ((float*)(ws + WS_H3))
#define FR ((u16*)(ws + WS_FR))
#define Z2T ((u16*)(ws + WS_Z2T))
#define OF ((float*)(ws + WS_OF))
#define OB ((float*)(ws + WS_OB))
#define X1 ((float*)(ws + WS_X1))
#define TOPI ((int*)(ws + WS_TOPI))
#define TOPG ((float*)(ws + WS_TOPG))
#define STOK ((int*)(ws + WS_STOK))
#define SOF ((int*)(ws + WS_SOF))
#define WINT ((u16*)(ws + WS_WINT))
#define WOUTT ((u16*)(ws + WS_WOUTT))
#define W1T ((u16*)(ws + WS_W1T))
#define W2T ((u16*)(ws + WS_W2T))
    if (tid == 0) *(LAS u32x4*)(lds + MEGA_XB) = (u32x4){0u, 0u, 0u, 0u};
    __syncthreads();
    XcdBarrier bar = xcd_barrier_post((unsigned*)(ws0 + WS_CTL + 16384), (volatile LAS unsigned*)(lds + MEGA_XB));

    {
        PHASE_ARGS();
    for (int rep = 0; rep < REP_P0; ++rep) {
    for (int row = bid * 8 + wid; row < NTOK; row += G * 8) rmsnorm_row_bf(pq_->x + (size_t)row * DM, pq_->norm_mix_gain, HB + (size_t)row * DM, lane);
    for (int m = bid * 8 + wid; m < SEQ; m += G * 8) h3_row(m, pq_->fw1, pq_->fb1, pq_->fw2, pq_->fb2, pq_->fw3, pq_->fb3, pq_->ffreq, (LAS float*)(lds + wid * 512), H3); }
    for (int rep = 0; rep < REP_CONV; ++rep)
    for (int id = bid; id < 1024 + 256; id += G) {
        const int tz = tid_fresh();
        if (id < 1024) { const int nt = id >> 5, kt = id & 31; convert_tile(pq_->w_in, DIN, kt * 64, ColMapPerm{nt * 256}, WINT + (size_t)id * 16384, tz); }
        else { const int q = id - 1024, nt = q >> 5, kt = q & 31; convert_tile(pq_->w_out, DM, kt * 64, ColMapPerm{nt * 256}, WOUTT + (size_t)q * 16384, tz); }
    }
    }
    xcd_barrier(bar);
    {
        PHASE_ARGS();
    for (int rep = 0; rep < REP_FR; ++rep)
    for (int item = bid; item < 256; item += G) frgen_item(lds, item, H3, pq_->fw4, FR);
    for (int rep = 0; rep < REP_GEMM1; ++rep)
    for (int u = c; u < 1024; u += G) {
        const int i = u >> 8, xx = (u >> 5) & 7, j = u & 31;
        const int mt = (xx & 3) * 8 + (j & 7), nt = ((xx >> 2) + 2 * i) * 4 + (j >> 3);
        const u16* bt = WINT + (size_t)nt * 32 * 16384;
        if (nt < 20) { Epi8PG e{PG, mt * 256, nt * 256}; gemm8_unit<false>(lds, HB, DM, nullptr, mt * 256, 256, bt, 32, e); }
        else { Epi8HYT e{HYT, mt * 256, nt * 256 - 5120}; gemm8_unit<true>(lds, HB, DM, nullptr, mt * 256, 256, bt, 32, e); }
    }
#ifdef PROBE_NOEPI
    for (int u = c; u < 1024; u += G) {
        const int i = u >> 8, xx = (u >> 5) & 7, j = u & 31;
        const int mt = (xx & 3) * 8 + (j & 7), nt = ((xx >> 2) + 2 * i) * 4 + (j >> 3);
        const u16* bt = WINT + (size_t)nt * 32 * 16384;
        EpiNone e{}; if (nt < 20) gemm8_unit<false>(lds, HB, DM, nullptr, mt * 256, 256, bt, 32, e); else gemm8_unit<true>(lds, HB, DM, nullptr, mt * 256, 256, bt, 32, e);
    }
#endif
    }
    xcd_barrier(bar);
    {
        PHASE_ARGS();
    for (int rep = 0; rep < REP_HY; ++rep)
    for (int u = bid; u < 256; u += G) hyena_unit(lds, u, HYT, FR, pq_->hy_conv_w, pq_->hy_conv_b, pq_->hy_bias, Z2T, ConvCtx{pq_->moe_w1, pq_->moe_w2, (unsigned char*)W1T, (unsigned char*)W2T});
    for (int rep = 0; rep < REP_HG; ++rep)
    for (int u = bid; u < 256; u += G) hgrn_unit(lds, u, PG, pq_->lb_logits, OF, OB, ConvCtx{pq_->moe_w1, pq_->moe_w2, (unsigned char*)W1T, (unsigned char*)W2T});
    }
    xcd_barrier(bar);
    {
        PHASE_ARGS();
    for (int rep = 0; rep < REP_P3; ++rep) {
    for (int it = bid * 8 + wid; it < NTOK * HGH; it += G * 8) hgrn_final_item(it, OF, OB, PG, pq_->hgrn_norm_gain, MIXB, lane);
    for (int t = bid; t < NTOK / 32; t += G) hy_norm_tile(lds, t, Z2T, pq_->hy_norm_gain, MIXB); }
    }
    xcd_barrier(bar);
    {
        PHASE_ARGS();
    for (int u = c; u < 256; u += G) {
        const int xx = u >> 5, j = u & 31;
        const int mt = (xx >> 1) * 8 + (j & 7), nt = (xx & 1) * 4 + (j >> 3);
        Epi8X1 e{pq_->x, X1, mt * 256, nt * 256};
        gemm8_unit<false>(lds, MIXB, DM, nullptr, mt * 256, 256, WOUTT + (size_t)nt * 32 * 16384, 32, e);
    }
    }
    xcd_barrier(bar);
    {
        PHASE_ARGS();
    if (tid < NE) *(LAS int*)(lds + RT_HIST + tid * 4) = 0;
    __syncthreads();
    for (int t = bid; t < NTOK / 16; t += G) router_tile(lds, t, X1, pq_->norm_ffn_gain, pq_->w_router, pq_->b_router, (unsigned char*)XNB, TOPI, TOPG, counts);
    if (tid < NE) { const int hcount = *(const LAS int*)(lds + RT_HIST + tid * 4); if (hcount) atomicAdd(&counts[tid * 32], hcount); }
    }
    xcd_barrier(bar);
    {
        PHASE_ARGS();
    {
        LAS int* so = (LAS int*)lds;
        LAS int* lh = (LAS int*)(lds + 256);
        LAS int* lb2 = (LAS int*)(lds + 512);
        if (tid == 0) { int a = 0; for (int e = 0; e < NE; ++e) { so[e] = a; a += __hip_atomic_load(&counts[e * 32], __ATOMIC_RELAXED, __HIP_MEMORY_SCOPE_AGENT); } so[NE] = a; }
        if (tid < NE) lh[tid] = 0;
        __syncthreads();
        if (bid == 0 && tid <= NE) offs[tid] = so[tid];
        for (int i0 = bid * 512; i0 < NSLOT; i0 += G * 512) {
            const int i = i0 + tid; const int e = TOPI[i];
            const int lpos = atomicAdd((int*)(lh + e), 1);
            __syncthreads();
            if (tid < NE) { const int n = lh[tid]; lb2[tid] = so[tid] + (n ? atomicAdd(&cursor[tid * 32], n) : 0); }
            __syncthreads();
            const int slot = lb2[e] + lpos; STOK[slot] = i >> 2; SOF[i] = slot;
            __syncthreads();
            if (tid < NE) lh[tid] = 0;
            __syncthreads();
        }
    }
    }
    xcd_barrier(bar);
    {
        PHASE_ARGS();
    {
        LAS int* us = (LAS int*)(lds + MEGA_XB + 64); LAS int* so2 = us + 40;
        if (tid == 0) { int a = 0; for (int e = 0; e < NE; ++e) { us[e] = a; a += ((offs[e + 1] - offs[e] + 255) >> 8) * 16; } us[NE] = a; }
        if (tid <= NE) so2[tid] = offs[tid];
        __syncthreads();
    }
    for (int rep = 0; rep < REP_MOEA; ++rep)
    for (;;) {
        LAS int* qs = (LAS int*)(lds + MEGA_XB + 32); LAS int* us = (LAS int*)(lds + MEGA_XB + 64); LAS int* so2 = us + 40;
        if (tid == 0) { qs[0] = atomicAdd((int*)(ws + WS_CTL + 12288 + (bid & 7) * 128 + rep * 32), 1); qs[1] = -1; }
        __syncthreads();
        const int tk = qs[0];
        const int u = 256 * (tk >> 5) + 32 * (bid & 7) + (tk & 31);
        if (tid < NE) { const int u0 = us[tid], u1 = us[tid + 1]; if (u >= u0 && u < u1) { const int o0 = so2[tid], cnt = so2[tid + 1] - o0, mtl = (cnt + 255) >> 8, ul = u - u0, mt = ul % mtl;
            int rows = cnt - mt * 256; rows = rows > 256 ? 256 : rows; qs[1] = tid; qs[2] = ul / mtl; qs[3] = o0 + mt * 256; qs[4] = rows; } }
        __syncthreads();
        const int e = qs[1], nt = qs[2], slot0 = qs[3], rows = qs[4];
        __syncthreads();
        if (e < 0) break;
        Epi8Swiglu8 ep{(unsigned char*)HMB, pq_->moe_b1 + (size_t)e * 2 * DFF, slot0, nt, rows};
        gemm8_unit<false, true>(lds, XNB, DM / 2, STOK + slot0, 0, rows, W1T + (size_t)(e * 16 + nt) * 16 * 16384, 16, ep);
    }
    }
    xcd_barrier(bar);
    {
        PHASE_ARGS();
    {
        LAS int* us = (LAS int*)(lds + MEGA_XB + 64); LAS int* so2 = us + 40;
        if (tid == 0) { int a = 0; for (int e = 0; e < NE; ++e) { us[e] = a; a += ((offs[e + 1] - offs[e] + 255) >> 8) * 8; } us[NE] = a; }
        if (tid <= NE) so2[tid] = offs[tid];
        __syncthreads();
    }
    for (int rep = 0; rep < REP_MOEB; ++rep)
    for (;;) {
        LAS int* qs = (LAS int*)(lds + MEGA_XB + 32); LAS int* us = (LAS int*)(lds + MEGA_XB + 64); LAS int* so2 = us + 40;
        if (tid == 0) { qs[0] = atomicAdd((int*)(ws + WS_CTL + 13312 + (bid & 7) * 128 + rep * 32), 1); qs[1] = -1; }
        __syncthreads();
        const int tk = qs[0];
        const int u = 256 * (tk >> 5) + 32 * (bid & 7) + (tk & 31);
        if (tid < NE) { const int u0 = us[tid], u1 = us[tid + 1]; if (u >= u0 && u < u1) { const int o0 = so2[tid], cnt = so2[tid + 1] - o0, mtl = (cnt + 255) >> 8, ul = u - u0, mt = ul % mtl;
            int rows = cnt - mt * 256; rows = rows > 256 ? 256 : rows; qs[1] = tid; qs[2] = ul / mtl; qs[3] = o0 + mt * 256; qs[4] = rows; } }
        __syncthreads();
        const int e = qs[1], nt = qs[2], slot0 = qs[3], rows = qs[4];
        __syncthreads();
        if (e < 0) break;
        Epi8Y ep{YB, pq_->moe_b2 + (size_t)e * DM, slot0, nt * 256, rows};
        gemm8_unit<false, true>(lds, HMB, DFF / 2, nullptr, slot0, rows, W2T + (size_t)(e * 8 + nt) * 16 * 16384, 16, ep);
    }
    }
    xcd_barrier(bar);
    {
        PHASE_ARGS();
    for (int rep = 0; rep < REP_P9; ++rep)
    for (int tok = bid * 8 + wid; tok < NTOK; tok += G * 8) combine_row(tok, X1, YB, SOF, TOPG, pq_->final_gain, pq_->out, lane);
    }
}
#undef counts
#undef cursor
#undef offs
#undef barw
#undef HB
#undef PG
#undef HYT
#undef MIXB
#undef XNB
#undef HMB
#undef YB
#undef H3
#undef FR
#undef Z2T
#undef OF
#undef OB
#undef X1
#undef TOPI
#undef TOPG
#undef STOK
#undef SOF
#undef WINT
#undef WOUTT
#undef W1T
#undef W2T

extern "C" void kernel_launch(void* const* d_in, const int* in_sizes, int n_in, void* d_out, int out_size, void* d_ws, size_t ws_size, hipStream_t stream) {
    if (n_in < 26 || ws_size < WS_END2) return;
    MegaP p{};
    const float** pp = (const float**)&p;
    for (int i = 0; i < 26; ++i) pp[i] = (const float*)d_in[i];
    p.out = (float*)d_out; p.ws = (unsigned char*)d_ws;
    static int grid = 0;
    if (!grid) {
        int dev = 0, cus = 0, per_cu = 0;
        (void)hipGetDevice(&dev);
        (void)hipDeviceGetAttribute(&cus, hipDeviceAttributeMultiprocessorCount, dev);
        (void)hipFuncSetAttribute((const void*)k_mega, hipFuncAttributeMaxDynamicSharedMemorySize, MEGA_LDS);
        (void)hipOccupancyMaxActiveBlocksPerMultiprocessor(&per_cu, (const void*)k_mega, 512, MEGA_LDS);
        if (per_cu < 1) per_cu = 1;
        grid = cus * 1;
        if (grid > 256) grid = 256;
        grid &= ~7;
        if (grid < 8) grid = 8;
    }
    (void)hipMemsetAsync((char*)d_ws + WS_CTL, 0, 65536, stream);
    hipLaunchKernelGGL(k_mega, dim3(grid), dim3(512), MEGA_LDS, stream, p);
}
```

```cpp
#include <hip/hip_runtime.h>
#include <stdint.h>

constexpr int BATCH = 4, SEQ = 2048, DM = 2048, NTOK = BATCH * SEQ;
constexpr int HGW = 1024, HGD = 128, HGH = 8;
constexpr int HYW = 1024;
constexpr int DIN = 8192;
constexpr int NE = 32, TOPK = 4, DFF = 2048;
constexpr int NSLOT = NTOK * TOPK;
constexpr float EPS = 1e-5f;

constexpr size_t MB = 1024ull * 1024ull;
constexpr size_t WS_CTL = 0;
constexpr size_t WS_HB = 1 * MB;
constexpr size_t WS_PG = WS_HB + 32 * MB;
constexpr size_t WS_HYT = WS_PG + 80 * MB;
constexpr size_t WS_MIXB = WS_HYT + 48 * MB;
constexpr size_t WS_XNB = WS_MIXB + 32 * MB;
constexpr size_t WS_HMB = WS_XNB + 32 * MB;
constexpr size_t WS_YB = WS_HMB + 128 * MB;
constexpr size_t WS_H3 = WS_YB + 128 * MB;
constexpr size_t WS_FR = WS_H3 + 1 * MB;
constexpr size_t WS_Z2T = WS_FR + 34 * MB;
constexpr size_t WS_OF = WS_Z2T + 16 * MB;
constexpr size_t WS_OB = WS_OF + 32 * MB;
constexpr size_t WS_X1 = WS_OB + 32 * MB;
constexpr size_t WS_TOPI = WS_X1 + 64 * MB;
constexpr size_t WS_TOPG = WS_TOPI + 1 * MB;
constexpr size_t WS_STOK = WS_TOPG + 1 * MB;
constexpr size_t WS_SOF = WS_STOK + 1 * MB;
constexpr size_t WS_WINT = WS_SOF + 1 * MB;
constexpr size_t WS_WOUTT = WS_WINT + 32 * MB;
constexpr size_t WS_W1T = WS_WOUTT + 8 * MB;
constexpr size_t WS_W2T = WS_W1T + 512 * MB;
constexpr size_t WS_END2 = WS_W2T + 256 * MB;

typedef short bf16x8 __attribute__((ext_vector_type(8)));
typedef float f32x4 __attribute__((ext_vector_type(4)));
typedef float f32x2 __attribute__((ext_vector_type(2)));
typedef unsigned u32x4 __attribute__((ext_vector_type(4)));
typedef unsigned u32x2 __attribute__((ext_vector_type(2)));
typedef unsigned short u16;
#define LAS __attribute__((address_space(3)))

__device__ __forceinline__ unsigned pk_bf16(float lo, float hi) {
    typedef __bf16 bf2 __attribute__((ext_vector_type(2)));
    const f32x2 v = {lo, hi};
    const bf2 r = __builtin_convertvector(v, bf2);
    return __builtin_bit_cast(unsigned, r);
}
__device__ __forceinline__ float bf2f(u16 b) { return __uint_as_float(((unsigned)b) << 16); }
__device__ __forceinline__ float bflo(unsigned w) { return __uint_as_float(w << 16); }
__device__ __forceinline__ float bfhi(unsigned w) { return __uint_as_float(w & 0xffff0000u); }

__device__ __forceinline__ int lds_byte(int r, int c) { const int st = (r >> 4) * 2 + (c >> 5), ob = (r & 15) * 64 + (c & 31) * 2; return st * 1024 + (ob ^ (((ob >> 9) & 1) << 5)); }
__device__ __forceinline__ void stage_rc(int b, int& R, int& C) { const int st = b >> 10, sb = b & 1023, swz = sb ^ (((sb >> 9) & 1) << 5); R = (st >> 1) * 16 + swz / 64; C = (st & 1) * 32 + (swz % 64) / 2; }
__device__ __forceinline__ f32x4 unperm(const f32x4 a, const bool s) { f32x4 o; o[0] = s ? a[1] : a[0]; o[1] = s ? a[0] : a[1]; o[2] = s ? a[3] : a[2]; o[3] = s ? a[2] : a[3]; return o; }

__device__ __forceinline__ int tid_fresh() { int t = threadIdx.x; asm volatile("" : "+v"(t)); return t; }
constexpr int GEMM_LDS = 131072;

template <bool TRANS, bool RAGGED, int PM = 0, class ColMap, class Epi>
__device__ __forceinline__ void gemm_unit(LAS unsigned char* lds, const u16* __restrict__ A, int lda, const int* __restrict__ arows, int arow0, int rows_valid,
                                          const float* __restrict__ B, int ldb, int K, const ColMap colmap, const Epi epi) {
    const int tid = tid_fresh(), wid = __builtin_amdgcn_readfirstlane(tid >> 6), lane = tid & 63;
    const int wr = wid >> 2, wc = wid & 3, fr = lane & 15, fq = lane >> 4;
    const int nt = K >> 6;
    const char* ap[4];
#pragma unroll
    for (int i = 0; i < 4; ++i) {
        int R, C; stage_rc(wid * 1024 + i * 8192 + lane * 16, R, C);
        const int rr = RAGGED ? (R < rows_valid ? R : rows_valid - 1) : R;
        const long rowid = arows ? (long)arows[rr] : (long)(arow0 + rr);
        ap[i] = (const char*)A + ((size_t)rowid * lda + C) * 2;
    }
    const int g = (lane & 3) + 4 * (wid >> 2), rg = (wid & 3) * 16 + (lane >> 2);
    const unsigned bvoff = (unsigned)(((size_t)(8 * g) * ldb + colmap(rg)) * 4);
    const int bbase = 65536 + lds_byte(4 * rg, 8 * g);
    const int bw0 = bbase + ((rg & 1) ? 64 : 0), bw1 = bbase + ((rg & 1) ? 0 : 64);
    const int aoff = lds_byte(wr * 128 + fr, fq * 8), boff = 65536 + lds_byte(wc * 64 + fr, fq * 8);
    int mvalid = 8;
    if (RAGGED) { mvalid = (rows_valid - wr * 128 + 15) >> 4; mvalid = mvalid < 0 ? 0 : (mvalid > 8 ? 8 : mvalid); }
    f32x4 vb0, vb1, vb2, vb3, vb4, vb5, vb6, vb7;
    if (PM & 1) { vb0 = (f32x4){1.f, 1.f, 1.f, 1.f}; vb1 = vb0; vb2 = vb0; vb3 = vb0; vb4 = vb0; vb5 = vb0; vb6 = vb0; vb7 = vb0; }
    f32x4 acc[8][4];
#pragma unroll
    for (int m = 0; m < 8; ++m)
#pragma unroll
        for (int n = 0; n < 4; ++n) acc[m][n] = (f32x4){0.f, 0.f, 0.f, 0.f};
    const size_t ldb4 = (size_t)ldb * 4;
#define GE_GLDS_A(buf, kt) do { if (!(PM & 2)) _Pragma("unroll") for (int _i = 0; _i < 4; ++_i) \
        __builtin_amdgcn_global_load_lds((const unsigned*)(ap[_i] + (size_t)(kt) * 128), (LAS unsigned*)(lds + (buf) * 32768 + wid * 1024 + _i * 8192), 16, 0, 0); } while (0)
#define GE_LD1(dst, sb) if (!(PM & 1)) asm volatile("global_load_dwordx4 %0, %1, %2" : "=v"(dst) : "v"(bvoff), "s"(sb) : "memory")
#define GE_LOAD_B(kt) do { const char* _sb = (const char*)B + (size_t)(kt) * 64 * ldb4; \
        GE_LD1(vb0, _sb); GE_LD1(vb1, _sb + ldb4); GE_LD1(vb2, _sb + 2 * ldb4); GE_LD1(vb3, _sb + 3 * ldb4); \
        GE_LD1(vb4, _sb + 4 * ldb4); GE_LD1(vb5, _sb + 5 * ldb4); GE_LD1(vb6, _sb + 6 * ldb4); GE_LD1(vb7, _sb + 7 * ldb4); } while (0)
#define GE_WAITV_B(n) asm volatile("s_waitcnt vmcnt(" #n ")" : "+v"(vb0), "+v"(vb1), "+v"(vb2), "+v"(vb3), "+v"(vb4), "+v"(vb5), "+v"(vb6), "+v"(vb7) :: "memory")
#define GE_WRITE_B(buf) do { _Pragma("unroll") for (int _i = 0; _i < 4; ++_i) { u32x4 _w; _w[0] = pk_bf16(vb0[_i], vb1[_i]); _w[1] = pk_bf16(vb2[_i], vb3[_i]); \
        _w[2] = pk_bf16(vb4[_i], vb5[_i]); _w[3] = pk_bf16(vb6[_i], vb7[_i]); \
        *(LAS u32x4*)(lds + ((_i & 1) ? bw1 : bw0) + (_i >> 1) * 128 + (buf) * 32768) = _w; } } while (0)
#define GE_KSTEP(buf, ks) do { bf16x8 Bf[4]; \
        _Pragma("unroll") for (int n = 0; n < 4; ++n) Bf[n] = *(const LAS bf16x8*)(lds + (buf) * 32768 + boff + n * 2048 + (ks) * 1024); \
        _Pragma("unroll") for (int mh = 0; mh < 2; ++mh) { bf16x8 At[4]; \
            _Pragma("unroll") for (int m = 0; m < 4; ++m) At[m] = *(const LAS bf16x8*)(lds + (buf) * 32768 + aoff + (mh * 4 + m) * 2048 + (ks) * 1024); \
            _Pragma("unroll") for (int m = 0; m < 4; ++m) { if (!RAGGED || (mh * 4 + m) < mvalid) { _Pragma("unroll") for (int n = 0; n < 4; ++n) \
                { if (PM & 4) { asm volatile("" :: "v"(At[m]), "v"(Bf[n])); } else acc[mh * 4 + m][n] = TRANS ? __builtin_amdgcn_mfma_f32_16x16x32_bf16(At[m], Bf[n], acc[mh * 4 + m][n], 0, 0, 0) : __builtin_amdgcn_mfma_f32_16x16x32_bf16(Bf[n], At[m], acc[mh * 4 + m][n], 0, 0, 0); } } } } } while (0)
    GE_GLDS_A(0, 0);
    GE_LOAD_B(0);
    GE_WAITV_B(0);
    GE_WRITE_B(0);
    GE_LOAD_B(1);
    asm volatile("s_waitcnt lgkmcnt(0)" ::: "memory");
    __builtin_amdgcn_s_barrier();
    int t = 0;
    for (; t < nt - 2; ++t) {
        const int cur = t & 1;
        GE_GLDS_A(cur ^ 1, t + 1);
        GE_KSTEP(cur, 0);
        GE_WAITV_B(4);
        GE_WRITE_B(cur ^ 1);
        GE_LOAD_B(t + 2);
        __builtin_amdgcn_sched_barrier(0);
        GE_KSTEP(cur, 1);
        asm volatile("s_waitcnt vmcnt(8) lgkmcnt(0)" ::: "memory");
        __builtin_amdgcn_s_barrier();
    }
    {
        const int cur = t & 1;
        GE_GLDS_A(cur ^ 1, t + 1);
        GE_KSTEP(cur, 0);
        GE_WAITV_B(4);
        GE_WRITE_B(cur ^ 1);
        GE_KSTEP(cur, 1);
        asm volatile("s_waitcnt vmcnt(0) lgkmcnt(0)" ::: "memory");
        __builtin_amdgcn_s_barrier();
        ++t;
    }
    {
        const int cur = t & 1;
        GE_KSTEP(cur, 0);
        GE_KSTEP(cur, 1);
        asm volatile("s_waitcnt lgkmcnt(0)" ::: "memory");
        __builtin_amdgcn_s_barrier();
    }
#undef GE_GLDS_A
#undef GE_LD1
#undef GE_LOAD_B
#undef GE_WAITV_B
#undef GE_WRITE_B
#undef GE_KSTEP
    __builtin_amdgcn_sched_barrier(0);
    { const int tz = tid_fresh(), wz = __builtin_amdgcn_readfirstlane(tz >> 6), lz = tz & 63;
      epi(acc, wz >> 2, wz & 3, lz & 15, lz >> 4); }
}

__device__ __forceinline__ int xcd_logical(int b, int G) { return (G & 7) ? b : (b & 7) * (G >> 3) + (b >> 3); }

struct ColMapDense { int c0; __device__ __forceinline__ int operator()(int rg) const { return c0 + 4 * rg; } };
struct EpiPG { u16* PG; int tok0, col0;
    __device__ __forceinline__ void operator()(const f32x4 (&acc)[8][4], int wr, int wc, int fr, int fq) const {
#pragma unroll
        for (int m = 0; m < 8; ++m) { u16* rowp = PG + (size_t)(tok0 + wr * 128 + m * 16 + fr) * 5120 + col0 + wc * 64 + 4 * fq;
#pragma unroll
            for (int n = 0; n < 4; ++n) { const f32x4 v = unperm(acc[m][n], fq & 1); u32x2 w; w[0] = pk_bf16(v[0], v[1]); w[1] = pk_bf16(v[2], v[3]); *(u32x2*)(rowp + n * 16) = w; } }
    } };
struct EpiHYT { u16* HYT; int tok0, col0;
    __device__ __forceinline__ void operator()(const f32x4 (&acc)[8][4], int wr, int wc, int fr, int fq) const {
#pragma unroll
        for (int n = 0; n < 4; ++n) { const int rho = wc * 64 + n * 16 + fr; const int col = col0 + (rho & ~3) + ((rho & 3) ^ ((rho >> 2) & 1));
            u16* colp = HYT + (size_t)col * NTOK + tok0 + wr * 128 + 4 * fq;
#pragma unroll
            for (int m = 0; m < 8; ++m) { const f32x4 v = acc[m][n]; u32x2 w; w[0] = pk_bf16(v[0], v[1]); w[1] = pk_bf16(v[2], v[3]); *(u32x2*)(colp + m * 16) = w; } }
    } };
struct EpiX1 { const float* x; float* X1; int tok0, col0;
    __device__ __forceinline__ void operator()(const f32x4 (&acc)[8][4], int wr, int wc, int fr, int fq) const {
#pragma unroll
        for (int m = 0; m < 8; ++m) { const size_t off = (size_t)(tok0 + wr * 128 + m * 16 + fr) * DM + col0 + wc * 64 + 4 * fq;
#pragma unroll
            for (int n = 0; n < 4; ++n) { const f32x4 r = *(const f32x4*)(x + off + n * 16); *(f32x4*)(X1 + off + n * 16) = r + unperm(acc[m][n], fq & 1); }
            asm volatile("" ::: "memory"); }
    } };
struct ColMapGlu { int nt; __device__ __forceinline__ int operator()(int rg) const { const int wcq = rg >> 4, n = (rg >> 2) & 3, f = rg & 3; return (n >> 1) * 2048 + nt * 128 + wcq * 32 + (n & 1) * 16 + f * 4; } };
struct EpiSwiglu { u16* HM; const float* b1; int slot0, nt, rows_valid;
    __device__ __forceinline__ void operator()(const f32x4 (&acc)[8][4], int wr, int wc, int fr, int fq) const {
        f32x4 bg[2], bl[2];
#pragma unroll
        for (int nn = 0; nn < 2; ++nn) { const int col = nt * 128 + wc * 32 + nn * 16 + 4 * fq; bg[nn] = *(const f32x4*)(b1 + col); bl[nn] = *(const f32x4*)(b1 + 2048 + col); }
#pragma unroll
        for (int m = 0; m < 8; ++m) { const int row = wr * 128 + m * 16 + fr;
            if (row < rows_valid) {
#pragma unroll
                for (int nn = 0; nn < 2; ++nn) { const f32x4 gl = unperm(acc[m][nn], fq & 1) + bg[nn], li = unperm(acc[m][nn + 2], fq & 1) + bl[nn]; float o[4];
#pragma unroll
                    for (int j = 0; j < 4; ++j) { const float gq = fminf(gl[j], 7.0f), lq = fminf(fmaxf(li[j], -7.0f), 7.0f); o[j] = gq * (1.0f / (1.0f + __expf(-1.702f * gq))) * (lq + 1.0f); }
                    u32x2 w; w[0] = pk_bf16(o[0], o[1]); w[1] = pk_bf16(o[2], o[3]);
                    *(u32x2*)(HM + (size_t)(slot0 + row) * DFF + nt * 128 + wc * 32 + nn * 16 + 4 * fq) = w; } } }
    } };
struct EpiY { u16* Y; const float* b2; int slot0, col0, rows_valid;
    __device__ __forceinline__ void operator()(const f32x4 (&acc)[8][4], int wr, int wc, int fr, int fq) const {
        f32x4 bv[4];
#pragma unroll
        for (int n = 0; n < 4; ++n) bv[n] = *(const f32x4*)(b2 + col0 + wc * 64 + n * 16 + 4 * fq);
#pragma unroll
        for (int m = 0; m < 8; ++m) { const int row = wr * 128 + m * 16 + fr;
            if (row < rows_valid) { u16* rowp = Y + (size_t)(slot0 + row) * DM + col0 + wc * 64 + 4 * fq;
#pragma unroll
                for (int n = 0; n < 4; ++n) { const f32x4 v = unperm(acc[m][n], fq & 1) + bv[n]; u32x2 w; w[0] = pk_bf16(v[0], v[1]); w[1] = pk_bf16(v[2], v[3]); *(u32x2*)(rowp + n * 16) = w; } } }
    } };
template <int NTILES>
__device__ __forceinline__ bool moe_decode(const int* __restrict__ offs, int u, int& e, int& mt, int& nt, int& slot0, int& rows) {
    int base = 0;
    for (int q = 0; q < NE; ++q) { const int o0 = offs[q], cnt = offs[q + 1] - o0, mtl = (cnt + 255) >> 8, nu = mtl * NTILES;
        if (u < base + nu) { const int ul = u - base; e = q; mt = ul % mtl; nt = ul / mtl; slot0 = o0 + mt * 256; rows = cnt - mt * 256; if (rows > 256) rows = 256; return true; }
        base += nu; }
    return false;
}


__device__ __forceinline__ int perm_col4(int rg) { const int rgl = rg & 31, t = rgl & 7; return 32 * (rgl >> 3) + 8 * (t & 3) + 4 * (t >> 2); }
__device__ __forceinline__ int perm32(int rho) { const int n = rho >> 4, i = rho & 15; return 8 * (i >> 2) + 4 * n + (i & 3); }
template <class ColMap>
__device__ __forceinline__ void convert_tile(const float* __restrict__ W, int ldb, int k0, const ColMap colmap, u16* __restrict__ dst, int tid) {
    const int wid = tid >> 6, lane = tid & 63;
    const int g = (lane & 3) + 4 * (wid >> 2), rg = (wid & 3) * 16 + (lane >> 2);
    const float* bp = W + (size_t)(k0 + 8 * g) * ldb + colmap(rg);
    f32x4 v[8];
#pragma unroll
    for (int kk = 0; kk < 8; ++kk) v[kk] = __builtin_nontemporal_load((const f32x4*)(bp + (size_t)kk * ldb));
    const int h = rg >> 5, r0 = (4 * rg) & 127;
    unsigned char* base = (unsigned char*)dst + h * 16384 + lds_byte(r0, 8 * g);
#pragma unroll
    for (int i = 0; i < 4; ++i) { u32x4 w; w[0] = pk_bf16(v[0][i], v[1][i]); w[1] = pk_bf16(v[2][i], v[3][i]); w[2] = pk_bf16(v[4][i], v[5][i]); w[3] = pk_bf16(v[6][i], v[7][i]);
        *(u32x4*)(base + i * 64) = w; }
}
typedef int i32x8 __attribute__((ext_vector_type(8)));
typedef int i32x4 __attribute__((ext_vector_type(4)));
constexpr float W8_SCALE = 32.0f;
constexpr int W8_MX = 0x7A7A7A7A;
constexpr int A8_MX = 0x7F7F7F7F;
__device__ __forceinline__ unsigned pk_fp8x4(float a, float b, float c, float d) { int p = __builtin_amdgcn_cvt_pk_fp8_f32(a, b, 0, false); p = __builtin_amdgcn_cvt_pk_fp8_f32(c, d, p, true); return (unsigned)p; }
__device__ __forceinline__ int lds_byte_b(int r, int cb) { const int st = (r >> 4) * 2 + (cb >> 6), ob = (r & 15) * 64 + (cb & 63); return st * 1024 + (ob ^ (((ob >> 9) & 1) << 5)); }
struct ConvCtx { const float* w1; const float* w2; unsigned char* W1T; unsigned char* W2T; };
__device__ __forceinline__ int conv_seq2tile(int s) {
    if (s < 16384) return (s >> 9) * 512 + (s & 15) * 32 + ((s >> 4) & 31);
    const int q = s - 16384; return 16384 + (q >> 8) * 256 + (q & 7) * 32 + ((q >> 3) & 31);
}
__device__ __forceinline__ void conv_issue(const ConvCtx& cc, int m, int wid, int lane, f32x2 (&v)[16]) {
    const int rp = 16 * wid + (lane & 15), rg = rp >> 1, p2 = (rp & 1) * 2, kg = lane >> 4;
    const float* bp; size_t ld;
    if (m < 16384) { const int e = m >> 9, nt = (m >> 5) & 15, kt = m & 31; ld = 2 * DFF; bp = cc.w1 + (size_t)e * DM * 2 * DFF + (size_t)(kt * 64 + 16 * kg) * ld + (rg >> 5) * 2048 + nt * 128 + perm_col4(rg) + p2; }
    else { const int q = m - 16384, e = q >> 8, nt = (q >> 5) & 7, kt = q & 31; ld = DM; bp = cc.w2 + (size_t)e * DFF * DM + (size_t)(kt * 64 + 16 * kg) * ld + nt * 256 + (rg >> 5) * 128 + perm_col4(rg) + p2; }
#pragma unroll
    for (int kk = 0; kk < 16; ++kk) v[kk] = __builtin_nontemporal_load((const f32x2*)(bp + (size_t)kk * ld));
}
__device__ __forceinline__ void conv_finish(const ConvCtx& cc, int m, int wid, int lane, const f32x2 (&v)[16]) {
    const int rp = 16 * wid + (lane & 15), kg = lane >> 4;
    const int kt64 = m & 31;
    unsigned char* dst = (m < 16384) ? cc.W1T + ((size_t)(m >> 5) * 16 + (kt64 >> 1)) * 32768 : cc.W2T + ((size_t)((m - 16384) >> 5) * 16 + (kt64 >> 1)) * 32768;
    unsigned char* base = dst + (rp >> 6) * 16384 + lds_byte_b((2 * rp) & 127, (kt64 & 1) * 64 + 16 * kg);
#pragma unroll
    for (int i = 0; i < 2; ++i) { u32x4 w;
#pragma unroll
        for (int q = 0; q < 4; ++q) w[q] = pk_fp8x4(v[4 * q][i] * W8_SCALE, v[4 * q + 1][i] * W8_SCALE, v[4 * q + 2][i] * W8_SCALE, v[4 * q + 3][i] * W8_SCALE);
        __builtin_nontemporal_store(w, (u32x4*)(base + i * 64)); }
}
struct ColMapGluT { int nt; __device__ __forceinline__ int operator()(int rg) const { return (rg >> 5) * 2048 + nt * 128 + perm_col4(rg); } };
struct ColMapPerm { int c0; __device__ __forceinline__ int operator()(int rg) const { return c0 + (rg >> 5) * 128 + perm_col4(rg); } };

template <bool TRANS, bool FP8 = false, class Epi>
__device__ __forceinline__ void gemm8_unit(LAS unsigned char* lds, const u16* __restrict__ A, int lda, const int* __restrict__ arows, int arow0, int rows_valid, const u16* __restrict__ Bt, int nt, const Epi epi) {
    const int tid = tid_fresh(), wid = __builtin_amdgcn_readfirstlane(tid >> 6), lane = tid & 63;
    const int wr = wid >> 2, wc = wid & 3, fr = lane & 15, fq = lane >> 4;
    unsigned aof[2][2];
#pragma unroll
    for (int h = 0; h < 2; ++h)
#pragma unroll
        for (int i = 0; i < 2; ++i) { int R, C; stage_rc(tid * 16 + i * 8192, R, C); int rr = h * 128 + R; rr = rr < rows_valid ? rr : rows_valid - 1;
            const unsigned rowid = arows ? (unsigned)arows[rr] : (unsigned)(arow0 + rr); aof[h][i] = (rowid * (unsigned)lda + (unsigned)C) * 2u; }
    const char* Ab = (const char*)A; const char* Bb = (const char*)Bt + tid * 16;
    const bool hi = rows_valid > 128;
    int mxw = W8_MX, mxa = A8_MX; asm volatile("" : "+v"(mxw), "+v"(mxa));
#define G8_SA(b, h) (((b) * 2 + (h)) * 16384)
#define G8_SB(b, h) (65536 + ((b) * 2 + (h)) * 16384)
#define G8_STA(b, h, kt) do { _Pragma("unroll") for (int _i = 0; _i < 2; ++_i) \
        __builtin_amdgcn_global_load_lds((const unsigned*)(Ab + aof[h][_i] + (size_t)(kt) * 128), (LAS unsigned*)(lds + G8_SA(b, h) + wid * 1024 + _i * 8192), 16, 0, 0); } while (0)
#define G8_STB(b, h, kt) do { _Pragma("unroll") for (int _i = 0; _i < 2; ++_i) \
        __builtin_amdgcn_global_load_lds((const unsigned*)(Bb + (size_t)(kt) * 32768 + (h) * 16384 + _i * 8192), (LAS unsigned*)(lds + G8_SB(b, h) + wid * 1024 + _i * 8192), 16, 0, 0); } while (0)
#define G8_LDA(dst, b, h) do { _Pragma("unroll") for (int m = 0; m < 4; ++m) _Pragma("unroll") for (int k = 0; k < 2; ++k) dst[m][k] = *(const LAS bf16x8*)(lds + G8_SA(b, h) + aoff + m * 2048 + k * 1024); } while (0)
#define G8_LDB(dst, b, h) do { _Pragma("unroll") for (int n = 0; n < 2; ++n) _Pragma("unroll") for (int k = 0; k < 2; ++k) dst[n][k] = *(const LAS bf16x8*)(lds + G8_SB(b, h) + boff + n * 2048 + k * 1024); } while (0)
#define G8_MMA(ai, bj, At, Bq) do { if ((ai) == 0 || hi) { __builtin_amdgcn_s_setprio(1); _Pragma("unroll") for (int m = 0; m < 4; ++m) _Pragma("unroll") for (int n = 0; n < 2; ++n) { \
        if (FP8) { const i32x4 a0 = __builtin_bit_cast(i32x4, At[m][0]), a1 = __builtin_bit_cast(i32x4, At[m][1]), b0 = __builtin_bit_cast(i32x4, Bq[n][0]), b1 = __builtin_bit_cast(i32x4, Bq[n][1]); \
            const i32x8 a8 = __builtin_shufflevector(a0, a1, 0, 1, 2, 3, 4, 5, 6, 7), b8 = __builtin_shufflevector(b0, b1, 0, 1, 2, 3, 4, 5, 6, 7); \
            asm volatile("v_mfma_scale_f32_16x16x128_f8f6f4 %0, %1, %2, %0, %3, %4 op_sel_hi:[0,0,0]" : "+v"(acc[ai][bj][m][n]) : "v"(b8), "v"(a8), "v"(mxw), "v"(mxa)); } \
        else { _Pragma("unroll") for (int k = 0; k < 2; ++k) \
            acc[ai][bj][m][n] = TRANS ? __builtin_amdgcn_mfma_f32_16x16x32_bf16(At[m][k], Bq[n][k], acc[ai][bj][m][n], 0, 0, 0) : __builtin_amdgcn_mfma_f32_16x16x32_bf16(Bq[n][k], At[m][k], acc[ai][bj][m][n], 0, 0, 0); } } \
        __builtin_amdgcn_s_setprio(0); } } while (0)
#define G8_WV(n) asm volatile("s_waitcnt vmcnt(" #n ")" ::: "memory")
#define G8_WL(n) asm volatile("s_waitcnt lgkmcnt(" #n ")" ::: "memory")
#define G8_BAR __builtin_amdgcn_s_barrier()
#define G8_SCHED __builtin_amdgcn_sched_barrier(0)
    const int aoff = lds_byte(wr * 64 + fr, fq * 8), boff = lds_byte(wc * 32 + fr, fq * 8);
    f32x4 acc[2][2][4][2];
#pragma unroll
    for (int a = 0; a < 2; ++a)
#pragma unroll
        for (int b = 0; b < 2; ++b)
#pragma unroll
            for (int m = 0; m < 4; ++m)
#pragma unroll
                for (int n = 0; n < 2; ++n) acc[a][b][m][n] = (f32x4){0.f, 0.f, 0.f, 0.f};
    bf16x8 At[4][2], B0[2][2], B1[2][2];
    G8_STB(0, 0, 0); G8_STA(0, 0, 0); G8_STB(0, 1, 0); G8_STA(0, 1, 0);
    if (wr == 1) G8_BAR;
    G8_WV(4); G8_BAR;
    G8_STB(1, 0, 1); G8_STA(1, 0, 1); G8_STB(1, 1, 1);
    G8_WV(6); G8_BAR;
    for (int t = 0; t < nt - 2; t += 2) {
        G8_LDB(B0, 0, 0); G8_SCHED; G8_LDA(At, 0, 0); G8_STA(1, 1, t + 1);
        G8_WL(8); G8_BAR; G8_WL(0); G8_MMA(0, 0, At, B0); G8_BAR; G8_SCHED;
        G8_LDB(B1, 0, 1); G8_STB(0, 0, t + 2);
        G8_BAR; G8_WL(0); G8_MMA(0, 1, At, B1); G8_BAR;
        G8_LDA(At, 0, 1); G8_STA(0, 0, t + 2);
        G8_BAR; G8_WL(0); G8_MMA(1, 0, At, B0); G8_BAR; G8_SCHED;
        G8_STB(0, 1, t + 2);
        G8_WV(6); G8_BAR; G8_MMA(1, 1, At, B1); G8_BAR;
        G8_LDB(B0, 1, 0); G8_SCHED; G8_LDA(At, 1, 0); G8_STA(0, 1, t + 2);
        G8_WL(8); G8_BAR; G8_WL(0); G8_MMA(0, 0, At, B0); G8_BAR; G8_SCHED;
        G8_LDB(B1, 1, 1); G8_STB(1, 0, t + 3);
        G8_BAR; G8_WL(0); G8_MMA(0, 1, At, B1); G8_BAR;
        G8_LDA(At, 1, 1); G8_STA(1, 0, t + 3);
        G8_BAR; G8_WL(0); G8_MMA(1, 0, At, B0); G8_BAR; G8_SCHED;
        G8_STB(1, 1, t + 3);
        G8_WV(6); G8_BAR; G8_MMA(1, 1, At, B1); G8_BAR;
    }
    { G8_LDB(B0, 0, 0); G8_WV(0); G8_LDA(At, 0, 0); G8_STA(1, 1, nt - 1);
      G8_BAR; G8_WL(0); G8_MMA(0, 0, At, B0); G8_BAR;
      G8_LDB(B1, 0, 1); G8_BAR; G8_WL(0); G8_MMA(0, 1, At, B1); G8_BAR;
      G8_LDA(At, 0, 1); G8_WV(4); G8_BAR; G8_WL(0); G8_MMA(1, 0, At, B0); G8_MMA(1, 1, At, B1); G8_BAR; }
    { G8_LDB(B0, 1, 0); G8_LDA(At, 1, 0); G8_WV(2); G8_BAR; G8_WL(0); G8_MMA(0, 0, At, B0); G8_BAR;
      G8_LDB(B1, 1, 1); G8_WV(0); G8_BAR; G8_WL(0); G8_MMA(0, 1, At, B1); G8_BAR;
      G8_LDA(At, 1, 1); G8_BAR; G8_WL(0); G8_MMA(1, 0, At, B0); G8_MMA(1, 1, At, B1); G8_BAR; }
    if (wr == 0) G8_BAR;
#undef G8_SA
#undef G8_SB
#undef G8_STA
#undef G8_STB
#undef G8_LDA
#undef G8_LDB
#undef G8_MMA
#undef G8_WV
#undef G8_WL
#undef G8_BAR
#undef G8_SCHED
    __builtin_amdgcn_sched_barrier(0);
    { const int tz = tid_fresh(), wz = __builtin_amdgcn_readfirstlane(tz >> 6), lz = tz & 63;
      epi(acc, wz >> 2, wz & 3, lz & 15, lz >> 4); }
}
struct StreamUnit { const char* A; const char* Bt; int arow0, rows, a, b, c; };
template <bool TRANS, bool FP8, class Src>
__device__ __forceinline__ void gemm8_stream(LAS unsigned char* lds, unsigned lda, int nt, const Src& src) {
    const int tid = tid_fresh(), wid = __builtin_amdgcn_readfirstlane(tid >> 6), lane = tid & 63;
    const int wr = wid >> 2, wc = wid & 3, fr = lane & 15, fq = lane >> 4;
    StreamUnit cur, nxt;
    if (!src.get(0, cur)) return;
    int R0, C0, R1, C1; stage_rc(tid * 16, R0, C0); stage_rc(tid * 16 + 8192, R1, C1);
    int mxw = W8_MX, mxa = A8_MX; asm volatile("" : "+v"(mxw), "+v"(mxa));
    const int aoff = lds_byte(wr * 64 + fr, fq * 8), boff = lds_byte(wc * 32 + fr, fq * 8);
#define GS_AOF(u, h, R, C) ((unsigned)(((unsigned)((u).arow0 + (((h) * 128 + (R)) < (u).rows ? ((h) * 128 + (R)) : (u).rows - 1)) * lda + (unsigned)(C)) * 2u))
    unsigned ac00 = GS_AOF(cur, 0, R0, C0), ac01 = GS_AOF(cur, 0, R1, C1), ac10 = GS_AOF(cur, 1, R0, C0), ac11 = GS_AOF(cur, 1, R1, C1);
#define GS_SA(b, h) (((b) * 2 + (h)) * 16384)
#define GS_SB(b, h) (65536 + ((b) * 2 + (h)) * 16384)
#define GS_GL(src_, dst_) __builtin_amdgcn_global_load_lds((const unsigned*)(src_), (LAS unsigned*)(lds + (dst_)), 16, 0, 0)
#define GS_STA(b, h, base, o0, o1, kt) do { GS_GL((base) + (o0) + (size_t)(kt) * 128, GS_SA(b, h) + wid * 1024); GS_GL((base) + (o1) + (size_t)(kt) * 128, GS_SA(b, h) + wid * 1024 + 8192); } while (0)
#define GS_STB(b, h, base, kt) do { GS_GL((base) + tid * 16 + (size_t)(kt) * 32768 + (h) * 16384, GS_SB(b, h) + wid * 1024); GS_GL((base) + tid * 16 + (size_t)(kt) * 32768 + (h) * 16384 + 8192, GS_SB(b, h) + wid * 1024 + 8192); } while (0)
#define GS_LDA(dst, b, h) do { _Pragma("unroll") for (int m = 0; m < 4; ++m) _Pragma("unroll") for (int k = 0; k < 2; ++k) dst[m][k] = *(const LAS bf16x8*)(lds + GS_SA(b, h) + aoff + m * 2048 + k * 1024); } while (0)
#define GS_LDB(dst, b, h) do { _Pragma("unroll") for (int n = 0; n < 2; ++n) _Pragma("unroll") for (int k = 0; k < 2; ++k) dst[n][k] = *(const LAS bf16x8*)(lds + GS_SB(b, h) + boff + n * 2048 + k * 1024); } while (0)
#define GS_MMA(ai, bj, At, Bq) do { if ((ai) == 0 || hi) { __builtin_amdgcn_s_setprio(1); _Pragma("unroll") for (int m = 0; m < 4; ++m) _Pragma("unroll") for (int n = 0; n < 2; ++n) { \
        if (FP8) { const i32x4 a0 = __builtin_bit_cast(i32x4, At[m][0]), a1 = __builtin_bit_cast(i32x4, At[m][1]), b0 = __builtin_bit_cast(i32x4, Bq[n][0]), b1 = __builtin_bit_cast(i32x4, Bq[n][1]); \
            const i32x8 a8 = __builtin_shufflevector(a0, a1, 0, 1, 2, 3, 4, 5, 6, 7), b8 = __builtin_shufflevector(b0, b1, 0, 1, 2, 3, 4, 5, 6, 7); \
            asm volatile("v_mfma_scale_f32_16x16x128_f8f6f4 %0, %1, %2, %0, %3, %4 op_sel_hi:[0,0,0]" : "+v"(acc[ai][bj][m][n]) : "v"(b8), "v"(a8), "v"(mxw), "v"(mxa)); } \
        else { _Pragma("unroll") for (int k = 0; k < 2; ++k) \
            acc[ai][bj][m][n] = TRANS ? __builtin_amdgcn_mfma_f32_16x16x32_bf16(At[m][k], Bq[n][k], acc[ai][bj][m][n], 0, 0, 0) : __builtin_amdgcn_mfma_f32_16x16x32_bf16(Bq[n][k], At[m][k], acc[ai][bj][m][n], 0, 0, 0); } } \
        __builtin_amdgcn_s_setprio(0); } } while (0)
#define GS_WV(n) asm volatile("s_waitcnt vmcnt(" #n ")" ::: "memory")
#define GS_WL(n) asm volatile("s_waitcnt lgkmcnt(" #n ")" ::: "memory")
#define GS_BAR __builtin_amdgcn_s_barrier()
#define GS_SCHED __builtin_amdgcn_sched_barrier(0)
    f32x4 acc[2][2][4][2];
#pragma unroll
    for (int a = 0; a < 2; ++a)
#pragma unroll
        for (int b = 0; b < 2; ++b)
#pragma unroll
            for (int m = 0; m < 4; ++m)
#pragma unroll
                for (int n = 0; n < 2; ++n) acc[a][b][m][n] = (f32x4){0.f, 0.f, 0.f, 0.f};
    bf16x8 At[4][2], B0[2][2], B1[2][2];
    GS_STB(0, 0, cur.Bt, 0); GS_STA(0, 0, cur.A, ac00, ac01, 0); GS_STB(0, 1, cur.Bt, 0); GS_STA(0, 1, cur.A, ac10, ac11, 0);
    if (wr == 1) GS_BAR;
    GS_WV(4); GS_BAR;
    GS_STB(1, 0, cur.Bt, 1); GS_STA(1, 0, cur.A, ac00, ac01, 1); GS_STB(1, 1, cur.Bt, 1);
    GS_WV(6); GS_BAR;
    for (int ui = 0;; ++ui) {
        const bool has_next = src.get(ui + 1, nxt);
        if (!has_next) nxt = cur;
        const unsigned an00 = GS_AOF(nxt, 0, R0, C0), an01 = GS_AOF(nxt, 0, R1, C1), an10 = GS_AOF(nxt, 1, R0, C0), an11 = GS_AOF(nxt, 1, R1, C1);
        const bool hi = cur.rows > 128;
        for (int t = 0; t < nt; t += 2) {
            const bool last = (t == nt - 2);
            const char* xA = last ? nxt.A : cur.A; const char* xB = last ? nxt.Bt : cur.Bt;
            const unsigned x00 = last ? an00 : ac00, x01 = last ? an01 : ac01, x10 = last ? an10 : ac10, x11 = last ? an11 : ac11;
            const int k2 = last ? 0 : t + 2, k3 = k2 + 1;
            GS_LDB(B0, 0, 0); GS_SCHED; GS_LDA(At, 0, 0); GS_STA(1, 1, cur.A, ac10, ac11, t + 1);
            GS_WL(8); GS_BAR; GS_WL(0); GS_MMA(0, 0, At, B0); GS_BAR; GS_SCHED;
            GS_LDB(B1, 0, 1); GS_STB(0, 0, xB, k2);
            GS_BAR; GS_WL(0); GS_MMA(0, 1, At, B1); GS_BAR;
            GS_LDA(At, 0, 1); GS_STA(0, 0, xA, x00, x01, k2);
            GS_BAR; GS_WL(0); GS_MMA(1, 0, At, B0); GS_BAR; GS_SCHED;
            GS_STB(0, 1, xB, k2);
            GS_WV(6); GS_BAR; GS_MMA(1, 1, At, B1); GS_BAR;
            GS_LDB(B0, 1, 0); GS_SCHED; GS_LDA(At, 1, 0); GS_STA(0, 1, xA, x10, x11, k2);
            GS_WL(8); GS_BAR; GS_WL(0); GS_MMA(0, 0, At, B0); GS_BAR; GS_SCHED;
            GS_LDB(B1, 1, 1); GS_STB(1, 0, xB, k3);
            GS_BAR; GS_WL(0); GS_MMA(0, 1, At, B1); GS_BAR;
            GS_LDA(At, 1, 1); GS_STA(1, 0, xA, x00, x01, k3);
            GS_BAR; GS_WL(0); GS_MMA(1, 0, At, B0); GS_BAR; GS_SCHED;
            GS_STB(1, 1, xB, k3);
            GS_WV(6); GS_BAR; GS_MMA(1, 1, At, B1); GS_BAR;
        }
        __builtin_amdgcn_sched_barrier(0);
        src.epi(acc, cur, wr, wc, fr, fq);
        __builtin_amdgcn_sched_barrier(0);
        if (!has_next) break;
#pragma unroll
        for (int a = 0; a < 2; ++a)
#pragma unroll
            for (int b = 0; b < 2; ++b)
#pragma unroll
                for (int m = 0; m < 4; ++m)
#pragma unroll
                    for (int n = 0; n < 2; ++n) acc[a][b][m][n] = (f32x4){0.f, 0.f, 0.f, 0.f};
        cur = nxt; ac00 = an00; ac01 = an01; ac10 = an10; ac11 = an11;
    }
    GS_WV(0);
    if (wr == 0) GS_BAR;
    GS_BAR;
#undef GS_AOF
#undef GS_SA
#undef GS_SB
#undef GS_GL
#undef GS_STA
#undef GS_STB
#undef GS_LDA
#undef GS_LDB
#undef GS_MMA
#undef GS_WV
#undef GS_WL
#undef GS_BAR
#undef GS_SCHED
}
struct Epi8PG { u16* PG; int tok0, col0;
    __device__ __forceinline__ void operator()(const f32x4 (&acc)[2][2][4][2], int wr, int wc, int fr, int fq) const {
#pragma unroll
        for (int ai = 0; ai < 2; ++ai)
#pragma unroll
            for (int m = 0; m < 4; ++m) { u16* rowp = PG + (size_t)(tok0 + ai * 128 + wr * 64 + m * 16 + fr) * 5120 + col0 + wc * 32 + 8 * fq;
#pragma unroll
                for (int bj = 0; bj < 2; ++bj) { const f32x4 v0 = acc[ai][bj][m][0], v1 = acc[ai][bj][m][1];
                    *(u32x4*)(rowp + bj * 128) = (u32x4){pk_bf16(v0[0], v0[1]), pk_bf16(v0[2], v0[3]), pk_bf16(v1[0], v1[1]), pk_bf16(v1[2], v1[3])}; } }
    } };
struct Epi8HYT { u16* HYT; int tok0, col0;
    __device__ __forceinline__ void operator()(const f32x4 (&acc)[2][2][4][2], int wr, int wc, int fr, int fq) const {
#pragma unroll
        for (int bj = 0; bj < 2; ++bj)
#pragma unroll
            for (int n = 0; n < 2; ++n) { u16* colp = HYT + (size_t)(col0 + bj * 128 + wc * 32 + perm32(n * 16 + fr)) * NTOK + tok0 + wr * 64 + 4 * fq;
#pragma unroll
                for (int ai = 0; ai < 2; ++ai)
#pragma unroll
                    for (int m = 0; m < 4; ++m) { const f32x4 v = acc[ai][bj][m][n]; *(u32x2*)(colp + ai * 128 + m * 16) = (u32x2){pk_bf16(v[0], v[1]), pk_bf16(v[2], v[3])}; } }
    } };
struct Epi8X1 { const float* x; float* X1; int tok0, col0;
    __device__ __forceinline__ void operator()(const f32x4 (&acc)[2][2][4][2], int wr, int wc, int fr, int fq) const {
#pragma unroll
        for (int ai = 0; ai < 2; ++ai)
#pragma unroll
            for (int m = 0; m < 4; ++m) { const size_t off = (size_t)(tok0 + ai * 128 + wr * 64 + m * 16 + fr) * DM + col0 + wc * 32 + 8 * fq;
#pragma unroll
                for (int bj = 0; bj < 2; ++bj)
#pragma unroll
                    for (int n = 0; n < 2; ++n) { const f32x4 r = *(const f32x4*)(x + off + bj * 128 + n * 4); *(f32x4*)(X1 + off + bj * 128 + n * 4) = r + acc[ai][bj][m][n]; }
                asm volatile("" ::: "memory"); }
    } };
struct Epi8Swiglu { u16* HM; const float* b1; int slot0, nt, rows_valid;
    __device__ __forceinline__ void operator()(const f32x4 (&acc)[2][2][4][2], int wr, int wc, int fr, int fq) const {
        f32x4 bg[2], bl[2];
#pragma unroll
        for (int n = 0; n < 2; ++n) { const int col = nt * 128 + wc * 32 + 8 * fq + 4 * n; bg[n] = *(const f32x4*)(b1 + col); bl[n] = *(const f32x4*)(b1 + 2048 + col); }
#pragma unroll
        for (int ai = 0; ai < 2; ++ai)
#pragma unroll
            for (int m = 0; m < 4; ++m) { const int row = ai * 128 + wr * 64 + m * 16 + fr;
                if (row < rows_valid) { float o[8];
#pragma unroll
                    for (int n = 0; n < 2; ++n) { const f32x4 gl = acc[ai][0][m][n] + bg[n], li = acc[ai][1][m][n] + bl[n];
#pragma unroll
                        for (int j = 0; j < 4; ++j) { const float gq = fminf(gl[j], 7.0f), lq = fminf(fmaxf(li[j], -7.0f), 7.0f); o[4 * n + j] = gq * (1.0f / (1.0f + __expf(-1.702f * gq))) * (lq + 1.0f); } }
                    *(u32x4*)(HM + (size_t)(slot0 + row) * DFF + nt * 128 + wc * 32 + 8 * fq) = (u32x4){pk_bf16(o[0], o[1]), pk_bf16(o[2], o[3]), pk_bf16(o[4], o[5]), pk_bf16(o[6], o[7])}; } }
    } };
struct Epi8Swiglu8 { unsigned char* HM; const float* b1; int slot0, nt, rows_valid;
    __device__ __forceinline__ void operator()(const f32x4 (&acc)[2][2][4][2], int wr, int wc, int fr, int fq) const {
        f32x4 bg[2], bl[2];
#pragma unroll
        for (int n = 0; n < 2; ++n) { const int col = nt * 128 + wc * 32 + 8 * fq + 4 * n; bg[n] = *(const f32x4*)(b1 + col); bl[n] = *(const f32x4*)(b1 + 2048 + col); }
#pragma unroll
        for (int ai = 0; ai < 2; ++ai)
#pragma unroll
            for (int m = 0; m < 4; ++m) { const int row = ai * 128 + wr * 64 + m * 16 + fr;
                if (row < rows_valid) { float o[8];
#pragma unroll
                    for (int n = 0; n < 2; ++n) { const f32x4 gl = acc[ai][0][m][n] + bg[n], li = acc[ai][1][m][n] + bl[n];
#pragma unroll
                        for (int j = 0; j < 4; ++j) { const float gq = fminf(gl[j], 7.0f), lq = fminf(fmaxf(li[j], -7.0f), 7.0f); o[4 * n + j] = gq * (1.0f / (1.0f + __expf(-1.702f * gq))) * (lq + 1.0f); } }
                    *(u32x2*)(HM + (size_t)(slot0 + row) * DFF + nt * 128 + wc * 32 + 8 * fq) = (u32x2){pk_fp8x4(o[0], o[1], o[2], o[3]), pk_fp8x4(o[4], o[5], o[6], o[7])}; } }
    } };
struct Epi8Y { u16* Y; const float* b2; int slot0, col0, rows_valid;
    __device__ __forceinline__ void operator()(const f32x4 (&acc)[2][2][4][2], int wr, int wc, int fr, int fq) const {
        f32x4 bv[2][2];
#pragma unroll
        for (int bj = 0; bj < 2; ++bj)
#pragma unroll
            for (int n = 0; n < 2; ++n) bv[bj][n] = *(const f32x4*)(b2 + col0 + bj * 128 + wc * 32 + 8 * fq + 4 * n);
#pragma unroll
        for (int ai = 0; ai < 2; ++ai)
#pragma unroll
            for (int m = 0; m < 4; ++m) { const int row = ai * 128 + wr * 64 + m * 16 + fr;
                if (row < rows_valid) { u16* rowp = Y + (size_t)(slot0 + row) * DM + col0 + wc * 32 + 8 * fq;
#pragma unroll
                    for (int bj = 0; bj < 2; ++bj) { const f32x4 v0 = acc[ai][bj][m][0] + bv[bj][0], v1 = acc[ai][bj][m][1] + bv[bj][1];
                        *(u32x4*)(rowp + bj * 128) = (u32x4){pk_bf16(v0[0], v0[1]), pk_bf16(v0[2], v0[3]), pk_bf16(v1[0], v1[1]), pk_bf16(v1[2], v1[3])}; } } }
    } };
struct EpiNone { __device__ __forceinline__ void operator()(const f32x4 (&acc)[2][2][4][2], int wr, int wc, int fr, int fq) const {
#pragma unroll
        for (int a = 0; a < 2; ++a)
#pragma unroll
            for (int b = 0; b < 2; ++b)
#pragma unroll
                for (int m = 0; m < 4; ++m)
#pragma unroll
                    for (int n = 0; n < 2; ++n) asm volatile("" :: "v"(acc[a][b][m][n]));
    } };

template <int NTILES>
__device__ __forceinline__ bool moe_unit_static(const LAS int* us, const LAS int* so2, int uu, int& e, int& nt, int& slot0, int& rows) {
    if (uu >= us[NE]) return false;
    int lo = 0, hi = NE;
#pragma unroll
    for (int s = 0; s < 5; ++s) { const int mid = (lo + hi) >> 1; if (us[mid] <= uu) lo = mid; else hi = mid; }
    e = lo; const int o0 = so2[e], cnt = so2[e + 1] - o0, mtl = (cnt + 255) >> 8, ul = uu - us[e], mt = ul % mtl;
    nt = ul / mtl; slot0 = o0 + mt * 256; rows = cnt - mt * 256; rows = rows > 256 ? 256 : rows; return true;
}
struct SrcMoeB { const LAS int* us; const LAS int* so2; int c, G; const char* HM8; const char* W2T8; u16* YB; const float* b2;
    __device__ __forceinline__ bool get(int i, StreamUnit& u) const { int e, nt, slot0, rows; if (!moe_unit_static<8>(us, so2, c + i * G, e, nt, slot0, rows)) return false;
        u.A = HM8; u.Bt = W2T8 + (size_t)((e * 8 + nt) * 16) * 32768; u.arow0 = slot0; u.rows = rows; u.a = e; u.b = nt; u.c = slot0; return true; }
    __device__ __forceinline__ void epi(const f32x4 (&acc)[2][2][4][2], const StreamUnit& u, int wr, int wc, int fr, int fq) const { Epi8Y ep{YB, b2 + (size_t)u.a * DM, u.c, u.b * 256, u.rows}; ep(acc, wr, wc, fr, fq); }
};
template <bool TRANS>
struct SrcG1 { int c, G; const char* HBp; const char* WINTp; u16* PG; u16* HYT;
    __device__ __forceinline__ bool get(int k, StreamUnit& su) const {
        int seen = 0;
        for (int u = c; u < 1024; u += G) { const int i = u >> 8, xx = (u >> 5) & 7, j = u & 31; const int mt = (xx & 3) * 8 + (j & 7), nt = ((xx >> 2) + 2 * i) * 4 + (j >> 3);
            if ((nt >= 20) == TRANS) { if (seen == k) { su.A = HBp; su.Bt = WINTp + (size_t)nt * 32 * 32768; su.arow0 = mt * 256; su.rows = 256; su.a = mt; su.b = nt; su.c = 0; return true; } ++seen; } }
        return false; }
    __device__ __forceinline__ void epi(const f32x4 (&acc)[2][2][4][2], const StreamUnit& u, int wr, int wc, int fr, int fq) const {
        if (TRANS) { Epi8HYT e{HYT, u.a * 256, u.b * 256 - 5120}; e(acc, wr, wc, fr, fq); } else { Epi8PG e{PG, u.a * 256, u.b * 256}; e(acc, wr, wc, fr, fq); } }
};

typedef float f32x16 __attribute__((ext_vector_type(16)));
__device__ __forceinline__ void h3_row(int m, const float* __restrict__ w1, const float* __restrict__ b1, const float* __restrict__ w2, const float* __restrict__ b2,
                                       const float* __restrict__ w3, const float* __restrict__ b3, const float* __restrict__ freq, LAS float* sc  , float* __restrict__ H3) {
    const int j = tid_fresh() & 63;
    const float tt = (float)m / (float)(SEQ - 1);
    if (j == 0) sc[0] = tt;
    if (j >= 1 && j <= 16) { const int i = j - 1; const float band = 1e-4f + (float)i * ((15.0f - 1e-4f) / 15.0f); const float ang = (2.0f * 3.14159265358979323846f / (float)SEQ) * (float)m * band; sc[1 + i] = cosf(ang); sc[17 + i] = -sinf(ang); }
    __builtin_amdgcn_wave_barrier();
    const float fr = freq[j];
    float s = b1[j];
    for (int i = 0; i < 33; ++i) s += sc[i] * w1[i * 64 + j];
    const float h1 = sinf(fr * s);
    sc[64 + j] = h1;
    __builtin_amdgcn_wave_barrier();
    s = b2[j];
    for (int i = 0; i < 64; ++i) s += sc[64 + i] * w2[i * 64 + j];
    const float h2 = sinf(fr * s);
    __builtin_amdgcn_wave_barrier();
    sc[j] = h2;
    __builtin_amdgcn_wave_barrier();
    s = b3[j];
    for (int i = 0; i < 64; ++i) s += sc[i] * w3[i * 64 + j];
    H3[(size_t)m * 64 + j] = sinf(fr * s);
    __builtin_amdgcn_wave_barrier();
}
constexpr int FR_LEN = 4128;
__device__ __forceinline__ void frgen_item(LAS unsigned char* lds, int item, const float* __restrict__ H3, const float* __restrict__ w4, u16* __restrict__ FR) {
    const int tid = tid_fresh(), wid = __builtin_amdgcn_readfirstlane(tid >> 6), lane = tid & 63, fr = lane & 15, fq = lane >> 4;
    const int oc0 = item * 8, o = oc0 >> 10;
    const int colB = o * 2048 + (fr >> 3) * 1024 + (oc0 & 1023) + (fr & 7);
    float wreg[16];
#pragma unroll
    for (int ks = 0; ks < 16; ++ks) wreg[ks] = w4[(size_t)(4 * ks + fq) * 4096 + colB];
    const int dir = fr >> 3, c = (oc0 & 1023) + (fr & 7);
    const float mind = logf(1e-2f) / 0.3f, maxd = logf(1e-2f) / 1.5f;
    const float delta = fabsf(mind + (float)c * ((maxd - mind) / 1023.0f));
    u16* r0 = FR + (size_t)((oc0 + (fr & 7)) * 2) * FR_LEN;
    LAS float* tile = (LAS float*)(lds + wid * 4608);
    const int wrow = lane >> 4, wcol = 4 * (lane & 15);
    f32x4 nx[4];
#pragma unroll
    for (int q = 0; q < 4; ++q) nx[q] = *(const f32x4*)(H3 + (size_t)wid * 1024 + q * 256 + lane * 4);
    for (int it = 0; it < 16; ++it) {
        const int mt = wid + 8 * it;
#pragma unroll
        for (int q = 0; q < 4; ++q) *(LAS f32x4*)(tile + (q * 4 + wrow) * 68 + wcol) = nx[q];
        if (it + 1 < 16) {
#pragma unroll
            for (int q = 0; q < 4; ++q) nx[q] = *(const f32x4*)(H3 + (size_t)(mt + 8) * 1024 + q * 256 + lane * 4);
        }
        f32x4 acc = {0.f, 0.f, 0.f, 0.f};
#pragma unroll
        for (int ks = 0; ks < 16; ++ks) acc = __builtin_amdgcn_mfma_f32_16x16x4f32(tile[fr * 68 + 4 * ks + fq], wreg[ks], acc, 0, 0, 0);
        const int m0 = mt * 16 + 4 * fq;
        float v[4];
#pragma unroll
        for (int j = 0; j < 4; ++j) v[j] = acc[j] * __expf(-((float)(m0 + j) / (float)(SEQ - 1)) * delta);
        if (dir == 0) {
            *(u32x2*)(r0 + 2044 - m0) = (u32x2){pk_bf16(v[3], v[2]), pk_bf16(v[1], v[0])};
#pragma unroll
            for (int j = 0; j < 4; ++j) r0[FR_LEN + 2046 - m0 - j] = (u16)(pk_bf16(v[j], 0.f) & 0xffffu);
        } else {
#pragma unroll
            for (int j = 0; j < 4; ++j) if (m0 + j >= 1) { const u16 b = (u16)(pk_bf16(v[j], 0.f) & 0xffffu); r0[2047 + m0 + j] = b; r0[FR_LEN + 2046 + m0 + j] = b; }
        }
    }
    if (tid < 8 * 34) { const int r = tid / 34, x = 4094 + tid % 34; u16* rr = FR + (size_t)((oc0 + r) * 2) * FR_LEN; if (x >= 4095) rr[x] = 0; rr[FR_LEN + x] = 0; }
    __syncthreads();
}
constexpr int HY_ZSTRIDE = 2312;
constexpr int HY_ZCH = 256 + 4 * HY_ZSTRIDE;
constexpr int HY_ZBYTES = HY_ZCH * 2;
constexpr int HY_FB = 4 * HY_ZBYTES;
constexpr int HY_FCH = 2 * FR_LEN * 2;
constexpr int HY_LDS = HY_FB + 4 * HY_FCH;

__device__ __forceinline__ void hy_load_row(LAS unsigned char* lds, int dest, int boff0, int bstride, const u16* __restrict__ row, float w0, float w1, float w2, float cb, int pl) {
#pragma unroll 2
    for (int it = 0; it < 8; ++it) {
        const int idx = pl + 128 * it, tok0 = idx * 8, b = tok0 >> 11, n0 = tok0 & 2047;
        const u32x4 raw = *(const u32x4*)(row + tok0);
        const float pm = (n0 > 0) ? bf2f(row[tok0 - 1]) : 0.f;
        const float pn = (n0 + 8 < SEQ) ? bf2f(row[tok0 + 8]) : 0.f;
        float p[10];
        p[0] = pm; p[9] = pn;
#pragma unroll
        for (int q = 0; q < 4; ++q) { p[1 + 2 * q] = bflo(raw[q]); p[2 + 2 * q] = bfhi(raw[q]); }
        float o[8];
#pragma unroll
        for (int q = 0; q < 8; ++q) o[q] = fmaf(w0, p[q], fmaf(w1, p[q + 1], fmaf(w2, p[q + 2], cb)));
        u32x4 w; w[0] = pk_bf16(o[0], o[1]); w[1] = pk_bf16(o[2], o[3]); w[2] = pk_bf16(o[4], o[5]); w[3] = pk_bf16(o[6], o[7]);
        *(LAS u32x4*)(lds + dest + (boff0 + b * bstride + n0) * 2) = w;
    }
}
__device__ __forceinline__ void hy_load_filters(LAS unsigned char* lds, int fb, const u16* __restrict__ src, int pl) {
    for (int idx = pl; idx < HY_FCH / 16; idx += 128) *(LAS u32x4*)(lds + fb + idx * 16) = *(const u32x4*)((const char*)src + idx * 16);
}
__device__ __forceinline__ void hy_mfma_loop(LAS unsigned char* lds, int zb, int fb, int hlf, int lane, f32x16 (&acc)[4], const ConvCtx& cc, int mbase, int cunit, int wid) {
    const int r = lane & 31, hh = lane >> 5, il = r >> 2, b = r & 3;
    const int bbase = zb + (256 + b * HY_ZSTRIDE + 32 * il + 8 * hh) * 2;
    const int xl = 2047 - r + 8 * hh - 1024 * hlf;
    const int abase = (r & 1) ? (fb + 2 * xl) : (fb + FR_LEN * 2 + 2 * (xl - 1));
#pragma unroll
    for (int q = 0; q < 4; ++q)
#pragma unroll
        for (int i = 0; i < 16; ++i) acc[q][i] = 0.f;
    for (int d0 = 0; d0 < 8; ++d0) {
#pragma unroll
        for (int ks = 0; ks < 2; ++ks) {
            f32x2 cv[16];
            const int mcv = conv_seq2tile((mbase + d0 * 2 + ks) * 256 + cunit);
            conv_issue(cc, mcv, wid, lane, cv);
            bf16x8 Bt[9];
#pragma unroll
            for (int j = 0; j < 9; ++j) Bt[j] = *(const LAS bf16x8*)(lds + bbase + 512 * j - 64 * d0 + 32 * ks);
#pragma unroll
            for (int ep = -8; ep <= 3; ++ep) {
                const LAS unsigned* ap = (const LAS unsigned*)(lds + abase - 64 * d0 - 512 * ep + 32 * ks);
                u32x4 av; av[0] = ap[0]; av[1] = ap[1]; av[2] = ap[2]; av[3] = ap[3];
                const bf16x8 a = __builtin_bit_cast(bf16x8, av);
#pragma unroll
                for (int ctl = 0; ctl < 4; ++ctl) { const int jt = ctl - ep; if (jt >= 0 && jt <= 8) acc[ctl] = __builtin_amdgcn_mfma_f32_32x32x16_bf16(a, Bt[jt], acc[ctl], 0, 0, 0); }
            }
            conv_finish(cc, mcv, wid, lane, cv);
        }
    }
}
__device__ __forceinline__ void hy_epilogue(LAS unsigned char* lds, int zb, int gb, int hlf, int lane, const f32x16 (&acc)[4], float bias) {
    const int r = lane & 31, hh = lane >> 5, il = r >> 2, b = r & 3;
#pragma unroll
    for (int ctl = 0; ctl < 4; ++ctl) {
        const int I = 8 * (4 * hlf + ctl) + il;
#pragma unroll
        for (int q = 0; q < 4; ++q) {
            const int n4 = 32 * I + 8 * q + 4 * hh;
            LAS u32x2* zp = (LAS u32x2*)(lds + zb + (256 + b * HY_ZSTRIDE + n4) * 2);
            const u32x2 zv = *zp, gv = *(const LAS u32x2*)(lds + gb + (b * 2048 + n4) * 2);
            const float z0 = bflo(zv[0]), z1 = bfhi(zv[0]), z2 = bflo(zv[1]), z3 = bfhi(zv[1]);
            const float g0 = bflo(gv[0]), g1 = bfhi(gv[0]), g2 = bflo(gv[1]), g3 = bfhi(gv[1]);
            u32x2 o; o[0] = pk_bf16(g0 * fmaf(bias, z0, acc[ctl][4 * q + 0]), g1 * fmaf(bias, z1, acc[ctl][4 * q + 1]));
            o[1] = pk_bf16(g2 * fmaf(bias, z2, acc[ctl][4 * q + 2]), g3 * fmaf(bias, z3, acc[ctl][4 * q + 3]));
            *zp = o;
        }
    }
}
__device__ __forceinline__ void hyena_unit(LAS unsigned char* lds, int unit, const u16* __restrict__ HYT, const u16* __restrict__ FR, const float* __restrict__ cw, const float* __restrict__ cbv,
                                           const float* __restrict__ hbias, u16* __restrict__ Z2T, const ConvCtx& cc) {
    const int tid = tid_fresh(), wid = __builtin_amdgcn_readfirstlane(tid >> 6), lane = tid & 63;
    const int cs = wid & 3, hlf = wid >> 2, c = unit * 4 + cs, pl = lane + 64 * hlf;
    const int zb = cs * HY_ZBYTES, fb = HY_FB + cs * HY_FCH;
    { const u32x4 z = {0u, 0u, 0u, 0u}; for (int idx = pl; idx < HY_ZBYTES / 16; idx += 128) *(LAS u32x4*)(lds + zb + idx * 16) = z; }
    __syncthreads();
    hy_load_row(lds, zb, 256, HY_ZSTRIDE, HYT + (size_t)c * NTOK, cw[0 * 3072 + c], cw[1 * 3072 + c], cw[2 * 3072 + c], cbv[c], pl);
    f32x16 acc[4];
#pragma unroll
    for (int o = 0; o < 2; ++o) {
        hy_load_filters(lds, fb, FR + (size_t)((o * 1024 + c) * 2) * FR_LEN, pl);
        __syncthreads();
        hy_mfma_loop(lds, zb, fb, hlf, lane, acc, cc, o * 16, unit, wid);
        __syncthreads();
        const int gc = (1 + o) * 1024 + c;
        hy_load_row(lds, fb, 0, 2048, HYT + (size_t)gc * NTOK, cw[0 * 3072 + gc], cw[1 * 3072 + gc], cw[2 * 3072 + gc], cbv[gc], pl);
        __syncthreads();
        hy_epilogue(lds, zb, fb, hlf, lane, acc, hbias[o * HYW + c]);
        __syncthreads();
    }
#pragma unroll 2
    for (int it = 0; it < 8; ++it) { const int idx = pl + 128 * it, tok0 = idx * 8, b = tok0 >> 11, n0 = tok0 & 2047;
        *(u32x4*)(Z2T + (size_t)c * NTOK + tok0) = *(const LAS u32x4*)(lds + zb + (256 + b * HY_ZSTRIDE + n0) * 2); }
    __syncthreads();
}

constexpr int HG_RAWQ = 0, HG_RAWF = 16384, HG_RAWV = 32768;
constexpr int HG_QM = 36864, HG_KM = HG_QM + 17408, HG_QI = HG_KM + 17408;
constexpr int HG_KL = HG_QI + 17408;
constexpr int HG_VT = HG_KL + 18432;
constexpr int HG_P = HG_VT + 4608;
constexpr int HG_ST = HG_P + 9216;
constexpr int HG_TOT = HG_ST + 8704;
constexpr int HG_EL2 = HG_TOT + 2048;
constexpr int HG_LDS = HG_EL2 + 512;

__device__ __forceinline__ void hgrn_unit(LAS unsigned char* lds, int unit, const u16* __restrict__ PG, const float* __restrict__ lb_logits, float* __restrict__ OF, float* __restrict__ OB, const ConvCtx& cc) {
    const int tid = tid_fresh(), wid = __builtin_amdgcn_readfirstlane(tid >> 6), lane = tid & 63, fr = lane & 15, fq = lane >> 4;
    const int vq = unit & 3, dir = (unit >> 2) & 1, h = (unit >> 3) & 7, b = unit >> 6;
    const int k = tid & 127, seg = tid >> 7;
    float* __restrict__ O = dir ? OB : OF;
    float lb;
    { const int c = h * 128 + k; const float l0 = lb_logits[(0 * 2 + dir) * HGW + c], l1 = lb_logits[(1 * 2 + dir) * HGW + c]; lb = 1.0f / (1.0f + __expf(l1 - l0)); }
    for (int i = tid; i < 8704 / 16; i += 512) *(LAS u32x4*)(lds + HG_ST + i * 16) = (u32x4){0u, 0u, 0u, 0u};
    f32x4 Sacc[2];
    Sacc[0] = (f32x4){0.f, 0.f, 0.f, 0.f}; Sacc[1] = Sacc[0];
    u32x4 pq[2], pf[2], pv;
    const int colq = h * 128, colf = (1 + dir) * 1024 + h * 128, colv = 3072 + h * 128 + vq * 32;
#define HG_TOK(c, tau) ((size_t)b * SEQ + (dir ? (SEQ - 1 - 64 * (c) - (tau)) : (64 * (c) + (tau))))
#define HG_PREFETCH(c) do { _Pragma("unroll") for (int _i = 0; _i < 2; ++_i) { const int _x = tid + 512 * _i, _tau = _x >> 4, _p = _x & 15; const u16* _r = PG + HG_TOK(c, _tau) * 5120; \
            pq[_i] = *(const u32x4*)(_r + colq + _p * 8); pf[_i] = *(const u32x4*)(_r + colf + _p * 8); } \
        if (tid < 256) { const int _tau = tid >> 2, _p = tid & 3; pv = *(const u32x4*)(PG + HG_TOK(c, _tau) * 5120 + colv + _p * 8); } } while (0)
    HG_PREFETCH(0);
    for (int c = 0; c < 32; ++c) {
#pragma unroll
        for (int i = 0; i < 2; ++i) { const int x = tid + 512 * i; *(LAS u32x4*)(lds + HG_RAWQ + x * 16) = pq[i]; *(LAS u32x4*)(lds + HG_RAWF + x * 16) = pf[i]; }
        if (tid < 256) *(LAS u32x4*)(lds + HG_RAWV + tid * 16) = pv;
        if (c + 1 < 32) HG_PREFETCH(c + 1);
        f32x2 cv[16];
        const int mqa = conv_seq2tile((32 + c * 2) * 256 + unit), mqb = conv_seq2tile((33 + c * 2) * 256 + unit);
        conv_issue(cc, mqa, wid, lane, cv);
        __syncthreads();
        float qv[16], kv[16], bl[16];
        { float run = 0.f;
#pragma unroll
          for (int i = 0; i < 16; ++i) { const int tau = seg * 16 + i;
              const float qr = bf2f(*(const LAS u16*)(lds + HG_RAWQ + tau * 256 + k * 2)), zf = bf2f(*(const LAS u16*)(lds + HG_RAWF + tau * 256 + k * 2));
              const float sg = 1.0f / (1.0f + __expf(-zf)); const float f = lb + (1.0f - lb) * sg;
              run += __logf(f); bl[i] = run; kv[i] = 1.0f - f; qv[i] = qr / (1.0f + __expf(-qr)); }
          *(LAS float*)(lds + HG_TOT + (seg * 128 + k) * 4) = run; }
        __syncthreads();
        { const float t0 = *(const LAS float*)(lds + HG_TOT + (0 * 128 + k) * 4), t1 = *(const LAS float*)(lds + HG_TOT + (1 * 128 + k) * 4),
                      t2 = *(const LAS float*)(lds + HG_TOT + (2 * 128 + k) * 4), t3 = *(const LAS float*)(lds + HG_TOT + (3 * 128 + k) * 4);
          const float pre = (seg > 0 ? t0 : 0.f) + (seg > 1 ? t1 : 0.f) + (seg > 2 ? t2 : 0.f);
          const float bref = t0 + t1, blast = bref + t2 + t3;
          const float er = __expf(bref), el = __expf(blast - bref);
          if (seg == 0) *(LAS float*)(lds + HG_EL2 + k * 4) = __expf(blast);
          unsigned klp[8];
#pragma unroll
          for (int i = 0; i < 16; i += 2) {
              float klv[2];
#pragma unroll
              for (int u = 0; u < 2; ++u) { const int tau = seg * 16 + i + u; const float bb = pre + bl[i + u];
                  const float e1 = __expf(bb - bref), e2 = __expf(bref - bb);
                  const float qm = qv[i + u] * e1, km = kv[i + u] * e2;
                  *(LAS u16*)(lds + HG_QM + tau * 272 + k * 2) = (u16)(pk_bf16(qm, 0.f) & 0xffffu);
                  *(LAS u16*)(lds + HG_KM + tau * 272 + k * 2) = (u16)(pk_bf16(km, 0.f) & 0xffffu);
                  *(LAS u16*)(lds + HG_QI + tau * 272 + k * 2) = (u16)(pk_bf16(qm * er, 0.f) & 0xffffu);
                  klv[u] = km * el; }
              klp[i >> 1] = pk_bf16(klv[0], klv[1]); }
          *(LAS u32x4*)(lds + HG_KL + k * 144 + seg * 32) = (u32x4){klp[0], klp[1], klp[2], klp[3]};
          *(LAS u32x4*)(lds + HG_KL + k * 144 + seg * 32 + 16) = (u32x4){klp[4], klp[5], klp[6], klp[7]};
          { const int v = tid & 31, tg = tid >> 5; unsigned short e[4];
#pragma unroll
            for (int u = 0; u < 4; ++u) e[u] = *(const LAS u16*)(lds + HG_RAWV + (tg * 4 + u) * 64 + v * 2);
            *(LAS u32x2*)(lds + HG_VT + v * 144 + tg * 8) = (u32x2){(unsigned)e[0] | ((unsigned)e[1] << 16), (unsigned)e[2] | ((unsigned)e[3] << 16)}; } }
        conv_finish(cc, mqa, wid, lane, cv);
        conv_issue(cc, mqb, wid, lane, cv);
        __syncthreads();
#pragma unroll
        for (int q = 0; q < 2; ++q) { const int idx = wid * 2 + q, ti = idx >> 2, si = idx & 3;
            f32x4 a = {0.f, 0.f, 0.f, 0.f};
            if (si <= ti) {
#pragma unroll
                for (int ks = 0; ks < 4; ++ks) { const bf16x8 ka = *(const LAS bf16x8*)(lds + HG_KM + (si * 16 + fr) * 272 + (ks * 32 + fq * 8) * 2), qb = *(const LAS bf16x8*)(lds + HG_QM + (ti * 16 + fr) * 272 + (ks * 32 + fq * 8) * 2);
                    a = __builtin_amdgcn_mfma_f32_16x16x32_bf16(ka, qb, a, 0, 0, 0); } }
            const int tau = ti * 16 + fr, s0 = si * 16 + fq * 4;
            float pvv[4];
#pragma unroll
            for (int j = 0; j < 4; ++j) pvv[j] = (si <= ti && s0 + j <= tau) ? a[j] : 0.f;
            *(LAS u32x2*)(lds + HG_P + tau * 144 + s0 * 2) = (u32x2){pk_bf16(pvv[0], pvv[1]), pk_bf16(pvv[2], pvv[3])}; }
        const int ti = wid >> 1, vi = wid & 1;
        f32x4 oacc = {0.f, 0.f, 0.f, 0.f};
#pragma unroll
        for (int ks = 0; ks < 4; ++ks) { const bf16x8 qa = *(const LAS bf16x8*)(lds + HG_QI + (ti * 16 + fr) * 272 + (ks * 32 + fq * 8) * 2), sb = *(const LAS bf16x8*)(lds + HG_ST + (vi * 16 + fr) * 272 + (ks * 32 + fq * 8) * 2);
            oacc = __builtin_amdgcn_mfma_f32_16x16x32_bf16(qa, sb, oacc, 0, 0, 0); }
        { const f32x4 e2 = *(const LAS f32x4*)(lds + HG_EL2 + (wid * 16 + fq * 4) * 4);
#pragma unroll
          for (int v2 = 0; v2 < 2; ++v2) { Sacc[v2] = Sacc[v2] * e2;
#pragma unroll
              for (int ks = 0; ks < 2; ++ks) { const bf16x8 ka = *(const LAS bf16x8*)(lds + HG_KL + (wid * 16 + fr) * 144 + (ks * 32 + fq * 8) * 2), vb = *(const LAS bf16x8*)(lds + HG_VT + (v2 * 16 + fr) * 144 + (ks * 32 + fq * 8) * 2);
                  Sacc[v2] = __builtin_amdgcn_mfma_f32_16x16x32_bf16(ka, vb, Sacc[v2], 0, 0, 0); } } }
        __syncthreads();
#pragma unroll
        for (int ks = 0; ks < 2; ++ks) { const bf16x8 pa = *(const LAS bf16x8*)(lds + HG_P + (ti * 16 + fr) * 144 + (ks * 32 + fq * 8) * 2), vb = *(const LAS bf16x8*)(lds + HG_VT + (vi * 16 + fr) * 144 + (ks * 32 + fq * 8) * 2);
            oacc = __builtin_amdgcn_mfma_f32_16x16x32_bf16(pa, vb, oacc, 0, 0, 0); }
#pragma unroll
        for (int j = 0; j < 4; ++j) { const int tau = ti * 16 + fq * 4 + j; O[HG_TOK(c, tau) * HGW + h * 128 + vq * 32 + vi * 16 + fr] = oacc[j]; }
        conv_finish(cc, mqb, wid, lane, cv);
#pragma unroll
        for (int v2 = 0; v2 < 2; ++v2) *(LAS u32x2*)(lds + HG_ST + (v2 * 16 + fr) * 272 + (wid * 16 + fq * 4) * 2) = (u32x2){pk_bf16(Sacc[v2][0], Sacc[v2][1]), pk_bf16(Sacc[v2][2], Sacc[v2][3])};
    }
    __syncthreads();
#undef HG_TOK
#undef HG_PREFETCH
}


#define XB_TMO      128
#define XB_XCNT(j)  (256  + 64 * (j))
#define XB_XSUB(j)  (1280 + 64 * (j))
#define XB_XGEN(j)  (2304 + 64 * (j))
#define XB_TOP      3328
#define XB_TOPGEN   3392
#define XCD_BAR_WORDS 3456
#define XB_SPIN_CAP (1u << 22)

__device__ __forceinline__ unsigned xb_ld(unsigned* p)              { return __hip_atomic_load(p, __ATOMIC_RELAXED, __HIP_MEMORY_SCOPE_AGENT); }
__device__ __forceinline__ unsigned xb_add(unsigned* p, unsigned v) { return __hip_atomic_fetch_add(p, v, __ATOMIC_RELAXED, __HIP_MEMORY_SCOPE_AGENT); }
__device__ __forceinline__ unsigned xb_xcc_id() { return (unsigned)__builtin_amdgcn_s_getreg((3 << 11) | 20) & 0xFu; }
#define XB_SPIN(cond, bar) do { unsigned _sp = 0; while (cond) { __builtin_amdgcn_s_sleep(1); \
    if ((++_sp & 255u) == 0u) { if (xb_ld(&(bar)[XB_TMO])) break; if (_sp > XB_SPIN_CAP) { atomicAdd(&(bar)[XB_TMO], 1u); break; } } } } while (0)

struct XcdBarrier {
    unsigned* bar; unsigned x;
    volatile LAS unsigned* st;
};

__device__ __forceinline__ XcdBarrier xcd_barrier_post(unsigned* bar, volatile LAS unsigned* st) {
    XcdBarrier b; b.bar = bar; b.x = xb_xcc_id(); b.st = st;
    if (threadIdx.x == 0) (void)xb_add(&bar[XB_XCNT(b.x)], 1u);
    return b;
}
__device__ __forceinline__ void xcd_barrier_complete(unsigned* bar, unsigned x, unsigned& nloc, unsigned& nx) {
    const unsigned G = gridDim.x * gridDim.y * gridDim.z;
    unsigned sum, cnt, mine, sp = 0u;
    for (;;) {
        sum = 0u; cnt = 0u; mine = 0u;
#pragma unroll
        for (unsigned j = 0; j < 16; ++j) { const unsigned c = xb_ld(&bar[XB_XCNT(j)]); sum += c; cnt += (c > 0u) ? 1u : 0u; mine = (j == x) ? c : mine; }
        if (sum == G) break;
        __builtin_amdgcn_s_sleep(1);
        if ((++sp & 255u) == 0u) { if (xb_ld(&bar[XB_TMO])) break; if (sp > XB_SPIN_CAP) { atomicAdd(&bar[XB_TMO], 1u); break; } }
    }
    nloc = mine > 0u ? mine : 1u; nx = cnt > 0u ? cnt : 1u;
}

__device__ __forceinline__ void xcd_barrier(const XcdBarrier& b) {
    asm volatile("s_waitcnt vmcnt(0)" ::: "memory");
    __syncthreads();
    if (threadIdx.x == 0) {
        unsigned* bar = b.bar;
        __builtin_amdgcn_s_waitcnt(0);
        unsigned nloc = b.st[0], nx = b.st[1];
        if (nloc == 0u) { xcd_barrier_complete(bar, b.x, nloc, nx); b.st[0] = nloc; b.st[1] = nx; }
        const unsigned old = xb_add(&bar[XB_XSUB(b.x)], 1u);
        const unsigned gen = old / nloc;
        if (old + 1u == (gen + 1u) * nloc) {
            __builtin_amdgcn_fence(__ATOMIC_RELEASE, "agent");
            asm volatile("s_waitcnt vmcnt(0)" ::: "memory");
            const unsigned og = xb_add(&bar[XB_TOP], 1u);
            const unsigned tg = og / nx;
            if (og + 1u == (tg + 1u) * nx) xb_add(&bar[XB_TOPGEN], 1u);
            else XB_SPIN(xb_ld(&bar[XB_TOPGEN]) == tg, bar);
            __builtin_amdgcn_fence(__ATOMIC_ACQUIRE, "agent");
            xb_add(&bar[XB_XGEN(b.x)], 1u);
            asm volatile("s_waitcnt vmcnt(0)" ::: "memory");
        } else {
            XB_SPIN(xb_ld(&bar[XB_XGEN(b.x)]) == gen, bar);
            __builtin_amdgcn_fence(__ATOMIC_ACQUIRE, "agent");
            asm volatile("s_waitcnt vmcnt(0)" ::: "memory");
        }
    }
    __syncthreads();
}

__device__ __forceinline__ float wave_sum(float s) {
#pragma unroll
    for (int o = 32; o >= 1; o >>= 1) s += __shfl_xor(s, o);
    return s;
}
__device__ __forceinline__ void rmsnorm_row_bf(const float* __restrict__ xr, const float* __restrict__ gain, u16* __restrict__ ob, int lane) {
    f32x4 v[8]; float s = 0.f;
#pragma unroll
    for (int j = 0; j < 8; ++j) { v[j] = *(const f32x4*)(xr + (lane + 64 * j) * 4); s += v[j][0] * v[j][0] + v[j][1] * v[j][1] + v[j][2] * v[j][2] + v[j][3] * v[j][3]; }
    s = wave_sum(s);
    const float r = rsqrtf(s * (1.0f / (float)DM) + EPS);
#pragma unroll
    for (int j = 0; j < 8; ++j) { const f32x4 g = *(const f32x4*)(gain + (lane + 64 * j) * 4); const f32x4 o = v[j] * r * g;
        *(u32x2*)(ob + (lane + 64 * j) * 4) = (u32x2){pk_bf16(o[0], o[1]), pk_bf16(o[2], o[3])}; }
}
__device__ __forceinline__ void hgrn_final_item(int item, const float* __restrict__ OF, const float* __restrict__ OB, const u16* __restrict__ PG, const float* __restrict__ gain, u16* __restrict__ MIXB, int lane) {
    const int tok = item >> 3, h = item & 7, c = h * 128 + 2 * lane;
    const f32x2 a = *(const f32x2*)(OF + (size_t)tok * HGW + c), b = *(const f32x2*)(OB + (size_t)tok * HGW + c);
    const float o0 = a[0] + b[0], o1 = a[1] + b[1];
    const float s = wave_sum(o0 * o0 + o1 * o1);
    const float r = rsqrtf(s * (1.0f / 128.0f) + EPS);
    const unsigned gw = *(const unsigned*)(PG + (size_t)tok * 5120 + 4096 + c);
    const float g0 = bflo(gw), g1 = bfhi(gw);
    const f32x2 gn = *(const f32x2*)(gain + c);
    const float v0 = o0 * r * gn[0] * (g0 / (1.0f + __expf(-g0))), v1 = o1 * r * gn[1] * (g1 / (1.0f + __expf(-g1)));
    *(unsigned*)(MIXB + (size_t)tok * DM + c) = pk_bf16(v0, v1);
}
__device__ __forceinline__ void hy_norm_tile(LAS unsigned char* lds, int tile_i, const u16* __restrict__ Z2T, const float* __restrict__ gain, u16* __restrict__ MIXB) {
    const int t = tid_fresh(), tok0 = tile_i * 32;
    LAS float* ssq = (LAS float*)(lds + 1024 * 80);
    if (t < 32) ssq[t] = 0.f;
    __syncthreads();
    float part[8];
#pragma unroll
    for (int q = 0; q < 8; ++q) part[q] = 0.f;
    const int ch = t & 3;
#pragma unroll
    for (int it = 0; it < 8; ++it) {
        const int c = (t >> 2) + 128 * it;
        const u32x4 v = *(const u32x4*)(Z2T + (size_t)c * NTOK + tok0 + ch * 8);
        *(LAS u32x4*)(lds + c * 80 + ch * 16) = v;
#pragma unroll
        for (int q = 0; q < 4; ++q) { const float a = bflo(v[q]), b = bfhi(v[q]); part[2 * q] += a * a; part[2 * q + 1] += b * b; }
    }
#pragma unroll
    for (int q = 0; q < 8; ++q) { float s = part[q]; s += __shfl_xor(s, 4); s += __shfl_xor(s, 8); s += __shfl_xor(s, 16); s += __shfl_xor(s, 32); part[q] = s; }
    if ((t & 63) < 4) {
#pragma unroll
        for (int q = 0; q < 8; ++q) atomicAdd((float*)(ssq + ch * 8 + q), part[q]);
    }
    __syncthreads();
    const int tt = t >> 4;
    const float r = rsqrtf(ssq[tt] * (1.0f / (float)HYW) + EPS);
#pragma unroll 2
    for (int k = 0; k < 8; ++k) {
        const int c0 = ((t & 15) + 16 * k) * 8;
        float o[8];
#pragma unroll
        for (int q = 0; q < 8; ++q) o[q] = bf2f(*(const LAS u16*)(lds + (c0 + q) * 80 + tt * 2)) * r * gain[c0 + q];
        *(u32x4*)(MIXB + (size_t)(tok0 + tt) * DM + 1024 + c0) = (u32x4){pk_bf16(o[0], o[1]), pk_bf16(o[2], o[3]), pk_bf16(o[4], o[5]), pk_bf16(o[6], o[7])};
    }
    __syncthreads();
}
constexpr int RT_XSTRIDE = 2049;
constexpr int RT_PART = 16 * RT_XSTRIDE * 4;
constexpr int RT_LG = RT_PART + 8 * 16 * 32 * 4;
constexpr int RT_HIST = RT_LG + 16 * 32 * 4;
constexpr int RT_END = RT_HIST + 128;
__device__ __forceinline__ void router_tile(LAS unsigned char* lds, int tile_i, const float* __restrict__ X1, const float* __restrict__ gain, const float* __restrict__ wr, const float* __restrict__ br,
                                            unsigned char* __restrict__ XN8, int* __restrict__ TOPI, float* __restrict__ TOPG, int* __restrict__ counts) {
    const int tid = tid_fresh(), wid = __builtin_amdgcn_readfirstlane(tid >> 6), lane = tid & 63;
    const int tok0 = tile_i * 16;
    LAS float* xs = (LAS float*)lds;
#pragma unroll
    for (int q = 0; q < 2; ++q) {
        const int tl = wid * 2 + q; const size_t tok = (size_t)tok0 + tl;
        const float* xr = X1 + tok * DM;
        f32x4 v[8]; float s = 0.f;
#pragma unroll
        for (int j = 0; j < 8; ++j) { v[j] = *(const f32x4*)(xr + (lane + 64 * j) * 4); s += v[j][0] * v[j][0] + v[j][1] * v[j][1] + v[j][2] * v[j][2] + v[j][3] * v[j][3]; }
        s = wave_sum(s);
        const float r = rsqrtf(s * (1.0f / (float)DM) + EPS);
#pragma unroll
        for (int j = 0; j < 8; ++j) { const int d = (lane + 64 * j) * 4; const f32x4 g = *(const f32x4*)(gain + d); const f32x4 o = v[j] * r * g;
            xs[tl * RT_XSTRIDE + d + 0] = o[0]; xs[tl * RT_XSTRIDE + d + 1] = o[1]; xs[tl * RT_XSTRIDE + d + 2] = o[2]; xs[tl * RT_XSTRIDE + d + 3] = o[3];
            *(unsigned*)(XN8 + tok * DM + d) = pk_fp8x4(o[0], o[1], o[2], o[3]); }
    }
    __syncthreads();
    {
        const int tl = lane & 15, kk = lane >> 4;
        f32x4 a0 = {0.f, 0.f, 0.f, 0.f}, a1 = a0;
        const LAS float* xp = xs + tl * RT_XSTRIDE + wid * 256 + kk;
        const float* wp = wr + (size_t)(wid * 256 + kk) * NE + tl;
#pragma unroll 8
        for (int ks = 0; ks < 64; ++ks) { const float a = xp[ks * 4]; const float b0 = wp[(size_t)ks * 4 * NE], b1 = wp[(size_t)ks * 4 * NE + 16];
            a0 = __builtin_amdgcn_mfma_f32_16x16x4f32(a, b0, a0, 0, 0, 0); a1 = __builtin_amdgcn_mfma_f32_16x16x4f32(a, b1, a1, 0, 0, 0); }
        LAS float* pp = (LAS float*)(lds + RT_PART) + wid * 512;
#pragma unroll
        for (int j = 0; j < 4; ++j) { pp[(kk * 4 + j) * 32 + tl] = a0[j]; pp[(kk * 4 + j) * 32 + 16 + tl] = a1[j]; }
    }
    __syncthreads();
    {   const LAS float* pp = (const LAS float*)(lds + RT_PART); float s = br[tid & 31];
#pragma unroll
        for (int w = 0; w < 8; ++w) s += pp[w * 512 + tid];
        ((LAS float*)(lds + RT_LG))[tid] = s; }
    __syncthreads();
    if (tid < 16) {
        LAS float* lg = (LAS float*)(lds + RT_LG) + tid * 32;
        int i0 = 0, i1 = 0, i2 = 0, i3 = 0; float v0, v1, v2, v3;
        { float bv = -3.0e38f; for (int j = 0; j < NE; ++j) { const float l = lg[j]; if (l > bv) { bv = l; i0 = j; } } v0 = bv; lg[i0] = -3.4e38f; }
        { float bv = -3.0e38f; for (int j = 0; j < NE; ++j) { const float l = lg[j]; if (l > bv) { bv = l; i1 = j; } } v1 = bv; lg[i1] = -3.4e38f; }
        { float bv = -3.0e38f; for (int j = 0; j < NE; ++j) { const float l = lg[j]; if (l > bv) { bv = l; i2 = j; } } v2 = bv; lg[i2] = -3.4e38f; }
        { float bv = -3.0e38f; for (int j = 0; j < NE; ++j) { const float l = lg[j]; if (l > bv) { bv = l; i3 = j; } } v3 = bv; lg[i3] = -3.4e38f; }
        const float e1 = __expf(v1 - v0), e2 = __expf(v2 - v0), e3 = __expf(v3 - v0), inv = 1.0f / (1.0f + e1 + e2 + e3);
        const int tok = tok0 + tid;
        *(int4*)(TOPI + tok * 4) = make_int4(i0, i1, i2, i3);
        *(f32x4*)(TOPG + tok * 4) = (f32x4){inv, e1 * inv, e2 * inv, e3 * inv};
        LAS int* hist = (LAS int*)(lds + RT_HIST);
        atomicAdd((int*)(hist + i0), 1); atomicAdd((int*)(hist + i1), 1); atomicAdd((int*)(hist + i2), 1); atomicAdd((int*)(hist + i3), 1);
    }
    __syncthreads();
}
__device__ __forceinline__ void combine_row(int tok, const float* __restrict__ X1, const u16* __restrict__ YB, const int* __restrict__ SOF, const float* __restrict__ TOPG, const float* __restrict__ gain, float* __restrict__ out, int lane) {
    const int4 sl = *(const int4*)(SOF + tok * 4); const f32x4 g = *(const f32x4*)(TOPG + tok * 4);
    const u16* y0 = YB + (size_t)sl.x * DM; const u16* y1 = YB + (size_t)sl.y * DM; const u16* y2 = YB + (size_t)sl.z * DM; const u16* y3 = YB + (size_t)sl.w * DM;
    f32x4 v[8]; float s = 0.f;
#pragma unroll
    for (int j = 0; j < 8; ++j) { const int d = (lane + 64 * j) * 4;
        f32x4 a = *(const f32x4*)(X1 + (size_t)tok * DM + d);
        const u32x2 q0 = *(const u32x2*)(y0 + d), q1 = *(const u32x2*)(y1 + d), q2 = *(const u32x2*)(y2 + d), q3 = *(const u32x2*)(y3 + d);
        a[0] += g[0] * bflo(q0[0]) + g[1] * bflo(q1[0]) + g[2] * bflo(q2[0]) + g[3] * bflo(q3[0]);
        a[1] += g[0] * bfhi(q0[0]) + g[1] * bfhi(q1[0]) + g[2] * bfhi(q2[0]) + g[3] * bfhi(q3[0]);
        a[2] += g[0] * bflo(q0[1]) + g[1] * bflo(q1[1]) + g[2] * bflo(q2[1]) + g[3] * bflo(q3[1]);
        a[3] += g[0] * bfhi(q0[1]) + g[1] * bfhi(q1[1]) + g[2] * bfhi(q2[1]) + g[3] * bfhi(q3[1]);
        v[j] = a; s += a[0] * a[0] + a[1] * a[1] + a[2] * a[2] + a[3] * a[3]; }
    s = wave_sum(s);
    const float r = rsqrtf(s * (1.0f / (float)DM) + EPS);
#pragma unroll
    for (int j = 0; j < 8; ++j) { const int d = (lane + 64 * j) * 4; const f32x4 gn = *(const f32x4*)(gain + d); *(f32x4*)(out + (size_t)tok * DM + d) = v[j] * r * gn; }
}

#ifndef REP_P9
#define REP_P9 1
#endif
#ifndef REP_P3
#define REP_P3 1
#endif
#ifndef REP_FR
#define REP_FR 1
#endif
#ifndef REP_P0
#define REP_P0 1
#endif
#ifndef REP_CONV
#define REP_CONV 1
#endif
#ifndef REP_GEMM1
#define REP_GEMM1 1
#endif
#ifndef REP_HY
#define REP_HY 1
#endif
#ifndef REP_HG
#define REP_HG 1
#endif
#ifndef REP_MOEA
#define REP_MOEA 1
#endif
#ifndef REP_MOEB
#define REP_MOEB 1
#endif
#ifndef REP_WOUT
#define REP_WOUT 1
#endif
struct MegaP {
    const float *x, *norm_mix_gain, *w_in, *lb_logits, *hgrn_norm_gain, *hy_conv_w, *hy_conv_b, *fw1, *fb1, *fw2, *fb2, *fw3, *fb3, *fw4, *ffreq, *hy_bias, *hy_norm_gain, *w_out,
        *norm_ffn_gain, *w_router, *b_router, *moe_w1, *moe_b1, *moe_w2, *moe_b2, *final_gain;
    float* out; unsigned char* ws;
};
constexpr int MEGA_XB = RT_END;
constexpr int MEGA_LDS = RT_END + 64 + 384;
static_assert(MEGA_LDS >= HY_LDS + 64 && MEGA_LDS >= HG_LDS + 64 && MEGA_LDS >= GEMM_LDS + 64, "LDS");

__global__ void __launch_bounds__(512, 2) k_mega(const MegaP p_arg) {
    extern __shared__ __attribute__((aligned(16))) unsigned char shm[];
    LAS unsigned char* lds = (LAS unsigned char*)shm;
    const int tid = threadIdx.x, wid = __builtin_amdgcn_readfirstlane(tid >> 6), lane = tid & 63;
    const int G = gridDim.x, bid = blockIdx.x, c = xcd_logical(bid, G);
#define PHASE_ARGS() const MegaP __attribute__((address_space(4)))* pq_ = (const MegaP __attribute__((address_space(4)))*)__builtin_amdgcn_kernarg_segment_ptr(); asm volatile("" : "+s"(pq_)); unsigned char* ws = pq_->ws; (void)ws
    unsigned char* ws0; { PHASE_ARGS(); ws0 = ws; }
#define counts ((int*)(ws + WS_CTL))
#define cursor ((int*)(ws + WS_CTL + 4096))
#define offs ((int*)(ws + WS_CTL + 8192))
#define barw ((unsigned*)(ws + WS_CTL + 16384))
#define HB ((u16*)(ws + WS_HB))
#define PG ((u16*)(ws + WS_PG))
#define HYT ((u16*)(ws + WS_HYT))
#define MIXB ((u16*)(ws + WS_MIXB))
#define XNB ((u16*)(ws + WS_XNB))
#define HMB ((u16*)(ws + WS_HMB))
#define YB ((u16*)(ws + WS_YB))
#define H3 ((float*)(ws + WS_H3))
#define FR ((u16*)(ws + WS_FR))
#define Z2T ((u16*)(ws + WS_Z2T))
#define OF ((float*)(ws + WS_OF))
#define OB ((float*)(ws + WS_OB))
#define X1 ((float*)(ws + WS_X1))
#define TOPI ((int*)(ws + WS_TOPI))
#define TOPG ((float*)(ws + WS_TOPG))
#define STOK ((int*)(ws + WS_STOK))
#define SOF ((int*)(ws + WS_SOF))
#define WINT ((u16*)(ws + WS_WINT))
#define WOUTT ((u16*)(ws + WS_WOUTT))
#define W1T ((u16*)(ws + WS_W1T))
#define W2T ((u16*)(ws + WS_W2T))
    if (tid == 0) *(LAS u32x4*)(lds + MEGA_XB) = (u32x4){0u, 0u, 0u, 0u};
    __syncthreads();
    XcdBarrier bar = xcd_barrier_post((unsigned*)(ws0 + WS_CTL + 16384), (volatile LAS unsigned*)(lds + MEGA_XB));

    {
        PHASE_ARGS();
    for (int rep = 0; rep < REP_P0; ++rep) {
    for (int row = bid * 8 + wid; row < NTOK; row += G * 8) rmsnorm_row_bf(pq_->x + (size_t)row * DM, pq_->norm_mix_gain, HB + (size_t)row * DM, lane);
    for (int m = bid * 8 + wid; m < SEQ; m += G * 8) h3_row(m, pq_->fw1, pq_->fb1, pq_->fw2, pq_->fb2, pq_->fw3, pq_->fb3, pq_->ffreq, (LAS float*)(lds + wid * 512), H3); }
    for (int rep = 0; rep < REP_CONV; ++rep)
    for (int id = bid; id < 1024 + 256; id += G) {
        const int tz = tid_fresh();
        if (id < 1024) { const int nt = id >> 5, kt = id & 31; convert_tile(pq_->w_in, DIN, kt * 64, ColMapPerm{nt * 256}, WINT + (size_t)id * 16384, tz); }
        else { const int q = id - 1024, nt = q >> 5, kt = q & 31; convert_tile(pq_->w_out, DM, kt * 64, ColMapPerm{nt * 256}, WOUTT + (size_t)q * 16384, tz); }
    }
    }
    xcd_barrier(bar);
    {
        PHASE_ARGS();
    for (int rep = 0; rep < REP_FR; ++rep)
    for (int item = bid; item < 256; item += G) frgen_item(lds, item, H3, pq_->fw4, FR);
    { SrcG1<false> s0{c, G, (const char*)HB, (const char*)WINT, PG, HYT}; gemm8_stream<false, false>(lds, DM, 32, s0);
      SrcG1<true> s1{c, G, (const char*)HB, (const char*)WINT, PG, HYT}; gemm8_stream<true, false>(lds, DM, 32, s1); }
#ifdef PROBE_NOEPI
    for (int u = c; u < 1024; u += G) {
        const int i = u >> 8, xx = (u >> 5) & 7, j = u & 31;
        const int mt = (xx & 3) * 8 + (j & 7), nt = ((xx >> 2) + 2 * i) * 4 + (j >> 3);
        const u16* bt = WINT + (size_t)nt * 32 * 16384;
        EpiNone e{}; if (nt < 20) gemm8_unit<false>(lds, HB, DM, nullptr, mt * 256, 256, bt, 32, e); else gemm8_unit<true>(lds, HB, DM, nullptr, mt * 256, 256, bt, 32, e);
    }
#endif
    }
    xcd_barrier(bar);
    {
        PHASE_ARGS();
    for (int rep = 0; rep < REP_HY; ++rep)
    for (int u = bid; u < 256; u += G) hyena_unit(lds, u, HYT, FR, pq_->hy_conv_w, pq_->hy_conv_b, pq_->hy_bias, Z2T, ConvCtx{pq_->moe_w1, pq_->moe_w2, (unsigned char*)W1T, (unsigned char*)W2T});
    for (int rep = 0; rep < REP_HG; ++rep)
    for (int u = bid; u < 256; u += G) hgrn_unit(lds, u, PG, pq_->lb_logits, OF, OB, ConvCtx{pq_->moe_w1, pq_->moe_w2, (unsigned char*)W1T, (unsigned char*)W2T});
    }
    xcd_barrier(bar);
    {
        PHASE_ARGS();
    for (int rep = 0; rep < REP_P3; ++rep) {
    for (int it = bid * 8 + wid; it < NTOK * HGH; it += G * 8) hgrn_final_item(it, OF, OB, PG, pq_->hgrn_norm_gain, MIXB, lane);
    for (int t = bid; t < NTOK / 32; t += G) hy_norm_tile(lds, t, Z2T, pq_->hy_norm_gain, MIXB); }
    }
    xcd_barrier(bar);
    {
        PHASE_ARGS();
    for (int u = c; u < 256; u += G) {
        const int xx = u >> 5, j = u & 31;
        const int mt = (xx >> 1) * 8 + (j & 7), nt = (xx & 1) * 4 + (j >> 3);
        Epi8X1 e{pq_->x, X1, mt * 256, nt * 256};
        gemm8_unit<false>(lds, MIXB, DM, nullptr, mt * 256, 256, WOUTT + (size_t)nt * 32 * 16384, 32, e);
    }
    }
    xcd_barrier(bar);
    {
        PHASE_ARGS();
    if (tid < NE) *(LAS int*)(lds + RT_HIST + tid * 4) = 0;
    __syncthreads();
    for (int t = bid; t < NTOK / 16; t += G) router_tile(lds, t, X1, pq_->norm_ffn_gain, pq_->w_router, pq_->b_router, (unsigned char*)XNB, TOPI, TOPG, counts);
    if (tid < NE) { const int hcount = *(const LAS int*)(lds + RT_HIST + tid * 4); if (hcount) atomicAdd(&counts[tid * 32], hcount); }
    }
    xcd_barrier(bar);
    {
        PHASE_ARGS();
    {
        LAS int* so = (LAS int*)lds;
        LAS int* lh = (LAS int*)(lds + 256);
        LAS int* lb2 = (LAS int*)(lds + 512);
        if (tid == 0) { int a = 0; for (int e = 0; e < NE; ++e) { so[e] = a; a += __hip_atomic_load(&counts[e * 32], __ATOMIC_RELAXED, __HIP_MEMORY_SCOPE_AGENT); } so[NE] = a; }
        if (tid < NE) lh[tid] = 0;
        __syncthreads();
        if (bid == 0 && tid <= NE) offs[tid] = so[tid];
        for (int i0 = bid * 512; i0 < NSLOT; i0 += G * 512) {
            const int i = i0 + tid; const int e = TOPI[i];
            const int lpos = atomicAdd((int*)(lh + e), 1);
            __syncthreads();
            if (tid < NE) { const int n = lh[tid]; lb2[tid] = so[tid] + (n ? atomicAdd(&cursor[tid * 32], n) : 0); }
            __syncthreads();
            const int slot = lb2[e] + lpos; STOK[slot] = i >> 2; SOF[i] = slot;
            __syncthreads();
            if (tid < NE) lh[tid] = 0;
            __syncthreads();
        }
    }
    }
    xcd_barrier(bar);
    {
        PHASE_ARGS();
    {
        LAS int* us = (LAS int*)(lds + MEGA_XB + 64); LAS int* so2 = us + 40;
        if (tid == 0) { int a = 0; for (int e = 0; e < NE; ++e) { us[e] = a; a += ((offs[e + 1] - offs[e] + 255) >> 8) * 16; } us[NE] = a; }
        if (tid <= NE) so2[tid] = offs[tid];
        __syncthreads();
    }
    {
        LAS int* qs = (LAS int*)(lds + MEGA_XB + 32); LAS int* us = (LAS int*)(lds + MEGA_XB + 64); LAS int* so2 = us + 40;
        int* qctr = (int*)(ws + WS_CTL + 12288 + (bid & 7) * 128);
        int tk_next = 0;
        if (tid == 0) tk_next = atomicAdd(qctr, 1);
        for (;;) {
            if (tid == 0) { qs[0] = tk_next; qs[1] = -1; }
            __syncthreads();
            const int tk = qs[0];
            const int u = 256 * (tk >> 5) + 32 * (bid & 7) + (tk & 31);
            if (tid < NE) { const int u0 = us[tid], u1 = us[tid + 1]; if (u >= u0 && u < u1) { const int o0 = so2[tid], cnt = so2[tid + 1] - o0, mtl = (cnt + 255) >> 8, ul = u - u0, mt = ul % mtl;
                int rows = cnt - mt * 256; rows = rows > 256 ? 256 : rows; qs[1] = tid; qs[2] = ul / mtl; qs[3] = o0 + mt * 256; qs[4] = rows; } }
            __syncthreads();
            const int e = qs[1], nt = qs[2], slot0 = qs[3], rows = qs[4];
            __syncthreads();
            if (e < 0) break;
            if (tid == 0) tk_next = atomicAdd(qctr, 1);
            Epi8Swiglu8 ep{(unsigned char*)HMB, pq_->moe_b1 + (size_t)e * 2 * DFF, slot0, nt, rows};
            gemm8_unit<false, true>(lds, XNB, DM / 2, STOK + slot0, 0, rows, W1T + (size_t)(e * 16 + nt) * 16 * 16384, 16, ep);
        }
    }
    }
    xcd_barrier(bar);
    {
        PHASE_ARGS();
    {
        LAS int* us = (LAS int*)(lds + MEGA_XB + 64); LAS int* so2 = us + 40;
        if (tid == 0) { int a = 0; for (int e = 0; e < NE; ++e) { us[e] = a; a += ((offs[e + 1] - offs[e] + 255) >> 8) * 8; } us[NE] = a; }
        if (tid <= NE) so2[tid] = offs[tid];
        __syncthreads();
    }
    {
        const LAS int* us = (const LAS int*)(lds + MEGA_XB + 64); const LAS int* so2 = us + 40;
        SrcMoeB src{us, so2, c, G, (const char*)HMB, (const char*)W2T, YB, pq_->moe_b2};
        gemm8_stream<false, true>(lds, DFF / 2, 16, src);
    }
    }
    xcd_barrier(bar);
    {
        PHASE_ARGS();
    for (int rep = 0; rep < REP_P9; ++rep)
    for (int tok = bid * 8 + wid; tok < NTOK; tok += G * 8) combine_row(tok, X1, YB, SOF, TOPG, pq_->final_gain, pq_->out, lane);
    }
}
#undef counts
#undef cursor
#undef offs
#undef barw
#undef HB
#undef PG
#undef HYT
#undef MIXB
#undef XNB
#undef HMB
#undef YB
#undef H3
#undef FR
#undef Z2T
#undef OF
#undef OB
#undef X1
#undef TOPI
#undef TOPG
#undef STOK
#undef SOF
#undef WINT
#undef WOUTT
#undef W1T
#undef W2T

extern "C" void kernel_launch(void* const* d_in, const int* in_sizes, int n_in, void* d_out, int out_size, void* d_ws, size_t ws_size, hipStream_t stream) {
    if (n_in < 26 || ws_size < WS_END2) return;
    MegaP p{};
    const float** pp = (const float**)&p;
    for (int i = 0; i < 26; ++i) pp[i] = (const float*)d_in[i];
    p.out = (float*)d_out; p.ws = (unsigned char*)d_ws;
    static int grid = 0;
    if (!grid) {
        int dev = 0, cus = 0, per_cu = 0;
        (void)hipGetDevice(&dev);
        (void)hipDeviceGetAttribute(&cus, hipDeviceAttributeMultiprocessorCount, dev);
        (void)hipFuncSetAttribute((const void*)k_mega, hipFuncAttributeMaxDynamicSharedMemorySize, MEGA_LDS);
        (void)hipOccupancyMaxActiveBlocksPerMultiprocessor(&per_cu, (const void*)k_mega, 512, MEGA_LDS);
        if (per_cu < 1) per_cu = 1;
        grid = cus * 1;
        if (grid > 256) grid = 256;
        grid &= ~7;
        if (grid < 8) grid = 8;
    }
    (void)hipMemsetAsync((char*)d_ws + WS_CTL, 0, 65536, stream);
    hipLaunchKernelGGL(k_mega, dim3(grid), dim3(512), MEGA_LDS, stream, p);
}
```

```cpp
#include <hip/hip_runtime.h>
#include <stdint.h>

constexpr int BATCH = 4, SEQ = 2048, DM = 2048, NTOK = BATCH * SEQ;
constexpr int HGW = 1024, HGD = 128, HGH = 8;
constexpr int HYW = 1024;
constexpr int DIN = 8192;
constexpr int NE = 32, TOPK = 4, DFF = 2048;
constexpr int NSLOT = NTOK * TOPK;
constexpr float EPS = 1e-5f;

constexpr size_t MB = 1024ull * 1024ull;
constexpr size_t WS_CTL = 0;
constexpr size_t WS_HB = 1 * MB;
constexpr size_t WS_PG = WS_HB + 32 * MB;
constexpr size_t WS_HYT = WS_PG + 80 * MB;
constexpr size_t WS_MIXB = WS_HYT + 48 * MB;
constexpr size_t WS_XNB = WS_MIXB + 32 * MB;
constexpr size_t WS_HMB = WS_XNB + 32 * MB;
constexpr size_t WS_YB = WS_HMB + 128 * MB;
constexpr size_t WS_H3 = WS_YB + 128 * MB;
constexpr size_t WS_FR = WS_H3 + 1 * MB;
constexpr size_t WS_Z2T = WS_FR + 34 * MB;
constexpr size_t WS_OF = WS_Z2T + 16 * MB;
constexpr size_t WS_OB = WS_OF + 32 * MB;
constexpr size_t WS_X1 = WS_OB + 32 * MB;
constexpr size_t WS_TOPI = WS_X1 + 64 * MB;
constexpr size_t WS_TOPG = WS_TOPI + 1 * MB;
constexpr size_t WS_STOK = WS_TOPG + 1 * MB;
constexpr size_t WS_SOF = WS_STOK + 1 * MB;
constexpr size_t WS_WINT = WS_SOF + 1 * MB;
constexpr size_t WS_WOUTT = WS_WINT + 32 * MB;
constexpr size_t WS_W1T = WS_WOUTT + 8 * MB;
constexpr size_t WS_W2T = WS_W1T + 512 * MB;
constexpr size_t WS_END2 = WS_W2T + 256 * MB;

typedef short bf16x8 __attribute__((ext_vector_type(8)));
typedef float f32x4 __attribute__((ext_vector_type(4)));
typedef float f32x2 __attribute__((ext_vector_type(2)));
typedef unsigned u32x4 __attribute__((ext_vector_type(4)));
typedef unsigned u32x2 __attribute__((ext_vector_type(2)));
typedef unsigned short u16;
#define LAS __attribute__((address_space(3)))

__device__ __forceinline__ unsigned pk_bf16(float lo, float hi) {
    typedef __bf16 bf2 __attribute__((ext_vector_type(2)));
    const f32x2 v = {lo, hi};
    const bf2 r = __builtin_convertvector(v, bf2);
    return __builtin_bit_cast(unsigned, r);
}
__device__ __forceinline__ float bf2f(u16 b) { return __uint_as_float(((unsigned)b) << 16); }
__device__ __forceinline__ float bflo(unsigned w) { return __uint_as_float(w << 16); }
__device__ __forceinline__ float bfhi(unsigned w) { return __uint_as_float(w & 0xffff0000u); }

__device__ __forceinline__ int lds_byte(int r, int c) { const int st = (r >> 4) * 2 + (c >> 5), ob = (r & 15) * 64 + (c & 31) * 2; return st * 1024 + (ob ^ (((ob >> 9) & 1) << 5)); }
__device__ __forceinline__ void stage_rc(int b, int& R, int& C) { const int st = b >> 10, sb = b & 1023, swz = sb ^ (((sb >> 9) & 1) << 5); R = (st >> 1) * 16 + swz / 64; C = (st & 1) * 32 + (swz % 64) / 2; }
__device__ __forceinline__ f32x4 unperm(const f32x4 a, const bool s) { f32x4 o; o[0] = s ? a[1] : a[0]; o[1] = s ? a[0] : a[1]; o[2] = s ? a[3] : a[2]; o[3] = s ? a[2] : a[3]; return o; }

__device__ __forceinline__ int tid_fresh() { int t = threadIdx.x; asm volatile("" : "+v"(t)); return t; }
constexpr int GEMM_LDS = 131072;

template <bool TRANS, bool RAGGED, int PM = 0, class ColMap, class Epi>
__device__ __forceinline__ void gemm_unit(LAS unsigned char* lds, const u16* __restrict__ A, int lda, const int* __restrict__ arows, int arow0, int rows_valid,
                                          const float* __restrict__ B, int ldb, int K, const ColMap colmap, const Epi epi) {
    const int tid = tid_fresh(), wid = __builtin_amdgcn_readfirstlane(tid >> 6), lane = tid & 63;
    const int wr = wid >> 2, wc = wid & 3, fr = lane & 15, fq = lane >> 4;
    const int nt = K >> 6;
    const char* ap[4];
#pragma unroll
    for (int i = 0; i < 4; ++i) {
        int R, C; stage_rc(wid * 1024 + i * 8192 + lane * 16, R, C);
        const int rr = RAGGED ? (R < rows_valid ? R : rows_valid - 1) : R;
        const long rowid = arows ? (long)arows[rr] : (long)(arow0 + rr);
        ap[i] = (const char*)A + ((size_t)rowid * lda + C) * 2;
    }
    const int g = (lane & 3) + 4 * (wid >> 2), rg = (wid & 3) * 16 + (lane >> 2);
    const unsigned bvoff = (unsigned)(((size_t)(8 * g) * ldb + colmap(rg)) * 4);
    const int bbase = 65536 + lds_byte(4 * rg, 8 * g);
    const int bw0 = bbase + ((rg & 1) ? 64 : 0), bw1 = bbase + ((rg & 1) ? 0 : 64);
    const int aoff = lds_byte(wr * 128 + fr, fq * 8), boff = 65536 + lds_byte(wc * 64 + fr, fq * 8);
    int mvalid = 8;
    if (RAGGED) { mvalid = (rows_valid - wr * 128 + 15) >> 4; mvalid = mvalid < 0 ? 0 : (mvalid > 8 ? 8 : mvalid); }
    f32x4 vb0, vb1, vb2, vb3, vb4, vb5, vb6, vb7;
    if (PM & 1) { vb0 = (f32x4){1.f, 1.f, 1.f, 1.f}; vb1 = vb0; vb2 = vb0; vb3 = vb0; vb4 = vb0; vb5 = vb0; vb6 = vb0; vb7 = vb0; }
    f32x4 acc[8][4];
#pragma unroll
    for (int m = 0; m < 8; ++m)
#pragma unroll
        for (int n = 0; n < 4; ++n) acc[m][n] = (f32x4){0.f, 0.f, 0.f, 0.f};
    const size_t ldb4 = (size_t)ldb * 4;
#define GE_GLDS_A(buf, kt) do { if (!(PM & 2)) _Pragma("unroll") for (int _i = 0; _i < 4; ++_i) \
        __builtin_amdgcn_global_load_lds((const unsigned*)(ap[_i] + (size_t)(kt) * 128), (LAS unsigned*)(lds + (buf) * 32768 + wid * 1024 + _i * 8192), 16, 0, 0); } while (0)
#define GE_LD1(dst, sb) if (!(PM & 1)) asm volatile("global_load_dwordx4 %0, %1, %2" : "=v"(dst) : "v"(bvoff), "s"(sb) : "memory")
#define GE_LOAD_B(kt) do { const char* _sb = (const char*)B + (size_t)(kt) * 64 * ldb4; \
        GE_LD1(vb0, _sb); GE_LD1(vb1, _sb + ldb4); GE_LD1(vb2, _sb + 2 * ldb4); GE_LD1(vb3, _sb + 3 * ldb4); \
        GE_LD1(vb4, _sb + 4 * ldb4); GE_LD1(vb5, _sb + 5 * ldb4); GE_LD1(vb6, _sb + 6 * ldb4); GE_LD1(vb7, _sb + 7 * ldb4); } while (0)
#define GE_WAITV_B(n) asm volatile("s_waitcnt vmcnt(" #n ")" : "+v"(vb0), "+v"(vb1), "+v"(vb2), "+v"(vb3), "+v"(vb4), "+v"(vb5), "+v"(vb6), "+v"(vb7) :: "memory")
#define GE_WRITE_B(buf) do { _Pragma("unroll") for (int _i = 0; _i < 4; ++_i) { u32x4 _w; _w[0] = pk_bf16(vb0[_i], vb1[_i]); _w[1] = pk_bf16(vb2[_i], vb3[_i]); \
        _w[2] = pk_bf16(vb4[_i], vb5[_i]); _w[3] = pk_bf16(vb6[_i], vb7[_i]); \
        *(LAS u32x4*)(lds + ((_i & 1) ? bw1 : bw0) + (_i >> 1) * 128 + (buf) * 32768) = _w; } } while (0)
#define GE_KSTEP(buf, ks) do { bf16x8 Bf[4]; \
        _Pragma("unroll") for (int n = 0; n < 4; ++n) Bf[n] = *(const LAS bf16x8*)(lds + (buf) * 32768 + boff + n * 2048 + (ks) * 1024); \
        _Pragma("unroll") for (int mh = 0; mh < 2; ++mh) { bf16x8 At[4]; \
            _Pragma("unroll") for (int m = 0; m < 4; ++m) At[m] = *(const LAS bf16x8*)(lds + (buf) * 32768 + aoff + (mh * 4 + m) * 2048 + (ks) * 1024); \
            _Pragma("unroll") for (int m = 0; m < 4; ++m) { if (!RAGGED || (mh * 4 + m) < mvalid) { _Pragma("unroll") for (int n = 0; n < 4; ++n) \
                { if (PM & 4) { asm volatile("" :: "v"(At[m]), "v"(Bf[n])); } else acc[mh * 4 + m][n] = TRANS ? __builtin_amdgcn_mfma_f32_16x16x32_bf16(At[m], Bf[n], acc[mh * 4 + m][n], 0, 0, 0) : __builtin_amdgcn_mfma_f32_16x16x32_bf16(Bf[n], At[m], acc[mh * 4 + m][n], 0, 0, 0); } } } } } while (0)
    GE_GLDS_A(0, 0);
    GE_LOAD_B(0);
    GE_WAITV_B(0);
    GE_WRITE_B(0);
    GE_LOAD_B(1);
    asm volatile("s_waitcnt lgkmcnt(0)" ::: "memory");
    __builtin_amdgcn_s_barrier();
    int t = 0;
    for (; t < nt - 2; ++t) {
        const int cur = t & 1;
        GE_GLDS_A(cur ^ 1, t + 1);
        GE_KSTEP(cur, 0);
        GE_WAITV_B(4);
        GE_WRITE_B(cur ^ 1);
        GE_LOAD_B(t + 2);
        __builtin_amdgcn_sched_barrier(0);
        GE_KSTEP(cur, 1);
        asm volatile("s_waitcnt vmcnt(8) lgkmcnt(0)" ::: "memory");
        __builtin_amdgcn_s_barrier();
    }
    {
        const int cur = t & 1;
        GE_GLDS_A(cur ^ 1, t + 1);
        GE_KSTEP(cur, 0);
        GE_WAITV_B(4);
        GE_WRITE_B(cur ^ 1);
        GE_KSTEP(cur, 1);
        asm volatile("s_waitcnt vmcnt(0) lgkmcnt(0)" ::: "memory");
        __builtin_amdgcn_s_barrier();
        ++t;
    }
    {
        const int cur = t & 1;
        GE_KSTEP(cur, 0);
        GE_KSTEP(cur, 1);
        asm volatile("s_waitcnt lgkmcnt(0)" ::: "memory");
        __builtin_amdgcn_s_barrier();
    }
#undef GE_GLDS_A
#undef GE_LD1
#undef GE_LOAD_B
#undef GE_WAITV_B
#undef GE_WRITE_B
#undef GE_KSTEP
    __builtin_amdgcn_sched_barrier(0);
    { const int tz = tid_fresh(), wz = __builtin_amdgcn_readfirstlane(tz >> 6), lz = tz & 63;
      epi(acc, wz >> 2, wz & 3, lz & 15, lz >> 4); }
}

__device__ __forceinline__ int xcd_logical(int b, int G) { return (G & 7) ? b : (b & 7) * (G >> 3) + (b >> 3); }

struct ColMapDense { int c0; __device__ __forceinline__ int operator()(int rg) const { return c0 + 4 * rg; } };
struct EpiPG { u16* PG; int tok0, col0;
    __device__ __forceinline__ void operator()(const f32x4 (&acc)[8][4], int wr, int wc, int fr, int fq) const {
#pragma unroll
        for (int m = 0; m < 8; ++m) { u16* rowp = PG + (size_t)(tok0 + wr * 128 + m * 16 + fr) * 5120 + col0 + wc * 64 + 4 * fq;
#pragma unroll
            for (int n = 0; n < 4; ++n) { const f32x4 v = unperm(acc[m][n], fq & 1); u32x2 w; w[0] = pk_bf16(v[0], v[1]); w[1] = pk_bf16(v[2], v[3]); *(u32x2*)(rowp + n * 16) = w; } }
    } };
struct EpiHYT { u16* HYT; int tok0, col0;
    __device__ __forceinline__ void operator()(const f32x4 (&acc)[8][4], int wr, int wc, int fr, int fq) const {
#pragma unroll
        for (int n = 0; n < 4; ++n) { const int rho = wc * 64 + n * 16 + fr; const int col = col0 + (rho & ~3) + ((rho & 3) ^ ((rho >> 2) & 1));
            u16* colp = HYT + (size_t)col * NTOK + tok0 + wr * 128 + 4 * fq;
#pragma unroll
            for (int m = 0; m < 8; ++m) { const f32x4 v = acc[m][n]; u32x2 w; w[0] = pk_bf16(v[0], v[1]); w[1] = pk_bf16(v[2], v[3]); *(u32x2*)(colp + m * 16) = w; } }
    } };
struct EpiX1 { const float* x; float* X1; int tok0, col0;
    __device__ __forceinline__ void operator()(const f32x4 (&acc)[8][4], int wr, int wc, int fr, int fq) const {
#pragma unroll
        for (int m = 0; m < 8; ++m) { const size_t off = (size_t)(tok0 + wr * 128 + m * 16 + fr) * DM + col0 + wc * 64 + 4 * fq;
#pragma unroll
            for (int n = 0; n < 4; ++n) { const f32x4 r = *(const f32x4*)(x + off + n * 16); *(f32x4*)(X1 + off + n * 16) = r + unperm(acc[m][n], fq & 1); }
            asm volatile("" ::: "memory"); }
    } };
struct ColMapGlu { int nt; __device__ __forceinline__ int operator()(int rg) const { const int wcq = rg >> 4, n = (rg >> 2) & 3, f = rg & 3; return (n >> 1) * 2048 + nt * 128 + wcq * 32 + (n & 1) * 16 + f * 4; } };
struct EpiSwiglu { u16* HM; const float* b1; int slot0, nt, rows_valid;
    __device__ __forceinline__ void operator()(const f32x4 (&acc)[8][4], int wr, int wc, int fr, int fq) const {
        f32x4 bg[2], bl[2];
#pragma unroll
        for (int nn = 0; nn < 2; ++nn) { const int col = nt * 128 + wc * 32 + nn * 16 + 4 * fq; bg[nn] = *(const f32x4*)(b1 + col); bl[nn] = *(const f32x4*)(b1 + 2048 + col); }
#pragma unroll
        for (int m = 0; m < 8; ++m) { const int row = wr * 128 + m * 16 + fr;
            if (row < rows_valid) {
#pragma unroll
                for (int nn = 0; nn < 2; ++nn) { const f32x4 gl = unperm(acc[m][nn], fq & 1) + bg[nn], li = unperm(acc[m][nn + 2], fq & 1) + bl[nn]; float o[4];
#pragma unroll
                    for (int j = 0; j < 4; ++j) { const float gq = fminf(gl[j], 7.0f), lq = fminf(fmaxf(li[j], -7.0f), 7.0f); o[j] = gq * (1.0f / (1.0f + __expf(-1.702f * gq))) * (lq + 1.0f); }
                    u32x2 w; w[0] = pk_bf16(o[0], o[1]); w[1] = pk_bf16(o[2], o[3]);
                    *(u32x2*)(HM + (size_t)(slot0 + row) * DFF + nt * 128 + wc * 32 + nn * 16 + 4 * fq) = w; } } }
    } };
struct EpiY { u16* Y; const float* b2; int slot0, col0, rows_valid;
    __device__ __forceinline__ void operator()(const f32x4 (&acc)[8][4], int wr, int wc, int fr, int fq) const {
        f32x4 bv[4];
#pragma unroll
        for (int n = 0; n < 4; ++n) bv[n] = *(const f32x4*)(b2 + col0 + wc * 64 + n * 16 + 4 * fq);
#pragma unroll
        for (int m = 0; m < 8; ++m) { const int row = wr * 128 + m * 16 + fr;
            if (row < rows_valid) { u16* rowp = Y + (size_t)(slot0 + row) * DM + col0 + wc * 64 + 4 * fq;
#pragma unroll
                for (int n = 0; n < 4; ++n) { const f32x4 v = unperm(acc[m][n], fq & 1) + bv[n]; u32x2 w; w[0] = pk_bf16(v[0], v[1]); w[1] = pk_bf16(v[2], v[3]); *(u32x2*)(rowp + n * 16) = w; } } }
    } };
template <int NTILES>
__device__ __forceinline__ bool moe_decode(const int* __restrict__ offs, int u, int& e, int& mt, int& nt, int& slot0, int& rows) {
    int base = 0;
    for (int q = 0; q < NE; ++q) { const int o0 = offs[q], cnt = offs[q + 1] - o0, mtl = (cnt + 255) >> 8, nu = mtl * NTILES;
        if (u < base + nu) { const int ul = u - base; e = q; mt = ul % mtl; nt = ul / mtl; slot0 = o0 + mt * 256; rows = cnt - mt * 256; if (rows > 256) rows = 256; return true; }
        base += nu; }
    return false;
}


__device__ __forceinline__ int perm_col4(int rg) { const int rgl = rg & 31, t = rgl & 7; return 32 * (rgl >> 3) + 8 * (t & 3) + 4 * (t >> 2); }
__device__ __forceinline__ int perm32(int rho) { const int n = rho >> 4, i = rho & 15; return 8 * (i >> 2) + 4 * n + (i & 3); }
template <class ColMap>
__device__ __forceinline__ void convert_tile(const float* __restrict__ W, int ldb, int k0, const ColMap colmap, u16* __restrict__ dst, int tid) {
    const int wid = tid >> 6, lane = tid & 63;
    const int g = (lane & 3) + 4 * (wid >> 2), rg = (wid & 3) * 16 + (lane >> 2);
    const float* bp = W + (size_t)(k0 + 8 * g) * ldb + colmap(rg);
    f32x4 v[8];
#pragma unroll
    for (int kk = 0; kk < 8; ++kk) v[kk] = __builtin_nontemporal_load((const f32x4*)(bp + (size_t)kk * ldb));
    const int h = rg >> 5, r0 = (4 * rg) & 127;
    unsigned char* base = (unsigned char*)dst + h * 16384 + lds_byte(r0, 8 * g);
#pragma unroll
    for (int i = 0; i < 4; ++i) { u32x4 w; w[0] = pk_bf16(v[0][i], v[1][i]); w[1] = pk_bf16(v[2][i], v[3][i]); w[2] = pk_bf16(v[4][i], v[5][i]); w[3] = pk_bf16(v[6][i], v[7][i]);
        *(u32x4*)(base + i * 64) = w; }
}
typedef int i32x8 __attribute__((ext_vector_type(8)));
typedef int i32x4 __attribute__((ext_vector_type(4)));
constexpr float W8_SCALE = 32.0f;
constexpr int W8_MX = 0x7A7A7A7A;
constexpr int A8_MX = 0x7F7F7F7F;
__device__ __forceinline__ unsigned pk_fp8x4(float a, float b, float c, float d) { int p = __builtin_amdgcn_cvt_pk_fp8_f32(a, b, 0, false); p = __builtin_amdgcn_cvt_pk_fp8_f32(c, d, p, true); return (unsigned)p; }
__device__ __forceinline__ int lds_byte_b(int r, int cb) { const int st = (r >> 4) * 2 + (cb >> 6), ob = (r & 15) * 64 + (cb & 63); return st * 1024 + (ob ^ (((ob >> 9) & 1) << 5)); }
struct ConvCtx { const float* w1; const float* w2; unsigned char* W1T; unsigned char* W2T; };
__device__ __forceinline__ int conv_seq2tile(int s) {
    if (s < 16384) return (s >> 9) * 512 + (s & 15) * 32 + ((s >> 4) & 31);
    const int q = s - 16384; return 16384 + (q >> 8) * 256 + (q & 7) * 32 + ((q >> 3) & 31);
}
__device__ __forceinline__ void conv_issue(const ConvCtx& cc, int m, int wid, int lane, f32x2 (&v)[16]) {
    const int rp = 16 * wid + (lane & 15), rg = rp >> 1, p2 = (rp & 1) * 2, kg = lane >> 4;
    const float* bp; size_t ld;
    if (m < 16384) { const int e = m >> 9, nt = (m >> 5) & 15, kt = m & 31; ld = 2 * DFF; bp = cc.w1 + (size_t)e * DM * 2 * DFF + (size_t)(kt * 64 + 16 * kg) * ld + (rg >> 5) * 2048 + nt * 128 + perm_col4(rg) + p2; }
    else { const int q = m - 16384, e = q >> 8, nt = (q >> 5) & 7, kt = q & 31; ld = DM; bp = cc.w2 + (size_t)e * DFF * DM + (size_t)(kt * 64 + 16 * kg) * ld + nt * 256 + (rg >> 5) * 128 + perm_col4(rg) + p2; }
#pragma unroll
    for (int kk = 0; kk < 16; ++kk) v[kk] = __builtin_nontemporal_load((const f32x2*)(bp + (size_t)kk * ld));
}
__device__ __forceinline__ void conv_finish(const ConvCtx& cc, int m, int wid, int lane, const f32x2 (&v)[16]) {
    const int rp = 16 * wid + (lane & 15), kg = lane >> 4;
    const int kt64 = m & 31;
    unsigned char* dst = (m < 16384) ? cc.W1T + ((size_t)(m >> 5) * 16 + (kt64 >> 1)) * 32768 : cc.W2T + ((size_t)((m - 16384) >> 5) * 16 + (kt64 >> 1)) * 32768;
    unsigned char* base = dst + (rp >> 6) * 16384 + lds_byte_b((2 * rp) & 127, (kt64 & 1) * 64 + 16 * kg);
#pragma unroll
    for (int i = 0; i < 2; ++i) { u32x4 w;
#pragma unroll
        for (int q = 0; q < 4; ++q) w[q] = pk_fp8x4(v[4 * q][i] * W8_SCALE, v[4 * q + 1][i] * W8_SCALE, v[4 * q + 2][i] * W8_SCALE, v[4 * q + 3][i] * W8_SCALE);
        __builtin_nontemporal_store(w, (u32x4*)(base + i * 64)); }
}
struct ColMapGluT { int nt; __device__ __forceinline__ int operator()(int rg) const { return (rg >> 5) * 2048 + nt * 128 + perm_col4(rg); } };
struct ColMapPerm { int c0; __device__ __forceinline__ int operator()(int rg) const { return c0 + (rg >> 5) * 128 + perm_col4(rg); } };

template <bool TRANS, bool FP8 = false, class Epi>
__device__ __forceinline__ void gemm8_unit(LAS unsigned char* lds, const u16* __restrict__ A, int lda, const int* __restrict__ arows, int arow0, int rows_valid, const u16* __restrict__ Bt, int nt, const Epi epi) {
    const int tid = tid_fresh(), wid = __builtin_amdgcn_readfirstlane(tid >> 6), lane = tid & 63;
    const int wr = wid >> 2, wc = wid & 3, fr = lane & 15, fq = lane >> 4;
    unsigned aof[2][2];
#pragma unroll
    for (int h = 0; h < 2; ++h)
#pragma unroll
        for (int i = 0; i < 2; ++i) { int R, C; stage_rc(tid * 16 + i * 8192, R, C); int rr = h * 128 + R; rr = rr < rows_valid ? rr : rows_valid - 1;
            const unsigned rowid = arows ? (unsigned)arows[rr] : (unsigned)(arow0 + rr); aof[h][i] = (rowid * (unsigned)lda + (unsigned)C) * 2u; }
    const char* Ab = (const char*)A; const char* Bb = (const char*)Bt + tid * 16;
    const bool hi = rows_valid > 128;
    int mxw = W8_MX, mxa = A8_MX; asm volatile("" : "+v"(mxw), "+v"(mxa));
#define G8_SA(b, h) (((b) * 2 + (h)) * 16384)
#define G8_SB(b, h) (65536 + ((b) * 2 + (h)) * 16384)
#define G8_STA(b, h, kt) do { _Pragma("unroll") for (int _i = 0; _i < 2; ++_i) \
        __builtin_amdgcn_global_load_lds((const unsigned*)(Ab + aof[h][_i] + (size_t)(kt) * 128), (LAS unsigned*)(lds + G8_SA(b, h) + wid * 1024 + _i * 8192), 16, 0, 0); } while (0)
#define G8_STB(b, h, kt) do { _Pragma("unroll") for (int _i = 0; _i < 2; ++_i) \
        __builtin_amdgcn_global_load_lds((const unsigned*)(Bb + (size_t)(kt) * 32768 + (h) * 16384 + _i * 8192), (LAS unsigned*)(lds + G8_SB(b, h) + wid * 1024 + _i * 8192), 16, 0, 0); } while (0)
#define G8_LDA(dst, b, h) do { _Pragma("unroll") for (int m = 0; m < 4; ++m) _Pragma("unroll") for (int k = 0; k < 2; ++k) dst[m][k] = *(const LAS bf16x8*)(lds + G8_SA(b, h) + aoff + m * 2048 + k * 1024); } while (0)
#define G8_LDB(dst, b, h) do { _Pragma("unroll") for (int n = 0; n < 2; ++n) _Pragma("unroll") for (int k = 0; k < 2; ++k) dst[n][k] = *(const LAS bf16x8*)(lds + G8_SB(b, h) + boff + n * 2048 + k * 1024); } while (0)
#define G8_MMA(ai, bj, At, Bq) do { if ((ai) == 0 || hi) { __builtin_amdgcn_s_setprio(1); _Pragma("unroll") for (int m = 0; m < 4; ++m) _Pragma("unroll") for (int n = 0; n < 2; ++n) { \
        if (FP8) { const i32x4 a0 = __builtin_bit_cast(i32x4, At[m][0]), a1 = __builtin_bit_cast(i32x4, At[m][1]), b0 = __builtin_bit_cast(i32x4, Bq[n][0]), b1 = __builtin_bit_cast(i32x4, Bq[n][1]); \
            const i32x8 a8 = __builtin_shufflevector(a0, a1, 0, 1, 2, 3, 4, 5, 6, 7), b8 = __builtin_shufflevector(b0, b1, 0, 1, 2, 3, 4, 5, 6, 7); \
            asm volatile("v_mfma_scale_f32_16x16x128_f8f6f4 %0, %1, %2, %0, %3, %4 op_sel_hi:[0,0,0]" : "+v"(acc[ai][bj][m][n]) : "v"(b8), "v"(a8), "v"(mxw), "v"(mxa)); } \
        else { _Pragma("unroll") for (int k = 0; k < 2; ++k) \
            acc[ai][bj][m][n] = TRANS ? __builtin_amdgcn_mfma_f32_16x16x32_bf16(At[m][k], Bq[n][k], acc[ai][bj][m][n], 0, 0, 0) : __builtin_amdgcn_mfma_f32_16x16x32_bf16(Bq[n][k], At[m][k], acc[ai][bj][m][n], 0, 0, 0); } } \
        __builtin_amdgcn_s_setprio(0); } } while (0)
#define G8_WV(n) asm volatile("s_waitcnt vmcnt(" #n ")" ::: "memory")
#define G8_WL(n) asm volatile("s_waitcnt lgkmcnt(" #n ")" ::: "memory")
#define G8_BAR __builtin_amdgcn_s_barrier()
#define G8_SCHED __builtin_amdgcn_sched_barrier(0)
    const int aoff = lds_byte(wr * 64 + fr, fq * 8), boff = lds_byte(wc * 32 + fr, fq * 8);
    f32x4 acc[2][2][4][2];
#pragma unroll
    for (int a = 0; a < 2; ++a)
#pragma unroll
        for (int b = 0; b < 2; ++b)
#pragma unroll
            for (int m = 0; m < 4; ++m)
#pragma unroll
                for (int n = 0; n < 2; ++n) acc[a][b][m][n] = (f32x4){0.f, 0.f, 0.f, 0.f};
    bf16x8 At[4][2], B0[2][2], B1[2][2];
    G8_STB(0, 0, 0); G8_STA(0, 0, 0); G8_STB(0, 1, 0); G8_STA(0, 1, 0);
    if (wr == 1) G8_BAR;
    G8_WV(4); G8_BAR;
    G8_STB(1, 0, 1); G8_STA(1, 0, 1); G8_STB(1, 1, 1);
    G8_WV(6); G8_BAR;
    for (int t = 0; t < nt - 2; t += 2) {
        G8_LDB(B0, 0, 0); G8_SCHED; G8_LDA(At, 0, 0); G8_STA(1, 1, t + 1);
        G8_WL(8); G8_BAR; G8_WL(0); G8_MMA(0, 0, At, B0); G8_BAR; G8_SCHED;
        G8_LDB(B1, 0, 1); G8_STB(0, 0, t + 2);
        G8_BAR; G8_WL(0); G8_MMA(0, 1, At, B1); G8_BAR;
        G8_LDA(At, 0, 1); G8_STA(0, 0, t + 2);
        G8_BAR; G8_WL(0); G8_MMA(1, 0, At, B0); G8_BAR; G8_SCHED;
        G8_STB(0, 1, t + 2);
        G8_WV(6); G8_BAR; G8_MMA(1, 1, At, B1); G8_BAR;
        G8_LDB(B0, 1, 0); G8_SCHED; G8_LDA(At, 1, 0); G8_STA(0, 1, t + 2);
        G8_WL(8); G8_BAR; G8_WL(0); G8_MMA(0, 0, At, B0); G8_BAR; G8_SCHED;
        G8_LDB(B1, 1, 1); G8_STB(1, 0, t + 3);
        G8_BAR; G8_WL(0); G8_MMA(0, 1, At, B1); G8_BAR;
        G8_LDA(At, 1, 1); G8_STA(1, 0, t + 3);
        G8_BAR; G8_WL(0); G8_MMA(1, 0, At, B0); G8_BAR; G8_SCHED;
        G8_STB(1, 1, t + 3);
        G8_WV(6); G8_BAR; G8_MMA(1, 1, At, B1); G8_BAR;
    }
    { G8_LDB(B0, 0, 0); G8_WV(0); G8_LDA(At, 0, 0); G8_STA(1, 1, nt - 1);
      G8_BAR; G8_WL(0); G8_MMA(0, 0, At, B0); G8_BAR;
      G8_LDB(B1, 0, 1); G8_BAR; G8_WL(0); G8_MMA(0, 1, At, B1); G8_BAR;
      G8_LDA(At, 0, 1); G8_WV(4); G8_BAR; G8_WL(0); G8_MMA(1, 0, At, B0); G8_MMA(1, 1, At, B1); G8_BAR; }
    { G8_LDB(B0, 1, 0); G8_LDA(At, 1, 0); G8_WV(2); G8_BAR; G8_WL(0); G8_MMA(0, 0, At, B0); G8_BAR;
      G8_LDB(B1, 1, 1); G8_WV(0); G8_BAR; G8_WL(0); G8_MMA(0, 1, At, B1); G8_BAR;
      G8_LDA(At, 1, 1); G8_BAR; G8_WL(0); G8_MMA(1, 0, At, B0); G8_MMA(1, 1, At, B1); G8_BAR; }
    if (wr == 0) G8_BAR;
#undef G8_SA
#undef G8_SB
#undef G8_STA
#undef G8_STB
#undef G8_LDA
#undef G8_LDB
#undef G8_MMA
#undef G8_WV
#undef G8_WL
#undef G8_BAR
#undef G8_SCHED
    __builtin_amdgcn_sched_barrier(0);
    { const int tz = tid_fresh(), wz = __builtin_amdgcn_readfirstlane(tz >> 6), lz = tz & 63;
      epi(acc, wz >> 2, wz & 3, lz & 15, lz >> 4); }
}
struct StreamUnit { const char* A; const char* Bt; int arow0, rows, a, b, c; };
template <bool TRANS, bool FP8, class Src>
__device__ __forceinline__ void gemm8_stream(LAS unsigned char* lds, unsigned lda, int nt, const Src& src) {
    const int tid = tid_fresh(), wid = __builtin_amdgcn_readfirstlane(tid >> 6), lane = tid & 63;
    const int wr = wid >> 2, wc = wid & 3, fr = lane & 15, fq = lane >> 4;
    StreamUnit cur, nxt;
    if (!src.get(0, cur)) return;
    int R0, C0, R1, C1; stage_rc(tid * 16, R0, C0); stage_rc(tid * 16 + 8192, R1, C1);
    int mxw = W8_MX, mxa = A8_MX; asm volatile("" : "+v"(mxw), "+v"(mxa));
    const int aoff = lds_byte(wr * 64 + fr, fq * 8), boff = lds_byte(wc * 32 + fr, fq * 8);
#define GS_AOF(u, h, R, C) ((unsigned)(((unsigned)((u).arow0 + (((h) * 128 + (R)) < (u).rows ? ((h) * 128 + (R)) : (u).rows - 1)) * lda + (unsigned)(C)) * 2u))
    unsigned ac00 = GS_AOF(cur, 0, R0, C0), ac01 = GS_AOF(cur, 0, R1, C1), ac10 = GS_AOF(cur, 1, R0, C0), ac11 = GS_AOF(cur, 1, R1, C1);
#define GS_SA(b, h) (((b) * 2 + (h)) * 16384)
#define GS_SB(b, h) (65536 + ((b) * 2 + (h)) * 16384)
#define GS_GL(src_, dst_) __builtin_amdgcn_global_load_lds((const unsigned*)(src_), (LAS unsigned*)(lds + (dst_)), 16, 0, 0)
#define GS_STA(b, h, base, o0, o1, kt) do { GS_GL((base) + (o0) + (size_t)(kt) * 128, GS_SA(b, h) + wid * 1024); GS_GL((base) + (o1) + (size_t)(kt) * 128, GS_SA(b, h) + wid * 1024 + 8192); } while (0)
#define GS_STB(b, h, base, kt) do { GS_GL((base) + tid * 16 + (size_t)(kt) * 32768 + (h) * 16384, GS_SB(b, h) + wid * 1024); GS_GL((base) + tid * 16 + (size_t)(kt) * 32768 + (h) * 16384 + 8192, GS_SB(b, h) + wid * 1024 + 8192); } while (0)
#define GS_LDA(dst, b, h) do { _Pragma("unroll") for (int m = 0; m < 4; ++m) _Pragma("unroll") for (int k = 0; k < 2; ++k) dst[m][k] = *(const LAS bf16x8*)(lds + GS_SA(b, h) + aoff + m * 2048 + k * 1024); } while (0)
#define GS_LDB(dst, b, h) do { _Pragma("unroll") for (int n = 0; n < 2; ++n) _Pragma("unroll") for (int k = 0; k < 2; ++k) dst[n][k] = *(const LAS bf16x8*)(lds + GS_SB(b, h) + boff + n * 2048 + k * 1024); } while (0)
#define GS_MMA(ai, bj, At, Bq) do { if ((ai) == 0 || hi) { __builtin_amdgcn_s_setprio(1); _Pragma("unroll") for (int m = 0; m < 4; ++m) _Pragma("unroll") for (int n = 0; n < 2; ++n) { \
        if (FP8) { const i32x4 a0 = __builtin_bit_cast(i32x4, At[m][0]), a1 = __builtin_bit_cast(i32x4, At[m][1]), b0 = __builtin_bit_cast(i32x4, Bq[n][0]), b1 = __builtin_bit_cast(i32x4, Bq[n][1]); \
            const i32x8 a8 = __builtin_shufflevector(a0, a1, 0, 1, 2, 3, 4, 5, 6, 7), b8 = __builtin_shufflevector(b0, b1, 0, 1, 2, 3, 4, 5, 6, 7); \
            asm volatile("v_mfma_scale_f32_16x16x128_f8f6f4 %0, %1, %2, %0, %3, %4 op_sel_hi:[0,0,0]" : "+v"(acc[ai][bj][m][n]) : "v"(b8), "v"(a8), "v"(mxw), "v"(mxa)); } \
        else { _Pragma("unroll") for (int k = 0; k < 2; ++k) \
            acc[ai][bj][m][n] = TRANS ? __builtin_amdgcn_mfma_f32_16x16x32_bf16(At[m][k], Bq[n][k], acc[ai][bj][m][n], 0, 0, 0) : __builtin_amdgcn_mfma_f32_16x16x32_bf16(Bq[n][k], At[m][k], acc[ai][bj][m][n], 0, 0, 0); } } \
        __builtin_amdgcn_s_setprio(0); } } while (0)
#define GS_WV(n) asm volatile("s_waitcnt vmcnt(" #n ")" ::: "memory")
#define GS_WL(n) asm volatile("s_waitcnt lgkmcnt(" #n ")" ::: "memory")
#define GS_BAR __builtin_amdgcn_s_barrier()
#define GS_SCHED __builtin_amdgcn_sched_barrier(0)
    f32x4 acc[2][2][4][2];
#pragma unroll
    for (int a = 0; a < 2; ++a)
#pragma unroll
        for (int b = 0; b < 2; ++b)
#pragma unroll
            for (int m = 0; m < 4; ++m)
#pragma unroll
                for (int n = 0; n < 2; ++n) acc[a][b][m][n] = (f32x4){0.f, 0.f, 0.f, 0.f};
    bf16x8 At[4][2], B0[2][2], B1[2][2];
    GS_STB(0, 0, cur.Bt, 0); GS_STA(0, 0, cur.A, ac00, ac01, 0); GS_STB(0, 1, cur.Bt, 0); GS_STA(0, 1, cur.A, ac10, ac11, 0);
    if (wr == 1) GS_BAR;
    GS_WV(4); GS_BAR;
    GS_STB(1, 0, cur.Bt, 1); GS_STA(1, 0, cur.A, ac00, ac01, 1); GS_STB(1, 1, cur.Bt, 1);
    GS_WV(6); GS_BAR;
    for (int ui = 0;; ++ui) {
        const bool has_next = src.get(ui + 1, nxt);
        if (!has_next) nxt = cur;
        const unsigned an00 = GS_AOF(nxt, 0, R0, C0), an01 = GS_AOF(nxt, 0, R1, C1), an10 = GS_AOF(nxt, 1, R0, C0), an11 = GS_AOF(nxt, 1, R1, C1);
        const bool hi = cur.rows > 128;
        for (int t = 0; t < nt; t += 2) {
            const bool last = (t == nt - 2);
            const char* xA = last ? nxt.A : cur.A; const char* xB = last ? nxt.Bt : cur.Bt;
            const unsigned x00 = last ? an00 : ac00, x01 = last ? an01 : ac01, x10 = last ? an10 : ac10, x11 = last ? an11 : ac11;
            const int k2 = last ? 0 : t + 2, k3 = k2 + 1;
            GS_LDB(B0, 0, 0); GS_SCHED; GS_LDA(At, 0, 0); GS_STA(1, 1, cur.A, ac10, ac11, t + 1);
            GS_WL(8); GS_BAR; GS_WL(0); GS_MMA(0, 0, At, B0); GS_BAR; GS_SCHED;
            GS_LDB(B1, 0, 1); GS_STB(0, 0, xB, k2);
            GS_BAR; GS_WL(0); GS_MMA(0, 1, At, B1); GS_BAR;
            GS_LDA(At, 0, 1); GS_STA(0, 0, xA, x00, x01, k2);
            GS_BAR; GS_WL(0); GS_MMA(1, 0, At, B0); GS_BAR; GS_SCHED;
            GS_STB(0, 1, xB, k2);
            GS_WV(6); GS_BAR; GS_MMA(1, 1, At, B1); GS_BAR;
            GS_LDB(B0, 1, 0); GS_SCHED; GS_LDA(At, 1, 0); GS_STA(0, 1, xA, x10, x11, k2);
            GS_WL(8); GS_BAR; GS_WL(0); GS_MMA(0, 0, At, B0); GS_BAR; GS_SCHED;
            GS_LDB(B1, 1, 1); GS_STB(1, 0, xB, k3);
            GS_BAR; GS_WL(0); GS_MMA(0, 1, At, B1); GS_BAR;
            GS_LDA(At, 1, 1); GS_STA(1, 0, xA, x00, x01, k3);
            GS_BAR; GS_WL(0); GS_MMA(1, 0, At, B0); GS_BAR; GS_SCHED;
            GS_STB(1, 1, xB, k3);
            GS_WV(6); GS_BAR; GS_MMA(1, 1, At, B1); GS_BAR;
        }
        __builtin_amdgcn_sched_barrier(0);
        src.epi(acc, cur, wr, wc, fr, fq);
        __builtin_amdgcn_sched_barrier(0);
        if (!has_next) break;
#pragma unroll
        for (int a = 0; a < 2; ++a)
#pragma unroll
            for (int b = 0; b < 2; ++b)
#pragma unroll
                for (int m = 0; m < 4; ++m)
#pragma unroll
                    for (int n = 0; n < 2; ++n) acc[a][b][m][n] = (f32x4){0.f, 0.f, 0.f, 0.f};
        cur = nxt; ac00 = an00; ac01 = an01; ac10 = an10; ac11 = an11;
    }
    GS_WV(0);
    if (wr == 0) GS_BAR;
    GS_BAR;
#undef GS_AOF
#undef GS_SA
#undef GS_SB
#undef GS_GL
#undef GS_STA
#undef GS_STB
#undef GS_LDA
#undef GS_LDB
#undef GS_MMA
#undef GS_WV
#undef GS_WL
#undef GS_BAR
#undef GS_SCHED
}
struct Epi8PG { u16* PG; int tok0, col0;
    __device__ __forceinline__ void operator()(const f32x4 (&acc)[2][2][4][2], int wr, int wc, int fr, int fq) const {
#pragma unroll
        for (int ai = 0; ai < 2; ++ai)
#pragma unroll
            for (int m = 0; m < 4; ++m) { u16* rowp = PG + (size_t)(tok0 + ai * 128 + wr * 64 + m * 16 + fr) * 5120 + col0 + wc * 32 + 8 * fq;
#pragma unroll
                for (int bj = 0; bj < 2; ++bj) { const f32x4 v0 = acc[ai][bj][m][0], v1 = acc[ai][bj][m][1];
                    *(u32x4*)(rowp + bj * 128) = (u32x4){pk_bf16(v0[0], v0[1]), pk_bf16(v0[2], v0[3]), pk_bf16(v1[0], v1[1]), pk_bf16(v1[2], v1[3])}; } }
    } };
struct Epi8HYT { u16* HYT; int tok0, col0;
    __device__ __forceinline__ void operator()(const f32x4 (&acc)[2][2][4][2], int wr, int wc, int fr, int fq) const {
#pragma unroll
        for (int bj = 0; bj < 2; ++bj)
#pragma unroll
            for (int n = 0; n < 2; ++n) { u16* colp = HYT + (size_t)(col0 + bj * 128 + wc * 32 + perm32(n * 16 + fr)) * NTOK + tok0 + wr * 64 + 4 * fq;
#pragma unroll
                for (int ai = 0; ai < 2; ++ai)
#pragma unroll
                    for (int m = 0; m < 4; ++m) { const f32x4 v = acc[ai][bj][m][n]; *(u32x2*)(colp + ai * 128 + m * 16) = (u32x2){pk_bf16(v[0], v[1]), pk_bf16(v[2], v[3])}; } }
    } };
struct Epi8X1 { const float* x; float* X1; int tok0, col0;
    __device__ __forceinline__ void operator()(const f32x4 (&acc)[2][2][4][2], int wr, int wc, int fr, int fq) const {
#pragma unroll
        for (int ai = 0; ai < 2; ++ai)
#pragma unroll
            for (int m = 0; m < 4; ++m) { const size_t off = (size_t)(tok0 + ai * 128 + wr * 64 + m * 16 + fr) * DM + col0 + wc * 32 + 8 * fq;
#pragma unroll
                for (int bj = 0; bj < 2; ++bj)
#pragma unroll
                    for (int n = 0; n < 2; ++n) { const f32x4 r = *(const f32x4*)(x + off + bj * 128 + n * 4); *(f32x4*)(X1 + off + bj * 128 + n * 4) = r + acc[ai][bj][m][n]; }
                asm volatile("" ::: "memory"); }
    } };
struct Epi8Swiglu { u16* HM; const float* b1; int slot0, nt, rows_valid;
    __device__ __forceinline__ void operator()(const f32x4 (&acc)[2][2][4][2], int wr, int wc, int fr, int fq) const {
        f32x4 bg[2], bl[2];
#pragma unroll
        for (int n = 0; n < 2; ++n) { const int col = nt * 128 + wc * 32 + 8 * fq + 4 * n; bg[n] = *(const f32x4*)(b1 + col); bl[n] = *(const f32x4*)(b1 + 2048 + col); }
#pragma unroll
        for (int ai = 0; ai < 2; ++ai)
#pragma unroll
            for (int m = 0; m < 4; ++m) { const int row = ai * 128 + wr * 64 + m * 16 + fr;
                if (row < rows_valid) { float o[8];
#pragma unroll
                    for (int n = 0; n < 2; ++n) { const f32x4 gl = acc[ai][0][m][n] + bg[n], li = acc[ai][1][m][n] + bl[n];
#pragma unroll
                        for (int j = 0; j < 4; ++j) { const float gq = fminf(gl[j], 7.0f), lq = fminf(fmaxf(li[j], -7.0f), 7.0f); o[4 * n + j] = gq * (1.0f / (1.0f + __expf(-1.702f * gq))) * (lq + 1.0f); } }
                    *(u32x4*)(HM + (size_t)(slot0 + row) * DFF + nt * 128 + wc * 32 + 8 * fq) = (u32x4){pk_bf16(o[0], o[1]), pk_bf16(o[2], o[3]), pk_bf16(o[4], o[5]), pk_bf16(o[6], o[7])}; } }
    } };
struct Epi8Swiglu8 { unsigned char* HM; const float* b1; int slot0, nt, rows_valid;
    __device__ __forceinline__ void operator()(const f32x4 (&acc)[2][2][4][2], int wr, int wc, int fr, int fq) const {
        f32x4 bg[2], bl[2];
#pragma unroll
        for (int n = 0; n < 2; ++n) { const int col = nt * 128 + wc * 32 + 8 * fq + 4 * n; bg[n] = *(const f32x4*)(b1 + col); bl[n] = *(const f32x4*)(b1 + 2048 + col); }
#pragma unroll
        for (int ai = 0; ai < 2; ++ai)
#pragma unroll
            for (int m = 0; m < 4; ++m) { const int row = ai * 128 + wr * 64 + m * 16 + fr;
                if (row < rows_valid) { float o[8];
#pragma unroll
                    for (int n = 0; n < 2; ++n) { const f32x4 gl = acc[ai][0][m][n] + bg[n], li = acc[ai][1][m][n] + bl[n];
#pragma unroll
                        for (int j = 0; j < 4; ++j) { const float gq = fminf(gl[j], 7.0f), lq = fminf(fmaxf(li[j], -7.0f), 7.0f); o[4 * n + j] = gq * (1.0f / (1.0f + __expf(-1.702f * gq))) * (lq + 1.0f); } }
                    *(u32x2*)(HM + (size_t)(slot0 + row) * DFF + nt * 128 + wc * 32 + 8 * fq) = (u32x2){pk_fp8x4(o[0], o[1], o[2], o[3]), pk_fp8x4(o[4], o[5], o[6], o[7])}; } }
    } };
struct Epi8Y { u16* Y; const float* b2; int slot0, col0, rows_valid;
    __device__ __forceinline__ void operator()(const f32x4 (&acc)[2][2][4][2], int wr, int wc, int fr, int fq) const {
        f32x4 bv[2][2];
#pragma unroll
        for (int bj = 0; bj < 2; ++bj)
#pragma unroll
            for (int n = 0; n < 2; ++n) bv[bj][n] = *(const f32x4*)(b2 + col0 + bj * 128 + wc * 32 + 8 * fq + 4 * n);
#pragma unroll
        for (int ai = 0; ai < 2; ++ai)
#pragma unroll
            for (int m = 0; m < 4; ++m) { const int row = ai * 128 + wr * 64 + m * 16 + fr;
                if (row < rows_valid) { u16* rowp = Y + (size_t)(slot0 + row) * DM + col0 + wc * 32 + 8 * fq;
#pragma unroll
                    for (int bj = 0; bj < 2; ++bj) { const f32x4 v0 = acc[ai][bj][m][0] + bv[bj][0], v1 = acc[ai][bj][m][1] + bv[bj][1];
                        *(u32x4*)(rowp + bj * 128) = (u32x4){pk_bf16(v0[0], v0[1]), pk_bf16(v0[2], v0[3]), pk_bf16(v1[0], v1[1]), pk_bf16(v1[2], v1[3])}; } } }
    } };
struct EpiNone { __device__ __forceinline__ void operator()(const f32x4 (&acc)[2][2][4][2], int wr, int wc, int fr, int fq) const {
#pragma unroll
        for (int a = 0; a < 2; ++a)
#pragma unroll
            for (int b = 0; b < 2; ++b)
#pragma unroll
                for (int m = 0; m < 4; ++m)
#pragma unroll
                    for (int n = 0; n < 2; ++n) asm volatile("" :: "v"(acc[a][b][m][n]));
    } };

template <int NTILES>
__device__ __forceinline__ bool moe_unit_static(const LAS int* us, const LAS int* so2, int uu, int& e, int& nt, int& slot0, int& rows) {
    if (uu >= us[NE]) return false;
    int lo = 0, hi = NE;
#pragma unroll
    for (int s = 0; s < 5; ++s) { const int mid = (lo + hi) >> 1; if (us[mid] <= uu) lo = mid; else hi = mid; }
    e = lo; const int o0 = so2[e], cnt = so2[e + 1] - o0, mtl = (cnt + 255) >> 8, ul = uu - us[e], mt = ul % mtl;
    nt = ul / mtl; slot0 = o0 + mt * 256; rows = cnt - mt * 256; rows = rows > 256 ? 256 : rows; return true;
}
struct SrcMoeB { const LAS int* us; const LAS int* so2; int c, G; const char* HM8; const char* W2T8; u16* YB; const float* b2;
    __device__ __forceinline__ bool get(int i, StreamUnit& u) const { int e, nt, slot0, rows; if (!moe_unit_static<8>(us, so2, c + i * G, e, nt, slot0, rows)) return false;
        u.A = HM8; u.Bt = W2T8 + (size_t)((e * 8 + nt) * 16) * 32768; u.arow0 = slot0; u.rows = rows; u.a = e; u.b = nt; u.c = slot0; return true; }
    __device__ __forceinline__ void epi(const f32x4 (&acc)[2][2][4][2], const StreamUnit& u, int wr, int wc, int fr, int fq) const { Epi8Y ep{YB, b2 + (size_t)u.a * DM, u.c, u.b * 256, u.rows}; ep(acc, wr, wc, fr, fq); }
};
template <bool TRANS>
struct SrcG1 { int c, G; const char* HBp; const char* WINTp; u16* PG; u16* HYT;
    __device__ __forceinline__ bool get(int k, StreamUnit& su) const {
        int seen = 0;
        for (int u = c; u < 1024; u += G) { const int i = u >> 8, xx = (u >> 5) & 7, j = u & 31; const int mt = (xx & 3) * 8 + (j & 7), nt = ((xx >> 2) + 2 * i) * 4 + (j >> 3);
            if ((nt >= 20) == TRANS) { if (seen == k) { su.A = HBp; su.Bt = WINTp + (size_t)nt * 32 * 32768; su.arow0 = mt * 256; su.rows = 256; su.a = mt; su.b = nt; su.c = 0; return true; } ++seen; } }
        return false; }
    __device__ __forceinline__ void epi(const f32x4 (&acc)[2][2][4][2], const StreamUnit& u, int wr, int wc, int fr, int fq) const {
        if (TRANS) { Epi8HYT e{HYT, u.a * 256, u.b * 256 - 5120}; e(acc, wr, wc, fr, fq); } else { Epi8PG e{PG, u.a * 256, u.b * 256}; e(acc, wr, wc, fr, fq); } }
};

typedef float f32x16 __attribute__((ext_vector_type(16)));
__device__ __forceinline__ void h3_row(int m, const float* __restrict__ w1, const float* __restrict__ b1, const float* __restrict__ w2, const float* __restrict__ b2,
                                       const float* __restrict__ w3, const float* __restrict__ b3, const float* __restrict__ freq, LAS float* sc  , float* __restrict__ H3) {
    const int j = tid_fresh() & 63;
    const float tt = (float)m / (float)(SEQ - 1);
    if (j == 0) sc[0] = tt;
    if (j >= 1 && j <= 16) { const int i = j - 1; const float band = 1e-4f + (float)i * ((15.0f - 1e-4f) / 15.0f); const float ang = (2.0f * 3.14159265358979323846f / (float)SEQ) * (float)m * band; sc[1 + i] = cosf(ang); sc[17 + i] = -sinf(ang); }
    __builtin_amdgcn_wave_barrier();
    const float fr = freq[j];
    float s = b1[j];
    for (int i = 0; i < 33; ++i) s += sc[i] * w1[i * 64 + j];
    const float h1 = sinf(fr * s);
    sc[64 + j] = h1;
    __builtin_amdgcn_wave_barrier();
    s = b2[j];
    for (int i = 0; i < 64; ++i) s += sc[64 + i] * w2[i * 64 + j];
    const float h2 = sinf(fr * s);
    __builtin_amdgcn_wave_barrier();
    sc[j] = h2;
    __builtin_amdgcn_wave_barrier();
    s = b3[j];
    for (int i = 0; i < 64; ++i) s += sc[i] * w3[i * 64 + j];
    H3[(size_t)m * 64 + j] = sinf(fr * s);
    __builtin_amdgcn_wave_barrier();
}
constexpr int FR_LEN = 4128;
__device__ __forceinline__ void frgen_item(LAS unsigned char* lds, int item, const float* __restrict__ H3, const float* __restrict__ w4, u16* __restrict__ FR) {
    const int tid = tid_fresh(), wid = __builtin_amdgcn_readfirstlane(tid >> 6), lane = tid & 63, fr = lane & 15, fq = lane >> 4;
    const int oc0 = item * 8, o = oc0 >> 10;
    const int colB = o * 2048 + (fr >> 3) * 1024 + (oc0 & 1023) + (fr & 7);
    float wreg[16];
#pragma unroll
    for (int ks = 0; ks < 16; ++ks) wreg[ks] = w4[(size_t)(4 * ks + fq) * 4096 + colB];
    const int dir = fr >> 3, c = (oc0 & 1023) + (fr & 7);
    const float mind = logf(1e-2f) / 0.3f, maxd = logf(1e-2f) / 1.5f;
    const float delta = fabsf(mind + (float)c * ((maxd - mind) / 1023.0f));
    u16* r0 = FR + (size_t)((oc0 + (fr & 7)) * 2) * FR_LEN;
    LAS float* tile = (LAS float*)(lds + wid * 4608);
    const int wrow = lane >> 4, wcol = 4 * (lane & 15);
    f32x4 nx[4];
#pragma unroll
    for (int q = 0; q < 4; ++q) nx[q] = *(const f32x4*)(H3 + (size_t)wid * 1024 + q * 256 + lane * 4);
    for (int it = 0; it < 16; ++it) {
        const int mt = wid + 8 * it;
#pragma unroll
        for (int q = 0; q < 4; ++q) *(LAS f32x4*)(tile + (q * 4 + wrow) * 68 + wcol) = nx[q];
        if (it + 1 < 16) {
#pragma unroll
            for (int q = 0; q < 4; ++q) nx[q] = *(const f32x4*)(H3 + (size_t)(mt + 8) * 1024 + q * 256 + lane * 4);
        }
        f32x4 acc = {0.f, 0.f, 0.f, 0.f};
#pragma unroll
        for (int ks = 0; ks < 16; ++ks) acc = __builtin_amdgcn_mfma_f32_16x16x4f32(tile[fr * 68 + 4 * ks + fq], wreg[ks], acc, 0, 0, 0);
        const int m0 = mt * 16 + 4 * fq;
        float v[4];
#pragma unroll
        for (int j = 0; j < 4; ++j) v[j] = acc[j] * __expf(-((float)(m0 + j) / (float)(SEQ - 1)) * delta);
        if (dir == 0) {
            *(u32x2*)(r0 + 2044 - m0) = (u32x2){pk_bf16(v[3], v[2]), pk_bf16(v[1], v[0])};
#pragma unroll
            for (int j = 0; j < 4; ++j) r0[FR_LEN + 2046 - m0 - j] = (u16)(pk_bf16(v[j], 0.f) & 0xffffu);
        } else {
#pragma unroll
            for (int j = 0; j < 4; ++j) if (m0 + j >= 1) { const u16 b = (u16)(pk_bf16(v[j], 0.f) & 0xffffu); r0[2047 + m0 + j] = b; r0[FR_LEN + 2046 + m0 + j] = b; }
        }
    }
    if (tid < 8 * 34) { const int r = tid / 34, x = 4094 + tid % 34; u16* rr = FR + (size_t)((oc0 + r) * 2) * FR_LEN; if (x >= 4095) rr[x] = 0; rr[FR_LEN + x] = 0; }
    __syncthreads();
}
constexpr int HY_ZSTRIDE = 2312;
constexpr int HY_ZCH = 256 + 4 * HY_ZSTRIDE;
constexpr int HY_ZBYTES = HY_ZCH * 2;
constexpr int HY_FB = 4 * HY_ZBYTES;
constexpr int HY_FCH = 2 * FR_LEN * 2;
constexpr int HY_LDS = HY_FB + 4 * HY_FCH;

__device__ __forceinline__ void hy_load_row(LAS unsigned char* lds, int dest, int boff0, int bstride, const u16* __restrict__ row, float w0, float w1, float w2, float cb, int pl) {
#pragma unroll 2
    for (int it = 0; it < 8; ++it) {
        const int idx = pl + 128 * it, tok0 = idx * 8, b = tok0 >> 11, n0 = tok0 & 2047;
        const u32x4 raw = *(const u32x4*)(row + tok0);
        const float pm = (n0 > 0) ? bf2f(row[tok0 - 1]) : 0.f;
        const float pn = (n0 + 8 < SEQ) ? bf2f(row[tok0 + 8]) : 0.f;
        float p[10];
        p[0] = pm; p[9] = pn;
#pragma unroll
        for (int q = 0; q < 4; ++q) { p[1 + 2 * q] = bflo(raw[q]); p[2 + 2 * q] = bfhi(raw[q]); }
        float o[8];
#pragma unroll
        for (int q = 0; q < 8; ++q) o[q] = fmaf(w0, p[q], fmaf(w1, p[q + 1], fmaf(w2, p[q + 2], cb)));
        u32x4 w; w[0] = pk_bf16(o[0], o[1]); w[1] = pk_bf16(o[2], o[3]); w[2] = pk_bf16(o[4], o[5]); w[3] = pk_bf16(o[6], o[7]);
        *(LAS u32x4*)(lds + dest + (boff0 + b * bstride + n0) * 2) = w;
    }
}
__device__ __forceinline__ void hy_load_filters(LAS unsigned char* lds, int fb, const u16* __restrict__ src, int pl) {
    for (int idx = pl; idx < HY_FCH / 16; idx += 128) *(LAS u32x4*)(lds + fb + idx * 16) = *(const u32x4*)((const char*)src + idx * 16);
}
__device__ __forceinline__ void hy_mfma_loop(LAS unsigned char* lds, int zb, int fb, int hlf, int lane, f32x16 (&acc)[4], const ConvCtx& cc, int mbase, int cunit, int wid) {
    const int r = lane & 31, hh = lane >> 5, il = r >> 2, b = r & 3;
    const int bbase = zb + (256 + b * HY_ZSTRIDE + 32 * il + 8 * hh) * 2;
    const int xl = 2047 - r + 8 * hh - 1024 * hlf;
    const int abase = (r & 1) ? (fb + 2 * xl) : (fb + FR_LEN * 2 + 2 * (xl - 1));
#pragma unroll
    for (int q = 0; q < 4; ++q)
#pragma unroll
        for (int i = 0; i < 16; ++i) acc[q][i] = 0.f;
    for (int d0 = 0; d0 < 8; ++d0) {
#pragma unroll
        for (int ks = 0; ks < 2; ++ks) {
            f32x2 cv[16];
            const int mcv = conv_seq2tile((mbase + d0 * 2 + ks) * 256 + cunit);
            conv_issue(cc, mcv, wid, lane, cv);
            bf16x8 Bt[9];
#pragma unroll
            for (int j = 0; j < 9; ++j) Bt[j] = *(const LAS bf16x8*)(lds + bbase + 512 * j - 64 * d0 + 32 * ks);
#pragma unroll
            for (int ep = -8; ep <= 3; ++ep) {
                const LAS unsigned* ap = (const LAS unsigned*)(lds + abase - 64 * d0 - 512 * ep + 32 * ks);
                u32x4 av; av[0] = ap[0]; av[1] = ap[1]; av[2] = ap[2]; av[3] = ap[3];
                const bf16x8 a = __builtin_bit_cast(bf16x8, av);
#pragma unroll
                for (int ctl = 0; ctl < 4; ++ctl) { const int jt = ctl - ep; if (jt >= 0 && jt <= 8) acc[ctl] = __builtin_amdgcn_mfma_f32_32x32x16_bf16(a, Bt[jt], acc[ctl], 0, 0, 0); }
            }
            conv_finish(cc, mcv, wid, lane, cv);
        }
    }
}
__device__ __forceinline__ void hy_epilogue(LAS unsigned char* lds, int zb, int gb, int hlf, int lane, const f32x16 (&acc)[4], float bias) {
    const int r = lane & 31, hh = lane >> 5, il = r >> 2, b = r & 3;
#pragma unroll
    for (int ctl = 0; ctl < 4; ++ctl) {
        const int I = 8 * (4 * hlf + ctl) + il;
#pragma unroll
        for (int q = 0; q < 4; ++q) {
            const int n4 = 32 * I + 8 * q + 4 * hh;
            LAS u32x2* zp = (LAS u32x2*)(lds + zb + (256 + b * HY_ZSTRIDE + n4) * 2);
            const u32x2 zv = *zp, gv = *(const LAS u32x2*)(lds + gb + (b * 2048 + n4) * 2);
            const float z0 = bflo(zv[0]), z1 = bfhi(zv[0]), z2 = bflo(zv[1]), z3 = bfhi(zv[1]);
            const float g0 = bflo(gv[0]), g1 = bfhi(gv[0]), g2 = bflo(gv[1]), g3 = bfhi(gv[1]);
            u32x2 o; o[0] = pk_bf16(g0 * fmaf(bias, z0, acc[ctl][4 * q + 0]), g1 * fmaf(bias, z1, acc[ctl][4 * q + 1]));
            o[1] = pk_bf16(g2 * fmaf(bias, z2, acc[ctl][4 * q + 2]), g3 * fmaf(bias, z3, acc[ctl][4 * q + 3]));
            *zp = o;
        }
    }
}
__device__ __forceinline__ void hyena_unit(LAS unsigned char* lds, int unit, const u16* __restrict__ HYT, const u16* __restrict__ FR, const float* __restrict__ cw, const float* __restrict__ cbv,
                                           const float* __restrict__ hbias, u16* __restrict__ Z2T, const ConvCtx& cc) {
    const int tid = tid_fresh(), wid = __builtin_amdgcn_readfirstlane(tid >> 6), lane = tid & 63;
    const int cs = wid & 3, hlf = wid >> 2, c = unit * 4 + cs, pl = lane + 64 * hlf;
    const int zb = cs * HY_ZBYTES, fb = HY_FB + cs * HY_FCH;
    { const u32x4 z = {0u, 0u, 0u, 0u}; for (int idx = pl; idx < HY_ZBYTES / 16; idx += 128) *(LAS u32x4*)(lds + zb + idx * 16) = z; }
    __syncthreads();
    hy_load_row(lds, zb, 256, HY_ZSTRIDE, HYT + (size_t)c * NTOK, cw[0 * 3072 + c], cw[1 * 3072 + c], cw[2 * 3072 + c], cbv[c], pl);
    f32x16 acc[4];
#pragma unroll
    for (int o = 0; o < 2; ++o) {
        hy_load_filters(lds, fb, FR + (size_t)((o * 1024 + c) * 2) * FR_LEN, pl);
        __syncthreads();
        hy_mfma_loop(lds, zb, fb, hlf, lane, acc, cc, o * 16, unit, wid);
        __syncthreads();
        const int gc = (1 + o) * 1024 + c;
        hy_load_row(lds, fb, 0, 2048, HYT + (size_t)gc * NTOK, cw[0 * 3072 + gc], cw[1 * 3072 + gc], cw[2 * 3072 + gc], cbv[gc], pl);
        __syncthreads();
        hy_epilogue(lds, zb, fb, hlf, lane, acc, hbias[o * HYW + c]);
        __syncthreads();
    }
#pragma unroll 2
    for (int it = 0; it < 8; ++it) { const int idx = pl + 128 * it, tok0 = idx * 8, b = tok0 >> 11, n0 = tok0 & 2047;
        *(u32x4*)(Z2T + (size_t)c * NTOK + tok0) = *(const LAS u32x4*)(lds + zb + (256 + b * HY_ZSTRIDE + n0) * 2); }
    __syncthreads();
}

constexpr int HG_RAWQ = 0, HG_RAWF = 16384, HG_RAWV = 32768;
constexpr int HG_QM = 36864, HG_KM = HG_QM + 17408, HG_QI = HG_KM + 17408;
constexpr int HG_KL = HG_QI + 17408;
constexpr int HG_VT = HG_KL + 18432;
constexpr int HG_P = HG_VT + 4608;
constexpr int HG_ST = HG_P + 9216;
constexpr int HG_TOT = HG_ST + 8704;
constexpr int HG_EL2 = HG_TOT + 2048;
constexpr int HG_LDS = HG_EL2 + 512;

__device__ __forceinline__ void hgrn_unit(LAS unsigned char* lds, int unit, const u16* __restrict__ PG, const float* __restrict__ lb_logits, float* __restrict__ OF, float* __restrict__ OB, const ConvCtx& cc) {
    const int tid = tid_fresh(), wid = __builtin_amdgcn_readfirstlane(tid >> 6), lane = tid & 63, fr = lane & 15, fq = lane >> 4;
    const int vq = unit & 3, dir = (unit >> 2) & 1, h = (unit >> 3) & 7, b = unit >> 6;
    const int k = tid & 127, seg = tid >> 7;
    float* __restrict__ O = dir ? OB : OF;
    float lb;
    { const int c = h * 128 + k; const float l0 = lb_logits[(0 * 2 + dir) * HGW + c], l1 = lb_logits[(1 * 2 + dir) * HGW + c]; lb = 1.0f / (1.0f + __expf(l1 - l0)); }
    for (int i = tid; i < 8704 / 16; i += 512) *(LAS u32x4*)(lds + HG_ST + i * 16) = (u32x4){0u, 0u, 0u, 0u};
    f32x4 Sacc[2];
    Sacc[0] = (f32x4){0.f, 0.f, 0.f, 0.f}; Sacc[1] = Sacc[0];
    u32x4 pq[2], pf[2], pv;
    const int colq = h * 128, colf = (1 + dir) * 1024 + h * 128, colv = 3072 + h * 128 + vq * 32;
#define HG_TOK(c, tau) ((size_t)b * SEQ + (dir ? (SEQ - 1 - 64 * (c) - (tau)) : (64 * (c) + (tau))))
#define HG_PREFETCH(c) do { _Pragma("unroll") for (int _i = 0; _i < 2; ++_i) { const int _x = tid + 512 * _i, _tau = _x >> 4, _p = _x & 15; const u16* _r = PG + HG_TOK(c, _tau) * 5120; \
            pq[_i] = *(const u32x4*)(_r + colq + _p * 8); pf[_i] = *(const u32x4*)(_r + colf + _p * 8); } \
        if (tid < 256) { const int _tau = tid >> 2, _p = tid & 3; pv = *(const u32x4*)(PG + HG_TOK(c, _tau) * 5120 + colv + _p * 8); } } while (0)
    HG_PREFETCH(0);
    for (int c = 0; c < 32; ++c) {
#pragma unroll
        for (int i = 0; i < 2; ++i) { const int x = tid + 512 * i; *(LAS u32x4*)(lds + HG_RAWQ + x * 16) = pq[i]; *(LAS u32x4*)(lds + HG_RAWF + x * 16) = pf[i]; }
        if (tid < 256) *(LAS u32x4*)(lds + HG_RAWV + tid * 16) = pv;
        if (c + 1 < 32) HG_PREFETCH(c + 1);
        f32x2 cv[16];
        const int mqa = conv_seq2tile((32 + c * 2) * 256 + unit), mqb = conv_seq2tile((33 + c * 2) * 256 + unit);
        conv_issue(cc, mqa, wid, lane, cv);
        __syncthreads();
        float qv[16], kv[16], bl[16];
        { float run = 0.f;
#pragma unroll
          for (int i = 0; i < 16; ++i) { const int tau = seg * 16 + i;
              const float qr = bf2f(*(const LAS u16*)(lds + HG_RAWQ + tau * 256 + k * 2)), zf = bf2f(*(const LAS u16*)(lds + HG_RAWF + tau * 256 + k * 2));
              const float sg = 1.0f / (1.0f + __expf(-zf)); const float f = lb + (1.0f - lb) * sg;
              run += __logf(f); bl[i] = run; kv[i] = 1.0f - f; qv[i] = qr / (1.0f + __expf(-qr)); }
          *(LAS float*)(lds + HG_TOT + (seg * 128 + k) * 4) = run; }
        __syncthreads();
        { const float t0 = *(const LAS float*)(lds + HG_TOT + (0 * 128 + k) * 4), t1 = *(const LAS float*)(lds + HG_TOT + (1 * 128 + k) * 4),
                      t2 = *(const LAS float*)(lds + HG_TOT + (2 * 128 + k) * 4), t3 = *(const LAS float*)(lds + HG_TOT + (3 * 128 + k) * 4);
          const float pre = (seg > 0 ? t0 : 0.f) + (seg > 1 ? t1 : 0.f) + (seg > 2 ? t2 : 0.f);
          const float bref = t0 + t1, blast = bref + t2 + t3;
          const float er = __expf(bref), el = __expf(blast - bref);
          if (seg == 0) *(LAS float*)(lds + HG_EL2 + k * 4) = __expf(blast);
          unsigned klp[8];
#pragma unroll
          for (int i = 0; i < 16; i += 2) {
              float klv[2];
#pragma unroll
              for (int u = 0; u < 2; ++u) { const int tau = seg * 16 + i + u; const float bb = pre + bl[i + u];
                  const float e1 = __expf(bb - bref), e2 = __expf(bref - bb);
                  const float qm = qv[i + u] * e1, km = kv[i + u] * e2;
                  *(LAS u16*)(lds + HG_QM + tau * 272 + k * 2) = (u16)(pk_bf16(qm, 0.f) & 0xffffu);
                  *(LAS u16*)(lds + HG_KM + tau * 272 + k * 2) = (u16)(pk_bf16(km, 0.f) & 0xffffu);
                  *(LAS u16*)(lds + HG_QI + tau * 272 + k * 2) = (u16)(pk_bf16(qm * er, 0.f) & 0xffffu);
                  klv[u] = km * el; }
              klp[i >> 1] = pk_bf16(klv[0], klv[1]); }
          *(LAS u32x4*)(lds + HG_KL + k * 144 + seg * 32) = (u32x4){klp[0], klp[1], klp[2], klp[3]};
          *(LAS u32x4*)(lds + HG_KL + k * 144 + seg * 32 + 16) = (u32x4){klp[4], klp[5], klp[6], klp[7]};
          { const int v = tid & 31, tg = tid >> 5; unsigned short e[4];
#pragma unroll
            for (int u = 0; u < 4; ++u) e[u] = *(const LAS u16*)(lds + HG_RAWV + (tg * 4 + u) * 64 + v * 2);
            *(LAS u32x2*)(lds + HG_VT + v * 144 + tg * 8) = (u32x2){(unsigned)e[0] | ((unsigned)e[1] << 16), (unsigned)e[2] | ((unsigned)e[3] << 16)}; } }
        conv_finish(cc, mqa, wid, lane, cv);
        conv_issue(cc, mqb, wid, lane, cv);
        __syncthreads();
#pragma unroll
        for (int q = 0; q < 2; ++q) { const int idx = wid * 2 + q, ti = idx >> 2, si = idx & 3;
            f32x4 a = {0.f, 0.f, 0.f, 0.f};
            if (si <= ti) {
#pragma unroll
                for (int ks = 0; ks < 4; ++ks) { const bf16x8 ka = *(const LAS bf16x8*)(lds + HG_KM + (si * 16 + fr) * 272 + (ks * 32 + fq * 8) * 2), qb = *(const LAS bf16x8*)(lds + HG_QM + (ti * 16 + fr) * 272 + (ks * 32 + fq * 8) * 2);
                    a = __builtin_amdgcn_mfma_f32_16x16x32_bf16(ka, qb, a, 0, 0, 0); } }
            const int tau = ti * 16 + fr, s0 = si * 16 + fq * 4;
            float pvv[4];
#pragma unroll
            for (int j = 0; j < 4; ++j) pvv[j] = (si <= ti && s0 + j <= tau) ? a[j] : 0.f;
            *(LAS u32x2*)(lds + HG_P + tau * 144 + s0 * 2) = (u32x2){pk_bf16(pvv[0], pvv[1]), pk_bf16(pvv[2], pvv[3])}; }
        const int ti = wid >> 1, vi = wid & 1;
        f32x4 oacc = {0.f, 0.f, 0.f, 0.f};
#pragma unroll
        for (int ks = 0; ks < 4; ++ks) { const bf16x8 qa = *(const LAS bf16x8*)(lds + HG_QI + (ti * 16 + fr) * 272 + (ks * 32 + fq * 8) * 2), sb = *(const LAS bf16x8*)(lds + HG_ST + (vi * 16 + fr) * 272 + (ks * 32 + fq * 8) * 2);
            oacc = __builtin_amdgcn_mfma_f32_16x16x32_bf16(qa, sb, oacc, 0, 0, 0); }
        { const f32x4 e2 = *(const LAS f32x4*)(lds + HG_EL2 + (wid * 16 + fq * 4) * 4);
#pragma unroll
          for (int v2 = 0; v2 < 2; ++v2) { Sacc[v2] = Sacc[v2] * e2;
#pragma unroll
              for (int ks = 0; ks < 2; ++ks) { const bf16x8 ka = *(const LAS bf16x8*)(lds + HG_KL + (wid * 16 + fr) * 144 + (ks * 32 + fq * 8) * 2), vb = *(const LAS bf16x8*)(lds + HG_VT + (v2 * 16 + fr) * 144 + (ks * 32 + fq * 8) * 2);
                  Sacc[v2] = __builtin_amdgcn_mfma_f32_16x16x32_bf16(ka, vb, Sacc[v2], 0, 0, 0); } } }
        __syncthreads();
#pragma unroll
        for (int ks = 0; ks < 2; ++ks) { const bf16x8 pa = *(const LAS bf16x8*)(lds + HG_P + (ti * 16 + fr) * 144 + (ks * 32 + fq * 8) * 2), vb = *(const LAS bf16x8*)(lds + HG_VT + (vi * 16 + fr) * 144 + (ks * 32 + fq * 8) * 2);
            oacc = __builtin_amdgcn_mfma_f32_16x16x32_bf16(pa, vb, oacc, 0, 0, 0); }
#pragma unroll
        for (int j = 0; j < 4; ++j) { const int tau = ti * 16 + fq * 4 + j; O[HG_TOK(c, tau) * HGW + h * 128 + vq * 32 + vi * 16 + fr] = oacc[j]; }
        conv_finish(cc, mqb, wid, lane, cv);
#pragma unroll
        for (int v2 = 0; v2 < 2; ++v2) *(LAS u32x2*)(lds + HG_ST + (v2 * 16 + fr) * 272 + (wid * 16 + fq * 4) * 2) = (u32x2){pk_bf16(Sacc[v2][0], Sacc[v2][1]), pk_bf16(Sacc[v2][2], Sacc[v2][3])};
    }
    __syncthreads();
#undef HG_TOK
#undef HG_PREFETCH
}


#define XB_TMO      128
#define XB_XCNT(j)  (256  + 64 * (j))
#define XB_XSUB(j)  (1280 + 64 * (j))
#define XB_XGEN(j)  (2304 + 64 * (j))
#define XB_TOP      3328
#define XB_TOPGEN   3392
#define XCD_BAR_WORDS 3456
#define XB_SPIN_CAP (1u << 22)

__device__ __forceinline__ unsigned xb_ld(unsigned* p)              { return __hip_atomic_load(p, __ATOMIC_RELAXED, __HIP_MEMORY_SCOPE_AGENT); }
__device__ __forceinline__ unsigned xb_add(unsigned* p, unsigned v) { return __hip_atomic_fetch_add(p, v, __ATOMIC_RELAXED, __HIP_MEMORY_SCOPE_AGENT); }
__device__ __forceinline__ unsigned xb_xcc_id() { return (unsigned)__builtin_amdgcn_s_getreg((3 << 11) | 20) & 0xFu; }
#define XB_SPIN(cond, bar) do { unsigned _sp = 0; while (cond) { __builtin_amdgcn_s_sleep(1); \
    if ((++_sp & 255u) == 0u) { if (xb_ld(&(bar)[XB_TMO])) break; if (_sp > XB_SPIN_CAP) { atomicAdd(&(bar)[XB_TMO], 1u); break; } } } } while (0)

struct XcdBarrier {
    unsigned* bar; unsigned x;
    volatile LAS unsigned* st;
};

__device__ __forceinline__ XcdBarrier xcd_barrier_post(unsigned* bar, volatile LAS unsigned* st) {
    XcdBarrier b; b.bar = bar; b.x = xb_xcc_id(); b.st = st;
    if (threadIdx.x == 0) (void)xb_add(&bar[XB_XCNT(b.x)], 1u);
    return b;
}
__device__ __forceinline__ void xcd_barrier_complete(unsigned* bar, unsigned x, unsigned& nloc, unsigned& nx) {
    const unsigned G = gridDim.x * gridDim.y * gridDim.z;
    unsigned sum, cnt, mine, sp = 0u;
    for (;;) {
        sum = 0u; cnt = 0u; mine = 0u;
#pragma unroll
        for (unsigned j = 0; j < 16; ++j) { const unsigned c = xb_ld(&bar[XB_XCNT(j)]); sum += c; cnt += (c > 0u) ? 1u : 0u; mine = (j == x) ? c : mine; }
        if (sum == G) break;
        __builtin_amdgcn_s_sleep(1);
        if ((++sp & 255u) == 0u) { if (xb_ld(&bar[XB_TMO])) break; if (sp > XB_SPIN_CAP) { atomicAdd(&bar[XB_TMO], 1u); break; } }
    }
    nloc = mine > 0u ? mine : 1u; nx = cnt > 0u ? cnt : 1u;
}

__device__ __forceinline__ void xcd_barrier(const XcdBarrier& b) {
    asm volatile("s_waitcnt vmcnt(0)" ::: "memory");
    __syncthreads();
    if (threadIdx.x == 0) {
        unsigned* bar = b.bar;
        __builtin_amdgcn_s_waitcnt(0);
        unsigned nloc = b.st[0], nx = b.st[1];
        if (nloc == 0u) { xcd_barrier_complete(bar, b.x, nloc, nx); b.st[0] = nloc; b.st[1] = nx; }
        const unsigned old = xb_add(&bar[XB_XSUB(b.x)], 1u);
        const unsigned gen = old / nloc;
        if (old + 1u == (gen + 1u) * nloc) {
            __builtin_amdgcn_fence(__ATOMIC_RELEASE, "agent");
            asm volatile("s_waitcnt vmcnt(0)" ::: "memory");
            const unsigned og = xb_add(&bar[XB_TOP], 1u);
            const unsigned tg = og / nx;
            if (og + 1u == (tg + 1u) * nx) xb_add(&bar[XB_TOPGEN], 1u);
            else XB_SPIN(xb_ld(&bar[XB_TOPGEN]) == tg, bar);
            __builtin_amdgcn_fence(__ATOMIC_ACQUIRE, "agent");
            xb_add(&bar[XB_XGEN(b.x)], 1u);
            asm volatile("s_waitcnt vmcnt(0)" ::: "memory");
        } else {
            XB_SPIN(xb_ld(&bar[XB_XGEN(b.x)]) == gen, bar);
            __builtin_amdgcn_fence(__ATOMIC_ACQUIRE, "agent");
            asm volatile("s_waitcnt vmcnt(0)" ::: "memory");
        }
    }
    __syncthreads();
}

__device__ __forceinline__ float wave_sum(float s) {
#pragma unroll
    for (int o = 32; o >= 1; o >>= 1) s += __shfl_xor(s, o);
    return s;
}
__device__ __forceinline__ void rmsnorm_row_bf(const float* __restrict__ xr, const float* __restrict__ gain, u16* __restrict__ ob, int lane) {
    f32x4 v[8]; float s = 0.f;
#pragma unroll
    for (int j = 0; j < 8; ++j) { v[j] = *(const f32x4*)(xr + (lane + 64 * j) * 4); s += v[j][0] * v[j][0] + v[j][1] * v[j][1] + v[j][2] * v[j][2] + v[j][3] * v[j][3]; }
    s = wave_sum(s);
    const float r = rsqrtf(s * (1.0f / (float)DM) + EPS);
#pragma unroll
    for (int j = 0; j < 8; ++j) { const f32x4 g = *(const f32x4*)(gain + (lane + 64 * j) * 4); const f32x4 o = v[j] * r * g;
        *(u32x2*)(ob + (lane + 64 * j) * 4) = (u32x2){pk_bf16(o[0], o[1]), pk_bf16(o[2], o[3])}; }
}
__device__ __forceinline__ void hgrn_final_item4(int item0, int stride, const float* __restrict__ OF, const float* __restrict__ OB, const u16* __restrict__ PG, const float* __restrict__ gain, u16* __restrict__ MIXB, int lane) {
    f32x2 a[4], b[4]; unsigned gw[4];
#pragma unroll
    for (int q = 0; q < 4; ++q) { const int item = item0 + q * stride, tok = item >> 3, c = (item & 7) * 128 + 2 * lane;
        a[q] = *(const f32x2*)(OF + (size_t)tok * HGW + c); b[q] = *(const f32x2*)(OB + (size_t)tok * HGW + c); gw[q] = *(const unsigned*)(PG + (size_t)tok * 5120 + 4096 + c); }
#pragma unroll
    for (int q = 0; q < 4; ++q) { const int item = item0 + q * stride, tok = item >> 3, c = (item & 7) * 128 + 2 * lane;
        const float o0 = a[q][0] + b[q][0], o1 = a[q][1] + b[q][1];
        const float s = wave_sum(o0 * o0 + o1 * o1);
        const float r = rsqrtf(s * (1.0f / 128.0f) + EPS);
        const float g0 = bflo(gw[q]), g1 = bfhi(gw[q]);
        const f32x2 gn = *(const f32x2*)(gain + c);
        const float v0 = o0 * r * gn[0] * (g0 / (1.0f + __expf(-g0))), v1 = o1 * r * gn[1] * (g1 / (1.0f + __expf(-g1)));
        *(unsigned*)(MIXB + (size_t)tok * DM + c) = pk_bf16(v0, v1); }
}
__device__ __forceinline__ void hy_norm_tile(LAS unsigned char* lds, int tile_i, const u16* __restrict__ Z2T, const float* __restrict__ gain, u16* __restrict__ MIXB) {
    const int t = tid_fresh(), tok0 = tile_i * 32;
    LAS float* ssq = (LAS float*)(lds + 1024 * 80);
    if (t < 32) ssq[t] = 0.f;
    __syncthreads();
    float part[8];
#pragma unroll
    for (int q = 0; q < 8; ++q) part[q] = 0.f;
    const int ch = t & 3;
#pragma unroll
    for (int it = 0; it < 8; ++it) {
        const int c = (t >> 2) + 128 * it;
        const u32x4 v = *(const u32x4*)(Z2T + (size_t)c * NTOK + tok0 + ch * 8);
        *(LAS u32x4*)(lds + c * 80 + ch * 16) = v;
#pragma unroll
        for (int q = 0; q < 4; ++q) { const float a = bflo(v[q]), b = bfhi(v[q]); part[2 * q] += a * a; part[2 * q + 1] += b * b; }
    }
#pragma unroll
    for (int q = 0; q < 8; ++q) { float s = part[q]; s += __shfl_xor(s, 4); s += __shfl_xor(s, 8); s += __shfl_xor(s, 16); s += __shfl_xor(s, 32); part[q] = s; }
    if ((t & 63) < 4) {
#pragma unroll
        for (int q = 0; q < 8; ++q) atomicAdd((float*)(ssq + ch * 8 + q), part[q]);
    }
    __syncthreads();
    const int tt = t >> 4;
    const float r = rsqrtf(ssq[tt] * (1.0f / (float)HYW) + EPS);
#pragma unroll 2
    for (int k = 0; k < 8; ++k) {
        const int c0 = ((t & 15) + 16 * k) * 8;
        float o[8];
#pragma unroll
        for (int q = 0; q < 8; ++q) o[q] = bf2f(*(const LAS u16*)(lds + (c0 + q) * 80 + tt * 2)) * r * gain[c0 + q];
        *(u32x4*)(MIXB + (size_t)(tok0 + tt) * DM + 1024 + c0) = (u32x4){pk_bf16(o[0], o[1]), pk_bf16(o[2], o[3]), pk_bf16(o[4], o[5]), pk_bf16(o[6], o[7])};
    }
    __syncthreads();
}
constexpr int RT_XSTRIDE = 2049;
constexpr int RT_PART = 16 * RT_XSTRIDE * 4;
constexpr int RT_LG = RT_PART + 8 * 16 * 32 * 4;
constexpr int RT_HIST = RT_LG + 16 * 32 * 4;
constexpr int RT_END = RT_HIST + 128;
__device__ __forceinline__ void router_tile(LAS unsigned char* lds, int tile_i, const float* __restrict__ X1, const float* __restrict__ gain, const float* __restrict__ wr, const float* __restrict__ br,
                                            unsigned char* __restrict__ XN8, int* __restrict__ TOPI, float* __restrict__ TOPG, int* __restrict__ counts) {
    const int tid = tid_fresh(), wid = __builtin_amdgcn_readfirstlane(tid >> 6), lane = tid & 63;
    const int tok0 = tile_i * 16;
    LAS float* xs = (LAS float*)lds;
#pragma unroll
    for (int q = 0; q < 2; ++q) {
        const int tl = wid * 2 + q; const size_t tok = (size_t)tok0 + tl;
        const float* xr = X1 + tok * DM;
        f32x4 v[8]; float s = 0.f;
#pragma unroll
        for (int j = 0; j < 8; ++j) { v[j] = *(const f32x4*)(xr + (lane + 64 * j) * 4); s += v[j][0] * v[j][0] + v[j][1] * v[j][1] + v[j][2] * v[j][2] + v[j][3] * v[j][3]; }
        s = wave_sum(s);
        const float r = rsqrtf(s * (1.0f / (float)DM) + EPS);
#pragma unroll
        for (int j = 0; j < 8; ++j) { const int d = (lane + 64 * j) * 4; const f32x4 g = *(const f32x4*)(gain + d); const f32x4 o = v[j] * r * g;
            xs[tl * RT_XSTRIDE + d + 0] = o[0]; xs[tl * RT_XSTRIDE + d + 1] = o[1]; xs[tl * RT_XSTRIDE + d + 2] = o[2]; xs[tl * RT_XSTRIDE + d + 3] = o[3];
            *(unsigned*)(XN8 + tok * DM + d) = pk_fp8x4(o[0], o[1], o[2], o[3]); }
    }
    __syncthreads();
    {
        const int tl = lane & 15, kk = lane >> 4;
        f32x4 a0 = {0.f, 0.f, 0.f, 0.f}, a1 = a0;
        const LAS float* xp = xs + tl * RT_XSTRIDE + wid * 256 + kk;
        const float* wp = wr + (size_t)(wid * 256 + kk) * NE + tl;
#pragma unroll 8
        for (int ks = 0; ks < 64; ++ks) { const float a = xp[ks * 4]; const float b0 = wp[(size_t)ks * 4 * NE], b1 = wp[(size_t)ks * 4 * NE + 16];
            a0 = __builtin_amdgcn_mfma_f32_16x16x4f32(a, b0, a0, 0, 0, 0); a1 = __builtin_amdgcn_mfma_f32_16x16x4f32(a, b1, a1, 0, 0, 0); }
        LAS float* pp = (LAS float*)(lds + RT_PART) + wid * 512;
#pragma unroll
        for (int j = 0; j < 4; ++j) { pp[(kk * 4 + j) * 32 + tl] = a0[j]; pp[(kk * 4 + j) * 32 + 16 + tl] = a1[j]; }
    }
    __syncthreads();
    {   const LAS float* pp = (const LAS float*)(lds + RT_PART); float s = br[tid & 31];
#pragma unroll
        for (int w = 0; w < 8; ++w) s += pp[w * 512 + tid];
        ((LAS float*)(lds + RT_LG))[tid] = s; }
    __syncthreads();
    if (tid < 16) {
        LAS float* lg = (LAS float*)(lds + RT_LG) + tid * 32;
        int i0 = 0, i1 = 0, i2 = 0, i3 = 0; float v0, v1, v2, v3;
        { float bv = -3.0e38f; for (int j = 0; j < NE; ++j) { const float l = lg[j]; if (l > bv) { bv = l; i0 = j; } } v0 = bv; lg[i0] = -3.4e38f; }
        { float bv = -3.0e38f; for (int j = 0; j < NE; ++j) { const float l = lg[j]; if (l > bv) { bv = l; i1 = j; } } v1 = bv; lg[i1] = -3.4e38f; }
        { float bv = -3.0e38f; for (int j = 0; j < NE; ++j) { const float l = lg[j]; if (l > bv) { bv = l; i2 = j; } } v2 = bv; lg[i2] = -3.4e38f; }
        { float bv = -3.0e38f; for (int j = 0; j < NE; ++j) { const float l = lg[j]; if (l > bv) { bv = l; i3 = j; } } v3 = bv; lg[i3] = -3.4e38f; }
        const float e1 = __expf(v1 - v0), e2 = __expf(v2 - v0), e3 = __expf(v3 - v0), inv = 1.0f / (1.0f + e1 + e2 + e3);
        const int tok = tok0 + tid;
        *(int4*)(TOPI + tok * 4) = make_int4(i0, i1, i2, i3);
        *(f32x4*)(TOPG + tok * 4) = (f32x4){inv, e1 * inv, e2 * inv, e3 * inv};
        LAS int* hist = (LAS int*)(lds + RT_HIST);
        atomicAdd((int*)(hist + i0), 1); atomicAdd((int*)(hist + i1), 1); atomicAdd((int*)(hist + i2), 1); atomicAdd((int*)(hist + i3), 1);
    }
    __syncthreads();
}
__device__ __forceinline__ void combine_row(int tok, const float* __restrict__ X1, const u16* __restrict__ YB, const int* __restrict__ SOF, const float* __restrict__ TOPG, const float* __restrict__ gain, float* __restrict__ out, int lane) {
    const int4 sl = *(const int4*)(SOF + tok * 4); const f32x4 g = *(const f32x4*)(TOPG + tok * 4);
    const u16* y0 = YB + (size_t)sl.x * DM; const u16* y1 = YB + (size_t)sl.y * DM; const u16* y2 = YB + (size_t)sl.z * DM; const u16* y3 = YB + (size_t)sl.w * DM;
    f32x4 v[8]; float s = 0.f;
#pragma unroll
    for (int j = 0; j < 8; ++j) { const int d = (lane + 64 * j) * 4;
        f32x4 a = *(const f32x4*)(X1 + (size_t)tok * DM + d);
        const u32x2 q0 = *(const u32x2*)(y0 + d), q1 = *(const u32x2*)(y1 + d), q2 = *(const u32x2*)(y2 + d), q3 = *(const u32x2*)(y3 + d);
        a[0] += g[0] * bflo(q0[0]) + g[1] * bflo(q1[0]) + g[2] * bflo(q2[0]) + g[3] * bflo(q3[0]);
        a[1] += g[0] * bfhi(q0[0]) + g[1] * bfhi(q1[0]) + g[2] * bfhi(q2[0]) + g[3] * bfhi(q3[0]);
        a[2] += g[0] * bflo(q0[1]) + g[1] * bflo(q1[1]) + g[2] * bflo(q2[1]) + g[3] * bflo(q3[1]);
        a[3] += g[0] * bfhi(q0[1]) + g[1] * bfhi(q1[1]) + g[2] * bfhi(q2[1]) + g[3] * bfhi(q3[1]);
        v[j] = a; s += a[0] * a[0] + a[1] * a[1] + a[2] * a[2] + a[3] * a[3]; }
    s = wave_sum(s);
    const float r = rsqrtf(s * (1.0f / (float)DM) + EPS);
#pragma unroll
    for (int j = 0; j < 8; ++j) { const int d = (lane + 64 * j) * 4; const f32x4 gn = *(const f32x4*)(gain + d); *(f32x4*)(out + (size_t)tok * DM + d) = v[j] * r * gn; }
}

__device__ __forceinline__ void combine_row2(int tokA, int tokB, const float* __restrict__ X1, const u16* __restrict__ YB, const int* __restrict__ SOF, const float* __restrict__ TOPG, const float* __restrict__ gain, float* __restrict__ out, int lane) {
    const int4 slA = *(const int4*)(SOF + tokA * 4), slB = *(const int4*)(SOF + tokB * 4); const f32x4 gA = *(const f32x4*)(TOPG + tokA * 4), gB = *(const f32x4*)(TOPG + tokB * 4);
    const u16* yA0 = YB + (size_t)slA.x * DM; const u16* yA1 = YB + (size_t)slA.y * DM; const u16* yA2 = YB + (size_t)slA.z * DM; const u16* yA3 = YB + (size_t)slA.w * DM;
    const u16* yB0 = YB + (size_t)slB.x * DM; const u16* yB1 = YB + (size_t)slB.y * DM; const u16* yB2 = YB + (size_t)slB.z * DM; const u16* yB3 = YB + (size_t)slB.w * DM;
    f32x4 vA[8], vB[8]; float sA = 0.f, sB = 0.f;
#pragma unroll
    for (int j = 0; j < 8; ++j) { const int d = (lane + 64 * j) * 4;
        f32x4 a = *(const f32x4*)(X1 + (size_t)tokA * DM + d), b = *(const f32x4*)(X1 + (size_t)tokB * DM + d);
        const u32x2 p0 = *(const u32x2*)(yA0 + d), p1 = *(const u32x2*)(yA1 + d), p2 = *(const u32x2*)(yA2 + d), p3 = *(const u32x2*)(yA3 + d);
        const u32x2 q0 = *(const u32x2*)(yB0 + d), q1 = *(const u32x2*)(yB1 + d), q2 = *(const u32x2*)(yB2 + d), q3 = *(const u32x2*)(yB3 + d);
        a[0] += gA[0] * bflo(p0[0]) + gA[1] * bflo(p1[0]) + gA[2] * bflo(p2[0]) + gA[3] * bflo(p3[0]);
        a[1] += gA[0] * bfhi(p0[0]) + gA[1] * bfhi(p1[0]) + gA[2] * bfhi(p2[0]) + gA[3] * bfhi(p3[0]);
        a[2] += gA[0] * bflo(p0[1]) + gA[1] * bflo(p1[1]) + gA[2] * bflo(p2[1]) + gA[3] * bflo(p3[1]);
        a[3] += gA[0] * bfhi(p0[1]) + gA[1] * bfhi(p1[1]) + gA[2] * bfhi(p2[1]) + gA[3] * bfhi(p3[1]);
        b[0] += gB[0] * bflo(q0[0]) + gB[1] * bflo(q1[0]) + gB[2] * bflo(q2[0]) + gB[3] * bflo(q3[0]);
        b[1] += gB[0] * bfhi(q0[0]) + gB[1] * bfhi(q1[0]) + gB[2] * bfhi(q2[0]) + gB[3] * bfhi(q3[0]);
        b[2] += gB[0] * bflo(q0[1]) + gB[1] * bflo(q1[1]) + gB[2] * bflo(q2[1]) + gB[3] * bflo(q3[1]);
        b[3] += gB[0] * bfhi(q0[1]) + gB[1] * bfhi(q1[1]) + gB[2] * bfhi(q2[1]) + gB[3] * bfhi(q3[1]);
        vA[j] = a; vB[j] = b; sA += a[0] * a[0] + a[1] * a[1] + a[2] * a[2] + a[3] * a[3]; sB += b[0] * b[0] + b[1] * b[1] + b[2] * b[2] + b[3] * b[3]; }
    sA = wave_sum(sA); sB = wave_sum(sB);
    const float rA = rsqrtf(sA * (1.0f / (float)DM) + EPS), rB = rsqrtf(sB * (1.0f / (float)DM) + EPS);
#pragma unroll
    for (int j = 0; j < 8; ++j) { const int d = (lane + 64 * j) * 4; const f32x4 gn = *(const f32x4*)(gain + d);
        *(f32x4*)(out + (size_t)tokA * DM + d) = vA[j] * rA * gn; *(f32x4*)(out + (size_t)tokB * DM + d) = vB[j] * rB * gn; }
}
#ifndef REP_P9
#define REP_P9 1
#endif
#ifndef REP_P3
#define REP_P3 1
#endif
#ifndef REP_FR
#define REP_FR 1
#endif
#ifndef REP_P0
#define REP_P0 1
#endif
#ifndef REP_CONV
#define REP_CONV 1
#endif
#ifndef REP_GEMM1
#define REP_GEMM1 1
#endif
#ifndef REP_HY
#define REP_HY 1
#endif
#ifndef REP_HG
#define REP_HG 1
#endif
#ifndef REP_MOEA
#define REP_MOEA 1
#endif
#ifndef REP_MOEB
#define REP_MOEB 1
#endif
#ifndef REP_WOUT
#define REP_WOUT 1
#endif
struct MegaP {
    const float *x, *norm_mix_gain, *w_in, *lb_logits, *hgrn_norm_gain, *hy_conv_w, *hy_conv_b, *fw1, *fb1, *fw2, *fb2, *fw3, *fb3, *fw4, *ffreq, *hy_bias, *hy_norm_gain, *w_out,
        *norm_ffn_gain, *w_router, *b_router, *moe_w1, *moe_b1, *moe_w2, *moe_b2, *final_gain;
    float* out; unsigned char* ws;
};
constexpr int MEGA_XB = RT_END;
constexpr int MEGA_LDS = RT_END + 64 + 384;
static_assert(MEGA_LDS >= HY_LDS + 64 && MEGA_LDS >= HG_LDS + 64 && MEGA_LDS >= GEMM_LDS + 64, "LDS");

__global__ void __launch_bounds__(512, 2) k_mega(const MegaP p_arg) {
    extern __shared__ __attribute__((aligned(16))) unsigned char shm[];
    LAS unsigned char* lds = (LAS unsigned char*)shm;
    const int tid = threadIdx.x, wid = __builtin_amdgcn_readfirstlane(tid >> 6), lane = tid & 63;
    const int G = gridDim.x, bid = blockIdx.x, c = xcd_logical(bid, G);
#define PHASE_ARGS() const MegaP __attribute__((address_space(4)))* pq_ = (const MegaP __attribute__((address_space(4)))*)__builtin_amdgcn_kernarg_segment_ptr(); asm volatile("" : "+s"(pq_)); unsigned char* ws = pq_->ws; (void)ws
    unsigned char* ws0; { PHASE_ARGS(); ws0 = ws; }
#define counts ((int*)(ws + WS_CTL))
#define cursor ((int*)(ws + WS_CTL + 4096))
#define offs ((int*)(ws + WS_CTL + 8192))
#define barw ((unsigned*)(ws + WS_CTL + 16384))
#define HB ((u16*)(ws + WS_HB))
#define PG ((u16*)(ws + WS_PG))
#define HYT ((u16*)(ws + WS_HYT))
#define MIXB ((u16*)(ws + WS_MIXB))
#define XNB ((u16*)(ws + WS_XNB))
#define HMB ((u16*)(ws + WS_HMB))
#define YB ((u16*)(ws + WS_YB))
#define H3 ((float*)(ws + WS_H3))
#define FR ((u16*)(ws + WS_FR))
#define Z2T ((u16*)(ws + WS_Z2T))
#define OF ((float*)(ws + WS_OF))
#define OB ((float*)(ws + WS_OB))
#define X1 ((float*)(ws + WS_X1))
#define TOPI ((int*)(ws + WS_TOPI))
#define TOPG ((float*)(ws + WS_TOPG))
#define STOK ((int*)(ws + WS_STOK))
#define SOF ((int*)(ws + WS_SOF))
#define WINT ((u16*)(ws + WS_WINT))
#define WOUTT ((u16*)(ws + WS_WOUTT))
#define W1T ((u16*)(ws + WS_W1T))
#define W2T ((u16*)(ws + WS_W2T))
    if (tid == 0) *(LAS u32x4*)(lds + MEGA_XB) = (u32x4){0u, 0u, 0u, 0u};
    __syncthreads();
    XcdBarrier bar = xcd_barrier_post((unsigned*)(ws0 + WS_CTL + 16384), (volatile LAS unsigned*)(lds + MEGA_XB));

    {
        PHASE_ARGS();
    for (int rep = 0; rep < REP_P0; ++rep) {
    for (int row = bid * 8 + wid; row < NTOK; row += G * 8) rmsnorm_row_bf(pq_->x + (size_t)row * DM, pq_->norm_mix_gain, HB + (size_t)row * DM, lane);
    for (int m = bid * 8 + wid; m < SEQ; m += G * 8) h3_row(m, pq_->fw1, pq_->fb1, pq_->fw2, pq_->fb2, pq_->fw3, pq_->fb3, pq_->ffreq, (LAS float*)(lds + wid * 512), H3); }
    for (int rep = 0; rep < REP_CONV; ++rep)
    for (int id = bid; id < 1024 + 256; id += G) {
        const int tz = tid_fresh();
        if (id < 1024) { const int nt = id >> 5, kt = id & 31; convert_tile(pq_->w_in, DIN, kt * 64, ColMapPerm{nt * 256}, WINT + (size_t)id * 16384, tz); }
        else { const int q = id - 1024, nt = q >> 5, kt = q & 31; convert_tile(pq_->w_out, DM, kt * 64, ColMapPerm{nt * 256}, WOUTT + (size_t)q * 16384, tz); }
    }
    }
    xcd_barrier(bar);
    {
        PHASE_ARGS();
    for (int rep = 0; rep < REP_FR; ++rep)
    for (int item = bid; item < 256; item += G) frgen_item(lds, item, H3, pq_->fw4, FR);
    { SrcG1<false> s0{c, G, (const char*)HB, (const char*)WINT, PG, HYT}; gemm8_stream<false, false>(lds, DM, 32, s0);
      SrcG1<true> s1{c, G, (const char*)HB, (const char*)WINT, PG, HYT}; gemm8_stream<true, false>(lds, DM, 32, s1); }
#ifdef PROBE_NOEPI
    for (int u = c; u < 1024; u += G) {
        const int i = u >> 8, xx = (u >> 5) & 7, j = u & 31;
        const int mt = (xx & 3) * 8 + (j & 7), nt = ((xx >> 2) + 2 * i) * 4 + (j >> 3);
        const u16* bt = WINT + (size_t)nt * 32 * 16384;
        EpiNone e{}; if (nt < 20) gemm8_unit<false>(lds, HB, DM, nullptr, mt * 256, 256, bt, 32, e); else gemm8_unit<true>(lds, HB, DM, nullptr, mt * 256, 256, bt, 32, e);
    }
#endif
    }
    xcd_barrier(bar);
    {
        PHASE_ARGS();
    for (int rep = 0; rep < REP_HY; ++rep)
    for (int u = bid; u < 256; u += G) hyena_unit(lds, u, HYT, FR, pq_->hy_conv_w, pq_->hy_conv_b, pq_->hy_bias, Z2T, ConvCtx{pq_->moe_w1, pq_->moe_w2, (unsigned char*)W1T, (unsigned char*)W2T});
    for (int rep = 0; rep < REP_HG; ++rep)
    for (int u = bid; u < 256; u += G) hgrn_unit(lds, u, PG, pq_->lb_logits, OF, OB, ConvCtx{pq_->moe_w1, pq_->moe_w2, (unsigned char*)W1T, (unsigned char*)W2T});
    }
    xcd_barrier(bar);
    {
        PHASE_ARGS();
    for (int rep = 0; rep < REP_P3; ++rep) {
    for (int it = bid * 8 + wid; it < NTOK * HGH; it += G * 8 * 4) hgrn_final_item4(it, G * 8, OF, OB, PG, pq_->hgrn_norm_gain, MIXB, lane);
    for (int t = bid; t < NTOK / 32; t += G) hy_norm_tile(lds, t, Z2T, pq_->hy_norm_gain, MIXB); }
    }
    xcd_barrier(bar);
    {
        PHASE_ARGS();
    for (int u = c; u < 256; u += G) {
        const int xx = u >> 5, j = u & 31;
        const int mt = (xx >> 1) * 8 + (j & 7), nt = (xx & 1) * 4 + (j >> 3);
        Epi8X1 e{pq_->x, X1, mt * 256, nt * 256};
        gemm8_unit<false>(lds, MIXB, DM, nullptr, mt * 256, 256, WOUTT + (size_t)nt * 32 * 16384, 32, e);
    }
    }
    xcd_barrier(bar);
    {
        PHASE_ARGS();
    if (tid < NE) *(LAS int*)(lds + RT_HIST + tid * 4) = 0;
    __syncthreads();
    for (int t = bid; t < NTOK / 16; t += G) router_tile(lds, t, X1, pq_->norm_ffn_gain, pq_->w_router, pq_->b_router, (unsigned char*)XNB, TOPI, TOPG, counts);
    if (tid < NE) { const int hcount = *(const LAS int*)(lds + RT_HIST + tid * 4); if (hcount) atomicAdd(&counts[tid * 32], hcount); }
    }
    xcd_barrier(bar);
    {
        PHASE_ARGS();
    {
        LAS int* so = (LAS int*)lds;
        LAS int* lh = (LAS int*)(lds + 256);
        LAS int* lb2 = (LAS int*)(lds + 512);
        if (tid == 0) { int a = 0; for (int e = 0; e < NE; ++e) { so[e] = a; a += __hip_atomic_load(&counts[e * 32], __ATOMIC_RELAXED, __HIP_MEMORY_SCOPE_AGENT); } so[NE] = a; }
        if (tid < NE) lh[tid] = 0;
        __syncthreads();
        if (bid == 0 && tid <= NE) offs[tid] = so[tid];
        for (int i0 = bid * 512; i0 < NSLOT; i0 += G * 512) {
            const int i = i0 + tid; const int e = TOPI[i];
            const int lpos = atomicAdd((int*)(lh + e), 1);
            __syncthreads();
            if (tid < NE) { const int n = lh[tid]; lb2[tid] = so[tid] + (n ? atomicAdd(&cursor[tid * 32], n) : 0); }
            __syncthreads();
            const int slot = lb2[e] + lpos; STOK[slot] = i >> 2; SOF[i] = slot;
            __syncthreads();
            if (tid < NE) lh[tid] = 0;
            __syncthreads();
        }
    }
    }
    xcd_barrier(bar);
    {
        PHASE_ARGS();
    {
        LAS int* us = (LAS int*)(lds + MEGA_XB + 64); LAS int* so2 = us + 40;
        if (tid == 0) { int a = 0; for (int e = 0; e < NE; ++e) { us[e] = a; a += ((offs[e + 1] - offs[e] + 255) >> 8) * 16; } us[NE] = a; }
        if (tid <= NE) so2[tid] = offs[tid];
        __syncthreads();
    }
    {
        LAS int* qs = (LAS int*)(lds + MEGA_XB + 32); LAS int* us = (LAS int*)(lds + MEGA_XB + 64); LAS int* so2 = us + 40;
        int* qctr = (int*)(ws + WS_CTL + 12288 + (bid & 7) * 128);
        int tk_next = 0;
        if (tid == 0) tk_next = atomicAdd(qctr, 1);
        for (;;) {
            if (tid == 0) { qs[0] = tk_next; qs[1] = -1; }
            __syncthreads();
            const int tk = qs[0];
            const int u = 256 * (tk >> 5) + 32 * (bid & 7) + (tk & 31);
            if (tid < NE) { const int u0 = us[tid], u1 = us[tid + 1]; if (u >= u0 && u < u1) { const int o0 = so2[tid], cnt = so2[tid + 1] - o0, mtl = (cnt + 255) >> 8, ul = u - u0, mt = ul % mtl;
                int rows = cnt - mt * 256; rows = rows > 256 ? 256 : rows; qs[1] = tid; qs[2] = ul / mtl; qs[3] = o0 + mt * 256; qs[4] = rows; } }
            __syncthreads();
            const int e = qs[1], nt = qs[2], slot0 = qs[3], rows = qs[4];
            __syncthreads();
            if (e < 0) break;
            if (tid == 0) tk_next = atomicAdd(qctr, 1);
            Epi8Swiglu8 ep{(unsigned char*)HMB, pq_->moe_b1 + (size_t)e * 2 * DFF, slot0, nt, rows};
            gemm8_unit<false, true>(lds, XNB, DM / 2, STOK + slot0, 0, rows, W1T + (size_t)(e * 16 + nt) * 16 * 16384, 16, ep);
        }
    }
    }
    xcd_barrier(bar);
    {
        PHASE_ARGS();
    {
        LAS int* us = (LAS int*)(lds + MEGA_XB + 64); LAS int* so2 = us + 40;
        if (tid == 0) { int a = 0; for (int e = 0; e < NE; ++e) { us[e] = a; a += ((offs[e + 1] - offs[e] + 255) >> 8) * 8; } us[NE] = a; }
        if (tid <= NE) so2[tid] = offs[tid];
        __syncthreads();
    }
    {
        const LAS int* us = (const LAS int*)(lds + MEGA_XB + 64); const LAS int* so2 = us + 40;
        SrcMoeB src{us, so2, c, G, (const char*)HMB, (const char*)W2T, YB, pq_->moe_b2};
        gemm8_stream<false, true>(lds, DFF / 2, 16, src);
    }
    }
    xcd_barrier(bar);
    {
        PHASE_ARGS();
    for (int rep = 0; rep < REP_P9; ++rep)
    for (int tok = bid * 8 + wid; tok < NTOK; tok += G * 8) combine_row(tok, X1, YB, SOF, TOPG, pq_->final_gain, pq_->out, lane);
    }
}
#undef counts
#undef cursor
#undef offs
#undef barw
#undef HB
#undef PG
#undef HYT
#undef MIXB
#undef XNB
#undef HMB
#undef YB
#undef H3
#undef FR
#undef Z2T
#undef OF
#undef OB
#undef X1
#undef TOPI
#undef TOPG
#undef STOK
#undef SOF
#undef WINT
#undef WOUTT
#undef W1T
#undef W2T

extern "C" void kernel_launch(void* const* d_in, const int* in_sizes, int n_in, void* d_out, int out_size, void* d_ws, size_t ws_size, hipStream_t stream) {
    if (n_in < 26 || ws_size < WS_END2) return;
    MegaP p{};
    const float** pp = (const float**)&p;
    for (int i = 0; i < 26; ++i) pp[i] = (const float*)d_in[i];
    p.out = (float*)d_out; p.ws = (unsigned char*)d_ws;
    static int grid = 0;
    if (!grid) {
        int dev = 0, cus = 0, per_cu = 0;
        (void)hipGetDevice(&dev);
        (void)hipDeviceGetAttribute(&cus, hipDeviceAttributeMultiprocessorCount, dev);
        (void)hipFuncSetAttribute((const void*)k_mega, hipFuncAttributeMaxDynamicSharedMemorySize, MEGA_LDS);
        (void)hipOccupancyMaxActiveBlocksPerMultiprocessor(&per_cu, (const void*)k_mega, 512, MEGA_LDS);
        if (per_cu < 1) per_cu = 1;
        grid = cus * 1;
        if (grid > 256) grid = 256;
        grid &= ~7;
        if (grid < 8) grid = 8;
    }
    (void)hipMemsetAsync((char*)d_ws + WS_CTL, 0, 65536, stream);
    hipLaunchKernelGGL(k_mega, dim3(grid), dim3(512), MEGA_LDS, stream, p);
}
```

```cpp
#include <hip/hip_runtime.h>
#include <stdint.h>

constexpr int BATCH = 4, SEQ = 2048, DM = 2048, NTOK = BATCH * SEQ;
constexpr int HGW = 1024, HGD = 128, HGH = 8;
constexpr int HYW = 1024;
constexpr int DIN = 8192;
constexpr int NE = 32, TOPK = 4, DFF = 2048;
constexpr int NSLOT = NTOK * TOPK;
constexpr float EPS = 1e-5f;

constexpr size_t MB = 1024ull * 1024ull;
constexpr size_t WS_CTL = 0;
constexpr size_t WS_HB = 1 * MB;
constexpr size_t WS_PG = WS_HB + 32 * MB;
constexpr size_t WS_HYT = WS_PG + 80 * MB;
constexpr size_t WS_MIXB = WS_HYT + 48 * MB;
constexpr size_t WS_XNB = WS_MIXB + 32 * MB;
constexpr size_t WS_HMB = WS_XNB + 32 * MB;
constexpr size_t WS_YB = WS_HMB + 128 * MB;
constexpr size_t WS_H3 = WS_YB + 128 * MB;
constexpr size_t WS_FR = WS_H3 + 1 * MB;
constexpr size_t WS_Z2T = WS_FR + 34 * MB;
constexpr size_t WS_OF = WS_Z2T + 16 * MB;
constexpr size_t WS_OB = WS_OF + 32 * MB;
constexpr size_t WS_X1 = WS_OB + 32 * MB;
constexpr size_t WS_TOPI = WS_X1 + 64 * MB;
constexpr size_t WS_TOPG = WS_TOPI + 1 * MB;
constexpr size_t WS_STOK = WS_TOPG + 1 * MB;
constexpr size_t WS_SOF = WS_STOK + 1 * MB;
constexpr size_t WS_WINT = WS_SOF + 1 * MB;
constexpr size_t WS_WOUTT = WS_WINT + 32 * MB;
constexpr size_t WS_W1T = WS_WOUTT + 8 * MB;
constexpr size_t WS_W2T = WS_W1T + 512 * MB;
constexpr size_t WS_END2 = WS_W2T + 256 * MB;

typedef short bf16x8 __attribute__((ext_vector_type(8)));
typedef float f32x4 __attribute__((ext_vector_type(4)));
typedef float f32x2 __attribute__((ext_vector_type(2)));
typedef unsigned u32x4 __attribute__((ext_vector_type(4)));
typedef unsigned u32x2 __attribute__((ext_vector_type(2)));
typedef unsigned short u16;
#define LAS __attribute__((address_space(3)))

__device__ __forceinline__ unsigned pk_bf16(float lo, float hi) {
    typedef __bf16 bf2 __attribute__((ext_vector_type(2)));
    const f32x2 v = {lo, hi};
    const bf2 r = __builtin_convertvector(v, bf2);
    return __builtin_bit_cast(unsigned, r);
}
__device__ __forceinline__ float bf2f(u16 b) { return __uint_as_float(((unsigned)b) << 16); }
__device__ __forceinline__ float bflo(unsigned w) { return __uint_as_float(w << 16); }
__device__ __forceinline__ float bfhi(unsigned w) { return __uint_as_float(w & 0xffff0000u); }

__device__ __forceinline__ int lds_byte(int r, int c) { const int st = (r >> 4) * 2 + (c >> 5), ob = (r & 15) * 64 + (c & 31) * 2; return st * 1024 + (ob ^ (((ob >> 9) & 1) << 5)); }
__device__ __forceinline__ void stage_rc(int b, int& R, int& C) { const int st = b >> 10, sb = b & 1023, swz = sb ^ (((sb >> 9) & 1) << 5); R = (st >> 1) * 16 + swz / 64; C = (st & 1) * 32 + (swz % 64) / 2; }
__device__ __forceinline__ f32x4 unperm(const f32x4 a, const bool s) { f32x4 o; o[0] = s ? a[1] : a[0]; o[1] = s ? a[0] : a[1]; o[2] = s ? a[3] : a[2]; o[3] = s ? a[2] : a[3]; return o; }

__device__ __forceinline__ int tid_fresh() { int t = threadIdx.x; asm volatile("" : "+v"(t)); return t; }
constexpr int GEMM_LDS = 131072;

template <bool TRANS, bool RAGGED, int PM = 0, class ColMap, class Epi>
__device__ __forceinline__ void gemm_unit(LAS unsigned char* lds, const u16* __restrict__ A, int lda, const int* __restrict__ arows, int arow0, int rows_valid,
                                          const float* __restrict__ B, int ldb, int K, const ColMap colmap, const Epi epi) {
    const int tid = tid_fresh(), wid = __builtin_amdgcn_readfirstlane(tid >> 6), lane = tid & 63;
    const int wr = wid >> 2, wc = wid & 3, fr = lane & 15, fq = lane >> 4;
    const int nt = K >> 6;
    const char* ap[4];
#pragma unroll
    for (int i = 0; i < 4; ++i) {
        int R, C; stage_rc(wid * 1024 + i * 8192 + lane * 16, R, C);
        const int rr = RAGGED ? (R < rows_valid ? R : rows_valid - 1) : R;
        const long rowid = arows ? (long)arows[rr] : (long)(arow0 + rr);
        ap[i] = (const char*)A + ((size_t)rowid * lda + C) * 2;
    }
    const int g = (lane & 3) + 4 * (wid >> 2), rg = (wid & 3) * 16 + (lane >> 2);
    const unsigned bvoff = (unsigned)(((size_t)(8 * g) * ldb + colmap(rg)) * 4);
    const int bbase = 65536 + lds_byte(4 * rg, 8 * g);
    const int bw0 = bbase + ((rg & 1) ? 64 : 0), bw1 = bbase + ((rg & 1) ? 0 : 64);
    const int aoff = lds_byte(wr * 128 + fr, fq * 8), boff = 65536 + lds_byte(wc * 64 + fr, fq * 8);
    int mvalid = 8;
    if (RAGGED) { mvalid = (rows_valid - wr * 128 + 15) >> 4; mvalid = mvalid < 0 ? 0 : (mvalid > 8 ? 8 : mvalid); }
    f32x4 vb0, vb1, vb2, vb3, vb4, vb5, vb6, vb7;
    if (PM & 1) { vb0 = (f32x4){1.f, 1.f, 1.f, 1.f}; vb1 = vb0; vb2 = vb0; vb3 = vb0; vb4 = vb0; vb5 = vb0; vb6 = vb0; vb7 = vb0; }
    f32x4 acc[8][4];
#pragma unroll
    for (int m = 0; m < 8; ++m)
#pragma unroll
        for (int n = 0; n < 4; ++n) acc[m][n] = (f32x4){0.f, 0.f, 0.f, 0.f};
    const size_t ldb4 = (size_t)ldb * 4;
#define GE_GLDS_A(buf, kt) do { if (!(PM & 2)) _Pragma("unroll") for (int _i = 0; _i < 4; ++_i) \
        __builtin_amdgcn_global_load_lds((const unsigned*)(ap[_i] + (size_t)(kt) * 128), (LAS unsigned*)(lds + (buf) * 32768 + wid * 1024 + _i * 8192), 16, 0, 0); } while (0)
#define GE_LD1(dst, sb) if (!(PM & 1)) asm volatile("global_load_dwordx4 %0, %1, %2" : "=v"(dst) : "v"(bvoff), "s"(sb) : "memory")
#define GE_LOAD_B(kt) do { const char* _sb = (const char*)B + (size_t)(kt) * 64 * ldb4; \
        GE_LD1(vb0, _sb); GE_LD1(vb1, _sb + ldb4); GE_LD1(vb2, _sb + 2 * ldb4); GE_LD1(vb3, _sb + 3 * ldb4); \
        GE_LD1(vb4, _sb + 4 * ldb4); GE_LD1(vb5, _sb + 5 * ldb4); GE_LD1(vb6, _sb + 6 * ldb4); GE_LD1(vb7, _sb + 7 * ldb4); } while (0)
#define GE_WAITV_B(n) asm volatile("s_waitcnt vmcnt(" #n ")" : "+v"(vb0), "+v"(vb1), "+v"(vb2), "+v"(vb3), "+v"(vb4), "+v"(vb5), "+v"(vb6), "+v"(vb7) :: "memory")
#define GE_WRITE_B(buf) do { _Pragma("unroll") for (int _i = 0; _i < 4; ++_i) { u32x4 _w; _w[0] = pk_bf16(vb0[_i], vb1[_i]); _w[1] = pk_bf16(vb2[_i], vb3[_i]); \
        _w[2] = pk_bf16(vb4[_i], vb5[_i]); _w[3] = pk_bf16(vb6[_i], vb7[_i]); \
        *(LAS u32x4*)(lds + ((_i & 1) ? bw1 : bw0) + (_i >> 1) * 128 + (buf) * 32768) = _w; } } while (0)
#define GE_KSTEP(buf, ks) do { bf16x8 Bf[4]; \
        _Pragma("unroll") for (int n = 0; n < 4; ++n) Bf[n] = *(const LAS bf16x8*)(lds + (buf) * 32768 + boff + n * 2048 + (ks) * 1024); \
        _Pragma("unroll") for (int mh = 0; mh < 2; ++mh) { bf16x8 At[4]; \
            _Pragma("unroll") for (int m = 0; m < 4; ++m) At[m] = *(const LAS bf16x8*)(lds + (buf) * 32768 + aoff + (mh * 4 + m) * 2048 + (ks) * 1024); \
            _Pragma("unroll") for (int m = 0; m < 4; ++m) { if (!RAGGED || (mh * 4 + m) < mvalid) { _Pragma("unroll") for (int n = 0; n < 4; ++n) \
                { if (PM & 4) { asm volatile("" :: "v"(At[m]), "v"(Bf[n])); } else acc[mh * 4 + m][n] = TRANS ? __builtin_amdgcn_mfma_f32_16x16x32_bf16(At[m], Bf[n], acc[mh * 4 + m][n], 0, 0, 0) : __builtin_amdgcn_mfma_f32_16x16x32_bf16(Bf[n], At[m], acc[mh * 4 + m][n], 0, 0, 0); } } } } } while (0)
    GE_GLDS_A(0, 0);
    GE_LOAD_B(0);
    GE_WAITV_B(0);
    GE_WRITE_B(0);
    GE_LOAD_B(1);
    asm volatile("s_waitcnt lgkmcnt(0)" ::: "memory");
    __builtin_amdgcn_s_barrier();
    int t = 0;
    for (; t < nt - 2; ++t) {
        const int cur = t & 1;
        GE_GLDS_A(cur ^ 1, t + 1);
        GE_KSTEP(cur, 0);
        GE_WAITV_B(4);
        GE_WRITE_B(cur ^ 1);
        GE_LOAD_B(t + 2);
        __builtin_amdgcn_sched_barrier(0);
        GE_KSTEP(cur, 1);
        asm volatile("s_waitcnt vmcnt(8) lgkmcnt(0)" ::: "memory");
        __builtin_amdgcn_s_barrier();
    }
    {
        const int cur = t & 1;
        GE_GLDS_A(cur ^ 1, t + 1);
        GE_KSTEP(cur, 0);
        GE_WAITV_B(4);
        GE_WRITE_B(cur ^ 1);
        GE_KSTEP(cur, 1);
        asm volatile("s_waitcnt vmcnt(0) lgkmcnt(0)" ::: "memory");
        __builtin_amdgcn_s_barrier();
        ++t;
    }
    {
        const int cur = t & 1;
        GE_KSTEP(cur, 0);
        GE_KSTEP(cur, 1);
        asm volatile("s_waitcnt lgkmcnt(0)" ::: "memory");
        __builtin_amdgcn_s_barrier();
    }
#undef GE_GLDS_A
#undef GE_LD1
#undef GE_LOAD_B
#undef GE_WAITV_B
#undef GE_WRITE_B
#undef GE_KSTEP
    __builtin_amdgcn_sched_barrier(0);
    { const int tz = tid_fresh(), wz = __builtin_amdgcn_readfirstlane(tz >> 6), lz = tz & 63;
      epi(acc, wz >> 2, wz & 3, lz & 15, lz >> 4); }
}

__device__ __forceinline__ int xcd_logical(int b, int G) { return (G & 7) ? b : (b & 7) * (G >> 3) + (b >> 3); }

struct ColMapDense { int c0; __device__ __forceinline__ int operator()(int rg) const { return c0 + 4 * rg; } };
struct EpiPG { u16* PG; int tok0, col0;
    __device__ __forceinline__ void operator()(const f32x4 (&acc)[8][4], int wr, int wc, int fr, int fq) const {
#pragma unroll
        for (int m = 0; m < 8; ++m) { u16* rowp = PG + (size_t)(tok0 + wr * 128 + m * 16 + fr) * 5120 + col0 + wc * 64 + 4 * fq;
#pragma unroll
            for (int n = 0; n < 4; ++n) { const f32x4 v = unperm(acc[m][n], fq & 1); u32x2 w; w[0] = pk_bf16(v[0], v[1]); w[1] = pk_bf16(v[2], v[3]); *(u32x2*)(rowp + n * 16) = w; } }
    } };
struct EpiHYT { u16* HYT; int tok0, col0;
    __device__ __forceinline__ void operator()(const f32x4 (&acc)[8][4], int wr, int wc, int fr, int fq) const {
#pragma unroll
        for (int n = 0; n < 4; ++n) { const int rho = wc * 64 + n * 16 + fr; const int col = col0 + (rho & ~3) + ((rho & 3) ^ ((rho >> 2) & 1));
            u16* colp = HYT + (size_t)col * NTOK + tok0 + wr * 128 + 4 * fq;
#pragma unroll
            for (int m = 0; m < 8; ++m) { const f32x4 v = acc[m][n]; u32x2 w; w[0] = pk_bf16(v[0], v[1]); w[1] = pk_bf16(v[2], v[3]); *(u32x2*)(colp + m * 16) = w; } }
    } };
struct EpiX1 { const float* x; float* X1; int tok0, col0;
    __device__ __forceinline__ void operator()(const f32x4 (&acc)[8][4], int wr, int wc, int fr, int fq) const {
#pragma unroll
        for (int m = 0; m < 8; ++m) { const size_t off = (size_t)(tok0 + wr * 128 + m * 16 + fr) * DM + col0 + wc * 64 + 4 * fq;
#pragma unroll
            for (int n = 0; n < 4; ++n) { const f32x4 r = *(const f32x4*)(x + off + n * 16); *(f32x4*)(X1 + off + n * 16) = r + unperm(acc[m][n], fq & 1); }
            asm volatile("" ::: "memory"); }
    } };
struct ColMapGlu { int nt; __device__ __forceinline__ int operator()(int rg) const { const int wcq = rg >> 4, n = (rg >> 2) & 3, f = rg & 3; return (n >> 1) * 2048 + nt * 128 + wcq * 32 + (n & 1) * 16 + f * 4; } };
struct EpiSwiglu { u16* HM; const float* b1; int slot0, nt, rows_valid;
    __device__ __forceinline__ void operator()(const f32x4 (&acc)[8][4], int wr, int wc, int fr, int fq) const {
        f32x4 bg[2], bl[2];
#pragma unroll
        for (int nn = 0; nn < 2; ++nn) { const int col = nt * 128 + wc * 32 + nn * 16 + 4 * fq; bg[nn] = *(const f32x4*)(b1 + col); bl[nn] = *(const f32x4*)(b1 + 2048 + col); }
#pragma unroll
        for (int m = 0; m < 8; ++m) { const int row = wr * 128 + m * 16 + fr;
            if (row < rows_valid) {
#pragma unroll
                for (int nn = 0; nn < 2; ++nn) { const f32x4 gl = unperm(acc[m][nn], fq & 1) + bg[nn], li = unperm(acc[m][nn + 2], fq & 1) + bl[nn]; float o[4];
#pragma unroll
                    for (int j = 0; j < 4; ++j) { const float gq = fminf(gl[j], 7.0f), lq = fminf(fmaxf(li[j], -7.0f), 7.0f); o[j] = gq * (1.0f / (1.0f + __expf(-1.702f * gq))) * (lq + 1.0f); }
                    u32x2 w; w[0] = pk_bf16(o[0], o[1]); w[1] = pk_bf16(o[2], o[3]);
                    *(u32x2*)(HM + (size_t)(slot0 + row) * DFF + nt * 128 + wc * 32 + nn * 16 + 4 * fq) = w; } } }
    } };
struct EpiY { u16* Y; const float* b2; int slot0, col0, rows_valid;
    __device__ __forceinline__ void operator()(const f32x4 (&acc)[8][4], int wr, int wc, int fr, int fq) const {
        f32x4 bv[4];
#pragma unroll
        for (int n = 0; n < 4; ++n) bv[n] = *(const f32x4*)(b2 + col0 + wc * 64 + n * 16 + 4 * fq);
#pragma unroll
        for (int m = 0; m < 8; ++m) { const int row = wr * 128 + m * 16 + fr;
            if (row < rows_valid) { u16* rowp = Y + (size_t)(slot0 + row) * DM + col0 + wc * 64 + 4 * fq;
#pragma unroll
                for (int n = 0; n < 4; ++n) { const f32x4 v = unperm(acc[m][n], fq & 1) + bv[n]; u32x2 w; w[0] = pk_bf16(v[0], v[1]); w[1] = pk_bf16(v[2], v[3]); *(u32x2*)(rowp + n * 16) = w; } } }
    } };
template <int NTILES>
__device__ __forceinline__ bool moe_decode(const int* __restrict__ offs, int u, int& e, int& mt, int& nt, int& slot0, int& rows) {
    int base = 0;
    for (int q = 0; q < NE; ++q) { const int o0 = offs[q], cnt = offs[q + 1] - o0, mtl = (cnt + 255) >> 8, nu = mtl * NTILES;
        if (u < base + nu) { const int ul = u - base; e = q; mt = ul % mtl; nt = ul / mtl; slot0 = o0 + mt * 256; rows = cnt - mt * 256; if (rows > 256) rows = 256; return true; }
        base += nu; }
    return false;
}


__device__ __forceinline__ int perm_col4(int rg) { const int rgl = rg & 31, t = rgl & 7; return 32 * (rgl >> 3) + 8 * (t & 3) + 4 * (t >> 2); }
__device__ __forceinline__ int perm32(int rho) { const int n = rho >> 4, i = rho & 15; return 8 * (i >> 2) + 4 * n + (i & 3); }
template <class ColMap>
__device__ __forceinline__ void convert_tile(const float* __restrict__ W, int ldb, int k0, const ColMap colmap, u16* __restrict__ dst, int tid) {
    const int wid = tid >> 6, lane = tid & 63;
    const int g = (lane & 3) + 4 * (wid >> 2), rg = (wid & 3) * 16 + (lane >> 2);
    const float* bp = W + (size_t)(k0 + 8 * g) * ldb + colmap(rg);
    f32x4 v[8];
#pragma unroll
    for (int kk = 0; kk < 8; ++kk) v[kk] = __builtin_nontemporal_load((const f32x4*)(bp + (size_t)kk * ldb));
    const int h = rg >> 5, r0 = (4 * rg) & 127;
    unsigned char* base = (unsigned char*)dst + h * 16384 + lds_byte(r0, 8 * g);
#pragma unroll
    for (int i = 0; i < 4; ++i) { u32x4 w; w[0] = pk_bf16(v[0][i], v[1][i]); w[1] = pk_bf16(v[2][i], v[3][i]); w[2] = pk_bf16(v[4][i], v[5][i]); w[3] = pk_bf16(v[6][i], v[7][i]);
        *(u32x4*)(base + i * 64) = w; }
}
typedef int i32x8 __attribute__((ext_vector_type(8)));
typedef int i32x4 __attribute__((ext_vector_type(4)));
constexpr float W8_SCALE = 32.0f;
constexpr int W8_MX = 0x7A7A7A7A;
constexpr int A8_MX = 0x7F7F7F7F;
__device__ __forceinline__ unsigned pk_fp8x4(float a, float b, float c, float d) { int p = __builtin_amdgcn_cvt_pk_fp8_f32(a, b, 0, false); p = __builtin_amdgcn_cvt_pk_fp8_f32(c, d, p, true); return (unsigned)p; }
__device__ __forceinline__ int lds_byte_b(int r, int cb) { const int st = (r >> 4) * 2 + (cb >> 6), ob = (r & 15) * 64 + (cb & 63); return st * 1024 + (ob ^ (((ob >> 9) & 1) << 5)); }
struct ConvCtx { const float* w1; const float* w2; unsigned char* W1T; unsigned char* W2T; };
__device__ __forceinline__ int conv_seq2tile(int s) {
    if (s < 16384) return (s >> 9) * 512 + (s & 15) * 32 + ((s >> 4) & 31);
    const int q = s - 16384; return 16384 + (q >> 8) * 256 + (q & 7) * 32 + ((q >> 3) & 31);
}
__device__ __forceinline__ void conv_issue(const ConvCtx& cc, int m, int wid, int lane, f32x2 (&v)[16]) {
    const int rp = 16 * wid + (lane & 15), rg = rp >> 1, p2 = (rp & 1) * 2, kg = lane >> 4;
    const float* bp; size_t ld;
    if (m < 16384) { const int e = m >> 9, nt = (m >> 5) & 15, kt = m & 31; ld = 2 * DFF; bp = cc.w1 + (size_t)e * DM * 2 * DFF + (size_t)(kt * 64 + 16 * kg) * ld + (rg >> 5) * 2048 + nt * 128 + perm_col4(rg) + p2; }
    else { const int q = m - 16384, e = q >> 8, nt = (q >> 5) & 7, kt = q & 31; ld = DM; bp = cc.w2 + (size_t)e * DFF * DM + (size_t)(kt * 64 + 16 * kg) * ld + nt * 256 + (rg >> 5) * 128 + perm_col4(rg) + p2; }
#pragma unroll
    for (int kk = 0; kk < 16; ++kk) v[kk] = __builtin_nontemporal_load((const f32x2*)(bp + (size_t)kk * ld));
}
__device__ __forceinline__ void conv_finish(const ConvCtx& cc, int m, int wid, int lane, const f32x2 (&v)[16]) {
    const int rp = 16 * wid + (lane & 15), kg = lane >> 4;
    const int kt64 = m & 31;
    unsigned char* dst = (m < 16384) ? cc.W1T + ((size_t)(m >> 5) * 16 + (kt64 >> 1)) * 32768 : cc.W2T + ((size_t)((m - 16384) >> 5) * 16 + (kt64 >> 1)) * 32768;
    unsigned char* base = dst + (rp >> 6) * 16384 + lds_byte_b((2 * rp) & 127, (kt64 & 1) * 64 + 16 * kg);
#pragma unroll
    for (int i = 0; i < 2; ++i) { u32x4 w;
#pragma unroll
        for (int q = 0; q < 4; ++q) w[q] = pk_fp8x4(v[4 * q][i] * W8_SCALE, v[4 * q + 1][i] * W8_SCALE, v[4 * q + 2][i] * W8_SCALE, v[4 * q + 3][i] * W8_SCALE);
        __builtin_nontemporal_store(w, (u32x4*)(base + i * 64)); }
}
struct ColMapGluT { int nt; __device__ __forceinline__ int operator()(int rg) const { return (rg >> 5) * 2048 + nt * 128 + perm_col4(rg); } };
struct ColMapPerm { int c0; __device__ __forceinline__ int operator()(int rg) const { return c0 + (rg >> 5) * 128 + perm_col4(rg); } };

template <bool TRANS, bool FP8 = false, class Epi>
__device__ __forceinline__ void gemm8_unit(LAS unsigned char* lds, const u16* __restrict__ A, int lda, const int* __restrict__ arows, int arow0, int rows_valid, const u16* __restrict__ Bt, int nt, const Epi epi) {
    const int tid = tid_fresh(), wid = __builtin_amdgcn_readfirstlane(tid >> 6), lane = tid & 63;
    const int wr = wid >> 2, wc = wid & 3, fr = lane & 15, fq = lane >> 4;
    unsigned aof[2][2];
#pragma unroll
    for (int h = 0; h < 2; ++h)
#pragma unroll
        for (int i = 0; i < 2; ++i) { int R, C; stage_rc(tid * 16 + i * 8192, R, C); int rr = h * 128 + R; rr = rr < rows_valid ? rr : rows_valid - 1;
            const unsigned rowid = arows ? (unsigned)arows[rr] : (unsigned)(arow0 + rr); aof[h][i] = (rowid * (unsigned)lda + (unsigned)C) * 2u; }
    const char* Ab = (const char*)A; const char* Bb = (const char*)Bt + tid * 16;
    const bool hi = rows_valid > 128;
    int mxw = W8_MX, mxa = A8_MX; asm volatile("" : "+v"(mxw), "+v"(mxa));
#define G8_SA(b, h) (((b) * 2 + (h)) * 16384)
#define G8_SB(b, h) (65536 + ((b) * 2 + (h)) * 16384)
#define G8_STA(b, h, kt) do { _Pragma("unroll") for (int _i = 0; _i < 2; ++_i) \
        __builtin_amdgcn_global_load_lds((const unsigned*)(Ab + aof[h][_i] + (size_t)(kt) * 128), (LAS unsigned*)(lds + G8_SA(b, h) + wid * 1024 + _i * 8192), 16, 0, 0); } while (0)
#define G8_STB(b, h, kt) do { _Pragma("unroll") for (int _i = 0; _i < 2; ++_i) \
        __builtin_amdgcn_global_load_lds((const unsigned*)(Bb + (size_t)(kt) * 32768 + (h) * 16384 + _i * 8192), (LAS unsigned*)(lds + G8_SB(b, h) + wid * 1024 + _i * 8192), 16, 0, 0); } while (0)
#define G8_LDA(dst, b, h) do { _Pragma("unroll") for (int m = 0; m < 4; ++m) _Pragma("unroll") for (int k = 0; k < 2; ++k) dst[m][k] = *(const LAS bf16x8*)(lds + G8_SA(b, h) + aoff + m * 2048 + k * 1024); } while (0)
#define G8_LDB(dst, b, h) do { _Pragma("unroll") for (int n = 0; n < 2; ++n) _Pragma("unroll") for (int k = 0; k < 2; ++k) dst[n][k] = *(const LAS bf16x8*)(lds + G8_SB(b, h) + boff + n * 2048 + k * 1024); } while (0)
#define G8_MMA(ai, bj, At, Bq) do { if ((ai) == 0 || hi) { __builtin_amdgcn_s_setprio(1); _Pragma("unroll") for (int m = 0; m < 4; ++m) _Pragma("unroll") for (int n = 0; n < 2; ++n) { \
        if (FP8) { const i32x4 a0 = __builtin_bit_cast(i32x4, At[m][0]), a1 = __builtin_bit_cast(i32x4, At[m][1]), b0 = __builtin_bit_cast(i32x4, Bq[n][0]), b1 = __builtin_bit_cast(i32x4, Bq[n][1]); \
            const i32x8 a8 = __builtin_shufflevector(a0, a1, 0, 1, 2, 3, 4, 5, 6, 7), b8 = __builtin_shufflevector(b0, b1, 0, 1, 2, 3, 4, 5, 6, 7); \
            asm volatile("v_mfma_scale_f32_16x16x128_f8f6f4 %0, %1, %2, %0, %3, %4 op_sel_hi:[0,0,0]" : "+v"(acc[ai][bj][m][n]) : "v"(b8), "v"(a8), "v"(mxw), "v"(mxa)); } \
        else { _Pragma("unroll") for (int k = 0; k < 2; ++k) \
            acc[ai][bj][m][n] = TRANS ? __builtin_amdgcn_mfma_f32_16x16x32_bf16(At[m][k], Bq[n][k], acc[ai][bj][m][n], 0, 0, 0) : __builtin_amdgcn_mfma_f32_16x16x32_bf16(Bq[n][k], At[m][k], acc[ai][bj][m][n], 0, 0, 0); } } \
        __builtin_amdgcn_s_setprio(0); } } while (0)
#define G8_WV(n) asm volatile("s_waitcnt vmcnt(" #n ")" ::: "memory")
#define G8_WL(n) asm volatile("s_waitcnt lgkmcnt(" #n ")" ::: "memory")
#define G8_BAR __builtin_amdgcn_s_barrier()
#define G8_SCHED __builtin_amdgcn_sched_barrier(0)
    const int aoff = lds_byte(wr * 64 + fr, fq * 8), boff = lds_byte(wc * 32 + fr, fq * 8);
    f32x4 acc[2][2][4][2];
#pragma unroll
    for (int a = 0; a < 2; ++a)
#pragma unroll
        for (int b = 0; b < 2; ++b)
#pragma unroll
            for (int m = 0; m < 4; ++m)
#pragma unroll
                for (int n = 0; n < 2; ++n) acc[a][b][m][n] = (f32x4){0.f, 0.f, 0.f, 0.f};
    bf16x8 At[4][2], B0[2][2], B1[2][2];
    G8_STB(0, 0, 0); G8_STA(0, 0, 0); G8_STB(0, 1, 0); G8_STA(0, 1, 0);
    if (wr == 1) G8_BAR;
    G8_WV(4); G8_BAR;
    G8_STB(1, 0, 1); G8_STA(1, 0, 1); G8_STB(1, 1, 1);
    G8_WV(6); G8_BAR;
    for (int t = 0; t < nt - 2; t += 2) {
        G8_LDB(B0, 0, 0); G8_SCHED; G8_LDA(At, 0, 0); G8_STA(1, 1, t + 1);
        G8_WL(8); G8_BAR; G8_WL(0); G8_MMA(0, 0, At, B0); G8_BAR; G8_SCHED;
        G8_LDB(B1, 0, 1); G8_STB(0, 0, t + 2);
        G8_BAR; G8_WL(0); G8_MMA(0, 1, At, B1); G8_BAR;
        G8_LDA(At, 0, 1); G8_STA(0, 0, t + 2);
        G8_BAR; G8_WL(0); G8_MMA(1, 0, At, B0); G8_BAR; G8_SCHED;
        G8_STB(0, 1, t + 2);
        G8_WV(6); G8_BAR; G8_MMA(1, 1, At, B1); G8_BAR;
        G8_LDB(B0, 1, 0); G8_SCHED; G8_LDA(At, 1, 0); G8_STA(0, 1, t + 2);
        G8_WL(8); G8_BAR; G8_WL(0); G8_MMA(0, 0, At, B0); G8_BAR; G8_SCHED;
        G8_LDB(B1, 1, 1); G8_STB(1, 0, t + 3);
        G8_BAR; G8_WL(0); G8_MMA(0, 1, At, B1); G8_BAR;
        G8_LDA(At, 1, 1); G8_STA(1, 0, t + 3);
        G8_BAR; G8_WL(0); G8_MMA(1, 0, At, B0); G8_BAR; G8_SCHED;
        G8_STB(1, 1, t + 3);
        G8_WV(6); G8_BAR; G8_MMA(1, 1, At, B1); G8_BAR;
    }
    { G8_LDB(B0, 0, 0); G8_WV(0); G8_LDA(At, 0, 0); G8_STA(1, 1, nt - 1);
      G8_BAR; G8_WL(0); G8_MMA(0, 0, At, B0); G8_BAR;
      G8_LDB(B1, 0, 1); G8_BAR; G8_WL(0); G8_MMA(0, 1, At, B1); G8_BAR;
      G8_LDA(At, 0, 1); G8_WV(4); G8_BAR; G8_WL(0); G8_MMA(1, 0, At, B0); G8_MMA(1, 1, At, B1); G8_BAR; }
    { G8_LDB(B0, 1, 0); G8_LDA(At, 1, 0); G8_WV(2); G8_BAR; G8_WL(0); G8_MMA(0, 0, At, B0); G8_BAR;
      G8_LDB(B1, 1, 1); G8_WV(0); G8_BAR; G8_WL(0); G8_MMA(0, 1, At, B1); G8_BAR;
      G8_LDA(At, 1, 1); G8_BAR; G8_WL(0); G8_MMA(1, 0, At, B0); G8_MMA(1, 1, At, B1); G8_BAR; }
    if (wr == 0) G8_BAR;
#undef G8_SA
#undef G8_SB
#undef G8_STA
#undef G8_STB
#undef G8_LDA
#undef G8_LDB
#undef G8_MMA
#undef G8_WV
#undef G8_WL
#undef G8_BAR
#undef G8_SCHED
    __builtin_amdgcn_sched_barrier(0);
    { const int tz = tid_fresh(), wz = __builtin_amdgcn_readfirstlane(tz >> 6), lz = tz & 63;
      epi(acc, wz >> 2, wz & 3, lz & 15, lz >> 4); }
}
struct StreamUnit { const char* A; const char* Bt; int arow0, rows, a, b, c; };
template <bool TRANS, bool FP8, class Src>
__device__ __forceinline__ void gemm8_stream(LAS unsigned char* lds, unsigned lda, int nt, const Src& src) {
    const int tid = tid_fresh(), wid = __builtin_amdgcn_readfirstlane(tid >> 6), lane = tid & 63;
    const int wr = wid >> 2, wc = wid & 3, fr = lane & 15, fq = lane >> 4;
    StreamUnit cur, nxt;
    if (!src.get(0, cur)) return;
    int R0, C0, R1, C1; stage_rc(tid * 16, R0, C0); stage_rc(tid * 16 + 8192, R1, C1);
    int mxw = W8_MX, mxa = A8_MX; asm volatile("" : "+v"(mxw), "+v"(mxa));
    const int aoff = lds_byte(wr * 64 + fr, fq * 8), boff = lds_byte(wc * 32 + fr, fq * 8);
#define GS_AOF(u, h, R, C) ((unsigned)(((unsigned)((u).arow0 + (((h) * 128 + (R)) < (u).rows ? ((h) * 128 + (R)) : (u).rows - 1)) * lda + (unsigned)(C)) * 2u))
    unsigned ac00 = GS_AOF(cur, 0, R0, C0), ac01 = GS_AOF(cur, 0, R1, C1), ac10 = GS_AOF(cur, 1, R0, C0), ac11 = GS_AOF(cur, 1, R1, C1);
#define GS_SA(b, h) (((b) * 2 + (h)) * 16384)
#define GS_SB(b, h) (65536 + ((b) * 2 + (h)) * 16384)
#define GS_GL(src_, dst_) __builtin_amdgcn_global_load_lds((const unsigned*)(src_), (LAS unsigned*)(lds + (dst_)), 16, 0, 0)
#define GS_STA(b, h, base, o0, o1, kt) do { GS_GL((base) + (o0) + (size_t)(kt) * 128, GS_SA(b, h) + wid * 1024); GS_GL((base) + (o1) + (size_t)(kt) * 128, GS_SA(b, h) + wid * 1024 + 8192); } while (0)
#define GS_STB(b, h, base, kt) do { GS_GL((base) + tid * 16 + (size_t)(kt) * 32768 + (h) * 16384, GS_SB(b, h) + wid * 1024); GS_GL((base) + tid * 16 + (size_t)(kt) * 32768 + (h) * 16384 + 8192, GS_SB(b, h) + wid * 1024 + 8192); } while (0)
#define GS_LDA(dst, b, h) do { _Pragma("unroll") for (int m = 0; m < 4; ++m) _Pragma("unroll") for (int k = 0; k < 2; ++k) dst[m][k] = *(const LAS bf16x8*)(lds + GS_SA(b, h) + aoff + m * 2048 + k * 1024); } while (0)
#define GS_LDB(dst, b, h) do { _Pragma("unroll") for (int n = 0; n < 2; ++n) _Pragma("unroll") for (int k = 0; k < 2; ++k) dst[n][k] = *(const LAS bf16x8*)(lds + GS_SB(b, h) + boff + n * 2048 + k * 1024); } while (0)
#define GS_MMA(ai, bj, At, Bq) do { if ((ai) == 0 || hi) { __builtin_amdgcn_s_setprio(1); _Pragma("unroll") for (int m = 0; m < 4; ++m) _Pragma("unroll") for (int n = 0; n < 2; ++n) { \
        if (FP8) { const i32x4 a0 = __builtin_bit_cast(i32x4, At[m][0]), a1 = __builtin_bit_cast(i32x4, At[m][1]), b0 = __builtin_bit_cast(i32x4, Bq[n][0]), b1 = __builtin_bit_cast(i32x4, Bq[n][1]); \
            const i32x8 a8 = __builtin_shufflevector(a0, a1, 0, 1, 2, 3, 4, 5, 6, 7), b8 = __builtin_shufflevector(b0, b1, 0, 1, 2, 3, 4, 5, 6, 7); \
            asm volatile("v_mfma_scale_f32_16x16x128_f8f6f4 %0, %1, %2, %0, %3, %4 op_sel_hi:[0,0,0]" : "+v"(acc[ai][bj][m][n]) : "v"(b8), "v"(a8), "v"(mxw), "v"(mxa)); } \
        else { _Pragma("unroll") for (int k = 0; k < 2; ++k) \
            acc[ai][bj][m][n] = TRANS ? __builtin_amdgcn_mfma_f32_16x16x32_bf16(At[m][k], Bq[n][k], acc[ai][bj][m][n], 0, 0, 0) : __builtin_amdgcn_mfma_f32_16x16x32_bf16(Bq[n][k], At[m][k], acc[ai][bj][m][n], 0, 0, 0); } } \
        __builtin_amdgcn_s_setprio(0); } } while (0)
#define GS_WV(n) asm volatile("s_waitcnt vmcnt(" #n ")" ::: "memory")
#define GS_WL(n) asm volatile("s_waitcnt lgkmcnt(" #n ")" ::: "memory")
#define GS_BAR __builtin_amdgcn_s_barrier()
#define GS_SCHED __builtin_amdgcn_sched_barrier(0)
    f32x4 acc[2][2][4][2];
#pragma unroll
    for (int a = 0; a < 2; ++a)
#pragma unroll
        for (int b = 0; b < 2; ++b)
#pragma unroll
            for (int m = 0; m < 4; ++m)
#pragma unroll
                for (int n = 0; n < 2; ++n) acc[a][b][m][n] = (f32x4){0.f, 0.f, 0.f, 0.f};
    bf16x8 At[4][2], B0[2][2], B1[2][2];
    GS_STB(0, 0, cur.Bt, 0); GS_STA(0, 0, cur.A, ac00, ac01, 0); GS_STB(0, 1, cur.Bt, 0); GS_STA(0, 1, cur.A, ac10, ac11, 0);
    if (wr == 1) GS_BAR;
    GS_WV(4); GS_BAR;
    GS_STB(1, 0, cur.Bt, 1); GS_STA(1, 0, cur.A, ac00, ac01, 1); GS_STB(1, 1, cur.Bt, 1);
    GS_WV(6); GS_BAR;
    for (int ui = 0;; ++ui) {
        const bool has_next = src.get(ui + 1, nxt);
        if (!has_next) nxt = cur;
        const unsigned an00 = GS_AOF(nxt, 0, R0, C0), an01 = GS_AOF(nxt, 0, R1, C1), an10 = GS_AOF(nxt, 1, R0, C0), an11 = GS_AOF(nxt, 1, R1, C1);
        const bool hi = cur.rows > 128;
        for (int t = 0; t < nt; t += 2) {
            const bool last = (t == nt - 2);
            const char* xA = last ? nxt.A : cur.A; const char* xB = last ? nxt.Bt : cur.Bt;
            const unsigned x00 = last ? an00 : ac00, x01 = last ? an01 : ac01, x10 = last ? an10 : ac10, x11 = last ? an11 : ac11;
            const int k2 = last ? 0 : t + 2, k3 = k2 + 1;
            GS_LDB(B0, 0, 0); GS_SCHED; GS_LDA(At, 0, 0); GS_STA(1, 1, cur.A, ac10, ac11, t + 1);
            GS_WL(8); GS_BAR; GS_WL(0); GS_MMA(0, 0, At, B0); GS_BAR; GS_SCHED;
            GS_LDB(B1, 0, 1); GS_STB(0, 0, xB, k2);
            GS_BAR; GS_WL(0); GS_MMA(0, 1, At, B1); GS_BAR;
            GS_LDA(At, 0, 1); GS_STA(0, 0, xA, x00, x01, k2);
            GS_BAR; GS_WL(0); GS_MMA(1, 0, At, B0); GS_BAR; GS_SCHED;
            GS_STB(0, 1, xB, k2);
            GS_WV(6); GS_BAR; GS_MMA(1, 1, At, B1); GS_BAR;
            GS_LDB(B0, 1, 0); GS_SCHED; GS_LDA(At, 1, 0); GS_STA(0, 1, xA, x10, x11, k2);
            GS_WL(8); GS_BAR; GS_WL(0); GS_MMA(0, 0, At, B0); GS_BAR; GS_SCHED;
            GS_LDB(B1, 1, 1); GS_STB(1, 0, xB, k3);
            GS_BAR; GS_WL(0); GS_MMA(0, 1, At, B1); GS_BAR;
            GS_LDA(At, 1, 1); GS_STA(1, 0, xA, x00, x01, k3);
            GS_BAR; GS_WL(0); GS_MMA(1, 0, At, B0); GS_BAR; GS_SCHED;
            GS_STB(1, 1, xB, k3);
            GS_WV(6); GS_BAR; GS_MMA(1, 1, At, B1); GS_BAR;
        }
        __builtin_amdgcn_sched_barrier(0);
        src.epi(acc, cur, wr, wc, fr, fq);
        __builtin_amdgcn_sched_barrier(0);
        if (!has_next) break;
#pragma unroll
        for (int a = 0; a < 2; ++a)
#pragma unroll
            for (int b = 0; b < 2; ++b)
#pragma unroll
                for (int m = 0; m < 4; ++m)
#pragma unroll
                    for (int n = 0; n < 2; ++n) acc[a][b][m][n] = (f32x4){0.f, 0.f, 0.f, 0.f};
        cur = nxt; ac00 = an00; ac01 = an01; ac10 = an10; ac11 = an11;
    }
    GS_WV(0);
    if (wr == 0) GS_BAR;
    GS_BAR;
#undef GS_AOF
#undef GS_SA
#undef GS_SB
#undef GS_GL
#undef GS_STA
#undef GS_STB
#undef GS_LDA
#undef GS_LDB
#undef GS_MMA
#undef GS_WV
#undef GS_WL
#undef GS_BAR
#undef GS_SCHED
}
struct Epi8PG { u16* PG; int tok0, col0;
    __device__ __forceinline__ void operator()(const f32x4 (&acc)[2][2][4][2], int wr, int wc, int fr, int fq) const {
#pragma unroll
        for (int ai = 0; ai < 2; ++ai)
#pragma unroll
            for (int m = 0; m < 4; ++m) { u16* rowp = PG + (size_t)(tok0 + ai * 128 + wr * 64 + m * 16 + fr) * 5120 + col0 + wc * 32 + 8 * fq;
#pragma unroll
                for (int bj = 0; bj < 2; ++bj) { const f32x4 v0 = acc[ai][bj][m][0], v1 = acc[ai][bj][m][1];
                    *(u32x4*)(rowp + bj * 128) = (u32x4){pk_bf16(v0[0], v0[1]), pk_bf16(v0[2], v0[3]), pk_bf16(v1[0], v1[1]), pk_bf16(v1[2], v1[3])}; } }
    } };
struct Epi8HYT { u16* HYT; int tok0, col0;
    __device__ __forceinline__ void operator()(const f32x4 (&acc)[2][2][4][2], int wr, int wc, int fr, int fq) const {
#pragma unroll
        for (int bj = 0; bj < 2; ++bj)
#pragma unroll
            for (int n = 0; n < 2; ++n) { u16* colp = HYT + (size_t)(col0 + bj * 128 + wc * 32 + perm32(n * 16 + fr)) * NTOK + tok0 + wr * 64 + 4 * fq;
#pragma unroll
                for (int ai = 0; ai < 2; ++ai)
#pragma unroll
                    for (int m = 0; m < 4; ++m) { const f32x4 v = acc[ai][bj][m][n]; *(u32x2*)(colp + ai * 128 + m * 16) = (u32x2){pk_bf16(v[0], v[1]), pk_bf16(v[2], v[3])}; } }
    } };
struct Epi8X1 { const float* x; float* X1; int tok0, col0;
    __device__ __forceinline__ void operator()(const f32x4 (&acc)[2][2][4][2], int wr, int wc, int fr, int fq) const {
#pragma unroll
        for (int ai = 0; ai < 2; ++ai)
#pragma unroll
            for (int m = 0; m < 4; ++m) { const size_t off = (size_t)(tok0 + ai * 128 + wr * 64 + m * 16 + fr) * DM + col0 + wc * 32 + 8 * fq;
#pragma unroll
                for (int bj = 0; bj < 2; ++bj)
#pragma unroll
                    for (int n = 0; n < 2; ++n) { const f32x4 r = *(const f32x4*)(x + off + bj * 128 + n * 4); *(f32x4*)(X1 + off + bj * 128 + n * 4) = r + acc[ai][bj][m][n]; }
                asm volatile("" ::: "memory"); }
    } };
struct Epi8Swiglu { u16* HM; const float* b1; int slot0, nt, rows_valid;
    __device__ __forceinline__ void operator()(const f32x4 (&acc)[2][2][4][2], int wr, int wc, int fr, int fq) const {
        f32x4 bg[2], bl[2];
#pragma unroll
        for (int n = 0; n < 2; ++n) { const int col = nt * 128 + wc * 32 + 8 * fq + 4 * n; bg[n] = *(const f32x4*)(b1 + col); bl[n] = *(const f32x4*)(b1 + 2048 + col); }
#pragma unroll
        for (int ai = 0; ai < 2; ++ai)
#pragma unroll
            for (int m = 0; m < 4; ++m) { const int row = ai * 128 + wr * 64 + m * 16 + fr;
                if (row < rows_valid) { float o[8];
#pragma unroll
                    for (int n = 0; n < 2; ++n) { const f32x4 gl = acc[ai][0][m][n] + bg[n], li = acc[ai][1][m][n] + bl[n];
#pragma unroll
                        for (int j = 0; j < 4; ++j) { const float gq = fminf(gl[j], 7.0f), lq = fminf(fmaxf(li[j], -7.0f), 7.0f); o[4 * n + j] = gq * (1.0f / (1.0f + __expf(-1.702f * gq))) * (lq + 1.0f); } }
                    *(u32x4*)(HM + (size_t)(slot0 + row) * DFF + nt * 128 + wc * 32 + 8 * fq) = (u32x4){pk_bf16(o[0], o[1]), pk_bf16(o[2], o[3]), pk_bf16(o[4], o[5]), pk_bf16(o[6], o[7])}; } }
    } };
struct Epi8Swiglu8 { unsigned char* HM; const float* b1; int slot0, nt, rows_valid;
    __device__ __forceinline__ void operator()(const f32x4 (&acc)[2][2][4][2], int wr, int wc, int fr, int fq) const {
        f32x4 bg[2], bl[2];
#pragma unroll
        for (int n = 0; n < 2; ++n) { const int col = nt * 128 + wc * 32 + 8 * fq + 4 * n; bg[n] = *(const f32x4*)(b1 + col); bl[n] = *(const f32x4*)(b1 + 2048 + col); }
#pragma unroll
        for (int ai = 0; ai < 2; ++ai)
#pragma unroll
            for (int m = 0; m < 4; ++m) { const int row = ai * 128 + wr * 64 + m * 16 + fr;
                if (row < rows_valid) { float o[8];
#pragma unroll
                    for (int n = 0; n < 2; ++n) { const f32x4 gl = acc[ai][0][m][n] + bg[n], li = acc[ai][1][m][n] + bl[n];
#pragma unroll
                        for (int j = 0; j < 4; ++j) { const float gq = fminf(gl[j], 7.0f), lq = fminf(fmaxf(li[j], -7.0f), 7.0f); o[4 * n + j] = gq * (1.0f / (1.0f + __expf(-1.702f * gq))) * (lq + 1.0f); } }
                    *(u32x2*)(HM + (size_t)(slot0 + row) * DFF + nt * 128 + wc * 32 + 8 * fq) = (u32x2){pk_fp8x4(o[0], o[1], o[2], o[3]), pk_fp8x4(o[4], o[5], o[6], o[7])}; } }
    } };
struct Epi8Y { u16* Y; const float* b2; int slot0, col0, rows_valid;
    __device__ __forceinline__ void operator()(const f32x4 (&acc)[2][2][4][2], int wr, int wc, int fr, int fq) const {
        f32x4 bv[2][2];
#pragma unroll
        for (int bj = 0; bj < 2; ++bj)
#pragma unroll
            for (int n = 0; n < 2; ++n) bv[bj][n] = *(const f32x4*)(b2 + col0 + bj * 128 + wc * 32 + 8 * fq + 4 * n);
#pragma unroll
        for (int ai = 0; ai < 2; ++ai)
#pragma unroll
            for (int m = 0; m < 4; ++m) { const int row = ai * 128 + wr * 64 + m * 16 + fr;
                if (row < rows_valid) { u16* rowp = Y + (size_t)(slot0 + row) * DM + col0 + wc * 32 + 8 * fq;
#pragma unroll
                    for (int bj = 0; bj < 2; ++bj) { const f32x4 v0 = acc[ai][bj][m][0] + bv[bj][0], v1 = acc[ai][bj][m][1] + bv[bj][1];
                        *(u32x4*)(rowp + bj * 128) = (u32x4){pk_bf16(v0[0], v0[1]), pk_bf16(v0[2], v0[3]), pk_bf16(v1[0], v1[1]), pk_bf16(v1[2], v1[3])}; } } }
    } };
struct EpiNone { __device__ __forceinline__ void operator()(const f32x4 (&acc)[2][2][4][2], int wr, int wc, int fr, int fq) const {
#pragma unroll
        for (int a = 0; a < 2; ++a)
#pragma unroll
            for (int b = 0; b < 2; ++b)
#pragma unroll
                for (int m = 0; m < 4; ++m)
#pragma unroll
                    for (int n = 0; n < 2; ++n) asm volatile("" :: "v"(acc[a][b][m][n]));
    } };

template <int NTILES>
__device__ __forceinline__ bool moe_unit_static(const LAS int* us, const LAS int* so2, int uu, int& e, int& nt, int& slot0, int& rows) {
    if (uu >= us[NE]) return false;
    int lo = 0, hi = NE;
#pragma unroll
    for (int s = 0; s < 5; ++s) { const int mid = (lo + hi) >> 1; if (us[mid] <= uu) lo = mid; else hi = mid; }
    e = lo; const int o0 = so2[e], cnt = so2[e + 1] - o0, mtl = (cnt + 255) >> 8, ul = uu - us[e], mt = ul % mtl;
    nt = ul / mtl; slot0 = o0 + mt * 256; rows = cnt - mt * 256; rows = rows > 256 ? 256 : rows; return true;
}
struct SrcMoeB { const LAS int* us; const LAS int* so2; int c, G; const char* HM8; const char* W2T8; u16* YB; const float* b2;
    __device__ __forceinline__ bool get(int i, StreamUnit& u) const { int e, nt, slot0, rows; if (!moe_unit_static<8>(us, so2, c + i * G, e, nt, slot0, rows)) return false;
        u.A = HM8; u.Bt = W2T8 + (size_t)((e * 8 + nt) * 16) * 32768; u.arow0 = slot0; u.rows = rows; u.a = e; u.b = nt; u.c = slot0; return true; }
    __device__ __forceinline__ void epi(const f32x4 (&acc)[2][2][4][2], const StreamUnit& u, int wr, int wc, int fr, int fq) const { Epi8Y ep{YB, b2 + (size_t)u.a * DM, u.c, u.b * 256, u.rows}; ep(acc, wr, wc, fr, fq); }
};
template <bool TRANS>
struct SrcG1 { int c, G; const char* HBp; const char* WINTp; u16* PG; u16* HYT;
    __device__ __forceinline__ bool get(int k, StreamUnit& su) const {
        int seen = 0;
        for (int u = c; u < 1024; u += G) { const int i = u >> 8, xx = (u >> 5) & 7, j = u & 31; const int mt = (xx & 3) * 8 + (j & 7), nt = ((xx >> 2) + 2 * i) * 4 + (j >> 3);
            if ((nt >= 20) == TRANS) { if (seen == k) { su.A = HBp; su.Bt = WINTp + (size_t)nt * 32 * 32768; su.arow0 = mt * 256; su.rows = 256; su.a = mt; su.b = nt; su.c = 0; return true; } ++seen; } }
        return false; }
    __device__ __forceinline__ void epi(const f32x4 (&acc)[2][2][4][2], const StreamUnit& u, int wr, int wc, int fr, int fq) const {
        if (TRANS) { Epi8HYT e{HYT, u.a * 256, u.b * 256 - 5120}; e(acc, wr, wc, fr, fq); } else { Epi8PG e{PG, u.a * 256, u.b * 256}; e(acc, wr, wc, fr, fq); } }
};

typedef float f32x16 __attribute__((ext_vector_type(16)));
__device__ __forceinline__ void h3_row(int m, const float* __restrict__ w1, const float* __restrict__ b1, const float* __restrict__ w2, const float* __restrict__ b2,
                                       const float* __restrict__ w3, const float* __restrict__ b3, const float* __restrict__ freq, LAS float* sc  , float* __restrict__ H3) {
    const int j = tid_fresh() & 63;
    const float tt = (float)m / (float)(SEQ - 1);
    if (j == 0) sc[0] = tt;
    if (j >= 1 && j <= 16) { const int i = j - 1; const float band = 1e-4f + (float)i * ((15.0f - 1e-4f) / 15.0f); const float ang = (2.0f * 3.14159265358979323846f / (float)SEQ) * (float)m * band; sc[1 + i] = cosf(ang); sc[17 + i] = -sinf(ang); }
    __builtin_amdgcn_wave_barrier();
    const float fr = freq[j];
    float s = b1[j];
    for (int i = 0; i < 33; ++i) s += sc[i] * w1[i * 64 + j];
    const float h1 = sinf(fr * s);
    sc[64 + j] = h1;
    __builtin_amdgcn_wave_barrier();
    s = b2[j];
    for (int i = 0; i < 64; ++i) s += sc[64 + i] * w2[i * 64 + j];
    const float h2 = sinf(fr * s);
    __builtin_amdgcn_wave_barrier();
    sc[j] = h2;
    __builtin_amdgcn_wave_barrier();
    s = b3[j];
    for (int i = 0; i < 64; ++i) s += sc[i] * w3[i * 64 + j];
    H3[(size_t)m * 64 + j] = sinf(fr * s);
    __builtin_amdgcn_wave_barrier();
}
constexpr int FR_LEN = 4128;
__device__ __forceinline__ void frgen_item(LAS unsigned char* lds, int item, const float* __restrict__ H3, const float* __restrict__ w4, u16* __restrict__ FR) {
    const int tid = tid_fresh(), wid = __builtin_amdgcn_readfirstlane(tid >> 6), lane = tid & 63, fr = lane & 15, fq = lane >> 4;
    const int oc0 = item * 8, o = oc0 >> 10;
    const int colB = o * 2048 + (fr >> 3) * 1024 + (oc0 & 1023) + (fr & 7);
    float wreg[16];
#pragma unroll
    for (int ks = 0; ks < 16; ++ks) wreg[ks] = w4[(size_t)(4 * ks + fq) * 4096 + colB];
    const int dir = fr >> 3, c = (oc0 & 1023) + (fr & 7);
    const float mind = logf(1e-2f) / 0.3f, maxd = logf(1e-2f) / 1.5f;
    const float delta = fabsf(mind + (float)c * ((maxd - mind) / 1023.0f));
    u16* r0 = FR + (size_t)((oc0 + (fr & 7)) * 2) * FR_LEN;
    LAS float* tile = (LAS float*)(lds + wid * 4608);
    const int wrow = lane >> 4, wcol = 4 * (lane & 15);
    f32x4 nx[4];
#pragma unroll
    for (int q = 0; q < 4; ++q) nx[q] = *(const f32x4*)(H3 + (size_t)wid * 1024 + q * 256 + lane * 4);
    for (int it = 0; it < 16; ++it) {
        const int mt = wid + 8 * it;
#pragma unroll
        for (int q = 0; q < 4; ++q) *(LAS f32x4*)(tile + (q * 4 + wrow) * 68 + wcol) = nx[q];
        if (it + 1 < 16) {
#pragma unroll
            for (int q = 0; q < 4; ++q) nx[q] = *(const f32x4*)(H3 + (size_t)(mt + 8) * 1024 + q * 256 + lane * 4);
        }
        f32x4 acc = {0.f, 0.f, 0.f, 0.f};
#pragma unroll
        for (int ks = 0; ks < 16; ++ks) acc = __builtin_amdgcn_mfma_f32_16x16x4f32(tile[fr * 68 + 4 * ks + fq], wreg[ks], acc, 0, 0, 0);
        const int m0 = mt * 16 + 4 * fq;
        float v[4];
#pragma unroll
        for (int j = 0; j < 4; ++j) v[j] = acc[j] * __expf(-((float)(m0 + j) / (float)(SEQ - 1)) * delta);
        if (dir == 0) {
            *(u32x2*)(r0 + 2044 - m0) = (u32x2){pk_bf16(v[3], v[2]), pk_bf16(v[1], v[0])};
#pragma unroll
            for (int j = 0; j < 4; ++j) r0[FR_LEN + 2046 - m0 - j] = (u16)(pk_bf16(v[j], 0.f) & 0xffffu);
        } else {
#pragma unroll
            for (int j = 0; j < 4; ++j) if (m0 + j >= 1) { const u16 b = (u16)(pk_bf16(v[j], 0.f) & 0xffffu); r0[2047 + m0 + j] = b; r0[FR_LEN + 2046 + m0 + j] = b; }
        }
    }
    if (tid < 8 * 34) { const int r = tid / 34, x = 4094 + tid % 34; u16* rr = FR + (size_t)((oc0 + r) * 2) * FR_LEN; if (x >= 4095) rr[x] = 0; rr[FR_LEN + x] = 0; }
    __syncthreads();
}
constexpr int HY_ZSTRIDE = 2312;
constexpr int HY_ZCH = 256 + 4 * HY_ZSTRIDE;
constexpr int HY_ZBYTES = HY_ZCH * 2;
constexpr int HY_FB = 4 * HY_ZBYTES;
constexpr int HY_FCH = 2 * FR_LEN * 2;
constexpr int HY_LDS = HY_FB + 4 * HY_FCH;

__device__ __forceinline__ void hy_load_row(LAS unsigned char* lds, int dest, int boff0, int bstride, const u16* __restrict__ row, float w0, float w1, float w2, float cb, int pl) {
#pragma unroll 2
    for (int it = 0; it < 8; ++it) {
        const int idx = pl + 128 * it, tok0 = idx * 8, b = tok0 >> 11, n0 = tok0 & 2047;
        const u32x4 raw = *(const u32x4*)(row + tok0);
        const float pm = (n0 > 0) ? bf2f(row[tok0 - 1]) : 0.f;
        const float pn = (n0 + 8 < SEQ) ? bf2f(row[tok0 + 8]) : 0.f;
        float p[10];
        p[0] = pm; p[9] = pn;
#pragma unroll
        for (int q = 0; q < 4; ++q) { p[1 + 2 * q] = bflo(raw[q]); p[2 + 2 * q] = bfhi(raw[q]); }
        float o[8];
#pragma unroll
        for (int q = 0; q < 8; ++q) o[q] = fmaf(w0, p[q], fmaf(w1, p[q + 1], fmaf(w2, p[q + 2], cb)));
        u32x4 w; w[0] = pk_bf16(o[0], o[1]); w[1] = pk_bf16(o[2], o[3]); w[2] = pk_bf16(o[4], o[5]); w[3] = pk_bf16(o[6], o[7]);
        *(LAS u32x4*)(lds + dest + (boff0 + b * bstride + n0) * 2) = w;
    }
}
__device__ __forceinline__ void hy_load_filters(LAS unsigned char* lds, int fb, const u16* __restrict__ src, int pl) {
    for (int idx = pl; idx < HY_FCH / 16; idx += 128) *(LAS u32x4*)(lds + fb + idx * 16) = *(const u32x4*)((const char*)src + idx * 16);
}
__device__ __forceinline__ void hy_mfma_loop(LAS unsigned char* lds, int zb, int fb, int hlf, int lane, f32x16 (&acc)[4], const ConvCtx& cc, int mbase, int cunit, int wid) {
    const int r = lane & 31, hh = lane >> 5, il = r >> 2, b = r & 3;
    const int bbase = zb + (256 + b * HY_ZSTRIDE + 32 * il + 8 * hh) * 2;
    const int xl = 2047 - r + 8 * hh - 1024 * hlf;
    const int abase = (r & 1) ? (fb + 2 * xl) : (fb + FR_LEN * 2 + 2 * (xl - 1));
#pragma unroll
    for (int q = 0; q < 4; ++q)
#pragma unroll
        for (int i = 0; i < 16; ++i) acc[q][i] = 0.f;
    for (int d0 = 0; d0 < 8; ++d0) {
#pragma unroll
        for (int ks = 0; ks < 2; ++ks) {
            f32x2 cv[16];
            const int mcv = conv_seq2tile((mbase + d0 * 2 + ks) * 256 + cunit);
            conv_issue(cc, mcv, wid, lane, cv);
            bf16x8 Bt[9];
#pragma unroll
            for (int j = 0; j < 9; ++j) Bt[j] = *(const LAS bf16x8*)(lds + bbase + 512 * j - 64 * d0 + 32 * ks);
#pragma unroll
            for (int ep = -8; ep <= 3; ++ep) {
                const LAS unsigned* ap = (const LAS unsigned*)(lds + abase - 64 * d0 - 512 * ep + 32 * ks);
                u32x4 av; av[0] = ap[0]; av[1] = ap[1]; av[2] = ap[2]; av[3] = ap[3];
                const bf16x8 a = __builtin_bit_cast(bf16x8, av);
#pragma unroll
                for (int ctl = 0; ctl < 4; ++ctl) { const int jt = ctl - ep; if (jt >= 0 && jt <= 8) acc[ctl] = __builtin_amdgcn_mfma_f32_32x32x16_bf16(a, Bt[jt], acc[ctl], 0, 0, 0); }
            }
            conv_finish(cc, mcv, wid, lane, cv);
        }
    }
}
__device__ __forceinline__ void hy_epilogue(LAS unsigned char* lds, int zb, int gb, int hlf, int lane, const f32x16 (&acc)[4], float bias) {
    const int r = lane & 31, hh = lane >> 5, il = r >> 2, b = r & 3;
#pragma unroll
    for (int ctl = 0; ctl < 4; ++ctl) {
        const int I = 8 * (4 * hlf + ctl) + il;
#pragma unroll
        for (int q = 0; q < 4; ++q) {
            const int n4 = 32 * I + 8 * q + 4 * hh;
            LAS u32x2* zp = (LAS u32x2*)(lds + zb + (256 + b * HY_ZSTRIDE + n4) * 2);
            const u32x2 zv = *zp, gv = *(const LAS u32x2*)(lds + gb + (b * 2048 + n4) * 2);
            const float z0 = bflo(zv[0]), z1 = bfhi(zv[0]), z2 = bflo(zv[1]), z3 = bfhi(zv[1]);
            const float g0 = bflo(gv[0]), g1 = bfhi(gv[0]), g2 = bflo(gv[1]), g3 = bfhi(gv[1]);
            u32x2 o; o[0] = pk_bf16(g0 * fmaf(bias, z0, acc[ctl][4 * q + 0]), g1 * fmaf(bias, z1, acc[ctl][4 * q + 1]));
            o[1] = pk_bf16(g2 * fmaf(bias, z2, acc[ctl][4 * q + 2]), g3 * fmaf(bias, z3, acc[ctl][4 * q + 3]));
            *zp = o;
        }
    }
}
__device__ __forceinline__ void hyena_unit(LAS unsigned char* lds, int unit, const u16* __restrict__ HYT, const u16* __restrict__ FR, const float* __restrict__ cw, const float* __restrict__ cbv,
                                           const float* __restrict__ hbias, u16* __restrict__ Z2T, const ConvCtx& cc) {
    const int tid = tid_fresh(), wid = __builtin_amdgcn_readfirstlane(tid >> 6), lane = tid & 63;
    const int cs = wid & 3, hlf = wid >> 2, c = unit * 4 + cs, pl = lane + 64 * hlf;
    const int zb = cs * HY_ZBYTES, fb = HY_FB + cs * HY_FCH;
    { const u32x4 z = {0u, 0u, 0u, 0u}; for (int idx = pl; idx < HY_ZBYTES / 16; idx += 128) *(LAS u32x4*)(lds + zb + idx * 16) = z; }
    __syncthreads();
    hy_load_row(lds, zb, 256, HY_ZSTRIDE, HYT + (size_t)c * NTOK, cw[0 * 3072 + c], cw[1 * 3072 + c], cw[2 * 3072 + c], cbv[c], pl);
    f32x16 acc[4];
#pragma unroll
    for (int o = 0; o < 2; ++o) {
        hy_load_filters(lds, fb, FR + (size_t)((o * 1024 + c) * 2) * FR_LEN, pl);
        __syncthreads();
        hy_mfma_loop(lds, zb, fb, hlf, lane, acc, cc, o * 16, unit, wid);
        __syncthreads();
        const int gc = (1 + o) * 1024 + c;
        hy_load_row(lds, fb, 0, 2048, HYT + (size_t)gc * NTOK, cw[0 * 3072 + gc], cw[1 * 3072 + gc], cw[2 * 3072 + gc], cbv[gc], pl);
        __syncthreads();
        hy_epilogue(lds, zb, fb, hlf, lane, acc, hbias[o * HYW + c]);
        __syncthreads();
    }
#pragma unroll 2
    for (int it = 0; it < 8; ++it) { const int idx = pl + 128 * it, tok0 = idx * 8, b = tok0 >> 11, n0 = tok0 & 2047;
        *(u32x4*)(Z2T + (size_t)c * NTOK + tok0) = *(const LAS u32x4*)(lds + zb + (256 + b * HY_ZSTRIDE + n0) * 2); }
    __syncthreads();
}

constexpr int HG_RAWQ = 0, HG_RAWF = 16384, HG_RAWV = 32768;
constexpr int HG_QM = 36864, HG_KM = HG_QM + 17408, HG_QI = HG_KM + 17408;
constexpr int HG_KL = HG_QI + 17408;
constexpr int HG_VT = HG_KL + 18432;
constexpr int HG_P = HG_VT + 4608;
constexpr int HG_ST = HG_P + 9216;
constexpr int HG_TOT = HG_ST + 8704;
constexpr int HG_EL2 = HG_TOT + 2048;
constexpr int HG_LDS = HG_EL2 + 512;

__device__ __forceinline__ void hgrn_unit(LAS unsigned char* lds, int unit, const u16* __restrict__ PG, const float* __restrict__ lb_logits, float* __restrict__ OF, float* __restrict__ OB, const ConvCtx& cc) {
    const int tid = tid_fresh(), wid = __builtin_amdgcn_readfirstlane(tid >> 6), lane = tid & 63, fr = lane & 15, fq = lane >> 4;
    const int vq = unit & 3, dir = (unit >> 2) & 1, h = (unit >> 3) & 7, b = unit >> 6;
    const int k = tid & 127, seg = tid >> 7;
    float* __restrict__ O = dir ? OB : OF;
    float lb;
    { const int c = h * 128 + k; const float l0 = lb_logits[(0 * 2 + dir) * HGW + c], l1 = lb_logits[(1 * 2 + dir) * HGW + c]; lb = 1.0f / (1.0f + __expf(l1 - l0)); }
    for (int i = tid; i < 8704 / 16; i += 512) *(LAS u32x4*)(lds + HG_ST + i * 16) = (u32x4){0u, 0u, 0u, 0u};
    f32x4 Sacc[2];
    Sacc[0] = (f32x4){0.f, 0.f, 0.f, 0.f}; Sacc[1] = Sacc[0];
    u32x4 pq[2], pf[2], pv;
    const int colq = h * 128, colf = (1 + dir) * 1024 + h * 128, colv = 3072 + h * 128 + vq * 32;
#define HG_TOK(c, tau) ((size_t)b * SEQ + (dir ? (SEQ - 1 - 64 * (c) - (tau)) : (64 * (c) + (tau))))
#define HG_PREFETCH(c) do { _Pragma("unroll") for (int _i = 0; _i < 2; ++_i) { const int _x = tid + 512 * _i, _tau = _x >> 4, _p = _x & 15; const u16* _r = PG + HG_TOK(c, _tau) * 5120; \
            pq[_i] = *(const u32x4*)(_r + colq + _p * 8); pf[_i] = *(const u32x4*)(_r + colf + _p * 8); } \
        if (tid < 256) { const int _tau = tid >> 2, _p = tid & 3; pv = *(const u32x4*)(PG + HG_TOK(c, _tau) * 5120 + colv + _p * 8); } } while (0)
    HG_PREFETCH(0);
    for (int c = 0; c < 32; ++c) {
#pragma unroll
        for (int i = 0; i < 2; ++i) { const int x = tid + 512 * i; *(LAS u32x4*)(lds + HG_RAWQ + x * 16) = pq[i]; *(LAS u32x4*)(lds + HG_RAWF + x * 16) = pf[i]; }
        if (tid < 256) *(LAS u32x4*)(lds + HG_RAWV + tid * 16) = pv;
        if (c + 1 < 32) HG_PREFETCH(c + 1);
        f32x2 cv[16];
        const int mqa = conv_seq2tile((32 + c * 2) * 256 + unit), mqb = conv_seq2tile((33 + c * 2) * 256 + unit);
        conv_issue(cc, mqa, wid, lane, cv);
        __syncthreads();
        float qv[16], kv[16], bl[16];
        { float run = 0.f;
#pragma unroll
          for (int i = 0; i < 16; ++i) { const int tau = seg * 16 + i;
              const float qr = bf2f(*(const LAS u16*)(lds + HG_RAWQ + tau * 256 + k * 2)), zf = bf2f(*(const LAS u16*)(lds + HG_RAWF + tau * 256 + k * 2));
              const float sg = 1.0f / (1.0f + __expf(-zf)); const float f = lb + (1.0f - lb) * sg;
              run += __logf(f); bl[i] = run; kv[i] = 1.0f - f; qv[i] = qr / (1.0f + __expf(-qr)); }
          *(LAS float*)(lds + HG_TOT + (seg * 128 + k) * 4) = run; }
        __syncthreads();
        { const float t0 = *(const LAS float*)(lds + HG_TOT + (0 * 128 + k) * 4), t1 = *(const LAS float*)(lds + HG_TOT + (1 * 128 + k) * 4),
                      t2 = *(const LAS float*)(lds + HG_TOT + (2 * 128 + k) * 4), t3 = *(const LAS float*)(lds + HG_TOT + (3 * 128 + k) * 4);
          const float pre = (seg > 0 ? t0 : 0.f) + (seg > 1 ? t1 : 0.f) + (seg > 2 ? t2 : 0.f);
          const float bref = t0 + t1, blast = bref + t2 + t3;
          const float er = __expf(bref), el = __expf(blast - bref);
          if (seg == 0) *(LAS float*)(lds + HG_EL2 + k * 4) = __expf(blast);
          unsigned klp[8];
#pragma unroll
          for (int i = 0; i < 16; i += 2) {
              float klv[2];
#pragma unroll
              for (int u = 0; u < 2; ++u) { const int tau = seg * 16 + i + u; const float bb = pre + bl[i + u];
                  const float e1 = __expf(bb - bref), e2 = __expf(bref - bb);
                  const float qm = qv[i + u] * e1, km = kv[i + u] * e2;
                  *(LAS u16*)(lds + HG_QM + tau * 272 + k * 2) = (u16)(pk_bf16(qm, 0.f) & 0xffffu);
                  *(LAS u16*)(lds + HG_KM + tau * 272 + k * 2) = (u16)(pk_bf16(km, 0.f) & 0xffffu);
                  *(LAS u16*)(lds + HG_QI + tau * 272 + k * 2) = (u16)(pk_bf16(qm * er, 0.f) & 0xffffu);
                  klv[u] = km * el; }
              klp[i >> 1] = pk_bf16(klv[0], klv[1]); }
          *(LAS u32x4*)(lds + HG_KL + k * 144 + seg * 32) = (u32x4){klp[0], klp[1], klp[2], klp[3]};
          *(LAS u32x4*)(lds + HG_KL + k * 144 + seg * 32 + 16) = (u32x4){klp[4], klp[5], klp[6], klp[7]};
          { const int v = tid & 31, tg = tid >> 5; unsigned short e[4];
#pragma unroll
            for (int u = 0; u < 4; ++u) e[u] = *(const LAS u16*)(lds + HG_RAWV + (tg * 4 + u) * 64 + v * 2);
            *(LAS u32x2*)(lds + HG_VT + v * 144 + tg * 8) = (u32x2){(unsigned)e[0] | ((unsigned)e[1] << 16), (unsigned)e[2] | ((unsigned)e[3] << 16)}; } }
        conv_finish(cc, mqa, wid, lane, cv);
        conv_issue(cc, mqb, wid, lane, cv);
        __syncthreads();
#pragma unroll
        for (int q = 0; q < 2; ++q) { const int idx = wid * 2 + q, ti = idx >> 2, si = idx & 3;
            f32x4 a = {0.f, 0.f, 0.f, 0.f};
            if (si <= ti) {
#pragma unroll
                for (int ks = 0; ks < 4; ++ks) { const bf16x8 ka = *(const LAS bf16x8*)(lds + HG_KM + (si * 16 + fr) * 272 + (ks * 32 + fq * 8) * 2), qb = *(const LAS bf16x8*)(lds + HG_QM + (ti * 16 + fr) * 272 + (ks * 32 + fq * 8) * 2);
                    a = __builtin_amdgcn_mfma_f32_16x16x32_bf16(ka, qb, a, 0, 0, 0); } }
            const int tau = ti * 16 + fr, s0 = si * 16 + fq * 4;
            float pvv[4];
#pragma unroll
            for (int j = 0; j < 4; ++j) pvv[j] = (si <= ti && s0 + j <= tau) ? a[j] : 0.f;
            *(LAS u32x2*)(lds + HG_P + tau * 144 + s0 * 2) = (u32x2){pk_bf16(pvv[0], pvv[1]), pk_bf16(pvv[2], pvv[3])}; }
        const int ti = wid >> 1, vi = wid & 1;
        f32x4 oacc = {0.f, 0.f, 0.f, 0.f};
#pragma unroll
        for (int ks = 0; ks < 4; ++ks) { const bf16x8 qa = *(const LAS bf16x8*)(lds + HG_QI + (ti * 16 + fr) * 272 + (ks * 32 + fq * 8) * 2), sb = *(const LAS bf16x8*)(lds + HG_ST + (vi * 16 + fr) * 272 + (ks * 32 + fq * 8) * 2);
            oacc = __builtin_amdgcn_mfma_f32_16x16x32_bf16(qa, sb, oacc, 0, 0, 0); }
        { const f32x4 e2 = *(const LAS f32x4*)(lds + HG_EL2 + (wid * 16 + fq * 4) * 4);
#pragma unroll
          for (int v2 = 0; v2 < 2; ++v2) { Sacc[v2] = Sacc[v2] * e2;
#pragma unroll
              for (int ks = 0; ks < 2; ++ks) { const bf16x8 ka = *(const LAS bf16x8*)(lds + HG_KL + (wid * 16 + fr) * 144 + (ks * 32 + fq * 8) * 2), vb = *(const LAS bf16x8*)(lds + HG_VT + (v2 * 16 + fr) * 144 + (ks * 32 + fq * 8) * 2);
                  Sacc[v2] = __builtin_amdgcn_mfma_f32_16x16x32_bf16(ka, vb, Sacc[v2], 0, 0, 0); } } }
        __syncthreads();
#pragma unroll
        for (int ks = 0; ks < 2; ++ks) { const bf16x8 pa = *(const LAS bf16x8*)(lds + HG_P + (ti * 16 + fr) * 144 + (ks * 32 + fq * 8) * 2), vb = *(const LAS bf16x8*)(lds + HG_VT + (vi * 16 + fr) * 144 + (ks * 32 + fq * 8) * 2);
            oacc = __builtin_amdgcn_mfma_f32_16x16x32_bf16(pa, vb, oacc, 0, 0, 0); }
#pragma unroll
        for (int j = 0; j < 4; ++j) { const int tau = ti * 16 + fq * 4 + j; O[HG_TOK(c, tau) * HGW + h * 128 + vq * 32 + vi * 16 + fr] = oacc[j]; }
        conv_finish(cc, mqb, wid, lane, cv);
#pragma unroll
        for (int v2 = 0; v2 < 2; ++v2) *(LAS u32x2*)(lds + HG_ST + (v2 * 16 + fr) * 272 + (wid * 16 + fq * 4) * 2) = (u32x2){pk_bf16(Sacc[v2][0], Sacc[v2][1]), pk_bf16(Sacc[v2][2], Sacc[v2][3])};
    }
    __syncthreads();
#undef HG_TOK
#undef HG_PREFETCH
}


#define XB_TMO      128
#define XB_XCNT(j)  (256  + 64 * (j))
#define XB_XSUB(j)  (1280 + 64 * (j))
#define XB_XGEN(j)  (2304 + 64 * (j))
#define XB_TOP      3328
#define XB_TOPGEN   3392
#define XCD_BAR_WORDS 3456
#define XB_SPIN_CAP (1u << 22)

__device__ __forceinline__ unsigned xb_ld(unsigned* p)              { return __hip_atomic_load(p, __ATOMIC_RELAXED, __HIP_MEMORY_SCOPE_AGENT); }
__device__ __forceinline__ unsigned xb_add(unsigned* p, unsigned v) { return __hip_atomic_fetch_add(p, v, __ATOMIC_RELAXED, __HIP_MEMORY_SCOPE_AGENT); }
__device__ __forceinline__ unsigned xb_xcc_id() { return (unsigned)__builtin_amdgcn_s_getreg((3 << 11) | 20) & 0xFu; }
#define XB_SPIN(cond, bar) do { unsigned _sp = 0; while (cond) { __builtin_amdgcn_s_sleep(1); \
    if ((++_sp & 255u) == 0u) { if (xb_ld(&(bar)[XB_TMO])) break; if (_sp > XB_SPIN_CAP) { atomicAdd(&(bar)[XB_TMO], 1u); break; } } } } while (0)

struct XcdBarrier {
    unsigned* bar; unsigned x;
    volatile LAS unsigned* st;
};

__device__ __forceinline__ XcdBarrier xcd_barrier_post(unsigned* bar, volatile LAS unsigned* st) {
    XcdBarrier b; b.bar = bar; b.x = xb_xcc_id(); b.st = st;
    if (threadIdx.x == 0) (void)xb_add(&bar[XB_XCNT(b.x)], 1u);
    return b;
}
__device__ __forceinline__ void xcd_barrier_complete(unsigned* bar, unsigned x, unsigned& nloc, unsigned& nx) {
    const unsigned G = gridDim.x * gridDim.y * gridDim.z;
    unsigned sum, cnt, mine, sp = 0u;
    for (;;) {
        sum = 0u; cnt = 0u; mine = 0u;
#pragma unroll
        for (unsigned j = 0; j < 16; ++j) { const unsigned c = xb_ld(&bar[XB_XCNT(j)]); sum += c; cnt += (c > 0u) ? 1u : 0u; mine = (j == x) ? c : mine; }
        if (sum == G) break;
        __builtin_amdgcn_s_sleep(1);
        if ((++sp & 255u) == 0u) { if (xb_ld(&bar[XB_TMO])) break; if (sp > XB_SPIN_CAP) { atomicAdd(&bar[XB_TMO], 1u); break; } }
    }
    nloc = mine > 0u ? mine : 1u; nx = cnt > 0u ? cnt : 1u;
}

__device__ __forceinline__ void xcd_barrier(const XcdBarrier& b) {
    asm volatile("s_waitcnt vmcnt(0)" ::: "memory");
    __syncthreads();
    if (threadIdx.x == 0) {
        unsigned* bar = b.bar;
        __builtin_amdgcn_s_waitcnt(0);
        unsigned nloc = b.st[0], nx = b.st[1];
        if (nloc == 0u) { xcd_barrier_complete(bar, b.x, nloc, nx); b.st[0] = nloc; b.st[1] = nx; }
        const unsigned old = xb_add(&bar[XB_XSUB(b.x)], 1u);
        const unsigned gen = old / nloc;
        if (old + 1u == (gen + 1u) * nloc) {
            __builtin_amdgcn_fence(__ATOMIC_RELEASE, "agent");
            asm volatile("s_waitcnt vmcnt(0)" ::: "memory");
            const unsigned og = xb_add(&bar[XB_TOP], 1u);
            const unsigned tg = og / nx;
            if (og + 1u == (tg + 1u) * nx) xb_add(&bar[XB_TOPGEN], 1u);
            else XB_SPIN(xb_ld(&bar[XB_TOPGEN]) == tg, bar);
            __builtin_amdgcn_fence(__ATOMIC_ACQUIRE, "agent");
            xb_add(&bar[XB_XGEN(b.x)], 1u);
            asm volatile("s_waitcnt vmcnt(0)" ::: "memory");
        } else {
            XB_SPIN(xb_ld(&bar[XB_XGEN(b.x)]) == gen, bar);
            __builtin_amdgcn_fence(__ATOMIC_ACQUIRE, "agent");
            asm volatile("s_waitcnt vmcnt(0)" ::: "memory");
        }
    }
    __syncthreads();
}

__device__ __forceinline__ float wave_sum(float s) {
#pragma unroll
    for (int o = 32; o >= 1; o >>= 1) s += __shfl_xor(s, o);
    return s;
}
__device__ __forceinline__ void rmsnorm_row_bf(const float* __restrict__ xr, const float* __restrict__ gain, u16* __restrict__ ob, int lane) {
    f32x4 v[8]; float s = 0.f;
#pragma unroll
    for (int j = 0; j < 8; ++j) { v[j] = *(const f32x4*)(xr + (lane + 64 * j) * 4); s += v[j][0] * v[j][0] + v[j][1] * v[j][1] + v[j][2] * v[j][2] + v[j][3] * v[j][3]; }
    s = wave_sum(s);
    const float r = rsqrtf(s * (1.0f / (float)DM) + EPS);
#pragma unroll
    for (int j = 0; j < 8; ++j) { const f32x4 g = *(const f32x4*)(gain + (lane + 64 * j) * 4); const f32x4 o = v[j] * r * g;
        *(u32x2*)(ob + (lane + 64 * j) * 4) = (u32x2){pk_bf16(o[0], o[1]), pk_bf16(o[2], o[3])}; }
}
__device__ __forceinline__ void hgrn_final_item4(int item0, int stride, const float* __restrict__ OF, const float* __restrict__ OB, const u16* __restrict__ PG, const float* __restrict__ gain, u16* __restrict__ MIXB, int lane) {
    f32x2 a[4], b[4]; unsigned gw[4];
#pragma unroll
    for (int q = 0; q < 4; ++q) { const int item = item0 + q * stride, tok = item >> 3, c = (item & 7) * 128 + 2 * lane;
        a[q] = *(const f32x2*)(OF + (size_t)tok * HGW + c); b[q] = *(const f32x2*)(OB + (size_t)tok * HGW + c); gw[q] = *(const unsigned*)(PG + (size_t)tok * 5120 + 4096 + c); }
#pragma unroll
    for (int q = 0; q < 4; ++q) { const int item = item0 + q * stride, tok = item >> 3, c = (item & 7) * 128 + 2 * lane;
        const float o0 = a[q][0] + b[q][0], o1 = a[q][1] + b[q][1];
        const float s = wave_sum(o0 * o0 + o1 * o1);
        const float r = rsqrtf(s * (1.0f / 128.0f) + EPS);
        const float g0 = bflo(gw[q]), g1 = bfhi(gw[q]);
        const f32x2 gn = *(const f32x2*)(gain + c);
        const float v0 = o0 * r * gn[0] * (g0 / (1.0f + __expf(-g0))), v1 = o1 * r * gn[1] * (g1 / (1.0f + __expf(-g1)));
        *(u16*)((unsigned char*)MIXB + (size_t)tok * DM + c) = (u16)(__builtin_amdgcn_cvt_pk_fp8_f32(v0, v1, 0, false) & 0xffff); }
}
__device__ __forceinline__ void hy_norm_tile(LAS unsigned char* lds, int tile_i, const u16* __restrict__ Z2T, const float* __restrict__ gain, u16* __restrict__ MIXB) {
    const int t = tid_fresh(), tok0 = tile_i * 32;
    LAS float* ssq = (LAS float*)(lds + 1024 * 80);
    if (t < 32) ssq[t] = 0.f;
    __syncthreads();
    float part[8];
#pragma unroll
    for (int q = 0; q < 8; ++q) part[q] = 0.f;
    const int ch = t & 3;
#pragma unroll
    for (int it = 0; it < 8; ++it) {
        const int c = (t >> 2) + 128 * it;
        const u32x4 v = *(const u32x4*)(Z2T + (size_t)c * NTOK + tok0 + ch * 8);
        *(LAS u32x4*)(lds + c * 80 + ch * 16) = v;
#pragma unroll
        for (int q = 0; q < 4; ++q) { const float a = bflo(v[q]), b = bfhi(v[q]); part[2 * q] += a * a; part[2 * q + 1] += b * b; }
    }
#pragma unroll
    for (int q = 0; q < 8; ++q) { float s = part[q]; s += __shfl_xor(s, 4); s += __shfl_xor(s, 8); s += __shfl_xor(s, 16); s += __shfl_xor(s, 32); part[q] = s; }
    if ((t & 63) < 4) {
#pragma unroll
        for (int q = 0; q < 8; ++q) atomicAdd((float*)(ssq + ch * 8 + q), part[q]);
    }
    __syncthreads();
    const int tt = t >> 4;
    const float r = rsqrtf(ssq[tt] * (1.0f / (float)HYW) + EPS);
#pragma unroll 2
    for (int k = 0; k < 8; ++k) {
        const int c0 = ((t & 15) + 16 * k) * 8;
        float o[8];
#pragma unroll
        for (int q = 0; q < 8; ++q) o[q] = bf2f(*(const LAS u16*)(lds + (c0 + q) * 80 + tt * 2)) * r * gain[c0 + q];
        *(u32x2*)((unsigned char*)MIXB + (size_t)(tok0 + tt) * DM + 1024 + c0) = (u32x2){pk_fp8x4(o[0], o[1], o[2], o[3]), pk_fp8x4(o[4], o[5], o[6], o[7])};
    }
    __syncthreads();
}
constexpr int RT_XSTRIDE = 2049;
constexpr int RT_PART = 16 * RT_XSTRIDE * 4;
constexpr int RT_LG = RT_PART + 8 * 16 * 32 * 4;
constexpr int RT_HIST = RT_LG + 16 * 32 * 4;
constexpr int RT_END = RT_HIST + 128;
__device__ __forceinline__ void router_tile(LAS unsigned char* lds, int tile_i, const float* __restrict__ X1, const float* __restrict__ gain, const float* __restrict__ wr, const float* __restrict__ br,
                                            unsigned char* __restrict__ XN8, int* __restrict__ TOPI, float* __restrict__ TOPG, int* __restrict__ counts) {
    const int tid = tid_fresh(), wid = __builtin_amdgcn_readfirstlane(tid >> 6), lane = tid & 63;
    const int tok0 = tile_i * 16;
    LAS float* xs = (LAS float*)lds;
#pragma unroll
    for (int q = 0; q < 2; ++q) {
        const int tl = wid * 2 + q; const size_t tok = (size_t)tok0 + tl;
        const float* xr = X1 + tok * DM;
        f32x4 v[8]; float s = 0.f;
#pragma unroll
        for (int j = 0; j < 8; ++j) { v[j] = *(const f32x4*)(xr + (lane + 64 * j) * 4); s += v[j][0] * v[j][0] + v[j][1] * v[j][1] + v[j][2] * v[j][2] + v[j][3] * v[j][3]; }
        s = wave_sum(s);
        const float r = rsqrtf(s * (1.0f / (float)DM) + EPS);
#pragma unroll
        for (int j = 0; j < 8; ++j) { const int d = (lane + 64 * j) * 4; const f32x4 g = *(const f32x4*)(gain + d); const f32x4 o = v[j] * r * g;
            xs[tl * RT_XSTRIDE + d + 0] = o[0]; xs[tl * RT_XSTRIDE + d + 1] = o[1]; xs[tl * RT_XSTRIDE + d + 2] = o[2]; xs[tl * RT_XSTRIDE + d + 3] = o[3];
            *(unsigned*)(XN8 + tok * DM + d) = pk_fp8x4(o[0], o[1], o[2], o[3]); }
    }
    __syncthreads();
    {
        const int tl = lane & 15, kk = lane >> 4;
        f32x4 a0 = {0.f, 0.f, 0.f, 0.f}, a1 = a0;
        const LAS float* xp = xs + tl * RT_XSTRIDE + wid * 256 + kk;
        const float* wp = wr + (size_t)(wid * 256 + kk) * NE + tl;
#pragma unroll 8
        for (int ks = 0; ks < 64; ++ks) { const float a = xp[ks * 4]; const float b0 = wp[(size_t)ks * 4 * NE], b1 = wp[(size_t)ks * 4 * NE + 16];
            a0 = __builtin_amdgcn_mfma_f32_16x16x4f32(a, b0, a0, 0, 0, 0); a1 = __builtin_amdgcn_mfma_f32_16x16x4f32(a, b1, a1, 0, 0, 0); }
        LAS float* pp = (LAS float*)(lds + RT_PART) + wid * 512;
#pragma unroll
        for (int j = 0; j < 4; ++j) { pp[(kk * 4 + j) * 32 + tl] = a0[j]; pp[(kk * 4 + j) * 32 + 16 + tl] = a1[j]; }
    }
    __syncthreads();
    {   const LAS float* pp = (const LAS float*)(lds + RT_PART); float s = br[tid & 31];
#pragma unroll
        for (int w = 0; w < 8; ++w) s += pp[w * 512 + tid];
        ((LAS float*)(lds + RT_LG))[tid] = s; }
    __syncthreads();
    if (tid < 16) {
        LAS float* lg = (LAS float*)(lds + RT_LG) + tid * 32;
        int i0 = 0, i1 = 0, i2 = 0, i3 = 0; float v0, v1, v2, v3;
        { float bv = -3.0e38f; for (int j = 0; j < NE; ++j) { const float l = lg[j]; if (l > bv) { bv = l; i0 = j; } } v0 = bv; lg[i0] = -3.4e38f; }
        { float bv = -3.0e38f; for (int j = 0; j < NE; ++j) { const float l = lg[j]; if (l > bv) { bv = l; i1 = j; } } v1 = bv; lg[i1] = -3.4e38f; }
        { float bv = -3.0e38f; for (int j = 0; j < NE; ++j) { const float l = lg[j]; if (l > bv) { bv = l; i2 = j; } } v2 = bv; lg[i2] = -3.4e38f; }
        { float bv = -3.0e38f; for (int j = 0; j < NE; ++j) { const float l = lg[j]; if (l > bv) { bv = l; i3 = j; } } v3 = bv; lg[i3] = -3.4e38f; }
        const float e1 = __expf(v1 - v0), e2 = __expf(v2 - v0), e3 = __expf(v3 - v0), inv = 1.0f / (1.0f + e1 + e2 + e3);
        const int tok = tok0 + tid;
        *(int4*)(TOPI + tok * 4) = make_int4(i0, i1, i2, i3);
        *(f32x4*)(TOPG + tok * 4) = (f32x4){inv, e1 * inv, e2 * inv, e3 * inv};
        LAS int* hist = (LAS int*)(lds + RT_HIST);
        atomicAdd((int*)(hist + i0), 1); atomicAdd((int*)(hist + i1), 1); atomicAdd((int*)(hist + i2), 1); atomicAdd((int*)(hist + i3), 1);
    }
    __syncthreads();
}
__device__ __forceinline__ void combine_row(int tok, const float* __restrict__ X1, const u16* __restrict__ YB, const int* __restrict__ SOF, const float* __restrict__ TOPG, const float* __restrict__ gain, float* __restrict__ out, int lane) {
    const int4 sl = *(const int4*)(SOF + tok * 4); const f32x4 g = *(const f32x4*)(TOPG + tok * 4);
    const u16* y0 = YB + (size_t)sl.x * DM; const u16* y1 = YB + (size_t)sl.y * DM; const u16* y2 = YB + (size_t)sl.z * DM; const u16* y3 = YB + (size_t)sl.w * DM;
    f32x4 v[8]; float s = 0.f;
#pragma unroll
    for (int j = 0; j < 8; ++j) { const int d = (lane + 64 * j) * 4;
        f32x4 a = *(const f32x4*)(X1 + (size_t)tok * DM + d);
        const u32x2 q0 = *(const u32x2*)(y0 + d), q1 = *(const u32x2*)(y1 + d), q2 = *(const u32x2*)(y2 + d), q3 = *(const u32x2*)(y3 + d);
        a[0] += g[0] * bflo(q0[0]) + g[1] * bflo(q1[0]) + g[2] * bflo(q2[0]) + g[3] * bflo(q3[0]);
        a[1] += g[0] * bfhi(q0[0]) + g[1] * bfhi(q1[0]) + g[2] * bfhi(q2[0]) + g[3] * bfhi(q3[0]);
        a[2] += g[0] * bflo(q0[1]) + g[1] * bflo(q1[1]) + g[2] * bflo(q2[1]) + g[3] * bflo(q3[1]);
        a[3] += g[0] * bfhi(q0[1]) + g[1] * bfhi(q1[1]) + g[2] * bfhi(q2[1]) + g[3] * bfhi(q3[1]);
        v[j] = a; s += a[0] * a[0] + a[1] * a[1] + a[2] * a[2] + a[3] * a[3]; }
    s = wave_sum(s);
    const float r = rsqrtf(s * (1.0f / (float)DM) + EPS);
#pragma unroll
    for (int j = 0; j < 8; ++j) { const int d = (lane + 64 * j) * 4; const f32x4 gn = *(const f32x4*)(gain + d); *(f32x4*)(out + (size_t)tok * DM + d) = v[j] * r * gn; }
}

__device__ __forceinline__ void combine_row2(int tokA, int tokB, const float* __restrict__ X1, const u16* __restrict__ YB, const int* __restrict__ SOF, const float* __restrict__ TOPG, const float* __restrict__ gain, float* __restrict__ out, int lane) {
    const int4 slA = *(const int4*)(SOF + tokA * 4), slB = *(const int4*)(SOF + tokB * 4); const f32x4 gA = *(const f32x4*)(TOPG + tokA * 4), gB = *(const f32x4*)(TOPG + tokB * 4);
    const u16* yA0 = YB + (size_t)slA.x * DM; const u16* yA1 = YB + (size_t)slA.y * DM; const u16* yA2 = YB + (size_t)slA.z * DM; const u16* yA3 = YB + (size_t)slA.w * DM;
    const u16* yB0 = YB + (size_t)slB.x * DM; const u16* yB1 = YB + (size_t)slB.y * DM; const u16* yB2 = YB + (size_t)slB.z * DM; const u16* yB3 = YB + (size_t)slB.w * DM;
    f32x4 vA[8], vB[8]; float sA = 0.f, sB = 0.f;
#pragma unroll
    for (int j = 0; j < 8; ++j) { const int d = (lane + 64 * j) * 4;
        f32x4 a = *(const f32x4*)(X1 + (size_t)tokA * DM + d), b = *(const f32x4*)(X1 + (size_t)tokB * DM + d);
        const u32x2 p0 = *(const u32x2*)(yA0 + d), p1 = *(const u32x2*)(yA1 + d), p2 = *(const u32x2*)(yA2 + d), p3 = *(const u32x2*)(yA3 + d);
        const u32x2 q0 = *(const u32x2*)(yB0 + d), q1 = *(const u32x2*)(yB1 + d), q2 = *(const u32x2*)(yB2 + d), q3 = *(const u32x2*)(yB3 + d);
        a[0] += gA[0] * bflo(p0[0]) + gA[1] * bflo(p1[0]) + gA[2] * bflo(p2[0]) + gA[3] * bflo(p3[0]);
        a[1] += gA[0] * bfhi(p0[0]) + gA[1] * bfhi(p1[0]) + gA[2] * bfhi(p2[0]) + gA[3] * bfhi(p3[0]);
        a[2] += gA[0] * bflo(p0[1]) + gA[1] * bflo(p1[1]) + gA[2] * bflo(p2[1]) + gA[3] * bflo(p3[1]);
        a[3] += gA[0] * bfhi(p0[1]) + gA[1] * bfhi(p1[1]) + gA[2] * bfhi(p2[1]) + gA[3] * bfhi(p3[1]);
        b[0] += gB[0] * bflo(q0[0]) + gB[1] * bflo(q1[0]) + gB[2] * bflo(q2[0]) + gB[3] * bflo(q3[0]);
        b[1] += gB[0] * bfhi(q0[0]) + gB[1] * bfhi(q1[0]) + gB[2] * bfhi(q2[0]) + gB[3] * bfhi(q3[0]);
        b[2] += gB[0] * bflo(q0[1]) + gB[1] * bflo(q1[1]) + gB[2] * bflo(q2[1]) + gB[3] * bflo(q3[1]);
        b[3] += gB[0] * bfhi(q0[1]) + gB[1] * bfhi(q1[1]) + gB[2] * bfhi(q2[1]) + gB[3] * bfhi(q3[1]);
        vA[j] = a; vB[j] = b; sA += a[0] * a[0] + a[1] * a[1] + a[2] * a[2] + a[3] * a[3]; sB += b[0] * b[0] + b[1] * b[1] + b[2] * b[2] + b[3] * b[3]; }
    sA = wave_sum(sA); sB = wave_sum(sB);
    const float rA = rsqrtf(sA * (1.0f / (float)DM) + EPS), rB = rsqrtf(sB * (1.0f / (float)DM) + EPS);
#pragma unroll
    for (int j = 0; j < 8; ++j) { const int d = (lane + 64 * j) * 4; const f32x4 gn = *(const f32x4*)(gain + d);
        *(f32x4*)(out + (size_t)tokA * DM + d) = vA[j] * rA * gn; *(f32x4*)(out + (size_t)tokB * DM + d) = vB[j] * rB * gn; }
}
#ifndef REP_P9
#define REP_P9 1
#endif
#ifndef REP_P3
#define REP_P3 1
#endif
#ifndef REP_FR
#define REP_FR 1
#endif
#ifndef REP_P0
#define REP_P0 1
#endif
#ifndef REP_CONV
#define REP_CONV 1
#endif
#ifndef REP_GEMM1
#define REP_GEMM1 1
#endif
#ifndef REP_HY
#define REP_HY 1
#endif
#ifndef REP_HG
#define REP_HG 1
#endif
#ifndef REP_MOEA
#define REP_MOEA 1
#endif
#ifndef REP_MOEB
#define REP_MOEB 1
#endif
#ifndef REP_WOUT
#define REP_WOUT 1
#endif
struct MegaP {
    const float *x, *norm_mix_gain, *w_in, *lb_logits, *hgrn_norm_gain, *hy_conv_w, *hy_conv_b, *fw1, *fb1, *fw2, *fb2, *fw3, *fb3, *fw4, *ffreq, *hy_bias, *hy_norm_gain, *w_out,
        *norm_ffn_gain, *w_router, *b_router, *moe_w1, *moe_b1, *moe_w2, *moe_b2, *final_gain;
    float* out; unsigned char* ws;
};
constexpr int MEGA_XB = RT_END;
constexpr int MEGA_LDS = RT_END + 64 + 384;
static_assert(MEGA_LDS >= HY_LDS + 64 && MEGA_LDS >= HG_LDS + 64 && MEGA_LDS >= GEMM_LDS + 64, "LDS");

__global__ void __launch_bounds__(512, 2) k_mega(const MegaP p_arg) {
    extern __shared__ __attribute__((aligned(16))) unsigned char shm[];
    LAS unsigned char* lds = (LAS unsigned char*)shm;
    const int tid = threadIdx.x, wid = __builtin_amdgcn_readfirstlane(tid >> 6), lane = tid & 63;
    const int G = gridDim.x, bid = blockIdx.x, c = xcd_logical(bid, G);
#define PHASE_ARGS() const MegaP __attribute__((address_space(4)))* pq_ = (const MegaP __attribute__((address_space(4)))*)__builtin_amdgcn_kernarg_segment_ptr(); asm volatile("" : "+s"(pq_)); unsigned char* ws = pq_->ws; (void)ws
    unsigned char* ws0; { PHASE_ARGS(); ws0 = ws; }
#define counts ((int*)(ws + WS_CTL))
#define cursor ((int*)(ws + WS_CTL + 4096))
#define offs ((int*)(ws + WS_CTL + 8192))
#define barw ((unsigned*)(ws + WS_CTL + 16384))
#define HB ((u16*)(ws + WS_HB))
#define PG ((u16*)(ws + WS_PG))
#define HYT ((u16*)(ws + WS_HYT))
#define MIXB ((u16*)(ws + WS_MIXB))
#define XNB ((u16*)(ws + WS_XNB))
#define HMB ((u16*)(ws + WS_HMB))
#define YB ((u16*)(ws + WS_YB))
#define H3 ((float*)(ws + WS_H3))
#define FR ((u16*)(ws + WS_FR))
#define Z2T ((u16*)(ws + WS_Z2T))
#define OF ((float*)(ws + WS_OF))
#define OB ((float*)(ws + WS_OB))
#define X1 ((float*)(ws + WS_X1))
#define TOPI ((int*)(ws + WS_TOPI))
#define TOPG ((float*)(ws + WS_TOPG))
#define STOK ((int*)(ws + WS_STOK))
#define SOF ((int*)(ws + WS_SOF))
#define WINT ((u16*)(ws + WS_WINT))
#define WOUTT ((u16*)(ws + WS_WOUTT))
#define W1T ((u16*)(ws + WS_W1T))
#define W2T ((u16*)(ws + WS_W2T))
    if (tid == 0) *(LAS u32x4*)(lds + MEGA_XB) = (u32x4){0u, 0u, 0u, 0u};
    __syncthreads();
    XcdBarrier bar = xcd_barrier_post((unsigned*)(ws0 + WS_CTL + 16384), (volatile LAS unsigned*)(lds + MEGA_XB));

    {
        PHASE_ARGS();
    for (int rep = 0; rep < REP_P0; ++rep) {
    for (int row = bid * 8 + wid; row < NTOK; row += G * 8) rmsnorm_row_bf(pq_->x + (size_t)row * DM, pq_->norm_mix_gain, HB + (size_t)row * DM, lane);
    for (int m = bid * 8 + wid; m < SEQ; m += G * 8) h3_row(m, pq_->fw1, pq_->fb1, pq_->fw2, pq_->fb2, pq_->fw3, pq_->fb3, pq_->ffreq, (LAS float*)(lds + wid * 512), H3); }
    for (int rep = 0; rep < REP_CONV; ++rep)
    for (int id = bid; id < 1024 + 256; id += G) {
        const int tz = tid_fresh();
        if (id < 1024) { const int nt = id >> 5, kt = id & 31; convert_tile(pq_->w_in, DIN, kt * 64, ColMapPerm{nt * 256}, WINT + (size_t)id * 16384, tz); }
        else { const int q = id - 1024; const ConvCtx cw{nullptr, pq_->w_out, nullptr, (unsigned char*)WOUTT};
            f32x2 cv[16]; conv_issue(cw, 16384 + q, tz >> 6, tz & 63, cv); conv_finish(cw, 16384 + q, tz >> 6, tz & 63, cv); }
    }
    }
    xcd_barrier(bar);
    {
        PHASE_ARGS();
    for (int rep = 0; rep < REP_FR; ++rep)
    for (int item = bid; item < 256; item += G) frgen_item(lds, item, H3, pq_->fw4, FR);
    { SrcG1<false> s0{c, G, (const char*)HB, (const char*)WINT, PG, HYT}; gemm8_stream<false, false>(lds, DM, 32, s0);
      SrcG1<true> s1{c, G, (const char*)HB, (const char*)WINT, PG, HYT}; gemm8_stream<true, false>(lds, DM, 32, s1); }
#ifdef PROBE_NOEPI
    for (int u = c; u < 1024; u += G) {
        const int i = u >> 8, xx = (u >> 5) & 7, j = u & 31;
        const int mt = (xx & 3) * 8 + (j & 7), nt = ((xx >> 2) + 2 * i) * 4 + (j >> 3);
        const u16* bt = WINT + (size_t)nt * 32 * 16384;
        EpiNone e{}; if (nt < 20) gemm8_unit<false>(lds, HB, DM, nullptr, mt * 256, 256, bt, 32, e); else gemm8_unit<true>(lds, HB, DM, nullptr, mt * 256, 256, bt, 32, e);
    }
#endif
    }
    xcd_barrier(bar);
    {
        PHASE_ARGS();
    for (int rep = 0; rep < REP_HY; ++rep)
    for (int u = bid; u < 256; u += G) hyena_unit(lds, u, HYT, FR, pq_->hy_conv_w, pq_->hy_conv_b, pq_->hy_bias, Z2T, ConvCtx{pq_->moe_w1, pq_->moe_w2, (unsigned char*)W1T, (unsigned char*)W2T});
    for (int rep = 0; rep < REP_HG; ++rep)
    for (int u = bid; u < 256; u += G) hgrn_unit(lds, u, PG, pq_->lb_logits, OF, OB, ConvCtx{pq_->moe_w1, pq_->moe_w2, (unsigned char*)W1T, (unsigned char*)W2T});
    }
    xcd_barrier(bar);
    {
        PHASE_ARGS();
    for (int rep = 0; rep < REP_P3; ++rep) {
    for (int it = bid * 8 + wid; it < NTOK * HGH; it += G * 8 * 4) hgrn_final_item4(it, G * 8, OF, OB, PG, pq_->hgrn_norm_gain, MIXB, lane);
    for (int t = bid; t < NTOK / 32; t += G) hy_norm_tile(lds, t, Z2T, pq_->hy_norm_gain, MIXB); }
    }
    xcd_barrier(bar);
    {
        PHASE_ARGS();
    for (int u = c; u < 256; u += G) {
        const int xx = u >> 5, j = u & 31;
        const int mt = (xx >> 1) * 8 + (j & 7), nt = (xx & 1) * 4 + (j >> 3);
        Epi8X1 e{pq_->x, X1, mt * 256, nt * 256};
        gemm8_unit<false, true>(lds, MIXB, DM / 2, nullptr, mt * 256, 256, WOUTT + (size_t)nt * 16 * 16384, 16, e);
    }
    }
    xcd_barrier(bar);
    {
        PHASE_ARGS();
    if (tid < NE) *(LAS int*)(lds + RT_HIST + tid * 4) = 0;
    __syncthreads();
    for (int t = bid; t < NTOK / 16; t += G) router_tile(lds, t, X1, pq_->norm_ffn_gain, pq_->w_router, pq_->b_router, (unsigned char*)XNB, TOPI, TOPG, counts);
    if (tid < NE) { const int hcount = *(const LAS int*)(lds + RT_HIST + tid * 4); if (hcount) atomicAdd(&counts[tid * 32], hcount); }
    }
    xcd_barrier(bar);
    {
        PHASE_ARGS();
    {
        LAS int* so = (LAS int*)lds;
        LAS int* lh = (LAS int*)(lds + 256);
        LAS int* lb2 = (LAS int*)(lds + 512);
        if (tid == 0) { int a = 0; for (int e = 0; e < NE; ++e) { so[e] = a; a += __hip_atomic_load(&counts[e * 32], __ATOMIC_RELAXED, __HIP_MEMORY_SCOPE_AGENT); } so[NE] = a; }
        if (tid < NE) lh[tid] = 0;
        __syncthreads();
        if (bid == 0 && tid <= NE) offs[tid] = so[tid];
        for (int i0 = bid * 512; i0 < NSLOT; i0 += G * 512) {
            const int i = i0 + tid; const int e = TOPI[i];
            const int lpos = atomicAdd((int*)(lh + e), 1);
            __syncthreads();
            if (tid < NE) { const int n = lh[tid]; lb2[tid] = so[tid] + (n ? atomicAdd(&cursor[tid * 32], n) : 0); }
            __syncthreads();
            const int slot = lb2[e] + lpos; STOK[slot] = i >> 2; SOF[i] = slot;
            __syncthreads();
            if (tid < NE) lh[tid] = 0;
            __syncthreads();
        }
    }
    }
    xcd_barrier(bar);
    {
        PHASE_ARGS();
    {
        LAS int* us = (LAS int*)(lds + MEGA_XB + 64); LAS int* so2 = us + 40;
        if (tid == 0) { int a = 0; for (int e = 0; e < NE; ++e) { us[e] = a; a += ((offs[e + 1] - offs[e] + 255) >> 8) * 16; } us[NE] = a; }
        if (tid <= NE) so2[tid] = offs[tid];
        __syncthreads();
    }
    {
        LAS int* qs = (LAS int*)(lds + MEGA_XB + 32); LAS int* us = (LAS int*)(lds + MEGA_XB + 64); LAS int* so2 = us + 40;
        int* qctr = (int*)(ws + WS_CTL + 12288 + (bid & 7) * 128);
        int tk_next = 0;
        if (tid == 0) tk_next = atomicAdd(qctr, 1);
        for (;;) {
            if (tid == 0) { qs[0] = tk_next; qs[1] = -1; }
            __syncthreads();
            const int tk = qs[0];
            const int u = 256 * (tk >> 5) + 32 * (bid & 7) + (tk & 31);
            if (tid < NE) { const int u0 = us[tid], u1 = us[tid + 1]; if (u >= u0 && u < u1) { const int o0 = so2[tid], cnt = so2[tid + 1] - o0, mtl = (cnt + 255) >> 8, ul = u - u0, mt = ul % mtl;
                int rows = cnt - mt * 256; rows = rows > 256 ? 256 : rows; qs[1] = tid; qs[2] = ul / mtl; qs[3] = o0 + mt * 256; qs[4] = rows; } }
            __syncthreads();
            const int e = qs[1], nt = qs[2], slot0 = qs[3], rows = qs[4];
            __syncthreads();
            if (e < 0) break;
            if (tid == 0) tk_next = atomicAdd(qctr, 1);
            Epi8Swiglu8 ep{(unsigned char*)HMB, pq_->moe_b1 + (size_t)e * 2 * DFF, slot0, nt, rows};
            gemm8_unit<false, true>(lds, XNB, DM / 2, STOK + slot0, 0, rows, W1T + (size_t)(e * 16 + nt) * 16 * 16384, 16, ep);
        }
    }
    }
    xcd_barrier(bar);
    {
        PHASE_ARGS();
    {
        LAS int* us = (LAS int*)(lds + MEGA_XB + 64); LAS int* so2 = us + 40;
        if (tid == 0) { int a = 0; for (int e = 0; e < NE; ++e) { us[e] = a; a += ((offs[e + 1] - offs[e] + 255) >> 8) * 8; } us[NE] = a; }
        if (tid <= NE) so2[tid] = offs[tid];
        __syncthreads();
    }
    {
        const LAS int* us = (const LAS int*)(lds + MEGA_XB + 64); const LAS int* so2 = us + 40;
        SrcMoeB src{us, so2, c, G, (const char*)HMB, (const char*)W2T, YB, pq_->moe_b2};
        gemm8_stream<false, true>(lds, DFF / 2, 16, src);
    }
    }
    xcd_barrier(bar);
    {
        PHASE_ARGS();
    for (int rep = 0; rep < REP_P9; ++rep)
    for (int tok = bid * 8 + wid; tok < NTOK; tok += G * 8) combine_row(tok, X1, YB, SOF, TOPG, pq_->final_gain, pq_->out, lane);
    }
}
#undef counts
#undef cursor
#undef offs
#undef barw
#undef HB
#undef PG
#undef HYT
#undef MIXB
#undef XNB
#undef HMB
#undef YB
#undef H3
#undef FR
#undef Z2T
#undef OF
#undef OB
#undef X1
#undef TOPI
#undef TOPG
#undef STOK
#undef SOF
#undef WINT
#undef WOUTT
#undef W1T
#undef W2T

extern "C" void kernel_launch(void* const* d_in, const int* in_sizes, int n_in, void* d_out, int out_size, void* d_ws, size_t ws_size, hipStream_t stream) {
    if (n_in < 26 || ws_size < WS_END2) return;
    MegaP p{};
    const float** pp = (const float**)&p;
    for (int i = 0; i < 26; ++i) pp[i] = (const float*)d_in[i];
    p.out = (float*)d_out; p.ws = (unsigned char*)d_ws;
    static int grid = 0;
    if (!grid) {
        int dev = 0, cus = 0, per_cu = 0;
        (void)hipGetDevice(&dev);
        (void)hipDeviceGetAttribute(&cus, hipDeviceAttributeMultiprocessorCount, dev);
        (void)hipFuncSetAttribute((const void*)k_mega, hipFuncAttributeMaxDynamicSharedMemorySize, MEGA_LDS);
        (void)hipOccupancyMaxActiveBlocksPerMultiprocessor(&per_cu, (const void*)k_mega, 512, MEGA_LDS);
        if (per_cu < 1) per_cu = 1;
        grid = cus * 1;
        if (grid > 256) grid = 256;
        grid &= ~7;
        if (grid < 8) grid = 8;
    }
    (void)hipMemsetAsync((char*)d_ws + WS_CTL, 0, 65536, stream);
    hipLaunchKernelGGL(k_mega, dim3(grid), dim3(512), MEGA_LDS, stream, p);
}
```

```cpp
#include <hip/hip_runtime.h>
#include <stdint.h>

constexpr int BATCH = 4, SEQ = 2048, DM = 2048, NTOK = BATCH * SEQ;
constexpr int HGW = 1024, HGD = 128, HGH = 8;
constexpr int HYW = 1024;
constexpr int DIN = 8192;
constexpr int NE = 32, TOPK = 4, DFF = 2048;
constexpr int NSLOT = NTOK * TOPK;
constexpr float EPS = 1e-5f;

constexpr size_t MB = 1024ull * 1024ull;
constexpr size_t WS_CTL = 0;
constexpr size_t WS_HB = 1 * MB;
constexpr size_t WS_PG = WS_HB + 32 * MB;
constexpr size_t WS_HYT = WS_PG + 80 * MB;
constexpr size_t WS_MIXB = WS_HYT + 48 * MB;
constexpr size_t WS_XNB = WS_MIXB + 32 * MB;
constexpr size_t WS_HMB = WS_XNB + 32 * MB;
constexpr size_t WS_YB = WS_HMB + 128 * MB;
constexpr size_t WS_H3 = WS_YB + 128 * MB;
constexpr size_t WS_FR = WS_H3 + 1 * MB;
constexpr size_t WS_Z2T = WS_FR + 34 * MB;
constexpr size_t WS_OF = WS_Z2T + 16 * MB;
constexpr size_t WS_OB = WS_OF + 32 * MB;
constexpr size_t WS_X1 = WS_OB + 32 * MB;
constexpr size_t WS_TOPI = WS_X1 + 64 * MB;
constexpr size_t WS_TOPG = WS_TOPI + 1 * MB;
constexpr size_t WS_STOK = WS_TOPG + 1 * MB;
constexpr size_t WS_SOF = WS_STOK + 1 * MB;
constexpr size_t WS_WINT = WS_SOF + 1 * MB;
constexpr size_t WS_WOUTT = WS_WINT + 32 * MB;
constexpr size_t WS_W1T = WS_WOUTT + 8 * MB;
constexpr size_t WS_W2T = WS_W1T + 512 * MB;
constexpr size_t WS_HMS = WS_W2T + 256 * MB;
constexpr size_t WS_YS = WS_HMS + 512 * MB;
constexpr size_t WS_STOKS = WS_YS + 1024 * MB;
constexpr size_t WS_END2 = WS_STOKS + 1 * MB;

typedef short bf16x8 __attribute__((ext_vector_type(8)));
typedef float f32x4 __attribute__((ext_vector_type(4)));
typedef float f32x2 __attribute__((ext_vector_type(2)));
typedef unsigned u32x4 __attribute__((ext_vector_type(4)));
typedef unsigned u32x2 __attribute__((ext_vector_type(2)));
typedef unsigned short u16;
#define LAS __attribute__((address_space(3)))

__device__ __forceinline__ unsigned pk_bf16(float lo, float hi) {
    typedef __bf16 bf2 __attribute__((ext_vector_type(2)));
    const f32x2 v = {lo, hi};
    const bf2 r = __builtin_convertvector(v, bf2);
    return __builtin_bit_cast(unsigned, r);
}
__device__ __forceinline__ float bf2f(u16 b) { return __uint_as_float(((unsigned)b) << 16); }
__device__ __forceinline__ float bflo(unsigned w) { return __uint_as_float(w << 16); }
__device__ __forceinline__ float bfhi(unsigned w) { return __uint_as_float(w & 0xffff0000u); }

__device__ __forceinline__ int lds_byte(int r, int c) { const int st = (r >> 4) * 2 + (c >> 5), ob = (r & 15) * 64 + (c & 31) * 2; return st * 1024 + (ob ^ (((ob >> 9) & 1) << 5)); }
__device__ __forceinline__ void stage_rc(int b, int& R, int& C) { const int st = b >> 10, sb = b & 1023, swz = sb ^ (((sb >> 9) & 1) << 5); R = (st >> 1) * 16 + swz / 64; C = (st & 1) * 32 + (swz % 64) / 2; }
__device__ __forceinline__ f32x4 unperm(const f32x4 a, const bool s) { f32x4 o; o[0] = s ? a[1] : a[0]; o[1] = s ? a[0] : a[1]; o[2] = s ? a[3] : a[2]; o[3] = s ? a[2] : a[3]; return o; }

__device__ __forceinline__ int tid_fresh() { int t = threadIdx.x; asm volatile("" : "+v"(t)); return t; }
constexpr int GEMM_LDS = 131072;

template <bool TRANS, bool RAGGED, int PM = 0, class ColMap, class Epi>
__device__ __forceinline__ void gemm_unit(LAS unsigned char* lds, const u16* __restrict__ A, int lda, const int* __restrict__ arows, int arow0, int rows_valid,
                                          const float* __restrict__ B, int ldb, int K, const ColMap colmap, const Epi epi) {
    const int tid = tid_fresh(), wid = __builtin_amdgcn_readfirstlane(tid >> 6), lane = tid & 63;
    const int wr = wid >> 2, wc = wid & 3, fr = lane & 15, fq = lane >> 4;
    const int nt = K >> 6;
    const char* ap[4];
#pragma unroll
    for (int i = 0; i < 4; ++i) {
        int R, C; stage_rc(wid * 1024 + i * 8192 + lane * 16, R, C);
        const int rr = RAGGED ? (R < rows_valid ? R : rows_valid - 1) : R;
        const long rowid = arows ? (long)arows[rr] : (long)(arow0 + rr);
        ap[i] = (const char*)A + ((size_t)rowid * lda + C) * 2;
    }
    const int g = (lane & 3) + 4 * (wid >> 2), rg = (wid & 3) * 16 + (lane >> 2);
    const unsigned bvoff = (unsigned)(((size_t)(8 * g) * ldb + colmap(rg)) * 4);
    const int bbase = 65536 + lds_byte(4 * rg, 8 * g);
    const int bw0 = bbase + ((rg & 1) ? 64 : 0), bw1 = bbase + ((rg & 1) ? 0 : 64);
    const int aoff = lds_byte(wr * 128 + fr, fq * 8), boff = 65536 + lds_byte(wc * 64 + fr, fq * 8);
    int mvalid = 8;
    if (RAGGED) { mvalid = (rows_valid - wr * 128 + 15) >> 4; mvalid = mvalid < 0 ? 0 : (mvalid > 8 ? 8 : mvalid); }
    f32x4 vb0, vb1, vb2, vb3, vb4, vb5, vb6, vb7;
    if (PM & 1) { vb0 = (f32x4){1.f, 1.f, 1.f, 1.f}; vb1 = vb0; vb2 = vb0; vb3 = vb0; vb4 = vb0; vb5 = vb0; vb6 = vb0; vb7 = vb0; }
    f32x4 acc[8][4];
#pragma unroll
    for (int m = 0; m < 8; ++m)
#pragma unroll
        for (int n = 0; n < 4; ++n) acc[m][n] = (f32x4){0.f, 0.f, 0.f, 0.f};
    const size_t ldb4 = (size_t)ldb * 4;
#define GE_GLDS_A(buf, kt) do { if (!(PM & 2)) _Pragma("unroll") for (int _i = 0; _i < 4; ++_i) \
        __builtin_amdgcn_global_load_lds((const unsigned*)(ap[_i] + (size_t)(kt) * 128), (LAS unsigned*)(lds + (buf) * 32768 + wid * 1024 + _i * 8192), 16, 0, 0); } while (0)
#define GE_LD1(dst, sb) if (!(PM & 1)) asm volatile("global_load_dwordx4 %0, %1, %2" : "=v"(dst) : "v"(bvoff), "s"(sb) : "memory")
#define GE_LOAD_B(kt) do { const char* _sb = (const char*)B + (size_t)(kt) * 64 * ldb4; \
        GE_LD1(vb0, _sb); GE_LD1(vb1, _sb + ldb4); GE_LD1(vb2, _sb + 2 * ldb4); GE_LD1(vb3, _sb + 3 * ldb4); \
        GE_LD1(vb4, _sb + 4 * ldb4); GE_LD1(vb5, _sb + 5 * ldb4); GE_LD1(vb6, _sb + 6 * ldb4); GE_LD1(vb7, _sb + 7 * ldb4); } while (0)
#define GE_WAITV_B(n) asm volatile("s_waitcnt vmcnt(" #n ")" : "+v"(vb0), "+v"(vb1), "+v"(vb2), "+v"(vb3), "+v"(vb4), "+v"(vb5), "+v"(vb6), "+v"(vb7) :: "memory")
#define GE_WRITE_B(buf) do { _Pragma("unroll") for (int _i = 0; _i < 4; ++_i) { u32x4 _w; _w[0] = pk_bf16(vb0[_i], vb1[_i]); _w[1] = pk_bf16(vb2[_i], vb3[_i]); \
        _w[2] = pk_bf16(vb4[_i], vb5[_i]); _w[3] = pk_bf16(vb6[_i], vb7[_i]); \
        *(LAS u32x4*)(lds + ((_i & 1) ? bw1 : bw0) + (_i >> 1) * 128 + (buf) * 32768) = _w; } } while (0)
#define GE_KSTEP(buf, ks) do { bf16x8 Bf[4]; \
        _Pragma("unroll") for (int n = 0; n < 4; ++n) Bf[n] = *(const LAS bf16x8*)(lds + (buf) * 32768 + boff + n * 2048 + (ks) * 1024); \
        _Pragma("unroll") for (int mh = 0; mh < 2; ++mh) { bf16x8 At[4]; \
            _Pragma("unroll") for (int m = 0; m < 4; ++m) At[m] = *(const LAS bf16x8*)(lds + (buf) * 32768 + aoff + (mh * 4 + m) * 2048 + (ks) * 1024); \
            _Pragma("unroll") for (int m = 0; m < 4; ++m) { if (!RAGGED || (mh * 4 + m) < mvalid) { _Pragma("unroll") for (int n = 0; n < 4; ++n) \
                { if (PM & 4) { asm volatile("" :: "v"(At[m]), "v"(Bf[n])); } else acc[mh * 4 + m][n] = TRANS ? __builtin_amdgcn_mfma_f32_16x16x32_bf16(At[m], Bf[n], acc[mh * 4 + m][n], 0, 0, 0) : __builtin_amdgcn_mfma_f32_16x16x32_bf16(Bf[n], At[m], acc[mh * 4 + m][n], 0, 0, 0); } } } } } while (0)
    GE_GLDS_A(0, 0);
    GE_LOAD_B(0);
    GE_WAITV_B(0);
    GE_WRITE_B(0);
    GE_LOAD_B(1);
    asm volatile("s_waitcnt lgkmcnt(0)" ::: "memory");
    __builtin_amdgcn_s_barrier();
    int t = 0;
    for (; t < nt - 2; ++t) {
        const int cur = t & 1;
        GE_GLDS_A(cur ^ 1, t + 1);
        GE_KSTEP(cur, 0);
        GE_WAITV_B(4);
        GE_WRITE_B(cur ^ 1);
        GE_LOAD_B(t + 2);
        __builtin_amdgcn_sched_barrier(0);
        GE_KSTEP(cur, 1);
        asm volatile("s_waitcnt vmcnt(8) lgkmcnt(0)" ::: "memory");
        __builtin_amdgcn_s_barrier();
    }
    {
        const int cur = t & 1;
        GE_GLDS_A(cur ^ 1, t + 1);
        GE_KSTEP(cur, 0);
        GE_WAITV_B(4);
        GE_WRITE_B(cur ^ 1);
        GE_KSTEP(cur, 1);
        asm volatile("s_waitcnt vmcnt(0) lgkmcnt(0)" ::: "memory");
        __builtin_amdgcn_s_barrier();
        ++t;
    }
    {
        const int cur = t & 1;
        GE_KSTEP(cur, 0);
        GE_KSTEP(cur, 1);
        asm volatile("s_waitcnt lgkmcnt(0)" ::: "memory");
        __builtin_amdgcn_s_barrier();
    }
#undef GE_GLDS_A
#undef GE_LD1
#undef GE_LOAD_B
#undef GE_WAITV_B
#undef GE_WRITE_B
#undef GE_KSTEP
    __builtin_amdgcn_sched_barrier(0);
    { const int tz = tid_fresh(), wz = __builtin_amdgcn_readfirstlane(tz >> 6), lz = tz & 63;
      epi(acc, wz >> 2, wz & 3, lz & 15, lz >> 4); }
}

__device__ __forceinline__ int xcd_logical(int b, int G) { return (G & 7) ? b : (b & 7) * (G >> 3) + (b >> 3); }

struct ColMapDense { int c0; __device__ __forceinline__ int operator()(int rg) const { return c0 + 4 * rg; } };
struct EpiPG { u16* PG; int tok0, col0;
    __device__ __forceinline__ void operator()(const f32x4 (&acc)[8][4], int wr, int wc, int fr, int fq) const {
#pragma unroll
        for (int m = 0; m < 8; ++m) { u16* rowp = PG + (size_t)(tok0 + wr * 128 + m * 16 + fr) * 5120 + col0 + wc * 64 + 4 * fq;
#pragma unroll
            for (int n = 0; n < 4; ++n) { const f32x4 v = unperm(acc[m][n], fq & 1); u32x2 w; w[0] = pk_bf16(v[0], v[1]); w[1] = pk_bf16(v[2], v[3]); *(u32x2*)(rowp + n * 16) = w; } }
    } };
struct EpiHYT { u16* HYT; int tok0, col0;
    __device__ __forceinline__ void operator()(const f32x4 (&acc)[8][4], int wr, int wc, int fr, int fq) const {
#pragma unroll
        for (int n = 0; n < 4; ++n) { const int rho = wc * 64 + n * 16 + fr; const int col = col0 + (rho & ~3) + ((rho & 3) ^ ((rho >> 2) & 1));
            u16* colp = HYT + (size_t)col * NTOK + tok0 + wr * 128 + 4 * fq;
#pragma unroll
            for (int m = 0; m < 8; ++m) { const f32x4 v = acc[m][n]; u32x2 w; w[0] = pk_bf16(v[0], v[1]); w[1] = pk_bf16(v[2], v[3]); *(u32x2*)(colp + m * 16) = w; } }
    } };
struct EpiX1 { const float* x; float* X1; int tok0, col0;
    __device__ __forceinline__ void operator()(const f32x4 (&acc)[8][4], int wr, int wc, int fr, int fq) const {
#pragma unroll
        for (int m = 0; m < 8; ++m) { const size_t off = (size_t)(tok0 + wr * 128 + m * 16 + fr) * DM + col0 + wc * 64 + 4 * fq;
#pragma unroll
            for (int n = 0; n < 4; ++n) { const f32x4 r = *(const f32x4*)(x + off + n * 16); *(f32x4*)(X1 + off + n * 16) = r + unperm(acc[m][n], fq & 1); }
            asm volatile("" ::: "memory"); }
    } };
struct ColMapGlu { int nt; __device__ __forceinline__ int operator()(int rg) const { const int wcq = rg >> 4, n = (rg >> 2) & 3, f = rg & 3; return (n >> 1) * 2048 + nt * 128 + wcq * 32 + (n & 1) * 16 + f * 4; } };
struct EpiSwiglu { u16* HM; const float* b1; int slot0, nt, rows_valid;
    __device__ __forceinline__ void operator()(const f32x4 (&acc)[8][4], int wr, int wc, int fr, int fq) const {
        f32x4 bg[2], bl[2];
#pragma unroll
        for (int nn = 0; nn < 2; ++nn) { const int col = nt * 128 + wc * 32 + nn * 16 + 4 * fq; bg[nn] = *(const f32x4*)(b1 + col); bl[nn] = *(const f32x4*)(b1 + 2048 + col); }
#pragma unroll
        for (int m = 0; m < 8; ++m) { const int row = wr * 128 + m * 16 + fr;
            if (row < rows_valid) {
#pragma unroll
                for (int nn = 0; nn < 2; ++nn) { const f32x4 gl = unperm(acc[m][nn], fq & 1) + bg[nn], li = unperm(acc[m][nn + 2], fq & 1) + bl[nn]; float o[4];
#pragma unroll
                    for (int j = 0; j < 4; ++j) { const float gq = fminf(gl[j], 7.0f), lq = fminf(fmaxf(li[j], -7.0f), 7.0f); o[j] = gq * (1.0f / (1.0f + __expf(-1.702f * gq))) * (lq + 1.0f); }
                    u32x2 w; w[0] = pk_bf16(o[0], o[1]); w[1] = pk_bf16(o[2], o[3]);
                    *(u32x2*)(HM + (size_t)(slot0 + row) * DFF + nt * 128 + wc * 32 + nn * 16 + 4 * fq) = w; } } }
    } };
struct EpiY { u16* Y; const float* b2; int slot0, col0, rows_valid;
    __device__ __forceinline__ void operator()(const f32x4 (&acc)[8][4], int wr, int wc, int fr, int fq) const {
        f32x4 bv[4];
#pragma unroll
        for (int n = 0; n < 4; ++n) bv[n] = *(const f32x4*)(b2 + col0 + wc * 64 + n * 16 + 4 * fq);
#pragma unroll
        for (int m = 0; m < 8; ++m) { const int row = wr * 128 + m * 16 + fr;
            if (row < rows_valid) { u16* rowp = Y + (size_t)(slot0 + row) * DM + col0 + wc * 64 + 4 * fq;
#pragma unroll
                for (int n = 0; n < 4; ++n) { const f32x4 v = unperm(acc[m][n], fq & 1) + bv[n]; u32x2 w; w[0] = pk_bf16(v[0], v[1]); w[1] = pk_bf16(v[2], v[3]); *(u32x2*)(rowp + n * 16) = w; } } }
    } };
template <int NTILES>
__device__ __forceinline__ bool moe_decode(const int* __restrict__ offs, int u, int& e, int& mt, int& nt, int& slot0, int& rows) {
    int base = 0;
    for (int q = 0; q < NE; ++q) { const int o0 = offs[q], cnt = offs[q + 1] - o0, mtl = (cnt + 255) >> 8, nu = mtl * NTILES;
        if (u < base + nu) { const int ul = u - base; e = q; mt = ul % mtl; nt = ul / mtl; slot0 = o0 + mt * 256; rows = cnt - mt * 256; if (rows > 256) rows = 256; return true; }
        base += nu; }
    return false;
}


__device__ __forceinline__ int perm_col4(int rg) { const int rgl = rg & 31, t = rgl & 7; return 32 * (rgl >> 3) + 8 * (t & 3) + 4 * (t >> 2); }
__device__ __forceinline__ int perm32(int rho) { const int n = rho >> 4, i = rho & 15; return 8 * (i >> 2) + 4 * n + (i & 3); }
template <class ColMap>
__device__ __forceinline__ void convert_tile(const float* __restrict__ W, int ldb, int k0, const ColMap colmap, u16* __restrict__ dst, int tid) {
    const int wid = tid >> 6, lane = tid & 63;
    const int g = (lane & 3) + 4 * (wid >> 2), rg = (wid & 3) * 16 + (lane >> 2);
    const float* bp = W + (size_t)(k0 + 8 * g) * ldb + colmap(rg);
    f32x4 v[8];
#pragma unroll
    for (int kk = 0; kk < 8; ++kk) v[kk] = __builtin_nontemporal_load((const f32x4*)(bp + (size_t)kk * ldb));
    const int h = rg >> 5, r0 = (4 * rg) & 127;
    unsigned char* base = (unsigned char*)dst + h * 16384 + lds_byte(r0, 8 * g);
#pragma unroll
    for (int i = 0; i < 4; ++i) { u32x4 w; w[0] = pk_bf16(v[0][i], v[1][i]); w[1] = pk_bf16(v[2][i], v[3][i]); w[2] = pk_bf16(v[4][i], v[5][i]); w[3] = pk_bf16(v[6][i], v[7][i]);
        *(u32x4*)(base + i * 64) = w; }
}
typedef int i32x8 __attribute__((ext_vector_type(8)));
typedef int i32x4 __attribute__((ext_vector_type(4)));
constexpr float W8_SCALE = 32.0f;
constexpr int W8_MX = 0x7A7A7A7A;
constexpr int A8_MX = 0x7F7F7F7F;
__device__ __forceinline__ unsigned pk_fp8x4(float a, float b, float c, float d) { int p = __builtin_amdgcn_cvt_pk_fp8_f32(a, b, 0, false); p = __builtin_amdgcn_cvt_pk_fp8_f32(c, d, p, true); return (unsigned)p; }
__device__ __forceinline__ int lds_byte_b(int r, int cb) { const int st = (r >> 4) * 2 + (cb >> 6), ob = (r & 15) * 64 + (cb & 63); return st * 1024 + (ob ^ (((ob >> 9) & 1) << 5)); }
struct ConvCtx { const float* w1; const float* w2; unsigned char* W1T; unsigned char* W2T; };
__device__ __forceinline__ int conv_seq2tile(int s) {
    if (s < 16384) return (s >> 9) * 512 + (s & 15) * 32 + ((s >> 4) & 31);
    const int q = s - 16384; return 16384 + (q >> 8) * 256 + (q & 7) * 32 + ((q >> 3) & 31);
}
__device__ __forceinline__ void conv_issue(const ConvCtx& cc, int m, int wid, int lane, f32x2 (&v)[16]) {
    const int rp = 16 * wid + (lane & 15), rg = rp >> 1, p2 = (rp & 1) * 2, kg = lane >> 4;
    const float* bp; size_t ld;
    if (m < 16384) { const int e = m >> 9, nt = (m >> 5) & 15, kt = m & 31; ld = 2 * DFF; bp = cc.w1 + (size_t)e * DM * 2 * DFF + (size_t)(kt * 64 + 16 * kg) * ld + (rg >> 5) * 2048 + nt * 128 + perm_col4(rg) + p2; }
    else { const int q = m - 16384, e = q >> 8, nt = (q >> 5) & 7, kt = q & 31; ld = DM; bp = cc.w2 + (size_t)e * DFF * DM + (size_t)(kt * 64 + 16 * kg) * ld + nt * 256 + (rg >> 5) * 128 + perm_col4(rg) + p2; }
#pragma unroll
    for (int kk = 0; kk < 16; ++kk) v[kk] = __builtin_nontemporal_load((const f32x2*)(bp + (size_t)kk * ld));
}
__device__ __forceinline__ void conv_finish(const ConvCtx& cc, int m, int wid, int lane, const f32x2 (&v)[16]) {
    const int rp = 16 * wid + (lane & 15), kg = lane >> 4;
    const int kt64 = m & 31;
    unsigned char* dst = (m < 16384) ? cc.W1T + ((size_t)(m >> 5) * 16 + (kt64 >> 1)) * 32768 : cc.W2T + ((size_t)((m - 16384) >> 5) * 16 + (kt64 >> 1)) * 32768;
    unsigned char* base = dst + (rp >> 6) * 16384 + lds_byte_b((2 * rp) & 127, (kt64 & 1) * 64 + 16 * kg);
#pragma unroll
    for (int i = 0; i < 2; ++i) { u32x4 w;
#pragma unroll
        for (int q = 0; q < 4; ++q) w[q] = pk_fp8x4(v[4 * q][i] * W8_SCALE, v[4 * q + 1][i] * W8_SCALE, v[4 * q + 2][i] * W8_SCALE, v[4 * q + 3][i] * W8_SCALE);
        __builtin_nontemporal_store(w, (u32x4*)(base + i * 64)); }
}
struct ColMapGluT { int nt; __device__ __forceinline__ int operator()(int rg) const { return (rg >> 5) * 2048 + nt * 128 + perm_col4(rg); } };
struct ColMapPerm { int c0; __device__ __forceinline__ int operator()(int rg) const { return c0 + (rg >> 5) * 128 + perm_col4(rg); } };

template <bool TRANS, bool FP8 = false, class Epi>
__device__ __forceinline__ void gemm8_unit(LAS unsigned char* lds, const u16* __restrict__ A, int lda, const int* __restrict__ arows, int arow0, int rows_valid, const u16* __restrict__ Bt, int nt, const Epi epi) {
    const int tid = tid_fresh(), wid = __builtin_amdgcn_readfirstlane(tid >> 6), lane = tid & 63;
    const int wr = wid >> 2, wc = wid & 3, fr = lane & 15, fq = lane >> 4;
    unsigned aof[2][2];
#pragma unroll
    for (int h = 0; h < 2; ++h)
#pragma unroll
        for (int i = 0; i < 2; ++i) { int R, C; stage_rc(tid * 16 + i * 8192, R, C); int rr = h * 128 + R; rr = rr < rows_valid ? rr : rows_valid - 1;
            const unsigned rowid = arows ? (unsigned)arows[rr] : (unsigned)(arow0 + rr); aof[h][i] = (rowid * (unsigned)lda + (unsigned)C) * 2u; }
    const char* Ab = (const char*)A; const char* Bb = (const char*)Bt + tid * 16;
    const bool hi = rows_valid > 128;
    int mxw = W8_MX, mxa = A8_MX; asm volatile("" : "+v"(mxw), "+v"(mxa));
#define G8_SA(b, h) (((b) * 2 + (h)) * 16384)
#define G8_SB(b, h) (65536 + ((b) * 2 + (h)) * 16384)
#define G8_STA(b, h, kt) do { _Pragma("unroll") for (int _i = 0; _i < 2; ++_i) \
        __builtin_amdgcn_global_load_lds((const unsigned*)(Ab + aof[h][_i] + (size_t)(kt) * 128), (LAS unsigned*)(lds + G8_SA(b, h) + wid * 1024 + _i * 8192), 16, 0, 0); } while (0)
#define G8_STB(b, h, kt) do { _Pragma("unroll") for (int _i = 0; _i < 2; ++_i) \
        __builtin_amdgcn_global_load_lds((const unsigned*)(Bb + (size_t)(kt) * 32768 + (h) * 16384 + _i * 8192), (LAS unsigned*)(lds + G8_SB(b, h) + wid * 1024 + _i * 8192), 16, 0, 0); } while (0)
#define G8_LDA(dst, b, h) do { _Pragma("unroll") for (int m = 0; m < 4; ++m) _Pragma("unroll") for (int k = 0; k < 2; ++k) dst[m][k] = *(const LAS bf16x8*)(lds + G8_SA(b, h) + aoff + m * 2048 + k * 1024); } while (0)
#define G8_LDB(dst, b, h) do { _Pragma("unroll") for (int n = 0; n < 2; ++n) _Pragma("unroll") for (int k = 0; k < 2; ++k) dst[n][k] = *(const LAS bf16x8*)(lds + G8_SB(b, h) + boff + n * 2048 + k * 1024); } while (0)
#define G8_MMA(ai, bj, At, Bq) do { if ((ai) == 0 || hi) { __builtin_amdgcn_s_setprio(1); _Pragma("unroll") for (int m = 0; m < 4; ++m) _Pragma("unroll") for (int n = 0; n < 2; ++n) { \
        if (FP8) { const i32x4 a0 = __builtin_bit_cast(i32x4, At[m][0]), a1 = __builtin_bit_cast(i32x4, At[m][1]), b0 = __builtin_bit_cast(i32x4, Bq[n][0]), b1 = __builtin_bit_cast(i32x4, Bq[n][1]); \
            const i32x8 a8 = __builtin_shufflevector(a0, a1, 0, 1, 2, 3, 4, 5, 6, 7), b8 = __builtin_shufflevector(b0, b1, 0, 1, 2, 3, 4, 5, 6, 7); \
            asm volatile("v_mfma_scale_f32_16x16x128_f8f6f4 %0, %1, %2, %0, %3, %4 op_sel_hi:[0,0,0]" : "+v"(acc[ai][bj][m][n]) : "v"(b8), "v"(a8), "v"(mxw), "v"(mxa)); } \
        else { _Pragma("unroll") for (int k = 0; k < 2; ++k) \
            acc[ai][bj][m][n] = TRANS ? __builtin_amdgcn_mfma_f32_16x16x32_bf16(At[m][k], Bq[n][k], acc[ai][bj][m][n], 0, 0, 0) : __builtin_amdgcn_mfma_f32_16x16x32_bf16(Bq[n][k], At[m][k], acc[ai][bj][m][n], 0, 0, 0); } } \
        __builtin_amdgcn_s_setprio(0); } } while (0)
#define G8_WV(n) asm volatile("s_waitcnt vmcnt(" #n ")" ::: "memory")
#define G8_WL(n) asm volatile("s_waitcnt lgkmcnt(" #n ")" ::: "memory")
#define G8_BAR __builtin_amdgcn_s_barrier()
#define G8_SCHED __builtin_amdgcn_sched_barrier(0)
    const int aoff = lds_byte(wr * 64 + fr, fq * 8), boff = lds_byte(wc * 32 + fr, fq * 8);
    f32x4 acc[2][2][4][2];
#pragma unroll
    for (int a = 0; a < 2; ++a)
#pragma unroll
        for (int b = 0; b < 2; ++b)
#pragma unroll
            for (int m = 0; m < 4; ++m)
#pragma unroll
                for (int n = 0; n < 2; ++n) acc[a][b][m][n] = (f32x4){0.f, 0.f, 0.f, 0.f};
    bf16x8 At[4][2], B0[2][2], B1[2][2];
    G8_STB(0, 0, 0); G8_STA(0, 0, 0); G8_STB(0, 1, 0); G8_STA(0, 1, 0);
    if (wr == 1) G8_BAR;
    G8_WV(4); G8_BAR;
    G8_STB(1, 0, 1); G8_STA(1, 0, 1); G8_STB(1, 1, 1);
    G8_WV(6); G8_BAR;
    for (int t = 0; t < nt - 2; t += 2) {
        G8_LDB(B0, 0, 0); G8_SCHED; G8_LDA(At, 0, 0); G8_STA(1, 1, t + 1);
        G8_WL(8); G8_BAR; G8_WL(0); G8_MMA(0, 0, At, B0); G8_BAR; G8_SCHED;
        G8_LDB(B1, 0, 1); G8_STB(0, 0, t + 2);
        G8_BAR; G8_WL(0); G8_MMA(0, 1, At, B1); G8_BAR;
        G8_LDA(At, 0, 1); G8_STA(0, 0, t + 2);
        G8_BAR; G8_WL(0); G8_MMA(1, 0, At, B0); G8_BAR; G8_SCHED;
        G8_STB(0, 1, t + 2);
        G8_WV(6); G8_BAR; G8_MMA(1, 1, At, B1); G8_BAR;
        G8_LDB(B0, 1, 0); G8_SCHED; G8_LDA(At, 1, 0); G8_STA(0, 1, t + 2);
        G8_WL(8); G8_BAR; G8_WL(0); G8_MMA(0, 0, At, B0); G8_BAR; G8_SCHED;
        G8_LDB(B1, 1, 1); G8_STB(1, 0, t + 3);
        G8_BAR; G8_WL(0); G8_MMA(0, 1, At, B1); G8_BAR;
        G8_LDA(At, 1, 1); G8_STA(1, 0, t + 3);
        G8_BAR; G8_WL(0); G8_MMA(1, 0, At, B0); G8_BAR; G8_SCHED;
        G8_STB(1, 1, t + 3);
        G8_WV(6); G8_BAR; G8_MMA(1, 1, At, B1); G8_BAR;
    }
    { G8_LDB(B0, 0, 0); G8_WV(0); G8_LDA(At, 0, 0); G8_STA(1, 1, nt - 1);
      G8_BAR; G8_WL(0); G8_MMA(0, 0, At, B0); G8_BAR;
      G8_LDB(B1, 0, 1); G8_BAR; G8_WL(0); G8_MMA(0, 1, At, B1); G8_BAR;
      G8_LDA(At, 0, 1); G8_WV(4); G8_BAR; G8_WL(0); G8_MMA(1, 0, At, B0); G8_MMA(1, 1, At, B1); G8_BAR; }
    { G8_LDB(B0, 1, 0); G8_LDA(At, 1, 0); G8_WV(2); G8_BAR; G8_WL(0); G8_MMA(0, 0, At, B0); G8_BAR;
      G8_LDB(B1, 1, 1); G8_WV(0); G8_BAR; G8_WL(0); G8_MMA(0, 1, At, B1); G8_BAR;
      G8_LDA(At, 1, 1); G8_BAR; G8_WL(0); G8_MMA(1, 0, At, B0); G8_MMA(1, 1, At, B1); G8_BAR; }
    if (wr == 0) G8_BAR;
#undef G8_SA
#undef G8_SB
#undef G8_STA
#undef G8_STB
#undef G8_LDA
#undef G8_LDB
#undef G8_MMA
#undef G8_WV
#undef G8_WL
#undef G8_BAR
#undef G8_SCHED
    __builtin_amdgcn_sched_barrier(0);
    { const int tz = tid_fresh(), wz = __builtin_amdgcn_readfirstlane(tz >> 6), lz = tz & 63;
      epi(acc, wz >> 2, wz & 3, lz & 15, lz >> 4); }
}
struct StreamUnit { const char* A; const char* Bt; int arow0, rows, a, b, c; };
template <bool TRANS, bool FP8, class Src>
__device__ __forceinline__ void gemm8_stream(LAS unsigned char* lds, unsigned lda, int nt, const Src& src) {
    const int tid = tid_fresh(), wid = __builtin_amdgcn_readfirstlane(tid >> 6), lane = tid & 63;
    const int wr = wid >> 2, wc = wid & 3, fr = lane & 15, fq = lane >> 4;
    StreamUnit cur, nxt;
    if (!src.get(0, cur)) return;
    int R0, C0, R1, C1; stage_rc(tid * 16, R0, C0); stage_rc(tid * 16 + 8192, R1, C1);
    int mxw = W8_MX, mxa = A8_MX; asm volatile("" : "+v"(mxw), "+v"(mxa));
    const int aoff = lds_byte(wr * 64 + fr, fq * 8), boff = lds_byte(wc * 32 + fr, fq * 8);
#define GS_AOF(u, h, R, C) ((unsigned)(((unsigned)((u).arow0 + (((h) * 128 + (R)) < (u).rows ? ((h) * 128 + (R)) : (u).rows - 1)) * lda + (unsigned)(C)) * 2u))
    unsigned ac00 = GS_AOF(cur, 0, R0, C0), ac01 = GS_AOF(cur, 0, R1, C1), ac10 = GS_AOF(cur, 1, R0, C0), ac11 = GS_AOF(cur, 1, R1, C1);
#define GS_SA(b, h) (((b) * 2 + (h)) * 16384)
#define GS_SB(b, h) (65536 + ((b) * 2 + (h)) * 16384)
#define GS_GL(src_, dst_) __builtin_amdgcn_global_load_lds((const unsigned*)(src_), (LAS unsigned*)(lds + (dst_)), 16, 0, 0)
#define GS_STA(b, h, base, o0, o1, kt) do { GS_GL((base) + (o0) + (size_t)(kt) * 128, GS_SA(b, h) + wid * 1024); GS_GL((base) + (o1) + (size_t)(kt) * 128, GS_SA(b, h) + wid * 1024 + 8192); } while (0)
#define GS_STB(b, h, base, kt) do { GS_GL((base) + tid * 16 + (size_t)(kt) * 32768 + (h) * 16384, GS_SB(b, h) + wid * 1024); GS_GL((base) + tid * 16 + (size_t)(kt) * 32768 + (h) * 16384 + 8192, GS_SB(b, h) + wid * 1024 + 8192); } while (0)
#define GS_LDA(dst, b, h) do { _Pragma("unroll") for (int m = 0; m < 4; ++m) _Pragma("unroll") for (int k = 0; k < 2; ++k) dst[m][k] = *(const LAS bf16x8*)(lds + GS_SA(b, h) + aoff + m * 2048 + k * 1024); } while (0)
#define GS_LDB(dst, b, h) do { _Pragma("unroll") for (int n = 0; n < 2; ++n) _Pragma("unroll") for (int k = 0; k < 2; ++k) dst[n][k] = *(const LAS bf16x8*)(lds + GS_SB(b, h) + boff + n * 2048 + k * 1024); } while (0)
#define GS_MMA(ai, bj, At, Bq) do { if ((ai) == 0 || hi) { __builtin_amdgcn_s_setprio(1); _Pragma("unroll") for (int m = 0; m < 4; ++m) _Pragma("unroll") for (int n = 0; n < 2; ++n) { \
        if (FP8) { const i32x4 a0 = __builtin_bit_cast(i32x4, At[m][0]), a1 = __builtin_bit_cast(i32x4, At[m][1]), b0 = __builtin_bit_cast(i32x4, Bq[n][0]), b1 = __builtin_bit_cast(i32x4, Bq[n][1]); \
            const i32x8 a8 = __builtin_shufflevector(a0, a1, 0, 1, 2, 3, 4, 5, 6, 7), b8 = __builtin_shufflevector(b0, b1, 0, 1, 2, 3, 4, 5, 6, 7); \
            asm volatile("v_mfma_scale_f32_16x16x128_f8f6f4 %0, %1, %2, %0, %3, %4 op_sel_hi:[0,0,0]" : "+v"(acc[ai][bj][m][n]) : "v"(b8), "v"(a8), "v"(mxw), "v"(mxa)); } \
        else { _Pragma("unroll") for (int k = 0; k < 2; ++k) \
            acc[ai][bj][m][n] = TRANS ? __builtin_amdgcn_mfma_f32_16x16x32_bf16(At[m][k], Bq[n][k], acc[ai][bj][m][n], 0, 0, 0) : __builtin_amdgcn_mfma_f32_16x16x32_bf16(Bq[n][k], At[m][k], acc[ai][bj][m][n], 0, 0, 0); } } \
        __builtin_amdgcn_s_setprio(0); } } while (0)
#define GS_WV(n) asm volatile("s_waitcnt vmcnt(" #n ")" ::: "memory")
#define GS_WL(n) asm volatile("s_waitcnt lgkmcnt(" #n ")" ::: "memory")
#define GS_BAR __builtin_amdgcn_s_barrier()
#define GS_SCHED __builtin_amdgcn_sched_barrier(0)
    f32x4 acc[2][2][4][2];
#pragma unroll
    for (int a = 0; a < 2; ++a)
#pragma unroll
        for (int b = 0; b < 2; ++b)
#pragma unroll
            for (int m = 0; m < 4; ++m)
#pragma unroll
                for (int n = 0; n < 2; ++n) acc[a][b][m][n] = (f32x4){0.f, 0.f, 0.f, 0.f};
    bf16x8 At[4][2], B0[2][2], B1[2][2];
    GS_STB(0, 0, cur.Bt, 0); GS_STA(0, 0, cur.A, ac00, ac01, 0); GS_STB(0, 1, cur.Bt, 0); GS_STA(0, 1, cur.A, ac10, ac11, 0);
    if (wr == 1) GS_BAR;
    GS_WV(4); GS_BAR;
    GS_STB(1, 0, cur.Bt, 1); GS_STA(1, 0, cur.A, ac00, ac01, 1); GS_STB(1, 1, cur.Bt, 1);
    GS_WV(6); GS_BAR;
    for (int ui = 0;; ++ui) {
        const bool has_next = src.get(ui + 1, nxt);
        if (!has_next) nxt = cur;
        const unsigned an00 = GS_AOF(nxt, 0, R0, C0), an01 = GS_AOF(nxt, 0, R1, C1), an10 = GS_AOF(nxt, 1, R0, C0), an11 = GS_AOF(nxt, 1, R1, C1);
        const bool hi = cur.rows > 128;
        for (int t = 0; t < nt; t += 2) {
            const bool last = (t == nt - 2);
            const char* xA = last ? nxt.A : cur.A; const char* xB = last ? nxt.Bt : cur.Bt;
            const unsigned x00 = last ? an00 : ac00, x01 = last ? an01 : ac01, x10 = last ? an10 : ac10, x11 = last ? an11 : ac11;
            const int k2 = last ? 0 : t + 2, k3 = k2 + 1;
            GS_LDB(B0, 0, 0); GS_SCHED; GS_LDA(At, 0, 0); GS_STA(1, 1, cur.A, ac10, ac11, t + 1);
            GS_WL(8); GS_BAR; GS_WL(0); GS_MMA(0, 0, At, B0); GS_BAR; GS_SCHED;
            GS_LDB(B1, 0, 1); GS_STB(0, 0, xB, k2);
            GS_BAR; GS_WL(0); GS_MMA(0, 1, At, B1); GS_BAR;
            GS_LDA(At, 0, 1); GS_STA(0, 0, xA, x00, x01, k2);
            GS_BAR; GS_WL(0); GS_MMA(1, 0, At, B0); GS_BAR; GS_SCHED;
            GS_STB(0, 1, xB, k2);
            GS_WV(6); GS_BAR; GS_MMA(1, 1, At, B1); GS_BAR;
            GS_LDB(B0, 1, 0); GS_SCHED; GS_LDA(At, 1, 0); GS_STA(0, 1, xA, x10, x11, k2);
            GS_WL(8); GS_BAR; GS_WL(0); GS_MMA(0, 0, At, B0); GS_BAR; GS_SCHED;
            GS_LDB(B1, 1, 1); GS_STB(1, 0, xB, k3);
            GS_BAR; GS_WL(0); GS_MMA(0, 1, At, B1); GS_BAR;
            GS_LDA(At, 1, 1); GS_STA(1, 0, xA, x00, x01, k3);
            GS_BAR; GS_WL(0); GS_MMA(1, 0, At, B0); GS_BAR; GS_SCHED;
            GS_STB(1, 1, xB, k3);
            GS_WV(6); GS_BAR; GS_MMA(1, 1, At, B1); GS_BAR;
        }
        __builtin_amdgcn_sched_barrier(0);
        src.epi(acc, cur, wr, wc, fr, fq);
        __builtin_amdgcn_sched_barrier(0);
        if (!has_next) break;
#pragma unroll
        for (int a = 0; a < 2; ++a)
#pragma unroll
            for (int b = 0; b < 2; ++b)
#pragma unroll
                for (int m = 0; m < 4; ++m)
#pragma unroll
                    for (int n = 0; n < 2; ++n) acc[a][b][m][n] = (f32x4){0.f, 0.f, 0.f, 0.f};
        cur = nxt; ac00 = an00; ac01 = an01; ac10 = an10; ac11 = an11;
    }
    GS_WV(0);
    if (wr == 0) GS_BAR;
    GS_BAR;
#undef GS_AOF
#undef GS_SA
#undef GS_SB
#undef GS_GL
#undef GS_STA
#undef GS_STB
#undef GS_LDA
#undef GS_LDB
#undef GS_MMA
#undef GS_WV
#undef GS_WL
#undef GS_BAR
#undef GS_SCHED
}
struct Epi8PG { u16* PG; int tok0, col0;
    __device__ __forceinline__ void operator()(const f32x4 (&acc)[2][2][4][2], int wr, int wc, int fr, int fq) const {
#pragma unroll
        for (int ai = 0; ai < 2; ++ai)
#pragma unroll
            for (int m = 0; m < 4; ++m) { u16* rowp = PG + (size_t)(tok0 + ai * 128 + wr * 64 + m * 16 + fr) * 5120 + col0 + wc * 32 + 8 * fq;
#pragma unroll
                for (int bj = 0; bj < 2; ++bj) { const f32x4 v0 = acc[ai][bj][m][0], v1 = acc[ai][bj][m][1];
                    *(u32x4*)(rowp + bj * 128) = (u32x4){pk_bf16(v0[0], v0[1]), pk_bf16(v0[2], v0[3]), pk_bf16(v1[0], v1[1]), pk_bf16(v1[2], v1[3])}; } }
    } };
struct Epi8HYT { u16* HYT; int tok0, col0;
    __device__ __forceinline__ void operator()(const f32x4 (&acc)[2][2][4][2], int wr, int wc, int fr, int fq) const {
#pragma unroll
        for (int bj = 0; bj < 2; ++bj)
#pragma unroll
            for (int n = 0; n < 2; ++n) { u16* colp = HYT + (size_t)(col0 + bj * 128 + wc * 32 + perm32(n * 16 + fr)) * NTOK + tok0 + wr * 64 + 4 * fq;
#pragma unroll
                for (int ai = 0; ai < 2; ++ai)
#pragma unroll
                    for (int m = 0; m < 4; ++m) { const f32x4 v = acc[ai][bj][m][n]; *(u32x2*)(colp + ai * 128 + m * 16) = (u32x2){pk_bf16(v[0], v[1]), pk_bf16(v[2], v[3])}; } }
    } };
struct Epi8X1 { const float* x; float* X1; int tok0, col0;
    __device__ __forceinline__ void operator()(const f32x4 (&acc)[2][2][4][2], int wr, int wc, int fr, int fq) const {
#pragma unroll
        for (int ai = 0; ai < 2; ++ai)
#pragma unroll
            for (int m = 0; m < 4; ++m) { const size_t off = (size_t)(tok0 + ai * 128 + wr * 64 + m * 16 + fr) * DM + col0 + wc * 32 + 8 * fq;
#pragma unroll
                for (int bj = 0; bj < 2; ++bj)
#pragma unroll
                    for (int n = 0; n < 2; ++n) { const f32x4 r = *(const f32x4*)(x + off + bj * 128 + n * 4); *(f32x4*)(X1 + off + bj * 128 + n * 4) = r + acc[ai][bj][m][n]; }
                asm volatile("" ::: "memory"); }
    } };
struct Epi8Swiglu { u16* HM; const float* b1; int slot0, nt, rows_valid;
    __device__ __forceinline__ void operator()(const f32x4 (&acc)[2][2][4][2], int wr, int wc, int fr, int fq) const {
        f32x4 bg[2], bl[2];
#pragma unroll
        for (int n = 0; n < 2; ++n) { const int col = nt * 128 + wc * 32 + 8 * fq + 4 * n; bg[n] = *(const f32x4*)(b1 + col); bl[n] = *(const f32x4*)(b1 + 2048 + col); }
#pragma unroll
        for (int ai = 0; ai < 2; ++ai)
#pragma unroll
            for (int m = 0; m < 4; ++m) { const int row = ai * 128 + wr * 64 + m * 16 + fr;
                if (row < rows_valid) { float o[8];
#pragma unroll
                    for (int n = 0; n < 2; ++n) { const f32x4 gl = acc[ai][0][m][n] + bg[n], li = acc[ai][1][m][n] + bl[n];
#pragma unroll
                        for (int j = 0; j < 4; ++j) { const float gq = fminf(gl[j], 7.0f), lq = fminf(fmaxf(li[j], -7.0f), 7.0f); o[4 * n + j] = gq * (1.0f / (1.0f + __expf(-1.702f * gq))) * (lq + 1.0f); } }
                    *(u32x4*)(HM + (size_t)(slot0 + row) * DFF + nt * 128 + wc * 32 + 8 * fq) = (u32x4){pk_bf16(o[0], o[1]), pk_bf16(o[2], o[3]), pk_bf16(o[4], o[5]), pk_bf16(o[6], o[7])}; } }
    } };
struct Epi8Swiglu8 { unsigned char* HM; const float* b1; int slot0, nt, rows_valid;
    __device__ __forceinline__ void operator()(const f32x4 (&acc)[2][2][4][2], int wr, int wc, int fr, int fq) const {
        f32x4 bg[2], bl[2];
#pragma unroll
        for (int n = 0; n < 2; ++n) { const int col = nt * 128 + wc * 32 + 8 * fq + 4 * n; bg[n] = *(const f32x4*)(b1 + col); bl[n] = *(const f32x4*)(b1 + 2048 + col); }
#pragma unroll
        for (int ai = 0; ai < 2; ++ai)
#pragma unroll
            for (int m = 0; m < 4; ++m) { const int row = ai * 128 + wr * 64 + m * 16 + fr;
                if (row < rows_valid) { float o[8];
#pragma unroll
                    for (int n = 0; n < 2; ++n) { const f32x4 gl = acc[ai][0][m][n] + bg[n], li = acc[ai][1][m][n] + bl[n];
#pragma unroll
                        for (int j = 0; j < 4; ++j) { const float gq = fminf(gl[j], 7.0f), lq = fminf(fmaxf(li[j], -7.0f), 7.0f); o[4 * n + j] = gq * (1.0f / (1.0f + __expf(-1.702f * gq))) * (lq + 1.0f); } }
                    *(u32x2*)(HM + (size_t)(slot0 + row) * DFF + nt * 128 + wc * 32 + 8 * fq) = (u32x2){pk_fp8x4(o[0], o[1], o[2], o[3]), pk_fp8x4(o[4], o[5], o[6], o[7])}; } }
    } };
struct Epi8Y { u16* Y; const float* b2; int slot0, col0, rows_valid;
    __device__ __forceinline__ void operator()(const f32x4 (&acc)[2][2][4][2], int wr, int wc, int fr, int fq) const {
        f32x4 bv[2][2];
#pragma unroll
        for (int bj = 0; bj < 2; ++bj)
#pragma unroll
            for (int n = 0; n < 2; ++n) bv[bj][n] = *(const f32x4*)(b2 + col0 + bj * 128 + wc * 32 + 8 * fq + 4 * n);
#pragma unroll
        for (int ai = 0; ai < 2; ++ai)
#pragma unroll
            for (int m = 0; m < 4; ++m) { const int row = ai * 128 + wr * 64 + m * 16 + fr;
                if (row < rows_valid) { u16* rowp = Y + (size_t)(slot0 + row) * DM + col0 + wc * 32 + 8 * fq;
#pragma unroll
                    for (int bj = 0; bj < 2; ++bj) { const f32x4 v0 = acc[ai][bj][m][0] + bv[bj][0], v1 = acc[ai][bj][m][1] + bv[bj][1];
                        *(u32x4*)(rowp + bj * 128) = (u32x4){pk_bf16(v0[0], v0[1]), pk_bf16(v0[2], v0[3]), pk_bf16(v1[0], v1[1]), pk_bf16(v1[2], v1[3])}; } } }
    } };
struct EpiNone { __device__ __forceinline__ void operator()(const f32x4 (&acc)[2][2][4][2], int wr, int wc, int fr, int fq) const {
#pragma unroll
        for (int a = 0; a < 2; ++a)
#pragma unroll
            for (int b = 0; b < 2; ++b)
#pragma unroll
                for (int m = 0; m < 4; ++m)
#pragma unroll
                    for (int n = 0; n < 2; ++n) asm volatile("" :: "v"(acc[a][b][m][n]));
    } };

template <int NTILES>
__device__ __forceinline__ bool moe_unit_static(const LAS int* us, const LAS int* so2, int uu, int& e, int& nt, int& slot0, int& rows) {
    if (uu >= us[NE]) return false;
    int lo = 0, hi = NE;
#pragma unroll
    for (int s = 0; s < 5; ++s) { const int mid = (lo + hi) >> 1; if (us[mid] <= uu) lo = mid; else hi = mid; }
    e = lo; const int o0 = e * NTOK, cnt = so2[e], mtl = (cnt + 255) >> 8, ul = uu - us[e], mt = ul % mtl;
    e = __builtin_amdgcn_readfirstlane(e); nt = __builtin_amdgcn_readfirstlane(ul / mtl); slot0 = __builtin_amdgcn_readfirstlane(o0 + mt * 256);
    rows = cnt - mt * 256; rows = __builtin_amdgcn_readfirstlane(rows > 256 ? 256 : rows); return true;
}
struct SrcMoeB { const LAS int* us; const LAS int* so2; int c, G; const char* HM8; const char* W2T8; u16* YB; const float* b2;
    __device__ __forceinline__ bool get(int i, StreamUnit& u) const { int e, nt, slot0, rows; if (!moe_unit_static<8>(us, so2, c + i * G, e, nt, slot0, rows)) return false;
        u.A = HM8; u.Bt = W2T8 + (size_t)((e * 8 + nt) * 16) * 32768; u.arow0 = slot0; u.rows = rows; u.a = e; u.b = nt; u.c = slot0; return true; }
    __device__ __forceinline__ void epi(const f32x4 (&acc)[2][2][4][2], const StreamUnit& u, int wr, int wc, int fr, int fq) const { Epi8Y ep{YB, b2 + (size_t)u.a * DM, u.c, u.b * 256, u.rows}; ep(acc, wr, wc, fr, fq); }
};
template <bool TRANS>
struct SrcG1 { int c, G; const char* HBp; const char* WINTp; u16* PG; u16* HYT;
    __device__ __forceinline__ bool get(int k, StreamUnit& su) const {
        int seen = 0;
        for (int u = c; u < 1024; u += G) { const int i = u >> 8, xx = (u >> 5) & 7, j = u & 31; const int mt = (xx & 3) * 8 + (j & 7), nt = ((xx >> 2) + 2 * i) * 4 + (j >> 3);
            if ((nt >= 20) == TRANS) { if (seen == k) { su.A = HBp; su.Bt = WINTp + (size_t)nt * 32 * 32768; su.arow0 = mt * 256; su.rows = 256; su.a = mt; su.b = nt; su.c = 0; return true; } ++seen; } }
        return false; }
    __device__ __forceinline__ void epi(const f32x4 (&acc)[2][2][4][2], const StreamUnit& u, int wr, int wc, int fr, int fq) const {
        if (TRANS) { Epi8HYT e{HYT, u.a * 256, u.b * 256 - 5120}; e(acc, wr, wc, fr, fq); } else { Epi8PG e{PG, u.a * 256, u.b * 256}; e(acc, wr, wc, fr, fq); } }
};

typedef float f32x16 __attribute__((ext_vector_type(16)));
__device__ __forceinline__ void h3_row(int m, const float* __restrict__ w1, const float* __restrict__ b1, const float* __restrict__ w2, const float* __restrict__ b2,
                                       const float* __restrict__ w3, const float* __restrict__ b3, const float* __restrict__ freq, LAS float* sc  , float* __restrict__ H3) {
    const int j = tid_fresh() & 63;
    const float tt = (float)m / (float)(SEQ - 1);
    if (j == 0) sc[0] = tt;
    if (j >= 1 && j <= 16) { const int i = j - 1; const float band = 1e-4f + (float)i * ((15.0f - 1e-4f) / 15.0f); const float ang = (2.0f * 3.14159265358979323846f / (float)SEQ) * (float)m * band; sc[1 + i] = cosf(ang); sc[17 + i] = -sinf(ang); }
    __builtin_amdgcn_wave_barrier();
    const float fr = freq[j];
    float s = b1[j];
    for (int i = 0; i < 33; ++i) s += sc[i] * w1[i * 64 + j];
    const float h1 = sinf(fr * s);
    sc[64 + j] = h1;
    __builtin_amdgcn_wave_barrier();
    s = b2[j];
    for (int i = 0; i < 64; ++i) s += sc[64 + i] * w2[i * 64 + j];
    const float h2 = sinf(fr * s);
    __builtin_amdgcn_wave_barrier();
    sc[j] = h2;
    __builtin_amdgcn_wave_barrier();
    s = b3[j];
    for (int i = 0; i < 64; ++i) s += sc[i] * w3[i * 64 + j];
    H3[(size_t)m * 64 + j] = sinf(fr * s);
    __builtin_amdgcn_wave_barrier();
}
constexpr int FR_LEN = 4128;
__device__ __forceinline__ void frgen_item(LAS unsigned char* lds, int item, const float* __restrict__ H3, const float* __restrict__ w4, u16* __restrict__ FR) {
    const int tid = tid_fresh(), wid = __builtin_amdgcn_readfirstlane(tid >> 6), lane = tid & 63, fr = lane & 15, fq = lane >> 4;
    const int oc0 = item * 8, o = oc0 >> 10;
    const int colB = o * 2048 + (fr >> 3) * 1024 + (oc0 & 1023) + (fr & 7);
    float wreg[16];
#pragma unroll
    for (int ks = 0; ks < 16; ++ks) wreg[ks] = w4[(size_t)(4 * ks + fq) * 4096 + colB];
    const int dir = fr >> 3, c = (oc0 & 1023) + (fr & 7);
    const float mind = logf(1e-2f) / 0.3f, maxd = logf(1e-2f) / 1.5f;
    const float delta = fabsf(mind + (float)c * ((maxd - mind) / 1023.0f));
    u16* r0 = FR + (size_t)((oc0 + (fr & 7)) * 2) * FR_LEN;
    LAS float* tile = (LAS float*)(lds + wid * 4608);
    const int wrow = lane >> 4, wcol = 4 * (lane & 15);
    f32x4 nx[4];
#pragma unroll
    for (int q = 0; q < 4; ++q) nx[q] = *(const f32x4*)(H3 + (size_t)wid * 1024 + q * 256 + lane * 4);
    for (int it = 0; it < 16; ++it) {
        const int mt = wid + 8 * it;
#pragma unroll
        for (int q = 0; q < 4; ++q) *(LAS f32x4*)(tile + (q * 4 + wrow) * 68 + wcol) = nx[q];
        if (it + 1 < 16) {
#pragma unroll
            for (int q = 0; q < 4; ++q) nx[q] = *(const f32x4*)(H3 + (size_t)(mt + 8) * 1024 + q * 256 + lane * 4);
        }
        f32x4 acc = {0.f, 0.f, 0.f, 0.f};
#pragma unroll
        for (int ks = 0; ks < 16; ++ks) acc = __builtin_amdgcn_mfma_f32_16x16x4f32(tile[fr * 68 + 4 * ks + fq], wreg[ks], acc, 0, 0, 0);
        const int m0 = mt * 16 + 4 * fq;
        float v[4];
#pragma unroll
        for (int j = 0; j < 4; ++j) v[j] = acc[j] * __expf(-((float)(m0 + j) / (float)(SEQ - 1)) * delta);
        if (dir == 0) {
            *(u32x2*)(r0 + 2044 - m0) = (u32x2){pk_bf16(v[3], v[2]), pk_bf16(v[1], v[0])};
#pragma unroll
            for (int j = 0; j < 4; ++j) r0[FR_LEN + 2046 - m0 - j] = (u16)(pk_bf16(v[j], 0.f) & 0xffffu);
        } else {
#pragma unroll
            for (int j = 0; j < 4; ++j) if (m0 + j >= 1) { const u16 b = (u16)(pk_bf16(v[j], 0.f) & 0xffffu); r0[2047 + m0 + j] = b; r0[FR_LEN + 2046 + m0 + j] = b; }
        }
    }
    if (tid < 8 * 34) { const int r = tid / 34, x = 4094 + tid % 34; u16* rr = FR + (size_t)((oc0 + r) * 2) * FR_LEN; if (x >= 4095) rr[x] = 0; rr[FR_LEN + x] = 0; }
    __syncthreads();
}
constexpr int HY_ZSTRIDE = 2312;
constexpr int HY_ZCH = 256 + 4 * HY_ZSTRIDE;
constexpr int HY_ZBYTES = HY_ZCH * 2;
constexpr int HY_FB = 4 * HY_ZBYTES;
constexpr int HY_FCH = 2 * FR_LEN * 2;
constexpr int HY_LDS = HY_FB + 4 * HY_FCH;

__device__ __forceinline__ void hy_load_row(LAS unsigned char* lds, int dest, int boff0, int bstride, const u16* __restrict__ row, float w0, float w1, float w2, float cb, int pl) {
#pragma unroll 2
    for (int it = 0; it < 8; ++it) {
        const int idx = pl + 128 * it, tok0 = idx * 8, b = tok0 >> 11, n0 = tok0 & 2047;
        const u32x4 raw = *(const u32x4*)(row + tok0);
        const float pm = (n0 > 0) ? bf2f(row[tok0 - 1]) : 0.f;
        const float pn = (n0 + 8 < SEQ) ? bf2f(row[tok0 + 8]) : 0.f;
        float p[10];
        p[0] = pm; p[9] = pn;
#pragma unroll
        for (int q = 0; q < 4; ++q) { p[1 + 2 * q] = bflo(raw[q]); p[2 + 2 * q] = bfhi(raw[q]); }
        float o[8];
#pragma unroll
        for (int q = 0; q < 8; ++q) o[q] = fmaf(w0, p[q], fmaf(w1, p[q + 1], fmaf(w2, p[q + 2], cb)));
        u32x4 w; w[0] = pk_bf16(o[0], o[1]); w[1] = pk_bf16(o[2], o[3]); w[2] = pk_bf16(o[4], o[5]); w[3] = pk_bf16(o[6], o[7]);
        *(LAS u32x4*)(lds + dest + (boff0 + b * bstride + n0) * 2) = w;
    }
}
__device__ __forceinline__ void hy_load_filters(LAS unsigned char* lds, int fb, const u16* __restrict__ src, int pl) {
    for (int idx = pl; idx < HY_FCH / 16; idx += 128) *(LAS u32x4*)(lds + fb + idx * 16) = *(const u32x4*)((const char*)src + idx * 16);
}
__device__ __forceinline__ void hy_mfma_loop(LAS unsigned char* lds, int zb, int fb, int hlf, int lane, f32x16 (&acc)[4], const ConvCtx& cc, int mbase, int cunit, int wid) {
    const int r = lane & 31, hh = lane >> 5, il = r >> 2, b = r & 3;
    const int bbase = zb + (256 + b * HY_ZSTRIDE + 32 * il + 8 * hh) * 2;
    const int xl = 2047 - r + 8 * hh - 1024 * hlf;
    const int abase = (r & 1) ? (fb + 2 * xl) : (fb + FR_LEN * 2 + 2 * (xl - 1));
#pragma unroll
    for (int q = 0; q < 4; ++q)
#pragma unroll
        for (int i = 0; i < 16; ++i) acc[q][i] = 0.f;
    for (int d0 = 0; d0 < 8; ++d0) {
#pragma unroll
        for (int ks = 0; ks < 2; ++ks) {
            f32x2 cv[16];
            const int mcv = conv_seq2tile((mbase + d0 * 2 + ks) * 256 + cunit);
            conv_issue(cc, mcv, wid, lane, cv);
            bf16x8 Bt[9];
#pragma unroll
            for (int j = 0; j < 9; ++j) Bt[j] = *(const LAS bf16x8*)(lds + bbase + 512 * j - 64 * d0 + 32 * ks);
#pragma unroll
            for (int ep = -8; ep <= 3; ++ep) {
                const LAS unsigned* ap = (const LAS unsigned*)(lds + abase - 64 * d0 - 512 * ep + 32 * ks);
                u32x4 av; av[0] = ap[0]; av[1] = ap[1]; av[2] = ap[2]; av[3] = ap[3];
                const bf16x8 a = __builtin_bit_cast(bf16x8, av);
#pragma unroll
                for (int ctl = 0; ctl < 4; ++ctl) { const int jt = ctl - ep; if (jt >= 0 && jt <= 8) acc[ctl] = __builtin_amdgcn_mfma_f32_32x32x16_bf16(a, Bt[jt], acc[ctl], 0, 0, 0); }
            }
            conv_finish(cc, mcv, wid, lane, cv);
        }
    }
}
__device__ __forceinline__ void hy_epilogue(LAS unsigned char* lds, int zb, int gb, int hlf, int lane, const f32x16 (&acc)[4], float bias) {
    const int r = lane & 31, hh = lane >> 5, il = r >> 2, b = r & 3;
#pragma unroll
    for (int ctl = 0; ctl < 4; ++ctl) {
        const int I = 8 * (4 * hlf + ctl) + il;
#pragma unroll
        for (int q = 0; q < 4; ++q) {
            const int n4 = 32 * I + 8 * q + 4 * hh;
            LAS u32x2* zp = (LAS u32x2*)(lds + zb + (256 + b * HY_ZSTRIDE + n4) * 2);
            const u32x2 zv = *zp, gv = *(const LAS u32x2*)(lds + gb + (b * 2048 + n4) * 2);
            const float z0 = bflo(zv[0]), z1 = bfhi(zv[0]), z2 = bflo(zv[1]), z3 = bfhi(zv[1]);
            const float g0 = bflo(gv[0]), g1 = bfhi(gv[0]), g2 = bflo(gv[1]), g3 = bfhi(gv[1]);
            u32x2 o; o[0] = pk_bf16(g0 * fmaf(bias, z0, acc[ctl][4 * q + 0]), g1 * fmaf(bias, z1, acc[ctl][4 * q + 1]));
            o[1] = pk_bf16(g2 * fmaf(bias, z2, acc[ctl][4 * q + 2]), g3 * fmaf(bias, z3, acc[ctl][4 * q + 3]));
            *zp = o;
        }
    }
}
__device__ __forceinline__ void hyena_unit(LAS unsigned char* lds, int unit, const u16* __restrict__ HYT, const u16* __restrict__ FR, const float* __restrict__ cw, const float* __restrict__ cbv,
                                           const float* __restrict__ hbias, u16* __restrict__ Z2T, const ConvCtx& cc) {
    const int tid = tid_fresh(), wid = __builtin_amdgcn_readfirstlane(tid >> 6), lane = tid & 63;
    const int cs = wid & 3, hlf = wid >> 2, c = unit * 4 + cs, pl = lane + 64 * hlf;
    const int zb = cs * HY_ZBYTES, fb = HY_FB + cs * HY_FCH;
    { const u32x4 z = {0u, 0u, 0u, 0u}; for (int idx = pl; idx < HY_ZBYTES / 16; idx += 128) *(LAS u32x4*)(lds + zb + idx * 16) = z; }
    __syncthreads();
    hy_load_row(lds, zb, 256, HY_ZSTRIDE, HYT + (size_t)c * NTOK, cw[0 * 3072 + c], cw[1 * 3072 + c], cw[2 * 3072 + c], cbv[c], pl);
    f32x16 acc[4];
#pragma unroll
    for (int o = 0; o < 2; ++o) {
        hy_load_filters(lds, fb, FR + (size_t)((o * 1024 + c) * 2) * FR_LEN, pl);
        __syncthreads();
        hy_mfma_loop(lds, zb, fb, hlf, lane, acc, cc, o * 16, unit, wid);
        __syncthreads();
        const int gc = (1 + o) * 1024 + c;
        hy_load_row(lds, fb, 0, 2048, HYT + (size_t)gc * NTOK, cw[0 * 3072 + gc], cw[1 * 3072 + gc], cw[2 * 3072 + gc], cbv[gc], pl);
        __syncthreads();
        hy_epilogue(lds, zb, fb, hlf, lane, acc, hbias[o * HYW + c]);
        __syncthreads();
    }
#pragma unroll 2
    for (int it = 0; it < 8; ++it) { const int idx = pl + 128 * it, tok0 = idx * 8, b = tok0 >> 11, n0 = tok0 & 2047;
        *(u32x4*)(Z2T + (size_t)c * NTOK + tok0) = *(const LAS u32x4*)(lds + zb + (256 + b * HY_ZSTRIDE + n0) * 2); }
    __syncthreads();
}

constexpr int HG_RAWQ = 0, HG_RAWF = 16384, HG_RAWV = 32768;
constexpr int HG_QM = 36864, HG_KM = HG_QM + 17408, HG_QI = HG_KM + 17408;
constexpr int HG_KL = HG_QI + 17408;
constexpr int HG_VT = HG_KL + 18432;
constexpr int HG_P = HG_VT + 4608;
constexpr int HG_ST = HG_P + 9216;
constexpr int HG_TOT = HG_ST + 8704;
constexpr int HG_EL2 = HG_TOT + 2048;
constexpr int HG_LDS = HG_EL2 + 512;

__device__ __forceinline__ void hgrn_unit(LAS unsigned char* lds, int unit, const u16* __restrict__ PG, const float* __restrict__ lb_logits, float* __restrict__ OF, float* __restrict__ OB, const ConvCtx& cc) {
    const int tid = tid_fresh(), wid = __builtin_amdgcn_readfirstlane(tid >> 6), lane = tid & 63, fr = lane & 15, fq = lane >> 4;
    const int vq = unit & 3, dir = (unit >> 2) & 1, h = (unit >> 3) & 7, b = unit >> 6;
    const int k = tid & 127, seg = tid >> 7;
    float* __restrict__ O = dir ? OB : OF;
    float lb;
    { const int c = h * 128 + k; const float l0 = lb_logits[(0 * 2 + dir) * HGW + c], l1 = lb_logits[(1 * 2 + dir) * HGW + c]; lb = 1.0f / (1.0f + __expf(l1 - l0)); }
    for (int i = tid; i < 8704 / 16; i += 512) *(LAS u32x4*)(lds + HG_ST + i * 16) = (u32x4){0u, 0u, 0u, 0u};
    f32x4 Sacc[2];
    Sacc[0] = (f32x4){0.f, 0.f, 0.f, 0.f}; Sacc[1] = Sacc[0];
    u32x4 pq[2], pf[2], pv;
    const int colq = h * 128, colf = (1 + dir) * 1024 + h * 128, colv = 3072 + h * 128 + vq * 32;
#define HG_TOK(c, tau) ((size_t)b * SEQ + (dir ? (SEQ - 1 - 64 * (c) - (tau)) : (64 * (c) + (tau))))
#define HG_PREFETCH(c) do { _Pragma("unroll") for (int _i = 0; _i < 2; ++_i) { const int _x = tid + 512 * _i, _tau = _x >> 4, _p = _x & 15; const u16* _r = PG + HG_TOK(c, _tau) * 5120; \
            pq[_i] = *(const u32x4*)(_r + colq + _p * 8); pf[_i] = *(const u32x4*)(_r + colf + _p * 8); } \
        if (tid < 256) { const int _tau = tid >> 2, _p = tid & 3; pv = *(const u32x4*)(PG + HG_TOK(c, _tau) * 5120 + colv + _p * 8); } } while (0)
    HG_PREFETCH(0);
    for (int c = 0; c < 32; ++c) {
#pragma unroll
        for (int i = 0; i < 2; ++i) { const int x = tid + 512 * i; *(LAS u32x4*)(lds + HG_RAWQ + x * 16) = pq[i]; *(LAS u32x4*)(lds + HG_RAWF + x * 16) = pf[i]; }
        if (tid < 256) *(LAS u32x4*)(lds + HG_RAWV + tid * 16) = pv;
        if (c + 1 < 32) HG_PREFETCH(c + 1);
        f32x2 cv[16];
        const int mqa = conv_seq2tile((32 + c * 2) * 256 + unit), mqb = conv_seq2tile((33 + c * 2) * 256 + unit);
        conv_issue(cc, mqa, wid, lane, cv);
        __syncthreads();
        float qv[16], kv[16], bl[16];
        { float run = 0.f;
#pragma unroll
          for (int i = 0; i < 16; ++i) { const int tau = seg * 16 + i;
              const float qr = bf2f(*(const LAS u16*)(lds + HG_RAWQ + tau * 256 + k * 2)), zf = bf2f(*(const LAS u16*)(lds + HG_RAWF + tau * 256 + k * 2));
              const float sg = 1.0f / (1.0f + __expf(-zf)); const float f = lb + (1.0f - lb) * sg;
              run += __logf(f); bl[i] = run; kv[i] = 1.0f - f; qv[i] = qr / (1.0f + __expf(-qr)); }
          *(LAS float*)(lds + HG_TOT + (seg * 128 + k) * 4) = run; }
        __syncthreads();
        { const float t0 = *(const LAS float*)(lds + HG_TOT + (0 * 128 + k) * 4), t1 = *(const LAS float*)(lds + HG_TOT + (1 * 128 + k) * 4),
                      t2 = *(const LAS float*)(lds + HG_TOT + (2 * 128 + k) * 4), t3 = *(const LAS float*)(lds + HG_TOT + (3 * 128 + k) * 4);
          const float pre = (seg > 0 ? t0 : 0.f) + (seg > 1 ? t1 : 0.f) + (seg > 2 ? t2 : 0.f);
          const float bref = t0 + t1, blast = bref + t2 + t3;
          const float er = __expf(bref), el = __expf(blast - bref);
          if (seg == 0) *(LAS float*)(lds + HG_EL2 + k * 4) = __expf(blast);
          unsigned klp[8];
#pragma unroll
          for (int i = 0; i < 16; i += 2) {
              float klv[2];
#pragma unroll
              for (int u = 0; u < 2; ++u) { const int tau = seg * 16 + i + u; const float bb = pre + bl[i + u];
                  const float e1 = __expf(bb - bref), e2 = __expf(bref - bb);
                  const float qm = qv[i + u] * e1, km = kv[i + u] * e2;
                  *(LAS u16*)(lds + HG_QM + tau * 272 + k * 2) = (u16)(pk_bf16(qm, 0.f) & 0xffffu);
                  *(LAS u16*)(lds + HG_KM + tau * 272 + k * 2) = (u16)(pk_bf16(km, 0.f) & 0xffffu);
                  *(LAS u16*)(lds + HG_QI + tau * 272 + k * 2) = (u16)(pk_bf16(qm * er, 0.f) & 0xffffu);
                  klv[u] = km * el; }
              klp[i >> 1] = pk_bf16(klv[0], klv[1]); }
          *(LAS u32x4*)(lds + HG_KL + k * 144 + seg * 32) = (u32x4){klp[0], klp[1], klp[2], klp[3]};
          *(LAS u32x4*)(lds + HG_KL + k * 144 + seg * 32 + 16) = (u32x4){klp[4], klp[5], klp[6], klp[7]};
          { const int v = tid & 31, tg = tid >> 5; unsigned short e[4];
#pragma unroll
            for (int u = 0; u < 4; ++u) e[u] = *(const LAS u16*)(lds + HG_RAWV + (tg * 4 + u) * 64 + v * 2);
            *(LAS u32x2*)(lds + HG_VT + v * 144 + tg * 8) = (u32x2){(unsigned)e[0] | ((unsigned)e[1] << 16), (unsigned)e[2] | ((unsigned)e[3] << 16)}; } }
        conv_finish(cc, mqa, wid, lane, cv);
        conv_issue(cc, mqb, wid, lane, cv);
        __syncthreads();
#pragma unroll
        for (int q = 0; q < 2; ++q) { const int idx = wid * 2 + q, ti = idx >> 2, si = idx & 3;
            f32x4 a = {0.f, 0.f, 0.f, 0.f};
            if (si <= ti) {
#pragma unroll
                for (int ks = 0; ks < 4; ++ks) { const bf16x8 ka = *(const LAS bf16x8*)(lds + HG_KM + (si * 16 + fr) * 272 + (ks * 32 + fq * 8) * 2), qb = *(const LAS bf16x8*)(lds + HG_QM + (ti * 16 + fr) * 272 + (ks * 32 + fq * 8) * 2);
                    a = __builtin_amdgcn_mfma_f32_16x16x32_bf16(ka, qb, a, 0, 0, 0); } }
            const int tau = ti * 16 + fr, s0 = si * 16 + fq * 4;
            float pvv[4];
#pragma unroll
            for (int j = 0; j < 4; ++j) pvv[j] = (si <= ti && s0 + j <= tau) ? a[j] : 0.f;
            *(LAS u32x2*)(lds + HG_P + tau * 144 + s0 * 2) = (u32x2){pk_bf16(pvv[0], pvv[1]), pk_bf16(pvv[2], pvv[3])}; }
        const int ti = wid >> 1, vi = wid & 1;
        f32x4 oacc = {0.f, 0.f, 0.f, 0.f};
#pragma unroll
        for (int ks = 0; ks < 4; ++ks) { const bf16x8 qa = *(const LAS bf16x8*)(lds + HG_QI + (ti * 16 + fr) * 272 + (ks * 32 + fq * 8) * 2), sb = *(const LAS bf16x8*)(lds + HG_ST + (vi * 16 + fr) * 272 + (ks * 32 + fq * 8) * 2);
            oacc = __builtin_amdgcn_mfma_f32_16x16x32_bf16(qa, sb, oacc, 0, 0, 0); }
        { const f32x4 e2 = *(const LAS f32x4*)(lds + HG_EL2 + (wid * 16 + fq * 4) * 4);
#pragma unroll
          for (int v2 = 0; v2 < 2; ++v2) { Sacc[v2] = Sacc[v2] * e2;
#pragma unroll
              for (int ks = 0; ks < 2; ++ks) { const bf16x8 ka = *(const LAS bf16x8*)(lds + HG_KL + (wid * 16 + fr) * 144 + (ks * 32 + fq * 8) * 2), vb = *(const LAS bf16x8*)(lds + HG_VT + (v2 * 16 + fr) * 144 + (ks * 32 + fq * 8) * 2);
                  Sacc[v2] = __builtin_amdgcn_mfma_f32_16x16x32_bf16(ka, vb, Sacc[v2], 0, 0, 0); } } }
        __syncthreads();
#pragma unroll
        for (int ks = 0; ks < 2; ++ks) { const bf16x8 pa = *(const LAS bf16x8*)(lds + HG_P + (ti * 16 + fr) * 144 + (ks * 32 + fq * 8) * 2), vb = *(const LAS bf16x8*)(lds + HG_VT + (vi * 16 + fr) * 144 + (ks * 32 + fq * 8) * 2);
            oacc = __builtin_amdgcn_mfma_f32_16x16x32_bf16(pa, vb, oacc, 0, 0, 0); }
#pragma unroll
        for (int j = 0; j < 4; ++j) { const int tau = ti * 16 + fq * 4 + j; O[HG_TOK(c, tau) * HGW + h * 128 + vq * 32 + vi * 16 + fr] = oacc[j]; }
        conv_finish(cc, mqb, wid, lane, cv);
#pragma unroll
        for (int v2 = 0; v2 < 2; ++v2) *(LAS u32x2*)(lds + HG_ST + (v2 * 16 + fr) * 272 + (wid * 16 + fq * 4) * 2) = (u32x2){pk_bf16(Sacc[v2][0], Sacc[v2][1]), pk_bf16(Sacc[v2][2], Sacc[v2][3])};
    }
    __syncthreads();
#undef HG_TOK
#undef HG_PREFETCH
}


#define XB_TMO      128
#define XB_XCNT(j)  (256  + 64 * (j))
#define XB_XSUB(j)  (1280 + 64 * (j))
#define XB_XGEN(j)  (2304 + 64 * (j))
#define XB_TOP      3328
#define XB_TOPGEN   3392
#define XCD_BAR_WORDS 3456
#define XB_SPIN_CAP (1u << 22)

__device__ __forceinline__ unsigned xb_ld(unsigned* p)              { return __hip_atomic_load(p, __ATOMIC_RELAXED, __HIP_MEMORY_SCOPE_AGENT); }
__device__ __forceinline__ unsigned xb_add(unsigned* p, unsigned v) { return __hip_atomic_fetch_add(p, v, __ATOMIC_RELAXED, __HIP_MEMORY_SCOPE_AGENT); }
__device__ __forceinline__ unsigned xb_xcc_id() { return (unsigned)__builtin_amdgcn_s_getreg((3 << 11) | 20) & 0xFu; }
#define XB_SPIN(cond, bar) do { unsigned _sp = 0; while (cond) { __builtin_amdgcn_s_sleep(1); \
    if ((++_sp & 255u) == 0u) { if (xb_ld(&(bar)[XB_TMO])) break; if (_sp > XB_SPIN_CAP) { atomicAdd(&(bar)[XB_TMO], 1u); break; } } } } while (0)

struct XcdBarrier {
    unsigned* bar; unsigned x;
    volatile LAS unsigned* st;
};

__device__ __forceinline__ XcdBarrier xcd_barrier_post(unsigned* bar, volatile LAS unsigned* st) {
    XcdBarrier b; b.bar = bar; b.x = xb_xcc_id(); b.st = st;
    if (threadIdx.x == 0) (void)xb_add(&bar[XB_XCNT(b.x)], 1u);
    return b;
}
__device__ __forceinline__ void xcd_barrier_complete(unsigned* bar, unsigned x, unsigned& nloc, unsigned& nx) {
    const unsigned G = gridDim.x * gridDim.y * gridDim.z;
    unsigned sum, cnt, mine, sp = 0u;
    for (;;) {
        sum = 0u; cnt = 0u; mine = 0u;
#pragma unroll
        for (unsigned j = 0; j < 16; ++j) { const unsigned c = xb_ld(&bar[XB_XCNT(j)]); sum += c; cnt += (c > 0u) ? 1u : 0u; mine = (j == x) ? c : mine; }
        if (sum == G) break;
        __builtin_amdgcn_s_sleep(1);
        if ((++sp & 255u) == 0u) { if (xb_ld(&bar[XB_TMO])) break; if (sp > XB_SPIN_CAP) { atomicAdd(&bar[XB_TMO], 1u); break; } }
    }
    nloc = mine > 0u ? mine : 1u; nx = cnt > 0u ? cnt : 1u;
}

__device__ __forceinline__ void xcd_barrier(const XcdBarrier& b) {
    asm volatile("s_waitcnt vmcnt(0)" ::: "memory");
    __syncthreads();
    if (threadIdx.x == 0) {
        unsigned* bar = b.bar;
        __builtin_amdgcn_s_waitcnt(0);
        unsigned nloc = b.st[0], nx = b.st[1];
        if (nloc == 0u) { xcd_barrier_complete(bar, b.x, nloc, nx); b.st[0] = nloc; b.st[1] = nx; }
        const unsigned old = xb_add(&bar[XB_XSUB(b.x)], 1u);
        const unsigned gen = old / nloc;
        if (old + 1u == (gen + 1u) * nloc) {
            __builtin_amdgcn_fence(__ATOMIC_RELEASE, "agent");
            asm volatile("s_waitcnt vmcnt(0)" ::: "memory");
            const unsigned og = xb_add(&bar[XB_TOP], 1u);
            const unsigned tg = og / nx;
            if (og + 1u == (tg + 1u) * nx) xb_add(&bar[XB_TOPGEN], 1u);
            else XB_SPIN(xb_ld(&bar[XB_TOPGEN]) == tg, bar);
            __builtin_amdgcn_fence(__ATOMIC_ACQUIRE, "agent");
            xb_add(&bar[XB_XGEN(b.x)], 1u);
            asm volatile("s_waitcnt vmcnt(0)" ::: "memory");
        } else {
            XB_SPIN(xb_ld(&bar[XB_XGEN(b.x)]) == gen, bar);
            __builtin_amdgcn_fence(__ATOMIC_ACQUIRE, "agent");
            asm volatile("s_waitcnt vmcnt(0)" ::: "memory");
        }
    }
    __syncthreads();
}

__device__ __forceinline__ float wave_sum(float s) {
#pragma unroll
    for (int o = 32; o >= 1; o >>= 1) s += __shfl_xor(s, o);
    return s;
}
__device__ __forceinline__ void rmsnorm_row_bf(const float* __restrict__ xr, const float* __restrict__ gain, u16* __restrict__ ob, int lane) {
    f32x4 v[8]; float s = 0.f;
#pragma unroll
    for (int j = 0; j < 8; ++j) { v[j] = *(const f32x4*)(xr + (lane + 64 * j) * 4); s += v[j][0] * v[j][0] + v[j][1] * v[j][1] + v[j][2] * v[j][2] + v[j][3] * v[j][3]; }
    s = wave_sum(s);
    const float r = rsqrtf(s * (1.0f / (float)DM) + EPS);
#pragma unroll
    for (int j = 0; j < 8; ++j) { const f32x4 g = *(const f32x4*)(gain + (lane + 64 * j) * 4); const f32x4 o = v[j] * r * g;
        *(u32x2*)(ob + (lane + 64 * j) * 4) = (u32x2){pk_bf16(o[0], o[1]), pk_bf16(o[2], o[3])}; }
}
__device__ __forceinline__ void hgrn_final_item4(int item0, int stride, const float* __restrict__ OF, const float* __restrict__ OB, const u16* __restrict__ PG, const float* __restrict__ gain, u16* __restrict__ MIXB, int lane) {
    f32x2 a[4], b[4]; unsigned gw[4];
#pragma unroll
    for (int q = 0; q < 4; ++q) { const int item = item0 + q * stride, tok = item >> 3, c = (item & 7) * 128 + 2 * lane;
        a[q] = *(const f32x2*)(OF + (size_t)tok * HGW + c); b[q] = *(const f32x2*)(OB + (size_t)tok * HGW + c); gw[q] = *(const unsigned*)(PG + (size_t)tok * 5120 + 4096 + c); }
#pragma unroll
    for (int q = 0; q < 4; ++q) { const int item = item0 + q * stride, tok = item >> 3, c = (item & 7) * 128 + 2 * lane;
        const float o0 = a[q][0] + b[q][0], o1 = a[q][1] + b[q][1];
        const float s = wave_sum(o0 * o0 + o1 * o1);
        const float r = rsqrtf(s * (1.0f / 128.0f) + EPS);
        const float g0 = bflo(gw[q]), g1 = bfhi(gw[q]);
        const f32x2 gn = *(const f32x2*)(gain + c);
        const float v0 = o0 * r * gn[0] * (g0 / (1.0f + __expf(-g0))), v1 = o1 * r * gn[1] * (g1 / (1.0f + __expf(-g1)));
        *(u16*)((unsigned char*)MIXB + (size_t)tok * DM + c) = (u16)(__builtin_amdgcn_cvt_pk_fp8_f32(v0, v1, 0, false) & 0xffff); }
}
__device__ __forceinline__ void hy_norm_tile(LAS unsigned char* lds, int tile_i, const u16* __restrict__ Z2T, const float* __restrict__ gain, u16* __restrict__ MIXB) {
    const int t = tid_fresh(), tok0 = tile_i * 32;
    LAS float* ssq = (LAS float*)(lds + 1024 * 80);
    if (t < 32) ssq[t] = 0.f;
    __syncthreads();
    float part[8];
#pragma unroll
    for (int q = 0; q < 8; ++q) part[q] = 0.f;
    const int ch = t & 3;
#pragma unroll
    for (int it = 0; it < 8; ++it) {
        const int c = (t >> 2) + 128 * it;
        const u32x4 v = *(const u32x4*)(Z2T + (size_t)c * NTOK + tok0 + ch * 8);
        *(LAS u32x4*)(lds + c * 80 + ch * 16) = v;
#pragma unroll
        for (int q = 0; q < 4; ++q) { const float a = bflo(v[q]), b = bfhi(v[q]); part[2 * q] += a * a; part[2 * q + 1] += b * b; }
    }
#pragma unroll
    for (int q = 0; q < 8; ++q) { float s = part[q]; s += __shfl_xor(s, 4); s += __shfl_xor(s, 8); s += __shfl_xor(s, 16); s += __shfl_xor(s, 32); part[q] = s; }
    if ((t & 63) < 4) {
#pragma unroll
        for (int q = 0; q < 8; ++q) atomicAdd((float*)(ssq + ch * 8 + q), part[q]);
    }
    __syncthreads();
    const int tt = t >> 4;
    const float r = rsqrtf(ssq[tt] * (1.0f / (float)HYW) + EPS);
#pragma unroll 2
    for (int k = 0; k < 8; ++k) {
        const int c0 = ((t & 15) + 16 * k) * 8;
        float o[8];
#pragma unroll
        for (int q = 0; q < 8; ++q) o[q] = bf2f(*(const LAS u16*)(lds + (c0 + q) * 80 + tt * 2)) * r * gain[c0 + q];
        *(u32x2*)((unsigned char*)MIXB + (size_t)(tok0 + tt) * DM + 1024 + c0) = (u32x2){pk_fp8x4(o[0], o[1], o[2], o[3]), pk_fp8x4(o[4], o[5], o[6], o[7])};
    }
    __syncthreads();
}
constexpr int RT_XSTRIDE = 2049;
constexpr int RT_PART = 16 * RT_XSTRIDE * 4;
constexpr int RT_LG = RT_PART + 8 * 16 * 32 * 4;
constexpr int RT_HIST = RT_LG + 16 * 32 * 4;
constexpr int RT_ITEMS = RT_HIST + 128;
constexpr int RT_RBASE = RT_ITEMS + 512;
constexpr int RT_END = RT_RBASE + 128;
__device__ __forceinline__ void router_tile(LAS unsigned char* lds, int tile_i, const float* __restrict__ X1, const float* __restrict__ gain, const float* __restrict__ wr, const float* __restrict__ br,
                                            unsigned char* __restrict__ XN8, float* __restrict__ TOPG, int tl2) {
    const int tid = tid_fresh(), wid = __builtin_amdgcn_readfirstlane(tid >> 6), lane = tid & 63;
    const int tok0 = tile_i * 16;
    LAS float* xs = (LAS float*)lds;
#pragma unroll
    for (int q = 0; q < 2; ++q) {
        const int tl = wid * 2 + q; const size_t tok = (size_t)tok0 + tl;
        const float* xr = X1 + tok * DM;
        f32x4 v[8]; float s = 0.f;
#pragma unroll
        for (int j = 0; j < 8; ++j) { v[j] = *(const f32x4*)(xr + (lane + 64 * j) * 4); s += v[j][0] * v[j][0] + v[j][1] * v[j][1] + v[j][2] * v[j][2] + v[j][3] * v[j][3]; }
        s = wave_sum(s);
        const float r = rsqrtf(s * (1.0f / (float)DM) + EPS);
#pragma unroll
        for (int j = 0; j < 8; ++j) { const int d = (lane + 64 * j) * 4; const f32x4 g = *(const f32x4*)(gain + d); const f32x4 o = v[j] * r * g;
            xs[tl * RT_XSTRIDE + d + 0] = o[0]; xs[tl * RT_XSTRIDE + d + 1] = o[1]; xs[tl * RT_XSTRIDE + d + 2] = o[2]; xs[tl * RT_XSTRIDE + d + 3] = o[3];
            *(unsigned*)(XN8 + tok * DM + d) = pk_fp8x4(o[0], o[1], o[2], o[3]); }
    }
    __syncthreads();
    {
        const int tl = lane & 15, kk = lane >> 4;
        f32x4 a0 = {0.f, 0.f, 0.f, 0.f}, a1 = a0;
        const LAS float* xp = xs + tl * RT_XSTRIDE + wid * 256 + kk;
        const float* wp = wr + (size_t)(wid * 256 + kk) * NE + tl;
#pragma unroll 8
        for (int ks = 0; ks < 64; ++ks) { const float a = xp[ks * 4]; const float b0 = wp[(size_t)ks * 4 * NE], b1 = wp[(size_t)ks * 4 * NE + 16];
            a0 = __builtin_amdgcn_mfma_f32_16x16x4f32(a, b0, a0, 0, 0, 0); a1 = __builtin_amdgcn_mfma_f32_16x16x4f32(a, b1, a1, 0, 0, 0); }
        LAS float* pp = (LAS float*)(lds + RT_PART) + wid * 512;
#pragma unroll
        for (int j = 0; j < 4; ++j) { pp[(kk * 4 + j) * 32 + tl] = a0[j]; pp[(kk * 4 + j) * 32 + 16 + tl] = a1[j]; }
    }
    __syncthreads();
    {   const LAS float* pp = (const LAS float*)(lds + RT_PART); float s = br[tid & 31];
#pragma unroll
        for (int w = 0; w < 8; ++w) s += pp[w * 512 + tid];
        ((LAS float*)(lds + RT_LG))[tid] = s; }
    __syncthreads();
    if (tid < 16) {
        LAS float* lg = (LAS float*)(lds + RT_LG) + tid * 32;
        int i0 = 0, i1 = 0, i2 = 0, i3 = 0; float v0, v1, v2, v3;
        { float bv = -3.0e38f; for (int j = 0; j < NE; ++j) { const float l = lg[j]; if (l > bv) { bv = l; i0 = j; } } v0 = bv; lg[i0] = -3.4e38f; }
        { float bv = -3.0e38f; for (int j = 0; j < NE; ++j) { const float l = lg[j]; if (l > bv) { bv = l; i1 = j; } } v1 = bv; lg[i1] = -3.4e38f; }
        { float bv = -3.0e38f; for (int j = 0; j < NE; ++j) { const float l = lg[j]; if (l > bv) { bv = l; i2 = j; } } v2 = bv; lg[i2] = -3.4e38f; }
        { float bv = -3.0e38f; for (int j = 0; j < NE; ++j) { const float l = lg[j]; if (l > bv) { bv = l; i3 = j; } } v3 = bv; lg[i3] = -3.4e38f; }
        const float e1 = __expf(v1 - v0), e2 = __expf(v2 - v0), e3 = __expf(v3 - v0), inv = 1.0f / (1.0f + e1 + e2 + e3);
        const int tok = tok0 + tid;
        *(f32x4*)(TOPG + tok * 4) = (f32x4){inv, e1 * inv, e2 * inv, e3 * inv};
        LAS int* hist = (LAS int*)(lds + RT_HIST);
        const int p0 = atomicAdd((int*)(hist + i0), 1), p1 = atomicAdd((int*)(hist + i1), 1), p2 = atomicAdd((int*)(hist + i2), 1), p3 = atomicAdd((int*)(hist + i3), 1);
        *(LAS u32x4*)(lds + RT_ITEMS + (tl2 * 16 + tid) * 16) = (u32x4){(unsigned)((i0 << 16) | p0), (unsigned)((i1 << 16) | p1), (unsigned)((i2 << 16) | p2), (unsigned)((i3 << 16) | p3)};
    }
    __syncthreads();
}
__device__ __forceinline__ void combine_row(int tok, const float* __restrict__ X1, const u16* __restrict__ YB, const int* __restrict__ SOF, const float* __restrict__ TOPG, const float* __restrict__ gain, float* __restrict__ out, int lane) {
    const int4 sl = *(const int4*)(SOF + tok * 4); const f32x4 g = *(const f32x4*)(TOPG + tok * 4);
    const u16* y0 = YB + (size_t)sl.x * DM; const u16* y1 = YB + (size_t)sl.y * DM; const u16* y2 = YB + (size_t)sl.z * DM; const u16* y3 = YB + (size_t)sl.w * DM;
    f32x4 v[8]; float s = 0.f;
#pragma unroll
    for (int j = 0; j < 8; ++j) { const int d = (lane + 64 * j) * 4;
        f32x4 a = *(const f32x4*)(X1 + (size_t)tok * DM + d);
        const u32x2 q0 = *(const u32x2*)(y0 + d), q1 = *(const u32x2*)(y1 + d), q2 = *(const u32x2*)(y2 + d), q3 = *(const u32x2*)(y3 + d);
        a[0] += g[0] * bflo(q0[0]) + g[1] * bflo(q1[0]) + g[2] * bflo(q2[0]) + g[3] * bflo(q3[0]);
        a[1] += g[0] * bfhi(q0[0]) + g[1] * bfhi(q1[0]) + g[2] * bfhi(q2[0]) + g[3] * bfhi(q3[0]);
        a[2] += g[0] * bflo(q0[1]) + g[1] * bflo(q1[1]) + g[2] * bflo(q2[1]) + g[3] * bflo(q3[1]);
        a[3] += g[0] * bfhi(q0[1]) + g[1] * bfhi(q1[1]) + g[2] * bfhi(q2[1]) + g[3] * bfhi(q3[1]);
        v[j] = a; s += a[0] * a[0] + a[1] * a[1] + a[2] * a[2] + a[3] * a[3]; }
    s = wave_sum(s);
    const float r = rsqrtf(s * (1.0f / (float)DM) + EPS);
#pragma unroll
    for (int j = 0; j < 8; ++j) { const int d = (lane + 64 * j) * 4; const f32x4 gn = *(const f32x4*)(gain + d); *(f32x4*)(out + (size_t)tok * DM + d) = v[j] * r * gn; }
}

__device__ __forceinline__ void combine_row2(int tokA, int tokB, const float* __restrict__ X1, const u16* __restrict__ YB, const int* __restrict__ SOF, const float* __restrict__ TOPG, const float* __restrict__ gain, float* __restrict__ out, int lane) {
    const int4 slA = *(const int4*)(SOF + tokA * 4), slB = *(const int4*)(SOF + tokB * 4); const f32x4 gA = *(const f32x4*)(TOPG + tokA * 4), gB = *(const f32x4*)(TOPG + tokB * 4);
    const u16* yA0 = YB + (size_t)slA.x * DM; const u16* yA1 = YB + (size_t)slA.y * DM; const u16* yA2 = YB + (size_t)slA.z * DM; const u16* yA3 = YB + (size_t)slA.w * DM;
    const u16* yB0 = YB + (size_t)slB.x * DM; const u16* yB1 = YB + (size_t)slB.y * DM; const u16* yB2 = YB + (size_t)slB.z * DM; const u16* yB3 = YB + (size_t)slB.w * DM;
    f32x4 vA[8], vB[8]; float sA = 0.f, sB = 0.f;
#pragma unroll
    for (int j = 0; j < 8; ++j) { const int d = (lane + 64 * j) * 4;
        f32x4 a = *(const f32x4*)(X1 + (size_t)tokA * DM + d), b = *(const f32x4*)(X1 + (size_t)tokB * DM + d);
        const u32x2 p0 = *(const u32x2*)(yA0 + d), p1 = *(const u32x2*)(yA1 + d), p2 = *(const u32x2*)(yA2 + d), p3 = *(const u32x2*)(yA3 + d);
        const u32x2 q0 = *(const u32x2*)(yB0 + d), q1 = *(const u32x2*)(yB1 + d), q2 = *(const u32x2*)(yB2 + d), q3 = *(const u32x2*)(yB3 + d);
        a[0] += gA[0] * bflo(p0[0]) + gA[1] * bflo(p1[0]) + gA[2] * bflo(p2[0]) + gA[3] * bflo(p3[0]);
        a[1] += gA[0] * bfhi(p0[0]) + gA[1] * bfhi(p1[0]) + gA[2] * bfhi(p2[0]) + gA[3] * bfhi(p3[0]);
        a[2] += gA[0] * bflo(p0[1]) + gA[1] * bflo(p1[1]) + gA[2] * bflo(p2[1]) + gA[3] * bflo(p3[1]);
        a[3] += gA[0] * bfhi(p0[1]) + gA[1] * bfhi(p1[1]) + gA[2] * bfhi(p2[1]) + gA[3] * bfhi(p3[1]);
        b[0] += gB[0] * bflo(q0[0]) + gB[1] * bflo(q1[0]) + gB[2] * bflo(q2[0]) + gB[3] * bflo(q3[0]);
        b[1] += gB[0] * bfhi(q0[0]) + gB[1] * bfhi(q1[0]) + gB[2] * bfhi(q2[0]) + gB[3] * bfhi(q3[0]);
        b[2] += gB[0] * bflo(q0[1]) + gB[1] * bflo(q1[1]) + gB[2] * bflo(q2[1]) + gB[3] * bflo(q3[1]);
        b[3] += gB[0] * bfhi(q0[1]) + gB[1] * bfhi(q1[1]) + gB[2] * bfhi(q2[1]) + gB[3] * bfhi(q3[1]);
        vA[j] = a; vB[j] = b; sA += a[0] * a[0] + a[1] * a[1] + a[2] * a[2] + a[3] * a[3]; sB += b[0] * b[0] + b[1] * b[1] + b[2] * b[2] + b[3] * b[3]; }
    sA = wave_sum(sA); sB = wave_sum(sB);
    const float rA = rsqrtf(sA * (1.0f / (float)DM) + EPS), rB = rsqrtf(sB * (1.0f / (float)DM) + EPS);
#pragma unroll
    for (int j = 0; j < 8; ++j) { const int d = (lane + 64 * j) * 4; const f32x4 gn = *(const f32x4*)(gain + d);
        *(f32x4*)(out + (size_t)tokA * DM + d) = vA[j] * rA * gn; *(f32x4*)(out + (size_t)tokB * DM + d) = vB[j] * rB * gn; }
}
#ifndef REP_P9
#define REP_P9 1
#endif
#ifndef REP_P3
#define REP_P3 1
#endif
#ifndef REP_FR
#define REP_FR 1
#endif
#ifndef REP_P0
#define REP_P0 1
#endif
#ifndef REP_CONV
#define REP_CONV 1
#endif
#ifndef REP_GEMM1
#define REP_GEMM1 1
#endif
#ifndef REP_HY
#define REP_HY 1
#endif
#ifndef REP_HG
#define REP_HG 1
#endif
#ifndef REP_MOEA
#define REP_MOEA 1
#endif
#ifndef REP_MOEB
#define REP_MOEB 1
#endif
#ifndef REP_WOUT
#define REP_WOUT 1
#endif
struct MegaP {
    const float *x, *norm_mix_gain, *w_in, *lb_logits, *hgrn_norm_gain, *hy_conv_w, *hy_conv_b, *fw1, *fb1, *fw2, *fb2, *fw3, *fb3, *fw4, *ffreq, *hy_bias, *hy_norm_gain, *w_out,
        *norm_ffn_gain, *w_router, *b_router, *moe_w1, *moe_b1, *moe_w2, *moe_b2, *final_gain;
    float* out; unsigned char* ws;
};
constexpr int MEGA_XB = RT_END;
constexpr int MEGA_LDS = RT_END + 64 + 384;
static_assert(MEGA_LDS >= HY_LDS + 64 && MEGA_LDS >= HG_LDS + 64 && MEGA_LDS >= GEMM_LDS + 64, "LDS");

__global__ void __launch_bounds__(512, 2) k_mega(const MegaP p_arg) {
    extern __shared__ __attribute__((aligned(16))) unsigned char shm[];
    LAS unsigned char* lds = (LAS unsigned char*)shm;
    const int tid = threadIdx.x, wid = __builtin_amdgcn_readfirstlane(tid >> 6), lane = tid & 63;
    const int G = gridDim.x, bid = blockIdx.x, c = xcd_logical(bid, G);
#define PHASE_ARGS() const MegaP __attribute__((address_space(4)))* pq_ = (const MegaP __attribute__((address_space(4)))*)__builtin_amdgcn_kernarg_segment_ptr(); asm volatile("" : "+s"(pq_)); unsigned char* ws = pq_->ws; (void)ws
    unsigned char* ws0; { PHASE_ARGS(); ws0 = ws; }
#define counts ((int*)(ws + WS_CTL))
#define cursor ((int*)(ws + WS_CTL + 4096))
#define offs ((int*)(ws + WS_CTL + 8192))
#define barw ((unsigned*)(ws + WS_CTL + 16384))
#define HB ((u16*)(ws + WS_HB))
#define PG ((u16*)(ws + WS_PG))
#define HYT ((u16*)(ws + WS_HYT))
#define MIXB ((u16*)(ws + WS_MIXB))
#define XNB ((u16*)(ws + WS_XNB))
#define HMB ((u16*)(ws + WS_HMS))
#define YB ((u16*)(ws + WS_YS))
#define H3 ((float*)(ws + WS_H3))
#define FR ((u16*)(ws + WS_FR))
#define Z2T ((u16*)(ws + WS_Z2T))
#define OF ((float*)(ws + WS_OF))
#define OB ((float*)(ws + WS_OB))
#define X1 ((float*)(ws + WS_X1))
#define TOPI ((int*)(ws + WS_TOPI))
#define TOPG ((float*)(ws + WS_TOPG))
#define STOK ((int*)(ws + WS_STOKS))
#define SOF ((int*)(ws + WS_SOF))
#define WINT ((u16*)(ws + WS_WINT))
#define WOUTT ((u16*)(ws + WS_WOUTT))
#define W1T ((u16*)(ws + WS_W1T))
#define W2T ((u16*)(ws + WS_W2T))
    if (tid == 0) *(LAS u32x4*)(lds + MEGA_XB) = (u32x4){0u, 0u, 0u, 0u};
    __syncthreads();
    XcdBarrier bar = xcd_barrier_post((unsigned*)(ws0 + WS_CTL + 16384), (volatile LAS unsigned*)(lds + MEGA_XB));

    {
        PHASE_ARGS();
    for (int rep = 0; rep < REP_P0; ++rep) {
    for (int row = bid * 8 + wid; row < NTOK; row += G * 8) rmsnorm_row_bf(pq_->x + (size_t)row * DM, pq_->norm_mix_gain, HB + (size_t)row * DM, lane);
    for (int m = bid * 8 + wid; m < SEQ; m += G * 8) h3_row(m, pq_->fw1, pq_->fb1, pq_->fw2, pq_->fb2, pq_->fw3, pq_->fb3, pq_->ffreq, (LAS float*)(lds + wid * 512), H3); }
    for (int rep = 0; rep < REP_CONV; ++rep)
    for (int id = bid; id < 1024 + 256; id += G) {
        const int tz = tid_fresh();
        if (id < 1024) { const int nt = id >> 5, kt = id & 31; convert_tile(pq_->w_in, DIN, kt * 64, ColMapPerm{nt * 256}, WINT + (size_t)id * 16384, tz); }
        else { const int q = id - 1024; const ConvCtx cw{nullptr, pq_->w_out, nullptr, (unsigned char*)WOUTT};
            f32x2 cv[16]; conv_issue(cw, 16384 + q, tz >> 6, tz & 63, cv); conv_finish(cw, 16384 + q, tz >> 6, tz & 63, cv); }
    }
    }
    xcd_barrier(bar);
    {
        PHASE_ARGS();
    for (int rep = 0; rep < REP_FR; ++rep)
    for (int item = bid; item < 256; item += G) frgen_item(lds, item, H3, pq_->fw4, FR);
    { SrcG1<false> s0{c, G, (const char*)HB, (const char*)WINT, PG, HYT}; gemm8_stream<false, false>(lds, DM, 32, s0);
      SrcG1<true> s1{c, G, (const char*)HB, (const char*)WINT, PG, HYT}; gemm8_stream<true, false>(lds, DM, 32, s1); }
#ifdef PROBE_NOEPI
    for (int u = c; u < 1024; u += G) {
        const int i = u >> 8, xx = (u >> 5) & 7, j = u & 31;
        const int mt = (xx & 3) * 8 + (j & 7), nt = ((xx >> 2) + 2 * i) * 4 + (j >> 3);
        const u16* bt = WINT + (size_t)nt * 32 * 16384;
        EpiNone e{}; if (nt < 20) gemm8_unit<false>(lds, HB, DM, nullptr, mt * 256, 256, bt, 32, e); else gemm8_unit<true>(lds, HB, DM, nullptr, mt * 256, 256, bt, 32, e);
    }
#endif
    }
    xcd_barrier(bar);
    {
        PHASE_ARGS();
    for (int rep = 0; rep < REP_HY; ++rep)
    for (int u = bid; u < 256; u += G) hyena_unit(lds, u, HYT, FR, pq_->hy_conv_w, pq_->hy_conv_b, pq_->hy_bias, Z2T, ConvCtx{pq_->moe_w1, pq_->moe_w2, (unsigned char*)W1T, (unsigned char*)W2T});
    for (int rep = 0; rep < REP_HG; ++rep)
    for (int u = bid; u < 256; u += G) hgrn_unit(lds, u, PG, pq_->lb_logits, OF, OB, ConvCtx{pq_->moe_w1, pq_->moe_w2, (unsigned char*)W1T, (unsigned char*)W2T});
    }
    xcd_barrier(bar);
    {
        PHASE_ARGS();
    for (int rep = 0; rep < REP_P3; ++rep) {
    for (int it = bid * 8 + wid; it < NTOK * HGH; it += G * 8 * 4) hgrn_final_item4(it, G * 8, OF, OB, PG, pq_->hgrn_norm_gain, MIXB, lane);
    for (int t = bid; t < NTOK / 32; t += G) hy_norm_tile(lds, t, Z2T, pq_->hy_norm_gain, MIXB); }
    }
    xcd_barrier(bar);
    {
        PHASE_ARGS();
    for (int u = c; u < 256; u += G) {
        const int xx = u >> 5, j = u & 31;
        const int mt = (xx >> 1) * 8 + (j & 7), nt = (xx & 1) * 4 + (j >> 3);
        Epi8X1 e{pq_->x, X1, mt * 256, nt * 256};
        gemm8_unit<false, true>(lds, MIXB, DM / 2, nullptr, mt * 256, 256, WOUTT + (size_t)nt * 16 * 16384, 16, e);
    }
    }
    xcd_barrier(bar);
    {
        PHASE_ARGS();
    if (tid < NE) *(LAS int*)(lds + RT_HIST + tid * 4) = 0;
    __syncthreads();
    for (int t0 = bid; t0 < NTOK / 16; t0 += 2 * G) {
        const int t1 = t0 + G, ntl = (t1 < NTOK / 16) ? 2 : 1;
        router_tile(lds, t0, X1, pq_->norm_ffn_gain, pq_->w_router, pq_->b_router, (unsigned char*)XNB, TOPG, 0);
        if (ntl == 2) router_tile(lds, t1, X1, pq_->norm_ffn_gain, pq_->w_router, pq_->b_router, (unsigned char*)XNB, TOPG, 1);
        const int tq = tid_fresh();
        if (tq < NE) { const int n = *(const LAS int*)(lds + RT_HIST + tq * 4); *(LAS int*)(lds + RT_RBASE + tq * 4) = n ? atomicAdd(&cursor[tq * 32], n) : 0; *(LAS int*)(lds + RT_HIST + tq * 4) = 0; }
        __syncthreads();
        if (tq < ntl * 64) { const int it = *(const LAS int*)(lds + RT_ITEMS + tq * 4), e = it >> 16, tok = ((tq >> 6) ? t1 : t0) * 16 + ((tq >> 2) & 15);
            const int slot = e * NTOK + *(const LAS int*)(lds + RT_RBASE + e * 4) + (it & 0xffff); STOK[slot] = tok; SOF[tok * 4 + (tq & 3)] = slot; }
        __syncthreads();
    }
    }
    xcd_barrier(bar);
    {
        PHASE_ARGS();
    {
        LAS int* us = (LAS int*)(lds + MEGA_XB + 64); LAS int* so2 = us + 40;
        if (tid < NE) so2[tid] = __hip_atomic_load(&cursor[tid * 32], __ATOMIC_RELAXED, __HIP_MEMORY_SCOPE_AGENT);
        __syncthreads();
        if (tid == 0) { int a = 0; for (int e = 0; e < NE; ++e) { us[e] = a; a += ((so2[e] + 255) >> 8) * 16; } us[NE] = a; }
        __syncthreads();
    }
    {
        LAS int* qs = (LAS int*)(lds + MEGA_XB + 32); LAS int* us = (LAS int*)(lds + MEGA_XB + 64); LAS int* so2 = us + 40;
        int* qctr = (int*)(ws + WS_CTL + 12288 + (bid & 7) * 128);
        int tk_next = 0;
        if (tid == 0) tk_next = atomicAdd(qctr, 1);
        for (;;) {
            if (tid == 0) { qs[0] = tk_next; qs[1] = -1; }
            __syncthreads();
            const int tk = qs[0];
            const int u = 256 * (tk >> 5) + 32 * (bid & 7) + (tk & 31);
            if (tid < NE) { const int u0 = us[tid], u1 = us[tid + 1]; if (u >= u0 && u < u1) { const int o0 = tid * NTOK, cnt = so2[tid], mtl = (cnt + 255) >> 8, ul = u - u0, mt = ul % mtl;
                int rows = cnt - mt * 256; rows = rows > 256 ? 256 : rows; qs[1] = tid; qs[2] = ul / mtl; qs[3] = o0 + mt * 256; qs[4] = rows; } }
            __syncthreads();
            const int e = qs[1], nt = qs[2], slot0 = qs[3], rows = qs[4];
            __syncthreads();
            if (e < 0) break;
            if (tid == 0) tk_next = atomicAdd(qctr, 1);
            Epi8Swiglu8 ep{(unsigned char*)HMB, pq_->moe_b1 + (size_t)e * 2 * DFF, slot0, nt, rows};
            gemm8_unit<false, true>(lds, XNB, DM / 2, STOK + slot0, 0, rows, W1T + (size_t)(e * 16 + nt) * 16 * 16384, 16, ep);
        }
    }
    }
    xcd_barrier(bar);
    {
        PHASE_ARGS();
    {
        LAS int* us = (LAS int*)(lds + MEGA_XB + 64); LAS int* so2 = us + 40;
        if (tid < NE) so2[tid] = __hip_atomic_load(&cursor[tid * 32], __ATOMIC_RELAXED, __HIP_MEMORY_SCOPE_AGENT);
        __syncthreads();
        if (tid == 0) { int a = 0; for (int e = 0; e < NE; ++e) { us[e] = a; a += ((so2[e] + 255) >> 8) * 8; } us[NE] = a; }
        __syncthreads();
    }
    {
        const LAS int* us = (const LAS int*)(lds + MEGA_XB + 64); const LAS int* so2 = us + 40;
        SrcMoeB src{us, so2, c, G, (const char*)HMB, (const char*)W2T, YB, pq_->moe_b2};
        gemm8_stream<false, true>(lds, DFF / 2, 16, src);
    }
    }
    xcd_barrier(bar);
    {
        PHASE_ARGS();
    for (int rep = 0; rep < REP_P9; ++rep)
    for (int tok = bid * 8 + wid; tok < NTOK; tok += G * 8) combine_row(tok, X1, YB, SOF, TOPG, pq_->final_gain, pq_->out, lane);
    }
}
#undef counts
#undef cursor
#undef offs
#undef barw
#undef HB
#undef PG
#undef HYT
#undef MIXB
#undef XNB
#undef HMB
#undef YB
#undef H3
#undef FR
#undef Z2T
#undef OF
#undef OB
#undef X1
#undef TOPI
#undef TOPG
#undef STOK
#undef SOF
#undef WINT
#undef WOUTT
#undef W1T
#undef W2T

extern "C" void kernel_launch(void* const* d_in, const int* in_sizes, int n_in, void* d_out, int out_size, void* d_ws, size_t ws_size, hipStream_t stream) {
    if (n_in < 26 || ws_size < WS_END2) return;
    MegaP p{};
    const float** pp = (const float**)&p;
    for (int i = 0; i < 26; ++i) pp[i] = (const float*)d_in[i];
    p.out = (float*)d_out; p.ws = (unsigned char*)d_ws;
    static int grid = 0;
    if (!grid) {
        int dev = 0, cus = 0, per_cu = 0;
        (void)hipGetDevice(&dev);
        (void)hipDeviceGetAttribute(&cus, hipDeviceAttributeMultiprocessorCount, dev);
        (void)hipFuncSetAttribute((const void*)k_mega, hipFuncAttributeMaxDynamicSharedMemorySize, MEGA_LDS);
        (void)hipOccupancyMaxActiveBlocksPerMultiprocessor(&per_cu, (const void*)k_mega, 512, MEGA_LDS);
        if (per_cu < 1) per_cu = 1;
        grid = cus * 1;
        if (grid > 256) grid = 256;
        grid &= ~7;
        if (grid < 8) grid = 8;
    }
    (void)hipMemsetAsync((char*)d_ws + WS_CTL, 0, 65536, stream);
    hipLaunchKernelGGL(k_mega, dim3(grid), dim3(512), MEGA_LDS, stream, p);
}
```

```cpp
#include <hip/hip_runtime.h>
#include <stdint.h>

constexpr int BATCH = 4, SEQ = 2048, DM = 2048, NTOK = BATCH * SEQ;
constexpr int HGW = 1024, HGD = 128, HGH = 8;
constexpr int HYW = 1024;
constexpr int DIN = 8192;
constexpr int NE = 32, TOPK = 4, DFF = 2048;
constexpr int NSLOT = NTOK * TOPK;
constexpr float EPS = 1e-5f;

constexpr size_t MB = 1024ull * 1024ull;
constexpr size_t WS_CTL = 0;
constexpr size_t WS_HB = 1 * MB;
constexpr size_t WS_PG = WS_HB + 32 * MB;
constexpr size_t WS_HYT = WS_PG + 80 * MB;
constexpr size_t WS_MIXB = WS_HYT + 48 * MB;
constexpr size_t WS_XNB = WS_MIXB + 32 * MB;
constexpr size_t WS_HMB = WS_XNB + 32 * MB;
constexpr size_t WS_YB = WS_HMB + 128 * MB;
constexpr size_t WS_H3 = WS_YB + 128 * MB;
constexpr size_t WS_FR = WS_H3 + 1 * MB;
constexpr size_t WS_Z2T = WS_FR + 34 * MB;
constexpr size_t WS_OF = WS_Z2T + 16 * MB;
constexpr size_t WS_OB = WS_OF + 32 * MB;
constexpr size_t WS_X1 = WS_OB + 32 * MB;
constexpr size_t WS_TOPI = WS_X1 + 64 * MB;
constexpr size_t WS_TOPG = WS_TOPI + 1 * MB;
constexpr size_t WS_STOK = WS_TOPG + 1 * MB;
constexpr size_t WS_SOF = WS_STOK + 1 * MB;
constexpr size_t WS_WINT = WS_SOF + 1 * MB;
constexpr size_t WS_WOUTT = WS_WINT + 32 * MB;
constexpr size_t WS_W1T = WS_WOUTT + 8 * MB;
constexpr size_t WS_W2T = WS_W1T + 512 * MB;
constexpr size_t WS_HMS = WS_W2T + 256 * MB;
constexpr size_t WS_YS = WS_HMS + 512 * MB;
constexpr size_t WS_STOKS = WS_YS + 1024 * MB;
constexpr size_t WS_END2 = WS_STOKS + 1 * MB;

typedef short bf16x8 __attribute__((ext_vector_type(8)));
typedef float f32x4 __attribute__((ext_vector_type(4)));
typedef float f32x2 __attribute__((ext_vector_type(2)));
typedef unsigned u32x4 __attribute__((ext_vector_type(4)));
typedef unsigned u32x2 __attribute__((ext_vector_type(2)));
typedef unsigned short u16;
#define LAS __attribute__((address_space(3)))

__device__ __forceinline__ unsigned pk_bf16(float lo, float hi) {
    typedef __bf16 bf2 __attribute__((ext_vector_type(2)));
    const f32x2 v = {lo, hi};
    const bf2 r = __builtin_convertvector(v, bf2);
    return __builtin_bit_cast(unsigned, r);
}
__device__ __forceinline__ float bf2f(u16 b) { return __uint_as_float(((unsigned)b) << 16); }
__device__ __forceinline__ float bflo(unsigned w) { return __uint_as_float(w << 16); }
__device__ __forceinline__ float bfhi(unsigned w) { return __uint_as_float(w & 0xffff0000u); }

__device__ __forceinline__ int lds_byte(int r, int c) { const int st = (r >> 4) * 2 + (c >> 5), ob = (r & 15) * 64 + (c & 31) * 2; return st * 1024 + (ob ^ (((ob >> 9) & 1) << 5)); }
__device__ __forceinline__ void stage_rc(int b, int& R, int& C) { const int st = b >> 10, sb = b & 1023, swz = sb ^ (((sb >> 9) & 1) << 5); R = (st >> 1) * 16 + swz / 64; C = (st & 1) * 32 + (swz % 64) / 2; }
__device__ __forceinline__ f32x4 unperm(const f32x4 a, const bool s) { f32x4 o; o[0] = s ? a[1] : a[0]; o[1] = s ? a[0] : a[1]; o[2] = s ? a[3] : a[2]; o[3] = s ? a[2] : a[3]; return o; }

__device__ __forceinline__ int tid_fresh() { int t = threadIdx.x; asm volatile("" : "+v"(t)); return t; }
constexpr int GEMM_LDS = 131072;

template <bool TRANS, bool RAGGED, int PM = 0, class ColMap, class Epi>
__device__ __forceinline__ void gemm_unit(LAS unsigned char* lds, const u16* __restrict__ A, int lda, const int* __restrict__ arows, int arow0, int rows_valid,
                                          const float* __restrict__ B, int ldb, int K, const ColMap colmap, const Epi epi) {
    const int tid = tid_fresh(), wid = __builtin_amdgcn_readfirstlane(tid >> 6), lane = tid & 63;
    const int wr = wid >> 2, wc = wid & 3, fr = lane & 15, fq = lane >> 4;
    const int nt = K >> 6;
    const char* ap[4];
#pragma unroll
    for (int i = 0; i < 4; ++i) {
        int R, C; stage_rc(wid * 1024 + i * 8192 + lane * 16, R, C);
        const int rr = RAGGED ? (R < rows_valid ? R : rows_valid - 1) : R;
        const long rowid = arows ? (long)arows[rr] : (long)(arow0 + rr);
        ap[i] = (const char*)A + ((size_t)rowid * lda + C) * 2;
    }
    const int g = (lane & 3) + 4 * (wid >> 2), rg = (wid & 3) * 16 + (lane >> 2);
    const unsigned bvoff = (unsigned)(((size_t)(8 * g) * ldb + colmap(rg)) * 4);
    const int bbase = 65536 + lds_byte(4 * rg, 8 * g);
    const int bw0 = bbase + ((rg & 1) ? 64 : 0), bw1 = bbase + ((rg & 1) ? 0 : 64);
    const int aoff = lds_byte(wr * 128 + fr, fq * 8), boff = 65536 + lds_byte(wc * 64 + fr, fq * 8);
    int mvalid = 8;
    if (RAGGED) { mvalid = (rows_valid - wr * 128 + 15) >> 4; mvalid = mvalid < 0 ? 0 : (mvalid > 8 ? 8 : mvalid); }
    f32x4 vb0, vb1, vb2, vb3, vb4, vb5, vb6, vb7;
    if (PM & 1) { vb0 = (f32x4){1.f, 1.f, 1.f, 1.f}; vb1 = vb0; vb2 = vb0; vb3 = vb0; vb4 = vb0; vb5 = vb0; vb6 = vb0; vb7 = vb0; }
    f32x4 acc[8][4];
#pragma unroll
    for (int m = 0; m < 8; ++m)
#pragma unroll
        for (int n = 0; n < 4; ++n) acc[m][n] = (f32x4){0.f, 0.f, 0.f, 0.f};
    const size_t ldb4 = (size_t)ldb * 4;
#define GE_GLDS_A(buf, kt) do { if (!(PM & 2)) _Pragma("unroll") for (int _i = 0; _i < 4; ++_i) \
        __builtin_amdgcn_global_load_lds((const unsigned*)(ap[_i] + (size_t)(kt) * 128), (LAS unsigned*)(lds + (buf) * 32768 + wid * 1024 + _i * 8192), 16, 0, 0); } while (0)
#define GE_LD1(dst, sb) if (!(PM & 1)) asm volatile("global_load_dwordx4 %0, %1, %2" : "=v"(dst) : "v"(bvoff), "s"(sb) : "memory")
#define GE_LOAD_B(kt) do { const char* _sb = (const char*)B + (size_t)(kt) * 64 * ldb4; \
        GE_LD1(vb0, _sb); GE_LD1(vb1, _sb + ldb4); GE_LD1(vb2, _sb + 2 * ldb4); GE_LD1(vb3, _sb + 3 * ldb4); \
        GE_LD1(vb4, _sb + 4 * ldb4); GE_LD1(vb5, _sb + 5 * ldb4); GE_LD1(vb6, _sb + 6 * ldb4); GE_LD1(vb7, _sb + 7 * ldb4); } while (0)
#define GE_WAITV_B(n) asm volatile("s_waitcnt vmcnt(" #n ")" : "+v"(vb0), "+v"(vb1), "+v"(vb2), "+v"(vb3), "+v"(vb4), "+v"(vb5), "+v"(vb6), "+v"(vb7) :: "memory")
#define GE_WRITE_B(buf) do { _Pragma("unroll") for (int _i = 0; _i < 4; ++_i) { u32x4 _w; _w[0] = pk_bf16(vb0[_i], vb1[_i]); _w[1] = pk_bf16(vb2[_i], vb3[_i]); \
        _w[2] = pk_bf16(vb4[_i], vb5[_i]); _w[3] = pk_bf16(vb6[_i], vb7[_i]); \
        *(LAS u32x4*)(lds + ((_i & 1) ? bw1 : bw0) + (_i >> 1) * 128 + (buf) * 32768) = _w; } } while (0)
#define GE_KSTEP(buf, ks) do { bf16x8 Bf[4]; \
        _Pragma("unroll") for (int n = 0; n < 4; ++n) Bf[n] = *(const LAS bf16x8*)(lds + (buf) * 32768 + boff + n * 2048 + (ks) * 1024); \
        _Pragma("unroll") for (int mh = 0; mh < 2; ++mh) { bf16x8 At[4]; \
            _Pragma("unroll") for (int m = 0; m < 4; ++m) At[m] = *(const LAS bf16x8*)(lds + (buf) * 32768 + aoff + (mh * 4 + m) * 2048 + (ks) * 1024); \
            _Pragma("unroll") for (int m = 0; m < 4; ++m) { if (!RAGGED || (mh * 4 + m) < mvalid) { _Pragma("unroll") for (int n = 0; n < 4; ++n) \
                { if (PM & 4) { asm volatile("" :: "v"(At[m]), "v"(Bf[n])); } else acc[mh * 4 + m][n] = TRANS ? __builtin_amdgcn_mfma_f32_16x16x32_bf16(At[m], Bf[n], acc[mh * 4 + m][n], 0, 0, 0) : __builtin_amdgcn_mfma_f32_16x16x32_bf16(Bf[n], At[m], acc[mh * 4 + m][n], 0, 0, 0); } } } } } while (0)
    GE_GLDS_A(0, 0);
    GE_LOAD_B(0);
    GE_WAITV_B(0);
    GE_WRITE_B(0);
    GE_LOAD_B(1);
    asm volatile("s_waitcnt lgkmcnt(0)" ::: "memory");
    __builtin_amdgcn_s_barrier();
    int t = 0;
    for (; t < nt - 2; ++t) {
        const int cur = t & 1;
        GE_GLDS_A(cur ^ 1, t + 1);
        GE_KSTEP(cur, 0);
        GE_WAITV_B(4);
        GE_WRITE_B(cur ^ 1);
        GE_LOAD_B(t + 2);
        __builtin_amdgcn_sched_barrier(0);
        GE_KSTEP(cur, 1);
        asm volatile("s_waitcnt vmcnt(8) lgkmcnt(0)" ::: "memory");
        __builtin_amdgcn_s_barrier();
    }
    {
        const int cur = t & 1;
        GE_GLDS_A(cur ^ 1, t + 1);
        GE_KSTEP(cur, 0);
        GE_WAITV_B(4);
        GE_WRITE_B(cur ^ 1);
        GE_KSTEP(cur, 1);
        asm volatile("s_waitcnt vmcnt(0) lgkmcnt(0)" ::: "memory");
        __builtin_amdgcn_s_barrier();
        ++t;
    }
    {
        const int cur = t & 1;
        GE_KSTEP(cur, 0);
        GE_KSTEP(cur, 1);
        asm volatile("s_waitcnt lgkmcnt(0)" ::: "memory");
        __builtin_amdgcn_s_barrier();
    }
#undef GE_GLDS_A
#undef GE_LD1
#undef GE_LOAD_B
#undef GE_WAITV_B
#undef GE_WRITE_B
#undef GE_KSTEP
    __builtin_amdgcn_sched_barrier(0);
    { const int tz = tid_fresh(), wz = __builtin_amdgcn_readfirstlane(tz >> 6), lz = tz & 63;
      epi(acc, wz >> 2, wz & 3, lz & 15, lz >> 4); }
}

__device__ __forceinline__ int xcd_logical(int b, int G) { return (G & 7) ? b : (b & 7) * (G >> 3) + (b >> 3); }

struct ColMapDense { int c0; __device__ __forceinline__ int operator()(int rg) const { return c0 + 4 * rg; } };
struct EpiPG { u16* PG; int tok0, col0;
    __device__ __forceinline__ void operator()(const f32x4 (&acc)[8][4], int wr, int wc, int fr, int fq) const {
#pragma unroll
        for (int m = 0; m < 8; ++m) { u16* rowp = PG + (size_t)(tok0 + wr * 128 + m * 16 + fr) * 5120 + col0 + wc * 64 + 4 * fq;
#pragma unroll
            for (int n = 0; n < 4; ++n) { const f32x4 v = unperm(acc[m][n], fq & 1); u32x2 w; w[0] = pk_bf16(v[0], v[1]); w[1] = pk_bf16(v[2], v[3]); *(u32x2*)(rowp + n * 16) = w; } }
    } };
struct EpiHYT { u16* HYT; int tok0, col0;
    __device__ __forceinline__ void operator()(const f32x4 (&acc)[8][4], int wr, int wc, int fr, int fq) const {
#pragma unroll
        for (int n = 0; n < 4; ++n) { const int rho = wc * 64 + n * 16 + fr; const int col = col0 + (rho & ~3) + ((rho & 3) ^ ((rho >> 2) & 1));
            u16* colp = HYT + (size_t)col * NTOK + tok0 + wr * 128 + 4 * fq;
#pragma unroll
            for (int m = 0; m < 8; ++m) { const f32x4 v = acc[m][n]; u32x2 w; w[0] = pk_bf16(v[0], v[1]); w[1] = pk_bf16(v[2], v[3]); *(u32x2*)(colp + m * 16) = w; } }
    } };
struct EpiX1 { const float* x; float* X1; int tok0, col0;
    __device__ __forceinline__ void operator()(const f32x4 (&acc)[8][4], int wr, int wc, int fr, int fq) const {
#pragma unroll
        for (int m = 0; m < 8; ++m) { const size_t off = (size_t)(tok0 + wr * 128 + m * 16 + fr) * DM + col0 + wc * 64 + 4 * fq;
#pragma unroll
            for (int n = 0; n < 4; ++n) { const f32x4 r = *(const f32x4*)(x + off + n * 16); *(f32x4*)(X1 + off + n * 16) = r + unperm(acc[m][n], fq & 1); }
            asm volatile("" ::: "memory"); }
    } };
struct ColMapGlu { int nt; __device__ __forceinline__ int operator()(int rg) const { const int wcq = rg >> 4, n = (rg >> 2) & 3, f = rg & 3; return (n >> 1) * 2048 + nt * 128 + wcq * 32 + (n & 1) * 16 + f * 4; } };
struct EpiSwiglu { u16* HM; const float* b1; int slot0, nt, rows_valid;
    __device__ __forceinline__ void operator()(const f32x4 (&acc)[8][4], int wr, int wc, int fr, int fq) const {
        f32x4 bg[2], bl[2];
#pragma unroll
        for (int nn = 0; nn < 2; ++nn) { const int col = nt * 128 + wc * 32 + nn * 16 + 4 * fq; bg[nn] = *(const f32x4*)(b1 + col); bl[nn] = *(const f32x4*)(b1 + 2048 + col); }
#pragma unroll
        for (int m = 0; m < 8; ++m) { const int row = wr * 128 + m * 16 + fr;
            if (row < rows_valid) {
#pragma unroll
                for (int nn = 0; nn < 2; ++nn) { const f32x4 gl = unperm(acc[m][nn], fq & 1) + bg[nn], li = unperm(acc[m][nn + 2], fq & 1) + bl[nn]; float o[4];
#pragma unroll
                    for (int j = 0; j < 4; ++j) { const float gq = fminf(gl[j], 7.0f), lq = fminf(fmaxf(li[j], -7.0f), 7.0f); o[j] = gq * (1.0f / (1.0f + __expf(-1.702f * gq))) * (lq + 1.0f); }
                    u32x2 w; w[0] = pk_bf16(o[0], o[1]); w[1] = pk_bf16(o[2], o[3]);
                    *(u32x2*)(HM + (size_t)(slot0 + row) * DFF + nt * 128 + wc * 32 + nn * 16 + 4 * fq) = w; } } }
    } };
struct EpiY { u16* Y; const float* b2; int slot0, col0, rows_valid;
    __device__ __forceinline__ void operator()(const f32x4 (&acc)[8][4], int wr, int wc, int fr, int fq) const {
        f32x4 bv[4];
#pragma unroll
        for (int n = 0; n < 4; ++n) bv[n] = *(const f32x4*)(b2 + col0 + wc * 64 + n * 16 + 4 * fq);
#pragma unroll
        for (int m = 0; m < 8; ++m) { const int row = wr * 128 + m * 16 + fr;
            if (row < rows_valid) { u16* rowp = Y + (size_t)(slot0 + row) * DM + col0 + wc * 64 + 4 * fq;
#pragma unroll
                for (int n = 0; n < 4; ++n) { const f32x4 v = unperm(acc[m][n], fq & 1) + bv[n]; u32x2 w; w[0] = pk_bf16(v[0], v[1]); w[1] = pk_bf16(v[2], v[3]); *(u32x2*)(rowp + n * 16) = w; } } }
    } };
template <int NTILES>
__device__ __forceinline__ bool moe_decode(const int* __restrict__ offs, int u, int& e, int& mt, int& nt, int& slot0, int& rows) {
    int base = 0;
    for (int q = 0; q < NE; ++q) { const int o0 = offs[q], cnt = offs[q + 1] - o0, mtl = (cnt + 255) >> 8, nu = mtl * NTILES;
        if (u < base + nu) { const int ul = u - base; e = q; mt = ul % mtl; nt = ul / mtl; slot0 = o0 + mt * 256; rows = cnt - mt * 256; if (rows > 256) rows = 256; return true; }
        base += nu; }
    return false;
}


__device__ __forceinline__ int perm_col4(int rg) { const int rgl = rg & 31, t = rgl & 7; return 32 * (rgl >> 3) + 8 * (t & 3) + 4 * (t >> 2); }
__device__ __forceinline__ int perm32(int rho) { const int n = rho >> 4, i = rho & 15; return 8 * (i >> 2) + 4 * n + (i & 3); }
template <class ColMap>
__device__ __forceinline__ void convert_tile(const float* __restrict__ W, int ldb, int k0, const ColMap colmap, u16* __restrict__ dst, int tid) {
    const int wid = tid >> 6, lane = tid & 63;
    const int g = (lane & 3) + 4 * (wid >> 2), rg = (wid & 3) * 16 + (lane >> 2);
    const float* bp = W + (size_t)(k0 + 8 * g) * ldb + colmap(rg);
    f32x4 v[8];
#pragma unroll
    for (int kk = 0; kk < 8; ++kk) v[kk] = __builtin_nontemporal_load((const f32x4*)(bp + (size_t)kk * ldb));
    const int h = rg >> 5, r0 = (4 * rg) & 127;
    unsigned char* base = (unsigned char*)dst + h * 16384 + lds_byte(r0, 8 * g);
#pragma unroll
    for (int i = 0; i < 4; ++i) { u32x4 w; w[0] = pk_bf16(v[0][i], v[1][i]); w[1] = pk_bf16(v[2][i], v[3][i]); w[2] = pk_bf16(v[4][i], v[5][i]); w[3] = pk_bf16(v[6][i], v[7][i]);
        *(u32x4*)(base + i * 64) = w; }
}
typedef int i32x8 __attribute__((ext_vector_type(8)));
typedef int i32x4 __attribute__((ext_vector_type(4)));
constexpr float W8_SCALE = 32.0f;
constexpr int W8_MX = 0x7A7A7A7A;
constexpr int A8_MX = 0x7F7F7F7F;
__device__ __forceinline__ unsigned pk_fp8x4(float a, float b, float c, float d) { int p = __builtin_amdgcn_cvt_pk_fp8_f32(a, b, 0, false); p = __builtin_amdgcn_cvt_pk_fp8_f32(c, d, p, true); return (unsigned)p; }
__device__ __forceinline__ int lds_byte_b(int r, int cb) { const int st = (r >> 4) * 2 + (cb >> 6), ob = (r & 15) * 64 + (cb & 63); return st * 1024 + (ob ^ (((ob >> 9) & 1) << 5)); }
struct ConvCtx { const float* w1; const float* w2; unsigned char* W1T; unsigned char* W2T; };
__device__ __forceinline__ int conv_seq2tile(int s) {
    if (s < 16384) return (s >> 9) * 512 + (s & 15) * 32 + ((s >> 4) & 31);
    const int q = s - 16384; return 16384 + (q >> 8) * 256 + (q & 7) * 32 + ((q >> 3) & 31);
}
__device__ __forceinline__ void conv_issue(const ConvCtx& cc, int m, int wid, int lane, f32x2 (&v)[16]) {
    const int rp = 16 * wid + (lane & 15), rg = rp >> 1, p2 = (rp & 1) * 2, kg = lane >> 4;
    const float* bp; size_t ld;
    if (m < 16384) { const int e = m >> 9, nt = (m >> 5) & 15, kt = m & 31; ld = 2 * DFF; bp = cc.w1 + (size_t)e * DM * 2 * DFF + (size_t)(kt * 64 + 16 * kg) * ld + (rg >> 5) * 2048 + nt * 128 + perm_col4(rg) + p2; }
    else { const int q = m - 16384, e = q >> 8, nt = (q >> 5) & 7, kt = q & 31; ld = DM; bp = cc.w2 + (size_t)e * DFF * DM + (size_t)(kt * 64 + 16 * kg) * ld + nt * 256 + (rg >> 5) * 128 + perm_col4(rg) + p2; }
#pragma unroll
    for (int kk = 0; kk < 16; ++kk) v[kk] = __builtin_nontemporal_load((const f32x2*)(bp + (size_t)kk * ld));
}
__device__ __forceinline__ void conv_finish(const ConvCtx& cc, int m, int wid, int lane, const f32x2 (&v)[16]) {
    const int rp = 16 * wid + (lane & 15), kg = lane >> 4;
    const int kt64 = m & 31;
    unsigned char* dst = (m < 16384) ? cc.W1T + ((size_t)(m >> 5) * 16 + (kt64 >> 1)) * 32768 : cc.W2T + ((size_t)((m - 16384) >> 5) * 16 + (kt64 >> 1)) * 32768;
    unsigned char* base = dst + (rp >> 6) * 16384 + lds_byte_b((2 * rp) & 127, (kt64 & 1) * 64 + 16 * kg);
#pragma unroll
    for (int i = 0; i < 2; ++i) { u32x4 w;
#pragma unroll
        for (int q = 0; q < 4; ++q) w[q] = pk_fp8x4(v[4 * q][i] * W8_SCALE, v[4 * q + 1][i] * W8_SCALE, v[4 * q + 2][i] * W8_SCALE, v[4 * q + 3][i] * W8_SCALE);
        __builtin_nontemporal_store(w, (u32x4*)(base + i * 64)); }
}
struct ColMapGluT { int nt; __device__ __forceinline__ int operator()(int rg) const { return (rg >> 5) * 2048 + nt * 128 + perm_col4(rg); } };
struct ColMapPerm { int c0; __device__ __forceinline__ int operator()(int rg) const { return c0 + (rg >> 5) * 128 + perm_col4(rg); } };

template <bool TRANS, bool FP8 = false, class Epi>
__device__ __forceinline__ void gemm8_unit(LAS unsigned char* lds, const u16* __restrict__ A, int lda, const int* __restrict__ arows, int arow0, int rows_valid, const u16* __restrict__ Bt, int nt, const Epi epi) {
    const int tid = tid_fresh(), wid = __builtin_amdgcn_readfirstlane(tid >> 6), lane = tid & 63;
    const int wr = wid >> 2, wc = wid & 3, fr = lane & 15, fq = lane >> 4;
    unsigned aof[2][2];
#pragma unroll
    for (int h = 0; h < 2; ++h)
#pragma unroll
        for (int i = 0; i < 2; ++i) { int R, C; stage_rc(tid * 16 + i * 8192, R, C); int rr = h * 128 + R; rr = rr < rows_valid ? rr : rows_valid - 1;
            const unsigned rowid = arows ? (unsigned)arows[rr] : (unsigned)(arow0 + rr); aof[h][i] = (rowid * (unsigned)lda + (unsigned)C) * 2u; }
    const char* Ab = (const char*)A; const char* Bb = (const char*)Bt + tid * 16;
    const bool hi = rows_valid > 128;
    int mxw = W8_MX, mxa = A8_MX; asm volatile("" : "+v"(mxw), "+v"(mxa));
#define G8_SA(b, h) (((b) * 2 + (h)) * 16384)
#define G8_SB(b, h) (65536 + ((b) * 2 + (h)) * 16384)
#define G8_STA(b, h, kt) do { _Pragma("unroll") for (int _i = 0; _i < 2; ++_i) \
        __builtin_amdgcn_global_load_lds((const unsigned*)(Ab + aof[h][_i] + (size_t)(kt) * 128), (LAS unsigned*)(lds + G8_SA(b, h) + wid * 1024 + _i * 8192), 16, 0, 0); } while (0)
#define G8_STB(b, h, kt) do { _Pragma("unroll") for (int _i = 0; _i < 2; ++_i) \
        __builtin_amdgcn_global_load_lds((const unsigned*)(Bb + (size_t)(kt) * 32768 + (h) * 16384 + _i * 8192), (LAS unsigned*)(lds + G8_SB(b, h) + wid * 1024 + _i * 8192), 16, 0, 0); } while (0)
#define G8_LDA(dst, b, h) do { _Pragma("unroll") for (int m = 0; m < 4; ++m) _Pragma("unroll") for (int k = 0; k < 2; ++k) dst[m][k] = *(const LAS bf16x8*)(lds + G8_SA(b, h) + aoff + m * 2048 + k * 1024); } while (0)
#define G8_LDB(dst, b, h) do { _Pragma("unroll") for (int n = 0; n < 2; ++n) _Pragma("unroll") for (int k = 0; k < 2; ++k) dst[n][k] = *(const LAS bf16x8*)(lds + G8_SB(b, h) + boff + n * 2048 + k * 1024); } while (0)
#define G8_MMA(ai, bj, At, Bq) do { if ((ai) == 0 || hi) { __builtin_amdgcn_s_setprio(1); _Pragma("unroll") for (int m = 0; m < 4; ++m) _Pragma("unroll") for (int n = 0; n < 2; ++n) { \
        if (FP8) { const i32x4 a0 = __builtin_bit_cast(i32x4, At[m][0]), a1 = __builtin_bit_cast(i32x4, At[m][1]), b0 = __builtin_bit_cast(i32x4, Bq[n][0]), b1 = __builtin_bit_cast(i32x4, Bq[n][1]); \
            const i32x8 a8 = __builtin_shufflevector(a0, a1, 0, 1, 2, 3, 4, 5, 6, 7), b8 = __builtin_shufflevector(b0, b1, 0, 1, 2, 3, 4, 5, 6, 7); \
            asm volatile("v_mfma_scale_f32_16x16x128_f8f6f4 %0, %1, %2, %0, %3, %4 op_sel_hi:[0,0,0]" : "+v"(acc[ai][bj][m][n]) : "v"(b8), "v"(a8), "v"(mxw), "v"(mxa)); } \
        else { _Pragma("unroll") for (int k = 0; k < 2; ++k) \
            acc[ai][bj][m][n] = TRANS ? __builtin_amdgcn_mfma_f32_16x16x32_bf16(At[m][k], Bq[n][k], acc[ai][bj][m][n], 0, 0, 0) : __builtin_amdgcn_mfma_f32_16x16x32_bf16(Bq[n][k], At[m][k], acc[ai][bj][m][n], 0, 0, 0); } } \
        __builtin_amdgcn_s_setprio(0); } } while (0)
#define G8_WV(n) asm volatile("s_waitcnt vmcnt(" #n ")" ::: "memory")
#define G8_WL(n) asm volatile("s_waitcnt lgkmcnt(" #n ")" ::: "memory")
#define G8_BAR __builtin_amdgcn_s_barrier()
#define G8_SCHED __builtin_amdgcn_sched_barrier(0)
    const int aoff = lds_byte(wr * 64 + fr, fq * 8), boff = lds_byte(wc * 32 + fr, fq * 8);
    f32x4 acc[2][2][4][2];
#pragma unroll
    for (int a = 0; a < 2; ++a)
#pragma unroll
        for (int b = 0; b < 2; ++b)
#pragma unroll
            for (int m = 0; m < 4; ++m)
#pragma unroll
                for (int n = 0; n < 2; ++n) acc[a][b][m][n] = (f32x4){0.f, 0.f, 0.f, 0.f};
    bf16x8 At[4][2], B0[2][2], B1[2][2];
    G8_STB(0, 0, 0); G8_STA(0, 0, 0); G8_STB(0, 1, 0); G8_STA(0, 1, 0);
    if (wr == 1) G8_BAR;
    G8_WV(4); G8_BAR;
    G8_STB(1, 0, 1); G8_STA(1, 0, 1); G8_STB(1, 1, 1);
    G8_WV(6); G8_BAR;
    for (int t = 0; t < nt - 2; t += 2) {
        G8_LDB(B0, 0, 0); G8_SCHED; G8_LDA(At, 0, 0); G8_STA(1, 1, t + 1);
        G8_WL(8); G8_BAR; G8_WL(0); G8_MMA(0, 0, At, B0); G8_BAR; G8_SCHED;
        G8_LDB(B1, 0, 1); G8_STB(0, 0, t + 2);
        G8_BAR; G8_WL(0); G8_MMA(0, 1, At, B1); G8_BAR;
        if (hi) G8_LDA(At, 0, 1); G8_STA(0, 0, t + 2);
        G8_BAR; G8_WL(0); G8_MMA(1, 0, At, B0); G8_BAR; G8_SCHED;
        G8_STB(0, 1, t + 2);
        G8_WV(6); G8_BAR; G8_MMA(1, 1, At, B1); G8_BAR;
        G8_LDB(B0, 1, 0); G8_SCHED; G8_LDA(At, 1, 0); G8_STA(0, 1, t + 2);
        G8_WL(8); G8_BAR; G8_WL(0); G8_MMA(0, 0, At, B0); G8_BAR; G8_SCHED;
        G8_LDB(B1, 1, 1); G8_STB(1, 0, t + 3);
        G8_BAR; G8_WL(0); G8_MMA(0, 1, At, B1); G8_BAR;
        if (hi) G8_LDA(At, 1, 1); G8_STA(1, 0, t + 3);
        G8_BAR; G8_WL(0); G8_MMA(1, 0, At, B0); G8_BAR; G8_SCHED;
        G8_STB(1, 1, t + 3);
        G8_WV(6); G8_BAR; G8_MMA(1, 1, At, B1); G8_BAR;
    }
    { G8_LDB(B0, 0, 0); G8_WV(0); G8_LDA(At, 0, 0); G8_STA(1, 1, nt - 1);
      G8_BAR; G8_WL(0); G8_MMA(0, 0, At, B0); G8_BAR;
      G8_LDB(B1, 0, 1); G8_BAR; G8_WL(0); G8_MMA(0, 1, At, B1); G8_BAR;
      G8_LDA(At, 0, 1); G8_WV(4); G8_BAR; G8_WL(0); G8_MMA(1, 0, At, B0); G8_MMA(1, 1, At, B1); G8_BAR; }
    { G8_LDB(B0, 1, 0); G8_LDA(At, 1, 0); G8_WV(2); G8_BAR; G8_WL(0); G8_MMA(0, 0, At, B0); G8_BAR;
      G8_LDB(B1, 1, 1); G8_WV(0); G8_BAR; G8_WL(0); G8_MMA(0, 1, At, B1); G8_BAR;
      G8_LDA(At, 1, 1); G8_BAR; G8_WL(0); G8_MMA(1, 0, At, B0); G8_MMA(1, 1, At, B1); G8_BAR; }
    if (wr == 0) G8_BAR;
#undef G8_SA
#undef G8_SB
#undef G8_STA
#undef G8_STB
#undef G8_LDA
#undef G8_LDB
#undef G8_MMA
#undef G8_WV
#undef G8_WL
#undef G8_BAR
#undef G8_SCHED
    __builtin_amdgcn_sched_barrier(0);
    { const int tz = tid_fresh(), wz = __builtin_amdgcn_readfirstlane(tz >> 6), lz = tz & 63;
      epi(acc, wz >> 2, wz & 3, lz & 15, lz >> 4); }
}
struct StreamUnit { const char* A; const char* Bt; int arow0, rows, a, b, c; };
template <bool TRANS, bool FP8, class Src>
__device__ __forceinline__ void gemm8_stream(LAS unsigned char* lds, unsigned lda, int nt, const Src& src) {
    const int tid = tid_fresh(), wid = __builtin_amdgcn_readfirstlane(tid >> 6), lane = tid & 63;
    const int wr = wid >> 2, wc = wid & 3, fr = lane & 15, fq = lane >> 4;
    StreamUnit cur, nxt;
    if (!src.get(0, cur)) return;
    int R0, C0, R1, C1; stage_rc(tid * 16, R0, C0); stage_rc(tid * 16 + 8192, R1, C1);
    int mxw = W8_MX, mxa = A8_MX; asm volatile("" : "+v"(mxw), "+v"(mxa));
    const int aoff = lds_byte(wr * 64 + fr, fq * 8), boff = lds_byte(wc * 32 + fr, fq * 8);
#define GS_AOF(u, h, R, C) ((unsigned)(((unsigned)((u).arow0 + (((h) * 128 + (R)) < (u).rows ? ((h) * 128 + (R)) : (u).rows - 1)) * lda + (unsigned)(C)) * 2u))
    unsigned ac00 = GS_AOF(cur, 0, R0, C0), ac01 = GS_AOF(cur, 0, R1, C1), ac10 = GS_AOF(cur, 1, R0, C0), ac11 = GS_AOF(cur, 1, R1, C1);
#define GS_SA(b, h) (((b) * 2 + (h)) * 16384)
#define GS_SB(b, h) (65536 + ((b) * 2 + (h)) * 16384)
#define GS_GL(src_, dst_) __builtin_amdgcn_global_load_lds((const unsigned*)(src_), (LAS unsigned*)(lds + (dst_)), 16, 0, 0)
#define GS_STA(b, h, base, o0, o1, kt) do { GS_GL((base) + (o0) + (size_t)(kt) * 128, GS_SA(b, h) + wid * 1024); GS_GL((base) + (o1) + (size_t)(kt) * 128, GS_SA(b, h) + wid * 1024 + 8192); } while (0)
#define GS_STB(b, h, base, kt) do { GS_GL((base) + tid * 16 + (size_t)(kt) * 32768 + (h) * 16384, GS_SB(b, h) + wid * 1024); GS_GL((base) + tid * 16 + (size_t)(kt) * 32768 + (h) * 16384 + 8192, GS_SB(b, h) + wid * 1024 + 8192); } while (0)
#define GS_LDA(dst, b, h) do { _Pragma("unroll") for (int m = 0; m < 4; ++m) _Pragma("unroll") for (int k = 0; k < 2; ++k) dst[m][k] = *(const LAS bf16x8*)(lds + GS_SA(b, h) + aoff + m * 2048 + k * 1024); } while (0)
#define GS_LDB(dst, b, h) do { _Pragma("unroll") for (int n = 0; n < 2; ++n) _Pragma("unroll") for (int k = 0; k < 2; ++k) dst[n][k] = *(const LAS bf16x8*)(lds + GS_SB(b, h) + boff + n * 2048 + k * 1024); } while (0)
#define GS_MMA(ai, bj, At, Bq) do { if ((ai) == 0 || hi) { __builtin_amdgcn_s_setprio(1); _Pragma("unroll") for (int m = 0; m < 4; ++m) _Pragma("unroll") for (int n = 0; n < 2; ++n) { \
        if (FP8) { const i32x4 a0 = __builtin_bit_cast(i32x4, At[m][0]), a1 = __builtin_bit_cast(i32x4, At[m][1]), b0 = __builtin_bit_cast(i32x4, Bq[n][0]), b1 = __builtin_bit_cast(i32x4, Bq[n][1]); \
            const i32x8 a8 = __builtin_shufflevector(a0, a1, 0, 1, 2, 3, 4, 5, 6, 7), b8 = __builtin_shufflevector(b0, b1, 0, 1, 2, 3, 4, 5, 6, 7); \
            asm volatile("v_mfma_scale_f32_16x16x128_f8f6f4 %0, %1, %2, %0, %3, %4 op_sel_hi:[0,0,0]" : "+v"(acc[ai][bj][m][n]) : "v"(b8), "v"(a8), "v"(mxw), "v"(mxa)); } \
        else { _Pragma("unroll") for (int k = 0; k < 2; ++k) \
            acc[ai][bj][m][n] = TRANS ? __builtin_amdgcn_mfma_f32_16x16x32_bf16(At[m][k], Bq[n][k], acc[ai][bj][m][n], 0, 0, 0) : __builtin_amdgcn_mfma_f32_16x16x32_bf16(Bq[n][k], At[m][k], acc[ai][bj][m][n], 0, 0, 0); } } \
        __builtin_amdgcn_s_setprio(0); } } while (0)
#define GS_WV(n) asm volatile("s_waitcnt vmcnt(" #n ")" ::: "memory")
#define GS_WL(n) asm volatile("s_waitcnt lgkmcnt(" #n ")" ::: "memory")
#define GS_BAR __builtin_amdgcn_s_barrier()
#define GS_SCHED __builtin_amdgcn_sched_barrier(0)
    f32x4 acc[2][2][4][2];
#pragma unroll
    for (int a = 0; a < 2; ++a)
#pragma unroll
        for (int b = 0; b < 2; ++b)
#pragma unroll
            for (int m = 0; m < 4; ++m)
#pragma unroll
                for (int n = 0; n < 2; ++n) acc[a][b][m][n] = (f32x4){0.f, 0.f, 0.f, 0.f};
    bf16x8 At[4][2], B0[2][2], B1[2][2];
    GS_STB(0, 0, cur.Bt, 0); GS_STA(0, 0, cur.A, ac00, ac01, 0); GS_STB(0, 1, cur.Bt, 0); GS_STA(0, 1, cur.A, ac10, ac11, 0);
    if (wr == 1) GS_BAR;
    GS_WV(4); GS_BAR;
    GS_STB(1, 0, cur.Bt, 1); GS_STA(1, 0, cur.A, ac00, ac01, 1); GS_STB(1, 1, cur.Bt, 1);
    GS_WV(6); GS_BAR;
    for (int ui = 0;; ++ui) {
        const bool has_next = src.get(ui + 1, nxt);
        if (!has_next) nxt = cur;
        const unsigned an00 = GS_AOF(nxt, 0, R0, C0), an01 = GS_AOF(nxt, 0, R1, C1), an10 = GS_AOF(nxt, 1, R0, C0), an11 = GS_AOF(nxt, 1, R1, C1);
        const bool hi = cur.rows > 128;
        for (int t = 0; t < nt; t += 2) {
            const bool last = (t == nt - 2);
            const char* xA = last ? nxt.A : cur.A; const char* xB = last ? nxt.Bt : cur.Bt;
            const unsigned x00 = last ? an00 : ac00, x01 = last ? an01 : ac01, x10 = last ? an10 : ac10, x11 = last ? an11 : ac11;
            const int k2 = last ? 0 : t + 2, k3 = k2 + 1;
            GS_LDB(B0, 0, 0); GS_SCHED; GS_LDA(At, 0, 0); GS_STA(1, 1, cur.A, ac10, ac11, t + 1);
            GS_WL(8); GS_BAR; GS_WL(0); GS_MMA(0, 0, At, B0); GS_BAR; GS_SCHED;
            GS_LDB(B1, 0, 1); GS_STB(0, 0, xB, k2);
            GS_BAR; GS_WL(0); GS_MMA(0, 1, At, B1); GS_BAR;
            if (hi) GS_LDA(At, 0, 1); GS_STA(0, 0, xA, x00, x01, k2);
            GS_BAR; GS_WL(0); GS_MMA(1, 0, At, B0); GS_BAR; GS_SCHED;
            GS_STB(0, 1, xB, k2);
            GS_WV(6); GS_BAR; GS_MMA(1, 1, At, B1); GS_BAR;
            GS_LDB(B0, 1, 0); GS_SCHED; GS_LDA(At, 1, 0); GS_STA(0, 1, xA, x10, x11, k2);
            GS_WL(8); GS_BAR; GS_WL(0); GS_MMA(0, 0, At, B0); GS_BAR; GS_SCHED;
            GS_LDB(B1, 1, 1); GS_STB(1, 0, xB, k3);
            GS_BAR; GS_WL(0); GS_MMA(0, 1, At, B1); GS_BAR;
            if (hi) GS_LDA(At, 1, 1); GS_STA(1, 0, xA, x00, x01, k3);
            GS_BAR; GS_WL(0); GS_MMA(1, 0, At, B0); GS_BAR; GS_SCHED;
            GS_STB(1, 1, xB, k3);
            GS_WV(6); GS_BAR; GS_MMA(1, 1, At, B1); GS_BAR;
        }
        __builtin_amdgcn_sched_barrier(0);
        src.epi(acc, cur, wr, wc, fr, fq);
        __builtin_amdgcn_sched_barrier(0);
        if (!has_next) break;
#pragma unroll
        for (int a = 0; a < 2; ++a)
#pragma unroll
            for (int b = 0; b < 2; ++b)
#pragma unroll
                for (int m = 0; m < 4; ++m)
#pragma unroll
                    for (int n = 0; n < 2; ++n) acc[a][b][m][n] = (f32x4){0.f, 0.f, 0.f, 0.f};
        cur = nxt; ac00 = an00; ac01 = an01; ac10 = an10; ac11 = an11;
    }
    GS_WV(0);
    if (wr == 0) GS_BAR;
    GS_BAR;
#undef GS_AOF
#undef GS_SA
#undef GS_SB
#undef GS_GL
#undef GS_STA
#undef GS_STB
#undef GS_LDA
#undef GS_LDB
#undef GS_MMA
#undef GS_WV
#undef GS_WL
#undef GS_BAR
#undef GS_SCHED
}
struct Epi8PG { u16* PG; const float* lbl; int tok0, col0;
    __device__ __forceinline__ void operator()(const f32x4 (&acc)[2][2][4][2], int wr, int wc, int fr, int fq) const {
        const int grp = col0 >> 10;
        if (grp == 0) {
#pragma unroll
            for (int ai = 0; ai < 2; ++ai)
#pragma unroll
                for (int m = 0; m < 4; ++m) { u16* rowp = PG + (size_t)(tok0 + ai * 128 + wr * 64 + m * 16 + fr) * 5120 + col0 + wc * 32 + 8 * fq;
#pragma unroll
                    for (int bj = 0; bj < 2; ++bj) { float o[8];
#pragma unroll
                        for (int n = 0; n < 2; ++n)
#pragma unroll
                            for (int q = 0; q < 4; ++q) { const float x = acc[ai][bj][m][n][q]; o[4 * n + q] = x / (1.0f + __expf(-x)); }
                        *(u32x4*)(rowp + bj * 128) = (u32x4){pk_bf16(o[0], o[1]), pk_bf16(o[2], o[3]), pk_bf16(o[4], o[5]), pk_bf16(o[6], o[7])}; } }
        } else if (grp <= 2) {
            float lbv[2][8];
#pragma unroll
            for (int bj = 0; bj < 2; ++bj)
#pragma unroll
                for (int q = 0; q < 8; ++q) { const int c = (col0 & 1023) + bj * 128 + wc * 32 + 8 * fq + q; const float l0 = lbl[(grp - 1) * HGW + c], l1 = lbl[(2 + grp - 1) * HGW + c]; lbv[bj][q] = 1.0f / (1.0f + __expf(l1 - l0)); }
#pragma unroll
            for (int ai = 0; ai < 2; ++ai)
#pragma unroll
                for (int m = 0; m < 4; ++m) { u16* rowp = PG + (size_t)(tok0 + ai * 128 + wr * 64 + m * 16 + fr) * 5120 + col0 + wc * 32 + 8 * fq;
#pragma unroll
                    for (int bj = 0; bj < 2; ++bj) { float o[8];
#pragma unroll
                        for (int n = 0; n < 2; ++n)
#pragma unroll
                            for (int q = 0; q < 4; ++q) { const float z = acc[ai][bj][m][n][q], lb = lbv[bj][4 * n + q]; const float sg = 1.0f / (1.0f + __expf(-z)); o[4 * n + q] = __logf(lb + (1.0f - lb) * sg); }
                        *(u32x4*)(rowp + bj * 128) = (u32x4){pk_bf16(o[0], o[1]), pk_bf16(o[2], o[3]), pk_bf16(o[4], o[5]), pk_bf16(o[6], o[7])}; } }
        } else {
#pragma unroll
            for (int ai = 0; ai < 2; ++ai)
#pragma unroll
                for (int m = 0; m < 4; ++m) { u16* rowp = PG + (size_t)(tok0 + ai * 128 + wr * 64 + m * 16 + fr) * 5120 + col0 + wc * 32 + 8 * fq;
#pragma unroll
                    for (int bj = 0; bj < 2; ++bj) { const f32x4 v0 = acc[ai][bj][m][0], v1 = acc[ai][bj][m][1];
                        *(u32x4*)(rowp + bj * 128) = (u32x4){pk_bf16(v0[0], v0[1]), pk_bf16(v0[2], v0[3]), pk_bf16(v1[0], v1[1]), pk_bf16(v1[2], v1[3])}; } }
        }
    } };
struct Epi8HYT { u16* HYT; int tok0, col0;
    __device__ __forceinline__ void operator()(const f32x4 (&acc)[2][2][4][2], int wr, int wc, int fr, int fq) const {
#pragma unroll
        for (int bj = 0; bj < 2; ++bj)
#pragma unroll
            for (int n = 0; n < 2; ++n) { u16* colp = HYT + (size_t)(col0 + bj * 128 + wc * 32 + perm32(n * 16 + fr)) * NTOK + tok0 + wr * 64 + 4 * fq;
#pragma unroll
                for (int ai = 0; ai < 2; ++ai)
#pragma unroll
                    for (int m = 0; m < 4; ++m) { const f32x4 v = acc[ai][bj][m][n]; *(u32x2*)(colp + ai * 128 + m * 16) = (u32x2){pk_bf16(v[0], v[1]), pk_bf16(v[2], v[3])}; } }
    } };
struct Epi8X1 { const float* x; float* X1; int tok0, col0;
    __device__ __forceinline__ void operator()(const f32x4 (&acc)[2][2][4][2], int wr, int wc, int fr, int fq) const {
#pragma unroll
        for (int ai = 0; ai < 2; ++ai)
#pragma unroll
            for (int m = 0; m < 4; ++m) { const size_t off = (size_t)(tok0 + ai * 128 + wr * 64 + m * 16 + fr) * DM + col0 + wc * 32 + 8 * fq;
#pragma unroll
                for (int bj = 0; bj < 2; ++bj)
#pragma unroll
                    for (int n = 0; n < 2; ++n) { const f32x4 r = *(const f32x4*)(x + off + bj * 128 + n * 4); *(f32x4*)(X1 + off + bj * 128 + n * 4) = r + acc[ai][bj][m][n]; }
                asm volatile("" ::: "memory"); }
    } };
struct Epi8Swiglu { u16* HM; const float* b1; int slot0, nt, rows_valid;
    __device__ __forceinline__ void operator()(const f32x4 (&acc)[2][2][4][2], int wr, int wc, int fr, int fq) const {
        f32x4 bg[2], bl[2];
#pragma unroll
        for (int n = 0; n < 2; ++n) { const int col = nt * 128 + wc * 32 + 8 * fq + 4 * n; bg[n] = *(const f32x4*)(b1 + col); bl[n] = *(const f32x4*)(b1 + 2048 + col); }
#pragma unroll
        for (int ai = 0; ai < 2; ++ai)
#pragma unroll
            for (int m = 0; m < 4; ++m) { const int row = ai * 128 + wr * 64 + m * 16 + fr;
                if (row < rows_valid) { float o[8];
#pragma unroll
                    for (int n = 0; n < 2; ++n) { const f32x4 gl = acc[ai][0][m][n] + bg[n], li = acc[ai][1][m][n] + bl[n];
#pragma unroll
                        for (int j = 0; j < 4; ++j) { const float gq = fminf(gl[j], 7.0f), lq = fminf(fmaxf(li[j], -7.0f), 7.0f); o[4 * n + j] = gq * (1.0f / (1.0f + __expf(-1.702f * gq))) * (lq + 1.0f); } }
                    *(u32x4*)(HM + (size_t)(slot0 + row) * DFF + nt * 128 + wc * 32 + 8 * fq) = (u32x4){pk_bf16(o[0], o[1]), pk_bf16(o[2], o[3]), pk_bf16(o[4], o[5]), pk_bf16(o[6], o[7])}; } }
    } };
struct Epi8Swiglu8 { unsigned char* HM; const float* b1; int slot0, nt, rows_valid;
    __device__ __forceinline__ void operator()(const f32x4 (&acc)[2][2][4][2], int wr, int wc, int fr, int fq) const {
        f32x4 bg[2], bl[2];
#pragma unroll
        for (int n = 0; n < 2; ++n) { const int col = nt * 128 + wc * 32 + 8 * fq + 4 * n; bg[n] = *(const f32x4*)(b1 + col); bl[n] = *(const f32x4*)(b1 + 2048 + col); }
#pragma unroll
        for (int ai = 0; ai < 2; ++ai)
#pragma unroll
            for (int m = 0; m < 4; ++m) { const int row = ai * 128 + wr * 64 + m * 16 + fr;
                if (row < rows_valid) { float o[8];
#pragma unroll
                    for (int n = 0; n < 2; ++n) { const f32x4 gl = acc[ai][0][m][n] + bg[n], li = acc[ai][1][m][n] + bl[n];
#pragma unroll
                        for (int j = 0; j < 4; ++j) { const float gq = fminf(gl[j], 7.0f), lq = fminf(fmaxf(li[j], -7.0f), 7.0f); o[4 * n + j] = gq * (1.0f / (1.0f + __expf(-1.702f * gq))) * (lq + 1.0f); } }
                    *(u32x2*)(HM + (size_t)(slot0 + row) * DFF + nt * 128 + wc * 32 + 8 * fq) = (u32x2){pk_fp8x4(o[0], o[1], o[2], o[3]), pk_fp8x4(o[4], o[5], o[6], o[7])}; } }
    } };
struct Epi8Y { u16* Y; const float* b2; int slot0, col0, rows_valid;
    __device__ __forceinline__ void operator()(const f32x4 (&acc)[2][2][4][2], int wr, int wc, int fr, int fq) const {
        f32x4 bv[2][2];
#pragma unroll
        for (int bj = 0; bj < 2; ++bj)
#pragma unroll
            for (int n = 0; n < 2; ++n) bv[bj][n] = *(const f32x4*)(b2 + col0 + bj * 128 + wc * 32 + 8 * fq + 4 * n);
#pragma unroll
        for (int ai = 0; ai < 2; ++ai)
#pragma unroll
            for (int m = 0; m < 4; ++m) { const int row = ai * 128 + wr * 64 + m * 16 + fr;
                if (row < rows_valid) { u16* rowp = Y + (size_t)(slot0 + row) * DM + col0 + wc * 32 + 8 * fq;
#pragma unroll
                    for (int bj = 0; bj < 2; ++bj) { const f32x4 v0 = acc[ai][bj][m][0] + bv[bj][0], v1 = acc[ai][bj][m][1] + bv[bj][1];
                        *(u32x4*)(rowp + bj * 128) = (u32x4){pk_bf16(v0[0], v0[1]), pk_bf16(v0[2], v0[3]), pk_bf16(v1[0], v1[1]), pk_bf16(v1[2], v1[3])}; } } }
    } };
struct EpiNone { __device__ __forceinline__ void operator()(const f32x4 (&acc)[2][2][4][2], int wr, int wc, int fr, int fq) const {
#pragma unroll
        for (int a = 0; a < 2; ++a)
#pragma unroll
            for (int b = 0; b < 2; ++b)
#pragma unroll
                for (int m = 0; m < 4; ++m)
#pragma unroll
                    for (int n = 0; n < 2; ++n) asm volatile("" :: "v"(acc[a][b][m][n]));
    } };

template <int NTILES>
__device__ __forceinline__ bool moe_unit_static(const LAS int* us, const LAS int* so2, int uu, int& e, int& nt, int& slot0, int& rows) {
    if (uu >= us[NE]) return false;
    int lo = 0, hi = NE;
#pragma unroll
    for (int s = 0; s < 5; ++s) { const int mid = (lo + hi) >> 1; if (us[mid] <= uu) lo = mid; else hi = mid; }
    e = lo; const int o0 = e * NTOK, cnt = so2[e], mtl = (cnt + 255) >> 8, ul = uu - us[e], mt = ul % mtl;
    e = __builtin_amdgcn_readfirstlane(e); nt = __builtin_amdgcn_readfirstlane(ul / mtl); slot0 = __builtin_amdgcn_readfirstlane(o0 + mt * 256);
    rows = cnt - mt * 256; rows = __builtin_amdgcn_readfirstlane(rows > 256 ? 256 : rows); return true;
}
struct SrcMoeB { const LAS int* us; const LAS int* so2; int c, G; const char* HM8; const char* W2T8; u16* YB; const float* b2;
    __device__ __forceinline__ bool get(int i, StreamUnit& u) const { int e, nt, slot0, rows; if (!moe_unit_static<8>(us, so2, c + i * G, e, nt, slot0, rows)) return false;
        u.A = HM8; u.Bt = W2T8 + (size_t)((e * 8 + nt) * 16) * 32768; u.arow0 = slot0; u.rows = rows; u.a = e; u.b = nt; u.c = slot0; return true; }
    __device__ __forceinline__ void epi(const f32x4 (&acc)[2][2][4][2], const StreamUnit& u, int wr, int wc, int fr, int fq) const { Epi8Y ep{YB, b2 + (size_t)u.a * DM, u.c, u.b * 256, u.rows}; ep(acc, wr, wc, fr, fq); }
};
template <bool TRANS>
struct SrcG1 { int c, G; const char* HBp; const char* WINTp; u16* PG; u16* HYT; const float* lbl;
    __device__ __forceinline__ bool get(int k, StreamUnit& su) const {
        int seen = 0;
        for (int u = c; u < 1024; u += G) { const int i = u >> 8, xx = (u >> 5) & 7, j = u & 31; const int mt = (xx & 3) * 8 + (j & 7), nt = ((xx >> 2) + 2 * i) * 4 + (j >> 3);
            if ((nt >= 20) == TRANS) { if (seen == k) { su.A = HBp; su.Bt = WINTp + (size_t)nt * 32 * 32768; su.arow0 = mt * 256; su.rows = 256; su.a = mt; su.b = nt; su.c = 0; return true; } ++seen; } }
        return false; }
    __device__ __forceinline__ void epi(const f32x4 (&acc)[2][2][4][2], const StreamUnit& u, int wr, int wc, int fr, int fq) const {
        if (TRANS) { Epi8HYT e{HYT, u.a * 256, u.b * 256 - 5120}; e(acc, wr, wc, fr, fq); } else { Epi8PG e{PG, lbl, u.a * 256, u.b * 256}; e(acc, wr, wc, fr, fq); } }
};

typedef float f32x16 __attribute__((ext_vector_type(16)));
__device__ __forceinline__ void h3_row(int m, const float* __restrict__ w1, const float* __restrict__ b1, const float* __restrict__ w2, const float* __restrict__ b2,
                                       const float* __restrict__ w3, const float* __restrict__ b3, const float* __restrict__ freq, LAS float* sc  , float* __restrict__ H3) {
    const int j = tid_fresh() & 63;
    const float tt = (float)m / (float)(SEQ - 1);
    if (j == 0) sc[0] = tt;
    if (j >= 1 && j <= 16) { const int i = j - 1; const float band = 1e-4f + (float)i * ((15.0f - 1e-4f) / 15.0f); const float ang = (2.0f * 3.14159265358979323846f / (float)SEQ) * (float)m * band; sc[1 + i] = cosf(ang); sc[17 + i] = -sinf(ang); }
    __builtin_amdgcn_wave_barrier();
    const float fr = freq[j];
    float s = b1[j];
    for (int i = 0; i < 33; ++i) s += sc[i] * w1[i * 64 + j];
    const float h1 = sinf(fr * s);
    sc[64 + j] = h1;
    __builtin_amdgcn_wave_barrier();
    s = b2[j];
    for (int i = 0; i < 64; ++i) s += sc[64 + i] * w2[i * 64 + j];
    const float h2 = sinf(fr * s);
    __builtin_amdgcn_wave_barrier();
    sc[j] = h2;
    __builtin_amdgcn_wave_barrier();
    s = b3[j];
    for (int i = 0; i < 64; ++i) s += sc[i] * w3[i * 64 + j];
    H3[(size_t)m * 64 + j] = sinf(fr * s);
    __builtin_amdgcn_wave_barrier();
}
constexpr int FR_LEN = 4128;
__device__ __forceinline__ void frgen_item(LAS unsigned char* lds, int item, const float* __restrict__ H3, const float* __restrict__ w4, u16* __restrict__ FR) {
    const int tid = tid_fresh(), wid = __builtin_amdgcn_readfirstlane(tid >> 6), lane = tid & 63, fr = lane & 15, fq = lane >> 4;
    const int oc0 = item * 8, o = oc0 >> 10;
    const int colB = o * 2048 + (fr >> 3) * 1024 + (oc0 & 1023) + (fr & 7);
    float wreg[16];
#pragma unroll
    for (int ks = 0; ks < 16; ++ks) wreg[ks] = w4[(size_t)(4 * ks + fq) * 4096 + colB];
    const int dir = fr >> 3, c = (oc0 & 1023) + (fr & 7);
    const float mind = logf(1e-2f) / 0.3f, maxd = logf(1e-2f) / 1.5f;
    const float delta = fabsf(mind + (float)c * ((maxd - mind) / 1023.0f));
    u16* r0 = FR + (size_t)((oc0 + (fr & 7)) * 2) * FR_LEN;
    LAS float* tile = (LAS float*)(lds + wid * 4608);
    const int wrow = lane >> 4, wcol = 4 * (lane & 15);
    f32x4 nx[4];
#pragma unroll
    for (int q = 0; q < 4; ++q) nx[q] = *(const f32x4*)(H3 + (size_t)wid * 1024 + q * 256 + lane * 4);
    for (int it = 0; it < 16; ++it) {
        const int mt = wid + 8 * it;
#pragma unroll
        for (int q = 0; q < 4; ++q) *(LAS f32x4*)(tile + (q * 4 + wrow) * 68 + wcol) = nx[q];
        if (it + 1 < 16) {
#pragma unroll
            for (int q = 0; q < 4; ++q) nx[q] = *(const f32x4*)(H3 + (size_t)(mt + 8) * 1024 + q * 256 + lane * 4);
        }
        f32x4 acc = {0.f, 0.f, 0.f, 0.f};
#pragma unroll
        for (int ks = 0; ks < 16; ++ks) acc = __builtin_amdgcn_mfma_f32_16x16x4f32(tile[fr * 68 + 4 * ks + fq], wreg[ks], acc, 0, 0, 0);
        const int m0 = mt * 16 + 4 * fq;
        float v[4];
#pragma unroll
        for (int j = 0; j < 4; ++j) v[j] = acc[j] * __expf(-((float)(m0 + j) / (float)(SEQ - 1)) * delta);
        if (dir == 0) {
            *(u32x2*)(r0 + 2044 - m0) = (u32x2){pk_bf16(v[3], v[2]), pk_bf16(v[1], v[0])};
#pragma unroll
            for (int j = 0; j < 4; ++j) r0[FR_LEN + 2046 - m0 - j] = (u16)(pk_bf16(v[j], 0.f) & 0xffffu);
        } else {
#pragma unroll
            for (int j = 0; j < 4; ++j) if (m0 + j >= 1) { const u16 b = (u16)(pk_bf16(v[j], 0.f) & 0xffffu); r0[2047 + m0 + j] = b; r0[FR_LEN + 2046 + m0 + j] = b; }
        }
    }
    if (tid < 8 * 34) { const int r = tid / 34, x = 4094 + tid % 34; u16* rr = FR + (size_t)((oc0 + r) * 2) * FR_LEN; if (x >= 4095) rr[x] = 0; rr[FR_LEN + x] = 0; }
    __syncthreads();
}
constexpr int HY_ZSTRIDE = 2312;
constexpr int HY_ZCH = 256 + 4 * HY_ZSTRIDE;
constexpr int HY_ZBYTES = HY_ZCH * 2;
constexpr int HY_FB = 4 * HY_ZBYTES;
constexpr int HY_FCH = 2 * FR_LEN * 2;
constexpr int HY_LDS = HY_FB + 4 * HY_FCH;

__device__ __forceinline__ void hy_load_row(LAS unsigned char* lds, int dest, int boff0, int bstride, const u16* __restrict__ row, float w0, float w1, float w2, float cb, int pl) {
#pragma unroll 2
    for (int it = 0; it < 8; ++it) {
        const int idx = pl + 128 * it, tok0 = idx * 8, b = tok0 >> 11, n0 = tok0 & 2047;
        const u32x4 raw = *(const u32x4*)(row + tok0);
        const float pm = (n0 > 0) ? bf2f(row[tok0 - 1]) : 0.f;
        const float pn = (n0 + 8 < SEQ) ? bf2f(row[tok0 + 8]) : 0.f;
        float p[10];
        p[0] = pm; p[9] = pn;
#pragma unroll
        for (int q = 0; q < 4; ++q) { p[1 + 2 * q] = bflo(raw[q]); p[2 + 2 * q] = bfhi(raw[q]); }
        float o[8];
#pragma unroll
        for (int q = 0; q < 8; ++q) o[q] = fmaf(w0, p[q], fmaf(w1, p[q + 1], fmaf(w2, p[q + 2], cb)));
        u32x4 w; w[0] = pk_bf16(o[0], o[1]); w[1] = pk_bf16(o[2], o[3]); w[2] = pk_bf16(o[4], o[5]); w[3] = pk_bf16(o[6], o[7]);
        *(LAS u32x4*)(lds + dest + (boff0 + b * bstride + n0) * 2) = w;
    }
}
__device__ __forceinline__ void hy_load_filters(LAS unsigned char* lds, int fb, const u16* __restrict__ src, int pl) {
    for (int idx = pl; idx < HY_FCH / 16; idx += 128) *(LAS u32x4*)(lds + fb + idx * 16) = *(const u32x4*)((const char*)src + idx * 16);
}
__device__ __forceinline__ void hy_mfma_loop(LAS unsigned char* lds, int zb, int fb, int hlf, int lane, f32x16 (&acc)[4], const ConvCtx& cc, int mbase, int cunit, int wid) {
    const int r = lane & 31, hh = lane >> 5, il = r >> 2, b = r & 3;
    const int bbase = zb + (256 + b * HY_ZSTRIDE + 32 * il + 8 * hh) * 2;
    const int xl = 2047 - r + 8 * hh - 1024 * hlf;
    const int abase = (r & 1) ? (fb + 2 * xl) : (fb + FR_LEN * 2 + 2 * (xl - 1));
#pragma unroll
    for (int q = 0; q < 4; ++q)
#pragma unroll
        for (int i = 0; i < 16; ++i) acc[q][i] = 0.f;
    for (int d0 = 0; d0 < 8; ++d0) {
#pragma unroll
        for (int ks = 0; ks < 2; ++ks) {
            f32x2 cv[16];
            const int mcv = conv_seq2tile((mbase + d0 * 2 + ks) * 256 + cunit);
            conv_issue(cc, mcv, wid, lane, cv);
            bf16x8 Bt[9];
#pragma unroll
            for (int j = 0; j < 9; ++j) Bt[j] = *(const LAS bf16x8*)(lds + bbase + 512 * j - 64 * d0 + 32 * ks);
#pragma unroll
            for (int ep = -8; ep <= 3; ++ep) {
                const LAS unsigned* ap = (const LAS unsigned*)(lds + abase - 64 * d0 - 512 * ep + 32 * ks);
                u32x4 av; av[0] = ap[0]; av[1] = ap[1]; av[2] = ap[2]; av[3] = ap[3];
                const bf16x8 a = __builtin_bit_cast(bf16x8, av);
#pragma unroll
                for (int ctl = 0; ctl < 4; ++ctl) { const int jt = ctl - ep; if (jt >= 0 && jt <= 8) acc[ctl] = __builtin_amdgcn_mfma_f32_32x32x16_bf16(a, Bt[jt], acc[ctl], 0, 0, 0); }
            }
            conv_finish(cc, mcv, wid, lane, cv);
        }
    }
}
__device__ __forceinline__ void hy_epilogue(LAS unsigned char* lds, int zb, int gb, int hlf, int lane, const f32x16 (&acc)[4], float bias) {
    const int r = lane & 31, hh = lane >> 5, il = r >> 2, b = r & 3;
#pragma unroll
    for (int ctl = 0; ctl < 4; ++ctl) {
        const int I = 8 * (4 * hlf + ctl) + il;
#pragma unroll
        for (int q = 0; q < 4; ++q) {
            const int n4 = 32 * I + 8 * q + 4 * hh;
            LAS u32x2* zp = (LAS u32x2*)(lds + zb + (256 + b * HY_ZSTRIDE + n4) * 2);
            const u32x2 zv = *zp, gv = *(const LAS u32x2*)(lds + gb + (b * 2048 + n4) * 2);
            const float z0 = bflo(zv[0]), z1 = bfhi(zv[0]), z2 = bflo(zv[1]), z3 = bfhi(zv[1]);
            const float g0 = bflo(gv[0]), g1 = bfhi(gv[0]), g2 = bflo(gv[1]), g3 = bfhi(gv[1]);
            u32x2 o; o[0] = pk_bf16(g0 * fmaf(bias, z0, acc[ctl][4 * q + 0]), g1 * fmaf(bias, z1, acc[ctl][4 * q + 1]));
            o[1] = pk_bf16(g2 * fmaf(bias, z2, acc[ctl][4 * q + 2]), g3 * fmaf(bias, z3, acc[ctl][4 * q + 3]));
            *zp = o;
        }
    }
}
__device__ __forceinline__ void hyena_unit(LAS unsigned char* lds, int unit, const u16* __restrict__ HYT, const u16* __restrict__ FR, const float* __restrict__ cw, const float* __restrict__ cbv,
                                           const float* __restrict__ hbias, u16* __restrict__ Z2T, const ConvCtx& cc) {
    const int tid = tid_fresh(), wid = __builtin_amdgcn_readfirstlane(tid >> 6), lane = tid & 63;
    const int cs = wid & 3, hlf = wid >> 2, c = unit * 4 + cs, pl = lane + 64 * hlf;
    const int zb = cs * HY_ZBYTES, fb = HY_FB + cs * HY_FCH;
    { const u32x4 z = {0u, 0u, 0u, 0u}; for (int idx = pl; idx < HY_ZBYTES / 16; idx += 128) *(LAS u32x4*)(lds + zb + idx * 16) = z; }
    __syncthreads();
    hy_load_row(lds, zb, 256, HY_ZSTRIDE, HYT + (size_t)c * NTOK, cw[0 * 3072 + c], cw[1 * 3072 + c], cw[2 * 3072 + c], cbv[c], pl);
    f32x16 acc[4];
#pragma unroll
    for (int o = 0; o < 2; ++o) {
        hy_load_filters(lds, fb, FR + (size_t)((o * 1024 + c) * 2) * FR_LEN, pl);
        __syncthreads();
        hy_mfma_loop(lds, zb, fb, hlf, lane, acc, cc, o * 16, unit, wid);
        __syncthreads();
        const int gc = (1 + o) * 1024 + c;
        hy_load_row(lds, fb, 0, 2048, HYT + (size_t)gc * NTOK, cw[0 * 3072 + gc], cw[1 * 3072 + gc], cw[2 * 3072 + gc], cbv[gc], pl);
        __syncthreads();
        hy_epilogue(lds, zb, fb, hlf, lane, acc, hbias[o * HYW + c]);
        __syncthreads();
    }
#pragma unroll 2
    for (int it = 0; it < 8; ++it) { const int idx = pl + 128 * it, tok0 = idx * 8, b = tok0 >> 11, n0 = tok0 & 2047;
        *(u32x4*)(Z2T + (size_t)c * NTOK + tok0) = *(const LAS u32x4*)(lds + zb + (256 + b * HY_ZSTRIDE + n0) * 2); }
    __syncthreads();
}

constexpr int HG_RAWQ = 0, HG_RAWF = 16384, HG_RAWV = 32768;
constexpr int HG_QM = 36864, HG_KM = HG_QM + 17408, HG_QI = HG_KM + 17408;
constexpr int HG_KL = HG_QI + 17408;
constexpr int HG_VT = HG_KL + 18432;
constexpr int HG_P = HG_VT + 4608;
constexpr int HG_ST = HG_P + 9216;
constexpr int HG_TOT = HG_ST + 8704;
constexpr int HG_EL2 = HG_TOT + 2048;
constexpr int HG_LDS = HG_EL2 + 512;

__device__ __forceinline__ void hgrn_unit(LAS unsigned char* lds, int unit, const u16* __restrict__ PG, const float* __restrict__ lb_logits, float* __restrict__ OF, float* __restrict__ OB, const ConvCtx& cc) {
    const int tid = tid_fresh(), wid = __builtin_amdgcn_readfirstlane(tid >> 6), lane = tid & 63, fr = lane & 15, fq = lane >> 4;
    const int vq = unit & 3, dir = (unit >> 2) & 1, h = (unit >> 3) & 7, b = unit >> 6;
    const int k = tid & 127, seg = tid >> 7;
    float* __restrict__ O = dir ? OB : OF;
    for (int i = tid; i < 8704 / 16; i += 512) *(LAS u32x4*)(lds + HG_ST + i * 16) = (u32x4){0u, 0u, 0u, 0u};
    f32x4 Sacc[2];
    Sacc[0] = (f32x4){0.f, 0.f, 0.f, 0.f}; Sacc[1] = Sacc[0];
    u32x4 pq[2], pf[2], pv;
    const int colq = h * 128, colf = (1 + dir) * 1024 + h * 128, colv = 3072 + h * 128 + vq * 32;
#define HG_TOK(c, tau) ((size_t)b * SEQ + (dir ? (SEQ - 1 - 64 * (c) - (tau)) : (64 * (c) + (tau))))
#define HG_PREFETCH(c) do { _Pragma("unroll") for (int _i = 0; _i < 2; ++_i) { const int _x = tid + 512 * _i, _tau = _x >> 4, _p = _x & 15; const u16* _r = PG + HG_TOK(c, _tau) * 5120; \
            pq[_i] = *(const u32x4*)(_r + colq + _p * 8); pf[_i] = *(const u32x4*)(_r + colf + _p * 8); } \
        if (tid < 256) { const int _tau = tid >> 2, _p = tid & 3; pv = *(const u32x4*)(PG + HG_TOK(c, _tau) * 5120 + colv + _p * 8); } } while (0)
    HG_PREFETCH(0);
    for (int c = 0; c < 32; ++c) {
#pragma unroll
        for (int i = 0; i < 2; ++i) { const int x = tid + 512 * i; *(LAS u32x4*)(lds + HG_RAWQ + x * 16) = pq[i]; *(LAS u32x4*)(lds + HG_RAWF + x * 16) = pf[i]; }
        if (tid < 256) *(LAS u32x4*)(lds + HG_RAWV + tid * 16) = pv;
        if (c + 1 < 32) HG_PREFETCH(c + 1);
        f32x2 cv[16];
        const int mqa = conv_seq2tile((32 + c * 2) * 256 + unit), mqb = conv_seq2tile((33 + c * 2) * 256 + unit);
        conv_issue(cc, mqa, wid, lane, cv);
        __syncthreads();
        float qv[16], kv[16], bl[16];
        { float run = 0.f;
#pragma unroll
          for (int i = 0; i < 16; ++i) { const int tau = seg * 16 + i;
              const float qs = bf2f(*(const LAS u16*)(lds + HG_RAWQ + tau * 256 + k * 2)), lf = bf2f(*(const LAS u16*)(lds + HG_RAWF + tau * 256 + k * 2));
              run += lf; bl[i] = run; kv[i] = 1.0f - __expf(lf); qv[i] = qs; }
          *(LAS float*)(lds + HG_TOT + (seg * 128 + k) * 4) = run; }
        __syncthreads();
        { const float t0 = *(const LAS float*)(lds + HG_TOT + (0 * 128 + k) * 4), t1 = *(const LAS float*)(lds + HG_TOT + (1 * 128 + k) * 4),
                      t2 = *(const LAS float*)(lds + HG_TOT + (2 * 128 + k) * 4), t3 = *(const LAS float*)(lds + HG_TOT + (3 * 128 + k) * 4);
          const float pre = (seg > 0 ? t0 : 0.f) + (seg > 1 ? t1 : 0.f) + (seg > 2 ? t2 : 0.f);
          const float bref = t0 + t1, blast = bref + t2 + t3;
          const float er = __expf(bref), el = __expf(blast - bref);
          if (seg == 0) *(LAS float*)(lds + HG_EL2 + k * 4) = __expf(blast);
          unsigned klp[8];
#pragma unroll
          for (int i = 0; i < 16; i += 2) {
              float klv[2];
#pragma unroll
              for (int u = 0; u < 2; ++u) { const int tau = seg * 16 + i + u; const float bb = pre + bl[i + u];
                  const float e1 = __expf(bb - bref), e2 = __expf(bref - bb);
                  const float qm = qv[i + u] * e1, km = kv[i + u] * e2;
                  *(LAS u16*)(lds + HG_QM + tau * 272 + k * 2) = (u16)(pk_bf16(qm, 0.f) & 0xffffu);
                  *(LAS u16*)(lds + HG_KM + tau * 272 + k * 2) = (u16)(pk_bf16(km, 0.f) & 0xffffu);
                  *(LAS u16*)(lds + HG_QI + tau * 272 + k * 2) = (u16)(pk_bf16(qm * er, 0.f) & 0xffffu);
                  klv[u] = km * el; }
              klp[i >> 1] = pk_bf16(klv[0], klv[1]); }
          *(LAS u32x4*)(lds + HG_KL + k * 144 + seg * 32) = (u32x4){klp[0], klp[1], klp[2], klp[3]};
          *(LAS u32x4*)(lds + HG_KL + k * 144 + seg * 32 + 16) = (u32x4){klp[4], klp[5], klp[6], klp[7]};
          { const int v = tid & 31, tg = tid >> 5; unsigned short e[4];
#pragma unroll
            for (int u = 0; u < 4; ++u) e[u] = *(const LAS u16*)(lds + HG_RAWV + (tg * 4 + u) * 64 + v * 2);
            *(LAS u32x2*)(lds + HG_VT + v * 144 + tg * 8) = (u32x2){(unsigned)e[0] | ((unsigned)e[1] << 16), (unsigned)e[2] | ((unsigned)e[3] << 16)}; } }
        conv_finish(cc, mqa, wid, lane, cv);
        conv_issue(cc, mqb, wid, lane, cv);
        __syncthreads();
#pragma unroll
        for (int q = 0; q < 2; ++q) { const int idx = wid * 2 + q, ti = idx >> 2, si = idx & 3;
            f32x4 a = {0.f, 0.f, 0.f, 0.f};
            if (si <= ti) {
#pragma unroll
                for (int ks = 0; ks < 4; ++ks) { const bf16x8 ka = *(const LAS bf16x8*)(lds + HG_KM + (si * 16 + fr) * 272 + (ks * 32 + fq * 8) * 2), qb = *(const LAS bf16x8*)(lds + HG_QM + (ti * 16 + fr) * 272 + (ks * 32 + fq * 8) * 2);
                    a = __builtin_amdgcn_mfma_f32_16x16x32_bf16(ka, qb, a, 0, 0, 0); } }
            const int tau = ti * 16 + fr, s0 = si * 16 + fq * 4;
            float pvv[4];
#pragma unroll
            for (int j = 0; j < 4; ++j) pvv[j] = (si <= ti && s0 + j <= tau) ? a[j] : 0.f;
            *(LAS u32x2*)(lds + HG_P + tau * 144 + s0 * 2) = (u32x2){pk_bf16(pvv[0], pvv[1]), pk_bf16(pvv[2], pvv[3])}; }
        const int ti = wid >> 1, vi = wid & 1;
        f32x4 oacc = {0.f, 0.f, 0.f, 0.f};
#pragma unroll
        for (int ks = 0; ks < 4; ++ks) { const bf16x8 qa = *(const LAS bf16x8*)(lds + HG_QI + (ti * 16 + fr) * 272 + (ks * 32 + fq * 8) * 2), sb = *(const LAS bf16x8*)(lds + HG_ST + (vi * 16 + fr) * 272 + (ks * 32 + fq * 8) * 2);
            oacc = __builtin_amdgcn_mfma_f32_16x16x32_bf16(qa, sb, oacc, 0, 0, 0); }
        { const f32x4 e2 = *(const LAS f32x4*)(lds + HG_EL2 + (wid * 16 + fq * 4) * 4);
#pragma unroll
          for (int v2 = 0; v2 < 2; ++v2) { Sacc[v2] = Sacc[v2] * e2;
#pragma unroll
              for (int ks = 0; ks < 2; ++ks) { const bf16x8 ka = *(const LAS bf16x8*)(lds + HG_KL + (wid * 16 + fr) * 144 + (ks * 32 + fq * 8) * 2), vb = *(const LAS bf16x8*)(lds + HG_VT + (v2 * 16 + fr) * 144 + (ks * 32 + fq * 8) * 2);
                  Sacc[v2] = __builtin_amdgcn_mfma_f32_16x16x32_bf16(ka, vb, Sacc[v2], 0, 0, 0); } } }
        __syncthreads();
#pragma unroll
        for (int ks = 0; ks < 2; ++ks) { const bf16x8 pa = *(const LAS bf16x8*)(lds + HG_P + (ti * 16 + fr) * 144 + (ks * 32 + fq * 8) * 2), vb = *(const LAS bf16x8*)(lds + HG_VT + (vi * 16 + fr) * 144 + (ks * 32 + fq * 8) * 2);
            oacc = __builtin_amdgcn_mfma_f32_16x16x32_bf16(pa, vb, oacc, 0, 0, 0); }
#pragma unroll
        for (int j = 0; j < 4; ++j) { const int tau = ti * 16 + fq * 4 + j; O[HG_TOK(c, tau) * HGW + h * 128 + vq * 32 + vi * 16 + fr] = oacc[j]; }
        conv_finish(cc, mqb, wid, lane, cv);
#pragma unroll
        for (int v2 = 0; v2 < 2; ++v2) *(LAS u32x2*)(lds + HG_ST + (v2 * 16 + fr) * 272 + (wid * 16 + fq * 4) * 2) = (u32x2){pk_bf16(Sacc[v2][0], Sacc[v2][1]), pk_bf16(Sacc[v2][2], Sacc[v2][3])};
    }
    __syncthreads();
#undef HG_TOK
#undef HG_PREFETCH
}


#define XB_TMO      128
#define XB_XCNT(j)  (256  + 64 * (j))
#define XB_XSUB(j)  (1280 + 64 * (j))
#define XB_XGEN(j)  (2304 + 64 * (j))
#define XB_TOP      3328
#define XB_TOPGEN   3392
#define XCD_BAR_WORDS 3456
#define XB_SPIN_CAP (1u << 22)

__device__ __forceinline__ unsigned xb_ld(unsigned* p)              { return __hip_atomic_load(p, __ATOMIC_RELAXED, __HIP_MEMORY_SCOPE_AGENT); }
__device__ __forceinline__ unsigned xb_add(unsigned* p, unsigned v) { return __hip_atomic_fetch_add(p, v, __ATOMIC_RELAXED, __HIP_MEMORY_SCOPE_AGENT); }
__device__ __forceinline__ unsigned xb_xcc_id() { return (unsigned)__builtin_amdgcn_s_getreg((3 << 11) | 20) & 0xFu; }
#define XB_SPIN(cond, bar) do { unsigned _sp = 0; while (cond) { __builtin_amdgcn_s_sleep(1); \
    if ((++_sp & 255u) == 0u) { if (xb_ld(&(bar)[XB_TMO])) break; if (_sp > XB_SPIN_CAP) { atomicAdd(&(bar)[XB_TMO], 1u); break; } } } } while (0)

struct XcdBarrier {
    unsigned* bar; unsigned x;
    volatile LAS unsigned* st;
};

__device__ __forceinline__ XcdBarrier xcd_barrier_post(unsigned* bar, volatile LAS unsigned* st) {
    XcdBarrier b; b.bar = bar; b.x = xb_xcc_id(); b.st = st;
    if (threadIdx.x == 0) (void)xb_add(&bar[XB_XCNT(b.x)], 1u);
    return b;
}
__device__ __forceinline__ void xcd_barrier_complete(unsigned* bar, unsigned x, unsigned& nloc, unsigned& nx) {
    const unsigned G = gridDim.x * gridDim.y * gridDim.z;
    unsigned sum, cnt, mine, sp = 0u;
    for (;;) {
        sum = 0u; cnt = 0u; mine = 0u;
#pragma unroll
        for (unsigned j = 0; j < 16; ++j) { const unsigned c = xb_ld(&bar[XB_XCNT(j)]); sum += c; cnt += (c > 0u) ? 1u : 0u; mine = (j == x) ? c : mine; }
        if (sum == G) break;
        __builtin_amdgcn_s_sleep(1);
        if ((++sp & 255u) == 0u) { if (xb_ld(&bar[XB_TMO])) break; if (sp > XB_SPIN_CAP) { atomicAdd(&bar[XB_TMO], 1u); break; } }
    }
    nloc = mine > 0u ? mine : 1u; nx = cnt > 0u ? cnt : 1u;
}

__device__ __forceinline__ void xcd_barrier(const XcdBarrier& b) {
    asm volatile("s_waitcnt vmcnt(0)" ::: "memory");
    __syncthreads();
    if (threadIdx.x == 0) {
        unsigned* bar = b.bar;
        __builtin_amdgcn_s_waitcnt(0);
        unsigned nloc = b.st[0], nx = b.st[1];
        if (nloc == 0u) { xcd_barrier_complete(bar, b.x, nloc, nx); b.st[0] = nloc; b.st[1] = nx; }
        const unsigned old = xb_add(&bar[XB_XSUB(b.x)], 1u);
        const unsigned gen = old / nloc;
        if (old + 1u == (gen + 1u) * nloc) {
            __builtin_amdgcn_fence(__ATOMIC_RELEASE, "agent");
            asm volatile("s_waitcnt vmcnt(0)" ::: "memory");
            const unsigned og = xb_add(&bar[XB_TOP], 1u);
            const unsigned tg = og / nx;
            if (og + 1u == (tg + 1u) * nx) xb_add(&bar[XB_TOPGEN], 1u);
            else XB_SPIN(xb_ld(&bar[XB_TOPGEN]) == tg, bar);
            __builtin_amdgcn_fence(__ATOMIC_ACQUIRE, "agent");
            xb_add(&bar[XB_XGEN(b.x)], 1u);
            asm volatile("s_waitcnt vmcnt(0)" ::: "memory");
        } else {
            XB_SPIN(xb_ld(&bar[XB_XGEN(b.x)]) == gen, bar);
            __builtin_amdgcn_fence(__ATOMIC_ACQUIRE, "agent");
            asm volatile("s_waitcnt vmcnt(0)" ::: "memory");
        }
    }
    __syncthreads();
}

__device__ __forceinline__ float wave_sum(float s) {
#pragma unroll
    for (int o = 32; o >= 1; o >>= 1) s += __shfl_xor(s, o);
    return s;
}
__device__ __forceinline__ void rmsnorm_row_bf(const float* __restrict__ xr, const float* __restrict__ gain, u16* __restrict__ ob, int lane) {
    f32x4 v[8]; float s = 0.f;
#pragma unroll
    for (int j = 0; j < 8; ++j) { v[j] = *(const f32x4*)(xr + (lane + 64 * j) * 4); s += v[j][0] * v[j][0] + v[j][1] * v[j][1] + v[j][2] * v[j][2] + v[j][3] * v[j][3]; }
    s = wave_sum(s);
    const float r = rsqrtf(s * (1.0f / (float)DM) + EPS);
#pragma unroll
    for (int j = 0; j < 8; ++j) { const f32x4 g = *(const f32x4*)(gain + (lane + 64 * j) * 4); const f32x4 o = v[j] * r * g;
        *(u32x2*)(ob + (lane + 64 * j) * 4) = (u32x2){pk_bf16(o[0], o[1]), pk_bf16(o[2], o[3])}; }
}
__device__ __forceinline__ void hgrn_final_item4(int item0, int stride, const float* __restrict__ OF, const float* __restrict__ OB, const u16* __restrict__ PG, const float* __restrict__ gain, u16* __restrict__ MIXB, int lane) {
    f32x2 a[4], b[4]; unsigned gw[4];
#pragma unroll
    for (int q = 0; q < 4; ++q) { const int item = item0 + q * stride, tok = item >> 3, c = (item & 7) * 128 + 2 * lane;
        a[q] = *(const f32x2*)(OF + (size_t)tok * HGW + c); b[q] = *(const f32x2*)(OB + (size_t)tok * HGW + c); gw[q] = *(const unsigned*)(PG + (size_t)tok * 5120 + 4096 + c); }
#pragma unroll
    for (int q = 0; q < 4; ++q) { const int item = item0 + q * stride, tok = item >> 3, c = (item & 7) * 128 + 2 * lane;
        const float o0 = a[q][0] + b[q][0], o1 = a[q][1] + b[q][1];
        const float s = wave_sum(o0 * o0 + o1 * o1);
        const float r = rsqrtf(s * (1.0f / 128.0f) + EPS);
        const float g0 = bflo(gw[q]), g1 = bfhi(gw[q]);
        const f32x2 gn = *(const f32x2*)(gain + c);
        const float v0 = o0 * r * gn[0] * (g0 / (1.0f + __expf(-g0))), v1 = o1 * r * gn[1] * (g1 / (1.0f + __expf(-g1)));
        *(u16*)((unsigned char*)MIXB + (size_t)tok * DM + c) = (u16)(__builtin_amdgcn_cvt_pk_fp8_f32(v0, v1, 0, false) & 0xffff); }
}
__device__ __forceinline__ void hy_norm_tile(LAS unsigned char* lds, int tile_i, const u16* __restrict__ Z2T, const float* __restrict__ gain, u16* __restrict__ MIXB) {
    const int t = tid_fresh(), tok0 = tile_i * 32;
    LAS float* ssq = (LAS float*)(lds + 1024 * 80);
    if (t < 32) ssq[t] = 0.f;
    __syncthreads();
    float part[8];
#pragma unroll
    for (int q = 0; q < 8; ++q) part[q] = 0.f;
    const int ch = t & 3;
#pragma unroll
    for (int it = 0; it < 8; ++it) {
        const int c = (t >> 2) + 128 * it;
        const u32x4 v = *(const u32x4*)(Z2T + (size_t)c * NTOK + tok0 + ch * 8);
        *(LAS u32x4*)(lds + c * 80 + ch * 16) = v;
#pragma unroll
        for (int q = 0; q < 4; ++q) { const float a = bflo(v[q]), b = bfhi(v[q]); part[2 * q] += a * a; part[2 * q + 1] += b * b; }
    }
#pragma unroll
    for (int q = 0; q < 8; ++q) { float s = part[q]; s += __shfl_xor(s, 4); s += __shfl_xor(s, 8); s += __shfl_xor(s, 16); s += __shfl_xor(s, 32); part[q] = s; }
    if ((t & 63) < 4) {
#pragma unroll
        for (int q = 0; q < 8; ++q) atomicAdd((float*)(ssq + ch * 8 + q), part[q]);
    }
    __syncthreads();
    const int tt = t >> 4;
    const float r = rsqrtf(ssq[tt] * (1.0f / (float)HYW) + EPS);
#pragma unroll 2
    for (int k = 0; k < 8; ++k) {
        const int c0 = ((t & 15) + 16 * k) * 8;
        float o[8];
#pragma unroll
        for (int q = 0; q < 8; ++q) o[q] = bf2f(*(const LAS u16*)(lds + (c0 + q) * 80 + tt * 2)) * r * gain[c0 + q];
        *(u32x2*)((unsigned char*)MIXB + (size_t)(tok0 + tt) * DM + 1024 + c0) = (u32x2){pk_fp8x4(o[0], o[1], o[2], o[3]), pk_fp8x4(o[4], o[5], o[6], o[7])};
    }
    __syncthreads();
}
constexpr int RT_XSTRIDE = 2049;
constexpr int RT_PART = 16 * RT_XSTRIDE * 4;
constexpr int RT_LG = RT_PART + 8 * 16 * 32 * 4;
constexpr int RT_HIST = RT_LG + 16 * 32 * 4;
constexpr int RT_ITEMS = RT_HIST + 128;
constexpr int RT_RBASE = RT_ITEMS + 512;
constexpr int RT_END = RT_RBASE + 128;
__device__ __forceinline__ void router_tile(LAS unsigned char* lds, int tile_i, const float* __restrict__ X1, const float* __restrict__ gain, const float* __restrict__ wr, const float* __restrict__ br,
                                            unsigned char* __restrict__ XN8, float* __restrict__ TOPG, int tl2) {
    const int tid = tid_fresh(), wid = __builtin_amdgcn_readfirstlane(tid >> 6), lane = tid & 63;
    const int tok0 = tile_i * 16;
    LAS float* xs = (LAS float*)lds;
#pragma unroll
    for (int q = 0; q < 2; ++q) {
        const int tl = wid * 2 + q; const size_t tok = (size_t)tok0 + tl;
        const float* xr = X1 + tok * DM;
        f32x4 v[8]; float s = 0.f;
#pragma unroll
        for (int j = 0; j < 8; ++j) { v[j] = *(const f32x4*)(xr + (lane + 64 * j) * 4); s += v[j][0] * v[j][0] + v[j][1] * v[j][1] + v[j][2] * v[j][2] + v[j][3] * v[j][3]; }
        s = wave_sum(s);
        const float r = rsqrtf(s * (1.0f / (float)DM) + EPS);
#pragma unroll
        for (int j = 0; j < 8; ++j) { const int d = (lane + 64 * j) * 4; const f32x4 g = *(const f32x4*)(gain + d); const f32x4 o = v[j] * r * g;
            xs[tl * RT_XSTRIDE + d + 0] = o[0]; xs[tl * RT_XSTRIDE + d + 1] = o[1]; xs[tl * RT_XSTRIDE + d + 2] = o[2]; xs[tl * RT_XSTRIDE + d + 3] = o[3];
            *(unsigned*)(XN8 + tok * DM + d) = pk_fp8x4(o[0], o[1], o[2], o[3]); }
    }
    __syncthreads();
    {
        const int tl = lane & 15, kk = lane >> 4;
        f32x4 a0 = {0.f, 0.f, 0.f, 0.f}, a1 = a0;
        const LAS float* xp = xs + tl * RT_XSTRIDE + wid * 256 + kk;
        const float* wp = wr + (size_t)(wid * 256 + kk) * NE + tl;
#pragma unroll 8
        for (int ks = 0; ks < 64; ++ks) { const float a = xp[ks * 4]; const float b0 = wp[(size_t)ks * 4 * NE], b1 = wp[(size_t)ks * 4 * NE + 16];
            a0 = __builtin_amdgcn_mfma_f32_16x16x4f32(a, b0, a0, 0, 0, 0); a1 = __builtin_amdgcn_mfma_f32_16x16x4f32(a, b1, a1, 0, 0, 0); }
        LAS float* pp = (LAS float*)(lds + RT_PART) + wid * 512;
#pragma unroll
        for (int j = 0; j < 4; ++j) { pp[(kk * 4 + j) * 32 + tl] = a0[j]; pp[(kk * 4 + j) * 32 + 16 + tl] = a1[j]; }
    }
    __syncthreads();
    {   const LAS float* pp = (const LAS float*)(lds + RT_PART); float s = br[tid & 31];
#pragma unroll
        for (int w = 0; w < 8; ++w) s += pp[w * 512 + tid];
        ((LAS float*)(lds + RT_LG))[tid] = s; }
    __syncthreads();
    if (tid < 16) {
        LAS float* lg = (LAS float*)(lds + RT_LG) + tid * 32;
        int i0 = 0, i1 = 0, i2 = 0, i3 = 0; float v0, v1, v2, v3;
        { float bv = -3.0e38f; for (int j = 0; j < NE; ++j) { const float l = lg[j]; if (l > bv) { bv = l; i0 = j; } } v0 = bv; lg[i0] = -3.4e38f; }
        { float bv = -3.0e38f; for (int j = 0; j < NE; ++j) { const float l = lg[j]; if (l > bv) { bv = l; i1 = j; } } v1 = bv; lg[i1] = -3.4e38f; }
        { float bv = -3.0e38f; for (int j = 0; j < NE; ++j) { const float l = lg[j]; if (l > bv) { bv = l; i2 = j; } } v2 = bv; lg[i2] = -3.4e38f; }
        { float bv = -3.0e38f; for (int j = 0; j < NE; ++j) { const float l = lg[j]; if (l > bv) { bv = l; i3 = j; } } v3 = bv; lg[i3] = -3.4e38f; }
        const float e1 = __expf(v1 - v0), e2 = __expf(v2 - v0), e3 = __expf(v3 - v0), inv = 1.0f / (1.0f + e1 + e2 + e3);
        const int tok = tok0 + tid;
        *(f32x4*)(TOPG + tok * 4) = (f32x4){inv, e1 * inv, e2 * inv, e3 * inv};
        LAS int* hist = (LAS int*)(lds + RT_HIST);
        const int p0 = atomicAdd((int*)(hist + i0), 1), p1 = atomicAdd((int*)(hist + i1), 1), p2 = atomicAdd((int*)(hist + i2), 1), p3 = atomicAdd((int*)(hist + i3), 1);
        *(LAS u32x4*)(lds + RT_ITEMS + (tl2 * 16 + tid) * 16) = (u32x4){(unsigned)((i0 << 16) | p0), (unsigned)((i1 << 16) | p1), (unsigned)((i2 << 16) | p2), (unsigned)((i3 << 16) | p3)};
    }
    __syncthreads();
}
__device__ __forceinline__ void combine_row(int tok, const float* __restrict__ X1, const u16* __restrict__ YB, const int* __restrict__ SOF, const float* __restrict__ TOPG, const float* __restrict__ gain, float* __restrict__ out, int lane) {
    const int4 sl = *(const int4*)(SOF + tok * 4); const f32x4 g = *(const f32x4*)(TOPG + tok * 4);
    const u16* y0 = YB + (size_t)sl.x * DM; const u16* y1 = YB + (size_t)sl.y * DM; const u16* y2 = YB + (size_t)sl.z * DM; const u16* y3 = YB + (size_t)sl.w * DM;
    f32x4 v[8]; float s = 0.f;
#pragma unroll
    for (int j = 0; j < 8; ++j) { const int d = (lane + 64 * j) * 4;
        f32x4 a = *(const f32x4*)(X1 + (size_t)tok * DM + d);
        const u32x2 q0 = *(const u32x2*)(y0 + d), q1 = *(const u32x2*)(y1 + d), q2 = *(const u32x2*)(y2 + d), q3 = *(const u32x2*)(y3 + d);
        a[0] += g[0] * bflo(q0[0]) + g[1] * bflo(q1[0]) + g[2] * bflo(q2[0]) + g[3] * bflo(q3[0]);
        a[1] += g[0] * bfhi(q0[0]) + g[1] * bfhi(q1[0]) + g[2] * bfhi(q2[0]) + g[3] * bfhi(q3[0]);
        a[2] += g[0] * bflo(q0[1]) + g[1] * bflo(q1[1]) + g[2] * bflo(q2[1]) + g[3] * bflo(q3[1]);
        a[3] += g[0] * bfhi(q0[1]) + g[1] * bfhi(q1[1]) + g[2] * bfhi(q2[1]) + g[3] * bfhi(q3[1]);
        v[j] = a; s += a[0] * a[0] + a[1] * a[1] + a[2] * a[2] + a[3] * a[3]; }
    s = wave_sum(s);
    const float r = rsqrtf(s * (1.0f / (float)DM) + EPS);
#pragma unroll
    for (int j = 0; j < 8; ++j) { const int d = (lane + 64 * j) * 4; const f32x4 gn = *(const f32x4*)(gain + d); *(f32x4*)(out + (size_t)tok * DM + d) = v[j] * r * gn; }
}

__device__ __forceinline__ void combine_row2(int tokA, int tokB, const float* __restrict__ X1, const u16* __restrict__ YB, const int* __restrict__ SOF, const float* __restrict__ TOPG, const float* __restrict__ gain, float* __restrict__ out, int lane) {
    const int4 slA = *(const int4*)(SOF + tokA * 4), slB = *(const int4*)(SOF + tokB * 4); const f32x4 gA = *(const f32x4*)(TOPG + tokA * 4), gB = *(const f32x4*)(TOPG + tokB * 4);
    const u16* yA0 = YB + (size_t)slA.x * DM; const u16* yA1 = YB + (size_t)slA.y * DM; const u16* yA2 = YB + (size_t)slA.z * DM; const u16* yA3 = YB + (size_t)slA.w * DM;
    const u16* yB0 = YB + (size_t)slB.x * DM; const u16* yB1 = YB + (size_t)slB.y * DM; const u16* yB2 = YB + (size_t)slB.z * DM; const u16* yB3 = YB + (size_t)slB.w * DM;
    f32x4 vA[8], vB[8]; float sA = 0.f, sB = 0.f;
#pragma unroll
    for (int j = 0; j < 8; ++j) { const int d = (lane + 64 * j) * 4;
        f32x4 a = *(const f32x4*)(X1 + (size_t)tokA * DM + d), b = *(const f32x4*)(X1 + (size_t)tokB * DM + d);
        const u32x2 p0 = *(const u32x2*)(yA0 + d), p1 = *(const u32x2*)(yA1 + d), p2 = *(const u32x2*)(yA2 + d), p3 = *(const u32x2*)(yA3 + d);
        const u32x2 q0 = *(const u32x2*)(yB0 + d), q1 = *(const u32x2*)(yB1 + d), q2 = *(const u32x2*)(yB2 + d), q3 = *(const u32x2*)(yB3 + d);
        a[0] += gA[0] * bflo(p0[0]) + gA[1] * bflo(p1[0]) + gA[2] * bflo(p2[0]) + gA[3] * bflo(p3[0]);
        a[1] += gA[0] * bfhi(p0[0]) + gA[1] * bfhi(p1[0]) + gA[2] * bfhi(p2[0]) + gA[3] * bfhi(p3[0]);
        a[2] += gA[0] * bflo(p0[1]) + gA[1] * bflo(p1[1]) + gA[2] * bflo(p2[1]) + gA[3] * bflo(p3[1]);
        a[3] += gA[0] * bfhi(p0[1]) + gA[1] * bfhi(p1[1]) + gA[2] * bfhi(p2[1]) + gA[3] * bfhi(p3[1]);
        b[0] += gB[0] * bflo(q0[0]) + gB[1] * bflo(q1[0]) + gB[2] * bflo(q2[0]) + gB[3] * bflo(q3[0]);
        b[1] += gB[0] * bfhi(q0[0]) + gB[1] * bfhi(q1[0]) + gB[2] * bfhi(q2[0]) + gB[3] * bfhi(q3[0]);
        b[2] += gB[0] * bflo(q0[1]) + gB[1] * bflo(q1[1]) + gB[2] * bflo(q2[1]) + gB[3] * bflo(q3[1]);
        b[3] += gB[0] * bfhi(q0[1]) + gB[1] * bfhi(q1[1]) + gB[2] * bfhi(q2[1]) + gB[3] * bfhi(q3[1]);
        vA[j] = a; vB[j] = b; sA += a[0] * a[0] + a[1] * a[1] + a[2] * a[2] + a[3] * a[3]; sB += b[0] * b[0] + b[1] * b[1] + b[2] * b[2] + b[3] * b[3]; }
    sA = wave_sum(sA); sB = wave_sum(sB);
    const float rA = rsqrtf(sA * (1.0f / (float)DM) + EPS), rB = rsqrtf(sB * (1.0f / (float)DM) + EPS);
#pragma unroll
    for (int j = 0; j < 8; ++j) { const int d = (lane + 64 * j) * 4; const f32x4 gn = *(const f32x4*)(gain + d);
        *(f32x4*)(out + (size_t)tokA * DM + d) = vA[j] * rA * gn; *(f32x4*)(out + (size_t)tokB * DM + d) = vB[j] * rB * gn; }
}
#ifndef REP_P9
#define REP_P9 1
#endif
#ifndef REP_P3
#define REP_P3 1
#endif
#ifndef REP_FR
#define REP_FR 1
#endif
#ifndef REP_P0
#define REP_P0 1
#endif
#ifndef REP_CONV
#define REP_CONV 1
#endif
#ifndef REP_GEMM1
#define REP_GEMM1 1
#endif
#ifndef REP_HY
#define REP_HY 1
#endif
#ifndef REP_HG
#define REP_HG 1
#endif
#ifndef REP_MOEA
#define REP_MOEA 1
#endif
#ifndef REP_MOEB
#define REP_MOEB 1
#endif
#ifndef REP_WOUT
#define REP_WOUT 1
#endif
struct MegaP {
    const float *x, *norm_mix_gain, *w_in, *lb_logits, *hgrn_norm_gain, *hy_conv_w, *hy_conv_b, *fw1, *fb1, *fw2, *fb2, *fw3, *fb3, *fw4, *ffreq, *hy_bias, *hy_norm_gain, *w_out,
        *norm_ffn_gain, *w_router, *b_router, *moe_w1, *moe_b1, *moe_w2, *moe_b2, *final_gain;
    float* out; unsigned char* ws;
};
constexpr int MEGA_XB = RT_END;
constexpr int MEGA_LDS = RT_END + 64 + 384;
static_assert(MEGA_LDS >= HY_LDS + 64 && MEGA_LDS >= HG_LDS + 64 && MEGA_LDS >= GEMM_LDS + 64, "LDS");

__global__ void __launch_bounds__(512, 2) k_mega(const MegaP p_arg) {
    extern __shared__ __attribute__((aligned(16))) unsigned char shm[];
    LAS unsigned char* lds = (LAS unsigned char*)shm;
    const int tid = threadIdx.x, wid = __builtin_amdgcn_readfirstlane(tid >> 6), lane = tid & 63;
    const int G = gridDim.x, bid = blockIdx.x, c = xcd_logical(bid, G);
#define PHASE_ARGS() const MegaP __attribute__((address_space(4)))* pq_ = (const MegaP __attribute__((address_space(4)))*)__builtin_amdgcn_kernarg_segment_ptr(); asm volatile("" : "+s"(pq_)); unsigned char* ws = pq_->ws; (void)ws
    unsigned char* ws0; { PHASE_ARGS(); ws0 = ws; }
#define counts ((int*)(ws + WS_CTL))
#define cursor ((int*)(ws + WS_CTL + 4096))
#define offs ((int*)(ws + WS_CTL + 8192))
#define barw ((unsigned*)(ws + WS_CTL + 16384))
#define HB ((u16*)(ws + WS_HB))
#define PG ((u16*)(ws + WS_PG))
#define HYT ((u16*)(ws + WS_HYT))
#define MIXB ((u16*)(ws + WS_MIXB))
#define XNB ((u16*)(ws + WS_XNB))
#define HMB ((u16*)(ws + WS_HMS))
#define YB ((u16*)(ws + WS_YS))
#define H3 ((float*)(ws + WS_H3))
#define FR ((u16*)(ws + WS_FR))
#define Z2T ((u16*)(ws + WS_Z2T))
#define OF ((float*)(ws + WS_OF))
#define OB ((float*)(ws + WS_OB))
#define X1 ((float*)(ws + WS_X1))
#define TOPI ((int*)(ws + WS_TOPI))
#define TOPG ((float*)(ws + WS_TOPG))
#define STOK ((int*)(ws + WS_STOKS))
#define SOF ((int*)(ws + WS_SOF))
#define WINT ((u16*)(ws + WS_WINT))
#define WOUTT ((u16*)(ws + WS_WOUTT))
#define W1T ((u16*)(ws + WS_W1T))
#define W2T ((u16*)(ws + WS_W2T))
    if (tid == 0) *(LAS u32x4*)(lds + MEGA_XB) = (u32x4){0u, 0u, 0u, 0u};
    __syncthreads();
    XcdBarrier bar = xcd_barrier_post((unsigned*)(ws0 + WS_CTL + 16384), (volatile LAS unsigned*)(lds + MEGA_XB));

    {
        PHASE_ARGS();
    for (int rep = 0; rep < REP_P0; ++rep) {
    for (int row = bid * 8 + wid; row < NTOK; row += G * 8) rmsnorm_row_bf(pq_->x + (size_t)row * DM, pq_->norm_mix_gain, HB + (size_t)row * DM, lane);
    for (int m = bid * 8 + wid; m < SEQ; m += G * 8) h3_row(m, pq_->fw1, pq_->fb1, pq_->fw2, pq_->fb2, pq_->fw3, pq_->fb3, pq_->ffreq, (LAS float*)(lds + wid * 512), H3); }
    for (int rep = 0; rep < REP_CONV; ++rep)
    for (int id = bid; id < 1024 + 256; id += G) {
        const int tz = tid_fresh();
        if (id < 1024) { const int nt = id >> 5, kt = id & 31; convert_tile(pq_->w_in, DIN, kt * 64, ColMapPerm{nt * 256}, WINT + (size_t)id * 16384, tz); }
        else { const int q = id - 1024; const ConvCtx cw{nullptr, pq_->w_out, nullptr, (unsigned char*)WOUTT};
            f32x2 cv[16]; conv_issue(cw, 16384 + q, tz >> 6, tz & 63, cv); conv_finish(cw, 16384 + q, tz >> 6, tz & 63, cv); }
    }
    }
    xcd_barrier(bar);
    {
        PHASE_ARGS();
    for (int rep = 0; rep < REP_FR; ++rep)
    for (int item = bid; item < 256; item += G) frgen_item(lds, item, H3, pq_->fw4, FR);
    { SrcG1<false> s0{c, G, (const char*)HB, (const char*)WINT, PG, HYT, pq_->lb_logits}; gemm8_stream<false, false>(lds, DM, 32, s0);
      SrcG1<true> s1{c, G, (const char*)HB, (const char*)WINT, PG, HYT, pq_->lb_logits}; gemm8_stream<true, false>(lds, DM, 32, s1); }
#ifdef PROBE_NOEPI
    for (int u = c; u < 1024; u += G) {
        const int i = u >> 8, xx = (u >> 5) & 7, j = u & 31;
        const int mt = (xx & 3) * 8 + (j & 7), nt = ((xx >> 2) + 2 * i) * 4 + (j >> 3);
        const u16* bt = WINT + (size_t)nt * 32 * 16384;
        EpiNone e{}; if (nt < 20) gemm8_unit<false>(lds, HB, DM, nullptr, mt * 256, 256, bt, 32, e); else gemm8_unit<true>(lds, HB, DM, nullptr, mt * 256, 256, bt, 32, e);
    }
#endif
    }
    xcd_barrier(bar);
    {
        PHASE_ARGS();
    for (int rep = 0; rep < REP_HY; ++rep)
    for (int u = bid; u < 256; u += G) hyena_unit(lds, u, HYT, FR, pq_->hy_conv_w, pq_->hy_conv_b, pq_->hy_bias, Z2T, ConvCtx{pq_->moe_w1, pq_->moe_w2, (unsigned char*)W1T, (unsigned char*)W2T});
    for (int rep = 0; rep < REP_HG; ++rep)
    for (int u = bid; u < 256; u += G) hgrn_unit(lds, u, PG, pq_->lb_logits, OF, OB, ConvCtx{pq_->moe_w1, pq_->moe_w2, (unsigned char*)W1T, (unsigned char*)W2T});
    }
    xcd_barrier(bar);
    {
        PHASE_ARGS();
    for (int rep = 0; rep < REP_P3; ++rep) {
    for (int it = bid * 8 + wid; it < NTOK * HGH; it += G * 8 * 4) hgrn_final_item4(it, G * 8, OF, OB, PG, pq_->hgrn_norm_gain, MIXB, lane);
    for (int t = bid; t < NTOK / 32; t += G) hy_norm_tile(lds, t, Z2T, pq_->hy_norm_gain, MIXB); }
    }
    xcd_barrier(bar);
    {
        PHASE_ARGS();
    for (int u = c; u < 256; u += G) {
        const int xx = u >> 5, j = u & 31;
        const int mt = (xx >> 1) * 8 + (j & 7), nt = (xx & 1) * 4 + (j >> 3);
        Epi8X1 e{pq_->x, X1, mt * 256, nt * 256};
        gemm8_unit<false, true>(lds, MIXB, DM / 2, nullptr, mt * 256, 256, WOUTT + (size_t)nt * 16 * 16384, 16, e);
    }
    }
    xcd_barrier(bar);
    {
        PHASE_ARGS();
    if (tid < NE) *(LAS int*)(lds + RT_HIST + tid * 4) = 0;
    __syncthreads();
    for (int t0 = bid; t0 < NTOK / 16; t0 += 2 * G) {
        const int t1 = t0 + G, ntl = (t1 < NTOK / 16) ? 2 : 1;
        router_tile(lds, t0, X1, pq_->norm_ffn_gain, pq_->w_router, pq_->b_router, (unsigned char*)XNB, TOPG, 0);
        if (ntl == 2) router_tile(lds, t1, X1, pq_->norm_ffn_gain, pq_->w_router, pq_->b_router, (unsigned char*)XNB, TOPG, 1);
        const int tq = tid_fresh();
        if (tq < NE) { const int n = *(const LAS int*)(lds + RT_HIST + tq * 4); *(LAS int*)(lds + RT_RBASE + tq * 4) = n ? atomicAdd(&cursor[tq * 32], n) : 0; *(LAS int*)(lds + RT_HIST + tq * 4) = 0; }
        __syncthreads();
        if (tq < ntl * 64) { const int it = *(const LAS int*)(lds + RT_ITEMS + tq * 4), e = it >> 16, tok = ((tq >> 6) ? t1 : t0) * 16 + ((tq >> 2) & 15);
            const int slot = e * NTOK + *(const LAS int*)(lds + RT_RBASE + e * 4) + (it & 0xffff); STOK[slot] = tok; SOF[tok * 4 + (tq & 3)] = slot; }
        __syncthreads();
    }
    }
    xcd_barrier(bar);
    {
        PHASE_ARGS();
    {
        LAS int* us = (LAS int*)(lds + MEGA_XB + 64); LAS int* so2 = us + 40;
        if (tid < NE) so2[tid] = __hip_atomic_load(&cursor[tid * 32], __ATOMIC_RELAXED, __HIP_MEMORY_SCOPE_AGENT);
        __syncthreads();
        if (tid == 0) { int a = 0; for (int e = 0; e < NE; ++e) { us[e] = a; a += ((so2[e] + 255) >> 8) * 16; } us[NE] = a; }
        __syncthreads();
    }
    {
        LAS int* qs = (LAS int*)(lds + MEGA_XB + 32); LAS int* us = (LAS int*)(lds + MEGA_XB + 64); LAS int* so2 = us + 40;
        int* qctr = (int*)(ws + WS_CTL + 12288 + (bid & 7) * 128);
        int tk_next = 0;
        if (tid == 0) tk_next = atomicAdd(qctr, 1);
        for (;;) {
            if (tid == 0) { qs[0] = tk_next; qs[1] = -1; }
            __syncthreads();
            const int tk = qs[0];
            const int u = 256 * (tk >> 5) + 32 * (bid & 7) + (tk & 31);
            if (tid < NE) { const int u0 = us[tid], u1 = us[tid + 1]; if (u >= u0 && u < u1) { const int o0 = tid * NTOK, cnt = so2[tid], mtl = (cnt + 255) >> 8, ul = u - u0, mt = ul % mtl;
                int rows = cnt - mt * 256; rows = rows > 256 ? 256 : rows; qs[1] = tid; qs[2] = ul / mtl; qs[3] = o0 + mt * 256; qs[4] = rows; } }
            __syncthreads();
            const int e = qs[1], nt = qs[2], slot0 = qs[3], rows = qs[4];
            __syncthreads();
            if (e < 0) break;
            if (tid == 0) tk_next = atomicAdd(qctr, 1);
            Epi8Swiglu8 ep{(unsigned char*)HMB, pq_->moe_b1 + (size_t)e * 2 * DFF, slot0, nt, rows};
            gemm8_unit<false, true>(lds, XNB, DM / 2, STOK + slot0, 0, rows, W1T + (size_t)(e * 16 + nt) * 16 * 16384, 16, ep);
        }
    }
    }
    xcd_barrier(bar);
    {
        PHASE_ARGS();
    {
        LAS int* us = (LAS int*)(lds + MEGA_XB + 64); LAS int* so2 = us + 40;
        if (tid < NE) so2[tid] = __hip_atomic_load(&cursor[tid * 32], __ATOMIC_RELAXED, __HIP_MEMORY_SCOPE_AGENT);
        __syncthreads();
        if (tid == 0) { int a = 0; for (int e = 0; e < NE; ++e) { us[e] = a; a += ((so2[e] + 255) >> 8) * 8; } us[NE] = a; }
        __syncthreads();
    }
    {
        const LAS int* us = (const LAS int*)(lds + MEGA_XB + 64); const LAS int* so2 = us + 40;
        SrcMoeB src{us, so2, c, G, (const char*)HMB, (const char*)W2T, YB, pq_->moe_b2};
        gemm8_stream<false, true>(lds, DFF / 2, 16, src);
    }
    }
    xcd_barrier(bar);
    {
        PHASE_ARGS();
    for (int rep = 0; rep < REP_P9; ++rep)
    for (int tok = bid * 8 + wid; tok < NTOK; tok += G * 8) combine_row(tok, X1, YB, SOF, TOPG, pq_->final_gain, pq_->out, lane);
    }
}
#undef counts
#undef cursor
#undef offs
#undef barw
#undef HB
#undef PG
#undef HYT
#undef MIXB
#undef XNB
#undef HMB
#undef YB
#undef H3
#undef FR
#undef Z2T
#undef OF
#undef OB
#undef X1
#undef TOPI
#undef TOPG
#undef STOK
#undef SOF
#undef WINT
#undef WOUTT
#undef W1T
#undef W2T

extern "C" void kernel_launch(void* const* d_in, const int* in_sizes, int n_in, void* d_out, int out_size, void* d_ws, size_t ws_size, hipStream_t stream) {
    if (n_in < 26 || ws_size < WS_END2) return;
    MegaP p{};
    const float** pp = (const float**)&p;
    for (int i = 0; i < 26; ++i) pp[i] = (const float*)d_in[i];
    p.out = (float*)d_out; p.ws = (unsigned char*)d_ws;
    static int grid = 0;
    if (!grid) {
        int dev = 0, cus = 0, per_cu = 0;
        (void)hipGetDevice(&dev);
        (void)hipDeviceGetAttribute(&cus, hipDeviceAttributeMultiprocessorCount, dev);
        (void)hipFuncSetAttribute((const void*)k_mega, hipFuncAttributeMaxDynamicSharedMemorySize, MEGA_LDS);
        (void)hipOccupancyMaxActiveBlocksPerMultiprocessor(&per_cu, (const void*)k_mega, 512, MEGA_LDS);
        if (per_cu < 1) per_cu = 1;
        grid = cus * 1;
        if (grid > 256) grid = 256;
        grid &= ~7;
        if (grid < 8) grid = 8;
    }
    (void)hipMemsetAsync((char*)d_ws + WS_CTL, 0, 65536, stream);
    hipLaunchKernelGGL(k_mega, dim3(grid), dim3(512), MEGA_LDS, stream, p);
}
```

```cpp
#include <hip/hip_runtime.h>
#include <stdint.h>

constexpr int BATCH = 4, SEQ = 2048, DM = 2048, NTOK = BATCH * SEQ;
constexpr int HGW = 1024, HGD = 128, HGH = 8;
constexpr int HYW = 1024;
constexpr int DIN = 8192;
constexpr int NE = 32, TOPK = 4, DFF = 2048;
constexpr int NSLOT = NTOK * TOPK;
constexpr float EPS = 1e-5f;

constexpr size_t MB = 1024ull * 1024ull;
constexpr size_t WS_CTL = 0;
constexpr size_t WS_HB = 1 * MB;
constexpr size_t WS_PG = WS_HB + 32 * MB;
constexpr size_t WS_HYT = WS_PG + 80 * MB;
constexpr size_t WS_MIXB = WS_HYT + 48 * MB;
constexpr size_t WS_XNB = WS_MIXB + 32 * MB;
constexpr size_t WS_HMB = WS_XNB + 32 * MB;
constexpr size_t WS_YB = WS_HMB + 128 * MB;
constexpr size_t WS_H3 = WS_YB + 128 * MB;
constexpr size_t WS_FR = WS_H3 + 1 * MB;
constexpr size_t WS_Z2T = WS_FR + 34 * MB;
constexpr size_t WS_OF = WS_Z2T + 16 * MB;
constexpr size_t WS_OB = WS_OF + 32 * MB;
constexpr size_t WS_X1 = WS_OB + 32 * MB;
constexpr size_t WS_TOPI = WS_X1 + 64 * MB;
constexpr size_t WS_TOPG = WS_TOPI + 1 * MB;
constexpr size_t WS_STOK = WS_TOPG + 1 * MB;
constexpr size_t WS_SOF = WS_STOK + 1 * MB;
constexpr size_t WS_WINT = WS_SOF + 1 * MB;
constexpr size_t WS_WOUTT = WS_WINT + 32 * MB;
constexpr size_t WS_W1T = WS_WOUTT + 8 * MB;
constexpr size_t WS_W2T = WS_W1T + 512 * MB;
constexpr size_t WS_HMS = WS_W2T + 256 * MB;
constexpr size_t WS_YS = WS_HMS + 512 * MB;
constexpr size_t WS_STOKS = WS_YS + 1024 * MB;
constexpr size_t WS_END2 = WS_STOKS + 1 * MB;

typedef short bf16x8 __attribute__((ext_vector_type(8)));
typedef float f32x4 __attribute__((ext_vector_type(4)));
typedef float f32x2 __attribute__((ext_vector_type(2)));
typedef unsigned u32x4 __attribute__((ext_vector_type(4)));
typedef unsigned u32x2 __attribute__((ext_vector_type(2)));
typedef unsigned short u16;
#define LAS __attribute__((address_space(3)))

__device__ __forceinline__ unsigned pk_bf16(float lo, float hi) {
    typedef __bf16 bf2 __attribute__((ext_vector_type(2)));
    const f32x2 v = {lo, hi};
    const bf2 r = __builtin_convertvector(v, bf2);
    return __builtin_bit_cast(unsigned, r);
}
__device__ __forceinline__ float bf2f(u16 b) { return __uint_as_float(((unsigned)b) << 16); }
__device__ __forceinline__ float bflo(unsigned w) { return __uint_as_float(w << 16); }
__device__ __forceinline__ float bfhi(unsigned w) { return __uint_as_float(w & 0xffff0000u); }

__device__ __forceinline__ int lds_byte(int r, int c) { const int st = (r >> 4) * 2 + (c >> 5), ob = (r & 15) * 64 + (c & 31) * 2; return st * 1024 + (ob ^ (((ob >> 9) & 1) << 5)); }
__device__ __forceinline__ void stage_rc(int b, int& R, int& C) { const int st = b >> 10, sb = b & 1023, swz = sb ^ (((sb >> 9) & 1) << 5); R = (st >> 1) * 16 + swz / 64; C = (st & 1) * 32 + (swz % 64) / 2; }
__device__ __forceinline__ f32x4 unperm(const f32x4 a, const bool s) { f32x4 o; o[0] = s ? a[1] : a[0]; o[1] = s ? a[0] : a[1]; o[2] = s ? a[3] : a[2]; o[3] = s ? a[2] : a[3]; return o; }

__device__ __forceinline__ int tid_fresh() { int t = threadIdx.x; asm volatile("" : "+v"(t)); return t; }
constexpr int GEMM_LDS = 131072;

template <bool TRANS, bool RAGGED, int PM = 0, class ColMap, class Epi>
__device__ __forceinline__ void gemm_unit(LAS unsigned char* lds, const u16* __restrict__ A, int lda, const int* __restrict__ arows, int arow0, int rows_valid,
                                          const float* __restrict__ B, int ldb, int K, const ColMap colmap, const Epi epi) {
    const int tid = tid_fresh(), wid = __builtin_amdgcn_readfirstlane(tid >> 6), lane = tid & 63;
    const int wr = wid >> 2, wc = wid & 3, fr = lane & 15, fq = lane >> 4;
    const int nt = K >> 6;
    const char* ap[4];
#pragma unroll
    for (int i = 0; i < 4; ++i) {
        int R, C; stage_rc(wid * 1024 + i * 8192 + lane * 16, R, C);
        const int rr = RAGGED ? (R < rows_valid ? R : rows_valid - 1) : R;
        const long rowid = arows ? (long)arows[rr] : (long)(arow0 + rr);
        ap[i] = (const char*)A + ((size_t)rowid * lda + C) * 2;
    }
    const int g = (lane & 3) + 4 * (wid >> 2), rg = (wid & 3) * 16 + (lane >> 2);
    const unsigned bvoff = (unsigned)(((size_t)(8 * g) * ldb + colmap(rg)) * 4);
    const int bbase = 65536 + lds_byte(4 * rg, 8 * g);
    const int bw0 = bbase + ((rg & 1) ? 64 : 0), bw1 = bbase + ((rg & 1) ? 0 : 64);
    const int aoff = lds_byte(wr * 128 + fr, fq * 8), boff = 65536 + lds_byte(wc * 64 + fr, fq * 8);
    int mvalid = 8;
    if (RAGGED) { mvalid = (rows_valid - wr * 128 + 15) >> 4; mvalid = mvalid < 0 ? 0 : (mvalid > 8 ? 8 : mvalid); }
    f32x4 vb0, vb1, vb2, vb3, vb4, vb5, vb6, vb7;
    if (PM & 1) { vb0 = (f32x4){1.f, 1.f, 1.f, 1.f}; vb1 = vb0; vb2 = vb0; vb3 = vb0; vb4 = vb0; vb5 = vb0; vb6 = vb0; vb7 = vb0; }
    f32x4 acc[8][4];
#pragma unroll
    for (int m = 0; m < 8; ++m)
#pragma unroll
        for (int n = 0; n < 4; ++n) acc[m][n] = (f32x4){0.f, 0.f, 0.f, 0.f};
    const size_t ldb4 = (size_t)ldb * 4;
#define GE_GLDS_A(buf, kt) do { if (!(PM & 2)) _Pragma("unroll") for (int _i = 0; _i < 4; ++_i) \
        __builtin_amdgcn_global_load_lds((const unsigned*)(ap[_i] + (size_t)(kt) * 128), (LAS unsigned*)(lds + (buf) * 32768 + wid * 1024 + _i * 8192), 16, 0, 0); } while (0)
#define GE_LD1(dst, sb) if (!(PM & 1)) asm volatile("global_load_dwordx4 %0, %1, %2" : "=v"(dst) : "v"(bvoff), "s"(sb) : "memory")
#define GE_LOAD_B(kt) do { const char* _sb = (const char*)B + (size_t)(kt) * 64 * ldb4; \
        GE_LD1(vb0, _sb); GE_LD1(vb1, _sb + ldb4); GE_LD1(vb2, _sb + 2 * ldb4); GE_LD1(vb3, _sb + 3 * ldb4); \
        GE_LD1(vb4, _sb + 4 * ldb4); GE_LD1(vb5, _sb + 5 * ldb4); GE_LD1(vb6, _sb + 6 * ldb4); GE_LD1(vb7, _sb + 7 * ldb4); } while (0)
#define GE_WAITV_B(n) asm volatile("s_waitcnt vmcnt(" #n ")" : "+v"(vb0), "+v"(vb1), "+v"(vb2), "+v"(vb3), "+v"(vb4), "+v"(vb5), "+v"(vb6), "+v"(vb7) :: "memory")
#define GE_WRITE_B(buf) do { _Pragma("unroll") for (int _i = 0; _i < 4; ++_i) { u32x4 _w; _w[0] = pk_bf16(vb0[_i], vb1[_i]); _w[1] = pk_bf16(vb2[_i], vb3[_i]); \
        _w[2] = pk_bf16(vb4[_i], vb5[_i]); _w[3] = pk_bf16(vb6[_i], vb7[_i]); \
        *(LAS u32x4*)(lds + ((_i & 1) ? bw1 : bw0) + (_i >> 1) * 128 + (buf) * 32768) = _w; } } while (0)
#define GE_KSTEP(buf, ks) do { bf16x8 Bf[4]; \
        _Pragma("unroll") for (int n = 0; n < 4; ++n) Bf[n] = *(const LAS bf16x8*)(lds + (buf) * 32768 + boff + n * 2048 + (ks) * 1024); \
        _Pragma("unroll") for (int mh = 0; mh < 2; ++mh) { bf16x8 At[4]; \
            _Pragma("unroll") for (int m = 0; m < 4; ++m) At[m] = *(const LAS bf16x8*)(lds + (buf) * 32768 + aoff + (mh * 4 + m) * 2048 + (ks) * 1024); \
            _Pragma("unroll") for (int m = 0; m < 4; ++m) { if (!RAGGED || (mh * 4 + m) < mvalid) { _Pragma("unroll") for (int n = 0; n < 4; ++n) \
                { if (PM & 4) { asm volatile("" :: "v"(At[m]), "v"(Bf[n])); } else acc[mh * 4 + m][n] = TRANS ? __builtin_amdgcn_mfma_f32_16x16x32_bf16(At[m], Bf[n], acc[mh * 4 + m][n], 0, 0, 0) : __builtin_amdgcn_mfma_f32_16x16x32_bf16(Bf[n], At[m], acc[mh * 4 + m][n], 0, 0, 0); } } } } } while (0)
    GE_GLDS_A(0, 0);
    GE_LOAD_B(0);
    GE_WAITV_B(0);
    GE_WRITE_B(0);
    GE_LOAD_B(1);
    asm volatile("s_waitcnt lgkmcnt(0)" ::: "memory");
    __builtin_amdgcn_s_barrier();
    int t = 0;
    for (; t < nt - 2; ++t) {
        const int cur = t & 1;
        GE_GLDS_A(cur ^ 1, t + 1);
        GE_KSTEP(cur, 0);
        GE_WAITV_B(4);
        GE_WRITE_B(cur ^ 1);
        GE_LOAD_B(t + 2);
        __builtin_amdgcn_sched_barrier(0);
        GE_KSTEP(cur, 1);
        asm volatile("s_waitcnt vmcnt(8) lgkmcnt(0)" ::: "memory");
        __builtin_amdgcn_s_barrier();
    }
    {
        const int cur = t & 1;
        GE_GLDS_A(cur ^ 1, t + 1);
        GE_KSTEP(cur, 0);
        GE_WAITV_B(4);
        GE_WRITE_B(cur ^ 1);
        GE_KSTEP(cur, 1);
        asm volatile("s_waitcnt vmcnt(0) lgkmcnt(0)" ::: "memory");
        __builtin_amdgcn_s_barrier();
        ++t;
    }
    {
        const int cur = t & 1;
        GE_KSTEP(cur, 0);
        GE_KSTEP(cur, 1);
        asm volatile("s_waitcnt lgkmcnt(0)" ::: "memory");
        __builtin_amdgcn_s_barrier();
    }
#undef GE_GLDS_A
#undef GE_LD1
#undef GE_LOAD_B
#undef GE_WAITV_B
#undef GE_WRITE_B
#undef GE_KSTEP
    __builtin_amdgcn_sched_barrier(0);
    { const int tz = tid_fresh(), wz = __builtin_amdgcn_readfirstlane(tz >> 6), lz = tz & 63;
      epi(acc, wz >> 2, wz & 3, lz & 15, lz >> 4); }
}

__device__ __forceinline__ int xcd_logical(int b, int G) { return (G & 7) ? b : (b & 7) * (G >> 3) + (b >> 3); }

struct ColMapDense { int c0; __device__ __forceinline__ int operator()(int rg) const { return c0 + 4 * rg; } };
struct EpiPG { u16* PG; int tok0, col0;
    __device__ __forceinline__ void operator()(const f32x4 (&acc)[8][4], int wr, int wc, int fr, int fq) const {
#pragma unroll
        for (int m = 0; m < 8; ++m) { u16* rowp = PG + (size_t)(tok0 + wr * 128 + m * 16 + fr) * 5120 + col0 + wc * 64 + 4 * fq;
#pragma unroll
            for (int n = 0; n < 4; ++n) { const f32x4 v = unperm(acc[m][n], fq & 1); u32x2 w; w[0] = pk_bf16(v[0], v[1]); w[1] = pk_bf16(v[2], v[3]); *(u32x2*)(rowp + n * 16) = w; } }
    } };
struct EpiHYT { u16* HYT; int tok0, col0;
    __device__ __forceinline__ void operator()(const f32x4 (&acc)[8][4], int wr, int wc, int fr, int fq) const {
#pragma unroll
        for (int n = 0; n < 4; ++n) { const int rho = wc * 64 + n * 16 + fr; const int col = col0 + (rho & ~3) + ((rho & 3) ^ ((rho >> 2) & 1));
            u16* colp = HYT + (size_t)col * NTOK + tok0 + wr * 128 + 4 * fq;
#pragma unroll
            for (int m = 0; m < 8; ++m) { const f32x4 v = acc[m][n]; u32x2 w; w[0] = pk_bf16(v[0], v[1]); w[1] = pk_bf16(v[2], v[3]); *(u32x2*)(colp + m * 16) = w; } }
    } };
struct EpiX1 { const float* x; float* X1; int tok0, col0;
    __device__ __forceinline__ void operator()(const f32x4 (&acc)[8][4], int wr, int wc, int fr, int fq) const {
#pragma unroll
        for (int m = 0; m < 8; ++m) { const size_t off = (size_t)(tok0 + wr * 128 + m * 16 + fr) * DM + col0 + wc * 64 + 4 * fq;
#pragma unroll
            for (int n = 0; n < 4; ++n) { const f32x4 r = *(const f32x4*)(x + off + n * 16); *(f32x4*)(X1 + off + n * 16) = r + unperm(acc[m][n], fq & 1); }
            asm volatile("" ::: "memory"); }
    } };
struct ColMapGlu { int nt; __device__ __forceinline__ int operator()(int rg) const { const int wcq = rg >> 4, n = (rg >> 2) & 3, f = rg & 3; return (n >> 1) * 2048 + nt * 128 + wcq * 32 + (n & 1) * 16 + f * 4; } };
struct EpiSwiglu { u16* HM; const float* b1; int slot0, nt, rows_valid;
    __device__ __forceinline__ void operator()(const f32x4 (&acc)[8][4], int wr, int wc, int fr, int fq) const {
        f32x4 bg[2], bl[2];
#pragma unroll
        for (int nn = 0; nn < 2; ++nn) { const int col = nt * 128 + wc * 32 + nn * 16 + 4 * fq; bg[nn] = *(const f32x4*)(b1 + col); bl[nn] = *(const f32x4*)(b1 + 2048 + col); }
#pragma unroll
        for (int m = 0; m < 8; ++m) { const int row = wr * 128 + m * 16 + fr;
            if (row < rows_valid) {
#pragma unroll
                for (int nn = 0; nn < 2; ++nn) { const f32x4 gl = unperm(acc[m][nn], fq & 1) + bg[nn], li = unperm(acc[m][nn + 2], fq & 1) + bl[nn]; float o[4];
#pragma unroll
                    for (int j = 0; j < 4; ++j) { const float gq = fminf(gl[j], 7.0f), lq = fminf(fmaxf(li[j], -7.0f), 7.0f); o[j] = gq * (1.0f / (1.0f + __expf(-1.702f * gq))) * (lq + 1.0f); }
                    u32x2 w; w[0] = pk_bf16(o[0], o[1]); w[1] = pk_bf16(o[2], o[3]);
                    *(u32x2*)(HM + (size_t)(slot0 + row) * DFF + nt * 128 + wc * 32 + nn * 16 + 4 * fq) = w; } } }
    } };
struct EpiY { u16* Y; const float* b2; int slot0, col0, rows_valid;
    __device__ __forceinline__ void operator()(const f32x4 (&acc)[8][4], int wr, int wc, int fr, int fq) const {
        f32x4 bv[4];
#pragma unroll
        for (int n = 0; n < 4; ++n) bv[n] = *(const f32x4*)(b2 + col0 + wc * 64 + n * 16 + 4 * fq);
#pragma unroll
        for (int m = 0; m < 8; ++m) { const int row = wr * 128 + m * 16 + fr;
            if (row < rows_valid) { u16* rowp = Y + (size_t)(slot0 + row) * DM + col0 + wc * 64 + 4 * fq;
#pragma unroll
                for (int n = 0; n < 4; ++n) { const f32x4 v = unperm(acc[m][n], fq & 1) + bv[n]; u32x2 w; w[0] = pk_bf16(v[0], v[1]); w[1] = pk_bf16(v[2], v[3]); *(u32x2*)(rowp + n * 16) = w; } } }
    } };
template <int NTILES>
__device__ __forceinline__ bool moe_decode(const int* __restrict__ offs, int u, int& e, int& mt, int& nt, int& slot0, int& rows) {
    int base = 0;
    for (int q = 0; q < NE; ++q) { const int o0 = offs[q], cnt = offs[q + 1] - o0, mtl = (cnt + 255) >> 8, nu = mtl * NTILES;
        if (u < base + nu) { const int ul = u - base; e = q; mt = ul % mtl; nt = ul / mtl; slot0 = o0 + mt * 256; rows = cnt - mt * 256; if (rows > 256) rows = 256; return true; }
        base += nu; }
    return false;
}


__device__ __forceinline__ int perm_col4(int rg) { const int rgl = rg & 31, t = rgl & 7; return 32 * (rgl >> 3) + 8 * (t & 3) + 4 * (t >> 2); }
__device__ __forceinline__ int perm32(int rho) { const int n = rho >> 4, i = rho & 15; return 8 * (i >> 2) + 4 * n + (i & 3); }
template <class ColMap>
__device__ __forceinline__ void convert_tile(const float* __restrict__ W, int ldb, int k0, const ColMap colmap, u16* __restrict__ dst, int tid) {
    const int wid = tid >> 6, lane = tid & 63;
    const int g = (lane & 3) + 4 * (wid >> 2), rg = (wid & 3) * 16 + (lane >> 2);
    const float* bp = W + (size_t)(k0 + 8 * g) * ldb + colmap(rg);
    f32x4 v[8];
#pragma unroll
    for (int kk = 0; kk < 8; ++kk) v[kk] = __builtin_nontemporal_load((const f32x4*)(bp + (size_t)kk * ldb));
    const int h = rg >> 5, r0 = (4 * rg) & 127;
    unsigned char* base = (unsigned char*)dst + h * 16384 + lds_byte(r0, 8 * g);
#pragma unroll
    for (int i = 0; i < 4; ++i) { u32x4 w; w[0] = pk_bf16(v[0][i], v[1][i]); w[1] = pk_bf16(v[2][i], v[3][i]); w[2] = pk_bf16(v[4][i], v[5][i]); w[3] = pk_bf16(v[6][i], v[7][i]);
        *(u32x4*)(base + i * 64) = w; }
}
typedef int i32x8 __attribute__((ext_vector_type(8)));
typedef int i32x4 __attribute__((ext_vector_type(4)));
constexpr float W8_SCALE = 32.0f;
constexpr int W8_MX = 0x7A7A7A7A;
constexpr int A8_MX = 0x7F7F7F7F;
__device__ __forceinline__ unsigned pk_fp8x4(float a, float b, float c, float d) { int p = __builtin_amdgcn_cvt_pk_fp8_f32(a, b, 0, false); p = __builtin_amdgcn_cvt_pk_fp8_f32(c, d, p, true); return (unsigned)p; }
__device__ __forceinline__ int lds_byte_b(int r, int cb) { const int st = (r >> 4) * 2 + (cb >> 6), ob = (r & 15) * 64 + (cb & 63); return st * 1024 + (ob ^ (((ob >> 9) & 1) << 5)); }
struct ConvCtx { const float* w1; const float* w2; unsigned char* W1T; unsigned char* W2T; };
__device__ __forceinline__ int conv_seq2tile(int s) {
    if (s < 16384) return (s >> 9) * 512 + (s & 15) * 32 + ((s >> 4) & 31);
    const int q = s - 16384; return 16384 + (q >> 8) * 256 + (q & 7) * 32 + ((q >> 3) & 31);
}
__device__ __forceinline__ void conv_issue(const ConvCtx& cc, int m, int wid, int lane, f32x2 (&v)[16]) {
    const int rp = 16 * wid + (lane & 15), rg = rp >> 1, p2 = (rp & 1) * 2, kg = lane >> 4;
    const float* bp; size_t ld;
    if (m < 16384) { const int e = m >> 9, nt = (m >> 5) & 15, kt = m & 31; ld = 2 * DFF; bp = cc.w1 + (size_t)e * DM * 2 * DFF + (size_t)(kt * 64 + 16 * kg) * ld + (rg >> 5) * 2048 + nt * 128 + perm_col4(rg) + p2; }
    else { const int q = m - 16384, e = q >> 8, nt = (q >> 5) & 7, kt = q & 31; ld = DM; bp = cc.w2 + (size_t)e * DFF * DM + (size_t)(kt * 64 + 16 * kg) * ld + nt * 256 + (rg >> 5) * 128 + perm_col4(rg) + p2; }
#pragma unroll
    for (int kk = 0; kk < 16; ++kk) v[kk] = __builtin_nontemporal_load((const f32x2*)(bp + (size_t)kk * ld));
}
__device__ __forceinline__ void conv_finish(const ConvCtx& cc, int m, int wid, int lane, const f32x2 (&v)[16]) {
    const int rp = 16 * wid + (lane & 15), kg = lane >> 4;
    const int kt64 = m & 31;
    unsigned char* dst = (m < 16384) ? cc.W1T + ((size_t)(m >> 5) * 16 + (kt64 >> 1)) * 32768 : cc.W2T + ((size_t)((m - 16384) >> 5) * 16 + (kt64 >> 1)) * 32768;
    unsigned char* base = dst + (rp >> 6) * 16384 + lds_byte_b((2 * rp) & 127, (kt64 & 1) * 64 + 16 * kg);
#pragma unroll
    for (int i = 0; i < 2; ++i) { u32x4 w;
#pragma unroll
        for (int q = 0; q < 4; ++q) w[q] = pk_fp8x4(v[4 * q][i] * W8_SCALE, v[4 * q + 1][i] * W8_SCALE, v[4 * q + 2][i] * W8_SCALE, v[4 * q + 3][i] * W8_SCALE);
        __builtin_nontemporal_store(w, (u32x4*)(base + i * 64)); }
}
struct ColMapGluT { int nt; __device__ __forceinline__ int operator()(int rg) const { return (rg >> 5) * 2048 + nt * 128 + perm_col4(rg); } };
struct ColMapPerm { int c0; __device__ __forceinline__ int operator()(int rg) const { return c0 + (rg >> 5) * 128 + perm_col4(rg); } };

template <bool TRANS, bool FP8 = false, class Epi>
__device__ __forceinline__ void gemm8_unit(LAS unsigned char* lds, const u16* __restrict__ A, int lda, const int* __restrict__ arows, int arow0, int rows_valid, const u16* __restrict__ Bt, int nt, const Epi epi) {
    const int tid = tid_fresh(), wid = __builtin_amdgcn_readfirstlane(tid >> 6), lane = tid & 63;
    const int wr = wid >> 2, wc = wid & 3, fr = lane & 15, fq = lane >> 4;
    unsigned aof[2][2];
#pragma unroll
    for (int h = 0; h < 2; ++h)
#pragma unroll
        for (int i = 0; i < 2; ++i) { int R, C; stage_rc(tid * 16 + i * 8192, R, C); int rr = h * 128 + R; rr = rr < rows_valid ? rr : rows_valid - 1;
            const unsigned rowid = arows ? (unsigned)arows[rr] : (unsigned)(arow0 + rr); aof[h][i] = (rowid * (unsigned)lda + (unsigned)C) * 2u; }
    const char* Ab = (const char*)A; const char* Bb = (const char*)Bt + tid * 16;
    const bool hi = rows_valid > 128;
    int mxw = W8_MX, mxa = A8_MX; asm volatile("" : "+v"(mxw), "+v"(mxa));
#define G8_SA(b, h) (((b) * 2 + (h)) * 16384)
#define G8_SB(b, h) (65536 + ((b) * 2 + (h)) * 16384)
#define G8_STA(b, h, kt) do { _Pragma("unroll") for (int _i = 0; _i < 2; ++_i) \
        __builtin_amdgcn_global_load_lds((const unsigned*)(Ab + aof[h][_i] + (size_t)(kt) * 128), (LAS unsigned*)(lds + G8_SA(b, h) + wid * 1024 + _i * 8192), 16, 0, 0); } while (0)
#define G8_STB(b, h, kt) do { _Pragma("unroll") for (int _i = 0; _i < 2; ++_i) \
        __builtin_amdgcn_global_load_lds((const unsigned*)(Bb + (size_t)(kt) * 32768 + (h) * 16384 + _i * 8192), (LAS unsigned*)(lds + G8_SB(b, h) + wid * 1024 + _i * 8192), 16, 0, 0); } while (0)
#define G8_LDA(dst, b, h) do { _Pragma("unroll") for (int m = 0; m < 4; ++m) _Pragma("unroll") for (int k = 0; k < 2; ++k) dst[m][k] = *(const LAS bf16x8*)(lds + G8_SA(b, h) + aoff + m * 2048 + k * 1024); } while (0)
#define G8_LDB(dst, b, h) do { _Pragma("unroll") for (int n = 0; n < 2; ++n) _Pragma("unroll") for (int k = 0; k < 2; ++k) dst[n][k] = *(const LAS bf16x8*)(lds + G8_SB(b, h) + boff + n * 2048 + k * 1024); } while (0)
#define G8_MMA(ai, bj, At, Bq) do { if ((ai) == 0 || hi) { __builtin_amdgcn_s_setprio(1); _Pragma("unroll") for (int m = 0; m < 4; ++m) _Pragma("unroll") for (int n = 0; n < 2; ++n) { \
        if (FP8) { const i32x4 a0 = __builtin_bit_cast(i32x4, At[m][0]), a1 = __builtin_bit_cast(i32x4, At[m][1]), b0 = __builtin_bit_cast(i32x4, Bq[n][0]), b1 = __builtin_bit_cast(i32x4, Bq[n][1]); \
            const i32x8 a8 = __builtin_shufflevector(a0, a1, 0, 1, 2, 3, 4, 5, 6, 7), b8 = __builtin_shufflevector(b0, b1, 0, 1, 2, 3, 4, 5, 6, 7); \
            asm volatile("v_mfma_scale_f32_16x16x128_f8f6f4 %0, %1, %2, %0, %3, %4 op_sel_hi:[0,0,0]" : "+v"(acc[ai][bj][m][n]) : "v"(b8), "v"(a8), "v"(mxw), "v"(mxa)); } \
        else { _Pragma("unroll") for (int k = 0; k < 2; ++k) \
            acc[ai][bj][m][n] = TRANS ? __builtin_amdgcn_mfma_f32_16x16x32_bf16(At[m][k], Bq[n][k], acc[ai][bj][m][n], 0, 0, 0) : __builtin_amdgcn_mfma_f32_16x16x32_bf16(Bq[n][k], At[m][k], acc[ai][bj][m][n], 0, 0, 0); } } \
        __builtin_amdgcn_s_setprio(0); } } while (0)
#define G8_WV(n) asm volatile("s_waitcnt vmcnt(" #n ")" ::: "memory")
#define G8_WL(n) asm volatile("s_waitcnt lgkmcnt(" #n ")" ::: "memory")
#define G8_BAR __builtin_amdgcn_s_barrier()
#define G8_SCHED __builtin_amdgcn_sched_barrier(0)
    const int aoff = lds_byte(wr * 64 + fr, fq * 8), boff = lds_byte(wc * 32 + fr, fq * 8);
    f32x4 acc[2][2][4][2];
#pragma unroll
    for (int a = 0; a < 2; ++a)
#pragma unroll
        for (int b = 0; b < 2; ++b)
#pragma unroll
            for (int m = 0; m < 4; ++m)
#pragma unroll
                for (int n = 0; n < 2; ++n) acc[a][b][m][n] = (f32x4){0.f, 0.f, 0.f, 0.f};
    bf16x8 At[4][2], B0[2][2], B1[2][2];
    G8_STB(0, 0, 0); G8_STA(0, 0, 0); G8_STB(0, 1, 0); G8_STA(0, 1, 0);
    if (wr == 1) G8_BAR;
    G8_WV(4); G8_BAR;
    G8_STB(1, 0, 1); G8_STA(1, 0, 1); G8_STB(1, 1, 1);
    G8_WV(6); G8_BAR;
    for (int t = 0; t < nt - 2; t += 2) {
        G8_LDB(B0, 0, 0); G8_SCHED; G8_LDA(At, 0, 0); G8_STA(1, 1, t + 1);
        G8_WL(8); G8_BAR; G8_WL(0); G8_MMA(0, 0, At, B0); G8_BAR; G8_SCHED;
        G8_LDB(B1, 0, 1); G8_STB(0, 0, t + 2);
        G8_BAR; G8_WL(0); G8_MMA(0, 1, At, B1); G8_BAR;
        if (hi) G8_LDA(At, 0, 1); G8_STA(0, 0, t + 2);
        G8_BAR; G8_WL(0); G8_MMA(1, 0, At, B0); G8_BAR; G8_SCHED;
        G8_STB(0, 1, t + 2);
        G8_WV(6); G8_BAR; G8_MMA(1, 1, At, B1); G8_BAR;
        G8_LDB(B0, 1, 0); G8_SCHED; G8_LDA(At, 1, 0); G8_STA(0, 1, t + 2);
        G8_WL(8); G8_BAR; G8_WL(0); G8_MMA(0, 0, At, B0); G8_BAR; G8_SCHED;
        G8_LDB(B1, 1, 1); G8_STB(1, 0, t + 3);
        G8_BAR; G8_WL(0); G8_MMA(0, 1, At, B1); G8_BAR;
        if (hi) G8_LDA(At, 1, 1); G8_STA(1, 0, t + 3);
        G8_BAR; G8_WL(0); G8_MMA(1, 0, At, B0); G8_BAR; G8_SCHED;
        G8_STB(1, 1, t + 3);
        G8_WV(6); G8_BAR; G8_MMA(1, 1, At, B1); G8_BAR;
    }
    { G8_LDB(B0, 0, 0); G8_WV(0); G8_LDA(At, 0, 0); G8_STA(1, 1, nt - 1);
      G8_BAR; G8_WL(0); G8_MMA(0, 0, At, B0); G8_BAR;
      G8_LDB(B1, 0, 1); G8_BAR; G8_WL(0); G8_MMA(0, 1, At, B1); G8_BAR;
      G8_LDA(At, 0, 1); G8_WV(4); G8_BAR; G8_WL(0); G8_MMA(1, 0, At, B0); G8_MMA(1, 1, At, B1); G8_BAR; }
    { G8_LDB(B0, 1, 0); G8_LDA(At, 1, 0); G8_WV(2); G8_BAR; G8_WL(0); G8_MMA(0, 0, At, B0); G8_BAR;
      G8_LDB(B1, 1, 1); G8_WV(0); G8_BAR; G8_WL(0); G8_MMA(0, 1, At, B1); G8_BAR;
      G8_LDA(At, 1, 1); G8_BAR; G8_WL(0); G8_MMA(1, 0, At, B0); G8_MMA(1, 1, At, B1); G8_BAR; }
    if (wr == 0) G8_BAR;
#undef G8_SA
#undef G8_SB
#undef G8_STA
#undef G8_STB
#undef G8_LDA
#undef G8_LDB
#undef G8_MMA
#undef G8_WV
#undef G8_WL
#undef G8_BAR
#undef G8_SCHED
    __builtin_amdgcn_sched_barrier(0);
    { const int tz = tid_fresh(), wz = __builtin_amdgcn_readfirstlane(tz >> 6), lz = tz & 63;
      epi(acc, wz >> 2, wz & 3, lz & 15, lz >> 4); }
}
struct StreamUnit { const char* A; const char* Bt; int arow0, rows, a, b, c; };
template <bool TRANS, bool FP8, class Src>
__device__ __forceinline__ void gemm8_stream(LAS unsigned char* lds, unsigned lda, int nt, const Src& src) {
    const int tid = tid_fresh(), wid = __builtin_amdgcn_readfirstlane(tid >> 6), lane = tid & 63;
    const int wr = wid >> 2, wc = wid & 3, fr = lane & 15, fq = lane >> 4;
    StreamUnit cur, nxt;
    if (!src.get(0, cur)) return;
    int R0, C0, R1, C1; stage_rc(tid * 16, R0, C0); stage_rc(tid * 16 + 8192, R1, C1);
    int mxw = W8_MX, mxa = A8_MX; asm volatile("" : "+v"(mxw), "+v"(mxa));
    const int aoff = lds_byte(wr * 64 + fr, fq * 8), boff = lds_byte(wc * 32 + fr, fq * 8);
#define GS_AOF(u, h, R, C) ((unsigned)(((unsigned)((u).arow0 + (((h) * 128 + (R)) < (u).rows ? ((h) * 128 + (R)) : (u).rows - 1)) * lda + (unsigned)(C)) * 2u))
    unsigned ac00 = GS_AOF(cur, 0, R0, C0), ac01 = GS_AOF(cur, 0, R1, C1), ac10 = GS_AOF(cur, 1, R0, C0), ac11 = GS_AOF(cur, 1, R1, C1);
#define GS_SA(b, h) (((b) * 2 + (h)) * 16384)
#define GS_SB(b, h) (65536 + ((b) * 2 + (h)) * 16384)
#define GS_GL(src_, dst_) __builtin_amdgcn_global_load_lds((const unsigned*)(src_), (LAS unsigned*)(lds + (dst_)), 16, 0, 0)
#define GS_STA(b, h, base, o0, o1, kt) do { GS_GL((base) + (o0) + (size_t)(kt) * 128, GS_SA(b, h) + wid * 1024); GS_GL((base) + (o1) + (size_t)(kt) * 128, GS_SA(b, h) + wid * 1024 + 8192); } while (0)
#define GS_STB(b, h, base, kt) do { GS_GL((base) + tid * 16 + (size_t)(kt) * 32768 + (h) * 16384, GS_SB(b, h) + wid * 1024); GS_GL((base) + tid * 16 + (size_t)(kt) * 32768 + (h) * 16384 + 8192, GS_SB(b, h) + wid * 1024 + 8192); } while (0)
#define GS_LDA(dst, b, h) do { _Pragma("unroll") for (int m = 0; m < 4; ++m) _Pragma("unroll") for (int k = 0; k < 2; ++k) dst[m][k] = *(const LAS bf16x8*)(lds + GS_SA(b, h) + aoff + m * 2048 + k * 1024); } while (0)
#define GS_LDB(dst, b, h) do { _Pragma("unroll") for (int n = 0; n < 2; ++n) _Pragma("unroll") for (int k = 0; k < 2; ++k) dst[n][k] = *(const LAS bf16x8*)(lds + GS_SB(b, h) + boff + n * 2048 + k * 1024); } while (0)
#define GS_MMA(ai, bj, At, Bq) do { if ((ai) == 0 || hi) { __builtin_amdgcn_s_setprio(1); _Pragma("unroll") for (int m = 0; m < 4; ++m) _Pragma("unroll") for (int n = 0; n < 2; ++n) { \
        if (FP8) { const i32x4 a0 = __builtin_bit_cast(i32x4, At[m][0]), a1 = __builtin_bit_cast(i32x4, At[m][1]), b0 = __builtin_bit_cast(i32x4, Bq[n][0]), b1 = __builtin_bit_cast(i32x4, Bq[n][1]); \
            const i32x8 a8 = __builtin_shufflevector(a0, a1, 0, 1, 2, 3, 4, 5, 6, 7), b8 = __builtin_shufflevector(b0, b1, 0, 1, 2, 3, 4, 5, 6, 7); \
            asm volatile("v_mfma_scale_f32_16x16x128_f8f6f4 %0, %1, %2, %0, %3, %4 op_sel_hi:[0,0,0]" : "+v"(acc[ai][bj][m][n]) : "v"(b8), "v"(a8), "v"(mxw), "v"(mxa)); } \
        else { _Pragma("unroll") for (int k = 0; k < 2; ++k) \
            acc[ai][bj][m][n] = TRANS ? __builtin_amdgcn_mfma_f32_16x16x32_bf16(At[m][k], Bq[n][k], acc[ai][bj][m][n], 0, 0, 0) : __builtin_amdgcn_mfma_f32_16x16x32_bf16(Bq[n][k], At[m][k], acc[ai][bj][m][n], 0, 0, 0); } } \
        __builtin_amdgcn_s_setprio(0); } } while (0)
#define GS_WV(n) asm volatile("s_waitcnt vmcnt(" #n ")" ::: "memory")
#define GS_WL(n) asm volatile("s_waitcnt lgkmcnt(" #n ")" ::: "memory")
#define GS_BAR __builtin_amdgcn_s_barrier()
#define GS_SCHED __builtin_amdgcn_sched_barrier(0)
    f32x4 acc[2][2][4][2];
#pragma unroll
    for (int a = 0; a < 2; ++a)
#pragma unroll
        for (int b = 0; b < 2; ++b)
#pragma unroll
            for (int m = 0; m < 4; ++m)
#pragma unroll
                for (int n = 0; n < 2; ++n) acc[a][b][m][n] = (f32x4){0.f, 0.f, 0.f, 0.f};
    bf16x8 At[4][2], B0[2][2], B1[2][2];
    GS_STB(0, 0, cur.Bt, 0); GS_STA(0, 0, cur.A, ac00, ac01, 0); GS_STB(0, 1, cur.Bt, 0); GS_STA(0, 1, cur.A, ac10, ac11, 0);
    if (wr == 1) GS_BAR;
    GS_WV(4); GS_BAR;
    GS_STB(1, 0, cur.Bt, 1); GS_STA(1, 0, cur.A, ac00, ac01, 1); GS_STB(1, 1, cur.Bt, 1);
    GS_WV(6); GS_BAR;
    for (int ui = 0;; ++ui) {
        const bool has_next = src.get(ui + 1, nxt);
        if (!has_next) nxt = cur;
        const unsigned an00 = GS_AOF(nxt, 0, R0, C0), an01 = GS_AOF(nxt, 0, R1, C1), an10 = GS_AOF(nxt, 1, R0, C0), an11 = GS_AOF(nxt, 1, R1, C1);
        const bool hi = cur.rows > 128;
        for (int t = 0; t < nt; t += 2) {
            const bool last = (t == nt - 2);
            const char* xA = last ? nxt.A : cur.A; const char* xB = last ? nxt.Bt : cur.Bt;
            const unsigned x00 = last ? an00 : ac00, x01 = last ? an01 : ac01, x10 = last ? an10 : ac10, x11 = last ? an11 : ac11;
            const int k2 = last ? 0 : t + 2, k3 = k2 + 1;
            GS_LDB(B0, 0, 0); GS_SCHED; GS_LDA(At, 0, 0); GS_STA(1, 1, cur.A, ac10, ac11, t + 1);
            GS_WL(8); GS_BAR; GS_WL(0); GS_MMA(0, 0, At, B0); GS_BAR; GS_SCHED;
            GS_LDB(B1, 0, 1); GS_STB(0, 0, xB, k2);
            GS_BAR; GS_WL(0); GS_MMA(0, 1, At, B1); GS_BAR;
            if (hi) GS_LDA(At, 0, 1); GS_STA(0, 0, xA, x00, x01, k2);
            GS_BAR; GS_WL(0); GS_MMA(1, 0, At, B0); GS_BAR; GS_SCHED;
            GS_STB(0, 1, xB, k2);
            GS_WV(6); GS_BAR; GS_MMA(1, 1, At, B1); GS_BAR;
            GS_LDB(B0, 1, 0); GS_SCHED; GS_LDA(At, 1, 0); GS_STA(0, 1, xA, x10, x11, k2);
            GS_WL(8); GS_BAR; GS_WL(0); GS_MMA(0, 0, At, B0); GS_BAR; GS_SCHED;
            GS_LDB(B1, 1, 1); GS_STB(1, 0, xB, k3);
            GS_BAR; GS_WL(0); GS_MMA(0, 1, At, B1); GS_BAR;
            if (hi) GS_LDA(At, 1, 1); GS_STA(1, 0, xA, x00, x01, k3);
            GS_BAR; GS_WL(0); GS_MMA(1, 0, At, B0); GS_BAR; GS_SCHED;
            GS_STB(1, 1, xB, k3);
            GS_WV(6); GS_BAR; GS_MMA(1, 1, At, B1); GS_BAR;
        }
        __builtin_amdgcn_sched_barrier(0);
        src.epi(acc, cur, wr, wc, fr, fq);
        __builtin_amdgcn_sched_barrier(0);
        if (!has_next) break;
#pragma unroll
        for (int a = 0; a < 2; ++a)
#pragma unroll
            for (int b = 0; b < 2; ++b)
#pragma unroll
                for (int m = 0; m < 4; ++m)
#pragma unroll
                    for (int n = 0; n < 2; ++n) acc[a][b][m][n] = (f32x4){0.f, 0.f, 0.f, 0.f};
        cur = nxt; ac00 = an00; ac01 = an01; ac10 = an10; ac11 = an11;
    }
    GS_WV(0);
    if (wr == 0) GS_BAR;
    GS_BAR;
#undef GS_AOF
#undef GS_SA
#undef GS_SB
#undef GS_GL
#undef GS_STA
#undef GS_STB
#undef GS_LDA
#undef GS_LDB
#undef GS_MMA
#undef GS_WV
#undef GS_WL
#undef GS_BAR
#undef GS_SCHED
}
struct Epi8PG { u16* PG; const float* lbl; int tok0, col0;
    __device__ __forceinline__ void operator()(const f32x4 (&acc)[2][2][4][2], int wr, int wc, int fr, int fq) const {
        const int grp = col0 >> 10;
        if (grp == 0) {
#pragma unroll
            for (int ai = 0; ai < 2; ++ai)
#pragma unroll
                for (int m = 0; m < 4; ++m) { u16* rowp = PG + (size_t)(tok0 + ai * 128 + wr * 64 + m * 16 + fr) * 5120 + col0 + wc * 32 + 8 * fq;
#pragma unroll
                    for (int bj = 0; bj < 2; ++bj) { float o[8];
#pragma unroll
                        for (int n = 0; n < 2; ++n)
#pragma unroll
                            for (int q = 0; q < 4; ++q) { const float x = acc[ai][bj][m][n][q]; o[4 * n + q] = x / (1.0f + __expf(-x)); }
                        *(u32x4*)(rowp + bj * 128) = (u32x4){pk_bf16(o[0], o[1]), pk_bf16(o[2], o[3]), pk_bf16(o[4], o[5]), pk_bf16(o[6], o[7])}; } }
        } else if (grp <= 2) {
            float lbv[2][8];
#pragma unroll
            for (int bj = 0; bj < 2; ++bj)
#pragma unroll
                for (int q = 0; q < 8; ++q) { const int c = (col0 & 1023) + bj * 128 + wc * 32 + 8 * fq + q; const float l0 = lbl[(grp - 1) * HGW + c], l1 = lbl[(2 + grp - 1) * HGW + c]; lbv[bj][q] = 1.0f / (1.0f + __expf(l1 - l0)); }
#pragma unroll
            for (int ai = 0; ai < 2; ++ai)
#pragma unroll
                for (int m = 0; m < 4; ++m) { u16* rowp = PG + (size_t)(tok0 + ai * 128 + wr * 64 + m * 16 + fr) * 5120 + col0 + wc * 32 + 8 * fq;
#pragma unroll
                    for (int bj = 0; bj < 2; ++bj) { float o[8];
#pragma unroll
                        for (int n = 0; n < 2; ++n)
#pragma unroll
                            for (int q = 0; q < 4; ++q) { const float z = acc[ai][bj][m][n][q], lb = lbv[bj][4 * n + q]; const float sg = 1.0f / (1.0f + __expf(-z)); o[4 * n + q] = __logf(lb + (1.0f - lb) * sg); }
                        *(u32x4*)(rowp + bj * 128) = (u32x4){pk_bf16(o[0], o[1]), pk_bf16(o[2], o[3]), pk_bf16(o[4], o[5]), pk_bf16(o[6], o[7])}; } }
        } else {
#pragma unroll
            for (int ai = 0; ai < 2; ++ai)
#pragma unroll
                for (int m = 0; m < 4; ++m) { u16* rowp = PG + (size_t)(tok0 + ai * 128 + wr * 64 + m * 16 + fr) * 5120 + col0 + wc * 32 + 8 * fq;
#pragma unroll
                    for (int bj = 0; bj < 2; ++bj) { const f32x4 v0 = acc[ai][bj][m][0], v1 = acc[ai][bj][m][1];
                        *(u32x4*)(rowp + bj * 128) = (u32x4){pk_bf16(v0[0], v0[1]), pk_bf16(v0[2], v0[3]), pk_bf16(v1[0], v1[1]), pk_bf16(v1[2], v1[3])}; } }
        }
    } };
struct Epi8HYT { u16* HYT; int tok0, col0;
    __device__ __forceinline__ void operator()(const f32x4 (&acc)[2][2][4][2], int wr, int wc, int fr, int fq) const {
#pragma unroll
        for (int bj = 0; bj < 2; ++bj)
#pragma unroll
            for (int n = 0; n < 2; ++n) { u16* colp = HYT + (size_t)(col0 + bj * 128 + wc * 32 + perm32(n * 16 + fr)) * NTOK + tok0 + wr * 64 + 4 * fq;
#pragma unroll
                for (int ai = 0; ai < 2; ++ai)
#pragma unroll
                    for (int m = 0; m < 4; ++m) { const f32x4 v = acc[ai][bj][m][n]; *(u32x2*)(colp + ai * 128 + m * 16) = (u32x2){pk_bf16(v[0], v[1]), pk_bf16(v[2], v[3])}; } }
    } };
struct Epi8X1 { const float* x; float* X1; int tok0, col0;
    __device__ __forceinline__ void operator()(const f32x4 (&acc)[2][2][4][2], int wr, int wc, int fr, int fq) const {
#pragma unroll
        for (int ai = 0; ai < 2; ++ai)
#pragma unroll
            for (int m = 0; m < 4; ++m) { const size_t off = (size_t)(tok0 + ai * 128 + wr * 64 + m * 16 + fr) * DM + col0 + wc * 32 + 8 * fq;
#pragma unroll
                for (int bj = 0; bj < 2; ++bj)
#pragma unroll
                    for (int n = 0; n < 2; ++n) { const f32x4 r = *(const f32x4*)(x + off + bj * 128 + n * 4); *(f32x4*)(X1 + off + bj * 128 + n * 4) = r + acc[ai][bj][m][n]; }
                asm volatile("" ::: "memory"); }
    } };
struct Epi8Swiglu { u16* HM; const float* b1; int slot0, nt, rows_valid;
    __device__ __forceinline__ void operator()(const f32x4 (&acc)[2][2][4][2], int wr, int wc, int fr, int fq) const {
        f32x4 bg[2], bl[2];
#pragma unroll
        for (int n = 0; n < 2; ++n) { const int col = nt * 128 + wc * 32 + 8 * fq + 4 * n; bg[n] = *(const f32x4*)(b1 + col); bl[n] = *(const f32x4*)(b1 + 2048 + col); }
#pragma unroll
        for (int ai = 0; ai < 2; ++ai)
#pragma unroll
            for (int m = 0; m < 4; ++m) { const int row = ai * 128 + wr * 64 + m * 16 + fr;
                if (row < rows_valid) { float o[8];
#pragma unroll
                    for (int n = 0; n < 2; ++n) { const f32x4 gl = acc[ai][0][m][n] + bg[n], li = acc[ai][1][m][n] + bl[n];
#pragma unroll
                        for (int j = 0; j < 4; ++j) { const float gq = fminf(gl[j], 7.0f), lq = fminf(fmaxf(li[j], -7.0f), 7.0f); o[4 * n + j] = gq * (1.0f / (1.0f + __expf(-1.702f * gq))) * (lq + 1.0f); } }
                    *(u32x4*)(HM + (size_t)(slot0 + row) * DFF + nt * 128 + wc * 32 + 8 * fq) = (u32x4){pk_bf16(o[0], o[1]), pk_bf16(o[2], o[3]), pk_bf16(o[4], o[5]), pk_bf16(o[6], o[7])}; } }
    } };
struct Epi8Swiglu8 { unsigned char* HM; const float* b1; int slot0, nt, rows_valid;
    __device__ __forceinline__ void operator()(const f32x4 (&acc)[2][2][4][2], int wr, int wc, int fr, int fq) const {
        f32x4 bg[2], bl[2];
#pragma unroll
        for (int n = 0; n < 2; ++n) { const int col = nt * 128 + wc * 32 + 8 * fq + 4 * n; bg[n] = *(const f32x4*)(b1 + col); bl[n] = *(const f32x4*)(b1 + 2048 + col); }
#pragma unroll
        for (int ai = 0; ai < 2; ++ai)
#pragma unroll
            for (int m = 0; m < 4; ++m) { const int row = ai * 128 + wr * 64 + m * 16 + fr;
                if (row < rows_valid) { float o[8];
#pragma unroll
                    for (int n = 0; n < 2; ++n) { const f32x4 gl = acc[ai][0][m][n] + bg[n], li = acc[ai][1][m][n] + bl[n];
#pragma unroll
                        for (int j = 0; j < 4; ++j) { const float gq = fminf(gl[j], 7.0f), lq = fminf(fmaxf(li[j], -7.0f), 7.0f); o[4 * n + j] = gq * (1.0f / (1.0f + __expf(-1.702f * gq))) * (lq + 1.0f); } }
                    *(u32x2*)(HM + (size_t)(slot0 + row) * DFF + nt * 128 + wc * 32 + 8 * fq) = (u32x2){pk_fp8x4(o[0], o[1], o[2], o[3]), pk_fp8x4(o[4], o[5], o[6], o[7])}; } }
    } };
struct Epi8Y { u16* Y; const float* b2; int slot0, col0, rows_valid;
    __device__ __forceinline__ void operator()(const f32x4 (&acc)[2][2][4][2], int wr, int wc, int fr, int fq) const {
        f32x4 bv[2][2];
#pragma unroll
        for (int bj = 0; bj < 2; ++bj)
#pragma unroll
            for (int n = 0; n < 2; ++n) bv[bj][n] = *(const f32x4*)(b2 + col0 + bj * 128 + wc * 32 + 8 * fq + 4 * n);
#pragma unroll
        for (int ai = 0; ai < 2; ++ai)
#pragma unroll
            for (int m = 0; m < 4; ++m) { const int row = ai * 128 + wr * 64 + m * 16 + fr;
                if (row < rows_valid) { u16* rowp = Y + (size_t)(slot0 + row) * DM + col0 + wc * 32 + 8 * fq;
#pragma unroll
                    for (int bj = 0; bj < 2; ++bj) { const f32x4 v0 = acc[ai][bj][m][0] + bv[bj][0], v1 = acc[ai][bj][m][1] + bv[bj][1];
                        *(u32x4*)(rowp + bj * 128) = (u32x4){pk_bf16(v0[0], v0[1]), pk_bf16(v0[2], v0[3]), pk_bf16(v1[0], v1[1]), pk_bf16(v1[2], v1[3])}; } } }
    } };
struct EpiNone { __device__ __forceinline__ void operator()(const f32x4 (&acc)[2][2][4][2], int wr, int wc, int fr, int fq) const {
#pragma unroll
        for (int a = 0; a < 2; ++a)
#pragma unroll
            for (int b = 0; b < 2; ++b)
#pragma unroll
                for (int m = 0; m < 4; ++m)
#pragma unroll
                    for (int n = 0; n < 2; ++n) asm volatile("" :: "v"(acc[a][b][m][n]));
    } };

template <int NTILES>
__device__ __forceinline__ bool moe_unit_static(const LAS int* us, const LAS int* so2, int uu, int& e, int& nt, int& slot0, int& rows) {
    if (uu >= us[NE]) return false;
    int lo = 0, hi = NE;
#pragma unroll
    for (int s = 0; s < 5; ++s) { const int mid = (lo + hi) >> 1; if (us[mid] <= uu) lo = mid; else hi = mid; }
    e = lo; const int o0 = e * NTOK, cnt = so2[e], mtl = (cnt + 255) >> 8, ul = uu - us[e], mt = ul % mtl;
    e = __builtin_amdgcn_readfirstlane(e); nt = __builtin_amdgcn_readfirstlane(ul / mtl); slot0 = __builtin_amdgcn_readfirstlane(o0 + mt * 256);
    rows = cnt - mt * 256; rows = __builtin_amdgcn_readfirstlane(rows > 256 ? 256 : rows); return true;
}
struct SrcMoeB { const LAS int* us; const LAS int* so2; int c, G; const char* HM8; const char* W2T8; u16* YB; const float* b2;
    __device__ __forceinline__ bool get(int i, StreamUnit& u) const { int e, nt, slot0, rows; if (!moe_unit_static<8>(us, so2, c + i * G, e, nt, slot0, rows)) return false;
        u.A = HM8; u.Bt = W2T8 + (size_t)((e * 8 + nt) * 16) * 32768; u.arow0 = slot0; u.rows = rows; u.a = e; u.b = nt; u.c = slot0; return true; }
    __device__ __forceinline__ void epi(const f32x4 (&acc)[2][2][4][2], const StreamUnit& u, int wr, int wc, int fr, int fq) const { Epi8Y ep{YB, b2 + (size_t)u.a * DM, u.c, u.b * 256, u.rows}; ep(acc, wr, wc, fr, fq); }
};
template <bool TRANS>
struct SrcG1 { int c, G; const char* HBp; const char* WINTp; u16* PG; u16* HYT; const float* lbl;
    __device__ __forceinline__ bool get(int k, StreamUnit& su) const {
        int seen = 0;
        for (int u = c; u < 1024; u += G) { const int i = u >> 8, xx = (u >> 5) & 7, j = u & 31; const int mt = (xx & 3) * 8 + (j & 7), nt = ((xx >> 2) + 2 * i) * 4 + (j >> 3);
            if ((nt >= 20) == TRANS) { if (seen == k) { su.A = HBp; su.Bt = WINTp + (size_t)nt * 32 * 32768; su.arow0 = mt * 256; su.rows = 256; su.a = mt; su.b = nt; su.c = 0; return true; } ++seen; } }
        return false; }
    __device__ __forceinline__ void epi(const f32x4 (&acc)[2][2][4][2], const StreamUnit& u, int wr, int wc, int fr, int fq) const {
        if (TRANS) { Epi8HYT e{HYT, u.a * 256, u.b * 256 - 5120}; e(acc, wr, wc, fr, fq); } else { Epi8PG e{PG, lbl, u.a * 256, u.b * 256}; e(acc, wr, wc, fr, fq); } }
};

typedef float f32x16 __attribute__((ext_vector_type(16)));
__device__ __forceinline__ void h3_row(int m, const float* __restrict__ w1, const float* __restrict__ b1, const float* __restrict__ w2, const float* __restrict__ b2,
                                       const float* __restrict__ w3, const float* __restrict__ b3, const float* __restrict__ freq, LAS float* sc  , float* __restrict__ H3) {
    const int j = tid_fresh() & 63;
    const float tt = (float)m / (float)(SEQ - 1);
    if (j == 0) sc[0] = tt;
    if (j >= 1 && j <= 16) { const int i = j - 1; const float band = 1e-4f + (float)i * ((15.0f - 1e-4f) / 15.0f); const float ang = (2.0f * 3.14159265358979323846f / (float)SEQ) * (float)m * band; sc[1 + i] = cosf(ang); sc[17 + i] = -sinf(ang); }
    __builtin_amdgcn_wave_barrier();
    const float fr = freq[j];
    float s = b1[j];
    for (int i = 0; i < 33; ++i) s += sc[i] * w1[i * 64 + j];
    const float h1 = sinf(fr * s);
    sc[64 + j] = h1;
    __builtin_amdgcn_wave_barrier();
    s = b2[j];
    for (int i = 0; i < 64; ++i) s += sc[64 + i] * w2[i * 64 + j];
    const float h2 = sinf(fr * s);
    __builtin_amdgcn_wave_barrier();
    sc[j] = h2;
    __builtin_amdgcn_wave_barrier();
    s = b3[j];
    for (int i = 0; i < 64; ++i) s += sc[i] * w3[i * 64 + j];
    H3[(size_t)m * 64 + j] = sinf(fr * s);
    __builtin_amdgcn_wave_barrier();
}
constexpr int FR_LEN = 4128;
__device__ __forceinline__ void frgen_item(LAS unsigned char* lds, int item, const float* __restrict__ H3, const float* __restrict__ w4, u16* __restrict__ FR) {
    const int tid = tid_fresh(), wid = __builtin_amdgcn_readfirstlane(tid >> 6), lane = tid & 63, fr = lane & 15, fq = lane >> 4;
    const int oc0 = item * 8, o = oc0 >> 10;
    const int colB = o * 2048 + (fr >> 3) * 1024 + (oc0 & 1023) + (fr & 7);
    float wreg[16];
#pragma unroll
    for (int ks = 0; ks < 16; ++ks) wreg[ks] = w4[(size_t)(4 * ks + fq) * 4096 + colB];
    const int dir = fr >> 3, c = (oc0 & 1023) + (fr & 7);
    const float mind = logf(1e-2f) / 0.3f, maxd = logf(1e-2f) / 1.5f;
    const float delta = fabsf(mind + (float)c * ((maxd - mind) / 1023.0f));
    u16* r0 = FR + (size_t)((oc0 + (fr & 7)) * 2) * FR_LEN;
    LAS float* tile = (LAS float*)(lds + wid * 4608);
    const int wrow = lane >> 4, wcol = 4 * (lane & 15);
    f32x4 nx[4];
#pragma unroll
    for (int q = 0; q < 4; ++q) nx[q] = *(const f32x4*)(H3 + (size_t)wid * 1024 + q * 256 + lane * 4);
    for (int it = 0; it < 16; ++it) {
        const int mt = wid + 8 * it;
#pragma unroll
        for (int q = 0; q < 4; ++q) *(LAS f32x4*)(tile + (q * 4 + wrow) * 68 + wcol) = nx[q];
        if (it + 1 < 16) {
#pragma unroll
            for (int q = 0; q < 4; ++q) nx[q] = *(const f32x4*)(H3 + (size_t)(mt + 8) * 1024 + q * 256 + lane * 4);
        }
        f32x4 acc = {0.f, 0.f, 0.f, 0.f};
#pragma unroll
        for (int ks = 0; ks < 16; ++ks) acc = __builtin_amdgcn_mfma_f32_16x16x4f32(tile[fr * 68 + 4 * ks + fq], wreg[ks], acc, 0, 0, 0);
        const int m0 = mt * 16 + 4 * fq;
        float v[4];
#pragma unroll
        for (int j = 0; j < 4; ++j) v[j] = acc[j] * __expf(-((float)(m0 + j) / (float)(SEQ - 1)) * delta);
        if (dir == 0) {
            *(u32x2*)(r0 + 2044 - m0) = (u32x2){pk_bf16(v[3], v[2]), pk_bf16(v[1], v[0])};
#pragma unroll
            for (int j = 0; j < 4; ++j) r0[FR_LEN + 2046 - m0 - j] = (u16)(pk_bf16(v[j], 0.f) & 0xffffu);
        } else {
#pragma unroll
            for (int j = 0; j < 4; ++j) if (m0 + j >= 1) { const u16 b = (u16)(pk_bf16(v[j], 0.f) & 0xffffu); r0[2047 + m0 + j] = b; r0[FR_LEN + 2046 + m0 + j] = b; }
        }
    }
    if (tid < 8 * 34) { const int r = tid / 34, x = 4094 + tid % 34; u16* rr = FR + (size_t)((oc0 + r) * 2) * FR_LEN; if (x >= 4095) rr[x] = 0; rr[FR_LEN + x] = 0; }
    __syncthreads();
}
constexpr int HY_ZSTRIDE = 2312;
constexpr int HY_ZCH = 256 + 4 * HY_ZSTRIDE;
constexpr int HY_ZBYTES = HY_ZCH * 2;
constexpr int HY_FB = 4 * HY_ZBYTES;
constexpr int HY_FCH = 2 * FR_LEN * 2;
constexpr int HY_LDS = HY_FB + 4 * HY_FCH;

__device__ __forceinline__ void hy_load_row(LAS unsigned char* lds, int dest, int boff0, int bstride, const u16* __restrict__ row, float w0, float w1, float w2, float cb, int pl) {
#pragma unroll 2
    for (int it = 0; it < 8; ++it) {
        const int idx = pl + 128 * it, tok0 = idx * 8, b = tok0 >> 11, n0 = tok0 & 2047;
        const u32x4 raw = *(const u32x4*)(row + tok0);
        const float pm = (n0 > 0) ? bf2f(row[tok0 - 1]) : 0.f;
        const float pn = (n0 + 8 < SEQ) ? bf2f(row[tok0 + 8]) : 0.f;
        float p[10];
        p[0] = pm; p[9] = pn;
#pragma unroll
        for (int q = 0; q < 4; ++q) { p[1 + 2 * q] = bflo(raw[q]); p[2 + 2 * q] = bfhi(raw[q]); }
        float o[8];
#pragma unroll
        for (int q = 0; q < 8; ++q) o[q] = fmaf(w0, p[q], fmaf(w1, p[q + 1], fmaf(w2, p[q + 2], cb)));
        u32x4 w; w[0] = pk_bf16(o[0], o[1]); w[1] = pk_bf16(o[2], o[3]); w[2] = pk_bf16(o[4], o[5]); w[3] = pk_bf16(o[6], o[7]);
        *(LAS u32x4*)(lds + dest + (boff0 + b * bstride + n0) * 2) = w;
    }
}
__device__ __forceinline__ void hy_load_filters(LAS unsigned char* lds, int fb, const u16* __restrict__ src, int pl) {
    for (int idx = pl; idx < HY_FCH / 16; idx += 128) *(LAS u32x4*)(lds + fb + idx * 16) = *(const u32x4*)((const char*)src + idx * 16);
}
__device__ __forceinline__ void hy_mfma_loop(LAS unsigned char* lds, int zb, int fb, int hlf, int lane, f32x16 (&acc)[4], const ConvCtx& cc, int mbase, int cunit, int wid) {
    const int r = lane & 31, hh = lane >> 5, il = r >> 2, b = r & 3;
    const int bbase = zb + (256 + b * HY_ZSTRIDE + 32 * il + 8 * hh) * 2;
    const int xl = 2047 - r + 8 * hh - 1024 * hlf;
    const int abase = (r & 1) ? (fb + 2 * xl) : (fb + FR_LEN * 2 + 2 * (xl - 1));
#pragma unroll
    for (int q = 0; q < 4; ++q)
#pragma unroll
        for (int i = 0; i < 16; ++i) acc[q][i] = 0.f;
    for (int d0 = 0; d0 < 8; ++d0) {
#pragma unroll
        for (int ks = 0; ks < 2; ++ks) {
            f32x2 cv[16];
            const int mcv = conv_seq2tile((mbase + d0 * 2 + ks) * 256 + cunit);
            conv_issue(cc, mcv, wid, lane, cv);
            bf16x8 Bt[9];
#pragma unroll
            for (int j = 0; j < 9; ++j) Bt[j] = *(const LAS bf16x8*)(lds + bbase + 512 * j - 64 * d0 + 32 * ks);
#pragma unroll
            for (int ep = -8; ep <= 3; ++ep) {
                const LAS unsigned* ap = (const LAS unsigned*)(lds + abase - 64 * d0 - 512 * ep + 32 * ks);
                u32x4 av; av[0] = ap[0]; av[1] = ap[1]; av[2] = ap[2]; av[3] = ap[3];
                const bf16x8 a = __builtin_bit_cast(bf16x8, av);
#pragma unroll
                for (int ctl = 0; ctl < 4; ++ctl) { const int jt = ctl - ep; if (jt >= 0 && jt <= 8) acc[ctl] = __builtin_amdgcn_mfma_f32_32x32x16_bf16(a, Bt[jt], acc[ctl], 0, 0, 0); }
            }
            conv_finish(cc, mcv, wid, lane, cv);
        }
    }
}
__device__ __forceinline__ void hy_epilogue(LAS unsigned char* lds, int zb, int gb, int hlf, int lane, const f32x16 (&acc)[4], float bias) {
    const int r = lane & 31, hh = lane >> 5, il = r >> 2, b = r & 3;
#pragma unroll
    for (int ctl = 0; ctl < 4; ++ctl) {
        const int I = 8 * (4 * hlf + ctl) + il;
#pragma unroll
        for (int q = 0; q < 4; ++q) {
            const int n4 = 32 * I + 8 * q + 4 * hh;
            LAS u32x2* zp = (LAS u32x2*)(lds + zb + (256 + b * HY_ZSTRIDE + n4) * 2);
            const u32x2 zv = *zp, gv = *(const LAS u32x2*)(lds + gb + (b * 2048 + n4) * 2);
            const float z0 = bflo(zv[0]), z1 = bfhi(zv[0]), z2 = bflo(zv[1]), z3 = bfhi(zv[1]);
            const float g0 = bflo(gv[0]), g1 = bfhi(gv[0]), g2 = bflo(gv[1]), g3 = bfhi(gv[1]);
            u32x2 o; o[0] = pk_bf16(g0 * fmaf(bias, z0, acc[ctl][4 * q + 0]), g1 * fmaf(bias, z1, acc[ctl][4 * q + 1]));
            o[1] = pk_bf16(g2 * fmaf(bias, z2, acc[ctl][4 * q + 2]), g3 * fmaf(bias, z3, acc[ctl][4 * q + 3]));
            *zp = o;
        }
    }
}
__device__ __forceinline__ void hyena_unit(LAS unsigned char* lds, int unit, const u16* __restrict__ HYT, const u16* __restrict__ FR, const float* __restrict__ cw, const float* __restrict__ cbv,
                                           const float* __restrict__ hbias, u16* __restrict__ Z2T, const ConvCtx& cc) {
    const int tid = tid_fresh(), wid = __builtin_amdgcn_readfirstlane(tid >> 6), lane = tid & 63;
    const int cs = wid & 3, hlf = wid >> 2, c = unit * 4 + cs, pl = lane + 64 * hlf;
    const int zb = cs * HY_ZBYTES, fb = HY_FB + cs * HY_FCH;
    { const u32x4 z = {0u, 0u, 0u, 0u}; for (int idx = pl; idx < HY_ZBYTES / 16; idx += 128) *(LAS u32x4*)(lds + zb + idx * 16) = z; }
    __syncthreads();
    hy_load_row(lds, zb, 256, HY_ZSTRIDE, HYT + (size_t)c * NTOK, cw[0 * 3072 + c], cw[1 * 3072 + c], cw[2 * 3072 + c], cbv[c], pl);
    f32x16 acc[4];
#pragma unroll
    for (int o = 0; o < 2; ++o) {
        hy_load_filters(lds, fb, FR + (size_t)((o * 1024 + c) * 2) * FR_LEN, pl);
        __syncthreads();
        hy_mfma_loop(lds, zb, fb, hlf, lane, acc, cc, o * 16, unit, wid);
        __syncthreads();
        const int gc = (1 + o) * 1024 + c;
        hy_load_row(lds, fb, 0, 2048, HYT + (size_t)gc * NTOK, cw[0 * 3072 + gc], cw[1 * 3072 + gc], cw[2 * 3072 + gc], cbv[gc], pl);
        __syncthreads();
        hy_epilogue(lds, zb, fb, hlf, lane, acc, hbias[o * HYW + c]);
        __syncthreads();
    }
#pragma unroll 2
    for (int it = 0; it < 8; ++it) { const int idx = pl + 128 * it, tok0 = idx * 8, b = tok0 >> 11, n0 = tok0 & 2047;
        *(u32x4*)(Z2T + (size_t)c * NTOK + tok0) = *(const LAS u32x4*)(lds + zb + (256 + b * HY_ZSTRIDE + n0) * 2); }
    __syncthreads();
}

constexpr int HG_RAWQ = 0, HG_RAWF = 16384, HG_RAWV = 32768;
constexpr int HG_QM = 36864, HG_KM = HG_QM + 17408, HG_QI = HG_KM + 17408;
constexpr int HG_KL = HG_QI + 17408;
constexpr int HG_VT = HG_KL + 18432;
constexpr int HG_P = HG_VT + 4608;
constexpr int HG_ST = HG_P + 9216;
constexpr int HG_TOT = HG_ST + 8704;
constexpr int HG_EL2 = HG_TOT + 4096;
constexpr int HG_LDS = HG_EL2 + 512;

__device__ __forceinline__ void hgrn_unit(LAS unsigned char* lds, int unit, const u16* __restrict__ PG, const float* __restrict__ lb_logits, float* __restrict__ OF, float* __restrict__ OB, const ConvCtx& cc) {
    const int tid = tid_fresh(), wid = __builtin_amdgcn_readfirstlane(tid >> 6), lane = tid & 63, fr = lane & 15, fq = lane >> 4;
    const int vq = unit & 3, dir = (unit >> 2) & 1, h = (unit >> 3) & 7, b = unit >> 6;
    const int k = tid & 127, seg = tid >> 7;
    float* __restrict__ O = dir ? OB : OF;
    for (int i = tid; i < 8704 / 16; i += 512) *(LAS u32x4*)(lds + HG_ST + i * 16) = (u32x4){0u, 0u, 0u, 0u};
    f32x4 Sacc[2];
    Sacc[0] = (f32x4){0.f, 0.f, 0.f, 0.f}; Sacc[1] = Sacc[0];
    u32x4 pq[2], pf[2], pv;
    const int colq = h * 128, colf = (1 + dir) * 1024 + h * 128, colv = 3072 + h * 128 + vq * 32;
#define HG_TOK(c, tau) ((size_t)b * SEQ + (dir ? (SEQ - 1 - 64 * (c) - (tau)) : (64 * (c) + (tau))))
#define HG_PREFETCH(c) do { _Pragma("unroll") for (int _i = 0; _i < 2; ++_i) { const int _x = tid + 512 * _i, _tau = _x >> 4, _p = _x & 15; const u16* _r = PG + HG_TOK(c, _tau) * 5120; \
            pq[_i] = *(const u32x4*)(_r + colq + _p * 8); pf[_i] = *(const u32x4*)(_r + colf + _p * 8); } \
        if (tid < 256) { const int _tau = tid >> 2, _p = tid & 3; pv = *(const u32x4*)(PG + HG_TOK(c, _tau) * 5120 + colv + _p * 8); } } while (0)
#define HG_RAW2LDS() do { _Pragma("unroll") for (int _i = 0; _i < 2; ++_i) { const int _x = tid + 512 * _i; *(LAS u32x4*)(lds + HG_RAWQ + _x * 16) = pq[_i]; *(LAS u32x4*)(lds + HG_RAWF + _x * 16) = pf[_i]; } \
        if (tid < 256) *(LAS u32x4*)(lds + HG_RAWV + tid * 16) = pv; } while (0)
    HG_PREFETCH(0);
    HG_RAW2LDS();
    HG_PREFETCH(1);
    __syncthreads();
    for (int c = 0; c < 32; ++c) {
        f32x2 cv[16];
        const int mqa = conv_seq2tile((32 + c * 2) * 256 + unit), mqb = conv_seq2tile((33 + c * 2) * 256 + unit);
        conv_issue(cc, mqa, wid, lane, cv);
        const int kp = lane, sg = wid;
        float qv0[8], qv1[8], kv0[8], kv1[8], bl0[8], bl1[8];
        { float r0 = 0.f, r1 = 0.f;
#pragma unroll
          for (int i = 0; i < 8; ++i) { const int tau = sg * 8 + i;
              const unsigned qw = *(const LAS unsigned*)(lds + HG_RAWQ + tau * 256 + kp * 4), fw = *(const LAS unsigned*)(lds + HG_RAWF + tau * 256 + kp * 4);
              const float l0 = bflo(fw), l1 = bfhi(fw);
              r0 += l0; r1 += l1; bl0[i] = r0; bl1[i] = r1; kv0[i] = 1.0f - __expf(l0); kv1[i] = 1.0f - __expf(l1); qv0[i] = bflo(qw); qv1[i] = bfhi(qw); }
          *(LAS f32x2*)(lds + HG_TOT + (sg * 128 + 2 * kp) * 4) = (f32x2){r0, r1}; }
        __syncthreads();
        { f32x2 tt[8];
#pragma unroll
          for (int q = 0; q < 8; ++q) tt[q] = *(const LAS f32x2*)(lds + HG_TOT + (q * 128 + 2 * kp) * 4);
          f32x2 pre = {0.f, 0.f};
#pragma unroll
          for (int q = 0; q < 7; ++q) if (q < sg) pre += tt[q];
          const f32x2 bref = tt[0] + tt[1] + tt[2] + tt[3], blast = bref + tt[4] + tt[5] + tt[6] + tt[7];
          const float er0 = __expf(bref[0]), er1 = __expf(bref[1]), el0 = __expf(blast[0] - bref[0]), el1 = __expf(blast[1] - bref[1]);
          if (sg == 0) *(LAS f32x2*)(lds + HG_EL2 + 2 * kp * 4) = (f32x2){__expf(blast[0]), __expf(blast[1])};
          float kl0[8], kl1[8];
#pragma unroll
          for (int i = 0; i < 8; ++i) { const int tau = sg * 8 + i; const float b0 = pre[0] + bl0[i], b1 = pre[1] + bl1[i];
              const float qm0 = qv0[i] * __expf(b0 - bref[0]), qm1 = qv1[i] * __expf(b1 - bref[1]), km0 = kv0[i] * __expf(bref[0] - b0), km1 = kv1[i] * __expf(bref[1] - b1);
              *(LAS unsigned*)(lds + HG_QM + tau * 272 + kp * 4) = pk_bf16(qm0, qm1);
              *(LAS unsigned*)(lds + HG_KM + tau * 272 + kp * 4) = pk_bf16(km0, km1);
              *(LAS unsigned*)(lds + HG_QI + tau * 272 + kp * 4) = pk_bf16(qm0 * er0, qm1 * er1);
              kl0[i] = km0 * el0; kl1[i] = km1 * el1; }
          *(LAS u32x4*)(lds + HG_KL + (2 * kp) * 144 + sg * 16) = (u32x4){pk_bf16(kl0[0], kl0[1]), pk_bf16(kl0[2], kl0[3]), pk_bf16(kl0[4], kl0[5]), pk_bf16(kl0[6], kl0[7])};
          *(LAS u32x4*)(lds + HG_KL + (2 * kp + 1) * 144 + sg * 16) = (u32x4){pk_bf16(kl1[0], kl1[1]), pk_bf16(kl1[2], kl1[3]), pk_bf16(kl1[4], kl1[5]), pk_bf16(kl1[6], kl1[7])};
          { const int v = tid & 31, tg = tid >> 5; unsigned short e[4];
#pragma unroll
            for (int u = 0; u < 4; ++u) e[u] = *(const LAS u16*)(lds + HG_RAWV + (tg * 4 + u) * 64 + v * 2);
            *(LAS u32x2*)(lds + HG_VT + v * 144 + tg * 8) = (u32x2){(unsigned)e[0] | ((unsigned)e[1] << 16), (unsigned)e[2] | ((unsigned)e[3] << 16)}; } }
        conv_finish(cc, mqa, wid, lane, cv);
        conv_issue(cc, mqb, wid, lane, cv);
        __syncthreads();
        if (c + 1 < 32) { HG_RAW2LDS(); if (c + 2 < 32) HG_PREFETCH(c + 2); }
#pragma unroll
        for (int q = 0; q < 2; ++q) { const int idx = wid * 2 + q, ti = idx >> 2, si = idx & 3;
            f32x4 a = {0.f, 0.f, 0.f, 0.f};
            if (si <= ti) {
#pragma unroll
                for (int ks = 0; ks < 4; ++ks) { const bf16x8 ka = *(const LAS bf16x8*)(lds + HG_KM + (si * 16 + fr) * 272 + (ks * 32 + fq * 8) * 2), qb = *(const LAS bf16x8*)(lds + HG_QM + (ti * 16 + fr) * 272 + (ks * 32 + fq * 8) * 2);
                    a = __builtin_amdgcn_mfma_f32_16x16x32_bf16(ka, qb, a, 0, 0, 0); } }
            const int tau = ti * 16 + fr, s0 = si * 16 + fq * 4;
            float pvv[4];
#pragma unroll
            for (int j = 0; j < 4; ++j) pvv[j] = (si <= ti && s0 + j <= tau) ? a[j] : 0.f;
            *(LAS u32x2*)(lds + HG_P + tau * 144 + s0 * 2) = (u32x2){pk_bf16(pvv[0], pvv[1]), pk_bf16(pvv[2], pvv[3])}; }
        const int ti = wid >> 1, vi = wid & 1;
        f32x4 oacc = {0.f, 0.f, 0.f, 0.f};
#pragma unroll
        for (int ks = 0; ks < 4; ++ks) { const bf16x8 qa = *(const LAS bf16x8*)(lds + HG_QI + (ti * 16 + fr) * 272 + (ks * 32 + fq * 8) * 2), sb = *(const LAS bf16x8*)(lds + HG_ST + (vi * 16 + fr) * 272 + (ks * 32 + fq * 8) * 2);
            oacc = __builtin_amdgcn_mfma_f32_16x16x32_bf16(qa, sb, oacc, 0, 0, 0); }
        { const f32x4 e2 = *(const LAS f32x4*)(lds + HG_EL2 + (wid * 16 + fq * 4) * 4);
#pragma unroll
          for (int v2 = 0; v2 < 2; ++v2) { Sacc[v2] = Sacc[v2] * e2;
#pragma unroll
              for (int ks = 0; ks < 2; ++ks) { const bf16x8 ka = *(const LAS bf16x8*)(lds + HG_KL + (wid * 16 + fr) * 144 + (ks * 32 + fq * 8) * 2), vb = *(const LAS bf16x8*)(lds + HG_VT + (v2 * 16 + fr) * 144 + (ks * 32 + fq * 8) * 2);
                  Sacc[v2] = __builtin_amdgcn_mfma_f32_16x16x32_bf16(ka, vb, Sacc[v2], 0, 0, 0); } } }
        __syncthreads();
#pragma unroll
        for (int ks = 0; ks < 2; ++ks) { const bf16x8 pa = *(const LAS bf16x8*)(lds + HG_P + (ti * 16 + fr) * 144 + (ks * 32 + fq * 8) * 2), vb = *(const LAS bf16x8*)(lds + HG_VT + (vi * 16 + fr) * 144 + (ks * 32 + fq * 8) * 2);
            oacc = __builtin_amdgcn_mfma_f32_16x16x32_bf16(pa, vb, oacc, 0, 0, 0); }
#pragma unroll
        for (int j = 0; j < 4; ++j) { const int tau = ti * 16 + fq * 4 + j; O[HG_TOK(c, tau) * HGW + h * 128 + vq * 32 + vi * 16 + fr] = oacc[j]; }
        conv_finish(cc, mqb, wid, lane, cv);
#pragma unroll
        for (int v2 = 0; v2 < 2; ++v2) *(LAS u32x2*)(lds + HG_ST + (v2 * 16 + fr) * 272 + (wid * 16 + fq * 4) * 2) = (u32x2){pk_bf16(Sacc[v2][0], Sacc[v2][1]), pk_bf16(Sacc[v2][2], Sacc[v2][3])};
    }
    __syncthreads();
#undef HG_TOK
#undef HG_PREFETCH
#undef HG_RAW2LDS
}


#define XB_TMO      128
#define XB_XCNT(j)  (256  + 64 * (j))
#define XB_XSUB(j)  (1280 + 64 * (j))
#define XB_XGEN(j)  (2304 + 64 * (j))
#define XB_TOP      3328
#define XB_TOPGEN   3392
#define XCD_BAR_WORDS 3456
#define XB_SPIN_CAP (1u << 22)

__device__ __forceinline__ unsigned xb_ld(unsigned* p)              { return __hip_atomic_load(p, __ATOMIC_RELAXED, __HIP_MEMORY_SCOPE_AGENT); }
__device__ __forceinline__ unsigned xb_add(unsigned* p, unsigned v) { return __hip_atomic_fetch_add(p, v, __ATOMIC_RELAXED, __HIP_MEMORY_SCOPE_AGENT); }
__device__ __forceinline__ unsigned xb_xcc_id() { return (unsigned)__builtin_amdgcn_s_getreg((3 << 11) | 20) & 0xFu; }
#define XB_SPIN(cond, bar) do { unsigned _sp = 0; while (cond) { __builtin_amdgcn_s_sleep(1); \
    if ((++_sp & 255u) == 0u) { if (xb_ld(&(bar)[XB_TMO])) break; if (_sp > XB_SPIN_CAP) { atomicAdd(&(bar)[XB_TMO], 1u); break; } } } } while (0)

struct XcdBarrier {
    unsigned* bar; unsigned x;
    volatile LAS unsigned* st;
};

__device__ __forceinline__ XcdBarrier xcd_barrier_post(unsigned* bar, volatile LAS unsigned* st) {
    XcdBarrier b; b.bar = bar; b.x = xb_xcc_id(); b.st = st;
    if (threadIdx.x == 0) (void)xb_add(&bar[XB_XCNT(b.x)], 1u);
    return b;
}
__device__ __forceinline__ void xcd_barrier_complete(unsigned* bar, unsigned x, unsigned& nloc, unsigned& nx) {
    const unsigned G = gridDim.x * gridDim.y * gridDim.z;
    unsigned sum, cnt, mine, sp = 0u;
    for (;;) {
        sum = 0u; cnt = 0u; mine = 0u;
#pragma unroll
        for (unsigned j = 0; j < 16; ++j) { const unsigned c = xb_ld(&bar[XB_XCNT(j)]); sum += c; cnt += (c > 0u) ? 1u : 0u; mine = (j == x) ? c : mine; }
        if (sum == G) break;
        __builtin_amdgcn_s_sleep(1);
        if ((++sp & 255u) == 0u) { if (xb_ld(&bar[XB_TMO])) break; if (sp > XB_SPIN_CAP) { atomicAdd(&bar[XB_TMO], 1u); break; } }
    }
    nloc = mine > 0u ? mine : 1u; nx = cnt > 0u ? cnt : 1u;
}

__device__ __forceinline__ void xcd_barrier(const XcdBarrier& b) {
    asm volatile("s_waitcnt vmcnt(0)" ::: "memory");
    __syncthreads();
    if (threadIdx.x == 0) {
        unsigned* bar = b.bar;
        __builtin_amdgcn_s_waitcnt(0);
        unsigned nloc = b.st[0], nx = b.st[1];
        if (nloc == 0u) { xcd_barrier_complete(bar, b.x, nloc, nx); b.st[0] = nloc; b.st[1] = nx; }
        const unsigned old = xb_add(&bar[XB_XSUB(b.x)], 1u);
        const unsigned gen = old / nloc;
        if (old + 1u == (gen + 1u) * nloc) {
            __builtin_amdgcn_fence(__ATOMIC_RELEASE, "agent");
            asm volatile("s_waitcnt vmcnt(0)" ::: "memory");
            const unsigned og = xb_add(&bar[XB_TOP], 1u);
            const unsigned tg = og / nx;
            if (og + 1u == (tg + 1u) * nx) xb_add(&bar[XB_TOPGEN], 1u);
            else XB_SPIN(xb_ld(&bar[XB_TOPGEN]) == tg, bar);
            __builtin_amdgcn_fence(__ATOMIC_ACQUIRE, "agent");
            xb_add(&bar[XB_XGEN(b.x)], 1u);
            asm volatile("s_waitcnt vmcnt(0)" ::: "memory");
        } else {
            XB_SPIN(xb_ld(&bar[XB_XGEN(b.x)]) == gen, bar);
            __builtin_amdgcn_fence(__ATOMIC_ACQUIRE, "agent");
            asm volatile("s_waitcnt vmcnt(0)" ::: "memory");
        }
    }
    __syncthreads();
}

__device__ __forceinline__ float wave_sum(float s) {
#pragma unroll
    for (int o = 32; o >= 1; o >>= 1) s += __shfl_xor(s, o);
    return s;
}
__device__ __forceinline__ void rmsnorm_row_bf(const float* __restrict__ xr, const float* __restrict__ gain, u16* __restrict__ ob, int lane) {
    f32x4 v[8]; float s = 0.f;
#pragma unroll
    for (int j = 0; j < 8; ++j) { v[j] = *(const f32x4*)(xr + (lane + 64 * j) * 4); s += v[j][0] * v[j][0] + v[j][1] * v[j][1] + v[j][2] * v[j][2] + v[j][3] * v[j][3]; }
    s = wave_sum(s);
    const float r = rsqrtf(s * (1.0f / (float)DM) + EPS);
#pragma unroll
    for (int j = 0; j < 8; ++j) { const f32x4 g = *(const f32x4*)(gain + (lane + 64 * j) * 4); const f32x4 o = v[j] * r * g;
        *(u32x2*)(ob + (lane + 64 * j) * 4) = (u32x2){pk_bf16(o[0], o[1]), pk_bf16(o[2], o[3])}; }
}
__device__ __forceinline__ void hgrn_final_item4(int item0, int stride, const float* __restrict__ OF, const float* __restrict__ OB, const u16* __restrict__ PG, const float* __restrict__ gain, u16* __restrict__ MIXB, int lane) {
    f32x2 a[4], b[4]; unsigned gw[4];
#pragma unroll
    for (int q = 0; q < 4; ++q) { const int item = item0 + q * stride, tok = item >> 3, c = (item & 7) * 128 + 2 * lane;
        a[q] = *(const f32x2*)(OF + (size_t)tok * HGW + c); b[q] = *(const f32x2*)(OB + (size_t)tok * HGW + c); gw[q] = *(const unsigned*)(PG + (size_t)tok * 5120 + 4096 + c); }
#pragma unroll
    for (int q = 0; q < 4; ++q) { const int item = item0 + q * stride, tok = item >> 3, c = (item & 7) * 128 + 2 * lane;
        const float o0 = a[q][0] + b[q][0], o1 = a[q][1] + b[q][1];
        const float s = wave_sum(o0 * o0 + o1 * o1);
        const float r = rsqrtf(s * (1.0f / 128.0f) + EPS);
        const float g0 = bflo(gw[q]), g1 = bfhi(gw[q]);
        const f32x2 gn = *(const f32x2*)(gain + c);
        const float v0 = o0 * r * gn[0] * (g0 / (1.0f + __expf(-g0))), v1 = o1 * r * gn[1] * (g1 / (1.0f + __expf(-g1)));
        *(u16*)((unsigned char*)MIXB + (size_t)tok * DM + c) = (u16)(__builtin_amdgcn_cvt_pk_fp8_f32(v0, v1, 0, false) & 0xffff); }
}
__device__ __forceinline__ void hy_norm_tile(LAS unsigned char* lds, int tile_i, const u16* __restrict__ Z2T, const float* __restrict__ gain, u16* __restrict__ MIXB) {
    const int t = tid_fresh(), tok0 = tile_i * 32;
    LAS float* ssq = (LAS float*)(lds + 1024 * 80);
    if (t < 32) ssq[t] = 0.f;
    __syncthreads();
    float part[8];
#pragma unroll
    for (int q = 0; q < 8; ++q) part[q] = 0.f;
    const int ch = t & 3;
#pragma unroll
    for (int it = 0; it < 8; ++it) {
        const int c = (t >> 2) + 128 * it;
        const u32x4 v = *(const u32x4*)(Z2T + (size_t)c * NTOK + tok0 + ch * 8);
        *(LAS u32x4*)(lds + c * 80 + ch * 16) = v;
#pragma unroll
        for (int q = 0; q < 4; ++q) { const float a = bflo(v[q]), b = bfhi(v[q]); part[2 * q] += a * a; part[2 * q + 1] += b * b; }
    }
#pragma unroll
    for (int q = 0; q < 8; ++q) { float s = part[q]; s += __shfl_xor(s, 4); s += __shfl_xor(s, 8); s += __shfl_xor(s, 16); s += __shfl_xor(s, 32); part[q] = s; }
    if ((t & 63) < 4) {
#pragma unroll
        for (int q = 0; q < 8; ++q) atomicAdd((float*)(ssq + ch * 8 + q), part[q]);
    }
    __syncthreads();
    const int tt = t >> 4;
    const float r = rsqrtf(ssq[tt] * (1.0f / (float)HYW) + EPS);
#pragma unroll 2
    for (int k = 0; k < 8; ++k) {
        const int c0 = ((t & 15) + 16 * k) * 8;
        float o[8];
#pragma unroll
        for (int q = 0; q < 8; ++q) o[q] = bf2f(*(const LAS u16*)(lds + (c0 + q) * 80 + tt * 2)) * r * gain[c0 + q];
        *(u32x2*)((unsigned char*)MIXB + (size_t)(tok0 + tt) * DM + 1024 + c0) = (u32x2){pk_fp8x4(o[0], o[1], o[2], o[3]), pk_fp8x4(o[4], o[5], o[6], o[7])};
    }
    __syncthreads();
}
constexpr int RT_XSTRIDE = 2049;
constexpr int RT_PART = 16 * RT_XSTRIDE * 4;
constexpr int RT_LG = RT_PART + 8 * 16 * 32 * 4;
constexpr int RT_HIST = RT_LG + 16 * 32 * 4;
constexpr int RT_ITEMS = RT_HIST + 128;
constexpr int RT_RBASE = RT_ITEMS + 512;
constexpr int RT_END = RT_RBASE + 128;
__device__ __forceinline__ void router_tile(LAS unsigned char* lds, int tile_i, const float* __restrict__ X1, const float* __restrict__ gain, const float* __restrict__ wr, const float* __restrict__ br,
                                            unsigned char* __restrict__ XN8, float* __restrict__ TOPG, int tl2) {
    const int tid = tid_fresh(), wid = __builtin_amdgcn_readfirstlane(tid >> 6), lane = tid & 63;
    const int tok0 = tile_i * 16;
    LAS float* xs = (LAS float*)lds;
#pragma unroll
    for (int q = 0; q < 2; ++q) {
        const int tl = wid * 2 + q; const size_t tok = (size_t)tok0 + tl;
        const float* xr = X1 + tok * DM;
        f32x4 v[8]; float s = 0.f;
#pragma unroll
        for (int j = 0; j < 8; ++j) { v[j] = *(const f32x4*)(xr + (lane + 64 * j) * 4); s += v[j][0] * v[j][0] + v[j][1] * v[j][1] + v[j][2] * v[j][2] + v[j][3] * v[j][3]; }
        s = wave_sum(s);
        const float r = rsqrtf(s * (1.0f / (float)DM) + EPS);
#pragma unroll
        for (int j = 0; j < 8; ++j) { const int d = (lane + 64 * j) * 4; const f32x4 g = *(const f32x4*)(gain + d); const f32x4 o = v[j] * r * g;
            xs[tl * RT_XSTRIDE + d + 0] = o[0]; xs[tl * RT_XSTRIDE + d + 1] = o[1]; xs[tl * RT_XSTRIDE + d + 2] = o[2]; xs[tl * RT_XSTRIDE + d + 3] = o[3];
            *(unsigned*)(XN8 + tok * DM + d) = pk_fp8x4(o[0], o[1], o[2], o[3]); }
    }
    __syncthreads();
    {
        const int tl = lane & 15, kk = lane >> 4;
        f32x4 a0 = {0.f, 0.f, 0.f, 0.f}, a1 = a0;
        const LAS float* xp = xs + tl * RT_XSTRIDE + wid * 256 + kk;
        const float* wp = wr + (size_t)(wid * 256 + kk) * NE + tl;
#pragma unroll 8
        for (int ks = 0; ks < 64; ++ks) { const float a = xp[ks * 4]; const float b0 = wp[(size_t)ks * 4 * NE], b1 = wp[(size_t)ks * 4 * NE + 16];
            a0 = __builtin_amdgcn_mfma_f32_16x16x4f32(a, b0, a0, 0, 0, 0); a1 = __builtin_amdgcn_mfma_f32_16x16x4f32(a, b1, a1, 0, 0, 0); }
        LAS float* pp = (LAS float*)(lds + RT_PART) + wid * 512;
#pragma unroll
        for (int j = 0; j < 4; ++j) { pp[(kk * 4 + j) * 32 + tl] = a0[j]; pp[(kk * 4 + j) * 32 + 16 + tl] = a1[j]; }
    }
    __syncthreads();
    {   const LAS float* pp = (const LAS float*)(lds + RT_PART); float s = br[tid & 31];
#pragma unroll
        for (int w = 0; w < 8; ++w) s += pp[w * 512 + tid];
        ((LAS float*)(lds + RT_LG))[tid] = s; }
    __syncthreads();
    if (tid < 16) {
        LAS float* lg = (LAS float*)(lds + RT_LG) + tid * 32;
        int i0 = 0, i1 = 0, i2 = 0, i3 = 0; float v0, v1, v2, v3;
        { float bv = -3.0e38f; for (int j = 0; j < NE; ++j) { const float l = lg[j]; if (l > bv) { bv = l; i0 = j; } } v0 = bv; lg[i0] = -3.4e38f; }
        { float bv = -3.0e38f; for (int j = 0; j < NE; ++j) { const float l = lg[j]; if (l > bv) { bv = l; i1 = j; } } v1 = bv; lg[i1] = -3.4e38f; }
        { float bv = -3.0e38f; for (int j = 0; j < NE; ++j) { const float l = lg[j]; if (l > bv) { bv = l; i2 = j; } } v2 = bv; lg[i2] = -3.4e38f; }
        { float bv = -3.0e38f; for (int j = 0; j < NE; ++j) { const float l = lg[j]; if (l > bv) { bv = l; i3 = j; } } v3 = bv; lg[i3] = -3.4e38f; }
        const float e1 = __expf(v1 - v0), e2 = __expf(v2 - v0), e3 = __expf(v3 - v0), inv = 1.0f / (1.0f + e1 + e2 + e3);
        const int tok = tok0 + tid;
        *(f32x4*)(TOPG + tok * 4) = (f32x4){inv, e1 * inv, e2 * inv, e3 * inv};
        LAS int* hist = (LAS int*)(lds + RT_HIST);
        const int p0 = atomicAdd((int*)(hist + i0), 1), p1 = atomicAdd((int*)(hist + i1), 1), p2 = atomicAdd((int*)(hist + i2), 1), p3 = atomicAdd((int*)(hist + i3), 1);
        *(LAS u32x4*)(lds + RT_ITEMS + (tl2 * 16 + tid) * 16) = (u32x4){(unsigned)((i0 << 16) | p0), (unsigned)((i1 << 16) | p1), (unsigned)((i2 << 16) | p2), (unsigned)((i3 << 16) | p3)};
    }
    __syncthreads();
}
__device__ __forceinline__ void combine_row(int tok, const float* __restrict__ X1, const u16* __restrict__ YB, const int* __restrict__ SOF, const float* __restrict__ TOPG, const float* __restrict__ gain, float* __restrict__ out, int lane) {
    const int4 sl = *(const int4*)(SOF + tok * 4); const f32x4 g = *(const f32x4*)(TOPG + tok * 4);
    const u16* y0 = YB + (size_t)sl.x * DM; const u16* y1 = YB + (size_t)sl.y * DM; const u16* y2 = YB + (size_t)sl.z * DM; const u16* y3 = YB + (size_t)sl.w * DM;
    f32x4 v[8]; float s = 0.f;
#pragma unroll
    for (int j = 0; j < 8; ++j) { const int d = (lane + 64 * j) * 4;
        f32x4 a = *(const f32x4*)(X1 + (size_t)tok * DM + d);
        const u32x2 q0 = *(const u32x2*)(y0 + d), q1 = *(const u32x2*)(y1 + d), q2 = *(const u32x2*)(y2 + d), q3 = *(const u32x2*)(y3 + d);
        a[0] += g[0] * bflo(q0[0]) + g[1] * bflo(q1[0]) + g[2] * bflo(q2[0]) + g[3] * bflo(q3[0]);
        a[1] += g[0] * bfhi(q0[0]) + g[1] * bfhi(q1[0]) + g[2] * bfhi(q2[0]) + g[3] * bfhi(q3[0]);
        a[2] += g[0] * bflo(q0[1]) + g[1] * bflo(q1[1]) + g[2] * bflo(q2[1]) + g[3] * bflo(q3[1]);
        a[3] += g[0] * bfhi(q0[1]) + g[1] * bfhi(q1[1]) + g[2] * bfhi(q2[1]) + g[3] * bfhi(q3[1]);
        v[j] = a; s += a[0] * a[0] + a[1] * a[1] + a[2] * a[2] + a[3] * a[3]; }
    s = wave_sum(s);
    const float r = rsqrtf(s * (1.0f / (float)DM) + EPS);
#pragma unroll
    for (int j = 0; j < 8; ++j) { const int d = (lane + 64 * j) * 4; const f32x4 gn = *(const f32x4*)(gain + d); *(f32x4*)(out + (size_t)tok * DM + d) = v[j] * r * gn; }
}

__device__ __forceinline__ void combine_row2(int tokA, int tokB, const float* __restrict__ X1, const u16* __restrict__ YB, const int* __restrict__ SOF, const float* __restrict__ TOPG, const float* __restrict__ gain, float* __restrict__ out, int lane) {
    const int4 slA = *(const int4*)(SOF + tokA * 4), slB = *(const int4*)(SOF + tokB * 4); const f32x4 gA = *(const f32x4*)(TOPG + tokA * 4), gB = *(const f32x4*)(TOPG + tokB * 4);
    const u16* yA0 = YB + (size_t)slA.x * DM; const u16* yA1 = YB + (size_t)slA.y * DM; const u16* yA2 = YB + (size_t)slA.z * DM; const u16* yA3 = YB + (size_t)slA.w * DM;
    const u16* yB0 = YB + (size_t)slB.x * DM; const u16* yB1 = YB + (size_t)slB.y * DM; const u16* yB2 = YB + (size_t)slB.z * DM; const u16* yB3 = YB + (size_t)slB.w * DM;
    f32x4 vA[8], vB[8]; float sA = 0.f, sB = 0.f;
#pragma unroll
    for (int j = 0; j < 8; ++j) { const int d = (lane + 64 * j) * 4;
        f32x4 a = *(const f32x4*)(X1 + (size_t)tokA * DM + d), b = *(const f32x4*)(X1 + (size_t)tokB * DM + d);
        const u32x2 p0 = *(const u32x2*)(yA0 + d), p1 = *(const u32x2*)(yA1 + d), p2 = *(const u32x2*)(yA2 + d), p3 = *(const u32x2*)(yA3 + d);
        const u32x2 q0 = *(const u32x2*)(yB0 + d), q1 = *(const u32x2*)(yB1 + d), q2 = *(const u32x2*)(yB2 + d), q3 = *(const u32x2*)(yB3 + d);
        a[0] += gA[0] * bflo(p0[0]) + gA[1] * bflo(p1[0]) + gA[2] * bflo(p2[0]) + gA[3] * bflo(p3[0]);
        a[1] += gA[0] * bfhi(p0[0]) + gA[1] * bfhi(p1[0]) + gA[2] * bfhi(p2[0]) + gA[3] * bfhi(p3[0]);
        a[2] += gA[0] * bflo(p0[1]) + gA[1] * bflo(p1[1]) + gA[2] * bflo(p2[1]) + gA[3] * bflo(p3[1]);
        a[3] += gA[0] * bfhi(p0[1]) + gA[1] * bfhi(p1[1]) + gA[2] * bfhi(p2[1]) + gA[3] * bfhi(p3[1]);
        b[0] += gB[0] * bflo(q0[0]) + gB[1] * bflo(q1[0]) + gB[2] * bflo(q2[0]) + gB[3] * bflo(q3[0]);
        b[1] += gB[0] * bfhi(q0[0]) + gB[1] * bfhi(q1[0]) + gB[2] * bfhi(q2[0]) + gB[3] * bfhi(q3[0]);
        b[2] += gB[0] * bflo(q0[1]) + gB[1] * bflo(q1[1]) + gB[2] * bflo(q2[1]) + gB[3] * bflo(q3[1]);
        b[3] += gB[0] * bfhi(q0[1]) + gB[1] * bfhi(q1[1]) + gB[2] * bfhi(q2[1]) + gB[3] * bfhi(q3[1]);
        vA[j] = a; vB[j] = b; sA += a[0] * a[0] + a[1] * a[1] + a[2] * a[2] + a[3] * a[3]; sB += b[0] * b[0] + b[1] * b[1] + b[2] * b[2] + b[3] * b[3]; }
    sA = wave_sum(sA); sB = wave_sum(sB);
    const float rA = rsqrtf(sA * (1.0f / (float)DM) + EPS), rB = rsqrtf(sB * (1.0f / (float)DM) + EPS);
#pragma unroll
    for (int j = 0; j < 8; ++j) { const int d = (lane + 64 * j) * 4; const f32x4 gn = *(const f32x4*)(gain + d);
        *(f32x4*)(out + (size_t)tokA * DM + d) = vA[j] * rA * gn; *(f32x4*)(out + (size_t)tokB * DM + d) = vB[j] * rB * gn; }
}
#ifndef REP_P9
#define REP_P9 1
#endif
#ifndef REP_P3
#define REP_P3 1
#endif
#ifndef REP_FR
#define REP_FR 1
#endif
#ifndef REP_P0
#define REP_P0 1
#endif
#ifndef REP_CONV
#define REP_CONV 1
#endif
#ifndef REP_GEMM1
#define REP_GEMM1 1
#endif
#ifndef REP_HY
#define REP_HY 1
#endif
#ifndef REP_HG
#define REP_HG 1
#endif
#ifndef REP_MOEA
#define REP_MOEA 1
#endif
#ifndef REP_MOEB
#define REP_MOEB 1
#endif
#ifndef REP_WOUT
#define REP_WOUT 1
#endif
struct MegaP {
    const float *x, *norm_mix_gain, *w_in, *lb_logits, *hgrn_norm_gain, *hy_conv_w, *hy_conv_b, *fw1, *fb1, *fw2, *fb2, *fw3, *fb3, *fw4, *ffreq, *hy_bias, *hy_norm_gain, *w_out,
        *norm_ffn_gain, *w_router, *b_router, *moe_w1, *moe_b1, *moe_w2, *moe_b2, *final_gain;
    float* out; unsigned char* ws;
};
constexpr int MEGA_XB = RT_END;
constexpr int MEGA_LDS = RT_END + 64 + 384;
static_assert(MEGA_LDS >= HY_LDS + 64 && MEGA_LDS >= HG_LDS + 64 && MEGA_LDS >= GEMM_LDS + 64, "LDS");

__global__ void __launch_bounds__(512, 2) k_mega(const MegaP p_arg) {
    extern __shared__ __attribute__((aligned(16))) unsigned char shm[];
    LAS unsigned char* lds = (LAS unsigned char*)shm;
    const int tid = threadIdx.x, wid = __builtin_amdgcn_readfirstlane(tid >> 6), lane = tid & 63;
    const int G = gridDim.x, bid = blockIdx.x, c = xcd_logical(bid, G);
#define PHASE_ARGS() const MegaP __attribute__((address_space(4)))* pq_ = (const MegaP __attribute__((address_space(4)))*)__builtin_amdgcn_kernarg_segment_ptr(); asm volatile("" : "+s"(pq_)); unsigned char* ws = pq_->ws; (void)ws
    unsigned char* ws0; { PHASE_ARGS(); ws0 = ws; }
#define counts ((int*)(ws + WS_CTL))
#define cursor ((int*)(ws + WS_CTL + 4096))
#define offs ((int*)(ws + WS_CTL + 8192))
#define barw ((unsigned*)(ws + WS_CTL + 16384))
#define HB ((u16*)(ws + WS_HB))
#define PG ((u16*)(ws + WS_PG))
#define HYT ((u16*)(ws + WS_HYT))
#define MIXB ((u16*)(ws + WS_MIXB))
#define XNB ((u16*)(ws + WS_XNB))
#define HMB ((u16*)(ws + WS_HMS))
#define YB ((u16*)(ws + WS_YS))
#define H3 ((float*)(ws + WS_H3))
#define FR ((u16*)(ws + WS_FR))
#define Z2T ((u16*)(ws + WS_Z2T))
#define OF ((float*)(ws + WS_OF))
#define OB ((float*)(ws + WS_OB))
#define X1 ((float*)(ws + WS_X1))
#define TOPI ((int*)(ws + WS_TOPI))
#define TOPG ((float*)(ws + WS_TOPG))
#define STOK ((int*)(ws + WS_STOKS))
#define SOF ((int*)(ws + WS_SOF))
#define WINT ((u16*)(ws + WS_WINT))
#define WOUTT ((u16*)(ws + WS_WOUTT))
#define W1T ((u16*)(ws + WS_W1T))
#define W2T ((u16*)(ws + WS_W2T))
    if (tid == 0) *(LAS u32x4*)(lds + MEGA_XB) = (u32x4){0u, 0u, 0u, 0u};
    __syncthreads();
    XcdBarrier bar = xcd_barrier_post((unsigned*)(ws0 + WS_CTL + 16384), (volatile LAS unsigned*)(lds + MEGA_XB));

    {
        PHASE_ARGS();
    for (int rep = 0; rep < REP_P0; ++rep) {
    for (int row = bid * 8 + wid; row < NTOK; row += G * 8) rmsnorm_row_bf(pq_->x + (size_t)row * DM, pq_->norm_mix_gain, HB + (size_t)row * DM, lane);
    for (int m = bid * 8 + wid; m < SEQ; m += G * 8) h3_row(m, pq_->fw1, pq_->fb1, pq_->fw2, pq_->fb2, pq_->fw3, pq_->fb3, pq_->ffreq, (LAS float*)(lds + wid * 512), H3); }
    for (int rep = 0; rep < REP_CONV; ++rep)
    for (int id = bid; id < 1024 + 256; id += G) {
        const int tz = tid_fresh();
        if (id < 1024) { const int nt = id >> 5, kt = id & 31; convert_tile(pq_->w_in, DIN, kt * 64, ColMapPerm{nt * 256}, WINT + (size_t)id * 16384, tz); }
        else { const int q = id - 1024; const ConvCtx cw{nullptr, pq_->w_out, nullptr, (unsigned char*)WOUTT};
            f32x2 cv[16]; conv_issue(cw, 16384 + q, tz >> 6, tz & 63, cv); conv_finish(cw, 16384 + q, tz >> 6, tz & 63, cv); }
    }
    }
    xcd_barrier(bar);
    {
        PHASE_ARGS();
    for (int rep = 0; rep < REP_FR; ++rep)
    for (int item = bid; item < 256; item += G) frgen_item(lds, item, H3, pq_->fw4, FR);
    { SrcG1<false> s0{c, G, (const char*)HB, (const char*)WINT, PG, HYT, pq_->lb_logits}; gemm8_stream<false, false>(lds, DM, 32, s0);
      SrcG1<true> s1{c, G, (const char*)HB, (const char*)WINT, PG, HYT, pq_->lb_logits}; gemm8_stream<true, false>(lds, DM, 32, s1); }
#ifdef PROBE_NOEPI
    for (int u = c; u < 1024; u += G) {
        const int i = u >> 8, xx = (u >> 5) & 7, j = u & 31;
        const int mt = (xx & 3) * 8 + (j & 7), nt = ((xx >> 2) + 2 * i) * 4 + (j >> 3);
        const u16* bt = WINT + (size_t)nt * 32 * 16384;
        EpiNone e{}; if (nt < 20) gemm8_unit<false>(lds, HB, DM, nullptr, mt * 256, 256, bt, 32, e); else gemm8_unit<true>(lds, HB, DM, nullptr, mt * 256, 256, bt, 32, e);
    }
#endif
    }
    xcd_barrier(bar);
    {
        PHASE_ARGS();
    for (int rep = 0; rep < REP_HY; ++rep)
    for (int u = bid; u < 256; u += G) hyena_unit(lds, u, HYT, FR, pq_->hy_conv_w, pq_->hy_conv_b, pq_->hy_bias, Z2T, ConvCtx{pq_->moe_w1, pq_->moe_w2, (unsigned char*)W1T, (unsigned char*)W2T});
    for (int rep = 0; rep < REP_HG; ++rep)
    for (int u = bid; u < 256; u += G) hgrn_unit(lds, u, PG, pq_->lb_logits, OF, OB, ConvCtx{pq_->moe_w1, pq_->moe_w2, (unsigned char*)W1T, (unsigned char*)W2T});
    }
    xcd_barrier(bar);
    {
        PHASE_ARGS();
    for (int rep = 0; rep < REP_P3; ++rep) {
    for (int it = bid * 8 + wid; it < NTOK * HGH; it += G * 8 * 4) hgrn_final_item4(it, G * 8, OF, OB, PG, pq_->hgrn_norm_gain, MIXB, lane);
    for (int t = bid; t < NTOK / 32; t += G) hy_norm_tile(lds, t, Z2T, pq_->hy_norm_gain, MIXB); }
    }
    xcd_barrier(bar);
    {
        PHASE_ARGS();
    for (int u = c; u < 256; u += G) {
        const int xx = u >> 5, j = u & 31;
        const int mt = (xx >> 1) * 8 + (j & 7), nt = (xx & 1) * 4 + (j >> 3);
        Epi8X1 e{pq_->x, X1, mt * 256, nt * 256};
        gemm8_unit<false, true>(lds, MIXB, DM / 2, nullptr, mt * 256, 256, WOUTT + (size_t)nt * 16 * 16384, 16, e);
    }
    }
    xcd_barrier(bar);
    {
        PHASE_ARGS();
    if (tid < NE) *(LAS int*)(lds + RT_HIST + tid * 4) = 0;
    __syncthreads();
    for (int t0 = bid; t0 < NTOK / 16; t0 += 2 * G) {
        const int t1 = t0 + G, ntl = (t1 < NTOK / 16) ? 2 : 1;
        router_tile(lds, t0, X1, pq_->norm_ffn_gain, pq_->w_router, pq_->b_router, (unsigned char*)XNB, TOPG, 0);
        if (ntl == 2) router_tile(lds, t1, X1, pq_->norm_ffn_gain, pq_->w_router, pq_->b_router, (unsigned char*)XNB, TOPG, 1);
        const int tq = tid_fresh();
        if (tq < NE) { const int n = *(const LAS int*)(lds + RT_HIST + tq * 4); *(LAS int*)(lds + RT_RBASE + tq * 4) = n ? atomicAdd(&cursor[tq * 32], n) : 0; *(LAS int*)(lds + RT_HIST + tq * 4) = 0; }
        __syncthreads();
        if (tq < ntl * 64) { const int it = *(const LAS int*)(lds + RT_ITEMS + tq * 4), e = it >> 16, tok = ((tq >> 6) ? t1 : t0) * 16 + ((tq >> 2) & 15);
            const int slot = e * NTOK + *(const LAS int*)(lds + RT_RBASE + e * 4) + (it & 0xffff); STOK[slot] = tok; SOF[tok * 4 + (tq & 3)] = slot; }
        __syncthreads();
    }
    }
    xcd_barrier(bar);
    {
        PHASE_ARGS();
    {
        LAS int* us = (LAS int*)(lds + MEGA_XB + 64); LAS int* so2 = us + 40;
        if (tid < NE) so2[tid] = __hip_atomic_load(&cursor[tid * 32], __ATOMIC_RELAXED, __HIP_MEMORY_SCOPE_AGENT);
        __syncthreads();
        if (tid == 0) { int a = 0; for (int e = 0; e < NE; ++e) { us[e] = a; a += ((so2[e] + 255) >> 8) * 16; } us[NE] = a; }
        __syncthreads();
    }
    {
        LAS int* qs = (LAS int*)(lds + MEGA_XB + 32); LAS int* us = (LAS int*)(lds + MEGA_XB + 64); LAS int* so2 = us + 40;
        int* qctr = (int*)(ws + WS_CTL + 12288 + (bid & 7) * 128);
        int tk_next = 0;
        if (tid == 0) tk_next = atomicAdd(qctr, 1);
        for (;;) {
            if (tid == 0) { qs[0] = tk_next; qs[1] = -1; }
            __syncthreads();
            const int tk = qs[0];
            const int u = 256 * (tk >> 5) + 32 * (bid & 7) + (tk & 31);
            if (tid < NE) { const int u0 = us[tid], u1 = us[tid + 1]; if (u >= u0 && u < u1) { const int o0 = tid * NTOK, cnt = so2[tid], mtl = (cnt + 255) >> 8, ul = u - u0, mt = ul % mtl;
                int rows = cnt - mt * 256; rows = rows > 256 ? 256 : rows; qs[1] = tid; qs[2] = ul / mtl; qs[3] = o0 + mt * 256; qs[4] = rows; } }
            __syncthreads();
            const int e = qs[1], nt = qs[2], slot0 = qs[3], rows = qs[4];
            __syncthreads();
            if (e < 0) break;
            if (tid == 0) tk_next = atomicAdd(qctr, 1);
            Epi8Swiglu8 ep{(unsigned char*)HMB, pq_->moe_b1 + (size_t)e * 2 * DFF, slot0, nt, rows};
            gemm8_unit<false, true>(lds, XNB, DM / 2, STOK + slot0, 0, rows, W1T + (size_t)(e * 16 + nt) * 16 * 16384, 16, ep);
        }
    }
    }
    xcd_barrier(bar);
    {
        PHASE_ARGS();
    {
        LAS int* us = (LAS int*)(lds + MEGA_XB + 64); LAS int* so2 = us + 40;
        if (tid < NE) so2[tid] = __hip_atomic_load(&cursor[tid * 32], __ATOMIC_RELAXED, __HIP_MEMORY_SCOPE_AGENT);
        __syncthreads();
        if (tid == 0) { int a = 0; for (int e = 0; e < NE; ++e) { us[e] = a; a += ((so2[e] + 255) >> 8) * 8; } us[NE] = a; }
        __syncthreads();
    }
    {
        const LAS int* us = (const LAS int*)(lds + MEGA_XB + 64); const LAS int* so2 = us + 40;
        SrcMoeB src{us, so2, c, G, (const char*)HMB, (const char*)W2T, YB, pq_->moe_b2};
        gemm8_stream<false, true>(lds, DFF / 2, 16, src);
    }
    }
    xcd_barrier(bar);
    {
        PHASE_ARGS();
    for (int rep = 0; rep < REP_P9; ++rep)
    for (int tok = bid * 8 + wid; tok < NTOK; tok += G * 8) combine_row(tok, X1, YB, SOF, TOPG, pq_->final_gain, pq_->out, lane);
    }
}
#undef counts
#undef cursor
#undef offs
#undef barw
#undef HB
#undef PG
#undef HYT
#undef MIXB
#undef XNB
#undef HMB
#undef YB
#undef H3
#undef FR
#undef Z2T
#undef OF
#undef OB
#undef X1
#undef TOPI
#undef TOPG
#undef STOK
#undef SOF
#undef WINT
#undef WOUTT
#undef W1T
#undef W2T

extern "C" void kernel_launch(void* const* d_in, const int* in_sizes, int n_in, void* d_out, int out_size, void* d_ws, size_t ws_size, hipStream_t stream) {
    if (n_in < 26 || ws_size < WS_END2) return;
    MegaP p{};
    const float** pp = (const float**)&p;
    for (int i = 0; i < 26; ++i) pp[i] = (const float*)d_in[i];
    p.out = (float*)d_out; p.ws = (unsigned char*)d_ws;
    static int grid = 0;
    if (!grid) {
        int dev = 0, cus = 0, per_cu = 0;
        (void)hipGetDevice(&dev);
        (void)hipDeviceGetAttribute(&cus, hipDeviceAttributeMultiprocessorCount, dev);
        (void)hipFuncSetAttribute((const void*)k_mega, hipFuncAttributeMaxDynamicSharedMemorySize, MEGA_LDS);
        (void)hipOccupancyMaxActiveBlocksPerMultiprocessor(&per_cu, (const void*)k_mega, 512, MEGA_LDS);
        if (per_cu < 1) per_cu = 1;
        grid = cus * 1;
        if (grid > 256) grid = 256;
        grid &= ~7;
        if (grid < 8) grid = 8;
    }
    (void)hipMemsetAsync((char*)d_ws + WS_CTL, 0, 65536, stream);
    hipLaunchKernelGGL(k_mega, dim3(grid), dim3(512), MEGA_LDS, stream, p);
}
```

```cpp
#include <hip/hip_runtime.h>
#include <stdint.h>

constexpr int BATCH = 4, SEQ = 2048, DM = 2048, NTOK = BATCH * SEQ;
constexpr int HGW = 1024, HGD = 128, HGH = 8;
constexpr int HYW = 1024;
constexpr int DIN = 8192;
constexpr int NE = 32, TOPK = 4, DFF = 2048;
constexpr int NSLOT = NTOK * TOPK;
constexpr float EPS = 1e-5f;

constexpr size_t MB = 1024ull * 1024ull;
constexpr size_t WS_CTL = 0;
constexpr size_t WS_HB = 1 * MB;
constexpr size_t WS_PG = WS_HB + 32 * MB;
constexpr size_t WS_HYT = WS_PG + 80 * MB;
constexpr size_t WS_MIXB = WS_HYT + 48 * MB;
constexpr size_t WS_XNB = WS_MIXB + 32 * MB;
constexpr size_t WS_HMB = WS_XNB + 32 * MB;
constexpr size_t WS_YB = WS_HMB + 128 * MB;
constexpr size_t WS_H3 = WS_YB + 128 * MB;
constexpr size_t WS_FR = WS_H3 + 1 * MB;
constexpr size_t WS_Z2T = WS_FR + 34 * MB;
constexpr size_t WS_OF = WS_Z2T + 16 * MB;
constexpr size_t WS_OB = WS_OF + 32 * MB;
constexpr size_t WS_X1 = WS_OB + 32 * MB;
constexpr size_t WS_TOPI = WS_X1 + 64 * MB;
constexpr size_t WS_TOPG = WS_TOPI + 1 * MB;
constexpr size_t WS_STOK = WS_TOPG + 1 * MB;
constexpr size_t WS_SOF = WS_STOK + 1 * MB;
constexpr size_t WS_WINT = WS_SOF + 1 * MB;
constexpr size_t WS_WOUTT = WS_WINT + 32 * MB;
constexpr size_t WS_W1T = WS_WOUTT + 8 * MB;
constexpr size_t WS_W2T = WS_W1T + 512 * MB;
constexpr size_t WS_HMS = WS_W2T + 256 * MB;
constexpr size_t WS_YS = WS_HMS + 512 * MB;
constexpr size_t WS_STOKS = WS_YS + 1024 * MB;
constexpr size_t WS_END2 = WS_STOKS + 1 * MB;

typedef short bf16x8 __attribute__((ext_vector_type(8)));
typedef float f32x4 __attribute__((ext_vector_type(4)));
typedef float f32x2 __attribute__((ext_vector_type(2)));
typedef unsigned u32x4 __attribute__((ext_vector_type(4)));
typedef unsigned u32x2 __attribute__((ext_vector_type(2)));
typedef unsigned short u16;
#define LAS __attribute__((address_space(3)))

__device__ __forceinline__ unsigned pk_bf16(float lo, float hi) {
    typedef __bf16 bf2 __attribute__((ext_vector_type(2)));
    const f32x2 v = {lo, hi};
    const bf2 r = __builtin_convertvector(v, bf2);
    return __builtin_bit_cast(unsigned, r);
}
__device__ __forceinline__ float bf2f(u16 b) { return __uint_as_float(((unsigned)b) << 16); }
__device__ __forceinline__ float bflo(unsigned w) { return __uint_as_float(w << 16); }
__device__ __forceinline__ float bfhi(unsigned w) { return __uint_as_float(w & 0xffff0000u); }

__device__ __forceinline__ int lds_byte(int r, int c) { const int st = (r >> 4) * 2 + (c >> 5), ob = (r & 15) * 64 + (c & 31) * 2; return st * 1024 + (ob ^ (((ob >> 9) & 1) << 5)); }
__device__ __forceinline__ void stage_rc(int b, int& R, int& C) { const int st = b >> 10, sb = b & 1023, swz = sb ^ (((sb >> 9) & 1) << 5); R = (st >> 1) * 16 + swz / 64; C = (st & 1) * 32 + (swz % 64) / 2; }
__device__ __forceinline__ f32x4 unperm(const f32x4 a, const bool s) { f32x4 o; o[0] = s ? a[1] : a[0]; o[1] = s ? a[0] : a[1]; o[2] = s ? a[3] : a[2]; o[3] = s ? a[2] : a[3]; return o; }

__device__ __forceinline__ int tid_fresh() { int t = threadIdx.x; asm volatile("" : "+v"(t)); return t; }
constexpr int GEMM_LDS = 131072;

template <bool TRANS, bool RAGGED, int PM = 0, class ColMap, class Epi>
__device__ __forceinline__ void gemm_unit(LAS unsigned char* lds, const u16* __restrict__ A, int lda, const int* __restrict__ arows, int arow0, int rows_valid,
                                          const float* __restrict__ B, int ldb, int K, const ColMap colmap, const Epi epi) {
    const int tid = tid_fresh(), wid = __builtin_amdgcn_readfirstlane(tid >> 6), lane = tid & 63;
    const int wr = wid >> 2, wc = wid & 3, fr = lane & 15, fq = lane >> 4;
    const int nt = K >> 6;
    const char* ap[4];
#pragma unroll
    for (int i = 0; i < 4; ++i) {
        int R, C; stage_rc(wid * 1024 + i * 8192 + lane * 16, R, C);
        const int rr = RAGGED ? (R < rows_valid ? R : rows_valid - 1) : R;
        const long rowid = arows ? (long)arows[rr] : (long)(arow0 + rr);
        ap[i] = (const char*)A + ((size_t)rowid * lda + C) * 2;
    }
    const int g = (lane & 3) + 4 * (wid >> 2), rg = (wid & 3) * 16 + (lane >> 2);
    const unsigned bvoff = (unsigned)(((size_t)(8 * g) * ldb + colmap(rg)) * 4);
    const int bbase = 65536 + lds_byte(4 * rg, 8 * g);
    const int bw0 = bbase + ((rg & 1) ? 64 : 0), bw1 = bbase + ((rg & 1) ? 0 : 64);
    const int aoff = lds_byte(wr * 128 + fr, fq * 8), boff = 65536 + lds_byte(wc * 64 + fr, fq * 8);
    int mvalid = 8;
    if (RAGGED) { mvalid = (rows_valid - wr * 128 + 15) >> 4; mvalid = mvalid < 0 ? 0 : (mvalid > 8 ? 8 : mvalid); }
    f32x4 vb0, vb1, vb2, vb3, vb4, vb5, vb6, vb7;
    if (PM & 1) { vb0 = (f32x4){1.f, 1.f, 1.f, 1.f}; vb1 = vb0; vb2 = vb0; vb3 = vb0; vb4 = vb0; vb5 = vb0; vb6 = vb0; vb7 = vb0; }
    f32x4 acc[8][4];
#pragma unroll
    for (int m = 0; m < 8; ++m)
#pragma unroll
        for (int n = 0; n < 4; ++n) acc[m][n] = (f32x4){0.f, 0.f, 0.f, 0.f};
    const size_t ldb4 = (size_t)ldb * 4;
#define GE_GLDS_A(buf, kt) do { if (!(PM & 2)) _Pragma("unroll") for (int _i = 0; _i < 4; ++_i) \
        __builtin_amdgcn_global_load_lds((const unsigned*)(ap[_i] + (size_t)(kt) * 128), (LAS unsigned*)(lds + (buf) * 32768 + wid * 1024 + _i * 8192), 16, 0, 0); } while (0)
#define GE_LD1(dst, sb) if (!(PM & 1)) asm volatile("global_load_dwordx4 %0, %1, %2" : "=v"(dst) : "v"(bvoff), "s"(sb) : "memory")
#define GE_LOAD_B(kt) do { const char* _sb = (const char*)B + (size_t)(kt) * 64 * ldb4; \
        GE_LD1(vb0, _sb); GE_LD1(vb1, _sb + ldb4); GE_LD1(vb2, _sb + 2 * ldb4); GE_LD1(vb3, _sb + 3 * ldb4); \
        GE_LD1(vb4, _sb + 4 * ldb4); GE_LD1(vb5, _sb + 5 * ldb4); GE_LD1(vb6, _sb + 6 * ldb4); GE_LD1(vb7, _sb + 7 * ldb4); } while (0)
#define GE_WAITV_B(n) asm volatile("s_waitcnt vmcnt(" #n ")" : "+v"(vb0), "+v"(vb1), "+v"(vb2), "+v"(vb3), "+v"(vb4), "+v"(vb5), "+v"(vb6), "+v"(vb7) :: "memory")
#define GE_WRITE_B(buf) do { _Pragma("unroll") for (int _i = 0; _i < 4; ++_i) { u32x4 _w; _w[0] = pk_bf16(vb0[_i], vb1[_i]); _w[1] = pk_bf16(vb2[_i], vb3[_i]); \
        _w[2] = pk_bf16(vb4[_i], vb5[_i]); _w[3] = pk_bf16(vb6[_i], vb7[_i]); \
        *(LAS u32x4*)(lds + ((_i & 1) ? bw1 : bw0) + (_i >> 1) * 128 + (buf) * 32768) = _w; } } while (0)
#define GE_KSTEP(buf, ks) do { bf16x8 Bf[4]; \
        _Pragma("unroll") for (int n = 0; n < 4; ++n) Bf[n] = *(const LAS bf16x8*)(lds + (buf) * 32768 + boff + n * 2048 + (ks) * 1024); \
        _Pragma("unroll") for (int mh = 0; mh < 2; ++mh) { bf16x8 At[4]; \
            _Pragma("unroll") for (int m = 0; m < 4; ++m) At[m] = *(const LAS bf16x8*)(lds + (buf) * 32768 + aoff + (mh * 4 + m) * 2048 + (ks) * 1024); \
            _Pragma("unroll") for (int m = 0; m < 4; ++m) { if (!RAGGED || (mh * 4 + m) < mvalid) { _Pragma("unroll") for (int n = 0; n < 4; ++n) \
                { if (PM & 4) { asm volatile("" :: "v"(At[m]), "v"(Bf[n])); } else acc[mh * 4 + m][n] = TRANS ? __builtin_amdgcn_mfma_f32_16x16x32_bf16(At[m], Bf[n], acc[mh * 4 + m][n], 0, 0, 0) : __builtin_amdgcn_mfma_f32_16x16x32_bf16(Bf[n], At[m], acc[mh * 4 + m][n], 0, 0, 0); } } } } } while (0)
    GE_GLDS_A(0, 0);
    GE_LOAD_B(0);
    GE_WAITV_B(0);
    GE_WRITE_B(0);
    GE_LOAD_B(1);
    asm volatile("s_waitcnt lgkmcnt(0)" ::: "memory");
    __builtin_amdgcn_s_barrier();
    int t = 0;
    for (; t < nt - 2; ++t) {
        const int cur = t & 1;
        GE_GLDS_A(cur ^ 1, t + 1);
        GE_KSTEP(cur, 0);
        GE_WAITV_B(4);
        GE_WRITE_B(cur ^ 1);
        GE_LOAD_B(t + 2);
        __builtin_amdgcn_sched_barrier(0);
        GE_KSTEP(cur, 1);
        asm volatile("s_waitcnt vmcnt(8) lgkmcnt(0)" ::: "memory");
        __builtin_amdgcn_s_barrier();
    }
    {
        const int cur = t & 1;
        GE_GLDS_A(cur ^ 1, t + 1);
        GE_KSTEP(cur, 0);
        GE_WAITV_B(4);
        GE_WRITE_B(cur ^ 1);
        GE_KSTEP(cur, 1);
        asm volatile("s_waitcnt vmcnt(0) lgkmcnt(0)" ::: "memory");
        __builtin_amdgcn_s_barrier();
        ++t;
    }
    {
        const int cur = t & 1;
        GE_KSTEP(cur, 0);
        GE_KSTEP(cur, 1);
        asm volatile("s_waitcnt lgkmcnt(0)" ::: "memory");
        __builtin_amdgcn_s_barrier();
    }
#undef GE_GLDS_A
#undef GE_LD1
#undef GE_LOAD_B
#undef GE_WAITV_B
#undef GE_WRITE_B
#undef GE_KSTEP
    __builtin_amdgcn_sched_barrier(0);
    { const int tz = tid_fresh(), wz = __builtin_amdgcn_readfirstlane(tz >> 6), lz = tz & 63;
      epi(acc, wz >> 2, wz & 3, lz & 15, lz >> 4); }
}

__device__ __forceinline__ int xcd_logical(int b, int G) { return (G & 7) ? b : (b & 7) * (G >> 3) + (b >> 3); }

struct ColMapDense { int c0; __device__ __forceinline__ int operator()(int rg) const { return c0 + 4 * rg; } };
struct EpiPG { u16* PG; int tok0, col0;
    __device__ __forceinline__ void operator()(const f32x4 (&acc)[8][4], int wr, int wc, int fr, int fq) const {
#pragma unroll
        for (int m = 0; m < 8; ++m) { u16* rowp = PG + (size_t)(tok0 + wr * 128 + m * 16 + fr) * 5120 + col0 + wc * 64 + 4 * fq;
#pragma unroll
            for (int n = 0; n < 4; ++n) { const f32x4 v = unperm(acc[m][n], fq & 1); u32x2 w; w[0] = pk_bf16(v[0], v[1]); w[1] = pk_bf16(v[2], v[3]); *(u32x2*)(rowp + n * 16) = w; } }
    } };
struct EpiHYT { u16* HYT; int tok0, col0;
    __device__ __forceinline__ void operator()(const f32x4 (&acc)[8][4], int wr, int wc, int fr, int fq) const {
#pragma unroll
        for (int n = 0; n < 4; ++n) { const int rho = wc * 64 + n * 16 + fr; const int col = col0 + (rho & ~3) + ((rho & 3) ^ ((rho >> 2) & 1));
            u16* colp = HYT + (size_t)col * NTOK + tok0 + wr * 128 + 4 * fq;
#pragma unroll
            for (int m = 0; m < 8; ++m) { const f32x4 v = acc[m][n]; u32x2 w; w[0] = pk_bf16(v[0], v[1]); w[1] = pk_bf16(v[2], v[3]); *(u32x2*)(colp + m * 16) = w; } }
    } };
struct EpiX1 { const float* x; float* X1; int tok0, col0;
    __device__ __forceinline__ void operator()(const f32x4 (&acc)[8][4], int wr, int wc, int fr, int fq) const {
#pragma unroll
        for (int m = 0; m < 8; ++m) { const size_t off = (size_t)(tok0 + wr * 128 + m * 16 + fr) * DM + col0 + wc * 64 + 4 * fq;
#pragma unroll
            for (int n = 0; n < 4; ++n) { const f32x4 r = *(const f32x4*)(x + off + n * 16); *(f32x4*)(X1 + off + n * 16) = r + unperm(acc[m][n], fq & 1); }
            asm volatile("" ::: "memory"); }
    } };
struct ColMapGlu { int nt; __device__ __forceinline__ int operator()(int rg) const { const int wcq = rg >> 4, n = (rg >> 2) & 3, f = rg & 3; return (n >> 1) * 2048 + nt * 128 + wcq * 32 + (n & 1) * 16 + f * 4; } };
struct EpiSwiglu { u16* HM; const float* b1; int slot0, nt, rows_valid;
    __device__ __forceinline__ void operator()(const f32x4 (&acc)[8][4], int wr, int wc, int fr, int fq) const {
        f32x4 bg[2], bl[2];
#pragma unroll
        for (int nn = 0; nn < 2; ++nn) { const int col = nt * 128 + wc * 32 + nn * 16 + 4 * fq; bg[nn] = *(const f32x4*)(b1 + col); bl[nn] = *(const f32x4*)(b1 + 2048 + col); }
#pragma unroll
        for (int m = 0; m < 8; ++m) { const int row = wr * 128 + m * 16 + fr;
            if (row < rows_valid) {
#pragma unroll
                for (int nn = 0; nn < 2; ++nn) { const f32x4 gl = unperm(acc[m][nn], fq & 1) + bg[nn], li = unperm(acc[m][nn + 2], fq & 1) + bl[nn]; float o[4];
#pragma unroll
                    for (int j = 0; j < 4; ++j) { const float gq = fminf(gl[j], 7.0f), lq = fminf(fmaxf(li[j], -7.0f), 7.0f); o[j] = gq * (1.0f / (1.0f + __expf(-1.702f * gq))) * (lq + 1.0f); }
                    u32x2 w; w[0] = pk_bf16(o[0], o[1]); w[1] = pk_bf16(o[2], o[3]);
                    *(u32x2*)(HM + (size_t)(slot0 + row) * DFF + nt * 128 + wc * 32 + nn * 16 + 4 * fq) = w; } } }
    } };
struct EpiY { u16* Y; const float* b2; int slot0, col0, rows_valid;
    __device__ __forceinline__ void operator()(const f32x4 (&acc)[8][4], int wr, int wc, int fr, int fq) const {
        f32x4 bv[4];
#pragma unroll
        for (int n = 0; n < 4; ++n) bv[n] = *(const f32x4*)(b2 + col0 + wc * 64 + n * 16 + 4 * fq);
#pragma unroll
        for (int m = 0; m < 8; ++m) { const int row = wr * 128 + m * 16 + fr;
            if (row < rows_valid) { u16* rowp = Y + (size_t)(slot0 + row) * DM + col0 + wc * 64 + 4 * fq;
#pragma unroll
                for (int n = 0; n < 4; ++n) { const f32x4 v = unperm(acc[m][n], fq & 1) + bv[n]; u32x2 w; w[0] = pk_bf16(v[0], v[1]); w[1] = pk_bf16(v[2], v[3]); *(u32x2*)(rowp + n * 16) = w; } } }
    } };
template <int NTILES>
__device__ __forceinline__ bool moe_decode(const int* __restrict__ offs, int u, int& e, int& mt, int& nt, int& slot0, int& rows) {
    int base = 0;
    for (int q = 0; q < NE; ++q) { const int o0 = offs[q], cnt = offs[q + 1] - o0, mtl = (cnt + 255) >> 8, nu = mtl * NTILES;
        if (u < base + nu) { const int ul = u - base; e = q; mt = ul % mtl; nt = ul / mtl; slot0 = o0 + mt * 256; rows = cnt - mt * 256; if (rows > 256) rows = 256; return true; }
        base += nu; }
    return false;
}


__device__ __forceinline__ int perm_col4(int rg) { const int rgl = rg & 31, t = rgl & 7; return 32 * (rgl >> 3) + 8 * (t & 3) + 4 * (t >> 2); }
__device__ __forceinline__ int perm32(int rho) { const int n = rho >> 4, i = rho & 15; return 8 * (i >> 2) + 4 * n + (i & 3); }
template <class ColMap>
__device__ __forceinline__ void convert_tile(const float* __restrict__ W, int ldb, int k0, const ColMap colmap, u16* __restrict__ dst, int tid) {
    const int wid = tid >> 6, lane = tid & 63;
    const int g = (lane & 3) + 4 * (wid >> 2), rg = (wid & 3) * 16 + (lane >> 2);
    const float* bp = W + (size_t)(k0 + 8 * g) * ldb + colmap(rg);
    f32x4 v[8];
#pragma unroll
    for (int kk = 0; kk < 8; ++kk) v[kk] = __builtin_nontemporal_load((const f32x4*)(bp + (size_t)kk * ldb));
    const int h = rg >> 5, r0 = (4 * rg) & 127;
    unsigned char* base = (unsigned char*)dst + h * 16384 + lds_byte(r0, 8 * g);
#pragma unroll
    for (int i = 0; i < 4; ++i) { u32x4 w; w[0] = pk_bf16(v[0][i], v[1][i]); w[1] = pk_bf16(v[2][i], v[3][i]); w[2] = pk_bf16(v[4][i], v[5][i]); w[3] = pk_bf16(v[6][i], v[7][i]);
        *(u32x4*)(base + i * 64) = w; }
}
typedef int i32x8 __attribute__((ext_vector_type(8)));
typedef int i32x4 __attribute__((ext_vector_type(4)));
constexpr float W8_SCALE = 32.0f;
constexpr int W8_MX = 0x7A7A7A7A;
constexpr int A8_MX = 0x7F7F7F7F;
__device__ __forceinline__ unsigned pk_fp8x4(float a, float b, float c, float d) { int p = __builtin_amdgcn_cvt_pk_fp8_f32(a, b, 0, false); p = __builtin_amdgcn_cvt_pk_fp8_f32(c, d, p, true); return (unsigned)p; }
__device__ __forceinline__ int lds_byte_b(int r, int cb) { const int st = (r >> 4) * 2 + (cb >> 6), ob = (r & 15) * 64 + (cb & 63); return st * 1024 + (ob ^ (((ob >> 9) & 1) << 5)); }
struct ConvCtx { const float* w1; const float* w2; unsigned char* W1T; unsigned char* W2T; };
__device__ __forceinline__ int conv_seq2tile(int s) {
    if (s < 16384) return (s >> 9) * 512 + (s & 15) * 32 + ((s >> 4) & 31);
    const int q = s - 16384; return 16384 + (q >> 8) * 256 + (q & 7) * 32 + ((q >> 3) & 31);
}
__device__ __forceinline__ void conv_issue(const ConvCtx& cc, int m, int wid, int lane, f32x2 (&v)[16]) {
    const int rp = 16 * wid + (lane & 15), rg = rp >> 1, p2 = (rp & 1) * 2, kg = lane >> 4;
    const float* bp; size_t ld;
    if (m < 16384) { const int e = m >> 9, nt = (m >> 5) & 15, kt = m & 31; ld = 2 * DFF; bp = cc.w1 + (size_t)e * DM * 2 * DFF + (size_t)(kt * 64 + 16 * kg) * ld + (rg >> 5) * 2048 + nt * 128 + perm_col4(rg) + p2; }
    else { const int q = m - 16384, e = q >> 8, nt = (q >> 5) & 7, kt = q & 31; ld = DM; bp = cc.w2 + (size_t)e * DFF * DM + (size_t)(kt * 64 + 16 * kg) * ld + nt * 256 + (rg >> 5) * 128 + perm_col4(rg) + p2; }
#pragma unroll
    for (int kk = 0; kk < 16; ++kk) v[kk] = __builtin_nontemporal_load((const f32x2*)(bp + (size_t)kk * ld));
}
__device__ __forceinline__ void conv_finish(const ConvCtx& cc, int m, int wid, int lane, const f32x2 (&v)[16]) {
    const int rp = 16 * wid + (lane & 15), kg = lane >> 4;
    const int kt64 = m & 31;
    unsigned char* dst = (m < 16384) ? cc.W1T + ((size_t)(m >> 5) * 16 + (kt64 >> 1)) * 32768 : cc.W2T + ((size_t)((m - 16384) >> 5) * 16 + (kt64 >> 1)) * 32768;
    unsigned char* base = dst + (rp >> 6) * 16384 + lds_byte_b((2 * rp) & 127, (kt64 & 1) * 64 + 16 * kg);
#pragma unroll
    for (int i = 0; i < 2; ++i) { u32x4 w;
#pragma unroll
        for (int q = 0; q < 4; ++q) w[q] = pk_fp8x4(v[4 * q][i] * W8_SCALE, v[4 * q + 1][i] * W8_SCALE, v[4 * q + 2][i] * W8_SCALE, v[4 * q + 3][i] * W8_SCALE);
        __builtin_nontemporal_store(w, (u32x4*)(base + i * 64)); }
}
struct ColMapGluT { int nt; __device__ __forceinline__ int operator()(int rg) const { return (rg >> 5) * 2048 + nt * 128 + perm_col4(rg); } };
struct ColMapPerm { int c0; __device__ __forceinline__ int operator()(int rg) const { return c0 + (rg >> 5) * 128 + perm_col4(rg); } };

template <bool TRANS, bool FP8 = false, class Epi>
__device__ __forceinline__ void gemm8_unit(LAS unsigned char* lds, const u16* __restrict__ A, int lda, const int* __restrict__ arows, int arow0, int rows_valid, const u16* __restrict__ Bt, int nt, const Epi epi) {
    const int tid = tid_fresh(), wid = __builtin_amdgcn_readfirstlane(tid >> 6), lane = tid & 63;
    const int wr = wid >> 2, wc = wid & 3, fr = lane & 15, fq = lane >> 4;
    unsigned aof[2][2];
#pragma unroll
    for (int h = 0; h < 2; ++h)
#pragma unroll
        for (int i = 0; i < 2; ++i) { int R, C; stage_rc(tid * 16 + i * 8192, R, C); int rr = h * 128 + R; rr = rr < rows_valid ? rr : rows_valid - 1;
            const unsigned rowid = arows ? (unsigned)arows[rr] : (unsigned)(arow0 + rr); aof[h][i] = (rowid * (unsigned)lda + (unsigned)C) * 2u; }
    const char* Ab = (const char*)A; const char* Bb = (const char*)Bt + tid * 16;
    const bool hi = rows_valid > 128;
    int mxw = W8_MX, mxa = A8_MX; asm volatile("" : "+v"(mxw), "+v"(mxa));
#define G8_SA(b, h) (((b) * 2 + (h)) * 16384)
#define G8_SB(b, h) (65536 + ((b) * 2 + (h)) * 16384)
#define G8_STA(b, h, kt) do { _Pragma("unroll") for (int _i = 0; _i < 2; ++_i) \
        __builtin_amdgcn_global_load_lds((const unsigned*)(Ab + aof[h][_i] + (size_t)(kt) * 128), (LAS unsigned*)(lds + G8_SA(b, h) + wid * 1024 + _i * 8192), 16, 0, 0); } while (0)
#define G8_STB(b, h, kt) do { _Pragma("unroll") for (int _i = 0; _i < 2; ++_i) \
        __builtin_amdgcn_global_load_lds((const unsigned*)(Bb + (size_t)(kt) * 32768 + (h) * 16384 + _i * 8192), (LAS unsigned*)(lds + G8_SB(b, h) + wid * 1024 + _i * 8192), 16, 0, 0); } while (0)
#define G8_LDA(dst, b, h) do { _Pragma("unroll") for (int m = 0; m < 4; ++m) _Pragma("unroll") for (int k = 0; k < 2; ++k) dst[m][k] = *(const LAS bf16x8*)(lds + G8_SA(b, h) + aoff + m * 2048 + k * 1024); } while (0)
#define G8_LDB(dst, b, h) do { _Pragma("unroll") for (int n = 0; n < 2; ++n) _Pragma("unroll") for (int k = 0; k < 2; ++k) dst[n][k] = *(const LAS bf16x8*)(lds + G8_SB(b, h) + boff + n * 2048 + k * 1024); } while (0)
#define G8_MMA(ai, bj, At, Bq) do { if ((ai) == 0 || hi) { __builtin_amdgcn_s_setprio(1); _Pragma("unroll") for (int m = 0; m < 4; ++m) _Pragma("unroll") for (int n = 0; n < 2; ++n) { \
        if (FP8) { const i32x4 a0 = __builtin_bit_cast(i32x4, At[m][0]), a1 = __builtin_bit_cast(i32x4, At[m][1]), b0 = __builtin_bit_cast(i32x4, Bq[n][0]), b1 = __builtin_bit_cast(i32x4, Bq[n][1]); \
            const i32x8 a8 = __builtin_shufflevector(a0, a1, 0, 1, 2, 3, 4, 5, 6, 7), b8 = __builtin_shufflevector(b0, b1, 0, 1, 2, 3, 4, 5, 6, 7); \
            asm volatile("v_mfma_scale_f32_16x16x128_f8f6f4 %0, %1, %2, %0, %3, %4 op_sel_hi:[0,0,0]" : "+v"(acc[ai][bj][m][n]) : "v"(b8), "v"(a8), "v"(mxw), "v"(mxa)); } \
        else { _Pragma("unroll") for (int k = 0; k < 2; ++k) \
            acc[ai][bj][m][n] = TRANS ? __builtin_amdgcn_mfma_f32_16x16x32_bf16(At[m][k], Bq[n][k], acc[ai][bj][m][n], 0, 0, 0) : __builtin_amdgcn_mfma_f32_16x16x32_bf16(Bq[n][k], At[m][k], acc[ai][bj][m][n], 0, 0, 0); } } \
        __builtin_amdgcn_s_setprio(0); } } while (0)
#define G8_WV(n) asm volatile("s_waitcnt vmcnt(" #n ")" ::: "memory")
#define G8_WL(n) asm volatile("s_waitcnt lgkmcnt(" #n ")" ::: "memory")
#define G8_BAR __builtin_amdgcn_s_barrier()
#define G8_SCHED __builtin_amdgcn_sched_barrier(0)
    const int aoff = lds_byte(wr * 64 + fr, fq * 8), boff = lds_byte(wc * 32 + fr, fq * 8);
    f32x4 acc[2][2][4][2];
#pragma unroll
    for (int a = 0; a < 2; ++a)
#pragma unroll
        for (int b = 0; b < 2; ++b)
#pragma unroll
            for (int m = 0; m < 4; ++m)
#pragma unroll
                for (int n = 0; n < 2; ++n) acc[a][b][m][n] = (f32x4){0.f, 0.f, 0.f, 0.f};
    bf16x8 At[4][2], B0[2][2], B1[2][2];
    G8_STB(0, 0, 0); G8_STA(0, 0, 0); G8_STB(0, 1, 0); G8_STA(0, 1, 0);
    if (wr == 1) G8_BAR;
    G8_WV(4); G8_BAR;
    G8_STB(1, 0, 1); G8_STA(1, 0, 1); G8_STB(1, 1, 1);
    G8_WV(6); G8_BAR;
    for (int t = 0; t < nt - 2; t += 2) {
        G8_LDB(B0, 0, 0); G8_SCHED; G8_LDA(At, 0, 0); G8_STA(1, 1, t + 1);
        G8_WL(8); G8_BAR; G8_WL(0); G8_MMA(0, 0, At, B0); G8_BAR; G8_SCHED;
        G8_LDB(B1, 0, 1); G8_STB(0, 0, t + 2);
        G8_BAR; G8_WL(0); G8_MMA(0, 1, At, B1); G8_BAR;
        if (hi) G8_LDA(At, 0, 1); G8_STA(0, 0, t + 2);
        G8_BAR; G8_WL(0); G8_MMA(1, 0, At, B0); G8_BAR; G8_SCHED;
        G8_STB(0, 1, t + 2);
        G8_WV(6); G8_BAR; G8_MMA(1, 1, At, B1); G8_BAR;
        G8_LDB(B0, 1, 0); G8_SCHED; G8_LDA(At, 1, 0); G8_STA(0, 1, t + 2);
        G8_WL(8); G8_BAR; G8_WL(0); G8_MMA(0, 0, At, B0); G8_BAR; G8_SCHED;
        G8_LDB(B1, 1, 1); G8_STB(1, 0, t + 3);
        G8_BAR; G8_WL(0); G8_MMA(0, 1, At, B1); G8_BAR;
        if (hi) G8_LDA(At, 1, 1); G8_STA(1, 0, t + 3);
        G8_BAR; G8_WL(0); G8_MMA(1, 0, At, B0); G8_BAR; G8_SCHED;
        G8_STB(1, 1, t + 3);
        G8_WV(6); G8_BAR; G8_MMA(1, 1, At, B1); G8_BAR;
    }
    { G8_LDB(B0, 0, 0); G8_WV(0); G8_LDA(At, 0, 0); G8_STA(1, 1, nt - 1);
      G8_BAR; G8_WL(0); G8_MMA(0, 0, At, B0); G8_BAR;
      G8_LDB(B1, 0, 1); G8_BAR; G8_WL(0); G8_MMA(0, 1, At, B1); G8_BAR;
      G8_LDA(At, 0, 1); G8_WV(4); G8_BAR; G8_WL(0); G8_MMA(1, 0, At, B0); G8_MMA(1, 1, At, B1); G8_BAR; }
    { G8_LDB(B0, 1, 0); G8_LDA(At, 1, 0); G8_WV(2); G8_BAR; G8_WL(0); G8_MMA(0, 0, At, B0); G8_BAR;
      G8_LDB(B1, 1, 1); G8_WV(0); G8_BAR; G8_WL(0); G8_MMA(0, 1, At, B1); G8_BAR;
      G8_LDA(At, 1, 1); G8_BAR; G8_WL(0); G8_MMA(1, 0, At, B0); G8_MMA(1, 1, At, B1); G8_BAR; }
    if (wr == 0) G8_BAR;
#undef G8_SA
#undef G8_SB
#undef G8_STA
#undef G8_STB
#undef G8_LDA
#undef G8_LDB
#undef G8_MMA
#undef G8_WV
#undef G8_WL
#undef G8_BAR
#undef G8_SCHED
    __builtin_amdgcn_sched_barrier(0);
    { const int tz = tid_fresh(), wz = __builtin_amdgcn_readfirstlane(tz >> 6), lz = tz & 63;
      epi(acc, wz >> 2, wz & 3, lz & 15, lz >> 4); }
}
struct StreamUnit { const char* A; const char* Bt; int arow0, rows, a, b, c; };
template <bool TRANS, bool FP8, class Src>
__device__ __forceinline__ void gemm8_stream(LAS unsigned char* lds, unsigned lda, int nt, const Src& src) {
    const int tid = tid_fresh(), wid = __builtin_amdgcn_readfirstlane(tid >> 6), lane = tid & 63;
    const int wr = wid >> 2, wc = wid & 3, fr = lane & 15, fq = lane >> 4;
    StreamUnit cur, nxt;
    if (!src.get(0, cur)) return;
    int R0, C0, R1, C1; stage_rc(tid * 16, R0, C0); stage_rc(tid * 16 + 8192, R1, C1);
    int mxw = W8_MX, mxa = A8_MX; asm volatile("" : "+v"(mxw), "+v"(mxa));
    const int aoff = lds_byte(wr * 64 + fr, fq * 8), boff = lds_byte(wc * 32 + fr, fq * 8);
#define GS_AOF(u, h, R, C) ((unsigned)(((unsigned)((u).arow0 + (((h) * 128 + (R)) < (u).rows ? ((h) * 128 + (R)) : (u).rows - 1)) * lda + (unsigned)(C)) * 2u))
    unsigned ac00 = GS_AOF(cur, 0, R0, C0), ac01 = GS_AOF(cur, 0, R1, C1), ac10 = GS_AOF(cur, 1, R0, C0), ac11 = GS_AOF(cur, 1, R1, C1);
#define GS_SA(b, h) (((b) * 2 + (h)) * 16384)
#define GS_SB(b, h) (65536 + ((b) * 2 + (h)) * 16384)
#define GS_GL(src_, dst_) __builtin_amdgcn_global_load_lds((const unsigned*)(src_), (LAS unsigned*)(lds + (dst_)), 16, 0, 0)
#define GS_STA(b, h, base, o0, o1, kt) do { GS_GL((base) + (o0) + (size_t)(kt) * 128, GS_SA(b, h) + wid * 1024); GS_GL((base) + (o1) + (size_t)(kt) * 128, GS_SA(b, h) + wid * 1024 + 8192); } while (0)
#define GS_STB(b, h, base, kt) do { GS_GL((base) + tid * 16 + (size_t)(kt) * 32768 + (h) * 16384, GS_SB(b, h) + wid * 1024); GS_GL((base) + tid * 16 + (size_t)(kt) * 32768 + (h) * 16384 + 8192, GS_SB(b, h) + wid * 1024 + 8192); } while (0)
#define GS_LDA(dst, b, h) do { _Pragma("unroll") for (int m = 0; m < 4; ++m) _Pragma("unroll") for (int k = 0; k < 2; ++k) dst[m][k] = *(const LAS bf16x8*)(lds + GS_SA(b, h) + aoff + m * 2048 + k * 1024); } while (0)
#define GS_LDB(dst, b, h) do { _Pragma("unroll") for (int n = 0; n < 2; ++n) _Pragma("unroll") for (int k = 0; k < 2; ++k) dst[n][k] = *(const LAS bf16x8*)(lds + GS_SB(b, h) + boff + n * 2048 + k * 1024); } while (0)
#define GS_MMA(ai, bj, At, Bq) do { if ((ai) == 0 || hi) { __builtin_amdgcn_s_setprio(1); _Pragma("unroll") for (int m = 0; m < 4; ++m) _Pragma("unroll") for (int n = 0; n < 2; ++n) { \
        if (FP8) { const i32x4 a0 = __builtin_bit_cast(i32x4, At[m][0]), a1 = __builtin_bit_cast(i32x4, At[m][1]), b0 = __builtin_bit_cast(i32x4, Bq[n][0]), b1 = __builtin_bit_cast(i32x4, Bq[n][1]); \
            const i32x8 a8 = __builtin_shufflevector(a0, a1, 0, 1, 2, 3, 4, 5, 6, 7), b8 = __builtin_shufflevector(b0, b1, 0, 1, 2, 3, 4, 5, 6, 7); \
            asm volatile("v_mfma_scale_f32_16x16x128_f8f6f4 %0, %1, %2, %0, %3, %4 op_sel_hi:[0,0,0]" : "+v"(acc[ai][bj][m][n]) : "v"(b8), "v"(a8), "v"(mxw), "v"(mxa)); } \
        else { _Pragma("unroll") for (int k = 0; k < 2; ++k) \
            acc[ai][bj][m][n] = TRANS ? __builtin_amdgcn_mfma_f32_16x16x32_bf16(At[m][k], Bq[n][k], acc[ai][bj][m][n], 0, 0, 0) : __builtin_amdgcn_mfma_f32_16x16x32_bf16(Bq[n][k], At[m][k], acc[ai][bj][m][n], 0, 0, 0); } } \
        __builtin_amdgcn_s_setprio(0); } } while (0)
#define GS_WV(n) asm volatile("s_waitcnt vmcnt(" #n ")" ::: "memory")
#define GS_WL(n) asm volatile("s_waitcnt lgkmcnt(" #n ")" ::: "memory")
#define GS_BAR __builtin_amdgcn_s_barrier()
#define GS_SCHED __builtin_amdgcn_sched_barrier(0)
    f32x4 acc[2][2][4][2];
#pragma unroll
    for (int a = 0; a < 2; ++a)
#pragma unroll
        for (int b = 0; b < 2; ++b)
#pragma unroll
            for (int m = 0; m < 4; ++m)
#pragma unroll
                for (int n = 0; n < 2; ++n) acc[a][b][m][n] = (f32x4){0.f, 0.f, 0.f, 0.f};
    bf16x8 At[4][2], B0[2][2], B1[2][2];
    GS_STB(0, 0, cur.Bt, 0); GS_STA(0, 0, cur.A, ac00, ac01, 0); GS_STB(0, 1, cur.Bt, 0); GS_STA(0, 1, cur.A, ac10, ac11, 0);
    if (wr == 1) GS_BAR;
    GS_WV(4); GS_BAR;
    GS_STB(1, 0, cur.Bt, 1); GS_STA(1, 0, cur.A, ac00, ac01, 1); GS_STB(1, 1, cur.Bt, 1);
    GS_WV(6); GS_BAR;
    for (int ui = 0;; ++ui) {
        const bool has_next = src.get(ui + 1, nxt);
        if (!has_next) nxt = cur;
        const unsigned an00 = GS_AOF(nxt, 0, R0, C0), an01 = GS_AOF(nxt, 0, R1, C1), an10 = GS_AOF(nxt, 1, R0, C0), an11 = GS_AOF(nxt, 1, R1, C1);
        const bool hi = cur.rows > 128;
        for (int t = 0; t < nt; t += 2) {
            const bool last = (t == nt - 2);
            const char* xA = last ? nxt.A : cur.A; const char* xB = last ? nxt.Bt : cur.Bt;
            const unsigned x00 = last ? an00 : ac00, x01 = last ? an01 : ac01, x10 = last ? an10 : ac10, x11 = last ? an11 : ac11;
            const int k2 = last ? 0 : t + 2, k3 = k2 + 1;
            GS_LDB(B0, 0, 0); GS_SCHED; GS_LDA(At, 0, 0); GS_STA(1, 1, cur.A, ac10, ac11, t + 1);
            GS_WL(8); GS_BAR; GS_WL(0); GS_MMA(0, 0, At, B0); GS_BAR; GS_SCHED;
            GS_LDB(B1, 0, 1); GS_STB(0, 0, xB, k2);
            GS_BAR; GS_WL(0); GS_MMA(0, 1, At, B1); GS_BAR;
            if (hi) GS_LDA(At, 0, 1); GS_STA(0, 0, xA, x00, x01, k2);
            GS_BAR; GS_WL(0); GS_MMA(1, 0, At, B0); GS_BAR; GS_SCHED;
            GS_STB(0, 1, xB, k2);
            GS_WV(6); GS_BAR; GS_MMA(1, 1, At, B1); GS_BAR;
            GS_LDB(B0, 1, 0); GS_SCHED; GS_LDA(At, 1, 0); GS_STA(0, 1, xA, x10, x11, k2);
            GS_WL(8); GS_BAR; GS_WL(0); GS_MMA(0, 0, At, B0); GS_BAR; GS_SCHED;
            GS_LDB(B1, 1, 1); GS_STB(1, 0, xB, k3);
            GS_BAR; GS_WL(0); GS_MMA(0, 1, At, B1); GS_BAR;
            if (hi) GS_LDA(At, 1, 1); GS_STA(1, 0, xA, x00, x01, k3);
            GS_BAR; GS_WL(0); GS_MMA(1, 0, At, B0); GS_BAR; GS_SCHED;
            GS_STB(1, 1, xB, k3);
            GS_WV(6); GS_BAR; GS_MMA(1, 1, At, B1); GS_BAR;
        }
        __builtin_amdgcn_sched_barrier(0);
        src.epi(acc, cur, wr, wc, fr, fq);
        __builtin_amdgcn_sched_barrier(0);
        if (!has_next) break;
#pragma unroll
        for (int a = 0; a < 2; ++a)
#pragma unroll
            for (int b = 0; b < 2; ++b)
#pragma unroll
                for (int m = 0; m < 4; ++m)
#pragma unroll
                    for (int n = 0; n < 2; ++n) acc[a][b][m][n] = (f32x4){0.f, 0.f, 0.f, 0.f};
        cur = nxt; ac00 = an00; ac01 = an01; ac10 = an10; ac11 = an11;
    }
    GS_WV(0);
    if (wr == 0) GS_BAR;
    GS_BAR;
#undef GS_AOF
#undef GS_SA
#undef GS_SB
#undef GS_GL
#undef GS_STA
#undef GS_STB
#undef GS_LDA
#undef GS_LDB
#undef GS_MMA
#undef GS_WV
#undef GS_WL
#undef GS_BAR
#undef GS_SCHED
}
struct Epi8PG { u16* PG; const float* lbl; int tok0, col0;
    __device__ __forceinline__ void operator()(const f32x4 (&acc)[2][2][4][2], int wr, int wc, int fr, int fq) const {
        const int grp = col0 >> 10;
        if (grp == 0) {
#pragma unroll
            for (int ai = 0; ai < 2; ++ai)
#pragma unroll
                for (int m = 0; m < 4; ++m) { u16* rowp = PG + (size_t)(tok0 + ai * 128 + wr * 64 + m * 16 + fr) * 5120 + col0 + wc * 32 + 8 * fq;
#pragma unroll
                    for (int bj = 0; bj < 2; ++bj) { float o[8];
#pragma unroll
                        for (int n = 0; n < 2; ++n)
#pragma unroll
                            for (int q = 0; q < 4; ++q) { const float x = acc[ai][bj][m][n][q]; o[4 * n + q] = x * __builtin_amdgcn_rcpf(1.0f + __expf(-x)); }
                        *(u32x4*)(rowp + bj * 128) = (u32x4){pk_bf16(o[0], o[1]), pk_bf16(o[2], o[3]), pk_bf16(o[4], o[5]), pk_bf16(o[6], o[7])}; } }
        } else if (grp <= 2) {
            float lbv[2][8];
#pragma unroll
            for (int bj = 0; bj < 2; ++bj)
#pragma unroll
                for (int q = 0; q < 8; ++q) { const int c = (col0 & 1023) + bj * 128 + wc * 32 + 8 * fq + q; const float l0 = lbl[(grp - 1) * HGW + c], l1 = lbl[(2 + grp - 1) * HGW + c]; lbv[bj][q] = __builtin_amdgcn_rcpf(1.0f + __expf(l1 - l0)); }
#pragma unroll
            for (int ai = 0; ai < 2; ++ai)
#pragma unroll
                for (int m = 0; m < 4; ++m) { u16* rowp = PG + (size_t)(tok0 + ai * 128 + wr * 64 + m * 16 + fr) * 5120 + col0 + wc * 32 + 8 * fq;
#pragma unroll
                    for (int bj = 0; bj < 2; ++bj) { float o[8];
#pragma unroll
                        for (int n = 0; n < 2; ++n)
#pragma unroll
                            for (int q = 0; q < 4; ++q) { const float z = acc[ai][bj][m][n][q], lb = lbv[bj][4 * n + q]; const float sg = __builtin_amdgcn_rcpf(1.0f + __expf(-z)); o[4 * n + q] = __log2f(lb + (1.0f - lb) * sg); }
                        *(u32x4*)(rowp + bj * 128) = (u32x4){pk_bf16(o[0], o[1]), pk_bf16(o[2], o[3]), pk_bf16(o[4], o[5]), pk_bf16(o[6], o[7])}; } }
        } else {
#pragma unroll
            for (int ai = 0; ai < 2; ++ai)
#pragma unroll
                for (int m = 0; m < 4; ++m) { u16* rowp = PG + (size_t)(tok0 + ai * 128 + wr * 64 + m * 16 + fr) * 5120 + col0 + wc * 32 + 8 * fq;
#pragma unroll
                    for (int bj = 0; bj < 2; ++bj) { const f32x4 v0 = acc[ai][bj][m][0], v1 = acc[ai][bj][m][1];
                        *(u32x4*)(rowp + bj * 128) = (u32x4){pk_bf16(v0[0], v0[1]), pk_bf16(v0[2], v0[3]), pk_bf16(v1[0], v1[1]), pk_bf16(v1[2], v1[3])}; } }
        }
    } };
struct Epi8HYT { u16* HYT; int tok0, col0;
    __device__ __forceinline__ void operator()(const f32x4 (&acc)[2][2][4][2], int wr, int wc, int fr, int fq) const {
#pragma unroll
        for (int bj = 0; bj < 2; ++bj)
#pragma unroll
            for (int n = 0; n < 2; ++n) { u16* colp = HYT + (size_t)(col0 + bj * 128 + wc * 32 + perm32(n * 16 + fr)) * NTOK + tok0 + wr * 64 + 4 * fq;
#pragma unroll
                for (int ai = 0; ai < 2; ++ai)
#pragma unroll
                    for (int m = 0; m < 4; ++m) { const f32x4 v = acc[ai][bj][m][n]; *(u32x2*)(colp + ai * 128 + m * 16) = (u32x2){pk_bf16(v[0], v[1]), pk_bf16(v[2], v[3])}; } }
    } };
struct Epi8X1 { const float* x; float* X1; int tok0, col0;
    __device__ __forceinline__ void operator()(const f32x4 (&acc)[2][2][4][2], int wr, int wc, int fr, int fq) const {
#pragma unroll
        for (int ai = 0; ai < 2; ++ai)
#pragma unroll
            for (int m = 0; m < 4; ++m) { const size_t off = (size_t)(tok0 + ai * 128 + wr * 64 + m * 16 + fr) * DM + col0 + wc * 32 + 8 * fq;
#pragma unroll
                for (int bj = 0; bj < 2; ++bj)
#pragma unroll
                    for (int n = 0; n < 2; ++n) { const f32x4 r = *(const f32x4*)(x + off + bj * 128 + n * 4); *(f32x4*)(X1 + off + bj * 128 + n * 4) = r + acc[ai][bj][m][n]; }
                asm volatile("" ::: "memory"); }
    } };
struct Epi8Swiglu { u16* HM; const float* b1; int slot0, nt, rows_valid;
    __device__ __forceinline__ void operator()(const f32x4 (&acc)[2][2][4][2], int wr, int wc, int fr, int fq) const {
        f32x4 bg[2], bl[2];
#pragma unroll
        for (int n = 0; n < 2; ++n) { const int col = nt * 128 + wc * 32 + 8 * fq + 4 * n; bg[n] = *(const f32x4*)(b1 + col); bl[n] = *(const f32x4*)(b1 + 2048 + col); }
#pragma unroll
        for (int ai = 0; ai < 2; ++ai)
#pragma unroll
            for (int m = 0; m < 4; ++m) { const int row = ai * 128 + wr * 64 + m * 16 + fr;
                if (row < rows_valid) { float o[8];
#pragma unroll
                    for (int n = 0; n < 2; ++n) { const f32x4 gl = acc[ai][0][m][n] + bg[n], li = acc[ai][1][m][n] + bl[n];
#pragma unroll
                        for (int j = 0; j < 4; ++j) { const float gq = fminf(gl[j], 7.0f), lq = fminf(fmaxf(li[j], -7.0f), 7.0f); o[4 * n + j] = gq * __builtin_amdgcn_rcpf(1.0f + __expf(-1.702f * gq)) * (lq + 1.0f); } }
                    *(u32x4*)(HM + (size_t)(slot0 + row) * DFF + nt * 128 + wc * 32 + 8 * fq) = (u32x4){pk_bf16(o[0], o[1]), pk_bf16(o[2], o[3]), pk_bf16(o[4], o[5]), pk_bf16(o[6], o[7])}; } }
    } };
struct Epi8Swiglu8 { unsigned char* HM; const float* b1; int slot0, nt, rows_valid;
    __device__ __forceinline__ void operator()(const f32x4 (&acc)[2][2][4][2], int wr, int wc, int fr, int fq) const {
        f32x4 bg[2], bl[2];
#pragma unroll
        for (int n = 0; n < 2; ++n) { const int col = nt * 128 + wc * 32 + 8 * fq + 4 * n; bg[n] = *(const f32x4*)(b1 + col); bl[n] = *(const f32x4*)(b1 + 2048 + col); }
#pragma unroll
        for (int ai = 0; ai < 2; ++ai)
#pragma unroll
            for (int m = 0; m < 4; ++m) { const int row = ai * 128 + wr * 64 + m * 16 + fr;
                if (row < rows_valid) { float o[8];
#pragma unroll
                    for (int n = 0; n < 2; ++n) { const f32x4 gl = acc[ai][0][m][n] + bg[n], li = acc[ai][1][m][n] + bl[n];
#pragma unroll
                        for (int j = 0; j < 4; ++j) { const float gq = fminf(gl[j], 7.0f), lq = fminf(fmaxf(li[j], -7.0f), 7.0f); o[4 * n + j] = gq * __builtin_amdgcn_rcpf(1.0f + __expf(-1.702f * gq)) * (lq + 1.0f); } }
                    *(u32x2*)(HM + (size_t)(slot0 + row) * DFF + nt * 128 + wc * 32 + 8 * fq) = (u32x2){pk_fp8x4(o[0], o[1], o[2], o[3]), pk_fp8x4(o[4], o[5], o[6], o[7])}; } }
    } };
struct Epi8Y { u16* Y; const float* b2; int slot0, col0, rows_valid;
    __device__ __forceinline__ void operator()(const f32x4 (&acc)[2][2][4][2], int wr, int wc, int fr, int fq) const {
        f32x4 bv[2][2];
#pragma unroll
        for (int bj = 0; bj < 2; ++bj)
#pragma unroll
            for (int n = 0; n < 2; ++n) bv[bj][n] = *(const f32x4*)(b2 + col0 + bj * 128 + wc * 32 + 8 * fq + 4 * n);
#pragma unroll
        for (int ai = 0; ai < 2; ++ai)
#pragma unroll
            for (int m = 0; m < 4; ++m) { const int row = ai * 128 + wr * 64 + m * 16 + fr;
                if (row < rows_valid) { u16* rowp = Y + (size_t)(slot0 + row) * DM + col0 + wc * 32 + 8 * fq;
#pragma unroll
                    for (int bj = 0; bj < 2; ++bj) { const f32x4 v0 = acc[ai][bj][m][0] + bv[bj][0], v1 = acc[ai][bj][m][1] + bv[bj][1];
                        *(u32x4*)(rowp + bj * 128) = (u32x4){pk_bf16(v0[0], v0[1]), pk_bf16(v0[2], v0[3]), pk_bf16(v1[0], v1[1]), pk_bf16(v1[2], v1[3])}; } } }
    } };
struct EpiNone { __device__ __forceinline__ void operator()(const f32x4 (&acc)[2][2][4][2], int wr, int wc, int fr, int fq) const {
#pragma unroll
        for (int a = 0; a < 2; ++a)
#pragma unroll
            for (int b = 0; b < 2; ++b)
#pragma unroll
                for (int m = 0; m < 4; ++m)
#pragma unroll
                    for (int n = 0; n < 2; ++n) asm volatile("" :: "v"(acc[a][b][m][n]));
    } };

template <int NTILES>
__device__ __forceinline__ bool moe_unit_static(const LAS int* us, const LAS int* so2, int uu, int& e, int& nt, int& slot0, int& rows) {
    if (uu >= us[NE]) return false;
    int lo = 0, hi = NE;
#pragma unroll
    for (int s = 0; s < 5; ++s) { const int mid = (lo + hi) >> 1; if (us[mid] <= uu) lo = mid; else hi = mid; }
    e = lo; const int o0 = e * NTOK, cnt = so2[e], mtl = (cnt + 255) >> 8, ul = uu - us[e], mt = ul % mtl;
    e = __builtin_amdgcn_readfirstlane(e); nt = __builtin_amdgcn_readfirstlane(ul / mtl); slot0 = __builtin_amdgcn_readfirstlane(o0 + mt * 256);
    rows = cnt - mt * 256; rows = __builtin_amdgcn_readfirstlane(rows > 256 ? 256 : rows); return true;
}
struct SrcMoeB { const LAS int* us; const LAS int* so2; int c, G; const char* HM8; const char* W2T8; u16* YB; const float* b2;
    __device__ __forceinline__ bool get(int i, StreamUnit& u) const { int e, nt, slot0, rows; if (!moe_unit_static<8>(us, so2, c + i * G, e, nt, slot0, rows)) return false;
        u.A = HM8; u.Bt = W2T8 + (size_t)((e * 8 + nt) * 16) * 32768; u.arow0 = slot0; u.rows = rows; u.a = e; u.b = nt; u.c = slot0; return true; }
    __device__ __forceinline__ void epi(const f32x4 (&acc)[2][2][4][2], const StreamUnit& u, int wr, int wc, int fr, int fq) const { Epi8Y ep{YB, b2 + (size_t)u.a * DM, u.c, u.b * 256, u.rows}; ep(acc, wr, wc, fr, fq); }
};
template <bool TRANS>
struct SrcG1 { int c, G; const char* HBp; const char* WINTp; u16* PG; u16* HYT; const float* lbl;
    __device__ __forceinline__ bool get(int k, StreamUnit& su) const {
        int seen = 0;
        for (int u = c; u < 1024; u += G) { const int i = u >> 8, xx = (u >> 5) & 7, j = u & 31; const int mt = (xx & 3) * 8 + (j & 7), nt = ((xx >> 2) + 2 * i) * 4 + (j >> 3);
            if ((nt >= 20) == TRANS) { if (seen == k) { su.A = HBp; su.Bt = WINTp + (size_t)nt * 32 * 32768; su.arow0 = mt * 256; su.rows = 256; su.a = mt; su.b = nt; su.c = 0; return true; } ++seen; } }
        return false; }
    __device__ __forceinline__ void epi(const f32x4 (&acc)[2][2][4][2], const StreamUnit& u, int wr, int wc, int fr, int fq) const {
        if (TRANS) { Epi8HYT e{HYT, u.a * 256, u.b * 256 - 5120}; e(acc, wr, wc, fr, fq); } else { Epi8PG e{PG, lbl, u.a * 256, u.b * 256}; e(acc, wr, wc, fr, fq); } }
};

typedef float f32x16 __attribute__((ext_vector_type(16)));
__device__ __forceinline__ void h3_row(int m, const float* __restrict__ w1, const float* __restrict__ b1, const float* __restrict__ w2, const float* __restrict__ b2,
                                       const float* __restrict__ w3, const float* __restrict__ b3, const float* __restrict__ freq, LAS float* sc  , float* __restrict__ H3) {
    const int j = tid_fresh() & 63;
    const float tt = (float)m / (float)(SEQ - 1);
    if (j == 0) sc[0] = tt;
    if (j >= 1 && j <= 16) { const int i = j - 1; const float band = 1e-4f + (float)i * ((15.0f - 1e-4f) / 15.0f); const float ang = (2.0f * 3.14159265358979323846f / (float)SEQ) * (float)m * band; sc[1 + i] = cosf(ang); sc[17 + i] = -sinf(ang); }
    __builtin_amdgcn_wave_barrier();
    const float fr = freq[j];
    float s = b1[j];
    for (int i = 0; i < 33; ++i) s += sc[i] * w1[i * 64 + j];
    const float h1 = sinf(fr * s);
    sc[64 + j] = h1;
    __builtin_amdgcn_wave_barrier();
    s = b2[j];
    for (int i = 0; i < 64; ++i) s += sc[64 + i] * w2[i * 64 + j];
    const float h2 = sinf(fr * s);
    __builtin_amdgcn_wave_barrier();
    sc[j] = h2;
    __builtin_amdgcn_wave_barrier();
    s = b3[j];
    for (int i = 0; i < 64; ++i) s += sc[i] * w3[i * 64 + j];
    H3[(size_t)m * 64 + j] = sinf(fr * s);
    __builtin_amdgcn_wave_barrier();
}
constexpr int FR_LEN = 4128;
__device__ __forceinline__ void frgen_item(LAS unsigned char* lds, int item, const float* __restrict__ H3, const float* __restrict__ w4, u16* __restrict__ FR) {
    const int tid = tid_fresh(), wid = __builtin_amdgcn_readfirstlane(tid >> 6), lane = tid & 63, fr = lane & 15, fq = lane >> 4;
    const int oc0 = item * 8, o = oc0 >> 10;
    const int colB = o * 2048 + (fr >> 3) * 1024 + (oc0 & 1023) + (fr & 7);
    float wreg[16];
#pragma unroll
    for (int ks = 0; ks < 16; ++ks) wreg[ks] = w4[(size_t)(4 * ks + fq) * 4096 + colB];
    const int dir = fr >> 3, c = (oc0 & 1023) + (fr & 7);
    const float mind = logf(1e-2f) / 0.3f, maxd = logf(1e-2f) / 1.5f;
    const float delta = fabsf(mind + (float)c * ((maxd - mind) / 1023.0f));
    u16* r0 = FR + (size_t)((oc0 + (fr & 7)) * 2) * FR_LEN;
    LAS float* tile = (LAS float*)(lds + wid * 4608);
    const int wrow = lane >> 4, wcol = 4 * (lane & 15);
    f32x4 nx[4];
#pragma unroll
    for (int q = 0; q < 4; ++q) nx[q] = *(const f32x4*)(H3 + (size_t)wid * 1024 + q * 256 + lane * 4);
    for (int it = 0; it < 16; ++it) {
        const int mt = wid + 8 * it;
#pragma unroll
        for (int q = 0; q < 4; ++q) *(LAS f32x4*)(tile + (q * 4 + wrow) * 68 + wcol) = nx[q];
        if (it + 1 < 16) {
#pragma unroll
            for (int q = 0; q < 4; ++q) nx[q] = *(const f32x4*)(H3 + (size_t)(mt + 8) * 1024 + q * 256 + lane * 4);
        }
        f32x4 acc = {0.f, 0.f, 0.f, 0.f};
#pragma unroll
        for (int ks = 0; ks < 16; ++ks) acc = __builtin_amdgcn_mfma_f32_16x16x4f32(tile[fr * 68 + 4 * ks + fq], wreg[ks], acc, 0, 0, 0);
        const int m0 = mt * 16 + 4 * fq;
        float v[4];
#pragma unroll
        for (int j = 0; j < 4; ++j) v[j] = acc[j] * __expf(-((float)(m0 + j) / (float)(SEQ - 1)) * delta);
        if (dir == 0) {
            *(u32x2*)(r0 + 2044 - m0) = (u32x2){pk_bf16(v[3], v[2]), pk_bf16(v[1], v[0])};
#pragma unroll
            for (int j = 0; j < 4; ++j) r0[FR_LEN + 2046 - m0 - j] = (u16)(pk_bf16(v[j], 0.f) & 0xffffu);
        } else {
#pragma unroll
            for (int j = 0; j < 4; ++j) if (m0 + j >= 1) { const u16 b = (u16)(pk_bf16(v[j], 0.f) & 0xffffu); r0[2047 + m0 + j] = b; r0[FR_LEN + 2046 + m0 + j] = b; }
        }
    }
    if (tid < 8 * 34) { const int r = tid / 34, x = 4094 + tid % 34; u16* rr = FR + (size_t)((oc0 + r) * 2) * FR_LEN; if (x >= 4095) rr[x] = 0; rr[FR_LEN + x] = 0; }
    __syncthreads();
}
constexpr int HY_ZSTRIDE = 2312;
constexpr int HY_ZCH = 256 + 4 * HY_ZSTRIDE;
constexpr int HY_ZBYTES = HY_ZCH * 2;
constexpr int HY_FB = 4 * HY_ZBYTES;
constexpr int HY_FCH = 2 * FR_LEN * 2;
constexpr int HY_LDS = HY_FB + 4 * HY_FCH;

__device__ __forceinline__ void hy_load_row(LAS unsigned char* lds, int dest, int boff0, int bstride, const u16* __restrict__ row, float w0, float w1, float w2, float cb, int pl) {
#pragma unroll 2
    for (int it = 0; it < 8; ++it) {
        const int idx = pl + 128 * it, tok0 = idx * 8, b = tok0 >> 11, n0 = tok0 & 2047;
        const u32x4 raw = *(const u32x4*)(row + tok0);
        const float pm = (n0 > 0) ? bf2f(row[tok0 - 1]) : 0.f;
        const float pn = (n0 + 8 < SEQ) ? bf2f(row[tok0 + 8]) : 0.f;
        float p[10];
        p[0] = pm; p[9] = pn;
#pragma unroll
        for (int q = 0; q < 4; ++q) { p[1 + 2 * q] = bflo(raw[q]); p[2 + 2 * q] = bfhi(raw[q]); }
        float o[8];
#pragma unroll
        for (int q = 0; q < 8; ++q) o[q] = fmaf(w0, p[q], fmaf(w1, p[q + 1], fmaf(w2, p[q + 2], cb)));
        u32x4 w; w[0] = pk_bf16(o[0], o[1]); w[1] = pk_bf16(o[2], o[3]); w[2] = pk_bf16(o[4], o[5]); w[3] = pk_bf16(o[6], o[7]);
        *(LAS u32x4*)(lds + dest + (boff0 + b * bstride + n0) * 2) = w;
    }
}
__device__ __forceinline__ void hy_load_filters(LAS unsigned char* lds, int fb, const u16* __restrict__ src, int pl) {
    for (int idx = pl; idx < HY_FCH / 16; idx += 128) *(LAS u32x4*)(lds + fb + idx * 16) = *(const u32x4*)((const char*)src + idx * 16);
}
__device__ __forceinline__ void hy_mfma_loop(LAS unsigned char* lds, int zb, int fb, int hlf, int lane, f32x16 (&acc)[4], const ConvCtx& cc, int mbase, int cunit, int wid) {
    const int r = lane & 31, hh = lane >> 5, il = r >> 2, b = r & 3;
    const int bbase = zb + (256 + b * HY_ZSTRIDE + 32 * il + 8 * hh) * 2;
    const int xl = 2047 - r + 8 * hh - 1024 * hlf;
    const int abase = (r & 1) ? (fb + 2 * xl) : (fb + FR_LEN * 2 + 2 * (xl - 1));
#pragma unroll
    for (int q = 0; q < 4; ++q)
#pragma unroll
        for (int i = 0; i < 16; ++i) acc[q][i] = 0.f;
    for (int d0 = 0; d0 < 8; ++d0) {
#pragma unroll
        for (int ks = 0; ks < 2; ++ks) {
            f32x2 cv[16];
            const int mcv = conv_seq2tile((mbase + d0 * 2 + ks) * 256 + cunit);
            conv_issue(cc, mcv, wid, lane, cv);
            bf16x8 Bt[9];
#pragma unroll
            for (int j = 0; j < 9; ++j) Bt[j] = *(const LAS bf16x8*)(lds + bbase + 512 * j - 64 * d0 + 32 * ks);
#pragma unroll
            for (int ep = -8; ep <= 3; ++ep) {
                const LAS unsigned* ap = (const LAS unsigned*)(lds + abase - 64 * d0 - 512 * ep + 32 * ks);
                u32x4 av; av[0] = ap[0]; av[1] = ap[1]; av[2] = ap[2]; av[3] = ap[3];
                const bf16x8 a = __builtin_bit_cast(bf16x8, av);
#pragma unroll
                for (int ctl = 0; ctl < 4; ++ctl) { const int jt = ctl - ep; if (jt >= 0 && jt <= 8) acc[ctl] = __builtin_amdgcn_mfma_f32_32x32x16_bf16(a, Bt[jt], acc[ctl], 0, 0, 0); }
            }
            conv_finish(cc, mcv, wid, lane, cv);
        }
    }
}
__device__ __forceinline__ void hy_epilogue(LAS unsigned char* lds, int zb, int gb, int hlf, int lane, const f32x16 (&acc)[4], float bias) {
    const int r = lane & 31, hh = lane >> 5, il = r >> 2, b = r & 3;
#pragma unroll
    for (int ctl = 0; ctl < 4; ++ctl) {
        const int I = 8 * (4 * hlf + ctl) + il;
#pragma unroll
        for (int q = 0; q < 4; ++q) {
            const int n4 = 32 * I + 8 * q + 4 * hh;
            LAS u32x2* zp = (LAS u32x2*)(lds + zb + (256 + b * HY_ZSTRIDE + n4) * 2);
            const u32x2 zv = *zp, gv = *(const LAS u32x2*)(lds + gb + (b * 2048 + n4) * 2);
            const float z0 = bflo(zv[0]), z1 = bfhi(zv[0]), z2 = bflo(zv[1]), z3 = bfhi(zv[1]);
            const float g0 = bflo(gv[0]), g1 = bfhi(gv[0]), g2 = bflo(gv[1]), g3 = bfhi(gv[1]);
            u32x2 o; o[0] = pk_bf16(g0 * fmaf(bias, z0, acc[ctl][4 * q + 0]), g1 * fmaf(bias, z1, acc[ctl][4 * q + 1]));
            o[1] = pk_bf16(g2 * fmaf(bias, z2, acc[ctl][4 * q + 2]), g3 * fmaf(bias, z3, acc[ctl][4 * q + 3]));
            *zp = o;
        }
    }
}
__device__ __forceinline__ void hyena_unit(LAS unsigned char* lds, int unit, const u16* __restrict__ HYT, const u16* __restrict__ FR, const float* __restrict__ cw, const float* __restrict__ cbv,
                                           const float* __restrict__ hbias, u16* __restrict__ Z2T, const ConvCtx& cc) {
    const int tid = tid_fresh(), wid = __builtin_amdgcn_readfirstlane(tid >> 6), lane = tid & 63;
    const int cs = wid & 3, hlf = wid >> 2, c = unit * 4 + cs, pl = lane + 64 * hlf;
    const int zb = cs * HY_ZBYTES, fb = HY_FB + cs * HY_FCH;
    { const u32x4 z = {0u, 0u, 0u, 0u}; for (int idx = pl; idx < HY_ZBYTES / 16; idx += 128) *(LAS u32x4*)(lds + zb + idx * 16) = z; }
    __syncthreads();
    hy_load_row(lds, zb, 256, HY_ZSTRIDE, HYT + (size_t)c * NTOK, cw[0 * 3072 + c], cw[1 * 3072 + c], cw[2 * 3072 + c], cbv[c], pl);
    f32x16 acc[4];
#pragma unroll
    for (int o = 0; o < 2; ++o) {
        hy_load_filters(lds, fb, FR + (size_t)((o * 1024 + c) * 2) * FR_LEN, pl);
        __syncthreads();
        hy_mfma_loop(lds, zb, fb, hlf, lane, acc, cc, o * 16, unit, wid);
        __syncthreads();
        const int gc = (1 + o) * 1024 + c;
        hy_load_row(lds, fb, 0, 2048, HYT + (size_t)gc * NTOK, cw[0 * 3072 + gc], cw[1 * 3072 + gc], cw[2 * 3072 + gc], cbv[gc], pl);
        __syncthreads();
        hy_epilogue(lds, zb, fb, hlf, lane, acc, hbias[o * HYW + c]);
        __syncthreads();
    }
#pragma unroll 2
    for (int it = 0; it < 8; ++it) { const int idx = pl + 128 * it, tok0 = idx * 8, b = tok0 >> 11, n0 = tok0 & 2047;
        *(u32x4*)(Z2T + (size_t)c * NTOK + tok0) = *(const LAS u32x4*)(lds + zb + (256 + b * HY_ZSTRIDE + n0) * 2); }
    __syncthreads();
}

constexpr int HG_RAWQ = 0, HG_RAWF = 16384, HG_RAWV = 32768;
constexpr int HG_QM = 36864, HG_KM = HG_QM + 17408, HG_QI = HG_KM + 17408;
constexpr int HG_KL = HG_QI + 17408;
constexpr int HG_VT = HG_KL + 18432;
constexpr int HG_P = HG_VT + 4608;
constexpr int HG_ST = HG_P + 9216;
constexpr int HG_TOT = HG_ST + 8704;
constexpr int HG_EL2 = HG_TOT + 4096;
constexpr int HG_LDS = HG_EL2 + 512;

__device__ __forceinline__ void hgrn_unit(LAS unsigned char* lds, int unit, const u16* __restrict__ PG, const float* __restrict__ lb_logits, float* __restrict__ OF, float* __restrict__ OB, const ConvCtx& cc) {
    const int tid = tid_fresh(), wid = __builtin_amdgcn_readfirstlane(tid >> 6), lane = tid & 63, fr = lane & 15, fq = lane >> 4;
    const int vq = unit & 3, dir = (unit >> 2) & 1, h = (unit >> 3) & 7, b = unit >> 6;
    const int k = tid & 127, seg = tid >> 7;
    float* __restrict__ O = dir ? OB : OF;
    for (int i = tid; i < 8704 / 16; i += 512) *(LAS u32x4*)(lds + HG_ST + i * 16) = (u32x4){0u, 0u, 0u, 0u};
    f32x4 Sacc[2];
    Sacc[0] = (f32x4){0.f, 0.f, 0.f, 0.f}; Sacc[1] = Sacc[0];
    u32x4 pq[2], pf[2], pv;
    const int colq = h * 128, colf = (1 + dir) * 1024 + h * 128, colv = 3072 + h * 128 + vq * 32;
#define HG_TOK(c, tau) ((size_t)b * SEQ + (dir ? (SEQ - 1 - 64 * (c) - (tau)) : (64 * (c) + (tau))))
#define HG_PREFETCH(c) do { _Pragma("unroll") for (int _i = 0; _i < 2; ++_i) { const int _x = tid + 512 * _i, _tau = _x >> 4, _p = _x & 15; const u16* _r = PG + HG_TOK(c, _tau) * 5120; \
            pq[_i] = *(const u32x4*)(_r + colq + _p * 8); pf[_i] = *(const u32x4*)(_r + colf + _p * 8); } \
        if (tid < 256) { const int _tau = tid >> 2, _p = tid & 3; pv = *(const u32x4*)(PG + HG_TOK(c, _tau) * 5120 + colv + _p * 8); } } while (0)
#define HG_RAW2LDS() do { _Pragma("unroll") for (int _i = 0; _i < 2; ++_i) { const int _x = tid + 512 * _i; *(LAS u32x4*)(lds + HG_RAWQ + _x * 16) = pq[_i]; *(LAS u32x4*)(lds + HG_RAWF + _x * 16) = pf[_i]; } \
        if (tid < 256) *(LAS u32x4*)(lds + HG_RAWV + tid * 16) = pv; } while (0)
    HG_PREFETCH(0);
    HG_RAW2LDS();
    HG_PREFETCH(1);
    __syncthreads();
    for (int c = 0; c < 32; ++c) {
        f32x2 cv[16];
        const int mqa = conv_seq2tile((32 + c * 2) * 256 + unit), mqb = conv_seq2tile((33 + c * 2) * 256 + unit);
        conv_issue(cc, mqa, wid, lane, cv);
        const int kp = lane, sg = wid;
        float qv0[8], qv1[8], kv0[8], kv1[8], bl0[8], bl1[8];
        { float r0 = 0.f, r1 = 0.f;
#pragma unroll
          for (int i = 0; i < 8; ++i) { const int tau = sg * 8 + i;
              const unsigned qw = *(const LAS unsigned*)(lds + HG_RAWQ + tau * 256 + kp * 4), fw = *(const LAS unsigned*)(lds + HG_RAWF + tau * 256 + kp * 4);
              const float l0 = bflo(fw), l1 = bfhi(fw);
              r0 += l0; r1 += l1; bl0[i] = r0; bl1[i] = r1; kv0[i] = 1.0f - __builtin_amdgcn_exp2f(l0); kv1[i] = 1.0f - __builtin_amdgcn_exp2f(l1); qv0[i] = bflo(qw); qv1[i] = bfhi(qw); }
          *(LAS f32x2*)(lds + HG_TOT + (sg * 128 + 2 * kp) * 4) = (f32x2){r0, r1}; }
        __syncthreads();
        { f32x2 tt[8];
#pragma unroll
          for (int q = 0; q < 8; ++q) tt[q] = *(const LAS f32x2*)(lds + HG_TOT + (q * 128 + 2 * kp) * 4);
          f32x2 pre = {0.f, 0.f};
#pragma unroll
          for (int q = 0; q < 7; ++q) if (q < sg) pre += tt[q];
          const f32x2 bref = tt[0] + tt[1] + tt[2] + tt[3], blast = bref + tt[4] + tt[5] + tt[6] + tt[7];
          const float er0 = __builtin_amdgcn_exp2f(bref[0]), er1 = __builtin_amdgcn_exp2f(bref[1]), el0 = __builtin_amdgcn_exp2f(blast[0] - bref[0]), el1 = __builtin_amdgcn_exp2f(blast[1] - bref[1]);
          if (sg == 0) *(LAS f32x2*)(lds + HG_EL2 + 2 * kp * 4) = (f32x2){__builtin_amdgcn_exp2f(blast[0]), __builtin_amdgcn_exp2f(blast[1])};
          const f32x2 dref = pre - bref;
          float kl0[8], kl1[8];
#pragma unroll
          for (int i = 0; i < 8; ++i) { const int tau = sg * 8 + i; const float x0 = dref[0] + bl0[i], x1 = dref[1] + bl1[i];
              const float qm0 = qv0[i] * __builtin_amdgcn_exp2f(x0), qm1 = qv1[i] * __builtin_amdgcn_exp2f(x1), km0 = kv0[i] * __builtin_amdgcn_exp2f(-x0), km1 = kv1[i] * __builtin_amdgcn_exp2f(-x1);
              *(LAS unsigned*)(lds + HG_QM + tau * 272 + kp * 4) = pk_bf16(qm0, qm1);
              *(LAS unsigned*)(lds + HG_KM + tau * 272 + kp * 4) = pk_bf16(km0, km1);
              *(LAS unsigned*)(lds + HG_QI + tau * 272 + kp * 4) = pk_bf16(qm0 * er0, qm1 * er1);
              kl0[i] = km0 * el0; kl1[i] = km1 * el1; }
          *(LAS u32x4*)(lds + HG_KL + (2 * kp) * 144 + sg * 16) = (u32x4){pk_bf16(kl0[0], kl0[1]), pk_bf16(kl0[2], kl0[3]), pk_bf16(kl0[4], kl0[5]), pk_bf16(kl0[6], kl0[7])};
          *(LAS u32x4*)(lds + HG_KL + (2 * kp + 1) * 144 + sg * 16) = (u32x4){pk_bf16(kl1[0], kl1[1]), pk_bf16(kl1[2], kl1[3]), pk_bf16(kl1[4], kl1[5]), pk_bf16(kl1[6], kl1[7])};
          { const int v = tid & 31, tg = tid >> 5; unsigned short e[4];
#pragma unroll
            for (int u = 0; u < 4; ++u) e[u] = *(const LAS u16*)(lds + HG_RAWV + (tg * 4 + u) * 64 + v * 2);
            *(LAS u32x2*)(lds + HG_VT + v * 144 + tg * 8) = (u32x2){(unsigned)e[0] | ((unsigned)e[1] << 16), (unsigned)e[2] | ((unsigned)e[3] << 16)}; } }
        conv_finish(cc, mqa, wid, lane, cv);
        conv_issue(cc, mqb, wid, lane, cv);
        __syncthreads();
        if (c + 1 < 32) { HG_RAW2LDS(); if (c + 2 < 32) HG_PREFETCH(c + 2); }
#pragma unroll
        for (int q = 0; q < 2; ++q) { const int idx = wid * 2 + q, ti = idx >> 2, si = idx & 3;
            f32x4 a = {0.f, 0.f, 0.f, 0.f};
            if (si <= ti) {
#pragma unroll
                for (int ks = 0; ks < 4; ++ks) { const bf16x8 ka = *(const LAS bf16x8*)(lds + HG_KM + (si * 16 + fr) * 272 + (ks * 32 + fq * 8) * 2), qb = *(const LAS bf16x8*)(lds + HG_QM + (ti * 16 + fr) * 272 + (ks * 32 + fq * 8) * 2);
                    a = __builtin_amdgcn_mfma_f32_16x16x32_bf16(ka, qb, a, 0, 0, 0); } }
            const int tau = ti * 16 + fr, s0 = si * 16 + fq * 4;
            float pvv[4];
#pragma unroll
            for (int j = 0; j < 4; ++j) pvv[j] = (si <= ti && s0 + j <= tau) ? a[j] : 0.f;
            *(LAS u32x2*)(lds + HG_P + tau * 144 + s0 * 2) = (u32x2){pk_bf16(pvv[0], pvv[1]), pk_bf16(pvv[2], pvv[3])}; }
        const int ti = wid >> 1, vi = wid & 1;
        f32x4 oacc = {0.f, 0.f, 0.f, 0.f};
#pragma unroll
        for (int ks = 0; ks < 4; ++ks) { const bf16x8 qa = *(const LAS bf16x8*)(lds + HG_QI + (ti * 16 + fr) * 272 + (ks * 32 + fq * 8) * 2), sb = *(const LAS bf16x8*)(lds + HG_ST + (vi * 16 + fr) * 272 + (ks * 32 + fq * 8) * 2);
            oacc = __builtin_amdgcn_mfma_f32_16x16x32_bf16(qa, sb, oacc, 0, 0, 0); }
        { const f32x4 e2 = *(const LAS f32x4*)(lds + HG_EL2 + (wid * 16 + fq * 4) * 4);
#pragma unroll
          for (int v2 = 0; v2 < 2; ++v2) { Sacc[v2] = Sacc[v2] * e2;
#pragma unroll
              for (int ks = 0; ks < 2; ++ks) { const bf16x8 ka = *(const LAS bf16x8*)(lds + HG_KL + (wid * 16 + fr) * 144 + (ks * 32 + fq * 8) * 2), vb = *(const LAS bf16x8*)(lds + HG_VT + (v2 * 16 + fr) * 144 + (ks * 32 + fq * 8) * 2);
                  Sacc[v2] = __builtin_amdgcn_mfma_f32_16x16x32_bf16(ka, vb, Sacc[v2], 0, 0, 0); } } }
        __syncthreads();
#pragma unroll
        for (int ks = 0; ks < 2; ++ks) { const bf16x8 pa = *(const LAS bf16x8*)(lds + HG_P + (ti * 16 + fr) * 144 + (ks * 32 + fq * 8) * 2), vb = *(const LAS bf16x8*)(lds + HG_VT + (vi * 16 + fr) * 144 + (ks * 32 + fq * 8) * 2);
            oacc = __builtin_amdgcn_mfma_f32_16x16x32_bf16(pa, vb, oacc, 0, 0, 0); }
#pragma unroll
        for (int j = 0; j < 4; ++j) { const int tau = ti * 16 + fq * 4 + j; O[HG_TOK(c, tau) * HGW + h * 128 + vq * 32 + vi * 16 + fr] = oacc[j]; }
        conv_finish(cc, mqb, wid, lane, cv);
#pragma unroll
        for (int v2 = 0; v2 < 2; ++v2) *(LAS u32x2*)(lds + HG_ST + (v2 * 16 + fr) * 272 + (wid * 16 + fq * 4) * 2) = (u32x2){pk_bf16(Sacc[v2][0], Sacc[v2][1]), pk_bf16(Sacc[v2][2], Sacc[v2][3])};
    }
    __syncthreads();
#undef HG_TOK
#undef HG_PREFETCH
#undef HG_RAW2LDS
}


#define XB_TMO      128
#define XB_XCNT(j)  (256  + 64 * (j))
#define XB_XSUB(j)  (1280 + 64 * (j))
#define XB_XGEN(j)  (2304 + 64 * (j))
#define XB_TOP      3328
#define XB_TOPGEN   3392
#define XCD_BAR_WORDS 3456
#define XB_SPIN_CAP (1u << 22)

__device__ __forceinline__ unsigned xb_ld(unsigned* p)              { return __hip_atomic_load(p, __ATOMIC_RELAXED, __HIP_MEMORY_SCOPE_AGENT); }
__device__ __forceinline__ unsigned xb_add(unsigned* p, unsigned v) { return __hip_atomic_fetch_add(p, v, __ATOMIC_RELAXED, __HIP_MEMORY_SCOPE_AGENT); }
__device__ __forceinline__ unsigned xb_xcc_id() { return (unsigned)__builtin_amdgcn_s_getreg((3 << 11) | 20) & 0xFu; }
#define XB_SPIN(cond, bar) do { unsigned _sp = 0; while (cond) { __builtin_amdgcn_s_sleep(1); \
    if ((++_sp & 255u) == 0u) { if (xb_ld(&(bar)[XB_TMO])) break; if (_sp > XB_SPIN_CAP) { atomicAdd(&(bar)[XB_TMO], 1u); break; } } } } while (0)

struct XcdBarrier {
    unsigned* bar; unsigned x;
    volatile LAS unsigned* st;
};

__device__ __forceinline__ XcdBarrier xcd_barrier_post(unsigned* bar, volatile LAS unsigned* st) {
    XcdBarrier b; b.bar = bar; b.x = xb_xcc_id(); b.st = st;
    if (threadIdx.x == 0) (void)xb_add(&bar[XB_XCNT(b.x)], 1u);
    return b;
}
__device__ __forceinline__ void xcd_barrier_complete(unsigned* bar, unsigned x, unsigned& nloc, unsigned& nx) {
    const unsigned G = gridDim.x * gridDim.y * gridDim.z;
    unsigned sum, cnt, mine, sp = 0u;
    for (;;) {
        sum = 0u; cnt = 0u; mine = 0u;
#pragma unroll
        for (unsigned j = 0; j < 16; ++j) { const unsigned c = xb_ld(&bar[XB_XCNT(j)]); sum += c; cnt += (c > 0u) ? 1u : 0u; mine = (j == x) ? c : mine; }
        if (sum == G) break;
        __builtin_amdgcn_s_sleep(1);
        if ((++sp & 255u) == 0u) { if (xb_ld(&bar[XB_TMO])) break; if (sp > XB_SPIN_CAP) { atomicAdd(&bar[XB_TMO], 1u); break; } }
    }
    nloc = mine > 0u ? mine : 1u; nx = cnt > 0u ? cnt : 1u;
}

__device__ __forceinline__ void xcd_barrier(const XcdBarrier& b) {
    asm volatile("s_waitcnt vmcnt(0)" ::: "memory");
    __syncthreads();
    if (threadIdx.x == 0) {
        unsigned* bar = b.bar;
        __builtin_amdgcn_s_waitcnt(0);
        unsigned nloc = b.st[0], nx = b.st[1];
        if (nloc == 0u) { xcd_barrier_complete(bar, b.x, nloc, nx); b.st[0] = nloc; b.st[1] = nx; }
        const unsigned old = xb_add(&bar[XB_XSUB(b.x)], 1u);
        const unsigned gen = old / nloc;
        if (old + 1u == (gen + 1u) * nloc) {
            __builtin_amdgcn_fence(__ATOMIC_RELEASE, "agent");
            asm volatile("s_waitcnt vmcnt(0)" ::: "memory");
            const unsigned og = xb_add(&bar[XB_TOP], 1u);
            const unsigned tg = og / nx;
            if (og + 1u == (tg + 1u) * nx) xb_add(&bar[XB_TOPGEN], 1u);
            else XB_SPIN(xb_ld(&bar[XB_TOPGEN]) == tg, bar);
            __builtin_amdgcn_fence(__ATOMIC_ACQUIRE, "agent");
            xb_add(&bar[XB_XGEN(b.x)], 1u);
            asm volatile("s_waitcnt vmcnt(0)" ::: "memory");
        } else {
            XB_SPIN(xb_ld(&bar[XB_XGEN(b.x)]) == gen, bar);
            __builtin_amdgcn_fence(__ATOMIC_ACQUIRE, "agent");
            asm volatile("s_waitcnt vmcnt(0)" ::: "memory");
        }
    }
    __syncthreads();
}

__device__ __forceinline__ float wave_sum(float s) {
#pragma unroll
    for (int o = 32; o >= 1; o >>= 1) s += __shfl_xor(s, o);
    return s;
}
__device__ __forceinline__ void rmsnorm_row_bf(const float* __restrict__ xr, const float* __restrict__ gain, u16* __restrict__ ob, int lane) {
    f32x4 v[8]; float s = 0.f;
#pragma unroll
    for (int j = 0; j < 8; ++j) { v[j] = *(const f32x4*)(xr + (lane + 64 * j) * 4); s += v[j][0] * v[j][0] + v[j][1] * v[j][1] + v[j][2] * v[j][2] + v[j][3] * v[j][3]; }
    s = wave_sum(s);
    const float r = rsqrtf(s * (1.0f / (float)DM) + EPS);
#pragma unroll
    for (int j = 0; j < 8; ++j) { const f32x4 g = *(const f32x4*)(gain + (lane + 64 * j) * 4); const f32x4 o = v[j] * r * g;
        *(u32x2*)(ob + (lane + 64 * j) * 4) = (u32x2){pk_bf16(o[0], o[1]), pk_bf16(o[2], o[3])}; }
}
__device__ __forceinline__ void hgrn_final_item4(int item0, int stride, const float* __restrict__ OF, const float* __restrict__ OB, const u16* __restrict__ PG, const float* __restrict__ gain, u16* __restrict__ MIXB, int lane) {
    f32x2 a[4], b[4]; unsigned gw[4];
#pragma unroll
    for (int q = 0; q < 4; ++q) { const int item = item0 + q * stride, tok = item >> 3, c = (item & 7) * 128 + 2 * lane;
        a[q] = *(const f32x2*)(OF + (size_t)tok * HGW + c); b[q] = *(const f32x2*)(OB + (size_t)tok * HGW + c); gw[q] = *(const unsigned*)(PG + (size_t)tok * 5120 + 4096 + c); }
#pragma unroll
    for (int q = 0; q < 4; ++q) { const int item = item0 + q * stride, tok = item >> 3, c = (item & 7) * 128 + 2 * lane;
        const float o0 = a[q][0] + b[q][0], o1 = a[q][1] + b[q][1];
        const float s = wave_sum(o0 * o0 + o1 * o1);
        const float r = rsqrtf(s * (1.0f / 128.0f) + EPS);
        const float g0 = bflo(gw[q]), g1 = bfhi(gw[q]);
        const f32x2 gn = *(const f32x2*)(gain + c);
        const float v0 = o0 * r * gn[0] * (g0 * __builtin_amdgcn_rcpf(1.0f + __expf(-g0))), v1 = o1 * r * gn[1] * (g1 * __builtin_amdgcn_rcpf(1.0f + __expf(-g1)));
        *(u16*)((unsigned char*)MIXB + (size_t)tok * DM + c) = (u16)(__builtin_amdgcn_cvt_pk_fp8_f32(v0, v1, 0, false) & 0xffff); }
}
__device__ __forceinline__ void hy_norm_tile(LAS unsigned char* lds, int tile_i, const u16* __restrict__ Z2T, const float* __restrict__ gain, u16* __restrict__ MIXB) {
    const int t = tid_fresh(), tok0 = tile_i * 32;
    LAS float* ssq = (LAS float*)(lds + 1024 * 80);
    if (t < 32) ssq[t] = 0.f;
    __syncthreads();
    float part[8];
#pragma unroll
    for (int q = 0; q < 8; ++q) part[q] = 0.f;
    const int ch = t & 3;
#pragma unroll
    for (int it = 0; it < 8; ++it) {
        const int c = (t >> 2) + 128 * it;
        const u32x4 v = *(const u32x4*)(Z2T + (size_t)c * NTOK + tok0 + ch * 8);
        *(LAS u32x4*)(lds + c * 80 + ch * 16) = v;
#pragma unroll
        for (int q = 0; q < 4; ++q) { const float a = bflo(v[q]), b = bfhi(v[q]); part[2 * q] += a * a; part[2 * q + 1] += b * b; }
    }
#pragma unroll
    for (int q = 0; q < 8; ++q) { float s = part[q]; s += __shfl_xor(s, 4); s += __shfl_xor(s, 8); s += __shfl_xor(s, 16); s += __shfl_xor(s, 32); part[q] = s; }
    if ((t & 63) < 4) {
#pragma unroll
        for (int q = 0; q < 8; ++q) atomicAdd((float*)(ssq + ch * 8 + q), part[q]);
    }
    __syncthreads();
    const int tt = t >> 4;
    const float r = rsqrtf(ssq[tt] * (1.0f / (float)HYW) + EPS);
#pragma unroll 2
    for (int k = 0; k < 8; ++k) {
        const int c0 = ((t & 15) + 16 * k) * 8;
        float o[8];
#pragma unroll
        for (int q = 0; q < 8; ++q) o[q] = bf2f(*(const LAS u16*)(lds + (c0 + q) * 80 + tt * 2)) * r * gain[c0 + q];
        *(u32x2*)((unsigned char*)MIXB + (size_t)(tok0 + tt) * DM + 1024 + c0) = (u32x2){pk_fp8x4(o[0], o[1], o[2], o[3]), pk_fp8x4(o[4], o[5], o[6], o[7])};
    }
    __syncthreads();
}
constexpr int RT_XSTRIDE = 2049;
constexpr int RT_PART = 16 * RT_XSTRIDE * 4;
constexpr int RT_LG = RT_PART + 8 * 16 * 32 * 4;
constexpr int RT_HIST = RT_LG + 16 * 32 * 4;
constexpr int RT_ITEMS = RT_HIST + 128;
constexpr int RT_RBASE = RT_ITEMS + 512;
constexpr int RT_END = RT_RBASE + 128;
__device__ __forceinline__ void router_tile(LAS unsigned char* lds, int tile_i, const float* __restrict__ X1, const float* __restrict__ gain, const float* __restrict__ wr, const float* __restrict__ br,
                                            unsigned char* __restrict__ XN8, float* __restrict__ TOPG, int tl2) {
    const int tid = tid_fresh(), wid = __builtin_amdgcn_readfirstlane(tid >> 6), lane = tid & 63;
    const int tok0 = tile_i * 16;
    LAS float* xs = (LAS float*)lds;
#pragma unroll
    for (int q = 0; q < 2; ++q) {
        const int tl = wid * 2 + q; const size_t tok = (size_t)tok0 + tl;
        const float* xr = X1 + tok * DM;
        f32x4 v[8]; float s = 0.f;
#pragma unroll
        for (int j = 0; j < 8; ++j) { v[j] = *(const f32x4*)(xr + (lane + 64 * j) * 4); s += v[j][0] * v[j][0] + v[j][1] * v[j][1] + v[j][2] * v[j][2] + v[j][3] * v[j][3]; }
        s = wave_sum(s);
        const float r = rsqrtf(s * (1.0f / (float)DM) + EPS);
#pragma unroll
        for (int j = 0; j < 8; ++j) { const int d = (lane + 64 * j) * 4; const f32x4 g = *(const f32x4*)(gain + d); const f32x4 o = v[j] * r * g;
            xs[tl * RT_XSTRIDE + d + 0] = o[0]; xs[tl * RT_XSTRIDE + d + 1] = o[1]; xs[tl * RT_XSTRIDE + d + 2] = o[2]; xs[tl * RT_XSTRIDE + d + 3] = o[3];
            *(unsigned*)(XN8 + tok * DM + d) = pk_fp8x4(o[0], o[1], o[2], o[3]); }
    }
    __syncthreads();
    {
        const int tl = lane & 15, kk = lane >> 4;
        f32x4 a0 = {0.f, 0.f, 0.f, 0.f}, a1 = a0;
        const LAS float* xp = xs + tl * RT_XSTRIDE + wid * 256 + kk;
        const float* wp = wr + (size_t)(wid * 256 + kk) * NE + tl;
#pragma unroll 8
        for (int ks = 0; ks < 64; ++ks) { const float a = xp[ks * 4]; const float b0 = wp[(size_t)ks * 4 * NE], b1 = wp[(size_t)ks * 4 * NE + 16];
            a0 = __builtin_amdgcn_mfma_f32_16x16x4f32(a, b0, a0, 0, 0, 0); a1 = __builtin_amdgcn_mfma_f32_16x16x4f32(a, b1, a1, 0, 0, 0); }
        LAS float* pp = (LAS float*)(lds + RT_PART) + wid * 512;
#pragma unroll
        for (int j = 0; j < 4; ++j) { pp[(kk * 4 + j) * 32 + tl] = a0[j]; pp[(kk * 4 + j) * 32 + 16 + tl] = a1[j]; }
    }
    __syncthreads();
    {   const LAS float* pp = (const LAS float*)(lds + RT_PART); float s = br[tid & 31];
#pragma unroll
        for (int w = 0; w < 8; ++w) s += pp[w * 512 + tid];
        ((LAS float*)(lds + RT_LG))[tid] = s; }
    __syncthreads();
    if (tid < 16) {
        LAS float* lg = (LAS float*)(lds + RT_LG) + tid * 32;
        int i0 = 0, i1 = 0, i2 = 0, i3 = 0; float v0, v1, v2, v3;
        { float bv = -3.0e38f; for (int j = 0; j < NE; ++j) { const float l = lg[j]; if (l > bv) { bv = l; i0 = j; } } v0 = bv; lg[i0] = -3.4e38f; }
        { float bv = -3.0e38f; for (int j = 0; j < NE; ++j) { const float l = lg[j]; if (l > bv) { bv = l; i1 = j; } } v1 = bv; lg[i1] = -3.4e38f; }
        { float bv = -3.0e38f; for (int j = 0; j < NE; ++j) { const float l = lg[j]; if (l > bv) { bv = l; i2 = j; } } v2 = bv; lg[i2] = -3.4e38f; }
        { float bv = -3.0e38f; for (int j = 0; j < NE; ++j) { const float l = lg[j]; if (l > bv) { bv = l; i3 = j; } } v3 = bv; lg[i3] = -3.4e38f; }
        const float e1 = __expf(v1 - v0), e2 = __expf(v2 - v0), e3 = __expf(v3 - v0), inv = 1.0f / (1.0f + e1 + e2 + e3);
        const int tok = tok0 + tid;
        *(f32x4*)(TOPG + tok * 4) = (f32x4){inv, e1 * inv, e2 * inv, e3 * inv};
        LAS int* hist = (LAS int*)(lds + RT_HIST);
        const int p0 = atomicAdd((int*)(hist + i0), 1), p1 = atomicAdd((int*)(hist + i1), 1), p2 = atomicAdd((int*)(hist + i2), 1), p3 = atomicAdd((int*)(hist + i3), 1);
        *(LAS u32x4*)(lds + RT_ITEMS + (tl2 * 16 + tid) * 16) = (u32x4){(unsigned)((i0 << 16) | p0), (unsigned)((i1 << 16) | p1), (unsigned)((i2 << 16) | p2), (unsigned)((i3 << 16) | p3)};
    }
    __syncthreads();
}
__device__ __forceinline__ void combine_row(int tok, const float* __restrict__ X1, const u16* __restrict__ YB, const int* __restrict__ SOF, const float* __restrict__ TOPG, const float* __restrict__ gain, float* __restrict__ out, int lane) {
    const int4 sl = *(const int4*)(SOF + tok * 4); const f32x4 g = *(const f32x4*)(TOPG + tok * 4);
    const u16* y0 = YB + (size_t)sl.x * DM; const u16* y1 = YB + (size_t)sl.y * DM; const u16* y2 = YB + (size_t)sl.z * DM; const u16* y3 = YB + (size_t)sl.w * DM;
    f32x4 v[8]; float s = 0.f;
#pragma unroll
    for (int j = 0; j < 8; ++j) { const int d = (lane + 64 * j) * 4;
        f32x4 a = *(const f32x4*)(X1 + (size_t)tok * DM + d);
        const u32x2 q0 = *(const u32x2*)(y0 + d), q1 = *(const u32x2*)(y1 + d), q2 = *(const u32x2*)(y2 + d), q3 = *(const u32x2*)(y3 + d);
        a[0] += g[0] * bflo(q0[0]) + g[1] * bflo(q1[0]) + g[2] * bflo(q2[0]) + g[3] * bflo(q3[0]);
        a[1] += g[0] * bfhi(q0[0]) + g[1] * bfhi(q1[0]) + g[2] * bfhi(q2[0]) + g[3] * bfhi(q3[0]);
        a[2] += g[0] * bflo(q0[1]) + g[1] * bflo(q1[1]) + g[2] * bflo(q2[1]) + g[3] * bflo(q3[1]);
        a[3] += g[0] * bfhi(q0[1]) + g[1] * bfhi(q1[1]) + g[2] * bfhi(q2[1]) + g[3] * bfhi(q3[1]);
        v[j] = a; s += a[0] * a[0] + a[1] * a[1] + a[2] * a[2] + a[3] * a[3]; }
    s = wave_sum(s);
    const float r = rsqrtf(s * (1.0f / (float)DM) + EPS);
#pragma unroll
    for (int j = 0; j < 8; ++j) { const int d = (lane + 64 * j) * 4; const f32x4 gn = *(const f32x4*)(gain + d); *(f32x4*)(out + (size_t)tok * DM + d) = v[j] * r * gn; }
}

__device__ __forceinline__ void combine_row2(int tokA, int tokB, const float* __restrict__ X1, const u16* __restrict__ YB, const int* __restrict__ SOF, const float* __restrict__ TOPG, const float* __restrict__ gain, float* __restrict__ out, int lane) {
    const int4 slA = *(const int4*)(SOF + tokA * 4), slB = *(const int4*)(SOF + tokB * 4); const f32x4 gA = *(const f32x4*)(TOPG + tokA * 4), gB = *(const f32x4*)(TOPG + tokB * 4);
    const u16* yA0 = YB + (size_t)slA.x * DM; const u16* yA1 = YB + (size_t)slA.y * DM; const u16* yA2 = YB + (size_t)slA.z * DM; const u16* yA3 = YB + (size_t)slA.w * DM;
    const u16* yB0 = YB + (size_t)slB.x * DM; const u16* yB1 = YB + (size_t)slB.y * DM; const u16* yB2 = YB + (size_t)slB.z * DM; const u16* yB3 = YB + (size_t)slB.w * DM;
    f32x4 vA[8], vB[8]; float sA = 0.f, sB = 0.f;
#pragma unroll
    for (int j = 0; j < 8; ++j) { const int d = (lane + 64 * j) * 4;
        f32x4 a = *(const f32x4*)(X1 + (size_t)tokA * DM + d), b = *(const f32x4*)(X1 + (size_t)tokB * DM + d);
        const u32x2 p0 = *(const u32x2*)(yA0 + d), p1 = *(const u32x2*)(yA1 + d), p2 = *(const u32x2*)(yA2 + d), p3 = *(const u32x2*)(yA3 + d);
        const u32x2 q0 = *(const u32x2*)(yB0 + d), q1 = *(const u32x2*)(yB1 + d), q2 = *(const u32x2*)(yB2 + d), q3 = *(const u32x2*)(yB3 + d);
        a[0] += gA[0] * bflo(p0[0]) + gA[1] * bflo(p1[0]) + gA[2] * bflo(p2[0]) + gA[3] * bflo(p3[0]);
        a[1] += gA[0] * bfhi(p0[0]) + gA[1] * bfhi(p1[0]) + gA[2] * bfhi(p2[0]) + gA[3] * bfhi(p3[0]);
        a[2] += gA[0] * bflo(p0[1]) + gA[1] * bflo(p1[1]) + gA[2] * bflo(p2[1]) + gA[3] * bflo(p3[1]);
        a[3] += gA[0] * bfhi(p0[1]) + gA[1] * bfhi(p1[1]) + gA[2] * bfhi(p2[1]) + gA[3] * bfhi(p3[1]);
        b[0] += gB[0] * bflo(q0[0]) + gB[1] * bflo(q1[0]) + gB[2] * bflo(q2[0]) + gB[3] * bflo(q3[0]);
        b[1] += gB[0] * bfhi(q0[0]) + gB[1] * bfhi(q1[0]) + gB[2] * bfhi(q2[0]) + gB[3] * bfhi(q3[0]);
        b[2] += gB[0] * bflo(q0[1]) + gB[1] * bflo(q1[1]) + gB[2] * bflo(q2[1]) + gB[3] * bflo(q3[1]);
        b[3] += gB[0] * bfhi(q0[1]) + gB[1] * bfhi(q1[1]) + gB[2] * bfhi(q2[1]) + gB[3] * bfhi(q3[1]);
        vA[j] = a; vB[j] = b; sA += a[0] * a[0] + a[1] * a[1] + a[2] * a[2] + a[3] * a[3]; sB += b[0] * b[0] + b[1] * b[1] + b[2] * b[2] + b[3] * b[3]; }
    sA = wave_sum(sA); sB = wave_sum(sB);
    const float rA = rsqrtf(sA * (1.0f / (float)DM) + EPS), rB = rsqrtf(sB * (1.0f / (float)DM) + EPS);
#pragma unroll
    for (int j = 0; j < 8; ++j) { const int d = (lane + 64 * j) * 4; const f32x4 gn = *(const f32x4*)(gain + d);
        *(f32x4*)(out + (size_t)tokA * DM + d) = vA[j] * rA * gn; *(f32x4*)(out + (size_t)tokB * DM + d) = vB[j] * rB * gn; }
}
#ifndef REP_P9
#define REP_P9 1
#endif
#ifndef REP_P3
#define REP_P3 1
#endif
#ifndef REP_FR
#define REP_FR 1
#endif
#ifndef REP_P0
#define REP_P0 1
#endif
#ifndef REP_CONV
#define REP_CONV 1
#endif
#ifndef REP_GEMM1
#define REP_GEMM1 1
#endif
#ifndef REP_HY
#define REP_HY 1
#endif
#ifndef REP_HG
#define REP_HG 1
#endif
#ifndef REP_MOEA
#define REP_MOEA 1
#endif
#ifndef REP_MOEB
#define REP_MOEB 1
#endif
#ifndef REP_WOUT
#define REP_WOUT 1
#endif
struct MegaP {
    const float *x, *norm_mix_gain, *w_in, *lb_logits, *hgrn_norm_gain, *hy_conv_w, *hy_conv_b, *fw1, *fb1, *fw2, *fb2, *fw3, *fb3, *fw4, *ffreq, *hy_bias, *hy_norm_gain, *w_out,
        *norm_ffn_gain, *w_router, *b_router, *moe_w1, *moe_b1, *moe_w2, *moe_b2, *final_gain;
    float* out; unsigned char* ws;
};
constexpr int MEGA_XB = RT_END;
constexpr int MEGA_LDS = RT_END + 64 + 384;
static_assert(MEGA_LDS >= HY_LDS + 64 && MEGA_LDS >= HG_LDS + 64 && MEGA_LDS >= GEMM_LDS + 64, "LDS");

__global__ void __launch_bounds__(512, 2) k_mega(const MegaP p_arg) {
    extern __shared__ __attribute__((aligned(16))) unsigned char shm[];
    LAS unsigned char* lds = (LAS unsigned char*)shm;
    const int tid = threadIdx.x, wid = __builtin_amdgcn_readfirstlane(tid >> 6), lane = tid & 63;
    const int G = gridDim.x, bid = blockIdx.x, c = xcd_logical(bid, G);
#define PHASE_ARGS() const MegaP __attribute__((address_space(4)))* pq_ = (const MegaP __attribute__((address_space(4)))*)__builtin_amdgcn_kernarg_segment_ptr(); asm volatile("" : "+s"(pq_)); unsigned char* ws = pq_->ws; (void)ws
    unsigned char* ws0; { PHASE_ARGS(); ws0 = ws; }
#define counts ((int*)(ws + WS_CTL))
#define cursor ((int*)(ws + WS_CTL + 4096))
#define offs ((int*)(ws + WS_CTL + 8192))
#define barw ((unsigned*)(ws + WS_CTL + 16384))
#define HB ((u16*)(ws + WS_HB))
#define PG ((u16*)(ws + WS_PG))
#define HYT ((u16*)(ws + WS_HYT))
#define MIXB ((u16*)(ws + WS_MIXB))
#define XNB ((u16*)(ws + WS_XNB))
#define HMB ((u16*)(ws + WS_HMS))
#define YB ((u16*)(ws + WS_YS))
#define H3 ((float*)(ws + WS_H3))
#define FR ((u16*)(ws + WS_FR))
#define Z2T ((u16*)(ws + WS_Z2T))
#define OF ((float*)(ws + WS_OF))
#define OB ((float*)(ws + WS_OB))
#define X1 ((float*)(ws + WS_X1))
#define TOPI ((int*)(ws + WS_TOPI))
#define TOPG ((float*)(ws + WS_TOPG))
#define STOK ((int*)(ws + WS_STOKS))
#define SOF ((int*)(ws + WS_SOF))
#define WINT ((u16*)(ws + WS_WINT))
#define WOUTT ((u16*)(ws + WS_WOUTT))
#define W1T ((u16*)(ws + WS_W1T))
#define W2T ((u16*)(ws + WS_W2T))
    if (tid == 0) *(LAS u32x4*)(lds + MEGA_XB) = (u32x4){0u, 0u, 0u, 0u};
    __syncthreads();
    XcdBarrier bar = xcd_barrier_post((unsigned*)(ws0 + WS_CTL + 16384), (volatile LAS unsigned*)(lds + MEGA_XB));

    {
        PHASE_ARGS();
    for (int rep = 0; rep < REP_P0; ++rep) {
    for (int row = bid * 8 + wid; row < NTOK; row += G * 8) rmsnorm_row_bf(pq_->x + (size_t)row * DM, pq_->norm_mix_gain, HB + (size_t)row * DM, lane);
    for (int m = bid * 8 + wid; m < SEQ; m += G * 8) h3_row(m, pq_->fw1, pq_->fb1, pq_->fw2, pq_->fb2, pq_->fw3, pq_->fb3, pq_->ffreq, (LAS float*)(lds + wid * 512), H3); }
    for (int rep = 0; rep < REP_CONV; ++rep)
    for (int id = bid; id < 1024 + 256; id += G) {
        const int tz = tid_fresh();
        if (id < 1024) { const int nt = id >> 5, kt = id & 31; convert_tile(pq_->w_in, DIN, kt * 64, ColMapPerm{nt * 256}, WINT + (size_t)id * 16384, tz); }
        else { const int q = id - 1024; const ConvCtx cw{nullptr, pq_->w_out, nullptr, (unsigned char*)WOUTT};
            f32x2 cv[16]; conv_issue(cw, 16384 + q, tz >> 6, tz & 63, cv); conv_finish(cw, 16384 + q, tz >> 6, tz & 63, cv); }
    }
    }
    xcd_barrier(bar);
    {
        PHASE_ARGS();
    for (int rep = 0; rep < REP_FR; ++rep)
    for (int item = bid; item < 256; item += G) frgen_item(lds, item, H3, pq_->fw4, FR);
    { SrcG1<false> s0{c, G, (const char*)HB, (const char*)WINT, PG, HYT, pq_->lb_logits}; gemm8_stream<false, false>(lds, DM, 32, s0);
      SrcG1<true> s1{c, G, (const char*)HB, (const char*)WINT, PG, HYT, pq_->lb_logits}; gemm8_stream<true, false>(lds, DM, 32, s1); }
#ifdef PROBE_NOEPI
    for (int u = c; u < 1024; u += G) {
        const int i = u >> 8, xx = (u >> 5) & 7, j = u & 31;
        const int mt = (xx & 3) * 8 + (j & 7), nt = ((xx >> 2) + 2 * i) * 4 + (j >> 3);
        const u16* bt = WINT + (size_t)nt * 32 * 16384;
        EpiNone e{}; if (nt < 20) gemm8_unit<false>(lds, HB, DM, nullptr, mt * 256, 256, bt, 32, e); else gemm8_unit<true>(lds, HB, DM, nullptr, mt * 256, 256, bt, 32, e);
    }
#endif
    }
    xcd_barrier(bar);
    {
        PHASE_ARGS();
    for (int rep = 0; rep < REP_HY; ++rep)
    for (int u = bid; u < 256; u += G) hyena_unit(lds, u, HYT, FR, pq_->hy_conv_w, pq_->hy_conv_b, pq_->hy_bias, Z2T, ConvCtx{pq_->moe_w1, pq_->moe_w2, (unsigned char*)W1T, (unsigned char*)W2T});
    for (int rep = 0; rep < REP_HG; ++rep)
    for (int u = bid; u < 256; u += G) hgrn_unit(lds, u, PG, pq_->lb_logits, OF, OB, ConvCtx{pq_->moe_w1, pq_->moe_w2, (unsigned char*)W1T, (unsigned char*)W2T});
    }
    xcd_barrier(bar);
    {
        PHASE_ARGS();
    for (int rep = 0; rep < REP_P3; ++rep) {
    for (int it = bid * 8 + wid; it < NTOK * HGH; it += G * 8 * 4) hgrn_final_item4(it, G * 8, OF, OB, PG, pq_->hgrn_norm_gain, MIXB, lane);
    for (int t = bid; t < NTOK / 32; t += G) hy_norm_tile(lds, t, Z2T, pq_->hy_norm_gain, MIXB); }
    }
    xcd_barrier(bar);
    {
        PHASE_ARGS();
    for (int u = c; u < 256; u += G) {
        const int xx = u >> 5, j = u & 31;
        const int mt = (xx >> 1) * 8 + (j & 7), nt = (xx & 1) * 4 + (j >> 3);
        Epi8X1 e{pq_->x, X1, mt * 256, nt * 256};
        gemm8_unit<false, true>(lds, MIXB, DM / 2, nullptr, mt * 256, 256, WOUTT + (size_t)nt * 16 * 16384, 16, e);
    }
    }
    xcd_barrier(bar);
    {
        PHASE_ARGS();
    if (tid < NE) *(LAS int*)(lds + RT_HIST + tid * 4) = 0;
    __syncthreads();
    for (int t0 = bid; t0 < NTOK / 16; t0 += 2 * G) {
        const int t1 = t0 + G, ntl = (t1 < NTOK / 16) ? 2 : 1;
        router_tile(lds, t0, X1, pq_->norm_ffn_gain, pq_->w_router, pq_->b_router, (unsigned char*)XNB, TOPG, 0);
        if (ntl == 2) router_tile(lds, t1, X1, pq_->norm_ffn_gain, pq_->w_router, pq_->b_router, (unsigned char*)XNB, TOPG, 1);
        const int tq = tid_fresh();
        if (tq < NE) { const int n = *(const LAS int*)(lds + RT_HIST + tq * 4); *(LAS int*)(lds + RT_RBASE + tq * 4) = n ? atomicAdd(&cursor[tq * 32], n) : 0; *(LAS int*)(lds + RT_HIST + tq * 4) = 0; }
        __syncthreads();
        if (tq < ntl * 64) { const int it = *(const LAS int*)(lds + RT_ITEMS + tq * 4), e = it >> 16, tok = ((tq >> 6) ? t1 : t0) * 16 + ((tq >> 2) & 15);
            const int slot = e * NTOK + *(const LAS int*)(lds + RT_RBASE + e * 4) + (it & 0xffff); STOK[slot] = tok; SOF[tok * 4 + (tq & 3)] = slot; }
        __syncthreads();
    }
    }
    xcd_barrier(bar);
    {
        PHASE_ARGS();
    {
        LAS int* us = (LAS int*)(lds + MEGA_XB + 64); LAS int* so2 = us + 40;
        if (tid < NE) so2[tid] = __hip_atomic_load(&cursor[tid * 32], __ATOMIC_RELAXED, __HIP_MEMORY_SCOPE_AGENT);
        __syncthreads();
        if (tid == 0) { int a = 0; for (int e = 0; e < NE; ++e) { us[e] = a; a += ((so2[e] + 255) >> 8) * 16; } us[NE] = a; }
        __syncthreads();
    }
    {
        LAS int* qs = (LAS int*)(lds + MEGA_XB + 32); LAS int* us = (LAS int*)(lds + MEGA_XB + 64); LAS int* so2 = us + 40;
        int* qctr = (int*)(ws + WS_CTL + 12288 + (bid & 7) * 128);
        int tk_next = 0;
        if (tid == 0) tk_next = atomicAdd(qctr, 1);
        for (;;) {
            if (tid == 0) { qs[0] = tk_next; qs[1] = -1; }
            __syncthreads();
            const int tk = qs[0];
            const int u = 256 * (tk >> 5) + 32 * (bid & 7) + (tk & 31);
            if (tid < NE) { const int u0 = us[tid], u1 = us[tid + 1]; if (u >= u0 && u < u1) { const int o0 = tid * NTOK, cnt = so2[tid], mtl = (cnt + 255) >> 8, ul = u - u0, mt = ul % mtl;
                int rows = cnt - mt * 256; rows = rows > 256 ? 256 : rows; qs[1] = tid; qs[2] = ul / mtl; qs[3] = o0 + mt * 256; qs[4] = rows; } }
            __syncthreads();
            const int e = qs[1], nt = qs[2], slot0 = qs[3], rows = qs[4];
            __syncthreads();
            if (e < 0) break;
            if (tid == 0) tk_next = atomicAdd(qctr, 1);
            Epi8Swiglu8 ep{(unsigned char*)HMB, pq_->moe_b1 + (size_t)e * 2 * DFF, slot0, nt, rows};
            gemm8_unit<false, true>(lds, XNB, DM / 2, STOK + slot0, 0, rows, W1T + (size_t)(e * 16 + nt) * 16 * 16384, 16, ep);
        }
    }
    }
    xcd_barrier(bar);
    {
        PHASE_ARGS();
    {
        LAS int* us = (LAS int*)(lds + MEGA_XB + 64); LAS int* so2 = us + 40;
        if (tid < NE) so2[tid] = __hip_atomic_load(&cursor[tid * 32], __ATOMIC_RELAXED, __HIP_MEMORY_SCOPE_AGENT);
        __syncthreads();
        if (tid == 0) { int a = 0; for (int e = 0; e < NE; ++e) { us[e] = a; a += ((so2[e] + 255) >> 8) * 8; } us[NE] = a; }
        __syncthreads();
    }
    {
        const LAS int* us = (const LAS int*)(lds + MEGA_XB + 64); const LAS int* so2 = us + 40;
        SrcMoeB src{us, so2, c, G, (const char*)HMB, (const char*)W2T, YB, pq_->moe_b2};
        gemm8_stream<false, true>(lds, DFF / 2, 16, src);
    }
    }
    xcd_barrier(bar);
    {
        PHASE_ARGS();
    for (int rep = 0; rep < REP_P9; ++rep)
    for (int tok = bid * 8 + wid; tok < NTOK; tok += G * 8) combine_row(tok, X1, YB, SOF, TOPG, pq_->final_gain, pq_->out, lane);
    }
}
#undef counts
#undef cursor
#undef offs
#undef barw
#undef HB
#undef PG
#undef HYT
#undef MIXB
#undef XNB
#undef HMB
#undef YB
#undef H3
#undef FR
#undef Z2T
#undef OF
#undef OB
#undef X1
#undef TOPI
#undef TOPG
#undef STOK
#undef SOF
#undef WINT
#undef WOUTT
#undef W1T
#undef W2T

extern "C" void kernel_launch(void* const* d_in, const int* in_sizes, int n_in, void* d_out, int out_size, void* d_ws, size_t ws_size, hipStream_t stream) {
    if (n_in < 26 || ws_size < WS_END2) return;
    MegaP p{};
    const float** pp = (const float**)&p;
    for (int i = 0; i < 26; ++i) pp[i] = (const float*)d_in[i];
    p.out = (float*)d_out; p.ws = (unsigned char*)d_ws;
    static int grid = 0;
    if (!grid) {
        int dev = 0, cus = 0, per_cu = 0;
        (void)hipGetDevice(&dev);
        (void)hipDeviceGetAttribute(&cus, hipDeviceAttributeMultiprocessorCount, dev);
        (void)hipFuncSetAttribute((const void*)k_mega, hipFuncAttributeMaxDynamicSharedMemorySize, MEGA_LDS);
        (void)hipOccupancyMaxActiveBlocksPerMultiprocessor(&per_cu, (const void*)k_mega, 512, MEGA_LDS);
        if (per_cu < 1) per_cu = 1;
        grid = cus * 1;
        if (grid > 256) grid = 256;
        grid &= ~7;
        if (grid < 8) grid = 8;
    }
    (void)hipMemsetAsync((char*)d_ws + WS_CTL, 0, 65536, stream);
    hipLaunchKernelGGL(k_mega, dim3(grid), dim3(512), MEGA_LDS, stream, p);
}
```

```cpp
#include <hip/hip_runtime.h>
#include <stdint.h>

constexpr int BATCH = 4, SEQ = 2048, DM = 2048, NTOK = BATCH * SEQ;
constexpr int HGW = 1024, HGD = 128, HGH = 8;
constexpr int HYW = 1024;
constexpr int DIN = 8192;
constexpr int NE = 32, TOPK = 4, DFF = 2048;
constexpr int NSLOT = NTOK * TOPK;
constexpr float EPS = 1e-5f;

constexpr size_t MB = 1024ull * 1024ull;
constexpr size_t WS_CTL = 0;
constexpr size_t WS_HB = 1 * MB;
constexpr size_t WS_PG = WS_HB + 32 * MB;
constexpr size_t WS_HYT = WS_PG + 80 * MB;
constexpr size_t WS_MIXB = WS_HYT + 48 * MB;
constexpr size_t WS_XNB = WS_MIXB + 32 * MB;
constexpr size_t WS_HMB = WS_XNB + 32 * MB;
constexpr size_t WS_YB = WS_HMB + 128 * MB;
constexpr size_t WS_H3 = WS_YB + 128 * MB;
constexpr size_t WS_FR = WS_H3 + 1 * MB;
constexpr size_t WS_Z2T = WS_FR + 34 * MB;
constexpr size_t WS_OF = WS_Z2T + 16 * MB;
constexpr size_t WS_OB = WS_OF + 32 * MB;
constexpr size_t WS_X1 = WS_OB + 32 * MB;
constexpr size_t WS_TOPI = WS_X1 + 64 * MB;
constexpr size_t WS_TOPG = WS_TOPI + 1 * MB;
constexpr size_t WS_STOK = WS_TOPG + 1 * MB;
constexpr size_t WS_SOF = WS_STOK + 1 * MB;
constexpr size_t WS_WINT = WS_SOF + 1 * MB;
constexpr size_t WS_WOUTT = WS_WINT + 32 * MB;
constexpr size_t WS_W1T = WS_WOUTT + 8 * MB;
constexpr size_t WS_W2T = WS_W1T + 512 * MB;
constexpr size_t WS_HMS = WS_W2T + 256 * MB;
constexpr size_t WS_YS = WS_HMS + 512 * MB;
constexpr size_t WS_STOKS = WS_YS + 1024 * MB;
constexpr size_t WS_END2 = WS_STOKS + 1 * MB;

typedef short bf16x8 __attribute__((ext_vector_type(8)));
typedef float f32x4 __attribute__((ext_vector_type(4)));
typedef float f32x2 __attribute__((ext_vector_type(2)));
typedef unsigned u32x4 __attribute__((ext_vector_type(4)));
typedef unsigned u32x2 __attribute__((ext_vector_type(2)));
typedef unsigned short u16;
#define LAS __attribute__((address_space(3)))

__device__ __forceinline__ unsigned pk_bf16(float lo, float hi) {
    typedef __bf16 bf2 __attribute__((ext_vector_type(2)));
    const f32x2 v = {lo, hi};
    const bf2 r = __builtin_convertvector(v, bf2);
    return __builtin_bit_cast(unsigned, r);
}
__device__ __forceinline__ float bf2f(u16 b) { return __uint_as_float(((unsigned)b) << 16); }
__device__ __forceinline__ float bflo(unsigned w) { return __uint_as_float(w << 16); }
__device__ __forceinline__ float bfhi(unsigned w) { return __uint_as_float(w & 0xffff0000u); }

__device__ __forceinline__ int lds_byte(int r, int c) { const int st = (r >> 4) * 2 + (c >> 5), ob = (r & 15) * 64 + (c & 31) * 2; return st * 1024 + (ob ^ (((ob >> 9) & 1) << 5)); }
__device__ __forceinline__ void stage_rc(int b, int& R, int& C) { const int st = b >> 10, sb = b & 1023, swz = sb ^ (((sb >> 9) & 1) << 5); R = (st >> 1) * 16 + swz / 64; C = (st & 1) * 32 + (swz % 64) / 2; }
__device__ __forceinline__ f32x4 unperm(const f32x4 a, const bool s) { f32x4 o; o[0] = s ? a[1] : a[0]; o[1] = s ? a[0] : a[1]; o[2] = s ? a[3] : a[2]; o[3] = s ? a[2] : a[3]; return o; }

__device__ __forceinline__ int tid_fresh() { int t = threadIdx.x; asm volatile("" : "+v"(t)); return t; }
constexpr int GEMM_LDS = 131072;

template <bool TRANS, bool RAGGED, int PM = 0, class ColMap, class Epi>
__device__ __forceinline__ void gemm_unit(LAS unsigned char* lds, const u16* __restrict__ A, int lda, const int* __restrict__ arows, int arow0, int rows_valid,
                                          const float* __restrict__ B, int ldb, int K, const ColMap colmap, const Epi epi) {
    const int tid = tid_fresh(), wid = __builtin_amdgcn_readfirstlane(tid >> 6), lane = tid & 63;
    const int wr = wid >> 2, wc = wid & 3, fr = lane & 15, fq = lane >> 4;
    const int nt = K >> 6;
    const char* ap[4];
#pragma unroll
    for (int i = 0; i < 4; ++i) {
        int R, C; stage_rc(wid * 1024 + i * 8192 + lane * 16, R, C);
        const int rr = RAGGED ? (R < rows_valid ? R : rows_valid - 1) : R;
        const long rowid = arows ? (long)arows[rr] : (long)(arow0 + rr);
        ap[i] = (const char*)A + ((size_t)rowid * lda + C) * 2;
    }
    const int g = (lane & 3) + 4 * (wid >> 2), rg = (wid & 3) * 16 + (lane >> 2);
    const unsigned bvoff = (unsigned)(((size_t)(8 * g) * ldb + colmap(rg)) * 4);
    const int bbase = 65536 + lds_byte(4 * rg, 8 * g);
    const int bw0 = bbase + ((rg & 1) ? 64 : 0), bw1 = bbase + ((rg & 1) ? 0 : 64);
    const int aoff = lds_byte(wr * 128 + fr, fq * 8), boff = 65536 + lds_byte(wc * 64 + fr, fq * 8);
    int mvalid = 8;
    if (RAGGED) { mvalid = (rows_valid - wr * 128 + 15) >> 4; mvalid = mvalid < 0 ? 0 : (mvalid > 8 ? 8 : mvalid); }
    f32x4 vb0, vb1, vb2, vb3, vb4, vb5, vb6, vb7;
    if (PM & 1) { vb0 = (f32x4){1.f, 1.f, 1.f, 1.f}; vb1 = vb0; vb2 = vb0; vb3 = vb0; vb4 = vb0; vb5 = vb0; vb6 = vb0; vb7 = vb0; }
    f32x4 acc[8][4];
#pragma unroll
    for (int m = 0; m < 8; ++m)
#pragma unroll
        for (int n = 0; n < 4; ++n) acc[m][n] = (f32x4){0.f, 0.f, 0.f, 0.f};
    const size_t ldb4 = (size_t)ldb * 4;
#define GE_GLDS_A(buf, kt) do { if (!(PM & 2)) _Pragma("unroll") for (int _i = 0; _i < 4; ++_i) \
        __builtin_amdgcn_global_load_lds((const unsigned*)(ap[_i] + (size_t)(kt) * 128), (LAS unsigned*)(lds + (buf) * 32768 + wid * 1024 + _i * 8192), 16, 0, 0); } while (0)
#define GE_LD1(dst, sb) if (!(PM & 1)) asm volatile("global_load_dwordx4 %0, %1, %2" : "=v"(dst) : "v"(bvoff), "s"(sb) : "memory")
#define GE_LOAD_B(kt) do { const char* _sb = (const char*)B + (size_t)(kt) * 64 * ldb4; \
        GE_LD1(vb0, _sb); GE_LD1(vb1, _sb + ldb4); GE_LD1(vb2, _sb + 2 * ldb4); GE_LD1(vb3, _sb + 3 * ldb4); \
        GE_LD1(vb4, _sb + 4 * ldb4); GE_LD1(vb5, _sb + 5 * ldb4); GE_LD1(vb6, _sb + 6 * ldb4); GE_LD1(vb7, _sb + 7 * ldb4); } while (0)
#define GE_WAITV_B(n) asm volatile("s_waitcnt vmcnt(" #n ")" : "+v"(vb0), "+v"(vb1), "+v"(vb2), "+v"(vb3), "+v"(vb4), "+v"(vb5), "+v"(vb6), "+v"(vb7) :: "memory")
#define GE_WRITE_B(buf) do { _Pragma("unroll") for (int _i = 0; _i < 4; ++_i) { u32x4 _w; _w[0] = pk_bf16(vb0[_i], vb1[_i]); _w[1] = pk_bf16(vb2[_i], vb3[_i]); \
        _w[2] = pk_bf16(vb4[_i], vb5[_i]); _w[3] = pk_bf16(vb6[_i], vb7[_i]); \
        *(LAS u32x4*)(lds + ((_i & 1) ? bw1 : bw0) + (_i >> 1) * 128 + (buf) * 32768) = _w; } } while (0)
#define GE_KSTEP(buf, ks) do { bf16x8 Bf[4]; \
        _Pragma("unroll") for (int n = 0; n < 4; ++n) Bf[n] = *(const LAS bf16x8*)(lds + (buf) * 32768 + boff + n * 2048 + (ks) * 1024); \
        _Pragma("unroll") for (int mh = 0; mh < 2; ++mh) { bf16x8 At[4]; \
            _Pragma("unroll") for (int m = 0; m < 4; ++m) At[m] = *(const LAS bf16x8*)(lds + (buf) * 32768 + aoff + (mh * 4 + m) * 2048 + (ks) * 1024); \
            _Pragma("unroll") for (int m = 0; m < 4; ++m) { if (!RAGGED || (mh * 4 + m) < mvalid) { _Pragma("unroll") for (int n = 0; n < 4; ++n) \
                { if (PM & 4) { asm volatile("" :: "v"(At[m]), "v"(Bf[n])); } else acc[mh * 4 + m][n] = TRANS ? __builtin_amdgcn_mfma_f32_16x16x32_bf16(At[m], Bf[n], acc[mh * 4 + m][n], 0, 0, 0) : __builtin_amdgcn_mfma_f32_16x16x32_bf16(Bf[n], At[m], acc[mh * 4 + m][n], 0, 0, 0); } } } } } while (0)
    GE_GLDS_A(0, 0);
    GE_LOAD_B(0);
    GE_WAITV_B(0);
    GE_WRITE_B(0);
    GE_LOAD_B(1);
    asm volatile("s_waitcnt lgkmcnt(0)" ::: "memory");
    __builtin_amdgcn_s_barrier();
    int t = 0;
    for (; t < nt - 2; ++t) {
        const int cur = t & 1;
        GE_GLDS_A(cur ^ 1, t + 1);
        GE_KSTEP(cur, 0);
        GE_WAITV_B(4);
        GE_WRITE_B(cur ^ 1);
        GE_LOAD_B(t + 2);
        __builtin_amdgcn_sched_barrier(0);
        GE_KSTEP(cur, 1);
        asm volatile("s_waitcnt vmcnt(8) lgkmcnt(0)" ::: "memory");
        __builtin_amdgcn_s_barrier();
    }
    {
        const int cur = t & 1;
        GE_GLDS_A(cur ^ 1, t + 1);
        GE_KSTEP(cur, 0);
        GE_WAITV_B(4);
        GE_WRITE_B(cur ^ 1);
        GE_KSTEP(cur, 1);
        asm volatile("s_waitcnt vmcnt(0) lgkmcnt(0)" ::: "memory");
        __builtin_amdgcn_s_barrier();
        ++t;
    }
    {
        const int cur = t & 1;
        GE_KSTEP(cur, 0);
        GE_KSTEP(cur, 1);
        asm volatile("s_waitcnt lgkmcnt(0)" ::: "memory");
        __builtin_amdgcn_s_barrier();
    }
#undef GE_GLDS_A
#undef GE_LD1
#undef GE_LOAD_B
#undef GE_WAITV_B
#undef GE_WRITE_B
#undef GE_KSTEP
    __builtin_amdgcn_sched_barrier(0);
    { const int tz = tid_fresh(), wz = __builtin_amdgcn_readfirstlane(tz >> 6), lz = tz & 63;
      epi(acc, wz >> 2, wz & 3, lz & 15, lz >> 4); }
}

__device__ __forceinline__ int xcd_logical(int b, int G) { return (G & 7) ? b : (b & 7) * (G >> 3) + (b >> 3); }

struct ColMapDense { int c0; __device__ __forceinline__ int operator()(int rg) const { return c0 + 4 * rg; } };
struct EpiPG { u16* PG; int tok0, col0;
    __device__ __forceinline__ void operator()(const f32x4 (&acc)[8][4], int wr, int wc, int fr, int fq) const {
#pragma unroll
        for (int m = 0; m < 8; ++m) { u16* rowp = PG + (size_t)(tok0 + wr * 128 + m * 16 + fr) * 5120 + col0 + wc * 64 + 4 * fq;
#pragma unroll
            for (int n = 0; n < 4; ++n) { const f32x4 v = unperm(acc[m][n], fq & 1); u32x2 w; w[0] = pk_bf16(v[0], v[1]); w[1] = pk_bf16(v[2], v[3]); *(u32x2*)(rowp + n * 16) = w; } }
    } };
struct EpiHYT { u16* HYT; int tok0, col0;
    __device__ __forceinline__ void operator()(const f32x4 (&acc)[8][4], int wr, int wc, int fr, int fq) const {
#pragma unroll
        for (int n = 0; n < 4; ++n) { const int rho = wc * 64 + n * 16 + fr; const int col = col0 + (rho & ~3) + ((rho & 3) ^ ((rho >> 2) & 1));
            u16* colp = HYT + (size_t)col * NTOK + tok0 + wr * 128 + 4 * fq;
#pragma unroll
            for (int m = 0; m < 8; ++m) { const f32x4 v = acc[m][n]; u32x2 w; w[0] = pk_bf16(v[0], v[1]); w[1] = pk_bf16(v[2], v[3]); *(u32x2*)(colp + m * 16) = w; } }
    } };
struct EpiX1 { const float* x; float* X1; int tok0, col0;
    __device__ __forceinline__ void operator()(const f32x4 (&acc)[8][4], int wr, int wc, int fr, int fq) const {
#pragma unroll
        for (int m = 0; m < 8; ++m) { const size_t off = (size_t)(tok0 + wr * 128 + m * 16 + fr) * DM + col0 + wc * 64 + 4 * fq;
#pragma unroll
            for (int n = 0; n < 4; ++n) { const f32x4 r = *(const f32x4*)(x + off + n * 16); *(f32x4*)(X1 + off + n * 16) = r + unperm(acc[m][n], fq & 1); }
            asm volatile("" ::: "memory"); }
    } };
struct ColMapGlu { int nt; __device__ __forceinline__ int operator()(int rg) const { const int wcq = rg >> 4, n = (rg >> 2) & 3, f = rg & 3; return (n >> 1) * 2048 + nt * 128 + wcq * 32 + (n & 1) * 16 + f * 4; } };
struct EpiSwiglu { u16* HM; const float* b1; int slot0, nt, rows_valid;
    __device__ __forceinline__ void operator()(const f32x4 (&acc)[8][4], int wr, int wc, int fr, int fq) const {
        f32x4 bg[2], bl[2];
#pragma unroll
        for (int nn = 0; nn < 2; ++nn) { const int col = nt * 128 + wc * 32 + nn * 16 + 4 * fq; bg[nn] = *(const f32x4*)(b1 + col); bl[nn] = *(const f32x4*)(b1 + 2048 + col); }
#pragma unroll
        for (int m = 0; m < 8; ++m) { const int row = wr * 128 + m * 16 + fr;
            if (row < rows_valid) {
#pragma unroll
                for (int nn = 0; nn < 2; ++nn) { const f32x4 gl = unperm(acc[m][nn], fq & 1) + bg[nn], li = unperm(acc[m][nn + 2], fq & 1) + bl[nn]; float o[4];
#pragma unroll
                    for (int j = 0; j < 4; ++j) { const float gq = fminf(gl[j], 7.0f), lq = fminf(fmaxf(li[j], -7.0f), 7.0f); o[j] = gq * (1.0f / (1.0f + __expf(-1.702f * gq))) * (lq + 1.0f); }
                    u32x2 w; w[0] = pk_bf16(o[0], o[1]); w[1] = pk_bf16(o[2], o[3]);
                    *(u32x2*)(HM + (size_t)(slot0 + row) * DFF + nt * 128 + wc * 32 + nn * 16 + 4 * fq) = w; } } }
    } };
struct EpiY { u16* Y; const float* b2; int slot0, col0, rows_valid;
    __device__ __forceinline__ void operator()(const f32x4 (&acc)[8][4], int wr, int wc, int fr, int fq) const {
        f32x4 bv[4];
#pragma unroll
        for (int n = 0; n < 4; ++n) bv[n] = *(const f32x4*)(b2 + col0 + wc * 64 + n * 16 + 4 * fq);
#pragma unroll
        for (int m = 0; m < 8; ++m) { const int row = wr * 128 + m * 16 + fr;
            if (row < rows_valid) { u16* rowp = Y + (size_t)(slot0 + row) * DM + col0 + wc * 64 + 4 * fq;
#pragma unroll
                for (int n = 0; n < 4; ++n) { const f32x4 v = unperm(acc[m][n], fq & 1) + bv[n]; u32x2 w; w[0] = pk_bf16(v[0], v[1]); w[1] = pk_bf16(v[2], v[3]); *(u32x2*)(rowp + n * 16) = w; } } }
    } };
template <int NTILES>
__device__ __forceinline__ bool moe_decode(const int* __restrict__ offs, int u, int& e, int& mt, int& nt, int& slot0, int& rows) {
    int base = 0;
    for (int q = 0; q < NE; ++q) { const int o0 = offs[q], cnt = offs[q + 1] - o0, mtl = (cnt + 255) >> 8, nu = mtl * NTILES;
        if (u < base + nu) { const int ul = u - base; e = q; mt = ul % mtl; nt = ul / mtl; slot0 = o0 + mt * 256; rows = cnt - mt * 256; if (rows > 256) rows = 256; return true; }
        base += nu; }
    return false;
}


__device__ __forceinline__ int perm_col4(int rg) { const int rgl = rg & 31, t = rgl & 7; return 32 * (rgl >> 3) + 8 * (t & 3) + 4 * (t >> 2); }
__device__ __forceinline__ int perm32(int rho) { const int n = rho >> 4, i = rho & 15; return 8 * (i >> 2) + 4 * n + (i & 3); }
template <class ColMap>
__device__ __forceinline__ void convert_tile(const float* __restrict__ W, int ldb, int k0, const ColMap colmap, u16* __restrict__ dst, int tid) {
    const int wid = tid >> 6, lane = tid & 63;
    const int g = (lane & 3) + 4 * (wid >> 2), rg = (wid & 3) * 16 + (lane >> 2);
    const float* bp = W + (size_t)(k0 + 8 * g) * ldb + colmap(rg);
    f32x4 v[8];
#pragma unroll
    for (int kk = 0; kk < 8; ++kk) v[kk] = __builtin_nontemporal_load((const f32x4*)(bp + (size_t)kk * ldb));
    const int h = rg >> 5, r0 = (4 * rg) & 127;
    unsigned char* base = (unsigned char*)dst + h * 16384 + lds_byte(r0, 8 * g);
#pragma unroll
    for (int i = 0; i < 4; ++i) { u32x4 w; w[0] = pk_bf16(v[0][i], v[1][i]); w[1] = pk_bf16(v[2][i], v[3][i]); w[2] = pk_bf16(v[4][i], v[5][i]); w[3] = pk_bf16(v[6][i], v[7][i]);
        *(u32x4*)(base + i * 64) = w; }
}
typedef int i32x8 __attribute__((ext_vector_type(8)));
typedef int i32x4 __attribute__((ext_vector_type(4)));
constexpr float W8_SCALE = 32.0f;
constexpr int W8_MX = 0x7A7A7A7A;
constexpr int A8_MX = 0x7F7F7F7F;
__device__ __forceinline__ unsigned pk_fp8x4(float a, float b, float c, float d) { int p = __builtin_amdgcn_cvt_pk_fp8_f32(a, b, 0, false); p = __builtin_amdgcn_cvt_pk_fp8_f32(c, d, p, true); return (unsigned)p; }
__device__ __forceinline__ int lds_byte_b(int r, int cb) { const int st = (r >> 4) * 2 + (cb >> 6), ob = (r & 15) * 64 + (cb & 63); return st * 1024 + (ob ^ (((ob >> 9) & 1) << 5)); }
struct ConvCtx { const float* w1; const float* w2; unsigned char* W1T; unsigned char* W2T; };
__device__ __forceinline__ int conv_seq2tile(int s) {
    if (s < 16384) return (s >> 9) * 512 + (s & 15) * 32 + ((s >> 4) & 31);
    const int q = s - 16384; return 16384 + (q >> 8) * 256 + (q & 7) * 32 + ((q >> 3) & 31);
}
__device__ __forceinline__ void conv_issue(const ConvCtx& cc, int m, int wid, int lane, f32x2 (&v)[16]) {
    const int rp = 16 * wid + (lane & 15), rg = rp >> 1, p2 = (rp & 1) * 2, kg = lane >> 4;
    const float* bp; size_t ld;
    if (m < 16384) { const int e = m >> 9, nt = (m >> 5) & 15, kt = m & 31; ld = 2 * DFF; bp = cc.w1 + (size_t)e * DM * 2 * DFF + (size_t)(kt * 64 + 16 * kg) * ld + (rg >> 5) * 2048 + nt * 128 + perm_col4(rg) + p2; }
    else { const int q = m - 16384, e = q >> 8, nt = (q >> 5) & 7, kt = q & 31; ld = DM; bp = cc.w2 + (size_t)e * DFF * DM + (size_t)(kt * 64 + 16 * kg) * ld + nt * 256 + (rg >> 5) * 128 + perm_col4(rg) + p2; }
#pragma unroll
    for (int kk = 0; kk < 16; ++kk) v[kk] = __builtin_nontemporal_load((const f32x2*)(bp + (size_t)kk * ld));
}
__device__ __forceinline__ void conv_finish(const ConvCtx& cc, int m, int wid, int lane, const f32x2 (&v)[16]) {
    const int rp = 16 * wid + (lane & 15), kg = lane >> 4;
    const int kt64 = m & 31;
    unsigned char* dst = (m < 16384) ? cc.W1T + ((size_t)(m >> 5) * 16 + (kt64 >> 1)) * 32768 : cc.W2T + ((size_t)((m - 16384) >> 5) * 16 + (kt64 >> 1)) * 32768;
    unsigned char* base = dst + (rp >> 6) * 16384 + lds_byte_b((2 * rp) & 127, (kt64 & 1) * 64 + 16 * kg);
#pragma unroll
    for (int i = 0; i < 2; ++i) { u32x4 w;
#pragma unroll
        for (int q = 0; q < 4; ++q) w[q] = pk_fp8x4(v[4 * q][i] * W8_SCALE, v[4 * q + 1][i] * W8_SCALE, v[4 * q + 2][i] * W8_SCALE, v[4 * q + 3][i] * W8_SCALE);
        __builtin_nontemporal_store(w, (u32x4*)(base + i * 64)); }
}
struct ColMapGluT { int nt; __device__ __forceinline__ int operator()(int rg) const { return (rg >> 5) * 2048 + nt * 128 + perm_col4(rg); } };
struct ColMapPerm { int c0; __device__ __forceinline__ int operator()(int rg) const { return c0 + (rg >> 5) * 128 + perm_col4(rg); } };

template <bool TRANS, bool FP8 = false, class Epi>
__device__ __forceinline__ void gemm8_unit(LAS unsigned char* lds, const u16* __restrict__ A, int lda, const int* __restrict__ arows, int arow0, int rows_valid, const u16* __restrict__ Bt, int nt, const Epi epi) {
    const int tid = tid_fresh(), wid = __builtin_amdgcn_readfirstlane(tid >> 6), lane = tid & 63;
    const int wr = wid >> 2, wc = wid & 3, fr = lane & 15, fq = lane >> 4;
    unsigned aof[2][2];
#pragma unroll
    for (int h = 0; h < 2; ++h)
#pragma unroll
        for (int i = 0; i < 2; ++i) { int R, C; stage_rc(tid * 16 + i * 8192, R, C); int rr = h * 128 + R; rr = rr < rows_valid ? rr : rows_valid - 1;
            const unsigned rowid = arows ? (unsigned)arows[rr] : (unsigned)(arow0 + rr); aof[h][i] = (rowid * (unsigned)lda + (unsigned)C) * 2u; }
    const char* Ab = (const char*)A; const char* Bb = (const char*)Bt + tid * 16;
    const bool hi = rows_valid > 128;
    int mxw = W8_MX, mxa = A8_MX; asm volatile("" : "+v"(mxw), "+v"(mxa));
#define G8_SA(b, h) (((b) * 2 + (h)) * 16384)
#define G8_SB(b, h) (65536 + ((b) * 2 + (h)) * 16384)
#define G8_STA(b, h, kt) do { _Pragma("unroll") for (int _i = 0; _i < 2; ++_i) \
        __builtin_amdgcn_global_load_lds((const unsigned*)(Ab + aof[h][_i] + (size_t)(kt) * 128), (LAS unsigned*)(lds + G8_SA(b, h) + wid * 1024 + _i * 8192), 16, 0, 0); } while (0)
#define G8_STB(b, h, kt) do { _Pragma("unroll") for (int _i = 0; _i < 2; ++_i) \
        __builtin_amdgcn_global_load_lds((const unsigned*)(Bb + (size_t)(kt) * 32768 + (h) * 16384 + _i * 8192), (LAS unsigned*)(lds + G8_SB(b, h) + wid * 1024 + _i * 8192), 16, 0, 0); } while (0)
#define G8_LDA(dst, b, h) do { _Pragma("unroll") for (int m = 0; m < 4; ++m) _Pragma("unroll") for (int k = 0; k < 2; ++k) dst[m][k] = *(const LAS bf16x8*)(lds + G8_SA(b, h) + aoff + m * 2048 + k * 1024); } while (0)
#define G8_LDB(dst, b, h) do { _Pragma("unroll") for (int n = 0; n < 2; ++n) _Pragma("unroll") for (int k = 0; k < 2; ++k) dst[n][k] = *(const LAS bf16x8*)(lds + G8_SB(b, h) + boff + n * 2048 + k * 1024); } while (0)
#define G8_MMA(ai, bj, At, Bq) do { if ((ai) == 0 || hi) { __builtin_amdgcn_s_setprio(1); _Pragma("unroll") for (int m = 0; m < 4; ++m) _Pragma("unroll") for (int n = 0; n < 2; ++n) { \
        if (FP8) { const i32x4 a0 = __builtin_bit_cast(i32x4, At[m][0]), a1 = __builtin_bit_cast(i32x4, At[m][1]), b0 = __builtin_bit_cast(i32x4, Bq[n][0]), b1 = __builtin_bit_cast(i32x4, Bq[n][1]); \
            const i32x8 a8 = __builtin_shufflevector(a0, a1, 0, 1, 2, 3, 4, 5, 6, 7), b8 = __builtin_shufflevector(b0, b1, 0, 1, 2, 3, 4, 5, 6, 7); \
            asm volatile("v_mfma_scale_f32_16x16x128_f8f6f4 %0, %1, %2, %0, %3, %4 op_sel_hi:[0,0,0]" : "+v"(acc[ai][bj][m][n]) : "v"(b8), "v"(a8), "v"(mxw), "v"(mxa)); } \
        else { _Pragma("unroll") for (int k = 0; k < 2; ++k) \
            acc[ai][bj][m][n] = TRANS ? __builtin_amdgcn_mfma_f32_16x16x32_bf16(At[m][k], Bq[n][k], acc[ai][bj][m][n], 0, 0, 0) : __builtin_amdgcn_mfma_f32_16x16x32_bf16(Bq[n][k], At[m][k], acc[ai][bj][m][n], 0, 0, 0); } } \
        __builtin_amdgcn_s_setprio(0); } } while (0)
#define G8_WV(n) asm volatile("s_waitcnt vmcnt(" #n ")" ::: "memory")
#define G8_WL(n) asm volatile("s_waitcnt lgkmcnt(" #n ")" ::: "memory")
#define G8_BAR __builtin_amdgcn_s_barrier()
#define G8_SCHED __builtin_amdgcn_sched_barrier(0)
    const int aoff = lds_byte(wr * 64 + fr, fq * 8), boff = lds_byte(wc * 32 + fr, fq * 8);
    f32x4 acc[2][2][4][2];
#pragma unroll
    for (int a = 0; a < 2; ++a)
#pragma unroll
        for (int b = 0; b < 2; ++b)
#pragma unroll
            for (int m = 0; m < 4; ++m)
#pragma unroll
                for (int n = 0; n < 2; ++n) acc[a][b][m][n] = (f32x4){0.f, 0.f, 0.f, 0.f};
    bf16x8 At[4][2], B0[2][2], B1[2][2];
    G8_STB(0, 0, 0); G8_STA(0, 0, 0); G8_STB(0, 1, 0); G8_STA(0, 1, 0);
    if (wr == 1) G8_BAR;
    G8_WV(4); G8_BAR;
    G8_STB(1, 0, 1); G8_STA(1, 0, 1); G8_STB(1, 1, 1);
    G8_WV(6); G8_BAR;
    for (int t = 0; t < nt - 2; t += 2) {
        G8_LDB(B0, 0, 0); G8_SCHED; G8_LDA(At, 0, 0); G8_STA(1, 1, t + 1);
        G8_WL(8); G8_BAR; G8_WL(0); G8_MMA(0, 0, At, B0); G8_BAR; G8_SCHED;
        G8_LDB(B1, 0, 1); G8_STB(0, 0, t + 2);
        G8_BAR; G8_WL(0); G8_MMA(0, 1, At, B1); G8_BAR;
        if (hi) G8_LDA(At, 0, 1); G8_STA(0, 0, t + 2);
        G8_BAR; G8_WL(0); G8_MMA(1, 0, At, B0); G8_BAR; G8_SCHED;
        G8_STB(0, 1, t + 2);
        G8_WV(6); G8_BAR; G8_MMA(1, 1, At, B1); G8_BAR;
        G8_LDB(B0, 1, 0); G8_SCHED; G8_LDA(At, 1, 0); G8_STA(0, 1, t + 2);
        G8_WL(8); G8_BAR; G8_WL(0); G8_MMA(0, 0, At, B0); G8_BAR; G8_SCHED;
        G8_LDB(B1, 1, 1); G8_STB(1, 0, t + 3);
        G8_BAR; G8_WL(0); G8_MMA(0, 1, At, B1); G8_BAR;
        if (hi) G8_LDA(At, 1, 1); G8_STA(1, 0, t + 3);
        G8_BAR; G8_WL(0); G8_MMA(1, 0, At, B0); G8_BAR; G8_SCHED;
        G8_STB(1, 1, t + 3);
        G8_WV(6); G8_BAR; G8_MMA(1, 1, At, B1); G8_BAR;
    }
    { G8_LDB(B0, 0, 0); G8_WV(0); G8_LDA(At, 0, 0); G8_STA(1, 1, nt - 1);
      G8_BAR; G8_WL(0); G8_MMA(0, 0, At, B0); G8_BAR;
      G8_LDB(B1, 0, 1); G8_BAR; G8_WL(0); G8_MMA(0, 1, At, B1); G8_BAR;
      G8_LDA(At, 0, 1); G8_WV(4); G8_BAR; G8_WL(0); G8_MMA(1, 0, At, B0); G8_MMA(1, 1, At, B1); G8_BAR; }
    { G8_LDB(B0, 1, 0); G8_LDA(At, 1, 0); G8_WV(2); G8_BAR; G8_WL(0); G8_MMA(0, 0, At, B0); G8_BAR;
      G8_LDB(B1, 1, 1); G8_WV(0); G8_BAR; G8_WL(0); G8_MMA(0, 1, At, B1); G8_BAR;
      G8_LDA(At, 1, 1); G8_BAR; G8_WL(0); G8_MMA(1, 0, At, B0); G8_MMA(1, 1, At, B1); G8_BAR; }
    if (wr == 0) G8_BAR;
#undef G8_SA
#undef G8_SB
#undef G8_STA
#undef G8_STB
#undef G8_LDA
#undef G8_LDB
#undef G8_MMA
#undef G8_WV
#undef G8_WL
#undef G8_BAR
#undef G8_SCHED
    __builtin_amdgcn_sched_barrier(0);
    { const int tz = tid_fresh(), wz = __builtin_amdgcn_readfirstlane(tz >> 6), lz = tz & 63;
      epi(acc, wz >> 2, wz & 3, lz & 15, lz >> 4); }
}
struct G8Pre { unsigned aof[2][2]; const char* Bt; int rows; };
__device__ __forceinline__ void g8_addr(G8Pre& p, int lda, const int* __restrict__ arows, int rows_valid, const u16* __restrict__ Bt) {
    const int tid = tid_fresh();
#pragma unroll
    for (int h = 0; h < 2; ++h)
#pragma unroll
        for (int i = 0; i < 2; ++i) { int R, C; stage_rc(tid * 16 + i * 8192, R, C); int rr = h * 128 + R; rr = rr < rows_valid ? rr : rows_valid - 1;
            p.aof[h][i] = ((unsigned)arows[rr] * (unsigned)lda + (unsigned)C) * 2u; }
    p.Bt = (const char*)Bt; p.rows = rows_valid;
}
__device__ __forceinline__ void g8_issue(LAS unsigned char* lds, const char* Ab, const G8Pre& p) {
    const int tid = tid_fresh(), wid = __builtin_amdgcn_readfirstlane(tid >> 6);
    const char* Bb = p.Bt + tid * 16;
#define G8I_A(b, h, kt) do { _Pragma("unroll") for (int _i = 0; _i < 2; ++_i) \
        __builtin_amdgcn_global_load_lds((const unsigned*)(Ab + p.aof[h][_i] + (size_t)(kt) * 128), (LAS unsigned*)(lds + ((b) * 2 + (h)) * 16384 + wid * 1024 + _i * 8192), 16, 0, 0); } while (0)
#define G8I_B(b, h, kt) do { _Pragma("unroll") for (int _i = 0; _i < 2; ++_i) \
        __builtin_amdgcn_global_load_lds((const unsigned*)(Bb + (size_t)(kt) * 32768 + (h) * 16384 + _i * 8192), (LAS unsigned*)(lds + 65536 + ((b) * 2 + (h)) * 16384 + wid * 1024 + _i * 8192), 16, 0, 0); } while (0)
    G8I_B(0, 0, 0); G8I_A(0, 0, 0); G8I_B(0, 1, 0); G8I_A(0, 1, 0); G8I_B(1, 0, 1); G8I_A(1, 0, 1); G8I_B(1, 1, 1);
#undef G8I_A
#undef G8I_B
}
template <bool TRANS, bool FP8, class Epi, class Next>
__device__ __forceinline__ bool gemm8_unit_ov(LAS unsigned char* lds, const u16* __restrict__ A, const G8Pre& pre, int nt, const Epi epi, Next& next) {
    const int tid = tid_fresh(), wid = __builtin_amdgcn_readfirstlane(tid >> 6), lane = tid & 63;
    const int wr = wid >> 2, wc = wid & 3, fr = lane & 15, fq = lane >> 4;
    unsigned aof[2][2];
    aof[0][0] = pre.aof[0][0]; aof[0][1] = pre.aof[0][1]; aof[1][0] = pre.aof[1][0]; aof[1][1] = pre.aof[1][1];
    const int rows_valid = pre.rows;
    const char* Ab = (const char*)A; const char* Bb = pre.Bt + tid * 16;
    const bool hi = rows_valid > 128;
    int mxw = W8_MX, mxa = A8_MX; asm volatile("" : "+v"(mxw), "+v"(mxa));
#define G8_SA(b, h) (((b) * 2 + (h)) * 16384)
#define G8_SB(b, h) (65536 + ((b) * 2 + (h)) * 16384)
#define G8_STA(b, h, kt) do { _Pragma("unroll") for (int _i = 0; _i < 2; ++_i) \
        __builtin_amdgcn_global_load_lds((const unsigned*)(Ab + aof[h][_i] + (size_t)(kt) * 128), (LAS unsigned*)(lds + G8_SA(b, h) + wid * 1024 + _i * 8192), 16, 0, 0); } while (0)
#define G8_STB(b, h, kt) do { _Pragma("unroll") for (int _i = 0; _i < 2; ++_i) \
        __builtin_amdgcn_global_load_lds((const unsigned*)(Bb + (size_t)(kt) * 32768 + (h) * 16384 + _i * 8192), (LAS unsigned*)(lds + G8_SB(b, h) + wid * 1024 + _i * 8192), 16, 0, 0); } while (0)
#define G8_LDA(dst, b, h) do { _Pragma("unroll") for (int m = 0; m < 4; ++m) _Pragma("unroll") for (int k = 0; k < 2; ++k) dst[m][k] = *(const LAS bf16x8*)(lds + G8_SA(b, h) + aoff + m * 2048 + k * 1024); } while (0)
#define G8_LDB(dst, b, h) do { _Pragma("unroll") for (int n = 0; n < 2; ++n) _Pragma("unroll") for (int k = 0; k < 2; ++k) dst[n][k] = *(const LAS bf16x8*)(lds + G8_SB(b, h) + boff + n * 2048 + k * 1024); } while (0)
#define G8_MMA(ai, bj, At, Bq) do { if ((ai) == 0 || hi) { __builtin_amdgcn_s_setprio(1); _Pragma("unroll") for (int m = 0; m < 4; ++m) _Pragma("unroll") for (int n = 0; n < 2; ++n) { \
        if (FP8) { const i32x4 a0 = __builtin_bit_cast(i32x4, At[m][0]), a1 = __builtin_bit_cast(i32x4, At[m][1]), b0 = __builtin_bit_cast(i32x4, Bq[n][0]), b1 = __builtin_bit_cast(i32x4, Bq[n][1]); \
            const i32x8 a8 = __builtin_shufflevector(a0, a1, 0, 1, 2, 3, 4, 5, 6, 7), b8 = __builtin_shufflevector(b0, b1, 0, 1, 2, 3, 4, 5, 6, 7); \
            asm volatile("v_mfma_scale_f32_16x16x128_f8f6f4 %0, %1, %2, %0, %3, %4 op_sel_hi:[0,0,0]" : "+v"(acc[ai][bj][m][n]) : "v"(b8), "v"(a8), "v"(mxw), "v"(mxa)); } \
        else { _Pragma("unroll") for (int k = 0; k < 2; ++k) \
            acc[ai][bj][m][n] = TRANS ? __builtin_amdgcn_mfma_f32_16x16x32_bf16(At[m][k], Bq[n][k], acc[ai][bj][m][n], 0, 0, 0) : __builtin_amdgcn_mfma_f32_16x16x32_bf16(Bq[n][k], At[m][k], acc[ai][bj][m][n], 0, 0, 0); } } \
        __builtin_amdgcn_s_setprio(0); } } while (0)
#define G8_WV(n) asm volatile("s_waitcnt vmcnt(" #n ")" ::: "memory")
#define G8_WL(n) asm volatile("s_waitcnt lgkmcnt(" #n ")" ::: "memory")
#define G8_BAR __builtin_amdgcn_s_barrier()
#define G8_SCHED __builtin_amdgcn_sched_barrier(0)
    const int aoff = lds_byte(wr * 64 + fr, fq * 8), boff = lds_byte(wc * 32 + fr, fq * 8);
    f32x4 acc[2][2][4][2];
#pragma unroll
    for (int a = 0; a < 2; ++a)
#pragma unroll
        for (int b = 0; b < 2; ++b)
#pragma unroll
            for (int m = 0; m < 4; ++m)
#pragma unroll
                for (int n = 0; n < 2; ++n) acc[a][b][m][n] = (f32x4){0.f, 0.f, 0.f, 0.f};
    bf16x8 At[4][2], B0[2][2], B1[2][2];
    if (wr == 1) G8_BAR;
    G8_WV(0); G8_BAR;
    G8_BAR;
    for (int t = 0; t < nt - 2; t += 2) {
        G8_LDB(B0, 0, 0); G8_SCHED; G8_LDA(At, 0, 0); G8_STA(1, 1, t + 1);
        G8_WL(8); G8_BAR; G8_WL(0); G8_MMA(0, 0, At, B0); G8_BAR; G8_SCHED;
        G8_LDB(B1, 0, 1); G8_STB(0, 0, t + 2);
        G8_BAR; G8_WL(0); G8_MMA(0, 1, At, B1); G8_BAR;
        if (hi) G8_LDA(At, 0, 1); G8_STA(0, 0, t + 2);
        G8_BAR; G8_WL(0); G8_MMA(1, 0, At, B0); G8_BAR; G8_SCHED;
        G8_STB(0, 1, t + 2);
        G8_WV(6); G8_BAR; G8_MMA(1, 1, At, B1); G8_BAR;
        G8_LDB(B0, 1, 0); G8_SCHED; G8_LDA(At, 1, 0); G8_STA(0, 1, t + 2);
        G8_WL(8); G8_BAR; G8_WL(0); G8_MMA(0, 0, At, B0); G8_BAR; G8_SCHED;
        G8_LDB(B1, 1, 1); G8_STB(1, 0, t + 3);
        G8_BAR; G8_WL(0); G8_MMA(0, 1, At, B1); G8_BAR;
        if (hi) G8_LDA(At, 1, 1); G8_STA(1, 0, t + 3);
        G8_BAR; G8_WL(0); G8_MMA(1, 0, At, B0); G8_BAR; G8_SCHED;
        G8_STB(1, 1, t + 3);
        G8_WV(6); G8_BAR; G8_MMA(1, 1, At, B1); G8_BAR;
    }
    { G8_LDB(B0, 0, 0); G8_WV(0); G8_LDA(At, 0, 0); G8_STA(1, 1, nt - 1);
      G8_BAR; G8_WL(0); G8_MMA(0, 0, At, B0); G8_BAR;
      G8_LDB(B1, 0, 1); G8_BAR; G8_WL(0); G8_MMA(0, 1, At, B1); G8_BAR;
      G8_LDA(At, 0, 1); G8_WV(4); G8_BAR; G8_WL(0); G8_MMA(1, 0, At, B0); G8_MMA(1, 1, At, B1); G8_BAR; }
    { G8_LDB(B0, 1, 0); G8_LDA(At, 1, 0); G8_WV(2); G8_BAR; G8_WL(0); G8_MMA(0, 0, At, B0); G8_BAR;
      G8_LDB(B1, 1, 1); G8_WV(0); G8_BAR; G8_WL(0); G8_MMA(0, 1, At, B1); G8_BAR;
      G8_LDA(At, 1, 1); G8_BAR; G8_WL(0); G8_MMA(1, 0, At, B0); G8_MMA(1, 1, At, B1); G8_BAR; }
    if (wr == 0) G8_BAR;
#undef G8_SA
#undef G8_SB
#undef G8_STA
#undef G8_STB
#undef G8_LDA
#undef G8_LDB
#undef G8_MMA
#undef G8_WV
#undef G8_WL
#undef G8_BAR
#undef G8_SCHED
    __builtin_amdgcn_sched_barrier(0);
    const bool has_next = next();
    __builtin_amdgcn_sched_barrier(0);
    { const int tz = tid_fresh(), wz = __builtin_amdgcn_readfirstlane(tz >> 6), lz = tz & 63;
      epi(acc, wz >> 2, wz & 3, lz & 15, lz >> 4); }
    return has_next;
}
struct StreamUnit { const char* A; const char* Bt; int arow0, rows, a, b, c; };
template <bool TRANS, bool FP8, class Src>
__device__ __forceinline__ void gemm8_stream(LAS unsigned char* lds, unsigned lda, int nt, const Src& src) {
    const int tid = tid_fresh(), wid = __builtin_amdgcn_readfirstlane(tid >> 6), lane = tid & 63;
    const int wr = wid >> 2, wc = wid & 3, fr = lane & 15, fq = lane >> 4;
    StreamUnit cur, nxt;
    if (!src.get(0, cur)) return;
    int R0, C0, R1, C1; stage_rc(tid * 16, R0, C0); stage_rc(tid * 16 + 8192, R1, C1);
    int mxw = W8_MX, mxa = A8_MX; asm volatile("" : "+v"(mxw), "+v"(mxa));
    const int aoff = lds_byte(wr * 64 + fr, fq * 8), boff = lds_byte(wc * 32 + fr, fq * 8);
#define GS_AOF(u, h, R, C) ((unsigned)(((unsigned)((u).arow0 + (((h) * 128 + (R)) < (u).rows ? ((h) * 128 + (R)) : (u).rows - 1)) * lda + (unsigned)(C)) * 2u))
    unsigned ac00 = GS_AOF(cur, 0, R0, C0), ac01 = GS_AOF(cur, 0, R1, C1), ac10 = GS_AOF(cur, 1, R0, C0), ac11 = GS_AOF(cur, 1, R1, C1);
#define GS_SA(b, h) (((b) * 2 + (h)) * 16384)
#define GS_SB(b, h) (65536 + ((b) * 2 + (h)) * 16384)
#define GS_GL(src_, dst_) __builtin_amdgcn_global_load_lds((const unsigned*)(src_), (LAS unsigned*)(lds + (dst_)), 16, 0, 0)
#define GS_STA(b, h, base, o0, o1, kt) do { GS_GL((base) + (o0) + (size_t)(kt) * 128, GS_SA(b, h) + wid * 1024); GS_GL((base) + (o1) + (size_t)(kt) * 128, GS_SA(b, h) + wid * 1024 + 8192); } while (0)
#define GS_STB(b, h, base, kt) do { GS_GL((base) + tid * 16 + (size_t)(kt) * 32768 + (h) * 16384, GS_SB(b, h) + wid * 1024); GS_GL((base) + tid * 16 + (size_t)(kt) * 32768 + (h) * 16384 + 8192, GS_SB(b, h) + wid * 1024 + 8192); } while (0)
#define GS_LDA(dst, b, h) do { _Pragma("unroll") for (int m = 0; m < 4; ++m) _Pragma("unroll") for (int k = 0; k < 2; ++k) dst[m][k] = *(const LAS bf16x8*)(lds + GS_SA(b, h) + aoff + m * 2048 + k * 1024); } while (0)
#define GS_LDB(dst, b, h) do { _Pragma("unroll") for (int n = 0; n < 2; ++n) _Pragma("unroll") for (int k = 0; k < 2; ++k) dst[n][k] = *(const LAS bf16x8*)(lds + GS_SB(b, h) + boff + n * 2048 + k * 1024); } while (0)
#define GS_MMA(ai, bj, At, Bq) do { if ((ai) == 0 || hi) { __builtin_amdgcn_s_setprio(1); _Pragma("unroll") for (int m = 0; m < 4; ++m) _Pragma("unroll") for (int n = 0; n < 2; ++n) { \
        if (FP8) { const i32x4 a0 = __builtin_bit_cast(i32x4, At[m][0]), a1 = __builtin_bit_cast(i32x4, At[m][1]), b0 = __builtin_bit_cast(i32x4, Bq[n][0]), b1 = __builtin_bit_cast(i32x4, Bq[n][1]); \
            const i32x8 a8 = __builtin_shufflevector(a0, a1, 0, 1, 2, 3, 4, 5, 6, 7), b8 = __builtin_shufflevector(b0, b1, 0, 1, 2, 3, 4, 5, 6, 7); \
            asm volatile("v_mfma_scale_f32_16x16x128_f8f6f4 %0, %1, %2, %0, %3, %4 op_sel_hi:[0,0,0]" : "+v"(acc[ai][bj][m][n]) : "v"(b8), "v"(a8), "v"(mxw), "v"(mxa)); } \
        else { _Pragma("unroll") for (int k = 0; k < 2; ++k) \
            acc[ai][bj][m][n] = TRANS ? __builtin_amdgcn_mfma_f32_16x16x32_bf16(At[m][k], Bq[n][k], acc[ai][bj][m][n], 0, 0, 0) : __builtin_amdgcn_mfma_f32_16x16x32_bf16(Bq[n][k], At[m][k], acc[ai][bj][m][n], 0, 0, 0); } } \
        __builtin_amdgcn_s_setprio(0); } } while (0)
#define GS_WV(n) asm volatile("s_waitcnt vmcnt(" #n ")" ::: "memory")
#define GS_WL(n) asm volatile("s_waitcnt lgkmcnt(" #n ")" ::: "memory")
#define GS_BAR __builtin_amdgcn_s_barrier()
#define GS_SCHED __builtin_amdgcn_sched_barrier(0)
    f32x4 acc[2][2][4][2];
#pragma unroll
    for (int a = 0; a < 2; ++a)
#pragma unroll
        for (int b = 0; b < 2; ++b)
#pragma unroll
            for (int m = 0; m < 4; ++m)
#pragma unroll
                for (int n = 0; n < 2; ++n) acc[a][b][m][n] = (f32x4){0.f, 0.f, 0.f, 0.f};
    bf16x8 At[4][2], B0[2][2], B1[2][2];
    GS_STB(0, 0, cur.Bt, 0); GS_STA(0, 0, cur.A, ac00, ac01, 0); GS_STB(0, 1, cur.Bt, 0); GS_STA(0, 1, cur.A, ac10, ac11, 0);
    if (wr == 1) GS_BAR;
    GS_WV(4); GS_BAR;
    GS_STB(1, 0, cur.Bt, 1); GS_STA(1, 0, cur.A, ac00, ac01, 1); GS_STB(1, 1, cur.Bt, 1);
    GS_WV(6); GS_BAR;
    for (int ui = 0;; ++ui) {
        const bool has_next = src.get(ui + 1, nxt);
        if (!has_next) nxt = cur;
        const unsigned an00 = GS_AOF(nxt, 0, R0, C0), an01 = GS_AOF(nxt, 0, R1, C1), an10 = GS_AOF(nxt, 1, R0, C0), an11 = GS_AOF(nxt, 1, R1, C1);
        const bool hi = cur.rows > 128;
        for (int t = 0; t < nt; t += 2) {
            const bool last = (t == nt - 2);
            const char* xA = last ? nxt.A : cur.A; const char* xB = last ? nxt.Bt : cur.Bt;
            const unsigned x00 = last ? an00 : ac00, x01 = last ? an01 : ac01, x10 = last ? an10 : ac10, x11 = last ? an11 : ac11;
            const int k2 = last ? 0 : t + 2, k3 = k2 + 1;
            GS_LDB(B0, 0, 0); GS_SCHED; GS_LDA(At, 0, 0); GS_STA(1, 1, cur.A, ac10, ac11, t + 1);
            GS_WL(8); GS_BAR; GS_WL(0); GS_MMA(0, 0, At, B0); GS_BAR; GS_SCHED;
            GS_LDB(B1, 0, 1); GS_STB(0, 0, xB, k2);
            GS_BAR; GS_WL(0); GS_MMA(0, 1, At, B1); GS_BAR;
            if (hi) GS_LDA(At, 0, 1); GS_STA(0, 0, xA, x00, x01, k2);
            GS_BAR; GS_WL(0); GS_MMA(1, 0, At, B0); GS_BAR; GS_SCHED;
            GS_STB(0, 1, xB, k2);
            GS_WV(6); GS_BAR; GS_MMA(1, 1, At, B1); GS_BAR;
            GS_LDB(B0, 1, 0); GS_SCHED; GS_LDA(At, 1, 0); GS_STA(0, 1, xA, x10, x11, k2);
            GS_WL(8); GS_BAR; GS_WL(0); GS_MMA(0, 0, At, B0); GS_BAR; GS_SCHED;
            GS_LDB(B1, 1, 1); GS_STB(1, 0, xB, k3);
            GS_BAR; GS_WL(0); GS_MMA(0, 1, At, B1); GS_BAR;
            if (hi) GS_LDA(At, 1, 1); GS_STA(1, 0, xA, x00, x01, k3);
            GS_BAR; GS_WL(0); GS_MMA(1, 0, At, B0); GS_BAR; GS_SCHED;
            GS_STB(1, 1, xB, k3);
            GS_WV(6); GS_BAR; GS_MMA(1, 1, At, B1); GS_BAR;
        }
        __builtin_amdgcn_sched_barrier(0);
        src.epi(acc, cur, wr, wc, fr, fq);
        __builtin_amdgcn_sched_barrier(0);
        if (!has_next) break;
#pragma unroll
        for (int a = 0; a < 2; ++a)
#pragma unroll
            for (int b = 0; b < 2; ++b)
#pragma unroll
                for (int m = 0; m < 4; ++m)
#pragma unroll
                    for (int n = 0; n < 2; ++n) acc[a][b][m][n] = (f32x4){0.f, 0.f, 0.f, 0.f};
        cur = nxt; ac00 = an00; ac01 = an01; ac10 = an10; ac11 = an11;
    }
    GS_WV(0);
    if (wr == 0) GS_BAR;
    GS_BAR;
#undef GS_AOF
#undef GS_SA
#undef GS_SB
#undef GS_GL
#undef GS_STA
#undef GS_STB
#undef GS_LDA
#undef GS_LDB
#undef GS_MMA
#undef GS_WV
#undef GS_WL
#undef GS_BAR
#undef GS_SCHED
}
struct Epi8PG { u16* PG; const float* lbl; int tok0, col0;
    __device__ __forceinline__ void operator()(const f32x4 (&acc)[2][2][4][2], int wr, int wc, int fr, int fq) const {
        const int grp = col0 >> 10;
        if (grp == 0) {
#pragma unroll
            for (int ai = 0; ai < 2; ++ai)
#pragma unroll
                for (int m = 0; m < 4; ++m) { u16* rowp = PG + (size_t)(tok0 + ai * 128 + wr * 64 + m * 16 + fr) * 5120 + col0 + wc * 32 + 8 * fq;
#pragma unroll
                    for (int bj = 0; bj < 2; ++bj) { float o[8];
#pragma unroll
                        for (int n = 0; n < 2; ++n)
#pragma unroll
                            for (int q = 0; q < 4; ++q) { const float x = acc[ai][bj][m][n][q]; o[4 * n + q] = x * __builtin_amdgcn_rcpf(1.0f + __expf(-x)); }
                        *(u32x4*)(rowp + bj * 128) = (u32x4){pk_bf16(o[0], o[1]), pk_bf16(o[2], o[3]), pk_bf16(o[4], o[5]), pk_bf16(o[6], o[7])}; } }
        } else if (grp <= 2) {
            float lbv[2][8];
#pragma unroll
            for (int bj = 0; bj < 2; ++bj)
#pragma unroll
                for (int q = 0; q < 8; ++q) { const int c = (col0 & 1023) + bj * 128 + wc * 32 + 8 * fq + q; const float l0 = lbl[(grp - 1) * HGW + c], l1 = lbl[(2 + grp - 1) * HGW + c]; lbv[bj][q] = __builtin_amdgcn_rcpf(1.0f + __expf(l1 - l0)); }
#pragma unroll
            for (int ai = 0; ai < 2; ++ai)
#pragma unroll
                for (int m = 0; m < 4; ++m) { u16* rowp = PG + (size_t)(tok0 + ai * 128 + wr * 64 + m * 16 + fr) * 5120 + col0 + wc * 32 + 8 * fq;
#pragma unroll
                    for (int bj = 0; bj < 2; ++bj) { float o[8];
#pragma unroll
                        for (int n = 0; n < 2; ++n)
#pragma unroll
                            for (int q = 0; q < 4; ++q) { const float z = acc[ai][bj][m][n][q], lb = lbv[bj][4 * n + q]; const float sg = __builtin_amdgcn_rcpf(1.0f + __expf(-z)); o[4 * n + q] = __log2f(lb + (1.0f - lb) * sg); }
                        *(u32x4*)(rowp + bj * 128) = (u32x4){pk_bf16(o[0], o[1]), pk_bf16(o[2], o[3]), pk_bf16(o[4], o[5]), pk_bf16(o[6], o[7])}; } }
        } else {
#pragma unroll
            for (int ai = 0; ai < 2; ++ai)
#pragma unroll
                for (int m = 0; m < 4; ++m) { u16* rowp = PG + (size_t)(tok0 + ai * 128 + wr * 64 + m * 16 + fr) * 5120 + col0 + wc * 32 + 8 * fq;
#pragma unroll
                    for (int bj = 0; bj < 2; ++bj) { const f32x4 v0 = acc[ai][bj][m][0], v1 = acc[ai][bj][m][1];
                        *(u32x4*)(rowp + bj * 128) = (u32x4){pk_bf16(v0[0], v0[1]), pk_bf16(v0[2], v0[3]), pk_bf16(v1[0], v1[1]), pk_bf16(v1[2], v1[3])}; } }
        }
    } };
struct Epi8HYT { u16* HYT; int tok0, col0;
    __device__ __forceinline__ void operator()(const f32x4 (&acc)[2][2][4][2], int wr, int wc, int fr, int fq) const {
#pragma unroll
        for (int bj = 0; bj < 2; ++bj)
#pragma unroll
            for (int n = 0; n < 2; ++n) { u16* colp = HYT + (size_t)(col0 + bj * 128 + wc * 32 + perm32(n * 16 + fr)) * NTOK + tok0 + wr * 64 + 4 * fq;
#pragma unroll
                for (int ai = 0; ai < 2; ++ai)
#pragma unroll
                    for (int m = 0; m < 4; ++m) { const f32x4 v = acc[ai][bj][m][n]; *(u32x2*)(colp + ai * 128 + m * 16) = (u32x2){pk_bf16(v[0], v[1]), pk_bf16(v[2], v[3])}; } }
    } };
struct Epi8X1 { const float* x; float* X1; int tok0, col0;
    __device__ __forceinline__ void operator()(const f32x4 (&acc)[2][2][4][2], int wr, int wc, int fr, int fq) const {
#pragma unroll
        for (int ai = 0; ai < 2; ++ai)
#pragma unroll
            for (int m = 0; m < 4; ++m) { const size_t off = (size_t)(tok0 + ai * 128 + wr * 64 + m * 16 + fr) * DM + col0 + wc * 32 + 8 * fq;
#pragma unroll
                for (int bj = 0; bj < 2; ++bj)
#pragma unroll
                    for (int n = 0; n < 2; ++n) { const f32x4 r = *(const f32x4*)(x + off + bj * 128 + n * 4); *(f32x4*)(X1 + off + bj * 128 + n * 4) = r + acc[ai][bj][m][n]; }
                asm volatile("" ::: "memory"); }
    } };
struct Epi8Swiglu { u16* HM; const float* b1; int slot0, nt, rows_valid;
    __device__ __forceinline__ void operator()(const f32x4 (&acc)[2][2][4][2], int wr, int wc, int fr, int fq) const {
        f32x4 bg[2], bl[2];
#pragma unroll
        for (int n = 0; n < 2; ++n) { const int col = nt * 128 + wc * 32 + 8 * fq + 4 * n; bg[n] = *(const f32x4*)(b1 + col); bl[n] = *(const f32x4*)(b1 + 2048 + col); }
#pragma unroll
        for (int ai = 0; ai < 2; ++ai)
#pragma unroll
            for (int m = 0; m < 4; ++m) { const int row = ai * 128 + wr * 64 + m * 16 + fr;
                if (row < rows_valid) { float o[8];
#pragma unroll
                    for (int n = 0; n < 2; ++n) { const f32x4 gl = acc[ai][0][m][n] + bg[n], li = acc[ai][1][m][n] + bl[n];
#pragma unroll
                        for (int j = 0; j < 4; ++j) { const float gq = fminf(gl[j], 7.0f), lq = fminf(fmaxf(li[j], -7.0f), 7.0f); o[4 * n + j] = gq * __builtin_amdgcn_rcpf(1.0f + __builtin_amdgcn_exp2f(-2.45546696f * gq)) * (lq + 1.0f); } }
                    *(u32x4*)(HM + (size_t)(slot0 + row) * DFF + nt * 128 + wc * 32 + 8 * fq) = (u32x4){pk_bf16(o[0], o[1]), pk_bf16(o[2], o[3]), pk_bf16(o[4], o[5]), pk_bf16(o[6], o[7])}; } }
    } };
struct Epi8Swiglu8 { unsigned char* HM; const float* b1; int slot0, nt, rows_valid;
    __device__ __forceinline__ void operator()(const f32x4 (&acc)[2][2][4][2], int wr, int wc, int fr, int fq) const {
        f32x4 bg[2], bl[2];
#pragma unroll
        for (int n = 0; n < 2; ++n) { const int col = nt * 128 + wc * 32 + 8 * fq + 4 * n; bg[n] = *(const f32x4*)(b1 + col); bl[n] = *(const f32x4*)(b1 + 2048 + col); }
#pragma unroll
        for (int ai = 0; ai < 2; ++ai)
#pragma unroll
            for (int m = 0; m < 4; ++m) { const int row = ai * 128 + wr * 64 + m * 16 + fr;
                if (row < rows_valid) { float o[8];
#pragma unroll
                    for (int n = 0; n < 2; ++n) { const f32x4 gl = acc[ai][0][m][n] + bg[n], li = acc[ai][1][m][n] + bl[n];
#pragma unroll
                        for (int j = 0; j < 4; ++j) { const float gq = fminf(gl[j], 7.0f), lq = fminf(fmaxf(li[j], -7.0f), 7.0f); o[4 * n + j] = gq * __builtin_amdgcn_rcpf(1.0f + __builtin_amdgcn_exp2f(-2.45546696f * gq)) * (lq + 1.0f); } }
                    *(u32x2*)(HM + (size_t)(slot0 + row) * DFF + nt * 128 + wc * 32 + 8 * fq) = (u32x2){pk_fp8x4(o[0], o[1], o[2], o[3]), pk_fp8x4(o[4], o[5], o[6], o[7])}; } }
    } };
struct Epi8Y { u16* Y; const float* b2; int slot0, col0, rows_valid;
    __device__ __forceinline__ void operator()(const f32x4 (&acc)[2][2][4][2], int wr, int wc, int fr, int fq) const {
        f32x4 bv[2][2];
#pragma unroll
        for (int bj = 0; bj < 2; ++bj)
#pragma unroll
            for (int n = 0; n < 2; ++n) bv[bj][n] = *(const f32x4*)(b2 + col0 + bj * 128 + wc * 32 + 8 * fq + 4 * n);
#pragma unroll
        for (int ai = 0; ai < 2; ++ai)
#pragma unroll
            for (int m = 0; m < 4; ++m) { const int row = ai * 128 + wr * 64 + m * 16 + fr;
                if (row < rows_valid) { u16* rowp = Y + (size_t)(slot0 + row) * DM + col0 + wc * 32 + 8 * fq;
#pragma unroll
                    for (int bj = 0; bj < 2; ++bj) { const f32x4 v0 = acc[ai][bj][m][0] + bv[bj][0], v1 = acc[ai][bj][m][1] + bv[bj][1];
                        *(u32x4*)(rowp + bj * 128) = (u32x4){pk_bf16(v0[0], v0[1]), pk_bf16(v0[2], v0[3]), pk_bf16(v1[0], v1[1]), pk_bf16(v1[2], v1[3])}; } } }
    } };
struct EpiNone { __device__ __forceinline__ void operator()(const f32x4 (&acc)[2][2][4][2], int wr, int wc, int fr, int fq) const {
#pragma unroll
        for (int a = 0; a < 2; ++a)
#pragma unroll
            for (int b = 0; b < 2; ++b)
#pragma unroll
                for (int m = 0; m < 4; ++m)
#pragma unroll
                    for (int n = 0; n < 2; ++n) asm volatile("" :: "v"(acc[a][b][m][n]));
    } };

template <int NTILES>
__device__ __forceinline__ bool moe_unit_static(const LAS int* us, const LAS int* so2, int uu, int& e, int& nt, int& slot0, int& rows) {
    if (uu >= us[NE]) return false;
    int lo = 0, hi = NE;
#pragma unroll
    for (int s = 0; s < 5; ++s) { const int mid = (lo + hi) >> 1; if (us[mid] <= uu) lo = mid; else hi = mid; }
    e = lo; const int o0 = e * NTOK, cnt = so2[e], mtl = (cnt + 255) >> 8, ul = uu - us[e], mt = ul % mtl;
    e = __builtin_amdgcn_readfirstlane(e); nt = __builtin_amdgcn_readfirstlane(ul / mtl); slot0 = __builtin_amdgcn_readfirstlane(o0 + mt * 256);
    rows = cnt - mt * 256; rows = __builtin_amdgcn_readfirstlane(rows > 256 ? 256 : rows); return true;
}
struct SrcMoeB { const LAS int* us; const LAS int* so2; int c, G; const char* HM8; const char* W2T8; u16* YB; const float* b2;
    __device__ __forceinline__ bool get(int i, StreamUnit& u) const { int e, nt, slot0, rows; if (!moe_unit_static<8>(us, so2, c + i * G, e, nt, slot0, rows)) return false;
        u.A = HM8; u.Bt = W2T8 + (size_t)((e * 8 + nt) * 16) * 32768; u.arow0 = slot0; u.rows = rows; u.a = e; u.b = nt; u.c = slot0; return true; }
    __device__ __forceinline__ void epi(const f32x4 (&acc)[2][2][4][2], const StreamUnit& u, int wr, int wc, int fr, int fq) const { Epi8Y ep{YB, b2 + (size_t)u.a * DM, u.c, u.b * 256, u.rows}; ep(acc, wr, wc, fr, fq); }
};
template <bool TRANS>
struct SrcG1 { int c, G; const char* HBp; const char* WINTp; u16* PG; u16* HYT; const float* lbl;
    __device__ __forceinline__ bool get(int k, StreamUnit& su) const {
        int seen = 0;
        for (int u = c; u < 1024; u += G) { const int i = u >> 8, xx = (u >> 5) & 7, j = u & 31; const int mt = (xx & 3) * 8 + (j & 7), nt = ((xx >> 2) + 2 * i) * 4 + (j >> 3);
            if ((nt >= 20) == TRANS) { if (seen == k) { su.A = HBp; su.Bt = WINTp + (size_t)nt * 32 * 32768; su.arow0 = mt * 256; su.rows = 256; su.a = mt; su.b = nt; su.c = 0; return true; } ++seen; } }
        return false; }
    __device__ __forceinline__ void epi(const f32x4 (&acc)[2][2][4][2], const StreamUnit& u, int wr, int wc, int fr, int fq) const {
        if (TRANS) { Epi8HYT e{HYT, u.a * 256, u.b * 256 - 5120}; e(acc, wr, wc, fr, fq); } else { Epi8PG e{PG, lbl, u.a * 256, u.b * 256}; e(acc, wr, wc, fr, fq); } }
};

typedef float f32x16 __attribute__((ext_vector_type(16)));
__device__ __forceinline__ void h3_row(int m, const float* __restrict__ w1, const float* __restrict__ b1, const float* __restrict__ w2, const float* __restrict__ b2,
                                       const float* __restrict__ w3, const float* __restrict__ b3, const float* __restrict__ freq, LAS float* sc  , float* __restrict__ H3) {
    const int j = tid_fresh() & 63;
    const float tt = (float)m / (float)(SEQ - 1);
    if (j == 0) sc[0] = tt;
    if (j >= 1 && j <= 16) { const int i = j - 1; const float band = 1e-4f + (float)i * ((15.0f - 1e-4f) / 15.0f); const float ang = (2.0f * 3.14159265358979323846f / (float)SEQ) * (float)m * band; sc[1 + i] = cosf(ang); sc[17 + i] = -sinf(ang); }
    __builtin_amdgcn_wave_barrier();
    const float fr = freq[j];
    float s = b1[j];
    for (int i = 0; i < 33; ++i) s += sc[i] * w1[i * 64 + j];
    const float h1 = sinf(fr * s);
    sc[64 + j] = h1;
    __builtin_amdgcn_wave_barrier();
    s = b2[j];
    for (int i = 0; i < 64; ++i) s += sc[64 + i] * w2[i * 64 + j];
    const float h2 = sinf(fr * s);
    __builtin_amdgcn_wave_barrier();
    sc[j] = h2;
    __builtin_amdgcn_wave_barrier();
    s = b3[j];
    for (int i = 0; i < 64; ++i) s += sc[i] * w3[i * 64 + j];
    H3[(size_t)m * 64 + j] = sinf(fr * s);
    __builtin_amdgcn_wave_barrier();
}
constexpr int FR_LEN = 4128;
__device__ __forceinline__ void frgen_item(LAS unsigned char* lds, int item, const float* __restrict__ H3, const float* __restrict__ w4, u16* __restrict__ FR) {
    const int tid = tid_fresh(), wid = __builtin_amdgcn_readfirstlane(tid >> 6), lane = tid & 63, fr = lane & 15, fq = lane >> 4;
    const int oc0 = item * 8, o = oc0 >> 10;
    const int colB = o * 2048 + (fr >> 3) * 1024 + (oc0 & 1023) + (fr & 7);
    float wreg[16];
#pragma unroll
    for (int ks = 0; ks < 16; ++ks) wreg[ks] = w4[(size_t)(4 * ks + fq) * 4096 + colB];
    const int dir = fr >> 3, c = (oc0 & 1023) + (fr & 7);
    const float mind = logf(1e-2f) / 0.3f, maxd = logf(1e-2f) / 1.5f;
    const float delta = fabsf(mind + (float)c * ((maxd - mind) / 1023.0f));
    u16* r0 = FR + (size_t)((oc0 + (fr & 7)) * 2) * FR_LEN;
    LAS float* tile = (LAS float*)(lds + wid * 4608);
    const int wrow = lane >> 4, wcol = 4 * (lane & 15);
    f32x4 nx[4];
#pragma unroll
    for (int q = 0; q < 4; ++q) nx[q] = *(const f32x4*)(H3 + (size_t)wid * 1024 + q * 256 + lane * 4);
    for (int it = 0; it < 16; ++it) {
        const int mt = wid + 8 * it;
#pragma unroll
        for (int q = 0; q < 4; ++q) *(LAS f32x4*)(tile + (q * 4 + wrow) * 68 + wcol) = nx[q];
        if (it + 1 < 16) {
#pragma unroll
            for (int q = 0; q < 4; ++q) nx[q] = *(const f32x4*)(H3 + (size_t)(mt + 8) * 1024 + q * 256 + lane * 4);
        }
        f32x4 acc = {0.f, 0.f, 0.f, 0.f};
#pragma unroll
        for (int ks = 0; ks < 16; ++ks) acc = __builtin_amdgcn_mfma_f32_16x16x4f32(tile[fr * 68 + 4 * ks + fq], wreg[ks], acc, 0, 0, 0);
        const int m0 = mt * 16 + 4 * fq;
        float v[4];
#pragma unroll
        for (int j = 0; j < 4; ++j) v[j] = acc[j] * __expf(-((float)(m0 + j) / (float)(SEQ - 1)) * delta);
        if (dir == 0) {
            *(u32x2*)(r0 + 2044 - m0) = (u32x2){pk_bf16(v[3], v[2]), pk_bf16(v[1], v[0])};
#pragma unroll
            for (int j = 0; j < 4; ++j) r0[FR_LEN + 2046 - m0 - j] = (u16)(pk_bf16(v[j], 0.f) & 0xffffu);
        } else {
#pragma unroll
            for (int j = 0; j < 4; ++j) if (m0 + j >= 1) { const u16 b = (u16)(pk_bf16(v[j], 0.f) & 0xffffu); r0[2047 + m0 + j] = b; r0[FR_LEN + 2046 + m0 + j] = b; }
        }
    }
    if (tid < 8 * 34) { const int r = tid / 34, x = 4094 + tid % 34; u16* rr = FR + (size_t)((oc0 + r) * 2) * FR_LEN; if (x >= 4095) rr[x] = 0; rr[FR_LEN + x] = 0; }
    __syncthreads();
}
constexpr int HY_ZSTRIDE = 2312;
constexpr int HY_ZCH = 256 + 4 * HY_ZSTRIDE;
constexpr int HY_ZBYTES = HY_ZCH * 2;
constexpr int HY_FB = 4 * HY_ZBYTES;
constexpr int HY_FCH = 2 * FR_LEN * 2;
constexpr int HY_LDS = HY_FB + 4 * HY_FCH;

__device__ __forceinline__ void hy_load_row(LAS unsigned char* lds, int dest, int boff0, int bstride, const u16* __restrict__ row, float w0, float w1, float w2, float cb, int pl) {
#pragma unroll 2
    for (int it = 0; it < 8; ++it) {
        const int idx = pl + 128 * it, tok0 = idx * 8, b = tok0 >> 11, n0 = tok0 & 2047;
        const u32x4 raw = *(const u32x4*)(row + tok0);
        const float pm = (n0 > 0) ? bf2f(row[tok0 - 1]) : 0.f;
        const float pn = (n0 + 8 < SEQ) ? bf2f(row[tok0 + 8]) : 0.f;
        float p[10];
        p[0] = pm; p[9] = pn;
#pragma unroll
        for (int q = 0; q < 4; ++q) { p[1 + 2 * q] = bflo(raw[q]); p[2 + 2 * q] = bfhi(raw[q]); }
        float o[8];
#pragma unroll
        for (int q = 0; q < 8; ++q) o[q] = fmaf(w0, p[q], fmaf(w1, p[q + 1], fmaf(w2, p[q + 2], cb)));
        u32x4 w; w[0] = pk_bf16(o[0], o[1]); w[1] = pk_bf16(o[2], o[3]); w[2] = pk_bf16(o[4], o[5]); w[3] = pk_bf16(o[6], o[7]);
        *(LAS u32x4*)(lds + dest + (boff0 + b * bstride + n0) * 2) = w;
    }
}
__device__ __forceinline__ void hy_load_filters(LAS unsigned char* lds, int fb, const u16* __restrict__ src, int pl) {
    for (int idx = pl; idx < HY_FCH / 16; idx += 128) *(LAS u32x4*)(lds + fb + idx * 16) = *(const u32x4*)((const char*)src + idx * 16);
}
__device__ __forceinline__ void hy_mfma_loop(LAS unsigned char* lds, int zb, int fb, int hlf, int lane, f32x16 (&acc)[4], const ConvCtx& cc, int mbase, int cunit, int wid) {
    const int r = lane & 31, hh = lane >> 5, il = r >> 2, b = r & 3;
    const int bbase = zb + (256 + b * HY_ZSTRIDE + 32 * il + 8 * hh) * 2;
    const int xl = 2047 - r + 8 * hh - 1024 * hlf;
    const int abase = (r & 1) ? (fb + 2 * xl) : (fb + FR_LEN * 2 + 2 * (xl - 1));
#pragma unroll
    for (int q = 0; q < 4; ++q)
#pragma unroll
        for (int i = 0; i < 16; ++i) acc[q][i] = 0.f;
    for (int d0 = 0; d0 < 8; ++d0) {
#pragma unroll
        for (int ks = 0; ks < 2; ++ks) {
            f32x2 cv[16];
            const int mcv = conv_seq2tile((mbase + d0 * 2 + ks) * 256 + cunit);
            conv_issue(cc, mcv, wid, lane, cv);
            bf16x8 Bt[9];
#pragma unroll
            for (int j = 0; j < 9; ++j) Bt[j] = *(const LAS bf16x8*)(lds + bbase + 512 * j - 64 * d0 + 32 * ks);
#pragma unroll
            for (int ep = -8; ep <= 3; ++ep) {
                const LAS unsigned* ap = (const LAS unsigned*)(lds + abase - 64 * d0 - 512 * ep + 32 * ks);
                u32x4 av; av[0] = ap[0]; av[1] = ap[1]; av[2] = ap[2]; av[3] = ap[3];
                const bf16x8 a = __builtin_bit_cast(bf16x8, av);
#pragma unroll
                for (int ctl = 0; ctl < 4; ++ctl) { const int jt = ctl - ep; if (jt >= 0 && jt <= 8) acc[ctl] = __builtin_amdgcn_mfma_f32_32x32x16_bf16(a, Bt[jt], acc[ctl], 0, 0, 0); }
            }
            conv_finish(cc, mcv, wid, lane, cv);
        }
    }
}
__device__ __forceinline__ void hy_epilogue(LAS unsigned char* lds, int zb, int gb, int hlf, int lane, const f32x16 (&acc)[4], float bias) {
    const int r = lane & 31, hh = lane >> 5, il = r >> 2, b = r & 3;
#pragma unroll
    for (int ctl = 0; ctl < 4; ++ctl) {
        const int I = 8 * (4 * hlf + ctl) + il;
#pragma unroll
        for (int q = 0; q < 4; ++q) {
            const int n4 = 32 * I + 8 * q + 4 * hh;
            LAS u32x2* zp = (LAS u32x2*)(lds + zb + (256 + b * HY_ZSTRIDE + n4) * 2);
            const u32x2 zv = *zp, gv = *(const LAS u32x2*)(lds + gb + (b * 2048 + n4) * 2);
            const float z0 = bflo(zv[0]), z1 = bfhi(zv[0]), z2 = bflo(zv[1]), z3 = bfhi(zv[1]);
            const float g0 = bflo(gv[0]), g1 = bfhi(gv[0]), g2 = bflo(gv[1]), g3 = bfhi(gv[1]);
            u32x2 o; o[0] = pk_bf16(g0 * fmaf(bias, z0, acc[ctl][4 * q + 0]), g1 * fmaf(bias, z1, acc[ctl][4 * q + 1]));
            o[1] = pk_bf16(g2 * fmaf(bias, z2, acc[ctl][4 * q + 2]), g3 * fmaf(bias, z3, acc[ctl][4 * q + 3]));
            *zp = o;
        }
    }
}
__device__ __forceinline__ void hyena_unit(LAS unsigned char* lds, int unit, const u16* __restrict__ HYT, const u16* __restrict__ FR, const float* __restrict__ cw, const float* __restrict__ cbv,
                                           const float* __restrict__ hbias, u16* __restrict__ Z2T, const ConvCtx& cc) {
    const int tid = tid_fresh(), wid = __builtin_amdgcn_readfirstlane(tid >> 6), lane = tid & 63;
    const int cs = wid & 3, hlf = wid >> 2, c = unit * 4 + cs, pl = lane + 64 * hlf;
    const int zb = cs * HY_ZBYTES, fb = HY_FB + cs * HY_FCH;
    { const u32x4 z = {0u, 0u, 0u, 0u}; for (int idx = pl; idx < HY_ZBYTES / 16; idx += 128) *(LAS u32x4*)(lds + zb + idx * 16) = z; }
    __syncthreads();
    hy_load_row(lds, zb, 256, HY_ZSTRIDE, HYT + (size_t)c * NTOK, cw[0 * 3072 + c], cw[1 * 3072 + c], cw[2 * 3072 + c], cbv[c], pl);
    f32x16 acc[4];
#pragma unroll
    for (int o = 0; o < 2; ++o) {
        hy_load_filters(lds, fb, FR + (size_t)((o * 1024 + c) * 2) * FR_LEN, pl);
        __syncthreads();
        hy_mfma_loop(lds, zb, fb, hlf, lane, acc, cc, o * 16, unit, wid);
        __syncthreads();
        const int gc = (1 + o) * 1024 + c;
        hy_load_row(lds, fb, 0, 2048, HYT + (size_t)gc * NTOK, cw[0 * 3072 + gc], cw[1 * 3072 + gc], cw[2 * 3072 + gc], cbv[gc], pl);
        __syncthreads();
        hy_epilogue(lds, zb, fb, hlf, lane, acc, hbias[o * HYW + c]);
        __syncthreads();
    }
#pragma unroll 2
    for (int it = 0; it < 8; ++it) { const int idx = pl + 128 * it, tok0 = idx * 8, b = tok0 >> 11, n0 = tok0 & 2047;
        *(u32x4*)(Z2T + (size_t)c * NTOK + tok0) = *(const LAS u32x4*)(lds + zb + (256 + b * HY_ZSTRIDE + n0) * 2); }
    __syncthreads();
}

constexpr int HG_RAWQ = 0, HG_RAWF = 16384, HG_RAWV = 32768;
constexpr int HG_QM = 36864, HG_KM = HG_QM + 17408, HG_QI = HG_KM + 17408;
constexpr int HG_KL = HG_QI + 17408;
constexpr int HG_VT = HG_KL + 18432;
constexpr int HG_P = HG_VT + 4608;
constexpr int HG_ST = HG_P + 9216;
constexpr int HG_TOT = HG_ST + 8704;
constexpr int HG_EL2 = HG_TOT + 4096;
constexpr int HG_LDS = HG_EL2 + 512;

__device__ __forceinline__ void hgrn_unit(LAS unsigned char* lds, int unit, const u16* __restrict__ PG, const float* __restrict__ lb_logits, float* __restrict__ OF, float* __restrict__ OB, const ConvCtx& cc) {
    const int tid = tid_fresh(), wid = __builtin_amdgcn_readfirstlane(tid >> 6), lane = tid & 63, fr = lane & 15, fq = lane >> 4;
    const int h = unit & 7, vq = (unit >> 3) & 3, dir = (unit >> 5) & 1, b = unit >> 6;
    const int k = tid & 127, seg = tid >> 7;
    float* __restrict__ O = dir ? OB : OF;
    for (int i = tid; i < 8704 / 16; i += 512) *(LAS u32x4*)(lds + HG_ST + i * 16) = (u32x4){0u, 0u, 0u, 0u};
    f32x4 Sacc[2];
    Sacc[0] = (f32x4){0.f, 0.f, 0.f, 0.f}; Sacc[1] = Sacc[0];
    u32x4 pq[2], pf[2], pv;
    const int colq = h * 128, colf = (1 + dir) * 1024 + h * 128, colv = 3072 + h * 128 + vq * 32;
#define HG_TOK(c, tau) ((size_t)b * SEQ + (dir ? (SEQ - 1 - 64 * (c) - (tau)) : (64 * (c) + (tau))))
#define HG_PREFETCH(c) do { _Pragma("unroll") for (int _i = 0; _i < 2; ++_i) { const int _x = tid + 512 * _i, _tau = _x >> 4, _p = _x & 15; const u16* _r = PG + HG_TOK(c, _tau) * 5120; \
            pq[_i] = *(const u32x4*)(_r + colq + _p * 8); pf[_i] = *(const u32x4*)(_r + colf + _p * 8); } \
        if (tid < 256) { const int _tau = tid >> 2, _p = tid & 3; pv = *(const u32x4*)(PG + HG_TOK(c, _tau) * 5120 + colv + _p * 8); } } while (0)
#define HG_RAW2LDS() do { _Pragma("unroll") for (int _i = 0; _i < 2; ++_i) { const int _x = tid + 512 * _i; *(LAS u32x4*)(lds + HG_RAWQ + _x * 16) = pq[_i]; *(LAS u32x4*)(lds + HG_RAWF + _x * 16) = pf[_i]; } \
        if (tid < 256) *(LAS u32x4*)(lds + HG_RAWV + tid * 16) = pv; } while (0)
    HG_PREFETCH(0);
    HG_RAW2LDS();
    HG_PREFETCH(1);
    __syncthreads();
    for (int c = 0; c < 32; ++c) {
        f32x2 cv[16];
        const int mqa = conv_seq2tile((32 + c * 2) * 256 + unit), mqb = conv_seq2tile((33 + c * 2) * 256 + unit);
        conv_issue(cc, mqa, wid, lane, cv);
        const int kp = lane, sg = wid;
        float qv0[8], qv1[8], kv0[8], kv1[8], bl0[8], bl1[8];
        { float r0 = 0.f, r1 = 0.f;
#pragma unroll
          for (int i = 0; i < 8; ++i) { const int tau = sg * 8 + i;
              const unsigned qw = *(const LAS unsigned*)(lds + HG_RAWQ + tau * 256 + kp * 4), fw = *(const LAS unsigned*)(lds + HG_RAWF + tau * 256 + kp * 4);
              const float l0 = bflo(fw), l1 = bfhi(fw);
              r0 += l0; r1 += l1; bl0[i] = r0; bl1[i] = r1; kv0[i] = 1.0f - __builtin_amdgcn_exp2f(l0); kv1[i] = 1.0f - __builtin_amdgcn_exp2f(l1); qv0[i] = bflo(qw); qv1[i] = bfhi(qw); }
          *(LAS f32x2*)(lds + HG_TOT + (sg * 128 + 2 * kp) * 4) = (f32x2){r0, r1}; }
        __syncthreads();
        { f32x2 tt[8];
#pragma unroll
          for (int q = 0; q < 8; ++q) tt[q] = *(const LAS f32x2*)(lds + HG_TOT + (q * 128 + 2 * kp) * 4);
          f32x2 pre = {0.f, 0.f};
#pragma unroll
          for (int q = 0; q < 7; ++q) if (q < sg) pre += tt[q];
          const f32x2 bref = tt[0] + tt[1] + tt[2] + tt[3], blast = bref + tt[4] + tt[5] + tt[6] + tt[7];
          const float er0 = __builtin_amdgcn_exp2f(bref[0]), er1 = __builtin_amdgcn_exp2f(bref[1]), el0 = __builtin_amdgcn_exp2f(blast[0] - bref[0]), el1 = __builtin_amdgcn_exp2f(blast[1] - bref[1]);
          if (sg == 0) *(LAS f32x2*)(lds + HG_EL2 + 2 * kp * 4) = (f32x2){__builtin_amdgcn_exp2f(blast[0]), __builtin_amdgcn_exp2f(blast[1])};
          const f32x2 dref = pre - bref;
          float kl0[8], kl1[8];
#pragma unroll
          for (int i = 0; i < 8; ++i) { const int tau = sg * 8 + i; const float x0 = dref[0] + bl0[i], x1 = dref[1] + bl1[i];
              const float qm0 = qv0[i] * __builtin_amdgcn_exp2f(x0), qm1 = qv1[i] * __builtin_amdgcn_exp2f(x1), km0 = kv0[i] * __builtin_amdgcn_exp2f(-x0), km1 = kv1[i] * __builtin_amdgcn_exp2f(-x1);
              *(LAS unsigned*)(lds + HG_QM + tau * 272 + kp * 4) = pk_bf16(qm0, qm1);
              *(LAS unsigned*)(lds + HG_KM + tau * 272 + kp * 4) = pk_bf16(km0, km1);
              *(LAS unsigned*)(lds + HG_QI + tau * 272 + kp * 4) = pk_bf16(qm0 * er0, qm1 * er1);
              kl0[i] = km0 * el0; kl1[i] = km1 * el1; }
          *(LAS u32x4*)(lds + HG_KL + (2 * kp) * 144 + sg * 16) = (u32x4){pk_bf16(kl0[0], kl0[1]), pk_bf16(kl0[2], kl0[3]), pk_bf16(kl0[4], kl0[5]), pk_bf16(kl0[6], kl0[7])};
          *(LAS u32x4*)(lds + HG_KL + (2 * kp + 1) * 144 + sg * 16) = (u32x4){pk_bf16(kl1[0], kl1[1]), pk_bf16(kl1[2], kl1[3]), pk_bf16(kl1[4], kl1[5]), pk_bf16(kl1[6], kl1[7])};
          { const int v = tid & 31, tg = tid >> 5; unsigned short e[4];
#pragma unroll
            for (int u = 0; u < 4; ++u) e[u] = *(const LAS u16*)(lds + HG_RAWV + (tg * 4 + u) * 64 + v * 2);
            *(LAS u32x2*)(lds + HG_VT + v * 144 + tg * 8) = (u32x2){(unsigned)e[0] | ((unsigned)e[1] << 16), (unsigned)e[2] | ((unsigned)e[3] << 16)}; } }
        conv_finish(cc, mqa, wid, lane, cv);
        conv_issue(cc, mqb, wid, lane, cv);
        __syncthreads();
        if (c + 1 < 32) { HG_RAW2LDS(); if (c + 2 < 32) HG_PREFETCH(c + 2); }
#pragma unroll
        for (int q = 0; q < 2; ++q) { const int idx = wid * 2 + q, ti = idx >> 2, si = idx & 3;
            f32x4 a = {0.f, 0.f, 0.f, 0.f};
            if (si <= ti) {
#pragma unroll
                for (int ks = 0; ks < 4; ++ks) { const bf16x8 ka = *(const LAS bf16x8*)(lds + HG_KM + (si * 16 + fr) * 272 + (ks * 32 + fq * 8) * 2), qb = *(const LAS bf16x8*)(lds + HG_QM + (ti * 16 + fr) * 272 + (ks * 32 + fq * 8) * 2);
                    a = __builtin_amdgcn_mfma_f32_16x16x32_bf16(ka, qb, a, 0, 0, 0); } }
            const int tau = ti * 16 + fr, s0 = si * 16 + fq * 4;
            float pvv[4];
#pragma unroll
            for (int j = 0; j < 4; ++j) pvv[j] = (si <= ti && s0 + j <= tau) ? a[j] : 0.f;
            *(LAS u32x2*)(lds + HG_P + tau * 144 + s0 * 2) = (u32x2){pk_bf16(pvv[0], pvv[1]), pk_bf16(pvv[2], pvv[3])}; }
        const int ti = wid >> 1, vi = wid & 1;
        f32x4 oacc = {0.f, 0.f, 0.f, 0.f};
#pragma unroll
        for (int ks = 0; ks < 4; ++ks) { const bf16x8 qa = *(const LAS bf16x8*)(lds + HG_QI + (ti * 16 + fr) * 272 + (ks * 32 + fq * 8) * 2), sb = *(const LAS bf16x8*)(lds + HG_ST + (vi * 16 + fr) * 272 + (ks * 32 + fq * 8) * 2);
            oacc = __builtin_amdgcn_mfma_f32_16x16x32_bf16(qa, sb, oacc, 0, 0, 0); }
        { const f32x4 e2 = *(const LAS f32x4*)(lds + HG_EL2 + (wid * 16 + fq * 4) * 4);
#pragma unroll
          for (int v2 = 0; v2 < 2; ++v2) { Sacc[v2] = Sacc[v2] * e2;
#pragma unroll
              for (int ks = 0; ks < 2; ++ks) { const bf16x8 ka = *(const LAS bf16x8*)(lds + HG_KL + (wid * 16 + fr) * 144 + (ks * 32 + fq * 8) * 2), vb = *(const LAS bf16x8*)(lds + HG_VT + (v2 * 16 + fr) * 144 + (ks * 32 + fq * 8) * 2);
                  Sacc[v2] = __builtin_amdgcn_mfma_f32_16x16x32_bf16(ka, vb, Sacc[v2], 0, 0, 0); } } }
        __syncthreads();
#pragma unroll
        for (int ks = 0; ks < 2; ++ks) { const bf16x8 pa = *(const LAS bf16x8*)(lds + HG_P + (ti * 16 + fr) * 144 + (ks * 32 + fq * 8) * 2), vb = *(const LAS bf16x8*)(lds + HG_VT + (vi * 16 + fr) * 144 + (ks * 32 + fq * 8) * 2);
            oacc = __builtin_amdgcn_mfma_f32_16x16x32_bf16(pa, vb, oacc, 0, 0, 0); }
#pragma unroll
        for (int j = 0; j < 4; ++j) { const int tau = ti * 16 + fq * 4 + j; O[HG_TOK(c, tau) * HGW + h * 128 + vq * 32 + vi * 16 + fr] = oacc[j]; }
        conv_finish(cc, mqb, wid, lane, cv);
#pragma unroll
        for (int v2 = 0; v2 < 2; ++v2) *(LAS u32x2*)(lds + HG_ST + (v2 * 16 + fr) * 272 + (wid * 16 + fq * 4) * 2) = (u32x2){pk_bf16(Sacc[v2][0], Sacc[v2][1]), pk_bf16(Sacc[v2][2], Sacc[v2][3])};
    }
    __syncthreads();
#undef HG_TOK
#undef HG_PREFETCH
#undef HG_RAW2LDS
}


#define XB_TMO      128
#define XB_XCNT(j)  (256  + 64 * (j))
#define XB_XSUB(j)  (1280 + 64 * (j))
#define XB_XGEN(j)  (2304 + 64 * (j))
#define XB_TOP      3328
#define XB_TOPGEN   3392
#define XCD_BAR_WORDS 3456
#define XB_SPIN_CAP (1u << 22)

__device__ __forceinline__ unsigned xb_ld(unsigned* p)              { return __hip_atomic_load(p, __ATOMIC_RELAXED, __HIP_MEMORY_SCOPE_AGENT); }
__device__ __forceinline__ unsigned xb_add(unsigned* p, unsigned v) { return __hip_atomic_fetch_add(p, v, __ATOMIC_RELAXED, __HIP_MEMORY_SCOPE_AGENT); }
__device__ __forceinline__ unsigned xb_xcc_id() { return (unsigned)__builtin_amdgcn_s_getreg((3 << 11) | 20) & 0xFu; }
#define XB_SPIN(cond, bar) do { unsigned _sp = 0; while (cond) { __builtin_amdgcn_s_sleep(1); \
    if ((++_sp & 255u) == 0u) { if (xb_ld(&(bar)[XB_TMO])) break; if (_sp > XB_SPIN_CAP) { atomicAdd(&(bar)[XB_TMO], 1u); break; } } } } while (0)

struct XcdBarrier {
    unsigned* bar; unsigned x;
    volatile LAS unsigned* st;
};

__device__ __forceinline__ XcdBarrier xcd_barrier_post(unsigned* bar, volatile LAS unsigned* st) {
    XcdBarrier b; b.bar = bar; b.x = xb_xcc_id(); b.st = st;
    if (threadIdx.x == 0) (void)xb_add(&bar[XB_XCNT(b.x)], 1u);
    return b;
}
__device__ __forceinline__ void xcd_barrier_complete(unsigned* bar, unsigned x, unsigned& nloc, unsigned& nx) {
    const unsigned G = gridDim.x * gridDim.y * gridDim.z;
    unsigned sum, cnt, mine, sp = 0u;
    for (;;) {
        sum = 0u; cnt = 0u; mine = 0u;
#pragma unroll
        for (unsigned j = 0; j < 16; ++j) { const unsigned c = xb_ld(&bar[XB_XCNT(j)]); sum += c; cnt += (c > 0u) ? 1u : 0u; mine = (j == x) ? c : mine; }
        if (sum == G) break;
        __builtin_amdgcn_s_sleep(1);
        if ((++sp & 255u) == 0u) { if (xb_ld(&bar[XB_TMO])) break; if (sp > XB_SPIN_CAP) { atomicAdd(&bar[XB_TMO], 1u); break; } }
    }
    nloc = mine > 0u ? mine : 1u; nx = cnt > 0u ? cnt : 1u;
}

__device__ __forceinline__ void xcd_barrier(const XcdBarrier& b) {
    asm volatile("s_waitcnt vmcnt(0)" ::: "memory");
    __syncthreads();
    if (threadIdx.x == 0) {
        unsigned* bar = b.bar;
        __builtin_amdgcn_s_waitcnt(0);
        unsigned nloc = b.st[0], nx = b.st[1];
        if (nloc == 0u) { xcd_barrier_complete(bar, b.x, nloc, nx); b.st[0] = nloc; b.st[1] = nx; }
        const unsigned old = xb_add(&bar[XB_XSUB(b.x)], 1u);
        const unsigned gen = old / nloc;
        if (old + 1u == (gen + 1u) * nloc) {
            __builtin_amdgcn_fence(__ATOMIC_RELEASE, "agent");
            asm volatile("s_waitcnt vmcnt(0)" ::: "memory");
            const unsigned og = xb_add(&bar[XB_TOP], 1u);
            const unsigned tg = og / nx;
            if (og + 1u == (tg + 1u) * nx) xb_add(&bar[XB_TOPGEN], 1u);
            else XB_SPIN(xb_ld(&bar[XB_TOPGEN]) == tg, bar);
            __builtin_amdgcn_fence(__ATOMIC_ACQUIRE, "agent");
            xb_add(&bar[XB_XGEN(b.x)], 1u);
            asm volatile("s_waitcnt vmcnt(0)" ::: "memory");
        } else {
            XB_SPIN(xb_ld(&bar[XB_XGEN(b.x)]) == gen, bar);
            __builtin_amdgcn_fence(__ATOMIC_ACQUIRE, "agent");
            asm volatile("s_waitcnt vmcnt(0)" ::: "memory");
        }
    }
    __syncthreads();
}

__device__ __forceinline__ float wave_sum(float s) {
#pragma unroll
    for (int o = 32; o >= 1; o >>= 1) s += __shfl_xor(s, o);
    return s;
}
__device__ __forceinline__ void rmsnorm_row_bf(const float* __restrict__ xr, const float* __restrict__ gain, u16* __restrict__ ob, int lane) {
    f32x4 v[8]; float s = 0.f;
#pragma unroll
    for (int j = 0; j < 8; ++j) { v[j] = *(const f32x4*)(xr + (lane + 64 * j) * 4); s += v[j][0] * v[j][0] + v[j][1] * v[j][1] + v[j][2] * v[j][2] + v[j][3] * v[j][3]; }
    s = wave_sum(s);
    const float r = rsqrtf(s * (1.0f / (float)DM) + EPS);
#pragma unroll
    for (int j = 0; j < 8; ++j) { const f32x4 g = *(const f32x4*)(gain + (lane + 64 * j) * 4); const f32x4 o = v[j] * r * g;
        *(u32x2*)(ob + (lane + 64 * j) * 4) = (u32x2){pk_bf16(o[0], o[1]), pk_bf16(o[2], o[3])}; }
}
__device__ __forceinline__ void hgrn_final_item4(int item0, int stride, const float* __restrict__ OF, const float* __restrict__ OB, const u16* __restrict__ PG, const float* __restrict__ gain, u16* __restrict__ MIXB, int lane) {
    f32x2 a[4], b[4]; unsigned gw[4];
#pragma unroll
    for (int q = 0; q < 4; ++q) { const int item = item0 + q * stride, tok = item >> 3, c = (item & 7) * 128 + 2 * lane;
        a[q] = *(const f32x2*)(OF + (size_t)tok * HGW + c); b[q] = *(const f32x2*)(OB + (size_t)tok * HGW + c); gw[q] = *(const unsigned*)(PG + (size_t)tok * 5120 + 4096 + c); }
#pragma unroll
    for (int q = 0; q < 4; ++q) { const int item = item0 + q * stride, tok = item >> 3, c = (item & 7) * 128 + 2 * lane;
        const float o0 = a[q][0] + b[q][0], o1 = a[q][1] + b[q][1];
        const float s = wave_sum(o0 * o0 + o1 * o1);
        const float r = rsqrtf(s * (1.0f / 128.0f) + EPS);
        const float g0 = bflo(gw[q]), g1 = bfhi(gw[q]);
        const f32x2 gn = *(const f32x2*)(gain + c);
        const float v0 = o0 * r * gn[0] * (g0 * __builtin_amdgcn_rcpf(1.0f + __expf(-g0))), v1 = o1 * r * gn[1] * (g1 * __builtin_amdgcn_rcpf(1.0f + __expf(-g1)));
        *(u16*)((unsigned char*)MIXB + (size_t)tok * DM + c) = (u16)(__builtin_amdgcn_cvt_pk_fp8_f32(v0, v1, 0, false) & 0xffff); }
}
__device__ __forceinline__ void hy_norm_tile(LAS unsigned char* lds, int tile_i, const u16* __restrict__ Z2T, const float* __restrict__ gain, u16* __restrict__ MIXB) {
    const int t = tid_fresh(), tok0 = tile_i * 32;
    LAS float* ssq = (LAS float*)(lds + 1024 * 80);
    if (t < 32) ssq[t] = 0.f;
    __syncthreads();
    float part[8];
#pragma unroll
    for (int q = 0; q < 8; ++q) part[q] = 0.f;
    const int ch = t & 3;
#pragma unroll
    for (int it = 0; it < 8; ++it) {
        const int c = (t >> 2) + 128 * it;
        const u32x4 v = *(const u32x4*)(Z2T + (size_t)c * NTOK + tok0 + ch * 8);
        *(LAS u32x4*)(lds + c * 80 + ch * 16) = v;
#pragma unroll
        for (int q = 0; q < 4; ++q) { const float a = bflo(v[q]), b = bfhi(v[q]); part[2 * q] += a * a; part[2 * q + 1] += b * b; }
    }
#pragma unroll
    for (int q = 0; q < 8; ++q) { float s = part[q]; s += __shfl_xor(s, 4); s += __shfl_xor(s, 8); s += __shfl_xor(s, 16); s += __shfl_xor(s, 32); part[q] = s; }
    if ((t & 63) < 4) {
#pragma unroll
        for (int q = 0; q < 8; ++q) atomicAdd((float*)(ssq + ch * 8 + q), part[q]);
    }
    __syncthreads();
    const int tt = t >> 4;
    const float r = rsqrtf(ssq[tt] * (1.0f / (float)HYW) + EPS);
#pragma unroll 2
    for (int k = 0; k < 8; ++k) {
        const int c0 = ((t & 15) + 16 * k) * 8;
        float o[8];
#pragma unroll
        for (int q = 0; q < 8; ++q) o[q] = bf2f(*(const LAS u16*)(lds + (c0 + q) * 80 + tt * 2)) * r * gain[c0 + q];
        *(u32x2*)((unsigned char*)MIXB + (size_t)(tok0 + tt) * DM + 1024 + c0) = (u32x2){pk_fp8x4(o[0], o[1], o[2], o[3]), pk_fp8x4(o[4], o[5], o[6], o[7])};
    }
    __syncthreads();
}
constexpr int RT_XSTRIDE = 2049;
constexpr int RT_PART = 16 * RT_XSTRIDE * 4;
constexpr int RT_LG = RT_PART + 8 * 16 * 32 * 4;
constexpr int RT_HIST = RT_LG + 16 * 32 * 4;
constexpr int RT_ITEMS = RT_HIST + 128;
constexpr int RT_RBASE = RT_ITEMS + 512;
constexpr int RT_END = RT_RBASE + 128;
__device__ __forceinline__ void router_tile(LAS unsigned char* lds, int tile_i, const float* __restrict__ X1, const float* __restrict__ gain, const float* __restrict__ wr, const float* __restrict__ br,
                                            unsigned char* __restrict__ XN8, float* __restrict__ TOPG, int tl2) {
    const int tid = tid_fresh(), wid = __builtin_amdgcn_readfirstlane(tid >> 6), lane = tid & 63;
    const int tok0 = tile_i * 16;
    LAS float* xs = (LAS float*)lds;
#pragma unroll
    for (int q = 0; q < 2; ++q) {
        const int tl = wid * 2 + q; const size_t tok = (size_t)tok0 + tl;
        const float* xr = X1 + tok * DM;
        f32x4 v[8]; float s = 0.f;
#pragma unroll
        for (int j = 0; j < 8; ++j) { v[j] = *(const f32x4*)(xr + (lane + 64 * j) * 4); s += v[j][0] * v[j][0] + v[j][1] * v[j][1] + v[j][2] * v[j][2] + v[j][3] * v[j][3]; }
        s = wave_sum(s);
        const float r = rsqrtf(s * (1.0f / (float)DM) + EPS);
#pragma unroll
        for (int j = 0; j < 8; ++j) { const int d = (lane + 64 * j) * 4; const f32x4 g = *(const f32x4*)(gain + d); const f32x4 o = v[j] * r * g;
            xs[tl * RT_XSTRIDE + d + 0] = o[0]; xs[tl * RT_XSTRIDE + d + 1] = o[1]; xs[tl * RT_XSTRIDE + d + 2] = o[2]; xs[tl * RT_XSTRIDE + d + 3] = o[3];
            *(unsigned*)(XN8 + tok * DM + d) = pk_fp8x4(o[0], o[1], o[2], o[3]); }
    }
    __syncthreads();
    {
        const int tl = lane & 15, kk = lane >> 4;
        f32x4 a0 = {0.f, 0.f, 0.f, 0.f}, a1 = a0;
        const LAS float* xp = xs + tl * RT_XSTRIDE + wid * 256 + kk;
        const float* wp = wr + (size_t)(wid * 256 + kk) * NE + tl;
#pragma unroll 8
        for (int ks = 0; ks < 64; ++ks) { const float a = xp[ks * 4]; const float b0 = wp[(size_t)ks * 4 * NE], b1 = wp[(size_t)ks * 4 * NE + 16];
            a0 = __builtin_amdgcn_mfma_f32_16x16x4f32(a, b0, a0, 0, 0, 0); a1 = __builtin_amdgcn_mfma_f32_16x16x4f32(a, b1, a1, 0, 0, 0); }
        LAS float* pp = (LAS float*)(lds + RT_PART) + wid * 512;
#pragma unroll
        for (int j = 0; j < 4; ++j) { pp[(kk * 4 + j) * 32 + tl] = a0[j]; pp[(kk * 4 + j) * 32 + 16 + tl] = a1[j]; }
    }
    __syncthreads();
    {   const LAS float* pp = (const LAS float*)(lds + RT_PART); float s = br[tid & 31];
#pragma unroll
        for (int w = 0; w < 8; ++w) s += pp[w * 512 + tid];
        ((LAS float*)(lds + RT_LG))[tid] = s; }
    __syncthreads();
    if (tid < 16) {
        LAS float* lg = (LAS float*)(lds + RT_LG) + tid * 32;
        int i0 = 0, i1 = 0, i2 = 0, i3 = 0; float v0, v1, v2, v3;
        { float bv = -3.0e38f; for (int j = 0; j < NE; ++j) { const float l = lg[j]; if (l > bv) { bv = l; i0 = j; } } v0 = bv; lg[i0] = -3.4e38f; }
        { float bv = -3.0e38f; for (int j = 0; j < NE; ++j) { const float l = lg[j]; if (l > bv) { bv = l; i1 = j; } } v1 = bv; lg[i1] = -3.4e38f; }
        { float bv = -3.0e38f; for (int j = 0; j < NE; ++j) { const float l = lg[j]; if (l > bv) { bv = l; i2 = j; } } v2 = bv; lg[i2] = -3.4e38f; }
        { float bv = -3.0e38f; for (int j = 0; j < NE; ++j) { const float l = lg[j]; if (l > bv) { bv = l; i3 = j; } } v3 = bv; lg[i3] = -3.4e38f; }
        const float e1 = __expf(v1 - v0), e2 = __expf(v2 - v0), e3 = __expf(v3 - v0), inv = 1.0f / (1.0f + e1 + e2 + e3);
        const int tok = tok0 + tid;
        *(f32x4*)(TOPG + tok * 4) = (f32x4){inv, e1 * inv, e2 * inv, e3 * inv};
        LAS int* hist = (LAS int*)(lds + RT_HIST);
        const int p0 = atomicAdd((int*)(hist + i0), 1), p1 = atomicAdd((int*)(hist + i1), 1), p2 = atomicAdd((int*)(hist + i2), 1), p3 = atomicAdd((int*)(hist + i3), 1);
        *(LAS u32x4*)(lds + RT_ITEMS + (tl2 * 16 + tid) * 16) = (u32x4){(unsigned)((i0 << 16) | p0), (unsigned)((i1 << 16) | p1), (unsigned)((i2 << 16) | p2), (unsigned)((i3 << 16) | p3)};
    }
    __syncthreads();
}
__device__ __forceinline__ void combine_row(int tok, const float* __restrict__ X1, const u16* __restrict__ YB, const int* __restrict__ SOF, const float* __restrict__ TOPG, const float* __restrict__ gain, float* __restrict__ out, int lane) {
    const int4 sl = *(const int4*)(SOF + tok * 4); const f32x4 g = *(const f32x4*)(TOPG + tok * 4);
    const u16* y0 = YB + (size_t)sl.x * DM; const u16* y1 = YB + (size_t)sl.y * DM; const u16* y2 = YB + (size_t)sl.z * DM; const u16* y3 = YB + (size_t)sl.w * DM;
    f32x4 v[8]; float s = 0.f;
#pragma unroll
    for (int j = 0; j < 8; ++j) { const int d = (lane + 64 * j) * 4;
        f32x4 a = *(const f32x4*)(X1 + (size_t)tok * DM + d);
        const u32x2 q0 = *(const u32x2*)(y0 + d), q1 = *(const u32x2*)(y1 + d), q2 = *(const u32x2*)(y2 + d), q3 = *(const u32x2*)(y3 + d);
        a[0] += g[0] * bflo(q0[0]) + g[1] * bflo(q1[0]) + g[2] * bflo(q2[0]) + g[3] * bflo(q3[0]);
        a[1] += g[0] * bfhi(q0[0]) + g[1] * bfhi(q1[0]) + g[2] * bfhi(q2[0]) + g[3] * bfhi(q3[0]);
        a[2] += g[0] * bflo(q0[1]) + g[1] * bflo(q1[1]) + g[2] * bflo(q2[1]) + g[3] * bflo(q3[1]);
        a[3] += g[0] * bfhi(q0[1]) + g[1] * bfhi(q1[1]) + g[2] * bfhi(q2[1]) + g[3] * bfhi(q3[1]);
        v[j] = a; s += a[0] * a[0] + a[1] * a[1] + a[2] * a[2] + a[3] * a[3]; }
    s = wave_sum(s);
    const float r = rsqrtf(s * (1.0f / (float)DM) + EPS);
#pragma unroll
    for (int j = 0; j < 8; ++j) { const int d = (lane + 64 * j) * 4; const f32x4 gn = *(const f32x4*)(gain + d); *(f32x4*)(out + (size_t)tok * DM + d) = v[j] * r * gn; }
}

__device__ __forceinline__ void combine_row2(int tokA, int tokB, const float* __restrict__ X1, const u16* __restrict__ YB, const int* __restrict__ SOF, const float* __restrict__ TOPG, const float* __restrict__ gain, float* __restrict__ out, int lane) {
    const int4 slA = *(const int4*)(SOF + tokA * 4), slB = *(const int4*)(SOF + tokB * 4); const f32x4 gA = *(const f32x4*)(TOPG + tokA * 4), gB = *(const f32x4*)(TOPG + tokB * 4);
    const u16* yA0 = YB + (size_t)slA.x * DM; const u16* yA1 = YB + (size_t)slA.y * DM; const u16* yA2 = YB + (size_t)slA.z * DM; const u16* yA3 = YB + (size_t)slA.w * DM;
    const u16* yB0 = YB + (size_t)slB.x * DM; const u16* yB1 = YB + (size_t)slB.y * DM; const u16* yB2 = YB + (size_t)slB.z * DM; const u16* yB3 = YB + (size_t)slB.w * DM;
    f32x4 vA[8], vB[8]; float sA = 0.f, sB = 0.f;
#pragma unroll
    for (int j = 0; j < 8; ++j) { const int d = (lane + 64 * j) * 4;
        f32x4 a = *(const f32x4*)(X1 + (size_t)tokA * DM + d), b = *(const f32x4*)(X1 + (size_t)tokB * DM + d);
        const u32x2 p0 = *(const u32x2*)(yA0 + d), p1 = *(const u32x2*)(yA1 + d), p2 = *(const u32x2*)(yA2 + d), p3 = *(const u32x2*)(yA3 + d);
        const u32x2 q0 = *(const u32x2*)(yB0 + d), q1 = *(const u32x2*)(yB1 + d), q2 = *(const u32x2*)(yB2 + d), q3 = *(const u32x2*)(yB3 + d);
        a[0] += gA[0] * bflo(p0[0]) + gA[1] * bflo(p1[0]) + gA[2] * bflo(p2[0]) + gA[3] * bflo(p3[0]);
        a[1] += gA[0] * bfhi(p0[0]) + gA[1] * bfhi(p1[0]) + gA[2] * bfhi(p2[0]) + gA[3] * bfhi(p3[0]);
        a[2] += gA[0] * bflo(p0[1]) + gA[1] * bflo(p1[1]) + gA[2] * bflo(p2[1]) + gA[3] * bflo(p3[1]);
        a[3] += gA[0] * bfhi(p0[1]) + gA[1] * bfhi(p1[1]) + gA[2] * bfhi(p2[1]) + gA[3] * bfhi(p3[1]);
        b[0] += gB[0] * bflo(q0[0]) + gB[1] * bflo(q1[0]) + gB[2] * bflo(q2[0]) + gB[3] * bflo(q3[0]);
        b[1] += gB[0] * bfhi(q0[0]) + gB[1] * bfhi(q1[0]) + gB[2] * bfhi(q2[0]) + gB[3] * bfhi(q3[0]);
        b[2] += gB[0] * bflo(q0[1]) + gB[1] * bflo(q1[1]) + gB[2] * bflo(q2[1]) + gB[3] * bflo(q3[1]);
        b[3] += gB[0] * bfhi(q0[1]) + gB[1] * bfhi(q1[1]) + gB[2] * bfhi(q2[1]) + gB[3] * bfhi(q3[1]);
        vA[j] = a; vB[j] = b; sA += a[0] * a[0] + a[1] * a[1] + a[2] * a[2] + a[3] * a[3]; sB += b[0] * b[0] + b[1] * b[1] + b[2] * b[2] + b[3] * b[3]; }
    sA = wave_sum(sA); sB = wave_sum(sB);
    const float rA = rsqrtf(sA * (1.0f / (float)DM) + EPS), rB = rsqrtf(sB * (1.0f / (float)DM) + EPS);
#pragma unroll
    for (int j = 0; j < 8; ++j) { const int d = (lane + 64 * j) * 4; const f32x4 gn = *(const f32x4*)(gain + d);
        *(f32x4*)(out + (size_t)tokA * DM + d) = vA[j] * rA * gn; *(f32x4*)(out + (size_t)tokB * DM + d) = vB[j] * rB * gn; }
}
#ifndef REP_P9
#define REP_P9 1
#endif
#ifndef REP_P3
#define REP_P3 1
#endif
#ifndef REP_FR
#define REP_FR 1
#endif
#ifndef REP_P0
#define REP_P0 1
#endif
#ifndef REP_CONV
#define REP_CONV 1
#endif
#ifndef REP_GEMM1
#define REP_GEMM1 1
#endif
#ifndef REP_HY
#define REP_HY 1
#endif
#ifndef REP_HG
#define REP_HG 1
#endif
#ifndef REP_MOEA
#define REP_MOEA 1
#endif
#ifndef REP_MOEB
#define REP_MOEB 1
#endif
#ifndef REP_WOUT
#define REP_WOUT 1
#endif
struct MegaP {
    const float *x, *norm_mix_gain, *w_in, *lb_logits, *hgrn_norm_gain, *hy_conv_w, *hy_conv_b, *fw1, *fb1, *fw2, *fb2, *fw3, *fb3, *fw4, *ffreq, *hy_bias, *hy_norm_gain, *w_out,
        *norm_ffn_gain, *w_router, *b_router, *moe_w1, *moe_b1, *moe_w2, *moe_b2, *final_gain;
    float* out; unsigned char* ws;
};
constexpr int MEGA_XB = RT_END;
constexpr int MEGA_LDS = RT_END + 64 + 384;
static_assert(MEGA_LDS >= HY_LDS + 64 && MEGA_LDS >= HG_LDS + 64 && MEGA_LDS >= GEMM_LDS + 64, "LDS");

__global__ void __launch_bounds__(512, 2) k_mega(const MegaP p_arg) {
    extern __shared__ __attribute__((aligned(16))) unsigned char shm[];
    LAS unsigned char* lds = (LAS unsigned char*)shm;
    const int tid = threadIdx.x, wid = __builtin_amdgcn_readfirstlane(tid >> 6), lane = tid & 63;
    const int G = gridDim.x, bid = blockIdx.x, c = xcd_logical(bid, G);
#define PHASE_ARGS() const MegaP __attribute__((address_space(4)))* pq_ = (const MegaP __attribute__((address_space(4)))*)__builtin_amdgcn_kernarg_segment_ptr(); asm volatile("" : "+s"(pq_)); unsigned char* ws = pq_->ws; (void)ws
    unsigned char* ws0; { PHASE_ARGS(); ws0 = ws; }
#define counts ((int*)(ws + WS_CTL))
#define cursor ((int*)(ws + WS_CTL + 4096))
#define offs ((int*)(ws + WS_CTL + 8192))
#define barw ((unsigned*)(ws + WS_CTL + 16384))
#define HB ((u16*)(ws + WS_HB))
#define PG ((u16*)(ws + WS_PG))
#define HYT ((u16*)(ws + WS_HYT))
#define MIXB ((u16*)(ws + WS_MIXB))
#define XNB ((u16*)(ws + WS_XNB))
#define HMB ((u16*)(ws + WS_HMS))
#define YB ((u16*)(ws + WS_YS))
#define H3 ((float*)(ws + WS_H3))
#define FR ((u16*)(ws + WS_FR))
#define Z2T ((u16*)(ws + WS_Z2T))
#define OF ((float*)(ws + WS_OF))
#define OB ((float*)(ws + WS_OB))
#define X1 ((float*)(ws + WS_X1))
#define TOPI ((int*)(ws + WS_TOPI))
#define TOPG ((float*)(ws + WS_TOPG))
#define STOK ((int*)(ws + WS_STOKS))
#define SOF ((int*)(ws + WS_SOF))
#define WINT ((u16*)(ws + WS_WINT))
#define WOUTT ((u16*)(ws + WS_WOUTT))
#define W1T ((u16*)(ws + WS_W1T))
#define W2T ((u16*)(ws + WS_W2T))
    if (tid == 0) *(LAS u32x4*)(lds + MEGA_XB) = (u32x4){0u, 0u, 0u, 0u};
    __syncthreads();
    XcdBarrier bar = xcd_barrier_post((unsigned*)(ws0 + WS_CTL + 16384), (volatile LAS unsigned*)(lds + MEGA_XB));

    {
        PHASE_ARGS();
    for (int rep = 0; rep < REP_P0; ++rep) {
    for (int row = bid * 8 + wid; row < NTOK; row += G * 8) rmsnorm_row_bf(pq_->x + (size_t)row * DM, pq_->norm_mix_gain, HB + (size_t)row * DM, lane);
    for (int m = bid * 8 + wid; m < SEQ; m += G * 8) h3_row(m, pq_->fw1, pq_->fb1, pq_->fw2, pq_->fb2, pq_->fw3, pq_->fb3, pq_->ffreq, (LAS float*)(lds + wid * 512), H3); }
    for (int rep = 0; rep < REP_CONV; ++rep)
    for (int id = bid; id < 1024 + 256; id += G) {
        const int tz = tid_fresh();
        if (id < 1024) { const int nt = id >> 5, kt = id & 31; convert_tile(pq_->w_in, DIN, kt * 64, ColMapPerm{nt * 256}, WINT + (size_t)id * 16384, tz); }
        else { const int q = id - 1024; const ConvCtx cw{nullptr, pq_->w_out, nullptr, (unsigned char*)WOUTT};
            f32x2 cv[16]; conv_issue(cw, 16384 + q, tz >> 6, tz & 63, cv); conv_finish(cw, 16384 + q, tz >> 6, tz & 63, cv); }
    }
    }
    xcd_barrier(bar);
    {
        PHASE_ARGS();
    for (int rep = 0; rep < REP_FR; ++rep)
    for (int item = bid; item < 256; item += G) frgen_item(lds, item, H3, pq_->fw4, FR);
    { SrcG1<false> s0{c, G, (const char*)HB, (const char*)WINT, PG, HYT, pq_->lb_logits}; gemm8_stream<false, false>(lds, DM, 32, s0);
      SrcG1<true> s1{c, G, (const char*)HB, (const char*)WINT, PG, HYT, pq_->lb_logits}; gemm8_stream<true, false>(lds, DM, 32, s1); }
#ifdef PROBE_NOEPI
    for (int u = c; u < 1024; u += G) {
        const int i = u >> 8, xx = (u >> 5) & 7, j = u & 31;
        const int mt = (xx & 3) * 8 + (j & 7), nt = ((xx >> 2) + 2 * i) * 4 + (j >> 3);
        const u16* bt = WINT + (size_t)nt * 32 * 16384;
        EpiNone e{}; if (nt < 20) gemm8_unit<false>(lds, HB, DM, nullptr, mt * 256, 256, bt, 32, e); else gemm8_unit<true>(lds, HB, DM, nullptr, mt * 256, 256, bt, 32, e);
    }
#endif
    }
    xcd_barrier(bar);
    {
        PHASE_ARGS();
    for (int rep = 0; rep < REP_HY; ++rep)
    for (int u = bid; u < 256; u += G) hyena_unit(lds, u, HYT, FR, pq_->hy_conv_w, pq_->hy_conv_b, pq_->hy_bias, Z2T, ConvCtx{pq_->moe_w1, pq_->moe_w2, (unsigned char*)W1T, (unsigned char*)W2T});
    for (int rep = 0; rep < REP_HG; ++rep)
    for (int u = bid; u < 256; u += G) hgrn_unit(lds, u, PG, pq_->lb_logits, OF, OB, ConvCtx{pq_->moe_w1, pq_->moe_w2, (unsigned char*)W1T, (unsigned char*)W2T});
    }
    xcd_barrier(bar);
    {
        PHASE_ARGS();
    for (int rep = 0; rep < REP_P3; ++rep) {
    for (int it = bid * 8 + wid; it < NTOK * HGH; it += G * 8 * 4) hgrn_final_item4(it, G * 8, OF, OB, PG, pq_->hgrn_norm_gain, MIXB, lane);
    for (int t = bid; t < NTOK / 32; t += G) hy_norm_tile(lds, t, Z2T, pq_->hy_norm_gain, MIXB); }
    }
    xcd_barrier(bar);
    {
        PHASE_ARGS();
    for (int u = c; u < 256; u += G) {
        const int xx = u >> 5, j = u & 31;
        const int mt = (xx >> 1) * 8 + (j & 7), nt = (xx & 1) * 4 + (j >> 3);
        Epi8X1 e{pq_->x, X1, mt * 256, nt * 256};
        gemm8_unit<false, true>(lds, MIXB, DM / 2, nullptr, mt * 256, 256, WOUTT + (size_t)nt * 16 * 16384, 16, e);
    }
    }
    xcd_barrier(bar);
    {
        PHASE_ARGS();
    if (tid < NE) *(LAS int*)(lds + RT_HIST + tid * 4) = 0;
    __syncthreads();
    for (int t0 = bid; t0 < NTOK / 16; t0 += 2 * G) {
        const int t1 = t0 + G, ntl = (t1 < NTOK / 16) ? 2 : 1;
        router_tile(lds, t0, X1, pq_->norm_ffn_gain, pq_->w_router, pq_->b_router, (unsigned char*)XNB, TOPG, 0);
        if (ntl == 2) router_tile(lds, t1, X1, pq_->norm_ffn_gain, pq_->w_router, pq_->b_router, (unsigned char*)XNB, TOPG, 1);
        const int tq = tid_fresh();
        if (tq < NE) { const int n = *(const LAS int*)(lds + RT_HIST + tq * 4); *(LAS int*)(lds + RT_RBASE + tq * 4) = n ? atomicAdd(&cursor[tq * 32], n) : 0; *(LAS int*)(lds + RT_HIST + tq * 4) = 0; }
        __syncthreads();
        if (tq < ntl * 64) { const int it = *(const LAS int*)(lds + RT_ITEMS + tq * 4), e = it >> 16, tok = ((tq >> 6) ? t1 : t0) * 16 + ((tq >> 2) & 15);
            const int slot = e * NTOK + *(const LAS int*)(lds + RT_RBASE + e * 4) + (it & 0xffff); STOK[slot] = tok; SOF[tok * 4 + (tq & 3)] = slot; }
        __syncthreads();
    }
    }
    xcd_barrier(bar);
    {
        PHASE_ARGS();
    {
        LAS int* us = (LAS int*)(lds + MEGA_XB + 64); LAS int* so2 = us + 40;
        if (tid < NE) so2[tid] = __hip_atomic_load(&cursor[tid * 32], __ATOMIC_RELAXED, __HIP_MEMORY_SCOPE_AGENT);
        __syncthreads();
        if (tid == 0) { int a = 0; for (int e = 0; e < NE; ++e) { us[e] = a; a += ((so2[e] + 255) >> 8) * 16; } us[NE] = a; }
        __syncthreads();
    }
    {
        LAS int* qs = (LAS int*)(lds + MEGA_XB + 32); LAS int* us = (LAS int*)(lds + MEGA_XB + 64); LAS int* so2 = us + 40;
        int* qctr = (int*)(ws + WS_CTL + 12288 + (bid & 7) * 128);
        int tk_next = 0;
        auto decode = [&](int tkv, int& e, int& nt, int& slot0, int& rows) -> bool {
            const int tq = tid_fresh();
            if (tq == 0) { qs[0] = tkv; qs[1] = -1; }
            __syncthreads();
            const int tk = qs[0];
            const int u = 256 * (tk >> 5) + 32 * (bid & 7) + (tk & 31);
            if (tq < NE) { const int u0 = us[tq], u1 = us[tq + 1]; if (u >= u0 && u < u1) { const int o0 = tq * NTOK, cnt = so2[tq], mtl = (cnt + 255) >> 8, ul = u - u0, mt = ul % mtl;
                int rw = cnt - mt * 256; rw = rw > 256 ? 256 : rw; qs[1] = tq; qs[2] = ul / mtl; qs[3] = o0 + mt * 256; qs[4] = rw; } }
            __syncthreads();
            e = qs[1]; nt = qs[2]; slot0 = qs[3]; rows = qs[4];
            __syncthreads();
            return e >= 0;
        };
        if (tid == 0) tk_next = atomicAdd(qctr, 1);
        int e, nt, slot0, rows;
        if (decode(tk_next, e, nt, slot0, rows)) {
            if (tid == 0) tk_next = atomicAdd(qctr, 1);
            G8Pre cur, nxp;
            g8_addr(cur, DM / 2, STOK + slot0, rows, W1T + (size_t)(e * 16 + nt) * 16 * 16384);
            g8_issue(lds, (const char*)XNB, cur);
            for (;;) {
                int e2 = -1, nt2 = 0, slot2 = 0, rows2 = 0;
                auto next = [&]() -> bool {
                    if (!decode(tk_next, e2, nt2, slot2, rows2)) return false;
                    if (tid_fresh() == 0) tk_next = atomicAdd(qctr, 1);
                    g8_addr(nxp, DM / 2, STOK + slot2, rows2, W1T + (size_t)(e2 * 16 + nt2) * 16 * 16384);
                    g8_issue(lds, (const char*)XNB, nxp);
                    return true; };
                Epi8Swiglu8 ep{(unsigned char*)HMB, pq_->moe_b1 + (size_t)e * 2 * DFF, slot0, nt, rows};
                const bool more = gemm8_unit_ov<false, true>(lds, XNB, cur, 16, ep, next);
                if (!more) break;
                cur = nxp; e = e2; nt = nt2; slot0 = slot2; rows = rows2;
            }
        }
    }
    }
    xcd_barrier(bar);
    {
        PHASE_ARGS();
    {
        LAS int* us = (LAS int*)(lds + MEGA_XB + 64); LAS int* so2 = us + 40;
        if (tid < NE) so2[tid] = __hip_atomic_load(&cursor[tid * 32], __ATOMIC_RELAXED, __HIP_MEMORY_SCOPE_AGENT);
        __syncthreads();
        if (tid == 0) { int a = 0; for (int e = 0; e < NE; ++e) { us[e] = a; a += ((so2[e] + 255) >> 8) * 8; } us[NE] = a; }
        __syncthreads();
    }
    {
        const LAS int* us = (const LAS int*)(lds + MEGA_XB + 64); const LAS int* so2 = us + 40;
        SrcMoeB src{us, so2, c, G, (const char*)HMB, (const char*)W2T, YB, pq_->moe_b2};
        gemm8_stream<false, true>(lds, DFF / 2, 16, src);
    }
    }
    xcd_barrier(bar);
    {
        PHASE_ARGS();
    for (int rep = 0; rep < REP_P9; ++rep)
    for (int tok = bid * 8 + wid; tok < NTOK; tok += G * 8) combine_row(tok, X1, YB, SOF, TOPG, pq_->final_gain, pq_->out, lane);
    }
}
#undef counts
#undef cursor
#undef offs
#undef barw
#undef HB
#undef PG
#undef HYT
#undef MIXB
#undef XNB
#undef HMB
#undef YB
#undef H3
#undef FR
#undef Z2T
#undef OF
#undef OB
#undef X1
#undef TOPI
#undef TOPG
#undef STOK
#undef SOF
#undef WINT
#undef WOUTT
#undef W1T
#undef W2T

extern "C" void kernel_launch(void* const* d_in, const int* in_sizes, int n_in, void* d_out, int out_size, void* d_ws, size_t ws_size, hipStream_t stream) {
    if (n_in < 26 || ws_size < WS_END2) return;
    MegaP p{};
    const float** pp = (const float**)&p;
    for (int i = 0; i < 26; ++i) pp[i] = (const float*)d_in[i];
    p.out = (float*)d_out; p.ws = (unsigned char*)d_ws;
    static int grid = 0;
    if (!grid) {
        int dev = 0, cus = 0, per_cu = 0;
        (void)hipGetDevice(&dev);
        (void)hipDeviceGetAttribute(&cus, hipDeviceAttributeMultiprocessorCount, dev);
        (void)hipFuncSetAttribute((const void*)k_mega, hipFuncAttributeMaxDynamicSharedMemorySize, MEGA_LDS);
        (void)hipOccupancyMaxActiveBlocksPerMultiprocessor(&per_cu, (const void*)k_mega, 512, MEGA_LDS);
        if (per_cu < 1) per_cu = 1;
        grid = cus * 1;
        if (grid > 256) grid = 256;
        grid &= ~7;
        if (grid < 8) grid = 8;
    }
    (void)hipMemsetAsync((char*)d_ws + WS_CTL, 0, 65536, stream);
    hipLaunchKernelGGL(k_mega, dim3(grid), dim3(512), MEGA_LDS, stream, p);
}
```

```cpp
#include <hip/hip_runtime.h>
#include <stdint.h>

constexpr int BATCH = 4, SEQ = 2048, DM = 2048, NTOK = BATCH * SEQ;
constexpr int HGW = 1024, HGD = 128, HGH = 8;
constexpr int HYW = 1024;
constexpr int DIN = 8192;
constexpr int NE = 32, TOPK = 4, DFF = 2048;
constexpr int NSLOT = NTOK * TOPK;
constexpr float EPS = 1e-5f;

constexpr size_t MB = 1024ull * 1024ull;
constexpr size_t WS_CTL = 0;
constexpr size_t WS_HB = 1 * MB;
constexpr size_t WS_PG = WS_HB + 32 * MB;
constexpr size_t WS_HYT = WS_PG + 80 * MB;
constexpr size_t WS_MIXB = WS_HYT + 48 * MB;
constexpr size_t WS_XNB = WS_MIXB + 32 * MB;
constexpr size_t WS_HMB = WS_XNB + 32 * MB;
constexpr size_t WS_YB = WS_HMB + 128 * MB;
constexpr size_t WS_H3 = WS_YB + 128 * MB;
constexpr size_t WS_FR = WS_H3 + 1 * MB;
constexpr size_t WS_Z2T = WS_FR + 34 * MB;
constexpr size_t WS_OF = WS_Z2T + 16 * MB;
constexpr size_t WS_OB = WS_OF + 32 * MB;
constexpr size_t WS_X1 = WS_OB + 32 * MB;
constexpr size_t WS_TOPI = WS_X1 + 64 * MB;
constexpr size_t WS_TOPG = WS_TOPI + 1 * MB;
constexpr size_t WS_STOK = WS_TOPG + 1 * MB;
constexpr size_t WS_SOF = WS_STOK + 1 * MB;
constexpr size_t WS_WINT = WS_SOF + 1 * MB;
constexpr size_t WS_WOUTT = WS_WINT + 32 * MB;
constexpr size_t WS_W1T = WS_WOUTT + 8 * MB;
constexpr size_t WS_W2T = WS_W1T + 512 * MB;
constexpr size_t WS_HMS = WS_W2T + 256 * MB;
constexpr size_t WS_YS = WS_HMS + 512 * MB;
constexpr size_t WS_STOKS = WS_YS + 1024 * MB;
constexpr size_t WS_END2 = WS_STOKS + 1 * MB;

typedef short bf16x8 __attribute__((ext_vector_type(8)));
typedef float f32x4 __attribute__((ext_vector_type(4)));
typedef float f32x2 __attribute__((ext_vector_type(2)));
typedef unsigned u32x4 __attribute__((ext_vector_type(4)));
typedef unsigned u32x2 __attribute__((ext_vector_type(2)));
typedef unsigned short u16;
#define LAS __attribute__((address_space(3)))

__device__ __forceinline__ unsigned pk_bf16(float lo, float hi) {
    typedef __bf16 bf2 __attribute__((ext_vector_type(2)));
    const f32x2 v = {lo, hi};
    const bf2 r = __builtin_convertvector(v, bf2);
    return __builtin_bit_cast(unsigned, r);
}
__device__ __forceinline__ float bf2f(u16 b) { return __uint_as_float(((unsigned)b) << 16); }
__device__ __forceinline__ float bflo(unsigned w) { return __uint_as_float(w << 16); }
__device__ __forceinline__ float bfhi(unsigned w) { return __uint_as_float(w & 0xffff0000u); }

__device__ __forceinline__ int lds_byte(int r, int c) { const int st = (r >> 4) * 2 + (c >> 5), ob = (r & 15) * 64 + (c & 31) * 2; return st * 1024 + (ob ^ (((ob >> 9) & 1) << 5)); }
__device__ __forceinline__ void stage_rc(int b, int& R, int& C) { const int st = b >> 10, sb = b & 1023, swz = sb ^ (((sb >> 9) & 1) << 5); R = (st >> 1) * 16 + swz / 64; C = (st & 1) * 32 + (swz % 64) / 2; }
__device__ __forceinline__ f32x4 unperm(const f32x4 a, const bool s) { f32x4 o; o[0] = s ? a[1] : a[0]; o[1] = s ? a[0] : a[1]; o[2] = s ? a[3] : a[2]; o[3] = s ? a[2] : a[3]; return o; }

__device__ __forceinline__ int tid_fresh() { int t = threadIdx.x; asm volatile("" : "+v"(t)); return t; }
constexpr int GEMM_LDS = 131072;

template <bool TRANS, bool RAGGED, int PM = 0, class ColMap, class Epi>
__device__ __forceinline__ void gemm_unit(LAS unsigned char* lds, const u16* __restrict__ A, int lda, const int* __restrict__ arows, int arow0, int rows_valid,
                                          const float* __restrict__ B, int ldb, int K, const ColMap colmap, const Epi epi) {
    const int tid = tid_fresh(), wid = __builtin_amdgcn_readfirstlane(tid >> 6), lane = tid & 63;
    const int wr = wid >> 2, wc = wid & 3, fr = lane & 15, fq = lane >> 4;
    const int nt = K >> 6;
    const char* ap[4];
#pragma unroll
    for (int i = 0; i < 4; ++i) {
        int R, C; stage_rc(wid * 1024 + i * 8192 + lane * 16, R, C);
        const int rr = RAGGED ? (R < rows_valid ? R : rows_valid - 1) : R;
        const long rowid = arows ? (long)arows[rr] : (long)(arow0 + rr);
        ap[i] = (const char*)A + ((size_t)rowid * lda + C) * 2;
    }
    const int g = (lane & 3) + 4 * (wid >> 2), rg = (wid & 3) * 16 + (lane >> 2);
    const unsigned bvoff = (unsigned)(((size_t)(8 * g) * ldb + colmap(rg)) * 4);
    const int bbase = 65536 + lds_byte(4 * rg, 8 * g);
    const int bw0 = bbase + ((rg & 1) ? 64 : 0), bw1 = bbase + ((rg & 1) ? 0 : 64);
    const int aoff = lds_byte(wr * 128 + fr, fq * 8), boff = 65536 + lds_byte(wc * 64 + fr, fq * 8);
    int mvalid = 8;
    if (RAGGED) { mvalid = (rows_valid - wr * 128 + 15) >> 4; mvalid = mvalid < 0 ? 0 : (mvalid > 8 ? 8 : mvalid); }
    f32x4 vb0, vb1, vb2, vb3, vb4, vb5, vb6, vb7;
    if (PM & 1) { vb0 = (f32x4){1.f, 1.f, 1.f, 1.f}; vb1 = vb0; vb2 = vb0; vb3 = vb0; vb4 = vb0; vb5 = vb0; vb6 = vb0; vb7 = vb0; }
    f32x4 acc[8][4];
#pragma unroll
    for (int m = 0; m < 8; ++m)
#pragma unroll
        for (int n = 0; n < 4; ++n) acc[m][n] = (f32x4){0.f, 0.f, 0.f, 0.f};
    const size_t ldb4 = (size_t)ldb * 4;
#define GE_GLDS_A(buf, kt) do { if (!(PM & 2)) _Pragma("unroll") for (int _i = 0; _i < 4; ++_i) \
        __builtin_amdgcn_global_load_lds((const unsigned*)(ap[_i] + (size_t)(kt) * 128), (LAS unsigned*)(lds + (buf) * 32768 + wid * 1024 + _i * 8192), 16, 0, 0); } while (0)
#define GE_LD1(dst, sb) if (!(PM & 1)) asm volatile("global_load_dwordx4 %0, %1, %2" : "=v"(dst) : "v"(bvoff), "s"(sb) : "memory")
#define GE_LOAD_B(kt) do { const char* _sb = (const char*)B + (size_t)(kt) * 64 * ldb4; \
        GE_LD1(vb0, _sb); GE_LD1(vb1, _sb + ldb4); GE_LD1(vb2, _sb + 2 * ldb4); GE_LD1(vb3, _sb + 3 * ldb4); \
        GE_LD1(vb4, _sb + 4 * ldb4); GE_LD1(vb5, _sb + 5 * ldb4); GE_LD1(vb6, _sb + 6 * ldb4); GE_LD1(vb7, _sb + 7 * ldb4); } while (0)
#define GE_WAITV_B(n) asm volatile("s_waitcnt vmcnt(" #n ")" : "+v"(vb0), "+v"(vb1), "+v"(vb2), "+v"(vb3), "+v"(vb4), "+v"(vb5), "+v"(vb6), "+v"(vb7) :: "memory")
#define GE_WRITE_B(buf) do { _Pragma("unroll") for (int _i = 0; _i < 4; ++_i) { u32x4 _w; _w[0] = pk_bf16(vb0[_i], vb1[_i]); _w[1] = pk_bf16(vb2[_i], vb3[_i]); \
        _w[2] = pk_bf16(vb4[_i], vb5[_i]); _w[3] = pk_bf16(vb6[_i], vb7[_i]); \
        *(LAS u32x4*)(lds + ((_i & 1) ? bw1 : bw0) + (_i >> 1) * 128 + (buf) * 32768) = _w; } } while (0)
#define GE_KSTEP(buf, ks) do { bf16x8 Bf[4]; \
        _Pragma("unroll") for (int n = 0; n < 4; ++n) Bf[n] = *(const LAS bf16x8*)(lds + (buf) * 32768 + boff + n * 2048 + (ks) * 1024); \
        _Pragma("unroll") for (int mh = 0; mh < 2; ++mh) { bf16x8 At[4]; \
            _Pragma("unroll") for (int m = 0; m < 4; ++m) At[m] = *(const LAS bf16x8*)(lds + (buf) * 32768 + aoff + (mh * 4 + m) * 2048 + (ks) * 1024); \
            _Pragma("unroll") for (int m = 0; m < 4; ++m) { if (!RAGGED || (mh * 4 + m) < mvalid) { _Pragma("unroll") for (int n = 0; n < 4; ++n) \
                { if (PM & 4) { asm volatile("" :: "v"(At[m]), "v"(Bf[n])); } else acc[mh * 4 + m][n] = TRANS ? __builtin_amdgcn_mfma_f32_16x16x32_bf16(At[m], Bf[n], acc[mh * 4 + m][n], 0, 0, 0) : __builtin_amdgcn_mfma_f32_16x16x32_bf16(Bf[n], At[m], acc[mh * 4 + m][n], 0, 0, 0); } } } } } while (0)
    GE_GLDS_A(0, 0);
    GE_LOAD_B(0);
    GE_WAITV_B(0);
    GE_WRITE_B(0);
    GE_LOAD_B(1);
    asm volatile("s_waitcnt lgkmcnt(0)" ::: "memory");
    __builtin_amdgcn_s_barrier();
    int t = 0;
    for (; t < nt - 2; ++t) {
        const int cur = t & 1;
        GE_GLDS_A(cur ^ 1, t + 1);
        GE_KSTEP(cur, 0);
        GE_WAITV_B(4);
        GE_WRITE_B(cur ^ 1);
        GE_LOAD_B(t + 2);
        __builtin_amdgcn_sched_barrier(0);
        GE_KSTEP(cur, 1);
        asm volatile("s_waitcnt vmcnt(8) lgkmcnt(0)" ::: "memory");
        __builtin_amdgcn_s_barrier();
    }
    {
        const int cur = t & 1;
        GE_GLDS_A(cur ^ 1, t + 1);
        GE_KSTEP(cur, 0);
        GE_WAITV_B(4);
        GE_WRITE_B(cur ^ 1);
        GE_KSTEP(cur, 1);
        asm volatile("s_waitcnt vmcnt(0) lgkmcnt(0)" ::: "memory");
        __builtin_amdgcn_s_barrier();
        ++t;
    }
    {
        const int cur = t & 1;
        GE_KSTEP(cur, 0);
        GE_KSTEP(cur, 1);
        asm volatile("s_waitcnt lgkmcnt(0)" ::: "memory");
        __builtin_amdgcn_s_barrier();
    }
#undef GE_GLDS_A
#undef GE_LD1
#undef GE_LOAD_B
#undef GE_WAITV_B
#undef GE_WRITE_B
#undef GE_KSTEP
    __builtin_amdgcn_sched_barrier(0);
    { const int tz = tid_fresh(), wz = __builtin_amdgcn_readfirstlane(tz >> 6), lz = tz & 63;
      epi(acc, wz >> 2, wz & 3, lz & 15, lz >> 4); }
}

__device__ __forceinline__ int xcd_logical(int b, int G) { return (G & 7) ? b : (b & 7) * (G >> 3) + (b >> 3); }

struct ColMapDense { int c0; __device__ __forceinline__ int operator()(int rg) const { return c0 + 4 * rg; } };
struct EpiPG { u16* PG; int tok0, col0;
    __device__ __forceinline__ void operator()(const f32x4 (&acc)[8][4], int wr, int wc, int fr, int fq) const {
#pragma unroll
        for (int m = 0; m < 8; ++m) { u16* rowp = PG + (size_t)(tok0 + wr * 128 + m * 16 + fr) * 5120 + col0 + wc * 64 + 4 * fq;
#pragma unroll
            for (int n = 0; n < 4; ++n) { const f32x4 v = unperm(acc[m][n], fq & 1); u32x2 w; w[0] = pk_bf16(v[0], v[1]); w[1] = pk_bf16(v[2], v[3]); *(u32x2*)(rowp + n * 16) = w; } }
    } };
struct EpiHYT { u16* HYT; int tok0, col0;
    __device__ __forceinline__ void operator()(const f32x4 (&acc)[8][4], int wr, int wc, int fr, int fq) const {
#pragma unroll
        for (int n = 0; n < 4; ++n) { const int rho = wc * 64 + n * 16 + fr; const int col = col0 + (rho & ~3) + ((rho & 3) ^ ((rho >> 2) & 1));
            u16* colp = HYT + (size_t)col * NTOK + tok0 + wr * 128 + 4 * fq;
#pragma unroll
            for (int m = 0; m < 8; ++m) { const f32x4 v = acc[m][n]; u32x2 w; w[0] = pk_bf16(v[0], v[1]); w[1] = pk_bf16(v[2], v[3]); *(u32x2*)(colp + m * 16) = w; } }
    } };
struct EpiX1 { const float* x; float* X1; int tok0, col0;
    __device__ __forceinline__ void operator()(const f32x4 (&acc)[8][4], int wr, int wc, int fr, int fq) const {
#pragma unroll
        for (int m = 0; m < 8; ++m) { const size_t off = (size_t)(tok0 + wr * 128 + m * 16 + fr) * DM + col0 + wc * 64 + 4 * fq;
#pragma unroll
            for (int n = 0; n < 4; ++n) { const f32x4 r = *(const f32x4*)(x + off + n * 16); *(f32x4*)(X1 + off + n * 16) = r + unperm(acc[m][n], fq & 1); }
            asm volatile("" ::: "memory"); }
    } };
struct ColMapGlu { int nt; __device__ __forceinline__ int operator()(int rg) const { const int wcq = rg >> 4, n = (rg >> 2) & 3, f = rg & 3; return (n >> 1) * 2048 + nt * 128 + wcq * 32 + (n & 1) * 16 + f * 4; } };
struct EpiSwiglu { u16* HM; const float* b1; int slot0, nt, rows_valid;
    __device__ __forceinline__ void operator()(const f32x4 (&acc)[8][4], int wr, int wc, int fr, int fq) const {
        f32x4 bg[2], bl[2];
#pragma unroll
        for (int nn = 0; nn < 2; ++nn) { const int col = nt * 128 + wc * 32 + nn * 16 + 4 * fq; bg[nn] = *(const f32x4*)(b1 + col); bl[nn] = *(const f32x4*)(b1 + 2048 + col); }
#pragma unroll
        for (int m = 0; m < 8; ++m) { const int row = wr * 128 + m * 16 + fr;
            if (row < rows_valid) {
#pragma unroll
                for (int nn = 0; nn < 2; ++nn) { const f32x4 gl = unperm(acc[m][nn], fq & 1) + bg[nn], li = unperm(acc[m][nn + 2], fq & 1) + bl[nn]; float o[4];
#pragma unroll
                    for (int j = 0; j < 4; ++j) { const float gq = fminf(gl[j], 7.0f), lq = fminf(fmaxf(li[j], -7.0f), 7.0f); o[j] = gq * (1.0f / (1.0f + __expf(-1.702f * gq))) * (lq + 1.0f); }
                    u32x2 w; w[0] = pk_bf16(o[0], o[1]); w[1] = pk_bf16(o[2], o[3]);
                    *(u32x2*)(HM + (size_t)(slot0 + row) * DFF + nt * 128 + wc * 32 + nn * 16 + 4 * fq) = w; } } }
    } };
struct EpiY { u16* Y; const float* b2; int slot0, col0, rows_valid;
    __device__ __forceinline__ void operator()(const f32x4 (&acc)[8][4], int wr, int wc, int fr, int fq) const {
        f32x4 bv[4];
#pragma unroll
        for (int n = 0; n < 4; ++n) bv[n] = *(const f32x4*)(b2 + col0 + wc * 64 + n * 16 + 4 * fq);
#pragma unroll
        for (int m = 0; m < 8; ++m) { const int row = wr * 128 + m * 16 + fr;
            if (row < rows_valid) { u16* rowp = Y + (size_t)(slot0 + row) * DM + col0 + wc * 64 + 4 * fq;
#pragma unroll
                for (int n = 0; n < 4; ++n) { const f32x4 v = unperm(acc[m][n], fq & 1) + bv[n]; u32x2 w; w[0] = pk_bf16(v[0], v[1]); w[1] = pk_bf16(v[2], v[3]); *(u32x2*)(rowp + n * 16) = w; } } }
    } };
template <int NTILES>
__device__ __forceinline__ bool moe_decode(const int* __restrict__ offs, int u, int& e, int& mt, int& nt, int& slot0, int& rows) {
    int base = 0;
    for (int q = 0; q < NE; ++q) { const int o0 = offs[q], cnt = offs[q + 1] - o0, mtl = (cnt + 255) >> 8, nu = mtl * NTILES;
        if (u < base + nu) { const int ul = u - base; e = q; mt = ul % mtl; nt = ul / mtl; slot0 = o0 + mt * 256; rows = cnt - mt * 256; if (rows > 256) rows = 256; return true; }
        base += nu; }
    return false;
}


__device__ __forceinline__ int perm_col4(int rg) { const int rgl = rg & 31, t = rgl & 7; return 32 * (rgl >> 3) + 8 * (t & 3) + 4 * (t >> 2); }
__device__ __forceinline__ int perm32(int rho) { const int n = rho >> 4, i = rho & 15; return 8 * (i >> 2) + 4 * n + (i & 3); }
template <class ColMap>
__device__ __forceinline__ void convert_tile(const float* __restrict__ W, int ldb, int k0, const ColMap colmap, u16* __restrict__ dst, int tid) {
    const int wid = tid >> 6, lane = tid & 63;
    const int g = (lane & 3) + 4 * (wid >> 2), rg = (wid & 3) * 16 + (lane >> 2);
    const float* bp = W + (size_t)(k0 + 8 * g) * ldb + colmap(rg);
    f32x4 v[8];
#pragma unroll
    for (int kk = 0; kk < 8; ++kk) v[kk] = __builtin_nontemporal_load((const f32x4*)(bp + (size_t)kk * ldb));
    const int h = rg >> 5, r0 = (4 * rg) & 127;
    unsigned char* base = (unsigned char*)dst + h * 16384 + lds_byte(r0, 8 * g);
#pragma unroll
    for (int i = 0; i < 4; ++i) { u32x4 w; w[0] = pk_bf16(v[0][i], v[1][i]); w[1] = pk_bf16(v[2][i], v[3][i]); w[2] = pk_bf16(v[4][i], v[5][i]); w[3] = pk_bf16(v[6][i], v[7][i]);
        *(u32x4*)(base + i * 64) = w; }
}
typedef int i32x8 __attribute__((ext_vector_type(8)));
typedef int i32x4 __attribute__((ext_vector_type(4)));
constexpr float W8_SCALE = 32.0f;
constexpr int W8_MX = 0x7A7A7A7A;
constexpr int A8_MX = 0x7F7F7F7F;
__device__ __forceinline__ unsigned pk_fp8x4(float a, float b, float c, float d) { int p = __builtin_amdgcn_cvt_pk_fp8_f32(a, b, 0, false); p = __builtin_amdgcn_cvt_pk_fp8_f32(c, d, p, true); return (unsigned)p; }
__device__ __forceinline__ int lds_byte_b(int r, int cb) { const int st = (r >> 4) * 2 + (cb >> 6), ob = (r & 15) * 64 + (cb & 63); return st * 1024 + (ob ^ (((ob >> 9) & 1) << 5)); }
struct ConvCtx { const float* w1; const float* w2; unsigned char* W1T; unsigned char* W2T; };
__device__ __forceinline__ int conv_seq2tile(int s) {
    if (s < 16384) return (s >> 9) * 512 + (s & 15) * 32 + ((s >> 4) & 31);
    const int q = s - 16384; return 16384 + (q >> 8) * 256 + (q & 7) * 32 + ((q >> 3) & 31);
}
__device__ __forceinline__ void conv_issue(const ConvCtx& cc, int m, int wid, int lane, f32x2 (&v)[16]) {
    const int rp = 16 * wid + (lane & 15), rg = rp >> 1, p2 = (rp & 1) * 2, kg = lane >> 4;
    const float* bp; size_t ld;
    if (m < 16384) { const int e = m >> 9, nt = (m >> 5) & 15, kt = m & 31; ld = 2 * DFF; bp = cc.w1 + (size_t)e * DM * 2 * DFF + (size_t)(kt * 64 + 16 * kg) * ld + (rg >> 5) * 2048 + nt * 128 + perm_col4(rg) + p2; }
    else { const int q = m - 16384, e = q >> 8, nt = (q >> 5) & 7, kt = q & 31; ld = DM; bp = cc.w2 + (size_t)e * DFF * DM + (size_t)(kt * 64 + 16 * kg) * ld + nt * 256 + (rg >> 5) * 128 + perm_col4(rg) + p2; }
#pragma unroll
    for (int kk = 0; kk < 16; ++kk) v[kk] = __builtin_nontemporal_load((const f32x2*)(bp + (size_t)kk * ld));
}
__device__ __forceinline__ void conv_finish(const ConvCtx& cc, int m, int wid, int lane, const f32x2 (&v)[16]) {
    const int rp = 16 * wid + (lane & 15), kg = lane >> 4;
    const int kt64 = m & 31;
    unsigned char* dst = (m < 16384) ? cc.W1T + ((size_t)(m >> 5) * 16 + (kt64 >> 1)) * 32768 : cc.W2T + ((size_t)((m - 16384) >> 5) * 16 + (kt64 >> 1)) * 32768;
    unsigned char* base = dst + (rp >> 6) * 16384 + lds_byte_b((2 * rp) & 127, (kt64 & 1) * 64 + 16 * kg);
#pragma unroll
    for (int i = 0; i < 2; ++i) { u32x4 w;
#pragma unroll
        for (int q = 0; q < 4; ++q) w[q] = pk_fp8x4(v[4 * q][i] * W8_SCALE, v[4 * q + 1][i] * W8_SCALE, v[4 * q + 2][i] * W8_SCALE, v[4 * q + 3][i] * W8_SCALE);
        __builtin_nontemporal_store(w, (u32x4*)(base + i * 64)); }
}
struct ColMapGluT { int nt; __device__ __forceinline__ int operator()(int rg) const { return (rg >> 5) * 2048 + nt * 128 + perm_col4(rg); } };
struct ColMapPerm { int c0; __device__ __forceinline__ int operator()(int rg) const { return c0 + (rg >> 5) * 128 + perm_col4(rg); } };

template <bool TRANS, bool FP8 = false, class Epi>
__device__ __forceinline__ void gemm8_unit(LAS unsigned char* lds, const u16* __restrict__ A, int lda, const int* __restrict__ arows, int arow0, int rows_valid, const u16* __restrict__ Bt, int nt, const Epi epi) {
    const int tid = tid_fresh(), wid = __builtin_amdgcn_readfirstlane(tid >> 6), lane = tid & 63;
    const int wr = wid >> 2, wc = wid & 3, fr = lane & 15, fq = lane >> 4;
    unsigned aof[2][2];
#pragma unroll
    for (int h = 0; h < 2; ++h)
#pragma unroll
        for (int i = 0; i < 2; ++i) { int R, C; stage_rc(tid * 16 + i * 8192, R, C); int rr = h * 128 + R; rr = rr < rows_valid ? rr : rows_valid - 1;
            const unsigned rowid = arows ? (unsigned)arows[rr] : (unsigned)(arow0 + rr); aof[h][i] = (rowid * (unsigned)lda + (unsigned)C) * 2u; }
    const char* Ab = (const char*)A; const char* Bb = (const char*)Bt + tid * 16;
    const bool hi = rows_valid > 128;
    int mxw = W8_MX, mxa = A8_MX; asm volatile("" : "+v"(mxw), "+v"(mxa));
#define G8_SA(b, h) (((b) * 2 + (h)) * 16384)
#define G8_SB(b, h) (65536 + ((b) * 2 + (h)) * 16384)
#define G8_STA(b, h, kt) do { _Pragma("unroll") for (int _i = 0; _i < 2; ++_i) \
        __builtin_amdgcn_global_load_lds((const unsigned*)(Ab + aof[h][_i] + (size_t)(kt) * 128), (LAS unsigned*)(lds + G8_SA(b, h) + wid * 1024 + _i * 8192), 16, 0, 0); } while (0)
#define G8_STB(b, h, kt) do { _Pragma("unroll") for (int _i = 0; _i < 2; ++_i) \
        __builtin_amdgcn_global_load_lds((const unsigned*)(Bb + (size_t)(kt) * 32768 + (h) * 16384 + _i * 8192), (LAS unsigned*)(lds + G8_SB(b, h) + wid * 1024 + _i * 8192), 16, 0, 0); } while (0)
#define G8_LDA(dst, b, h) do { _Pragma("unroll") for (int m = 0; m < 4; ++m) _Pragma("unroll") for (int k = 0; k < 2; ++k) dst[m][k] = *(const LAS bf16x8*)(lds + G8_SA(b, h) + aoff + m * 2048 + k * 1024); } while (0)
#define G8_LDB(dst, b, h) do { _Pragma("unroll") for (int n = 0; n < 2; ++n) _Pragma("unroll") for (int k = 0; k < 2; ++k) dst[n][k] = *(const LAS bf16x8*)(lds + G8_SB(b, h) + boff + n * 2048 + k * 1024); } while (0)
#define G8_MMA(ai, bj, At, Bq) do { if ((ai) == 0 || hi) { __builtin_amdgcn_s_setprio(1); _Pragma("unroll") for (int m = 0; m < 4; ++m) _Pragma("unroll") for (int n = 0; n < 2; ++n) { \
        if (FP8) { const i32x4 a0 = __builtin_bit_cast(i32x4, At[m][0]), a1 = __builtin_bit_cast(i32x4, At[m][1]), b0 = __builtin_bit_cast(i32x4, Bq[n][0]), b1 = __builtin_bit_cast(i32x4, Bq[n][1]); \
            const i32x8 a8 = __builtin_shufflevector(a0, a1, 0, 1, 2, 3, 4, 5, 6, 7), b8 = __builtin_shufflevector(b0, b1, 0, 1, 2, 3, 4, 5, 6, 7); \
            asm volatile("v_mfma_scale_f32_16x16x128_f8f6f4 %0, %1, %2, %0, %3, %4 op_sel_hi:[0,0,0]" : "+v"(acc[ai][bj][m][n]) : "v"(b8), "v"(a8), "v"(mxw), "v"(mxa)); } \
        else { _Pragma("unroll") for (int k = 0; k < 2; ++k) \
            acc[ai][bj][m][n] = TRANS ? __builtin_amdgcn_mfma_f32_16x16x32_bf16(At[m][k], Bq[n][k], acc[ai][bj][m][n], 0, 0, 0) : __builtin_amdgcn_mfma_f32_16x16x32_bf16(Bq[n][k], At[m][k], acc[ai][bj][m][n], 0, 0, 0); } } \
        __builtin_amdgcn_s_setprio(0); } } while (0)
#define G8_WV(n) asm volatile("s_waitcnt vmcnt(" #n ")" ::: "memory")
#define G8_WL(n) asm volatile("s_waitcnt lgkmcnt(" #n ")" ::: "memory")
#define G8_BAR __builtin_amdgcn_s_barrier()
#define G8_SCHED __builtin_amdgcn_sched_barrier(0)
    const int aoff = lds_byte(wr * 64 + fr, fq * 8), boff = lds_byte(wc * 32 + fr, fq * 8);
    f32x4 acc[2][2][4][2];
#pragma unroll
    for (int a = 0; a < 2; ++a)
#pragma unroll
        for (int b = 0; b < 2; ++b)
#pragma unroll
            for (int m = 0; m < 4; ++m)
#pragma unroll
                for (int n = 0; n < 2; ++n) acc[a][b][m][n] = (f32x4){0.f, 0.f, 0.f, 0.f};
    bf16x8 At[4][2], B0[2][2], B1[2][2];
    G8_STB(0, 0, 0); G8_STA(0, 0, 0); G8_STB(0, 1, 0); G8_STA(0, 1, 0);
    if (wr == 1) G8_BAR;
    G8_WV(4); G8_BAR;
    G8_STB(1, 0, 1); G8_STA(1, 0, 1); G8_STB(1, 1, 1);
    G8_WV(6); G8_BAR;
    for (int t = 0; t < nt - 2; t += 2) {
        G8_LDB(B0, 0, 0); G8_SCHED; G8_LDA(At, 0, 0); G8_STA(1, 1, t + 1);
        G8_WL(8); G8_BAR; G8_WL(0); G8_MMA(0, 0, At, B0); G8_BAR; G8_SCHED;
        G8_LDB(B1, 0, 1); G8_STB(0, 0, t + 2);
        G8_BAR; G8_WL(0); G8_MMA(0, 1, At, B1); G8_BAR;
        if (hi) G8_LDA(At, 0, 1); G8_STA(0, 0, t + 2);
        G8_BAR; G8_WL(0); G8_MMA(1, 0, At, B0); G8_BAR; G8_SCHED;
        G8_STB(0, 1, t + 2);
        G8_WV(6); G8_BAR; G8_MMA(1, 1, At, B1); G8_BAR;
        G8_LDB(B0, 1, 0); G8_SCHED; G8_LDA(At, 1, 0); G8_STA(0, 1, t + 2);
        G8_WL(8); G8_BAR; G8_WL(0); G8_MMA(0, 0, At, B0); G8_BAR; G8_SCHED;
        G8_LDB(B1, 1, 1); G8_STB(1, 0, t + 3);
        G8_BAR; G8_WL(0); G8_MMA(0, 1, At, B1); G8_BAR;
        if (hi) G8_LDA(At, 1, 1); G8_STA(1, 0, t + 3);
        G8_BAR; G8_WL(0); G8_MMA(1, 0, At, B0); G8_BAR; G8_SCHED;
        G8_STB(1, 1, t + 3);
        G8_WV(6); G8_BAR; G8_MMA(1, 1, At, B1); G8_BAR;
    }
    { G8_LDB(B0, 0, 0); G8_WV(0); G8_LDA(At, 0, 0); G8_STA(1, 1, nt - 1);
      G8_BAR; G8_WL(0); G8_MMA(0, 0, At, B0); G8_BAR;
      G8_LDB(B1, 0, 1); G8_BAR; G8_WL(0); G8_MMA(0, 1, At, B1); G8_BAR;
      G8_LDA(At, 0, 1); G8_WV(4); G8_BAR; G8_WL(0); G8_MMA(1, 0, At, B0); G8_MMA(1, 1, At, B1); G8_BAR; }
    { G8_LDB(B0, 1, 0); G8_LDA(At, 1, 0); G8_WV(2); G8_BAR; G8_WL(0); G8_MMA(0, 0, At, B0); G8_BAR;
      G8_LDB(B1, 1, 1); G8_WV(0); G8_BAR; G8_WL(0); G8_MMA(0, 1, At, B1); G8_BAR;
      G8_LDA(At, 1, 1); G8_BAR; G8_WL(0); G8_MMA(1, 0, At, B0); G8_MMA(1, 1, At, B1); G8_BAR; }
    if (wr == 0) G8_BAR;
#undef G8_SA
#undef G8_SB
#undef G8_STA
#undef G8_STB
#undef G8_LDA
#undef G8_LDB
#undef G8_MMA
#undef G8_WV
#undef G8_WL
#undef G8_BAR
#undef G8_SCHED
    __builtin_amdgcn_sched_barrier(0);
    { const int tz = tid_fresh(), wz = __builtin_amdgcn_readfirstlane(tz >> 6), lz = tz & 63;
      epi(acc, wz >> 2, wz & 3, lz & 15, lz >> 4); }
}
struct G8Pre { unsigned aof[2][2]; const char* Bt; int rows; };
__device__ __forceinline__ void g8_addr(G8Pre& p, int lda, const int* __restrict__ arows, int rows_valid, const u16* __restrict__ Bt) {
    const int tid = tid_fresh();
#pragma unroll
    for (int h = 0; h < 2; ++h)
#pragma unroll
        for (int i = 0; i < 2; ++i) { int R, C; stage_rc(tid * 16 + i * 8192, R, C); int rr = h * 128 + R; rr = rr < rows_valid ? rr : rows_valid - 1;
            p.aof[h][i] = ((unsigned)arows[rr] * (unsigned)lda + (unsigned)C) * 2u; }
    p.Bt = (const char*)Bt; p.rows = rows_valid;
}
__device__ __forceinline__ void g8_issue(LAS unsigned char* lds, const char* Ab, const G8Pre& p) {
    const int tid = tid_fresh(), wid = __builtin_amdgcn_readfirstlane(tid >> 6);
    const char* Bb = p.Bt + tid * 16;
#define G8I_A(b, h, kt) do { _Pragma("unroll") for (int _i = 0; _i < 2; ++_i) \
        __builtin_amdgcn_global_load_lds((const unsigned*)(Ab + p.aof[h][_i] + (size_t)(kt) * 128), (LAS unsigned*)(lds + ((b) * 2 + (h)) * 16384 + wid * 1024 + _i * 8192), 16, 0, 0); } while (0)
#define G8I_B(b, h, kt) do { _Pragma("unroll") for (int _i = 0; _i < 2; ++_i) \
        __builtin_amdgcn_global_load_lds((const unsigned*)(Bb + (size_t)(kt) * 32768 + (h) * 16384 + _i * 8192), (LAS unsigned*)(lds + 65536 + ((b) * 2 + (h)) * 16384 + wid * 1024 + _i * 8192), 16, 0, 0); } while (0)
    G8I_B(0, 0, 0); G8I_A(0, 0, 0); G8I_B(0, 1, 0); G8I_A(0, 1, 0); G8I_B(1, 0, 1); G8I_A(1, 0, 1); G8I_B(1, 1, 1);
#undef G8I_A
#undef G8I_B
}
template <bool TRANS, bool FP8, class Epi, class Next>
__device__ __forceinline__ bool gemm8_unit_ov(LAS unsigned char* lds, const u16* __restrict__ A, const G8Pre& pre, int nt, const Epi epi, Next& next) {
    const int tid = tid_fresh(), wid = __builtin_amdgcn_readfirstlane(tid >> 6), lane = tid & 63;
    const int wr = wid >> 2, wc = wid & 3, fr = lane & 15, fq = lane >> 4;
    unsigned aof[2][2];
    aof[0][0] = pre.aof[0][0]; aof[0][1] = pre.aof[0][1]; aof[1][0] = pre.aof[1][0]; aof[1][1] = pre.aof[1][1];
    const int rows_valid = pre.rows;
    const char* Ab = (const char*)A; const char* Bb = pre.Bt + tid * 16;
    const bool hi = rows_valid > 128;
    int mxw = W8_MX, mxa = A8_MX; asm volatile("" : "+v"(mxw), "+v"(mxa));
#define G8_SA(b, h) (((b) * 2 + (h)) * 16384)
#define G8_SB(b, h) (65536 + ((b) * 2 + (h)) * 16384)
#define G8_STA(b, h, kt) do { _Pragma("unroll") for (int _i = 0; _i < 2; ++_i) \
        __builtin_amdgcn_global_load_lds((const unsigned*)(Ab + aof[h][_i] + (size_t)(kt) * 128), (LAS unsigned*)(lds + G8_SA(b, h) + wid * 1024 + _i * 8192), 16, 0, 0); } while (0)
#define G8_STB(b, h, kt) do { _Pragma("unroll") for (int _i = 0; _i < 2; ++_i) \
        __builtin_amdgcn_global_load_lds((const unsigned*)(Bb + (size_t)(kt) * 32768 + (h) * 16384 + _i * 8192), (LAS unsigned*)(lds + G8_SB(b, h) + wid * 1024 + _i * 8192), 16, 0, 0); } while (0)
#define G8_LDA(dst, b, h) do { _Pragma("unroll") for (int m = 0; m < 4; ++m) _Pragma("unroll") for (int k = 0; k < 2; ++k) dst[m][k] = *(const LAS bf16x8*)(lds + G8_SA(b, h) + aoff + m * 2048 + k * 1024); } while (0)
#define G8_LDB(dst, b, h) do { _Pragma("unroll") for (int n = 0; n < 2; ++n) _Pragma("unroll") for (int k = 0; k < 2; ++k) dst[n][k] = *(const LAS bf16x8*)(lds + G8_SB(b, h) + boff + n * 2048 + k * 1024); } while (0)
#define G8_MMA(ai, bj, At, Bq) do { if ((ai) == 0 || hi) { __builtin_amdgcn_s_setprio(1); _Pragma("unroll") for (int m = 0; m < 4; ++m) _Pragma("unroll") for (int n = 0; n < 2; ++n) { \
        if (FP8) { const i32x4 a0 = __builtin_bit_cast(i32x4, At[m][0]), a1 = __builtin_bit_cast(i32x4, At[m][1]), b0 = __builtin_bit_cast(i32x4, Bq[n][0]), b1 = __builtin_bit_cast(i32x4, Bq[n][1]); \
            const i32x8 a8 = __builtin_shufflevector(a0, a1, 0, 1, 2, 3, 4, 5, 6, 7), b8 = __builtin_shufflevector(b0, b1, 0, 1, 2, 3, 4, 5, 6, 7); \
            asm volatile("v_mfma_scale_f32_16x16x128_f8f6f4 %0, %1, %2, %0, %3, %4 op_sel_hi:[0,0,0]" : "+v"(acc[ai][bj][m][n]) : "v"(b8), "v"(a8), "v"(mxw), "v"(mxa)); } \
        else { _Pragma("unroll") for (int k = 0; k < 2; ++k) \
            acc[ai][bj][m][n] = TRANS ? __builtin_amdgcn_mfma_f32_16x16x32_bf16(At[m][k], Bq[n][k], acc[ai][bj][m][n], 0, 0, 0) : __builtin_amdgcn_mfma_f32_16x16x32_bf16(Bq[n][k], At[m][k], acc[ai][bj][m][n], 0, 0, 0); } } \
        __builtin_amdgcn_s_setprio(0); } } while (0)
#define G8_WV(n) asm volatile("s_waitcnt vmcnt(" #n ")" ::: "memory")
#define G8_WL(n) asm volatile("s_waitcnt lgkmcnt(" #n ")" ::: "memory")
#define G8_BAR __builtin_amdgcn_s_barrier()
#define G8_SCHED __builtin_amdgcn_sched_barrier(0)
    const int aoff = lds_byte(wr * 64 + fr, fq * 8), boff = lds_byte(wc * 32 + fr, fq * 8);
    f32x4 acc[2][2][4][2];
#pragma unroll
    for (int a = 0; a < 2; ++a)
#pragma unroll
        for (int b = 0; b < 2; ++b)
#pragma unroll
            for (int m = 0; m < 4; ++m)
#pragma unroll
                for (int n = 0; n < 2; ++n) acc[a][b][m][n] = (f32x4){0.f, 0.f, 0.f, 0.f};
    bf16x8 At[4][2], B0[2][2], B1[2][2];
    if (wr == 1) G8_BAR;
    G8_WV(0); G8_BAR;
    G8_BAR;
    for (int t = 0; t < nt - 2; t += 2) {
        G8_LDB(B0, 0, 0); G8_SCHED; G8_LDA(At, 0, 0); G8_STA(1, 1, t + 1);
        G8_WL(8); G8_BAR; G8_WL(0); G8_MMA(0, 0, At, B0); G8_BAR; G8_SCHED;
        G8_LDB(B1, 0, 1); G8_STB(0, 0, t + 2);
        G8_BAR; G8_WL(0); G8_MMA(0, 1, At, B1); G8_BAR;
        if (hi) G8_LDA(At, 0, 1); G8_STA(0, 0, t + 2);
        G8_BAR; G8_WL(0); G8_MMA(1, 0, At, B0); G8_BAR; G8_SCHED;
        G8_STB(0, 1, t + 2);
        G8_WV(6); G8_BAR; G8_MMA(1, 1, At, B1); G8_BAR;
        G8_LDB(B0, 1, 0); G8_SCHED; G8_LDA(At, 1, 0); G8_STA(0, 1, t + 2);
        G8_WL(8); G8_BAR; G8_WL(0); G8_MMA(0, 0, At, B0); G8_BAR; G8_SCHED;
        G8_LDB(B1, 1, 1); G8_STB(1, 0, t + 3);
        G8_BAR; G8_WL(0); G8_MMA(0, 1, At, B1); G8_BAR;
        if (hi) G8_LDA(At, 1, 1); G8_STA(1, 0, t + 3);
        G8_BAR; G8_WL(0); G8_MMA(1, 0, At, B0); G8_BAR; G8_SCHED;
        G8_STB(1, 1, t + 3);
        G8_WV(6); G8_BAR; G8_MMA(1, 1, At, B1); G8_BAR;
    }
    { G8_LDB(B0, 0, 0); G8_WV(0); G8_LDA(At, 0, 0); G8_STA(1, 1, nt - 1);
      G8_BAR; G8_WL(0); G8_MMA(0, 0, At, B0); G8_BAR;
      G8_LDB(B1, 0, 1); G8_BAR; G8_WL(0); G8_MMA(0, 1, At, B1); G8_BAR;
      G8_LDA(At, 0, 1); G8_WV(4); G8_BAR; G8_WL(0); G8_MMA(1, 0, At, B0); G8_MMA(1, 1, At, B1); G8_BAR; }
    { G8_LDB(B0, 1, 0); G8_LDA(At, 1, 0); G8_WV(2); G8_BAR; G8_WL(0); G8_MMA(0, 0, At, B0); G8_BAR;
      G8_LDB(B1, 1, 1); G8_WV(0); G8_BAR; G8_WL(0); G8_MMA(0, 1, At, B1); G8_BAR;
      G8_LDA(At, 1, 1); G8_BAR; G8_WL(0); G8_MMA(1, 0, At, B0); G8_MMA(1, 1, At, B1); G8_BAR; }
    if (wr == 0) G8_BAR;
#undef G8_SA
#undef G8_SB
#undef G8_STA
#undef G8_STB
#undef G8_LDA
#undef G8_LDB
#undef G8_MMA
#undef G8_WV
#undef G8_WL
#undef G8_BAR
#undef G8_SCHED
    __builtin_amdgcn_sched_barrier(0);
    const bool has_next = next();
    __builtin_amdgcn_sched_barrier(0);
    { const int tz = tid_fresh(), wz = __builtin_amdgcn_readfirstlane(tz >> 6), lz = tz & 63;
      epi(acc, wz >> 2, wz & 3, lz & 15, lz >> 4); }
    return has_next;
}
struct StreamUnit { const char* A; const char* Bt; int arow0, rows, a, b, c; };
template <bool TRANS, bool FP8, class Src>
__device__ __forceinline__ void gemm8_stream(LAS unsigned char* lds, unsigned lda, int nt, const Src& src) {
    const int tid = tid_fresh(), wid = __builtin_amdgcn_readfirstlane(tid >> 6), lane = tid & 63;
    const int wr = wid >> 2, wc = wid & 3, fr = lane & 15, fq = lane >> 4;
    StreamUnit cur, nxt;
    if (!src.get(0, cur)) return;
    int R0, C0, R1, C1; stage_rc(tid * 16, R0, C0); stage_rc(tid * 16 + 8192, R1, C1);
    int mxw = W8_MX, mxa = A8_MX; asm volatile("" : "+v"(mxw), "+v"(mxa));
    const int aoff = lds_byte(wr * 64 + fr, fq * 8), boff = lds_byte(wc * 32 + fr, fq * 8);
#define GS_AOF(u, h, R, C) ((unsigned)(((unsigned)((u).arow0 + (((h) * 128 + (R)) < (u).rows ? ((h) * 128 + (R)) : (u).rows - 1)) * lda + (unsigned)(C)) * 2u))
    unsigned ac00 = GS_AOF(cur, 0, R0, C0), ac01 = GS_AOF(cur, 0, R1, C1), ac10 = GS_AOF(cur, 1, R0, C0), ac11 = GS_AOF(cur, 1, R1, C1);
#define GS_SA(b, h) (((b) * 2 + (h)) * 16384)
#define GS_SB(b, h) (65536 + ((b) * 2 + (h)) * 16384)
#define GS_GL(src_, dst_) __builtin_amdgcn_global_load_lds((const unsigned*)(src_), (LAS unsigned*)(lds + (dst_)), 16, 0, 0)
#define GS_STA(b, h, base, o0, o1, kt) do { GS_GL((base) + (o0) + (size_t)(kt) * 128, GS_SA(b, h) + wid * 1024); GS_GL((base) + (o1) + (size_t)(kt) * 128, GS_SA(b, h) + wid * 1024 + 8192); } while (0)
#define GS_STB(b, h, base, kt) do { GS_GL((base) + tid * 16 + (size_t)(kt) * 32768 + (h) * 16384, GS_SB(b, h) + wid * 1024); GS_GL((base) + tid * 16 + (size_t)(kt) * 32768 + (h) * 16384 + 8192, GS_SB(b, h) + wid * 1024 + 8192); } while (0)
#define GS_LDA(dst, b, h) do { _Pragma("unroll") for (int m = 0; m < 4; ++m) _Pragma("unroll") for (int k = 0; k < 2; ++k) dst[m][k] = *(const LAS bf16x8*)(lds + GS_SA(b, h) + aoff + m * 2048 + k * 1024); } while (0)
#define GS_LDB(dst, b, h) do { _Pragma("unroll") for (int n = 0; n < 2; ++n) _Pragma("unroll") for (int k = 0; k < 2; ++k) dst[n][k] = *(const LAS bf16x8*)(lds + GS_SB(b, h) + boff + n * 2048 + k * 1024); } while (0)
#define GS_MMA(ai, bj, At, Bq) do { if ((ai) == 0 || hi) { __builtin_amdgcn_s_setprio(1); _Pragma("unroll") for (int m = 0; m < 4; ++m) _Pragma("unroll") for (int n = 0; n < 2; ++n) { \
        if (FP8) { const i32x4 a0 = __builtin_bit_cast(i32x4, At[m][0]), a1 = __builtin_bit_cast(i32x4, At[m][1]), b0 = __builtin_bit_cast(i32x4, Bq[n][0]), b1 = __builtin_bit_cast(i32x4, Bq[n][1]); \
            const i32x8 a8 = __builtin_shufflevector(a0, a1, 0, 1, 2, 3, 4, 5, 6, 7), b8 = __builtin_shufflevector(b0, b1, 0, 1, 2, 3, 4, 5, 6, 7); \
            asm volatile("v_mfma_scale_f32_16x16x128_f8f6f4 %0, %1, %2, %0, %3, %4 op_sel_hi:[0,0,0]" : "+v"(acc[ai][bj][m][n]) : "v"(b8), "v"(a8), "v"(mxw), "v"(mxa)); } \
        else { _Pragma("unroll") for (int k = 0; k < 2; ++k) \
            acc[ai][bj][m][n] = TRANS ? __builtin_amdgcn_mfma_f32_16x16x32_bf16(At[m][k], Bq[n][k], acc[ai][bj][m][n], 0, 0, 0) : __builtin_amdgcn_mfma_f32_16x16x32_bf16(Bq[n][k], At[m][k], acc[ai][bj][m][n], 0, 0, 0); } } \
        __builtin_amdgcn_s_setprio(0); } } while (0)
#define GS_WV(n) asm volatile("s_waitcnt vmcnt(" #n ")" ::: "memory")
#define GS_WL(n) asm volatile("s_waitcnt lgkmcnt(" #n ")" ::: "memory")
#define GS_BAR __builtin_amdgcn_s_barrier()
#define GS_SCHED __builtin_amdgcn_sched_barrier(0)
    f32x4 acc[2][2][4][2];
#pragma unroll
    for (int a = 0; a < 2; ++a)
#pragma unroll
        for (int b = 0; b < 2; ++b)
#pragma unroll
            for (int m = 0; m < 4; ++m)
#pragma unroll
                for (int n = 0; n < 2; ++n) acc[a][b][m][n] = (f32x4){0.f, 0.f, 0.f, 0.f};
    bf16x8 At[4][2], B0[2][2], B1[2][2];
    GS_STB(0, 0, cur.Bt, 0); GS_STA(0, 0, cur.A, ac00, ac01, 0); GS_STB(0, 1, cur.Bt, 0); GS_STA(0, 1, cur.A, ac10, ac11, 0);
    if (wr == 1) GS_BAR;
    GS_WV(4); GS_BAR;
    GS_STB(1, 0, cur.Bt, 1); GS_STA(1, 0, cur.A, ac00, ac01, 1); GS_STB(1, 1, cur.Bt, 1);
    GS_WV(6); GS_BAR;
    for (int ui = 0;; ++ui) {
        const bool has_next = src.get(ui + 1, nxt);
        if (!has_next) nxt = cur;
        const unsigned an00 = GS_AOF(nxt, 0, R0, C0), an01 = GS_AOF(nxt, 0, R1, C1), an10 = GS_AOF(nxt, 1, R0, C0), an11 = GS_AOF(nxt, 1, R1, C1);
        const bool hi = cur.rows > 128;
        for (int t = 0; t < nt; t += 2) {
            const bool last = (t == nt - 2);
            const char* xA = last ? nxt.A : cur.A; const char* xB = last ? nxt.Bt : cur.Bt;
            const unsigned x00 = last ? an00 : ac00, x01 = last ? an01 : ac01, x10 = last ? an10 : ac10, x11 = last ? an11 : ac11;
            const int k2 = last ? 0 : t + 2, k3 = k2 + 1;
            GS_LDB(B0, 0, 0); GS_SCHED; GS_LDA(At, 0, 0); GS_STA(1, 1, cur.A, ac10, ac11, t + 1);
            GS_WL(8); GS_BAR; GS_WL(0); GS_MMA(0, 0, At, B0); GS_BAR; GS_SCHED;
            GS_LDB(B1, 0, 1); GS_STB(0, 0, xB, k2);
            GS_BAR; GS_WL(0); GS_MMA(0, 1, At, B1); GS_BAR;
            if (hi) GS_LDA(At, 0, 1); GS_STA(0, 0, xA, x00, x01, k2);
            GS_BAR; GS_WL(0); GS_MMA(1, 0, At, B0); GS_BAR; GS_SCHED;
            GS_STB(0, 1, xB, k2);
            GS_WV(6); GS_BAR; GS_MMA(1, 1, At, B1); GS_BAR;
            GS_LDB(B0, 1, 0); GS_SCHED; GS_LDA(At, 1, 0); GS_STA(0, 1, xA, x10, x11, k2);
            GS_WL(8); GS_BAR; GS_WL(0); GS_MMA(0, 0, At, B0); GS_BAR; GS_SCHED;
            GS_LDB(B1, 1, 1); GS_STB(1, 0, xB, k3);
            GS_BAR; GS_WL(0); GS_MMA(0, 1, At, B1); GS_BAR;
            if (hi) GS_LDA(At, 1, 1); GS_STA(1, 0, xA, x00, x01, k3);
            GS_BAR; GS_WL(0); GS_MMA(1, 0, At, B0); GS_BAR; GS_SCHED;
            GS_STB(1, 1, xB, k3);
            GS_WV(6); GS_BAR; GS_MMA(1, 1, At, B1); GS_BAR;
        }
        __builtin_amdgcn_sched_barrier(0);
        src.epi(acc, cur, wr, wc, fr, fq);
        __builtin_amdgcn_sched_barrier(0);
        if (!has_next) break;
#pragma unroll
        for (int a = 0; a < 2; ++a)
#pragma unroll
            for (int b = 0; b < 2; ++b)
#pragma unroll
                for (int m = 0; m < 4; ++m)
#pragma unroll
                    for (int n = 0; n < 2; ++n) acc[a][b][m][n] = (f32x4){0.f, 0.f, 0.f, 0.f};
        cur = nxt; ac00 = an00; ac01 = an01; ac10 = an10; ac11 = an11;
    }
    GS_WV(0);
    if (wr == 0) GS_BAR;
    GS_BAR;
#undef GS_AOF
#undef GS_SA
#undef GS_SB
#undef GS_GL
#undef GS_STA
#undef GS_STB
#undef GS_LDA
#undef GS_LDB
#undef GS_MMA
#undef GS_WV
#undef GS_WL
#undef GS_BAR
#undef GS_SCHED
}
struct Epi8PG { u16* PG; const float* lbl; int tok0, col0;
    __device__ __forceinline__ void operator()(const f32x4 (&acc)[2][2][4][2], int wr, int wc, int fr, int fq) const {
        const int grp = col0 >> 10;
        if (grp == 0) {
#pragma unroll
            for (int ai = 0; ai < 2; ++ai)
#pragma unroll
                for (int m = 0; m < 4; ++m) { u16* rowp = PG + (size_t)(tok0 + ai * 128 + wr * 64 + m * 16 + fr) * 5120 + col0 + wc * 32 + 8 * fq;
#pragma unroll
                    for (int bj = 0; bj < 2; ++bj) { float o[8];
#pragma unroll
                        for (int n = 0; n < 2; ++n)
#pragma unroll
                            for (int q = 0; q < 4; ++q) { const float x = acc[ai][bj][m][n][q]; o[4 * n + q] = x * __builtin_amdgcn_rcpf(1.0f + __expf(-x)); }
                        *(u32x4*)(rowp + bj * 128) = (u32x4){pk_bf16(o[0], o[1]), pk_bf16(o[2], o[3]), pk_bf16(o[4], o[5]), pk_bf16(o[6], o[7])}; } }
        } else if (grp <= 2) {
            float lbv[2][8];
#pragma unroll
            for (int bj = 0; bj < 2; ++bj)
#pragma unroll
                for (int q = 0; q < 8; ++q) { const int c = (col0 & 1023) + bj * 128 + wc * 32 + 8 * fq + q; const float l0 = lbl[(grp - 1) * HGW + c], l1 = lbl[(2 + grp - 1) * HGW + c]; lbv[bj][q] = __builtin_amdgcn_rcpf(1.0f + __expf(l1 - l0)); }
#pragma unroll
            for (int ai = 0; ai < 2; ++ai)
#pragma unroll
                for (int m = 0; m < 4; ++m) { u16* rowp = PG + (size_t)(tok0 + ai * 128 + wr * 64 + m * 16 + fr) * 5120 + col0 + wc * 32 + 8 * fq;
#pragma unroll
                    for (int bj = 0; bj < 2; ++bj) { float o[8];
#pragma unroll
                        for (int n = 0; n < 2; ++n)
#pragma unroll
                            for (int q = 0; q < 4; ++q) { const float z = acc[ai][bj][m][n][q], lb = lbv[bj][4 * n + q]; const float sg = __builtin_amdgcn_rcpf(1.0f + __expf(-z)); o[4 * n + q] = __log2f(lb + (1.0f - lb) * sg); }
                        *(u32x4*)(rowp + bj * 128) = (u32x4){pk_bf16(o[0], o[1]), pk_bf16(o[2], o[3]), pk_bf16(o[4], o[5]), pk_bf16(o[6], o[7])}; } }
        } else {
#pragma unroll
            for (int ai = 0; ai < 2; ++ai)
#pragma unroll
                for (int m = 0; m < 4; ++m) { u16* rowp = PG + (size_t)(tok0 + ai * 128 + wr * 64 + m * 16 + fr) * 5120 + col0 + wc * 32 + 8 * fq;
#pragma unroll
                    for (int bj = 0; bj < 2; ++bj) { const f32x4 v0 = acc[ai][bj][m][0], v1 = acc[ai][bj][m][1];
                        *(u32x4*)(rowp + bj * 128) = (u32x4){pk_bf16(v0[0], v0[1]), pk_bf16(v0[2], v0[3]), pk_bf16(v1[0], v1[1]), pk_bf16(v1[2], v1[3])}; } }
        }
    } };
struct Epi8HYT { u16* HYT; int tok0, col0;
    __device__ __forceinline__ void operator()(const f32x4 (&acc)[2][2][4][2], int wr, int wc, int fr, int fq) const {
#pragma unroll
        for (int bj = 0; bj < 2; ++bj)
#pragma unroll
            for (int n = 0; n < 2; ++n) { u16* colp = HYT + (size_t)(col0 + bj * 128 + wc * 32 + perm32(n * 16 + fr)) * NTOK + tok0 + wr * 64 + 4 * fq;
#pragma unroll
                for (int ai = 0; ai < 2; ++ai)
#pragma unroll
                    for (int m = 0; m < 4; ++m) { const f32x4 v = acc[ai][bj][m][n]; *(u32x2*)(colp + ai * 128 + m * 16) = (u32x2){pk_bf16(v[0], v[1]), pk_bf16(v[2], v[3])}; } }
    } };
struct Epi8X1 { const float* x; float* X1; int tok0, col0;
    __device__ __forceinline__ void operator()(const f32x4 (&acc)[2][2][4][2], int wr, int wc, int fr, int fq) const {
#pragma unroll
        for (int ai = 0; ai < 2; ++ai)
#pragma unroll
            for (int m = 0; m < 4; ++m) { const size_t off = (size_t)(tok0 + ai * 128 + wr * 64 + m * 16 + fr) * DM + col0 + wc * 32 + 8 * fq;
#pragma unroll
                for (int bj = 0; bj < 2; ++bj)
#pragma unroll
                    for (int n = 0; n < 2; ++n) { const f32x4 r = *(const f32x4*)(x + off + bj * 128 + n * 4); *(f32x4*)(X1 + off + bj * 128 + n * 4) = r + acc[ai][bj][m][n]; }
                asm volatile("" ::: "memory"); }
    } };
struct Epi8Swiglu { u16* HM; const float* b1; int slot0, nt, rows_valid;
    __device__ __forceinline__ void operator()(const f32x4 (&acc)[2][2][4][2], int wr, int wc, int fr, int fq) const {
        f32x4 bg[2], bl[2];
#pragma unroll
        for (int n = 0; n < 2; ++n) { const int col = nt * 128 + wc * 32 + 8 * fq + 4 * n; bg[n] = *(const f32x4*)(b1 + col); bl[n] = *(const f32x4*)(b1 + 2048 + col); }
#pragma unroll
        for (int ai = 0; ai < 2; ++ai)
#pragma unroll
            for (int m = 0; m < 4; ++m) { const int row = ai * 128 + wr * 64 + m * 16 + fr;
                if (row < rows_valid) { float o[8];
#pragma unroll
                    for (int n = 0; n < 2; ++n) { const f32x4 gl = acc[ai][0][m][n] + bg[n], li = acc[ai][1][m][n] + bl[n];
#pragma unroll
                        for (int j = 0; j < 4; ++j) { const float gq = fminf(gl[j], 7.0f), lq = fminf(fmaxf(li[j], -7.0f), 7.0f); o[4 * n + j] = gq * __builtin_amdgcn_rcpf(1.0f + __builtin_amdgcn_exp2f(-2.45546696f * gq)) * (lq + 1.0f); } }
                    *(u32x4*)(HM + (size_t)(slot0 + row) * DFF + nt * 128 + wc * 32 + 8 * fq) = (u32x4){pk_bf16(o[0], o[1]), pk_bf16(o[2], o[3]), pk_bf16(o[4], o[5]), pk_bf16(o[6], o[7])}; } }
    } };
struct Epi8Swiglu8 { unsigned char* HM; const float* b1; int slot0, nt, rows_valid;
    __device__ __forceinline__ void operator()(const f32x4 (&acc)[2][2][4][2], int wr, int wc, int fr, int fq) const {
        f32x4 bg[2], bl[2];
#pragma unroll
        for (int n = 0; n < 2; ++n) { const int col = nt * 128 + wc * 32 + 8 * fq + 4 * n; bg[n] = *(const f32x4*)(b1 + col); bl[n] = *(const f32x4*)(b1 + 2048 + col); }
#pragma unroll
        for (int ai = 0; ai < 2; ++ai)
#pragma unroll
            for (int m = 0; m < 4; ++m) { const int row = ai * 128 + wr * 64 + m * 16 + fr;
                if (row < rows_valid) { float o[8];
#pragma unroll
                    for (int n = 0; n < 2; ++n) { const f32x4 gl = acc[ai][0][m][n] + bg[n], li = acc[ai][1][m][n] + bl[n];
#pragma unroll
                        for (int j = 0; j < 4; ++j) { const float gq = fminf(gl[j], 7.0f), lq = fminf(fmaxf(li[j], -7.0f), 7.0f); o[4 * n + j] = gq * __builtin_amdgcn_rcpf(1.0f + __builtin_amdgcn_exp2f(-2.45546696f * gq)) * (lq + 1.0f); } }
                    *(u32x2*)(HM + (size_t)(slot0 + row) * DFF + nt * 128 + wc * 32 + 8 * fq) = (u32x2){pk_fp8x4(o[0], o[1], o[2], o[3]), pk_fp8x4(o[4], o[5], o[6], o[7])}; } }
    } };
struct Epi8Y { u16* Y; const float* b2; int slot0, col0, rows_valid;
    __device__ __forceinline__ void operator()(const f32x4 (&acc)[2][2][4][2], int wr, int wc, int fr, int fq) const {
        f32x4 bv[2][2];
#pragma unroll
        for (int bj = 0; bj < 2; ++bj)
#pragma unroll
            for (int n = 0; n < 2; ++n) bv[bj][n] = *(const f32x4*)(b2 + col0 + bj * 128 + wc * 32 + 8 * fq + 4 * n);
#pragma unroll
        for (int ai = 0; ai < 2; ++ai)
#pragma unroll
            for (int m = 0; m < 4; ++m) { const int row = ai * 128 + wr * 64 + m * 16 + fr;
                if (row < rows_valid) { u16* rowp = Y + (size_t)(slot0 + row) * DM + col0 + wc * 32 + 8 * fq;
#pragma unroll
                    for (int bj = 0; bj < 2; ++bj) { const f32x4 v0 = acc[ai][bj][m][0] + bv[bj][0], v1 = acc[ai][bj][m][1] + bv[bj][1];
                        *(u32x4*)(rowp + bj * 128) = (u32x4){pk_bf16(v0[0], v0[1]), pk_bf16(v0[2], v0[3]), pk_bf16(v1[0], v1[1]), pk_bf16(v1[2], v1[3])}; } } }
    } };
struct EpiNone { __device__ __forceinline__ void operator()(const f32x4 (&acc)[2][2][4][2], int wr, int wc, int fr, int fq) const {
#pragma unroll
        for (int a = 0; a < 2; ++a)
#pragma unroll
            for (int b = 0; b < 2; ++b)
#pragma unroll
                for (int m = 0; m < 4; ++m)
#pragma unroll
                    for (int n = 0; n < 2; ++n) asm volatile("" :: "v"(acc[a][b][m][n]));
    } };

template <int NTILES>
__device__ __forceinline__ bool moe_unit_static(const LAS int* us, const LAS int* so2, int uu, int& e, int& nt, int& slot0, int& rows) {
    if (uu >= us[NE]) return false;
    int lo = 0, hi = NE;
#pragma unroll
    for (int s = 0; s < 5; ++s) { const int mid = (lo + hi) >> 1; if (us[mid] <= uu) lo = mid; else hi = mid; }
    e = lo; const int o0 = e * NTOK, cnt = so2[e], mtl = (cnt + 255) >> 8, ul = uu - us[e], mt = ul % mtl;
    e = __builtin_amdgcn_readfirstlane(e); nt = __builtin_amdgcn_readfirstlane(ul / mtl); slot0 = __builtin_amdgcn_readfirstlane(o0 + mt * 256);
    rows = cnt - mt * 256; rows = __builtin_amdgcn_readfirstlane(rows > 256 ? 256 : rows); return true;
}
struct SrcMoeB { const LAS int* us; const LAS int* so2; int c, G; const char* HM8; const char* W2T8; u16* YB; const float* b2;
    __device__ __forceinline__ bool get(int i, StreamUnit& u) const { int e, nt, slot0, rows; if (!moe_unit_static<8>(us, so2, c + i * G, e, nt, slot0, rows)) return false;
        u.A = HM8; u.Bt = W2T8 + (size_t)((e * 8 + nt) * 16) * 32768; u.arow0 = slot0; u.rows = rows; u.a = e; u.b = nt; u.c = slot0; return true; }
    __device__ __forceinline__ void epi(const f32x4 (&acc)[2][2][4][2], const StreamUnit& u, int wr, int wc, int fr, int fq) const { Epi8Y ep{YB, b2 + (size_t)u.a * DM, u.c, u.b * 256, u.rows}; ep(acc, wr, wc, fr, fq); }
};
template <bool TRANS>
struct SrcG1 { int c, G; const char* HBp; const char* WINTp; u16* PG; u16* HYT; const float* lbl;
    __device__ __forceinline__ bool get(int k, StreamUnit& su) const {
        int seen = 0;
        for (int u = c; u < 1024; u += G) { const int i = u >> 8, xx = (u >> 5) & 7, j = u & 31; const int mt = (xx & 3) * 8 + (j & 7), nt = ((xx >> 2) + 2 * i) * 4 + (j >> 3);
            if ((nt >= 20) == TRANS) { if (seen == k) { su.A = HBp; su.Bt = WINTp + (size_t)nt * 32 * 32768; su.arow0 = mt * 256; su.rows = 256; su.a = mt; su.b = nt; su.c = 0; return true; } ++seen; } }
        return false; }
    __device__ __forceinline__ void epi(const f32x4 (&acc)[2][2][4][2], const StreamUnit& u, int wr, int wc, int fr, int fq) const {
        if (TRANS) { Epi8HYT e{HYT, u.a * 256, u.b * 256 - 5120}; e(acc, wr, wc, fr, fq); } else { Epi8PG e{PG, lbl, u.a * 256, u.b * 256}; e(acc, wr, wc, fr, fq); } }
};

typedef float f32x16 __attribute__((ext_vector_type(16)));
__device__ __forceinline__ void h3_row(int m, const float* __restrict__ w1, const float* __restrict__ b1, const float* __restrict__ w2, const float* __restrict__ b2,
                                       const float* __restrict__ w3, const float* __restrict__ b3, const float* __restrict__ freq, LAS float* sc  , float* __restrict__ H3) {
    const int j = tid_fresh() & 63;
    const float tt = (float)m / (float)(SEQ - 1);
    if (j == 0) sc[0] = tt;
    if (j >= 1 && j <= 16) { const int i = j - 1; const float band = 1e-4f + (float)i * ((15.0f - 1e-4f) / 15.0f); const float ang = (2.0f * 3.14159265358979323846f / (float)SEQ) * (float)m * band; sc[1 + i] = cosf(ang); sc[17 + i] = -sinf(ang); }
    __builtin_amdgcn_wave_barrier();
    const float fr = freq[j];
    float s = b1[j];
    for (int i = 0; i < 33; ++i) s += sc[i] * w1[i * 64 + j];
    const float h1 = sinf(fr * s);
    sc[64 + j] = h1;
    __builtin_amdgcn_wave_barrier();
    s = b2[j];
    for (int i = 0; i < 64; ++i) s += sc[64 + i] * w2[i * 64 + j];
    const float h2 = sinf(fr * s);
    __builtin_amdgcn_wave_barrier();
    sc[j] = h2;
    __builtin_amdgcn_wave_barrier();
    s = b3[j];
    for (int i = 0; i < 64; ++i) s += sc[i] * w3[i * 64 + j];
    H3[(size_t)m * 64 + j] = sinf(fr * s);
    __builtin_amdgcn_wave_barrier();
}
constexpr int FR_LEN = 4128;
__device__ __forceinline__ void frgen_item(LAS unsigned char* lds, int item, const float* __restrict__ H3, const float* __restrict__ w4, u16* __restrict__ FR) {
    const int tid = tid_fresh(), wid = __builtin_amdgcn_readfirstlane(tid >> 6), lane = tid & 63, fr = lane & 15, fq = lane >> 4;
    const int oc0 = item * 8, o = oc0 >> 10;
    const int colB = o * 2048 + (fr >> 3) * 1024 + (oc0 & 1023) + (fr & 7);
    float wreg[16];
#pragma unroll
    for (int ks = 0; ks < 16; ++ks) wreg[ks] = w4[(size_t)(4 * ks + fq) * 4096 + colB];
    const int dir = fr >> 3, c = (oc0 & 1023) + (fr & 7);
    const float mind = logf(1e-2f) / 0.3f, maxd = logf(1e-2f) / 1.5f;
    const float delta = fabsf(mind + (float)c * ((maxd - mind) / 1023.0f));
    u16* r0 = FR + (size_t)((oc0 + (fr & 7)) * 2) * FR_LEN;
    LAS float* tile = (LAS float*)(lds + wid * 4608);
    const int wrow = lane >> 4, wcol = 4 * (lane & 15);
    f32x4 nx[4];
#pragma unroll
    for (int q = 0; q < 4; ++q) nx[q] = *(const f32x4*)(H3 + (size_t)wid * 1024 + q * 256 + lane * 4);
    for (int it = 0; it < 16; ++it) {
        const int mt = wid + 8 * it;
#pragma unroll
        for (int q = 0; q < 4; ++q) *(LAS f32x4*)(tile + (q * 4 + wrow) * 68 + wcol) = nx[q];
        if (it + 1 < 16) {
#pragma unroll
            for (int q = 0; q < 4; ++q) nx[q] = *(const f32x4*)(H3 + (size_t)(mt + 8) * 1024 + q * 256 + lane * 4);
        }
        f32x4 acc = {0.f, 0.f, 0.f, 0.f}, acc1 = acc;
#pragma unroll
        for (int ks = 0; ks < 16; ks += 2) { acc = __builtin_amdgcn_mfma_f32_16x16x4f32(tile[fr * 68 + 4 * ks + fq], wreg[ks], acc, 0, 0, 0);
            acc1 = __builtin_amdgcn_mfma_f32_16x16x4f32(tile[fr * 68 + 4 * (ks + 1) + fq], wreg[ks + 1], acc1, 0, 0, 0); }
        acc += acc1;
        const int m0 = mt * 16 + 4 * fq;
        float v[4];
#pragma unroll
        for (int j = 0; j < 4; ++j) v[j] = acc[j] * __expf(-((float)(m0 + j) * (1.0f / (float)(SEQ - 1))) * delta);
        if (dir == 0) {
            *(u32x2*)(r0 + 2044 - m0) = (u32x2){pk_bf16(v[3], v[2]), pk_bf16(v[1], v[0])};
#pragma unroll
            for (int j = 0; j < 4; ++j) r0[FR_LEN + 2046 - m0 - j] = (u16)(pk_bf16(v[j], 0.f) & 0xffffu);
        } else {
#pragma unroll
            for (int j = 0; j < 4; ++j) if (m0 + j >= 1) { const u16 b = (u16)(pk_bf16(v[j], 0.f) & 0xffffu); r0[2047 + m0 + j] = b; r0[FR_LEN + 2046 + m0 + j] = b; }
        }
    }
    if (tid < 8 * 34) { const int r = tid / 34, x = 4094 + tid % 34; u16* rr = FR + (size_t)((oc0 + r) * 2) * FR_LEN; if (x >= 4095) rr[x] = 0; rr[FR_LEN + x] = 0; }
    __syncthreads();
}
constexpr int HY_ZSTRIDE = 2312;
constexpr int HY_ZCH = 256 + 4 * HY_ZSTRIDE;
constexpr int HY_ZBYTES = HY_ZCH * 2;
constexpr int HY_FB = 4 * HY_ZBYTES;
constexpr int HY_FCH = 2 * FR_LEN * 2;
constexpr int HY_LDS = HY_FB + 4 * HY_FCH;

__device__ __forceinline__ void hy_load_row(LAS unsigned char* lds, int dest, int boff0, int bstride, const u16* __restrict__ row, float w0, float w1, float w2, float cb, int pl) {
#pragma unroll 2
    for (int it = 0; it < 8; ++it) {
        const int idx = pl + 128 * it, tok0 = idx * 8, b = tok0 >> 11, n0 = tok0 & 2047;
        const u32x4 raw = *(const u32x4*)(row + tok0);
        const float pm = (n0 > 0) ? bf2f(row[tok0 - 1]) : 0.f;
        const float pn = (n0 + 8 < SEQ) ? bf2f(row[tok0 + 8]) : 0.f;
        float p[10];
        p[0] = pm; p[9] = pn;
#pragma unroll
        for (int q = 0; q < 4; ++q) { p[1 + 2 * q] = bflo(raw[q]); p[2 + 2 * q] = bfhi(raw[q]); }
        float o[8];
#pragma unroll
        for (int q = 0; q < 8; ++q) o[q] = fmaf(w0, p[q], fmaf(w1, p[q + 1], fmaf(w2, p[q + 2], cb)));
        u32x4 w; w[0] = pk_bf16(o[0], o[1]); w[1] = pk_bf16(o[2], o[3]); w[2] = pk_bf16(o[4], o[5]); w[3] = pk_bf16(o[6], o[7]);
        *(LAS u32x4*)(lds + dest + (boff0 + b * bstride + n0) * 2) = w;
    }
}
__device__ __forceinline__ void hy_load_filters(LAS unsigned char* lds, int fb, const u16* __restrict__ src, int pl) {
    for (int idx = pl; idx < HY_FCH / 16; idx += 128) *(LAS u32x4*)(lds + fb + idx * 16) = *(const u32x4*)((const char*)src + idx * 16);
}
__device__ __forceinline__ void hy_mfma_loop(LAS unsigned char* lds, int zb, int fb, int hlf, int lane, f32x16 (&acc)[4], const ConvCtx& cc, int mbase, int cunit, int wid) {
    const int r = lane & 31, hh = lane >> 5, il = r >> 2, b = r & 3;
    const int bbase = zb + (256 + b * HY_ZSTRIDE + 32 * il + 8 * hh) * 2;
    const int xl = 2047 - r + 8 * hh - 1024 * hlf;
    const int abase = (r & 1) ? (fb + 2 * xl) : (fb + FR_LEN * 2 + 2 * (xl - 1));
#pragma unroll
    for (int q = 0; q < 4; ++q)
#pragma unroll
        for (int i = 0; i < 16; ++i) acc[q][i] = 0.f;
    for (int d0 = 0; d0 < 8; ++d0) {
#pragma unroll
        for (int ks = 0; ks < 2; ++ks) {
            f32x2 cv[16];
            const int mcv = conv_seq2tile((mbase + d0 * 2 + ks) * 256 + cunit);
            conv_issue(cc, mcv, wid, lane, cv);
            bf16x8 Bt[9];
#pragma unroll
            for (int j = 0; j < 9; ++j) Bt[j] = *(const LAS bf16x8*)(lds + bbase + 512 * j - 64 * d0 + 32 * ks);
#pragma unroll
            for (int ep = -8; ep <= 3; ++ep) {
                const LAS unsigned* ap = (const LAS unsigned*)(lds + abase - 64 * d0 - 512 * ep + 32 * ks);
                u32x4 av; av[0] = ap[0]; av[1] = ap[1]; av[2] = ap[2]; av[3] = ap[3];
                const bf16x8 a = __builtin_bit_cast(bf16x8, av);
#pragma unroll
                for (int ctl = 0; ctl < 4; ++ctl) { const int jt = ctl - ep; if (jt >= 0 && jt <= 8) acc[ctl] = __builtin_amdgcn_mfma_f32_32x32x16_bf16(a, Bt[jt], acc[ctl], 0, 0, 0); }
            }
            conv_finish(cc, mcv, wid, lane, cv);
        }
    }
}
__device__ __forceinline__ void hy_epilogue(LAS unsigned char* lds, int zb, int gb, int hlf, int lane, const f32x16 (&acc)[4], float bias) {
    const int r = lane & 31, hh = lane >> 5, il = r >> 2, b = r & 3;
#pragma unroll
    for (int ctl = 0; ctl < 4; ++ctl) {
        const int I = 8 * (4 * hlf + ctl) + il;
#pragma unroll
        for (int q = 0; q < 4; ++q) {
            const int n4 = 32 * I + 8 * q + 4 * hh;
            LAS u32x2* zp = (LAS u32x2*)(lds + zb + (256 + b * HY_ZSTRIDE + n4) * 2);
            const u32x2 zv = *zp, gv = *(const LAS u32x2*)(lds + gb + (b * 2048 + n4) * 2);
            const float z0 = bflo(zv[0]), z1 = bfhi(zv[0]), z2 = bflo(zv[1]), z3 = bfhi(zv[1]);
            const float g0 = bflo(gv[0]), g1 = bfhi(gv[0]), g2 = bflo(gv[1]), g3 = bfhi(gv[1]);
            u32x2 o; o[0] = pk_bf16(g0 * fmaf(bias, z0, acc[ctl][4 * q + 0]), g1 * fmaf(bias, z1, acc[ctl][4 * q + 1]));
            o[1] = pk_bf16(g2 * fmaf(bias, z2, acc[ctl][4 * q + 2]), g3 * fmaf(bias, z3, acc[ctl][4 * q + 3]));
            *zp = o;
        }
    }
}
__device__ __forceinline__ void hyena_unit(LAS unsigned char* lds, int unit, const u16* __restrict__ HYT, const u16* __restrict__ FR, const float* __restrict__ cw, const float* __restrict__ cbv,
                                           const float* __restrict__ hbias, u16* __restrict__ Z2T, const ConvCtx& cc) {
    const int tid = tid_fresh(), wid = __builtin_amdgcn_readfirstlane(tid >> 6), lane = tid & 63;
    const int cs = wid & 3, hlf = wid >> 2, c = unit * 4 + cs, pl = lane + 64 * hlf;
    const int zb = cs * HY_ZBYTES, fb = HY_FB + cs * HY_FCH;
    { const u32x4 z = {0u, 0u, 0u, 0u}; for (int idx = pl; idx < HY_ZBYTES / 16; idx += 128) *(LAS u32x4*)(lds + zb + idx * 16) = z; }
    __syncthreads();
    hy_load_row(lds, zb, 256, HY_ZSTRIDE, HYT + (size_t)c * NTOK, cw[0 * 3072 + c], cw[1 * 3072 + c], cw[2 * 3072 + c], cbv[c], pl);
    f32x16 acc[4];
#pragma unroll
    for (int o = 0; o < 2; ++o) {
        hy_load_filters(lds, fb, FR + (size_t)((o * 1024 + c) * 2) * FR_LEN, pl);
        __syncthreads();
        hy_mfma_loop(lds, zb, fb, hlf, lane, acc, cc, o * 16, unit, wid);
        __syncthreads();
        const int gc = (1 + o) * 1024 + c;
        hy_load_row(lds, fb, 0, 2048, HYT + (size_t)gc * NTOK, cw[0 * 3072 + gc], cw[1 * 3072 + gc], cw[2 * 3072 + gc], cbv[gc], pl);
        __syncthreads();
        hy_epilogue(lds, zb, fb, hlf, lane, acc, hbias[o * HYW + c]);
        __syncthreads();
    }
#pragma unroll 2
    for (int it = 0; it < 8; ++it) { const int idx = pl + 128 * it, tok0 = idx * 8, b = tok0 >> 11, n0 = tok0 & 2047;
        *(u32x4*)(Z2T + (size_t)c * NTOK + tok0) = *(const LAS u32x4*)(lds + zb + (256 + b * HY_ZSTRIDE + n0) * 2); }
    __syncthreads();
}

constexpr int HG_RAWQ = 0, HG_RAWF = 16384, HG_RAWV = 32768;
constexpr int HG_QM = 36864, HG_KM = HG_QM + 17408, HG_QI = HG_KM + 17408;
constexpr int HG_KL = HG_QI + 17408;
constexpr int HG_VT = HG_KL + 18432;
constexpr int HG_P = HG_VT + 4608;
constexpr int HG_ST = HG_P + 9216;
constexpr int HG_TOT = HG_ST + 8704;
constexpr int HG_EL2 = HG_TOT + 4096;
constexpr int HG_LDS = HG_EL2 + 512;

__device__ __forceinline__ void hgrn_unit(LAS unsigned char* lds, int unit, const u16* __restrict__ PG, const float* __restrict__ lb_logits, float* __restrict__ OF, float* __restrict__ OB, const ConvCtx& cc) {
    const int tid = tid_fresh(), wid = __builtin_amdgcn_readfirstlane(tid >> 6), lane = tid & 63, fr = lane & 15, fq = lane >> 4;
    const int h = unit & 7, vq = (unit >> 3) & 3, dir = (unit >> 5) & 1, b = unit >> 6;
    const int k = tid & 127, seg = tid >> 7;
    float* __restrict__ O = dir ? OB : OF;
    for (int i = tid; i < 8704 / 16; i += 512) *(LAS u32x4*)(lds + HG_ST + i * 16) = (u32x4){0u, 0u, 0u, 0u};
    f32x4 Sacc[2];
    Sacc[0] = (f32x4){0.f, 0.f, 0.f, 0.f}; Sacc[1] = Sacc[0];
    u32x4 pq[2], pf[2], pv;
    const int colq = h * 128, colf = (1 + dir) * 1024 + h * 128, colv = 3072 + h * 128 + vq * 32;
#define HG_TOK(c, tau) ((size_t)b * SEQ + (dir ? (SEQ - 1 - 64 * (c) - (tau)) : (64 * (c) + (tau))))
#define HG_PREFETCH(c) do { _Pragma("unroll") for (int _i = 0; _i < 2; ++_i) { const int _x = tid + 512 * _i, _tau = _x >> 4, _p = _x & 15; const u16* _r = PG + HG_TOK(c, _tau) * 5120; \
            pq[_i] = *(const u32x4*)(_r + colq + _p * 8); pf[_i] = *(const u32x4*)(_r + colf + _p * 8); } \
        if (tid < 256) { const int _tau = tid >> 2, _p = tid & 3; pv = *(const u32x4*)(PG + HG_TOK(c, _tau) * 5120 + colv + _p * 8); } } while (0)
#define HG_RAW2LDS() do { _Pragma("unroll") for (int _i = 0; _i < 2; ++_i) { const int _x = tid + 512 * _i; *(LAS u32x4*)(lds + HG_RAWQ + _x * 16) = pq[_i]; *(LAS u32x4*)(lds + HG_RAWF + _x * 16) = pf[_i]; } \
        if (tid < 256) *(LAS u32x4*)(lds + HG_RAWV + tid * 16) = pv; } while (0)
    HG_PREFETCH(0);
    HG_RAW2LDS();
    HG_PREFETCH(1);
    __syncthreads();
    for (int c = 0; c < 32; ++c) {
        f32x2 cv[16];
        const int mqa = conv_seq2tile((32 + c * 2) * 256 + unit), mqb = conv_seq2tile((33 + c * 2) * 256 + unit);
        conv_issue(cc, mqa, wid, lane, cv);
        const int kp = lane, sg = wid;
        float qv0[8], qv1[8], kv0[8], kv1[8], bl0[8], bl1[8];
        { float r0 = 0.f, r1 = 0.f;
#pragma unroll
          for (int i = 0; i < 8; ++i) { const int tau = sg * 8 + i;
              const unsigned qw = *(const LAS unsigned*)(lds + HG_RAWQ + tau * 256 + kp * 4), fw = *(const LAS unsigned*)(lds + HG_RAWF + tau * 256 + kp * 4);
              const float l0 = bflo(fw), l1 = bfhi(fw);
              r0 += l0; r1 += l1; bl0[i] = r0; bl1[i] = r1; kv0[i] = 1.0f - __builtin_amdgcn_exp2f(l0); kv1[i] = 1.0f - __builtin_amdgcn_exp2f(l1); qv0[i] = bflo(qw); qv1[i] = bfhi(qw); }
          *(LAS f32x2*)(lds + HG_TOT + (sg * 128 + 2 * kp) * 4) = (f32x2){r0, r1}; }
        __syncthreads();
        { f32x2 tt[8];
#pragma unroll
          for (int q = 0; q < 8; ++q) tt[q] = *(const LAS f32x2*)(lds + HG_TOT + (q * 128 + 2 * kp) * 4);
          f32x2 pre = {0.f, 0.f};
#pragma unroll
          for (int q = 0; q < 7; ++q) if (q < sg) pre += tt[q];
          const f32x2 bref = tt[0] + tt[1] + tt[2] + tt[3], blast = bref + tt[4] + tt[5] + tt[6] + tt[7];
          const float er0 = __builtin_amdgcn_exp2f(bref[0]), er1 = __builtin_amdgcn_exp2f(bref[1]), el0 = __builtin_amdgcn_exp2f(blast[0] - bref[0]), el1 = __builtin_amdgcn_exp2f(blast[1] - bref[1]);
          if (sg == 0) *(LAS f32x2*)(lds + HG_EL2 + 2 * kp * 4) = (f32x2){__builtin_amdgcn_exp2f(blast[0]), __builtin_amdgcn_exp2f(blast[1])};
          const f32x2 dref = pre - bref;
          float kl0[8], kl1[8];
#pragma unroll
          for (int i = 0; i < 8; ++i) { const int tau = sg * 8 + i; const float x0 = dref[0] + bl0[i], x1 = dref[1] + bl1[i];
              const float qm0 = qv0[i] * __builtin_amdgcn_exp2f(x0), qm1 = qv1[i] * __builtin_amdgcn_exp2f(x1), km0 = kv0[i] * __builtin_amdgcn_exp2f(-x0), km1 = kv1[i] * __builtin_amdgcn_exp2f(-x1);
              *(LAS unsigned*)(lds + HG_QM + tau * 272 + kp * 4) = pk_bf16(qm0, qm1);
              *(LAS unsigned*)(lds + HG_KM + tau * 272 + kp * 4) = pk_bf16(km0, km1);
              *(LAS unsigned*)(lds + HG_QI + tau * 272 + kp * 4) = pk_bf16(qm0 * er0, qm1 * er1);
              kl0[i] = km0 * el0; kl1[i] = km1 * el1; }
          *(LAS u32x4*)(lds + HG_KL + (2 * kp) * 144 + sg * 16) = (u32x4){pk_bf16(kl0[0], kl0[1]), pk_bf16(kl0[2], kl0[3]), pk_bf16(kl0[4], kl0[5]), pk_bf16(kl0[6], kl0[7])};
          *(LAS u32x4*)(lds + HG_KL + (2 * kp + 1) * 144 + sg * 16) = (u32x4){pk_bf16(kl1[0], kl1[1]), pk_bf16(kl1[2], kl1[3]), pk_bf16(kl1[4], kl1[5]), pk_bf16(kl1[6], kl1[7])};
          { const int v = tid & 31, tg = tid >> 5; unsigned short e[4];
#pragma unroll
            for (int u = 0; u < 4; ++u) e[u] = *(const LAS u16*)(lds + HG_RAWV + (tg * 4 + u) * 64 + v * 2);
            *(LAS u32x2*)(lds + HG_VT + v * 144 + tg * 8) = (u32x2){(unsigned)e[0] | ((unsigned)e[1] << 16), (unsigned)e[2] | ((unsigned)e[3] << 16)}; } }
        conv_finish(cc, mqa, wid, lane, cv);
        conv_issue(cc, mqb, wid, lane, cv);
        __syncthreads();
        if (c + 1 < 32) { HG_RAW2LDS(); if (c + 2 < 32) HG_PREFETCH(c + 2); }
#pragma unroll
        for (int q = 0; q < 2; ++q) { const int idx = wid * 2 + q, ti = idx >> 2, si = idx & 3;
            f32x4 a = {0.f, 0.f, 0.f, 0.f};
            if (si <= ti) {
#pragma unroll
                for (int ks = 0; ks < 4; ++ks) { const bf16x8 ka = *(const LAS bf16x8*)(lds + HG_KM + (si * 16 + fr) * 272 + (ks * 32 + fq * 8) * 2), qb = *(const LAS bf16x8*)(lds + HG_QM + (ti * 16 + fr) * 272 + (ks * 32 + fq * 8) * 2);
                    a = __builtin_amdgcn_mfma_f32_16x16x32_bf16(ka, qb, a, 0, 0, 0); } }
            const int tau = ti * 16 + fr, s0 = si * 16 + fq * 4;
            float pvv[4];
#pragma unroll
            for (int j = 0; j < 4; ++j) pvv[j] = (si <= ti && s0 + j <= tau) ? a[j] : 0.f;
            *(LAS u32x2*)(lds + HG_P + tau * 144 + s0 * 2) = (u32x2){pk_bf16(pvv[0], pvv[1]), pk_bf16(pvv[2], pvv[3])}; }
        const int ti = wid >> 1, vi = wid & 1;
        f32x4 oacc = {0.f, 0.f, 0.f, 0.f};
#pragma unroll
        for (int ks = 0; ks < 4; ++ks) { const bf16x8 qa = *(const LAS bf16x8*)(lds + HG_QI + (ti * 16 + fr) * 272 + (ks * 32 + fq * 8) * 2), sb = *(const LAS bf16x8*)(lds + HG_ST + (vi * 16 + fr) * 272 + (ks * 32 + fq * 8) * 2);
            oacc = __builtin_amdgcn_mfma_f32_16x16x32_bf16(qa, sb, oacc, 0, 0, 0); }
        { const f32x4 e2 = *(const LAS f32x4*)(lds + HG_EL2 + (wid * 16 + fq * 4) * 4);
#pragma unroll
          for (int v2 = 0; v2 < 2; ++v2) { Sacc[v2] = Sacc[v2] * e2;
#pragma unroll
              for (int ks = 0; ks < 2; ++ks) { const bf16x8 ka = *(const LAS bf16x8*)(lds + HG_KL + (wid * 16 + fr) * 144 + (ks * 32 + fq * 8) * 2), vb = *(const LAS bf16x8*)(lds + HG_VT + (v2 * 16 + fr) * 144 + (ks * 32 + fq * 8) * 2);
                  Sacc[v2] = __builtin_amdgcn_mfma_f32_16x16x32_bf16(ka, vb, Sacc[v2], 0, 0, 0); } } }
        __syncthreads();
#pragma unroll
        for (int ks = 0; ks < 2; ++ks) { const bf16x8 pa = *(const LAS bf16x8*)(lds + HG_P + (ti * 16 + fr) * 144 + (ks * 32 + fq * 8) * 2), vb = *(const LAS bf16x8*)(lds + HG_VT + (vi * 16 + fr) * 144 + (ks * 32 + fq * 8) * 2);
            oacc = __builtin_amdgcn_mfma_f32_16x16x32_bf16(pa, vb, oacc, 0, 0, 0); }
#pragma unroll
        for (int j = 0; j < 4; ++j) { const int tau = ti * 16 + fq * 4 + j; O[HG_TOK(c, tau) * HGW + h * 128 + vq * 32 + vi * 16 + fr] = oacc[j]; }
        conv_finish(cc, mqb, wid, lane, cv);
#pragma unroll
        for (int v2 = 0; v2 < 2; ++v2) *(LAS u32x2*)(lds + HG_ST + (v2 * 16 + fr) * 272 + (wid * 16 + fq * 4) * 2) = (u32x2){pk_bf16(Sacc[v2][0], Sacc[v2][1]), pk_bf16(Sacc[v2][2], Sacc[v2][3])};
    }
    __syncthreads();
#undef HG_TOK
#undef HG_PREFETCH
#undef HG_RAW2LDS
}


#define XB_TMO      128
#define XB_XCNT(j)  (256  + 64 * (j))
#define XB_XSUB(j)  (1280 + 64 * (j))
#define XB_XGEN(j)  (2304 + 64 * (j))
#define XB_TOP      3328
#define XB_TOPGEN   3392
#define XCD_BAR_WORDS 3456
#define XB_SPIN_CAP (1u << 22)

__device__ __forceinline__ unsigned xb_ld(unsigned* p)              { return __hip_atomic_load(p, __ATOMIC_RELAXED, __HIP_MEMORY_SCOPE_AGENT); }
__device__ __forceinline__ unsigned xb_add(unsigned* p, unsigned v) { return __hip_atomic_fetch_add(p, v, __ATOMIC_RELAXED, __HIP_MEMORY_SCOPE_AGENT); }
__device__ __forceinline__ unsigned xb_xcc_id() { return (unsigned)__builtin_amdgcn_s_getreg((3 << 11) | 20) & 0xFu; }
#define XB_SPIN(cond, bar) do { unsigned _sp = 0; while (cond) { __builtin_amdgcn_s_sleep(1); \
    if ((++_sp & 255u) == 0u) { if (xb_ld(&(bar)[XB_TMO])) break; if (_sp > XB_SPIN_CAP) { atomicAdd(&(bar)[XB_TMO], 1u); break; } } } } while (0)

struct XcdBarrier {
    unsigned* bar; unsigned x;
    volatile LAS unsigned* st;
};

__device__ __forceinline__ XcdBarrier xcd_barrier_post(unsigned* bar, volatile LAS unsigned* st) {
    XcdBarrier b; b.bar = bar; b.x = xb_xcc_id(); b.st = st;
    if (threadIdx.x == 0) (void)xb_add(&bar[XB_XCNT(b.x)], 1u);
    return b;
}
__device__ __forceinline__ void xcd_barrier_complete(unsigned* bar, unsigned x, unsigned& nloc, unsigned& nx) {
    const unsigned G = gridDim.x * gridDim.y * gridDim.z;
    unsigned sum, cnt, mine, sp = 0u;
    for (;;) {
        sum = 0u; cnt = 0u; mine = 0u;
#pragma unroll
        for (unsigned j = 0; j < 16; ++j) { const unsigned c = xb_ld(&bar[XB_XCNT(j)]); sum += c; cnt += (c > 0u) ? 1u : 0u; mine = (j == x) ? c : mine; }
        if (sum == G) break;
        __builtin_amdgcn_s_sleep(1);
        if ((++sp & 255u) == 0u) { if (xb_ld(&bar[XB_TMO])) break; if (sp > XB_SPIN_CAP) { atomicAdd(&bar[XB_TMO], 1u); break; } }
    }
    nloc = mine > 0u ? mine : 1u; nx = cnt > 0u ? cnt : 1u;
}

__device__ __forceinline__ void xcd_barrier(const XcdBarrier& b) {
    asm volatile("s_waitcnt vmcnt(0)" ::: "memory");
    __syncthreads();
    if (threadIdx.x == 0) {
        unsigned* bar = b.bar;
        __builtin_amdgcn_s_waitcnt(0);
        unsigned nloc = b.st[0], nx = b.st[1];
        if (nloc == 0u) { xcd_barrier_complete(bar, b.x, nloc, nx); b.st[0] = nloc; b.st[1] = nx; }
        const unsigned old = xb_add(&bar[XB_XSUB(b.x)], 1u);
        const unsigned gen = old / nloc;
        if (old + 1u == (gen + 1u) * nloc) {
            __builtin_amdgcn_fence(__ATOMIC_RELEASE, "agent");
            asm volatile("s_waitcnt vmcnt(0)" ::: "memory");
            const unsigned og = xb_add(&bar[XB_TOP], 1u);
            const unsigned tg = og / nx;
            if (og + 1u == (tg + 1u) * nx) xb_add(&bar[XB_TOPGEN], 1u);
            else XB_SPIN(xb_ld(&bar[XB_TOPGEN]) == tg, bar);
            __builtin_amdgcn_fence(__ATOMIC_ACQUIRE, "agent");
            xb_add(&bar[XB_XGEN(b.x)], 1u);
            asm volatile("s_waitcnt vmcnt(0)" ::: "memory");
        } else {
            XB_SPIN(xb_ld(&bar[XB_XGEN(b.x)]) == gen, bar);
            __builtin_amdgcn_fence(__ATOMIC_ACQUIRE, "agent");
            asm volatile("s_waitcnt vmcnt(0)" ::: "memory");
        }
    }
    __syncthreads();
}

__device__ __forceinline__ float wave_sum(float s) {
#pragma unroll
    for (int o = 32; o >= 1; o >>= 1) s += __shfl_xor(s, o);
    return s;
}
__device__ __forceinline__ void rmsnorm_row_bf(const float* __restrict__ xr, const float* __restrict__ gain, u16* __restrict__ ob, int lane) {
    f32x4 v[8]; float s = 0.f;
#pragma unroll
    for (int j = 0; j < 8; ++j) { v[j] = *(const f32x4*)(xr + (lane + 64 * j) * 4); s += v[j][0] * v[j][0] + v[j][1] * v[j][1] + v[j][2] * v[j][2] + v[j][3] * v[j][3]; }
    s = wave_sum(s);
    const float r = rsqrtf(s * (1.0f / (float)DM) + EPS);
#pragma unroll
    for (int j = 0; j < 8; ++j) { const f32x4 g = *(const f32x4*)(gain + (lane + 64 * j) * 4); const f32x4 o = v[j] * r * g;
        *(u32x2*)(ob + (lane + 64 * j) * 4) = (u32x2){pk_bf16(o[0], o[1]), pk_bf16(o[2], o[3])}; }
}
__device__ __forceinline__ void hgrn_final_item4(int item0, int stride, const float* __restrict__ OF, const float* __restrict__ OB, const u16* __restrict__ PG, const float* __restrict__ gain, u16* __restrict__ MIXB, int lane) {
    f32x2 a[4], b[4]; unsigned gw[4];
#pragma unroll
    for (int q = 0; q < 4; ++q) { const int item = item0 + q * stride, tok = item >> 3, c = (item & 7) * 128 + 2 * lane;
        a[q] = *(const f32x2*)(OF + (size_t)tok * HGW + c); b[q] = *(const f32x2*)(OB + (size_t)tok * HGW + c); gw[q] = *(const unsigned*)(PG + (size_t)tok * 5120 + 4096 + c); }
#pragma unroll
    for (int q = 0; q < 4; ++q) { const int item = item0 + q * stride, tok = item >> 3, c = (item & 7) * 128 + 2 * lane;
        const float o0 = a[q][0] + b[q][0], o1 = a[q][1] + b[q][1];
        const float s = wave_sum(o0 * o0 + o1 * o1);
        const float r = rsqrtf(s * (1.0f / 128.0f) + EPS);
        const float g0 = bflo(gw[q]), g1 = bfhi(gw[q]);
        const f32x2 gn = *(const f32x2*)(gain + c);
        const float v0 = o0 * r * gn[0] * (g0 * __builtin_amdgcn_rcpf(1.0f + __expf(-g0))), v1 = o1 * r * gn[1] * (g1 * __builtin_amdgcn_rcpf(1.0f + __expf(-g1)));
        *(u16*)((unsigned char*)MIXB + (size_t)tok * DM + c) = (u16)(__builtin_amdgcn_cvt_pk_fp8_f32(v0, v1, 0, false) & 0xffff); }
}
__device__ __forceinline__ void hy_norm_tile(LAS unsigned char* lds, int tile_i, const u16* __restrict__ Z2T, const float* __restrict__ gain, u16* __restrict__ MIXB) {
    const int t = tid_fresh(), tok0 = tile_i * 32;
    LAS float* ssq = (LAS float*)(lds + 1024 * 80);
    if (t < 32) ssq[t] = 0.f;
    __syncthreads();
    float part[8];
#pragma unroll
    for (int q = 0; q < 8; ++q) part[q] = 0.f;
    const int ch = t & 3;
#pragma unroll
    for (int it = 0; it < 8; ++it) {
        const int c = (t >> 2) + 128 * it;
        const u32x4 v = *(const u32x4*)(Z2T + (size_t)c * NTOK + tok0 + ch * 8);
        *(LAS u32x4*)(lds + c * 80 + ch * 16) = v;
#pragma unroll
        for (int q = 0; q < 4; ++q) { const float a = bflo(v[q]), b = bfhi(v[q]); part[2 * q] += a * a; part[2 * q + 1] += b * b; }
    }
#pragma unroll
    for (int q = 0; q < 8; ++q) { float s = part[q]; s += __shfl_xor(s, 4); s += __shfl_xor(s, 8); s += __shfl_xor(s, 16); s += __shfl_xor(s, 32); part[q] = s; }
    if ((t & 63) < 4) {
#pragma unroll
        for (int q = 0; q < 8; ++q) atomicAdd((float*)(ssq + ch * 8 + q), part[q]);
    }
    __syncthreads();
    const int tt = t >> 4;
    const float r = rsqrtf(ssq[tt] * (1.0f / (float)HYW) + EPS);
#pragma unroll 2
    for (int k = 0; k < 8; ++k) {
        const int c0 = ((t & 15) + 16 * k) * 8;
        float o[8];
#pragma unroll
        for (int q = 0; q < 8; ++q) o[q] = bf2f(*(const LAS u16*)(lds + (c0 + q) * 80 + tt * 2)) * r * gain[c0 + q];
        *(u32x2*)((unsigned char*)MIXB + (size_t)(tok0 + tt) * DM + 1024 + c0) = (u32x2){pk_fp8x4(o[0], o[1], o[2], o[3]), pk_fp8x4(o[4], o[5], o[6], o[7])};
    }
    __syncthreads();
}
constexpr int RT_XSTRIDE = 2049;
constexpr int RT_PART = 16 * RT_XSTRIDE * 4;
constexpr int RT_LG = RT_PART + 8 * 16 * 32 * 4;
constexpr int RT_HIST = RT_LG + 16 * 32 * 4;
constexpr int RT_ITEMS = RT_HIST + 128;
constexpr int RT_RBASE = RT_ITEMS + 512;
constexpr int RT_END = RT_RBASE + 128;
__device__ __forceinline__ void router_tile(LAS unsigned char* lds, int tile_i, const float* __restrict__ X1, const float* __restrict__ gain, const float* __restrict__ wr, const float* __restrict__ br,
                                            unsigned char* __restrict__ XN8, float* __restrict__ TOPG, int tl2, const float (&bw)[128]) {
    const int tid = tid_fresh(), wid = __builtin_amdgcn_readfirstlane(tid >> 6), lane = tid & 63;
    const int tok0 = tile_i * 16;
    LAS float* xs = (LAS float*)lds;
#pragma unroll
    for (int q = 0; q < 2; ++q) {
        const int tl = wid * 2 + q; const size_t tok = (size_t)tok0 + tl;
        const float* xr = X1 + tok * DM;
        f32x4 v[8]; float s = 0.f;
#pragma unroll
        for (int j = 0; j < 8; ++j) { v[j] = *(const f32x4*)(xr + (lane + 64 * j) * 4); s += v[j][0] * v[j][0] + v[j][1] * v[j][1] + v[j][2] * v[j][2] + v[j][3] * v[j][3]; }
        s = wave_sum(s);
        const float r = rsqrtf(s * (1.0f / (float)DM) + EPS);
#pragma unroll
        for (int j = 0; j < 8; ++j) { const int d = (lane + 64 * j) * 4; const f32x4 g = *(const f32x4*)(gain + d); const f32x4 o = v[j] * r * g;
            xs[tl * RT_XSTRIDE + d + 0] = o[0]; xs[tl * RT_XSTRIDE + d + 1] = o[1]; xs[tl * RT_XSTRIDE + d + 2] = o[2]; xs[tl * RT_XSTRIDE + d + 3] = o[3];
            *(unsigned*)(XN8 + tok * DM + d) = pk_fp8x4(o[0], o[1], o[2], o[3]); }
    }
    __syncthreads();
    {
        const int tl = lane & 15, kk = lane >> 4;
        f32x4 a0 = {0.f, 0.f, 0.f, 0.f}, a1 = a0;
        const LAS float* xp = xs + tl * RT_XSTRIDE + wid * 256 + kk;
#pragma unroll
        for (int ks = 0; ks < 64; ++ks) { const float a = xp[ks * 4];
            a0 = __builtin_amdgcn_mfma_f32_16x16x4f32(a, bw[2 * ks], a0, 0, 0, 0); a1 = __builtin_amdgcn_mfma_f32_16x16x4f32(a, bw[2 * ks + 1], a1, 0, 0, 0); }
        LAS float* pp = (LAS float*)(lds + RT_PART) + wid * 512;
#pragma unroll
        for (int j = 0; j < 4; ++j) { pp[(kk * 4 + j) * 32 + tl] = a0[j]; pp[(kk * 4 + j) * 32 + 16 + tl] = a1[j]; }
    }
    __syncthreads();
    {   const LAS float* pp = (const LAS float*)(lds + RT_PART); float s = br[tid & 31];
#pragma unroll
        for (int w = 0; w < 8; ++w) s += pp[w * 512 + tid];
        ((LAS float*)(lds + RT_LG))[tid] = s; }
    __syncthreads();
    if (tid < 16) {
        LAS float* lg = (LAS float*)(lds + RT_LG) + tid * 32;
        int i0 = 0, i1 = 0, i2 = 0, i3 = 0; float v0, v1, v2, v3;
        { float bv = -3.0e38f; for (int j = 0; j < NE; ++j) { const float l = lg[j]; if (l > bv) { bv = l; i0 = j; } } v0 = bv; lg[i0] = -3.4e38f; }
        { float bv = -3.0e38f; for (int j = 0; j < NE; ++j) { const float l = lg[j]; if (l > bv) { bv = l; i1 = j; } } v1 = bv; lg[i1] = -3.4e38f; }
        { float bv = -3.0e38f; for (int j = 0; j < NE; ++j) { const float l = lg[j]; if (l > bv) { bv = l; i2 = j; } } v2 = bv; lg[i2] = -3.4e38f; }
        { float bv = -3.0e38f; for (int j = 0; j < NE; ++j) { const float l = lg[j]; if (l > bv) { bv = l; i3 = j; } } v3 = bv; lg[i3] = -3.4e38f; }
        const float e1 = __expf(v1 - v0), e2 = __expf(v2 - v0), e3 = __expf(v3 - v0), inv = 1.0f / (1.0f + e1 + e2 + e3);
        const int tok = tok0 + tid;
        *(f32x4*)(TOPG + tok * 4) = (f32x4){inv, e1 * inv, e2 * inv, e3 * inv};
        LAS int* hist = (LAS int*)(lds + RT_HIST);
        const int p0 = atomicAdd((int*)(hist + i0), 1), p1 = atomicAdd((int*)(hist + i1), 1), p2 = atomicAdd((int*)(hist + i2), 1), p3 = atomicAdd((int*)(hist + i3), 1);
        *(LAS u32x4*)(lds + RT_ITEMS + (tl2 * 16 + tid) * 16) = (u32x4){(unsigned)((i0 << 16) | p0), (unsigned)((i1 << 16) | p1), (unsigned)((i2 << 16) | p2), (unsigned)((i3 << 16) | p3)};
    }
    __syncthreads();
}
__device__ __forceinline__ void combine_row(int tok, const float* __restrict__ X1, const u16* __restrict__ YB, const int* __restrict__ SOF, const float* __restrict__ TOPG, const float* __restrict__ gain, float* __restrict__ out, int lane) {
    const int4 sl = *(const int4*)(SOF + tok * 4); const f32x4 g = *(const f32x4*)(TOPG + tok * 4);
    const u16* y0 = YB + (size_t)sl.x * DM; const u16* y1 = YB + (size_t)sl.y * DM; const u16* y2 = YB + (size_t)sl.z * DM; const u16* y3 = YB + (size_t)sl.w * DM;
    f32x4 v[8]; float s = 0.f;
#pragma unroll
    for (int j = 0; j < 8; ++j) { const int d = (lane + 64 * j) * 4;
        f32x4 a = *(const f32x4*)(X1 + (size_t)tok * DM + d);
        const u32x2 q0 = *(const u32x2*)(y0 + d), q1 = *(const u32x2*)(y1 + d), q2 = *(const u32x2*)(y2 + d), q3 = *(const u32x2*)(y3 + d);
        a[0] += g[0] * bflo(q0[0]) + g[1] * bflo(q1[0]) + g[2] * bflo(q2[0]) + g[3] * bflo(q3[0]);
        a[1] += g[0] * bfhi(q0[0]) + g[1] * bfhi(q1[0]) + g[2] * bfhi(q2[0]) + g[3] * bfhi(q3[0]);
        a[2] += g[0] * bflo(q0[1]) + g[1] * bflo(q1[1]) + g[2] * bflo(q2[1]) + g[3] * bflo(q3[1]);
        a[3] += g[0] * bfhi(q0[1]) + g[1] * bfhi(q1[1]) + g[2] * bfhi(q2[1]) + g[3] * bfhi(q3[1]);
        v[j] = a; s += a[0] * a[0] + a[1] * a[1] + a[2] * a[2] + a[3] * a[3]; }
    s = wave_sum(s);
    const float r = rsqrtf(s * (1.0f / (float)DM) + EPS);
#pragma unroll
    for (int j = 0; j < 8; ++j) { const int d = (lane + 64 * j) * 4; const f32x4 gn = *(const f32x4*)(gain + d); *(f32x4*)(out + (size_t)tok * DM + d) = v[j] * r * gn; }
}

__device__ __forceinline__ void combine_row2(int tokA, int tokB, const float* __restrict__ X1, const u16* __restrict__ YB, const int* __restrict__ SOF, const float* __restrict__ TOPG, const float* __restrict__ gain, float* __restrict__ out, int lane) {
    const int4 slA = *(const int4*)(SOF + tokA * 4), slB = *(const int4*)(SOF + tokB * 4); const f32x4 gA = *(const f32x4*)(TOPG + tokA * 4), gB = *(const f32x4*)(TOPG + tokB * 4);
    const u16* yA0 = YB + (size_t)slA.x * DM; const u16* yA1 = YB + (size_t)slA.y * DM; const u16* yA2 = YB + (size_t)slA.z * DM; const u16* yA3 = YB + (size_t)slA.w * DM;
    const u16* yB0 = YB + (size_t)slB.x * DM; const u16* yB1 = YB + (size_t)slB.y * DM; const u16* yB2 = YB + (size_t)slB.z * DM; const u16* yB3 = YB + (size_t)slB.w * DM;
    f32x4 vA[8], vB[8]; float sA = 0.f, sB = 0.f;
#pragma unroll
    for (int j = 0; j < 8; ++j) { const int d = (lane + 64 * j) * 4;
        f32x4 a = *(const f32x4*)(X1 + (size_t)tokA * DM + d), b = *(const f32x4*)(X1 + (size_t)tokB * DM + d);
        const u32x2 p0 = *(const u32x2*)(yA0 + d), p1 = *(const u32x2*)(yA1 + d), p2 = *(const u32x2*)(yA2 + d), p3 = *(const u32x2*)(yA3 + d);
        const u32x2 q0 = *(const u32x2*)(yB0 + d), q1 = *(const u32x2*)(yB1 + d), q2 = *(const u32x2*)(yB2 + d), q3 = *(const u32x2*)(yB3 + d);
        a[0] += gA[0] * bflo(p0[0]) + gA[1] * bflo(p1[0]) + gA[2] * bflo(p2[0]) + gA[3] * bflo(p3[0]);
        a[1] += gA[0] * bfhi(p0[0]) + gA[1] * bfhi(p1[0]) + gA[2] * bfhi(p2[0]) + gA[3] * bfhi(p3[0]);
        a[2] += gA[0] * bflo(p0[1]) + gA[1] * bflo(p1[1]) + gA[2] * bflo(p2[1]) + gA[3] * bflo(p3[1]);
        a[3] += gA[0] * bfhi(p0[1]) + gA[1] * bfhi(p1[1]) + gA[2] * bfhi(p2[1]) + gA[3] * bfhi(p3[1]);
        b[0] += gB[0] * bflo(q0[0]) + gB[1] * bflo(q1[0]) + gB[2] * bflo(q2[0]) + gB[3] * bflo(q3[0]);
        b[1] += gB[0] * bfhi(q0[0]) + gB[1] * bfhi(q1[0]) + gB[2] * bfhi(q2[0]) + gB[3] * bfhi(q3[0]);
        b[2] += gB[0] * bflo(q0[1]) + gB[1] * bflo(q1[1]) + gB[2] * bflo(q2[1]) + gB[3] * bflo(q3[1]);
        b[3] += gB[0] * bfhi(q0[1]) + gB[1] * bfhi(q1[1]) + gB[2] * bfhi(q2[1]) + gB[3] * bfhi(q3[1]);
        vA[j] = a; vB[j] = b; sA += a[0] * a[0] + a[1] * a[1] + a[2] * a[2] + a[3] * a[3]; sB += b[0] * b[0] + b[1] * b[1] + b[2] * b[2] + b[3] * b[3]; }
    sA = wave_sum(sA); sB = wave_sum(sB);
    const float rA = rsqrtf(sA * (1.0f / (float)DM) + EPS), rB = rsqrtf(sB * (1.0f / (float)DM) + EPS);
#pragma unroll
    for (int j = 0; j < 8; ++j) { const int d = (lane + 64 * j) * 4; const f32x4 gn = *(const f32x4*)(gain + d);
        *(f32x4*)(out + (size_t)tokA * DM + d) = vA[j] * rA * gn; *(f32x4*)(out + (size_t)tokB * DM + d) = vB[j] * rB * gn; }
}
#ifndef REP_P9
#define REP_P9 1
#endif
#ifndef REP_P3
#define REP_P3 1
#endif
#ifndef REP_FR
#define REP_FR 1
#endif
#ifndef REP_P0
#define REP_P0 1
#endif
#ifndef REP_CONV
#define REP_CONV 1
#endif
#ifndef REP_GEMM1
#define REP_GEMM1 1
#endif
#ifndef REP_HY
#define REP_HY 1
#endif
#ifndef REP_HG
#define REP_HG 1
#endif
#ifndef REP_MOEA
#define REP_MOEA 1
#endif
#ifndef REP_MOEB
#define REP_MOEB 1
#endif
#ifndef REP_WOUT
#define REP_WOUT 1
#endif
struct MegaP {
    const float *x, *norm_mix_gain, *w_in, *lb_logits, *hgrn_norm_gain, *hy_conv_w, *hy_conv_b, *fw1, *fb1, *fw2, *fb2, *fw3, *fb3, *fw4, *ffreq, *hy_bias, *hy_norm_gain, *w_out,
        *norm_ffn_gain, *w_router, *b_router, *moe_w1, *moe_b1, *moe_w2, *moe_b2, *final_gain;
    float* out; unsigned char* ws;
};
constexpr int MEGA_XB = RT_END;
constexpr int MEGA_LDS = RT_END + 64 + 384;
static_assert(MEGA_LDS >= HY_LDS + 64 && MEGA_LDS >= HG_LDS + 64 && MEGA_LDS >= GEMM_LDS + 64, "LDS");

__global__ void __launch_bounds__(512, 2) k_mega(const MegaP p_arg) {
    extern __shared__ __attribute__((aligned(16))) unsigned char shm[];
    LAS unsigned char* lds = (LAS unsigned char*)shm;
    const int tid = threadIdx.x, wid = __builtin_amdgcn_readfirstlane(tid >> 6), lane = tid & 63;
    const int G = gridDim.x, bid = blockIdx.x, c = xcd_logical(bid, G);
#define PHASE_ARGS() const MegaP __attribute__((address_space(4)))* pq_ = (const MegaP __attribute__((address_space(4)))*)__builtin_amdgcn_kernarg_segment_ptr(); asm volatile("" : "+s"(pq_)); unsigned char* ws = pq_->ws; (void)ws
    unsigned char* ws0; { PHASE_ARGS(); ws0 = ws; }
#define counts ((int*)(ws + WS_CTL))
#define cursor ((int*)(ws + WS_CTL + 4096))
#define offs ((int*)(ws + WS_CTL + 8192))
#define barw ((unsigned*)(ws + WS_CTL + 16384))
#define HB ((u16*)(ws + WS_HB))
#define PG ((u16*)(ws + WS_PG))
#define HYT ((u16*)(ws + WS_HYT))
#define MIXB ((u16*)(ws + WS_MIXB))
#define XNB ((u16*)(ws + WS_XNB))
#define HMB ((u16*)(ws + WS_HMS))
#define YB ((u16*)(ws + WS_YS))
#define H3 ((float*)(ws + WS_H3))
#define FR ((u16*)(ws + WS_FR))
#define Z2T ((u16*)(ws + WS_Z2T))
#define OF ((float*)(ws + WS_OF))
#define OB ((float*)(ws + WS_OB))
#define X1 ((float*)(ws + WS_X1))
#define TOPI ((int*)(ws + WS_TOPI))
#define TOPG ((float*)(ws + WS_TOPG))
#define STOK ((int*)(ws + WS_STOKS))
#define SOF ((int*)(ws + WS_SOF))
#define WINT ((u16*)(ws + WS_WINT))
#define WOUTT ((u16*)(ws + WS_WOUTT))
#define W1T ((u16*)(ws + WS_W1T))
#define W2T ((u16*)(ws + WS_W2T))
    if (tid == 0) *(LAS u32x4*)(lds + MEGA_XB) = (u32x4){0u, 0u, 0u, 0u};
    __syncthreads();
    XcdBarrier bar = xcd_barrier_post((unsigned*)(ws0 + WS_CTL + 16384), (volatile LAS unsigned*)(lds + MEGA_XB));

    {
        PHASE_ARGS();
    for (int rep = 0; rep < REP_P0; ++rep) {
    for (int row = bid * 8 + wid; row < NTOK; row += G * 8) rmsnorm_row_bf(pq_->x + (size_t)row * DM, pq_->norm_mix_gain, HB + (size_t)row * DM, lane);
    for (int m = bid * 8 + wid; m < SEQ; m += G * 8) h3_row(m, pq_->fw1, pq_->fb1, pq_->fw2, pq_->fb2, pq_->fw3, pq_->fb3, pq_->ffreq, (LAS float*)(lds + wid * 512), H3); }
    for (int rep = 0; rep < REP_CONV; ++rep)
    for (int id = bid; id < 1024 + 256; id += G) {
        const int tz = tid_fresh();
        if (id < 1024) { const int nt = id >> 5, kt = id & 31; convert_tile(pq_->w_in, DIN, kt * 64, ColMapPerm{nt * 256}, WINT + (size_t)id * 16384, tz); }
        else { const int q = id - 1024; const ConvCtx cw{nullptr, pq_->w_out, nullptr, (unsigned char*)WOUTT};
            f32x2 cv[16]; conv_issue(cw, 16384 + q, tz >> 6, tz & 63, cv); conv_finish(cw, 16384 + q, tz >> 6, tz & 63, cv); }
    }
    }
    xcd_barrier(bar);
    {
        PHASE_ARGS();
    for (int rep = 0; rep < REP_FR; ++rep)
    for (int item = bid; item < 256; item += G) frgen_item(lds, item, H3, pq_->fw4, FR);
    { SrcG1<false> s0{c, G, (const char*)HB, (const char*)WINT, PG, HYT, pq_->lb_logits}; gemm8_stream<false, false>(lds, DM, 32, s0);
      SrcG1<true> s1{c, G, (const char*)HB, (const char*)WINT, PG, HYT, pq_->lb_logits}; gemm8_stream<true, false>(lds, DM, 32, s1); }
#ifdef PROBE_NOEPI
    for (int u = c; u < 1024; u += G) {
        const int i = u >> 8, xx = (u >> 5) & 7, j = u & 31;
        const int mt = (xx & 3) * 8 + (j & 7), nt = ((xx >> 2) + 2 * i) * 4 + (j >> 3);
        const u16* bt = WINT + (size_t)nt * 32 * 16384;
        EpiNone e{}; if (nt < 20) gemm8_unit<false>(lds, HB, DM, nullptr, mt * 256, 256, bt, 32, e); else gemm8_unit<true>(lds, HB, DM, nullptr, mt * 256, 256, bt, 32, e);
    }
#endif
    }
    xcd_barrier(bar);
    {
        PHASE_ARGS();
    for (int rep = 0; rep < REP_HY; ++rep)
    for (int u = bid; u < 256; u += G) hyena_unit(lds, u, HYT, FR, pq_->hy_conv_w, pq_->hy_conv_b, pq_->hy_bias, Z2T, ConvCtx{pq_->moe_w1, pq_->moe_w2, (unsigned char*)W1T, (unsigned char*)W2T});
    for (int rep = 0; rep < REP_HG; ++rep)
    for (int u = bid; u < 256; u += G) hgrn_unit(lds, u, PG, pq_->lb_logits, OF, OB, ConvCtx{pq_->moe_w1, pq_->moe_w2, (unsigned char*)W1T, (unsigned char*)W2T});
    }
    xcd_barrier(bar);
    {
        PHASE_ARGS();
    for (int rep = 0; rep < REP_P3; ++rep) {
    for (int it = bid * 8 + wid; it < NTOK * HGH; it += G * 8 * 4) hgrn_final_item4(it, G * 8, OF, OB, PG, pq_->hgrn_norm_gain, MIXB, lane);
    for (int t = bid; t < NTOK / 32; t += G) hy_norm_tile(lds, t, Z2T, pq_->hy_norm_gain, MIXB); }
    }
    xcd_barrier(bar);
    {
        PHASE_ARGS();
    for (int u = c; u < 256; u += G) {
        const int xx = u >> 5, j = u & 31;
        const int mt = (xx >> 1) * 8 + (j & 7), nt = (xx & 1) * 4 + (j >> 3);
        Epi8X1 e{pq_->x, X1, mt * 256, nt * 256};
        gemm8_unit<false, true>(lds, MIXB, DM / 2, nullptr, mt * 256, 256, WOUTT + (size_t)nt * 16 * 16384, 16, e);
    }
    }
    xcd_barrier(bar);
    {
        PHASE_ARGS();
    if (tid < NE) *(LAS int*)(lds + RT_HIST + tid * 4) = 0;
    __syncthreads();
    float bw[128];
    { const float* wp = pq_->w_router + (size_t)(wid * 256 + (lane >> 4)) * NE + (lane & 15);
#pragma unroll
      for (int ks = 0; ks < 64; ++ks) { bw[2 * ks] = wp[(size_t)ks * 4 * NE]; bw[2 * ks + 1] = wp[(size_t)ks * 4 * NE + 16]; } }
    for (int t0 = bid; t0 < NTOK / 16; t0 += 2 * G) {
        const int t1 = t0 + G, ntl = (t1 < NTOK / 16) ? 2 : 1;
        router_tile(lds, t0, X1, pq_->norm_ffn_gain, pq_->w_router, pq_->b_router, (unsigned char*)XNB, TOPG, 0, bw);
        if (ntl == 2) router_tile(lds, t1, X1, pq_->norm_ffn_gain, pq_->w_router, pq_->b_router, (unsigned char*)XNB, TOPG, 1, bw);
        const int tq = tid_fresh();
        if (tq < NE) { const int n = *(const LAS int*)(lds + RT_HIST + tq * 4); *(LAS int*)(lds + RT_RBASE + tq * 4) = n ? atomicAdd(&cursor[tq * 32], n) : 0; *(LAS int*)(lds + RT_HIST + tq * 4) = 0; }
        __syncthreads();
        if (tq < ntl * 64) { const int it = *(const LAS int*)(lds + RT_ITEMS + tq * 4), e = it >> 16, tok = ((tq >> 6) ? t1 : t0) * 16 + ((tq >> 2) & 15);
            const int slot = e * NTOK + *(const LAS int*)(lds + RT_RBASE + e * 4) + (it & 0xffff); STOK[slot] = tok; SOF[tok * 4 + (tq & 3)] = slot; }
        __syncthreads();
    }
    }
    xcd_barrier(bar);
    {
        PHASE_ARGS();
    {
        LAS int* us = (LAS int*)(lds + MEGA_XB + 64); LAS int* so2 = us + 40;
        if (tid < NE) so2[tid] = __hip_atomic_load(&cursor[tid * 32], __ATOMIC_RELAXED, __HIP_MEMORY_SCOPE_AGENT);
        __syncthreads();
        if (tid == 0) { int a = 0; for (int e = 0; e < NE; ++e) { us[e] = a; a += ((so2[e] + 255) >> 8) * 16; } us[NE] = a; }
        __syncthreads();
    }
    {
        LAS int* qs = (LAS int*)(lds + MEGA_XB + 32); LAS int* us = (LAS int*)(lds + MEGA_XB + 64); LAS int* so2 = us + 40;
        int* qctr = (int*)(ws + WS_CTL + 12288 + (bid & 7) * 128);
        int tk_next = 0;
        auto decode = [&](int tkv, int& e, int& nt, int& slot0, int& rows) -> bool {
            const int tq = tid_fresh();
            if (tq == 0) { qs[0] = tkv; qs[1] = -1; }
            __syncthreads();
            const int tk = qs[0];
            const int u = 256 * (tk >> 5) + 32 * (bid & 7) + (tk & 31);
            if (tq < NE) { const int u0 = us[tq], u1 = us[tq + 1]; if (u >= u0 && u < u1) { const int o0 = tq * NTOK, cnt = so2[tq], mtl = (cnt + 255) >> 8, ul = u - u0, mt = ul % mtl;
                int rw = cnt - mt * 256; rw = rw > 256 ? 256 : rw; qs[1] = tq; qs[2] = ul / mtl; qs[3] = o0 + mt * 256; qs[4] = rw; } }
            __syncthreads();
            e = qs[1]; nt = qs[2]; slot0 = qs[3]; rows = qs[4];
            __syncthreads();
            return e >= 0;
        };
        if (tid == 0) tk_next = atomicAdd(qctr, 1);
        int e, nt, slot0, rows;
        if (decode(tk_next, e, nt, slot0, rows)) {
            if (tid == 0) tk_next = atomicAdd(qctr, 1);
            G8Pre cur, nxp;
            g8_addr(cur, DM / 2, STOK + slot0, rows, W1T + (size_t)(e * 16 + nt) * 16 * 16384);
            g8_issue(lds, (const char*)XNB, cur);
            for (;;) {
                int e2 = -1, nt2 = 0, slot2 = 0, rows2 = 0;
                auto next = [&]() -> bool {
                    if (!decode(tk_next, e2, nt2, slot2, rows2)) return false;
                    if (tid_fresh() == 0) tk_next = atomicAdd(qctr, 1);
                    g8_addr(nxp, DM / 2, STOK + slot2, rows2, W1T + (size_t)(e2 * 16 + nt2) * 16 * 16384);
                    g8_issue(lds, (const char*)XNB, nxp);
                    return true; };
                Epi8Swiglu8 ep{(unsigned char*)HMB, pq_->moe_b1 + (size_t)e * 2 * DFF, slot0, nt, rows};
                const bool more = gemm8_unit_ov<false, true>(lds, XNB, cur, 16, ep, next);
                if (!more) break;
                cur = nxp; e = e2; nt = nt2; slot0 = slot2; rows = rows2;
            }
        }
    }
    }
    xcd_barrier(bar);
    {
        PHASE_ARGS();
    {
        LAS int* us = (LAS int*)(lds + MEGA_XB + 64); LAS int* so2 = us + 40;
        if (tid < NE) so2[tid] = __hip_atomic_load(&cursor[tid * 32], __ATOMIC_RELAXED, __HIP_MEMORY_SCOPE_AGENT);
        __syncthreads();
        if (tid == 0) { int a = 0; for (int e = 0; e < NE; ++e) { us[e] = a; a += ((so2[e] + 255) >> 8) * 8; } us[NE] = a; }
        __syncthreads();
    }
    {
        const LAS int* us = (const LAS int*)(lds + MEGA_XB + 64); const LAS int* so2 = us + 40;
        SrcMoeB src{us, so2, c, G, (const char*)HMB, (const char*)W2T, YB, pq_->moe_b2};
        gemm8_stream<false, true>(lds, DFF / 2, 16, src);
    }
    }
    xcd_barrier(bar);
    {
        PHASE_ARGS();
    for (int rep = 0; rep < REP_P9; ++rep)
    for (int tok = bid * 8 + wid; tok < NTOK; tok += G * 8) combine_row(tok, X1, YB, SOF, TOPG, pq_->final_gain, pq_->out, lane);
    }
}
#undef counts
#undef cursor
#undef offs
#undef barw
#undef HB
#undef PG
#undef HYT
#undef MIXB
#undef XNB
#undef HMB
#undef YB
#undef H3
#undef FR
#undef Z2T
#undef OF
#undef OB
#undef X1
#undef TOPI
#undef TOPG
#undef STOK
#undef SOF
#undef WINT
#undef WOUTT
#undef W1T
#undef W2T

extern "C" void kernel_launch(void* const* d_in, const int* in_sizes, int n_in, void* d_out, int out_size, void* d_ws, size_t ws_size, hipStream_t stream) {
    if (n_in < 26 || ws_size < WS_END2) return;
    MegaP p{};
    const float** pp = (const float**)&p;
    for (int i = 0; i < 26; ++i) pp[i] = (const float*)d_in[i];
    p.out = (float*)d_out; p.ws = (unsigned char*)d_ws;
    static int grid = 0;
    if (!grid) {
        int dev = 0, cus = 0, per_cu = 0;
        (void)hipGetDevice(&dev);
        (void)hipDeviceGetAttribute(&cus, hipDeviceAttributeMultiprocessorCount, dev);
        (void)hipFuncSetAttribute((const void*)k_mega, hipFuncAttributeMaxDynamicSharedMemorySize, MEGA_LDS);
        (void)hipOccupancyMaxActiveBlocksPerMultiprocessor(&per_cu, (const void*)k_mega, 512, MEGA_LDS);
        if (per_cu < 1) per_cu = 1;
        grid = cus * 1;
        if (grid > 256) grid = 256;
        grid &= ~7;
        if (grid < 8) grid = 8;
    }
    (void)hipMemsetAsync((char*)d_ws + WS_CTL, 0, 65536, stream);
    hipLaunchKernelGGL(k_mega, dim3(grid), dim3(512), MEGA_LDS, stream, p);
}
```

```cpp
#include <hip/hip_runtime.h>
#include <stdint.h>

constexpr int BATCH = 4, SEQ = 2048, DM = 2048, NTOK = BATCH * SEQ;
constexpr int HGW = 1024, HGD = 128, HGH = 8;
constexpr int HYW = 1024;
constexpr int DIN = 8192;
constexpr int NE = 32, TOPK = 4, DFF = 2048;
constexpr int NSLOT = NTOK * TOPK;
constexpr float EPS = 1e-5f;

constexpr size_t MB = 1024ull * 1024ull;
constexpr size_t WS_CTL = 0;
constexpr size_t WS_HB = 1 * MB;
constexpr size_t WS_PG = WS_HB + 32 * MB;
constexpr size_t WS_HYT = WS_PG + 80 * MB;
constexpr size_t WS_MIXB = WS_HYT + 48 * MB;
constexpr size_t WS_XNB = WS_MIXB + 32 * MB;
constexpr size_t WS_HMB = WS_XNB + 32 * MB;
constexpr size_t WS_YB = WS_HMB + 128 * MB;
constexpr size_t WS_H3 = WS_YB + 128 * MB;
constexpr size_t WS_FR = WS_H3 + 1 * MB;
constexpr size_t WS_Z2T = WS_FR + 34 * MB;
constexpr size_t WS_OF = WS_Z2T + 16 * MB;
constexpr size_t WS_OB = WS_OF + 32 * MB;
constexpr size_t WS_X1 = WS_OB + 32 * MB;
constexpr size_t WS_TOPI = WS_X1 + 64 * MB;
constexpr size_t WS_TOPG = WS_TOPI + 1 * MB;
constexpr size_t WS_STOK = WS_TOPG + 1 * MB;
constexpr size_t WS_SOF = WS_STOK + 1 * MB;
constexpr size_t WS_WINT = WS_SOF + 1 * MB;
constexpr size_t WS_WOUTT = WS_WINT + 32 * MB;
constexpr size_t WS_W1T = WS_WOUTT + 8 * MB;
constexpr size_t WS_W2T = WS_W1T + 512 * MB;
constexpr size_t WS_HMS = WS_W2T + 256 * MB;
constexpr size_t WS_YS = WS_HMS + 512 * MB;
constexpr size_t WS_STOKS = WS_YS + 1024 * MB;
constexpr size_t WS_END2 = WS_STOKS + 1 * MB;

typedef short bf16x8 __attribute__((ext_vector_type(8)));
typedef float f32x4 __attribute__((ext_vector_type(4)));
typedef float f32x2 __attribute__((ext_vector_type(2)));
typedef unsigned u32x4 __attribute__((ext_vector_type(4)));
typedef unsigned u32x2 __attribute__((ext_vector_type(2)));
typedef unsigned short u16;
#define LAS __attribute__((address_space(3)))

__device__ __forceinline__ unsigned pk_bf16(float lo, float hi) {
    typedef __bf16 bf2 __attribute__((ext_vector_type(2)));
    const f32x2 v = {lo, hi};
    const bf2 r = __builtin_convertvector(v, bf2);
    return __builtin_bit_cast(unsigned, r);
}
__device__ __forceinline__ float bf2f(u16 b) { return __uint_as_float(((unsigned)b) << 16); }
__device__ __forceinline__ float bflo(unsigned w) { return __uint_as_float(w << 16); }
__device__ __forceinline__ float bfhi(unsigned w) { return __uint_as_float(w & 0xffff0000u); }

__device__ __forceinline__ int lds_byte(int r, int c) { const int st = (r >> 4) * 2 + (c >> 5), ob = (r & 15) * 64 + (c & 31) * 2; return st * 1024 + (ob ^ (((ob >> 9) & 1) << 5)); }
__device__ __forceinline__ void stage_rc(int b, int& R, int& C) { const int st = b >> 10, sb = b & 1023, swz = sb ^ (((sb >> 9) & 1) << 5); R = (st >> 1) * 16 + swz / 64; C = (st & 1) * 32 + (swz % 64) / 2; }
__device__ __forceinline__ f32x4 unperm(const f32x4 a, const bool s) { f32x4 o; o[0] = s ? a[1] : a[0]; o[1] = s ? a[0] : a[1]; o[2] = s ? a[3] : a[2]; o[3] = s ? a[2] : a[3]; return o; }

__device__ __forceinline__ int tid_fresh() { int t = threadIdx.x; asm volatile("" : "+v"(t)); return t; }
constexpr int GEMM_LDS = 131072;

template <bool TRANS, bool RAGGED, int PM = 0, class ColMap, class Epi>
__device__ __forceinline__ void gemm_unit(LAS unsigned char* lds, const u16* __restrict__ A, int lda, const int* __restrict__ arows, int arow0, int rows_valid,
                                          const float* __restrict__ B, int ldb, int K, const ColMap colmap, const Epi epi) {
    const int tid = tid_fresh(), wid = __builtin_amdgcn_readfirstlane(tid >> 6), lane = tid & 63;
    const int wr = wid >> 2, wc = wid & 3, fr = lane & 15, fq = lane >> 4;
    const int nt = K >> 6;
    const char* ap[4];
#pragma unroll
    for (int i = 0; i < 4; ++i) {
        int R, C; stage_rc(wid * 1024 + i * 8192 + lane * 16, R, C);
        const int rr = RAGGED ? (R < rows_valid ? R : rows_valid - 1) : R;
        const long rowid = arows ? (long)arows[rr] : (long)(arow0 + rr);
        ap[i] = (const char*)A + ((size_t)rowid * lda + C) * 2;
    }
    const int g = (lane & 3) + 4 * (wid >> 2), rg = (wid & 3) * 16 + (lane >> 2);
    const unsigned bvoff = (unsigned)(((size_t)(8 * g) * ldb + colmap(rg)) * 4);
    const int bbase = 65536 + lds_byte(4 * rg, 8 * g);
    const int bw0 = bbase + ((rg & 1) ? 64 : 0), bw1 = bbase + ((rg & 1) ? 0 : 64);
    const int aoff = lds_byte(wr * 128 + fr, fq * 8), boff = 65536 + lds_byte(wc * 64 + fr, fq * 8);
    int mvalid = 8;
    if (RAGGED) { mvalid = (rows_valid - wr * 128 + 15) >> 4; mvalid = mvalid < 0 ? 0 : (mvalid > 8 ? 8 : mvalid); }
    f32x4 vb0, vb1, vb2, vb3, vb4, vb5, vb6, vb7;
    if (PM & 1) { vb0 = (f32x4){1.f, 1.f, 1.f, 1.f}; vb1 = vb0; vb2 = vb0; vb3 = vb0; vb4 = vb0; vb5 = vb0; vb6 = vb0; vb7 = vb0; }
    f32x4 acc[8][4];
#pragma unroll
    for (int m = 0; m < 8; ++m)
#pragma unroll
        for (int n = 0; n < 4; ++n) acc[m][n] = (f32x4){0.f, 0.f, 0.f, 0.f};
    const size_t ldb4 = (size_t)ldb * 4;
#define GE_GLDS_A(buf, kt) do { if (!(PM & 2)) _Pragma("unroll") for (int _i = 0; _i < 4; ++_i) \
        __builtin_amdgcn_global_load_lds((const unsigned*)(ap[_i] + (size_t)(kt) * 128), (LAS unsigned*)(lds + (buf) * 32768 + wid * 1024 + _i * 8192), 16, 0, 0); } while (0)
#define GE_LD1(dst, sb) if (!(PM & 1)) asm volatile("global_load_dwordx4 %0, %1, %2" : "=v"(dst) : "v"(bvoff), "s"(sb) : "memory")
#define GE_LOAD_B(kt) do { const char* _sb = (const char*)B + (size_t)(kt) * 64 * ldb4; \
        GE_LD1(vb0, _sb); GE_LD1(vb1, _sb + ldb4); GE_LD1(vb2, _sb + 2 * ldb4); GE_LD1(vb3, _sb + 3 * ldb4); \
        GE_LD1(vb4, _sb + 4 * ldb4); GE_LD1(vb5, _sb + 5 * ldb4); GE_LD1(vb6, _sb + 6 * ldb4); GE_LD1(vb7, _sb + 7 * ldb4); } while (0)
#define GE_WAITV_B(n) asm volatile("s_waitcnt vmcnt(" #n ")" : "+v"(vb0), "+v"(vb1), "+v"(vb2), "+v"(vb3), "+v"(vb4), "+v"(vb5), "+v"(vb6), "+v"(vb7) :: "memory")
#define GE_WRITE_B(buf) do { _Pragma("unroll") for (int _i = 0; _i < 4; ++_i) { u32x4 _w; _w[0] = pk_bf16(vb0[_i], vb1[_i]); _w[1] = pk_bf16(vb2[_i], vb3[_i]); \
        _w[2] = pk_bf16(vb4[_i], vb5[_i]); _w[3] = pk_bf16(vb6[_i], vb7[_i]); \
        *(LAS u32x4*)(lds + ((_i & 1) ? bw1 : bw0) + (_i >> 1) * 128 + (buf) * 32768) = _w; } } while (0)
#define GE_KSTEP(buf, ks) do { bf16x8 Bf[4]; \
        _Pragma("unroll") for (int n = 0; n < 4; ++n) Bf[n] = *(const LAS bf16x8*)(lds + (buf) * 32768 + boff + n * 2048 + (ks) * 1024); \
        _Pragma("unroll") for (int mh = 0; mh < 2; ++mh) { bf16x8 At[4]; \
            _Pragma("unroll") for (int m = 0; m < 4; ++m) At[m] = *(const LAS bf16x8*)(lds + (buf) * 32768 + aoff + (mh * 4 + m) * 2048 + (ks) * 1024); \
            _Pragma("unroll") for (int m = 0; m < 4; ++m) { if (!RAGGED || (mh * 4 + m) < mvalid) { _Pragma("unroll") for (int n = 0; n < 4; ++n) \
                { if (PM & 4) { asm volatile("" :: "v"(At[m]), "v"(Bf[n])); } else acc[mh * 4 + m][n] = TRANS ? __builtin_amdgcn_mfma_f32_16x16x32_bf16(At[m], Bf[n], acc[mh * 4 + m][n], 0, 0, 0) : __builtin_amdgcn_mfma_f32_16x16x32_bf16(Bf[n], At[m], acc[mh * 4 + m][n], 0, 0, 0); } } } } } while (0)
    GE_GLDS_A(0, 0);
    GE_LOAD_B(0);
    GE_WAITV_B(0);
    GE_WRITE_B(0);
    GE_LOAD_B(1);
    asm volatile("s_waitcnt lgkmcnt(0)" ::: "memory");
    __builtin_amdgcn_s_barrier();
    int t = 0;
    for (; t < nt - 2; ++t) {
        const int cur = t & 1;
        GE_GLDS_A(cur ^ 1, t + 1);
        GE_KSTEP(cur, 0);
        GE_WAITV_B(4);
        GE_WRITE_B(cur ^ 1);
        GE_LOAD_B(t + 2);
        __builtin_amdgcn_sched_barrier(0);
        GE_KSTEP(cur, 1);
        asm volatile("s_waitcnt vmcnt(8) lgkmcnt(0)" ::: "memory");
        __builtin_amdgcn_s_barrier();
    }
    {
        const int cur = t & 1;
        GE_GLDS_A(cur ^ 1, t + 1);
        GE_KSTEP(cur, 0);
        GE_WAITV_B(4);
        GE_WRITE_B(cur ^ 1);
        GE_KSTEP(cur, 1);
        asm volatile("s_waitcnt vmcnt(0) lgkmcnt(0)" ::: "memory");
        __builtin_amdgcn_s_barrier();
        ++t;
    }
    {
        const int cur = t & 1;
        GE_KSTEP(cur, 0);
        GE_KSTEP(cur, 1);
        asm volatile("s_waitcnt lgkmcnt(0)" ::: "memory");
        __builtin_amdgcn_s_barrier();
    }
#undef GE_GLDS_A
#undef GE_LD1
#undef GE_LOAD_B
#undef GE_WAITV_B
#undef GE_WRITE_B
#undef GE_KSTEP
    __builtin_amdgcn_sched_barrier(0);
    { const int tz = tid_fresh(), wz = __builtin_amdgcn_readfirstlane(tz >> 6), lz = tz & 63;
      epi(acc, wz >> 2, wz & 3, lz & 15, lz >> 4); }
}

__device__ __forceinline__ int xcd_logical(int b, int G) { return (G & 7) ? b : (b & 7) * (G >> 3) + (b >> 3); }

struct ColMapDense { int c0; __device__ __forceinline__ int operator()(int rg) const { return c0 + 4 * rg; } };
struct EpiPG { u16* PG; int tok0, col0;
    __device__ __forceinline__ void operator()(const f32x4 (&acc)[8][4], int wr, int wc, int fr, int fq) const {
#pragma unroll
        for (int m = 0; m < 8; ++m) { u16* rowp = PG + (size_t)(tok0 + wr * 128 + m * 16 + fr) * 5120 + col0 + wc * 64 + 4 * fq;
#pragma unroll
            for (int n = 0; n < 4; ++n) { const f32x4 v = unperm(acc[m][n], fq & 1); u32x2 w; w[0] = pk_bf16(v[0], v[1]); w[1] = pk_bf16(v[2], v[3]); *(u32x2*)(rowp + n * 16) = w; } }
    } };
struct EpiHYT { u16* HYT; int tok0, col0;
    __device__ __forceinline__ void operator()(const f32x4 (&acc)[8][4], int wr, int wc, int fr, int fq) const {
#pragma unroll
        for (int n = 0; n < 4; ++n) { const int rho = wc * 64 + n * 16 + fr; const int col = col0 + (rho & ~3) + ((rho & 3) ^ ((rho >> 2) & 1));
            u16* colp = HYT + (size_t)col * NTOK + tok0 + wr * 128 + 4 * fq;
#pragma unroll
            for (int m = 0; m < 8; ++m) { const f32x4 v = acc[m][n]; u32x2 w; w[0] = pk_bf16(v[0], v[1]); w[1] = pk_bf16(v[2], v[3]); *(u32x2*)(colp + m * 16) = w; } }
    } };
struct EpiX1 { const float* x; float* X1; int tok0, col0;
    __device__ __forceinline__ void operator()(const f32x4 (&acc)[8][4], int wr, int wc, int fr, int fq) const {
#pragma unroll
        for (int m = 0; m < 8; ++m) { const size_t off = (size_t)(tok0 + wr * 128 + m * 16 + fr) * DM + col0 + wc * 64 + 4 * fq;
#pragma unroll
            for (int n = 0; n < 4; ++n) { const f32x4 r = *(const f32x4*)(x + off + n * 16); *(f32x4*)(X1 + off + n * 16) = r + unperm(acc[m][n], fq & 1); }
            asm volatile("" ::: "memory"); }
    } };
struct ColMapGlu { int nt; __device__ __forceinline__ int operator()(int rg) const { const int wcq = rg >> 4, n = (rg >> 2) & 3, f = rg & 3; return (n >> 1) * 2048 + nt * 128 + wcq * 32 + (n & 1) * 16 + f * 4; } };
struct EpiSwiglu { u16* HM; const float* b1; int slot0, nt, rows_valid;
    __device__ __forceinline__ void operator()(const f32x4 (&acc)[8][4], int wr, int wc, int fr, int fq) const {
        f32x4 bg[2], bl[2];
#pragma unroll
        for (int nn = 0; nn < 2; ++nn) { const int col = nt * 128 + wc * 32 + nn * 16 + 4 * fq; bg[nn] = *(const f32x4*)(b1 + col); bl[nn] = *(const f32x4*)(b1 + 2048 + col); }
#pragma unroll
        for (int m = 0; m < 8; ++m) { const int row = wr * 128 + m * 16 + fr;
            if (row < rows_valid) {
#pragma unroll
                for (int nn = 0; nn < 2; ++nn) { const f32x4 gl = unperm(acc[m][nn], fq & 1) + bg[nn], li = unperm(acc[m][nn + 2], fq & 1) + bl[nn]; float o[4];
#pragma unroll
                    for (int j = 0; j < 4; ++j) { const float gq = fminf(gl[j], 7.0f), lq = fminf(fmaxf(li[j], -7.0f), 7.0f); o[j] = gq * (1.0f / (1.0f + __expf(-1.702f * gq))) * (lq + 1.0f); }
                    u32x2 w; w[0] = pk_bf16(o[0], o[1]); w[1] = pk_bf16(o[2], o[3]);
                    *(u32x2*)(HM + (size_t)(slot0 + row) * DFF + nt * 128 + wc * 32 + nn * 16 + 4 * fq) = w; } } }
    } };
struct EpiY { u16* Y; const float* b2; int slot0, col0, rows_valid;
    __device__ __forceinline__ void operator()(const f32x4 (&acc)[8][4], int wr, int wc, int fr, int fq) const {
        f32x4 bv[4];
#pragma unroll
        for (int n = 0; n < 4; ++n) bv[n] = *(const f32x4*)(b2 + col0 + wc * 64 + n * 16 + 4 * fq);
#pragma unroll
        for (int m = 0; m < 8; ++m) { const int row = wr * 128 + m * 16 + fr;
            if (row < rows_valid) { u16* rowp = Y + (size_t)(slot0 + row) * DM + col0 + wc * 64 + 4 * fq;
#pragma unroll
                for (int n = 0; n < 4; ++n) { const f32x4 v = unperm(acc[m][n], fq & 1) + bv[n]; u32x2 w; w[0] = pk_bf16(v[0], v[1]); w[1] = pk_bf16(v[2], v[3]); *(u32x2*)(rowp + n * 16) = w; } } }
    } };
template <int NTILES>
__device__ __forceinline__ bool moe_decode(const int* __restrict__ offs, int u, int& e, int& mt, int& nt, int& slot0, int& rows) {
    int base = 0;
    for (int q = 0; q < NE; ++q) { const int o0 = offs[q], cnt = offs[q + 1] - o0, mtl = (cnt + 255) >> 8, nu = mtl * NTILES;
        if (u < base + nu) { const int ul = u - base; e = q; mt = ul % mtl; nt = ul / mtl; slot0 = o0 + mt * 256; rows = cnt - mt * 256; if (rows > 256) rows = 256; return true; }
        base += nu; }
    return false;
}


__device__ __forceinline__ int perm_col4(int rg) { const int rgl = rg & 31, t = rgl & 7; return 32 * (rgl >> 3) + 8 * (t & 3) + 4 * (t >> 2); }
__device__ __forceinline__ int perm32(int rho) { const int n = rho >> 4, i = rho & 15; return 8 * (i >> 2) + 4 * n + (i & 3); }
template <class ColMap>
__device__ __forceinline__ void convert_tile(const float* __restrict__ W, int ldb, int k0, const ColMap colmap, u16* __restrict__ dst, int tid) {
    const int wid = tid >> 6, lane = tid & 63;
    const int g = (lane & 3) + 4 * (wid >> 2), rg = (wid & 3) * 16 + (lane >> 2);
    const float* bp = W + (size_t)(k0 + 8 * g) * ldb + colmap(rg);
    f32x4 v[8];
#pragma unroll
    for (int kk = 0; kk < 8; ++kk) v[kk] = __builtin_nontemporal_load((const f32x4*)(bp + (size_t)kk * ldb));
    const int h = rg >> 5, r0 = (4 * rg) & 127;
    unsigned char* base = (unsigned char*)dst + h * 16384 + lds_byte(r0, 8 * g);
#pragma unroll
    for (int i = 0; i < 4; ++i) { u32x4 w; w[0] = pk_bf16(v[0][i], v[1][i]); w[1] = pk_bf16(v[2][i], v[3][i]); w[2] = pk_bf16(v[4][i], v[5][i]); w[3] = pk_bf16(v[6][i], v[7][i]);
        *(u32x4*)(base + i * 64) = w; }
}
typedef int i32x8 __attribute__((ext_vector_type(8)));
typedef int i32x4 __attribute__((ext_vector_type(4)));
constexpr float W8_SCALE = 32.0f;
constexpr int W8_MX = 0x7A7A7A7A;
constexpr int A8_MX = 0x7F7F7F7F;
__device__ __forceinline__ unsigned pk_fp8x4(float a, float b, float c, float d) { int p = __builtin_amdgcn_cvt_pk_fp8_f32(a, b, 0, false); p = __builtin_amdgcn_cvt_pk_fp8_f32(c, d, p, true); return (unsigned)p; }
__device__ __forceinline__ int lds_byte_b(int r, int cb) { const int st = (r >> 4) * 2 + (cb >> 6), ob = (r & 15) * 64 + (cb & 63); return st * 1024 + (ob ^ (((ob >> 9) & 1) << 5)); }
struct ConvCtx { const float* w1; const float* w2; unsigned char* W1T; unsigned char* W2T; };
__device__ __forceinline__ int conv_seq2tile(int s) {
    if (s < 16384) return (s >> 9) * 512 + (s & 15) * 32 + ((s >> 4) & 31);
    const int q = s - 16384; return 16384 + (q >> 8) * 256 + (q & 7) * 32 + ((q >> 3) & 31);
}
__device__ __forceinline__ void conv_issue(const ConvCtx& cc, int m, int wid, int lane, f32x2 (&v)[16]) {
    const int rp = 16 * wid + (lane & 15), rg = rp >> 1, p2 = (rp & 1) * 2, kg = lane >> 4;
    const float* bp; size_t ld;
    if (m < 16384) { const int e = m >> 9, nt = (m >> 5) & 15, kt = m & 31; ld = 2 * DFF; bp = cc.w1 + (size_t)e * DM * 2 * DFF + (size_t)(kt * 64 + 16 * kg) * ld + (rg >> 5) * 2048 + nt * 128 + perm_col4(rg) + p2; }
    else { const int q = m - 16384, e = q >> 8, nt = (q >> 5) & 7, kt = q & 31; ld = DM; bp = cc.w2 + (size_t)e * DFF * DM + (size_t)(kt * 64 + 16 * kg) * ld + nt * 256 + (rg >> 5) * 128 + perm_col4(rg) + p2; }
#pragma unroll
    for (int kk = 0; kk < 16; ++kk) v[kk] = __builtin_nontemporal_load((const f32x2*)(bp + (size_t)kk * ld));
}
__device__ __forceinline__ void conv_finish(const ConvCtx& cc, int m, int wid, int lane, const f32x2 (&v)[16]) {
    const int rp = 16 * wid + (lane & 15), kg = lane >> 4;
    const int kt64 = m & 31;
    unsigned char* dst = (m < 16384) ? cc.W1T + ((size_t)(m >> 5) * 16 + (kt64 >> 1)) * 32768 : cc.W2T + ((size_t)((m - 16384) >> 5) * 16 + (kt64 >> 1)) * 32768;
    unsigned char* base = dst + (rp >> 6) * 16384 + lds_byte_b((2 * rp) & 127, (kt64 & 1) * 64 + 16 * kg);
#pragma unroll
    for (int i = 0; i < 2; ++i) { u32x4 w;
#pragma unroll
        for (int q = 0; q < 4; ++q) w[q] = pk_fp8x4(v[4 * q][i] * W8_SCALE, v[4 * q + 1][i] * W8_SCALE, v[4 * q + 2][i] * W8_SCALE, v[4 * q + 3][i] * W8_SCALE);
        __builtin_nontemporal_store(w, (u32x4*)(base + i * 64)); }
}
struct ColMapGluT { int nt; __device__ __forceinline__ int operator()(int rg) const { return (rg >> 5) * 2048 + nt * 128 + perm_col4(rg); } };
struct ColMapPerm { int c0; __device__ __forceinline__ int operator()(int rg) const { return c0 + (rg >> 5) * 128 + perm_col4(rg); } };

template <bool TRANS, bool FP8 = false, class Epi>
__device__ __forceinline__ void gemm8_unit(LAS unsigned char* lds, const u16* __restrict__ A, int lda, const int* __restrict__ arows, int arow0, int rows_valid, const u16* __restrict__ Bt, int nt, const Epi epi) {
    const int tid = tid_fresh(), wid = __builtin_amdgcn_readfirstlane(tid >> 6), lane = tid & 63;
    const int wr = wid >> 2, wc = wid & 3, fr = lane & 15, fq = lane >> 4;
    unsigned aof[2][2];
#pragma unroll
    for (int h = 0; h < 2; ++h)
#pragma unroll
        for (int i = 0; i < 2; ++i) { int R, C; stage_rc(tid * 16 + i * 8192, R, C); int rr = h * 128 + R; rr = rr < rows_valid ? rr : rows_valid - 1;
            const unsigned rowid = arows ? (unsigned)arows[rr] : (unsigned)(arow0 + rr); aof[h][i] = (rowid * (unsigned)lda + (unsigned)C) * 2u; }
    const char* Ab = (const char*)A; const char* Bb = (const char*)Bt + tid * 16;
    const bool hi = rows_valid > 128;
    int mxw = W8_MX, mxa = A8_MX; asm volatile("" : "+v"(mxw), "+v"(mxa));
#define G8_SA(b, h) (((b) * 2 + (h)) * 16384)
#define G8_SB(b, h) (65536 + ((b) * 2 + (h)) * 16384)
#define G8_STA(b, h, kt) do { _Pragma("unroll") for (int _i = 0; _i < 2; ++_i) \
        __builtin_amdgcn_global_load_lds((const unsigned*)(Ab + aof[h][_i] + (size_t)(kt) * 128), (LAS unsigned*)(lds + G8_SA(b, h) + wid * 1024 + _i * 8192), 16, 0, 0); } while (0)
#define G8_STB(b, h, kt) do { _Pragma("unroll") for (int _i = 0; _i < 2; ++_i) \
        __builtin_amdgcn_global_load_lds((const unsigned*)(Bb + (size_t)(kt) * 32768 + (h) * 16384 + _i * 8192), (LAS unsigned*)(lds + G8_SB(b, h) + wid * 1024 + _i * 8192), 16, 0, 0); } while (0)
#define G8_LDA(dst, b, h) do { _Pragma("unroll") for (int m = 0; m < 4; ++m) _Pragma("unroll") for (int k = 0; k < 2; ++k) dst[m][k] = *(const LAS bf16x8*)(lds + G8_SA(b, h) + aoff + m * 2048 + k * 1024); } while (0)
#define G8_LDB(dst, b, h) do { _Pragma("unroll") for (int n = 0; n < 2; ++n) _Pragma("unroll") for (int k = 0; k < 2; ++k) dst[n][k] = *(const LAS bf16x8*)(lds + G8_SB(b, h) + boff + n * 2048 + k * 1024); } while (0)
#define G8_MMA(ai, bj, At, Bq) do { if ((ai) == 0 || hi) { __builtin_amdgcn_s_setprio(1); _Pragma("unroll") for (int m = 0; m < 4; ++m) _Pragma("unroll") for (int n = 0; n < 2; ++n) { \
        if (FP8) { const i32x4 a0 = __builtin_bit_cast(i32x4, At[m][0]), a1 = __builtin_bit_cast(i32x4, At[m][1]), b0 = __builtin_bit_cast(i32x4, Bq[n][0]), b1 = __builtin_bit_cast(i32x4, Bq[n][1]); \
            const i32x8 a8 = __builtin_shufflevector(a0, a1, 0, 1, 2, 3, 4, 5, 6, 7), b8 = __builtin_shufflevector(b0, b1, 0, 1, 2, 3, 4, 5, 6, 7); \
            asm volatile("v_mfma_scale_f32_16x16x128_f8f6f4 %0, %1, %2, %0, %3, %4 op_sel_hi:[0,0,0]" : "+v"(acc[ai][bj][m][n]) : "v"(b8), "v"(a8), "v"(mxw), "v"(mxa)); } \
        else { _Pragma("unroll") for (int k = 0; k < 2; ++k) \
            acc[ai][bj][m][n] = TRANS ? __builtin_amdgcn_mfma_f32_16x16x32_bf16(At[m][k], Bq[n][k], acc[ai][bj][m][n], 0, 0, 0) : __builtin_amdgcn_mfma_f32_16x16x32_bf16(Bq[n][k], At[m][k], acc[ai][bj][m][n], 0, 0, 0); } } \
        __builtin_amdgcn_s_setprio(0); } } while (0)
#define G8_WV(n) asm volatile("s_waitcnt vmcnt(" #n ")" ::: "memory")
#define G8_WL(n) asm volatile("s_waitcnt lgkmcnt(" #n ")" ::: "memory")
#define G8_BAR __builtin_amdgcn_s_barrier()
#define G8_SCHED __builtin_amdgcn_sched_barrier(0)
    const int aoff = lds_byte(wr * 64 + fr, fq * 8), boff = lds_byte(wc * 32 + fr, fq * 8);
    f32x4 acc[2][2][4][2];
#pragma unroll
    for (int a = 0; a < 2; ++a)
#pragma unroll
        for (int b = 0; b < 2; ++b)
#pragma unroll
            for (int m = 0; m < 4; ++m)
#pragma unroll
                for (int n = 0; n < 2; ++n) acc[a][b][m][n] = (f32x4){0.f, 0.f, 0.f, 0.f};
    bf16x8 At[4][2], B0[2][2], B1[2][2];
    G8_STB(0, 0, 0); G8_STA(0, 0, 0); G8_STB(0, 1, 0); G8_STA(0, 1, 0);
    if (wr == 1) G8_BAR;
    G8_WV(4); G8_BAR;
    G8_STB(1, 0, 1); G8_STA(1, 0, 1); G8_STB(1, 1, 1);
    G8_WV(6); G8_BAR;
    for (int t = 0; t < nt - 2; t += 2) {
        G8_LDB(B0, 0, 0); G8_SCHED; G8_LDA(At, 0, 0); G8_STA(1, 1, t + 1);
        G8_WL(8); G8_BAR; G8_WL(0); G8_MMA(0, 0, At, B0); G8_BAR; G8_SCHED;
        G8_LDB(B1, 0, 1); G8_STB(0, 0, t + 2);
        G8_BAR; G8_WL(0); G8_MMA(0, 1, At, B1); G8_BAR;
        if (hi) G8_LDA(At, 0, 1); G8_STA(0, 0, t + 2);
        G8_BAR; G8_WL(0); G8_MMA(1, 0, At, B0); G8_BAR; G8_SCHED;
        G8_STB(0, 1, t + 2);
        G8_WV(6); G8_BAR; G8_MMA(1, 1, At, B1); G8_BAR;
        G8_LDB(B0, 1, 0); G8_SCHED; G8_LDA(At, 1, 0); G8_STA(0, 1, t + 2);
        G8_WL(8); G8_BAR; G8_WL(0); G8_MMA(0, 0, At, B0); G8_BAR; G8_SCHED;
        G8_LDB(B1, 1, 1); G8_STB(1, 0, t + 3);
        G8_BAR; G8_WL(0); G8_MMA(0, 1, At, B1); G8_BAR;
        if (hi) G8_LDA(At, 1, 1); G8_STA(1, 0, t + 3);
        G8_BAR; G8_WL(0); G8_MMA(1, 0, At, B0); G8_BAR; G8_SCHED;
        G8_STB(1, 1, t + 3);
        G8_WV(6); G8_BAR; G8_MMA(1, 1, At, B1); G8_BAR;
    }
    { G8_LDB(B0, 0, 0); G8_WV(0); G8_LDA(At, 0, 0); G8_STA(1, 1, nt - 1);
      G8_BAR; G8_WL(0); G8_MMA(0, 0, At, B0); G8_BAR;
      G8_LDB(B1, 0, 1); G8_BAR; G8_WL(0); G8_MMA(0, 1, At, B1); G8_BAR;
      G8_LDA(At, 0, 1); G8_WV(4); G8_BAR; G8_WL(0); G8_MMA(1, 0, At, B0); G8_MMA(1, 1, At, B1); G8_BAR; }
    { G8_LDB(B0, 1, 0); G8_LDA(At, 1, 0); G8_WV(2); G8_BAR; G8_WL(0); G8_MMA(0, 0, At, B0); G8_BAR;
      G8_LDB(B1, 1, 1); G8_WV(0); G8_BAR; G8_WL(0); G8_MMA(0, 1, At, B1); G8_BAR;
      G8_LDA(At, 1, 1); G8_BAR; G8_WL(0); G8_MMA(1, 0, At, B0); G8_MMA(1, 1, At, B1); G8_BAR; }
    if (wr == 0) G8_BAR;
#undef G8_SA
#undef G8_SB
#undef G8_STA
#undef G8_STB
#undef G8_LDA
#undef G8_LDB
#undef G8_MMA
#undef G8_WV
#undef G8_WL
#undef G8_BAR
#undef G8_SCHED
    __builtin_amdgcn_sched_barrier(0);
    { const int tz = tid_fresh(), wz = __builtin_amdgcn_readfirstlane(tz >> 6), lz = tz & 63;
      epi(acc, wz >> 2, wz & 3, lz & 15, lz >> 4); }
}
struct G8Pre { unsigned aof[2][2]; const char* Bt; int rows; };
__device__ __forceinline__ void g8_addr(G8Pre& p, int lda, const int* __restrict__ arows, int rows_valid, const u16* __restrict__ Bt) {
    const int tid = tid_fresh();
#pragma unroll
    for (int h = 0; h < 2; ++h)
#pragma unroll
        for (int i = 0; i < 2; ++i) { int R, C; stage_rc(tid * 16 + i * 8192, R, C); int rr = h * 128 + R; rr = rr < rows_valid ? rr : rows_valid - 1;
            p.aof[h][i] = ((unsigned)arows[rr] * (unsigned)lda + (unsigned)C) * 2u; }
    p.Bt = (const char*)Bt; p.rows = rows_valid;
}
__device__ __forceinline__ void g8_issue(LAS unsigned char* lds, const char* Ab, const G8Pre& p) {
    const int tid = tid_fresh(), wid = __builtin_amdgcn_readfirstlane(tid >> 6);
    const char* Bb = p.Bt + tid * 16;
#define G8I_A(b, h, kt) do { _Pragma("unroll") for (int _i = 0; _i < 2; ++_i) \
        __builtin_amdgcn_global_load_lds((const unsigned*)(Ab + p.aof[h][_i] + (size_t)(kt) * 128), (LAS unsigned*)(lds + ((b) * 2 + (h)) * 16384 + wid * 1024 + _i * 8192), 16, 0, 0); } while (0)
#define G8I_B(b, h, kt) do { _Pragma("unroll") for (int _i = 0; _i < 2; ++_i) \
        __builtin_amdgcn_global_load_lds((const unsigned*)(Bb + (size_t)(kt) * 32768 + (h) * 16384 + _i * 8192), (LAS unsigned*)(lds + 65536 + ((b) * 2 + (h)) * 16384 + wid * 1024 + _i * 8192), 16, 0, 0); } while (0)
    G8I_B(0, 0, 0); G8I_A(0, 0, 0); G8I_B(0, 1, 0); G8I_A(0, 1, 0); G8I_B(1, 0, 1); G8I_A(1, 0, 1); G8I_B(1, 1, 1);
#undef G8I_A
#undef G8I_B
}
template <bool TRANS, bool FP8, class Epi, class Next>
__device__ __forceinline__ bool gemm8_unit_ov(LAS unsigned char* lds, const u16* __restrict__ A, const G8Pre& pre, int nt, const Epi epi, Next& next) {
    const int tid = tid_fresh(), wid = __builtin_amdgcn_readfirstlane(tid >> 6), lane = tid & 63;
    const int wr = wid >> 2, wc = wid & 3, fr = lane & 15, fq = lane >> 4;
    unsigned aof[2][2];
    aof[0][0] = pre.aof[0][0]; aof[0][1] = pre.aof[0][1]; aof[1][0] = pre.aof[1][0]; aof[1][1] = pre.aof[1][1];
    const int rows_valid = pre.rows;
    const char* Ab = (const char*)A; const char* Bb = pre.Bt + tid * 16;
    const bool hi = rows_valid > 128;
    int mxw = W8_MX, mxa = A8_MX; asm volatile("" : "+v"(mxw), "+v"(mxa));
#define G8_SA(b, h) (((b) * 2 + (h)) * 16384)
#define G8_SB(b, h) (65536 + ((b) * 2 + (h)) * 16384)
#define G8_STA(b, h, kt) do { _Pragma("unroll") for (int _i = 0; _i < 2; ++_i) \
        __builtin_amdgcn_global_load_lds((const unsigned*)(Ab + aof[h][_i] + (size_t)(kt) * 128), (LAS unsigned*)(lds + G8_SA(b, h) + wid * 1024 + _i * 8192), 16, 0, 0); } while (0)
#define G8_STB(b, h, kt) do { _Pragma("unroll") for (int _i = 0; _i < 2; ++_i) \
        __builtin_amdgcn_global_load_lds((const unsigned*)(Bb + (size_t)(kt) * 32768 + (h) * 16384 + _i * 8192), (LAS unsigned*)(lds + G8_SB(b, h) + wid * 1024 + _i * 8192), 16, 0, 0); } while (0)
#define G8_LDA(dst, b, h) do { _Pragma("unroll") for (int m = 0; m < 4; ++m) _Pragma("unroll") for (int k = 0; k < 2; ++k) dst[m][k] = *(const LAS bf16x8*)(lds + G8_SA(b, h) + aoff + m * 2048 + k * 1024); } while (0)
#define G8_LDB(dst, b, h) do { _Pragma("unroll") for (int n = 0; n < 2; ++n) _Pragma("unroll") for (int k = 0; k < 2; ++k) dst[n][k] = *(const LAS bf16x8*)(lds + G8_SB(b, h) + boff + n * 2048 + k * 1024); } while (0)
#define G8_MMA(ai, bj, At, Bq) do { if ((ai) == 0 || hi) { __builtin_amdgcn_s_setprio(1); _Pragma("unroll") for (int m = 0; m < 4; ++m) _Pragma("unroll") for (int n = 0; n < 2; ++n) { \
        if (FP8) { const i32x4 a0 = __builtin_bit_cast(i32x4, At[m][0]), a1 = __builtin_bit_cast(i32x4, At[m][1]), b0 = __builtin_bit_cast(i32x4, Bq[n][0]), b1 = __builtin_bit_cast(i32x4, Bq[n][1]); \
            const i32x8 a8 = __builtin_shufflevector(a0, a1, 0, 1, 2, 3, 4, 5, 6, 7), b8 = __builtin_shufflevector(b0, b1, 0, 1, 2, 3, 4, 5, 6, 7); \
            asm volatile("v_mfma_scale_f32_16x16x128_f8f6f4 %0, %1, %2, %0, %3, %4 op_sel_hi:[0,0,0]" : "+v"(acc[ai][bj][m][n]) : "v"(b8), "v"(a8), "v"(mxw), "v"(mxa)); } \
        else { _Pragma("unroll") for (int k = 0; k < 2; ++k) \
            acc[ai][bj][m][n] = TRANS ? __builtin_amdgcn_mfma_f32_16x16x32_bf16(At[m][k], Bq[n][k], acc[ai][bj][m][n], 0, 0, 0) : __builtin_amdgcn_mfma_f32_16x16x32_bf16(Bq[n][k], At[m][k], acc[ai][bj][m][n], 0, 0, 0); } } \
        __builtin_amdgcn_s_setprio(0); } } while (0)
#define G8_WV(n) asm volatile("s_waitcnt vmcnt(" #n ")" ::: "memory")
#define G8_WL(n) asm volatile("s_waitcnt lgkmcnt(" #n ")" ::: "memory")
#define G8_BAR __builtin_amdgcn_s_barrier()
#define G8_SCHED __builtin_amdgcn_sched_barrier(0)
    const int aoff = lds_byte(wr * 64 + fr, fq * 8), boff = lds_byte(wc * 32 + fr, fq * 8);
    f32x4 acc[2][2][4][2];
#pragma unroll
    for (int a = 0; a < 2; ++a)
#pragma unroll
        for (int b = 0; b < 2; ++b)
#pragma unroll
            for (int m = 0; m < 4; ++m)
#pragma unroll
                for (int n = 0; n < 2; ++n) acc[a][b][m][n] = (f32x4){0.f, 0.f, 0.f, 0.f};
    bf16x8 At[4][2], B0[2][2], B1[2][2];
    if (wr == 1) G8_BAR;
    G8_WV(0); G8_BAR;
    G8_BAR;
    for (int t = 0; t < nt - 2; t += 2) {
        G8_LDB(B0, 0, 0); G8_SCHED; G8_LDA(At, 0, 0); G8_STA(1, 1, t + 1);
        G8_WL(8); G8_BAR; G8_WL(0); G8_MMA(0, 0, At, B0); G8_BAR; G8_SCHED;
        G8_LDB(B1, 0, 1); G8_STB(0, 0, t + 2);
        G8_BAR; G8_WL(0); G8_MMA(0, 1, At, B1); G8_BAR;
        if (hi) G8_LDA(At, 0, 1); G8_STA(0, 0, t + 2);
        G8_BAR; G8_WL(0); G8_MMA(1, 0, At, B0); G8_BAR; G8_SCHED;
        G8_STB(0, 1, t + 2);
        G8_WV(6); G8_BAR; G8_MMA(1, 1, At, B1); G8_BAR;
        G8_LDB(B0, 1, 0); G8_SCHED; G8_LDA(At, 1, 0); G8_STA(0, 1, t + 2);
        G8_WL(8); G8_BAR; G8_WL(0); G8_MMA(0, 0, At, B0); G8_BAR; G8_SCHED;
        G8_LDB(B1, 1, 1); G8_STB(1, 0, t + 3);
        G8_BAR; G8_WL(0); G8_MMA(0, 1, At, B1); G8_BAR;
        if (hi) G8_LDA(At, 1, 1); G8_STA(1, 0, t + 3);
        G8_BAR; G8_WL(0); G8_MMA(1, 0, At, B0); G8_BAR; G8_SCHED;
        G8_STB(1, 1, t + 3);
        G8_WV(6); G8_BAR; G8_MMA(1, 1, At, B1); G8_BAR;
    }
    { G8_LDB(B0, 0, 0); G8_WV(0); G8_LDA(At, 0, 0); G8_STA(1, 1, nt - 1);
      G8_BAR; G8_WL(0); G8_MMA(0, 0, At, B0); G8_BAR;
      G8_LDB(B1, 0, 1); G8_BAR; G8_WL(0); G8_MMA(0, 1, At, B1); G8_BAR;
      G8_LDA(At, 0, 1); G8_WV(4); G8_BAR; G8_WL(0); G8_MMA(1, 0, At, B0); G8_MMA(1, 1, At, B1); G8_BAR; }
    { G8_LDB(B0, 1, 0); G8_LDA(At, 1, 0); G8_WV(2); G8_BAR; G8_WL(0); G8_MMA(0, 0, At, B0); G8_BAR;
      G8_LDB(B1, 1, 1); G8_WV(0); G8_BAR; G8_WL(0); G8_MMA(0, 1, At, B1); G8_BAR;
      G8_LDA(At, 1, 1); G8_BAR; G8_WL(0); G8_MMA(1, 0, At, B0); G8_MMA(1, 1, At, B1); G8_BAR; }
    if (wr == 0) G8_BAR;
#undef G8_SA
#undef G8_SB
#undef G8_STA
#undef G8_STB
#undef G8_LDA
#undef G8_LDB
#undef G8_MMA
#undef G8_WV
#undef G8_WL
#undef G8_BAR
#undef G8_SCHED
    __builtin_amdgcn_sched_barrier(0);
    const bool has_next = next();
    __builtin_amdgcn_sched_barrier(0);
    { const int tz = tid_fresh(), wz = __builtin_amdgcn_readfirstlane(tz >> 6), lz = tz & 63;
      epi(acc, wz >> 2, wz & 3, lz & 15, lz >> 4); }
    return has_next;
}
struct StreamUnit { const char* A; const char* Bt; int arow0, rows, a, b, c; };
template <bool TRANS, bool FP8, class Src>
__device__ __forceinline__ void gemm8_stream(LAS unsigned char* lds, unsigned lda, int nt, const Src& src) {
    const int tid = tid_fresh(), wid = __builtin_amdgcn_readfirstlane(tid >> 6), lane = tid & 63;
    const int wr = wid >> 2, wc = wid & 3, fr = lane & 15, fq = lane >> 4;
    StreamUnit cur, nxt;
    if (!src.get(0, cur)) return;
    int R0, C0, R1, C1; stage_rc(tid * 16, R0, C0); stage_rc(tid * 16 + 8192, R1, C1);
    int mxw = W8_MX, mxa = A8_MX; asm volatile("" : "+v"(mxw), "+v"(mxa));
    const int aoff = lds_byte(wr * 64 + fr, fq * 8), boff = lds_byte(wc * 32 + fr, fq * 8);
#define GS_AOF(u, h, R, C) ((unsigned)(((unsigned)((u).arow0 + (((h) * 128 + (R)) < (u).rows ? ((h) * 128 + (R)) : (u).rows - 1)) * lda + (unsigned)(C)) * 2u))
    unsigned ac00 = GS_AOF(cur, 0, R0, C0), ac01 = GS_AOF(cur, 0, R1, C1), ac10 = GS_AOF(cur, 1, R0, C0), ac11 = GS_AOF(cur, 1, R1, C1);
#define GS_SA(b, h) (((b) * 2 + (h)) * 16384)
#define GS_SB(b, h) (65536 + ((b) * 2 + (h)) * 16384)
#define GS_GL(src_, dst_) __builtin_amdgcn_global_load_lds((const unsigned*)(src_), (LAS unsigned*)(lds + (dst_)), 16, 0, 0)
#define GS_STA(b, h, base, o0, o1, kt) do { GS_GL((base) + (o0) + (size_t)(kt) * 128, GS_SA(b, h) + wid * 1024); GS_GL((base) + (o1) + (size_t)(kt) * 128, GS_SA(b, h) + wid * 1024 + 8192); } while (0)
#define GS_STB(b, h, base, kt) do { GS_GL((base) + tid * 16 + (size_t)(kt) * 32768 + (h) * 16384, GS_SB(b, h) + wid * 1024); GS_GL((base) + tid * 16 + (size_t)(kt) * 32768 + (h) * 16384 + 8192, GS_SB(b, h) + wid * 1024 + 8192); } while (0)
#define GS_LDA(dst, b, h) do { _Pragma("unroll") for (int m = 0; m < 4; ++m) _Pragma("unroll") for (int k = 0; k < 2; ++k) dst[m][k] = *(const LAS bf16x8*)(lds + GS_SA(b, h) + aoff + m * 2048 + k * 1024); } while (0)
#define GS_LDB(dst, b, h) do { _Pragma("unroll") for (int n = 0; n < 2; ++n) _Pragma("unroll") for (int k = 0; k < 2; ++k) dst[n][k] = *(const LAS bf16x8*)(lds + GS_SB(b, h) + boff + n * 2048 + k * 1024); } while (0)
#define GS_MMA(ai, bj, At, Bq) do { if ((ai) == 0 || hi) { __builtin_amdgcn_s_setprio(1); _Pragma("unroll") for (int m = 0; m < 4; ++m) _Pragma("unroll") for (int n = 0; n < 2; ++n) { \
        if (FP8) { const i32x4 a0 = __builtin_bit_cast(i32x4, At[m][0]), a1 = __builtin_bit_cast(i32x4, At[m][1]), b0 = __builtin_bit_cast(i32x4, Bq[n][0]), b1 = __builtin_bit_cast(i32x4, Bq[n][1]); \
            const i32x8 a8 = __builtin_shufflevector(a0, a1, 0, 1, 2, 3, 4, 5, 6, 7), b8 = __builtin_shufflevector(b0, b1, 0, 1, 2, 3, 4, 5, 6, 7); \
            asm volatile("v_mfma_scale_f32_16x16x128_f8f6f4 %0, %1, %2, %0, %3, %4 op_sel_hi:[0,0,0]" : "+v"(acc[ai][bj][m][n]) : "v"(b8), "v"(a8), "v"(mxw), "v"(mxa)); } \
        else { _Pragma("unroll") for (int k = 0; k < 2; ++k) \
            acc[ai][bj][m][n] = TRANS ? __builtin_amdgcn_mfma_f32_16x16x32_bf16(At[m][k], Bq[n][k], acc[ai][bj][m][n], 0, 0, 0) : __builtin_amdgcn_mfma_f32_16x16x32_bf16(Bq[n][k], At[m][k], acc[ai][bj][m][n], 0, 0, 0); } } \
        __builtin_amdgcn_s_setprio(0); } } while (0)
#define GS_WV(n) asm volatile("s_waitcnt vmcnt(" #n ")" ::: "memory")
#define GS_WL(n) asm volatile("s_waitcnt lgkmcnt(" #n ")" ::: "memory")
#define GS_BAR __builtin_amdgcn_s_barrier()
#define GS_SCHED __builtin_amdgcn_sched_barrier(0)
    f32x4 acc[2][2][4][2];
#pragma unroll
    for (int a = 0; a < 2; ++a)
#pragma unroll
        for (int b = 0; b < 2; ++b)
#pragma unroll
            for (int m = 0; m < 4; ++m)
#pragma unroll
                for (int n = 0; n < 2; ++n) acc[a][b][m][n] = (f32x4){0.f, 0.f, 0.f, 0.f};
    bf16x8 At[4][2], B0[2][2], B1[2][2];
    GS_STB(0, 0, cur.Bt, 0); GS_STA(0, 0, cur.A, ac00, ac01, 0); GS_STB(0, 1, cur.Bt, 0); GS_STA(0, 1, cur.A, ac10, ac11, 0);
    if (wr == 1) GS_BAR;
    GS_WV(4); GS_BAR;
    GS_STB(1, 0, cur.Bt, 1); GS_STA(1, 0, cur.A, ac00, ac01, 1); GS_STB(1, 1, cur.Bt, 1);
    GS_WV(6); GS_BAR;
    for (int ui = 0;; ++ui) {
        const bool has_next = src.get(ui + 1, nxt);
        if (!has_next) nxt = cur;
        const unsigned an00 = GS_AOF(nxt, 0, R0, C0), an01 = GS_AOF(nxt, 0, R1, C1), an10 = GS_AOF(nxt, 1, R0, C0), an11 = GS_AOF(nxt, 1, R1, C1);
        const bool hi = cur.rows > 128;
        for (int t = 0; t < nt; t += 2) {
            const bool last = (t == nt - 2);
            const char* xA = last ? nxt.A : cur.A; const char* xB = last ? nxt.Bt : cur.Bt;
            const unsigned x00 = last ? an00 : ac00, x01 = last ? an01 : ac01, x10 = last ? an10 : ac10, x11 = last ? an11 : ac11;
            const int k2 = last ? 0 : t + 2, k3 = k2 + 1;
            GS_LDB(B0, 0, 0); GS_SCHED; GS_LDA(At, 0, 0); GS_STA(1, 1, cur.A, ac10, ac11, t + 1);
            GS_WL(8); GS_BAR; GS_WL(0); GS_MMA(0, 0, At, B0); GS_BAR; GS_SCHED;
            GS_LDB(B1, 0, 1); GS_STB(0, 0, xB, k2);
            GS_BAR; GS_WL(0); GS_MMA(0, 1, At, B1); GS_BAR;
            if (hi) GS_LDA(At, 0, 1); GS_STA(0, 0, xA, x00, x01, k2);
            GS_BAR; GS_WL(0); GS_MMA(1, 0, At, B0); GS_BAR; GS_SCHED;
            GS_STB(0, 1, xB, k2);
            GS_WV(6); GS_BAR; GS_MMA(1, 1, At, B1); GS_BAR;
            GS_LDB(B0, 1, 0); GS_SCHED; GS_LDA(At, 1, 0); GS_STA(0, 1, xA, x10, x11, k2);
            GS_WL(8); GS_BAR; GS_WL(0); GS_MMA(0, 0, At, B0); GS_BAR; GS_SCHED;
            GS_LDB(B1, 1, 1); GS_STB(1, 0, xB, k3);
            GS_BAR; GS_WL(0); GS_MMA(0, 1, At, B1); GS_BAR;
            if (hi) GS_LDA(At, 1, 1); GS_STA(1, 0, xA, x00, x01, k3);
            GS_BAR; GS_WL(0); GS_MMA(1, 0, At, B0); GS_BAR; GS_SCHED;
            GS_STB(1, 1, xB, k3);
            GS_WV(6); GS_BAR; GS_MMA(1, 1, At, B1); GS_BAR;
        }
        __builtin_amdgcn_sched_barrier(0);
        src.epi(acc, cur, wr, wc, fr, fq);
        __builtin_amdgcn_sched_barrier(0);
        if (!has_next) break;
#pragma unroll
        for (int a = 0; a < 2; ++a)
#pragma unroll
            for (int b = 0; b < 2; ++b)
#pragma unroll
                for (int m = 0; m < 4; ++m)
#pragma unroll
                    for (int n = 0; n < 2; ++n) acc[a][b][m][n] = (f32x4){0.f, 0.f, 0.f, 0.f};
        cur = nxt; ac00 = an00; ac01 = an01; ac10 = an10; ac11 = an11;
    }
    GS_WV(0);
    if (wr == 0) GS_BAR;
    GS_BAR;
#undef GS_AOF
#undef GS_SA
#undef GS_SB
#undef GS_GL
#undef GS_STA
#undef GS_STB
#undef GS_LDA
#undef GS_LDB
#undef GS_MMA
#undef GS_WV
#undef GS_WL
#undef GS_BAR
#undef GS_SCHED
}
struct Epi8PG { u16* PG; const float* lbl; int tok0, col0;
    __device__ __forceinline__ void operator()(const f32x4 (&acc)[2][2][4][2], int wr, int wc, int fr, int fq) const {
        const int grp = col0 >> 10;
        if (grp == 0) {
#pragma unroll
            for (int ai = 0; ai < 2; ++ai)
#pragma unroll
                for (int m = 0; m < 4; ++m) { u16* rowp = PG + (size_t)(tok0 + ai * 128 + wr * 64 + m * 16 + fr) * 5120 + col0 + wc * 32 + 8 * fq;
#pragma unroll
                    for (int bj = 0; bj < 2; ++bj) { float o[8];
#pragma unroll
                        for (int n = 0; n < 2; ++n)
#pragma unroll
                            for (int q = 0; q < 4; ++q) { const float x = acc[ai][bj][m][n][q]; o[4 * n + q] = x * __builtin_amdgcn_rcpf(1.0f + __expf(-x)); }
                        *(u32x4*)(rowp + bj * 128) = (u32x4){pk_bf16(o[0], o[1]), pk_bf16(o[2], o[3]), pk_bf16(o[4], o[5]), pk_bf16(o[6], o[7])}; } }
        } else if (grp <= 2) {
            float lbv[2][8];
#pragma unroll
            for (int bj = 0; bj < 2; ++bj)
#pragma unroll
                for (int q = 0; q < 8; ++q) { const int c = (col0 & 1023) + bj * 128 + wc * 32 + 8 * fq + q; const float l0 = lbl[(grp - 1) * HGW + c], l1 = lbl[(2 + grp - 1) * HGW + c]; lbv[bj][q] = __builtin_amdgcn_rcpf(1.0f + __expf(l1 - l0)); }
#pragma unroll
            for (int ai = 0; ai < 2; ++ai)
#pragma unroll
                for (int m = 0; m < 4; ++m) { u16* rowp = PG + (size_t)(tok0 + ai * 128 + wr * 64 + m * 16 + fr) * 5120 + col0 + wc * 32 + 8 * fq;
#pragma unroll
                    for (int bj = 0; bj < 2; ++bj) { float o[8];
#pragma unroll
                        for (int n = 0; n < 2; ++n)
#pragma unroll
                            for (int q = 0; q < 4; ++q) { const float z = acc[ai][bj][m][n][q], lb = lbv[bj][4 * n + q]; const float sg = __builtin_amdgcn_rcpf(1.0f + __expf(-z)); o[4 * n + q] = __log2f(lb + (1.0f - lb) * sg); }
                        *(u32x4*)(rowp + bj * 128) = (u32x4){pk_bf16(o[0], o[1]), pk_bf16(o[2], o[3]), pk_bf16(o[4], o[5]), pk_bf16(o[6], o[7])}; } }
        } else {
#pragma unroll
            for (int ai = 0; ai < 2; ++ai)
#pragma unroll
                for (int m = 0; m < 4; ++m) { u16* rowp = PG + (size_t)(tok0 + ai * 128 + wr * 64 + m * 16 + fr) * 5120 + col0 + wc * 32 + 8 * fq;
#pragma unroll
                    for (int bj = 0; bj < 2; ++bj) { const f32x4 v0 = acc[ai][bj][m][0], v1 = acc[ai][bj][m][1];
                        *(u32x4*)(rowp + bj * 128) = (u32x4){pk_bf16(v0[0], v0[1]), pk_bf16(v0[2], v0[3]), pk_bf16(v1[0], v1[1]), pk_bf16(v1[2], v1[3])}; } }
        }
    } };
struct Epi8HYT { u16* HYT; int tok0, col0;
    __device__ __forceinline__ void operator()(const f32x4 (&acc)[2][2][4][2], int wr, int wc, int fr, int fq) const {
#pragma unroll
        for (int bj = 0; bj < 2; ++bj)
#pragma unroll
            for (int n = 0; n < 2; ++n) { u16* colp = HYT + (size_t)(col0 + bj * 128 + wc * 32 + perm32(n * 16 + fr)) * NTOK + tok0 + wr * 64 + 4 * fq;
#pragma unroll
                for (int ai = 0; ai < 2; ++ai)
#pragma unroll
                    for (int m = 0; m < 4; ++m) { const f32x4 v = acc[ai][bj][m][n]; *(u32x2*)(colp + ai * 128 + m * 16) = (u32x2){pk_bf16(v[0], v[1]), pk_bf16(v[2], v[3])}; } }
    } };
struct Epi8X1 { const float* x; float* X1; int tok0, col0;
    __device__ __forceinline__ void operator()(const f32x4 (&acc)[2][2][4][2], int wr, int wc, int fr, int fq) const {
#pragma unroll
        for (int ai = 0; ai < 2; ++ai)
#pragma unroll
            for (int m = 0; m < 4; ++m) { const size_t off = (size_t)(tok0 + ai * 128 + wr * 64 + m * 16 + fr) * DM + col0 + wc * 32 + 8 * fq;
#pragma unroll
                for (int bj = 0; bj < 2; ++bj)
#pragma unroll
                    for (int n = 0; n < 2; ++n) { const f32x4 r = *(const f32x4*)(x + off + bj * 128 + n * 4); *(f32x4*)(X1 + off + bj * 128 + n * 4) = r + acc[ai][bj][m][n]; }
                asm volatile("" ::: "memory"); }
    } };
struct Epi8Swiglu { u16* HM; const float* b1; int slot0, nt, rows_valid;
    __device__ __forceinline__ void operator()(const f32x4 (&acc)[2][2][4][2], int wr, int wc, int fr, int fq) const {
        f32x4 bg[2], bl[2];
#pragma unroll
        for (int n = 0; n < 2; ++n) { const int col = nt * 128 + wc * 32 + 8 * fq + 4 * n; bg[n] = *(const f32x4*)(b1 + col); bl[n] = *(const f32x4*)(b1 + 2048 + col); }
#pragma unroll
        for (int ai = 0; ai < 2; ++ai)
#pragma unroll
            for (int m = 0; m < 4; ++m) { const int row = ai * 128 + wr * 64 + m * 16 + fr;
                if (row < rows_valid) { float o[8];
#pragma unroll
                    for (int n = 0; n < 2; ++n) { const f32x4 gl = acc[ai][0][m][n] + bg[n], li = acc[ai][1][m][n] + bl[n];
#pragma unroll
                        for (int j = 0; j < 4; ++j) { const float gq = fminf(gl[j], 7.0f), lq = fminf(fmaxf(li[j], -7.0f), 7.0f); o[4 * n + j] = gq * __builtin_amdgcn_rcpf(1.0f + __builtin_amdgcn_exp2f(-2.45546696f * gq)) * (lq + 1.0f); } }
                    *(u32x4*)(HM + (size_t)(slot0 + row) * DFF + nt * 128 + wc * 32 + 8 * fq) = (u32x4){pk_bf16(o[0], o[1]), pk_bf16(o[2], o[3]), pk_bf16(o[4], o[5]), pk_bf16(o[6], o[7])}; } }
    } };
struct Epi8Swiglu8 { unsigned char* HM; const float* b1; int slot0, nt, rows_valid;
    __device__ __forceinline__ void operator()(const f32x4 (&acc)[2][2][4][2], int wr, int wc, int fr, int fq) const {
        f32x4 bg[2], bl[2];
#pragma unroll
        for (int n = 0; n < 2; ++n) { const int col = nt * 128 + wc * 32 + 8 * fq + 4 * n; bg[n] = *(const f32x4*)(b1 + col); bl[n] = *(const f32x4*)(b1 + 2048 + col); }
#pragma unroll
        for (int ai = 0; ai < 2; ++ai)
#pragma unroll
            for (int m = 0; m < 4; ++m) { const int row = ai * 128 + wr * 64 + m * 16 + fr;
                if (row < rows_valid) { float o[8];
#pragma unroll
                    for (int n = 0; n < 2; ++n) { const f32x4 gl = acc[ai][0][m][n] + bg[n], li = acc[ai][1][m][n] + bl[n];
#pragma unroll
                        for (int j = 0; j < 4; ++j) { const float gq = fminf(gl[j], 7.0f), lq = fminf(fmaxf(li[j], -7.0f), 7.0f); o[4 * n + j] = gq * __builtin_amdgcn_rcpf(1.0f + __builtin_amdgcn_exp2f(-2.45546696f * gq)) * (lq + 1.0f); } }
                    *(u32x2*)(HM + (size_t)(slot0 + row) * DFF + nt * 128 + wc * 32 + 8 * fq) = (u32x2){pk_fp8x4(o[0], o[1], o[2], o[3]), pk_fp8x4(o[4], o[5], o[6], o[7])}; } }
    } };
struct Epi8Y { u16* Y; const float* b2; int slot0, col0, rows_valid;
    __device__ __forceinline__ void operator()(const f32x4 (&acc)[2][2][4][2], int wr, int wc, int fr, int fq) const {
        f32x4 bv[2][2];
#pragma unroll
        for (int bj = 0; bj < 2; ++bj)
#pragma unroll
            for (int n = 0; n < 2; ++n) bv[bj][n] = *(const f32x4*)(b2 + col0 + bj * 128 + wc * 32 + 8 * fq + 4 * n);
#pragma unroll
        for (int ai = 0; ai < 2; ++ai)
#pragma unroll
            for (int m = 0; m < 4; ++m) { const int row = ai * 128 + wr * 64 + m * 16 + fr;
                if (row < rows_valid) { u16* rowp = Y + (size_t)(slot0 + row) * DM + col0 + wc * 32 + 8 * fq;
#pragma unroll
                    for (int bj = 0; bj < 2; ++bj) { const f32x4 v0 = acc[ai][bj][m][0] + bv[bj][0], v1 = acc[ai][bj][m][1] + bv[bj][1];
                        *(u32x4*)(rowp + bj * 128) = (u32x4){pk_bf16(v0[0], v0[1]), pk_bf16(v0[2], v0[3]), pk_bf16(v1[0], v1[1]), pk_bf16(v1[2], v1[3])}; } } }
    } };
struct EpiNone { __device__ __forceinline__ void operator()(const f32x4 (&acc)[2][2][4][2], int wr, int wc, int fr, int fq) const {
#pragma unroll
        for (int a = 0; a < 2; ++a)
#pragma unroll
            for (int b = 0; b < 2; ++b)
#pragma unroll
                for (int m = 0; m < 4; ++m)
#pragma unroll
                    for (int n = 0; n < 2; ++n) asm volatile("" :: "v"(acc[a][b][m][n]));
    } };

template <int NTILES>
__device__ __forceinline__ bool moe_unit_static(const LAS int* us, const LAS int* so2, int uu, int& e, int& nt, int& slot0, int& rows) {
    if (uu >= us[NE]) return false;
    int lo = 0, hi = NE;
#pragma unroll
    for (int s = 0; s < 5; ++s) { const int mid = (lo + hi) >> 1; if (us[mid] <= uu) lo = mid; else hi = mid; }
    e = lo; const int o0 = e * NTOK, cnt = so2[e], mtl = (cnt + 255) >> 8, ul = uu - us[e], mt = ul % mtl;
    e = __builtin_amdgcn_readfirstlane(e); nt = __builtin_amdgcn_readfirstlane(ul / mtl); slot0 = __builtin_amdgcn_readfirstlane(o0 + mt * 256);
    rows = cnt - mt * 256; rows = __builtin_amdgcn_readfirstlane(rows > 256 ? 256 : rows); return true;
}
struct SrcMoeB { const LAS int* us; const LAS int* so2; int c, G; const char* HM8; const char* W2T8; u16* YB; const float* b2;
    __device__ __forceinline__ bool get(int i, StreamUnit& u) const { int e, nt, slot0, rows; if (!moe_unit_static<8>(us, so2, c + i * G, e, nt, slot0, rows)) return false;
        u.A = HM8; u.Bt = W2T8 + (size_t)((e * 8 + nt) * 16) * 32768; u.arow0 = slot0; u.rows = rows; u.a = e; u.b = nt; u.c = slot0; return true; }
    __device__ __forceinline__ void epi(const f32x4 (&acc)[2][2][4][2], const StreamUnit& u, int wr, int wc, int fr, int fq) const { Epi8Y ep{YB, b2 + (size_t)u.a * DM, u.c, u.b * 256, u.rows}; ep(acc, wr, wc, fr, fq); }
};
template <bool TRANS>
struct SrcG1 { int c, G; const char* HBp; const char* WINTp; u16* PG; u16* HYT; const float* lbl;
    __device__ __forceinline__ bool get(int k, StreamUnit& su) const {
        int seen = 0;
        for (int u = c; u < 1024; u += G) { const int i = u >> 8, xx = (u >> 5) & 7, j = u & 31; const int mt = (xx & 3) * 8 + (j & 7), nt = ((xx >> 2) + 2 * i) * 4 + (j >> 3);
            if ((nt >= 20) == TRANS) { if (seen == k) { su.A = HBp; su.Bt = WINTp + (size_t)nt * 32 * 32768; su.arow0 = mt * 256; su.rows = 256; su.a = mt; su.b = nt; su.c = 0; return true; } ++seen; } }
        return false; }
    __device__ __forceinline__ void epi(const f32x4 (&acc)[2][2][4][2], const StreamUnit& u, int wr, int wc, int fr, int fq) const {
        if (TRANS) { Epi8HYT e{HYT, u.a * 256, u.b * 256 - 5120}; e(acc, wr, wc, fr, fq); } else { Epi8PG e{PG, lbl, u.a * 256, u.b * 256}; e(acc, wr, wc, fr, fq); } }
};

typedef float f32x16 __attribute__((ext_vector_type(16)));
__device__ __forceinline__ void h3_row(int m, const float* __restrict__ w1, const float* __restrict__ b1, const float* __restrict__ w2, const float* __restrict__ b2,
                                       const float* __restrict__ w3, const float* __restrict__ b3, const float* __restrict__ freq, LAS float* sc  , float* __restrict__ H3) {
    const int j = tid_fresh() & 63;
    const float tt = (float)m / (float)(SEQ - 1);
    if (j == 0) sc[0] = tt;
    if (j >= 1 && j <= 16) { const int i = j - 1; const float band = 1e-4f + (float)i * ((15.0f - 1e-4f) / 15.0f); const float ang = (2.0f * 3.14159265358979323846f / (float)SEQ) * (float)m * band; sc[1 + i] = cosf(ang); sc[17 + i] = -sinf(ang); }
    __builtin_amdgcn_wave_barrier();
    const float fr = freq[j];
    float s = b1[j];
    for (int i = 0; i < 33; ++i) s += sc[i] * w1[i * 64 + j];
    const float h1 = sinf(fr * s);
    sc[64 + j] = h1;
    __builtin_amdgcn_wave_barrier();
    s = b2[j];
    for (int i = 0; i < 64; ++i) s += sc[64 + i] * w2[i * 64 + j];
    const float h2 = sinf(fr * s);
    __builtin_amdgcn_wave_barrier();
    sc[j] = h2;
    __builtin_amdgcn_wave_barrier();
    s = b3[j];
    for (int i = 0; i < 64; ++i) s += sc[i] * w3[i * 64 + j];
    H3[(size_t)m * 64 + j] = sinf(fr * s);
    __builtin_amdgcn_wave_barrier();
}
constexpr int FR_LEN = 4128;
__device__ __forceinline__ void frgen_item(LAS unsigned char* lds, int item, const float* __restrict__ H3, const float* __restrict__ w4, u16* __restrict__ FR) {
    const int tid = tid_fresh(), wid = __builtin_amdgcn_readfirstlane(tid >> 6), lane = tid & 63, fr = lane & 15, fq = lane >> 4;
    const int oc0 = item * 8, o = oc0 >> 10;
    const int colB = o * 2048 + (fr >> 3) * 1024 + (oc0 & 1023) + (fr & 7);
    float wreg[16];
#pragma unroll
    for (int ks = 0; ks < 16; ++ks) wreg[ks] = w4[(size_t)(4 * ks + fq) * 4096 + colB];
    const int dir = fr >> 3, c = (oc0 & 1023) + (fr & 7);
    const float mind = logf(1e-2f) / 0.3f, maxd = logf(1e-2f) / 1.5f;
    const float delta = fabsf(mind + (float)c * ((maxd - mind) / 1023.0f));
    u16* r0 = FR + (size_t)((oc0 + (fr & 7)) * 2) * FR_LEN;
    LAS float* tile = (LAS float*)(lds + wid * 4608);
    const int wrow = lane >> 4, wcol = 4 * (lane & 15);
    f32x4 nx[4];
#pragma unroll
    for (int q = 0; q < 4; ++q) nx[q] = *(const f32x4*)(H3 + (size_t)wid * 1024 + q * 256 + lane * 4);
    for (int it = 0; it < 16; ++it) {
        const int mt = wid + 8 * it;
#pragma unroll
        for (int q = 0; q < 4; ++q) *(LAS f32x4*)(tile + (q * 4 + wrow) * 68 + wcol) = nx[q];
        if (it + 1 < 16) {
#pragma unroll
            for (int q = 0; q < 4; ++q) nx[q] = *(const f32x4*)(H3 + (size_t)(mt + 8) * 1024 + q * 256 + lane * 4);
        }
        f32x4 acc = {0.f, 0.f, 0.f, 0.f}, acc1 = acc;
#pragma unroll
        for (int ks = 0; ks < 16; ks += 2) { acc = __builtin_amdgcn_mfma_f32_16x16x4f32(tile[fr * 68 + 4 * ks + fq], wreg[ks], acc, 0, 0, 0);
            acc1 = __builtin_amdgcn_mfma_f32_16x16x4f32(tile[fr * 68 + 4 * (ks + 1) + fq], wreg[ks + 1], acc1, 0, 0, 0); }
        acc += acc1;
        const int m0 = mt * 16 + 4 * fq;
        float v[4];
#pragma unroll
        for (int j = 0; j < 4; ++j) v[j] = acc[j] * __expf(-((float)(m0 + j) * (1.0f / (float)(SEQ - 1))) * delta);
        if (dir == 0) {
            *(u32x2*)(r0 + 2044 - m0) = (u32x2){pk_bf16(v[3], v[2]), pk_bf16(v[1], v[0])};
#pragma unroll
            for (int j = 0; j < 4; ++j) r0[FR_LEN + 2046 - m0 - j] = (u16)(pk_bf16(v[j], 0.f) & 0xffffu);
        } else {
#pragma unroll
            for (int j = 0; j < 4; ++j) if (m0 + j >= 1) { const u16 b = (u16)(pk_bf16(v[j], 0.f) & 0xffffu); r0[2047 + m0 + j] = b; r0[FR_LEN + 2046 + m0 + j] = b; }
        }
    }
    if (tid < 8 * 34) { const int r = tid / 34, x = 4094 + tid % 34; u16* rr = FR + (size_t)((oc0 + r) * 2) * FR_LEN; if (x >= 4095) rr[x] = 0; rr[FR_LEN + x] = 0; }
    __syncthreads();
}
constexpr int HY_ZSTRIDE = 2312;
constexpr int HY_ZCH = 256 + 4 * HY_ZSTRIDE;
constexpr int HY_ZBYTES = HY_ZCH * 2;
constexpr int HY_FB = 4 * HY_ZBYTES;
constexpr int HY_FCH = 2 * FR_LEN * 2;
constexpr int HY_LDS = HY_FB + 4 * HY_FCH;

__device__ __forceinline__ void hy_load_row(LAS unsigned char* lds, int dest, int boff0, int bstride, const u16* __restrict__ row, float w0, float w1, float w2, float cb, int pl) {
#pragma unroll 2
    for (int it = 0; it < 8; ++it) {
        const int idx = pl + 128 * it, tok0 = idx * 8, b = tok0 >> 11, n0 = tok0 & 2047;
        const u32x4 raw = *(const u32x4*)(row + tok0);
        const float pm = (n0 > 0) ? bf2f(row[tok0 - 1]) : 0.f;
        const float pn = (n0 + 8 < SEQ) ? bf2f(row[tok0 + 8]) : 0.f;
        float p[10];
        p[0] = pm; p[9] = pn;
#pragma unroll
        for (int q = 0; q < 4; ++q) { p[1 + 2 * q] = bflo(raw[q]); p[2 + 2 * q] = bfhi(raw[q]); }
        float o[8];
#pragma unroll
        for (int q = 0; q < 8; ++q) o[q] = fmaf(w0, p[q], fmaf(w1, p[q + 1], fmaf(w2, p[q + 2], cb)));
        u32x4 w; w[0] = pk_bf16(o[0], o[1]); w[1] = pk_bf16(o[2], o[3]); w[2] = pk_bf16(o[4], o[5]); w[3] = pk_bf16(o[6], o[7]);
        *(LAS u32x4*)(lds + dest + (boff0 + b * bstride + n0) * 2) = w;
    }
}
__device__ __forceinline__ void hy_load_filters(LAS unsigned char* lds, int fb, const u16* __restrict__ src, int pl) {
    for (int idx = pl; idx < HY_FCH / 16; idx += 128) *(LAS u32x4*)(lds + fb + idx * 16) = *(const u32x4*)((const char*)src + idx * 16);
}
__device__ __forceinline__ void hy_mfma_loop(LAS unsigned char* lds, int zb, int fb, int hlf, int lane, f32x16 (&acc)[4], const ConvCtx& cc, int mbase, int cunit, int wid) {
    const int r = lane & 31, hh = lane >> 5, il = r >> 2, b = r & 3;
    const int bbase = zb + (256 + b * HY_ZSTRIDE + 32 * il + 8 * hh) * 2;
    const int xl = 2047 - r + 8 * hh - 1024 * hlf;
    const int abase = (r & 1) ? (fb + 2 * xl) : (fb + FR_LEN * 2 + 2 * (xl - 1));
#pragma unroll
    for (int q = 0; q < 4; ++q)
#pragma unroll
        for (int i = 0; i < 16; ++i) acc[q][i] = 0.f;
    f32x2 cvA[16], cvB[16];
    conv_issue(cc, conv_seq2tile((mbase + 0) * 256 + cunit), wid, lane, cvA);
    for (int d0 = 0; d0 < 8; ++d0) {
#pragma unroll
        for (int ks = 0; ks < 2; ++ks) {
            const int idx = d0 * 2 + ks;
            const int mcv = conv_seq2tile((mbase + idx) * 256 + cunit), mnx = conv_seq2tile((mbase + idx + 1) * 256 + cunit);
            if (idx + 1 < 16) { if (ks == 0) conv_issue(cc, mnx, wid, lane, cvB); else conv_issue(cc, mnx, wid, lane, cvA); }
            bf16x8 Bt[9];
#pragma unroll
            for (int j = 0; j < 9; ++j) Bt[j] = *(const LAS bf16x8*)(lds + bbase + 512 * j - 64 * d0 + 32 * ks);
#pragma unroll
            for (int ep = -8; ep <= 3; ++ep) {
                const LAS unsigned* ap = (const LAS unsigned*)(lds + abase - 64 * d0 - 512 * ep + 32 * ks);
                u32x4 av; av[0] = ap[0]; av[1] = ap[1]; av[2] = ap[2]; av[3] = ap[3];
                const bf16x8 a = __builtin_bit_cast(bf16x8, av);
#pragma unroll
                for (int ctl = 0; ctl < 4; ++ctl) { const int jt = ctl - ep; if (jt >= 0 && jt <= 8) acc[ctl] = __builtin_amdgcn_mfma_f32_32x32x16_bf16(a, Bt[jt], acc[ctl], 0, 0, 0); }
            }
            if (ks == 0) conv_finish(cc, mcv, wid, lane, cvA); else conv_finish(cc, mcv, wid, lane, cvB);
        }
    }
}
__device__ __forceinline__ void hy_epilogue(LAS unsigned char* lds, int zb, int gb, int hlf, int lane, const f32x16 (&acc)[4], float bias) {
    const int r = lane & 31, hh = lane >> 5, il = r >> 2, b = r & 3;
#pragma unroll
    for (int ctl = 0; ctl < 4; ++ctl) {
        const int I = 8 * (4 * hlf + ctl) + il;
#pragma unroll
        for (int q = 0; q < 4; ++q) {
            const int n4 = 32 * I + 8 * q + 4 * hh;
            LAS u32x2* zp = (LAS u32x2*)(lds + zb + (256 + b * HY_ZSTRIDE + n4) * 2);
            const u32x2 zv = *zp, gv = *(const LAS u32x2*)(lds + gb + (b * 2048 + n4) * 2);
            const float z0 = bflo(zv[0]), z1 = bfhi(zv[0]), z2 = bflo(zv[1]), z3 = bfhi(zv[1]);
            const float g0 = bflo(gv[0]), g1 = bfhi(gv[0]), g2 = bflo(gv[1]), g3 = bfhi(gv[1]);
            u32x2 o; o[0] = pk_bf16(g0 * fmaf(bias, z0, acc[ctl][4 * q + 0]), g1 * fmaf(bias, z1, acc[ctl][4 * q + 1]));
            o[1] = pk_bf16(g2 * fmaf(bias, z2, acc[ctl][4 * q + 2]), g3 * fmaf(bias, z3, acc[ctl][4 * q + 3]));
            *zp = o;
        }
    }
}
__device__ __forceinline__ void hyena_unit(LAS unsigned char* lds, int unit, const u16* __restrict__ HYT, const u16* __restrict__ FR, const float* __restrict__ cw, const float* __restrict__ cbv,
                                           const float* __restrict__ hbias, u16* __restrict__ Z2T, const ConvCtx& cc) {
    const int tid = tid_fresh(), wid = __builtin_amdgcn_readfirstlane(tid >> 6), lane = tid & 63;
    const int cs = wid & 3, hlf = wid >> 2, c = unit * 4 + cs, pl = lane + 64 * hlf;
    const int zb = cs * HY_ZBYTES, fb = HY_FB + cs * HY_FCH;
    { const u32x4 z = {0u, 0u, 0u, 0u}; for (int idx = pl; idx < HY_ZBYTES / 16; idx += 128) *(LAS u32x4*)(lds + zb + idx * 16) = z; }
    __syncthreads();
    hy_load_row(lds, zb, 256, HY_ZSTRIDE, HYT + (size_t)c * NTOK, cw[0 * 3072 + c], cw[1 * 3072 + c], cw[2 * 3072 + c], cbv[c], pl);
    f32x16 acc[4];
#pragma unroll
    for (int o = 0; o < 2; ++o) {
        hy_load_filters(lds, fb, FR + (size_t)((o * 1024 + c) * 2) * FR_LEN, pl);
        __syncthreads();
        hy_mfma_loop(lds, zb, fb, hlf, lane, acc, cc, o * 16, unit, wid);
        __syncthreads();
        const int gc = (1 + o) * 1024 + c;
        hy_load_row(lds, fb, 0, 2048, HYT + (size_t)gc * NTOK, cw[0 * 3072 + gc], cw[1 * 3072 + gc], cw[2 * 3072 + gc], cbv[gc], pl);
        __syncthreads();
        hy_epilogue(lds, zb, fb, hlf, lane, acc, hbias[o * HYW + c]);
        __syncthreads();
    }
#pragma unroll 2
    for (int it = 0; it < 8; ++it) { const int idx = pl + 128 * it, tok0 = idx * 8, b = tok0 >> 11, n0 = tok0 & 2047;
        *(u32x4*)(Z2T + (size_t)c * NTOK + tok0) = *(const LAS u32x4*)(lds + zb + (256 + b * HY_ZSTRIDE + n0) * 2); }
    __syncthreads();
}

constexpr int HG_RAWQ = 0, HG_RAWF = 16384, HG_RAWV = 32768;
constexpr int HG_QM = 36864, HG_KM = HG_QM + 17408, HG_QI = HG_KM + 17408;
constexpr int HG_KL = HG_QI + 17408;
constexpr int HG_VT = HG_KL + 18432;
constexpr int HG_P = HG_VT + 4608;
constexpr int HG_ST = HG_P + 9216;
constexpr int HG_TOT = HG_ST + 8704;
constexpr int HG_EL2 = HG_TOT + 4096;
constexpr int HG_LDS = HG_EL2 + 512;

__device__ __forceinline__ void hgrn_unit(LAS unsigned char* lds, int unit, const u16* __restrict__ PG, const float* __restrict__ lb_logits, float* __restrict__ OF, float* __restrict__ OB, const ConvCtx& cc) {
    const int tid = tid_fresh(), wid = __builtin_amdgcn_readfirstlane(tid >> 6), lane = tid & 63, fr = lane & 15, fq = lane >> 4;
    const int h = unit & 7, vq = (unit >> 3) & 3, dir = (unit >> 5) & 1, b = unit >> 6;
    const int k = tid & 127, seg = tid >> 7;
    float* __restrict__ O = dir ? OB : OF;
    for (int i = tid; i < 8704 / 16; i += 512) *(LAS u32x4*)(lds + HG_ST + i * 16) = (u32x4){0u, 0u, 0u, 0u};
    f32x4 Sacc[2];
    Sacc[0] = (f32x4){0.f, 0.f, 0.f, 0.f}; Sacc[1] = Sacc[0];
    u32x4 pq[2], pf[2], pv;
    const int colq = h * 128, colf = (1 + dir) * 1024 + h * 128, colv = 3072 + h * 128 + vq * 32;
#define HG_TOK(c, tau) ((size_t)b * SEQ + (dir ? (SEQ - 1 - 64 * (c) - (tau)) : (64 * (c) + (tau))))
#define HG_PREFETCH(c) do { _Pragma("unroll") for (int _i = 0; _i < 2; ++_i) { const int _x = tid + 512 * _i, _tau = _x >> 4, _p = _x & 15; const u16* _r = PG + HG_TOK(c, _tau) * 5120; \
            pq[_i] = *(const u32x4*)(_r + colq + _p * 8); pf[_i] = *(const u32x4*)(_r + colf + _p * 8); } \
        if (tid < 256) { const int _tau = tid >> 2, _p = tid & 3; pv = *(const u32x4*)(PG + HG_TOK(c, _tau) * 5120 + colv + _p * 8); } } while (0)
#define HG_RAW2LDS() do { _Pragma("unroll") for (int _i = 0; _i < 2; ++_i) { const int _x = tid + 512 * _i; *(LAS u32x4*)(lds + HG_RAWQ + _x * 16) = pq[_i]; *(LAS u32x4*)(lds + HG_RAWF + _x * 16) = pf[_i]; } \
        if (tid < 256) *(LAS u32x4*)(lds + HG_RAWV + tid * 16) = pv; } while (0)
    HG_PREFETCH(0);
    HG_RAW2LDS();
    HG_PREFETCH(1);
    __syncthreads();
    for (int c = 0; c < 32; ++c) {
        f32x2 cv[16];
        const int mqa = conv_seq2tile((32 + c * 2) * 256 + unit), mqb = conv_seq2tile((33 + c * 2) * 256 + unit);
        conv_issue(cc, mqa, wid, lane, cv);
        const int kp = lane, sg = wid;
        float qv0[8], qv1[8], kv0[8], kv1[8], bl0[8], bl1[8];
        { float r0 = 0.f, r1 = 0.f;
#pragma unroll
          for (int i = 0; i < 8; ++i) { const int tau = sg * 8 + i;
              const unsigned qw = *(const LAS unsigned*)(lds + HG_RAWQ + tau * 256 + kp * 4), fw = *(const LAS unsigned*)(lds + HG_RAWF + tau * 256 + kp * 4);
              const float l0 = bflo(fw), l1 = bfhi(fw);
              r0 += l0; r1 += l1; bl0[i] = r0; bl1[i] = r1; kv0[i] = 1.0f - __builtin_amdgcn_exp2f(l0); kv1[i] = 1.0f - __builtin_amdgcn_exp2f(l1); qv0[i] = bflo(qw); qv1[i] = bfhi(qw); }
          *(LAS f32x2*)(lds + HG_TOT + (sg * 128 + 2 * kp) * 4) = (f32x2){r0, r1}; }
        __syncthreads();
        { f32x2 tt[8];
#pragma unroll
          for (int q = 0; q < 8; ++q) tt[q] = *(const LAS f32x2*)(lds + HG_TOT + (q * 128 + 2 * kp) * 4);
          f32x2 pre = {0.f, 0.f};
#pragma unroll
          for (int q = 0; q < 7; ++q) if (q < sg) pre += tt[q];
          const f32x2 bref = tt[0] + tt[1] + tt[2] + tt[3], blast = bref + tt[4] + tt[5] + tt[6] + tt[7];
          const float er0 = __builtin_amdgcn_exp2f(bref[0]), er1 = __builtin_amdgcn_exp2f(bref[1]), el0 = __builtin_amdgcn_exp2f(blast[0] - bref[0]), el1 = __builtin_amdgcn_exp2f(blast[1] - bref[1]);
          if (sg == 0) *(LAS f32x2*)(lds + HG_EL2 + 2 * kp * 4) = (f32x2){__builtin_amdgcn_exp2f(blast[0]), __builtin_amdgcn_exp2f(blast[1])};
          const f32x2 dref = pre - bref;
          float kl0[8], kl1[8];
#pragma unroll
          for (int i = 0; i < 8; ++i) { const int tau = sg * 8 + i; const float x0 = dref[0] + bl0[i], x1 = dref[1] + bl1[i];
              const float qm0 = qv0[i] * __builtin_amdgcn_exp2f(x0), qm1 = qv1[i] * __builtin_amdgcn_exp2f(x1), km0 = kv0[i] * __builtin_amdgcn_exp2f(-x0), km1 = kv1[i] * __builtin_amdgcn_exp2f(-x1);
              *(LAS unsigned*)(lds + HG_QM + tau * 272 + kp * 4) = pk_bf16(qm0, qm1);
              *(LAS unsigned*)(lds + HG_KM + tau * 272 + kp * 4) = pk_bf16(km0, km1);
              *(LAS unsigned*)(lds + HG_QI + tau * 272 + kp * 4) = pk_bf16(qm0 * er0, qm1 * er1);
              kl0[i] = km0 * el0; kl1[i] = km1 * el1; }
          *(LAS u32x4*)(lds + HG_KL + (2 * kp) * 144 + sg * 16) = (u32x4){pk_bf16(kl0[0], kl0[1]), pk_bf16(kl0[2], kl0[3]), pk_bf16(kl0[4], kl0[5]), pk_bf16(kl0[6], kl0[7])};
          *(LAS u32x4*)(lds + HG_KL + (2 * kp + 1) * 144 + sg * 16) = (u32x4){pk_bf16(kl1[0], kl1[1]), pk_bf16(kl1[2], kl1[3]), pk_bf16(kl1[4], kl1[5]), pk_bf16(kl1[6], kl1[7])};
          { const int v = tid & 31, tg = tid >> 5; unsigned short e[4];
#pragma unroll
            for (int u = 0; u < 4; ++u) e[u] = *(const LAS u16*)(lds + HG_RAWV + (tg * 4 + u) * 64 + v * 2);
            *(LAS u32x2*)(lds + HG_VT + v * 144 + tg * 8) = (u32x2){(unsigned)e[0] | ((unsigned)e[1] << 16), (unsigned)e[2] | ((unsigned)e[3] << 16)}; } }
        conv_finish(cc, mqa, wid, lane, cv);
        conv_issue(cc, mqb, wid, lane, cv);
        __syncthreads();
        if (c + 1 < 32) { HG_RAW2LDS(); if (c + 2 < 32) HG_PREFETCH(c + 2); }
#pragma unroll
        for (int q = 0; q < 2; ++q) { const int idx = wid * 2 + q, ti = idx >> 2, si = idx & 3;
            f32x4 a = {0.f, 0.f, 0.f, 0.f};
            if (si <= ti) {
#pragma unroll
                for (int ks = 0; ks < 4; ++ks) { const bf16x8 ka = *(const LAS bf16x8*)(lds + HG_KM + (si * 16 + fr) * 272 + (ks * 32 + fq * 8) * 2), qb = *(const LAS bf16x8*)(lds + HG_QM + (ti * 16 + fr) * 272 + (ks * 32 + fq * 8) * 2);
                    a = __builtin_amdgcn_mfma_f32_16x16x32_bf16(ka, qb, a, 0, 0, 0); } }
            const int tau = ti * 16 + fr, s0 = si * 16 + fq * 4;
            float pvv[4];
#pragma unroll
            for (int j = 0; j < 4; ++j) pvv[j] = (si <= ti && s0 + j <= tau) ? a[j] : 0.f;
            *(LAS u32x2*)(lds + HG_P + tau * 144 + s0 * 2) = (u32x2){pk_bf16(pvv[0], pvv[1]), pk_bf16(pvv[2], pvv[3])}; }
        const int ti = wid >> 1, vi = wid & 1;
        f32x4 oacc = {0.f, 0.f, 0.f, 0.f};
#pragma unroll
        for (int ks = 0; ks < 4; ++ks) { const bf16x8 qa = *(const LAS bf16x8*)(lds + HG_QI + (ti * 16 + fr) * 272 + (ks * 32 + fq * 8) * 2), sb = *(const LAS bf16x8*)(lds + HG_ST + (vi * 16 + fr) * 272 + (ks * 32 + fq * 8) * 2);
            oacc = __builtin_amdgcn_mfma_f32_16x16x32_bf16(qa, sb, oacc, 0, 0, 0); }
        { const f32x4 e2 = *(const LAS f32x4*)(lds + HG_EL2 + (wid * 16 + fq * 4) * 4);
#pragma unroll
          for (int v2 = 0; v2 < 2; ++v2) { Sacc[v2] = Sacc[v2] * e2;
#pragma unroll
              for (int ks = 0; ks < 2; ++ks) { const bf16x8 ka = *(const LAS bf16x8*)(lds + HG_KL + (wid * 16 + fr) * 144 + (ks * 32 + fq * 8) * 2), vb = *(const LAS bf16x8*)(lds + HG_VT + (v2 * 16 + fr) * 144 + (ks * 32 + fq * 8) * 2);
                  Sacc[v2] = __builtin_amdgcn_mfma_f32_16x16x32_bf16(ka, vb, Sacc[v2], 0, 0, 0); } } }
        __syncthreads();
#pragma unroll
        for (int ks = 0; ks < 2; ++ks) { const bf16x8 pa = *(const LAS bf16x8*)(lds + HG_P + (ti * 16 + fr) * 144 + (ks * 32 + fq * 8) * 2), vb = *(const LAS bf16x8*)(lds + HG_VT + (vi * 16 + fr) * 144 + (ks * 32 + fq * 8) * 2);
            oacc = __builtin_amdgcn_mfma_f32_16x16x32_bf16(pa, vb, oacc, 0, 0, 0); }
#pragma unroll
        for (int j = 0; j < 4; ++j) { const int tau = ti * 16 + fq * 4 + j; O[HG_TOK(c, tau) * HGW + h * 128 + vq * 32 + vi * 16 + fr] = oacc[j]; }
        conv_finish(cc, mqb, wid, lane, cv);
#pragma unroll
        for (int v2 = 0; v2 < 2; ++v2) *(LAS u32x2*)(lds + HG_ST + (v2 * 16 + fr) * 272 + (wid * 16 + fq * 4) * 2) = (u32x2){pk_bf16(Sacc[v2][0], Sacc[v2][1]), pk_bf16(Sacc[v2][2], Sacc[v2][3])};
    }
    __syncthreads();
#undef HG_TOK
#undef HG_PREFETCH
#undef HG_RAW2LDS
}


#define XB_TMO      128
#define XB_XCNT(j)  (256  + 64 * (j))
#define XB_XSUB(j)  (1280 + 64 * (j))
#define XB_XGEN(j)  (2304 + 64 * (j))
#define XB_TOP      3328
#define XB_TOPGEN   3392
#define XCD_BAR_WORDS 3456
#define XB_SPIN_CAP (1u << 22)

__device__ __forceinline__ unsigned xb_ld(unsigned* p)              { return __hip_atomic_load(p, __ATOMIC_RELAXED, __HIP_MEMORY_SCOPE_AGENT); }
__device__ __forceinline__ unsigned xb_add(unsigned* p, unsigned v) { return __hip_atomic_fetch_add(p, v, __ATOMIC_RELAXED, __HIP_MEMORY_SCOPE_AGENT); }
__device__ __forceinline__ unsigned xb_xcc_id() { return (unsigned)__builtin_amdgcn_s_getreg((3 << 11) | 20) & 0xFu; }
#define XB_SPIN(cond, bar) do { unsigned _sp = 0; while (cond) { __builtin_amdgcn_s_sleep(1); \
    if ((++_sp & 255u) == 0u) { if (xb_ld(&(bar)[XB_TMO])) break; if (_sp > XB_SPIN_CAP) { atomicAdd(&(bar)[XB_TMO], 1u); break; } } } } while (0)

struct XcdBarrier {
    unsigned* bar; unsigned x;
    volatile LAS unsigned* st;
};

__device__ __forceinline__ XcdBarrier xcd_barrier_post(unsigned* bar, volatile LAS unsigned* st) {
    XcdBarrier b; b.bar = bar; b.x = xb_xcc_id(); b.st = st;
    if (threadIdx.x == 0) (void)xb_add(&bar[XB_XCNT(b.x)], 1u);
    return b;
}
__device__ __forceinline__ void xcd_barrier_complete(unsigned* bar, unsigned x, unsigned& nloc, unsigned& nx) {
    const unsigned G = gridDim.x * gridDim.y * gridDim.z;
    unsigned sum, cnt, mine, sp = 0u;
    for (;;) {
        sum = 0u; cnt = 0u; mine = 0u;
#pragma unroll
        for (unsigned j = 0; j < 16; ++j) { const unsigned c = xb_ld(&bar[XB_XCNT(j)]); sum += c; cnt += (c > 0u) ? 1u : 0u; mine = (j == x) ? c : mine; }
        if (sum == G) break;
        __builtin_amdgcn_s_sleep(1);
        if ((++sp & 255u) == 0u) { if (xb_ld(&bar[XB_TMO])) break; if (sp > XB_SPIN_CAP) { atomicAdd(&bar[XB_TMO], 1u); break; } }
    }
    nloc = mine > 0u ? mine : 1u; nx = cnt > 0u ? cnt : 1u;
}

__device__ __forceinline__ void xcd_barrier(const XcdBarrier& b) {
    asm volatile("s_waitcnt vmcnt(0)" ::: "memory");
    __syncthreads();
    if (threadIdx.x == 0) {
        unsigned* bar = b.bar;
        __builtin_amdgcn_s_waitcnt(0);
        unsigned nloc = b.st[0], nx = b.st[1];
        if (nloc == 0u) { xcd_barrier_complete(bar, b.x, nloc, nx); b.st[0] = nloc; b.st[1] = nx; }
        const unsigned old = xb_add(&bar[XB_XSUB(b.x)], 1u);
        const unsigned gen = old / nloc;
        if (old + 1u == (gen + 1u) * nloc) {
            __builtin_amdgcn_fence(__ATOMIC_RELEASE, "agent");
            asm volatile("s_waitcnt vmcnt(0)" ::: "memory");
            const unsigned og = xb_add(&bar[XB_TOP], 1u);
            const unsigned tg = og / nx;
            if (og + 1u == (tg + 1u) * nx) xb_add(&bar[XB_TOPGEN], 1u);
            else XB_SPIN(xb_ld(&bar[XB_TOPGEN]) == tg, bar);
            __builtin_amdgcn_fence(__ATOMIC_ACQUIRE, "agent");
            xb_add(&bar[XB_XGEN(b.x)], 1u);
            asm volatile("s_waitcnt vmcnt(0)" ::: "memory");
        } else {
            XB_SPIN(xb_ld(&bar[XB_XGEN(b.x)]) == gen, bar);
            __builtin_amdgcn_fence(__ATOMIC_ACQUIRE, "agent");
            asm volatile("s_waitcnt vmcnt(0)" ::: "memory");
        }
    }
    __syncthreads();
}

__device__ __forceinline__ float wave_sum(float s) {
#pragma unroll
    for (int o = 32; o >= 1; o >>= 1) s += __shfl_xor(s, o);
    return s;
}
__device__ __forceinline__ void rmsnorm_row_bf(const float* __restrict__ xr, const float* __restrict__ gain, u16* __restrict__ ob, int lane) {
    f32x4 v[8]; float s = 0.f;
#pragma unroll
    for (int j = 0; j < 8; ++j) { v[j] = *(const f32x4*)(xr + (lane + 64 * j) * 4); s += v[j][0] * v[j][0] + v[j][1] * v[j][1] + v[j][2] * v[j][2] + v[j][3] * v[j][3]; }
    s = wave_sum(s);
    const float r = rsqrtf(s * (1.0f / (float)DM) + EPS);
#pragma unroll
    for (int j = 0; j < 8; ++j) { const f32x4 g = *(const f32x4*)(gain + (lane + 64 * j) * 4); const f32x4 o = v[j] * r * g;
        *(u32x2*)(ob + (lane + 64 * j) * 4) = (u32x2){pk_bf16(o[0], o[1]), pk_bf16(o[2], o[3])}; }
}
__device__ __forceinline__ void hgrn_final_item4(int item0, int stride, const float* __restrict__ OF, const float* __restrict__ OB, const u16* __restrict__ PG, const float* __restrict__ gain, u16* __restrict__ MIXB, int lane) {
    f32x2 a[4], b[4]; unsigned gw[4];
#pragma unroll
    for (int q = 0; q < 4; ++q) { const int item = item0 + q * stride, tok = item >> 3, c = (item & 7) * 128 + 2 * lane;
        a[q] = *(const f32x2*)(OF + (size_t)tok * HGW + c); b[q] = *(const f32x2*)(OB + (size_t)tok * HGW + c); gw[q] = *(const unsigned*)(PG + (size_t)tok * 5120 + 4096 + c); }
#pragma unroll
    for (int q = 0; q < 4; ++q) { const int item = item0 + q * stride, tok = item >> 3, c = (item & 7) * 128 + 2 * lane;
        const float o0 = a[q][0] + b[q][0], o1 = a[q][1] + b[q][1];
        const float s = wave_sum(o0 * o0 + o1 * o1);
        const float r = rsqrtf(s * (1.0f / 128.0f) + EPS);
        const float g0 = bflo(gw[q]), g1 = bfhi(gw[q]);
        const f32x2 gn = *(const f32x2*)(gain + c);
        const float v0 = o0 * r * gn[0] * (g0 * __builtin_amdgcn_rcpf(1.0f + __expf(-g0))), v1 = o1 * r * gn[1] * (g1 * __builtin_amdgcn_rcpf(1.0f + __expf(-g1)));
        *(u16*)((unsigned char*)MIXB + (size_t)tok * DM + c) = (u16)(__builtin_amdgcn_cvt_pk_fp8_f32(v0, v1, 0, false) & 0xffff); }
}
__device__ __forceinline__ void hy_norm_tile(LAS unsigned char* lds, int tile_i, const u16* __restrict__ Z2T, const float* __restrict__ gain, u16* __restrict__ MIXB) {
    const int t = tid_fresh(), tok0 = tile_i * 32;
    LAS float* ssq = (LAS float*)(lds + 1024 * 80);
    if (t < 32) ssq[t] = 0.f;
    __syncthreads();
    float part[8];
#pragma unroll
    for (int q = 0; q < 8; ++q) part[q] = 0.f;
    const int ch = t & 3;
#pragma unroll
    for (int it = 0; it < 8; ++it) {
        const int c = (t >> 2) + 128 * it;
        const u32x4 v = *(const u32x4*)(Z2T + (size_t)c * NTOK + tok0 + ch * 8);
        *(LAS u32x4*)(lds + c * 80 + ch * 16) = v;
#pragma unroll
        for (int q = 0; q < 4; ++q) { const float a = bflo(v[q]), b = bfhi(v[q]); part[2 * q] += a * a; part[2 * q + 1] += b * b; }
    }
#pragma unroll
    for (int q = 0; q < 8; ++q) { float s = part[q]; s += __shfl_xor(s, 4); s += __shfl_xor(s, 8); s += __shfl_xor(s, 16); s += __shfl_xor(s, 32); part[q] = s; }
    if ((t & 63) < 4) {
#pragma unroll
        for (int q = 0; q < 8; ++q) atomicAdd((float*)(ssq + ch * 8 + q), part[q]);
    }
    __syncthreads();
    const int tt = t >> 4;
    const float r = rsqrtf(ssq[tt] * (1.0f / (float)HYW) + EPS);
#pragma unroll 2
    for (int k = 0; k < 8; ++k) {
        const int c0 = ((t & 15) + 16 * k) * 8;
        float o[8];
#pragma unroll
        for (int q = 0; q < 8; ++q) o[q] = bf2f(*(const LAS u16*)(lds + (c0 + q) * 80 + tt * 2)) * r * gain[c0 + q];
        *(u32x2*)((unsigned char*)MIXB + (size_t)(tok0 + tt) * DM + 1024 + c0) = (u32x2){pk_fp8x4(o[0], o[1], o[2], o[3]), pk_fp8x4(o[4], o[5], o[6], o[7])};
    }
    __syncthreads();
}
constexpr int RT_XSTRIDE = 2049;
constexpr int RT_PART = 16 * RT_XSTRIDE * 4;
constexpr int RT_LG = RT_PART + 8 * 16 * 32 * 4;
constexpr int RT_HIST = RT_LG + 16 * 32 * 4;
constexpr int RT_ITEMS = RT_HIST + 128;
constexpr int RT_RBASE = RT_ITEMS + 512;
constexpr int RT_END = RT_RBASE + 128;
__device__ __forceinline__ void router_tile(LAS unsigned char* lds, int tile_i, const float* __restrict__ X1, const float* __restrict__ gain, const float* __restrict__ wr, const float* __restrict__ br,
                                            unsigned char* __restrict__ XN8, float* __restrict__ TOPG, int tl2, const float (&bw)[128]) {
    const int tid = tid_fresh(), wid = __builtin_amdgcn_readfirstlane(tid >> 6), lane = tid & 63;
    const int tok0 = tile_i * 16;
    LAS float* xs = (LAS float*)lds;
#pragma unroll
    for (int q = 0; q < 2; ++q) {
        const int tl = wid * 2 + q; const size_t tok = (size_t)tok0 + tl;
        const float* xr = X1 + tok * DM;
        f32x4 v[8]; float s = 0.f;
#pragma unroll
        for (int j = 0; j < 8; ++j) { v[j] = *(const f32x4*)(xr + (lane + 64 * j) * 4); s += v[j][0] * v[j][0] + v[j][1] * v[j][1] + v[j][2] * v[j][2] + v[j][3] * v[j][3]; }
        s = wave_sum(s);
        const float r = rsqrtf(s * (1.0f / (float)DM) + EPS);
#pragma unroll
        for (int j = 0; j < 8; ++j) { const int d = (lane + 64 * j) * 4; const f32x4 g = *(const f32x4*)(gain + d); const f32x4 o = v[j] * r * g;
            xs[tl * RT_XSTRIDE + d + 0] = o[0]; xs[tl * RT_XSTRIDE + d + 1] = o[1]; xs[tl * RT_XSTRIDE + d + 2] = o[2]; xs[tl * RT_XSTRIDE + d + 3] = o[3];
            *(unsigned*)(XN8 + tok * DM + d) = pk_fp8x4(o[0], o[1], o[2], o[3]); }
    }
    __syncthreads();
    {
        const int tl = lane & 15, kk = lane >> 4;
        f32x4 a0 = {0.f, 0.f, 0.f, 0.f}, a1 = a0;
        const LAS float* xp = xs + tl * RT_XSTRIDE + wid * 256 + kk;
#pragma unroll
        for (int ks = 0; ks < 64; ++ks) { const float a = xp[ks * 4];
            a0 = __builtin_amdgcn_mfma_f32_16x16x4f32(a, bw[2 * ks], a0, 0, 0, 0); a1 = __builtin_amdgcn_mfma_f32_16x16x4f32(a, bw[2 * ks + 1], a1, 0, 0, 0); }
        LAS float* pp = (LAS float*)(lds + RT_PART) + wid * 512;
#pragma unroll
        for (int j = 0; j < 4; ++j) { pp[(kk * 4 + j) * 32 + tl] = a0[j]; pp[(kk * 4 + j) * 32 + 16 + tl] = a1[j]; }
    }
    __syncthreads();
    {   const LAS float* pp = (const LAS float*)(lds + RT_PART); float s = br[tid & 31];
#pragma unroll
        for (int w = 0; w < 8; ++w) s += pp[w * 512 + tid];
        ((LAS float*)(lds + RT_LG))[tid] = s; }
    __syncthreads();
    if (tid < 16) {
        LAS float* lg = (LAS float*)(lds + RT_LG) + tid * 32;
        int i0 = 0, i1 = 0, i2 = 0, i3 = 0; float v0, v1, v2, v3;
        { float bv = -3.0e38f; for (int j = 0; j < NE; ++j) { const float l = lg[j]; if (l > bv) { bv = l; i0 = j; } } v0 = bv; lg[i0] = -3.4e38f; }
        { float bv = -3.0e38f; for (int j = 0; j < NE; ++j) { const float l = lg[j]; if (l > bv) { bv = l; i1 = j; } } v1 = bv; lg[i1] = -3.4e38f; }
        { float bv = -3.0e38f; for (int j = 0; j < NE; ++j) { const float l = lg[j]; if (l > bv) { bv = l; i2 = j; } } v2 = bv; lg[i2] = -3.4e38f; }
        { float bv = -3.0e38f; for (int j = 0; j < NE; ++j) { const float l = lg[j]; if (l > bv) { bv = l; i3 = j; } } v3 = bv; lg[i3] = -3.4e38f; }
        const float e1 = __expf(v1 - v0), e2 = __expf(v2 - v0), e3 = __expf(v3 - v0), inv = 1.0f / (1.0f + e1 + e2 + e3);
        const int tok = tok0 + tid;
        *(f32x4*)(TOPG + tok * 4) = (f32x4){inv, e1 * inv, e2 * inv, e3 * inv};
        LAS int* hist = (LAS int*)(lds + RT_HIST);
        const int p0 = atomicAdd((int*)(hist + i0), 1), p1 = atomicAdd((int*)(hist + i1), 1), p2 = atomicAdd((int*)(hist + i2), 1), p3 = atomicAdd((int*)(hist + i3), 1);
        *(LAS u32x4*)(lds + RT_ITEMS + (tl2 * 16 + tid) * 16) = (u32x4){(unsigned)((i0 << 16) | p0), (unsigned)((i1 << 16) | p1), (unsigned)((i2 << 16) | p2), (unsigned)((i3 << 16) | p3)};
    }
    __syncthreads();
}
__device__ __forceinline__ void combine_row(int tok, const float* __restrict__ X1, const u16* __restrict__ YB, const int* __restrict__ SOF, const float* __restrict__ TOPG, const float* __restrict__ gain, float* __restrict__ out, int lane) {
    const int4 sl = *(const int4*)(SOF + tok * 4); const f32x4 g = *(const f32x4*)(TOPG + tok * 4);
    const u16* y0 = YB + (size_t)sl.x * DM; const u16* y1 = YB + (size_t)sl.y * DM; const u16* y2 = YB + (size_t)sl.z * DM; const u16* y3 = YB + (size_t)sl.w * DM;
    f32x4 v[8]; float s = 0.f;
#pragma unroll
    for (int j = 0; j < 8; ++j) { const int d = (lane + 64 * j) * 4;
        f32x4 a = *(const f32x4*)(X1 + (size_t)tok * DM + d);
        const u32x2 q0 = *(const u32x2*)(y0 + d), q1 = *(const u32x2*)(y1 + d), q2 = *(const u32x2*)(y2 + d), q3 = *(const u32x2*)(y3 + d);
        a[0] += g[0] * bflo(q0[0]) + g[1] * bflo(q1[0]) + g[2] * bflo(q2[0]) + g[3] * bflo(q3[0]);
        a[1] += g[0] * bfhi(q0[0]) + g[1] * bfhi(q1[0]) + g[2] * bfhi(q2[0]) + g[3] * bfhi(q3[0]);
        a[2] += g[0] * bflo(q0[1]) + g[1] * bflo(q1[1]) + g[2] * bflo(q2[1]) + g[3] * bflo(q3[1]);
        a[3] += g[0] * bfhi(q0[1]) + g[1] * bfhi(q1[1]) + g[2] * bfhi(q2[1]) + g[3] * bfhi(q3[1]);
        v[j] = a; s += a[0] * a[0] + a[1] * a[1] + a[2] * a[2] + a[3] * a[3]; }
    s = wave_sum(s);
    const float r = rsqrtf(s * (1.0f / (float)DM) + EPS);
#pragma unroll
    for (int j = 0; j < 8; ++j) { const int d = (lane + 64 * j) * 4; const f32x4 gn = *(const f32x4*)(gain + d); *(f32x4*)(out + (size_t)tok * DM + d) = v[j] * r * gn; }
}

__device__ __forceinline__ void combine_row2(int tokA, int tokB, const float* __restrict__ X1, const u16* __restrict__ YB, const int* __restrict__ SOF, const float* __restrict__ TOPG, const float* __restrict__ gain, float* __restrict__ out, int lane) {
    const int4 slA = *(const int4*)(SOF + tokA * 4), slB = *(const int4*)(SOF + tokB * 4); const f32x4 gA = *(const f32x4*)(TOPG + tokA * 4), gB = *(const f32x4*)(TOPG + tokB * 4);
    const u16* yA0 = YB + (size_t)slA.x * DM; const u16* yA1 = YB + (size_t)slA.y * DM; const u16* yA2 = YB + (size_t)slA.z * DM; const u16* yA3 = YB + (size_t)slA.w * DM;
    const u16* yB0 = YB + (size_t)slB.x * DM; const u16* yB1 = YB + (size_t)slB.y * DM; const u16* yB2 = YB + (size_t)slB.z * DM; const u16* yB3 = YB + (size_t)slB.w * DM;
    f32x4 vA[8], vB[8]; float sA = 0.f, sB = 0.f;
#pragma unroll
    for (int j = 0; j < 8; ++j) { const int d = (lane + 64 * j) * 4;
        f32x4 a = *(const f32x4*)(X1 + (size_t)tokA * DM + d), b = *(const f32x4*)(X1 + (size_t)tokB * DM + d);
        const u32x2 p0 = *(const u32x2*)(yA0 + d), p1 = *(const u32x2*)(yA1 + d), p2 = *(const u32x2*)(yA2 + d), p3 = *(const u32x2*)(yA3 + d);
        const u32x2 q0 = *(const u32x2*)(yB0 + d), q1 = *(const u32x2*)(yB1 + d), q2 = *(const u32x2*)(yB2 + d), q3 = *(const u32x2*)(yB3 + d);
        a[0] += gA[0] * bflo(p0[0]) + gA[1] * bflo(p1[0]) + gA[2] * bflo(p2[0]) + gA[3] * bflo(p3[0]);
        a[1] += gA[0] * bfhi(p0[0]) + gA[1] * bfhi(p1[0]) + gA[2] * bfhi(p2[0]) + gA[3] * bfhi(p3[0]);
        a[2] += gA[0] * bflo(p0[1]) + gA[1] * bflo(p1[1]) + gA[2] * bflo(p2[1]) + gA[3] * bflo(p3[1]);
        a[3] += gA[0] * bfhi(p0[1]) + gA[1] * bfhi(p1[1]) + gA[2] * bfhi(p2[1]) + gA[3] * bfhi(p3[1]);
        b[0] += gB[0] * bflo(q0[0]) + gB[1] * bflo(q1[0]) + gB[2] * bflo(q2[0]) + gB[3] * bflo(q3[0]);
        b[1] += gB[0] * bfhi(q0[0]) + gB[1] * bfhi(q1[0]) + gB[2] * bfhi(q2[0]) + gB[3] * bfhi(q3[0]);
        b[2] += gB[0] * bflo(q0[1]) + gB[1] * bflo(q1[1]) + gB[2] * bflo(q2[1]) + gB[3] * bflo(q3[1]);
        b[3] += gB[0] * bfhi(q0[1]) + gB[1] * bfhi(q1[1]) + gB[2] * bfhi(q2[1]) + gB[3] * bfhi(q3[1]);
        vA[j] = a; vB[j] = b; sA += a[0] * a[0] + a[1] * a[1] + a[2] * a[2] + a[3] * a[3]; sB += b[0] * b[0] + b[1] * b[1] + b[2] * b[2] + b[3] * b[3]; }
    sA = wave_sum(sA); sB = wave_sum(sB);
    const float rA = rsqrtf(sA * (1.0f / (float)DM) + EPS), rB = rsqrtf(sB * (1.0f / (float)DM) + EPS);
#pragma unroll
    for (int j = 0; j < 8; ++j) { const int d = (lane + 64 * j) * 4; const f32x4 gn = *(const f32x4*)(gain + d);
        *(f32x4*)(out + (size_t)tokA * DM + d) = vA[j] * rA * gn; *(f32x4*)(out + (size_t)tokB * DM + d) = vB[j] * rB * gn; }
}
#ifndef REP_P9
#define REP_P9 1
#endif
#ifndef REP_P3
#define REP_P3 1
#endif
#ifndef REP_FR
#define REP_FR 1
#endif
#ifndef REP_P0
#define REP_P0 1
#endif
#ifndef REP_CONV
#define REP_CONV 1
#endif
#ifndef REP_GEMM1
#define REP_GEMM1 1
#endif
#ifndef REP_HY
#define REP_HY 1
#endif
#ifndef REP_HG
#define REP_HG 1
#endif
#ifndef REP_MOEA
#define REP_MOEA 1
#endif
#ifndef REP_MOEB
#define REP_MOEB 1
#endif
#ifndef REP_WOUT
#define REP_WOUT 1
#endif
struct MegaP {
    const float *x, *norm_mix_gain, *w_in, *lb_logits, *hgrn_norm_gain, *hy_conv_w, *hy_conv_b, *fw1, *fb1, *fw2, *fb2, *fw3, *fb3, *fw4, *ffreq, *hy_bias, *hy_norm_gain, *w_out,
        *norm_ffn_gain, *w_router, *b_router, *moe_w1, *moe_b1, *moe_w2, *moe_b2, *final_gain;
    float* out; unsigned char* ws;
};
constexpr int MEGA_XB = RT_END;
constexpr int MEGA_LDS = RT_END + 64 + 384;
static_assert(MEGA_LDS >= HY_LDS + 64 && MEGA_LDS >= HG_LDS + 64 && MEGA_LDS >= GEMM_LDS + 64, "LDS");

__global__ void __launch_bounds__(512, 2) k_mega(const MegaP p_arg) {
    extern __shared__ __attribute__((aligned(16))) unsigned char shm[];
    LAS unsigned char* lds = (LAS unsigned char*)shm;
    const int tid = threadIdx.x, wid = __builtin_amdgcn_readfirstlane(tid >> 6), lane = tid & 63;
    const int G = gridDim.x, bid = blockIdx.x, c = xcd_logical(bid, G);
#define PHASE_ARGS() const MegaP __attribute__((address_space(4)))* pq_ = (const MegaP __attribute__((address_space(4)))*)__builtin_amdgcn_kernarg_segment_ptr(); asm volatile("" : "+s"(pq_)); unsigned char* ws = pq_->ws; (void)ws
    unsigned char* ws0; { PHASE_ARGS(); ws0 = ws; }
#define counts ((int*)(ws + WS_CTL))
#define cursor ((int*)(ws + WS_CTL + 4096))
#define offs ((int*)(ws + WS_CTL + 8192))
#define barw ((unsigned*)(ws + WS_CTL + 16384))
#define HB ((u16*)(ws + WS_HB))
#define PG ((u16*)(ws + WS_PG))
#define HYT ((u16*)(ws + WS_HYT))
#define MIXB ((u16*)(ws + WS_MIXB))
#define XNB ((u16*)(ws + WS_XNB))
#define HMB ((u16*)(ws + WS_HMS))
#define YB ((u16*)(ws + WS_YS))
#define H3 ((float*)(ws + WS_H3))
#define FR ((u16*)(ws + WS_FR))
#define Z2T ((u16*)(ws + WS_Z2T))
#define OF ((float*)(ws + WS_OF))
#define OB ((float*)(ws + WS_OB))
#define X1 ((float*)(ws + WS_X1))
#define TOPI ((int*)(ws + WS_TOPI))
#define TOPG ((float*)(ws + WS_TOPG))
#define STOK ((int*)(ws + WS_STOKS))
#define SOF ((int*)(ws + WS_SOF))
#define WINT ((u16*)(ws + WS_WINT))
#define WOUTT ((u16*)(ws + WS_WOUTT))
#define W1T ((u16*)(ws + WS_W1T))
#define W2T ((u16*)(ws + WS_W2T))
    if (tid == 0) *(LAS u32x4*)(lds + MEGA_XB) = (u32x4){0u, 0u, 0u, 0u};
    __syncthreads();
    XcdBarrier bar = xcd_barrier_post((unsigned*)(ws0 + WS_CTL + 16384), (volatile LAS unsigned*)(lds + MEGA_XB));

    {
        PHASE_ARGS();
    for (int rep = 0; rep < REP_P0; ++rep) {
    for (int row = bid * 8 + wid; row < NTOK; row += G * 8) rmsnorm_row_bf(pq_->x + (size_t)row * DM, pq_->norm_mix_gain, HB + (size_t)row * DM, lane);
    for (int m = bid * 8 + wid; m < SEQ; m += G * 8) h3_row(m, pq_->fw1, pq_->fb1, pq_->fw2, pq_->fb2, pq_->fw3, pq_->fb3, pq_->ffreq, (LAS float*)(lds + wid * 512), H3); }
    for (int rep = 0; rep < REP_CONV; ++rep)
    for (int id = bid; id < 1024 + 256; id += G) {
        const int tz = tid_fresh();
        if (id < 1024) { const int nt = id >> 5, kt = id & 31; convert_tile(pq_->w_in, DIN, kt * 64, ColMapPerm{nt * 256}, WINT + (size_t)id * 16384, tz); }
        else { const int q = id - 1024; const ConvCtx cw{nullptr, pq_->w_out, nullptr, (unsigned char*)WOUTT};
            f32x2 cv[16]; conv_issue(cw, 16384 + q, tz >> 6, tz & 63, cv); conv_finish(cw, 16384 + q, tz >> 6, tz & 63, cv); }
    }
    }
    xcd_barrier(bar);
    {
        PHASE_ARGS();
    for (int rep = 0; rep < REP_FR; ++rep)
    for (int item = bid; item < 256; item += G) frgen_item(lds, item, H3, pq_->fw4, FR);
    { SrcG1<false> s0{c, G, (const char*)HB, (const char*)WINT, PG, HYT, pq_->lb_logits}; gemm8_stream<false, false>(lds, DM, 32, s0);
      SrcG1<true> s1{c, G, (const char*)HB, (const char*)WINT, PG, HYT, pq_->lb_logits}; gemm8_stream<true, false>(lds, DM, 32, s1); }
#ifdef PROBE_NOEPI
    for (int u = c; u < 1024; u += G) {
        const int i = u >> 8, xx = (u >> 5) & 7, j = u & 31;
        const int mt = (xx & 3) * 8 + (j & 7), nt = ((xx >> 2) + 2 * i) * 4 + (j >> 3);
        const u16* bt = WINT + (size_t)nt * 32 * 16384;
        EpiNone e{}; if (nt < 20) gemm8_unit<false>(lds, HB, DM, nullptr, mt * 256, 256, bt, 32, e); else gemm8_unit<true>(lds, HB, DM, nullptr, mt * 256, 256, bt, 32, e);
    }
#endif
    }
    xcd_barrier(bar);
    {
        PHASE_ARGS();
    for (int rep = 0; rep < REP_HY; ++rep)
    for (int u = bid; u < 256; u += G) hyena_unit(lds, u, HYT, FR, pq_->hy_conv_w, pq_->hy_conv_b, pq_->hy_bias, Z2T, ConvCtx{pq_->moe_w1, pq_->moe_w2, (unsigned char*)W1T, (unsigned char*)W2T});
    for (int rep = 0; rep < REP_HG; ++rep)
    for (int u = bid; u < 256; u += G) hgrn_unit(lds, u, PG, pq_->lb_logits, OF, OB, ConvCtx{pq_->moe_w1, pq_->moe_w2, (unsigned char*)W1T, (unsigned char*)W2T});
    }
    xcd_barrier(bar);
    {
        PHASE_ARGS();
    for (int rep = 0; rep < REP_P3; ++rep) {
    for (int it = bid * 8 + wid; it < NTOK * HGH; it += G * 8 * 4) hgrn_final_item4(it, G * 8, OF, OB, PG, pq_->hgrn_norm_gain, MIXB, lane);
    for (int t = bid; t < NTOK / 32; t += G) hy_norm_tile(lds, t, Z2T, pq_->hy_norm_gain, MIXB); }
    }
    xcd_barrier(bar);
    {
        PHASE_ARGS();
    for (int u = c; u < 256; u += G) {
        const int xx = u >> 5, j = u & 31;
        const int mt = (xx >> 1) * 8 + (j & 7), nt = (xx & 1) * 4 + (j >> 3);
        Epi8X1 e{pq_->x, X1, mt * 256, nt * 256};
        gemm8_unit<false, true>(lds, MIXB, DM / 2, nullptr, mt * 256, 256, WOUTT + (size_t)nt * 16 * 16384, 16, e);
    }
    }
    xcd_barrier(bar);
    {
        PHASE_ARGS();
    if (tid < NE) *(LAS int*)(lds + RT_HIST + tid * 4) = 0;
    __syncthreads();
    float bw[128];
    { const float* wp = pq_->w_router + (size_t)(wid * 256 + (lane >> 4)) * NE + (lane & 15);
#pragma unroll
      for (int ks = 0; ks < 64; ++ks) { bw[2 * ks] = wp[(size_t)ks * 4 * NE]; bw[2 * ks + 1] = wp[(size_t)ks * 4 * NE + 16]; } }
    for (int t0 = bid; t0 < NTOK / 16; t0 += 2 * G) {
        const int t1 = t0 + G, ntl = (t1 < NTOK / 16) ? 2 : 1;
        router_tile(lds, t0, X1, pq_->norm_ffn_gain, pq_->w_router, pq_->b_router, (unsigned char*)XNB, TOPG, 0, bw);
        if (ntl == 2) router_tile(lds, t1, X1, pq_->norm_ffn_gain, pq_->w_router, pq_->b_router, (unsigned char*)XNB, TOPG, 1, bw);
        const int tq = tid_fresh();
        if (tq < NE) { const int n = *(const LAS int*)(lds + RT_HIST + tq * 4); *(LAS int*)(lds + RT_RBASE + tq * 4) = n ? atomicAdd(&cursor[tq * 32], n) : 0; *(LAS int*)(lds + RT_HIST + tq * 4) = 0; }
        __syncthreads();
        if (tq < ntl * 64) { const int it = *(const LAS int*)(lds + RT_ITEMS + tq * 4), e = it >> 16, tok = ((tq >> 6) ? t1 : t0) * 16 + ((tq >> 2) & 15);
            const int slot = e * NTOK + *(const LAS int*)(lds + RT_RBASE + e * 4) + (it & 0xffff); STOK[slot] = tok; SOF[tok * 4 + (tq & 3)] = slot; }
        __syncthreads();
    }
    }
    xcd_barrier(bar);
    {
        PHASE_ARGS();
    {
        LAS int* us = (LAS int*)(lds + MEGA_XB + 64); LAS int* so2 = us + 40;
        if (tid < NE) so2[tid] = __hip_atomic_load(&cursor[tid * 32], __ATOMIC_RELAXED, __HIP_MEMORY_SCOPE_AGENT);
        __syncthreads();
        if (tid == 0) { int a = 0; for (int e = 0; e < NE; ++e) { us[e] = a; a += ((so2[e] + 255) >> 8) * 16; } us[NE] = a; }
        __syncthreads();
    }
    {
        LAS int* qs = (LAS int*)(lds + MEGA_XB + 32); LAS int* us = (LAS int*)(lds + MEGA_XB + 64); LAS int* so2 = us + 40;
        int* qctr = (int*)(ws + WS_CTL + 12288 + (bid & 7) * 128);
        int tk_next = 0;
        auto decode = [&](int tkv, int& e, int& nt, int& slot0, int& rows) -> bool {
            const int tq = tid_fresh();
            if (tq == 0) { qs[0] = tkv; qs[1] = -1; }
            __syncthreads();
            const int tk = qs[0];
            const int u = 256 * (tk >> 5) + 32 * (bid & 7) + (tk & 31);
            if (tq < NE) { const int u0 = us[tq], u1 = us[tq + 1]; if (u >= u0 && u < u1) { const int o0 = tq * NTOK, cnt = so2[tq], mtl = (cnt + 255) >> 8, ul = u - u0, mt = ul % mtl;
                int rw = cnt - mt * 256; rw = rw > 256 ? 256 : rw; qs[1] = tq; qs[2] = ul / mtl; qs[3] = o0 + mt * 256; qs[4] = rw; } }
            __syncthreads();
            e = qs[1]; nt = qs[2]; slot0 = qs[3]; rows = qs[4];
            __syncthreads();
            return e >= 0;
        };
        if (tid == 0) tk_next = atomicAdd(qctr, 1);
        int e, nt, slot0, rows;
        if (decode(tk_next, e, nt, slot0, rows)) {
            if (tid == 0) tk_next = atomicAdd(qctr, 1);
            G8Pre cur, nxp;
            g8_addr(cur, DM / 2, STOK + slot0, rows, W1T + (size_t)(e * 16 + nt) * 16 * 16384);
            g8_issue(lds, (const char*)XNB, cur);
            for (;;) {
                int e2 = -1, nt2 = 0, slot2 = 0, rows2 = 0;
                auto next = [&]() -> bool {
                    if (!decode(tk_next, e2, nt2, slot2, rows2)) return false;
                    if (tid_fresh() == 0) tk_next = atomicAdd(qctr, 1);
                    g8_addr(nxp, DM / 2, STOK + slot2, rows2, W1T + (size_t)(e2 * 16 + nt2) * 16 * 16384);
                    g8_issue(lds, (const char*)XNB, nxp);
                    return true; };
                Epi8Swiglu8 ep{(unsigned char*)HMB, pq_->moe_b1 + (size_t)e * 2 * DFF, slot0, nt, rows};
                const bool more = gemm8_unit_ov<false, true>(lds, XNB, cur, 16, ep, next);
                if (!more) break;
                cur = nxp; e = e2; nt = nt2; slot0 = slot2; rows = rows2;
            }
        }
    }
    }
    xcd_barrier(bar);
    {
        PHASE_ARGS();
    {
        LAS int* us = (LAS int*)(lds + MEGA_XB + 64); LAS int* so2 = us + 40;
        if (tid < NE) so2[tid] = __hip_atomic_load(&cursor[tid * 32], __ATOMIC_RELAXED, __HIP_MEMORY_SCOPE_AGENT);
        __syncthreads();
        if (tid == 0) { int a = 0; for (int e = 0; e < NE; ++e) { us[e] = a; a += ((so2[e] + 255) >> 8) * 8; } us[NE] = a; }
        __syncthreads();
    }
    {
        const LAS int* us = (const LAS int*)(lds + MEGA_XB + 64); const LAS int* so2 = us + 40;
        SrcMoeB src{us, so2, c, G, (const char*)HMB, (const char*)W2T, YB, pq_->moe_b2};
        gemm8_stream<false, true>(lds, DFF / 2, 16, src);
    }
    }
    xcd_barrier(bar);
    {
        PHASE_ARGS();
    for (int rep = 0; rep < REP_P9; ++rep)
    for (int tok = bid * 8 + wid; tok < NTOK; tok += G * 8) combine_row(tok, X1, YB, SOF, TOPG, pq_->final_gain, pq_->out, lane);
    }
}
#undef counts
#undef cursor
#undef offs
#undef barw
#undef HB
#undef PG
#undef HYT
#undef MIXB
#undef XNB
#undef HMB
#undef YB
#undef H3
#undef FR
#undef Z2T
#undef OF
#undef OB
#undef X1
#undef TOPI
#undef TOPG
#undef STOK
#undef SOF
#undef WINT
#undef WOUTT
#undef W1T
#undef W2T

extern "C" void kernel_launch(void* const* d_in, const int* in_sizes, int n_in, void* d_out, int out_size, void* d_ws, size_t ws_size, hipStream_t stream) {
    if (n_in < 26 || ws_size < WS_END2) return;
    MegaP p{};
    const float** pp = (const float**)&p;
    for (int i = 0; i < 26; ++i) pp[i] = (const float*)d_in[i];
    p.out = (float*)d_out; p.ws = (unsigned char*)d_ws;
    static int grid = 0;
    if (!grid) {
        int dev = 0, cus = 0, per_cu = 0;
        (void)hipGetDevice(&dev);
        (void)hipDeviceGetAttribute(&cus, hipDeviceAttributeMultiprocessorCount, dev);
        (void)hipFuncSetAttribute((const void*)k_mega, hipFuncAttributeMaxDynamicSharedMemorySize, MEGA_LDS);
        (void)hipOccupancyMaxActiveBlocksPerMultiprocessor(&per_cu, (const void*)k_mega, 512, MEGA_LDS);
        if (per_cu < 1) per_cu = 1;
        grid = cus * 1;
        if (grid > 256) grid = 256;
        grid &= ~7;
        if (grid < 8) grid = 8;
    }
    (void)hipMemsetAsync((char*)d_ws + WS_CTL, 0, 65536, stream);
    hipLaunchKernelGGL(k_mega, dim3(grid), dim3(512), MEGA_LDS, stream, p);
}
```

```cpp
#include <hip/hip_runtime.h>
#include <stdint.h>

constexpr int BATCH = 4, SEQ = 2048, DM = 2048, NTOK = BATCH * SEQ;
constexpr int HGW = 1024, HGD = 128, HGH = 8;
constexpr int HYW = 1024;
constexpr int DIN = 8192;
constexpr int NE = 32, TOPK = 4, DFF = 2048;
constexpr int NSLOT = NTOK * TOPK;
constexpr float EPS = 1e-5f;

constexpr size_t MB = 1024ull * 1024ull;
constexpr size_t WS_CTL = 0;
constexpr size_t WS_HB = 1 * MB;
constexpr size_t WS_PG = WS_HB + 32 * MB;
constexpr size_t WS_HYT = WS_PG + 80 * MB;
constexpr size_t WS_MIXB = WS_HYT + 48 * MB;
constexpr size_t WS_XNB = WS_MIXB + 32 * MB;
constexpr size_t WS_HMB = WS_XNB + 32 * MB;
constexpr size_t WS_YB = WS_HMB + 128 * MB;
constexpr size_t WS_H3 = WS_YB + 128 * MB;
constexpr size_t WS_FR = WS_H3 + 1 * MB;
constexpr size_t WS_Z2T = WS_FR + 34 * MB;
constexpr size_t WS_OF = WS_Z2T + 16 * MB;
constexpr size_t WS_OB = WS_OF + 32 * MB;
constexpr size_t WS_X1 = WS_OB + 32 * MB;
constexpr size_t WS_TOPI = WS_X1 + 64 * MB;
constexpr size_t WS_TOPG = WS_TOPI + 1 * MB;
constexpr size_t WS_STOK = WS_TOPG + 1 * MB;
constexpr size_t WS_SOF = WS_STOK + 1 * MB;
constexpr size_t WS_WINT = WS_SOF + 1 * MB;
constexpr size_t WS_WOUTT = WS_WINT + 32 * MB;
constexpr size_t WS_W1T = WS_WOUTT + 8 * MB;
constexpr size_t WS_W2T = WS_W1T + 512 * MB;
constexpr size_t WS_HMS = WS_W2T + 256 * MB;
constexpr size_t WS_YS = WS_HMS + 512 * MB;
constexpr size_t WS_STOKS = WS_YS + 1024 * MB;
constexpr size_t WS_END2 = WS_STOKS + 1 * MB;

typedef short bf16x8 __attribute__((ext_vector_type(8)));
typedef float f32x4 __attribute__((ext_vector_type(4)));
typedef float f32x2 __attribute__((ext_vector_type(2)));
typedef unsigned u32x4 __attribute__((ext_vector_type(4)));
typedef unsigned u32x2 __attribute__((ext_vector_type(2)));
typedef unsigned short u16;
#define LAS __attribute__((address_space(3)))

__device__ __forceinline__ unsigned pk_bf16(float lo, float hi) {
    typedef __bf16 bf2 __attribute__((ext_vector_type(2)));
    const f32x2 v = {lo, hi};
    const bf2 r = __builtin_convertvector(v, bf2);
    return __builtin_bit_cast(unsigned, r);
}
__device__ __forceinline__ float bf2f(u16 b) { return __uint_as_float(((unsigned)b) << 16); }
__device__ __forceinline__ float bflo(unsigned w) { return __uint_as_float(w << 16); }
__device__ __forceinline__ float bfhi(unsigned w) { return __uint_as_float(w & 0xffff0000u); }

__device__ __forceinline__ int lds_byte(int r, int c) { const int st = (r >> 4) * 2 + (c >> 5), ob = (r & 15) * 64 + (c & 31) * 2; return st * 1024 + (ob ^ (((ob >> 9) & 1) << 5)); }
__device__ __forceinline__ void stage_rc(int b, int& R, int& C) { const int st = b >> 10, sb = b & 1023, swz = sb ^ (((sb >> 9) & 1) << 5); R = (st >> 1) * 16 + swz / 64; C = (st & 1) * 32 + (swz % 64) / 2; }
__device__ __forceinline__ f32x4 unperm(const f32x4 a, const bool s) { f32x4 o; o[0] = s ? a[1] : a[0]; o[1] = s ? a[0] : a[1]; o[2] = s ? a[3] : a[2]; o[3] = s ? a[2] : a[3]; return o; }

__device__ __forceinline__ int tid_fresh() { int t = threadIdx.x; asm volatile("" : "+v"(t)); return t; }
constexpr int GEMM_LDS = 131072;

template <bool TRANS, bool RAGGED, int PM = 0, class ColMap, class Epi>
__device__ __forceinline__ void gemm_unit(LAS unsigned char* lds, const u16* __restrict__ A, int lda, const int* __restrict__ arows, int arow0, int rows_valid,
                                          const float* __restrict__ B, int ldb, int K, const ColMap colmap, const Epi epi) {
    const int tid = tid_fresh(), wid = __builtin_amdgcn_readfirstlane(tid >> 6), lane = tid & 63;
    const int wr = wid >> 2, wc = wid & 3, fr = lane & 15, fq = lane >> 4;
    const int nt = K >> 6;
    const char* ap[4];
#pragma unroll
    for (int i = 0; i < 4; ++i) {
        int R, C; stage_rc(wid * 1024 + i * 8192 + lane * 16, R, C);
        const int rr = RAGGED ? (R < rows_valid ? R : rows_valid - 1) : R;
        const long rowid = arows ? (long)arows[rr] : (long)(arow0 + rr);
        ap[i] = (const char*)A + ((size_t)rowid * lda + C) * 2;
    }
    const int g = (lane & 3) + 4 * (wid >> 2), rg = (wid & 3) * 16 + (lane >> 2);
    const unsigned bvoff = (unsigned)(((size_t)(8 * g) * ldb + colmap(rg)) * 4);
    const int bbase = 65536 + lds_byte(4 * rg, 8 * g);
    const int bw0 = bbase + ((rg & 1) ? 64 : 0), bw1 = bbase + ((rg & 1) ? 0 : 64);
    const int aoff = lds_byte(wr * 128 + fr, fq * 8), boff = 65536 + lds_byte(wc * 64 + fr, fq * 8);
    int mvalid = 8;
    if (RAGGED) { mvalid = (rows_valid - wr * 128 + 15) >> 4; mvalid = mvalid < 0 ? 0 : (mvalid > 8 ? 8 : mvalid); }
    f32x4 vb0, vb1, vb2, vb3, vb4, vb5, vb6, vb7;
    if (PM & 1) { vb0 = (f32x4){1.f, 1.f, 1.f, 1.f}; vb1 = vb0; vb2 = vb0; vb3 = vb0; vb4 = vb0; vb5 = vb0; vb6 = vb0; vb7 = vb0; }
    f32x4 acc[8][4];
#pragma unroll
    for (int m = 0; m < 8; ++m)
#pragma unroll
        for (int n = 0; n < 4; ++n) acc[m][n] = (f32x4){0.f, 0.f, 0.f, 0.f};
    const size_t ldb4 = (size_t)ldb * 4;
#define GE_GLDS_A(buf, kt) do { if (!(PM & 2)) _Pragma("unroll") for (int _i = 0; _i < 4; ++_i) \
        __builtin_amdgcn_global_load_lds((const unsigned*)(ap[_i] + (size_t)(kt) * 128), (LAS unsigned*)(lds + (buf) * 32768 + wid * 1024 + _i * 8192), 16, 0, 0); } while (0)
#define GE_LD1(dst, sb) if (!(PM & 1)) asm volatile("global_load_dwordx4 %0, %1, %2" : "=v"(dst) : "v"(bvoff), "s"(sb) : "memory")
#define GE_LOAD_B(kt) do { const char* _sb = (const char*)B + (size_t)(kt) * 64 * ldb4; \
        GE_LD1(vb0, _sb); GE_LD1(vb1, _sb + ldb4); GE_LD1(vb2, _sb + 2 * ldb4); GE_LD1(vb3, _sb + 3 * ldb4); \
        GE_LD1(vb4, _sb + 4 * ldb4); GE_LD1(vb5, _sb + 5 * ldb4); GE_LD1(vb6, _sb + 6 * ldb4); GE_LD1(vb7, _sb + 7 * ldb4); } while (0)
#define GE_WAITV_B(n) asm volatile("s_waitcnt vmcnt(" #n ")" : "+v"(vb0), "+v"(vb1), "+v"(vb2), "+v"(vb3), "+v"(vb4), "+v"(vb5), "+v"(vb6), "+v"(vb7) :: "memory")
#define GE_WRITE_B(buf) do { _Pragma("unroll") for (int _i = 0; _i < 4; ++_i) { u32x4 _w; _w[0] = pk_bf16(vb0[_i], vb1[_i]); _w[1] = pk_bf16(vb2[_i], vb3[_i]); \
        _w[2] = pk_bf16(vb4[_i], vb5[_i]); _w[3] = pk_bf16(vb6[_i], vb7[_i]); \
        *(LAS u32x4*)(lds + ((_i & 1) ? bw1 : bw0) + (_i >> 1) * 128 + (buf) * 32768) = _w; } } while (0)
#define GE_KSTEP(buf, ks) do { bf16x8 Bf[4]; \
        _Pragma("unroll") for (int n = 0; n < 4; ++n) Bf[n] = *(const LAS bf16x8*)(lds + (buf) * 32768 + boff + n * 2048 + (ks) * 1024); \
        _Pragma("unroll") for (int mh = 0; mh < 2; ++mh) { bf16x8 At[4]; \
            _Pragma("unroll") for (int m = 0; m < 4; ++m) At[m] = *(const LAS bf16x8*)(lds + (buf) * 32768 + aoff + (mh * 4 + m) * 2048 + (ks) * 1024); \
            _Pragma("unroll") for (int m = 0; m < 4; ++m) { if (!RAGGED || (mh * 4 + m) < mvalid) { _Pragma("unroll") for (int n = 0; n < 4; ++n) \
                { if (PM & 4) { asm volatile("" :: "v"(At[m]), "v"(Bf[n])); } else acc[mh * 4 + m][n] = TRANS ? __builtin_amdgcn_mfma_f32_16x16x32_bf16(At[m], Bf[n], acc[mh * 4 + m][n], 0, 0, 0) : __builtin_amdgcn_mfma_f32_16x16x32_bf16(Bf[n], At[m], acc[mh * 4 + m][n], 0, 0, 0); } } } } } while (0)
    GE_GLDS_A(0, 0);
    GE_LOAD_B(0);
    GE_WAITV_B(0);
    GE_WRITE_B(0);
    GE_LOAD_B(1);
    asm volatile("s_waitcnt lgkmcnt(0)" ::: "memory");
    __builtin_amdgcn_s_barrier();
    int t = 0;
    for (; t < nt - 2; ++t) {
        const int cur = t & 1;
        GE_GLDS_A(cur ^ 1, t + 1);
        GE_KSTEP(cur, 0);
        GE_WAITV_B(4);
        GE_WRITE_B(cur ^ 1);
        GE_LOAD_B(t + 2);
        __builtin_amdgcn_sched_barrier(0);
        GE_KSTEP(cur, 1);
        asm volatile("s_waitcnt vmcnt(8) lgkmcnt(0)" ::: "memory");
        __builtin_amdgcn_s_barrier();
    }
    {
        const int cur = t & 1;
        GE_GLDS_A(cur ^ 1, t + 1);
        GE_KSTEP(cur, 0);
        GE_WAITV_B(4);
        GE_WRITE_B(cur ^ 1);
        GE_KSTEP(cur, 1);
        asm volatile("s_waitcnt vmcnt(0) lgkmcnt(0)" ::: "memory");
        __builtin_amdgcn_s_barrier();
        ++t;
    }
    {
        const int cur = t & 1;
        GE_KSTEP(cur, 0);
        GE_KSTEP(cur, 1);
        asm volatile("s_waitcnt lgkmcnt(0)" ::: "memory");
        __builtin_amdgcn_s_barrier();
    }
#undef GE_GLDS_A
#undef GE_LD1
#undef GE_LOAD_B
#undef GE_WAITV_B
#undef GE_WRITE_B
#undef GE_KSTEP
    __builtin_amdgcn_sched_barrier(0);
    { const int tz = tid_fresh(), wz = __builtin_amdgcn_readfirstlane(tz >> 6), lz = tz & 63;
      epi(acc, wz >> 2, wz & 3, lz & 15, lz >> 4); }
}

__device__ __forceinline__ int xcd_logical(int b, int G) { return (G & 7) ? b : (b & 7) * (G >> 3) + (b >> 3); }

struct ColMapDense { int c0; __device__ __forceinline__ int operator()(int rg) const { return c0 + 4 * rg; } };
struct EpiPG { u16* PG; int tok0, col0;
    __device__ __forceinline__ void operator()(const f32x4 (&acc)[8][4], int wr, int wc, int fr, int fq) const {
#pragma unroll
        for (int m = 0; m < 8; ++m) { u16* rowp = PG + (size_t)(tok0 + wr * 128 + m * 16 + fr) * 5120 + col0 + wc * 64 + 4 * fq;
#pragma unroll
            for (int n = 0; n < 4; ++n) { const f32x4 v = unperm(acc[m][n], fq & 1); u32x2 w; w[0] = pk_bf16(v[0], v[1]); w[1] = pk_bf16(v[2], v[3]); *(u32x2*)(rowp + n * 16) = w; } }
    } };
struct EpiHYT { u16* HYT; int tok0, col0;
    __device__ __forceinline__ void operator()(const f32x4 (&acc)[8][4], int wr, int wc, int fr, int fq) const {
#pragma unroll
        for (int n = 0; n < 4; ++n) { const int rho = wc * 64 + n * 16 + fr; const int col = col0 + (rho & ~3) + ((rho & 3) ^ ((rho >> 2) & 1));
            u16* colp = HYT + (size_t)col * NTOK + tok0 + wr * 128 + 4 * fq;
#pragma unroll
            for (int m = 0; m < 8; ++m) { const f32x4 v = acc[m][n]; u32x2 w; w[0] = pk_bf16(v[0], v[1]); w[1] = pk_bf16(v[2], v[3]); *(u32x2*)(colp + m * 16) = w; } }
    } };
struct EpiX1 { const float* x; float* X1; int tok0, col0;
    __device__ __forceinline__ void operator()(const f32x4 (&acc)[8][4], int wr, int wc, int fr, int fq) const {
#pragma unroll
        for (int m = 0; m < 8; ++m) { const size_t off = (size_t)(tok0 + wr * 128 + m * 16 + fr) * DM + col0 + wc * 64 + 4 * fq;
#pragma unroll
            for (int n = 0; n < 4; ++n) { const f32x4 r = *(const f32x4*)(x + off + n * 16); *(f32x4*)(X1 + off + n * 16) = r + unperm(acc[m][n], fq & 1); }
            asm volatile("" ::: "memory"); }
    } };
struct ColMapGlu { int nt; __device__ __forceinline__ int operator()(int rg) const { const int wcq = rg >> 4, n = (rg >> 2) & 3, f = rg & 3; return (n >> 1) * 2048 + nt * 128 + wcq * 32 + (n & 1) * 16 + f * 4; } };
struct EpiSwiglu { u16* HM; const float* b1; int slot0, nt, rows_valid;
    __device__ __forceinline__ void operator()(const f32x4 (&acc)[8][4], int wr, int wc, int fr, int fq) const {
        f32x4 bg[2], bl[2];
#pragma unroll
        for (int nn = 0; nn < 2; ++nn) { const int col = nt * 128 + wc * 32 + nn * 16 + 4 * fq; bg[nn] = *(const f32x4*)(b1 + col); bl[nn] = *(const f32x4*)(b1 + 2048 + col); }
#pragma unroll
        for (int m = 0; m < 8; ++m) { const int row = wr * 128 + m * 16 + fr;
            if (row < rows_valid) {
#pragma unroll
                for (int nn = 0; nn < 2; ++nn) { const f32x4 gl = unperm(acc[m][nn], fq & 1) + bg[nn], li = unperm(acc[m][nn + 2], fq & 1) + bl[nn]; float o[4];
#pragma unroll
                    for (int j = 0; j < 4; ++j) { const float gq = fminf(gl[j], 7.0f), lq = fminf(fmaxf(li[j], -7.0f), 7.0f); o[j] = gq * (1.0f / (1.0f + __expf(-1.702f * gq))) * (lq + 1.0f); }
                    u32x2 w; w[0] = pk_bf16(o[0], o[1]); w[1] = pk_bf16(o[2], o[3]);
                    *(u32x2*)(HM + (size_t)(slot0 + row) * DFF + nt * 128 + wc * 32 + nn * 16 + 4 * fq) = w; } } }
    } };
struct EpiY { u16* Y; const float* b2; int slot0, col0, rows_valid;
    __device__ __forceinline__ void operator()(const f32x4 (&acc)[8][4], int wr, int wc, int fr, int fq) const {
        f32x4 bv[4];
#pragma unroll
        for (int n = 0; n < 4; ++n) bv[n] = *(const f32x4*)(b2 + col0 + wc * 64 + n * 16 + 4 * fq);
#pragma unroll
        for (int m = 0; m < 8; ++m) { const int row = wr * 128 + m * 16 + fr;
            if (row < rows_valid) { u16* rowp = Y + (size_t)(slot0 + row) * DM + col0 + wc * 64 + 4 * fq;
#pragma unroll
                for (int n = 0; n < 4; ++n) { const f32x4 v = unperm(acc[m][n], fq & 1) + bv[n]; u32x2 w; w[0] = pk_bf16(v[0], v[1]); w[1] = pk_bf16(v[2], v[3]); *(u32x2*)(rowp + n * 16) = w; } } }
    } };
template <int NTILES>
__device__ __forceinline__ bool moe_decode(const int* __restrict__ offs, int u, int& e, int& mt, int& nt, int& slot0, int& rows) {
    int base = 0;
    for (int q = 0; q < NE; ++q) { const int o0 = offs[q], cnt = offs[q + 1] - o0, mtl = (cnt + 255) >> 8, nu = mtl * NTILES;
        if (u < base + nu) { const int ul = u - base; e = q; mt = ul % mtl; nt = ul / mtl; slot0 = o0 + mt * 256; rows = cnt - mt * 256; if (rows > 256) rows = 256; return true; }
        base += nu; }
    return false;
}


__device__ __forceinline__ int perm_col4(int rg) { const int rgl = rg & 31, t = rgl & 7; return 32 * (rgl >> 3) + 8 * (t & 3) + 4 * (t >> 2); }
__device__ __forceinline__ int perm32(int rho) { const int n = rho >> 4, i = rho & 15; return 8 * (i >> 2) + 4 * n + (i & 3); }
template <class ColMap>
__device__ __forceinline__ void convert_tile(const float* __restrict__ W, int ldb, int k0, const ColMap colmap, u16* __restrict__ dst, int tid) {
    const int wid = tid >> 6, lane = tid & 63;
    const int g = (lane & 3) + 4 * (wid >> 2), rg = (wid & 3) * 16 + (lane >> 2);
    const float* bp = W + (size_t)(k0 + 8 * g) * ldb + colmap(rg);
    f32x4 v[8];
#pragma unroll
    for (int kk = 0; kk < 8; ++kk) v[kk] = __builtin_nontemporal_load((const f32x4*)(bp + (size_t)kk * ldb));
    const int h = rg >> 5, r0 = (4 * rg) & 127;
    unsigned char* base = (unsigned char*)dst + h * 16384 + lds_byte(r0, 8 * g);
#pragma unroll
    for (int i = 0; i < 4; ++i) { u32x4 w; w[0] = pk_bf16(v[0][i], v[1][i]); w[1] = pk_bf16(v[2][i], v[3][i]); w[2] = pk_bf16(v[4][i], v[5][i]); w[3] = pk_bf16(v[6][i], v[7][i]);
        *(u32x4*)(base + i * 64) = w; }
}
typedef int i32x8 __attribute__((ext_vector_type(8)));
typedef int i32x4 __attribute__((ext_vector_type(4)));
constexpr float W8_SCALE = 32.0f;
constexpr int W8_MX = 0x7A7A7A7A;
constexpr int A8_MX = 0x7F7F7F7F;
__device__ __forceinline__ unsigned pk_fp8x4(float a, float b, float c, float d) { int p = __builtin_amdgcn_cvt_pk_fp8_f32(a, b, 0, false); p = __builtin_amdgcn_cvt_pk_fp8_f32(c, d, p, true); return (unsigned)p; }
__device__ __forceinline__ int lds_byte_b(int r, int cb) { const int st = (r >> 4) * 2 + (cb >> 6), ob = (r & 15) * 64 + (cb & 63); return st * 1024 + (ob ^ (((ob >> 9) & 1) << 5)); }
struct ConvCtx { const float* w1; const float* w2; unsigned char* W1T; unsigned char* W2T; };
__device__ __forceinline__ int conv_seq2tile(int s) {
    if (s < 16384) return (s >> 9) * 512 + (s & 15) * 32 + ((s >> 4) & 31);
    const int q = s - 16384; return 16384 + (q >> 8) * 256 + (q & 7) * 32 + ((q >> 3) & 31);
}
__device__ __forceinline__ void conv_issue(const ConvCtx& cc, int m, int wid, int lane, f32x2 (&v)[16]) {
    const int rp = 16 * wid + (lane & 15), rg = rp >> 1, p2 = (rp & 1) * 2, kg = lane >> 4;
    const float* bp; size_t ld;
    if (m < 16384) { const int e = m >> 9, nt = (m >> 5) & 15, kt = m & 31; ld = 2 * DFF; bp = cc.w1 + (size_t)e * DM * 2 * DFF + (size_t)(kt * 64 + 16 * kg) * ld + (rg >> 5) * 2048 + nt * 128 + perm_col4(rg) + p2; }
    else { const int q = m - 16384, e = q >> 8, nt = (q >> 5) & 7, kt = q & 31; ld = DM; bp = cc.w2 + (size_t)e * DFF * DM + (size_t)(kt * 64 + 16 * kg) * ld + nt * 256 + (rg >> 5) * 128 + perm_col4(rg) + p2; }
#pragma unroll
    for (int kk = 0; kk < 16; ++kk) v[kk] = __builtin_nontemporal_load((const f32x2*)(bp + (size_t)kk * ld));
}
__device__ __forceinline__ void conv_finish(const ConvCtx& cc, int m, int wid, int lane, const f32x2 (&v)[16]) {
    const int rp = 16 * wid + (lane & 15), kg = lane >> 4;
    const int kt64 = m & 31;
    unsigned char* dst = (m < 16384) ? cc.W1T + ((size_t)(m >> 5) * 16 + (kt64 >> 1)) * 32768 : cc.W2T + ((size_t)((m - 16384) >> 5) * 16 + (kt64 >> 1)) * 32768;
    unsigned char* base = dst + (rp >> 6) * 16384 + lds_byte_b((2 * rp) & 127, (kt64 & 1) * 64 + 16 * kg);
#pragma unroll
    for (int i = 0; i < 2; ++i) { u32x4 w;
#pragma unroll
        for (int q = 0; q < 4; ++q) w[q] = pk_fp8x4(v[4 * q][i] * W8_SCALE, v[4 * q + 1][i] * W8_SCALE, v[4 * q + 2][i] * W8_SCALE, v[4 * q + 3][i] * W8_SCALE);
        __builtin_nontemporal_store(w, (u32x4*)(base + i * 64)); }
}
__device__ __forceinline__ void conv_issue_win(const float* __restrict__ w_in, int q, int wid, int lane, f32x2 (&v)[16]) {
    const int rp = 16 * wid + (lane & 15), rg = rp >> 1, p2 = (rp & 1) * 2, kg = lane >> 4;
    const int nt = q >> 5, kt = q & 31;
    const float* bp = w_in + (size_t)(kt * 64 + 16 * kg) * DIN + nt * 256 + (rg >> 5) * 128 + perm_col4(rg) + p2;
#pragma unroll
    for (int kk = 0; kk < 16; ++kk) v[kk] = __builtin_nontemporal_load((const f32x2*)(bp + (size_t)kk * DIN));
}
__device__ __forceinline__ void conv_finish_win(unsigned char* __restrict__ WT, int q, int wid, int lane, const f32x2 (&v)[16]) {
    const int rp = 16 * wid + (lane & 15), kg = lane >> 4;
    const int kt64 = q & 31;
    unsigned char* base = WT + ((size_t)(q >> 5) * 16 + (kt64 >> 1)) * 32768 + (rp >> 6) * 16384 + lds_byte_b((2 * rp) & 127, (kt64 & 1) * 64 + 16 * kg);
#pragma unroll
    for (int i = 0; i < 2; ++i) { u32x4 w;
#pragma unroll
        for (int qq = 0; qq < 4; ++qq) w[qq] = pk_fp8x4(v[4 * qq][i] * W8_SCALE, v[4 * qq + 1][i] * W8_SCALE, v[4 * qq + 2][i] * W8_SCALE, v[4 * qq + 3][i] * W8_SCALE);
        __builtin_nontemporal_store(w, (u32x4*)(base + i * 64)); }
}
struct ColMapGluT { int nt; __device__ __forceinline__ int operator()(int rg) const { return (rg >> 5) * 2048 + nt * 128 + perm_col4(rg); } };
struct ColMapPerm { int c0; __device__ __forceinline__ int operator()(int rg) const { return c0 + (rg >> 5) * 128 + perm_col4(rg); } };

template <bool TRANS, bool FP8 = false, class Epi>
__device__ __forceinline__ void gemm8_unit(LAS unsigned char* lds, const u16* __restrict__ A, int lda, const int* __restrict__ arows, int arow0, int rows_valid, const u16* __restrict__ Bt, int nt, const Epi epi) {
    const int tid = tid_fresh(), wid = __builtin_amdgcn_readfirstlane(tid >> 6), lane = tid & 63;
    const int wr = wid >> 2, wc = wid & 3, fr = lane & 15, fq = lane >> 4;
    unsigned aof[2][2];
#pragma unroll
    for (int h = 0; h < 2; ++h)
#pragma unroll
        for (int i = 0; i < 2; ++i) { int R, C; stage_rc(tid * 16 + i * 8192, R, C); int rr = h * 128 + R; rr = rr < rows_valid ? rr : rows_valid - 1;
            const unsigned rowid = arows ? (unsigned)arows[rr] : (unsigned)(arow0 + rr); aof[h][i] = (rowid * (unsigned)lda + (unsigned)C) * 2u; }
    const char* Ab = (const char*)A; const char* Bb = (const char*)Bt + tid * 16;
    const bool hi = rows_valid > 128;
    int mxw = W8_MX, mxa = A8_MX; asm volatile("" : "+v"(mxw), "+v"(mxa));
#define G8_SA(b, h) (((b) * 2 + (h)) * 16384)
#define G8_SB(b, h) (65536 + ((b) * 2 + (h)) * 16384)
#define G8_STA(b, h, kt) do { _Pragma("unroll") for (int _i = 0; _i < 2; ++_i) \
        __builtin_amdgcn_global_load_lds((const unsigned*)(Ab + aof[h][_i] + (size_t)(kt) * 128), (LAS unsigned*)(lds + G8_SA(b, h) + wid * 1024 + _i * 8192), 16, 0, 0); } while (0)
#define G8_STB(b, h, kt) do { _Pragma("unroll") for (int _i = 0; _i < 2; ++_i) \
        __builtin_amdgcn_global_load_lds((const unsigned*)(Bb + (size_t)(kt) * 32768 + (h) * 16384 + _i * 8192), (LAS unsigned*)(lds + G8_SB(b, h) + wid * 1024 + _i * 8192), 16, 0, 0); } while (0)
#define G8_LDA(dst, b, h) do { _Pragma("unroll") for (int m = 0; m < 4; ++m) _Pragma("unroll") for (int k = 0; k < 2; ++k) dst[m][k] = *(const LAS bf16x8*)(lds + G8_SA(b, h) + aoff + m * 2048 + k * 1024); } while (0)
#define G8_LDB(dst, b, h) do { _Pragma("unroll") for (int n = 0; n < 2; ++n) _Pragma("unroll") for (int k = 0; k < 2; ++k) dst[n][k] = *(const LAS bf16x8*)(lds + G8_SB(b, h) + boff + n * 2048 + k * 1024); } while (0)
#define G8_MMA(ai, bj, At, Bq) do { if ((ai) == 0 || hi) { __builtin_amdgcn_s_setprio(1); _Pragma("unroll") for (int m = 0; m < 4; ++m) _Pragma("unroll") for (int n = 0; n < 2; ++n) { \
        if (FP8) { const i32x4 a0 = __builtin_bit_cast(i32x4, At[m][0]), a1 = __builtin_bit_cast(i32x4, At[m][1]), b0 = __builtin_bit_cast(i32x4, Bq[n][0]), b1 = __builtin_bit_cast(i32x4, Bq[n][1]); \
            const i32x8 a8 = __builtin_shufflevector(a0, a1, 0, 1, 2, 3, 4, 5, 6, 7), b8 = __builtin_shufflevector(b0, b1, 0, 1, 2, 3, 4, 5, 6, 7); \
            if (TRANS) asm volatile("v_mfma_scale_f32_16x16x128_f8f6f4 %0, %1, %2, %0, %3, %4 op_sel_hi:[0,0,0]" : "+v"(acc[ai][bj][m][n]) : "v"(a8), "v"(b8), "v"(mxa), "v"(mxw)); \
            else asm volatile("v_mfma_scale_f32_16x16x128_f8f6f4 %0, %1, %2, %0, %3, %4 op_sel_hi:[0,0,0]" : "+v"(acc[ai][bj][m][n]) : "v"(b8), "v"(a8), "v"(mxw), "v"(mxa)); } \
        else { _Pragma("unroll") for (int k = 0; k < 2; ++k) \
            acc[ai][bj][m][n] = TRANS ? __builtin_amdgcn_mfma_f32_16x16x32_bf16(At[m][k], Bq[n][k], acc[ai][bj][m][n], 0, 0, 0) : __builtin_amdgcn_mfma_f32_16x16x32_bf16(Bq[n][k], At[m][k], acc[ai][bj][m][n], 0, 0, 0); } } \
        __builtin_amdgcn_s_setprio(0); } } while (0)
#define G8_WV(n) asm volatile("s_waitcnt vmcnt(" #n ")" ::: "memory")
#define G8_WL(n) asm volatile("s_waitcnt lgkmcnt(" #n ")" ::: "memory")
#define G8_BAR __builtin_amdgcn_s_barrier()
#define G8_SCHED __builtin_amdgcn_sched_barrier(0)
    const int aoff = lds_byte(wr * 64 + fr, fq * 8), boff = lds_byte(wc * 32 + fr, fq * 8);
    f32x4 acc[2][2][4][2];
#pragma unroll
    for (int a = 0; a < 2; ++a)
#pragma unroll
        for (int b = 0; b < 2; ++b)
#pragma unroll
            for (int m = 0; m < 4; ++m)
#pragma unroll
                for (int n = 0; n < 2; ++n) acc[a][b][m][n] = (f32x4){0.f, 0.f, 0.f, 0.f};
    bf16x8 At[4][2], B0[2][2], B1[2][2];
    G8_STB(0, 0, 0); G8_STA(0, 0, 0); G8_STB(0, 1, 0); G8_STA(0, 1, 0);
    if (wr == 1) G8_BAR;
    G8_WV(4); G8_BAR;
    G8_STB(1, 0, 1); G8_STA(1, 0, 1); G8_STB(1, 1, 1);
    G8_WV(6); G8_BAR;
    for (int t = 0; t < nt - 2; t += 2) {
        G8_LDB(B0, 0, 0); G8_SCHED; G8_LDA(At, 0, 0); G8_STA(1, 1, t + 1);
        G8_WL(8); G8_BAR; G8_WL(0); G8_MMA(0, 0, At, B0); G8_BAR; G8_SCHED;
        G8_LDB(B1, 0, 1); G8_STB(0, 0, t + 2);
        G8_BAR; G8_WL(0); G8_MMA(0, 1, At, B1); G8_BAR;
        if (hi) G8_LDA(At, 0, 1); G8_STA(0, 0, t + 2);
        G8_BAR; G8_WL(0); G8_MMA(1, 0, At, B0); G8_BAR; G8_SCHED;
        G8_STB(0, 1, t + 2);
        G8_WV(6); G8_BAR; G8_MMA(1, 1, At, B1); G8_BAR;
        G8_LDB(B0, 1, 0); G8_SCHED; G8_LDA(At, 1, 0); G8_STA(0, 1, t + 2);
        G8_WL(8); G8_BAR; G8_WL(0); G8_MMA(0, 0, At, B0); G8_BAR; G8_SCHED;
        G8_LDB(B1, 1, 1); G8_STB(1, 0, t + 3);
        G8_BAR; G8_WL(0); G8_MMA(0, 1, At, B1); G8_BAR;
        if (hi) G8_LDA(At, 1, 1); G8_STA(1, 0, t + 3);
        G8_BAR; G8_WL(0); G8_MMA(1, 0, At, B0); G8_BAR; G8_SCHED;
        G8_STB(1, 1, t + 3);
        G8_WV(6); G8_BAR; G8_MMA(1, 1, At, B1); G8_BAR;
    }
    { G8_LDB(B0, 0, 0); G8_WV(0); G8_LDA(At, 0, 0); G8_STA(1, 1, nt - 1);
      G8_BAR; G8_WL(0); G8_MMA(0, 0, At, B0); G8_BAR;
      G8_LDB(B1, 0, 1); G8_BAR; G8_WL(0); G8_MMA(0, 1, At, B1); G8_BAR;
      G8_LDA(At, 0, 1); G8_WV(4); G8_BAR; G8_WL(0); G8_MMA(1, 0, At, B0); G8_MMA(1, 1, At, B1); G8_BAR; }
    { G8_LDB(B0, 1, 0); G8_LDA(At, 1, 0); G8_WV(2); G8_BAR; G8_WL(0); G8_MMA(0, 0, At, B0); G8_BAR;
      G8_LDB(B1, 1, 1); G8_WV(0); G8_BAR; G8_WL(0); G8_MMA(0, 1, At, B1); G8_BAR;
      G8_LDA(At, 1, 1); G8_BAR; G8_WL(0); G8_MMA(1, 0, At, B0); G8_MMA(1, 1, At, B1); G8_BAR; }
    if (wr == 0) G8_BAR;
#undef G8_SA
#undef G8_SB
#undef G8_STA
#undef G8_STB
#undef G8_LDA
#undef G8_LDB
#undef G8_MMA
#undef G8_WV
#undef G8_WL
#undef G8_BAR
#undef G8_SCHED
    __builtin_amdgcn_sched_barrier(0);
    { const int tz = tid_fresh(), wz = __builtin_amdgcn_readfirstlane(tz >> 6), lz = tz & 63;
      epi(acc, wz >> 2, wz & 3, lz & 15, lz >> 4); }
}
struct G8Pre { unsigned aof[2][2]; const char* Bt; int rows; };
__device__ __forceinline__ void g8_addr(G8Pre& p, int lda, const int* __restrict__ arows, int rows_valid, const u16* __restrict__ Bt) {
    const int tid = tid_fresh();
#pragma unroll
    for (int h = 0; h < 2; ++h)
#pragma unroll
        for (int i = 0; i < 2; ++i) { int R, C; stage_rc(tid * 16 + i * 8192, R, C); int rr = h * 128 + R; rr = rr < rows_valid ? rr : rows_valid - 1;
            p.aof[h][i] = ((unsigned)arows[rr] * (unsigned)lda + (unsigned)C) * 2u; }
    p.Bt = (const char*)Bt; p.rows = rows_valid;
}
__device__ __forceinline__ void g8_issue(LAS unsigned char* lds, const char* Ab, const G8Pre& p) {
    const int tid = tid_fresh(), wid = __builtin_amdgcn_readfirstlane(tid >> 6);
    const char* Bb = p.Bt + tid * 16;
#define G8I_A(b, h, kt) do { _Pragma("unroll") for (int _i = 0; _i < 2; ++_i) \
        __builtin_amdgcn_global_load_lds((const unsigned*)(Ab + p.aof[h][_i] + (size_t)(kt) * 128), (LAS unsigned*)(lds + ((b) * 2 + (h)) * 16384 + wid * 1024 + _i * 8192), 16, 0, 0); } while (0)
#define G8I_B(b, h, kt) do { _Pragma("unroll") for (int _i = 0; _i < 2; ++_i) \
        __builtin_amdgcn_global_load_lds((const unsigned*)(Bb + (size_t)(kt) * 32768 + (h) * 16384 + _i * 8192), (LAS unsigned*)(lds + 65536 + ((b) * 2 + (h)) * 16384 + wid * 1024 + _i * 8192), 16, 0, 0); } while (0)
    G8I_B(0, 0, 0); G8I_A(0, 0, 0); G8I_B(0, 1, 0); G8I_A(0, 1, 0); G8I_B(1, 0, 1); G8I_A(1, 0, 1); G8I_B(1, 1, 1);
#undef G8I_A
#undef G8I_B
}
template <bool TRANS, bool FP8, class Epi, class Next>
__device__ __forceinline__ bool gemm8_unit_ov(LAS unsigned char* lds, const u16* __restrict__ A, const G8Pre& pre, int nt, const Epi epi, Next& next) {
    const int tid = tid_fresh(), wid = __builtin_amdgcn_readfirstlane(tid >> 6), lane = tid & 63;
    const int wr = wid >> 2, wc = wid & 3, fr = lane & 15, fq = lane >> 4;
    unsigned aof[2][2];
    aof[0][0] = pre.aof[0][0]; aof[0][1] = pre.aof[0][1]; aof[1][0] = pre.aof[1][0]; aof[1][1] = pre.aof[1][1];
    const int rows_valid = pre.rows;
    const char* Ab = (const char*)A; const char* Bb = pre.Bt + tid * 16;
    const bool hi = rows_valid > 128;
    int mxw = W8_MX, mxa = A8_MX; asm volatile("" : "+v"(mxw), "+v"(mxa));
#define G8_SA(b, h) (((b) * 2 + (h)) * 16384)
#define G8_SB(b, h) (65536 + ((b) * 2 + (h)) * 16384)
#define G8_STA(b, h, kt) do { _Pragma("unroll") for (int _i = 0; _i < 2; ++_i) \
        __builtin_amdgcn_global_load_lds((const unsigned*)(Ab + aof[h][_i] + (size_t)(kt) * 128), (LAS unsigned*)(lds + G8_SA(b, h) + wid * 1024 + _i * 8192), 16, 0, 0); } while (0)
#define G8_STB(b, h, kt) do { _Pragma("unroll") for (int _i = 0; _i < 2; ++_i) \
        __builtin_amdgcn_global_load_lds((const unsigned*)(Bb + (size_t)(kt) * 32768 + (h) * 16384 + _i * 8192), (LAS unsigned*)(lds + G8_SB(b, h) + wid * 1024 + _i * 8192), 16, 0, 0); } while (0)
#define G8_LDA(dst, b, h) do { _Pragma("unroll") for (int m = 0; m < 4; ++m) _Pragma("unroll") for (int k = 0; k < 2; ++k) dst[m][k] = *(const LAS bf16x8*)(lds + G8_SA(b, h) + aoff + m * 2048 + k * 1024); } while (0)
#define G8_LDB(dst, b, h) do { _Pragma("unroll") for (int n = 0; n < 2; ++n) _Pragma("unroll") for (int k = 0; k < 2; ++k) dst[n][k] = *(const LAS bf16x8*)(lds + G8_SB(b, h) + boff + n * 2048 + k * 1024); } while (0)
#define G8_MMA(ai, bj, At, Bq) do { if ((ai) == 0 || hi) { __builtin_amdgcn_s_setprio(1); _Pragma("unroll") for (int m = 0; m < 4; ++m) _Pragma("unroll") for (int n = 0; n < 2; ++n) { \
        if (FP8) { const i32x4 a0 = __builtin_bit_cast(i32x4, At[m][0]), a1 = __builtin_bit_cast(i32x4, At[m][1]), b0 = __builtin_bit_cast(i32x4, Bq[n][0]), b1 = __builtin_bit_cast(i32x4, Bq[n][1]); \
            const i32x8 a8 = __builtin_shufflevector(a0, a1, 0, 1, 2, 3, 4, 5, 6, 7), b8 = __builtin_shufflevector(b0, b1, 0, 1, 2, 3, 4, 5, 6, 7); \
            if (TRANS) asm volatile("v_mfma_scale_f32_16x16x128_f8f6f4 %0, %1, %2, %0, %3, %4 op_sel_hi:[0,0,0]" : "+v"(acc[ai][bj][m][n]) : "v"(a8), "v"(b8), "v"(mxa), "v"(mxw)); \
            else asm volatile("v_mfma_scale_f32_16x16x128_f8f6f4 %0, %1, %2, %0, %3, %4 op_sel_hi:[0,0,0]" : "+v"(acc[ai][bj][m][n]) : "v"(b8), "v"(a8), "v"(mxw), "v"(mxa)); } \
        else { _Pragma("unroll") for (int k = 0; k < 2; ++k) \
            acc[ai][bj][m][n] = TRANS ? __builtin_amdgcn_mfma_f32_16x16x32_bf16(At[m][k], Bq[n][k], acc[ai][bj][m][n], 0, 0, 0) : __builtin_amdgcn_mfma_f32_16x16x32_bf16(Bq[n][k], At[m][k], acc[ai][bj][m][n], 0, 0, 0); } } \
        __builtin_amdgcn_s_setprio(0); } } while (0)
#define G8_WV(n) asm volatile("s_waitcnt vmcnt(" #n ")" ::: "memory")
#define G8_WL(n) asm volatile("s_waitcnt lgkmcnt(" #n ")" ::: "memory")
#define G8_BAR __builtin_amdgcn_s_barrier()
#define G8_SCHED __builtin_amdgcn_sched_barrier(0)
    const int aoff = lds_byte(wr * 64 + fr, fq * 8), boff = lds_byte(wc * 32 + fr, fq * 8);
    f32x4 acc[2][2][4][2];
#pragma unroll
    for (int a = 0; a < 2; ++a)
#pragma unroll
        for (int b = 0; b < 2; ++b)
#pragma unroll
            for (int m = 0; m < 4; ++m)
#pragma unroll
                for (int n = 0; n < 2; ++n) acc[a][b][m][n] = (f32x4){0.f, 0.f, 0.f, 0.f};
    bf16x8 At[4][2], B0[2][2], B1[2][2];
    if (wr == 1) G8_BAR;
    G8_WV(0); G8_BAR;
    G8_BAR;
    for (int t = 0; t < nt - 2; t += 2) {
        G8_LDB(B0, 0, 0); G8_SCHED; G8_LDA(At, 0, 0); G8_STA(1, 1, t + 1);
        G8_WL(8); G8_BAR; G8_WL(0); G8_MMA(0, 0, At, B0); G8_BAR; G8_SCHED;
        G8_LDB(B1, 0, 1); G8_STB(0, 0, t + 2);
        G8_BAR; G8_WL(0); G8_MMA(0, 1, At, B1); G8_BAR;
        if (hi) G8_LDA(At, 0, 1); G8_STA(0, 0, t + 2);
        G8_BAR; G8_WL(0); G8_MMA(1, 0, At, B0); G8_BAR; G8_SCHED;
        G8_STB(0, 1, t + 2);
        G8_WV(6); G8_BAR; G8_MMA(1, 1, At, B1); G8_BAR;
        G8_LDB(B0, 1, 0); G8_SCHED; G8_LDA(At, 1, 0); G8_STA(0, 1, t + 2);
        G8_WL(8); G8_BAR; G8_WL(0); G8_MMA(0, 0, At, B0); G8_BAR; G8_SCHED;
        G8_LDB(B1, 1, 1); G8_STB(1, 0, t + 3);
        G8_BAR; G8_WL(0); G8_MMA(0, 1, At, B1); G8_BAR;
        if (hi) G8_LDA(At, 1, 1); G8_STA(1, 0, t + 3);
        G8_BAR; G8_WL(0); G8_MMA(1, 0, At, B0); G8_BAR; G8_SCHED;
        G8_STB(1, 1, t + 3);
        G8_WV(6); G8_BAR; G8_MMA(1, 1, At, B1); G8_BAR;
    }
    { G8_LDB(B0, 0, 0); G8_WV(0); G8_LDA(At, 0, 0); G8_STA(1, 1, nt - 1);
      G8_BAR; G8_WL(0); G8_MMA(0, 0, At, B0); G8_BAR;
      G8_LDB(B1, 0, 1); G8_BAR; G8_WL(0); G8_MMA(0, 1, At, B1); G8_BAR;
      G8_LDA(At, 0, 1); G8_WV(4); G8_BAR; G8_WL(0); G8_MMA(1, 0, At, B0); G8_MMA(1, 1, At, B1); G8_BAR; }
    { G8_LDB(B0, 1, 0); G8_LDA(At, 1, 0); G8_WV(2); G8_BAR; G8_WL(0); G8_MMA(0, 0, At, B0); G8_BAR;
      G8_LDB(B1, 1, 1); G8_WV(0); G8_BAR; G8_WL(0); G8_MMA(0, 1, At, B1); G8_BAR;
      G8_LDA(At, 1, 1); G8_BAR; G8_WL(0); G8_MMA(1, 0, At, B0); G8_MMA(1, 1, At, B1); G8_BAR; }
    if (wr == 0) G8_BAR;
#undef G8_SA
#undef G8_SB
#undef G8_STA
#undef G8_STB
#undef G8_LDA
#undef G8_LDB
#undef G8_MMA
#undef G8_WV
#undef G8_WL
#undef G8_BAR
#undef G8_SCHED
    __builtin_amdgcn_sched_barrier(0);
    const bool has_next = next();
    __builtin_amdgcn_sched_barrier(0);
    { const int tz = tid_fresh(), wz = __builtin_amdgcn_readfirstlane(tz >> 6), lz = tz & 63;
      epi(acc, wz >> 2, wz & 3, lz & 15, lz >> 4); }
    return has_next;
}
struct StreamUnit { const char* A; const char* Bt; int arow0, rows, a, b, c; };
template <bool TRANS, bool FP8, class Src>
__device__ __forceinline__ void gemm8_stream(LAS unsigned char* lds, unsigned lda, int nt, const Src& src) {
    const int tid = tid_fresh(), wid = __builtin_amdgcn_readfirstlane(tid >> 6), lane = tid & 63;
    const int wr = wid >> 2, wc = wid & 3, fr = lane & 15, fq = lane >> 4;
    StreamUnit cur, nxt;
    if (!src.get(0, cur)) return;
    int R0, C0, R1, C1; stage_rc(tid * 16, R0, C0); stage_rc(tid * 16 + 8192, R1, C1);
    int mxw = W8_MX, mxa = A8_MX; asm volatile("" : "+v"(mxw), "+v"(mxa));
    const int aoff = lds_byte(wr * 64 + fr, fq * 8), boff = lds_byte(wc * 32 + fr, fq * 8);
#define GS_AOF(u, h, R, C) ((unsigned)(((unsigned)((u).arow0 + (((h) * 128 + (R)) < (u).rows ? ((h) * 128 + (R)) : (u).rows - 1)) * lda + (unsigned)(C)) * 2u))
    unsigned ac00 = GS_AOF(cur, 0, R0, C0), ac01 = GS_AOF(cur, 0, R1, C1), ac10 = GS_AOF(cur, 1, R0, C0), ac11 = GS_AOF(cur, 1, R1, C1);
#define GS_SA(b, h) (((b) * 2 + (h)) * 16384)
#define GS_SB(b, h) (65536 + ((b) * 2 + (h)) * 16384)
#define GS_GL(src_, dst_) __builtin_amdgcn_global_load_lds((const unsigned*)(src_), (LAS unsigned*)(lds + (dst_)), 16, 0, 0)
#define GS_STA(b, h, base, o0, o1, kt) do { GS_GL((base) + (o0) + (size_t)(kt) * 128, GS_SA(b, h) + wid * 1024); GS_GL((base) + (o1) + (size_t)(kt) * 128, GS_SA(b, h) + wid * 1024 + 8192); } while (0)
#define GS_STB(b, h, base, kt) do { GS_GL((base) + tid * 16 + (size_t)(kt) * 32768 + (h) * 16384, GS_SB(b, h) + wid * 1024); GS_GL((base) + tid * 16 + (size_t)(kt) * 32768 + (h) * 16384 + 8192, GS_SB(b, h) + wid * 1024 + 8192); } while (0)
#define GS_LDA(dst, b, h) do { _Pragma("unroll") for (int m = 0; m < 4; ++m) _Pragma("unroll") for (int k = 0; k < 2; ++k) dst[m][k] = *(const LAS bf16x8*)(lds + GS_SA(b, h) + aoff + m * 2048 + k * 1024); } while (0)
#define GS_LDB(dst, b, h) do { _Pragma("unroll") for (int n = 0; n < 2; ++n) _Pragma("unroll") for (int k = 0; k < 2; ++k) dst[n][k] = *(const LAS bf16x8*)(lds + GS_SB(b, h) + boff + n * 2048 + k * 1024); } while (0)
#define GS_MMA(ai, bj, At, Bq) do { if ((ai) == 0 || hi) { __builtin_amdgcn_s_setprio(1); _Pragma("unroll") for (int m = 0; m < 4; ++m) _Pragma("unroll") for (int n = 0; n < 2; ++n) { \
        if (FP8) { const i32x4 a0 = __builtin_bit_cast(i32x4, At[m][0]), a1 = __builtin_bit_cast(i32x4, At[m][1]), b0 = __builtin_bit_cast(i32x4, Bq[n][0]), b1 = __builtin_bit_cast(i32x4, Bq[n][1]); \
            const i32x8 a8 = __builtin_shufflevector(a0, a1, 0, 1, 2, 3, 4, 5, 6, 7), b8 = __builtin_shufflevector(b0, b1, 0, 1, 2, 3, 4, 5, 6, 7); \
            if (TRANS) asm volatile("v_mfma_scale_f32_16x16x128_f8f6f4 %0, %1, %2, %0, %3, %4 op_sel_hi:[0,0,0]" : "+v"(acc[ai][bj][m][n]) : "v"(a8), "v"(b8), "v"(mxa), "v"(mxw)); \
            else asm volatile("v_mfma_scale_f32_16x16x128_f8f6f4 %0, %1, %2, %0, %3, %4 op_sel_hi:[0,0,0]" : "+v"(acc[ai][bj][m][n]) : "v"(b8), "v"(a8), "v"(mxw), "v"(mxa)); } \
        else { _Pragma("unroll") for (int k = 0; k < 2; ++k) \
            acc[ai][bj][m][n] = TRANS ? __builtin_amdgcn_mfma_f32_16x16x32_bf16(At[m][k], Bq[n][k], acc[ai][bj][m][n], 0, 0, 0) : __builtin_amdgcn_mfma_f32_16x16x32_bf16(Bq[n][k], At[m][k], acc[ai][bj][m][n], 0, 0, 0); } } \
        __builtin_amdgcn_s_setprio(0); } } while (0)
#define GS_WV(n) asm volatile("s_waitcnt vmcnt(" #n ")" ::: "memory")
#define GS_WL(n) asm volatile("s_waitcnt lgkmcnt(" #n ")" ::: "memory")
#define GS_BAR __builtin_amdgcn_s_barrier()
#define GS_SCHED __builtin_amdgcn_sched_barrier(0)
    f32x4 acc[2][2][4][2];
#pragma unroll
    for (int a = 0; a < 2; ++a)
#pragma unroll
        for (int b = 0; b < 2; ++b)
#pragma unroll
            for (int m = 0; m < 4; ++m)
#pragma unroll
                for (int n = 0; n < 2; ++n) acc[a][b][m][n] = (f32x4){0.f, 0.f, 0.f, 0.f};
    bf16x8 At[4][2], B0[2][2], B1[2][2];
    GS_STB(0, 0, cur.Bt, 0); GS_STA(0, 0, cur.A, ac00, ac01, 0); GS_STB(0, 1, cur.Bt, 0); GS_STA(0, 1, cur.A, ac10, ac11, 0);
    if (wr == 1) GS_BAR;
    GS_WV(4); GS_BAR;
    GS_STB(1, 0, cur.Bt, 1); GS_STA(1, 0, cur.A, ac00, ac01, 1); GS_STB(1, 1, cur.Bt, 1);
    GS_WV(6); GS_BAR;
    for (int ui = 0;; ++ui) {
        const bool has_next = src.get(ui + 1, nxt);
        if (!has_next) nxt = cur;
        const unsigned an00 = GS_AOF(nxt, 0, R0, C0), an01 = GS_AOF(nxt, 0, R1, C1), an10 = GS_AOF(nxt, 1, R0, C0), an11 = GS_AOF(nxt, 1, R1, C1);
        const bool hi = cur.rows > 128;
        for (int t = 0; t < nt; t += 2) {
            const bool last = (t == nt - 2);
            const char* xA = last ? nxt.A : cur.A; const char* xB = last ? nxt.Bt : cur.Bt;
            const unsigned x00 = last ? an00 : ac00, x01 = last ? an01 : ac01, x10 = last ? an10 : ac10, x11 = last ? an11 : ac11;
            const int k2 = last ? 0 : t + 2, k3 = k2 + 1;
            GS_LDB(B0, 0, 0); GS_SCHED; GS_LDA(At, 0, 0); GS_STA(1, 1, cur.A, ac10, ac11, t + 1);
            GS_WL(8); GS_BAR; GS_WL(0); GS_MMA(0, 0, At, B0); GS_BAR; GS_SCHED;
            GS_LDB(B1, 0, 1); GS_STB(0, 0, xB, k2);
            GS_BAR; GS_WL(0); GS_MMA(0, 1, At, B1); GS_BAR;
            if (hi) GS_LDA(At, 0, 1); GS_STA(0, 0, xA, x00, x01, k2);
            GS_BAR; GS_WL(0); GS_MMA(1, 0, At, B0); GS_BAR; GS_SCHED;
            GS_STB(0, 1, xB, k2);
            GS_WV(6); GS_BAR; GS_MMA(1, 1, At, B1); GS_BAR;
            GS_LDB(B0, 1, 0); GS_SCHED; GS_LDA(At, 1, 0); GS_STA(0, 1, xA, x10, x11, k2);
            GS_WL(8); GS_BAR; GS_WL(0); GS_MMA(0, 0, At, B0); GS_BAR; GS_SCHED;
            GS_LDB(B1, 1, 1); GS_STB(1, 0, xB, k3);
            GS_BAR; GS_WL(0); GS_MMA(0, 1, At, B1); GS_BAR;
            if (hi) GS_LDA(At, 1, 1); GS_STA(1, 0, xA, x00, x01, k3);
            GS_BAR; GS_WL(0); GS_MMA(1, 0, At, B0); GS_BAR; GS_SCHED;
            GS_STB(1, 1, xB, k3);
            GS_WV(6); GS_BAR; GS_MMA(1, 1, At, B1); GS_BAR;
        }
        __builtin_amdgcn_sched_barrier(0);
        src.epi(acc, cur, wr, wc, fr, fq);
        __builtin_amdgcn_sched_barrier(0);
        if (!has_next) break;
#pragma unroll
        for (int a = 0; a < 2; ++a)
#pragma unroll
            for (int b = 0; b < 2; ++b)
#pragma unroll
                for (int m = 0; m < 4; ++m)
#pragma unroll
                    for (int n = 0; n < 2; ++n) acc[a][b][m][n] = (f32x4){0.f, 0.f, 0.f, 0.f};
        cur = nxt; ac00 = an00; ac01 = an01; ac10 = an10; ac11 = an11;
    }
    GS_WV(0);
    if (wr == 0) GS_BAR;
    GS_BAR;
#undef GS_AOF
#undef GS_SA
#undef GS_SB
#undef GS_GL
#undef GS_STA
#undef GS_STB
#undef GS_LDA
#undef GS_LDB
#undef GS_MMA
#undef GS_WV
#undef GS_WL
#undef GS_BAR
#undef GS_SCHED
}
struct Epi8PG { u16* PG; const float* lbl; int tok0, col0;
    __device__ __forceinline__ void operator()(const f32x4 (&acc)[2][2][4][2], int wr, int wc, int fr, int fq) const {
        const int grp = col0 >> 10;
        if (grp == 0) {
#pragma unroll
            for (int ai = 0; ai < 2; ++ai)
#pragma unroll
                for (int m = 0; m < 4; ++m) { u16* rowp = PG + (size_t)(tok0 + ai * 128 + wr * 64 + m * 16 + fr) * 5120 + col0 + wc * 32 + 8 * fq;
#pragma unroll
                    for (int bj = 0; bj < 2; ++bj) { float o[8];
#pragma unroll
                        for (int n = 0; n < 2; ++n)
#pragma unroll
                            for (int q = 0; q < 4; ++q) { const float x = acc[ai][bj][m][n][q]; o[4 * n + q] = x * __builtin_amdgcn_rcpf(1.0f + __expf(-x)); }
                        *(u32x4*)(rowp + bj * 128) = (u32x4){pk_bf16(o[0], o[1]), pk_bf16(o[2], o[3]), pk_bf16(o[4], o[5]), pk_bf16(o[6], o[7])}; } }
        } else if (grp <= 2) {
#pragma unroll
            for (int bj = 0; bj < 2; ++bj) { float lbv[8];
#pragma unroll
                for (int q = 0; q < 8; ++q) { const int c = (col0 & 1023) + bj * 128 + wc * 32 + 8 * fq + q; const float l0 = lbl[(grp - 1) * HGW + c], l1 = lbl[(2 + grp - 1) * HGW + c]; lbv[q] = __builtin_amdgcn_rcpf(1.0f + __expf(l1 - l0)); }
#pragma unroll
                for (int ai = 0; ai < 2; ++ai)
#pragma unroll
                    for (int m = 0; m < 4; ++m) { u16* rowp = PG + (size_t)(tok0 + ai * 128 + wr * 64 + m * 16 + fr) * 5120 + col0 + wc * 32 + 8 * fq; float o[8];
#pragma unroll
                        for (int n = 0; n < 2; ++n)
#pragma unroll
                            for (int q = 0; q < 4; ++q) { const float z = acc[ai][bj][m][n][q], lb = lbv[4 * n + q]; const float sg = __builtin_amdgcn_rcpf(1.0f + __expf(-z)); o[4 * n + q] = __log2f(lb + (1.0f - lb) * sg); }
                        *(u32x4*)(rowp + bj * 128) = (u32x4){pk_bf16(o[0], o[1]), pk_bf16(o[2], o[3]), pk_bf16(o[4], o[5]), pk_bf16(o[6], o[7])}; } }
        } else {
#pragma unroll
            for (int ai = 0; ai < 2; ++ai)
#pragma unroll
                for (int m = 0; m < 4; ++m) { u16* rowp = PG + (size_t)(tok0 + ai * 128 + wr * 64 + m * 16 + fr) * 5120 + col0 + wc * 32 + 8 * fq;
#pragma unroll
                    for (int bj = 0; bj < 2; ++bj) { const f32x4 v0 = acc[ai][bj][m][0], v1 = acc[ai][bj][m][1];
                        *(u32x4*)(rowp + bj * 128) = (u32x4){pk_bf16(v0[0], v0[1]), pk_bf16(v0[2], v0[3]), pk_bf16(v1[0], v1[1]), pk_bf16(v1[2], v1[3])}; } }
        }
    } };
struct Epi8HYT { u16* HYT; int tok0, col0;
    __device__ __forceinline__ void operator()(const f32x4 (&acc)[2][2][4][2], int wr, int wc, int fr, int fq) const {
#pragma unroll
        for (int bj = 0; bj < 2; ++bj)
#pragma unroll
            for (int n = 0; n < 2; ++n) { u16* colp = HYT + (size_t)(col0 + bj * 128 + wc * 32 + perm32(n * 16 + fr)) * NTOK + tok0 + wr * 64 + 4 * fq;
#pragma unroll
                for (int ai = 0; ai < 2; ++ai)
#pragma unroll
                    for (int m = 0; m < 4; ++m) { const f32x4 v = acc[ai][bj][m][n]; *(u32x2*)(colp + ai * 128 + m * 16) = (u32x2){pk_bf16(v[0], v[1]), pk_bf16(v[2], v[3])}; } }
    } };
struct Epi8X1 { const float* x; float* X1; int tok0, col0;
    __device__ __forceinline__ void operator()(const f32x4 (&acc)[2][2][4][2], int wr, int wc, int fr, int fq) const {
#pragma unroll
        for (int ai = 0; ai < 2; ++ai)
#pragma unroll
            for (int m = 0; m < 4; ++m) { const size_t off = (size_t)(tok0 + ai * 128 + wr * 64 + m * 16 + fr) * DM + col0 + wc * 32 + 8 * fq;
#pragma unroll
                for (int bj = 0; bj < 2; ++bj)
#pragma unroll
                    for (int n = 0; n < 2; ++n) { const f32x4 r = *(const f32x4*)(x + off + bj * 128 + n * 4); *(f32x4*)(X1 + off + bj * 128 + n * 4) = r + acc[ai][bj][m][n]; }
                asm volatile("" ::: "memory"); }
    } };
struct Epi8Swiglu { u16* HM; const float* b1; int slot0, nt, rows_valid;
    __device__ __forceinline__ void operator()(const f32x4 (&acc)[2][2][4][2], int wr, int wc, int fr, int fq) const {
        f32x4 bg[2], bl[2];
#pragma unroll
        for (int n = 0; n < 2; ++n) { const int col = nt * 128 + wc * 32 + 8 * fq + 4 * n; bg[n] = *(const f32x4*)(b1 + col); bl[n] = *(const f32x4*)(b1 + 2048 + col); }
#pragma unroll
        for (int ai = 0; ai < 2; ++ai)
#pragma unroll
            for (int m = 0; m < 4; ++m) { const int row = ai * 128 + wr * 64 + m * 16 + fr;
                if (row < rows_valid) { float o[8];
#pragma unroll
                    for (int n = 0; n < 2; ++n) { const f32x4 gl = acc[ai][0][m][n] + bg[n], li = acc[ai][1][m][n] + bl[n];
#pragma unroll
                        for (int j = 0; j < 4; ++j) { const float gq = fminf(gl[j], 7.0f), lq = fminf(fmaxf(li[j], -7.0f), 7.0f); o[4 * n + j] = gq * __builtin_amdgcn_rcpf(1.0f + __builtin_amdgcn_exp2f(-2.45546696f * gq)) * (lq + 1.0f); } }
                    *(u32x4*)(HM + (size_t)(slot0 + row) * DFF + nt * 128 + wc * 32 + 8 * fq) = (u32x4){pk_bf16(o[0], o[1]), pk_bf16(o[2], o[3]), pk_bf16(o[4], o[5]), pk_bf16(o[6], o[7])}; } }
    } };
struct Epi8Swiglu8 { unsigned char* HM; const float* b1; int slot0, nt, rows_valid;
    __device__ __forceinline__ void operator()(const f32x4 (&acc)[2][2][4][2], int wr, int wc, int fr, int fq) const {
        f32x4 bg[2], bl[2];
#pragma unroll
        for (int n = 0; n < 2; ++n) { const int col = nt * 128 + wc * 32 + 8 * fq + 4 * n; bg[n] = *(const f32x4*)(b1 + col); bl[n] = *(const f32x4*)(b1 + 2048 + col); }
#pragma unroll
        for (int ai = 0; ai < 2; ++ai)
#pragma unroll
            for (int m = 0; m < 4; ++m) { const int row = ai * 128 + wr * 64 + m * 16 + fr;
                if (row < rows_valid) { float o[8];
#pragma unroll
                    for (int n = 0; n < 2; ++n) { const f32x4 gl = acc[ai][0][m][n] + bg[n], li = acc[ai][1][m][n] + bl[n];
#pragma unroll
                        for (int j = 0; j < 4; ++j) { const float gq = fminf(gl[j], 7.0f), lq = fminf(fmaxf(li[j], -7.0f), 7.0f); o[4 * n + j] = gq * __builtin_amdgcn_rcpf(1.0f + __builtin_amdgcn_exp2f(-2.45546696f * gq)) * (lq + 1.0f); } }
                    *(u32x2*)(HM + (size_t)(slot0 + row) * DFF + nt * 128 + wc * 32 + 8 * fq) = (u32x2){pk_fp8x4(o[0], o[1], o[2], o[3]), pk_fp8x4(o[4], o[5], o[6], o[7])}; } }
    } };
struct Epi8Y { u16* Y; const float* b2; int slot0, col0, rows_valid;
    __device__ __forceinline__ void operator()(const f32x4 (&acc)[2][2][4][2], int wr, int wc, int fr, int fq) const {
        f32x4 bv[2][2];
#pragma unroll
        for (int bj = 0; bj < 2; ++bj)
#pragma unroll
            for (int n = 0; n < 2; ++n) bv[bj][n] = *(const f32x4*)(b2 + col0 + bj * 128 + wc * 32 + 8 * fq + 4 * n);
#pragma unroll
        for (int ai = 0; ai < 2; ++ai)
#pragma unroll
            for (int m = 0; m < 4; ++m) { const int row = ai * 128 + wr * 64 + m * 16 + fr;
                if (row < rows_valid) { u16* rowp = Y + (size_t)(slot0 + row) * DM + col0 + wc * 32 + 8 * fq;
#pragma unroll
                    for (int bj = 0; bj < 2; ++bj) { const f32x4 v0 = acc[ai][bj][m][0] + bv[bj][0], v1 = acc[ai][bj][m][1] + bv[bj][1];
                        *(u32x4*)(rowp + bj * 128) = (u32x4){pk_bf16(v0[0], v0[1]), pk_bf16(v0[2], v0[3]), pk_bf16(v1[0], v1[1]), pk_bf16(v1[2], v1[3])}; } } }
    } };
struct EpiNone { __device__ __forceinline__ void operator()(const f32x4 (&acc)[2][2][4][2], int wr, int wc, int fr, int fq) const {
#pragma unroll
        for (int a = 0; a < 2; ++a)
#pragma unroll
            for (int b = 0; b < 2; ++b)
#pragma unroll
                for (int m = 0; m < 4; ++m)
#pragma unroll
                    for (int n = 0; n < 2; ++n) asm volatile("" :: "v"(acc[a][b][m][n]));
    } };

template <int NTILES>
__device__ __forceinline__ bool moe_unit_static(const LAS int* us, const LAS int* so2, int uu, int& e, int& nt, int& slot0, int& rows) {
    if (uu >= us[NE]) return false;
    int lo = 0, hi = NE;
#pragma unroll
    for (int s = 0; s < 5; ++s) { const int mid = (lo + hi) >> 1; if (us[mid] <= uu) lo = mid; else hi = mid; }
    e = lo; const int o0 = e * NTOK, cnt = so2[e], mtl = (cnt + 255) >> 8, ul = uu - us[e], mt = ul % mtl;
    e = __builtin_amdgcn_readfirstlane(e); nt = __builtin_amdgcn_readfirstlane(ul / mtl); slot0 = __builtin_amdgcn_readfirstlane(o0 + mt * 256);
    rows = cnt - mt * 256; rows = __builtin_amdgcn_readfirstlane(rows > 256 ? 256 : rows); return true;
}
struct SrcMoeB { const LAS int* us; const LAS int* so2; int c, G; const char* HM8; const char* W2T8; u16* YB; const float* b2;
    __device__ __forceinline__ bool get(int i, StreamUnit& u) const { int e, nt, slot0, rows; if (!moe_unit_static<8>(us, so2, c + i * G, e, nt, slot0, rows)) return false;
        u.A = HM8; u.Bt = W2T8 + (size_t)((e * 8 + nt) * 16) * 32768; u.arow0 = slot0; u.rows = rows; u.a = e; u.b = nt; u.c = slot0; return true; }
    __device__ __forceinline__ void epi(const f32x4 (&acc)[2][2][4][2], const StreamUnit& u, int wr, int wc, int fr, int fq) const { Epi8Y ep{YB, b2 + (size_t)u.a * DM, u.c, u.b * 256, u.rows}; ep(acc, wr, wc, fr, fq); }
};
template <bool TRANS>
struct SrcG1 { int c, G; const char* HBp; const char* WINTp; u16* PG; u16* HYT; const float* lbl; int ktiles;
    __device__ __forceinline__ bool get(int k, StreamUnit& su) const {
        int seen = 0;
        for (int u = c; u < 1024; u += G) { const int i = u >> 8, xx = (u >> 5) & 7, j = u & 31; const int mt = (xx & 3) * 8 + (j & 7), nt = ((xx >> 2) + 2 * i) * 4 + (j >> 3);
            if ((nt >= 20) == TRANS) { if (seen == k) { su.A = HBp; su.Bt = WINTp + (size_t)nt * ktiles * 32768; su.arow0 = mt * 256; su.rows = 256; su.a = mt; su.b = nt; su.c = 0; return true; } ++seen; } }
        return false; }
    __device__ __forceinline__ void epi(const f32x4 (&acc)[2][2][4][2], const StreamUnit& u, int wr, int wc, int fr, int fq) const {
        if (TRANS) { Epi8HYT e{HYT, u.a * 256, u.b * 256 - 5120}; e(acc, wr, wc, fr, fq); } else { Epi8PG e{PG, lbl, u.a * 256, u.b * 256}; e(acc, wr, wc, fr, fq); } }
};

typedef float f32x16 __attribute__((ext_vector_type(16)));
__device__ __forceinline__ void h3_row(int m, const float* __restrict__ w1, const float* __restrict__ b1, const float* __restrict__ w2, const float* __restrict__ b2,
                                       const float* __restrict__ w3, const float* __restrict__ b3, const float* __restrict__ freq, LAS float* sc  , float* __restrict__ H3) {
    const int j = tid_fresh() & 63;
    const float tt = (float)m / (float)(SEQ - 1);
    if (j == 0) sc[0] = tt;
    if (j >= 1 && j <= 16) { const int i = j - 1; const float band = 1e-4f + (float)i * ((15.0f - 1e-4f) / 15.0f); const float ang = (2.0f * 3.14159265358979323846f / (float)SEQ) * (float)m * band; sc[1 + i] = cosf(ang); sc[17 + i] = -sinf(ang); }
    __builtin_amdgcn_wave_barrier();
    const float fr = freq[j];
    float s = b1[j];
    for (int i = 0; i < 33; ++i) s += sc[i] * w1[i * 64 + j];
    const float h1 = sinf(fr * s);
    sc[64 + j] = h1;
    __builtin_amdgcn_wave_barrier();
    s = b2[j];
    for (int i = 0; i < 64; ++i) s += sc[64 + i] * w2[i * 64 + j];
    const float h2 = sinf(fr * s);
    __builtin_amdgcn_wave_barrier();
    sc[j] = h2;
    __builtin_amdgcn_wave_barrier();
    s = b3[j];
    for (int i = 0; i < 64; ++i) s += sc[i] * w3[i * 64 + j];
    H3[(size_t)m * 64 + j] = sinf(fr * s);
    __builtin_amdgcn_wave_barrier();
}
constexpr int FR_LEN = 4128;
__device__ __forceinline__ void frgen_item(LAS unsigned char* lds, int item, const float* __restrict__ H3, const float* __restrict__ w4, u16* __restrict__ FR) {
    const int tid = tid_fresh(), wid = __builtin_amdgcn_readfirstlane(tid >> 6), lane = tid & 63, fr = lane & 15, fq = lane >> 4;
    const int oc0 = item * 8, o = oc0 >> 10;
    const int colB = o * 2048 + (fr >> 3) * 1024 + (oc0 & 1023) + (fr & 7);
    float wreg[16];
#pragma unroll
    for (int ks = 0; ks < 16; ++ks) wreg[ks] = w4[(size_t)(4 * ks + fq) * 4096 + colB];
    const int dir = fr >> 3, c = (oc0 & 1023) + (fr & 7);
    const float mind = logf(1e-2f) / 0.3f, maxd = logf(1e-2f) / 1.5f;
    const float delta = fabsf(mind + (float)c * ((maxd - mind) / 1023.0f));
    u16* r0 = FR + (size_t)((oc0 + (fr & 7)) * 2) * FR_LEN;
    LAS float* tile = (LAS float*)(lds + wid * 4608);
    const int wrow = lane >> 4, wcol = 4 * (lane & 15);
    f32x4 nx[4];
#pragma unroll
    for (int q = 0; q < 4; ++q) nx[q] = *(const f32x4*)(H3 + (size_t)wid * 1024 + q * 256 + lane * 4);
    for (int it = 0; it < 16; ++it) {
        const int mt = wid + 8 * it;
#pragma unroll
        for (int q = 0; q < 4; ++q) *(LAS f32x4*)(tile + (q * 4 + wrow) * 68 + wcol) = nx[q];
        if (it + 1 < 16) {
#pragma unroll
            for (int q = 0; q < 4; ++q) nx[q] = *(const f32x4*)(H3 + (size_t)(mt + 8) * 1024 + q * 256 + lane * 4);
        }
        f32x4 acc = {0.f, 0.f, 0.f, 0.f}, acc1 = acc;
#pragma unroll
        for (int ks = 0; ks < 16; ks += 2) { acc = __builtin_amdgcn_mfma_f32_16x16x4f32(tile[fr * 68 + 4 * ks + fq], wreg[ks], acc, 0, 0, 0);
            acc1 = __builtin_amdgcn_mfma_f32_16x16x4f32(tile[fr * 68 + 4 * (ks + 1) + fq], wreg[ks + 1], acc1, 0, 0, 0); }
        acc += acc1;
        const int m0 = mt * 16 + 4 * fq;
        float v[4];
#pragma unroll
        for (int j = 0; j < 4; ++j) v[j] = acc[j] * __expf(-((float)(m0 + j) * (1.0f / (float)(SEQ - 1))) * delta);
        if (dir == 0) {
            *(u32x2*)(r0 + 2044 - m0) = (u32x2){pk_bf16(v[3], v[2]), pk_bf16(v[1], v[0])};
#pragma unroll
            for (int j = 0; j < 4; ++j) r0[FR_LEN + 2046 - m0 - j] = (u16)(pk_bf16(v[j], 0.f) & 0xffffu);
        } else {
#pragma unroll
            for (int j = 0; j < 4; ++j) if (m0 + j >= 1) { const u16 b = (u16)(pk_bf16(v[j], 0.f) & 0xffffu); r0[2047 + m0 + j] = b; r0[FR_LEN + 2046 + m0 + j] = b; }
        }
    }
    if (tid < 8 * 34) { const int r = tid / 34, x = 4094 + tid % 34; u16* rr = FR + (size_t)((oc0 + r) * 2) * FR_LEN; if (x >= 4095) rr[x] = 0; rr[FR_LEN + x] = 0; }
    __syncthreads();
}
constexpr int HY_ZSTRIDE = 2312;
constexpr int HY_ZCH = 256 + 4 * HY_ZSTRIDE;
constexpr int HY_ZBYTES = HY_ZCH * 2;
constexpr int HY_FB = 4 * HY_ZBYTES;
constexpr int HY_FCH = 2 * FR_LEN * 2;
constexpr int HY_LDS = HY_FB + 4 * HY_FCH;

__device__ __forceinline__ void hy_load_row(LAS unsigned char* lds, int dest, int boff0, int bstride, const u16* __restrict__ row, float w0, float w1, float w2, float cb, int pl) {
#pragma unroll 2
    for (int it = 0; it < 8; ++it) {
        const int idx = pl + 128 * it, tok0 = idx * 8, b = tok0 >> 11, n0 = tok0 & 2047;
        const u32x4 raw = *(const u32x4*)(row + tok0);
        const float pm = (n0 > 0) ? bf2f(row[tok0 - 1]) : 0.f;
        const float pn = (n0 + 8 < SEQ) ? bf2f(row[tok0 + 8]) : 0.f;
        float p[10];
        p[0] = pm; p[9] = pn;
#pragma unroll
        for (int q = 0; q < 4; ++q) { p[1 + 2 * q] = bflo(raw[q]); p[2 + 2 * q] = bfhi(raw[q]); }
        float o[8];
#pragma unroll
        for (int q = 0; q < 8; ++q) o[q] = fmaf(w0, p[q], fmaf(w1, p[q + 1], fmaf(w2, p[q + 2], cb)));
        u32x4 w; w[0] = pk_bf16(o[0], o[1]); w[1] = pk_bf16(o[2], o[3]); w[2] = pk_bf16(o[4], o[5]); w[3] = pk_bf16(o[6], o[7]);
        *(LAS u32x4*)(lds + dest + (boff0 + b * bstride + n0) * 2) = w;
    }
}
__device__ __forceinline__ void hy_load_filters(LAS unsigned char* lds, int fb, const u16* __restrict__ src, int pl) {
    for (int idx = pl; idx < HY_FCH / 16; idx += 128) *(LAS u32x4*)(lds + fb + idx * 16) = *(const u32x4*)((const char*)src + idx * 16);
}
__device__ __forceinline__ void hy_mfma_loop(LAS unsigned char* lds, int zb, int fb, int hlf, int lane, f32x16 (&acc)[4], const ConvCtx& cc, int mbase, int cunit, int wid) {
    const int r = lane & 31, hh = lane >> 5, il = r >> 2, b = r & 3;
    const int bbase = zb + (256 + b * HY_ZSTRIDE + 32 * il + 8 * hh) * 2;
    const int xl = 2047 - r + 8 * hh - 1024 * hlf;
    const int abase = (r & 1) ? (fb + 2 * xl) : (fb + FR_LEN * 2 + 2 * (xl - 1));
#pragma unroll
    for (int q = 0; q < 4; ++q)
#pragma unroll
        for (int i = 0; i < 16; ++i) acc[q][i] = 0.f;
    f32x2 cvA[16], cvB[16];
    conv_issue(cc, conv_seq2tile((mbase + 0) * 256 + cunit), wid, lane, cvA);
    for (int d0 = 0; d0 < 8; ++d0) {
#pragma unroll
        for (int ks = 0; ks < 2; ++ks) {
            const int idx = d0 * 2 + ks;
            const int mcv = conv_seq2tile((mbase + idx) * 256 + cunit), mnx = conv_seq2tile((mbase + idx + 1) * 256 + cunit);
            if (idx + 1 < 16) { if (ks == 0) conv_issue(cc, mnx, wid, lane, cvB); else conv_issue(cc, mnx, wid, lane, cvA); }
            bf16x8 Bt[9];
#pragma unroll
            for (int j = 0; j < 9; ++j) Bt[j] = *(const LAS bf16x8*)(lds + bbase + 512 * j - 64 * d0 + 32 * ks);
#pragma unroll
            for (int ep = -8; ep <= 3; ++ep) {
                const LAS unsigned* ap = (const LAS unsigned*)(lds + abase - 64 * d0 - 512 * ep + 32 * ks);
                u32x4 av; av[0] = ap[0]; av[1] = ap[1]; av[2] = ap[2]; av[3] = ap[3];
                const bf16x8 a = __builtin_bit_cast(bf16x8, av);
#pragma unroll
                for (int ctl = 0; ctl < 4; ++ctl) { const int jt = ctl - ep; if (jt >= 0 && jt <= 8) acc[ctl] = __builtin_amdgcn_mfma_f32_32x32x16_bf16(a, Bt[jt], acc[ctl], 0, 0, 0); }
            }
            if (ks == 0) conv_finish(cc, mcv, wid, lane, cvA); else conv_finish(cc, mcv, wid, lane, cvB);
        }
    }
}
__device__ __forceinline__ void hy_epilogue(LAS unsigned char* lds, int zb, int gb, int hlf, int lane, const f32x16 (&acc)[4], float bias) {
    const int r = lane & 31, hh = lane >> 5, il = r >> 2, b = r & 3;
#pragma unroll
    for (int ctl = 0; ctl < 4; ++ctl) {
        const int I = 8 * (4 * hlf + ctl) + il;
#pragma unroll
        for (int q = 0; q < 4; ++q) {
            const int n4 = 32 * I + 8 * q + 4 * hh;
            LAS u32x2* zp = (LAS u32x2*)(lds + zb + (256 + b * HY_ZSTRIDE + n4) * 2);
            const u32x2 zv = *zp, gv = *(const LAS u32x2*)(lds + gb + (b * 2048 + n4) * 2);
            const float z0 = bflo(zv[0]), z1 = bfhi(zv[0]), z2 = bflo(zv[1]), z3 = bfhi(zv[1]);
            const float g0 = bflo(gv[0]), g1 = bfhi(gv[0]), g2 = bflo(gv[1]), g3 = bfhi(gv[1]);
            u32x2 o; o[0] = pk_bf16(g0 * fmaf(bias, z0, acc[ctl][4 * q + 0]), g1 * fmaf(bias, z1, acc[ctl][4 * q + 1]));
            o[1] = pk_bf16(g2 * fmaf(bias, z2, acc[ctl][4 * q + 2]), g3 * fmaf(bias, z3, acc[ctl][4 * q + 3]));
            *zp = o;
        }
    }
}
__device__ __forceinline__ void hyena_unit(LAS unsigned char* lds, int unit, const u16* __restrict__ HYT, const u16* __restrict__ FR, const float* __restrict__ cw, const float* __restrict__ cbv,
                                           const float* __restrict__ hbias, u16* __restrict__ Z2T, const ConvCtx& cc) {
    const int tid = tid_fresh(), wid = __builtin_amdgcn_readfirstlane(tid >> 6), lane = tid & 63;
    const int cs = wid & 3, hlf = wid >> 2, c = unit * 4 + cs, pl = lane + 64 * hlf;
    const int zb = cs * HY_ZBYTES, fb = HY_FB + cs * HY_FCH;
    { const u32x4 z = {0u, 0u, 0u, 0u}; for (int idx = pl; idx < HY_ZBYTES / 16; idx += 128) *(LAS u32x4*)(lds + zb + idx * 16) = z; }
    __syncthreads();
    hy_load_row(lds, zb, 256, HY_ZSTRIDE, HYT + (size_t)c * NTOK, cw[0 * 3072 + c], cw[1 * 3072 + c], cw[2 * 3072 + c], cbv[c], pl);
    f32x16 acc[4];
#pragma unroll
    for (int o = 0; o < 2; ++o) {
        hy_load_filters(lds, fb, FR + (size_t)((o * 1024 + c) * 2) * FR_LEN, pl);
        __syncthreads();
        hy_mfma_loop(lds, zb, fb, hlf, lane, acc, cc, o * 16, unit, wid);
        __syncthreads();
        const int gc = (1 + o) * 1024 + c;
        hy_load_row(lds, fb, 0, 2048, HYT + (size_t)gc * NTOK, cw[0 * 3072 + gc], cw[1 * 3072 + gc], cw[2 * 3072 + gc], cbv[gc], pl);
        __syncthreads();
        hy_epilogue(lds, zb, fb, hlf, lane, acc, hbias[o * HYW + c]);
        __syncthreads();
    }
#pragma unroll 2
    for (int it = 0; it < 8; ++it) { const int idx = pl + 128 * it, tok0 = idx * 8, b = tok0 >> 11, n0 = tok0 & 2047;
        *(u32x4*)(Z2T + (size_t)c * NTOK + tok0) = *(const LAS u32x4*)(lds + zb + (256 + b * HY_ZSTRIDE + n0) * 2); }
    __syncthreads();
}

constexpr int HG_RAWQ = 0, HG_RAWF = 16384, HG_RAWV = 32768;
constexpr int HG_QM = 36864, HG_KM = HG_QM + 17408, HG_QI = HG_KM + 17408;
constexpr int HG_KL = HG_QI + 17408;
constexpr int HG_VT = HG_KL + 18432;
constexpr int HG_P = HG_VT + 4608;
constexpr int HG_ST = HG_P + 9216;
constexpr int HG_TOT = HG_ST + 8704;
constexpr int HG_EL2 = HG_TOT + 4096;
constexpr int HG_LDS = HG_EL2 + 512;

__device__ __forceinline__ void hgrn_unit(LAS unsigned char* lds, int unit, const u16* __restrict__ PG, const float* __restrict__ lb_logits, float* __restrict__ OF, float* __restrict__ OB, const ConvCtx& cc) {
    const int tid = tid_fresh(), wid = __builtin_amdgcn_readfirstlane(tid >> 6), lane = tid & 63, fr = lane & 15, fq = lane >> 4;
    const int h = unit & 7, vq = (unit >> 3) & 3, dir = (unit >> 5) & 1, b = unit >> 6;
    const int k = tid & 127, seg = tid >> 7;
    float* __restrict__ O = dir ? OB : OF;
    for (int i = tid; i < 8704 / 16; i += 512) *(LAS u32x4*)(lds + HG_ST + i * 16) = (u32x4){0u, 0u, 0u, 0u};
    f32x4 Sacc[2];
    Sacc[0] = (f32x4){0.f, 0.f, 0.f, 0.f}; Sacc[1] = Sacc[0];
    u32x4 pq[2], pf[2], pv;
    const int colq = h * 128, colf = (1 + dir) * 1024 + h * 128, colv = 3072 + h * 128 + vq * 32;
#define HG_TOK(c, tau) ((size_t)b * SEQ + (dir ? (SEQ - 1 - 64 * (c) - (tau)) : (64 * (c) + (tau))))
#define HG_PREFETCH(c) do { _Pragma("unroll") for (int _i = 0; _i < 2; ++_i) { const int _x = tid + 512 * _i, _tau = _x >> 4, _p = _x & 15; const u16* _r = PG + HG_TOK(c, _tau) * 5120; \
            pq[_i] = *(const u32x4*)(_r + colq + _p * 8); pf[_i] = *(const u32x4*)(_r + colf + _p * 8); } \
        if (tid < 256) { const int _tau = tid >> 2, _p = tid & 3; pv = *(const u32x4*)(PG + HG_TOK(c, _tau) * 5120 + colv + _p * 8); } } while (0)
#define HG_RAW2LDS() do { _Pragma("unroll") for (int _i = 0; _i < 2; ++_i) { const int _x = tid + 512 * _i; *(LAS u32x4*)(lds + HG_RAWQ + _x * 16) = pq[_i]; *(LAS u32x4*)(lds + HG_RAWF + _x * 16) = pf[_i]; } \
        if (tid < 256) *(LAS u32x4*)(lds + HG_RAWV + tid * 16) = pv; } while (0)
    HG_PREFETCH(0);
    HG_RAW2LDS();
    HG_PREFETCH(1);
    __syncthreads();
    for (int c = 0; c < 32; ++c) {
        f32x2 cv[16];
        const int mqa = conv_seq2tile((32 + c * 2) * 256 + unit), mqb = conv_seq2tile((33 + c * 2) * 256 + unit);
        conv_issue(cc, mqa, wid, lane, cv);
        const int kp = lane, sg = wid;
        float qv0[8], qv1[8], kv0[8], kv1[8], bl0[8], bl1[8];
        { float r0 = 0.f, r1 = 0.f;
#pragma unroll
          for (int i = 0; i < 8; ++i) { const int tau = sg * 8 + i;
              const unsigned qw = *(const LAS unsigned*)(lds + HG_RAWQ + tau * 256 + kp * 4), fw = *(const LAS unsigned*)(lds + HG_RAWF + tau * 256 + kp * 4);
              const float l0 = bflo(fw), l1 = bfhi(fw);
              r0 += l0; r1 += l1; bl0[i] = r0; bl1[i] = r1; kv0[i] = 1.0f - __builtin_amdgcn_exp2f(l0); kv1[i] = 1.0f - __builtin_amdgcn_exp2f(l1); qv0[i] = bflo(qw); qv1[i] = bfhi(qw); }
          *(LAS f32x2*)(lds + HG_TOT + (sg * 128 + 2 * kp) * 4) = (f32x2){r0, r1}; }
        __syncthreads();
        { f32x2 tt[8];
#pragma unroll
          for (int q = 0; q < 8; ++q) tt[q] = *(const LAS f32x2*)(lds + HG_TOT + (q * 128 + 2 * kp) * 4);
          f32x2 pre = {0.f, 0.f};
#pragma unroll
          for (int q = 0; q < 7; ++q) if (q < sg) pre += tt[q];
          const f32x2 bref = tt[0] + tt[1] + tt[2] + tt[3], blast = bref + tt[4] + tt[5] + tt[6] + tt[7];
          const float er0 = __builtin_amdgcn_exp2f(bref[0]), er1 = __builtin_amdgcn_exp2f(bref[1]), el0 = __builtin_amdgcn_exp2f(blast[0] - bref[0]), el1 = __builtin_amdgcn_exp2f(blast[1] - bref[1]);
          if (sg == 0) *(LAS f32x2*)(lds + HG_EL2 + 2 * kp * 4) = (f32x2){__builtin_amdgcn_exp2f(blast[0]), __builtin_amdgcn_exp2f(blast[1])};
          const f32x2 dref = pre - bref;
          float kl0[8], kl1[8];
#pragma unroll
          for (int i = 0; i < 8; ++i) { const int tau = sg * 8 + i; const float x0 = dref[0] + bl0[i], x1 = dref[1] + bl1[i];
              const float qm0 = qv0[i] * __builtin_amdgcn_exp2f(x0), qm1 = qv1[i] * __builtin_amdgcn_exp2f(x1), km0 = kv0[i] * __builtin_amdgcn_exp2f(-x0), km1 = kv1[i] * __builtin_amdgcn_exp2f(-x1);
              *(LAS unsigned*)(lds + HG_QM + tau * 272 + kp * 4) = pk_bf16(qm0, qm1);
              *(LAS unsigned*)(lds + HG_KM + tau * 272 + kp * 4) = pk_bf16(km0, km1);
              *(LAS unsigned*)(lds + HG_QI + tau * 272 + kp * 4) = pk_bf16(qm0 * er0, qm1 * er1);
              kl0[i] = km0 * el0; kl1[i] = km1 * el1; }
          *(LAS u32x4*)(lds + HG_KL + (2 * kp) * 144 + sg * 16) = (u32x4){pk_bf16(kl0[0], kl0[1]), pk_bf16(kl0[2], kl0[3]), pk_bf16(kl0[4], kl0[5]), pk_bf16(kl0[6], kl0[7])};
          *(LAS u32x4*)(lds + HG_KL + (2 * kp + 1) * 144 + sg * 16) = (u32x4){pk_bf16(kl1[0], kl1[1]), pk_bf16(kl1[2], kl1[3]), pk_bf16(kl1[4], kl1[5]), pk_bf16(kl1[6], kl1[7])};
          { const int v = tid & 31, tg = tid >> 5; unsigned short e[4];
#pragma unroll
            for (int u = 0; u < 4; ++u) e[u] = *(const LAS u16*)(lds + HG_RAWV + (tg * 4 + u) * 64 + v * 2);
            *(LAS u32x2*)(lds + HG_VT + v * 144 + tg * 8) = (u32x2){(unsigned)e[0] | ((unsigned)e[1] << 16), (unsigned)e[2] | ((unsigned)e[3] << 16)}; } }
        conv_finish(cc, mqa, wid, lane, cv);
        conv_issue(cc, mqb, wid, lane, cv);
        __syncthreads();
        if (c + 1 < 32) { HG_RAW2LDS(); if (c + 2 < 32) HG_PREFETCH(c + 2); }
#pragma unroll
        for (int q = 0; q < 2; ++q) { const int idx = wid * 2 + q, ti = idx >> 2, si = idx & 3;
            f32x4 a = {0.f, 0.f, 0.f, 0.f};
            if (si <= ti) {
#pragma unroll
                for (int ks = 0; ks < 4; ++ks) { const bf16x8 ka = *(const LAS bf16x8*)(lds + HG_KM + (si * 16 + fr) * 272 + (ks * 32 + fq * 8) * 2), qb = *(const LAS bf16x8*)(lds + HG_QM + (ti * 16 + fr) * 272 + (ks * 32 + fq * 8) * 2);
                    a = __builtin_amdgcn_mfma_f32_16x16x32_bf16(ka, qb, a, 0, 0, 0); } }
            const int tau = ti * 16 + fr, s0 = si * 16 + fq * 4;
            float pvv[4];
#pragma unroll
            for (int j = 0; j < 4; ++j) pvv[j] = (si <= ti && s0 + j <= tau) ? a[j] : 0.f;
            *(LAS u32x2*)(lds + HG_P + tau * 144 + s0 * 2) = (u32x2){pk_bf16(pvv[0], pvv[1]), pk_bf16(pvv[2], pvv[3])}; }
        const int ti = wid >> 1, vi = wid & 1;
        f32x4 oacc = {0.f, 0.f, 0.f, 0.f};
#pragma unroll
        for (int ks = 0; ks < 4; ++ks) { const bf16x8 qa = *(const LAS bf16x8*)(lds + HG_QI + (ti * 16 + fr) * 272 + (ks * 32 + fq * 8) * 2), sb = *(const LAS bf16x8*)(lds + HG_ST + (vi * 16 + fr) * 272 + (ks * 32 + fq * 8) * 2);
            oacc = __builtin_amdgcn_mfma_f32_16x16x32_bf16(qa, sb, oacc, 0, 0, 0); }
        { const f32x4 e2 = *(const LAS f32x4*)(lds + HG_EL2 + (wid * 16 + fq * 4) * 4);
#pragma unroll
          for (int v2 = 0; v2 < 2; ++v2) { Sacc[v2] = Sacc[v2] * e2;
#pragma unroll
              for (int ks = 0; ks < 2; ++ks) { const bf16x8 ka = *(const LAS bf16x8*)(lds + HG_KL + (wid * 16 + fr) * 144 + (ks * 32 + fq * 8) * 2), vb = *(const LAS bf16x8*)(lds + HG_VT + (v2 * 16 + fr) * 144 + (ks * 32 + fq * 8) * 2);
                  Sacc[v2] = __builtin_amdgcn_mfma_f32_16x16x32_bf16(ka, vb, Sacc[v2], 0, 0, 0); } } }
        __syncthreads();
#pragma unroll
        for (int ks = 0; ks < 2; ++ks) { const bf16x8 pa = *(const LAS bf16x8*)(lds + HG_P + (ti * 16 + fr) * 144 + (ks * 32 + fq * 8) * 2), vb = *(const LAS bf16x8*)(lds + HG_VT + (vi * 16 + fr) * 144 + (ks * 32 + fq * 8) * 2);
            oacc = __builtin_amdgcn_mfma_f32_16x16x32_bf16(pa, vb, oacc, 0, 0, 0); }
#pragma unroll
        for (int j = 0; j < 4; ++j) { const int tau = ti * 16 + fq * 4 + j; O[HG_TOK(c, tau) * HGW + h * 128 + vq * 32 + vi * 16 + fr] = oacc[j]; }
        conv_finish(cc, mqb, wid, lane, cv);
#pragma unroll
        for (int v2 = 0; v2 < 2; ++v2) *(LAS u32x2*)(lds + HG_ST + (v2 * 16 + fr) * 272 + (wid * 16 + fq * 4) * 2) = (u32x2){pk_bf16(Sacc[v2][0], Sacc[v2][1]), pk_bf16(Sacc[v2][2], Sacc[v2][3])};
    }
    __syncthreads();
#undef HG_TOK
#undef HG_PREFETCH
#undef HG_RAW2LDS
}


#define XB_TMO      128
#define XB_XCNT(j)  (256  + 64 * (j))
#define XB_XSUB(j)  (1280 + 64 * (j))
#define XB_XGEN(j)  (2304 + 64 * (j))
#define XB_TOP      3328
#define XB_TOPGEN   3392
#define XCD_BAR_WORDS 3456
#define XB_SPIN_CAP (1u << 22)

__device__ __forceinline__ unsigned xb_ld(unsigned* p)              { return __hip_atomic_load(p, __ATOMIC_RELAXED, __HIP_MEMORY_SCOPE_AGENT); }
__device__ __forceinline__ unsigned xb_add(unsigned* p, unsigned v) { return __hip_atomic_fetch_add(p, v, __ATOMIC_RELAXED, __HIP_MEMORY_SCOPE_AGENT); }
__device__ __forceinline__ unsigned xb_xcc_id() { return (unsigned)__builtin_amdgcn_s_getreg((3 << 11) | 20) & 0xFu; }
#define XB_SPIN(cond, bar) do { unsigned _sp = 0; while (cond) { __builtin_amdgcn_s_sleep(1); \
    if ((++_sp & 255u) == 0u) { if (xb_ld(&(bar)[XB_TMO])) break; if (_sp > XB_SPIN_CAP) { atomicAdd(&(bar)[XB_TMO], 1u); break; } } } } while (0)

struct XcdBarrier {
    unsigned* bar; unsigned x;
    volatile LAS unsigned* st;
};

__device__ __forceinline__ XcdBarrier xcd_barrier_post(unsigned* bar, volatile LAS unsigned* st) {
    XcdBarrier b; b.bar = bar; b.x = xb_xcc_id(); b.st = st;
    if (threadIdx.x == 0) (void)xb_add(&bar[XB_XCNT(b.x)], 1u);
    return b;
}
__device__ __forceinline__ void xcd_barrier_complete(unsigned* bar, unsigned x, unsigned& nloc, unsigned& nx) {
    const unsigned G = gridDim.x * gridDim.y * gridDim.z;
    unsigned sum, cnt, mine, sp = 0u;
    for (;;) {
        sum = 0u; cnt = 0u; mine = 0u;
#pragma unroll
        for (unsigned j = 0; j < 16; ++j) { const unsigned c = xb_ld(&bar[XB_XCNT(j)]); sum += c; cnt += (c > 0u) ? 1u : 0u; mine = (j == x) ? c : mine; }
        if (sum == G) break;
        __builtin_amdgcn_s_sleep(1);
        if ((++sp & 255u) == 0u) { if (xb_ld(&bar[XB_TMO])) break; if (sp > XB_SPIN_CAP) { atomicAdd(&bar[XB_TMO], 1u); break; } }
    }
    nloc = mine > 0u ? mine : 1u; nx = cnt > 0u ? cnt : 1u;
}

__device__ __forceinline__ void xcd_barrier(const XcdBarrier& b) {
    asm volatile("s_waitcnt vmcnt(0)" ::: "memory");
    __syncthreads();
    if (threadIdx.x == 0) {
        unsigned* bar = b.bar;
        __builtin_amdgcn_s_waitcnt(0);
        unsigned nloc = b.st[0], nx = b.st[1];
        if (nloc == 0u) { xcd_barrier_complete(bar, b.x, nloc, nx); b.st[0] = nloc; b.st[1] = nx; }
        const unsigned old = xb_add(&bar[XB_XSUB(b.x)], 1u);
        const unsigned gen = old / nloc;
        if (old + 1u == (gen + 1u) * nloc) {
            __builtin_amdgcn_fence(__ATOMIC_RELEASE, "agent");
            asm volatile("s_waitcnt vmcnt(0)" ::: "memory");
            const unsigned og = xb_add(&bar[XB_TOP], 1u);
            const unsigned tg = og / nx;
            if (og + 1u == (tg + 1u) * nx) xb_add(&bar[XB_TOPGEN], 1u);
            else XB_SPIN(xb_ld(&bar[XB_TOPGEN]) == tg, bar);
            __builtin_amdgcn_fence(__ATOMIC_ACQUIRE, "agent");
            xb_add(&bar[XB_XGEN(b.x)], 1u);
            asm volatile("s_waitcnt vmcnt(0)" ::: "memory");
        } else {
            XB_SPIN(xb_ld(&bar[XB_XGEN(b.x)]) == gen, bar);
            __builtin_amdgcn_fence(__ATOMIC_ACQUIRE, "agent");
            asm volatile("s_waitcnt vmcnt(0)" ::: "memory");
        }
    }
    __syncthreads();
}

__device__ __forceinline__ float wave_sum(float s) {
#pragma unroll
    for (int o = 32; o >= 1; o >>= 1) s += __shfl_xor(s, o);
    return s;
}
__device__ __forceinline__ void rmsnorm_row_bf(const float* __restrict__ xr, const float* __restrict__ gain, u16* __restrict__ ob, unsigned char* __restrict__ ob8, int lane) {
    f32x4 v[8]; float s = 0.f;
#pragma unroll
    for (int j = 0; j < 8; ++j) { v[j] = *(const f32x4*)(xr + (lane + 64 * j) * 4); s += v[j][0] * v[j][0] + v[j][1] * v[j][1] + v[j][2] * v[j][2] + v[j][3] * v[j][3]; }
    s = wave_sum(s);
    const float r = rsqrtf(s * (1.0f / (float)DM) + EPS);
#pragma unroll
    for (int j = 0; j < 8; ++j) { const f32x4 g = *(const f32x4*)(gain + (lane + 64 * j) * 4); const f32x4 o = v[j] * r * g;
        *(u32x2*)(ob + (lane + 64 * j) * 4) = (u32x2){pk_bf16(o[0], o[1]), pk_bf16(o[2], o[3])};
        *(unsigned*)(ob8 + (lane + 64 * j) * 4) = pk_fp8x4(o[0], o[1], o[2], o[3]); }
}
__device__ __forceinline__ void hgrn_final_item4(int item0, int stride, const float* __restrict__ OF, const float* __restrict__ OB, const u16* __restrict__ PG, const float* __restrict__ gain, u16* __restrict__ MIXB, int lane) {
    f32x2 a[4], b[4]; unsigned gw[4];
#pragma unroll
    for (int q = 0; q < 4; ++q) { const int item = item0 + q * stride, tok = item >> 3, c = (item & 7) * 128 + 2 * lane;
        a[q] = *(const f32x2*)(OF + (size_t)tok * HGW + c); b[q] = *(const f32x2*)(OB + (size_t)tok * HGW + c); gw[q] = *(const unsigned*)(PG + (size_t)tok * 5120 + 4096 + c); }
#pragma unroll
    for (int q = 0; q < 4; ++q) { const int item = item0 + q * stride, tok = item >> 3, c = (item & 7) * 128 + 2 * lane;
        const float o0 = a[q][0] + b[q][0], o1 = a[q][1] + b[q][1];
        const float s = wave_sum(o0 * o0 + o1 * o1);
        const float r = rsqrtf(s * (1.0f / 128.0f) + EPS);
        const float g0 = bflo(gw[q]), g1 = bfhi(gw[q]);
        const f32x2 gn = *(const f32x2*)(gain + c);
        const float v0 = o0 * r * gn[0] * (g0 * __builtin_amdgcn_rcpf(1.0f + __expf(-g0))), v1 = o1 * r * gn[1] * (g1 * __builtin_amdgcn_rcpf(1.0f + __expf(-g1)));
        *(unsigned*)(MIXB + (size_t)tok * DM + c) = pk_bf16(v0, v1); }
}
__device__ __forceinline__ void hy_norm_tile(LAS unsigned char* lds, int tile_i, const u16* __restrict__ Z2T, const float* __restrict__ gain, u16* __restrict__ MIXB) {
    const int t = tid_fresh(), tok0 = tile_i * 32;
    LAS float* ssq = (LAS float*)(lds + 1024 * 80);
    if (t < 32) ssq[t] = 0.f;
    __syncthreads();
    float part[8];
#pragma unroll
    for (int q = 0; q < 8; ++q) part[q] = 0.f;
    const int ch = t & 3;
#pragma unroll
    for (int it = 0; it < 8; ++it) {
        const int c = (t >> 2) + 128 * it;
        const u32x4 v = *(const u32x4*)(Z2T + (size_t)c * NTOK + tok0 + ch * 8);
        *(LAS u32x4*)(lds + c * 80 + ch * 16) = v;
#pragma unroll
        for (int q = 0; q < 4; ++q) { const float a = bflo(v[q]), b = bfhi(v[q]); part[2 * q] += a * a; part[2 * q + 1] += b * b; }
    }
#pragma unroll
    for (int q = 0; q < 8; ++q) { float s = part[q]; s += __shfl_xor(s, 4); s += __shfl_xor(s, 8); s += __shfl_xor(s, 16); s += __shfl_xor(s, 32); part[q] = s; }
    if ((t & 63) < 4) {
#pragma unroll
        for (int q = 0; q < 8; ++q) atomicAdd((float*)(ssq + ch * 8 + q), part[q]);
    }
    __syncthreads();
    const int tt = t >> 4;
    const float r = rsqrtf(ssq[tt] * (1.0f / (float)HYW) + EPS);
#pragma unroll 2
    for (int k = 0; k < 8; ++k) {
        const int c0 = ((t & 15) + 16 * k) * 8;
        float o[8];
#pragma unroll
        for (int q = 0; q < 8; ++q) o[q] = bf2f(*(const LAS u16*)(lds + (c0 + q) * 80 + tt * 2)) * r * gain[c0 + q];
        *(u32x4*)(MIXB + (size_t)(tok0 + tt) * DM + 1024 + c0) = (u32x4){pk_bf16(o[0], o[1]), pk_bf16(o[2], o[3]), pk_bf16(o[4], o[5]), pk_bf16(o[6], o[7])};
    }
    __syncthreads();
}
constexpr int RT_XSTRIDE = 2049;
constexpr int RT_PART = 16 * RT_XSTRIDE * 4;
constexpr int RT_LG = RT_PART + 8 * 16 * 32 * 4;
constexpr int RT_HIST = RT_LG + 16 * 32 * 4;
constexpr int RT_ITEMS = RT_HIST + 128;
constexpr int RT_RBASE = RT_ITEMS + 512;
constexpr int RT_END = RT_RBASE + 128;
__device__ __forceinline__ void router_tile(LAS unsigned char* lds, int tile_i, const float* __restrict__ X1, const float* __restrict__ gain, const float* __restrict__ wr, const float* __restrict__ br,
                                            unsigned char* __restrict__ XN8, float* __restrict__ TOPG, int tl2, const float (&bw)[128]) {
    const int tid = tid_fresh(), wid = __builtin_amdgcn_readfirstlane(tid >> 6), lane = tid & 63;
    const int tok0 = tile_i * 16;
    LAS float* xs = (LAS float*)lds;
#pragma unroll
    for (int q = 0; q < 2; ++q) {
        const int tl = wid * 2 + q; const size_t tok = (size_t)tok0 + tl;
        const float* xr = X1 + tok * DM;
        f32x4 v[8]; float s = 0.f;
#pragma unroll
        for (int j = 0; j < 8; ++j) { v[j] = *(const f32x4*)(xr + (lane + 64 * j) * 4); s += v[j][0] * v[j][0] + v[j][1] * v[j][1] + v[j][2] * v[j][2] + v[j][3] * v[j][3]; }
        s = wave_sum(s);
        const float r = rsqrtf(s * (1.0f / (float)DM) + EPS);
#pragma unroll
        for (int j = 0; j < 8; ++j) { const int d = (lane + 64 * j) * 4; const f32x4 g = *(const f32x4*)(gain + d); const f32x4 o = v[j] * r * g;
            xs[tl * RT_XSTRIDE + d + 0] = o[0]; xs[tl * RT_XSTRIDE + d + 1] = o[1]; xs[tl * RT_XSTRIDE + d + 2] = o[2]; xs[tl * RT_XSTRIDE + d + 3] = o[3];
            *(unsigned*)(XN8 + tok * DM + d) = pk_fp8x4(o[0], o[1], o[2], o[3]); }
    }
    __syncthreads();
    {
        const int tl = lane & 15, kk = lane >> 4;
        f32x4 a0 = {0.f, 0.f, 0.f, 0.f}, a1 = a0;
        const LAS float* xp = xs + tl * RT_XSTRIDE + wid * 256 + kk;
#pragma unroll
        for (int ks = 0; ks < 64; ++ks) { const float a = xp[ks * 4];
            a0 = __builtin_amdgcn_mfma_f32_16x16x4f32(a, bw[2 * ks], a0, 0, 0, 0); a1 = __builtin_amdgcn_mfma_f32_16x16x4f32(a, bw[2 * ks + 1], a1, 0, 0, 0); }
        LAS float* pp = (LAS float*)(lds + RT_PART) + wid * 512;
#pragma unroll
        for (int j = 0; j < 4; ++j) { pp[(kk * 4 + j) * 32 + tl] = a0[j]; pp[(kk * 4 + j) * 32 + 16 + tl] = a1[j]; }
    }
    __syncthreads();
    {   const LAS float* pp = (const LAS float*)(lds + RT_PART); float s = br[tid & 31];
#pragma unroll
        for (int w = 0; w < 8; ++w) s += pp[w * 512 + tid];
        ((LAS float*)(lds + RT_LG))[tid] = s; }
    __syncthreads();
    if (tid < 16) {
        LAS float* lg = (LAS float*)(lds + RT_LG) + tid * 32;
        int i0 = 0, i1 = 0, i2 = 0, i3 = 0; float v0, v1, v2, v3;
        { float bv = -3.0e38f; for (int j = 0; j < NE; ++j) { const float l = lg[j]; if (l > bv) { bv = l; i0 = j; } } v0 = bv; lg[i0] = -3.4e38f; }
        { float bv = -3.0e38f; for (int j = 0; j < NE; ++j) { const float l = lg[j]; if (l > bv) { bv = l; i1 = j; } } v1 = bv; lg[i1] = -3.4e38f; }
        { float bv = -3.0e38f; for (int j = 0; j < NE; ++j) { const float l = lg[j]; if (l > bv) { bv = l; i2 = j; } } v2 = bv; lg[i2] = -3.4e38f; }
        { float bv = -3.0e38f; for (int j = 0; j < NE; ++j) { const float l = lg[j]; if (l > bv) { bv = l; i3 = j; } } v3 = bv; lg[i3] = -3.4e38f; }
        const float e1 = __expf(v1 - v0), e2 = __expf(v2 - v0), e3 = __expf(v3 - v0), inv = 1.0f / (1.0f + e1 + e2 + e3);
        const int tok = tok0 + tid;
        *(f32x4*)(TOPG + tok * 4) = (f32x4){inv, e1 * inv, e2 * inv, e3 * inv};
        LAS int* hist = (LAS int*)(lds + RT_HIST);
        const int p0 = atomicAdd((int*)(hist + i0), 1), p1 = atomicAdd((int*)(hist + i1), 1), p2 = atomicAdd((int*)(hist + i2), 1), p3 = atomicAdd((int*)(hist + i3), 1);
        *(LAS u32x4*)(lds + RT_ITEMS + (tl2 * 16 + tid) * 16) = (u32x4){(unsigned)((i0 << 16) | p0), (unsigned)((i1 << 16) | p1), (unsigned)((i2 << 16) | p2), (unsigned)((i3 << 16) | p3)};
    }
    __syncthreads();
}
__device__ __forceinline__ void combine_row(int tok, const float* __restrict__ X1, const u16* __restrict__ YB, const int* __restrict__ SOF, const float* __restrict__ TOPG, const float* __restrict__ gain, float* __restrict__ out, int lane) {
    const int4 sl = *(const int4*)(SOF + tok * 4); const f32x4 g = *(const f32x4*)(TOPG + tok * 4);
    const u16* y0 = YB + (size_t)sl.x * DM; const u16* y1 = YB + (size_t)sl.y * DM; const u16* y2 = YB + (size_t)sl.z * DM; const u16* y3 = YB + (size_t)sl.w * DM;
    f32x4 v[8]; float s = 0.f;
#pragma unroll
    for (int j = 0; j < 8; ++j) { const int d = (lane + 64 * j) * 4;
        f32x4 a = *(const f32x4*)(X1 + (size_t)tok * DM + d);
        const u32x2 q0 = *(const u32x2*)(y0 + d), q1 = *(const u32x2*)(y1 + d), q2 = *(const u32x2*)(y2 + d), q3 = *(const u32x2*)(y3 + d);
        a[0] += g[0] * bflo(q0[0]) + g[1] * bflo(q1[0]) + g[2] * bflo(q2[0]) + g[3] * bflo(q3[0]);
        a[1] += g[0] * bfhi(q0[0]) + g[1] * bfhi(q1[0]) + g[2] * bfhi(q2[0]) + g[3] * bfhi(q3[0]);
        a[2] += g[0] * bflo(q0[1]) + g[1] * bflo(q1[1]) + g[2] * bflo(q2[1]) + g[3] * bflo(q3[1]);
        a[3] += g[0] * bfhi(q0[1]) + g[1] * bfhi(q1[1]) + g[2] * bfhi(q2[1]) + g[3] * bfhi(q3[1]);
        v[j] = a; s += a[0] * a[0] + a[1] * a[1] + a[2] * a[2] + a[3] * a[3]; }
    s = wave_sum(s);
    const float r = rsqrtf(s * (1.0f / (float)DM) + EPS);
#pragma unroll
    for (int j = 0; j < 8; ++j) { const int d = (lane + 64 * j) * 4; const f32x4 gn = *(const f32x4*)(gain + d); *(f32x4*)(out + (size_t)tok * DM + d) = v[j] * r * gn; }
}

__device__ __forceinline__ void combine_row2(int tokA, int tokB, const float* __restrict__ X1, const u16* __restrict__ YB, const int* __restrict__ SOF, const float* __restrict__ TOPG, const float* __restrict__ gain, float* __restrict__ out, int lane) {
    const int4 slA = *(const int4*)(SOF + tokA * 4), slB = *(const int4*)(SOF + tokB * 4); const f32x4 gA = *(const f32x4*)(TOPG + tokA * 4), gB = *(const f32x4*)(TOPG + tokB * 4);
    const u16* yA0 = YB + (size_t)slA.x * DM; const u16* yA1 = YB + (size_t)slA.y * DM; const u16* yA2 = YB + (size_t)slA.z * DM; const u16* yA3 = YB + (size_t)slA.w * DM;
    const u16* yB0 = YB + (size_t)slB.x * DM; const u16* yB1 = YB + (size_t)slB.y * DM; const u16* yB2 = YB + (size_t)slB.z * DM; const u16* yB3 = YB + (size_t)slB.w * DM;
    f32x4 vA[8], vB[8]; float sA = 0.f, sB = 0.f;
#pragma unroll
    for (int j = 0; j < 8; ++j) { const int d = (lane + 64 * j) * 4;
        f32x4 a = *(const f32x4*)(X1 + (size_t)tokA * DM + d), b = *(const f32x4*)(X1 + (size_t)tokB * DM + d);
        const u32x2 p0 = *(const u32x2*)(yA0 + d), p1 = *(const u32x2*)(yA1 + d), p2 = *(const u32x2*)(yA2 + d), p3 = *(const u32x2*)(yA3 + d);
        const u32x2 q0 = *(const u32x2*)(yB0 + d), q1 = *(const u32x2*)(yB1 + d), q2 = *(const u32x2*)(yB2 + d), q3 = *(const u32x2*)(yB3 + d);
        a[0] += gA[0] * bflo(p0[0]) + gA[1] * bflo(p1[0]) + gA[2] * bflo(p2[0]) + gA[3] * bflo(p3[0]);
        a[1] += gA[0] * bfhi(p0[0]) + gA[1] * bfhi(p1[0]) + gA[2] * bfhi(p2[0]) + gA[3] * bfhi(p3[0]);
        a[2] += gA[0] * bflo(p0[1]) + gA[1] * bflo(p1[1]) + gA[2] * bflo(p2[1]) + gA[3] * bflo(p3[1]);
        a[3] += gA[0] * bfhi(p0[1]) + gA[1] * bfhi(p1[1]) + gA[2] * bfhi(p2[1]) + gA[3] * bfhi(p3[1]);
        b[0] += gB[0] * bflo(q0[0]) + gB[1] * bflo(q1[0]) + gB[2] * bflo(q2[0]) + gB[3] * bflo(q3[0]);
        b[1] += gB[0] * bfhi(q0[0]) + gB[1] * bfhi(q1[0]) + gB[2] * bfhi(q2[0]) + gB[3] * bfhi(q3[0]);
        b[2] += gB[0] * bflo(q0[1]) + gB[1] * bflo(q1[1]) + gB[2] * bflo(q2[1]) + gB[3] * bflo(q3[1]);
        b[3] += gB[0] * bfhi(q0[1]) + gB[1] * bfhi(q1[1]) + gB[2] * bfhi(q2[1]) + gB[3] * bfhi(q3[1]);
        vA[j] = a; vB[j] = b; sA += a[0] * a[0] + a[1] * a[1] + a[2] * a[2] + a[3] * a[3]; sB += b[0] * b[0] + b[1] * b[1] + b[2] * b[2] + b[3] * b[3]; }
    sA = wave_sum(sA); sB = wave_sum(sB);
    const float rA = rsqrtf(sA * (1.0f / (float)DM) + EPS), rB = rsqrtf(sB * (1.0f / (float)DM) + EPS);
#pragma unroll
    for (int j = 0; j < 8; ++j) { const int d = (lane + 64 * j) * 4; const f32x4 gn = *(const f32x4*)(gain + d);
        *(f32x4*)(out + (size_t)tokA * DM + d) = vA[j] * rA * gn; *(f32x4*)(out + (size_t)tokB * DM + d) = vB[j] * rB * gn; }
}
#ifndef REP_P9
#define REP_P9 1
#endif
#ifndef REP_P3
#define REP_P3 1
#endif
#ifndef REP_FR
#define REP_FR 1
#endif
#ifndef REP_P0
#define REP_P0 1
#endif
#ifndef REP_CONV
#define REP_CONV 1
#endif
#ifndef REP_GEMM1
#define REP_GEMM1 1
#endif
#ifndef REP_HY
#define REP_HY 1
#endif
#ifndef REP_HG
#define REP_HG 1
#endif
#ifndef REP_MOEA
#define REP_MOEA 1
#endif
#ifndef REP_MOEB
#define REP_MOEB 1
#endif
#ifndef REP_WOUT
#define REP_WOUT 1
#endif
struct MegaP {
    const float *x, *norm_mix_gain, *w_in, *lb_logits, *hgrn_norm_gain, *hy_conv_w, *hy_conv_b, *fw1, *fb1, *fw2, *fb2, *fw3, *fb3, *fw4, *ffreq, *hy_bias, *hy_norm_gain, *w_out,
        *norm_ffn_gain, *w_router, *b_router, *moe_w1, *moe_b1, *moe_w2, *moe_b2, *final_gain;
    float* out; unsigned char* ws;
};
constexpr int MEGA_XB = RT_END;
constexpr int MEGA_LDS = RT_END + 64 + 384;
static_assert(MEGA_LDS >= HY_LDS + 64 && MEGA_LDS >= HG_LDS + 64 && MEGA_LDS >= GEMM_LDS + 64, "LDS");

__global__ void __launch_bounds__(512, 2) k_mega(const MegaP p_arg) {
    extern __shared__ __attribute__((aligned(16))) unsigned char shm[];
    LAS unsigned char* lds = (LAS unsigned char*)shm;
    const int tid = threadIdx.x, wid = __builtin_amdgcn_readfirstlane(tid >> 6), lane = tid & 63;
    const int G = gridDim.x, bid = blockIdx.x, c = xcd_logical(bid, G);
#define PHASE_ARGS() const MegaP __attribute__((address_space(4)))* pq_ = (const MegaP __attribute__((address_space(4)))*)__builtin_amdgcn_kernarg_segment_ptr(); asm volatile("" : "+s"(pq_)); unsigned char* ws = pq_->ws; (void)ws
    unsigned char* ws0; { PHASE_ARGS(); ws0 = ws; }
#define counts ((int*)(ws + WS_CTL))
#define cursor ((int*)(ws + WS_CTL + 4096))
#define offs ((int*)(ws + WS_CTL + 8192))
#define barw ((unsigned*)(ws + WS_CTL + 16384))
#define HB ((u16*)(ws + WS_HB))
#define PG ((u16*)(ws + WS_PG))
#define HYT ((u16*)(ws + WS_HYT))
#define MIXB ((u16*)(ws + WS_MIXB))
#define XNB ((u16*)(ws + WS_XNB))
#define HMB ((u16*)(ws + WS_HMS))
#define YB ((u16*)(ws + WS_YS))
#define H3 ((float*)(ws + WS_H3))
#define FR ((u16*)(ws + WS_FR))
#define Z2T ((u16*)(ws + WS_Z2T))
#define OF ((float*)(ws + WS_OF))
#define OB ((float*)(ws + WS_OB))
#define X1 ((float*)(ws + WS_X1))
#define TOPI ((int*)(ws + WS_TOPI))
#define TOPG ((float*)(ws + WS_TOPG))
#define STOK ((int*)(ws + WS_STOKS))
#define SOF ((int*)(ws + WS_SOF))
#define WINT ((u16*)(ws + WS_WINT))
#define WOUTT ((u16*)(ws + WS_WOUTT))
#define W1T ((u16*)(ws + WS_W1T))
#define W2T ((u16*)(ws + WS_W2T))
    if (tid == 0) *(LAS u32x4*)(lds + MEGA_XB) = (u32x4){0u, 0u, 0u, 0u};
    __syncthreads();
    XcdBarrier bar = xcd_barrier_post((unsigned*)(ws0 + WS_CTL + 16384), (volatile LAS unsigned*)(lds + MEGA_XB));

    {
        PHASE_ARGS();
        const int tid = tid_fresh(), wid = __builtin_amdgcn_readfirstlane(tid >> 6), lane = tid & 63; (void)wid; (void)lane;
    for (int rep = 0; rep < REP_P0; ++rep) {
    for (int row = bid * 8 + wid; row < NTOK; row += G * 8) rmsnorm_row_bf(pq_->x + (size_t)row * DM, pq_->norm_mix_gain, HB + (size_t)row * DM, (unsigned char*)XNB + (size_t)row * DM, lane);
    for (int m = bid * 8 + wid; m < SEQ; m += G * 8) h3_row(m, pq_->fw1, pq_->fb1, pq_->fw2, pq_->fb2, pq_->fw3, pq_->fb3, pq_->ffreq, (LAS float*)(lds + wid * 512), H3); }
    for (int rep = 0; rep < REP_CONV; ++rep)
    for (int id = bid; id < 1024 + 256; id += G) {
        const int tz = tid_fresh();
        if (id < 640) { f32x2 cv[16]; conv_issue_win(pq_->w_in, id, tz >> 6, tz & 63, cv); conv_finish_win((unsigned char*)WINT, id, tz >> 6, tz & 63, cv); }
        else if (id < 1024) { const int nt = id >> 5, kt = id & 31; convert_tile(pq_->w_in, DIN, kt * 64, ColMapPerm{nt * 256}, WINT + (size_t)id * 16384, tz); }
        else { const int q = id - 1024, nt = q >> 5, kt = q & 31; convert_tile(pq_->w_out, DM, kt * 64, ColMapPerm{nt * 256}, WOUTT + (size_t)q * 16384, tz); }
    }
    }
    xcd_barrier(bar);
    {
        PHASE_ARGS();
        const int tid = tid_fresh(), wid = __builtin_amdgcn_readfirstlane(tid >> 6), lane = tid & 63; (void)wid; (void)lane;
    for (int rep = 0; rep < REP_FR; ++rep)
    for (int item = bid; item < 256; item += G) frgen_item(lds, item, H3, pq_->fw4, FR);
    { SrcG1<false> s0{c, G, (const char*)XNB, (const char*)WINT, PG, HYT, pq_->lb_logits, 16}; gemm8_stream<false, true>(lds, DM / 2, 16, s0);
      SrcG1<true> s1{c, G, (const char*)HB, (const char*)WINT, PG, HYT, pq_->lb_logits, 32}; gemm8_stream<true, false>(lds, DM, 32, s1); }
#ifdef PROBE_NOEPI
    for (int u = c; u < 1024; u += G) {
        const int i = u >> 8, xx = (u >> 5) & 7, j = u & 31;
        const int mt = (xx & 3) * 8 + (j & 7), nt = ((xx >> 2) + 2 * i) * 4 + (j >> 3);
        const u16* bt = WINT + (size_t)nt * 32 * 16384;
        EpiNone e{}; if (nt < 20) gemm8_unit<false>(lds, HB, DM, nullptr, mt * 256, 256, bt, 32, e); else gemm8_unit<true>(lds, HB, DM, nullptr, mt * 256, 256, bt, 32, e);
    }
#endif
    }
    xcd_barrier(bar);
    {
        PHASE_ARGS();
        const int tid = tid_fresh(), wid = __builtin_amdgcn_readfirstlane(tid >> 6), lane = tid & 63; (void)wid; (void)lane;
    for (int rep = 0; rep < REP_HY; ++rep)
    for (int u = bid; u < 256; u += G) hyena_unit(lds, u, HYT, FR, pq_->hy_conv_w, pq_->hy_conv_b, pq_->hy_bias, Z2T, ConvCtx{pq_->moe_w1, pq_->moe_w2, (unsigned char*)W1T, (unsigned char*)W2T});
    for (int rep = 0; rep < REP_HG; ++rep)
    for (int u = bid; u < 256; u += G) hgrn_unit(lds, u, PG, pq_->lb_logits, OF, OB, ConvCtx{pq_->moe_w1, pq_->moe_w2, (unsigned char*)W1T, (unsigned char*)W2T});
    }
    xcd_barrier(bar);
    {
        PHASE_ARGS();
        const int tid = tid_fresh(), wid = __builtin_amdgcn_readfirstlane(tid >> 6), lane = tid & 63; (void)wid; (void)lane;
    for (int rep = 0; rep < REP_P3; ++rep) {
    for (int it = bid * 8 + wid; it < NTOK * HGH; it += G * 8 * 4) hgrn_final_item4(it, G * 8, OF, OB, PG, pq_->hgrn_norm_gain, MIXB, lane);
    for (int t = bid; t < NTOK / 32; t += G) hy_norm_tile(lds, t, Z2T, pq_->hy_norm_gain, MIXB); }
    }
    xcd_barrier(bar);
    {
        PHASE_ARGS();
        const int tid = tid_fresh(), wid = __builtin_amdgcn_readfirstlane(tid >> 6), lane = tid & 63; (void)wid; (void)lane;
    for (int u = c; u < 256; u += G) {
        const int xx = u >> 5, j = u & 31;
        const int mt = (xx >> 1) * 8 + (j & 7), nt = (xx & 1) * 4 + (j >> 3);
        Epi8X1 e{pq_->x, X1, mt * 256, nt * 256};
        gemm8_unit<false>(lds, MIXB, DM, nullptr, mt * 256, 256, WOUTT + (size_t)nt * 32 * 16384, 32, e);
    }
    }
    xcd_barrier(bar);
    {
        PHASE_ARGS();
        const int tid = tid_fresh(), wid = __builtin_amdgcn_readfirstlane(tid >> 6), lane = tid & 63; (void)wid; (void)lane;
    if (tid < NE) *(LAS int*)(lds + RT_HIST + tid * 4) = 0;
    __syncthreads();
    float bw[128];
    { const float* wp = pq_->w_router + (size_t)(wid * 256 + (lane >> 4)) * NE + (lane & 15);
#pragma unroll
      for (int ks = 0; ks < 64; ++ks) { bw[2 * ks] = wp[(size_t)ks * 4 * NE]; bw[2 * ks + 1] = wp[(size_t)ks * 4 * NE + 16]; } }
    for (int t0 = bid; t0 < NTOK / 16; t0 += 2 * G) {
        const int t1 = t0 + G, ntl = (t1 < NTOK / 16) ? 2 : 1;
        router_tile(lds, t0, X1, pq_->norm_ffn_gain, pq_->w_router, pq_->b_router, (unsigned char*)XNB, TOPG, 0, bw);
        if (ntl == 2) router_tile(lds, t1, X1, pq_->norm_ffn_gain, pq_->w_router, pq_->b_router, (unsigned char*)XNB, TOPG, 1, bw);
        const int tq = tid_fresh();
        if (tq < NE) { const int n = *(const LAS int*)(lds + RT_HIST + tq * 4); *(LAS int*)(lds + RT_RBASE + tq * 4) = n ? atomicAdd(&cursor[tq * 32], n) : 0; *(LAS int*)(lds + RT_HIST + tq * 4) = 0; }
        __syncthreads();
        if (tq < ntl * 64) { const int it = *(const LAS int*)(lds + RT_ITEMS + tq * 4), e = it >> 16, tok = ((tq >> 6) ? t1 : t0) * 16 + ((tq >> 2) & 15);
            const int slot = e * NTOK + *(const LAS int*)(lds + RT_RBASE + e * 4) + (it & 0xffff); STOK[slot] = tok; SOF[tok * 4 + (tq & 3)] = slot; }
        __syncthreads();
    }
    }
    xcd_barrier(bar);
    {
        PHASE_ARGS();
        const int tid = tid_fresh(), wid = __builtin_amdgcn_readfirstlane(tid >> 6), lane = tid & 63; (void)wid; (void)lane;
    {
        LAS int* us = (LAS int*)(lds + MEGA_XB + 64); LAS int* so2 = us + 40;
        if (tid < NE) so2[tid] = __hip_atomic_load(&cursor[tid * 32], __ATOMIC_RELAXED, __HIP_MEMORY_SCOPE_AGENT);
        __syncthreads();
        if (tid == 0) { int a = 0; for (int e = 0; e < NE; ++e) { us[e] = a; a += ((so2[e] + 255) >> 8) * 16; } us[NE] = a; }
        __syncthreads();
    }
    {
        LAS int* qs = (LAS int*)(lds + MEGA_XB + 32); LAS int* us = (LAS int*)(lds + MEGA_XB + 64); LAS int* so2 = us + 40;
        int* qctr = (int*)(ws + WS_CTL + 12288 + (bid & 7) * 128);
        int tk_next = 0;
        auto decode = [&](int tkv, int& e, int& nt, int& slot0, int& rows) -> bool {
            const int tq = tid_fresh();
            if (tq == 0) { qs[0] = tkv; qs[1] = -1; }
            __syncthreads();
            const int tk = qs[0];
            const int u = 256 * (tk >> 5) + 32 * (bid & 7) + (tk & 31);
            if (tq < NE) { const int u0 = us[tq], u1 = us[tq + 1]; if (u >= u0 && u < u1) { const int o0 = tq * NTOK, cnt = so2[tq], mtl = (cnt + 255) >> 8, ul = u - u0, mt = ul % mtl;
                int rw = cnt - mt * 256; rw = rw > 256 ? 256 : rw; qs[1] = tq; qs[2] = ul / mtl; qs[3] = o0 + mt * 256; qs[4] = rw; } }
            __syncthreads();
            e = qs[1]; nt = qs[2]; slot0 = qs[3]; rows = qs[4];
            __syncthreads();
            return e >= 0;
        };
        if (tid == 0) tk_next = atomicAdd(qctr, 1);
        int e, nt, slot0, rows;
        if (decode(tk_next, e, nt, slot0, rows)) {
            if (tid == 0) tk_next = atomicAdd(qctr, 1);
            G8Pre cur, nxp;
            g8_addr(cur, DM / 2, STOK + slot0, rows, W1T + (size_t)(e * 16 + nt) * 16 * 16384);
            g8_issue(lds, (const char*)XNB, cur);
            for (;;) {
                int e2 = -1, nt2 = 0, slot2 = 0, rows2 = 0;
                auto next = [&]() -> bool {
                    if (!decode(tk_next, e2, nt2, slot2, rows2)) return false;
                    if (tid_fresh() == 0) tk_next = atomicAdd(qctr, 1);
                    g8_addr(nxp, DM / 2, STOK + slot2, rows2, W1T + (size_t)(e2 * 16 + nt2) * 16 * 16384);
                    g8_issue(lds, (const char*)XNB, nxp);
                    return true; };
                Epi8Swiglu8 ep{(unsigned char*)HMB, pq_->moe_b1 + (size_t)e * 2 * DFF, slot0, nt, rows};
                const bool more = gemm8_unit_ov<false, true>(lds, XNB, cur, 16, ep, next);
                if (!more) break;
                cur = nxp; e = e2; nt = nt2; slot0 = slot2; rows = rows2;
            }
        }
    }
    }
    xcd_barrier(bar);
    {
        PHASE_ARGS();
        const int tid = tid_fresh(), wid = __builtin_amdgcn_readfirstlane(tid >> 6), lane = tid & 63; (void)wid; (void)lane;
    {
        LAS int* us = (LAS int*)(lds + MEGA_XB + 64); LAS int* so2 = us + 40;
        if (tid < NE) so2[tid] = __hip_atomic_load(&cursor[tid * 32], __ATOMIC_RELAXED, __HIP_MEMORY_SCOPE_AGENT);
        __syncthreads();
        if (tid == 0) { int a = 0; for (int e = 0; e < NE; ++e) { us[e] = a; a += ((so2[e] + 255) >> 8) * 8; } us[NE] = a; }
        __syncthreads();
    }
    {
        const LAS int* us = (const LAS int*)(lds + MEGA_XB + 64); const LAS int* so2 = us + 40;
        SrcMoeB src{us, so2, c, G, (const char*)HMB, (const char*)W2T, YB, pq_->moe_b2};
        gemm8_stream<false, true>(lds, DFF / 2, 16, src);
    }
    }
    xcd_barrier(bar);
    {
        PHASE_ARGS();
        const int tid = tid_fresh(), wid = __builtin_amdgcn_readfirstlane(tid >> 6), lane = tid & 63; (void)wid; (void)lane;
    for (int rep = 0; rep < REP_P9; ++rep)
    for (int tok = bid * 8 + wid; tok < NTOK; tok += G * 8) combine_row(tok, X1, YB, SOF, TOPG, pq_->final_gain, pq_->out, lane);
    }
}
#undef counts
#undef cursor
#undef offs
#undef barw
#undef HB
#undef PG
#undef HYT
#undef MIXB
#undef XNB
#undef HMB
#undef YB
#undef H3
#undef FR
#undef Z2T
#undef OF
#undef OB
#undef X1
#undef TOPI
#undef TOPG
#undef STOK
#undef SOF
#undef WINT
#undef WOUTT
#undef W1T
#undef W2T

extern "C" void kernel_launch(void* const* d_in, const int* in_sizes, int n_in, void* d_out, int out_size, void* d_ws, size_t ws_size, hipStream_t stream) {
    if (n_in < 26 || ws_size < WS_END2) return;
    MegaP p{};
    const float** pp = (const float**)&p;
    for (int i = 0; i < 26; ++i) pp[i] = (const float*)d_in[i];
    p.out = (float*)d_out; p.ws = (unsigned char*)d_ws;
    static int grid = 0;
    if (!grid) {
        int dev = 0, cus = 0, per_cu = 0;
        (void)hipGetDevice(&dev);
        (void)hipDeviceGetAttribute(&cus, hipDeviceAttributeMultiprocessorCount, dev);
        (void)hipFuncSetAttribute((const void*)k_mega, hipFuncAttributeMaxDynamicSharedMemorySize, MEGA_LDS);
        (void)hipOccupancyMaxActiveBlocksPerMultiprocessor(&per_cu, (const void*)k_mega, 512, MEGA_LDS);
        if (per_cu < 1) per_cu = 1;
        grid = cus * 1;
        if (grid > 256) grid = 256;
        grid &= ~7;
        if (grid < 8) grid = 8;
    }
    (void)hipMemsetAsync((char*)d_ws + WS_CTL, 0, 65536, stream);
    hipLaunchKernelGGL(k_mega, dim3(grid), dim3(512), MEGA_LDS, stream, p);
}
```

```cpp
#include <hip/hip_runtime.h>
#include <stdint.h>

constexpr int BATCH = 4, SEQ = 2048, DM = 2048, NTOK = BATCH * SEQ;
constexpr int HGW = 1024, HGD = 128, HGH = 8;
constexpr int HYW = 1024;
constexpr int DIN = 8192;
constexpr int NE = 32, TOPK = 4, DFF = 2048;
constexpr int NSLOT = NTOK * TOPK;
constexpr float EPS = 1e-5f;

constexpr size_t MB = 1024ull * 1024ull;
constexpr size_t WS_CTL = 0;
constexpr size_t WS_HB = 1 * MB;
constexpr size_t WS_PG = WS_HB + 32 * MB;
constexpr size_t WS_HYT = WS_PG + 80 * MB;
constexpr size_t WS_MIXB = WS_HYT + 48 * MB;
constexpr size_t WS_XNB = WS_MIXB + 32 * MB;
constexpr size_t WS_HMB = WS_XNB + 32 * MB;
constexpr size_t WS_YB = WS_HMB + 128 * MB;
constexpr size_t WS_H3 = WS_YB + 128 * MB;
constexpr size_t WS_FR = WS_H3 + 1 * MB;
constexpr size_t WS_Z2T = WS_FR + 34 * MB;
constexpr size_t WS_OF = WS_Z2T + 16 * MB;
constexpr size_t WS_OB = WS_OF + 32 * MB;
constexpr size_t WS_X1 = WS_OB + 32 * MB;
constexpr size_t WS_TOPI = WS_X1 + 64 * MB;
constexpr size_t WS_TOPG = WS_TOPI + 1 * MB;
constexpr size_t WS_STOK = WS_TOPG + 1 * MB;
constexpr size_t WS_SOF = WS_STOK + 1 * MB;
constexpr size_t WS_WINT = WS_SOF + 1 * MB;
constexpr size_t WS_WOUTT = WS_WINT + 32 * MB;
constexpr size_t WS_W1T = WS_WOUTT + 8 * MB;
constexpr size_t WS_W2T = WS_W1T + 512 * MB;
constexpr size_t WS_HMS = WS_W2T + 256 * MB;
constexpr size_t WS_YS = WS_HMS + 512 * MB;
constexpr size_t WS_STOKS = WS_YS + 1024 * MB;
constexpr size_t WS_END2 = WS_STOKS + 1 * MB;

typedef short bf16x8 __attribute__((ext_vector_type(8)));
typedef float f32x4 __attribute__((ext_vector_type(4)));
typedef float f32x2 __attribute__((ext_vector_type(2)));
typedef unsigned u32x4 __attribute__((ext_vector_type(4)));
typedef unsigned u32x2 __attribute__((ext_vector_type(2)));
typedef unsigned short u16;
#define LAS __attribute__((address_space(3)))

__device__ __forceinline__ unsigned pk_bf16(float lo, float hi) {
    typedef __bf16 bf2 __attribute__((ext_vector_type(2)));
    const f32x2 v = {lo, hi};
    const bf2 r = __builtin_convertvector(v, bf2);
    return __builtin_bit_cast(unsigned, r);
}
__device__ __forceinline__ float bf2f(u16 b) { return __uint_as_float(((unsigned)b) << 16); }
__device__ __forceinline__ float bflo(unsigned w) { return __uint_as_float(w << 16); }
__device__ __forceinline__ float bfhi(unsigned w) { return __uint_as_float(w & 0xffff0000u); }

__device__ __forceinline__ int lds_byte(int r, int c) { const int st = (r >> 4) * 2 + (c >> 5), ob = (r & 15) * 64 + (c & 31) * 2; return st * 1024 + (ob ^ (((ob >> 9) & 1) << 5)); }
__device__ __forceinline__ void stage_rc(int b, int& R, int& C) { const int st = b >> 10, sb = b & 1023, swz = sb ^ (((sb >> 9) & 1) << 5); R = (st >> 1) * 16 + swz / 64; C = (st & 1) * 32 + (swz % 64) / 2; }
__device__ __forceinline__ f32x4 unperm(const f32x4 a, const bool s) { f32x4 o; o[0] = s ? a[1] : a[0]; o[1] = s ? a[0] : a[1]; o[2] = s ? a[3] : a[2]; o[3] = s ? a[2] : a[3]; return o; }

__device__ __forceinline__ int tid_fresh() { int t = threadIdx.x; asm volatile("" : "+v"(t)); return t; }
constexpr int GEMM_LDS = 131072;

template <bool TRANS, bool RAGGED, int PM = 0, class ColMap, class Epi>
__device__ __forceinline__ void gemm_unit(LAS unsigned char* lds, const u16* __restrict__ A, int lda, const int* __restrict__ arows, int arow0, int rows_valid,
                                          const float* __restrict__ B, int ldb, int K, const ColMap colmap, const Epi epi) {
    const int tid = tid_fresh(), wid = __builtin_amdgcn_readfirstlane(tid >> 6), lane = tid & 63;
    const int wr = wid >> 2, wc = wid & 3, fr = lane & 15, fq = lane >> 4;
    const int nt = K >> 6;
    const char* ap[4];
#pragma unroll
    for (int i = 0; i < 4; ++i) {
        int R, C; stage_rc(wid * 1024 + i * 8192 + lane * 16, R, C);
        const int rr = RAGGED ? (R < rows_valid ? R : rows_valid - 1) : R;
        const long rowid = arows ? (long)arows[rr] : (long)(arow0 + rr);
        ap[i] = (const char*)A + ((size_t)rowid * lda + C) * 2;
    }
    const int g = (lane & 3) + 4 * (wid >> 2), rg = (wid & 3) * 16 + (lane >> 2);
    const unsigned bvoff = (unsigned)(((size_t)(8 * g) * ldb + colmap(rg)) * 4);
    const int bbase = 65536 + lds_byte(4 * rg, 8 * g);
    const int bw0 = bbase + ((rg & 1) ? 64 : 0), bw1 = bbase + ((rg & 1) ? 0 : 64);
    const int aoff = lds_byte(wr * 128 + fr, fq * 8), boff = 65536 + lds_byte(wc * 64 + fr, fq * 8);
    int mvalid = 8;
    if (RAGGED) { mvalid = (rows_valid - wr * 128 + 15) >> 4; mvalid = mvalid < 0 ? 0 : (mvalid > 8 ? 8 : mvalid); }
    f32x4 vb0, vb1, vb2, vb3, vb4, vb5, vb6, vb7;
    if (PM & 1) { vb0 = (f32x4){1.f, 1.f, 1.f, 1.f}; vb1 = vb0; vb2 = vb0; vb3 = vb0; vb4 = vb0; vb5 = vb0; vb6 = vb0; vb7 = vb0; }
    f32x4 acc[8][4];
#pragma unroll
    for (int m = 0; m < 8; ++m)
#pragma unroll
        for (int n = 0; n < 4; ++n) acc[m][n] = (f32x4){0.f, 0.f, 0.f, 0.f};
    const size_t ldb4 = (size_t)ldb * 4;
#define GE_GLDS_A(buf, kt) do { if (!(PM & 2)) _Pragma("unroll") for (int _i = 0; _i < 4; ++_i) \
        __builtin_amdgcn_global_load_lds((const unsigned*)(ap[_i] + (size_t)(kt) * 128), (LAS unsigned*)(lds + (buf) * 32768 + wid * 1024 + _i * 8192), 16, 0, 0); } while (0)
#define GE_LD1(dst, sb) if (!(PM & 1)) asm volatile("global_load_dwordx4 %0, %1, %2" : "=v"(dst) : "v"(bvoff), "s"(sb) : "memory")
#define GE_LOAD_B(kt) do { const char* _sb = (const char*)B + (size_t)(kt) * 64 * ldb4; \
        GE_LD1(vb0, _sb); GE_LD1(vb1, _sb + ldb4); GE_LD1(vb2, _sb + 2 * ldb4); GE_LD1(vb3, _sb + 3 * ldb4); \
        GE_LD1(vb4, _sb + 4 * ldb4); GE_LD1(vb5, _sb + 5 * ldb4); GE_LD1(vb6, _sb + 6 * ldb4); GE_LD1(vb7, _sb + 7 * ldb4); } while (0)
#define GE_WAITV_B(n) asm volatile("s_waitcnt vmcnt(" #n ")" : "+v"(vb0), "+v"(vb1), "+v"(vb2), "+v"(vb3), "+v"(vb4), "+v"(vb5), "+v"(vb6), "+v"(vb7) :: "memory")
#define GE_WRITE_B(buf) do { _Pragma("unroll") for (int _i = 0; _i < 4; ++_i) { u32x4 _w; _w[0] = pk_bf16(vb0[_i], vb1[_i]); _w[1] = pk_bf16(vb2[_i], vb3[_i]); \
        _w[2] = pk_bf16(vb4[_i], vb5[_i]); _w[3] = pk_bf16(vb6[_i], vb7[_i]); \
        *(LAS u32x4*)(lds + ((_i & 1) ? bw1 : bw0) + (_i >> 1) * 128 + (buf) * 32768) = _w; } } while (0)
#define GE_KSTEP(buf, ks) do { bf16x8 Bf[4]; \
        _Pragma("unroll") for (int n = 0; n < 4; ++n) Bf[n] = *(const LAS bf16x8*)(lds + (buf) * 32768 + boff + n * 2048 + (ks) * 1024); \
        _Pragma("unroll") for (int mh = 0; mh < 2; ++mh) { bf16x8 At[4]; \
            _Pragma("unroll") for (int m = 0; m < 4; ++m) At[m] = *(const LAS bf16x8*)(lds + (buf) * 32768 + aoff + (mh * 4 + m) * 2048 + (ks) * 1024); \
            _Pragma("unroll") for (int m = 0; m < 4; ++m) { if (!RAGGED || (mh * 4 + m) < mvalid) { _Pragma("unroll") for (int n = 0; n < 4; ++n) \
                { if (PM & 4) { asm volatile("" :: "v"(At[m]), "v"(Bf[n])); } else acc[mh * 4 + m][n] = TRANS ? __builtin_amdgcn_mfma_f32_16x16x32_bf16(At[m], Bf[n], acc[mh * 4 + m][n], 0, 0, 0) : __builtin_amdgcn_mfma_f32_16x16x32_bf16(Bf[n], At[m], acc[mh * 4 + m][n], 0, 0, 0); } } } } } while (0)
    GE_GLDS_A(0, 0);
    GE_LOAD_B(0);
    GE_WAITV_B(0);
    GE_WRITE_B(0);
    GE_LOAD_B(1);
    asm volatile("s_waitcnt lgkmcnt(0)" ::: "memory");
    __builtin_amdgcn_s_barrier();
    int t = 0;
    for (; t < nt - 2; ++t) {
        const int cur = t & 1;
        GE_GLDS_A(cur ^ 1, t + 1);
        GE_KSTEP(cur, 0);
        GE_WAITV_B(4);
        GE_WRITE_B(cur ^ 1);
        GE_LOAD_B(t + 2);
        __builtin_amdgcn_sched_barrier(0);
        GE_KSTEP(cur, 1);
        asm volatile("s_waitcnt vmcnt(8) lgkmcnt(0)" ::: "memory");
        __builtin_amdgcn_s_barrier();
    }
    {
        const int cur = t & 1;
        GE_GLDS_A(cur ^ 1, t + 1);
        GE_KSTEP(cur, 0);
        GE_WAITV_B(4);
        GE_WRITE_B(cur ^ 1);
        GE_KSTEP(cur, 1);
        asm volatile("s_waitcnt vmcnt(0) lgkmcnt(0)" ::: "memory");
        __builtin_amdgcn_s_barrier();
        ++t;
    }
    {
        const int cur = t & 1;
        GE_KSTEP(cur, 0);
        GE_KSTEP(cur, 1);
        asm volatile("s_waitcnt lgkmcnt(0)" ::: "memory");
        __builtin_amdgcn_s_barrier();
    }
#undef GE_GLDS_A
#undef GE_LD1
#undef GE_LOAD_B
#undef GE_WAITV_B
#undef GE_WRITE_B
#undef GE_KSTEP
    __builtin_amdgcn_sched_barrier(0);
    { const int tz = tid_fresh(), wz = __builtin_amdgcn_readfirstlane(tz >> 6), lz = tz & 63;
      epi(acc, wz >> 2, wz & 3, lz & 15, lz >> 4); }
}

__device__ __forceinline__ int xcd_logical(int b, int G) { return (G & 7) ? b : (b & 7) * (G >> 3) + (b >> 3); }

struct ColMapDense { int c0; __device__ __forceinline__ int operator()(int rg) const { return c0 + 4 * rg; } };
struct EpiPG { u16* PG; int tok0, col0;
    __device__ __forceinline__ void operator()(const f32x4 (&acc)[8][4], int wr, int wc, int fr, int fq) const {
#pragma unroll
        for (int m = 0; m < 8; ++m) { u16* rowp = PG + (size_t)(tok0 + wr * 128 + m * 16 + fr) * 5120 + col0 + wc * 64 + 4 * fq;
#pragma unroll
            for (int n = 0; n < 4; ++n) { const f32x4 v = unperm(acc[m][n], fq & 1); u32x2 w; w[0] = pk_bf16(v[0], v[1]); w[1] = pk_bf16(v[2], v[3]); *(u32x2*)(rowp + n * 16) = w; } }
    } };
struct EpiHYT { u16* HYT; int tok0, col0;
    __device__ __forceinline__ void operator()(const f32x4 (&acc)[8][4], int wr, int wc, int fr, int fq) const {
#pragma unroll
        for (int n = 0; n < 4; ++n) { const int rho = wc * 64 + n * 16 + fr; const int col = col0 + (rho & ~3) + ((rho & 3) ^ ((rho >> 2) & 1));
            u16* colp = HYT + (size_t)col * NTOK + tok0 + wr * 128 + 4 * fq;
#pragma unroll
            for (int m = 0; m < 8; ++m) { const f32x4 v = acc[m][n]; u32x2 w; w[0] = pk_bf16(v[0], v[1]); w[1] = pk_bf16(v[2], v[3]); *(u32x2*)(colp + m * 16) = w; } }
    } };
struct EpiX1 { const float* x; float* X1; int tok0, col0;
    __device__ __forceinline__ void operator()(const f32x4 (&acc)[8][4], int wr, int wc, int fr, int fq) const {
#pragma unroll
        for (int m = 0; m < 8; ++m) { const size_t off = (size_t)(tok0 + wr * 128 + m * 16 + fr) * DM + col0 + wc * 64 + 4 * fq;
#pragma unroll
            for (int n = 0; n < 4; ++n) { const f32x4 r = *(const f32x4*)(x + off + n * 16); *(f32x4*)(X1 + off + n * 16) = r + unperm(acc[m][n], fq & 1); }
            asm volatile("" ::: "memory"); }
    } };
struct ColMapGlu { int nt; __device__ __forceinline__ int operator()(int rg) const { const int wcq = rg >> 4, n = (rg >> 2) & 3, f = rg & 3; return (n >> 1) * 2048 + nt * 128 + wcq * 32 + (n & 1) * 16 + f * 4; } };
struct EpiSwiglu { u16* HM; const float* b1; int slot0, nt, rows_valid;
    __device__ __forceinline__ void operator()(const f32x4 (&acc)[8][4], int wr, int wc, int fr, int fq) const {
        f32x4 bg[2], bl[2];
#pragma unroll
        for (int nn = 0; nn < 2; ++nn) { const int col = nt * 128 + wc * 32 + nn * 16 + 4 * fq; bg[nn] = *(const f32x4*)(b1 + col); bl[nn] = *(const f32x4*)(b1 + 2048 + col); }
#pragma unroll
        for (int m = 0; m < 8; ++m) { const int row = wr * 128 + m * 16 + fr;
            if (row < rows_valid) {
#pragma unroll
                for (int nn = 0; nn < 2; ++nn) { const f32x4 gl = unperm(acc[m][nn], fq & 1) + bg[nn], li = unperm(acc[m][nn + 2], fq & 1) + bl[nn]; float o[4];
#pragma unroll
                    for (int j = 0; j < 4; ++j) { const float gq = fminf(gl[j], 7.0f), lq = fminf(fmaxf(li[j], -7.0f), 7.0f); o[j] = gq * (1.0f / (1.0f + __expf(-1.702f * gq))) * (lq + 1.0f); }
                    u32x2 w; w[0] = pk_bf16(o[0], o[1]); w[1] = pk_bf16(o[2], o[3]);
                    *(u32x2*)(HM + (size_t)(slot0 + row) * DFF + nt * 128 + wc * 32 + nn * 16 + 4 * fq) = w; } } }
    } };
struct EpiY { u16* Y; const float* b2; int slot0, col0, rows_valid;
    __device__ __forceinline__ void operator()(const f32x4 (&acc)[8][4], int wr, int wc, int fr, int fq) const {
        f32x4 bv[4];
#pragma unroll
        for (int n = 0; n < 4; ++n) bv[n] = *(const f32x4*)(b2 + col0 + wc * 64 + n * 16 + 4 * fq);
#pragma unroll
        for (int m = 0; m < 8; ++m) { const int row = wr * 128 + m * 16 + fr;
            if (row < rows_valid) { u16* rowp = Y + (size_t)(slot0 + row) * DM + col0 + wc * 64 + 4 * fq;
#pragma unroll
                for (int n = 0; n < 4; ++n) { const f32x4 v = unperm(acc[m][n], fq & 1) + bv[n]; u32x2 w; w[0] = pk_bf16(v[0], v[1]); w[1] = pk_bf16(v[2], v[3]); *(u32x2*)(rowp + n * 16) = w; } } }
    } };
template <int NTILES>
__device__ __forceinline__ bool moe_decode(const int* __restrict__ offs, int u, int& e, int& mt, int& nt, int& slot0, int& rows) {
    int base = 0;
    for (int q = 0; q < NE; ++q) { const int o0 = offs[q], cnt = offs[q + 1] - o0, mtl = (cnt + 255) >> 8, nu = mtl * NTILES;
        if (u < base + nu) { const int ul = u - base; e = q; mt = ul % mtl; nt = ul / mtl; slot0 = o0 + mt * 256; rows = cnt - mt * 256; if (rows > 256) rows = 256; return true; }
        base += nu; }
    return false;
}


__device__ __forceinline__ int perm_col4(int rg) { const int rgl = rg & 31, t = rgl & 7; return 32 * (rgl >> 3) + 8 * (t & 3) + 4 * (t >> 2); }
__device__ __forceinline__ int perm32(int rho) { const int n = rho >> 4, i = rho & 15; return 8 * (i >> 2) + 4 * n + (i & 3); }
template <class ColMap>
__device__ __forceinline__ void convert_tile(const float* __restrict__ W, int ldb, int k0, const ColMap colmap, u16* __restrict__ dst, int tid) {
    const int wid = tid >> 6, lane = tid & 63;
    const int g = (lane & 3) + 4 * (wid >> 2), rg = (wid & 3) * 16 + (lane >> 2);
    const float* bp = W + (size_t)(k0 + 8 * g) * ldb + colmap(rg);
    f32x4 v[8];
#pragma unroll
    for (int kk = 0; kk < 8; ++kk) v[kk] = __builtin_nontemporal_load((const f32x4*)(bp + (size_t)kk * ldb));
    const int h = rg >> 5, r0 = (4 * rg) & 127;
    unsigned char* base = (unsigned char*)dst + h * 16384 + lds_byte(r0, 8 * g);
#pragma unroll
    for (int i = 0; i < 4; ++i) { u32x4 w; w[0] = pk_bf16(v[0][i], v[1][i]); w[1] = pk_bf16(v[2][i], v[3][i]); w[2] = pk_bf16(v[4][i], v[5][i]); w[3] = pk_bf16(v[6][i], v[7][i]);
        *(u32x4*)(base + i * 64) = w; }
}
typedef int i32x8 __attribute__((ext_vector_type(8)));
typedef int i32x4 __attribute__((ext_vector_type(4)));
constexpr float W8_SCALE = 32.0f;
constexpr int W8_MX = 0x7A7A7A7A;
constexpr int A8_MX = 0x7F7F7F7F;
__device__ __forceinline__ unsigned pk_fp8x4(float a, float b, float c, float d) { int p = __builtin_amdgcn_cvt_pk_fp8_f32(a, b, 0, false); p = __builtin_amdgcn_cvt_pk_fp8_f32(c, d, p, true); return (unsigned)p; }
__device__ __forceinline__ int lds_byte_b(int r, int cb) { const int st = (r >> 4) * 2 + (cb >> 6), ob = (r & 15) * 64 + (cb & 63); return st * 1024 + (ob ^ (((ob >> 9) & 1) << 5)); }
struct ConvCtx { const float* w1; const float* w2; unsigned char* W1T; unsigned char* W2T; };
__device__ __forceinline__ int conv_seq2tile(int s) {
    if (s < 16384) return (s >> 9) * 512 + (s & 15) * 32 + ((s >> 4) & 31);
    const int q = s - 16384; return 16384 + (q >> 8) * 256 + (q & 7) * 32 + ((q >> 3) & 31);
}
__device__ __forceinline__ void conv_issue(const ConvCtx& cc, int m, int wid, int lane, f32x2 (&v)[16]) {
    const int rp = 16 * wid + (lane & 15), rg = rp >> 1, p2 = (rp & 1) * 2, kg = lane >> 4;
    const float* bp; size_t ld;
    if (m < 16384) { const int e = m >> 9, nt = (m >> 5) & 15, kt = m & 31; ld = 2 * DFF; bp = cc.w1 + (size_t)e * DM * 2 * DFF + (size_t)(kt * 64 + 16 * kg) * ld + (rg >> 5) * 2048 + nt * 128 + perm_col4(rg) + p2; }
    else { const int q = m - 16384, e = q >> 8, nt = (q >> 5) & 7, kt = q & 31; ld = DM; bp = cc.w2 + (size_t)e * DFF * DM + (size_t)(kt * 64 + 16 * kg) * ld + nt * 256 + (rg >> 5) * 128 + perm_col4(rg) + p2; }
#pragma unroll
    for (int kk = 0; kk < 16; ++kk) v[kk] = __builtin_nontemporal_load((const f32x2*)(bp + (size_t)kk * ld));
}
__device__ __forceinline__ void conv_finish(const ConvCtx& cc, int m, int wid, int lane, const f32x2 (&v)[16]) {
    const int rp = 16 * wid + (lane & 15), kg = lane >> 4;
    const int kt64 = m & 31;
    unsigned char* dst = (m < 16384) ? cc.W1T + ((size_t)(m >> 5) * 16 + (kt64 >> 1)) * 32768 : cc.W2T + ((size_t)((m - 16384) >> 5) * 16 + (kt64 >> 1)) * 32768;
    unsigned char* base = dst + (rp >> 6) * 16384 + lds_byte_b((2 * rp) & 127, (kt64 & 1) * 64 + 16 * kg);
#pragma unroll
    for (int i = 0; i < 2; ++i) { u32x4 w;
#pragma unroll
        for (int q = 0; q < 4; ++q) w[q] = pk_fp8x4(v[4 * q][i] * W8_SCALE, v[4 * q + 1][i] * W8_SCALE, v[4 * q + 2][i] * W8_SCALE, v[4 * q + 3][i] * W8_SCALE);
        __builtin_nontemporal_store(w, (u32x4*)(base + i * 64)); }
}
__device__ __forceinline__ void conv_issue_win(const float* __restrict__ w_in, int q, int wid, int lane, f32x2 (&v)[16]) {
    const int rp = 16 * wid + (lane & 15), rg = rp >> 1, p2 = (rp & 1) * 2, kg = lane >> 4;
    const int nt = q >> 5, kt = q & 31;
    const float* bp = w_in + (size_t)(kt * 64 + 16 * kg) * DIN + nt * 256 + (rg >> 5) * 128 + perm_col4(rg) + p2;
#pragma unroll
    for (int kk = 0; kk < 16; ++kk) v[kk] = __builtin_nontemporal_load((const f32x2*)(bp + (size_t)kk * DIN));
}
__device__ __forceinline__ void conv_finish_win(unsigned char* __restrict__ WT, int q, int wid, int lane, const f32x2 (&v)[16]) {
    const int rp = 16 * wid + (lane & 15), kg = lane >> 4;
    const int kt64 = q & 31;
    unsigned char* base = WT + ((size_t)(q >> 5) * 16 + (kt64 >> 1)) * 32768 + (rp >> 6) * 16384 + lds_byte_b((2 * rp) & 127, (kt64 & 1) * 64 + 16 * kg);
#pragma unroll
    for (int i = 0; i < 2; ++i) { u32x4 w;
#pragma unroll
        for (int qq = 0; qq < 4; ++qq) w[qq] = pk_fp8x4(v[4 * qq][i] * W8_SCALE, v[4 * qq + 1][i] * W8_SCALE, v[4 * qq + 2][i] * W8_SCALE, v[4 * qq + 3][i] * W8_SCALE);
        __builtin_nontemporal_store(w, (u32x4*)(base + i * 64)); }
}
struct ColMapGluT { int nt; __device__ __forceinline__ int operator()(int rg) const { return (rg >> 5) * 2048 + nt * 128 + perm_col4(rg); } };
struct ColMapPerm { int c0; __device__ __forceinline__ int operator()(int rg) const { return c0 + (rg >> 5) * 128 + perm_col4(rg); } };

template <bool TRANS, bool FP8 = false, class Epi>
__device__ __forceinline__ void gemm8_unit(LAS unsigned char* lds, const u16* __restrict__ A, int lda, const int* __restrict__ arows, int arow0, int rows_valid, const u16* __restrict__ Bt, int nt, const Epi epi) {
    const int tid = tid_fresh(), wid = __builtin_amdgcn_readfirstlane(tid >> 6), lane = tid & 63;
    const int wr = wid >> 2, wc = wid & 3, fr = lane & 15, fq = lane >> 4;
    unsigned aof[2][2];
#pragma unroll
    for (int h = 0; h < 2; ++h)
#pragma unroll
        for (int i = 0; i < 2; ++i) { int R, C; stage_rc(tid * 16 + i * 8192, R, C); int rr = h * 128 + R; rr = rr < rows_valid ? rr : rows_valid - 1;
            const unsigned rowid = arows ? (unsigned)arows[rr] : (unsigned)(arow0 + rr); aof[h][i] = (rowid * (unsigned)lda + (unsigned)C) * 2u; }
    const char* Ab = (const char*)A; const char* Bb = (const char*)Bt + tid * 16;
    const bool hi = rows_valid > 128;
    int mxw = W8_MX, mxa = A8_MX; asm volatile("" : "+v"(mxw), "+v"(mxa));
#define G8_SA(b, h) (((b) * 2 + (h)) * 16384)
#define G8_SB(b, h) (65536 + ((b) * 2 + (h)) * 16384)
#define G8_STA(b, h, kt) do { _Pragma("unroll") for (int _i = 0; _i < 2; ++_i) \
        __builtin_amdgcn_global_load_lds((const unsigned*)(Ab + aof[h][_i] + (size_t)(kt) * 128), (LAS unsigned*)(lds + G8_SA(b, h) + wid * 1024 + _i * 8192), 16, 0, 0); } while (0)
#define G8_STB(b, h, kt) do { _Pragma("unroll") for (int _i = 0; _i < 2; ++_i) \
        __builtin_amdgcn_global_load_lds((const unsigned*)(Bb + (size_t)(kt) * 32768 + (h) * 16384 + _i * 8192), (LAS unsigned*)(lds + G8_SB(b, h) + wid * 1024 + _i * 8192), 16, 0, 0); } while (0)
#define G8_LDA(dst, b, h) do { _Pragma("unroll") for (int m = 0; m < 4; ++m) _Pragma("unroll") for (int k = 0; k < 2; ++k) dst[m][k] = *(const LAS bf16x8*)(lds + G8_SA(b, h) + aoff + m * 2048 + k * 1024); } while (0)
#define G8_LDB(dst, b, h) do { _Pragma("unroll") for (int n = 0; n < 2; ++n) _Pragma("unroll") for (int k = 0; k < 2; ++k) dst[n][k] = *(const LAS bf16x8*)(lds + G8_SB(b, h) + boff + n * 2048 + k * 1024); } while (0)
#define G8_MMA(ai, bj, At, Bq) do { if ((ai) == 0 || hi) { __builtin_amdgcn_s_setprio(1); _Pragma("unroll") for (int m = 0; m < 4; ++m) _Pragma("unroll") for (int n = 0; n < 2; ++n) { \
        if (FP8) { const i32x4 a0 = __builtin_bit_cast(i32x4, At[m][0]), a1 = __builtin_bit_cast(i32x4, At[m][1]), b0 = __builtin_bit_cast(i32x4, Bq[n][0]), b1 = __builtin_bit_cast(i32x4, Bq[n][1]); \
            const i32x8 a8 = __builtin_shufflevector(a0, a1, 0, 1, 2, 3, 4, 5, 6, 7), b8 = __builtin_shufflevector(b0, b1, 0, 1, 2, 3, 4, 5, 6, 7); \
            if (TRANS) asm volatile("v_mfma_scale_f32_16x16x128_f8f6f4 %0, %1, %2, %0, %3, %4 op_sel_hi:[0,0,0]" : "+v"(acc[ai][bj][m][n]) : "v"(a8), "v"(b8), "v"(mxa), "v"(mxw)); \
            else asm volatile("v_mfma_scale_f32_16x16x128_f8f6f4 %0, %1, %2, %0, %3, %4 op_sel_hi:[0,0,0]" : "+v"(acc[ai][bj][m][n]) : "v"(b8), "v"(a8), "v"(mxw), "v"(mxa)); } \
        else { _Pragma("unroll") for (int k = 0; k < 2; ++k) \
            acc[ai][bj][m][n] = TRANS ? __builtin_amdgcn_mfma_f32_16x16x32_bf16(At[m][k], Bq[n][k], acc[ai][bj][m][n], 0, 0, 0) : __builtin_amdgcn_mfma_f32_16x16x32_bf16(Bq[n][k], At[m][k], acc[ai][bj][m][n], 0, 0, 0); } } \
        __builtin_amdgcn_s_setprio(0); } } while (0)
#define G8_WV(n) asm volatile("s_waitcnt vmcnt(" #n ")" ::: "memory")
#define G8_WL(n) asm volatile("s_waitcnt lgkmcnt(" #n ")" ::: "memory")
#define G8_BAR __builtin_amdgcn_s_barrier()
#define G8_SCHED __builtin_amdgcn_sched_barrier(0)
    const int aoff = lds_byte(wr * 64 + fr, fq * 8), boff = lds_byte(wc * 32 + fr, fq * 8);
    f32x4 acc[2][2][4][2];
#pragma unroll
    for (int a = 0; a < 2; ++a)
#pragma unroll
        for (int b = 0; b < 2; ++b)
#pragma unroll
            for (int m = 0; m < 4; ++m)
#pragma unroll
                for (int n = 0; n < 2; ++n) acc[a][b][m][n] = (f32x4){0.f, 0.f, 0.f, 0.f};
    bf16x8 At[4][2], B0[2][2], B1[2][2];
    G8_STB(0, 0, 0); G8_STA(0, 0, 0); G8_STB(0, 1, 0); G8_STA(0, 1, 0);
    if (wr == 1) G8_BAR;
    G8_WV(4); G8_BAR;
    G8_STB(1, 0, 1); G8_STA(1, 0, 1); G8_STB(1, 1, 1);
    G8_WV(6); G8_BAR;
    for (int t = 0; t < nt - 2; t += 2) {
        G8_LDB(B0, 0, 0); G8_SCHED; G8_LDA(At, 0, 0); G8_STA(1, 1, t + 1);
        G8_WL(8); G8_BAR; G8_WL(0); G8_MMA(0, 0, At, B0); G8_BAR; G8_SCHED;
        G8_LDB(B1, 0, 1); G8_STB(0, 0, t + 2);
        G8_BAR; G8_WL(0); G8_MMA(0, 1, At, B1); G8_BAR;
        if (hi) G8_LDA(At, 0, 1); G8_STA(0, 0, t + 2);
        G8_BAR; G8_WL(0); G8_MMA(1, 0, At, B0); G8_BAR; G8_SCHED;
        G8_STB(0, 1, t + 2);
        G8_WV(6); G8_BAR; G8_MMA(1, 1, At, B1); G8_BAR;
        G8_LDB(B0, 1, 0); G8_SCHED; G8_LDA(At, 1, 0); G8_STA(0, 1, t + 2);
        G8_WL(8); G8_BAR; G8_WL(0); G8_MMA(0, 0, At, B0); G8_BAR; G8_SCHED;
        G8_LDB(B1, 1, 1); G8_STB(1, 0, t + 3);
        G8_BAR; G8_WL(0); G8_MMA(0, 1, At, B1); G8_BAR;
        if (hi) G8_LDA(At, 1, 1); G8_STA(1, 0, t + 3);
        G8_BAR; G8_WL(0); G8_MMA(1, 0, At, B0); G8_BAR; G8_SCHED;
        G8_STB(1, 1, t + 3);
        G8_WV(6); G8_BAR; G8_MMA(1, 1, At, B1); G8_BAR;
    }
    { G8_LDB(B0, 0, 0); G8_WV(0); G8_LDA(At, 0, 0); G8_STA(1, 1, nt - 1);
      G8_BAR; G8_WL(0); G8_MMA(0, 0, At, B0); G8_BAR;
      G8_LDB(B1, 0, 1); G8_BAR; G8_WL(0); G8_MMA(0, 1, At, B1); G8_BAR;
      G8_LDA(At, 0, 1); G8_WV(4); G8_BAR; G8_WL(0); G8_MMA(1, 0, At, B0); G8_MMA(1, 1, At, B1); G8_BAR; }
    { G8_LDB(B0, 1, 0); G8_LDA(At, 1, 0); G8_WV(2); G8_BAR; G8_WL(0); G8_MMA(0, 0, At, B0); G8_BAR;
      G8_LDB(B1, 1, 1); G8_WV(0); G8_BAR; G8_WL(0); G8_MMA(0, 1, At, B1); G8_BAR;
      G8_LDA(At, 1, 1); G8_BAR; G8_WL(0); G8_MMA(1, 0, At, B0); G8_MMA(1, 1, At, B1); G8_BAR; }
    if (wr == 0) G8_BAR;
#undef G8_SA
#undef G8_SB
#undef G8_STA
#undef G8_STB
#undef G8_LDA
#undef G8_LDB
#undef G8_MMA
#undef G8_WV
#undef G8_WL
#undef G8_BAR
#undef G8_SCHED
    __builtin_amdgcn_sched_barrier(0);
    { const int tz = tid_fresh(), wz = __builtin_amdgcn_readfirstlane(tz >> 6), lz = tz & 63;
      epi(acc, wz >> 2, wz & 3, lz & 15, lz >> 4); }
}
struct G8Pre { unsigned aof[2][2]; const char* Bt; int rows; };
__device__ __forceinline__ void g8_addr(G8Pre& p, int lda, const int* __restrict__ arows, int rows_valid, const u16* __restrict__ Bt) {
    const int tid = tid_fresh();
#pragma unroll
    for (int h = 0; h < 2; ++h)
#pragma unroll
        for (int i = 0; i < 2; ++i) { int R, C; stage_rc(tid * 16 + i * 8192, R, C); int rr = h * 128 + R; rr = rr < rows_valid ? rr : rows_valid - 1;
            p.aof[h][i] = ((unsigned)arows[rr] * (unsigned)lda + (unsigned)C) * 2u; }
    p.Bt = (const char*)Bt; p.rows = rows_valid;
}
__device__ __forceinline__ void g8_issue(LAS unsigned char* lds, const char* Ab, const G8Pre& p) {
    const int tid = tid_fresh(), wid = __builtin_amdgcn_readfirstlane(tid >> 6);
    const char* Bb = p.Bt + tid * 16;
#define G8I_A(b, h, kt) do { _Pragma("unroll") for (int _i = 0; _i < 2; ++_i) \
        __builtin_amdgcn_global_load_lds((const unsigned*)(Ab + p.aof[h][_i] + (size_t)(kt) * 128), (LAS unsigned*)(lds + ((b) * 2 + (h)) * 16384 + wid * 1024 + _i * 8192), 16, 0, 0); } while (0)
#define G8I_B(b, h, kt) do { _Pragma("unroll") for (int _i = 0; _i < 2; ++_i) \
        __builtin_amdgcn_global_load_lds((const unsigned*)(Bb + (size_t)(kt) * 32768 + (h) * 16384 + _i * 8192), (LAS unsigned*)(lds + 65536 + ((b) * 2 + (h)) * 16384 + wid * 1024 + _i * 8192), 16, 0, 0); } while (0)
    G8I_B(0, 0, 0); G8I_A(0, 0, 0); G8I_B(0, 1, 0); G8I_A(0, 1, 0); G8I_B(1, 0, 1); G8I_A(1, 0, 1); G8I_B(1, 1, 1);
#undef G8I_A
#undef G8I_B
}
template <bool TRANS, bool FP8, class Epi, class Next>
__device__ __forceinline__ bool gemm8_unit_ov(LAS unsigned char* lds, const u16* __restrict__ A, const G8Pre& pre, int nt, const Epi epi, Next& next) {
    const int tid = tid_fresh(), wid = __builtin_amdgcn_readfirstlane(tid >> 6), lane = tid & 63;
    const int wr = wid >> 2, wc = wid & 3, fr = lane & 15, fq = lane >> 4;
    unsigned aof[2][2];
    aof[0][0] = pre.aof[0][0]; aof[0][1] = pre.aof[0][1]; aof[1][0] = pre.aof[1][0]; aof[1][1] = pre.aof[1][1];
    const int rows_valid = pre.rows;
    const char* Ab = (const char*)A; const char* Bb = pre.Bt + tid * 16;
    const bool hi = rows_valid > 128;
    int mxw = W8_MX, mxa = A8_MX; asm volatile("" : "+v"(mxw), "+v"(mxa));
#define G8_SA(b, h) (((b) * 2 + (h)) * 16384)
#define G8_SB(b, h) (65536 + ((b) * 2 + (h)) * 16384)
#define G8_STA(b, h, kt) do { _Pragma("unroll") for (int _i = 0; _i < 2; ++_i) \
        __builtin_amdgcn_global_load_lds((const unsigned*)(Ab + aof[h][_i] + (size_t)(kt) * 128), (LAS unsigned*)(lds + G8_SA(b, h) + wid * 1024 + _i * 8192), 16, 0, 0); } while (0)
#define G8_STB(b, h, kt) do { _Pragma("unroll") for (int _i = 0; _i < 2; ++_i) \
        __builtin_amdgcn_global_load_lds((const unsigned*)(Bb + (size_t)(kt) * 32768 + (h) * 16384 + _i * 8192), (LAS unsigned*)(lds + G8_SB(b, h) + wid * 1024 + _i * 8192), 16, 0, 0); } while (0)
#define G8_LDA(dst, b, h) do { _Pragma("unroll") for (int m = 0; m < 4; ++m) _Pragma("unroll") for (int k = 0; k < 2; ++k) dst[m][k] = *(const LAS bf16x8*)(lds + G8_SA(b, h) + aoff + m * 2048 + k * 1024); } while (0)
#define G8_LDB(dst, b, h) do { _Pragma("unroll") for (int n = 0; n < 2; ++n) _Pragma("unroll") for (int k = 0; k < 2; ++k) dst[n][k] = *(const LAS bf16x8*)(lds + G8_SB(b, h) + boff + n * 2048 + k * 1024); } while (0)
#define G8_MMA(ai, bj, At, Bq) do { if ((ai) == 0 || hi) { __builtin_amdgcn_s_setprio(1); _Pragma("unroll") for (int m = 0; m < 4; ++m) _Pragma("unroll") for (int n = 0; n < 2; ++n) { \
        if (FP8) { const i32x4 a0 = __builtin_bit_cast(i32x4, At[m][0]), a1 = __builtin_bit_cast(i32x4, At[m][1]), b0 = __builtin_bit_cast(i32x4, Bq[n][0]), b1 = __builtin_bit_cast(i32x4, Bq[n][1]); \
            const i32x8 a8 = __builtin_shufflevector(a0, a1, 0, 1, 2, 3, 4, 5, 6, 7), b8 = __builtin_shufflevector(b0, b1, 0, 1, 2, 3, 4, 5, 6, 7); \
            if (TRANS) asm volatile("v_mfma_scale_f32_16x16x128_f8f6f4 %0, %1, %2, %0, %3, %4 op_sel_hi:[0,0,0]" : "+v"(acc[ai][bj][m][n]) : "v"(a8), "v"(b8), "v"(mxa), "v"(mxw)); \
            else asm volatile("v_mfma_scale_f32_16x16x128_f8f6f4 %0, %1, %2, %0, %3, %4 op_sel_hi:[0,0,0]" : "+v"(acc[ai][bj][m][n]) : "v"(b8), "v"(a8), "v"(mxw), "v"(mxa)); } \
        else { _Pragma("unroll") for (int k = 0; k < 2; ++k) \
            acc[ai][bj][m][n] = TRANS ? __builtin_amdgcn_mfma_f32_16x16x32_bf16(At[m][k], Bq[n][k], acc[ai][bj][m][n], 0, 0, 0) : __builtin_amdgcn_mfma_f32_16x16x32_bf16(Bq[n][k], At[m][k], acc[ai][bj][m][n], 0, 0, 0); } } \
        __builtin_amdgcn_s_setprio(0); } } while (0)
#define G8_WV(n) asm volatile("s_waitcnt vmcnt(" #n ")" ::: "memory")
#define G8_WL(n) asm volatile("s_waitcnt lgkmcnt(" #n ")" ::: "memory")
#define G8_BAR __builtin_amdgcn_s_barrier()
#define G8_SCHED __builtin_amdgcn_sched_barrier(0)
    const int aoff = lds_byte(wr * 64 + fr, fq * 8), boff = lds_byte(wc * 32 + fr, fq * 8);
    f32x4 acc[2][2][4][2];
#pragma unroll
    for (int a = 0; a < 2; ++a)
#pragma unroll
        for (int b = 0; b < 2; ++b)
#pragma unroll
            for (int m = 0; m < 4; ++m)
#pragma unroll
                for (int n = 0; n < 2; ++n) acc[a][b][m][n] = (f32x4){0.f, 0.f, 0.f, 0.f};
    bf16x8 At[4][2], B0[2][2], B1[2][2];
    if (wr == 1) G8_BAR;
    G8_WV(0); G8_BAR;
    G8_BAR;
    for (int t = 0; t < nt - 2; t += 2) {
        G8_LDB(B0, 0, 0); G8_SCHED; G8_LDA(At, 0, 0); G8_STA(1, 1, t + 1);
        G8_WL(8); G8_BAR; G8_WL(0); G8_MMA(0, 0, At, B0); G8_BAR; G8_SCHED;
        G8_LDB(B1, 0, 1); G8_STB(0, 0, t + 2);
        G8_BAR; G8_WL(0); G8_MMA(0, 1, At, B1); G8_BAR;
        if (hi) G8_LDA(At, 0, 1); G8_STA(0, 0, t + 2);
        G8_BAR; G8_WL(0); G8_MMA(1, 0, At, B0); G8_BAR; G8_SCHED;
        G8_STB(0, 1, t + 2);
        G8_WV(6); G8_BAR; G8_MMA(1, 1, At, B1); G8_BAR;
        G8_LDB(B0, 1, 0); G8_SCHED; G8_LDA(At, 1, 0); G8_STA(0, 1, t + 2);
        G8_WL(8); G8_BAR; G8_WL(0); G8_MMA(0, 0, At, B0); G8_BAR; G8_SCHED;
        G8_LDB(B1, 1, 1); G8_STB(1, 0, t + 3);
        G8_BAR; G8_WL(0); G8_MMA(0, 1, At, B1); G8_BAR;
        if (hi) G8_LDA(At, 1, 1); G8_STA(1, 0, t + 3);
        G8_BAR; G8_WL(0); G8_MMA(1, 0, At, B0); G8_BAR; G8_SCHED;
        G8_STB(1, 1, t + 3);
        G8_WV(6); G8_BAR; G8_MMA(1, 1, At, B1); G8_BAR;
    }
    { G8_LDB(B0, 0, 0); G8_WV(0); G8_LDA(At, 0, 0); G8_STA(1, 1, nt - 1);
      G8_BAR; G8_WL(0); G8_MMA(0, 0, At, B0); G8_BAR;
      G8_LDB(B1, 0, 1); G8_BAR; G8_WL(0); G8_MMA(0, 1, At, B1); G8_BAR;
      G8_LDA(At, 0, 1); G8_WV(4); G8_BAR; G8_WL(0); G8_MMA(1, 0, At, B0); G8_MMA(1, 1, At, B1); G8_BAR; }
    { G8_LDB(B0, 1, 0); G8_LDA(At, 1, 0); G8_WV(2); G8_BAR; G8_WL(0); G8_MMA(0, 0, At, B0); G8_BAR;
      G8_LDB(B1, 1, 1); G8_WV(0); G8_BAR; G8_WL(0); G8_MMA(0, 1, At, B1); G8_BAR;
      G8_LDA(At, 1, 1); G8_BAR; G8_WL(0); G8_MMA(1, 0, At, B0); G8_MMA(1, 1, At, B1); G8_BAR; }
    if (wr == 0) G8_BAR;
#undef G8_SA
#undef G8_SB
#undef G8_STA
#undef G8_STB
#undef G8_LDA
#undef G8_LDB
#undef G8_MMA
#undef G8_WV
#undef G8_WL
#undef G8_BAR
#undef G8_SCHED
    __builtin_amdgcn_sched_barrier(0);
    const bool has_next = next();
    __builtin_amdgcn_sched_barrier(0);
    { const int tz = tid_fresh(), wz = __builtin_amdgcn_readfirstlane(tz >> 6), lz = tz & 63;
      epi(acc, wz >> 2, wz & 3, lz & 15, lz >> 4); }
    return has_next;
}
struct StreamUnit { const char* A; const char* Bt; int arow0, rows, a, b, c; };
template <bool TRANS, bool FP8, class Src>
__device__ __forceinline__ void gemm8_stream(LAS unsigned char* lds, unsigned lda, int nt, const Src& src) {
    const int tid = tid_fresh(), wid = __builtin_amdgcn_readfirstlane(tid >> 6), lane = tid & 63;
    const int wr = wid >> 2, wc = wid & 3, fr = lane & 15, fq = lane >> 4;
    StreamUnit cur, nxt;
    if (!src.get(0, cur)) return;
    int R0, C0, R1, C1; stage_rc(tid * 16, R0, C0); stage_rc(tid * 16 + 8192, R1, C1);
    int mxw = W8_MX, mxa = A8_MX; asm volatile("" : "+v"(mxw), "+v"(mxa));
    const int aoff = lds_byte(wr * 64 + fr, fq * 8), boff = lds_byte(wc * 32 + fr, fq * 8);
#define GS_AOF(u, h, R, C) ((unsigned)(((unsigned)((u).arow0 + (((h) * 128 + (R)) < (u).rows ? ((h) * 128 + (R)) : (u).rows - 1)) * lda + (unsigned)(C)) * 2u))
    unsigned ac00 = GS_AOF(cur, 0, R0, C0), ac01 = GS_AOF(cur, 0, R1, C1), ac10 = GS_AOF(cur, 1, R0, C0), ac11 = GS_AOF(cur, 1, R1, C1);
#define GS_SA(b, h) (((b) * 2 + (h)) * 16384)
#define GS_SB(b, h) (65536 + ((b) * 2 + (h)) * 16384)
#define GS_GL(src_, dst_) __builtin_amdgcn_global_load_lds((const unsigned*)(src_), (LAS unsigned*)(lds + (dst_)), 16, 0, 0)
#define GS_STA(b, h, base, o0, o1, kt) do { GS_GL((base) + (o0) + (size_t)(kt) * 128, GS_SA(b, h) + wid * 1024); GS_GL((base) + (o1) + (size_t)(kt) * 128, GS_SA(b, h) + wid * 1024 + 8192); } while (0)
#define GS_STB(b, h, base, kt) do { GS_GL((base) + tid * 16 + (size_t)(kt) * 32768 + (h) * 16384, GS_SB(b, h) + wid * 1024); GS_GL((base) + tid * 16 + (size_t)(kt) * 32768 + (h) * 16384 + 8192, GS_SB(b, h) + wid * 1024 + 8192); } while (0)
#define GS_LDA(dst, b, h) do { _Pragma("unroll") for (int m = 0; m < 4; ++m) _Pragma("unroll") for (int k = 0; k < 2; ++k) dst[m][k] = *(const LAS bf16x8*)(lds + GS_SA(b, h) + aoff + m * 2048 + k * 1024); } while (0)
#define GS_LDB(dst, b, h) do { _Pragma("unroll") for (int n = 0; n < 2; ++n) _Pragma("unroll") for (int k = 0; k < 2; ++k) dst[n][k] = *(const LAS bf16x8*)(lds + GS_SB(b, h) + boff + n * 2048 + k * 1024); } while (0)
#define GS_MMA(ai, bj, At, Bq) do { if ((ai) == 0 || hi) { __builtin_amdgcn_s_setprio(1); _Pragma("unroll") for (int m = 0; m < 4; ++m) _Pragma("unroll") for (int n = 0; n < 2; ++n) { \
        if (FP8) { const i32x4 a0 = __builtin_bit_cast(i32x4, At[m][0]), a1 = __builtin_bit_cast(i32x4, At[m][1]), b0 = __builtin_bit_cast(i32x4, Bq[n][0]), b1 = __builtin_bit_cast(i32x4, Bq[n][1]); \
            const i32x8 a8 = __builtin_shufflevector(a0, a1, 0, 1, 2, 3, 4, 5, 6, 7), b8 = __builtin_shufflevector(b0, b1, 0, 1, 2, 3, 4, 5, 6, 7); \
            if (TRANS) asm volatile("v_mfma_scale_f32_16x16x128_f8f6f4 %0, %1, %2, %0, %3, %4 op_sel_hi:[0,0,0]" : "+v"(acc[ai][bj][m][n]) : "v"(a8), "v"(b8), "v"(mxa), "v"(mxw)); \
            else asm volatile("v_mfma_scale_f32_16x16x128_f8f6f4 %0, %1, %2, %0, %3, %4 op_sel_hi:[0,0,0]" : "+v"(acc[ai][bj][m][n]) : "v"(b8), "v"(a8), "v"(mxw), "v"(mxa)); } \
        else { _Pragma("unroll") for (int k = 0; k < 2; ++k) \
            acc[ai][bj][m][n] = TRANS ? __builtin_amdgcn_mfma_f32_16x16x32_bf16(At[m][k], Bq[n][k], acc[ai][bj][m][n], 0, 0, 0) : __builtin_amdgcn_mfma_f32_16x16x32_bf16(Bq[n][k], At[m][k], acc[ai][bj][m][n], 0, 0, 0); } } \
        __builtin_amdgcn_s_setprio(0); } } while (0)
#define GS_WV(n) asm volatile("s_waitcnt vmcnt(" #n ")" ::: "memory")
#define GS_WL(n) asm volatile("s_waitcnt lgkmcnt(" #n ")" ::: "memory")
#define GS_BAR __builtin_amdgcn_s_barrier()
#define GS_SCHED __builtin_amdgcn_sched_barrier(0)
    f32x4 acc[2][2][4][2];
#pragma unroll
    for (int a = 0; a < 2; ++a)
#pragma unroll
        for (int b = 0; b < 2; ++b)
#pragma unroll
            for (int m = 0; m < 4; ++m)
#pragma unroll
                for (int n = 0; n < 2; ++n) acc[a][b][m][n] = (f32x4){0.f, 0.f, 0.f, 0.f};
    bf16x8 At[4][2], B0[2][2], B1[2][2];
    GS_STB(0, 0, cur.Bt, 0); GS_STA(0, 0, cur.A, ac00, ac01, 0); GS_STB(0, 1, cur.Bt, 0); GS_STA(0, 1, cur.A, ac10, ac11, 0);
    if (wr == 1) GS_BAR;
    GS_WV(4); GS_BAR;
    GS_STB(1, 0, cur.Bt, 1); GS_STA(1, 0, cur.A, ac00, ac01, 1); GS_STB(1, 1, cur.Bt, 1);
    GS_WV(6); GS_BAR;
    for (int ui = 0;; ++ui) {
        const bool has_next = src.get(ui + 1, nxt);
        if (!has_next) nxt = cur;
        const unsigned an00 = GS_AOF(nxt, 0, R0, C0), an01 = GS_AOF(nxt, 0, R1, C1), an10 = GS_AOF(nxt, 1, R0, C0), an11 = GS_AOF(nxt, 1, R1, C1);
        const bool hi = cur.rows > 128;
        for (int t = 0; t < nt; t += 2) {
            const bool last = (t == nt - 2);
            const char* xA = last ? nxt.A : cur.A; const char* xB = last ? nxt.Bt : cur.Bt;
            const unsigned x00 = last ? an00 : ac00, x01 = last ? an01 : ac01, x10 = last ? an10 : ac10, x11 = last ? an11 : ac11;
            const int k2 = last ? 0 : t + 2, k3 = k2 + 1;
            GS_LDB(B0, 0, 0); GS_SCHED; GS_LDA(At, 0, 0); GS_STA(1, 1, cur.A, ac10, ac11, t + 1);
            GS_WL(8); GS_BAR; GS_WL(0); GS_MMA(0, 0, At, B0); GS_BAR; GS_SCHED;
            GS_LDB(B1, 0, 1); GS_STB(0, 0, xB, k2);
            GS_BAR; GS_WL(0); GS_MMA(0, 1, At, B1); GS_BAR;
            if (hi) GS_LDA(At, 0, 1); GS_STA(0, 0, xA, x00, x01, k2);
            GS_BAR; GS_WL(0); GS_MMA(1, 0, At, B0); GS_BAR; GS_SCHED;
            GS_STB(0, 1, xB, k2);
            GS_WV(6); GS_BAR; GS_MMA(1, 1, At, B1); GS_BAR;
            GS_LDB(B0, 1, 0); GS_SCHED; GS_LDA(At, 1, 0); GS_STA(0, 1, xA, x10, x11, k2);
            GS_WL(8); GS_BAR; GS_WL(0); GS_MMA(0, 0, At, B0); GS_BAR; GS_SCHED;
            GS_LDB(B1, 1, 1); GS_STB(1, 0, xB, k3);
            GS_BAR; GS_WL(0); GS_MMA(0, 1, At, B1); GS_BAR;
            if (hi) GS_LDA(At, 1, 1); GS_STA(1, 0, xA, x00, x01, k3);
            GS_BAR; GS_WL(0); GS_MMA(1, 0, At, B0); GS_BAR; GS_SCHED;
            GS_STB(1, 1, xB, k3);
            GS_WV(6); GS_BAR; GS_MMA(1, 1, At, B1); GS_BAR;
        }
        __builtin_amdgcn_sched_barrier(0);
        src.epi(acc, cur, wr, wc, fr, fq);
        __builtin_amdgcn_sched_barrier(0);
        if (!has_next) break;
#pragma unroll
        for (int a = 0; a < 2; ++a)
#pragma unroll
            for (int b = 0; b < 2; ++b)
#pragma unroll
                for (int m = 0; m < 4; ++m)
#pragma unroll
                    for (int n = 0; n < 2; ++n) acc[a][b][m][n] = (f32x4){0.f, 0.f, 0.f, 0.f};
        cur = nxt; ac00 = an00; ac01 = an01; ac10 = an10; ac11 = an11;
    }
    GS_WV(0);
    if (wr == 0) GS_BAR;
    GS_BAR;
#undef GS_AOF
#undef GS_SA
#undef GS_SB
#undef GS_GL
#undef GS_STA
#undef GS_STB
#undef GS_LDA
#undef GS_LDB
#undef GS_MMA
#undef GS_WV
#undef GS_WL
#undef GS_BAR
#undef GS_SCHED
}
struct Epi8PG { u16* PG; const float* lbl; int tok0, col0;
    __device__ __forceinline__ void operator()(const f32x4 (&acc)[2][2][4][2], int wr, int wc, int fr, int fq) const {
        const int grp = col0 >> 10;
        if (grp == 0) {
#pragma unroll
            for (int ai = 0; ai < 2; ++ai)
#pragma unroll
                for (int m = 0; m < 4; ++m) { u16* rowp = PG + (size_t)(tok0 + ai * 128 + wr * 64 + m * 16 + fr) * 5120 + col0 + wc * 32 + 8 * fq;
#pragma unroll
                    for (int bj = 0; bj < 2; ++bj) { float o[8];
#pragma unroll
                        for (int n = 0; n < 2; ++n)
#pragma unroll
                            for (int q = 0; q < 4; ++q) { const float x = acc[ai][bj][m][n][q]; o[4 * n + q] = x * __builtin_amdgcn_rcpf(1.0f + __expf(-x)); }
                        *(u32x4*)(rowp + bj * 128) = (u32x4){pk_bf16(o[0], o[1]), pk_bf16(o[2], o[3]), pk_bf16(o[4], o[5]), pk_bf16(o[6], o[7])}; } }
        } else if (grp <= 2) {
#pragma unroll
            for (int bj = 0; bj < 2; ++bj) { float lbv[8];
#pragma unroll
                for (int q = 0; q < 8; ++q) { const int c = (col0 & 1023) + bj * 128 + wc * 32 + 8 * fq + q; const float l0 = lbl[(grp - 1) * HGW + c], l1 = lbl[(2 + grp - 1) * HGW + c]; lbv[q] = __builtin_amdgcn_rcpf(1.0f + __expf(l1 - l0)); }
#pragma unroll
                for (int ai = 0; ai < 2; ++ai)
#pragma unroll
                    for (int m = 0; m < 4; ++m) { u16* rowp = PG + (size_t)(tok0 + ai * 128 + wr * 64 + m * 16 + fr) * 5120 + col0 + wc * 32 + 8 * fq; float o[8];
#pragma unroll
                        for (int n = 0; n < 2; ++n)
#pragma unroll
                            for (int q = 0; q < 4; ++q) { const float z = acc[ai][bj][m][n][q], lb = lbv[4 * n + q]; const float sg = __builtin_amdgcn_rcpf(1.0f + __expf(-z)); o[4 * n + q] = __log2f(lb + (1.0f - lb) * sg); }
                        *(u32x4*)(rowp + bj * 128) = (u32x4){pk_bf16(o[0], o[1]), pk_bf16(o[2], o[3]), pk_bf16(o[4], o[5]), pk_bf16(o[6], o[7])}; } }
        } else {
#pragma unroll
            for (int ai = 0; ai < 2; ++ai)
#pragma unroll
                for (int m = 0; m < 4; ++m) { u16* rowp = PG + (size_t)(tok0 + ai * 128 + wr * 64 + m * 16 + fr) * 5120 + col0 + wc * 32 + 8 * fq;
#pragma unroll
                    for (int bj = 0; bj < 2; ++bj) { const f32x4 v0 = acc[ai][bj][m][0], v1 = acc[ai][bj][m][1];
                        *(u32x4*)(rowp + bj * 128) = (u32x4){pk_bf16(v0[0], v0[1]), pk_bf16(v0[2], v0[3]), pk_bf16(v1[0], v1[1]), pk_bf16(v1[2], v1[3])}; } }
        }
    } };
struct Epi8HYT { u16* HYT; int tok0, col0;
    __device__ __forceinline__ void operator()(const f32x4 (&acc)[2][2][4][2], int wr, int wc, int fr, int fq) const {
#pragma unroll
        for (int bj = 0; bj < 2; ++bj)
#pragma unroll
            for (int n = 0; n < 2; ++n) { u16* colp = HYT + (size_t)(col0 + bj * 128 + wc * 32 + perm32(n * 16 + fr)) * NTOK + tok0 + wr * 64 + 4 * fq;
#pragma unroll
                for (int ai = 0; ai < 2; ++ai)
#pragma unroll
                    for (int m = 0; m < 4; ++m) { const f32x4 v = acc[ai][bj][m][n]; *(u32x2*)(colp + ai * 128 + m * 16) = (u32x2){pk_bf16(v[0], v[1]), pk_bf16(v[2], v[3])}; } }
    } };
struct Epi8X1 { const float* x; float* X1; int tok0, col0;
    __device__ __forceinline__ void operator()(const f32x4 (&acc)[2][2][4][2], int wr, int wc, int fr, int fq) const {
#pragma unroll
        for (int ai = 0; ai < 2; ++ai)
#pragma unroll
            for (int m = 0; m < 4; ++m) { const size_t off = (size_t)(tok0 + ai * 128 + wr * 64 + m * 16 + fr) * DM + col0 + wc * 32 + 8 * fq;
#pragma unroll
                for (int bj = 0; bj < 2; ++bj)
#pragma unroll
                    for (int n = 0; n < 2; ++n) { const f32x4 r = *(const f32x4*)(x + off + bj * 128 + n * 4); *(f32x4*)(X1 + off + bj * 128 + n * 4) = r + acc[ai][bj][m][n]; }
                asm volatile("" ::: "memory"); }
    } };
struct Epi8Swiglu { u16* HM; const float* b1; int slot0, nt, rows_valid;
    __device__ __forceinline__ void operator()(const f32x4 (&acc)[2][2][4][2], int wr, int wc, int fr, int fq) const {
        f32x4 bg[2], bl[2];
#pragma unroll
        for (int n = 0; n < 2; ++n) { const int col = nt * 128 + wc * 32 + 8 * fq + 4 * n; bg[n] = *(const f32x4*)(b1 + col); bl[n] = *(const f32x4*)(b1 + 2048 + col); }
#pragma unroll
        for (int ai = 0; ai < 2; ++ai)
#pragma unroll
            for (int m = 0; m < 4; ++m) { const int row = ai * 128 + wr * 64 + m * 16 + fr;
                if (row < rows_valid) { float o[8];
#pragma unroll
                    for (int n = 0; n < 2; ++n) { const f32x4 gl = acc[ai][0][m][n] + bg[n], li = acc[ai][1][m][n] + bl[n];
#pragma unroll
                        for (int j = 0; j < 4; ++j) { const float gq = fminf(gl[j], 7.0f), lq = fminf(fmaxf(li[j], -7.0f), 7.0f); o[4 * n + j] = gq * __builtin_amdgcn_rcpf(1.0f + __builtin_amdgcn_exp2f(-2.45546696f * gq)) * (lq + 1.0f); } }
                    *(u32x4*)(HM + (size_t)(slot0 + row) * DFF + nt * 128 + wc * 32 + 8 * fq) = (u32x4){pk_bf16(o[0], o[1]), pk_bf16(o[2], o[3]), pk_bf16(o[4], o[5]), pk_bf16(o[6], o[7])}; } }
    } };
struct Epi8Swiglu8 { unsigned char* HM; const float* b1; int slot0, nt, rows_valid;
    __device__ __forceinline__ void operator()(const f32x4 (&acc)[2][2][4][2], int wr, int wc, int fr, int fq) const {
        f32x4 bg[2], bl[2];
#pragma unroll
        for (int n = 0; n < 2; ++n) { const int col = nt * 128 + wc * 32 + 8 * fq + 4 * n; bg[n] = *(const f32x4*)(b1 + col); bl[n] = *(const f32x4*)(b1 + 2048 + col); }
#pragma unroll
        for (int ai = 0; ai < 2; ++ai)
#pragma unroll
            for (int m = 0; m < 4; ++m) { const int row = ai * 128 + wr * 64 + m * 16 + fr;
                if (row < rows_valid) { float o[8];
#pragma unroll
                    for (int n = 0; n < 2; ++n) { const f32x4 gl = acc[ai][0][m][n] + bg[n], li = acc[ai][1][m][n] + bl[n];
#pragma unroll
                        for (int j = 0; j < 4; ++j) { const float gq = fminf(gl[j], 7.0f), lq = fminf(fmaxf(li[j], -7.0f), 7.0f); o[4 * n + j] = gq * __builtin_amdgcn_rcpf(1.0f + __builtin_amdgcn_exp2f(-2.45546696f * gq)) * (lq + 1.0f); } }
                    *(u32x2*)(HM + (size_t)(slot0 + row) * DFF + nt * 128 + wc * 32 + 8 * fq) = (u32x2){pk_fp8x4(o[0], o[1], o[2], o[3]), pk_fp8x4(o[4], o[5], o[6], o[7])}; } }
    } };
struct Epi8Y { u16* Y; const float* b2; int slot0, col0, rows_valid;
    __device__ __forceinline__ void operator()(const f32x4 (&acc)[2][2][4][2], int wr, int wc, int fr, int fq) const {
        f32x4 bv[2][2];
#pragma unroll
        for (int bj = 0; bj < 2; ++bj)
#pragma unroll
            for (int n = 0; n < 2; ++n) bv[bj][n] = *(const f32x4*)(b2 + col0 + bj * 128 + wc * 32 + 8 * fq + 4 * n);
#pragma unroll
        for (int ai = 0; ai < 2; ++ai)
#pragma unroll
            for (int m = 0; m < 4; ++m) { const int row = ai * 128 + wr * 64 + m * 16 + fr;
                if (row < rows_valid) { u16* rowp = Y + (size_t)(slot0 + row) * DM + col0 + wc * 32 + 8 * fq;
#pragma unroll
                    for (int bj = 0; bj < 2; ++bj) { const f32x4 v0 = acc[ai][bj][m][0] + bv[bj][0], v1 = acc[ai][bj][m][1] + bv[bj][1];
                        *(u32x4*)(rowp + bj * 128) = (u32x4){pk_bf16(v0[0], v0[1]), pk_bf16(v0[2], v0[3]), pk_bf16(v1[0], v1[1]), pk_bf16(v1[2], v1[3])}; } } }
    } };
struct EpiNone { __device__ __forceinline__ void operator()(const f32x4 (&acc)[2][2][4][2], int wr, int wc, int fr, int fq) const {
#pragma unroll
        for (int a = 0; a < 2; ++a)
#pragma unroll
            for (int b = 0; b < 2; ++b)
#pragma unroll
                for (int m = 0; m < 4; ++m)
#pragma unroll
                    for (int n = 0; n < 2; ++n) asm volatile("" :: "v"(acc[a][b][m][n]));
    } };

template <int NTILES>
__device__ __forceinline__ bool moe_unit_static(const LAS int* us, const LAS int* so2, int uu, int& e, int& nt, int& slot0, int& rows) {
    if (uu >= us[NE]) return false;
    int lo = 0, hi = NE;
#pragma unroll
    for (int s = 0; s < 5; ++s) { const int mid = (lo + hi) >> 1; if (us[mid] <= uu) lo = mid; else hi = mid; }
    e = lo; const int o0 = e * NTOK, cnt = so2[e], mtl = (cnt + 255) >> 8, ul = uu - us[e], mt = ul % mtl;
    e = __builtin_amdgcn_readfirstlane(e); nt = __builtin_amdgcn_readfirstlane(ul / mtl); slot0 = __builtin_amdgcn_readfirstlane(o0 + mt * 256);
    rows = cnt - mt * 256; rows = __builtin_amdgcn_readfirstlane(rows > 256 ? 256 : rows); return true;
}
struct SrcMoeB { const LAS int* us; const LAS int* so2; int c, G; const char* HM8; const char* W2T8; u16* YB; const float* b2;
    __device__ __forceinline__ bool get(int i, StreamUnit& u) const { int e, nt, slot0, rows; if (!moe_unit_static<8>(us, so2, c + i * G, e, nt, slot0, rows)) return false;
        u.A = HM8; u.Bt = W2T8 + (size_t)((e * 8 + nt) * 16) * 32768; u.arow0 = slot0; u.rows = rows; u.a = e; u.b = nt; u.c = slot0; return true; }
    __device__ __forceinline__ void epi(const f32x4 (&acc)[2][2][4][2], const StreamUnit& u, int wr, int wc, int fr, int fq) const { Epi8Y ep{YB, b2 + (size_t)u.a * DM, u.c, u.b * 256, u.rows}; ep(acc, wr, wc, fr, fq); }
};
template <bool TRANS>
struct SrcG1 { int c, G; const char* HBp; const char* WINTp; u16* PG; u16* HYT; const float* lbl; int ktiles;
    __device__ __forceinline__ bool get(int k, StreamUnit& su) const {
        int seen = 0;
        for (int u = c; u < 1024; u += G) { const int i = u >> 8, xx = (u >> 5) & 7, j = u & 31; const int mt = (xx & 3) * 8 + (j & 7), nt = ((xx >> 2) + 2 * i) * 4 + (j >> 3);
            if ((nt >= 20) == TRANS) { if (seen == k) { su.A = HBp; su.Bt = WINTp + (size_t)nt * ktiles * 32768; su.arow0 = mt * 256; su.rows = 256; su.a = mt; su.b = nt; su.c = 0; return true; } ++seen; } }
        return false; }
    __device__ __forceinline__ void epi(const f32x4 (&acc)[2][2][4][2], const StreamUnit& u, int wr, int wc, int fr, int fq) const {
        if (TRANS) { Epi8HYT e{HYT, u.a * 256, u.b * 256 - 5120}; e(acc, wr, wc, fr, fq); } else { Epi8PG e{PG, lbl, u.a * 256, u.b * 256}; e(acc, wr, wc, fr, fq); } }
};

typedef float f32x16 __attribute__((ext_vector_type(16)));
__device__ __forceinline__ void h3_row(int m, const float* __restrict__ w1, const float* __restrict__ b1, const float* __restrict__ w2, const float* __restrict__ b2,
                                       const float* __restrict__ w3, const float* __restrict__ b3, const float* __restrict__ freq, LAS float* sc  , float* __restrict__ H3) {
    const int j = tid_fresh() & 63;
    const float tt = (float)m / (float)(SEQ - 1);
    if (j == 0) sc[0] = tt;
    if (j >= 1 && j <= 16) { const int i = j - 1; const float band = 1e-4f + (float)i * ((15.0f - 1e-4f) / 15.0f); const float ang = (2.0f * 3.14159265358979323846f / (float)SEQ) * (float)m * band; sc[1 + i] = cosf(ang); sc[17 + i] = -sinf(ang); }
    __builtin_amdgcn_wave_barrier();
    const float fr = freq[j];
    float s = b1[j];
    for (int i = 0; i < 33; ++i) s += sc[i] * w1[i * 64 + j];
    const float h1 = sinf(fr * s);
    sc[64 + j] = h1;
    __builtin_amdgcn_wave_barrier();
    s = b2[j];
    for (int i = 0; i < 64; ++i) s += sc[64 + i] * w2[i * 64 + j];
    const float h2 = sinf(fr * s);
    __builtin_amdgcn_wave_barrier();
    sc[j] = h2;
    __builtin_amdgcn_wave_barrier();
    s = b3[j];
    for (int i = 0; i < 64; ++i) s += sc[i] * w3[i * 64 + j];
    H3[(size_t)m * 64 + j] = sinf(fr * s);
    __builtin_amdgcn_wave_barrier();
}
constexpr int FR_LEN = 4128;
__device__ __forceinline__ void frgen_item(LAS unsigned char* lds, int item, const float* __restrict__ H3, const float* __restrict__ w4, u16* __restrict__ FR) {
    const int tid = tid_fresh(), wid = __builtin_amdgcn_readfirstlane(tid >> 6), lane = tid & 63, fr = lane & 15, fq = lane >> 4;
    const int oc0 = item * 8, o = oc0 >> 10;
    const int colB = o * 2048 + (fr >> 3) * 1024 + (oc0 & 1023) + (fr & 7);
    float wreg[16];
#pragma unroll
    for (int ks = 0; ks < 16; ++ks) wreg[ks] = w4[(size_t)(4 * ks + fq) * 4096 + colB];
    const int dir = fr >> 3, c = (oc0 & 1023) + (fr & 7);
    const float mind = logf(1e-2f) / 0.3f, maxd = logf(1e-2f) / 1.5f;
    const float delta = fabsf(mind + (float)c * ((maxd - mind) / 1023.0f));
    u16* r0 = FR + (size_t)((oc0 + (fr & 7)) * 2) * FR_LEN;
    LAS float* tile = (LAS float*)(lds + wid * 4608);
    const int wrow = lane >> 4, wcol = 4 * (lane & 15);
    f32x4 nx[4];
#pragma unroll
    for (int q = 0; q < 4; ++q) nx[q] = *(const f32x4*)(H3 + (size_t)wid * 1024 + q * 256 + lane * 4);
    for (int it = 0; it < 16; ++it) {
        const int mt = wid + 8 * it;
#pragma unroll
        for (int q = 0; q < 4; ++q) *(LAS f32x4*)(tile + (q * 4 + wrow) * 68 + wcol) = nx[q];
        if (it + 1 < 16) {
#pragma unroll
            for (int q = 0; q < 4; ++q) nx[q] = *(const f32x4*)(H3 + (size_t)(mt + 8) * 1024 + q * 256 + lane * 4);
        }
        f32x4 acc = {0.f, 0.f, 0.f, 0.f}, acc1 = acc;
#pragma unroll
        for (int ks = 0; ks < 16; ks += 2) { acc = __builtin_amdgcn_mfma_f32_16x16x4f32(tile[fr * 68 + 4 * ks + fq], wreg[ks], acc, 0, 0, 0);
            acc1 = __builtin_amdgcn_mfma_f32_16x16x4f32(tile[fr * 68 + 4 * (ks + 1) + fq], wreg[ks + 1], acc1, 0, 0, 0); }
        acc += acc1;
        const int m0 = mt * 16 + 4 * fq;
        float v[4];
#pragma unroll
        for (int j = 0; j < 4; ++j) v[j] = acc[j] * __expf(-((float)(m0 + j) * (1.0f / (float)(SEQ - 1))) * delta);
        if (dir == 0) {
            *(u32x2*)(r0 + 2044 - m0) = (u32x2){pk_bf16(v[3], v[2]), pk_bf16(v[1], v[0])};
#pragma unroll
            for (int j = 0; j < 4; ++j) r0[FR_LEN + 2046 - m0 - j] = (u16)(pk_bf16(v[j], 0.f) & 0xffffu);
        } else {
#pragma unroll
            for (int j = 0; j < 4; ++j) if (m0 + j >= 1) { const u16 b = (u16)(pk_bf16(v[j], 0.f) & 0xffffu); r0[2047 + m0 + j] = b; r0[FR_LEN + 2046 + m0 + j] = b; }
        }
    }
    if (tid < 8 * 34) { const int r = tid / 34, x = 4094 + tid % 34; u16* rr = FR + (size_t)((oc0 + r) * 2) * FR_LEN; if (x >= 4095) rr[x] = 0; rr[FR_LEN + x] = 0; }
    __syncthreads();
}
constexpr int HY_ZSTRIDE = 2312;
constexpr int HY_ZCH = 256 + 4 * HY_ZSTRIDE;
constexpr int HY_ZBYTES = HY_ZCH * 2;
constexpr int HY_FB = 4 * HY_ZBYTES;
constexpr int HY_FCH = 2 * FR_LEN * 2;
constexpr int HY_LDS = HY_FB + 4 * HY_FCH;

__device__ __forceinline__ void hy_load_row(LAS unsigned char* lds, int dest, int boff0, int bstride, const u16* __restrict__ row, float w0, float w1, float w2, float cb, int pl) {
#pragma unroll 2
    for (int it = 0; it < 8; ++it) {
        const int idx = pl + 128 * it, tok0 = idx * 8, b = tok0 >> 11, n0 = tok0 & 2047;
        const u32x4 raw = *(const u32x4*)(row + tok0);
        const float pm = (n0 > 0) ? bf2f(row[tok0 - 1]) : 0.f;
        const float pn = (n0 + 8 < SEQ) ? bf2f(row[tok0 + 8]) : 0.f;
        float p[10];
        p[0] = pm; p[9] = pn;
#pragma unroll
        for (int q = 0; q < 4; ++q) { p[1 + 2 * q] = bflo(raw[q]); p[2 + 2 * q] = bfhi(raw[q]); }
        float o[8];
#pragma unroll
        for (int q = 0; q < 8; ++q) o[q] = fmaf(w0, p[q], fmaf(w1, p[q + 1], fmaf(w2, p[q + 2], cb)));
        u32x4 w; w[0] = pk_bf16(o[0], o[1]); w[1] = pk_bf16(o[2], o[3]); w[2] = pk_bf16(o[4], o[5]); w[3] = pk_bf16(o[6], o[7]);
        *(LAS u32x4*)(lds + dest + (boff0 + b * bstride + n0) * 2) = w;
    }
}
__device__ __forceinline__ void hy_load_filters(LAS unsigned char* lds, int fb, const u16* __restrict__ src, int pl) {
    for (int idx = pl; idx < HY_FCH / 16; idx += 128) *(LAS u32x4*)(lds + fb + idx * 16) = *(const u32x4*)((const char*)src + idx * 16);
}
__device__ __forceinline__ void hy_mfma_loop(LAS unsigned char* lds, int zb, int fb, int hlf, int lane, f32x16 (&acc)[4], const ConvCtx& cc, int mbase, int cunit, int wid) {
    const int r = lane & 31, hh = lane >> 5, il = r >> 2, b = r & 3;
    const int bbase = zb + (256 + b * HY_ZSTRIDE + 32 * il + 8 * hh) * 2;
    const int xl = 2047 - r + 8 * hh - 1024 * hlf;
    const int abase = (r & 1) ? (fb + 2 * xl) : (fb + FR_LEN * 2 + 2 * (xl - 1));
#pragma unroll
    for (int q = 0; q < 4; ++q)
#pragma unroll
        for (int i = 0; i < 16; ++i) acc[q][i] = 0.f;
    f32x2 cvA[16], cvB[16];
    conv_issue(cc, conv_seq2tile((mbase + 0) * 256 + cunit), wid, lane, cvA);
    for (int d0 = 0; d0 < 8; ++d0) {
#pragma unroll
        for (int ks = 0; ks < 2; ++ks) {
            const int idx = d0 * 2 + ks;
            const int mcv = conv_seq2tile((mbase + idx) * 256 + cunit), mnx = conv_seq2tile((mbase + idx + 1) * 256 + cunit);
            if (idx + 1 < 16) { if (ks == 0) conv_issue(cc, mnx, wid, lane, cvB); else conv_issue(cc, mnx, wid, lane, cvA); }
            bf16x8 Bt[9];
#pragma unroll
            for (int j = 0; j < 9; ++j) Bt[j] = *(const LAS bf16x8*)(lds + bbase + 512 * j - 64 * d0 + 32 * ks);
#pragma unroll
            for (int ep = -8; ep <= 3; ++ep) {
                const LAS unsigned* ap = (const LAS unsigned*)(lds + abase - 64 * d0 - 512 * ep + 32 * ks);
                u32x4 av; av[0] = ap[0]; av[1] = ap[1]; av[2] = ap[2]; av[3] = ap[3];
                const bf16x8 a = __builtin_bit_cast(bf16x8, av);
#pragma unroll
                for (int ctl = 0; ctl < 4; ++ctl) { const int jt = ctl - ep; if (jt >= 0 && jt <= 8) acc[ctl] = __builtin_amdgcn_mfma_f32_32x32x16_bf16(a, Bt[jt], acc[ctl], 0, 0, 0); }
            }
            if (ks == 0) conv_finish(cc, mcv, wid, lane, cvA); else conv_finish(cc, mcv, wid, lane, cvB);
        }
    }
}
__device__ __forceinline__ void hy_epilogue(LAS unsigned char* lds, int zb, int gb, int hlf, int lane, const f32x16 (&acc)[4], float bias) {
    const int r = lane & 31, hh = lane >> 5, il = r >> 2, b = r & 3;
#pragma unroll
    for (int ctl = 0; ctl < 4; ++ctl) {
        const int I = 8 * (4 * hlf + ctl) + il;
#pragma unroll
        for (int q = 0; q < 4; ++q) {
            const int n4 = 32 * I + 8 * q + 4 * hh;
            LAS u32x2* zp = (LAS u32x2*)(lds + zb + (256 + b * HY_ZSTRIDE + n4) * 2);
            const u32x2 zv = *zp, gv = *(const LAS u32x2*)(lds + gb + (b * 2048 + n4) * 2);
            const float z0 = bflo(zv[0]), z1 = bfhi(zv[0]), z2 = bflo(zv[1]), z3 = bfhi(zv[1]);
            const float g0 = bflo(gv[0]), g1 = bfhi(gv[0]), g2 = bflo(gv[1]), g3 = bfhi(gv[1]);
            u32x2 o; o[0] = pk_bf16(g0 * fmaf(bias, z0, acc[ctl][4 * q + 0]), g1 * fmaf(bias, z1, acc[ctl][4 * q + 1]));
            o[1] = pk_bf16(g2 * fmaf(bias, z2, acc[ctl][4 * q + 2]), g3 * fmaf(bias, z3, acc[ctl][4 * q + 3]));
            *zp = o;
        }
    }
}
__device__ __forceinline__ void hyena_unit(LAS unsigned char* lds, int unit, const u16* __restrict__ HYT, const u16* __restrict__ FR, const float* __restrict__ cw, const float* __restrict__ cbv,
                                           const float* __restrict__ hbias, u16* __restrict__ Z2T, const ConvCtx& cc) {
    const int tid = tid_fresh(), wid = __builtin_amdgcn_readfirstlane(tid >> 6), lane = tid & 63;
    const int cs = wid & 3, hlf = wid >> 2, c = unit * 4 + cs, pl = lane + 64 * hlf;
    const int zb = cs * HY_ZBYTES, fb = HY_FB + cs * HY_FCH;
    { const u32x4 z = {0u, 0u, 0u, 0u}; for (int idx = pl; idx < HY_ZBYTES / 16; idx += 128) *(LAS u32x4*)(lds + zb + idx * 16) = z; }
    __syncthreads();
    hy_load_row(lds, zb, 256, HY_ZSTRIDE, HYT + (size_t)c * NTOK, cw[0 * 3072 + c], cw[1 * 3072 + c], cw[2 * 3072 + c], cbv[c], pl);
    f32x16 acc[4];
#pragma unroll
    for (int o = 0; o < 2; ++o) {
        hy_load_filters(lds, fb, FR + (size_t)((o * 1024 + c) * 2) * FR_LEN, pl);
        __syncthreads();
        hy_mfma_loop(lds, zb, fb, hlf, lane, acc, cc, o * 16, unit, wid);
        __syncthreads();
        const int gc = (1 + o) * 1024 + c;
        hy_load_row(lds, fb, 0, 2048, HYT + (size_t)gc * NTOK, cw[0 * 3072 + gc], cw[1 * 3072 + gc], cw[2 * 3072 + gc], cbv[gc], pl);
        __syncthreads();
        hy_epilogue(lds, zb, fb, hlf, lane, acc, hbias[o * HYW + c]);
        __syncthreads();
    }
#pragma unroll 2
    for (int it = 0; it < 8; ++it) { const int idx = pl + 128 * it, tok0 = idx * 8, b = tok0 >> 11, n0 = tok0 & 2047;
        *(u32x4*)(Z2T + (size_t)c * NTOK + tok0) = *(const LAS u32x4*)(lds + zb + (256 + b * HY_ZSTRIDE + n0) * 2); }
    __syncthreads();
}

constexpr int HG_RAWQ = 0, HG_RAWF = 16384, HG_RAWV = 32768;
constexpr int HG_QM = 36864, HG_KM = HG_QM + 17408, HG_QI = HG_KM + 17408;
constexpr int HG_KL = HG_QI + 17408;
constexpr int HG_VT = HG_KL + 18432;
constexpr int HG_P = HG_VT + 4608;
constexpr int HG_ST = HG_P + 9216;
constexpr int HG_TOT = HG_ST + 8704;
constexpr int HG_EL2 = HG_TOT + 4096;
constexpr int HG_LDS = HG_EL2 + 512;

__device__ __forceinline__ void hgrn_unit(LAS unsigned char* lds, int unit, const u16* __restrict__ PG, const float* __restrict__ lb_logits, float* __restrict__ OF, float* __restrict__ OB, const ConvCtx& cc) {
    const int tid = tid_fresh(), wid = __builtin_amdgcn_readfirstlane(tid >> 6), lane = tid & 63, fr = lane & 15, fq = lane >> 4;
    const int h = unit & 7, vq = (unit >> 3) & 3, dir = (unit >> 5) & 1, b = unit >> 6;
    const int k = tid & 127, seg = tid >> 7;
    float* __restrict__ O = dir ? OB : OF;
    for (int i = tid; i < 8704 / 16; i += 512) *(LAS u32x4*)(lds + HG_ST + i * 16) = (u32x4){0u, 0u, 0u, 0u};
    f32x4 Sacc[2];
    Sacc[0] = (f32x4){0.f, 0.f, 0.f, 0.f}; Sacc[1] = Sacc[0];
    u32x4 pq[2], pf[2], pv;
    const int colq = h * 128, colf = (1 + dir) * 1024 + h * 128, colv = 3072 + h * 128 + vq * 32;
#define HG_TOK(c, tau) ((size_t)b * SEQ + (dir ? (SEQ - 1 - 64 * (c) - (tau)) : (64 * (c) + (tau))))
#define HG_PREFETCH(c) do { _Pragma("unroll") for (int _i = 0; _i < 2; ++_i) { const int _x = tid + 512 * _i, _tau = _x >> 4, _p = _x & 15; const u16* _r = PG + HG_TOK(c, _tau) * 5120; \
            pq[_i] = *(const u32x4*)(_r + colq + _p * 8); pf[_i] = *(const u32x4*)(_r + colf + _p * 8); } \
        if (tid < 256) { const int _tau = tid >> 2, _p = tid & 3; pv = *(const u32x4*)(PG + HG_TOK(c, _tau) * 5120 + colv + _p * 8); } } while (0)
#define HG_RAW2LDS() do { _Pragma("unroll") for (int _i = 0; _i < 2; ++_i) { const int _x = tid + 512 * _i; *(LAS u32x4*)(lds + HG_RAWQ + _x * 16) = pq[_i]; *(LAS u32x4*)(lds + HG_RAWF + _x * 16) = pf[_i]; } \
        if (tid < 256) *(LAS u32x4*)(lds + HG_RAWV + tid * 16) = pv; } while (0)
    HG_PREFETCH(0);
    HG_RAW2LDS();
    HG_PREFETCH(1);
    __syncthreads();
    for (int c = 0; c < 32; ++c) {
        f32x2 cv[16];
        const int mqa = conv_seq2tile((32 + c * 2) * 256 + unit), mqb = conv_seq2tile((33 + c * 2) * 256 + unit);
        conv_issue(cc, mqa, wid, lane, cv);
        const int kp = lane, sg = wid;
        float qv0[8], qv1[8], kv0[8], kv1[8], bl0[8], bl1[8];
        { float r0 = 0.f, r1 = 0.f;
#pragma unroll
          for (int i = 0; i < 8; ++i) { const int tau = sg * 8 + i;
              const unsigned qw = *(const LAS unsigned*)(lds + HG_RAWQ + tau * 256 + kp * 4), fw = *(const LAS unsigned*)(lds + HG_RAWF + tau * 256 + kp * 4);
              const float l0 = bflo(fw), l1 = bfhi(fw);
              r0 += l0; r1 += l1; bl0[i] = r0; bl1[i] = r1; kv0[i] = 1.0f - __builtin_amdgcn_exp2f(l0); kv1[i] = 1.0f - __builtin_amdgcn_exp2f(l1); qv0[i] = bflo(qw); qv1[i] = bfhi(qw); }
          *(LAS f32x2*)(lds + HG_TOT + (sg * 128 + 2 * kp) * 4) = (f32x2){r0, r1}; }
        __syncthreads();
        { f32x2 tt[8];
#pragma unroll
          for (int q = 0; q < 8; ++q) tt[q] = *(const LAS f32x2*)(lds + HG_TOT + (q * 128 + 2 * kp) * 4);
          f32x2 pre = {0.f, 0.f};
#pragma unroll
          for (int q = 0; q < 7; ++q) if (q < sg) pre += tt[q];
          const f32x2 bref = tt[0] + tt[1] + tt[2] + tt[3], blast = bref + tt[4] + tt[5] + tt[6] + tt[7];
          const float er0 = __builtin_amdgcn_exp2f(bref[0]), er1 = __builtin_amdgcn_exp2f(bref[1]), el0 = __builtin_amdgcn_exp2f(blast[0] - bref[0]), el1 = __builtin_amdgcn_exp2f(blast[1] - bref[1]);
          if (sg == 0) *(LAS f32x2*)(lds + HG_EL2 + 2 * kp * 4) = (f32x2){__builtin_amdgcn_exp2f(blast[0]), __builtin_amdgcn_exp2f(blast[1])};
          const f32x2 dref = pre - bref;
          float kl0[8], kl1[8];
#pragma unroll
          for (int i = 0; i < 8; ++i) { const int tau = sg * 8 + i; const float x0 = dref[0] + bl0[i], x1 = dref[1] + bl1[i];
              const float qm0 = qv0[i] * __builtin_amdgcn_exp2f(x0), qm1 = qv1[i] * __builtin_amdgcn_exp2f(x1), km0 = kv0[i] * __builtin_amdgcn_exp2f(-x0), km1 = kv1[i] * __builtin_amdgcn_exp2f(-x1);
              *(LAS unsigned*)(lds + HG_QM + tau * 272 + kp * 4) = pk_bf16(qm0, qm1);
              *(LAS unsigned*)(lds + HG_KM + tau * 272 + kp * 4) = pk_bf16(km0, km1);
              *(LAS unsigned*)(lds + HG_QI + tau * 272 + kp * 4) = pk_bf16(qm0 * er0, qm1 * er1);
              kl0[i] = km0 * el0; kl1[i] = km1 * el1; }
          *(LAS u32x4*)(lds + HG_KL + (2 * kp) * 144 + sg * 16) = (u32x4){pk_bf16(kl0[0], kl0[1]), pk_bf16(kl0[2], kl0[3]), pk_bf16(kl0[4], kl0[5]), pk_bf16(kl0[6], kl0[7])};
          *(LAS u32x4*)(lds + HG_KL + (2 * kp + 1) * 144 + sg * 16) = (u32x4){pk_bf16(kl1[0], kl1[1]), pk_bf16(kl1[2], kl1[3]), pk_bf16(kl1[4], kl1[5]), pk_bf16(kl1[6], kl1[7])};
          { const int v = tid & 31, tg = tid >> 5; unsigned short e[4];
#pragma unroll
            for (int u = 0; u < 4; ++u) e[u] = *(const LAS u16*)(lds + HG_RAWV + (tg * 4 + u) * 64 + v * 2);
            *(LAS u32x2*)(lds + HG_VT + v * 144 + tg * 8) = (u32x2){(unsigned)e[0] | ((unsigned)e[1] << 16), (unsigned)e[2] | ((unsigned)e[3] << 16)}; } }
        conv_finish(cc, mqa, wid, lane, cv);
        conv_issue(cc, mqb, wid, lane, cv);
        __syncthreads();
        if (c + 1 < 32) { HG_RAW2LDS(); if (c + 2 < 32) HG_PREFETCH(c + 2); }
#pragma unroll
        for (int q = 0; q < 2; ++q) { const int idx = wid * 2 + q, ti = idx >> 2, si = idx & 3;
            f32x4 a = {0.f, 0.f, 0.f, 0.f};
            if (si <= ti) {
#pragma unroll
                for (int ks = 0; ks < 4; ++ks) { const bf16x8 ka = *(const LAS bf16x8*)(lds + HG_KM + (si * 16 + fr) * 272 + (ks * 32 + fq * 8) * 2), qb = *(const LAS bf16x8*)(lds + HG_QM + (ti * 16 + fr) * 272 + (ks * 32 + fq * 8) * 2);
                    a = __builtin_amdgcn_mfma_f32_16x16x32_bf16(ka, qb, a, 0, 0, 0); } }
            const int tau = ti * 16 + fr, s0 = si * 16 + fq * 4;
            float pvv[4];
#pragma unroll
            for (int j = 0; j < 4; ++j) pvv[j] = (si <= ti && s0 + j <= tau) ? a[j] : 0.f;
            *(LAS u32x2*)(lds + HG_P + tau * 144 + s0 * 2) = (u32x2){pk_bf16(pvv[0], pvv[1]), pk_bf16(pvv[2], pvv[3])}; }
        const int ti = wid >> 1, vi = wid & 1;
        f32x4 oacc = {0.f, 0.f, 0.f, 0.f};
#pragma unroll
        for (int ks = 0; ks < 4; ++ks) { const bf16x8 qa = *(const LAS bf16x8*)(lds + HG_QI + (ti * 16 + fr) * 272 + (ks * 32 + fq * 8) * 2), sb = *(const LAS bf16x8*)(lds + HG_ST + (vi * 16 + fr) * 272 + (ks * 32 + fq * 8) * 2);
            oacc = __builtin_amdgcn_mfma_f32_16x16x32_bf16(qa, sb, oacc, 0, 0, 0); }
        { const f32x4 e2 = *(const LAS f32x4*)(lds + HG_EL2 + (wid * 16 + fq * 4) * 4);
#pragma unroll
          for (int v2 = 0; v2 < 2; ++v2) { Sacc[v2] = Sacc[v2] * e2;
#pragma unroll
              for (int ks = 0; ks < 2; ++ks) { const bf16x8 ka = *(const LAS bf16x8*)(lds + HG_KL + (wid * 16 + fr) * 144 + (ks * 32 + fq * 8) * 2), vb = *(const LAS bf16x8*)(lds + HG_VT + (v2 * 16 + fr) * 144 + (ks * 32 + fq * 8) * 2);
                  Sacc[v2] = __builtin_amdgcn_mfma_f32_16x16x32_bf16(ka, vb, Sacc[v2], 0, 0, 0); } } }
        __syncthreads();
#pragma unroll
        for (int ks = 0; ks < 2; ++ks) { const bf16x8 pa = *(const LAS bf16x8*)(lds + HG_P + (ti * 16 + fr) * 144 + (ks * 32 + fq * 8) * 2), vb = *(const LAS bf16x8*)(lds + HG_VT + (vi * 16 + fr) * 144 + (ks * 32 + fq * 8) * 2);
            oacc = __builtin_amdgcn_mfma_f32_16x16x32_bf16(pa, vb, oacc, 0, 0, 0); }
#pragma unroll
        for (int j = 0; j < 4; ++j) { const int tau = ti * 16 + fq * 4 + j; O[HG_TOK(c, tau) * HGW + h * 128 + vq * 32 + vi * 16 + fr] = oacc[j]; }
        conv_finish(cc, mqb, wid, lane, cv);
#pragma unroll
        for (int v2 = 0; v2 < 2; ++v2) *(LAS u32x2*)(lds + HG_ST + (v2 * 16 + fr) * 272 + (wid * 16 + fq * 4) * 2) = (u32x2){pk_bf16(Sacc[v2][0], Sacc[v2][1]), pk_bf16(Sacc[v2][2], Sacc[v2][3])};
    }
    __syncthreads();
#undef HG_TOK
#undef HG_PREFETCH
#undef HG_RAW2LDS
}


#define XB_TMO      128
#define XB_XCNT(j)  (256  + 64 * (j))
#define XB_XSUB(j)  (1280 + 64 * (j))
#define XB_XGEN(j)  (2304 + 64 * (j))
#define XB_TOP      3328
#define XB_TOPGEN   3392
#define XCD_BAR_WORDS 3456
#define XB_SPIN_CAP (1u << 22)

__device__ __forceinline__ unsigned xb_ld(unsigned* p)              { return __hip_atomic_load(p, __ATOMIC_RELAXED, __HIP_MEMORY_SCOPE_AGENT); }
__device__ __forceinline__ unsigned xb_add(unsigned* p, unsigned v) { return __hip_atomic_fetch_add(p, v, __ATOMIC_RELAXED, __HIP_MEMORY_SCOPE_AGENT); }
__device__ __forceinline__ unsigned xb_xcc_id() { return (unsigned)__builtin_amdgcn_s_getreg((3 << 11) | 20) & 0xFu; }
#define XB_SPIN(cond, bar) do { unsigned _sp = 0; while (cond) { __builtin_amdgcn_s_sleep(1); \
    if ((++_sp & 255u) == 0u) { if (xb_ld(&(bar)[XB_TMO])) break; if (_sp > XB_SPIN_CAP) { atomicAdd(&(bar)[XB_TMO], 1u); break; } } } } while (0)

struct XcdBarrier {
    unsigned* bar; unsigned x;
    volatile LAS unsigned* st;
};

__device__ __forceinline__ XcdBarrier xcd_barrier_post(unsigned* bar, volatile LAS unsigned* st) {
    XcdBarrier b; b.bar = bar; b.x = xb_xcc_id(); b.st = st;
    if (threadIdx.x == 0) (void)xb_add(&bar[XB_XCNT(b.x)], 1u);
    return b;
}
__device__ __forceinline__ void xcd_barrier_complete(unsigned* bar, unsigned x, unsigned& nloc, unsigned& nx) {
    const unsigned G = gridDim.x * gridDim.y * gridDim.z;
    unsigned sum, cnt, mine, sp = 0u;
    for (;;) {
        sum = 0u; cnt = 0u; mine = 0u;
#pragma unroll
        for (unsigned j = 0; j < 16; ++j) { const unsigned c = xb_ld(&bar[XB_XCNT(j)]); sum += c; cnt += (c > 0u) ? 1u : 0u; mine = (j == x) ? c : mine; }
        if (sum == G) break;
        __builtin_amdgcn_s_sleep(1);
        if ((++sp & 255u) == 0u) { if (xb_ld(&bar[XB_TMO])) break; if (sp > XB_SPIN_CAP) { atomicAdd(&bar[XB_TMO], 1u); break; } }
    }
    nloc = mine > 0u ? mine : 1u; nx = cnt > 0u ? cnt : 1u;
}

__device__ __forceinline__ void xcd_barrier(const XcdBarrier& b) {
    asm volatile("s_waitcnt vmcnt(0)" ::: "memory");
    __syncthreads();
    if (threadIdx.x == 0) {
        unsigned* bar = b.bar;
        __builtin_amdgcn_s_waitcnt(0);
        unsigned nloc = b.st[0], nx = b.st[1];
        if (nloc == 0u) { xcd_barrier_complete(bar, b.x, nloc, nx); b.st[0] = nloc; b.st[1] = nx; }
        const unsigned old = xb_add(&bar[XB_XSUB(b.x)], 1u);
        const unsigned gen = old / nloc;
        if (old + 1u == (gen + 1u) * nloc) {
            __builtin_amdgcn_fence(__ATOMIC_RELEASE, "agent");
            asm volatile("s_waitcnt vmcnt(0)" ::: "memory");
            const unsigned og = xb_add(&bar[XB_TOP], 1u);
            const unsigned tg = og / nx;
            if (og + 1u == (tg + 1u) * nx) xb_add(&bar[XB_TOPGEN], 1u);
            else XB_SPIN(xb_ld(&bar[XB_TOPGEN]) == tg, bar);
            __builtin_amdgcn_fence(__ATOMIC_ACQUIRE, "agent");
            xb_add(&bar[XB_XGEN(b.x)], 1u);
            asm volatile("s_waitcnt vmcnt(0)" ::: "memory");
        } else {
            XB_SPIN(xb_ld(&bar[XB_XGEN(b.x)]) == gen, bar);
            __builtin_amdgcn_fence(__ATOMIC_ACQUIRE, "agent");
            asm volatile("s_waitcnt vmcnt(0)" ::: "memory");
        }
    }
    __syncthreads();
}

__device__ __forceinline__ float wave_sum(float s) {
#pragma unroll
    for (int o = 32; o >= 1; o >>= 1) s += __shfl_xor(s, o);
    return s;
}
__device__ __forceinline__ void rmsnorm_row_bf(const float* __restrict__ xr, const float* __restrict__ gain, u16* __restrict__ ob, unsigned char* __restrict__ ob8, int lane) {
    f32x4 v[8]; float s = 0.f;
#pragma unroll
    for (int j = 0; j < 8; ++j) { v[j] = *(const f32x4*)(xr + (lane + 64 * j) * 4); s += v[j][0] * v[j][0] + v[j][1] * v[j][1] + v[j][2] * v[j][2] + v[j][3] * v[j][3]; }
    s = wave_sum(s);
    const float r = rsqrtf(s * (1.0f / (float)DM) + EPS);
#pragma unroll
    for (int j = 0; j < 8; ++j) { const f32x4 g = *(const f32x4*)(gain + (lane + 64 * j) * 4); const f32x4 o = v[j] * r * g;
        *(u32x2*)(ob + (lane + 64 * j) * 4) = (u32x2){pk_bf16(o[0], o[1]), pk_bf16(o[2], o[3])};
        *(unsigned*)(ob8 + (lane + 64 * j) * 4) = pk_fp8x4(o[0], o[1], o[2], o[3]); }
}
__device__ __forceinline__ void hgrn_final_item4(int item0, int stride, const float* __restrict__ OF, const float* __restrict__ OB, const u16* __restrict__ PG, const float* __restrict__ gain, u16* __restrict__ MIXB, int lane) {
    f32x2 a[4], b[4]; unsigned gw[4];
#pragma unroll
    for (int q = 0; q < 4; ++q) { const int item = item0 + q * stride, tok = item >> 3, c = (item & 7) * 128 + 2 * lane;
        a[q] = *(const f32x2*)(OF + (size_t)tok * HGW + c); b[q] = *(const f32x2*)(OB + (size_t)tok * HGW + c); gw[q] = *(const unsigned*)(PG + (size_t)tok * 5120 + 4096 + c); }
#pragma unroll
    for (int q = 0; q < 4; ++q) { const int item = item0 + q * stride, tok = item >> 3, c = (item & 7) * 128 + 2 * lane;
        const float o0 = a[q][0] + b[q][0], o1 = a[q][1] + b[q][1];
        const float s = wave_sum(o0 * o0 + o1 * o1);
        const float r = rsqrtf(s * (1.0f / 128.0f) + EPS);
        const float g0 = bflo(gw[q]), g1 = bfhi(gw[q]);
        const f32x2 gn = *(const f32x2*)(gain + c);
        const float v0 = o0 * r * gn[0] * (g0 * __builtin_amdgcn_rcpf(1.0f + __expf(-g0))), v1 = o1 * r * gn[1] * (g1 * __builtin_amdgcn_rcpf(1.0f + __expf(-g1)));
        *(u16*)((unsigned char*)MIXB + (size_t)tok * DM + c) = (u16)(__builtin_amdgcn_cvt_pk_fp8_f32(v0, v1, 0, false) & 0xffff); }
}
__device__ __forceinline__ void hy_norm_tile(LAS unsigned char* lds, int tile_i, const u16* __restrict__ Z2T, const float* __restrict__ gain, u16* __restrict__ MIXB) {
    const int t = tid_fresh(), tok0 = tile_i * 32;
    LAS float* ssq = (LAS float*)(lds + 1024 * 80);
    if (t < 32) ssq[t] = 0.f;
    __syncthreads();
    float part[8];
#pragma unroll
    for (int q = 0; q < 8; ++q) part[q] = 0.f;
    const int ch = t & 3;
#pragma unroll
    for (int it = 0; it < 8; ++it) {
        const int c = (t >> 2) + 128 * it;
        const u32x4 v = *(const u32x4*)(Z2T + (size_t)c * NTOK + tok0 + ch * 8);
        *(LAS u32x4*)(lds + c * 80 + ch * 16) = v;
#pragma unroll
        for (int q = 0; q < 4; ++q) { const float a = bflo(v[q]), b = bfhi(v[q]); part[2 * q] += a * a; part[2 * q + 1] += b * b; }
    }
#pragma unroll
    for (int q = 0; q < 8; ++q) { float s = part[q]; s += __shfl_xor(s, 4); s += __shfl_xor(s, 8); s += __shfl_xor(s, 16); s += __shfl_xor(s, 32); part[q] = s; }
    if ((t & 63) < 4) {
#pragma unroll
        for (int q = 0; q < 8; ++q) atomicAdd((float*)(ssq + ch * 8 + q), part[q]);
    }
    __syncthreads();
    const int tt = t >> 4;
    const float r = rsqrtf(ssq[tt] * (1.0f / (float)HYW) + EPS);
#pragma unroll 2
    for (int k = 0; k < 8; ++k) {
        const int c0 = ((t & 15) + 16 * k) * 8;
        float o[8];
#pragma unroll
        for (int q = 0; q < 8; ++q) o[q] = bf2f(*(const LAS u16*)(lds + (c0 + q) * 80 + tt * 2)) * r * gain[c0 + q];
        *(u32x2*)((unsigned char*)MIXB + (size_t)(tok0 + tt) * DM + 1024 + c0) = (u32x2){pk_fp8x4(o[0], o[1], o[2], o[3]), pk_fp8x4(o[4], o[5], o[6], o[7])};
    }
    __syncthreads();
}
constexpr int RT_XSTRIDE = 2049;
constexpr int RT_PART = 16 * RT_XSTRIDE * 4;
constexpr int RT_LG = RT_PART + 8 * 16 * 32 * 4;
constexpr int RT_HIST = RT_LG + 16 * 32 * 4;
constexpr int RT_ITEMS = RT_HIST + 128;
constexpr int RT_RBASE = RT_ITEMS + 512;
constexpr int RT_END = RT_RBASE + 128;
__device__ __forceinline__ void router_tile(LAS unsigned char* lds, int tile_i, const float* __restrict__ X1, const float* __restrict__ gain, const float* __restrict__ wr, const float* __restrict__ br,
                                            unsigned char* __restrict__ XN8, float* __restrict__ TOPG, int tl2, const float (&bw)[128]) {
    const int tid = tid_fresh(), wid = __builtin_amdgcn_readfirstlane(tid >> 6), lane = tid & 63;
    const int tok0 = tile_i * 16;
    LAS float* xs = (LAS float*)lds;
#pragma unroll
    for (int q = 0; q < 2; ++q) {
        const int tl = wid * 2 + q; const size_t tok = (size_t)tok0 + tl;
        const float* xr = X1 + tok * DM;
        f32x4 v[8]; float s = 0.f;
#pragma unroll
        for (int j = 0; j < 8; ++j) { v[j] = *(const f32x4*)(xr + (lane + 64 * j) * 4); s += v[j][0] * v[j][0] + v[j][1] * v[j][1] + v[j][2] * v[j][2] + v[j][3] * v[j][3]; }
        s = wave_sum(s);
        const float r = rsqrtf(s * (1.0f / (float)DM) + EPS);
#pragma unroll
        for (int j = 0; j < 8; ++j) { const int d = (lane + 64 * j) * 4; const f32x4 g = *(const f32x4*)(gain + d); const f32x4 o = v[j] * r * g;
            xs[tl * RT_XSTRIDE + d + 0] = o[0]; xs[tl * RT_XSTRIDE + d + 1] = o[1]; xs[tl * RT_XSTRIDE + d + 2] = o[2]; xs[tl * RT_XSTRIDE + d + 3] = o[3];
            *(unsigned*)(XN8 + tok * DM + d) = pk_fp8x4(o[0], o[1], o[2], o[3]); }
    }
    __syncthreads();
    {
        const int tl = lane & 15, kk = lane >> 4;
        f32x4 a0 = {0.f, 0.f, 0.f, 0.f}, a1 = a0;
        const LAS float* xp = xs + tl * RT_XSTRIDE + wid * 256 + kk;
#pragma unroll
        for (int ks = 0; ks < 64; ++ks) { const float a = xp[ks * 4];
            a0 = __builtin_amdgcn_mfma_f32_16x16x4f32(a, bw[2 * ks], a0, 0, 0, 0); a1 = __builtin_amdgcn_mfma_f32_16x16x4f32(a, bw[2 * ks + 1], a1, 0, 0, 0); }
        LAS float* pp = (LAS float*)(lds + RT_PART) + wid * 512;
#pragma unroll
        for (int j = 0; j < 4; ++j) { pp[(kk * 4 + j) * 32 + tl] = a0[j]; pp[(kk * 4 + j) * 32 + 16 + tl] = a1[j]; }
    }
    __syncthreads();
    {   const LAS float* pp = (const LAS float*)(lds + RT_PART); float s = br[tid & 31];
#pragma unroll
        for (int w = 0; w < 8; ++w) s += pp[w * 512 + tid];
        ((LAS float*)(lds + RT_LG))[tid] = s; }
    __syncthreads();
    if (tid < 16) {
        LAS float* lg = (LAS float*)(lds + RT_LG) + tid * 32;
        int i0 = 0, i1 = 0, i2 = 0, i3 = 0; float v0, v1, v2, v3;
        { float bv = -3.0e38f; for (int j = 0; j < NE; ++j) { const float l = lg[j]; if (l > bv) { bv = l; i0 = j; } } v0 = bv; lg[i0] = -3.4e38f; }
        { float bv = -3.0e38f; for (int j = 0; j < NE; ++j) { const float l = lg[j]; if (l > bv) { bv = l; i1 = j; } } v1 = bv; lg[i1] = -3.4e38f; }
        { float bv = -3.0e38f; for (int j = 0; j < NE; ++j) { const float l = lg[j]; if (l > bv) { bv = l; i2 = j; } } v2 = bv; lg[i2] = -3.4e38f; }
        { float bv = -3.0e38f; for (int j = 0; j < NE; ++j) { const float l = lg[j]; if (l > bv) { bv = l; i3 = j; } } v3 = bv; lg[i3] = -3.4e38f; }
        const float e1 = __expf(v1 - v0), e2 = __expf(v2 - v0), e3 = __expf(v3 - v0), inv = 1.0f / (1.0f + e1 + e2 + e3);
        const int tok = tok0 + tid;
        *(f32x4*)(TOPG + tok * 4) = (f32x4){inv, e1 * inv, e2 * inv, e3 * inv};
        LAS int* hist = (LAS int*)(lds + RT_HIST);
        const int p0 = atomicAdd((int*)(hist + i0), 1), p1 = atomicAdd((int*)(hist + i1), 1), p2 = atomicAdd((int*)(hist + i2), 1), p3 = atomicAdd((int*)(hist + i3), 1);
        *(LAS u32x4*)(lds + RT_ITEMS + (tl2 * 16 + tid) * 16) = (u32x4){(unsigned)((i0 << 16) | p0), (unsigned)((i1 << 16) | p1), (unsigned)((i2 << 16) | p2), (unsigned)((i3 << 16) | p3)};
    }
    __syncthreads();
}
__device__ __forceinline__ void combine_row(int tok, const float* __restrict__ X1, const u16* __restrict__ YB, const int* __restrict__ SOF, const float* __restrict__ TOPG, const float* __restrict__ gain, float* __restrict__ out, int lane) {
    const int4 sl = *(const int4*)(SOF + tok * 4); const f32x4 g = *(const f32x4*)(TOPG + tok * 4);
    const u16* y0 = YB + (size_t)sl.x * DM; const u16* y1 = YB + (size_t)sl.y * DM; const u16* y2 = YB + (size_t)sl.z * DM; const u16* y3 = YB + (size_t)sl.w * DM;
    f32x4 v[8]; float s = 0.f;
#pragma unroll
    for (int j = 0; j < 8; ++j) { const int d = (lane + 64 * j) * 4;
        f32x4 a = *(const f32x4*)(X1 + (size_t)tok * DM + d);
        const u32x2 q0 = *(const u32x2*)(y0 + d), q1 = *(const u32x2*)(y1 + d), q2 = *(const u32x2*)(y2 + d), q3 = *(const u32x2*)(y3 + d);
        a[0] += g[0] * bflo(q0[0]) + g[1] * bflo(q1[0]) + g[2] * bflo(q2[0]) + g[3] * bflo(q3[0]);
        a[1] += g[0] * bfhi(q0[0]) + g[1] * bfhi(q1[0]) + g[2] * bfhi(q2[0]) + g[3] * bfhi(q3[0]);
        a[2] += g[0] * bflo(q0[1]) + g[1] * bflo(q1[1]) + g[2] * bflo(q2[1]) + g[3] * bflo(q3[1]);
        a[3] += g[0] * bfhi(q0[1]) + g[1] * bfhi(q1[1]) + g[2] * bfhi(q2[1]) + g[3] * bfhi(q3[1]);
        v[j] = a; s += a[0] * a[0] + a[1] * a[1] + a[2] * a[2] + a[3] * a[3]; }
    s = wave_sum(s);
    const float r = rsqrtf(s * (1.0f / (float)DM) + EPS);
#pragma unroll
    for (int j = 0; j < 8; ++j) { const int d = (lane + 64 * j) * 4; const f32x4 gn = *(const f32x4*)(gain + d); *(f32x4*)(out + (size_t)tok * DM + d) = v[j] * r * gn; }
}

__device__ __forceinline__ void combine_row2(int tokA, int tokB, const float* __restrict__ X1, const u16* __restrict__ YB, const int* __restrict__ SOF, const float* __restrict__ TOPG, const float* __restrict__ gain, float* __restrict__ out, int lane) {
    const int4 slA = *(const int4*)(SOF + tokA * 4), slB = *(const int4*)(SOF + tokB * 4); const f32x4 gA = *(const f32x4*)(TOPG + tokA * 4), gB = *(const f32x4*)(TOPG + tokB * 4);
    const u16* yA0 = YB + (size_t)slA.x * DM; const u16* yA1 = YB + (size_t)slA.y * DM; const u16* yA2 = YB + (size_t)slA.z * DM; const u16* yA3 = YB + (size_t)slA.w * DM;
    const u16* yB0 = YB + (size_t)slB.x * DM; const u16* yB1 = YB + (size_t)slB.y * DM; const u16* yB2 = YB + (size_t)slB.z * DM; const u16* yB3 = YB + (size_t)slB.w * DM;
    f32x4 vA[8], vB[8]; float sA = 0.f, sB = 0.f;
#pragma unroll
    for (int j = 0; j < 8; ++j) { const int d = (lane + 64 * j) * 4;
        f32x4 a = *(const f32x4*)(X1 + (size_t)tokA * DM + d), b = *(const f32x4*)(X1 + (size_t)tokB * DM + d);
        const u32x2 p0 = *(const u32x2*)(yA0 + d), p1 = *(const u32x2*)(yA1 + d), p2 = *(const u32x2*)(yA2 + d), p3 = *(const u32x2*)(yA3 + d);
        const u32x2 q0 = *(const u32x2*)(yB0 + d), q1 = *(const u32x2*)(yB1 + d), q2 = *(const u32x2*)(yB2 + d), q3 = *(const u32x2*)(yB3 + d);
        a[0] += gA[0] * bflo(p0[0]) + gA[1] * bflo(p1[0]) + gA[2] * bflo(p2[0]) + gA[3] * bflo(p3[0]);
        a[1] += gA[0] * bfhi(p0[0]) + gA[1] * bfhi(p1[0]) + gA[2] * bfhi(p2[0]) + gA[3] * bfhi(p3[0]);
        a[2] += gA[0] * bflo(p0[1]) + gA[1] * bflo(p1[1]) + gA[2] * bflo(p2[1]) + gA[3] * bflo(p3[1]);
        a[3] += gA[0] * bfhi(p0[1]) + gA[1] * bfhi(p1[1]) + gA[2] * bfhi(p2[1]) + gA[3] * bfhi(p3[1]);
        b[0] += gB[0] * bflo(q0[0]) + gB[1] * bflo(q1[0]) + gB[2] * bflo(q2[0]) + gB[3] * bflo(q3[0]);
        b[1] += gB[0] * bfhi(q0[0]) + gB[1] * bfhi(q1[0]) + gB[2] * bfhi(q2[0]) + gB[3] * bfhi(q3[0]);
        b[2] += gB[0] * bflo(q0[1]) + gB[1] * bflo(q1[1]) + gB[2] * bflo(q2[1]) + gB[3] * bflo(q3[1]);
        b[3] += gB[0] * bfhi(q0[1]) + gB[1] * bfhi(q1[1]) + gB[2] * bfhi(q2[1]) + gB[3] * bfhi(q3[1]);
        vA[j] = a; vB[j] = b; sA += a[0] * a[0] + a[1] * a[1] + a[2] * a[2] + a[3] * a[3]; sB += b[0] * b[0] + b[1] * b[1] + b[2] * b[2] + b[3] * b[3]; }
    sA = wave_sum(sA); sB = wave_sum(sB);
    const float rA = rsqrtf(sA * (1.0f / (float)DM) + EPS), rB = rsqrtf(sB * (1.0f / (float)DM) + EPS);
#pragma unroll
    for (int j = 0; j < 8; ++j) { const int d = (lane + 64 * j) * 4; const f32x4 gn = *(const f32x4*)(gain + d);
        *(f32x4*)(out + (size_t)tokA * DM + d) = vA[j] * rA * gn; *(f32x4*)(out + (size_t)tokB * DM + d) = vB[j] * rB * gn; }
}
#ifndef REP_P9
#define REP_P9 1
#endif
#ifndef REP_P3
#define REP_P3 1
#endif
#ifndef REP_FR
#define REP_FR 1
#endif
#ifndef REP_P0
#define REP_P0 1
#endif
#ifndef REP_CONV
#define REP_CONV 1
#endif
#ifndef REP_GEMM1
#define REP_GEMM1 1
#endif
#ifndef REP_HY
#define REP_HY 1
#endif
#ifndef REP_HG
#define REP_HG 1
#endif
#ifndef REP_MOEA
#define REP_MOEA 1
#endif
#ifndef REP_MOEB
#define REP_MOEB 1
#endif
#ifndef REP_WOUT
#define REP_WOUT 1
#endif
struct MegaP {
    const float *x, *norm_mix_gain, *w_in, *lb_logits, *hgrn_norm_gain, *hy_conv_w, *hy_conv_b, *fw1, *fb1, *fw2, *fb2, *fw3, *fb3, *fw4, *ffreq, *hy_bias, *hy_norm_gain, *w_out,
        *norm_ffn_gain, *w_router, *b_router, *moe_w1, *moe_b1, *moe_w2, *moe_b2, *final_gain;
    float* out; unsigned char* ws;
};
constexpr int MEGA_XB = RT_END;
constexpr int MEGA_LDS = RT_END + 64 + 384;
static_assert(MEGA_LDS >= HY_LDS + 64 && MEGA_LDS >= HG_LDS + 64 && MEGA_LDS >= GEMM_LDS + 64, "LDS");

__global__ void __launch_bounds__(512, 2) k_mega(const MegaP p_arg) {
    extern __shared__ __attribute__((aligned(16))) unsigned char shm[];
    LAS unsigned char* lds = (LAS unsigned char*)shm;
    const int tid = threadIdx.x, wid = __builtin_amdgcn_readfirstlane(tid >> 6), lane = tid & 63;
    const int G = gridDim.x, bid = blockIdx.x, c = xcd_logical(bid, G);
#define PHASE_ARGS() const MegaP __attribute__((address_space(4)))* pq_ = (const MegaP __attribute__((address_space(4)))*)__builtin_amdgcn_kernarg_segment_ptr(); asm volatile("" : "+s"(pq_)); unsigned char* ws = pq_->ws; (void)ws
    unsigned char* ws0; { PHASE_ARGS(); ws0 = ws; }
#define counts ((int*)(ws + WS_CTL))
#define cursor ((int*)(ws + WS_CTL + 4096))
#define offs ((int*)(ws + WS_CTL + 8192))
#define barw ((unsigned*)(ws + WS_CTL + 16384))
#define HB ((u16*)(ws + WS_HB))
#define PG ((u16*)(ws + WS_PG))
#define HYT ((u16*)(ws + WS_HYT))
#define MIXB ((u16*)(ws + WS_MIXB))
#define XNB ((u16*)(ws + WS_XNB))
#define HMB ((u16*)(ws + WS_HMS))
#define YB ((u16*)(ws + WS_YS))
#define H3 ((float*)(ws + WS_H3))
#define FR ((u16*)(ws + WS_FR))
#define Z2T ((u16*)(ws + WS_Z2T))
#define OF ((float*)(ws + WS_OF))
#define OB ((float*)(ws + WS_OB))
#define X1 ((float*)(ws + WS_X1))
#define TOPI ((int*)(ws + WS_TOPI))
#define TOPG ((float*)(ws + WS_TOPG))
#define STOK ((int*)(ws + WS_STOKS))
#define SOF ((int*)(ws + WS_SOF))
#define WINT ((u16*)(ws + WS_WINT))
#define WOUTT ((u16*)(ws + WS_WOUTT))
#define W1T ((u16*)(ws + WS_W1T))
#define W2T ((u16*)(ws + WS_W2T))
    if (tid == 0) *(LAS u32x4*)(lds + MEGA_XB) = (u32x4){0u, 0u, 0u, 0u};
    __syncthreads();
    XcdBarrier bar = xcd_barrier_post((unsigned*)(ws0 + WS_CTL + 16384), (volatile LAS unsigned*)(lds + MEGA_XB));

    {
        PHASE_ARGS();
        const int tid = tid_fresh(), wid = __builtin_amdgcn_readfirstlane(tid >> 6), lane = tid & 63; (void)wid; (void)lane;
    for (int rep = 0; rep < REP_P0; ++rep) {
    for (int row = bid * 8 + wid; row < NTOK; row += G * 8) rmsnorm_row_bf(pq_->x + (size_t)row * DM, pq_->norm_mix_gain, HB + (size_t)row * DM, (unsigned char*)XNB + (size_t)row * DM, lane);
    for (int m = bid * 8 + wid; m < SEQ; m += G * 8) h3_row(m, pq_->fw1, pq_->fb1, pq_->fw2, pq_->fb2, pq_->fw3, pq_->fb3, pq_->ffreq, (LAS float*)(lds + wid * 512), H3); }
    for (int rep = 0; rep < REP_CONV; ++rep)
    for (int id = bid; id < 1024 + 256; id += G) {
        const int tz = tid_fresh();
        if (id < 640) { f32x2 cv[16]; conv_issue_win(pq_->w_in, id, tz >> 6, tz & 63, cv); conv_finish_win((unsigned char*)WINT, id, tz >> 6, tz & 63, cv); }
        else if (id < 1024) { const int nt = id >> 5, kt = id & 31; convert_tile(pq_->w_in, DIN, kt * 64, ColMapPerm{nt * 256}, WINT + (size_t)id * 16384, tz); }
        else { const int q = id - 1024; const ConvCtx cw{nullptr, pq_->w_out, nullptr, (unsigned char*)WOUTT};
            f32x2 cv[16]; conv_issue(cw, 16384 + q, tz >> 6, tz & 63, cv); conv_finish(cw, 16384 + q, tz >> 6, tz & 63, cv); }
    }
    }
    xcd_barrier(bar);
    {
        PHASE_ARGS();
        const int tid = tid_fresh(), wid = __builtin_amdgcn_readfirstlane(tid >> 6), lane = tid & 63; (void)wid; (void)lane;
    for (int rep = 0; rep < REP_FR; ++rep)
    for (int item = bid; item < 256; item += G) frgen_item(lds, item, H3, pq_->fw4, FR);
    { SrcG1<false> s0{c, G, (const char*)XNB, (const char*)WINT, PG, HYT, pq_->lb_logits, 16}; gemm8_stream<false, true>(lds, DM / 2, 16, s0);
      SrcG1<true> s1{c, G, (const char*)HB, (const char*)WINT, PG, HYT, pq_->lb_logits, 32}; gemm8_stream<true, false>(lds, DM, 32, s1); }
#ifdef PROBE_NOEPI
    for (int u = c; u < 1024; u += G) {
        const int i = u >> 8, xx = (u >> 5) & 7, j = u & 31;
        const int mt = (xx & 3) * 8 + (j & 7), nt = ((xx >> 2) + 2 * i) * 4 + (j >> 3);
        const u16* bt = WINT + (size_t)nt * 32 * 16384;
        EpiNone e{}; if (nt < 20) gemm8_unit<false>(lds, HB, DM, nullptr, mt * 256, 256, bt, 32, e); else gemm8_unit<true>(lds, HB, DM, nullptr, mt * 256, 256, bt, 32, e);
    }
#endif
    }
    xcd_barrier(bar);
    {
        PHASE_ARGS();
        const int tid = tid_fresh(), wid = __builtin_amdgcn_readfirstlane(tid >> 6), lane = tid & 63; (void)wid; (void)lane;
    for (int rep = 0; rep < REP_HY; ++rep)
    for (int u = bid; u < 256; u += G) hyena_unit(lds, u, HYT, FR, pq_->hy_conv_w, pq_->hy_conv_b, pq_->hy_bias, Z2T, ConvCtx{pq_->moe_w1, pq_->moe_w2, (unsigned char*)W1T, (unsigned char*)W2T});
    for (int rep = 0; rep < REP_HG; ++rep)
    for (int u = bid; u < 256; u += G) hgrn_unit(lds, u, PG, pq_->lb_logits, OF, OB, ConvCtx{pq_->moe_w1, pq_->moe_w2, (unsigned char*)W1T, (unsigned char*)W2T});
    }
    xcd_barrier(bar);
    {
        PHASE_ARGS();
        const int tid = tid_fresh(), wid = __builtin_amdgcn_readfirstlane(tid >> 6), lane = tid & 63; (void)wid; (void)lane;
    for (int rep = 0; rep < REP_P3; ++rep) {
    for (int it = bid * 8 + wid; it < NTOK * HGH; it += G * 8 * 4) hgrn_final_item4(it, G * 8, OF, OB, PG, pq_->hgrn_norm_gain, MIXB, lane);
    for (int t = bid; t < NTOK / 32; t += G) hy_norm_tile(lds, t, Z2T, pq_->hy_norm_gain, MIXB); }
    }
    xcd_barrier(bar);
    {
        PHASE_ARGS();
        const int tid = tid_fresh(), wid = __builtin_amdgcn_readfirstlane(tid >> 6), lane = tid & 63; (void)wid; (void)lane;
    for (int u = c; u < 256; u += G) {
        const int xx = u >> 5, j = u & 31;
        const int mt = (xx >> 1) * 8 + (j & 7), nt = (xx & 1) * 4 + (j >> 3);
        Epi8X1 e{pq_->x, X1, mt * 256, nt * 256};
        gemm8_unit<false, true>(lds, MIXB, DM / 2, nullptr, mt * 256, 256, WOUTT + (size_t)nt * 16 * 16384, 16, e);
    }
    }
    xcd_barrier(bar);
    {
        PHASE_ARGS();
        const int tid = tid_fresh(), wid = __builtin_amdgcn_readfirstlane(tid >> 6), lane = tid & 63; (void)wid; (void)lane;
    if (tid < NE) *(LAS int*)(lds + RT_HIST + tid * 4) = 0;
    __syncthreads();
    float bw[128];
    { const float* wp = pq_->w_router + (size_t)(wid * 256 + (lane >> 4)) * NE + (lane & 15);
#pragma unroll
      for (int ks = 0; ks < 64; ++ks) { bw[2 * ks] = wp[(size_t)ks * 4 * NE]; bw[2 * ks + 1] = wp[(size_t)ks * 4 * NE + 16]; } }
    for (int t0 = bid; t0 < NTOK / 16; t0 += 2 * G) {
        const int t1 = t0 + G, ntl = (t1 < NTOK / 16) ? 2 : 1;
        router_tile(lds, t0, X1, pq_->norm_ffn_gain, pq_->w_router, pq_->b_router, (unsigned char*)XNB, TOPG, 0, bw);
        if (ntl == 2) router_tile(lds, t1, X1, pq_->norm_ffn_gain, pq_->w_router, pq_->b_router, (unsigned char*)XNB, TOPG, 1, bw);
        const int tq = tid_fresh();
        if (tq < NE) { const int n = *(const LAS int*)(lds + RT_HIST + tq * 4); *(LAS int*)(lds + RT_RBASE + tq * 4) = n ? atomicAdd(&cursor[tq * 32], n) : 0; *(LAS int*)(lds + RT_HIST + tq * 4) = 0; }
        __syncthreads();
        if (tq < ntl * 64) { const int it = *(const LAS int*)(lds + RT_ITEMS + tq * 4), e = it >> 16, tok = ((tq >> 6) ? t1 : t0) * 16 + ((tq >> 2) & 15);
            const int slot = e * NTOK + *(const LAS int*)(lds + RT_RBASE + e * 4) + (it & 0xffff); STOK[slot] = tok; SOF[tok * 4 + (tq & 3)] = slot; }
        __syncthreads();
    }
    }
    xcd_barrier(bar);
    {
        PHASE_ARGS();
        const int tid = tid_fresh(), wid = __builtin_amdgcn_readfirstlane(tid >> 6), lane = tid & 63; (void)wid; (void)lane;
    {
        LAS int* us = (LAS int*)(lds + MEGA_XB + 64); LAS int* so2 = us + 40;
        if (tid < NE) so2[tid] = __hip_atomic_load(&cursor[tid * 32], __ATOMIC_RELAXED, __HIP_MEMORY_SCOPE_AGENT);
        __syncthreads();
        if (tid == 0) { int a = 0; for (int e = 0; e < NE; ++e) { us[e] = a; a += ((so2[e] + 255) >> 8) * 16; } us[NE] = a; }
        __syncthreads();
    }
    {
        LAS int* qs = (LAS int*)(lds + MEGA_XB + 32); LAS int* us = (LAS int*)(lds + MEGA_XB + 64); LAS int* so2 = us + 40;
        int* qctr = (int*)(ws + WS_CTL + 12288 + (bid & 7) * 128);
        int tk_next = 0;
        auto decode = [&](int tkv, int& e, int& nt, int& slot0, int& rows) -> bool {
            const int tq = tid_fresh();
            if (tq == 0) { qs[0] = tkv; qs[1] = -1; }
            __syncthreads();
            const int tk = qs[0];
            const int u = 256 * (tk >> 5) + 32 * (bid & 7) + (tk & 31);
            if (tq < NE) { const int u0 = us[tq], u1 = us[tq + 1]; if (u >= u0 && u < u1) { const int o0 = tq * NTOK, cnt = so2[tq], mtl = (cnt + 255) >> 8, ul = u - u0, mt = ul % mtl;
                int rw = cnt - mt * 256; rw = rw > 256 ? 256 : rw; qs[1] = tq; qs[2] = ul / mtl; qs[3] = o0 + mt * 256; qs[4] = rw; } }
            __syncthreads();
            e = qs[1]; nt = qs[2]; slot0 = qs[3]; rows = qs[4];
            __syncthreads();
            return e >= 0;
        };
        if (tid == 0) tk_next = atomicAdd(qctr, 1);
        int e, nt, slot0, rows;
        if (decode(tk_next, e, nt, slot0, rows)) {
            if (tid == 0) tk_next = atomicAdd(qctr, 1);
            G8Pre cur, nxp;
            g8_addr(cur, DM / 2, STOK + slot0, rows, W1T + (size_t)(e * 16 + nt) * 16 * 16384);
            g8_issue(lds, (const char*)XNB, cur);
            for (;;) {
                int e2 = -1, nt2 = 0, slot2 = 0, rows2 = 0;
                auto next = [&]() -> bool {
                    if (!decode(tk_next, e2, nt2, slot2, rows2)) return false;
                    if (tid_fresh() == 0) tk_next = atomicAdd(qctr, 1);
                    g8_addr(nxp, DM / 2, STOK + slot2, rows2, W1T + (size_t)(e2 * 16 + nt2) * 16 * 16384);
                    g8_issue(lds, (const char*)XNB, nxp);
                    return true; };
                Epi8Swiglu8 ep{(unsigned char*)HMB, pq_->moe_b1 + (size_t)e * 2 * DFF, slot0, nt, rows};
                const bool more = gemm8_unit_ov<false, true>(lds, XNB, cur, 16, ep, next);
                if (!more) break;
                cur = nxp; e = e2; nt = nt2; slot0 = slot2; rows = rows2;
            }
        }
    }
    }
    xcd_barrier(bar);
    {
        PHASE_ARGS();
        const int tid = tid_fresh(), wid = __builtin_amdgcn_readfirstlane(tid >> 6), lane = tid & 63; (void)wid; (void)lane;
    {
        LAS int* us = (LAS int*)(lds + MEGA_XB + 64); LAS int* so2 = us + 40;
        if (tid < NE) so2[tid] = __hip_atomic_load(&cursor[tid * 32], __ATOMIC_RELAXED, __HIP_MEMORY_SCOPE_AGENT);
        __syncthreads();
        if (tid == 0) { int a = 0; for (int e = 0; e < NE; ++e) { us[e] = a; a += ((so2[e] + 255) >> 8) * 8; } us[NE] = a; }
        __syncthreads();
    }
    {
        const LAS int* us = (const LAS int*)(lds + MEGA_XB + 64); const LAS int* so2 = us + 40;
        SrcMoeB src{us, so2, c, G, (const char*)HMB, (const char*)W2T, YB, pq_->moe_b2};
        gemm8_stream<false, true>(lds, DFF / 2, 16, src);
    }
    }
    xcd_barrier(bar);
    {
        PHASE_ARGS();
        const int tid = tid_fresh(), wid = __builtin_amdgcn_readfirstlane(tid >> 6), lane = tid & 63; (void)wid; (void)lane;
    for (int rep = 0; rep < REP_P9; ++rep)
    for (int tok = bid * 8 + wid; tok < NTOK; tok += G * 8) combine_row(tok, X1, YB, SOF, TOPG, pq_->final_gain, pq_->out, lane);
    }
}
#undef counts
#undef cursor
#undef offs
#undef barw
#undef HB
#undef PG
#undef HYT
#undef MIXB
#undef XNB
#undef HMB
#undef YB
#undef H3
#undef FR
#undef Z2T
#undef OF
#undef OB
#undef X1
#undef TOPI
#undef TOPG
#undef STOK
#undef SOF
#undef WINT
#undef WOUTT
#undef W1T
#undef W2T

extern "C" void kernel_launch(void* const* d_in, const int* in_sizes, int n_in, void* d_out, int out_size, void* d_ws, size_t ws_size, hipStream_t stream) {
    if (n_in < 26 || ws_size < WS_END2) return;
    MegaP p{};
    const float** pp = (const float**)&p;
    for (int i = 0; i < 26; ++i) pp[i] = (const float*)d_in[i];
    p.out = (float*)d_out; p.ws = (unsigned char*)d_ws;
    static int grid = 0;
    if (!grid) {
        int dev = 0, cus = 0, per_cu = 0;
        (void)hipGetDevice(&dev);
        (void)hipDeviceGetAttribute(&cus, hipDeviceAttributeMultiprocessorCount, dev);
        (void)hipFuncSetAttribute((const void*)k_mega, hipFuncAttributeMaxDynamicSharedMemorySize, MEGA_LDS);
        (void)hipOccupancyMaxActiveBlocksPerMultiprocessor(&per_cu, (const void*)k_mega, 512, MEGA_LDS);
        if (per_cu < 1) per_cu = 1;
        grid = cus * 1;
        if (grid > 256) grid = 256;
        grid &= ~7;
        if (grid < 8) grid = 8;
    }
    (void)hipMemsetAsync((char*)d_ws + WS_CTL, 0, 65536, stream);
    hipLaunchKernelGGL(k_mega, dim3(grid), dim3(512), MEGA_LDS, stream, p);
}
```

```cpp
#include <hip/hip_runtime.h>
#include <stdint.h>

constexpr int BATCH = 4, SEQ = 2048, DM = 2048, NTOK = BATCH * SEQ;
constexpr int HGW = 1024, HGD = 128, HGH = 8;
constexpr int HYW = 1024;
constexpr int DIN = 8192;
constexpr int NE = 32, TOPK = 4, DFF = 2048;
constexpr int NSLOT = NTOK * TOPK;
constexpr float EPS = 1e-5f;

constexpr size_t MB = 1024ull * 1024ull;
constexpr size_t WS_CTL = 0;
constexpr size_t WS_HB = 1 * MB;
constexpr size_t WS_PG = WS_HB + 32 * MB;
constexpr size_t WS_HYT = WS_PG + 80 * MB;
constexpr size_t WS_MIXB = WS_HYT + 48 * MB;
constexpr size_t WS_XNB = WS_MIXB + 32 * MB;
constexpr size_t WS_HMB = WS_XNB + 32 * MB;
constexpr size_t WS_YB = WS_HMB + 128 * MB;
constexpr size_t WS_H3 = WS_YB + 128 * MB;
constexpr size_t WS_FR = WS_H3 + 1 * MB;
constexpr size_t WS_Z2T = WS_FR + 34 * MB;
constexpr size_t WS_OF = WS_Z2T + 16 * MB;
constexpr size_t WS_OB = WS_OF + 32 * MB;
constexpr size_t WS_X1 = WS_OB + 32 * MB;
constexpr size_t WS_TOPI = WS_X1 + 64 * MB;
constexpr size_t WS_TOPG = WS_TOPI + 1 * MB;
constexpr size_t WS_STOK = WS_TOPG + 1 * MB;
constexpr size_t WS_SOF = WS_STOK + 1 * MB;
constexpr size_t WS_WINT = WS_SOF + 1 * MB;
constexpr size_t WS_WOUTT = WS_WINT + 32 * MB;
constexpr size_t WS_W1T = WS_WOUTT + 8 * MB;
constexpr size_t WS_W2T = WS_W1T + 512 * MB;
constexpr size_t WS_HMS = WS_W2T + 256 * MB;
constexpr size_t WS_YS = WS_HMS + 512 * MB;
constexpr size_t WS_STOKS = WS_YS + 1024 * MB;
constexpr size_t WS_END2 = WS_STOKS + 1 * MB;

typedef short bf16x8 __attribute__((ext_vector_type(8)));
typedef float f32x4 __attribute__((ext_vector_type(4)));
typedef float f32x2 __attribute__((ext_vector_type(2)));
typedef unsigned u32x4 __attribute__((ext_vector_type(4)));
typedef unsigned u32x2 __attribute__((ext_vector_type(2)));
typedef unsigned short u16;
#define LAS __attribute__((address_space(3)))

__device__ __forceinline__ unsigned pk_bf16(float lo, float hi) {
    typedef __bf16 bf2 __attribute__((ext_vector_type(2)));
    const f32x2 v = {lo, hi};
    const bf2 r = __builtin_convertvector(v, bf2);
    return __builtin_bit_cast(unsigned, r);
}
__device__ __forceinline__ float bf2f(u16 b) { return __uint_as_float(((unsigned)b) << 16); }
__device__ __forceinline__ float bflo(unsigned w) { return __uint_as_float(w << 16); }
__device__ __forceinline__ float bfhi(unsigned w) { return __uint_as_float(w & 0xffff0000u); }

__device__ __forceinline__ int lds_byte(int r, int c) { const int st = (r >> 4) * 2 + (c >> 5), ob = (r & 15) * 64 + (c & 31) * 2; return st * 1024 + (ob ^ (((ob >> 9) & 1) << 5)); }
__device__ __forceinline__ void stage_rc(int b, int& R, int& C) { const int st = b >> 10, sb = b & 1023, swz = sb ^ (((sb >> 9) & 1) << 5); R = (st >> 1) * 16 + swz / 64; C = (st & 1) * 32 + (swz % 64) / 2; }
__device__ __forceinline__ f32x4 unperm(const f32x4 a, const bool s) { f32x4 o; o[0] = s ? a[1] : a[0]; o[1] = s ? a[0] : a[1]; o[2] = s ? a[3] : a[2]; o[3] = s ? a[2] : a[3]; return o; }

__device__ __forceinline__ int tid_fresh() { int t = threadIdx.x; asm volatile("" : "+v"(t)); return t; }
constexpr int GEMM_LDS = 131072;

template <bool TRANS, bool RAGGED, int PM = 0, class ColMap, class Epi>
__device__ __forceinline__ void gemm_unit(LAS unsigned char* lds, const u16* __restrict__ A, int lda, const int* __restrict__ arows, int arow0, int rows_valid,
                                          const float* __restrict__ B, int ldb, int K, const ColMap colmap, const Epi epi) {
    const int tid = tid_fresh(), wid = __builtin_amdgcn_readfirstlane(tid >> 6), lane = tid & 63;
    const int wr = wid >> 2, wc = wid & 3, fr = lane & 15, fq = lane >> 4;
    const int nt = K >> 6;
    const char* ap[4];
#pragma unroll
    for (int i = 0; i < 4; ++i) {
        int R, C; stage_rc(wid * 1024 + i * 8192 + lane * 16, R, C);
        const int rr = RAGGED ? (R < rows_valid ? R : rows_valid - 1) : R;
        const long rowid = arows ? (long)arows[rr] : (long)(arow0 + rr);
        ap[i] = (const char*)A + ((size_t)rowid * lda + C) * 2;
    }
    const int g = (lane & 3) + 4 * (wid >> 2), rg = (wid & 3) * 16 + (lane >> 2);
    const unsigned bvoff = (unsigned)(((size_t)(8 * g) * ldb + colmap(rg)) * 4);
    const int bbase = 65536 + lds_byte(4 * rg, 8 * g);
    const int bw0 = bbase + ((rg & 1) ? 64 : 0), bw1 = bbase + ((rg & 1) ? 0 : 64);
    const int aoff = lds_byte(wr * 128 + fr, fq * 8), boff = 65536 + lds_byte(wc * 64 + fr, fq * 8);
    int mvalid = 8;
    if (RAGGED) { mvalid = (rows_valid - wr * 128 + 15) >> 4; mvalid = mvalid < 0 ? 0 : (mvalid > 8 ? 8 : mvalid); }
    f32x4 vb0, vb1, vb2, vb3, vb4, vb5, vb6, vb7;
    if (PM & 1) { vb0 = (f32x4){1.f, 1.f, 1.f, 1.f}; vb1 = vb0; vb2 = vb0; vb3 = vb0; vb4 = vb0; vb5 = vb0; vb6 = vb0; vb7 = vb0; }
    f32x4 acc[8][4];
#pragma unroll
    for (int m = 0; m < 8; ++m)
#pragma unroll
        for (int n = 0; n < 4; ++n) acc[m][n] = (f32x4){0.f, 0.f, 0.f, 0.f};
    const size_t ldb4 = (size_t)ldb * 4;
#define GE_GLDS_A(buf, kt) do { if (!(PM & 2)) _Pragma("unroll") for (int _i = 0; _i < 4; ++_i) \
        __builtin_amdgcn_global_load_lds((const unsigned*)(ap[_i] + (size_t)(kt) * 128), (LAS unsigned*)(lds + (buf) * 32768 + wid * 1024 + _i * 8192), 16, 0, 0); } while (0)
#define GE_LD1(dst, sb) if (!(PM & 1)) asm volatile("global_load_dwordx4 %0, %1, %2" : "=v"(dst) : "v"(bvoff), "s"(sb) : "memory")
#define GE_LOAD_B(kt) do { const char* _sb = (const char*)B + (size_t)(kt) * 64 * ldb4; \
        GE_LD1(vb0, _sb); GE_LD1(vb1, _sb + ldb4); GE_LD1(vb2, _sb + 2 * ldb4); GE_LD1(vb3, _sb + 3 * ldb4); \
        GE_LD1(vb4, _sb + 4 * ldb4); GE_LD1(vb5, _sb + 5 * ldb4); GE_LD1(vb6, _sb + 6 * ldb4); GE_LD1(vb7, _sb + 7 * ldb4); } while (0)
#define GE_WAITV_B(n) asm volatile("s_waitcnt vmcnt(" #n ")" : "+v"(vb0), "+v"(vb1), "+v"(vb2), "+v"(vb3), "+v"(vb4), "+v"(vb5), "+v"(vb6), "+v"(vb7) :: "memory")
#define GE_WRITE_B(buf) do { _Pragma("unroll") for (int _i = 0; _i < 4; ++_i) { u32x4 _w; _w[0] = pk_bf16(vb0[_i], vb1[_i]); _w[1] = pk_bf16(vb2[_i], vb3[_i]); \
        _w[2] = pk_bf16(vb4[_i], vb5[_i]); _w[3] = pk_bf16(vb6[_i], vb7[_i]); \
        *(LAS u32x4*)(lds + ((_i & 1) ? bw1 : bw0) + (_i >> 1) * 128 + (buf) * 32768) = _w; } } while (0)
#define GE_KSTEP(buf, ks) do { bf16x8 Bf[4]; \
        _Pragma("unroll") for (int n = 0; n < 4; ++n) Bf[n] = *(const LAS bf16x8*)(lds + (buf) * 32768 + boff + n * 2048 + (ks) * 1024); \
        _Pragma("unroll") for (int mh = 0; mh < 2; ++mh) { bf16x8 At[4]; \
            _Pragma("unroll") for (int m = 0; m < 4; ++m) At[m] = *(const LAS bf16x8*)(lds + (buf) * 32768 + aoff + (mh * 4 + m) * 2048 + (ks) * 1024); \
            _Pragma("unroll") for (int m = 0; m < 4; ++m) { if (!RAGGED || (mh * 4 + m) < mvalid) { _Pragma("unroll") for (int n = 0; n < 4; ++n) \
                { if (PM & 4) { asm volatile("" :: "v"(At[m]), "v"(Bf[n])); } else acc[mh * 4 + m][n] = TRANS ? __builtin_amdgcn_mfma_f32_16x16x32_bf16(At[m], Bf[n], acc[mh * 4 + m][n], 0, 0, 0) : __builtin_amdgcn_mfma_f32_16x16x32_bf16(Bf[n], At[m], acc[mh * 4 + m][n], 0, 0, 0); } } } } } while (0)
    GE_GLDS_A(0, 0);
    GE_LOAD_B(0);
    GE_WAITV_B(0);
    GE_WRITE_B(0);
    GE_LOAD_B(1);
    asm volatile("s_waitcnt lgkmcnt(0)" ::: "memory");
    __builtin_amdgcn_s_barrier();
    int t = 0;
    for (; t < nt - 2; ++t) {
        const int cur = t & 1;
        GE_GLDS_A(cur ^ 1, t + 1);
        GE_KSTEP(cur, 0);
        GE_WAITV_B(4);
        GE_WRITE_B(cur ^ 1);
        GE_LOAD_B(t + 2);
        __builtin_amdgcn_sched_barrier(0);
        GE_KSTEP(cur, 1);
        asm volatile("s_waitcnt vmcnt(8) lgkmcnt(0)" ::: "memory");
        __builtin_amdgcn_s_barrier();
    }
    {
        const int cur = t & 1;
        GE_GLDS_A(cur ^ 1, t + 1);
        GE_KSTEP(cur, 0);
        GE_WAITV_B(4);
        GE_WRITE_B(cur ^ 1);
        GE_KSTEP(cur, 1);
        asm volatile("s_waitcnt vmcnt(0) lgkmcnt(0)" ::: "memory");
        __builtin_amdgcn_s_barrier();
        ++t;
    }
    {
        const int cur = t & 1;
        GE_KSTEP(cur, 0);
        GE_KSTEP(cur, 1);
        asm volatile("s_waitcnt lgkmcnt(0)" ::: "memory");
        __builtin_amdgcn_s_barrier();
    }
#undef GE_GLDS_A
#undef GE_LD1
#undef GE_LOAD_B
#undef GE_WAITV_B
#undef GE_WRITE_B
#undef GE_KSTEP
    __builtin_amdgcn_sched_barrier(0);
    { const int tz = tid_fresh(), wz = __builtin_amdgcn_readfirstlane(tz >> 6), lz = tz & 63;
      epi(acc, wz >> 2, wz & 3, lz & 15, lz >> 4); }
}

__device__ __forceinline__ int xcd_logical(int b, int G) { return (G & 7) ? b : (b & 7) * (G >> 3) + (b >> 3); }

struct ColMapDense { int c0; __device__ __forceinline__ int operator()(int rg) const { return c0 + 4 * rg; } };
struct EpiPG { u16* PG; int tok0, col0;
    __device__ __forceinline__ void operator()(const f32x4 (&acc)[8][4], int wr, int wc, int fr, int fq) const {
#pragma unroll
        for (int m = 0; m < 8; ++m) { u16* rowp = PG + (size_t)(tok0 + wr * 128 + m * 16 + fr) * 5120 + col0 + wc * 64 + 4 * fq;
#pragma unroll
            for (int n = 0; n < 4; ++n) { const f32x4 v = unperm(acc[m][n], fq & 1); u32x2 w; w[0] = pk_bf16(v[0], v[1]); w[1] = pk_bf16(v[2], v[3]); *(u32x2*)(rowp + n * 16) = w; } }
    } };
struct EpiHYT { u16* HYT; int tok0, col0;
    __device__ __forceinline__ void operator()(const f32x4 (&acc)[8][4], int wr, int wc, int fr, int fq) const {
#pragma unroll
        for (int n = 0; n < 4; ++n) { const int rho = wc * 64 + n * 16 + fr; const int col = col0 + (rho & ~3) + ((rho & 3) ^ ((rho >> 2) & 1));
            u16* colp = HYT + (size_t)col * NTOK + tok0 + wr * 128 + 4 * fq;
#pragma unroll
            for (int m = 0; m < 8; ++m) { const f32x4 v = acc[m][n]; u32x2 w; w[0] = pk_bf16(v[0], v[1]); w[1] = pk_bf16(v[2], v[3]); *(u32x2*)(colp + m * 16) = w; } }
    } };
struct EpiX1 { const float* x; float* X1; int tok0, col0;
    __device__ __forceinline__ void operator()(const f32x4 (&acc)[8][4], int wr, int wc, int fr, int fq) const {
#pragma unroll
        for (int m = 0; m < 8; ++m) { const size_t off = (size_t)(tok0 + wr * 128 + m * 16 + fr) * DM + col0 + wc * 64 + 4 * fq;
#pragma unroll
            for (int n = 0; n < 4; ++n) { const f32x4 r = *(const f32x4*)(x + off + n * 16); *(f32x4*)(X1 + off + n * 16) = r + unperm(acc[m][n], fq & 1); }
            asm volatile("" ::: "memory"); }
    } };
struct ColMapGlu { int nt; __device__ __forceinline__ int operator()(int rg) const { const int wcq = rg >> 4, n = (rg >> 2) & 3, f = rg & 3; return (n >> 1) * 2048 + nt * 128 + wcq * 32 + (n & 1) * 16 + f * 4; } };
struct EpiSwiglu { u16* HM; const float* b1; int slot0, nt, rows_valid;
    __device__ __forceinline__ void operator()(const f32x4 (&acc)[8][4], int wr, int wc, int fr, int fq) const {
        f32x4 bg[2], bl[2];
#pragma unroll
        for (int nn = 0; nn < 2; ++nn) { const int col = nt * 128 + wc * 32 + nn * 16 + 4 * fq; bg[nn] = *(const f32x4*)(b1 + col); bl[nn] = *(const f32x4*)(b1 + 2048 + col); }
#pragma unroll
        for (int m = 0; m < 8; ++m) { const int row = wr * 128 + m * 16 + fr;
            if (row < rows_valid) {
#pragma unroll
                for (int nn = 0; nn < 2; ++nn) { const f32x4 gl = unperm(acc[m][nn], fq & 1) + bg[nn], li = unperm(acc[m][nn + 2], fq & 1) + bl[nn]; float o[4];
#pragma unroll
                    for (int j = 0; j < 4; ++j) { const float gq = fminf(gl[j], 7.0f), lq = fminf(fmaxf(li[j], -7.0f), 7.0f); o[j] = gq * (1.0f / (1.0f + __expf(-1.702f * gq))) * (lq + 1.0f); }
                    u32x2 w; w[0] = pk_bf16(o[0], o[1]); w[1] = pk_bf16(o[2], o[3]);
                    *(u32x2*)(HM + (size_t)(slot0 + row) * DFF + nt * 128 + wc * 32 + nn * 16 + 4 * fq) = w; } } }
    } };
struct EpiY { u16* Y; const float* b2; int slot0, col0, rows_valid;
    __device__ __forceinline__ void operator()(const f32x4 (&acc)[8][4], int wr, int wc, int fr, int fq) const {
        f32x4 bv[4];
#pragma unroll
        for (int n = 0; n < 4; ++n) bv[n] = *(const f32x4*)(b2 + col0 + wc * 64 + n * 16 + 4 * fq);
#pragma unroll
        for (int m = 0; m < 8; ++m) { const int row = wr * 128 + m * 16 + fr;
            if (row < rows_valid) { u16* rowp = Y + (size_t)(slot0 + row) * DM + col0 + wc * 64 + 4 * fq;
#pragma unroll
                for (int n = 0; n < 4; ++n) { const f32x4 v = unperm(acc[m][n], fq & 1) + bv[n]; u32x2 w; w[0] = pk_bf16(v[0], v[1]); w[1] = pk_bf16(v[2], v[3]); *(u32x2*)(rowp + n * 16) = w; } } }
    } };
template <int NTILES>
__device__ __forceinline__ bool moe_decode(const int* __restrict__ offs, int u, int& e, int& mt, int& nt, int& slot0, int& rows) {
    int base = 0;
    for (int q = 0; q < NE; ++q) { const int o0 = offs[q], cnt = offs[q + 1] - o0, mtl = (cnt + 255) >> 8, nu = mtl * NTILES;
        if (u < base + nu) { const int ul = u - base; e = q; mt = ul % mtl; nt = ul / mtl; slot0 = o0 + mt * 256; rows = cnt - mt * 256; if (rows > 256) rows = 256; return true; }
        base += nu; }
    return false;
}


__device__ __forceinline__ int perm_col4(int rg) { const int rgl = rg & 31, t = rgl & 7; return 32 * (rgl >> 3) + 8 * (t & 3) + 4 * (t >> 2); }
__device__ __forceinline__ int perm32(int rho) { const int n = rho >> 4, i = rho & 15; return 8 * (i >> 2) + 4 * n + (i & 3); }
template <class ColMap>
__device__ __forceinline__ void convert_tile(const float* __restrict__ W, int ldb, int k0, const ColMap colmap, u16* __restrict__ dst, int tid) {
    const int wid = tid >> 6, lane = tid & 63;
    const int g = (lane & 3) + 4 * (wid >> 2), rg = (wid & 3) * 16 + (lane >> 2);
    const float* bp = W + (size_t)(k0 + 8 * g) * ldb + colmap(rg);
    f32x4 v[8];
#pragma unroll
    for (int kk = 0; kk < 8; ++kk) v[kk] = __builtin_nontemporal_load((const f32x4*)(bp + (size_t)kk * ldb));
    const int h = rg >> 5, r0 = (4 * rg) & 127;
    unsigned char* base = (unsigned char*)dst + h * 16384 + lds_byte(r0, 8 * g);
#pragma unroll
    for (int i = 0; i < 4; ++i) { u32x4 w; w[0] = pk_bf16(v[0][i], v[1][i]); w[1] = pk_bf16(v[2][i], v[3][i]); w[2] = pk_bf16(v[4][i], v[5][i]); w[3] = pk_bf16(v[6][i], v[7][i]);
        *(u32x4*)(base + i * 64) = w; }
}
typedef int i32x8 __attribute__((ext_vector_type(8)));
typedef int i32x4 __attribute__((ext_vector_type(4)));
constexpr float W8_SCALE = 32.0f;
constexpr int W8_MX = 0x7A7A7A7A;
constexpr int A8_MX = 0x7F7F7F7F;
__device__ __forceinline__ unsigned pk_fp8x4(float a, float b, float c, float d) { int p = __builtin_amdgcn_cvt_pk_fp8_f32(a, b, 0, false); p = __builtin_amdgcn_cvt_pk_fp8_f32(c, d, p, true); return (unsigned)p; }
__device__ __forceinline__ int lds_byte_b(int r, int cb) { const int st = (r >> 4) * 2 + (cb >> 6), ob = (r & 15) * 64 + (cb & 63); return st * 1024 + (ob ^ (((ob >> 9) & 1) << 5)); }
struct ConvCtx { const float* w1; const float* w2; unsigned char* W1T; unsigned char* W2T; };
__device__ __forceinline__ int conv_seq2tile(int s) {
    if (s < 16384) return (s >> 9) * 512 + (s & 15) * 32 + ((s >> 4) & 31);
    const int q = s - 16384; return 16384 + (q >> 8) * 256 + (q & 7) * 32 + ((q >> 3) & 31);
}
__device__ __forceinline__ void conv_issue(const ConvCtx& cc, int m, int wid, int lane, f32x2 (&v)[16]) {
    const int rp = 16 * wid + (lane & 15), rg = rp >> 1, p2 = (rp & 1) * 2, kg = lane >> 4;
    const float* bp; size_t ld;
    if (m < 16384) { const int e = m >> 9, nt = (m >> 5) & 15, kt = m & 31; ld = 2 * DFF; bp = cc.w1 + (size_t)e * DM * 2 * DFF + (size_t)(kt * 64 + 16 * kg) * ld + (rg >> 5) * 2048 + nt * 128 + perm_col4(rg) + p2; }
    else { const int q = m - 16384, e = q >> 8, nt = (q >> 5) & 7, kt = q & 31; ld = DM; bp = cc.w2 + (size_t)e * DFF * DM + (size_t)(kt * 64 + 16 * kg) * ld + nt * 256 + (rg >> 5) * 128 + perm_col4(rg) + p2; }
#pragma unroll
    for (int kk = 0; kk < 16; ++kk) v[kk] = __builtin_nontemporal_load((const f32x2*)(bp + (size_t)kk * ld));
}
__device__ __forceinline__ void conv_finish(const ConvCtx& cc, int m, int wid, int lane, const f32x2 (&v)[16]) {
    const int rp = 16 * wid + (lane & 15), kg = lane >> 4;
    const int kt64 = m & 31;
    unsigned char* dst = (m < 16384) ? cc.W1T + ((size_t)(m >> 5) * 16 + (kt64 >> 1)) * 32768 : cc.W2T + ((size_t)((m - 16384) >> 5) * 16 + (kt64 >> 1)) * 32768;
    unsigned char* base = dst + (rp >> 6) * 16384 + lds_byte_b((2 * rp) & 127, (kt64 & 1) * 64 + 16 * kg);
#pragma unroll
    for (int i = 0; i < 2; ++i) { u32x4 w;
#pragma unroll
        for (int q = 0; q < 4; ++q) w[q] = pk_fp8x4(v[4 * q][i] * W8_SCALE, v[4 * q + 1][i] * W8_SCALE, v[4 * q + 2][i] * W8_SCALE, v[4 * q + 3][i] * W8_SCALE);
        __builtin_nontemporal_store(w, (u32x4*)(base + i * 64)); }
}
__device__ __forceinline__ void conv_issue_win(const float* __restrict__ w_in, int q, int wid, int lane, f32x2 (&v)[16]) {
    const int rp = 16 * wid + (lane & 15), rg = rp >> 1, p2 = (rp & 1) * 2, kg = lane >> 4;
    const int nt = q >> 5, kt = q & 31;
    const float* bp = w_in + (size_t)(kt * 64 + 16 * kg) * DIN + nt * 256 + (rg >> 5) * 128 + perm_col4(rg) + p2;
#pragma unroll
    for (int kk = 0; kk < 16; ++kk) v[kk] = __builtin_nontemporal_load((const f32x2*)(bp + (size_t)kk * DIN));
}
__device__ __forceinline__ void conv_finish_win(unsigned char* __restrict__ WT, int q, int wid, int lane, const f32x2 (&v)[16]) {
    const int rp = 16 * wid + (lane & 15), kg = lane >> 4;
    const int kt64 = q & 31;
    unsigned char* base = WT + ((size_t)(q >> 5) * 16 + (kt64 >> 1)) * 32768 + (rp >> 6) * 16384 + lds_byte_b((2 * rp) & 127, (kt64 & 1) * 64 + 16 * kg);
#pragma unroll
    for (int i = 0; i < 2; ++i) { u32x4 w;
#pragma unroll
        for (int qq = 0; qq < 4; ++qq) w[qq] = pk_fp8x4(v[4 * qq][i] * W8_SCALE, v[4 * qq + 1][i] * W8_SCALE, v[4 * qq + 2][i] * W8_SCALE, v[4 * qq + 3][i] * W8_SCALE);
        __builtin_nontemporal_store(w, (u32x4*)(base + i * 64)); }
}
struct ColMapGluT { int nt; __device__ __forceinline__ int operator()(int rg) const { return (rg >> 5) * 2048 + nt * 128 + perm_col4(rg); } };
struct ColMapPerm { int c0; __device__ __forceinline__ int operator()(int rg) const { return c0 + (rg >> 5) * 128 + perm_col4(rg); } };

template <bool TRANS, bool FP8 = false, class Epi>
__device__ __forceinline__ void gemm8_unit(LAS unsigned char* lds, const u16* __restrict__ A, int lda, const int* __restrict__ arows, int arow0, int rows_valid, const u16* __restrict__ Bt, int nt, const Epi epi) {
    const int tid = tid_fresh(), wid = __builtin_amdgcn_readfirstlane(tid >> 6), lane = tid & 63;
    const int wr = wid >> 2, wc = wid & 3, fr = lane & 15, fq = lane >> 4;
    unsigned aof[2][2];
#pragma unroll
    for (int h = 0; h < 2; ++h)
#pragma unroll
        for (int i = 0; i < 2; ++i) { int R, C; stage_rc(tid * 16 + i * 8192, R, C); int rr = h * 128 + R; rr = rr < rows_valid ? rr : rows_valid - 1;
            const unsigned rowid = arows ? (unsigned)arows[rr] : (unsigned)(arow0 + rr); aof[h][i] = (rowid * (unsigned)lda + (unsigned)C) * 2u; }
    const char* Ab = (const char*)A; const char* Bb = (const char*)Bt + tid * 16;
    const bool hi = rows_valid > 128;
    int mxw = W8_MX, mxa = A8_MX; asm volatile("" : "+v"(mxw), "+v"(mxa));
#define G8_SA(b, h) (((b) * 2 + (h)) * 16384)
#define G8_SB(b, h) (65536 + ((b) * 2 + (h)) * 16384)
#define G8_STA(b, h, kt) do { _Pragma("unroll") for (int _i = 0; _i < 2; ++_i) \
        __builtin_amdgcn_global_load_lds((const unsigned*)(Ab + aof[h][_i] + (size_t)(kt) * 128), (LAS unsigned*)(lds + G8_SA(b, h) + wid * 1024 + _i * 8192), 16, 0, 0); } while (0)
#define G8_STB(b, h, kt) do { _Pragma("unroll") for (int _i = 0; _i < 2; ++_i) \
        __builtin_amdgcn_global_load_lds((const unsigned*)(Bb + (size_t)(kt) * 32768 + (h) * 16384 + _i * 8192), (LAS unsigned*)(lds + G8_SB(b, h) + wid * 1024 + _i * 8192), 16, 0, 0); } while (0)
#define G8_LDA(dst, b, h) do { _Pragma("unroll") for (int m = 0; m < 4; ++m) _Pragma("unroll") for (int k = 0; k < 2; ++k) dst[m][k] = *(const LAS bf16x8*)(lds + G8_SA(b, h) + aoff + m * 2048 + k * 1024); } while (0)
#define G8_LDB(dst, b, h) do { _Pragma("unroll") for (int n = 0; n < 2; ++n) _Pragma("unroll") for (int k = 0; k < 2; ++k) dst[n][k] = *(const LAS bf16x8*)(lds + G8_SB(b, h) + boff + n * 2048 + k * 1024); } while (0)
#define G8_MMA(ai, bj, At, Bq) do { if ((ai) == 0 || hi) { __builtin_amdgcn_s_setprio(1); _Pragma("unroll") for (int m = 0; m < 4; ++m) _Pragma("unroll") for (int n = 0; n < 2; ++n) { \
        if (FP8) { const i32x4 a0 = __builtin_bit_cast(i32x4, At[m][0]), a1 = __builtin_bit_cast(i32x4, At[m][1]), b0 = __builtin_bit_cast(i32x4, Bq[n][0]), b1 = __builtin_bit_cast(i32x4, Bq[n][1]); \
            const i32x8 a8 = __builtin_shufflevector(a0, a1, 0, 1, 2, 3, 4, 5, 6, 7), b8 = __builtin_shufflevector(b0, b1, 0, 1, 2, 3, 4, 5, 6, 7); \
            if (TRANS) asm volatile("v_mfma_scale_f32_16x16x128_f8f6f4 %0, %1, %2, %0, %3, %4 op_sel_hi:[0,0,0]" : "+v"(acc[ai][bj][m][n]) : "v"(a8), "v"(b8), "v"(mxa), "v"(mxw)); \
            else asm volatile("v_mfma_scale_f32_16x16x128_f8f6f4 %0, %1, %2, %0, %3, %4 op_sel_hi:[0,0,0]" : "+v"(acc[ai][bj][m][n]) : "v"(b8), "v"(a8), "v"(mxw), "v"(mxa)); } \
        else { _Pragma("unroll") for (int k = 0; k < 2; ++k) \
            acc[ai][bj][m][n] = TRANS ? __builtin_amdgcn_mfma_f32_16x16x32_bf16(At[m][k], Bq[n][k], acc[ai][bj][m][n], 0, 0, 0) : __builtin_amdgcn_mfma_f32_16x16x32_bf16(Bq[n][k], At[m][k], acc[ai][bj][m][n], 0, 0, 0); } } \
        __builtin_amdgcn_s_setprio(0); } } while (0)
#define G8_WV(n) asm volatile("s_waitcnt vmcnt(" #n ")" ::: "memory")
#define G8_WL(n) asm volatile("s_waitcnt lgkmcnt(" #n ")" ::: "memory")
#define G8_BAR __builtin_amdgcn_s_barrier()
#define G8_SCHED __builtin_amdgcn_sched_barrier(0)
    const int aoff = lds_byte(wr * 64 + fr, fq * 8), boff = lds_byte(wc * 32 + fr, fq * 8);
    f32x4 acc[2][2][4][2];
#pragma unroll
    for (int a = 0; a < 2; ++a)
#pragma unroll
        for (int b = 0; b < 2; ++b)
#pragma unroll
            for (int m = 0; m < 4; ++m)
#pragma unroll
                for (int n = 0; n < 2; ++n) acc[a][b][m][n] = (f32x4){0.f, 0.f, 0.f, 0.f};
    bf16x8 At[4][2], B0[2][2], B1[2][2];
    G8_STB(0, 0, 0); G8_STA(0, 0, 0); G8_STB(0, 1, 0); G8_STA(0, 1, 0);
    if (wr == 1) G8_BAR;
    G8_WV(4); G8_BAR;
    G8_STB(1, 0, 1); G8_STA(1, 0, 1); G8_STB(1, 1, 1);
    G8_WV(6); G8_BAR;
    for (int t = 0; t < nt - 2; t += 2) {
        G8_LDB(B0, 0, 0); G8_SCHED; G8_LDA(At, 0, 0); G8_STA(1, 1, t + 1);
        G8_WL(8); G8_BAR; G8_WL(0); G8_MMA(0, 0, At, B0); G8_BAR; G8_SCHED;
        G8_LDB(B1, 0, 1); G8_STB(0, 0, t + 2);
        G8_BAR; G8_WL(0); G8_MMA(0, 1, At, B1); G8_BAR;
        if (hi) G8_LDA(At, 0, 1); G8_STA(0, 0, t + 2);
        G8_BAR; G8_WL(0); G8_MMA(1, 0, At, B0); G8_BAR; G8_SCHED;
        G8_STB(0, 1, t + 2);
        G8_WV(6); G8_BAR; G8_MMA(1, 1, At, B1); G8_BAR;
        G8_LDB(B0, 1, 0); G8_SCHED; G8_LDA(At, 1, 0); G8_STA(0, 1, t + 2);
        G8_WL(8); G8_BAR; G8_WL(0); G8_MMA(0, 0, At, B0); G8_BAR; G8_SCHED;
        G8_LDB(B1, 1, 1); G8_STB(1, 0, t + 3);
        G8_BAR; G8_WL(0); G8_MMA(0, 1, At, B1); G8_BAR;
        if (hi) G8_LDA(At, 1, 1); G8_STA(1, 0, t + 3);
        G8_BAR; G8_WL(0); G8_MMA(1, 0, At, B0); G8_BAR; G8_SCHED;
        G8_STB(1, 1, t + 3);
        G8_WV(6); G8_BAR; G8_MMA(1, 1, At, B1); G8_BAR;
    }
    { G8_LDB(B0, 0, 0); G8_WV(0); G8_LDA(At, 0, 0); G8_STA(1, 1, nt - 1);
      G8_BAR; G8_WL(0); G8_MMA(0, 0, At, B0); G8_BAR;
      G8_LDB(B1, 0, 1); G8_BAR; G8_WL(0); G8_MMA(0, 1, At, B1); G8_BAR;
      G8_LDA(At, 0, 1); G8_WV(4); G8_BAR; G8_WL(0); G8_MMA(1, 0, At, B0); G8_MMA(1, 1, At, B1); G8_BAR; }
    { G8_LDB(B0, 1, 0); G8_LDA(At, 1, 0); G8_WV(2); G8_BAR; G8_WL(0); G8_MMA(0, 0, At, B0); G8_BAR;
      G8_LDB(B1, 1, 1); G8_WV(0); G8_BAR; G8_WL(0); G8_MMA(0, 1, At, B1); G8_BAR;
      G8_LDA(At, 1, 1); G8_BAR; G8_WL(0); G8_MMA(1, 0, At, B0); G8_MMA(1, 1, At, B1); G8_BAR; }
    if (wr == 0) G8_BAR;
#undef G8_SA
#undef G8_SB
#undef G8_STA
#undef G8_STB
#undef G8_LDA
#undef G8_LDB
#undef G8_MMA
#undef G8_WV
#undef G8_WL
#undef G8_BAR
#undef G8_SCHED
    __builtin_amdgcn_sched_barrier(0);
    { const int tz = tid_fresh(), wz = __builtin_amdgcn_readfirstlane(tz >> 6), lz = tz & 63;
      epi(acc, wz >> 2, wz & 3, lz & 15, lz >> 4); }
}
struct G8Pre { unsigned aof[2][2]; const char* Bt; int rows; };
__device__ __forceinline__ void g8_addr(G8Pre& p, int lda, const int* __restrict__ arows, int rows_valid, const u16* __restrict__ Bt) {
    const int tid = tid_fresh();
#pragma unroll
    for (int h = 0; h < 2; ++h)
#pragma unroll
        for (int i = 0; i < 2; ++i) { int R, C; stage_rc(tid * 16 + i * 8192, R, C); int rr = h * 128 + R; rr = rr < rows_valid ? rr : rows_valid - 1;
            p.aof[h][i] = ((unsigned)arows[rr] * (unsigned)lda + (unsigned)C) * 2u; }
    p.Bt = (const char*)Bt; p.rows = rows_valid;
}
__device__ __forceinline__ void g8_issue(LAS unsigned char* lds, const char* Ab, const G8Pre& p) {
    const int tid = tid_fresh(), wid = __builtin_amdgcn_readfirstlane(tid >> 6);
    const char* Bb = p.Bt + tid * 16;
#define G8I_A(b, h, kt) do { _Pragma("unroll") for (int _i = 0; _i < 2; ++_i) \
        __builtin_amdgcn_global_load_lds((const unsigned*)(Ab + p.aof[h][_i] + (size_t)(kt) * 128), (LAS unsigned*)(lds + ((b) * 2 + (h)) * 16384 + wid * 1024 + _i * 8192), 16, 0, 0); } while (0)
#define G8I_B(b, h, kt) do { _Pragma("unroll") for (int _i = 0; _i < 2; ++_i) \
        __builtin_amdgcn_global_load_lds((const unsigned*)(Bb + (size_t)(kt) * 32768 + (h) * 16384 + _i * 8192), (LAS unsigned*)(lds + 65536 + ((b) * 2 + (h)) * 16384 + wid * 1024 + _i * 8192), 16, 0, 0); } while (0)
    G8I_B(0, 0, 0); G8I_A(0, 0, 0); G8I_B(0, 1, 0); G8I_A(0, 1, 0); G8I_B(1, 0, 1); G8I_A(1, 0, 1); G8I_B(1, 1, 1);
#undef G8I_A
#undef G8I_B
}
template <bool TRANS, bool FP8, class Epi, class Next>
__device__ __forceinline__ bool gemm8_unit_ov(LAS unsigned char* lds, const u16* __restrict__ A, const G8Pre& pre, int nt, const Epi epi, Next& next) {
    const int tid = tid_fresh(), wid = __builtin_amdgcn_readfirstlane(tid >> 6), lane = tid & 63;
    const int wr = wid >> 2, wc = wid & 3, fr = lane & 15, fq = lane >> 4;
    unsigned aof[2][2];
    aof[0][0] = pre.aof[0][0]; aof[0][1] = pre.aof[0][1]; aof[1][0] = pre.aof[1][0]; aof[1][1] = pre.aof[1][1];
    const int rows_valid = pre.rows;
    const char* Ab = (const char*)A; const char* Bb = pre.Bt + tid * 16;
    const bool hi = rows_valid > 128;
    int mxw = W8_MX, mxa = A8_MX; asm volatile("" : "+v"(mxw), "+v"(mxa));
#define G8_SA(b, h) (((b) * 2 + (h)) * 16384)
#define G8_SB(b, h) (65536 + ((b) * 2 + (h)) * 16384)
#define G8_STA(b, h, kt) do { _Pragma("unroll") for (int _i = 0; _i < 2; ++_i) \
        __builtin_amdgcn_global_load_lds((const unsigned*)(Ab + aof[h][_i] + (size_t)(kt) * 128), (LAS unsigned*)(lds + G8_SA(b, h) + wid * 1024 + _i * 8192), 16, 0, 0); } while (0)
#define G8_STB(b, h, kt) do { _Pragma("unroll") for (int _i = 0; _i < 2; ++_i) \
        __builtin_amdgcn_global_load_lds((const unsigned*)(Bb + (size_t)(kt) * 32768 + (h) * 16384 + _i * 8192), (LAS unsigned*)(lds + G8_SB(b, h) + wid * 1024 + _i * 8192), 16, 0, 0); } while (0)
#define G8_LDA(dst, b, h) do { _Pragma("unroll") for (int m = 0; m < 4; ++m) _Pragma("unroll") for (int k = 0; k < 2; ++k) dst[m][k] = *(const LAS bf16x8*)(lds + G8_SA(b, h) + aoff + m * 2048 + k * 1024); } while (0)
#define G8_LDB(dst, b, h) do { _Pragma("unroll") for (int n = 0; n < 2; ++n) _Pragma("unroll") for (int k = 0; k < 2; ++k) dst[n][k] = *(const LAS bf16x8*)(lds + G8_SB(b, h) + boff + n * 2048 + k * 1024); } while (0)
#define G8_MMA(ai, bj, At, Bq) do { if ((ai) == 0 || hi) { __builtin_amdgcn_s_setprio(1); _Pragma("unroll") for (int m = 0; m < 4; ++m) _Pragma("unroll") for (int n = 0; n < 2; ++n) { \
        if (FP8) { const i32x4 a0 = __builtin_bit_cast(i32x4, At[m][0]), a1 = __builtin_bit_cast(i32x4, At[m][1]), b0 = __builtin_bit_cast(i32x4, Bq[n][0]), b1 = __builtin_bit_cast(i32x4, Bq[n][1]); \
            const i32x8 a8 = __builtin_shufflevector(a0, a1, 0, 1, 2, 3, 4, 5, 6, 7), b8 = __builtin_shufflevector(b0, b1, 0, 1, 2, 3, 4, 5, 6, 7); \
            if (TRANS) asm volatile("v_mfma_scale_f32_16x16x128_f8f6f4 %0, %1, %2, %0, %3, %4 op_sel_hi:[0,0,0]" : "+v"(acc[ai][bj][m][n]) : "v"(a8), "v"(b8), "v"(mxa), "v"(mxw)); \
            else asm volatile("v_mfma_scale_f32_16x16x128_f8f6f4 %0, %1, %2, %0, %3, %4 op_sel_hi:[0,0,0]" : "+v"(acc[ai][bj][m][n]) : "v"(b8), "v"(a8), "v"(mxw), "v"(mxa)); } \
        else { _Pragma("unroll") for (int k = 0; k < 2; ++k) \
            acc[ai][bj][m][n] = TRANS ? __builtin_amdgcn_mfma_f32_16x16x32_bf16(At[m][k], Bq[n][k], acc[ai][bj][m][n], 0, 0, 0) : __builtin_amdgcn_mfma_f32_16x16x32_bf16(Bq[n][k], At[m][k], acc[ai][bj][m][n], 0, 0, 0); } } \
        __builtin_amdgcn_s_setprio(0); } } while (0)
#define G8_WV(n) asm volatile("s_waitcnt vmcnt(" #n ")" ::: "memory")
#define G8_WL(n) asm volatile("s_waitcnt lgkmcnt(" #n ")" ::: "memory")
#define G8_BAR __builtin_amdgcn_s_barrier()
#define G8_SCHED __builtin_amdgcn_sched_barrier(0)
    const int aoff = lds_byte(wr * 64 + fr, fq * 8), boff = lds_byte(wc * 32 + fr, fq * 8);
    f32x4 acc[2][2][4][2];
#pragma unroll
    for (int a = 0; a < 2; ++a)
#pragma unroll
        for (int b = 0; b < 2; ++b)
#pragma unroll
            for (int m = 0; m < 4; ++m)
#pragma unroll
                for (int n = 0; n < 2; ++n) acc[a][b][m][n] = (f32x4){0.f, 0.f, 0.f, 0.f};
    bf16x8 At[4][2], B0[2][2], B1[2][2];
    if (wr == 1) G8_BAR;
    G8_WV(0); G8_BAR;
    G8_BAR;
    for (int t = 0; t < nt - 2; t += 2) {
        G8_LDB(B0, 0, 0); G8_SCHED; G8_LDA(At, 0, 0); G8_STA(1, 1, t + 1);
        G8_WL(8); G8_BAR; G8_WL(0); G8_MMA(0, 0, At, B0); G8_BAR; G8_SCHED;
        G8_LDB(B1, 0, 1); G8_STB(0, 0, t + 2);
        G8_BAR; G8_WL(0); G8_MMA(0, 1, At, B1); G8_BAR;
        if (hi) G8_LDA(At, 0, 1); G8_STA(0, 0, t + 2);
        G8_BAR; G8_WL(0); G8_MMA(1, 0, At, B0); G8_BAR; G8_SCHED;
        G8_STB(0, 1, t + 2);
        G8_WV(6); G8_BAR; G8_MMA(1, 1, At, B1); G8_BAR;
        G8_LDB(B0, 1, 0); G8_SCHED; G8_LDA(At, 1, 0); G8_STA(0, 1, t + 2);
        G8_WL(8); G8_BAR; G8_WL(0); G8_MMA(0, 0, At, B0); G8_BAR; G8_SCHED;
        G8_LDB(B1, 1, 1); G8_STB(1, 0, t + 3);
        G8_BAR; G8_WL(0); G8_MMA(0, 1, At, B1); G8_BAR;
        if (hi) G8_LDA(At, 1, 1); G8_STA(1, 0, t + 3);
        G8_BAR; G8_WL(0); G8_MMA(1, 0, At, B0); G8_BAR; G8_SCHED;
        G8_STB(1, 1, t + 3);
        G8_WV(6); G8_BAR; G8_MMA(1, 1, At, B1); G8_BAR;
    }
    { G8_LDB(B0, 0, 0); G8_WV(0); G8_LDA(At, 0, 0); G8_STA(1, 1, nt - 1);
      G8_BAR; G8_WL(0); G8_MMA(0, 0, At, B0); G8_BAR;
      G8_LDB(B1, 0, 1); G8_BAR; G8_WL(0); G8_MMA(0, 1, At, B1); G8_BAR;
      G8_LDA(At, 0, 1); G8_WV(4); G8_BAR; G8_WL(0); G8_MMA(1, 0, At, B0); G8_MMA(1, 1, At, B1); G8_BAR; }
    { G8_LDB(B0, 1, 0); G8_LDA(At, 1, 0); G8_WV(2); G8_BAR; G8_WL(0); G8_MMA(0, 0, At, B0); G8_BAR;
      G8_LDB(B1, 1, 1); G8_WV(0); G8_BAR; G8_WL(0); G8_MMA(0, 1, At, B1); G8_BAR;
      G8_LDA(At, 1, 1); G8_BAR; G8_WL(0); G8_MMA(1, 0, At, B0); G8_MMA(1, 1, At, B1); G8_BAR; }
    if (wr == 0) G8_BAR;
#undef G8_SA
#undef G8_SB
#undef G8_STA
#undef G8_STB
#undef G8_LDA
#undef G8_LDB
#undef G8_MMA
#undef G8_WV
#undef G8_WL
#undef G8_BAR
#undef G8_SCHED
    __builtin_amdgcn_sched_barrier(0);
    const bool has_next = next();
    __builtin_amdgcn_sched_barrier(0);
    { const int tz = tid_fresh(), wz = __builtin_amdgcn_readfirstlane(tz >> 6), lz = tz & 63;
      epi(acc, wz >> 2, wz & 3, lz & 15, lz >> 4); }
    return has_next;
}
struct StreamUnit { const char* A; const char* Bt; int arow0, rows, a, b, c; };
template <bool TRANS, bool FP8, class Src>
__device__ __forceinline__ void gemm8_stream(LAS unsigned char* lds, unsigned lda, int nt, const Src& src) {
    const int tid = tid_fresh(), wid = __builtin_amdgcn_readfirstlane(tid >> 6), lane = tid & 63;
    const int wr = wid >> 2, wc = wid & 3, fr = lane & 15, fq = lane >> 4;
    StreamUnit cur, nxt;
    if (!src.get(0, cur)) return;
    int R0, C0, R1, C1; stage_rc(tid * 16, R0, C0); stage_rc(tid * 16 + 8192, R1, C1);
    int mxw = W8_MX, mxa = A8_MX; asm volatile("" : "+v"(mxw), "+v"(mxa));
    const int aoff = lds_byte(wr * 64 + fr, fq * 8), boff = lds_byte(wc * 32 + fr, fq * 8);
#define GS_AOF(u, h, R, C) ((unsigned)(((unsigned)((u).arow0 + (((h) * 128 + (R)) < (u).rows ? ((h) * 128 + (R)) : (u).rows - 1)) * lda + (unsigned)(C)) * 2u))
    unsigned ac00 = GS_AOF(cur, 0, R0, C0), ac01 = GS_AOF(cur, 0, R1, C1), ac10 = GS_AOF(cur, 1, R0, C0), ac11 = GS_AOF(cur, 1, R1, C1);
#define GS_SA(b, h) (((b) * 2 + (h)) * 16384)
#define GS_SB(b, h) (65536 + ((b) * 2 + (h)) * 16384)
#define GS_GL(src_, dst_) __builtin_amdgcn_global_load_lds((const unsigned*)(src_), (LAS unsigned*)(lds + (dst_)), 16, 0, 0)
#define GS_STA(b, h, base, o0, o1, kt) do { GS_GL((base) + (o0) + (size_t)(kt) * 128, GS_SA(b, h) + wid * 1024); GS_GL((base) + (o1) + (size_t)(kt) * 128, GS_SA(b, h) + wid * 1024 + 8192); } while (0)
#define GS_STB(b, h, base, kt) do { GS_GL((base) + tid * 16 + (size_t)(kt) * 32768 + (h) * 16384, GS_SB(b, h) + wid * 1024); GS_GL((base) + tid * 16 + (size_t)(kt) * 32768 + (h) * 16384 + 8192, GS_SB(b, h) + wid * 1024 + 8192); } while (0)
#define GS_LDA(dst, b, h) do { _Pragma("unroll") for (int m = 0; m < 4; ++m) _Pragma("unroll") for (int k = 0; k < 2; ++k) dst[m][k] = *(const LAS bf16x8*)(lds + GS_SA(b, h) + aoff + m * 2048 + k * 1024); } while (0)
#define GS_LDB(dst, b, h) do { _Pragma("unroll") for (int n = 0; n < 2; ++n) _Pragma("unroll") for (int k = 0; k < 2; ++k) dst[n][k] = *(const LAS bf16x8*)(lds + GS_SB(b, h) + boff + n * 2048 + k * 1024); } while (0)
#define GS_MMA(ai, bj, At, Bq) do { if ((ai) == 0 || hi) { __builtin_amdgcn_s_setprio(1); _Pragma("unroll") for (int m = 0; m < 4; ++m) _Pragma("unroll") for (int n = 0; n < 2; ++n) { \
        if (FP8) { const i32x4 a0 = __builtin_bit_cast(i32x4, At[m][0]), a1 = __builtin_bit_cast(i32x4, At[m][1]), b0 = __builtin_bit_cast(i32x4, Bq[n][0]), b1 = __builtin_bit_cast(i32x4, Bq[n][1]); \
            const i32x8 a8 = __builtin_shufflevector(a0, a1, 0, 1, 2, 3, 4, 5, 6, 7), b8 = __builtin_shufflevector(b0, b1, 0, 1, 2, 3, 4, 5, 6, 7); \
            if (TRANS) asm volatile("v_mfma_scale_f32_16x16x128_f8f6f4 %0, %1, %2, %0, %3, %4 op_sel_hi:[0,0,0]" : "+v"(acc[ai][bj][m][n]) : "v"(a8), "v"(b8), "v"(mxa), "v"(mxw)); \
            else asm volatile("v_mfma_scale_f32_16x16x128_f8f6f4 %0, %1, %2, %0, %3, %4 op_sel_hi:[0,0,0]" : "+v"(acc[ai][bj][m][n]) : "v"(b8), "v"(a8), "v"(mxw), "v"(mxa)); } \
        else { _Pragma("unroll") for (int k = 0; k < 2; ++k) \
            acc[ai][bj][m][n] = TRANS ? __builtin_amdgcn_mfma_f32_16x16x32_bf16(At[m][k], Bq[n][k], acc[ai][bj][m][n], 0, 0, 0) : __builtin_amdgcn_mfma_f32_16x16x32_bf16(Bq[n][k], At[m][k], acc[ai][bj][m][n], 0, 0, 0); } } \
        __builtin_amdgcn_s_setprio(0); } } while (0)
#define GS_WV(n) asm volatile("s_waitcnt vmcnt(" #n ")" ::: "memory")
#define GS_WL(n) asm volatile("s_waitcnt lgkmcnt(" #n ")" ::: "memory")
#define GS_BAR __builtin_amdgcn_s_barrier()
#define GS_SCHED __builtin_amdgcn_sched_barrier(0)
    f32x4 acc[2][2][4][2];
#pragma unroll
    for (int a = 0; a < 2; ++a)
#pragma unroll
        for (int b = 0; b < 2; ++b)
#pragma unroll
            for (int m = 0; m < 4; ++m)
#pragma unroll
                for (int n = 0; n < 2; ++n) acc[a][b][m][n] = (f32x4){0.f, 0.f, 0.f, 0.f};
    bf16x8 At[4][2], B0[2][2], B1[2][2];
    GS_STB(0, 0, cur.Bt, 0); GS_STA(0, 0, cur.A, ac00, ac01, 0); GS_STB(0, 1, cur.Bt, 0); GS_STA(0, 1, cur.A, ac10, ac11, 0);
    if (wr == 1) GS_BAR;
    GS_WV(4); GS_BAR;
    GS_STB(1, 0, cur.Bt, 1); GS_STA(1, 0, cur.A, ac00, ac01, 1); GS_STB(1, 1, cur.Bt, 1);
    GS_WV(6); GS_BAR;
    for (int ui = 0;; ++ui) {
        const bool has_next = src.get(ui + 1, nxt);
        if (!has_next) nxt = cur;
        const unsigned an00 = GS_AOF(nxt, 0, R0, C0), an01 = GS_AOF(nxt, 0, R1, C1), an10 = GS_AOF(nxt, 1, R0, C0), an11 = GS_AOF(nxt, 1, R1, C1);
        const bool hi = cur.rows > 128;
        for (int t = 0; t < nt; t += 2) {
            const bool last = (t == nt - 2);
            const char* xA = last ? nxt.A : cur.A; const char* xB = last ? nxt.Bt : cur.Bt;
            const unsigned x00 = last ? an00 : ac00, x01 = last ? an01 : ac01, x10 = last ? an10 : ac10, x11 = last ? an11 : ac11;
            const int k2 = last ? 0 : t + 2, k3 = k2 + 1;
            GS_LDB(B0, 0, 0); GS_SCHED; GS_LDA(At, 0, 0); GS_STA(1, 1, cur.A, ac10, ac11, t + 1);
            GS_WL(8); GS_BAR; GS_WL(0); GS_MMA(0, 0, At, B0); GS_BAR; GS_SCHED;
            GS_LDB(B1, 0, 1); GS_STB(0, 0, xB, k2);
            GS_BAR; GS_WL(0); GS_MMA(0, 1, At, B1); GS_BAR;
            if (hi) GS_LDA(At, 0, 1); GS_STA(0, 0, xA, x00, x01, k2);
            GS_BAR; GS_WL(0); GS_MMA(1, 0, At, B0); GS_BAR; GS_SCHED;
            GS_STB(0, 1, xB, k2);
            GS_WV(6); GS_BAR; GS_MMA(1, 1, At, B1); GS_BAR;
            GS_LDB(B0, 1, 0); GS_SCHED; GS_LDA(At, 1, 0); GS_STA(0, 1, xA, x10, x11, k2);
            GS_WL(8); GS_BAR; GS_WL(0); GS_MMA(0, 0, At, B0); GS_BAR; GS_SCHED;
            GS_LDB(B1, 1, 1); GS_STB(1, 0, xB, k3);
            GS_BAR; GS_WL(0); GS_MMA(0, 1, At, B1); GS_BAR;
            if (hi) GS_LDA(At, 1, 1); GS_STA(1, 0, xA, x00, x01, k3);
            GS_BAR; GS_WL(0); GS_MMA(1, 0, At, B0); GS_BAR; GS_SCHED;
            GS_STB(1, 1, xB, k3);
            GS_WV(6); GS_BAR; GS_MMA(1, 1, At, B1); GS_BAR;
        }
        __builtin_amdgcn_sched_barrier(0);
        src.epi(acc, cur, wr, wc, fr, fq);
        __builtin_amdgcn_sched_barrier(0);
        if (!has_next) break;
#pragma unroll
        for (int a = 0; a < 2; ++a)
#pragma unroll
            for (int b = 0; b < 2; ++b)
#pragma unroll
                for (int m = 0; m < 4; ++m)
#pragma unroll
                    for (int n = 0; n < 2; ++n) acc[a][b][m][n] = (f32x4){0.f, 0.f, 0.f, 0.f};
        cur = nxt; ac00 = an00; ac01 = an01; ac10 = an10; ac11 = an11;
    }
    GS_WV(0);
    if (wr == 0) GS_BAR;
    GS_BAR;
#undef GS_AOF
#undef GS_SA
#undef GS_SB
#undef GS_GL
#undef GS_STA
#undef GS_STB
#undef GS_LDA
#undef GS_LDB
#undef GS_MMA
#undef GS_WV
#undef GS_WL
#undef GS_BAR
#undef GS_SCHED
}
struct Epi8PG { u16* PG; const float* lbl; int tok0, col0;
    __device__ __forceinline__ void operator()(const f32x4 (&acc)[2][2][4][2], int wr, int wc, int fr, int fq) const {
        const int grp = col0 >> 10;
        if (grp == 0) {
#pragma unroll
            for (int ai = 0; ai < 2; ++ai)
#pragma unroll
                for (int m = 0; m < 4; ++m) { u16* rowp = PG + (size_t)(tok0 + ai * 128 + wr * 64 + m * 16 + fr) * 5120 + col0 + wc * 32 + 8 * fq;
#pragma unroll
                    for (int bj = 0; bj < 2; ++bj) { float o[8];
#pragma unroll
                        for (int n = 0; n < 2; ++n)
#pragma unroll
                            for (int q = 0; q < 4; ++q) { const float x = acc[ai][bj][m][n][q]; o[4 * n + q] = x * __builtin_amdgcn_rcpf(1.0f + __expf(-x)); }
                        *(u32x4*)(rowp + bj * 128) = (u32x4){pk_bf16(o[0], o[1]), pk_bf16(o[2], o[3]), pk_bf16(o[4], o[5]), pk_bf16(o[6], o[7])}; } }
        } else if (grp <= 2) {
#pragma unroll
            for (int bj = 0; bj < 2; ++bj) { float lbv[8];
#pragma unroll
                for (int q = 0; q < 8; ++q) { const int c = (col0 & 1023) + bj * 128 + wc * 32 + 8 * fq + q; const float l0 = lbl[(grp - 1) * HGW + c], l1 = lbl[(2 + grp - 1) * HGW + c]; lbv[q] = __builtin_amdgcn_rcpf(1.0f + __expf(l1 - l0)); }
#pragma unroll
                for (int ai = 0; ai < 2; ++ai)
#pragma unroll
                    for (int m = 0; m < 4; ++m) { u16* rowp = PG + (size_t)(tok0 + ai * 128 + wr * 64 + m * 16 + fr) * 5120 + col0 + wc * 32 + 8 * fq; float o[8];
#pragma unroll
                        for (int n = 0; n < 2; ++n)
#pragma unroll
                            for (int q = 0; q < 4; ++q) { const float z = acc[ai][bj][m][n][q], lb = lbv[4 * n + q]; const float sg = __builtin_amdgcn_rcpf(1.0f + __expf(-z)); o[4 * n + q] = __log2f(lb + (1.0f - lb) * sg); }
                        *(u32x4*)(rowp + bj * 128) = (u32x4){pk_bf16(o[0], o[1]), pk_bf16(o[2], o[3]), pk_bf16(o[4], o[5]), pk_bf16(o[6], o[7])}; } }
        } else {
#pragma unroll
            for (int ai = 0; ai < 2; ++ai)
#pragma unroll
                for (int m = 0; m < 4; ++m) { u16* rowp = PG + (size_t)(tok0 + ai * 128 + wr * 64 + m * 16 + fr) * 5120 + col0 + wc * 32 + 8 * fq;
#pragma unroll
                    for (int bj = 0; bj < 2; ++bj) { const f32x4 v0 = acc[ai][bj][m][0], v1 = acc[ai][bj][m][1];
                        *(u32x4*)(rowp + bj * 128) = (u32x4){pk_bf16(v0[0], v0[1]), pk_bf16(v0[2], v0[3]), pk_bf16(v1[0], v1[1]), pk_bf16(v1[2], v1[3])}; } }
        }
    } };
struct Epi8HYT { u16* HYT; int tok0, col0;
    __device__ __forceinline__ void operator()(const f32x4 (&acc)[2][2][4][2], int wr, int wc, int fr, int fq) const {
#pragma unroll
        for (int bj = 0; bj < 2; ++bj)
#pragma unroll
            for (int n = 0; n < 2; ++n) { u16* colp = HYT + (size_t)(col0 + bj * 128 + wc * 32 + perm32(n * 16 + fr)) * NTOK + tok0 + wr * 64 + 4 * fq;
#pragma unroll
                for (int ai = 0; ai < 2; ++ai)
#pragma unroll
                    for (int m = 0; m < 4; ++m) { const f32x4 v = acc[ai][bj][m][n]; *(u32x2*)(colp + ai * 128 + m * 16) = (u32x2){pk_bf16(v[0], v[1]), pk_bf16(v[2], v[3])}; } }
    } };
struct Epi8X1 { const float* x; float* X1; int tok0, col0;
    __device__ __forceinline__ void operator()(const f32x4 (&acc)[2][2][4][2], int wr, int wc, int fr, int fq) const {
#pragma unroll
        for (int ai = 0; ai < 2; ++ai)
#pragma unroll
            for (int m = 0; m < 4; ++m) { const size_t off = (size_t)(tok0 + ai * 128 + wr * 64 + m * 16 + fr) * DM + col0 + wc * 32 + 8 * fq;
#pragma unroll
                for (int bj = 0; bj < 2; ++bj)
#pragma unroll
                    for (int n = 0; n < 2; ++n) { const f32x4 r = *(const f32x4*)(x + off + bj * 128 + n * 4); *(f32x4*)(X1 + off + bj * 128 + n * 4) = r + acc[ai][bj][m][n]; }
                asm volatile("" ::: "memory"); }
    } };
struct Epi8Swiglu { u16* HM; const float* b1; int slot0, nt, rows_valid;
    __device__ __forceinline__ void operator()(const f32x4 (&acc)[2][2][4][2], int wr, int wc, int fr, int fq) const {
        f32x4 bg[2], bl[2];
#pragma unroll
        for (int n = 0; n < 2; ++n) { const int col = nt * 128 + wc * 32 + 8 * fq + 4 * n; bg[n] = *(const f32x4*)(b1 + col); bl[n] = *(const f32x4*)(b1 + 2048 + col); }
#pragma unroll
        for (int ai = 0; ai < 2; ++ai)
#pragma unroll
            for (int m = 0; m < 4; ++m) { const int row = ai * 128 + wr * 64 + m * 16 + fr;
                if (row < rows_valid) { float o[8];
#pragma unroll
                    for (int n = 0; n < 2; ++n) { const f32x4 gl = acc[ai][0][m][n] + bg[n], li = acc[ai][1][m][n] + bl[n];
#pragma unroll
                        for (int j = 0; j < 4; ++j) { const float gq = fminf(gl[j], 7.0f), lq = fminf(fmaxf(li[j], -7.0f), 7.0f); o[4 * n + j] = gq * __builtin_amdgcn_rcpf(1.0f + __builtin_amdgcn_exp2f(-2.45546696f * gq)) * (lq + 1.0f); } }
                    *(u32x4*)(HM + (size_t)(slot0 + row) * DFF + nt * 128 + wc * 32 + 8 * fq) = (u32x4){pk_bf16(o[0], o[1]), pk_bf16(o[2], o[3]), pk_bf16(o[4], o[5]), pk_bf16(o[6], o[7])}; } }
    } };
struct Epi8Swiglu8 { unsigned char* HM; const float* b1; int slot0, nt, rows_valid;
    __device__ __forceinline__ void operator()(const f32x4 (&acc)[2][2][4][2], int wr, int wc, int fr, int fq) const {
        f32x4 bg[2], bl[2];
#pragma unroll
        for (int n = 0; n < 2; ++n) { const int col = nt * 128 + wc * 32 + 8 * fq + 4 * n; bg[n] = *(const f32x4*)(b1 + col); bl[n] = *(const f32x4*)(b1 + 2048 + col); }
#pragma unroll
        for (int ai = 0; ai < 2; ++ai)
#pragma unroll
            for (int m = 0; m < 4; ++m) { const int row = ai * 128 + wr * 64 + m * 16 + fr;
                if (row < rows_valid) { float o[8];
#pragma unroll
                    for (int n = 0; n < 2; ++n) { const f32x4 gl = acc[ai][0][m][n] + bg[n], li = acc[ai][1][m][n] + bl[n];
#pragma unroll
                        for (int j = 0; j < 4; ++j) { const float gq = fminf(gl[j], 7.0f), lq = fminf(fmaxf(li[j], -7.0f), 7.0f); o[4 * n + j] = gq * __builtin_amdgcn_rcpf(1.0f + __builtin_amdgcn_exp2f(-2.45546696f * gq)) * (lq + 1.0f); } }
                    *(u32x2*)(HM + (size_t)(slot0 + row) * DFF + nt * 128 + wc * 32 + 8 * fq) = (u32x2){pk_fp8x4(o[0], o[1], o[2], o[3]), pk_fp8x4(o[4], o[5], o[6], o[7])}; } }
    } };
struct Epi8Y { u16* Y; const float* b2; int slot0, col0, rows_valid;
    __device__ __forceinline__ void operator()(const f32x4 (&acc)[2][2][4][2], int wr, int wc, int fr, int fq) const {
        f32x4 bv[2][2];
#pragma unroll
        for (int bj = 0; bj < 2; ++bj)
#pragma unroll
            for (int n = 0; n < 2; ++n) bv[bj][n] = *(const f32x4*)(b2 + col0 + bj * 128 + wc * 32 + 8 * fq + 4 * n);
#pragma unroll
        for (int ai = 0; ai < 2; ++ai)
#pragma unroll
            for (int m = 0; m < 4; ++m) { const int row = ai * 128 + wr * 64 + m * 16 + fr;
                if (row < rows_valid) { u16* rowp = Y + (size_t)(slot0 + row) * DM + col0 + wc * 32 + 8 * fq;
#pragma unroll
                    for (int bj = 0; bj < 2; ++bj) { const f32x4 v0 = acc[ai][bj][m][0] + bv[bj][0], v1 = acc[ai][bj][m][1] + bv[bj][1];
                        *(u32x4*)(rowp + bj * 128) = (u32x4){pk_bf16(v0[0], v0[1]), pk_bf16(v0[2], v0[3]), pk_bf16(v1[0], v1[1]), pk_bf16(v1[2], v1[3])}; } } }
    } };
struct EpiNone { __device__ __forceinline__ void operator()(const f32x4 (&acc)[2][2][4][2], int wr, int wc, int fr, int fq) const {
#pragma unroll
        for (int a = 0; a < 2; ++a)
#pragma unroll
            for (int b = 0; b < 2; ++b)
#pragma unroll
                for (int m = 0; m < 4; ++m)
#pragma unroll
                    for (int n = 0; n < 2; ++n) asm volatile("" :: "v"(acc[a][b][m][n]));
    } };

template <int NTILES>
__device__ __forceinline__ bool moe_unit_static(const LAS int* us, const LAS int* so2, int uu, int& e, int& nt, int& slot0, int& rows) {
    if (uu >= us[NE]) return false;
    int lo = 0, hi = NE;
#pragma unroll
    for (int s = 0; s < 5; ++s) { const int mid = (lo + hi) >> 1; if (us[mid] <= uu) lo = mid; else hi = mid; }
    e = lo; const int o0 = e * NTOK, cnt = so2[e], mtl = (cnt + 255) >> 8, ul = uu - us[e], mt = ul % mtl;
    e = __builtin_amdgcn_readfirstlane(e); nt = __builtin_amdgcn_readfirstlane(ul / mtl); slot0 = __builtin_amdgcn_readfirstlane(o0 + mt * 256);
    rows = cnt - mt * 256; rows = __builtin_amdgcn_readfirstlane(rows > 256 ? 256 : rows); return true;
}
struct SrcMoeB { const LAS int* us; const LAS int* so2; int c, G; const char* HM8; const char* W2T8; u16* YB; const float* b2;
    __device__ __forceinline__ bool get(int i, StreamUnit& u) const { int e, nt, slot0, rows; if (!moe_unit_static<8>(us, so2, c + i * G, e, nt, slot0, rows)) return false;
        u.A = HM8; u.Bt = W2T8 + (size_t)((e * 8 + nt) * 16) * 32768; u.arow0 = slot0; u.rows = rows; u.a = e; u.b = nt; u.c = slot0; return true; }
    __device__ __forceinline__ void epi(const f32x4 (&acc)[2][2][4][2], const StreamUnit& u, int wr, int wc, int fr, int fq) const { Epi8Y ep{YB, b2 + (size_t)u.a * DM, u.c, u.b * 256, u.rows}; ep(acc, wr, wc, fr, fq); }
};
template <bool TRANS>
struct SrcG1 { int c, G; const char* HBp; const char* WINTp; u16* PG; u16* HYT; const float* lbl; int ktiles;
    __device__ __forceinline__ bool get(int k, StreamUnit& su) const {
        int seen = 0;
        for (int u = c; u < 1024; u += G) { const int i = u >> 8, xx = (u >> 5) & 7, j = u & 31; const int mt = (xx & 3) * 8 + (j & 7), nt = ((xx >> 2) + 2 * i) * 4 + (j >> 3);
            if ((nt >= 20) == TRANS) { if (seen == k) { su.A = HBp; su.Bt = WINTp + (size_t)nt * ktiles * 32768; su.arow0 = mt * 256; su.rows = 256; su.a = mt; su.b = nt; su.c = 0; return true; } ++seen; } }
        return false; }
    __device__ __forceinline__ void epi(const f32x4 (&acc)[2][2][4][2], const StreamUnit& u, int wr, int wc, int fr, int fq) const {
        if (TRANS) { Epi8HYT e{HYT, u.a * 256, u.b * 256 - 5120}; e(acc, wr, wc, fr, fq); } else { Epi8PG e{PG, lbl, u.a * 256, u.b * 256}; e(acc, wr, wc, fr, fq); } }
};

typedef float f32x16 __attribute__((ext_vector_type(16)));
__device__ __forceinline__ void h3_row(int m, const float* __restrict__ w1, const float* __restrict__ b1, const float* __restrict__ w2, const float* __restrict__ b2,
                                       const float* __restrict__ w3, const float* __restrict__ b3, const float* __restrict__ freq, LAS float* sc  , float* __restrict__ H3) {
    const int j = tid_fresh() & 63;
    const float tt = (float)m / (float)(SEQ - 1);
    if (j == 0) sc[0] = tt;
    if (j >= 1 && j <= 16) { const int i = j - 1; const float band = 1e-4f + (float)i * ((15.0f - 1e-4f) / 15.0f); const float ang = (2.0f * 3.14159265358979323846f / (float)SEQ) * (float)m * band; sc[1 + i] = cosf(ang); sc[17 + i] = -sinf(ang); }
    __builtin_amdgcn_wave_barrier();
    const float fr = freq[j];
    float s = b1[j];
    for (int i = 0; i < 33; ++i) s += sc[i] * w1[i * 64 + j];
    const float h1 = sinf(fr * s);
    sc[64 + j] = h1;
    __builtin_amdgcn_wave_barrier();
    s = b2[j];
    for (int i = 0; i < 64; ++i) s += sc[64 + i] * w2[i * 64 + j];
    const float h2 = sinf(fr * s);
    __builtin_amdgcn_wave_barrier();
    sc[j] = h2;
    __builtin_amdgcn_wave_barrier();
    s = b3[j];
    for (int i = 0; i < 64; ++i) s += sc[i] * w3[i * 64 + j];
    H3[(size_t)m * 64 + j] = sinf(fr * s);
    __builtin_amdgcn_wave_barrier();
}
constexpr int FR_LEN = 4128;
__device__ __forceinline__ void frgen_item(LAS unsigned char* lds, int item, const float* __restrict__ H3, const float* __restrict__ w4, u16* __restrict__ FR) {
    const int tid = tid_fresh(), wid = __builtin_amdgcn_readfirstlane(tid >> 6), lane = tid & 63, fr = lane & 15, fq = lane >> 4;
    const int oc0 = item * 8, o = oc0 >> 10;
    const int colB = o * 2048 + (fr >> 3) * 1024 + (oc0 & 1023) + (fr & 7);
    float wreg[16];
#pragma unroll
    for (int ks = 0; ks < 16; ++ks) wreg[ks] = w4[(size_t)(4 * ks + fq) * 4096 + colB];
    const int dir = fr >> 3, c = (oc0 & 1023) + (fr & 7);
    const float mind = logf(1e-2f) / 0.3f, maxd = logf(1e-2f) / 1.5f;
    const float delta = fabsf(mind + (float)c * ((maxd - mind) / 1023.0f));
    u16* r0 = FR + ((size_t)((oc0 + (fr & 7)) * 2) + (fr >> 3)) * 2048;
    LAS float* tile = (LAS float*)(lds + wid * 4608);
    const int wrow = lane >> 4, wcol = 4 * (lane & 15);
    f32x4 nx[4];
    const int rot = (blockIdx.x >> 3) & 15;
#pragma unroll
    for (int q = 0; q < 4; ++q) nx[q] = *(const f32x4*)(H3 + (size_t)(wid + 8 * rot) * 1024 + q * 256 + lane * 4);
    for (int it = 0; it < 16; ++it) {
        const int mt = wid + 8 * ((it + rot) & 15), mtn = wid + 8 * ((it + 1 + rot) & 15);
#pragma unroll
        for (int q = 0; q < 4; ++q) *(LAS f32x4*)(tile + (q * 4 + wrow) * 68 + wcol) = nx[q];
        if (it + 1 < 16) {
#pragma unroll
            for (int q = 0; q < 4; ++q) nx[q] = *(const f32x4*)(H3 + (size_t)mtn * 1024 + q * 256 + lane * 4);
        }
        f32x4 acc = {0.f, 0.f, 0.f, 0.f}, acc1 = acc;
#pragma unroll
        for (int ks = 0; ks < 16; ks += 2) { acc = __builtin_amdgcn_mfma_f32_16x16x4f32(tile[fr * 68 + 4 * ks + fq], wreg[ks], acc, 0, 0, 0);
            acc1 = __builtin_amdgcn_mfma_f32_16x16x4f32(tile[fr * 68 + 4 * (ks + 1) + fq], wreg[ks + 1], acc1, 0, 0, 0); }
        acc += acc1;
        const int m0 = mt * 16 + 4 * fq;
        float v[4];
#pragma unroll
        for (int j = 0; j < 4; ++j) v[j] = acc[j] * __expf(-((float)(m0 + j) * (1.0f / (float)(SEQ - 1))) * delta);
        *(u32x2*)(r0 + m0) = (u32x2){pk_bf16(v[0], v[1]), pk_bf16(v[2], v[3])};
    }
    __syncthreads();
}
constexpr int HY_ZSTRIDE = 2312;
constexpr int HY_ZCH = 256 + 4 * HY_ZSTRIDE;
constexpr int HY_ZBYTES = HY_ZCH * 2;
constexpr int HY_FB = 4 * HY_ZBYTES;
constexpr int HY_FCH = 2 * FR_LEN * 2;
constexpr int HY_LDS = HY_FB + 4 * HY_FCH;

__device__ __forceinline__ void hy_load_row(LAS unsigned char* lds, int dest, int boff0, int bstride, const u16* __restrict__ row, float w0, float w1, float w2, float cb, int pl) {
#pragma unroll 2
    for (int it = 0; it < 8; ++it) {
        const int idx = pl + 128 * it, tok0 = idx * 8, b = tok0 >> 11, n0 = tok0 & 2047;
        const u32x4 raw = *(const u32x4*)(row + tok0);
        const float pm = (n0 > 0) ? bf2f(row[tok0 - 1]) : 0.f;
        const float pn = (n0 + 8 < SEQ) ? bf2f(row[tok0 + 8]) : 0.f;
        float p[10];
        p[0] = pm; p[9] = pn;
#pragma unroll
        for (int q = 0; q < 4; ++q) { p[1 + 2 * q] = bflo(raw[q]); p[2 + 2 * q] = bfhi(raw[q]); }
        float o[8];
#pragma unroll
        for (int q = 0; q < 8; ++q) o[q] = fmaf(w0, p[q], fmaf(w1, p[q + 1], fmaf(w2, p[q + 2], cb)));
        u32x4 w; w[0] = pk_bf16(o[0], o[1]); w[1] = pk_bf16(o[2], o[3]); w[2] = pk_bf16(o[4], o[5]); w[3] = pk_bf16(o[6], o[7]);
        *(LAS u32x4*)(lds + dest + (boff0 + b * bstride + n0) * 2) = w;
    }
}
__device__ __forceinline__ unsigned hy_rot16(unsigned x) { return __builtin_amdgcn_alignbit(x, x, 16); }
__device__ __forceinline__ void hy_load_filters(LAS unsigned char* lds, int fb, const u16* __restrict__ src, int pl) {
    const int c1 = fb + FR_LEN * 2;
    if (pl < 34) { const int x = 4094 + pl; if (x >= 4095) *(LAS u16*)(lds + fb + x * 2) = 0; *(LAS u16*)(lds + c1 + x * 2) = 0; }
#pragma unroll
    for (int it = 0; it < 2; ++it) { const int i = pl + 128 * it;
        const u32x4 v = *(const u32x4*)(src + 8 * i), w = *(const u32x4*)(src + 2048 + 8 * i);
        const unsigned r0 = hy_rot16(v[3]), r1 = hy_rot16(v[2]), r2 = hy_rot16(v[1]), r3 = hy_rot16(v[0]);
        *(LAS u32x4*)(lds + fb + (2040 - 8 * i) * 2) = (u32x4){r0, r1, r2, r3};
        const int q0 = 2039 - 8 * i;
        if (q0 >= 0) *(LAS u16*)(lds + c1 + q0 * 2) = (u16)(r0 & 0xffffu);
        *(LAS unsigned*)(lds + c1 + (q0 + 1) * 2) = __builtin_amdgcn_alignbit(r1, r0, 16);
        *(LAS unsigned*)(lds + c1 + (q0 + 3) * 2) = __builtin_amdgcn_alignbit(r2, r1, 16);
        *(LAS unsigned*)(lds + c1 + (q0 + 5) * 2) = __builtin_amdgcn_alignbit(r3, r2, 16);
        *(LAS u16*)(lds + c1 + (q0 + 7) * 2) = (u16)(r3 >> 16);
        const int p0 = 2047 + 8 * i;
        if (i > 0) *(LAS u16*)(lds + fb + p0 * 2) = (u16)(w[0] & 0xffffu);
        *(LAS unsigned*)(lds + fb + (p0 + 1) * 2) = __builtin_amdgcn_alignbit(w[1], w[0], 16);
        *(LAS unsigned*)(lds + fb + (p0 + 3) * 2) = __builtin_amdgcn_alignbit(w[2], w[1], 16);
        *(LAS unsigned*)(lds + fb + (p0 + 5) * 2) = __builtin_amdgcn_alignbit(w[3], w[2], 16);
        *(LAS u16*)(lds + fb + (p0 + 7) * 2) = (u16)(w[3] >> 16);
        if (i > 0) *(LAS unsigned*)(lds + c1 + (2046 + 8 * i) * 2) = w[0]; else *(LAS u16*)(lds + c1 + 2047 * 2) = (u16)(w[0] >> 16);
        *(LAS unsigned*)(lds + c1 + (2048 + 8 * i) * 2) = w[1];
        *(LAS unsigned*)(lds + c1 + (2050 + 8 * i) * 2) = w[2];
        *(LAS unsigned*)(lds + c1 + (2052 + 8 * i) * 2) = w[3];
    }
}
__device__ __forceinline__ void hy_mfma_loop(LAS unsigned char* lds, int zb, int fb, int hlf, int lane, f32x16 (&acc)[4], const ConvCtx& cc, int mbase, int cunit, int wid) {
    const int r = lane & 31, hh = lane >> 5, il = r >> 2, b = r & 3;
    const int bbase = zb + (256 + b * HY_ZSTRIDE + 32 * il + 8 * hh) * 2;
    const int xl = 2047 - r + 8 * hh - 1024 * hlf;
    const int abase = (r & 1) ? (fb + 2 * xl) : (fb + FR_LEN * 2 + 2 * (xl - 1));
#pragma unroll
    for (int q = 0; q < 4; ++q)
#pragma unroll
        for (int i = 0; i < 16; ++i) acc[q][i] = 0.f;
    f32x2 cvA[16], cvB[16];
    conv_issue(cc, conv_seq2tile((mbase + 0) * 256 + cunit), wid, lane, cvA);
    for (int d0 = 0; d0 < 8; ++d0) {
#pragma unroll
        for (int ks = 0; ks < 2; ++ks) {
            const int idx = d0 * 2 + ks;
            const int mcv = conv_seq2tile((mbase + idx) * 256 + cunit), mnx = conv_seq2tile((mbase + idx + 1) * 256 + cunit);
            if (idx + 1 < 16) { if (ks == 0) conv_issue(cc, mnx, wid, lane, cvB); else conv_issue(cc, mnx, wid, lane, cvA); }
            bf16x8 Bt[9];
#pragma unroll
            for (int j = 0; j < 9; ++j) Bt[j] = *(const LAS bf16x8*)(lds + bbase + 512 * j - 64 * d0 + 32 * ks);
#pragma unroll
            for (int ep = -8; ep <= 3; ++ep) {
                const LAS unsigned* ap = (const LAS unsigned*)(lds + abase - 64 * d0 - 512 * ep + 32 * ks);
                u32x4 av; av[0] = ap[0]; av[1] = ap[1]; av[2] = ap[2]; av[3] = ap[3];
                const bf16x8 a = __builtin_bit_cast(bf16x8, av);
#pragma unroll
                for (int ctl = 0; ctl < 4; ++ctl) { const int jt = ctl - ep; if (jt >= 0 && jt <= 8) acc[ctl] = __builtin_amdgcn_mfma_f32_32x32x16_bf16(a, Bt[jt], acc[ctl], 0, 0, 0); }
            }
            if (ks == 0) conv_finish(cc, mcv, wid, lane, cvA); else conv_finish(cc, mcv, wid, lane, cvB);
        }
    }
}
__device__ __forceinline__ void hy_epilogue(LAS unsigned char* lds, int zb, int gb, int hlf, int lane, const f32x16 (&acc)[4], float bias) {
    const int r = lane & 31, hh = lane >> 5, il = r >> 2, b = r & 3;
#pragma unroll
    for (int ctl = 0; ctl < 4; ++ctl) {
        const int I = 8 * (4 * hlf + ctl) + il;
#pragma unroll
        for (int q = 0; q < 4; ++q) {
            const int n4 = 32 * I + 8 * q + 4 * hh;
            LAS u32x2* zp = (LAS u32x2*)(lds + zb + (256 + b * HY_ZSTRIDE + n4) * 2);
            const u32x2 zv = *zp, gv = *(const LAS u32x2*)(lds + gb + (b * 2048 + n4) * 2);
            const float z0 = bflo(zv[0]), z1 = bfhi(zv[0]), z2 = bflo(zv[1]), z3 = bfhi(zv[1]);
            const float g0 = bflo(gv[0]), g1 = bfhi(gv[0]), g2 = bflo(gv[1]), g3 = bfhi(gv[1]);
            u32x2 o; o[0] = pk_bf16(g0 * fmaf(bias, z0, acc[ctl][4 * q + 0]), g1 * fmaf(bias, z1, acc[ctl][4 * q + 1]));
            o[1] = pk_bf16(g2 * fmaf(bias, z2, acc[ctl][4 * q + 2]), g3 * fmaf(bias, z3, acc[ctl][4 * q + 3]));
            *zp = o;
        }
    }
}
__device__ __forceinline__ void hyena_unit(LAS unsigned char* lds, int unit, const u16* __restrict__ HYT, const u16* __restrict__ FR, const float* __restrict__ cw, const float* __restrict__ cbv,
                                           const float* __restrict__ hbias, u16* __restrict__ Z2T, const ConvCtx& cc) {
    const int tid = tid_fresh(), wid = __builtin_amdgcn_readfirstlane(tid >> 6), lane = tid & 63;
    const int cs = wid & 3, hlf = wid >> 2, c = unit * 4 + cs, pl = lane + 64 * hlf;
    const int zb = cs * HY_ZBYTES, fb = HY_FB + cs * HY_FCH;
    { const u32x4 z = {0u, 0u, 0u, 0u}; for (int idx = pl; idx < HY_ZBYTES / 16; idx += 128) *(LAS u32x4*)(lds + zb + idx * 16) = z; }
    __syncthreads();
    hy_load_row(lds, zb, 256, HY_ZSTRIDE, HYT + (size_t)c * NTOK, cw[0 * 3072 + c], cw[1 * 3072 + c], cw[2 * 3072 + c], cbv[c], pl);
    f32x16 acc[4];
#pragma unroll
    for (int o = 0; o < 2; ++o) {
        hy_load_filters(lds, fb, FR + (size_t)((o * 1024 + c) * 2) * 2048, pl);
        __syncthreads();
        hy_mfma_loop(lds, zb, fb, hlf, lane, acc, cc, o * 16, unit, wid);
        __syncthreads();
        const int gc = (1 + o) * 1024 + c;
        hy_load_row(lds, fb, 0, 2048, HYT + (size_t)gc * NTOK, cw[0 * 3072 + gc], cw[1 * 3072 + gc], cw[2 * 3072 + gc], cbv[gc], pl);
        __syncthreads();
        hy_epilogue(lds, zb, fb, hlf, lane, acc, hbias[o * HYW + c]);
        __syncthreads();
    }
#pragma unroll 2
    for (int it = 0; it < 8; ++it) { const int idx = pl + 128 * it, tok0 = idx * 8, b = tok0 >> 11, n0 = tok0 & 2047;
        *(u32x4*)(Z2T + (size_t)c * NTOK + tok0) = *(const LAS u32x4*)(lds + zb + (256 + b * HY_ZSTRIDE + n0) * 2); }
    __syncthreads();
}

constexpr int HG_RAWQ = 0, HG_RAWF = 16384, HG_RAWV = 32768;
constexpr int HG_QM = 36864, HG_KM = HG_QM + 17408, HG_QI = HG_KM + 17408;
constexpr int HG_KL = HG_QI + 17408;
constexpr int HG_VT = HG_KL + 18432;
constexpr int HG_P = HG_VT + 4608;
constexpr int HG_ST = HG_P + 9216;
constexpr int HG_TOT = HG_ST + 8704;
constexpr int HG_EL2 = HG_TOT + 4096;
constexpr int HG_LDS = HG_EL2 + 512;

__device__ __forceinline__ void hgrn_unit(LAS unsigned char* lds, int unit, const u16* __restrict__ PG, const float* __restrict__ lb_logits, float* __restrict__ OF, float* __restrict__ OB, const ConvCtx& cc) {
    const int tid = tid_fresh(), wid = __builtin_amdgcn_readfirstlane(tid >> 6), lane = tid & 63, fr = lane & 15, fq = lane >> 4;
    const int h = unit & 7, vq = (unit >> 3) & 3, dir = (unit >> 5) & 1, b = unit >> 6;
    const int k = tid & 127, seg = tid >> 7;
    float* __restrict__ O = dir ? OB : OF;
    for (int i = tid; i < 8704 / 16; i += 512) *(LAS u32x4*)(lds + HG_ST + i * 16) = (u32x4){0u, 0u, 0u, 0u};
    f32x4 Sacc[2];
    Sacc[0] = (f32x4){0.f, 0.f, 0.f, 0.f}; Sacc[1] = Sacc[0];
    u32x4 pq[2], pf[2], pv;
    const int colq = h * 128, colf = (1 + dir) * 1024 + h * 128, colv = 3072 + h * 128 + vq * 32;
#define HG_TOK(c, tau) ((size_t)b * SEQ + (dir ? (SEQ - 1 - 64 * (c) - (tau)) : (64 * (c) + (tau))))
#define HG_PREFETCH(c) do { _Pragma("unroll") for (int _i = 0; _i < 2; ++_i) { const int _x = tid + 512 * _i, _tau = _x >> 4, _p = _x & 15; const u16* _r = PG + HG_TOK(c, _tau) * 5120; \
            pq[_i] = *(const u32x4*)(_r + colq + _p * 8); pf[_i] = *(const u32x4*)(_r + colf + _p * 8); } \
        if (tid < 256) { const int _tau = tid >> 2, _p = tid & 3; pv = *(const u32x4*)(PG + HG_TOK(c, _tau) * 5120 + colv + _p * 8); } } while (0)
#define HG_RAW2LDS() do { _Pragma("unroll") for (int _i = 0; _i < 2; ++_i) { const int _x = tid + 512 * _i; *(LAS u32x4*)(lds + HG_RAWQ + _x * 16) = pq[_i]; *(LAS u32x4*)(lds + HG_RAWF + _x * 16) = pf[_i]; } \
        if (tid < 256) *(LAS u32x4*)(lds + HG_RAWV + tid * 16) = pv; } while (0)
    HG_PREFETCH(0);
    HG_RAW2LDS();
    HG_PREFETCH(1);
    __syncthreads();
    for (int c = 0; c < 32; ++c) {
        f32x2 cv[16];
        const int mqa = conv_seq2tile((32 + c * 2) * 256 + unit), mqb = conv_seq2tile((33 + c * 2) * 256 + unit);
        conv_issue(cc, mqa, wid, lane, cv);
        const int kp = lane, sg = wid;
        float qv0[8], qv1[8], kv0[8], kv1[8], bl0[8], bl1[8];
        { float r0 = 0.f, r1 = 0.f;
#pragma unroll
          for (int i = 0; i < 8; ++i) { const int tau = sg * 8 + i;
              const unsigned qw = *(const LAS unsigned*)(lds + HG_RAWQ + tau * 256 + kp * 4), fw = *(const LAS unsigned*)(lds + HG_RAWF + tau * 256 + kp * 4);
              const float l0 = bflo(fw), l1 = bfhi(fw);
              r0 += l0; r1 += l1; bl0[i] = r0; bl1[i] = r1; kv0[i] = 1.0f - __builtin_amdgcn_exp2f(l0); kv1[i] = 1.0f - __builtin_amdgcn_exp2f(l1); qv0[i] = bflo(qw); qv1[i] = bfhi(qw); }
          *(LAS f32x2*)(lds + HG_TOT + (sg * 128 + 2 * kp) * 4) = (f32x2){r0, r1}; }
        __syncthreads();
        { f32x2 tt[8];
#pragma unroll
          for (int q = 0; q < 8; ++q) tt[q] = *(const LAS f32x2*)(lds + HG_TOT + (q * 128 + 2 * kp) * 4);
          f32x2 pre = {0.f, 0.f};
#pragma unroll
          for (int q = 0; q < 7; ++q) if (q < sg) pre += tt[q];
          const f32x2 bref = tt[0] + tt[1] + tt[2] + tt[3], blast = bref + tt[4] + tt[5] + tt[6] + tt[7];
          const float er0 = __builtin_amdgcn_exp2f(bref[0]), er1 = __builtin_amdgcn_exp2f(bref[1]), el0 = __builtin_amdgcn_exp2f(blast[0] - bref[0]), el1 = __builtin_amdgcn_exp2f(blast[1] - bref[1]);
          if (sg == 0) *(LAS f32x2*)(lds + HG_EL2 + 2 * kp * 4) = (f32x2){__builtin_amdgcn_exp2f(blast[0]), __builtin_amdgcn_exp2f(blast[1])};
          const f32x2 dref = pre - bref;
          float kl0[8], kl1[8];
#pragma unroll
          for (int i = 0; i < 8; ++i) { const int tau = sg * 8 + i; const float x0 = dref[0] + bl0[i], x1 = dref[1] + bl1[i];
              const float qm0 = qv0[i] * __builtin_amdgcn_exp2f(x0), qm1 = qv1[i] * __builtin_amdgcn_exp2f(x1), km0 = kv0[i] * __builtin_amdgcn_exp2f(-x0), km1 = kv1[i] * __builtin_amdgcn_exp2f(-x1);
              *(LAS unsigned*)(lds + HG_QM + tau * 272 + kp * 4) = pk_bf16(qm0, qm1);
              *(LAS unsigned*)(lds + HG_KM + tau * 272 + kp * 4) = pk_bf16(km0, km1);
              *(LAS unsigned*)(lds + HG_QI + tau * 272 + kp * 4) = pk_bf16(qm0 * er0, qm1 * er1);
              kl0[i] = km0 * el0; kl1[i] = km1 * el1; }
          *(LAS u32x4*)(lds + HG_KL + (2 * kp) * 144 + sg * 16) = (u32x4){pk_bf16(kl0[0], kl0[1]), pk_bf16(kl0[2], kl0[3]), pk_bf16(kl0[4], kl0[5]), pk_bf16(kl0[6], kl0[7])};
          *(LAS u32x4*)(lds + HG_KL + (2 * kp + 1) * 144 + sg * 16) = (u32x4){pk_bf16(kl1[0], kl1[1]), pk_bf16(kl1[2], kl1[3]), pk_bf16(kl1[4], kl1[5]), pk_bf16(kl1[6], kl1[7])};
          { const int v = tid & 31, tg = tid >> 5; unsigned short e[4];
#pragma unroll
            for (int u = 0; u < 4; ++u) e[u] = *(const LAS u16*)(lds + HG_RAWV + (tg * 4 + u) * 64 + v * 2);
            *(LAS u32x2*)(lds + HG_VT + v * 144 + tg * 8) = (u32x2){(unsigned)e[0] | ((unsigned)e[1] << 16), (unsigned)e[2] | ((unsigned)e[3] << 16)}; } }
        conv_finish(cc, mqa, wid, lane, cv);
        conv_issue(cc, mqb, wid, lane, cv);
        __syncthreads();
        if (c + 1 < 32) { HG_RAW2LDS(); if (c + 2 < 32) HG_PREFETCH(c + 2); }
#pragma unroll
        for (int q = 0; q < 2; ++q) { const int idx = wid * 2 + q, ti = idx >> 2, si = idx & 3;
            f32x4 a = {0.f, 0.f, 0.f, 0.f};
            if (si <= ti) {
#pragma unroll
                for (int ks = 0; ks < 4; ++ks) { const bf16x8 ka = *(const LAS bf16x8*)(lds + HG_KM + (si * 16 + fr) * 272 + (ks * 32 + fq * 8) * 2), qb = *(const LAS bf16x8*)(lds + HG_QM + (ti * 16 + fr) * 272 + (ks * 32 + fq * 8) * 2);
                    a = __builtin_amdgcn_mfma_f32_16x16x32_bf16(ka, qb, a, 0, 0, 0); } }
            const int tau = ti * 16 + fr, s0 = si * 16 + fq * 4;
            float pvv[4];
#pragma unroll
            for (int j = 0; j < 4; ++j) pvv[j] = (si <= ti && s0 + j <= tau) ? a[j] : 0.f;
            *(LAS u32x2*)(lds + HG_P + tau * 144 + s0 * 2) = (u32x2){pk_bf16(pvv[0], pvv[1]), pk_bf16(pvv[2], pvv[3])}; }
        const int ti = wid >> 1, vi = wid & 1;
        f32x4 oacc = {0.f, 0.f, 0.f, 0.f};
#pragma unroll
        for (int ks = 0; ks < 4; ++ks) { const bf16x8 qa = *(const LAS bf16x8*)(lds + HG_QI + (ti * 16 + fr) * 272 + (ks * 32 + fq * 8) * 2), sb = *(const LAS bf16x8*)(lds + HG_ST + (vi * 16 + fr) * 272 + (ks * 32 + fq * 8) * 2);
            oacc = __builtin_amdgcn_mfma_f32_16x16x32_bf16(qa, sb, oacc, 0, 0, 0); }
        { const f32x4 e2 = *(const LAS f32x4*)(lds + HG_EL2 + (wid * 16 + fq * 4) * 4);
#pragma unroll
          for (int v2 = 0; v2 < 2; ++v2) { Sacc[v2] = Sacc[v2] * e2;
#pragma unroll
              for (int ks = 0; ks < 2; ++ks) { const bf16x8 ka = *(const LAS bf16x8*)(lds + HG_KL + (wid * 16 + fr) * 144 + (ks * 32 + fq * 8) * 2), vb = *(const LAS bf16x8*)(lds + HG_VT + (v2 * 16 + fr) * 144 + (ks * 32 + fq * 8) * 2);
                  Sacc[v2] = __builtin_amdgcn_mfma_f32_16x16x32_bf16(ka, vb, Sacc[v2], 0, 0, 0); } } }
        __syncthreads();
#pragma unroll
        for (int ks = 0; ks < 2; ++ks) { const bf16x8 pa = *(const LAS bf16x8*)(lds + HG_P + (ti * 16 + fr) * 144 + (ks * 32 + fq * 8) * 2), vb = *(const LAS bf16x8*)(lds + HG_VT + (vi * 16 + fr) * 144 + (ks * 32 + fq * 8) * 2);
            oacc = __builtin_amdgcn_mfma_f32_16x16x32_bf16(pa, vb, oacc, 0, 0, 0); }
#pragma unroll
        for (int j = 0; j < 4; ++j) { const int tau = ti * 16 + fq * 4 + j; O[HG_TOK(c, tau) * HGW + h * 128 + vq * 32 + vi * 16 + fr] = oacc[j]; }
        conv_finish(cc, mqb, wid, lane, cv);
#pragma unroll
        for (int v2 = 0; v2 < 2; ++v2) *(LAS u32x2*)(lds + HG_ST + (v2 * 16 + fr) * 272 + (wid * 16 + fq * 4) * 2) = (u32x2){pk_bf16(Sacc[v2][0], Sacc[v2][1]), pk_bf16(Sacc[v2][2], Sacc[v2][3])};
    }
    __syncthreads();
#undef HG_TOK
#undef HG_PREFETCH
#undef HG_RAW2LDS
}


#define XB_TMO      128
#define XB_XCNT(j)  (256  + 64 * (j))
#define XB_XSUB(j)  (1280 + 64 * (j))
#define XB_XGEN(j)  (2304 + 64 * (j))
#define XB_TOP      3328
#define XB_TOPGEN   3392
#define XCD_BAR_WORDS 3456
#define XB_SPIN_CAP (1u << 22)

__device__ __forceinline__ unsigned xb_ld(unsigned* p)              { return __hip_atomic_load(p, __ATOMIC_RELAXED, __HIP_MEMORY_SCOPE_AGENT); }
__device__ __forceinline__ unsigned xb_add(unsigned* p, unsigned v) { return __hip_atomic_fetch_add(p, v, __ATOMIC_RELAXED, __HIP_MEMORY_SCOPE_AGENT); }
__device__ __forceinline__ unsigned xb_xcc_id() { return (unsigned)__builtin_amdgcn_s_getreg((3 << 11) | 20) & 0xFu; }
#define XB_SPIN(cond, bar) do { unsigned _sp = 0; while (cond) { __builtin_amdgcn_s_sleep(1); \
    if ((++_sp & 255u) == 0u) { if (xb_ld(&(bar)[XB_TMO])) break; if (_sp > XB_SPIN_CAP) { atomicAdd(&(bar)[XB_TMO], 1u); break; } } } } while (0)

struct XcdBarrier {
    unsigned* bar; unsigned x;
    volatile LAS unsigned* st;
};

__device__ __forceinline__ XcdBarrier xcd_barrier_post(unsigned* bar, volatile LAS unsigned* st) {
    XcdBarrier b; b.bar = bar; b.x = xb_xcc_id(); b.st = st;
    if (threadIdx.x == 0) (void)xb_add(&bar[XB_XCNT(b.x)], 1u);
    return b;
}
__device__ __forceinline__ void xcd_barrier_complete(unsigned* bar, unsigned x, unsigned& nloc, unsigned& nx) {
    const unsigned G = gridDim.x * gridDim.y * gridDim.z;
    unsigned sum, cnt, mine, sp = 0u;
    for (;;) {
        sum = 0u; cnt = 0u; mine = 0u;
#pragma unroll
        for (unsigned j = 0; j < 16; ++j) { const unsigned c = xb_ld(&bar[XB_XCNT(j)]); sum += c; cnt += (c > 0u) ? 1u : 0u; mine = (j == x) ? c : mine; }
        if (sum == G) break;
        __builtin_amdgcn_s_sleep(1);
        if ((++sp & 255u) == 0u) { if (xb_ld(&bar[XB_TMO])) break; if (sp > XB_SPIN_CAP) { atomicAdd(&bar[XB_TMO], 1u); break; } }
    }
    nloc = mine > 0u ? mine : 1u; nx = cnt > 0u ? cnt : 1u;
}

__device__ __forceinline__ void xcd_barrier(const XcdBarrier& b) {
    asm volatile("s_waitcnt vmcnt(0)" ::: "memory");
    __syncthreads();
    if (threadIdx.x == 0) {
        unsigned* bar = b.bar;
        __builtin_amdgcn_s_waitcnt(0);
        unsigned nloc = b.st[0], nx = b.st[1];
        if (nloc == 0u) { xcd_barrier_complete(bar, b.x, nloc, nx); b.st[0] = nloc; b.st[1] = nx; }
        const unsigned old = xb_add(&bar[XB_XSUB(b.x)], 1u);
        const unsigned gen = old / nloc;
        if (old + 1u == (gen + 1u) * nloc) {
            __builtin_amdgcn_fence(__ATOMIC_RELEASE, "agent");
            asm volatile("s_waitcnt vmcnt(0)" ::: "memory");
            const unsigned og = xb_add(&bar[XB_TOP], 1u);
            const unsigned tg = og / nx;
            if (og + 1u == (tg + 1u) * nx) xb_add(&bar[XB_TOPGEN], 1u);
            else XB_SPIN(xb_ld(&bar[XB_TOPGEN]) == tg, bar);
            __builtin_amdgcn_fence(__ATOMIC_ACQUIRE, "agent");
            xb_add(&bar[XB_XGEN(b.x)], 1u);
            asm volatile("s_waitcnt vmcnt(0)" ::: "memory");
        } else {
            XB_SPIN(xb_ld(&bar[XB_XGEN(b.x)]) == gen, bar);
            __builtin_amdgcn_fence(__ATOMIC_ACQUIRE, "agent");
            asm volatile("s_waitcnt vmcnt(0)" ::: "memory");
        }
    }
    __syncthreads();
}

__device__ __forceinline__ float wave_sum(float s) {
#pragma unroll
    for (int o = 32; o >= 1; o >>= 1) s += __shfl_xor(s, o);
    return s;
}
__device__ __forceinline__ void rmsnorm_row_bf(const float* __restrict__ xr, const float* __restrict__ gain, u16* __restrict__ ob, unsigned char* __restrict__ ob8, int lane) {
    f32x4 v[8]; float s = 0.f;
#pragma unroll
    for (int j = 0; j < 8; ++j) { v[j] = *(const f32x4*)(xr + (lane + 64 * j) * 4); s += v[j][0] * v[j][0] + v[j][1] * v[j][1] + v[j][2] * v[j][2] + v[j][3] * v[j][3]; }
    s = wave_sum(s);
    const float r = rsqrtf(s * (1.0f / (float)DM) + EPS);
#pragma unroll
    for (int j = 0; j < 8; ++j) { const f32x4 g = *(const f32x4*)(gain + (lane + 64 * j) * 4); const f32x4 o = v[j] * r * g;
        *(u32x2*)(ob + (lane + 64 * j) * 4) = (u32x2){pk_bf16(o[0], o[1]), pk_bf16(o[2], o[3])};
        *(unsigned*)(ob8 + (lane + 64 * j) * 4) = pk_fp8x4(o[0], o[1], o[2], o[3]); }
}
__device__ __forceinline__ void hgrn_final_item4(int item0, int stride, const float* __restrict__ OF, const float* __restrict__ OB, const u16* __restrict__ PG, const float* __restrict__ gain, u16* __restrict__ MIXB, int lane) {
    f32x2 a[4], b[4]; unsigned gw[4];
#pragma unroll
    for (int q = 0; q < 4; ++q) { const int item = item0 + q * stride, tok = item >> 3, c = (item & 7) * 128 + 2 * lane;
        a[q] = *(const f32x2*)(OF + (size_t)tok * HGW + c); b[q] = *(const f32x2*)(OB + (size_t)tok * HGW + c); gw[q] = *(const unsigned*)(PG + (size_t)tok * 5120 + 4096 + c); }
#pragma unroll
    for (int q = 0; q < 4; ++q) { const int item = item0 + q * stride, tok = item >> 3, c = (item & 7) * 128 + 2 * lane;
        const float o0 = a[q][0] + b[q][0], o1 = a[q][1] + b[q][1];
        const float s = wave_sum(o0 * o0 + o1 * o1);
        const float r = rsqrtf(s * (1.0f / 128.0f) + EPS);
        const float g0 = bflo(gw[q]), g1 = bfhi(gw[q]);
        const f32x2 gn = *(const f32x2*)(gain + c);
        const float v0 = o0 * r * gn[0] * (g0 * __builtin_amdgcn_rcpf(1.0f + __expf(-g0))), v1 = o1 * r * gn[1] * (g1 * __builtin_amdgcn_rcpf(1.0f + __expf(-g1)));
        *(u16*)((unsigned char*)MIXB + (size_t)tok * DM + c) = (u16)(__builtin_amdgcn_cvt_pk_fp8_f32(v0, v1, 0, false) & 0xffff); }
}
__device__ __forceinline__ void hy_norm_tile(LAS unsigned char* lds, int tile_i, const u16* __restrict__ Z2T, const float* __restrict__ gain, u16* __restrict__ MIXB) {
    const int t = tid_fresh(), tok0 = tile_i * 32;
    LAS float* ssq = (LAS float*)(lds + 1024 * 80);
    if (t < 32) ssq[t] = 0.f;
    __syncthreads();
    float part[8];
#pragma unroll
    for (int q = 0; q < 8; ++q) part[q] = 0.f;
    const int ch = t & 3;
#pragma unroll
    for (int it = 0; it < 8; ++it) {
        const int c = (t >> 2) + 128 * it;
        const u32x4 v = *(const u32x4*)(Z2T + (size_t)c * NTOK + tok0 + ch * 8);
        *(LAS u32x4*)(lds + c * 80 + ch * 16) = v;
#pragma unroll
        for (int q = 0; q < 4; ++q) { const float a = bflo(v[q]), b = bfhi(v[q]); part[2 * q] += a * a; part[2 * q + 1] += b * b; }
    }
#pragma unroll
    for (int q = 0; q < 8; ++q) { float s = part[q]; s += __shfl_xor(s, 4); s += __shfl_xor(s, 8); s += __shfl_xor(s, 16); s += __shfl_xor(s, 32); part[q] = s; }
    if ((t & 63) < 4) {
#pragma unroll
        for (int q = 0; q < 8; ++q) atomicAdd((float*)(ssq + ch * 8 + q), part[q]);
    }
    __syncthreads();
    const int tt = t >> 4;
    const float r = rsqrtf(ssq[tt] * (1.0f / (float)HYW) + EPS);
#pragma unroll 2
    for (int k = 0; k < 8; ++k) {
        const int c0 = ((t & 15) + 16 * k) * 8;
        float o[8];
#pragma unroll
        for (int q = 0; q < 8; ++q) o[q] = bf2f(*(const LAS u16*)(lds + (c0 + q) * 80 + tt * 2)) * r * gain[c0 + q];
        *(u32x2*)((unsigned char*)MIXB + (size_t)(tok0 + tt) * DM + 1024 + c0) = (u32x2){pk_fp8x4(o[0], o[1], o[2], o[3]), pk_fp8x4(o[4], o[5], o[6], o[7])};
    }
    __syncthreads();
}
constexpr int RT_XSTRIDE = 2049;
constexpr int RT_PART = 16 * RT_XSTRIDE * 4;
constexpr int RT_LG = RT_PART + 8 * 16 * 32 * 4;
constexpr int RT_HIST = RT_LG + 16 * 32 * 4;
constexpr int RT_ITEMS = RT_HIST + 128;
constexpr int RT_RBASE = RT_ITEMS + 512;
constexpr int RT_END = RT_RBASE + 128;
__device__ __forceinline__ void router_tile(LAS unsigned char* lds, int tile_i, const float* __restrict__ X1, const float* __restrict__ gain, const float* __restrict__ wr, const float* __restrict__ br,
                                            unsigned char* __restrict__ XN8, float* __restrict__ TOPG, int tl2, const float (&bw)[128]) {
    const int tid = tid_fresh(), wid = __builtin_amdgcn_readfirstlane(tid >> 6), lane = tid & 63;
    const int tok0 = tile_i * 16;
    LAS float* xs = (LAS float*)lds;
#pragma unroll
    for (int q = 0; q < 2; ++q) {
        const int tl = wid * 2 + q; const size_t tok = (size_t)tok0 + tl;
        const float* xr = X1 + tok * DM;
        f32x4 v[8]; float s = 0.f;
#pragma unroll
        for (int j = 0; j < 8; ++j) { v[j] = *(const f32x4*)(xr + (lane + 64 * j) * 4); s += v[j][0] * v[j][0] + v[j][1] * v[j][1] + v[j][2] * v[j][2] + v[j][3] * v[j][3]; }
        s = wave_sum(s);
        const float r = rsqrtf(s * (1.0f / (float)DM) + EPS);
#pragma unroll
        for (int j = 0; j < 8; ++j) { const int d = (lane + 64 * j) * 4; const f32x4 g = *(const f32x4*)(gain + d); const f32x4 o = v[j] * r * g;
            xs[tl * RT_XSTRIDE + d + 0] = o[0]; xs[tl * RT_XSTRIDE + d + 1] = o[1]; xs[tl * RT_XSTRIDE + d + 2] = o[2]; xs[tl * RT_XSTRIDE + d + 3] = o[3];
            *(unsigned*)(XN8 + tok * DM + d) = pk_fp8x4(o[0], o[1], o[2], o[3]); }
    }
    __syncthreads();
    {
        const int tl = lane & 15, kk = lane >> 4;
        f32x4 a0 = {0.f, 0.f, 0.f, 0.f}, a1 = a0;
        const LAS float* xp = xs + tl * RT_XSTRIDE + wid * 256 + kk;
#pragma unroll
        for (int ks = 0; ks < 64; ++ks) { const float a = xp[ks * 4];
            a0 = __builtin_amdgcn_mfma_f32_16x16x4f32(a, bw[2 * ks], a0, 0, 0, 0); a1 = __builtin_amdgcn_mfma_f32_16x16x4f32(a, bw[2 * ks + 1], a1, 0, 0, 0); }
        LAS float* pp = (LAS float*)(lds + RT_PART) + wid * 512;
#pragma unroll
        for (int j = 0; j < 4; ++j) { pp[(kk * 4 + j) * 32 + tl] = a0[j]; pp[(kk * 4 + j) * 32 + 16 + tl] = a1[j]; }
    }
    __syncthreads();
    {   const LAS float* pp = (const LAS float*)(lds + RT_PART); float s = br[tid & 31];
#pragma unroll
        for (int w = 0; w < 8; ++w) s += pp[w * 512 + tid];
        ((LAS float*)(lds + RT_LG))[tid] = s; }
    __syncthreads();
    if (tid < 16) {
        LAS float* lg = (LAS float*)(lds + RT_LG) + tid * 32;
        int i0 = 0, i1 = 0, i2 = 0, i3 = 0; float v0, v1, v2, v3;
        { float bv = -3.0e38f; for (int j = 0; j < NE; ++j) { const float l = lg[j]; if (l > bv) { bv = l; i0 = j; } } v0 = bv; lg[i0] = -3.4e38f; }
        { float bv = -3.0e38f; for (int j = 0; j < NE; ++j) { const float l = lg[j]; if (l > bv) { bv = l; i1 = j; } } v1 = bv; lg[i1] = -3.4e38f; }
        { float bv = -3.0e38f; for (int j = 0; j < NE; ++j) { const float l = lg[j]; if (l > bv) { bv = l; i2 = j; } } v2 = bv; lg[i2] = -3.4e38f; }
        { float bv = -3.0e38f; for (int j = 0; j < NE; ++j) { const float l = lg[j]; if (l > bv) { bv = l; i3 = j; } } v3 = bv; lg[i3] = -3.4e38f; }
        const float e1 = __expf(v1 - v0), e2 = __expf(v2 - v0), e3 = __expf(v3 - v0), inv = 1.0f / (1.0f + e1 + e2 + e3);
        const int tok = tok0 + tid;
        *(f32x4*)(TOPG + tok * 4) = (f32x4){inv, e1 * inv, e2 * inv, e3 * inv};
        LAS int* hist = (LAS int*)(lds + RT_HIST);
        const int p0 = atomicAdd((int*)(hist + i0), 1), p1 = atomicAdd((int*)(hist + i1), 1), p2 = atomicAdd((int*)(hist + i2), 1), p3 = atomicAdd((int*)(hist + i3), 1);
        *(LAS u32x4*)(lds + RT_ITEMS + (tl2 * 16 + tid) * 16) = (u32x4){(unsigned)((i0 << 16) | p0), (unsigned)((i1 << 16) | p1), (unsigned)((i2 << 16) | p2), (unsigned)((i3 << 16) | p3)};
    }
    __syncthreads();
}
__device__ __forceinline__ void combine_row(int tok, const float* __restrict__ X1, const u16* __restrict__ YB, const int* __restrict__ SOF, const float* __restrict__ TOPG, const float* __restrict__ gain, float* __restrict__ out, int lane) {
    const int4 sl = *(const int4*)(SOF + tok * 4); const f32x4 g = *(const f32x4*)(TOPG + tok * 4);
    const u16* y0 = YB + (size_t)sl.x * DM; const u16* y1 = YB + (size_t)sl.y * DM; const u16* y2 = YB + (size_t)sl.z * DM; const u16* y3 = YB + (size_t)sl.w * DM;
    f32x4 v[8]; float s = 0.f;
#pragma unroll
    for (int j = 0; j < 8; ++j) { const int d = (lane + 64 * j) * 4;
        f32x4 a = *(const f32x4*)(X1 + (size_t)tok * DM + d);
        const u32x2 q0 = *(const u32x2*)(y0 + d), q1 = *(const u32x2*)(y1 + d), q2 = *(const u32x2*)(y2 + d), q3 = *(const u32x2*)(y3 + d);
        a[0] += g[0] * bflo(q0[0]) + g[1] * bflo(q1[0]) + g[2] * bflo(q2[0]) + g[3] * bflo(q3[0]);
        a[1] += g[0] * bfhi(q0[0]) + g[1] * bfhi(q1[0]) + g[2] * bfhi(q2[0]) + g[3] * bfhi(q3[0]);
        a[2] += g[0] * bflo(q0[1]) + g[1] * bflo(q1[1]) + g[2] * bflo(q2[1]) + g[3] * bflo(q3[1]);
        a[3] += g[0] * bfhi(q0[1]) + g[1] * bfhi(q1[1]) + g[2] * bfhi(q2[1]) + g[3] * bfhi(q3[1]);
        v[j] = a; s += a[0] * a[0] + a[1] * a[1] + a[2] * a[2] + a[3] * a[3]; }
    s = wave_sum(s);
    const float r = rsqrtf(s * (1.0f / (float)DM) + EPS);
#pragma unroll
    for (int j = 0; j < 8; ++j) { const int d = (lane + 64 * j) * 4; const f32x4 gn = *(const f32x4*)(gain + d); *(f32x4*)(out + (size_t)tok * DM + d) = v[j] * r * gn; }
}

__device__ __forceinline__ void combine_row2(int tokA, int tokB, const float* __restrict__ X1, const u16* __restrict__ YB, const int* __restrict__ SOF, const float* __restrict__ TOPG, const float* __restrict__ gain, float* __restrict__ out, int lane) {
    const int4 slA = *(const int4*)(SOF + tokA * 4), slB = *(const int4*)(SOF + tokB * 4); const f32x4 gA = *(const f32x4*)(TOPG + tokA * 4), gB = *(const f32x4*)(TOPG + tokB * 4);
    const u16* yA0 = YB + (size_t)slA.x * DM; const u16* yA1 = YB + (size_t)slA.y * DM; const u16* yA2 = YB + (size_t)slA.z * DM; const u16* yA3 = YB + (size_t)slA.w * DM;
    const u16* yB0 = YB + (size_t)slB.x * DM; const u16* yB1 = YB + (size_t)slB.y * DM; const u16* yB2 = YB + (size_t)slB.z * DM; const u16* yB3 = YB + (size_t)slB.w * DM;
    f32x4 vA[8], vB[8]; float sA = 0.f, sB = 0.f;
#pragma unroll
    for (int j = 0; j < 8; ++j) { const int d = (lane + 64 * j) * 4;
        f32x4 a = *(const f32x4*)(X1 + (size_t)tokA * DM + d), b = *(const f32x4*)(X1 + (size_t)tokB * DM + d);
        const u32x2 p0 = *(const u32x2*)(yA0 + d), p1 = *(const u32x2*)(yA1 + d), p2 = *(const u32x2*)(yA2 + d), p3 = *(const u32x2*)(yA3 + d);
        const u32x2 q0 = *(const u32x2*)(yB0 + d), q1 = *(const u32x2*)(yB1 + d), q2 = *(const u32x2*)(yB2 + d), q3 = *(const u32x2*)(yB3 + d);
        a[0] += gA[0] * bflo(p0[0]) + gA[1] * bflo(p1[0]) + gA[2] * bflo(p2[0]) + gA[3] * bflo(p3[0]);
        a[1] += gA[0] * bfhi(p0[0]) + gA[1] * bfhi(p1[0]) + gA[2] * bfhi(p2[0]) + gA[3] * bfhi(p3[0]);
        a[2] += gA[0] * bflo(p0[1]) + gA[1] * bflo(p1[1]) + gA[2] * bflo(p2[1]) + gA[3] * bflo(p3[1]);
        a[3] += gA[0] * bfhi(p0[1]) + gA[1] * bfhi(p1[1]) + gA[2] * bfhi(p2[1]) + gA[3] * bfhi(p3[1]);
        b[0] += gB[0] * bflo(q0[0]) + gB[1] * bflo(q1[0]) + gB[2] * bflo(q2[0]) + gB[3] * bflo(q3[0]);
        b[1] += gB[0] * bfhi(q0[0]) + gB[1] * bfhi(q1[0]) + gB[2] * bfhi(q2[0]) + gB[3] * bfhi(q3[0]);
        b[2] += gB[0] * bflo(q0[1]) + gB[1] * bflo(q1[1]) + gB[2] * bflo(q2[1]) + gB[3] * bflo(q3[1]);
        b[3] += gB[0] * bfhi(q0[1]) + gB[1] * bfhi(q1[1]) + gB[2] * bfhi(q2[1]) + gB[3] * bfhi(q3[1]);
        vA[j] = a; vB[j] = b; sA += a[0] * a[0] + a[1] * a[1] + a[2] * a[2] + a[3] * a[3]; sB += b[0] * b[0] + b[1] * b[1] + b[2] * b[2] + b[3] * b[3]; }
    sA = wave_sum(sA); sB = wave_sum(sB);
    const float rA = rsqrtf(sA * (1.0f / (float)DM) + EPS), rB = rsqrtf(sB * (1.0f / (float)DM) + EPS);
#pragma unroll
    for (int j = 0; j < 8; ++j) { const int d = (lane + 64 * j) * 4; const f32x4 gn = *(const f32x4*)(gain + d);
        *(f32x4*)(out + (size_t)tokA * DM + d) = vA[j] * rA * gn; *(f32x4*)(out + (size_t)tokB * DM + d) = vB[j] * rB * gn; }
}
#ifndef REP_P9
#define REP_P9 1
#endif
#ifndef REP_P3
#define REP_P3 1
#endif
#ifndef REP_FR
#define REP_FR 1
#endif
#ifndef REP_P0
#define REP_P0 1
#endif
#ifndef REP_CONV
#define REP_CONV 1
#endif
#ifndef REP_GEMM1
#define REP_GEMM1 1
#endif
#ifndef REP_HY
#define REP_HY 1
#endif
#ifndef REP_HG
#define REP_HG 1
#endif
#ifndef REP_MOEA
#define REP_MOEA 1
#endif
#ifndef REP_MOEB
#define REP_MOEB 1
#endif
#ifndef REP_WOUT
#define REP_WOUT 1
#endif
struct MegaP {
    const float *x, *norm_mix_gain, *w_in, *lb_logits, *hgrn_norm_gain, *hy_conv_w, *hy_conv_b, *fw1, *fb1, *fw2, *fb2, *fw3, *fb3, *fw4, *ffreq, *hy_bias, *hy_norm_gain, *w_out,
        *norm_ffn_gain, *w_router, *b_router, *moe_w1, *moe_b1, *moe_w2, *moe_b2, *final_gain;
    float* out; unsigned char* ws;
};
constexpr int MEGA_XB = RT_END;
constexpr int MEGA_LDS = RT_END + 64 + 384;
static_assert(MEGA_LDS >= HY_LDS + 64 && MEGA_LDS >= HG_LDS + 64 && MEGA_LDS >= GEMM_LDS + 64, "LDS");

__global__ void __launch_bounds__(512, 2) k_mega(const MegaP p_arg) {
    extern __shared__ __attribute__((aligned(16))) unsigned char shm[];
    LAS unsigned char* lds = (LAS unsigned char*)shm;
    const int tid = threadIdx.x, wid = __builtin_amdgcn_readfirstlane(tid >> 6), lane = tid & 63;
    const int G = gridDim.x, bid = blockIdx.x, c = xcd_logical(bid, G);
#define PHASE_ARGS() const MegaP __attribute__((address_space(4)))* pq_ = (const MegaP __attribute__((address_space(4)))*)__builtin_amdgcn_kernarg_segment_ptr(); asm volatile("" : "+s"(pq_)); unsigned char* ws = pq_->ws; (void)ws
    unsigned char* ws0; { PHASE_ARGS(); ws0 = ws; }
#define counts ((int*)(ws + WS_CTL))
#define cursor ((int*)(ws + WS_CTL + 4096))
#define offs ((int*)(ws + WS_CTL + 8192))
#define barw ((unsigned*)(ws + WS_CTL + 16384))
#define HB ((u16*)(ws + WS_HB))
#define PG ((u16*)(ws + WS_PG))
#define HYT ((u16*)(ws + WS_HYT))
#define MIXB ((u16*)(ws + WS_MIXB))
#define XNB ((u16*)(ws + WS_XNB))
#define HMB ((u16*)(ws + WS_HMS))
#define YB ((u16*)(ws + WS_YS))
#define H3 ((float*)(ws + WS_H3))
#define FR ((u16*)(ws + WS_FR))
#define Z2T ((u16*)(ws + WS_Z2T))
#define OF ((float*)(ws + WS_OF))
#define OB ((float*)(ws + WS_OB))
#define X1 ((float*)(ws + WS_X1))
#define TOPI ((int*)(ws + WS_TOPI))
#define TOPG ((float*)(ws + WS_TOPG))
#define STOK ((int*)(ws + WS_STOKS))
#define SOF ((int*)(ws + WS_SOF))
#define WINT ((u16*)(ws + WS_WINT))
#define WOUTT ((u16*)(ws + WS_WOUTT))
#define W1T ((u16*)(ws + WS_W1T))
#define W2T ((u16*)(ws + WS_W2T))
    if (tid == 0) *(LAS u32x4*)(lds + MEGA_XB) = (u32x4){0u, 0u, 0u, 0u};
    __syncthreads();
    XcdBarrier bar = xcd_barrier_post((unsigned*)(ws0 + WS_CTL + 16384), (volatile LAS unsigned*)(lds + MEGA_XB));

    {
        PHASE_ARGS();
        const int tid = tid_fresh(), wid = __builtin_amdgcn_readfirstlane(tid >> 6), lane = tid & 63; (void)wid; (void)lane;
    for (int rep = 0; rep < REP_P0; ++rep) {
    for (int row = bid * 8 + wid; row < NTOK; row += G * 8) rmsnorm_row_bf(pq_->x + (size_t)row * DM, pq_->norm_mix_gain, HB + (size_t)row * DM, (unsigned char*)XNB + (size_t)row * DM, lane);
    for (int m = bid * 8 + wid; m < SEQ; m += G * 8) h3_row(m, pq_->fw1, pq_->fb1, pq_->fw2, pq_->fb2, pq_->fw3, pq_->fb3, pq_->ffreq, (LAS float*)(lds + wid * 512), H3); }
    for (int rep = 0; rep < REP_CONV; ++rep)
    for (int id = bid; id < 1024 + 256; id += G) {
        const int tz = tid_fresh();
        if (id < 640) { f32x2 cv[16]; conv_issue_win(pq_->w_in, id, tz >> 6, tz & 63, cv); conv_finish_win((unsigned char*)WINT, id, tz >> 6, tz & 63, cv); }
        else if (id < 1024) { const int nt = id >> 5, kt = id & 31; convert_tile(pq_->w_in, DIN, kt * 64, ColMapPerm{nt * 256}, WINT + (size_t)id * 16384, tz); }
        else { const int q = id - 1024; const ConvCtx cw{nullptr, pq_->w_out, nullptr, (unsigned char*)WOUTT};
            f32x2 cv[16]; conv_issue(cw, 16384 + q, tz >> 6, tz & 63, cv); conv_finish(cw, 16384 + q, tz >> 6, tz & 63, cv); }
    }
    }
    xcd_barrier(bar);
    {
        PHASE_ARGS();
        const int tid = tid_fresh(), wid = __builtin_amdgcn_readfirstlane(tid >> 6), lane = tid & 63; (void)wid; (void)lane;
    for (int rep = 0; rep < REP_FR; ++rep)
    for (int item = bid; item < 256; item += G) frgen_item(lds, item, H3, pq_->fw4, FR);
    { SrcG1<false> s0{c, G, (const char*)XNB, (const char*)WINT, PG, HYT, pq_->lb_logits, 16}; gemm8_stream<false, true>(lds, DM / 2, 16, s0);
      SrcG1<true> s1{c, G, (const char*)HB, (const char*)WINT, PG, HYT, pq_->lb_logits, 32}; gemm8_stream<true, false>(lds, DM, 32, s1); }
#ifdef PROBE_NOEPI
    for (int u = c; u < 1024; u += G) {
        const int i = u >> 8, xx = (u >> 5) & 7, j = u & 31;
        const int mt = (xx & 3) * 8 + (j & 7), nt = ((xx >> 2) + 2 * i) * 4 + (j >> 3);
        const u16* bt = WINT + (size_t)nt * 32 * 16384;
        EpiNone e{}; if (nt < 20) gemm8_unit<false>(lds, HB, DM, nullptr, mt * 256, 256, bt, 32, e); else gemm8_unit<true>(lds, HB, DM, nullptr, mt * 256, 256, bt, 32, e);
    }
#endif
    }
    xcd_barrier(bar);
    {
        PHASE_ARGS();
        const int tid = tid_fresh(), wid = __builtin_amdgcn_readfirstlane(tid >> 6), lane = tid & 63; (void)wid; (void)lane;
    for (int rep = 0; rep < REP_HY; ++rep)
    for (int u = bid; u < 256; u += G) hyena_unit(lds, u, HYT, FR, pq_->hy_conv_w, pq_->hy_conv_b, pq_->hy_bias, Z2T, ConvCtx{pq_->moe_w1, pq_->moe_w2, (unsigned char*)W1T, (unsigned char*)W2T});
    for (int rep = 0; rep < REP_HG; ++rep)
    for (int u = bid; u < 256; u += G) hgrn_unit(lds, u, PG, pq_->lb_logits, OF, OB, ConvCtx{pq_->moe_w1, pq_->moe_w2, (unsigned char*)W1T, (unsigned char*)W2T});
    }
    xcd_barrier(bar);
    {
        PHASE_ARGS();
        const int tid = tid_fresh(), wid = __builtin_amdgcn_readfirstlane(tid >> 6), lane = tid & 63; (void)wid; (void)lane;
    for (int rep = 0; rep < REP_P3; ++rep) {
    for (int it = bid * 8 + wid; it < NTOK * HGH; it += G * 8 * 4) hgrn_final_item4(it, G * 8, OF, OB, PG, pq_->hgrn_norm_gain, MIXB, lane);
    for (int t = bid; t < NTOK / 32; t += G) hy_norm_tile(lds, t, Z2T, pq_->hy_norm_gain, MIXB); }
    }
    xcd_barrier(bar);
    {
        PHASE_ARGS();
        const int tid = tid_fresh(), wid = __builtin_amdgcn_readfirstlane(tid >> 6), lane = tid & 63; (void)wid; (void)lane;
    for (int u = c; u < 256; u += G) {
        const int xx = u >> 5, j = u & 31;
        const int mt = (xx >> 1) * 8 + (j & 7), nt = (xx & 1) * 4 + (j >> 3);
        Epi8X1 e{pq_->x, X1, mt * 256, nt * 256};
        gemm8_unit<false, true>(lds, MIXB, DM / 2, nullptr, mt * 256, 256, WOUTT + (size_t)nt * 16 * 16384, 16, e);
    }
    }
    xcd_barrier(bar);
    {
        PHASE_ARGS();
        const int tid = tid_fresh(), wid = __builtin_amdgcn_readfirstlane(tid >> 6), lane = tid & 63; (void)wid; (void)lane;
    if (tid < NE) *(LAS int*)(lds + RT_HIST + tid * 4) = 0;
    __syncthreads();
    float bw[128];
    { const float* wp = pq_->w_router + (size_t)(wid * 256 + (lane >> 4)) * NE + (lane & 15);
#pragma unroll
      for (int ks = 0; ks < 64; ++ks) { bw[2 * ks] = wp[(size_t)ks * 4 * NE]; bw[2 * ks + 1] = wp[(size_t)ks * 4 * NE + 16]; } }
    for (int t0 = bid; t0 < NTOK / 16; t0 += 2 * G) {
        const int t1 = t0 + G, ntl = (t1 < NTOK / 16) ? 2 : 1;
        router_tile(lds, t0, X1, pq_->norm_ffn_gain, pq_->w_router, pq_->b_router, (unsigned char*)XNB, TOPG, 0, bw);
        if (ntl == 2) router_tile(lds, t1, X1, pq_->norm_ffn_gain, pq_->w_router, pq_->b_router, (unsigned char*)XNB, TOPG, 1, bw);
        const int tq = tid_fresh();
        if (tq < NE) { const int n = *(const LAS int*)(lds + RT_HIST + tq * 4); *(LAS int*)(lds + RT_RBASE + tq * 4) = n ? atomicAdd(&cursor[tq * 32], n) : 0; *(LAS int*)(lds + RT_HIST + tq * 4) = 0; }
        __syncthreads();
        if (tq < ntl * 64) { const int it = *(const LAS int*)(lds + RT_ITEMS + tq * 4), e = it >> 16, tok = ((tq >> 6) ? t1 : t0) * 16 + ((tq >> 2) & 15);
            const int slot = e * NTOK + *(const LAS int*)(lds + RT_RBASE + e * 4) + (it & 0xffff); STOK[slot] = tok; SOF[tok * 4 + (tq & 3)] = slot; }
        __syncthreads();
    }
    }
    xcd_barrier(bar);
    {
        PHASE_ARGS();
        const int tid = tid_fresh(), wid = __builtin_amdgcn_readfirstlane(tid >> 6), lane = tid & 63; (void)wid; (void)lane;
    {
        LAS int* us = (LAS int*)(lds + MEGA_XB + 64); LAS int* so2 = us + 40;
        if (tid < NE) so2[tid] = __hip_atomic_load(&cursor[tid * 32], __ATOMIC_RELAXED, __HIP_MEMORY_SCOPE_AGENT);
        __syncthreads();
        if (tid == 0) { int a = 0; for (int e = 0; e < NE; ++e) { us[e] = a; a += ((so2[e] + 255) >> 8) * 16; } us[NE] = a; }
        __syncthreads();
    }
    {
        LAS int* qs = (LAS int*)(lds + MEGA_XB + 32); LAS int* us = (LAS int*)(lds + MEGA_XB + 64); LAS int* so2 = us + 40;
        int* qctr = (int*)(ws + WS_CTL + 12288 + (bid & 7) * 128);
        int tk_next = 0;
        auto decode = [&](int tkv, int& e, int& nt, int& slot0, int& rows) -> bool {
            const int tq = tid_fresh();
            if (tq == 0) { qs[0] = tkv; qs[1] = -1; }
            __syncthreads();
            const int tk = qs[0];
            const int u = 256 * (tk >> 5) + 32 * (bid & 7) + (tk & 31);
            if (tq < NE) { const int u0 = us[tq], u1 = us[tq + 1]; if (u >= u0 && u < u1) { const int o0 = tq * NTOK, cnt = so2[tq], mtl = (cnt + 255) >> 8, ul = u - u0, mt = ul % mtl;
                int rw = cnt - mt * 256; rw = rw > 256 ? 256 : rw; qs[1] = tq; qs[2] = ul / mtl; qs[3] = o0 + mt * 256; qs[4] = rw; } }
            __syncthreads();
            e = qs[1]; nt = qs[2]; slot0 = qs[3]; rows = qs[4];
            __syncthreads();
            return e >= 0;
        };
        if (tid == 0) tk_next = atomicAdd(qctr, 1);
        int e, nt, slot0, rows;
        if (decode(tk_next, e, nt, slot0, rows)) {
            if (tid == 0) tk_next = atomicAdd(qctr, 1);
            G8Pre cur, nxp;
            g8_addr(cur, DM / 2, STOK + slot0, rows, W1T + (size_t)(e * 16 + nt) * 16 * 16384);
            g8_issue(lds, (const char*)XNB, cur);
            for (;;) {
                int e2 = -1, nt2 = 0, slot2 = 0, rows2 = 0;
                auto next = [&]() -> bool {
                    if (!decode(tk_next, e2, nt2, slot2, rows2)) return false;
                    if (tid_fresh() == 0) tk_next = atomicAdd(qctr, 1);
                    g8_addr(nxp, DM / 2, STOK + slot2, rows2, W1T + (size_t)(e2 * 16 + nt2) * 16 * 16384);
                    g8_issue(lds, (const char*)XNB, nxp);
                    return true; };
                Epi8Swiglu8 ep{(unsigned char*)HMB, pq_->moe_b1 + (size_t)e * 2 * DFF, slot0, nt, rows};
                const bool more = gemm8_unit_ov<false, true>(lds, XNB, cur, 16, ep, next);
                if (!more) break;
                cur = nxp; e = e2; nt = nt2; slot0 = slot2; rows = rows2;
            }
        }
    }
    }
    xcd_barrier(bar);
    {
        PHASE_ARGS();
        const int tid = tid_fresh(), wid = __builtin_amdgcn_readfirstlane(tid >> 6), lane = tid & 63; (void)wid; (void)lane;
    {
        LAS int* us = (LAS int*)(lds + MEGA_XB + 64); LAS int* so2 = us + 40;
        if (tid < NE) so2[tid] = __hip_atomic_load(&cursor[tid * 32], __ATOMIC_RELAXED, __HIP_MEMORY_SCOPE_AGENT);
        __syncthreads();
        if (tid == 0) { int a = 0; for (int e = 0; e < NE; ++e) { us[e] = a; a += ((so2[e] + 255) >> 8) * 8; } us[NE] = a; }
        __syncthreads();
    }
    {
        const LAS int* us = (const LAS int*)(lds + MEGA_XB + 64); const LAS int* so2 = us + 40;
        SrcMoeB src{us, so2, c, G, (const char*)HMB, (const char*)W2T, YB, pq_->moe_b2};
        gemm8_stream<false, true>(lds, DFF / 2, 16, src);
    }
    }
    xcd_barrier(bar);
    {
        PHASE_ARGS();
        const int tid = tid_fresh(), wid = __builtin_amdgcn_readfirstlane(tid >> 6), lane = tid & 63; (void)wid; (void)lane;
    for (int rep = 0; rep < REP_P9; ++rep)
    for (int tok = bid * 8 + wid; tok < NTOK; tok += G * 8) combine_row(tok, X1, YB, SOF, TOPG, pq_->final_gain, pq_->out, lane);
    }
}
#undef counts
#undef cursor
#undef offs
#undef barw
#undef HB
#undef PG
#undef HYT
#undef MIXB
#undef XNB
#undef HMB
#undef YB
#undef H3
#undef FR
#undef Z2T
#undef OF
#undef OB
#undef X1
#undef TOPI
#undef TOPG
#undef STOK
#undef SOF
#undef WINT
#undef WOUTT
#undef W1T
#undef W2T

extern "C" void kernel_launch(void* const* d_in, const int* in_sizes, int n_in, void* d_out, int out_size, void* d_ws, size_t ws_size, hipStream_t stream) {
    if (n_in < 26 || ws_size < WS_END2) return;
    MegaP p{};
    const float** pp = (const float**)&p;
    for (int i = 0; i < 26; ++i) pp[i] = (const float*)d_in[i];
    p.out = (float*)d_out; p.ws = (unsigned char*)d_ws;
    static int grid = 0;
    if (!grid) {
        int dev = 0, cus = 0, per_cu = 0;
        (void)hipGetDevice(&dev);
        (void)hipDeviceGetAttribute(&cus, hipDeviceAttributeMultiprocessorCount, dev);
        (void)hipFuncSetAttribute((const void*)k_mega, hipFuncAttributeMaxDynamicSharedMemorySize, MEGA_LDS);
        (void)hipOccupancyMaxActiveBlocksPerMultiprocessor(&per_cu, (const void*)k_mega, 512, MEGA_LDS);
        if (per_cu < 1) per_cu = 1;
        grid = cus * 1;
        if (grid > 256) grid = 256;
        grid &= ~7;
        if (grid < 8) grid = 8;
    }
    (void)hipMemsetAsync((char*)d_ws + WS_CTL, 0, 65536, stream);
    hipLaunchKernelGGL(k_mega, dim3(grid), dim3(512), MEGA_LDS, stream, p);
}
```
